# Optimizing an MI355X kernel written in HIP

```python
import math
import jax, jax.numpy as jnp
from jax import lax
import numpy as np

D_MODEL = 4096
BATCH = 2
SEQ = 8192
DEPTH = 4

MIX_WIDTH = D_MODEL
S5_WIDTH = D_MODEL // 4
S5_GROUP = 16
S5_GROUPS = S5_WIDTH // S5_GROUP
S5_STATE = 64
HG_WIDTH = (3 * D_MODEL) // 8
HG_HEAD = 128
HG_HEADS = HG_WIDTH // HG_HEAD
GLA_WIDTH = MIX_WIDTH - S5_WIDTH - HG_WIDTH
GLA_HEADS = 4
GLA_V_HEAD = GLA_WIDTH // GLA_HEADS
GLA_K_HEAD = GLA_V_HEAD // 2
GLA_K_WIDTH = GLA_HEADS * GLA_K_HEAD
GLA_GATE_RANK = 16
GLA_GATE_TEMP = 16.0
CHUNK = 64
D_FF = ((8 * D_MODEL + 3 * 256 - 1) // (3 * 256)) * 256
N_MOD = 6
LN_EPS = 1e-5
DEEPNORM_ALPHA = (2.0 * DEPTH) ** 0.25
DEEPNORM_BETA = (8.0 * DEPTH) ** -0.25
IN_SIZES = (S5_WIDTH,
            HG_WIDTH, HG_WIDTH, HG_WIDTH, HG_WIDTH,
            GLA_K_WIDTH, GLA_K_WIDTH, GLA_WIDTH,
            GLA_WIDTH, GLA_GATE_RANK)
IN_WIDTH = sum(IN_SIZES)

kernel_name = 'hybrid_s5_hgrn2_gla_deepnorm_adaln'


def _normalize(x, eps=LN_EPS):
    mu = jnp.mean(x, axis=-1, keepdims=True)
    xc = x - mu
    var = jnp.mean(xc * xc, axis=-1, keepdims=True)
    return xc * lax.rsqrt(var + eps)


def layer_norm(x, gain, bias):
    y = _normalize(x.astype(jnp.float32)) * gain.astype(jnp.float32) + bias.astype(jnp.float32)
    return y.astype(x.dtype)


def chunked_gated_linear_attention(q, k, v, log_g):
    bsz, seq, heads, dk = q.shape
    dv = v.shape[-1]
    n_chunks = seq // CHUNK

    def to_chunks(t):
        return t.reshape(bsz, n_chunks, CHUNK, heads, t.shape[-1]).transpose(1, 0, 3, 2, 4)

    causal = jnp.tril(jnp.ones((CHUNK, CHUNK), dtype=bool))[:, :, None]

    def step(state, inp):
        qc, kc, vc, gc = inp
        b = jnp.cumsum(gc, axis=2)
        diff = b[:, :, :, None, :] - b[:, :, None, :, :]
        decay = jnp.exp(jnp.where(causal, diff, -jnp.inf))
        scores = jnp.einsum('bhijd,bhjd->bhij', qc[:, :, :, None, :] * decay, kc)
        o = jnp.einsum('bhij,bhje->bhie', scores, vc) \
            + jnp.einsum('bhid,bhde->bhie', qc * jnp.exp(b), state)
        b_last = b[:, :, -1:, :]
        state = jnp.exp(b_last)[:, :, 0, :, None] * state \
            + jnp.einsum('bhjd,bhje->bhde', kc * jnp.exp(b_last - b), vc)
        return state, o

    state0 = jnp.zeros((bsz, heads, dk, dv), jnp.float32)
    _, o = lax.scan(step, state0, (to_chunks(q), to_chunks(k), to_chunks(v), to_chunks(log_g)))
    return o.transpose(1, 0, 3, 2, 4).reshape(bsz, seq, heads, dv)


def s5_mixer(u, a_re, a_im, log_dt, b_re, b_im, c_re, c_im, d_skip, glu_w, glu_b):
    f32 = jnp.float32
    bsz, seq, _ = u.shape
    uf = u.astype(f32).reshape(bsz, seq, S5_GROUPS, S5_GROUP)
    ar = a_re.astype(f32)
    ai = a_im.astype(f32)
    dt = jnp.exp(log_dt.astype(f32))[:, None]
    mag = jnp.exp(ar * dt)
    lam_re = mag * jnp.cos(ai * dt)
    lam_im = mag * jnp.sin(ai * dt)
    den = ar * ar + ai * ai
    nr = lam_re - 1.0
    ni = lam_im
    coef_re = ((nr * ar + ni * ai) / den)[..., None]
    coef_im = ((ni * ar - nr * ai) / den)[..., None]
    br = b_re.astype(f32)
    bi = b_im.astype(f32)
    bbar_re = coef_re * br - coef_im * bi
    bbar_im = coef_re * bi + coef_im * br
    bu_re = jnp.einsum('blgh,gph->blgp', uf, bbar_re)
    bu_im = jnp.einsum('blgh,gph->blgp', uf, bbar_im)
    lam_re_seq = jnp.broadcast_to(lam_re[None, None], (1, seq, S5_GROUPS, S5_STATE))
    lam_im_seq = jnp.broadcast_to(lam_im[None, None], (1, seq, S5_GROUPS, S5_STATE))

    def combine(left, right):
        lr1, li1, xr1, xi1 = left
        lr2, li2, xr2, xi2 = right
        return (lr2 * lr1 - li2 * li1,
                lr2 * li1 + li2 * lr1,
                lr2 * xr1 - li2 * xi1 + xr2,
                lr2 * xi1 + li2 * xr1 + xi2)

    _, _, xs_re, xs_im = lax.associative_scan(
        combine, (lam_re_seq, lam_im_seq, bu_re, bu_im), axis=1)
    y = jnp.einsum('blgp,ghp->blgh', xs_re, c_re.astype(f32)) \
        - jnp.einsum('blgp,ghp->blgh', xs_im, c_im.astype(f32)) \
        + uf * d_skip.astype(f32).reshape(S5_GROUPS, S5_GROUP)
    z = jax.nn.gelu(y.reshape(bsz, seq, S5_WIDTH))
    return z * jax.nn.sigmoid(z @ glu_w.astype(f32) + glu_b.astype(f32))


def hgrn2_mixer(q_in, f_in, i_in, g_in, lower_bound, gain, bias):
    f32 = jnp.float32
    bsz, seq, _ = q_in.shape
    shp = (bsz, seq, HG_HEADS, HG_HEAD)
    q = jax.nn.silu(q_in.astype(f32)).reshape(shp)
    f = lower_bound + (1.0 - lower_bound) * jax.nn.sigmoid(f_in.astype(f32))
    k = (1.0 - f).reshape(shp)
    log_f = jnp.log(f).reshape(shp)
    o = chunked_gated_linear_attention(q, k, i_in.astype(f32).reshape(shp), log_f)
    o = _normalize(jax.nn.sigmoid(g_in.astype(f32)).reshape(shp) * o)
    return o.reshape(bsz, seq, HG_WIDTH) * gain.astype(f32) + bias.astype(f32)


def gla_mixer(q_in, k_in, v_in, g_in, gate_lr, w_gate, b_gate, gain):
    f32 = jnp.float32
    bsz, seq, _ = q_in.shape
    kshp = (bsz, seq, GLA_HEADS, GLA_K_HEAD)
    vshp = (bsz, seq, GLA_HEADS, GLA_V_HEAD)
    q = q_in.astype(f32).reshape(kshp) * (GLA_K_HEAD ** -0.5)
    k = k_in.astype(f32).reshape(kshp)
    v = v_in.astype(f32).reshape(vshp)
    log_a = jax.nn.log_sigmoid(gate_lr.astype(f32) @ w_gate.astype(f32) + b_gate.astype(f32)) / GLA_GATE_TEMP
    o = chunked_gated_linear_attention(q, k, v, log_a.reshape(kshp))
    o = o * lax.rsqrt(jnp.mean(o * o, axis=-1, keepdims=True) + LN_EPS)
    return o.reshape(bsz, seq, GLA_WIDTH) * gain.astype(f32) * jax.nn.silu(g_in.astype(f32))


def setup_inputs(seed: int = 0) -> dict:
    key = jax.random.key(seed)
    ks = jax.random.split(key, 40)
    f32 = jnp.float32

    def nrm(i, shape, scale):
        return jax.random.normal(ks[i], shape, f32) * scale

    L = DEPTH
    return {
        'x': nrm(0, (BATCH, SEQ, D_MODEL), 1.0),
        'c': nrm(1, (BATCH, D_MODEL), 1.0),
        'w_ada': nrm(2, (D_MODEL, N_MOD * D_MODEL), 0.1 * D_MODEL ** -0.5),
        'b_ada': nrm(3, (N_MOD * D_MODEL,), 0.01),
        'ada_table': nrm(4, (L, N_MOD, D_MODEL), 0.02),
        'w_in': nrm(5, (L, D_MODEL, IN_WIDTH), D_MODEL ** -0.5),
        'w_out': nrm(6, (L, MIX_WIDTH, D_MODEL), DEEPNORM_BETA * MIX_WIDTH ** -0.5),
        's5_a_re': -0.5 * jnp.exp(nrm(7, (L, S5_GROUPS, S5_STATE), 0.05)),
        's5_a_im': jnp.pi * jnp.arange(S5_STATE, dtype=f32)[None, None, :]
                   + nrm(8, (L, S5_GROUPS, S5_STATE), 0.01),
        's5_log_dt': jax.random.uniform(ks[9], (L, S5_GROUPS), f32,
                                        minval=math.log(1e-3), maxval=math.log(1e-1)),
        's5_b_re': nrm(10, (L, S5_GROUPS, S5_STATE, S5_GROUP), (2.0 * S5_GROUP) ** -0.5),
        's5_b_im': nrm(11, (L, S5_GROUPS, S5_STATE, S5_GROUP), (2.0 * S5_GROUP) ** -0.5),
        's5_c_re': nrm(12, (L, S5_GROUPS, S5_GROUP, S5_STATE), (2.0 * S5_STATE) ** -0.5),
        's5_c_im': nrm(13, (L, S5_GROUPS, S5_GROUP, S5_STATE), (2.0 * S5_STATE) ** -0.5),
        's5_d': nrm(14, (L, S5_WIDTH), 1.0),
        's5_glu_w': nrm(15, (L, S5_WIDTH, S5_WIDTH), S5_WIDTH ** -0.5),
        's5_glu_b': nrm(16, (L, S5_WIDTH), 0.01),
        'hg_lb_raw': nrm(17, (L, HG_WIDTH), 1.0),
        'hg_norm_gain': 1.0 + nrm(18, (L, HG_WIDTH), 0.01),
        'hg_norm_bias': nrm(19, (L, HG_WIDTH), 0.01),
        'gla_w_gate': nrm(20, (L, GLA_GATE_RANK, GLA_K_WIDTH), GLA_GATE_RANK ** -0.5),
        'gla_b_gate': nrm(21, (L, GLA_K_WIDTH), 0.01),
        'gla_norm_gain': 1.0 + nrm(22, (L, GLA_WIDTH), 0.01),
        'w_ffn_gate': nrm(23, (L, D_MODEL, D_FF), D_MODEL ** -0.5),
        'w_ffn_up': nrm(24, (L, D_MODEL, D_FF), D_MODEL ** -0.5),
        'w_ffn_down': nrm(25, (L, D_FF, D_MODEL), DEEPNORM_BETA * D_FF ** -0.5),
        'ln1_gain': 1.0 + nrm(26, (L, D_MODEL), 0.01),
        'ln1_bias': nrm(27, (L, D_MODEL), 0.01),
        'ln2_gain': 1.0 + nrm(28, (L, D_MODEL), 0.01),
        'ln2_bias': nrm(29, (L, D_MODEL), 0.01),
    }


def reference(x, c, w_ada, b_ada, ada_table, w_in, w_out,
              s5_a_re, s5_a_im, s5_log_dt, s5_b_re, s5_b_im, s5_c_re, s5_c_im, s5_d,
              s5_glu_w, s5_glu_b, hg_lb_raw, hg_norm_gain, hg_norm_bias,
              gla_w_gate, gla_b_gate, gla_norm_gain,
              w_ffn_gate, w_ffn_up, w_ffn_down, ln1_gain, ln1_bias, ln2_gain, ln2_bias):
    bsz = x.shape[0]
    cond = (jax.nn.silu(c) @ w_ada + b_ada).reshape(bsz, N_MOD, D_MODEL)
    lb_cum = jnp.cumsum(jax.nn.softmax(hg_lb_raw.astype(jnp.float32), axis=0), axis=0)
    lower_bounds = lb_cum - lb_cum[0:1]
    split_points = np.cumsum(IN_SIZES)[:-1].tolist()

    for l in range(DEPTH):
        mod = (cond + ada_table[l][None]).astype(x.dtype)
        shift1, scale1, gate1 = mod[:, 0, None, :], mod[:, 1, None, :], mod[:, 2, None, :]
        shift2, scale2, gate2 = mod[:, 3, None, :], mod[:, 4, None, :], mod[:, 5, None, :]

        h = x * (1.0 + scale1) + shift1
        proj = h @ w_in[l]
        (u_a, q_b, f_b, i_b, g_b, q_c, k_c, v_c, g_c, lr_c) = jnp.split(proj, split_points, axis=-1)
        y_a = s5_mixer(u_a, s5_a_re[l], s5_a_im[l], s5_log_dt[l], s5_b_re[l], s5_b_im[l],
                       s5_c_re[l], s5_c_im[l], s5_d[l], s5_glu_w[l], s5_glu_b[l])
        y_b = hgrn2_mixer(q_b, f_b, i_b, g_b, lower_bounds[l], hg_norm_gain[l], hg_norm_bias[l])
        y_c = gla_mixer(q_c, k_c, v_c, g_c, lr_c, gla_w_gate[l], gla_b_gate[l], gla_norm_gain[l])
        mixed = jnp.concatenate([y_a, y_b, y_c], axis=-1).astype(x.dtype) @ w_out[l]
        x = layer_norm(DEEPNORM_ALPHA * x + (1.0 + gate1) * mixed, ln1_gain[l], ln1_bias[l])

        h = x * (1.0 + scale2) + shift2
        ffn = (jax.nn.silu(h @ w_ffn_gate[l]) * (h @ w_ffn_up[l])) @ w_ffn_down[l]
        x = layer_norm(DEEPNORM_ALPHA * x + (1.0 + gate2) * ffn, ln2_gain[l], ln2_bias[l])
    return x
```

```cpp
#include <hip/hip_runtime.h>
#include <cstdio>
#include <cstdint>
namespace pg8 {
#define PG8_LAS __attribute__((address_space(3)))
typedef unsigned short bf16_t;
typedef short bf16x8 __attribute__((ext_vector_type(8)));
typedef float f32x4 __attribute__((ext_vector_type(4)));
typedef unsigned u32x4 __attribute__((ext_vector_type(4)));
constexpr int BM = 256, BK = 64, HALF = 128, HTB = HALF * BK * 2  , STAGE_BYTES = 8 * HTB, NXCD = 8, WGM = 8;

__host__ __device__ __forceinline__ int lds_byte(int r, int c) { const int st = (r >> 4) * 2 + (c >> 5), rr = r & 15, cc = c & 31, ob = rr * 64 + cc * 2; return st * 1024 + (ob ^ (((ob >> 9) & 1) << 5)); }
__host__ __device__ __forceinline__ void stage_rc(int b, int& R, int& C) { const int st = b / 1024, sb = b % 1024, swz = sb ^ (((sb >> 9) & 1) << 5); R = (st >> 1) * 16 + swz / 64; C = (st & 1) * 32 + (swz % 64) / 2; }
__host__ __device__ __forceinline__ int perm32(int rho) { const int n = rho >> 4, i = rho & 15; return 8 * (i >> 2) + 4 * n + (i & 3); }

struct Unit { int pm, pn; };
struct Gemm { const bf16_t* A; const bf16_t* Bt; int M, N, K; };

struct StaticOrder {
    int nM, nN, nwg, G, c;
    __host__ __device__ void init(int M, int N, int G_, int c_) { nM = M / BM; nN = N / BM; nwg = nM * nN; G = G_; c = c_; }
    __host__ __device__ bool next(int i, Unit& u) const {
        const long L = (long)i * G + c; if (L >= nwg) return false;
        int wgid = (int)L; { const int q = nwg / NXCD, r = nwg % NXCD, xcd = wgid % NXCD, off = wgid / NXCD; wgid = (xcd < r ? xcd * (q + 1) : r * (q + 1) + (xcd - r) * q) + off; }
        const int nig = WGM * nN, gid = wgid / nig, fm = gid * WGM, gsz = (nM - fm) < WGM ? (nM - fm) : WGM;
        u.pm = fm + ((wgid % nig) % gsz); u.pn = (wgid % nig) / gsz; return true;
    }
    __device__ __forceinline__ void a_ready(const Unit&) const {}
    __device__ __forceinline__ void done(const Unit&) const {}
};
__device__ __forceinline__ unsigned cvt_pk_bf16(float lo, float hi) { unsigned r; asm volatile("v_cvt_pk_bf16_f32 %0, %1, %2" : "=v"(r) : "v"(lo), "v"(hi)); return r; }
typedef float f32x2 __attribute__((ext_vector_type(2)));
template <class Epi, class Sched, bool ALIGN_EPI = false, bool SP2 = false>
__device__ __forceinline__ void gemm_phase(PG8_LAS unsigned char* lds, const Gemm g, const Sched& S, const Epi& E) {
    int tid_ = threadIdx.x; asm volatile("" : "+v"(tid_));
    const int tid = tid_, wid = __builtin_amdgcn_readfirstlane(tid >> 6), lane = tid & 63, wr = wid >> 2, wc = wid & 3, fr = lane & 15, fq = lane >> 4;
    const int K = g.K, nt = K / BK;
    unsigned voffA[2], voffB[2];
#pragma unroll
    for (int i = 0; i < 2; ++i) { int R, C; stage_rc(tid * 16 + i * 8192, R, C); const int Rb = Epi::PERM ? ((R & ~31) + perm32(R & 31)) : R;
        voffA[i] = (unsigned)(R * K + C) * 2u; voffB[i] = (unsigned)(Rb * K + C) * 2u; }
    const size_t kstep = (size_t)(BK * 2);
    const size_t hstep = (size_t)HALF * K * 2;
    const size_t tstep = 2 * hstep;
    const unsigned ldsw = (unsigned)wid * 1024u;
    const int aoff = lds_byte(wr * 64 + fr, fq * 8), boff = lds_byte(wc * 32 + fr, fq * 8);
#define PG8_SA(b, h) (((b) * 2 + (h)) * HTB)
#define PG8_SB(b, h) ((4 + (b) * 2 + (h)) * HTB)
#define PG8_STAGE(bufoff, gbase, voff) do { _Pragma("unroll") for (int _i = 0; _i < 2; ++_i) \
        __builtin_amdgcn_global_load_lds((const unsigned*)((const char*)(gbase) + (voff)[_i]), (PG8_LAS unsigned*)(lds + (bufoff) + ldsw + _i * 8192), 16, 0, 0); } while (0)
#define PG8_LDA(dst, b, h) do { _Pragma("unroll") for (int m = 0; m < 4; ++m) _Pragma("unroll") for (int k = 0; k < 2; ++k) dst[m][k] = *(const PG8_LAS bf16x8*)(lds + PG8_SA(b, h) + aoff + m * 2048 + k * 1024); } while (0)
#define PG8_LDB(dst, b, h) do { _Pragma("unroll") for (int n = 0; n < 2; ++n) _Pragma("unroll") for (int k = 0; k < 2; ++k) dst[n][k] = *(const PG8_LAS bf16x8*)(lds + PG8_SB(b, h) + boff + n * 2048 + k * 1024); } while (0)
#define PG8_MMA(ai, bj, At, Bt) do { __builtin_amdgcn_s_setprio(1); _Pragma("unroll") for (int m = 0; m < 4; ++m) _Pragma("unroll") for (int n = 0; n < 2; ++n) _Pragma("unroll") for (int k = 0; k < 2; ++k) \
        acc[ai][bj][m][n] = __builtin_amdgcn_mfma_f32_16x16x32_bf16(Bt[n][k], At[m][k], acc[ai][bj][m][n], 0, 0, 0); __builtin_amdgcn_s_setprio(0); } while (0)
#define PG8_WAIT_V(n) asm volatile("s_waitcnt vmcnt(" #n ")" ::: "memory")
#define PG8_WAIT_L(n) asm volatile("s_waitcnt lgkmcnt(" #n ")" ::: "memory")
#define PG8_BAR __builtin_amdgcn_s_barrier()
#define PG8_SCHED __builtin_amdgcn_sched_barrier(0)
    Unit cur, nxt; int ui = 0;
    if (!S.next(0, cur)) return;
    f32x4 acc[2][2][4][2];
#pragma unroll
    for (int a = 0; a < 2; ++a)
#pragma unroll
        for (int b = 0; b < 2; ++b)
#pragma unroll
            for (int m = 0; m < 4; ++m)
#pragma unroll
                for (int n = 0; n < 2; ++n) acc[a][b][m][n] = (f32x4){0.f, 0.f, 0.f, 0.f};
    bf16x8 At[4][2], B0[2][2], B1[2][2];
    const char* cA = (const char*)g.A + (size_t)cur.pm * tstep; const char* cB = (const char*)g.Bt + (size_t)cur.pn * tstep;
    S.a_ready(cur);
    if constexpr (SP2) {
        PG8_STAGE(PG8_SB(0, 0), cB, voffB); PG8_STAGE(PG8_SB(0, 1), cB + hstep, voffB); PG8_STAGE(PG8_SA(0, 0), cA, voffA); PG8_STAGE(PG8_SA(0, 1), cA + hstep, voffA);
        if (wr == 1) PG8_BAR;
        PG8_WAIT_V(2); PG8_BAR;
        PG8_STAGE(PG8_SB(1, 0), cB + kstep, voffB); PG8_STAGE(PG8_SA(1, 0), cA + kstep, voffA); PG8_STAGE(PG8_SB(1, 1), cB + hstep + kstep, voffB);
        PG8_WAIT_V(6); PG8_BAR;
    } else {
        PG8_STAGE(PG8_SB(0, 0), cB, voffB); PG8_STAGE(PG8_SA(0, 0), cA, voffA); PG8_STAGE(PG8_SB(0, 1), cB + hstep, voffB); PG8_STAGE(PG8_SA(0, 1), cA + hstep, voffA);
        if (wr == 1) PG8_BAR;
        PG8_WAIT_V(4); PG8_BAR;
        PG8_STAGE(PG8_SB(1, 0), cB + kstep, voffB); PG8_STAGE(PG8_SA(1, 0), cA + kstep, voffA); PG8_STAGE(PG8_SB(1, 1), cB + hstep + kstep, voffB);
        PG8_WAIT_V(6); PG8_BAR;
    }
    for (;;) {
        const bool has_next = S.next(ui + 1, nxt);
        const char* nA = has_next ? (const char*)g.A + (size_t)nxt.pm * tstep : cA; const char* nB = has_next ? (const char*)g.Bt + (size_t)nxt.pn * tstep : cB;
        for (int t = 0; t < nt; t += 2) {
            const bool last = (t == nt - 2);
            const char* a1 = cA + (size_t)(t + 1) * kstep;
            const char* a2 = last ? nA : cA + (size_t)(t + 2) * kstep; const char* b2 = last ? nB : cB + (size_t)(t + 2) * kstep;
            const char* a3 = a2 + kstep; const char* b3 = b2 + kstep;
            if (last && has_next) S.a_ready(nxt);
            if constexpr (SP2) {
            PG8_LDB(B0, 0, 0); PG8_LDB(B1, 0, 1); PG8_SCHED; PG8_LDA(At, 0, 0); PG8_STAGE(PG8_SA(1, 1), a1 + hstep, voffA);
            PG8_WAIT_V(8); PG8_WAIT_L(0); PG8_BAR; PG8_MMA(0, 0, At, B0); PG8_MMA(0, 1, At, B1); PG8_BAR; PG8_SCHED;
            PG8_LDA(At, 0, 1); PG8_STAGE(PG8_SB(0, 0), b2, voffB); PG8_STAGE(PG8_SB(0, 1), b2 + hstep, voffB); PG8_STAGE(PG8_SA(0, 0), a2, voffA);
            PG8_WAIT_V(8); PG8_WAIT_L(0); PG8_BAR; PG8_MMA(1, 0, At, B0); PG8_MMA(1, 1, At, B1); PG8_BAR; PG8_SCHED;
            PG8_LDB(B0, 1, 0); PG8_LDB(B1, 1, 1); PG8_SCHED; PG8_LDA(At, 1, 0); PG8_STAGE(PG8_SA(0, 1), a2 + hstep, voffA);
            PG8_WAIT_V(8); PG8_WAIT_L(0); PG8_BAR; PG8_MMA(0, 0, At, B0); PG8_MMA(0, 1, At, B1); PG8_BAR; PG8_SCHED;
            PG8_LDA(At, 1, 1); PG8_STAGE(PG8_SB(1, 0), b3, voffB); PG8_STAGE(PG8_SB(1, 1), b3 + hstep, voffB); PG8_STAGE(PG8_SA(1, 0), a3, voffA);
            PG8_WAIT_V(8); PG8_WAIT_L(0); PG8_BAR; PG8_MMA(1, 0, At, B0); PG8_MMA(1, 1, At, B1); PG8_BAR; PG8_SCHED;
            } else {
            PG8_LDB(B0, 0, 0); PG8_SCHED; PG8_LDA(At, 0, 0); PG8_STAGE(PG8_SA(1, 1), a1 + hstep, voffA);
            PG8_WAIT_L(8); PG8_BAR; PG8_WAIT_L(0); PG8_MMA(0, 0, At, B0); PG8_BAR; PG8_SCHED;
            PG8_LDB(B1, 0, 1); PG8_STAGE(PG8_SB(0, 0), b2, voffB);
            PG8_BAR; PG8_WAIT_L(0); PG8_MMA(0, 1, At, B1); PG8_BAR;
            PG8_LDA(At, 0, 1); PG8_STAGE(PG8_SA(0, 0), a2, voffA);
            PG8_BAR; PG8_WAIT_L(0); PG8_MMA(1, 0, At, B0); PG8_BAR; PG8_SCHED;
            PG8_STAGE(PG8_SB(0, 1), b2 + hstep, voffB);
            PG8_WAIT_V(6); PG8_BAR; PG8_MMA(1, 1, At, B1); PG8_BAR;
            PG8_LDB(B0, 1, 0); PG8_SCHED; PG8_LDA(At, 1, 0); PG8_STAGE(PG8_SA(0, 1), a2 + hstep, voffA);
            PG8_WAIT_L(8); PG8_BAR; PG8_WAIT_L(0); PG8_MMA(0, 0, At, B0); PG8_BAR; PG8_SCHED;
            PG8_LDB(B1, 1, 1); PG8_STAGE(PG8_SB(1, 0), b3, voffB);
            PG8_BAR; PG8_WAIT_L(0); PG8_MMA(0, 1, At, B1); PG8_BAR;
            PG8_LDA(At, 1, 1); PG8_STAGE(PG8_SA(1, 0), a3, voffA);
            PG8_BAR; PG8_WAIT_L(0); PG8_MMA(1, 0, At, B0); PG8_BAR; PG8_SCHED;
            PG8_STAGE(PG8_SB(1, 1), b3 + hstep, voffB);
            PG8_WAIT_V(6); PG8_BAR; PG8_MMA(1, 1, At, B1); PG8_BAR;
            }
        }
        if constexpr (ALIGN_EPI) { if (wr == 0) PG8_BAR; }
        if constexpr (!Epi::AFTER_DRAIN) { E(acc, cur, wr, wc, fr, fq); S.done(cur); }
        if (!has_next) break;
#pragma unroll
        for (int a = 0; a < 2; ++a)
#pragma unroll
            for (int b = 0; b < 2; ++b)
#pragma unroll
                for (int m = 0; m < 4; ++m)
#pragma unroll
                    for (int n = 0; n < 2; ++n) acc[a][b][m][n] = (f32x4){0.f, 0.f, 0.f, 0.f};
        cur = nxt; cA = nA; cB = nB; ++ui;
        if constexpr (ALIGN_EPI) { if (wr == 1) PG8_BAR; }
    }
    PG8_WAIT_V(0);
    if constexpr (!ALIGN_EPI) { if (wr == 0) PG8_BAR; }
    PG8_BAR;
    if constexpr (Epi::AFTER_DRAIN) { E.fused(acc, cur, wr, wc, fr, fq, lds, wid, lane); S.done(cur); }
#undef PG8_SA
#undef PG8_SB
#undef PG8_STAGE
#undef PG8_LDA
#undef PG8_LDB
#undef PG8_MMA
#undef PG8_WAIT_V
#undef PG8_WAIT_L
#undef PG8_BAR
#undef PG8_SCHED
}
}
#define LAS __attribute__((address_space(3)))
#define XB_TMO      128
#define XB_XCNT(j)  (256  + 64 * (j))
#define XB_XSUB(j)  (1280 + 64 * (j))
#define XB_XGEN(j)  (2304 + 64 * (j))
#define XB_TOP      3328
#define XB_TOPGEN   3392
#define XCD_BAR_WORDS 3456
#define XB_SPIN_CAP (1u << 18)

__device__ __forceinline__ unsigned xb_ld(unsigned* p)              { return __hip_atomic_load(p, __ATOMIC_RELAXED, __HIP_MEMORY_SCOPE_AGENT); }
__device__ __forceinline__ unsigned xb_add(unsigned* p, unsigned v) { return __hip_atomic_fetch_add(p, v, __ATOMIC_RELAXED, __HIP_MEMORY_SCOPE_AGENT); }
__device__ __forceinline__ unsigned xb_xcc_id() { return (unsigned)__builtin_amdgcn_s_getreg((3 << 11) | 20) & 0xFu; }
#define XB_SPIN(cond, bar) do { unsigned _sp = 0; while (cond) { __builtin_amdgcn_s_sleep(1); \
    if ((++_sp & 255u) == 0u) { if (xb_ld(&(bar)[XB_TMO])) break; if (_sp > XB_SPIN_CAP) { atomicAdd(&(bar)[XB_TMO], 1u); break; } } } } while (0)

struct XcdBarrier {
    unsigned* bar; unsigned x;
    volatile LAS unsigned* st;
};

__device__ __forceinline__ XcdBarrier xcd_barrier_post(unsigned* bar, volatile LAS unsigned* st) {
    XcdBarrier b; b.bar = bar; b.x = xb_xcc_id(); b.st = st;
    if (threadIdx.x == 0) (void)xb_add(&bar[XB_XCNT(b.x)], 1u);
    return b;
}
__device__ __forceinline__ void xcd_barrier_complete(unsigned* bar, unsigned x, unsigned& nloc, unsigned& nx) {
    const unsigned G = gridDim.x * gridDim.y * gridDim.z;
    unsigned sum, cnt, mine, sp = 0u;
    for (;;) {
        sum = 0u; cnt = 0u; mine = 0u;
#pragma unroll
        for (unsigned j = 0; j < 16; ++j) { const unsigned c = xb_ld(&bar[XB_XCNT(j)]); sum += c; cnt += (c > 0u) ? 1u : 0u; mine = (j == x) ? c : mine; }
        if (sum == G) break;
        __builtin_amdgcn_s_sleep(1);
        if ((++sp & 255u) == 0u) { if (xb_ld(&bar[XB_TMO])) break; if (sp > XB_SPIN_CAP) { atomicAdd(&bar[XB_TMO], 1u); break; } }
    }
    nloc = mine > 0u ? mine : 1u; nx = cnt > 0u ? cnt : 1u;
}

__device__ __forceinline__ void xcd_barrier(const XcdBarrier& b) {
    asm volatile("s_waitcnt vmcnt(0)" ::: "memory");
    __syncthreads();
    if (threadIdx.x == 0) {
        unsigned* bar = b.bar;
        __builtin_amdgcn_s_waitcnt(0);
        unsigned nloc = b.st[0], nx = b.st[1];
        if (nloc == 0u) { xcd_barrier_complete(bar, b.x, nloc, nx); b.st[0] = nloc; b.st[1] = nx; }
        const unsigned old = xb_add(&bar[XB_XSUB(b.x)], 1u);
        const unsigned gen = old / nloc;
        if (old + 1u == (gen + 1u) * nloc) {
            __builtin_amdgcn_fence(__ATOMIC_RELEASE, "agent");
            asm volatile("s_waitcnt vmcnt(0)" ::: "memory");
            const unsigned og = xb_add(&bar[XB_TOP], 1u);
            const unsigned tg = og / nx;
            if (og + 1u == (tg + 1u) * nx) xb_add(&bar[XB_TOPGEN], 1u);
            else XB_SPIN(xb_ld(&bar[XB_TOPGEN]) == tg, bar);
            __builtin_amdgcn_fence(__ATOMIC_ACQUIRE, "agent");
            xb_add(&bar[XB_XGEN(b.x)], 1u);
            asm volatile("s_waitcnt vmcnt(0)" ::: "memory");
        } else {
            XB_SPIN(xb_ld(&bar[XB_XGEN(b.x)]) == gen, bar);
            __builtin_amdgcn_fence(__ATOMIC_ACQUIRE, "agent");
            asm volatile("s_waitcnt vmcnt(0)" ::: "memory");
        }
    }
    __syncthreads();
}

constexpr int DM = 4096, NB = 2, SEQ = 8192, MTOK = NB * SEQ, DEPTH = 4;
constexpr int S5W = 1024;
constexpr int HGW = 1536;
constexpr int GLKW = 768;
constexpr int INW = 11792, INP = 12032, DFF = 11008;
constexpr int OW = 3072;
constexpr int C_U = 0, C_QB = 1024, C_FB = 2560, C_IB = 4096, C_GB = 5632, C_QC = 7168, C_KC = 7936, C_VC = 8704, C_GC = 10240, C_LR = 11776;
constexpr float LN_EPS = 1e-5f;
constexpr float ALPHA = 1.6817928305074290861f;
constexpr float GLA_QSCALE = 0.07216878364870322f;

enum { I_X = 0, I_C, I_WADA, I_BADA, I_TABLE, I_WIN, I_WOUT, I_AREAL, I_AIMAG, I_LOGDT, I_BRE, I_BIM, I_CRE, I_CIM, I_S5D, I_GLUW, I_GLUB,
       I_LBRAW, I_HGG, I_HGB, I_WGATE, I_BGATE, I_GLG, I_WFG, I_WFU, I_WFD, I_LN1G, I_LN1B, I_LN2G, I_LN2B, N_IN };

constexpr size_t MiB = 1u << 20;
constexpr size_t WS_CTL = 0, CTL_ZERO_BYTES = 1 * MiB;
constexpr size_t WS_MOD = 1 * MiB;
constexpr size_t WS_MISC = 2 * MiB;
constexpr size_t WS_ROWSTATS = 3 * MiB;
constexpr size_t WS_ROWPART = 4 * MiB;
constexpr size_t WS_CONDPART = 12 * MiB;
constexpr size_t WS_H = 24 * MiB;
constexpr size_t WS_MIXED = WS_H + 128 * MiB;
constexpr size_t WS_Z = WS_MIXED + 128 * MiB;
constexpr size_t WS_O = WS_Z + 32 * MiB;
constexpr size_t WS_P = WS_O + 192 * MiB;
constexpr size_t WS_WT = WS_P + 376 * MiB;
constexpr size_t WT_IN = 0, WT_OUT = 94 * MiB, WT_GU = 126 * MiB, WT_DN = 298 * MiB, WT_GLU = 384 * MiB, WT_LAYER = 386 * MiB;
constexpr size_t WS_END = WS_WT + DEPTH * WT_LAYER;
static_assert((size_t)INP * DM * 2 == 94 * MiB && (size_t)DM * DM * 2 == 32 * MiB && (size_t)2 * DFF * DM * 2 == 172 * MiB && (size_t)DM * DFF * 2 == 86 * MiB, "weight map");
static_assert((size_t)MTOK * INP * 2 == 376 * MiB && (size_t)MTOK * DFF * 2 <= 376 * MiB, "activation map");

constexpr int RING_BYTES = 131072;
constexpr int LDSCTL_OFF = 135168;
constexpr int LDS_BYTES = 147456;

#ifndef LAS
#define LAS __attribute__((address_space(3)))
#endif
typedef unsigned short bf16_t;
typedef float f32x4 __attribute__((ext_vector_type(4)));
typedef float f32x2 __attribute__((ext_vector_type(2)));
typedef unsigned u32x4 __attribute__((ext_vector_type(4)));
typedef unsigned u32x2 __attribute__((ext_vector_type(2)));
#define LDS_WAIT() asm volatile("s_waitcnt lgkmcnt(0)" ::: "memory")
#define VM_WAIT() asm volatile("s_waitcnt vmcnt(0)" ::: "memory")
using pg8::cvt_pk_bf16;

__device__ __forceinline__ float bf_lo(unsigned w) { return __uint_as_float(w << 16); }
__device__ __forceinline__ float bf_hi(unsigned w) { return __uint_as_float(w & 0xffff0000u); }
__device__ __forceinline__ float bf2f(bf16_t b) { return __uint_as_float(((unsigned)b) << 16); }
__device__ __forceinline__ float wave_sum(float v) {
#pragma unroll
    for (int o = 1; o < 64; o <<= 1) v += __shfl_xor(v, o);
    return v;
}
__device__ __forceinline__ float sigmoidf_(float x) { return 1.0f / (1.0f + __expf(-x)); }
__device__ __forceinline__ float gelu_tanh(float y) { const float a = 0.7978845608028654f * (y + 0.044715f * y * y * y); const float t = 1.0f - 2.0f / (1.0f + __expf(2.0f * a)); return 0.5f * y * (1.0f + t); }

struct EpiProj {
    static constexpr bool PERM = true, AFTER_DRAIN = false;
    bf16_t* P;
    __device__ __forceinline__ void operator()(const f32x4 (&acc)[2][2][4][2], const pg8::Unit& u, int wr, int wc, int fr, int fq) const {
        const int row0 = u.pm * 256 + wr * 64 + fr, col0 = u.pn * 256 + wc * 32 + 8 * fq;
#pragma unroll
        for (int ai = 0; ai < 2; ++ai)
#pragma unroll
            for (int m = 0; m < 4; ++m) { bf16_t* rowp = P + (size_t)(row0 + ai * 128 + m * 16) * INP + col0;
#pragma unroll
                for (int bj = 0; bj < 2; ++bj) { const f32x4 v0 = acc[ai][bj][m][0], v1 = acc[ai][bj][m][1];
                    u32x4 w; w.x = cvt_pk_bf16(v0[0], v0[1]); w.y = cvt_pk_bf16(v0[2], v0[3]); w.z = cvt_pk_bf16(v1[0], v1[1]); w.w = cvt_pk_bf16(v1[2], v1[3]);
                    *(u32x4*)(rowp + bj * 128) = w; } }
    }
};
struct EpiSwiglu {
    static constexpr bool PERM = true, AFTER_DRAIN = false;
    bf16_t* HID;
    __device__ __forceinline__ void operator()(const f32x4 (&acc)[2][2][4][2], const pg8::Unit& u, int wr, int wc, int fr, int fq) const {
        const int row0 = u.pm * 256 + wr * 64 + fr, col0 = u.pn * 128 + wc * 32 + 8 * fq;
#pragma unroll
        for (int ai = 0; ai < 2; ++ai)
#pragma unroll
            for (int m = 0; m < 4; ++m) { bf16_t* rowp = HID + (size_t)(row0 + ai * 128 + m * 16) * DFF + col0;
                float o[8];
#pragma unroll
                for (int n = 0; n < 2; ++n)
#pragma unroll
                    for (int j = 0; j < 4; ++j) { const float g = acc[ai][0][m][n][j], up = acc[ai][1][m][n][j]; o[n * 4 + j] = g * __builtin_amdgcn_rcpf(1.0f + __expf(-g)) * up; }
                u32x4 w; w.x = cvt_pk_bf16(o[0], o[1]); w.y = cvt_pk_bf16(o[2], o[3]); w.z = cvt_pk_bf16(o[4], o[5]); w.w = cvt_pk_bf16(o[6], o[7]);
                *(u32x4*)rowp = w; }
    }
};
struct EpiGlu {
    static constexpr bool PERM = true, AFTER_DRAIN = false;
    const bf16_t* Z; bf16_t* MIXED; const float* bias;
    __device__ __forceinline__ void operator()(const f32x4 (&acc)[2][2][4][2], const pg8::Unit& u, int wr, int wc, int fr, int fq) const {
        const int row0 = u.pm * 256 + wr * 64 + fr, col0 = u.pn * 256 + wc * 32 + 8 * fq;
#pragma unroll
        for (int bj = 0; bj < 2; ++bj) {
            const f32x4 b0 = *(const f32x4*)(bias + col0 + bj * 128), b1 = *(const f32x4*)(bias + col0 + bj * 128 + 4);
#pragma unroll
            for (int ai = 0; ai < 2; ++ai)
#pragma unroll
                for (int m = 0; m < 4; ++m) { const size_t r = (size_t)(row0 + ai * 128 + m * 16);
                    const u32x4 zz = *(const u32x4*)(Z + r * S5W + col0 + bj * 128);
                    const f32x4 v0 = acc[ai][bj][m][0] + b0, v1 = acc[ai][bj][m][1] + b1;
                    u32x4 w;
                    w.x = cvt_pk_bf16(bf_lo(zz.x) * sigmoidf_(v0[0]), bf_hi(zz.x) * sigmoidf_(v0[1]));
                    w.y = cvt_pk_bf16(bf_lo(zz.y) * sigmoidf_(v0[2]), bf_hi(zz.y) * sigmoidf_(v0[3]));
                    w.z = cvt_pk_bf16(bf_lo(zz.z) * sigmoidf_(v1[0]), bf_hi(zz.z) * sigmoidf_(v1[1]));
                    w.w = cvt_pk_bf16(bf_lo(zz.w) * sigmoidf_(v1[2]), bf_hi(zz.w) * sigmoidf_(v1[3]));
                    *(u32x4*)(MIXED + r * DM + col0 + bj * 128) = w;
                    if (m & 1) asm volatile("" ::: "memory"); }
        }
    }
};
struct EpiResid {
    static constexpr bool PERM = false, AFTER_DRAIN = false;
    const float* base; float* out; const float* rowstats; const float* lng; const float* lnb; const float* gate0; float* rowpart;
    __device__ __forceinline__ void operator()(const f32x4 (&acc)[2][2][4][2], const pg8::Unit& u, int wr, int wc, int fr, int fq) const {
        const int rowb = u.pm * 256 + wr * 64 + fr, col0 = u.pn * 256 + wc * 32 + 4 * fq;
        const float* gp = gate0 + (u.pm >= 32 ? 6 * DM : 0);
#pragma unroll
        for (int ai = 0; ai < 2; ++ai)
#pragma unroll
            for (int m = 0; m < 4; ++m) { const int row = rowb + ai * 128 + m * 16;
                const f32x2 st = *(const f32x2*)(rowstats + (size_t)row * 2);
                float s1 = 0.f, s2 = 0.f;
#pragma unroll
                for (int bj = 0; bj < 2; ++bj)
#pragma unroll
                    for (int n = 0; n < 2; ++n) { const int c = col0 + bj * 128 + n * 16; const size_t off = (size_t)row * DM + c;
                        const f32x4 vb = *(const f32x4*)(base + off);
                        const f32x4 A = *(const f32x4*)(lng + c), Bc = *(const f32x4*)(lnb + c), Gm = *(const f32x4*)(gp + c);
                        const f32x4 o = (((vb - st.x) * st.y) * A + Bc) * ALPHA + (Gm + 1.0f) * acc[ai][bj][m][n];
                        *(f32x4*)(out + off) = o;
                        s1 += (o[0] + o[1]) + (o[2] + o[3]); s2 += (o[0] * o[0] + o[1] * o[1]) + (o[2] * o[2] + o[3] * o[3]); }
                s1 += __shfl_xor(s1, 16); s1 += __shfl_xor(s1, 32); s2 += __shfl_xor(s2, 16); s2 += __shfl_xor(s2, 32);
                if (fq == 0) *(f32x2*)(rowpart + ((size_t)row * 64 + u.pn * 4 + wc) * 2) = (f32x2){s1, s2};
                asm volatile("" ::: "memory"); }
    }
};

struct Args { const float* in[N_IN]; float* out; unsigned char* ws; int ph_lo, ph_hi; };

__device__ __forceinline__ void transpose_item(const float* W, int N, int k0, int n0, bf16_t* WT, int drow0, int Kd, LAS float* scr, int lane) {
    const int nl = 4 * (lane & 15), kq = lane >> 4;
    const bool valid = (n0 + nl) < N;
    f32x4 v[16];
#pragma unroll
    for (int i = 0; i < 16; ++i) { const int k = 4 * i + kq; v[i] = valid ? *(const f32x4*)(W + (size_t)(k0 + k) * N + n0 + nl) : (f32x4){0.f, 0.f, 0.f, 0.f}; }
#pragma unroll
    for (int i = 0; i < 16; ++i) { const int k = 4 * i + kq; LAS float* s = scr + k * 65 + nl; s[0] = v[i][0]; s[1] = v[i][1]; s[2] = v[i][2]; s[3] = v[i][3]; }
    LDS_WAIT();
    const int c = lane & 7;
#pragma unroll
    for (int j = 0; j < 8; ++j) { const int n = (lane >> 3) + 8 * j; const LAS float* s = scr + (8 * c) * 65 + n;
        u32x4 o; o.x = cvt_pk_bf16(s[0], s[65]); o.y = cvt_pk_bf16(s[130], s[195]); o.z = cvt_pk_bf16(s[260], s[325]); o.w = cvt_pk_bf16(s[390], s[455]);
        *(u32x4*)(WT + (size_t)(drow0 + n) * Kd + k0 + 8 * c) = o; }
    LDS_WAIT();
}
constexpr int NIT_IN = 64 * 188, NIT_OUT = 64 * 64, NIT_G = 64 * 172, NIT_DN = 172 * 64, NIT_GLU = 16 * 16;
constexpr int NIT_LAYER = NIT_IN + NIT_OUT + 2 * NIT_G + NIT_DN + NIT_GLU;
constexpr int NIT_TR = DEPTH * NIT_LAYER, NIT_COND = 64 * 96;

__device__ __forceinline__ void phase_prologue(const Args& a, LAS unsigned char* lds, int wave, int lane) {
    LAS float* scr = (LAS float*)(lds + wave * 16640);
    const int gw = blockIdx.x * 8 + wave, NGW = gridDim.x * 8;
    for (int it = gw; it < NIT_TR + NIT_COND; it += NGW) {
        if (it < NIT_TR) {
            const int l = it / NIT_LAYER; int r = it % NIT_LAYER;
            unsigned char* wt = a.ws + WS_WT + (size_t)l * WT_LAYER;
            if (r < NIT_IN) { const int kb = r / 188, nb = r % 188; transpose_item(a.in[I_WIN] + (size_t)l * DM * INW, INW, 64 * kb, 64 * nb, (bf16_t*)(wt + WT_IN), 64 * nb, DM, scr, lane); continue; } r -= NIT_IN;
            if (r < NIT_OUT) { const int kb = r / 64, nb = r % 64; transpose_item(a.in[I_WOUT] + (size_t)l * DM * DM, DM, 64 * kb, 64 * nb, (bf16_t*)(wt + WT_OUT), 64 * nb, DM, scr, lane); continue; } r -= NIT_OUT;
            if (r < NIT_G) { const int kb = r / 172, nb = r % 172, n0 = 64 * nb; transpose_item(a.in[I_WFG] + (size_t)l * DM * DFF, DFF, 64 * kb, n0, (bf16_t*)(wt + WT_GU), 256 * (n0 / 128) + (n0 % 128), DM, scr, lane); continue; } r -= NIT_G;
            if (r < NIT_G) { const int kb = r / 172, nb = r % 172, n0 = 64 * nb; transpose_item(a.in[I_WFU] + (size_t)l * DM * DFF, DFF, 64 * kb, n0, (bf16_t*)(wt + WT_GU), 256 * (n0 / 128) + 128 + (n0 % 128), DM, scr, lane); continue; } r -= NIT_G;
            if (r < NIT_DN) { const int kb = r / 64, nb = r % 64; transpose_item(a.in[I_WFD] + (size_t)l * DFF * DM, DM, 64 * kb, 64 * nb, (bf16_t*)(wt + WT_DN), 64 * nb, DFF, scr, lane); continue; } r -= NIT_DN;
            { const int kb = r / 16, nb = r % 16; transpose_item(a.in[I_GLUW] + (size_t)l * S5W * S5W, S5W, 64 * kb, 64 * nb, (bf16_t*)(wt + WT_GLU), 64 * nb, S5W, scr, lane); }
        } else {
            const int item = it - NIT_TR, kb = item / 96, jb = item % 96, k0 = 64 * kb, j0 = 256 * jb + 4 * lane;
            const float* c = a.in[I_C];
            float c0 = c[k0 + lane], c1 = c[DM + k0 + lane];
            c0 = c0 / (1.0f + expf(-c0)); c1 = c1 / (1.0f + expf(-c1));
            f32x4 a0 = (f32x4){0.f, 0.f, 0.f, 0.f}, a1 = a0;
            const float* w = a.in[I_WADA] + (size_t)k0 * (6 * DM) + j0;
#pragma unroll 8
            for (int kk = 0; kk < 64; ++kk) { const f32x4 wv = *(const f32x4*)(w + (size_t)kk * (6 * DM));
                const float s0 = __int_as_float(__builtin_amdgcn_readlane(__float_as_int(c0), kk)), s1 = __int_as_float(__builtin_amdgcn_readlane(__float_as_int(c1), kk));
                a0 += wv * s0; a1 += wv * s1; }
            float* cp = (float*)(a.ws + WS_CONDPART);
            *(f32x4*)(cp + (size_t)(kb * 2 + 0) * (6 * DM) + j0) = a0;
            *(f32x4*)(cp + (size_t)(kb * 2 + 1) * (6 * DM) + j0) = a1;
        }
    }
}
__device__ __forceinline__ void phase_mod(const Args& a) {
    const int gt = blockIdx.x * 512 + threadIdx.x, NT = gridDim.x * 512;
    const float* cp = (const float*)(a.ws + WS_CONDPART);
    float* mod = (float*)(a.ws + WS_MOD); float* misc = (float*)(a.ws + WS_MISC);
    for (int idx = gt; idx < NB * 6 * DM; idx += NT) {
        const int b = idx / (6 * DM), j = idx % (6 * DM);
        float s = a.in[I_BADA][j];
        for (int kb = 0; kb < 64; ++kb) s += cp[(size_t)(kb * 2 + b) * (6 * DM) + j];
        for (int l = 0; l < DEPTH; ++l) mod[(size_t)((l * 2 + b) * 6) * DM + j] = s + a.in[I_TABLE][(size_t)l * 6 * DM + j];
    }
    for (int idx = gt; idx < DM; idx += NT) { misc[idx] = 1.0f; misc[DM + idx] = 0.0f; }
    for (int idx = gt; idx < HGW; idx += NT) {
        const float* raw = a.in[I_LBRAW]; float r[DEPTH], mx = -3.0e38f;
#pragma unroll
        for (int l = 0; l < DEPTH; ++l) { r[l] = raw[l * HGW + idx]; mx = fmaxf(mx, r[l]); }
        float e[DEPTH], sum = 0.f;
#pragma unroll
        for (int l = 0; l < DEPTH; ++l) { e[l] = expf(r[l] - mx); sum += e[l]; }
        float cum = 0.f;
#pragma unroll
        for (int l = 0; l < DEPTH; ++l) { misc[2 * DM + l * HGW + idx] = cum; if (l + 1 < DEPTH) cum += e[l + 1] / sum; }
    }
}

template <int MODE>
__device__ __forceinline__ void phase_lnapply(const float* vsrc, const float* rowpart, float* rowstats, const float* lng, const float* lnb, const float* modp, int i_shift, int i_scale,
                                              bf16_t* H, float* outf, LAS unsigned char* lds, int wave, int lane) {
    LAS f32x2* st = (LAS f32x2*)lds;
    for (int blk = blockIdx.x; blk < MTOK / 64; blk += gridDim.x) {
        const int r0 = blk * 64, b = (r0 >= SEQ) ? 1 : 0;
        for (int rr = 0; rr < 8; ++rr) { const int rl = wave * 8 + rr, r = r0 + rl; float mu = 0.f, rs = 1.f;
            if (MODE != 0) { const f32x2 p = *(const f32x2*)(rowpart + ((size_t)r * 64 + lane) * 2); const float s1 = wave_sum(p.x), s2 = wave_sum(p.y);
                mu = s1 * (1.0f / DM); const float var = fmaxf(s2 * (1.0f / DM) - mu * mu, 0.f); rs = 1.0f / sqrtf(var + LN_EPS); }
            if (lane == 0) { st[rl] = (f32x2){mu, rs}; if (MODE != 2) *(f32x2*)(rowstats + (size_t)r * 2) = (f32x2){mu, rs}; } }
        __syncthreads();
        f32x4 A[2], B[2];
#pragma unroll
        for (int jj = 0; jj < 2; ++jj) { const int c = 512 * wave + 256 * jj + 4 * lane;
            f32x4 g = (f32x4){1.f, 1.f, 1.f, 1.f}, bb = (f32x4){0.f, 0.f, 0.f, 0.f};
            if (MODE != 0) { g = *(const f32x4*)(lng + c); bb = *(const f32x4*)(lnb + c); }
            if (MODE != 2) { const f32x4 sc = *(const f32x4*)(modp + (size_t)(b * 6 + i_scale) * DM + c) + 1.0f, sh = *(const f32x4*)(modp + (size_t)(b * 6 + i_shift) * DM + c); A[jj] = g * sc; B[jj] = bb * sc + sh; }
            else { A[jj] = g; B[jj] = bb; } }
#pragma unroll 8
        for (int rl = 0; rl < 64; ++rl) { const f32x2 s = st[rl]; const size_t off = (size_t)(r0 + rl) * DM + 512 * wave + 4 * lane;
#pragma unroll
            for (int jj = 0; jj < 2; ++jj) { const f32x4 v = *(const f32x4*)(vsrc + off + 256 * jj); const f32x4 y = ((v - s.x) * s.y) * A[jj] + B[jj];
                if (MODE == 2) *(f32x4*)(outf + off + 256 * jj) = y;
                else { u32x2 w; w.x = cvt_pk_bf16(y[0], y[1]); w.y = cvt_pk_bf16(y[2], y[3]); *(u32x2*)(H + off + 256 * jj) = w; } } }
        __syncthreads();
    }
}

__device__ __forceinline__ void s5_naive_wave(const Args& a, int l, int b, int g, LAS unsigned char* ldsw, int lane) {
    LAS float* Cs = (LAS float*)ldsw;
    LAS float* Ub = Cs + 2048;
    LAS f32x2* X = (LAS f32x2*)(Ub + 1280);
    const int lg = l * 64 + g;
    float lr, li, Bbr[16], Bbi[16], dsk[16];
    {
        const double ar = (double)a.in[I_AREAL][lg * 64 + lane], ai = (double)a.in[I_AIMAG][lg * 64 + lane], dt = exp((double)a.in[I_LOGDT][lg]);
        const double mag = exp(ar * dt), ang = ai * dt, lrd = mag * cos(ang), lid = mag * sin(ang);
        const double den = ar * ar + ai * ai, nr = lrd - 1.0, ni = lid, cr = (nr * ar + ni * ai) / den, ci = (ni * ar - nr * ai) / den;
        lr = (float)lrd; li = (float)lid;
#pragma unroll
        for (int h = 0; h < 16; ++h) { const double br = (double)a.in[I_BRE][((size_t)lg * 64 + lane) * 16 + h], bi = (double)a.in[I_BIM][((size_t)lg * 64 + lane) * 16 + h];
            Bbr[h] = (float)(cr * br - ci * bi); Bbi[h] = (float)(cr * bi + ci * br); }
#pragma unroll
        for (int h = 0; h < 16; ++h) { Cs[lane * 32 + h] = a.in[I_CRE][((size_t)lg * 16 + h) * 64 + lane]; Cs[lane * 32 + 16 + h] = a.in[I_CIM][((size_t)lg * 16 + h) * 64 + lane]; dsk[h] = a.in[I_S5D][l * S5W + g * 16 + h]; }
    }
    const bf16_t* P = (const bf16_t*)(a.ws + WS_P); bf16_t* Z = (bf16_t*)(a.ws + WS_Z);
    float xr = 0.f, xi = 0.f;
    LDS_WAIT();
    for (int tb = 0; tb < SEQ / 64; ++tb) {
        const size_t row = (size_t)b * SEQ + tb * 64 + lane;
        { const u32x4 u0 = *(const u32x4*)(P + row * INP + C_U + g * 16), u1 = *(const u32x4*)(P + row * INP + C_U + g * 16 + 8);
          LAS float* d = Ub + lane * 20;
          *(LAS f32x4*)(d + 0) = (f32x4){bf_lo(u0.x), bf_hi(u0.x), bf_lo(u0.y), bf_hi(u0.y)}; *(LAS f32x4*)(d + 4) = (f32x4){bf_lo(u0.z), bf_hi(u0.z), bf_lo(u0.w), bf_hi(u0.w)};
          *(LAS f32x4*)(d + 8) = (f32x4){bf_lo(u1.x), bf_hi(u1.x), bf_lo(u1.y), bf_hi(u1.y)}; *(LAS f32x4*)(d + 12) = (f32x4){bf_lo(u1.z), bf_hi(u1.z), bf_lo(u1.w), bf_hi(u1.w)}; }
        LDS_WAIT();
#pragma unroll 4
        for (int tt = 0; tt < 64; ++tt) {
            const LAS float* us = Ub + tt * 20;
            const f32x4 q0 = *(const LAS f32x4*)(us + 0), q1 = *(const LAS f32x4*)(us + 4), q2 = *(const LAS f32x4*)(us + 8), q3 = *(const LAS f32x4*)(us + 12);
            const float uu[16] = {q0[0], q0[1], q0[2], q0[3], q1[0], q1[1], q1[2], q1[3], q2[0], q2[1], q2[2], q2[3], q3[0], q3[1], q3[2], q3[3]};
            float bur = 0.f, bui = 0.f;
#pragma unroll
            for (int h = 0; h < 16; ++h) { bur += Bbr[h] * uu[h]; bui += Bbi[h] * uu[h]; }
            const float nxr = lr * xr - li * xi + bur, nxi = lr * xi + li * xr + bui; xr = nxr; xi = nxi;
            X[tt * 65 + lane] = (f32x2){xr, xi};
        }
        LDS_WAIT();
        float y[16];
        { const LAS float* us = Ub + lane * 20;
#pragma unroll
          for (int h = 0; h < 16; ++h) y[h] = dsk[h] * us[h]; }
#pragma unroll 2
        for (int p = 0; p < 64; ++p) { const f32x2 x = X[lane * 65 + p]; const LAS float* cs = Cs + p * 32;
#pragma unroll
            for (int h4 = 0; h4 < 4; ++h4) { const f32x4 cre = *(const LAS f32x4*)(cs + 4 * h4), cim = *(const LAS f32x4*)(cs + 16 + 4 * h4);
#pragma unroll
                for (int j = 0; j < 4; ++j) y[4 * h4 + j] += cre[j] * x.x - cim[j] * x.y; } }
        u32x4 w0, w1;
        w0.x = cvt_pk_bf16(gelu_tanh(y[0]), gelu_tanh(y[1])); w0.y = cvt_pk_bf16(gelu_tanh(y[2]), gelu_tanh(y[3])); w0.z = cvt_pk_bf16(gelu_tanh(y[4]), gelu_tanh(y[5])); w0.w = cvt_pk_bf16(gelu_tanh(y[6]), gelu_tanh(y[7]));
        w1.x = cvt_pk_bf16(gelu_tanh(y[8]), gelu_tanh(y[9])); w1.y = cvt_pk_bf16(gelu_tanh(y[10]), gelu_tanh(y[11])); w1.z = cvt_pk_bf16(gelu_tanh(y[12]), gelu_tanh(y[13])); w1.w = cvt_pk_bf16(gelu_tanh(y[14]), gelu_tanh(y[15]));
        *(u32x4*)(Z + row * S5W + g * 16) = w0; *(u32x4*)(Z + row * S5W + g * 16 + 8) = w1;
        LDS_WAIT();
    }
}
template <int DK, bool IS_GLA>
__device__ __forceinline__ void lin_naive_wave(const Args& a, int l, int b, int h, int cg, LAS unsigned char* ldsw, int lane) {
    constexpr int DS = DK / 4, TB = 8, NJ = DK / 64;
    LAS float* qkd = (LAS float*)ldsw;
    const int e = lane & 15, dp = lane >> 4;
    const bf16_t* P = (const bf16_t*)(a.ws + WS_P); float* O = (float*)(a.ws + WS_O);
    const int qoff = IS_GLA ? C_QC + h * 192 : C_QB + h * 128, koff = IS_GLA ? C_KC + h * 192 : C_FB + h * 128;
    const int voff = (IS_GLA ? C_VC + h * 384 : C_IB + h * 128) + cg * 16 + e, ocol = (IS_GLA ? HGW + h * 384 : h * 128) + cg * 16 + e;
    float S[DS];
#pragma unroll
    for (int i = 0; i < DS; ++i) S[i] = 0.f;
    float wg[IS_GLA ? 16 : 1][NJ], bg[NJ], lb[NJ];
#pragma unroll
    for (int j = 0; j < NJ; ++j) { const int d = lane + 64 * j;
        if (IS_GLA) {
#pragma unroll
            for (int r = 0; r < 16; ++r) wg[r][j] = a.in[I_WGATE][((size_t)l * 16 + r) * GLKW + h * 192 + d];
            bg[j] = a.in[I_BGATE][l * GLKW + h * 192 + d]; lb[j] = 0.f;
        } else { lb[j] = ((const float*)(a.ws + WS_MISC))[2 * DM + l * HGW + h * 128 + d]; bg[j] = 0.f; wg[0][j] = 0.f; } }
    for (int t0 = 0; t0 < SEQ; t0 += TB) {
        float vv[TB];
#pragma unroll
        for (int tt = 0; tt < TB; ++tt) { const size_t row = (size_t)b * SEQ + t0 + tt; const bf16_t* prow = P + row * INP;
            vv[tt] = bf2f(prow[voff]);
            if (IS_GLA) {
                const u32x4 l0 = *(const u32x4*)(prow + C_LR), l1 = *(const u32x4*)(prow + C_LR + 8);
                const float lrv[16] = {bf_lo(l0.x), bf_hi(l0.x), bf_lo(l0.y), bf_hi(l0.y), bf_lo(l0.z), bf_hi(l0.z), bf_lo(l0.w), bf_hi(l0.w), bf_lo(l1.x), bf_hi(l1.x), bf_lo(l1.y), bf_hi(l1.y), bf_lo(l1.z), bf_hi(l1.z), bf_lo(l1.w), bf_hi(l1.w)};
#pragma unroll
                for (int j = 0; j < NJ; ++j) { const int d = lane + 64 * j;
                    const float q = bf2f(prow[qoff + d]) * GLA_QSCALE, k = bf2f(prow[koff + d]);
                    float x = bg[j];
#pragma unroll
                    for (int r = 0; r < 16; ++r) x += lrv[r] * wg[r][j];
                    const float ls = fminf(x, 0.f) - log1pf(expf(-fabsf(x)));
                    const float dec = expf(ls * 0.0625f);
                    qkd[(tt * 3 + 0) * DK + d] = q; qkd[(tt * 3 + 1) * DK + d] = k; qkd[(tt * 3 + 2) * DK + d] = dec; }
            } else {
#pragma unroll
                for (int j = 0; j < NJ; ++j) { const int d = lane + 64 * j;
                    const float qin = bf2f(prow[qoff + d]), fin = bf2f(prow[koff + d]);
                    const float q = qin / (1.0f + expf(-qin));
                    const float f = lb[j] + (1.0f - lb[j]) / (1.0f + expf(-fin));
                    const float k = (1.0f - lb[j]) / (1.0f + expf(fin));
                    qkd[(tt * 3 + 0) * DK + d] = q; qkd[(tt * 3 + 1) * DK + d] = k; qkd[(tt * 3 + 2) * DK + d] = f; }
            } }
        LDS_WAIT();
#pragma unroll
        for (int tt = 0; tt < TB; ++tt) {
            float o = 0.f; const float v = vv[tt];
            const LAS float* qs = qkd + (tt * 3 + 0) * DK + dp * DS; const LAS float* ks = qkd + (tt * 3 + 1) * DK + dp * DS; const LAS float* ds = qkd + (tt * 3 + 2) * DK + dp * DS;
#pragma unroll
            for (int i = 0; i < DS; i += 4) { const f32x4 q4 = *(const LAS f32x4*)(qs + i), k4 = *(const LAS f32x4*)(ks + i), d4 = *(const LAS f32x4*)(ds + i);
#pragma unroll
                for (int ii = 0; ii < 4; ++ii) { S[i + ii] = d4[ii] * S[i + ii] + k4[ii] * v; o += q4[ii] * S[i + ii]; } }
            o += __shfl_xor(o, 16); o += __shfl_xor(o, 32);
            if (dp == 0) O[((size_t)b * SEQ + t0 + tt) * OW + ocol] = o;
        }
        LDS_WAIT();
    }
}
__device__ __forceinline__ void phase_mixers_naive(const Args& a, int l, LAS unsigned char* lds, int wave, int lane) {
    const int bx = blockIdx.x, G = gridDim.x;
    if (wave == 0) { for (int it = bx; it < 128; it += G) s5_naive_wave(a, l, it / 64, it % 64, lds, lane); }
    else if (wave <= 2) {
        LAS unsigned char* lw = lds + 49152 + (wave - 1) * 18432;
        for (int it = bx + G * (wave - 1); it < 384; it += 2 * G) {
            if (it < 192) { const int b = it / 96, r = it % 96; lin_naive_wave<128, false>(a, l, b, r / 8, r % 8, lw, lane); }
            else { const int q = it - 192, b = q / 96, r = q % 96; lin_naive_wave<192, true>(a, l, b, r / 24, r % 24, lw, lane); }
        }
    }
}
__device__ __forceinline__ void phase_finalize(const Args& a, int l, int wave, int lane) {
    const bf16_t* P = (const bf16_t*)(a.ws + WS_P); const float* O = (const float*)(a.ws + WS_O); bf16_t* MX = (bf16_t*)(a.ws + WS_MIXED);
    const float* hgg = a.in[I_HGG] + l * HGW; const float* hgb = a.in[I_HGB] + l * HGW; const float* glg = a.in[I_GLG] + l * HGW;
    const int gw = blockIdx.x * 8 + wave, NGW = gridDim.x * 8;
    for (int row = gw; row < MTOK; row += NGW) {
        const float* orow = O + (size_t)row * OW; const bf16_t* prow = P + (size_t)row * INP; bf16_t* mrow = MX + (size_t)row * DM;
#pragma unroll 4
        for (int h = 0; h < 12; ++h) { const int c = h * 128 + 2 * lane;
            const f32x2 o2 = *(const f32x2*)(orow + c); const unsigned gg = *(const unsigned*)(prow + C_GB + c);
            const float v0 = sigmoidf_(bf_lo(gg)) * o2.x, v1 = sigmoidf_(bf_hi(gg)) * o2.y;
            const float mu = wave_sum(v0 + v1) * (1.0f / 128.0f), d0 = v0 - mu, d1 = v1 - mu;
            const float rs = 1.0f / sqrtf(wave_sum(d0 * d0 + d1 * d1) * (1.0f / 128.0f) + LN_EPS);
            const f32x2 g2 = *(const f32x2*)(hgg + c), b2 = *(const f32x2*)(hgb + c);
            *(unsigned*)(mrow + S5W + c) = cvt_pk_bf16(d0 * rs * g2.x + b2.x, d1 * rs * g2.y + b2.y); }
#pragma unroll
        for (int h = 0; h < 4; ++h) { f32x2 o2[3]; float ss = 0.f;
#pragma unroll
            for (int j = 0; j < 3; ++j) { o2[j] = *(const f32x2*)(orow + HGW + h * 384 + 128 * j + 2 * lane); ss += o2[j].x * o2[j].x + o2[j].y * o2[j].y; }
            const float rms = 1.0f / sqrtf(wave_sum(ss) * (1.0f / 384.0f) + LN_EPS);
#pragma unroll
            for (int j = 0; j < 3; ++j) { const int c = h * 384 + 128 * j + 2 * lane; const unsigned gg = *(const unsigned*)(prow + C_GC + c);
                const float g0 = bf_lo(gg), g1 = bf_hi(gg); const f32x2 gn = *(const f32x2*)(glg + c);
                *(unsigned*)(mrow + S5W + HGW + c) = cvt_pk_bf16(o2[j].x * rms * gn.x * (g0 * sigmoidf_(g0)), o2[j].y * rms * gn.y * (g1 * sigmoidf_(g1))); } }
    }
}

#ifndef EN_PRO
#define EN_PRO 1
#endif
#ifndef EN_MOD
#define EN_MOD 1
#endif
#ifndef EN_LN
#define EN_LN 1
#endif
#ifndef EN_INPROJ
#define EN_INPROJ 1
#endif
#ifndef EN_MIX
#define EN_MIX 1
#endif
#ifndef EN_GLU
#define EN_GLU 1
#endif
#ifndef EN_OUT
#define EN_OUT 1
#endif
#ifndef EN_GU
#define EN_GU 1
#endif
#ifndef EN_DN
#define EN_DN 1
#endif
constexpr int PH_PRO = 0, PH_MOD = 1, PH_LN0 = 2, PH_L0 = 3, PH_PER_LAYER = 8, N_PHASES = PH_L0 + DEPTH * PH_PER_LAYER;
constexpr int CW_BAR = 4096;

__global__ void __launch_bounds__(512, 2) hybrid_fwd(Args args) {
    extern __shared__ __attribute__((aligned(16))) unsigned char lds_raw[];
    LAS unsigned char* lds = (LAS unsigned char*)lds_raw;
    const int tid = threadIdx.x, lane = tid & 63, wave = __builtin_amdgcn_readfirstlane(tid >> 6);
    volatile LAS unsigned* MISC = (volatile LAS unsigned*)(lds + LDSCTL_OFF);
    if (tid < 16) MISC[tid] = 0u;
    __syncthreads();
    const int lo = args.ph_lo, hi = args.ph_hi;
    XcdBarrier bar; bar.bar = (unsigned*)(args.ws + WS_CTL) + CW_BAR; bar.x = 0; bar.st = nullptr;
    if (hi - lo > 1) bar = xcd_barrier_post((unsigned*)(args.ws + WS_CTL) + CW_BAR, MISC + 8);
#define IN(k) (lo <= (k) && (k) < hi)
#define OPQ() int ln = lane, wv = wave; asm volatile("" : "+v"(ln), "+s"(wv))
#define SEAM(k) do { if (IN(k) && IN((k) + 1)) xcd_barrier(bar); } while (0)
    unsigned char* ws = args.ws;
    float* mod = (float*)(ws + WS_MOD); float* misc = (float*)(ws + WS_MISC); float* rowstats = (float*)(ws + WS_ROWSTATS); float* rowpart = (float*)(ws + WS_ROWPART);
    bf16_t* H = (bf16_t*)(ws + WS_H); bf16_t* MX = (bf16_t*)(ws + WS_MIXED); bf16_t* Z = (bf16_t*)(ws + WS_Z); bf16_t* P = (bf16_t*)(ws + WS_P); bf16_t* HID = (bf16_t*)(ws + WS_P);

#if EN_PRO
    if (IN(PH_PRO)) { OPQ(); phase_prologue(args, lds, wv, ln); }
#endif
    SEAM(PH_PRO);
#if EN_MOD
    if (IN(PH_MOD)) phase_mod(args);
#endif
    SEAM(PH_MOD);
#if EN_LN
    if (IN(PH_LN0)) { OPQ(); phase_lnapply<0>(args.in[I_X], nullptr, rowstats, nullptr, nullptr, mod, 0, 1, H, nullptr, lds, wv, ln); }
#endif
    SEAM(PH_LN0);

    for (int l = 0; l < DEPTH; ++l) {
        const int p0 = PH_L0 + l * PH_PER_LAYER;
        unsigned char* wt = ws + WS_WT + (size_t)l * WT_LAYER;
        const float* modl = mod + (size_t)l * NB * 6 * DM;
#if EN_INPROJ
        if (IN(p0 + 0)) { pg8::Gemm g{H, (const bf16_t*)(wt + WT_IN), MTOK, INP, DM}; pg8::StaticOrder S; S.init(MTOK, INP, (int)gridDim.x, (int)blockIdx.x);
            EpiProj E{P}; pg8::gemm_phase<EpiProj, pg8::StaticOrder, true, true>(lds, g, S, E); }
#endif
        SEAM(p0 + 0);
#if EN_MIX
        if (IN(p0 + 1)) { OPQ(); phase_mixers_naive(args, l, lds, wv, ln); }
#endif
        SEAM(p0 + 1);
#if EN_GLU
        if (IN(p0 + 2)) { pg8::Gemm g{Z, (const bf16_t*)(wt + WT_GLU), MTOK, S5W, S5W}; pg8::StaticOrder S; S.init(MTOK, S5W, (int)gridDim.x, (int)blockIdx.x);
            EpiGlu E{Z, MX, args.in[I_GLUB] + l * S5W}; pg8::gemm_phase<EpiGlu, pg8::StaticOrder, true, true>(lds, g, S, E);
            { OPQ(); phase_finalize(args, l, wv, ln); } }
#endif
        SEAM(p0 + 2);
#if EN_OUT
        if (IN(p0 + 3)) { pg8::Gemm g{MX, (const bf16_t*)(wt + WT_OUT), MTOK, DM, DM}; pg8::StaticOrder S; S.init(MTOK, DM, (int)gridDim.x, (int)blockIdx.x);
            EpiResid E{l == 0 ? args.in[I_X] : args.out, args.out, rowstats, l == 0 ? misc : args.in[I_LN2G] + (l - 1) * DM, l == 0 ? misc + DM : args.in[I_LN2B] + (l - 1) * DM, modl + 2 * DM, rowpart};
            pg8::gemm_phase<EpiResid, pg8::StaticOrder, true, true>(lds, g, S, E); }
#endif
        SEAM(p0 + 3);
#if EN_LN
        if (IN(p0 + 4)) { OPQ(); phase_lnapply<1>(args.out, rowpart, rowstats, args.in[I_LN1G] + l * DM, args.in[I_LN1B] + l * DM, modl, 3, 4, H, nullptr, lds, wv, ln); }
#endif
        SEAM(p0 + 4);
#if EN_GU
        if (IN(p0 + 5)) { pg8::Gemm g{H, (const bf16_t*)(wt + WT_GU), MTOK, 2 * DFF, DM}; pg8::StaticOrder S; S.init(MTOK, 2 * DFF, (int)gridDim.x, (int)blockIdx.x);
            EpiSwiglu E{HID}; pg8::gemm_phase<EpiSwiglu, pg8::StaticOrder, true, true>(lds, g, S, E); }
#endif
        SEAM(p0 + 5);
#if EN_DN
        if (IN(p0 + 6)) { pg8::Gemm g{HID, (const bf16_t*)(wt + WT_DN), MTOK, DM, DFF}; pg8::StaticOrder S; S.init(MTOK, DM, (int)gridDim.x, (int)blockIdx.x);
            EpiResid E{args.out, args.out, rowstats, args.in[I_LN1G] + l * DM, args.in[I_LN1B] + l * DM, modl + 5 * DM, rowpart};
            pg8::gemm_phase<EpiResid, pg8::StaticOrder, true, true>(lds, g, S, E); }
#endif
        SEAM(p0 + 6);
#if EN_LN
        if (IN(p0 + 7)) { OPQ();
            if (l + 1 < DEPTH) phase_lnapply<1>(args.out, rowpart, rowstats, args.in[I_LN2G] + l * DM, args.in[I_LN2B] + l * DM, modl + (size_t)NB * 6 * DM, 0, 1, H, nullptr, lds, wv, ln);
            else phase_lnapply<2>(args.out, rowpart, rowstats, args.in[I_LN2G] + l * DM, args.in[I_LN2B] + l * DM, nullptr, 0, 0, nullptr, args.out, lds, wv, ln);
        }
#endif
        SEAM(p0 + 7);
    }
#undef IN
#undef SEAM
}

#ifndef MK_PER_PHASE
#define MK_PER_PHASE 0
#endif
extern "C" void kernel_launch(void* const* d_in, const int* in_sizes, int n_in, void* d_out, int out_size, void* d_ws, size_t ws_size, hipStream_t stream) {
    static int grid = 0;
    if (grid == 0) {
        if (n_in != N_IN || out_size != MTOK * DM || ws_size < WS_END) { fprintf(stderr, "kernel_launch: unexpected problem (n_in %d, out %d, ws %zu < %zu); nothing launched\n", n_in, out_size, ws_size, (size_t)WS_END); grid = -1; return; }
        int dev = 0, cus = 0, per_cu = 0;
        if (hipGetDevice(&dev) != hipSuccess || hipDeviceGetAttribute(&cus, hipDeviceAttributeMultiprocessorCount, dev) != hipSuccess) { grid = -1; return; }
        if (hipFuncSetAttribute((const void*)hybrid_fwd, hipFuncAttributeMaxDynamicSharedMemorySize, LDS_BYTES) != hipSuccess) { fprintf(stderr, "kernel_launch: hipFuncSetAttribute failed\n"); grid = -1; return; }
        if (hipOccupancyMaxActiveBlocksPerMultiprocessor(&per_cu, (const void*)hybrid_fwd, 512, LDS_BYTES) != hipSuccess || per_cu < 1) fprintf(stderr, "kernel_launch: occupancy query reports %d blocks per CU\n", per_cu);
        (void)hipGetLastError();
        grid = cus;
    }
    if (grid < 0) return;
    (void)in_sizes;
    if (hipMemsetAsync((char*)d_ws + WS_CTL, 0, CTL_ZERO_BYTES, stream) != hipSuccess) return;
    Args a{};
    for (int i = 0; i < N_IN; ++i) a.in[i] = (const float*)d_in[i];
    a.out = (float*)d_out; a.ws = (unsigned char*)d_ws;
#if MK_PER_PHASE
    for (int p = 0; p < N_PHASES; ++p) { a.ph_lo = p; a.ph_hi = p + 1; hipLaunchKernelGGL(hybrid_fwd, dim3(grid), dim3(512), LDS_BYTES, stream, a); }
#else
    a.ph_lo = 0; a.ph_hi = N_PHASES; hipLaunchKernelGGL(hybrid_fwd, dim3(grid), dim3(512), LDS_BYTES, stream, a);
#endif
}
```

```cpp
#include <hip/hip_runtime.h>
#include <cstdio>
#include <cstdint>
namespace pg8 {
#define PG8_LAS __attribute__((address_space(3)))
typedef unsigned short bf16_t;
typedef short bf16x8 __attribute__((ext_vector_type(8)));
typedef float f32x4 __attribute__((ext_vector_type(4)));
typedef unsigned u32x4 __attribute__((ext_vector_type(4)));
constexpr int BM = 256, BK = 64, HALF = 128, HTB = HALF * BK * 2  , STAGE_BYTES = 8 * HTB, NXCD = 8, WGM = 8;

__host__ __device__ __forceinline__ int lds_byte(int r, int c) { const int st = (r >> 4) * 2 + (c >> 5), rr = r & 15, cc = c & 31, ob = rr * 64 + cc * 2; return st * 1024 + (ob ^ (((ob >> 9) & 1) << 5)); }
__host__ __device__ __forceinline__ void stage_rc(int b, int& R, int& C) { const int st = b / 1024, sb = b % 1024, swz = sb ^ (((sb >> 9) & 1) << 5); R = (st >> 1) * 16 + swz / 64; C = (st & 1) * 32 + (swz % 64) / 2; }
__host__ __device__ __forceinline__ int perm32(int rho) { const int n = rho >> 4, i = rho & 15; return 8 * (i >> 2) + 4 * n + (i & 3); }

struct Unit { int pm, pn; };
struct Gemm { const bf16_t* A; const bf16_t* Bt; int M, N, K; };

struct StaticOrder {
    int nM, nN, nwg, G, c;
    __host__ __device__ void init(int M, int N, int G_, int c_) { nM = M / BM; nN = N / BM; nwg = nM * nN; G = G_; c = c_; }
    __host__ __device__ bool next(int i, Unit& u) const {
        const long L = (long)i * G + c; if (L >= nwg) return false;
        int wgid = (int)L; { const int q = nwg / NXCD, r = nwg % NXCD, xcd = wgid % NXCD, off = wgid / NXCD; wgid = (xcd < r ? xcd * (q + 1) : r * (q + 1) + (xcd - r) * q) + off; }
        const int nig = WGM * nN, gid = wgid / nig, fm = gid * WGM, gsz = (nM - fm) < WGM ? (nM - fm) : WGM;
        u.pm = fm + ((wgid % nig) % gsz); u.pn = (wgid % nig) / gsz; return true;
    }
    __device__ __forceinline__ void a_ready(const Unit&) const {}
    __device__ __forceinline__ void done(const Unit&) const {}
};
__device__ __forceinline__ unsigned cvt_pk_bf16(float lo, float hi) { unsigned r; asm volatile("v_cvt_pk_bf16_f32 %0, %1, %2" : "=v"(r) : "v"(lo), "v"(hi)); return r; }
typedef float f32x2 __attribute__((ext_vector_type(2)));
template <class Epi, class Sched, bool ALIGN_EPI = false, bool SP2 = false>
__device__ __forceinline__ void gemm_phase(PG8_LAS unsigned char* lds, const Gemm g, const Sched& S, const Epi& E, int wave_id) {
    int tid_; asm volatile("v_mbcnt_lo_u32_b32 %0, -1, 0\n\tv_mbcnt_hi_u32_b32 %0, -1, %0" : "=v"(tid_)); tid_ += wave_id * 64;
    const int tid = tid_, wid = __builtin_amdgcn_readfirstlane(tid >> 6), lane = tid & 63, wr = wid >> 2, wc = wid & 3, fr = lane & 15, fq = lane >> 4;
    const int K = g.K, nt = K / BK;
    unsigned voffA[2], voffB[2];
#pragma unroll
    for (int i = 0; i < 2; ++i) { int R, C; stage_rc(tid * 16 + i * 8192, R, C); const int Rb = Epi::PERM ? ((R & ~31) + perm32(R & 31)) : R;
        voffA[i] = (unsigned)(R * K + C) * 2u; voffB[i] = (unsigned)(Rb * K + C) * 2u; }
    const size_t kstep = (size_t)(BK * 2);
    const size_t hstep = (size_t)HALF * K * 2;
    const size_t tstep = 2 * hstep;
    const unsigned ldsw = (unsigned)wid * 1024u;
    const int aoff = lds_byte(wr * 64 + fr, fq * 8), boff = lds_byte(wc * 32 + fr, fq * 8);
#define PG8_SA(b, h) (((b) * 2 + (h)) * HTB)
#define PG8_SB(b, h) ((4 + (b) * 2 + (h)) * HTB)
#define PG8_STAGE(bufoff, gbase, voff) do { _Pragma("unroll") for (int _i = 0; _i < 2; ++_i) \
        __builtin_amdgcn_global_load_lds((const unsigned*)((const char*)(gbase) + (voff)[_i]), (PG8_LAS unsigned*)(lds + (bufoff) + ldsw + _i * 8192), 16, 0, 0); } while (0)
#define PG8_LDA(dst, b, h) do { _Pragma("unroll") for (int m = 0; m < 4; ++m) _Pragma("unroll") for (int k = 0; k < 2; ++k) dst[m][k] = *(const PG8_LAS bf16x8*)(lds + PG8_SA(b, h) + aoff + m * 2048 + k * 1024); } while (0)
#define PG8_LDB(dst, b, h) do { _Pragma("unroll") for (int n = 0; n < 2; ++n) _Pragma("unroll") for (int k = 0; k < 2; ++k) dst[n][k] = *(const PG8_LAS bf16x8*)(lds + PG8_SB(b, h) + boff + n * 2048 + k * 1024); } while (0)
#define PG8_MMA(ai, bj, At, Bt) do { __builtin_amdgcn_s_setprio(1); _Pragma("unroll") for (int m = 0; m < 4; ++m) _Pragma("unroll") for (int n = 0; n < 2; ++n) _Pragma("unroll") for (int k = 0; k < 2; ++k) \
        acc[ai][bj][m][n] = __builtin_amdgcn_mfma_f32_16x16x32_bf16(Bt[n][k], At[m][k], acc[ai][bj][m][n], 0, 0, 0); __builtin_amdgcn_s_setprio(0); } while (0)
#define PG8_WAIT_V(n) asm volatile("s_waitcnt vmcnt(" #n ")" ::: "memory")
#define PG8_WAIT_L(n) asm volatile("s_waitcnt lgkmcnt(" #n ")" ::: "memory")
#define PG8_BAR __builtin_amdgcn_s_barrier()
#define PG8_SCHED __builtin_amdgcn_sched_barrier(0)
    Unit cur, nxt; int ui = 0;
    if (!S.next(0, cur)) return;
    f32x4 acc[2][2][4][2];
#pragma unroll
    for (int a = 0; a < 2; ++a)
#pragma unroll
        for (int b = 0; b < 2; ++b)
#pragma unroll
            for (int m = 0; m < 4; ++m)
#pragma unroll
                for (int n = 0; n < 2; ++n) acc[a][b][m][n] = (f32x4){0.f, 0.f, 0.f, 0.f};
    bf16x8 At[4][2], B0[2][2], B1[2][2];
    const char* cA = (const char*)g.A + (size_t)cur.pm * tstep; const char* cB = (const char*)g.Bt + (size_t)cur.pn * tstep;
    S.a_ready(cur);
    if constexpr (SP2) {
        PG8_STAGE(PG8_SB(0, 0), cB, voffB); PG8_STAGE(PG8_SB(0, 1), cB + hstep, voffB); PG8_STAGE(PG8_SA(0, 0), cA, voffA); PG8_STAGE(PG8_SA(0, 1), cA + hstep, voffA);
        if (wr == 1) PG8_BAR;
        PG8_WAIT_V(2); PG8_BAR;
        PG8_STAGE(PG8_SB(1, 0), cB + kstep, voffB); PG8_STAGE(PG8_SA(1, 0), cA + kstep, voffA); PG8_STAGE(PG8_SB(1, 1), cB + hstep + kstep, voffB);
        PG8_WAIT_V(6); PG8_BAR;
    } else {
        PG8_STAGE(PG8_SB(0, 0), cB, voffB); PG8_STAGE(PG8_SA(0, 0), cA, voffA); PG8_STAGE(PG8_SB(0, 1), cB + hstep, voffB); PG8_STAGE(PG8_SA(0, 1), cA + hstep, voffA);
        if (wr == 1) PG8_BAR;
        PG8_WAIT_V(4); PG8_BAR;
        PG8_STAGE(PG8_SB(1, 0), cB + kstep, voffB); PG8_STAGE(PG8_SA(1, 0), cA + kstep, voffA); PG8_STAGE(PG8_SB(1, 1), cB + hstep + kstep, voffB);
        PG8_WAIT_V(6); PG8_BAR;
    }
    for (;;) {
        const bool has_next = S.next(ui + 1, nxt);
        const char* nA = has_next ? (const char*)g.A + (size_t)nxt.pm * tstep : cA; const char* nB = has_next ? (const char*)g.Bt + (size_t)nxt.pn * tstep : cB;
        for (int t = 0; t < nt; t += 2) {
            const bool last = (t == nt - 2);
            const char* a1 = cA + (size_t)(t + 1) * kstep;
            const char* a2 = last ? nA : cA + (size_t)(t + 2) * kstep; const char* b2 = last ? nB : cB + (size_t)(t + 2) * kstep;
            const char* a3 = a2 + kstep; const char* b3 = b2 + kstep;
            if (last && has_next) S.a_ready(nxt);
            if constexpr (SP2) {
            PG8_LDB(B0, 0, 0); PG8_LDB(B1, 0, 1); PG8_SCHED; PG8_LDA(At, 0, 0); PG8_STAGE(PG8_SA(1, 1), a1 + hstep, voffA);
            PG8_WAIT_V(8); PG8_WAIT_L(0); PG8_BAR; PG8_MMA(0, 0, At, B0); PG8_MMA(0, 1, At, B1); PG8_BAR; PG8_SCHED;
            PG8_LDA(At, 0, 1); PG8_STAGE(PG8_SB(0, 0), b2, voffB); PG8_STAGE(PG8_SB(0, 1), b2 + hstep, voffB); PG8_STAGE(PG8_SA(0, 0), a2, voffA);
            PG8_WAIT_V(8); PG8_WAIT_L(0); PG8_BAR; PG8_MMA(1, 0, At, B0); PG8_MMA(1, 1, At, B1); PG8_BAR; PG8_SCHED;
            PG8_LDB(B0, 1, 0); PG8_LDB(B1, 1, 1); PG8_SCHED; PG8_LDA(At, 1, 0); PG8_STAGE(PG8_SA(0, 1), a2 + hstep, voffA);
            PG8_WAIT_V(8); PG8_WAIT_L(0); PG8_BAR; PG8_MMA(0, 0, At, B0); PG8_MMA(0, 1, At, B1); PG8_BAR; PG8_SCHED;
            PG8_LDA(At, 1, 1); PG8_STAGE(PG8_SB(1, 0), b3, voffB); PG8_STAGE(PG8_SB(1, 1), b3 + hstep, voffB); PG8_STAGE(PG8_SA(1, 0), a3, voffA);
            PG8_WAIT_V(8); PG8_WAIT_L(0); PG8_BAR; PG8_MMA(1, 0, At, B0); PG8_MMA(1, 1, At, B1); PG8_BAR; PG8_SCHED;
            } else {
            PG8_LDB(B0, 0, 0); PG8_SCHED; PG8_LDA(At, 0, 0); PG8_STAGE(PG8_SA(1, 1), a1 + hstep, voffA);
            PG8_WAIT_L(8); PG8_BAR; PG8_WAIT_L(0); PG8_MMA(0, 0, At, B0); PG8_BAR; PG8_SCHED;
            PG8_LDB(B1, 0, 1); PG8_STAGE(PG8_SB(0, 0), b2, voffB);
            PG8_BAR; PG8_WAIT_L(0); PG8_MMA(0, 1, At, B1); PG8_BAR;
            PG8_LDA(At, 0, 1); PG8_STAGE(PG8_SA(0, 0), a2, voffA);
            PG8_BAR; PG8_WAIT_L(0); PG8_MMA(1, 0, At, B0); PG8_BAR; PG8_SCHED;
            PG8_STAGE(PG8_SB(0, 1), b2 + hstep, voffB);
            PG8_WAIT_V(6); PG8_BAR; PG8_MMA(1, 1, At, B1); PG8_BAR;
            PG8_LDB(B0, 1, 0); PG8_SCHED; PG8_LDA(At, 1, 0); PG8_STAGE(PG8_SA(0, 1), a2 + hstep, voffA);
            PG8_WAIT_L(8); PG8_BAR; PG8_WAIT_L(0); PG8_MMA(0, 0, At, B0); PG8_BAR; PG8_SCHED;
            PG8_LDB(B1, 1, 1); PG8_STAGE(PG8_SB(1, 0), b3, voffB);
            PG8_BAR; PG8_WAIT_L(0); PG8_MMA(0, 1, At, B1); PG8_BAR;
            PG8_LDA(At, 1, 1); PG8_STAGE(PG8_SA(1, 0), a3, voffA);
            PG8_BAR; PG8_WAIT_L(0); PG8_MMA(1, 0, At, B0); PG8_BAR; PG8_SCHED;
            PG8_STAGE(PG8_SB(1, 1), b3 + hstep, voffB);
            PG8_WAIT_V(6); PG8_BAR; PG8_MMA(1, 1, At, B1); PG8_BAR;
            }
        }
        if constexpr (ALIGN_EPI) { if (wr == 0) PG8_BAR; }
        if constexpr (!Epi::AFTER_DRAIN) { E(acc, cur, wr, wc, fr, fq); S.done(cur); }
        if (!has_next) break;
#pragma unroll
        for (int a = 0; a < 2; ++a)
#pragma unroll
            for (int b = 0; b < 2; ++b)
#pragma unroll
                for (int m = 0; m < 4; ++m)
#pragma unroll
                    for (int n = 0; n < 2; ++n) acc[a][b][m][n] = (f32x4){0.f, 0.f, 0.f, 0.f};
        cur = nxt; cA = nA; cB = nB; ++ui;
        if constexpr (ALIGN_EPI) { if (wr == 1) PG8_BAR; }
    }
    PG8_WAIT_V(0);
    if constexpr (!ALIGN_EPI) { if (wr == 0) PG8_BAR; }
    PG8_BAR;
    if constexpr (Epi::AFTER_DRAIN) { E.fused(acc, cur, wr, wc, fr, fq, lds, wid, lane); S.done(cur); }
#undef PG8_SA
#undef PG8_SB
#undef PG8_STAGE
#undef PG8_LDA
#undef PG8_LDB
#undef PG8_MMA
#undef PG8_WAIT_V
#undef PG8_WAIT_L
#undef PG8_BAR
#undef PG8_SCHED
}
}
#define LAS __attribute__((address_space(3)))
#define XB_TMO      128
#define XB_XCNT(j)  (256  + 64 * (j))
#define XB_XSUB(j)  (1280 + 64 * (j))
#define XB_XGEN(j)  (2304 + 64 * (j))
#define XB_TOP      3328
#define XB_TOPGEN   3392
#define XCD_BAR_WORDS 3456
#define XB_SPIN_CAP (1u << 24)

__device__ __forceinline__ unsigned xb_ld(unsigned* p)              { return __hip_atomic_load(p, __ATOMIC_RELAXED, __HIP_MEMORY_SCOPE_AGENT); }
__device__ __forceinline__ unsigned xb_add(unsigned* p, unsigned v) { return __hip_atomic_fetch_add(p, v, __ATOMIC_RELAXED, __HIP_MEMORY_SCOPE_AGENT); }
__device__ __forceinline__ unsigned xb_xcc_id() { return (unsigned)__builtin_amdgcn_s_getreg((3 << 11) | 20) & 0xFu; }
#define XB_SPIN(cond, bar) do { unsigned _sp = 0; while (cond) { __builtin_amdgcn_s_sleep(1); \
    if ((++_sp & 255u) == 0u) { if (xb_ld(&(bar)[XB_TMO])) break; if (_sp > XB_SPIN_CAP) { atomicAdd(&(bar)[XB_TMO], 1u); break; } } } } while (0)

struct XcdBarrier {
    unsigned* bar; unsigned x; unsigned w0;
    volatile LAS unsigned* st;
};

__device__ __forceinline__ bool xb_lane0() { return __builtin_amdgcn_mbcnt_hi(~0u, __builtin_amdgcn_mbcnt_lo(~0u, 0u)) == 0u; }
__device__ __forceinline__ XcdBarrier xcd_barrier_post(unsigned* bar, volatile LAS unsigned* st, unsigned w0) {
    XcdBarrier b; b.bar = bar; b.x = xb_xcc_id(); b.st = st; b.w0 = w0;
    if (w0 && xb_lane0()) (void)xb_add(&bar[XB_XCNT(b.x)], 1u);
    return b;
}
__device__ __forceinline__ void xcd_barrier_complete(unsigned* bar, unsigned x, unsigned& nloc, unsigned& nx) {
    const unsigned G = gridDim.x * gridDim.y * gridDim.z;
    unsigned sum, cnt, mine, sp = 0u;
    for (;;) {
        sum = 0u; cnt = 0u; mine = 0u;
#pragma unroll
        for (unsigned j = 0; j < 16; ++j) { const unsigned c = xb_ld(&bar[XB_XCNT(j)]); sum += c; cnt += (c > 0u) ? 1u : 0u; mine = (j == x) ? c : mine; }
        if (sum == G) break;
        __builtin_amdgcn_s_sleep(1);
        if ((++sp & 255u) == 0u) { if (xb_ld(&bar[XB_TMO])) break; if (sp > XB_SPIN_CAP) { atomicAdd(&bar[XB_TMO], 1u); break; } }
    }
    nloc = mine > 0u ? mine : 1u; nx = cnt > 0u ? cnt : 1u;
}

__device__ __forceinline__ void xcd_barrier(const XcdBarrier& b) {
    asm volatile("s_waitcnt vmcnt(0)" ::: "memory");
    __syncthreads();
    if (b.w0 && xb_lane0()) {
        unsigned* bar = b.bar;
        __builtin_amdgcn_s_waitcnt(0);
        unsigned nloc = b.st[0], nx = b.st[1];
        if (nloc == 0u) { xcd_barrier_complete(bar, b.x, nloc, nx); b.st[0] = nloc; b.st[1] = nx; }
        const unsigned old = xb_add(&bar[XB_XSUB(b.x)], 1u);
        const unsigned gen = old / nloc;
        if (old + 1u == (gen + 1u) * nloc) {
            __builtin_amdgcn_fence(__ATOMIC_RELEASE, "agent");
            asm volatile("s_waitcnt vmcnt(0)" ::: "memory");
            const unsigned og = xb_add(&bar[XB_TOP], 1u);
            const unsigned tg = og / nx;
            if (og + 1u == (tg + 1u) * nx) xb_add(&bar[XB_TOPGEN], 1u);
            else XB_SPIN(xb_ld(&bar[XB_TOPGEN]) == tg, bar);
            __builtin_amdgcn_fence(__ATOMIC_ACQUIRE, "agent");
            xb_add(&bar[XB_XGEN(b.x)], 1u);
            asm volatile("s_waitcnt vmcnt(0)" ::: "memory");
        } else {
            XB_SPIN(xb_ld(&bar[XB_XGEN(b.x)]) == gen, bar);
            __builtin_amdgcn_fence(__ATOMIC_ACQUIRE, "agent");
            asm volatile("s_waitcnt vmcnt(0)" ::: "memory");
        }
    }
    __syncthreads();
}
#ifndef EN_CH128
#define EN_CH128 1
#endif
#ifndef EN_CH192
#define EN_CH192 1
#endif
#ifndef EN_DN
#define EN_DN 1
#endif
#ifndef EN_GLU
#define EN_GLU 1
#endif
#ifndef EN_GU
#define EN_GU 1
#endif
#ifndef EN_INPROJ
#define EN_INPROJ 1
#endif
#ifndef EN_LN
#define EN_LN 1
#endif
#ifndef EN_MIX
#define EN_MIX 1
#endif
#ifndef EN_MOD
#define EN_MOD 1
#endif
#ifndef EN_OUT
#define EN_OUT 1
#endif
#ifndef EN_PRE
#define EN_PRE 1
#endif
#ifndef EN_PRO
#define EN_PRO 1
#endif
#ifndef EN_S5N
#define EN_S5N 1
#endif

constexpr int DM = 4096, NB = 2, SEQ = 8192, MTOK = NB * SEQ, DEPTH = 4;
constexpr int S5W = 1024;
constexpr int HGW = 1536;
constexpr int GLKW = 768;
constexpr int INW = 11792, INP = 12032, DFF = 11008;
constexpr int OW = 3072;
constexpr int C_U = 0, C_QB = 1024, C_FB = 2560, C_IB = 4096, C_GB = 5632, C_QC = 7168, C_KC = 7936, C_VC = 8704, C_GC = 10240, C_LR = 11776;
constexpr float LN_EPS = 1e-5f;
constexpr float ALPHA = 1.6817928305074290861f;
constexpr float GLA_QSCALE = 0.07216878364870322f;

enum { I_X = 0, I_C, I_WADA, I_BADA, I_TABLE, I_WIN, I_WOUT, I_AREAL, I_AIMAG, I_LOGDT, I_BRE, I_BIM, I_CRE, I_CIM, I_S5D, I_GLUW, I_GLUB,
       I_LBRAW, I_HGG, I_HGB, I_WGATE, I_BGATE, I_GLG, I_WFG, I_WFU, I_WFD, I_LN1G, I_LN1B, I_LN2G, I_LN2B, N_IN };

constexpr size_t MiB = 1u << 20;
constexpr size_t WS_CTL = 0, CTL_ZERO_BYTES = 1 * MiB;
constexpr size_t WS_MOD = 1 * MiB;
constexpr size_t WS_MISC = 2 * MiB;
constexpr size_t WS_ROWSTATS = 3 * MiB;
constexpr size_t WS_ROWPART = 4 * MiB;
constexpr size_t WS_CONDPART = 12 * MiB;
constexpr size_t WS_H = 24 * MiB;
constexpr size_t WS_MIXED = WS_H + 128 * MiB;
constexpr size_t WS_Z = WS_MIXED + 128 * MiB;
constexpr size_t WS_O = WS_Z + 32 * MiB;
constexpr size_t WS_P = WS_O + 192 * MiB;
constexpr size_t WS_WT = WS_P + 376 * MiB;
constexpr size_t WT_IN = 0, WT_OUT = 94 * MiB, WT_GU = 126 * MiB, WT_DN = 298 * MiB, WT_GLU = 384 * MiB, WT_LAYER = 386 * MiB;
constexpr size_t WS_HGB = WS_WT + DEPTH * WT_LAYER;
constexpr size_t WS_GLB = WS_HGB + 198 * MiB;
constexpr size_t WS_END = WS_GLB + 128 * MiB;
static_assert((size_t)INP * DM * 2 == 94 * MiB && (size_t)DM * DM * 2 == 32 * MiB && (size_t)2 * DFF * DM * 2 == 172 * MiB && (size_t)DM * DFF * 2 == 86 * MiB, "weight map");
static_assert((size_t)MTOK * INP * 2 == 376 * MiB && (size_t)MTOK * DFF * 2 <= 376 * MiB, "activation map");

constexpr int RING_BYTES = 131072;
constexpr int LDSCTL_OFF = 135168;
constexpr int LDS_BYTES = 147456;

#ifndef LAS
#define LAS __attribute__((address_space(3)))
#endif
typedef unsigned short bf16_t;
typedef float f32x4 __attribute__((ext_vector_type(4)));
typedef float f32x2 __attribute__((ext_vector_type(2)));
typedef unsigned u32x4 __attribute__((ext_vector_type(4)));
typedef unsigned u32x2 __attribute__((ext_vector_type(2)));
#define LDS_WAIT() asm volatile("s_waitcnt lgkmcnt(0)" ::: "memory")
#define VM_WAIT() asm volatile("s_waitcnt vmcnt(0)" ::: "memory")
typedef __bf16 bf16x2_t __attribute__((ext_vector_type(2)));
__device__ __forceinline__ unsigned cvt_pk_bf16(float lo, float hi) { return __builtin_bit_cast(unsigned, __builtin_convertvector((f32x2){lo, hi}, bf16x2_t)); }

__device__ __forceinline__ float bf_lo(unsigned w) { return __uint_as_float(w << 16); }
__device__ __forceinline__ float bf_hi(unsigned w) { return __uint_as_float(w & 0xffff0000u); }
__device__ __forceinline__ float bf2f(bf16_t b) { return __uint_as_float(((unsigned)b) << 16); }
__device__ __forceinline__ float wave_sum(float v) {
#pragma unroll
    for (int o = 1; o < 64; o <<= 1) v += __shfl_xor(v, o);
    return v;
}
__device__ __forceinline__ float sigmoidf_(float x) { return 1.0f / (1.0f + __expf(-x)); }
__device__ __forceinline__ float gelu_tanh(float y) { const float a = 0.7978845608028654f * (y + 0.044715f * y * y * y); const float t = 1.0f - 2.0f / (1.0f + __expf(2.0f * a)); return 0.5f * y * (1.0f + t); }

struct EpiProj {
    static constexpr bool PERM = true, AFTER_DRAIN = false;
    bf16_t* P;
    __device__ __forceinline__ void operator()(const f32x4 (&acc)[2][2][4][2], const pg8::Unit& u, int wr, int wc, int fr, int fq) const {
        const int row0 = u.pm * 256 + wr * 64 + fr, col0 = u.pn * 256 + wc * 32 + 8 * fq;
#pragma unroll
        for (int ai = 0; ai < 2; ++ai)
#pragma unroll
            for (int m = 0; m < 4; ++m) { bf16_t* rowp = P + (size_t)(row0 + ai * 128 + m * 16) * INP + col0;
#pragma unroll
                for (int bj = 0; bj < 2; ++bj) { const f32x4 v0 = acc[ai][bj][m][0], v1 = acc[ai][bj][m][1];
                    u32x4 w; w.x = cvt_pk_bf16(v0[0], v0[1]); w.y = cvt_pk_bf16(v0[2], v0[3]); w.z = cvt_pk_bf16(v1[0], v1[1]); w.w = cvt_pk_bf16(v1[2], v1[3]);
                    *(u32x4*)(rowp + bj * 128) = w; } }
    }
};
struct EpiSwiglu {
    static constexpr bool PERM = true, AFTER_DRAIN = false;
    bf16_t* HID;
    __device__ __forceinline__ void operator()(const f32x4 (&acc)[2][2][4][2], const pg8::Unit& u, int wr, int wc, int fr, int fq) const {
        const int row0 = u.pm * 256 + wr * 64 + fr, col0 = u.pn * 128 + wc * 32 + 8 * fq;
#pragma unroll
        for (int ai = 0; ai < 2; ++ai)
#pragma unroll
            for (int m = 0; m < 4; ++m) { bf16_t* rowp = HID + (size_t)(row0 + ai * 128 + m * 16) * DFF + col0;
                float o[8];
#pragma unroll
                for (int n = 0; n < 2; ++n)
#pragma unroll
                    for (int j = 0; j < 4; ++j) { const float g = acc[ai][0][m][n][j], up = acc[ai][1][m][n][j]; o[n * 4 + j] = g * __builtin_amdgcn_rcpf(1.0f + __expf(-g)) * up; }
                u32x4 w; w.x = cvt_pk_bf16(o[0], o[1]); w.y = cvt_pk_bf16(o[2], o[3]); w.z = cvt_pk_bf16(o[4], o[5]); w.w = cvt_pk_bf16(o[6], o[7]);
                *(u32x4*)rowp = w; }
    }
};
struct EpiGlu {
    static constexpr bool PERM = true, AFTER_DRAIN = false;
    const bf16_t* Z; bf16_t* MIXED; const float* bias;
    __device__ __forceinline__ void operator()(const f32x4 (&acc)[2][2][4][2], const pg8::Unit& u, int wr, int wc, int fr, int fq) const {
        const int row0 = u.pm * 256 + wr * 64 + fr, col0 = u.pn * 256 + wc * 32 + 8 * fq;
#pragma unroll
        for (int bj = 0; bj < 2; ++bj) {
            const f32x4 b0 = *(const f32x4*)(bias + col0 + bj * 128), b1 = *(const f32x4*)(bias + col0 + bj * 128 + 4);
#pragma unroll
            for (int ai = 0; ai < 2; ++ai)
#pragma unroll
                for (int m = 0; m < 4; ++m) { const size_t r = (size_t)(row0 + ai * 128 + m * 16);
                    const u32x4 zz = *(const u32x4*)(Z + r * S5W + col0 + bj * 128);
                    const f32x4 v0 = acc[ai][bj][m][0] + b0, v1 = acc[ai][bj][m][1] + b1;
                    u32x4 w;
                    w.x = cvt_pk_bf16(bf_lo(zz.x) * sigmoidf_(v0[0]), bf_hi(zz.x) * sigmoidf_(v0[1]));
                    w.y = cvt_pk_bf16(bf_lo(zz.y) * sigmoidf_(v0[2]), bf_hi(zz.y) * sigmoidf_(v0[3]));
                    w.z = cvt_pk_bf16(bf_lo(zz.z) * sigmoidf_(v1[0]), bf_hi(zz.z) * sigmoidf_(v1[1]));
                    w.w = cvt_pk_bf16(bf_lo(zz.w) * sigmoidf_(v1[2]), bf_hi(zz.w) * sigmoidf_(v1[3]));
                    *(u32x4*)(MIXED + r * DM + col0 + bj * 128) = w;
                    if (m & 1) asm volatile("" ::: "memory"); }
        }
    }
};
struct EpiResid {
    static constexpr bool PERM = false, AFTER_DRAIN = false;
    const float* base; float* out; const float* rowstats; const float* lng; const float* lnb; const float* gate0; float* rowpart;
    __device__ __forceinline__ void operator()(const f32x4 (&acc)[2][2][4][2], const pg8::Unit& u, int wr, int wc, int fr, int fq) const {
        const int rowb = u.pm * 256 + wr * 64 + fr, col0 = u.pn * 256 + wc * 32 + 4 * fq;
        const float* gp = gate0 + (u.pm >= 32 ? 6 * DM : 0);
#pragma unroll
        for (int ai = 0; ai < 2; ++ai)
#pragma unroll
            for (int m = 0; m < 4; ++m) { const int row = rowb + ai * 128 + m * 16;
                const f32x2 st = *(const f32x2*)(rowstats + (size_t)row * 2);
                float s1 = 0.f, s2 = 0.f;
#pragma unroll
                for (int bj = 0; bj < 2; ++bj)
#pragma unroll
                    for (int n = 0; n < 2; ++n) { const int c = col0 + bj * 128 + n * 16; const size_t off = (size_t)row * DM + c;
                        const f32x4 vb = *(const f32x4*)(base + off);
                        const f32x4 A = *(const f32x4*)(lng + c), Bc = *(const f32x4*)(lnb + c), Gm = *(const f32x4*)(gp + c);
                        const f32x4 o = (((vb - st.x) * st.y) * A + Bc) * ALPHA + (Gm + 1.0f) * acc[ai][bj][m][n];
                        *(f32x4*)(out + off) = o;
                        s1 += (o[0] + o[1]) + (o[2] + o[3]); s2 += (o[0] * o[0] + o[1] * o[1]) + (o[2] * o[2] + o[3] * o[3]); }
                s1 += __shfl_xor(s1, 16); s1 += __shfl_xor(s1, 32); s2 += __shfl_xor(s2, 16); s2 += __shfl_xor(s2, 32);
                if (fq == 0) *(f32x2*)(rowpart + ((size_t)row * 64 + u.pn * 4 + wc) * 2) = (f32x2){s1, s2};
                asm volatile("" ::: "memory"); }
    }
};

__device__ __forceinline__ int lane_id_v() { int r; asm volatile("v_mbcnt_lo_u32_b32 %0, -1, 0\n\tv_mbcnt_hi_u32_b32 %0, -1, %0" : "=v"(r)); return r; }
struct Args { const float* in[N_IN]; float* out; unsigned char* ws; int ph_lo, ph_hi; };
struct Ctx {
    volatile LAS unsigned long long* t;
    __device__ __forceinline__ unsigned long long ld(int i) const { const unsigned long long v = t[i];
        return ((unsigned long long)(unsigned)__builtin_amdgcn_readfirstlane((int)(v >> 32)) << 32) | (unsigned long long)(unsigned)__builtin_amdgcn_readfirstlane((int)(unsigned)v); }
    __device__ __forceinline__ const float* in(int i) const { return (const float*)ld(i); }
    __device__ __forceinline__ float* out() const { return (float*)ld(30); }
    __device__ __forceinline__ unsigned char* ws() const { return (unsigned char*)ld(31); }
};

__device__ __forceinline__ void transpose_item(const float* W, int N, int k0, int n0, bf16_t* WT, int drow0, int Kd, LAS float* scr, int lane) {
    const int nl = 4 * (lane & 15), kq = lane >> 4;
    const bool valid = (n0 + nl) < N;
    f32x4 v[16];
#pragma unroll
    for (int i = 0; i < 16; ++i) { const int k = 4 * i + kq; v[i] = valid ? *(const f32x4*)(W + (size_t)(k0 + k) * N + n0 + nl) : (f32x4){0.f, 0.f, 0.f, 0.f}; }
#pragma unroll
    for (int i = 0; i < 16; ++i) { const int k = 4 * i + kq; LAS float* s = scr + k * 65 + nl; s[0] = v[i][0]; s[1] = v[i][1]; s[2] = v[i][2]; s[3] = v[i][3]; }
    LDS_WAIT();
    const int c = lane & 7;
#pragma unroll
    for (int j = 0; j < 8; ++j) { const int n = (lane >> 3) + 8 * j; const LAS float* s = scr + (8 * c) * 65 + n;
        u32x4 o; o.x = cvt_pk_bf16(s[0], s[65]); o.y = cvt_pk_bf16(s[130], s[195]); o.z = cvt_pk_bf16(s[260], s[325]); o.w = cvt_pk_bf16(s[390], s[455]);
        *(u32x4*)(WT + (size_t)(drow0 + n) * Kd + k0 + 8 * c) = o; }
    LDS_WAIT();
}
constexpr int NIT_IN = 64 * 188, NIT_OUT = 64 * 64, NIT_G = 64 * 172, NIT_DN = 172 * 64, NIT_GLU = 16 * 16;
constexpr int NIT_LAYER = NIT_IN + NIT_OUT + 2 * NIT_G + NIT_DN + NIT_GLU;
constexpr int NIT_TR = DEPTH * NIT_LAYER, NIT_COND = 64 * 96;

__device__ __forceinline__ void phase_prologue(const Ctx& a, LAS unsigned char* lds, int wave, int lane) {
    LAS float* scr = (LAS float*)(lds + wave * 16640);
    const int gw = blockIdx.x * 8 + wave, NGW = gridDim.x * 8;
    for (int it = gw; it < NIT_TR + NIT_COND; it += NGW) {
        if (it < NIT_TR) {
            const int l = it / NIT_LAYER; int r = it % NIT_LAYER;
            unsigned char* wt = a.ws() + WS_WT + (size_t)l * WT_LAYER;
            if (r < NIT_IN) { const int kb = r / 188, nb = r % 188; transpose_item(a.in(I_WIN) + (size_t)l * DM * INW, INW, 64 * kb, 64 * nb, (bf16_t*)(wt + WT_IN), 64 * nb, DM, scr, lane); continue; } r -= NIT_IN;
            if (r < NIT_OUT) { const int kb = r / 64, nb = r % 64; transpose_item(a.in(I_WOUT) + (size_t)l * DM * DM, DM, 64 * kb, 64 * nb, (bf16_t*)(wt + WT_OUT), 64 * nb, DM, scr, lane); continue; } r -= NIT_OUT;
            if (r < NIT_G) { const int kb = r / 172, nb = r % 172, n0 = 64 * nb; transpose_item(a.in(I_WFG) + (size_t)l * DM * DFF, DFF, 64 * kb, n0, (bf16_t*)(wt + WT_GU), 256 * (n0 / 128) + (n0 % 128), DM, scr, lane); continue; } r -= NIT_G;
            if (r < NIT_G) { const int kb = r / 172, nb = r % 172, n0 = 64 * nb; transpose_item(a.in(I_WFU) + (size_t)l * DM * DFF, DFF, 64 * kb, n0, (bf16_t*)(wt + WT_GU), 256 * (n0 / 128) + 128 + (n0 % 128), DM, scr, lane); continue; } r -= NIT_G;
            if (r < NIT_DN) { const int kb = r / 64, nb = r % 64; transpose_item(a.in(I_WFD) + (size_t)l * DFF * DM, DM, 64 * kb, 64 * nb, (bf16_t*)(wt + WT_DN), 64 * nb, DFF, scr, lane); continue; } r -= NIT_DN;
            { const int kb = r / 16, nb = r % 16; transpose_item(a.in(I_GLUW) + (size_t)l * S5W * S5W, S5W, 64 * kb, 64 * nb, (bf16_t*)(wt + WT_GLU), 64 * nb, S5W, scr, lane); }
        } else {
            const int item = it - NIT_TR, kb = item / 96, jb = item % 96, k0 = 64 * kb, j0 = 256 * jb + 4 * lane;
            const float* c = a.in(I_C);
            float c0 = c[k0 + lane], c1 = c[DM + k0 + lane];
            c0 = c0 / (1.0f + expf(-c0)); c1 = c1 / (1.0f + expf(-c1));
            f32x4 a0 = (f32x4){0.f, 0.f, 0.f, 0.f}, a1 = a0;
            const float* w = a.in(I_WADA) + (size_t)k0 * (6 * DM) + j0;
#pragma unroll 8
            for (int kk = 0; kk < 64; ++kk) { const f32x4 wv = *(const f32x4*)(w + (size_t)kk * (6 * DM));
                const float s0 = __int_as_float(__builtin_amdgcn_readlane(__float_as_int(c0), kk)), s1 = __int_as_float(__builtin_amdgcn_readlane(__float_as_int(c1), kk));
                a0 += wv * s0; a1 += wv * s1; }
            float* cp = (float*)(a.ws() + WS_CONDPART);
            *(f32x4*)(cp + (size_t)(kb * 2 + 0) * (6 * DM) + j0) = a0;
            *(f32x4*)(cp + (size_t)(kb * 2 + 1) * (6 * DM) + j0) = a1;
        }
    }
}
__device__ __forceinline__ void phase_mod(const Ctx& a, int wave, int lane) {
    const int gt = blockIdx.x * 512 + wave * 64 + lane, NT = gridDim.x * 512;
    const float* cp = (const float*)(a.ws() + WS_CONDPART);
    float* mod = (float*)(a.ws() + WS_MOD); float* misc = (float*)(a.ws() + WS_MISC);
    for (int idx = gt; idx < NB * 6 * DM; idx += NT) {
        const int b = idx / (6 * DM), j = idx % (6 * DM);
        float s = a.in(I_BADA)[j];
        for (int kb = 0; kb < 64; ++kb) s += cp[(size_t)(kb * 2 + b) * (6 * DM) + j];
        for (int l = 0; l < DEPTH; ++l) mod[(size_t)((l * 2 + b) * 6) * DM + j] = s + a.in(I_TABLE)[(size_t)l * 6 * DM + j];
    }
    for (int idx = gt; idx < DM; idx += NT) { misc[idx] = 1.0f; misc[DM + idx] = 0.0f; }
    for (int idx = gt; idx < HGW; idx += NT) {
        const float* raw = a.in(I_LBRAW); float r[DEPTH], mx = -3.0e38f;
#pragma unroll
        for (int l = 0; l < DEPTH; ++l) { r[l] = raw[l * HGW + idx]; mx = fmaxf(mx, r[l]); }
        float e[DEPTH], sum = 0.f;
#pragma unroll
        for (int l = 0; l < DEPTH; ++l) { e[l] = expf(r[l] - mx); sum += e[l]; }
        float cum = 0.f;
#pragma unroll
        for (int l = 0; l < DEPTH; ++l) { misc[2 * DM + l * HGW + idx] = cum; if (l + 1 < DEPTH) cum += e[l + 1] / sum; }
    }
}

template <int MODE>
__device__ __forceinline__ void phase_lnapply(const float* vsrc, const float* rowpart, float* rowstats, const float* lng, const float* lnb, const float* modp, int i_shift, int i_scale,
                                              bf16_t* H, float* outf, LAS unsigned char* lds, int wave, int lane) {
    LAS f32x2* st = (LAS f32x2*)lds;
    for (int blk = blockIdx.x; blk < MTOK / 64; blk += gridDim.x) {
        const int r0 = blk * 64, b = (r0 >= SEQ) ? 1 : 0;
        for (int rr = 0; rr < 8; ++rr) { const int rl = wave * 8 + rr, r = r0 + rl; float mu = 0.f, rs = 1.f;
            if (MODE != 0) { const f32x2 p = *(const f32x2*)(rowpart + ((size_t)r * 64 + lane) * 2); const float s1 = wave_sum(p.x), s2 = wave_sum(p.y);
                mu = s1 * (1.0f / DM); const float var = fmaxf(s2 * (1.0f / DM) - mu * mu, 0.f); rs = 1.0f / sqrtf(var + LN_EPS); }
            if (lane == 0) { st[rl] = (f32x2){mu, rs}; if (MODE != 2) *(f32x2*)(rowstats + (size_t)r * 2) = (f32x2){mu, rs}; } }
        __syncthreads();
        f32x4 A[2], B[2];
#pragma unroll
        for (int jj = 0; jj < 2; ++jj) { const int c = 512 * wave + 256 * jj + 4 * lane;
            f32x4 g = (f32x4){1.f, 1.f, 1.f, 1.f}, bb = (f32x4){0.f, 0.f, 0.f, 0.f};
            if (MODE != 0) { g = *(const f32x4*)(lng + c); bb = *(const f32x4*)(lnb + c); }
            if (MODE != 2) { const f32x4 sc = *(const f32x4*)(modp + (size_t)(b * 6 + i_scale) * DM + c) + 1.0f, sh = *(const f32x4*)(modp + (size_t)(b * 6 + i_shift) * DM + c); A[jj] = g * sc; B[jj] = bb * sc + sh; }
            else { A[jj] = g; B[jj] = bb; } }
#pragma unroll 8
        for (int rl = 0; rl < 64; ++rl) { const f32x2 s = st[rl]; const size_t off = (size_t)(r0 + rl) * DM + 512 * wave + 4 * lane;
#pragma unroll
            for (int jj = 0; jj < 2; ++jj) { const f32x4 v = *(const f32x4*)(vsrc + off + 256 * jj); const f32x4 y = ((v - s.x) * s.y) * A[jj] + B[jj];
                if (MODE == 2) *(f32x4*)(outf + off + 256 * jj) = y;
                else { u32x2 w; w.x = cvt_pk_bf16(y[0], y[1]); w.y = cvt_pk_bf16(y[2], y[3]); *(u32x2*)(H + off + 256 * jj) = w; } } }
        __syncthreads();
    }
}

__device__ __forceinline__ void s5_naive_wave(const Ctx& a, int l, int b, int g, LAS unsigned char* ldsw, int lane) {
    asm volatile("" : "+v"(lane));
    LAS float* Cs = (LAS float*)ldsw;
    LAS float* Ub = Cs + 2048;
    LAS f32x2* X = (LAS f32x2*)(Ub + 1280);
    const int lg = l * 64 + g;
    float lr, li, Bbr[16], Bbi[16], dsk[16];
    {
        const double ar = (double)a.in(I_AREAL)[lg * 64 + lane], ai = (double)a.in(I_AIMAG)[lg * 64 + lane], dt = exp((double)a.in(I_LOGDT)[lg]);
        const double mag = exp(ar * dt), ang = ai * dt, lrd = mag * cos(ang), lid = mag * sin(ang);
        const double den = ar * ar + ai * ai, nr = lrd - 1.0, ni = lid, cr = (nr * ar + ni * ai) / den, ci = (ni * ar - nr * ai) / den;
        lr = (float)lrd; li = (float)lid;
#pragma unroll
        for (int h = 0; h < 16; ++h) { const double br = (double)a.in(I_BRE)[((size_t)lg * 64 + lane) * 16 + h], bi = (double)a.in(I_BIM)[((size_t)lg * 64 + lane) * 16 + h];
            Bbr[h] = (float)(cr * br - ci * bi); Bbi[h] = (float)(cr * bi + ci * br); }
#pragma unroll
        for (int h = 0; h < 16; ++h) { Cs[lane * 32 + h] = a.in(I_CRE)[((size_t)lg * 16 + h) * 64 + lane]; Cs[lane * 32 + 16 + h] = a.in(I_CIM)[((size_t)lg * 16 + h) * 64 + lane]; dsk[h] = a.in(I_S5D)[l * S5W + g * 16 + h]; }
    }
    const bf16_t* P = (const bf16_t*)(a.ws() + WS_P); bf16_t* Z = (bf16_t*)(a.ws() + WS_Z);
    float xr = 0.f, xi = 0.f;
    LDS_WAIT();
    for (int tb = 0; tb < SEQ / 64; ++tb) {
        const size_t row = (size_t)b * SEQ + tb * 64 + lane;
        { const u32x4 u0 = *(const u32x4*)(P + row * INP + C_U + g * 16), u1 = *(const u32x4*)(P + row * INP + C_U + g * 16 + 8);
          LAS float* d = Ub + lane * 20;
          *(LAS f32x4*)(d + 0) = (f32x4){bf_lo(u0.x), bf_hi(u0.x), bf_lo(u0.y), bf_hi(u0.y)}; *(LAS f32x4*)(d + 4) = (f32x4){bf_lo(u0.z), bf_hi(u0.z), bf_lo(u0.w), bf_hi(u0.w)};
          *(LAS f32x4*)(d + 8) = (f32x4){bf_lo(u1.x), bf_hi(u1.x), bf_lo(u1.y), bf_hi(u1.y)}; *(LAS f32x4*)(d + 12) = (f32x4){bf_lo(u1.z), bf_hi(u1.z), bf_lo(u1.w), bf_hi(u1.w)}; }
        LDS_WAIT();
#pragma unroll 4
        for (int tt = 0; tt < 64; ++tt) {
            const LAS float* us = Ub + tt * 20;
            const f32x4 q0 = *(const LAS f32x4*)(us + 0), q1 = *(const LAS f32x4*)(us + 4), q2 = *(const LAS f32x4*)(us + 8), q3 = *(const LAS f32x4*)(us + 12);
            const float uu[16] = {q0[0], q0[1], q0[2], q0[3], q1[0], q1[1], q1[2], q1[3], q2[0], q2[1], q2[2], q2[3], q3[0], q3[1], q3[2], q3[3]};
            float bur = 0.f, bui = 0.f;
#pragma unroll
            for (int h = 0; h < 16; ++h) { bur += Bbr[h] * uu[h]; bui += Bbi[h] * uu[h]; }
            const float nxr = lr * xr - li * xi + bur, nxi = lr * xi + li * xr + bui; xr = nxr; xi = nxi;
            X[tt * 65 + lane] = (f32x2){xr, xi};
        }
        LDS_WAIT();
        float y[16];
        { const LAS float* us = Ub + lane * 20;
#pragma unroll
          for (int h = 0; h < 16; ++h) y[h] = dsk[h] * us[h]; }
#pragma unroll 2
        for (int p = 0; p < 64; ++p) { const f32x2 x = X[lane * 65 + p]; const LAS float* cs = Cs + p * 32;
#pragma unroll
            for (int h4 = 0; h4 < 4; ++h4) { const f32x4 cre = *(const LAS f32x4*)(cs + 4 * h4), cim = *(const LAS f32x4*)(cs + 16 + 4 * h4);
#pragma unroll
                for (int j = 0; j < 4; ++j) y[4 * h4 + j] += cre[j] * x.x - cim[j] * x.y; } }
        u32x4 w0, w1;
        w0.x = cvt_pk_bf16(gelu_tanh(y[0]), gelu_tanh(y[1])); w0.y = cvt_pk_bf16(gelu_tanh(y[2]), gelu_tanh(y[3])); w0.z = cvt_pk_bf16(gelu_tanh(y[4]), gelu_tanh(y[5])); w0.w = cvt_pk_bf16(gelu_tanh(y[6]), gelu_tanh(y[7]));
        w1.x = cvt_pk_bf16(gelu_tanh(y[8]), gelu_tanh(y[9])); w1.y = cvt_pk_bf16(gelu_tanh(y[10]), gelu_tanh(y[11])); w1.z = cvt_pk_bf16(gelu_tanh(y[12]), gelu_tanh(y[13])); w1.w = cvt_pk_bf16(gelu_tanh(y[14]), gelu_tanh(y[15]));
        *(u32x4*)(Z + row * S5W + g * 16) = w0; *(u32x4*)(Z + row * S5W + g * 16 + 8) = w1;
        LDS_WAIT();
    }
}
template <int DK, bool IS_GLA>
__device__ __forceinline__ void lin_naive_wave(const Ctx& a, int l, int b, int h, int cg, LAS unsigned char* ldsw, int lane) {
    asm volatile("" : "+v"(lane));
    constexpr int DS = DK / 4, TB = 8, NJ = DK / 64;
    LAS float* qkd = (LAS float*)ldsw;
    const int e = lane & 15, dp = lane >> 4;
    const bf16_t* P = (const bf16_t*)(a.ws() + WS_P); float* O = (float*)(a.ws() + WS_O);
    const int qoff = IS_GLA ? C_QC + h * 192 : C_QB + h * 128, koff = IS_GLA ? C_KC + h * 192 : C_FB + h * 128;
    const int voff = (IS_GLA ? C_VC + h * 384 : C_IB + h * 128) + cg * 16 + e, ocol = (IS_GLA ? HGW + h * 384 : h * 128) + cg * 16 + e;
    float S[DS];
#pragma unroll
    for (int i = 0; i < DS; ++i) S[i] = 0.f;
    float wg[IS_GLA ? 16 : 1][NJ], bg[NJ], lb[NJ];
#pragma unroll
    for (int j = 0; j < NJ; ++j) { const int d = lane + 64 * j;
        if (IS_GLA) {
#pragma unroll
            for (int r = 0; r < 16; ++r) wg[r][j] = a.in(I_WGATE)[((size_t)l * 16 + r) * GLKW + h * 192 + d];
            bg[j] = a.in(I_BGATE)[l * GLKW + h * 192 + d]; lb[j] = 0.f;
        } else { lb[j] = ((const float*)(a.ws() + WS_MISC))[2 * DM + l * HGW + h * 128 + d]; bg[j] = 0.f; wg[0][j] = 0.f; } }
    for (int t0 = 0; t0 < SEQ; t0 += TB) {
        float vv[TB];
#pragma unroll
        for (int tt = 0; tt < TB; ++tt) { const size_t row = (size_t)b * SEQ + t0 + tt; const bf16_t* prow = P + row * INP;
            vv[tt] = bf2f(prow[voff]);
            if (IS_GLA) {
                const u32x4 l0 = *(const u32x4*)(prow + C_LR), l1 = *(const u32x4*)(prow + C_LR + 8);
                const float lrv[16] = {bf_lo(l0.x), bf_hi(l0.x), bf_lo(l0.y), bf_hi(l0.y), bf_lo(l0.z), bf_hi(l0.z), bf_lo(l0.w), bf_hi(l0.w), bf_lo(l1.x), bf_hi(l1.x), bf_lo(l1.y), bf_hi(l1.y), bf_lo(l1.z), bf_hi(l1.z), bf_lo(l1.w), bf_hi(l1.w)};
#pragma unroll
                for (int j = 0; j < NJ; ++j) { const int d = lane + 64 * j;
                    const float q = bf2f(prow[qoff + d]) * GLA_QSCALE, k = bf2f(prow[koff + d]);
                    float x = bg[j];
#pragma unroll
                    for (int r = 0; r < 16; ++r) x += lrv[r] * wg[r][j];
                    const float ls = fminf(x, 0.f) - log1pf(expf(-fabsf(x)));
                    const float dec = expf(ls * 0.0625f);
                    qkd[(tt * 3 + 0) * DK + d] = q; qkd[(tt * 3 + 1) * DK + d] = k; qkd[(tt * 3 + 2) * DK + d] = dec; }
            } else {
#pragma unroll
                for (int j = 0; j < NJ; ++j) { const int d = lane + 64 * j;
                    const float qin = bf2f(prow[qoff + d]), fin = bf2f(prow[koff + d]);
                    const float q = qin / (1.0f + expf(-qin));
                    const float f = lb[j] + (1.0f - lb[j]) / (1.0f + expf(-fin));
                    const float k = (1.0f - lb[j]) / (1.0f + expf(fin));
                    qkd[(tt * 3 + 0) * DK + d] = q; qkd[(tt * 3 + 1) * DK + d] = k; qkd[(tt * 3 + 2) * DK + d] = f; }
            } }
        LDS_WAIT();
#pragma unroll
        for (int tt = 0; tt < TB; ++tt) {
            float o = 0.f; const float v = vv[tt];
            const LAS float* qs = qkd + (tt * 3 + 0) * DK + dp * DS; const LAS float* ks = qkd + (tt * 3 + 1) * DK + dp * DS; const LAS float* ds = qkd + (tt * 3 + 2) * DK + dp * DS;
#pragma unroll
            for (int i = 0; i < DS; i += 4) { const f32x4 q4 = *(const LAS f32x4*)(qs + i), k4 = *(const LAS f32x4*)(ks + i), d4 = *(const LAS f32x4*)(ds + i);
#pragma unroll
                for (int ii = 0; ii < 4; ++ii) { S[i + ii] = d4[ii] * S[i + ii] + k4[ii] * v; o += q4[ii] * S[i + ii]; } }
            o += __shfl_xor(o, 16); o += __shfl_xor(o, 32);
            if (dp == 0) O[((size_t)b * SEQ + t0 + tt) * OW + ocol] = o;
        }
        LDS_WAIT();
    }
}
typedef short bf16x8 __attribute__((ext_vector_type(8)));
typedef short bf16x4 __attribute__((ext_vector_type(4)));
constexpr int HG_BLK = 16896, HG_OQ = 0, HG_OK = 4096, HG_OKT = 8192, HG_OVT = 12288, HG_ODL = 16384;
constexpr int GL_BLK = 32768, GL_OQ = 0, GL_OK = 6400, GL_OKT = 12800, GL_ODL = 18944, GL_SHARED = 20480, GL_OVT = 20480;
constexpr int NSUB = SEQ / 16;

__device__ __forceinline__ unsigned short f2bf1(float x) { return (unsigned short)(cvt_pk_bf16(x, x) & 0xffffu); }

__device__ __forceinline__ void pre_finish(const float (&qq)[16], const float (&kk)[16], float (&g)[16], unsigned char* blk, int oq, int ok, int okt, int odl, int rowb, int d, bool swz) {
    float b = 0.f;
#pragma unroll
    for (int j = 0; j < 16; ++j) { b += g[j]; g[j] = b; }
    const float bl = b;
    unsigned kt[8];
#pragma unroll
    for (int j = 0; j < 16; j += 2) {
        float kv[2];
#pragma unroll
        for (int jj = 0; jj < 2; ++jj) { const int t = j + jj; const float bj = g[t];
            const int off = t * rowb + (swz ? ((2 * d) ^ (t << 4)) : 2 * d);
            const float qv = qq[t] * __expf(bj), kc = kk[t] * __expf(fminf(-bj, 80.f));
            const float qn = __shfl_xor(qv, 1), kn = __shfl_xor(kc, 1);
            if ((d & 1) == 0) { *(unsigned*)(blk + oq + off) = cvt_pk_bf16(qv, qn); *(unsigned*)(blk + ok + off) = cvt_pk_bf16(kc, kn); }
            kv[jj] = kk[t] * __expf(bl - bj); }
        kt[j >> 1] = cvt_pk_bf16(kv[0], kv[1]); }
    *(u32x4*)(blk + okt + d * 32) = (u32x4){kt[0], kt[1], kt[2], kt[3]};
    *(u32x4*)(blk + okt + d * 32 + 16) = (u32x4){kt[4], kt[5], kt[6], kt[7]};
    *(float*)(blk + odl + d * 4) = __expf(bl);
}
__device__ __forceinline__ void phase_pre(const Ctx& a, int l, int wave, int lane) {
    const bf16_t* P = (const bf16_t*)(a.ws() + WS_P);
    int tid = wave * 64 + lane;
    for (int task = blockIdx.x; task < NB * NSUB * 8; task += gridDim.x) {
        asm volatile("" : "+v"(tid));
        const int kind = task & 7, bsc = task >> 3, b = bsc / NSUB, sc = bsc % NSUB;
        const size_t row0 = (size_t)b * SEQ + sc * 16;
        if (kind < 3) {
            const int ch = kind * 512 + tid, h = ch >> 7, d = ch & 127;
            const float lb = ((const float*)(a.ws() + WS_MISC))[2 * DM + l * HGW + ch];
            unsigned char* blk = a.ws() + WS_HGB + ((size_t)(b * 12 + h) * NSUB + sc) * HG_BLK;
            float g[16], qq[16], kk[16]; unsigned vv[8];
#pragma unroll
            for (int j = 0; j < 16; ++j) { const bf16_t* prow = P + (row0 + j) * INP;
                const float qin = fmaxf(bf2f(prow[C_QB + ch]), -80.f), fin = fminf(fmaxf(bf2f(prow[C_FB + ch]), -80.f), 80.f);
                const unsigned short v = prow[C_IB + ch]; if (j & 1) vv[j >> 1] |= ((unsigned)v) << 16; else vv[j >> 1] = v;
                const float e = __expf(-fin), sg = 1.0f / (1.0f + e);
                const float f = lb + (1.0f - lb) * sg;
                g[j] = fmaxf(__logf(f), -100.f); kk[j] = (1.0f - lb) * (e * sg); qq[j] = qin / (1.0f + __expf(-qin)); }
            *(u32x4*)(blk + HG_OVT + d * 32) = (u32x4){vv[0], vv[1], vv[2], vv[3]};
            *(u32x4*)(blk + HG_OVT + d * 32 + 16) = (u32x4){vv[4], vv[5], vv[6], vv[7]};
            pre_finish(qq, kk, g, blk, HG_OQ, HG_OK, HG_OKT, HG_ODL, 256, d, true);
        } else if (kind < 5) {
            if (tid < 384) {
                const int ch = (kind - 3) * 384 + tid, h = ch / 192, d = ch % 192;
                unsigned char* blk = a.ws() + WS_GLB + ((size_t)(b * 4 + h) * NSUB + sc) * GL_BLK;
                float wg[16];
#pragma unroll
                for (int r = 0; r < 16; ++r) wg[r] = a.in(I_WGATE)[((size_t)l * 16 + r) * GLKW + ch];
                const float bgv = a.in(I_BGATE)[l * GLKW + ch];
                float g[16], qq[16], kk[16];
#pragma unroll
                for (int j = 0; j < 16; ++j) { const bf16_t* prow = P + (row0 + j) * INP;
                    const u32x4 l0 = *(const u32x4*)(prow + C_LR), l1 = *(const u32x4*)(prow + C_LR + 8);
                    float x = bgv;
                    x += bf_lo(l0.x) * wg[0] + bf_hi(l0.x) * wg[1] + bf_lo(l0.y) * wg[2] + bf_hi(l0.y) * wg[3] + bf_lo(l0.z) * wg[4] + bf_hi(l0.z) * wg[5] + bf_lo(l0.w) * wg[6] + bf_hi(l0.w) * wg[7];
                    x += bf_lo(l1.x) * wg[8] + bf_hi(l1.x) * wg[9] + bf_lo(l1.y) * wg[10] + bf_hi(l1.y) * wg[11] + bf_lo(l1.z) * wg[12] + bf_hi(l1.z) * wg[13] + bf_lo(l1.w) * wg[14] + bf_hi(l1.w) * wg[15];
                    g[j] = (fminf(x, 0.f) - log1pf(__expf(-fabsf(x)))) * 0.0625f;
                    qq[j] = bf2f(prow[C_QC + ch]) * GLA_QSCALE; kk[j] = bf2f(prow[C_KC + ch]); }
                pre_finish(qq, kk, g, blk, GL_OQ, GL_OK, GL_OKT, GL_ODL, 400, d, false);
            }
        } else {
            const int ch = (kind - 5) * 512 + tid, h = ch / 384, e = ch % 384;
            unsigned char* blk = a.ws() + WS_GLB + ((size_t)(b * 4 + h) * NSUB + sc) * GL_BLK;
            unsigned vv[8];
#pragma unroll
            for (int j = 0; j < 16; ++j) { const unsigned short v = P[(row0 + j) * INP + C_VC + ch]; if (j & 1) vv[j >> 1] |= ((unsigned)v) << 16; else vv[j >> 1] = v; }
            *(u32x4*)(blk + GL_OVT + e * 32) = (u32x4){vv[0], vv[1], vv[2], vv[3]};
            *(u32x4*)(blk + GL_OVT + e * 32 + 16) = (u32x4){vv[4], vv[5], vv[6], vv[7]};
        }
    }
}

template <int DK>
__device__ __forceinline__ void chain_sub(const LAS unsigned char* sb, f32x4 (&S)[DK / 16], float* op, int wave, int n, int q) {
    constexpr bool IS_GLA = (DK == 192);
    constexpr int NKS = DK / 32, NMB = DK / 16, ROWB = IS_GLA ? 400 : 256;
    constexpr int OQ = 0, OK = IS_GLA ? GL_OK : HG_OK, OKT = IS_GLA ? GL_OKT : HG_OKT, OVT = IS_GLA ? GL_OVT : HG_OVT, ODL = IS_GLA ? GL_ODL : HG_ODL;
    bf16x8 qf[NKS], kf[NKS];
#pragma unroll
    for (int ks = 0; ks < NKS; ++ks) { const int c0 = 2 * (32 * ks + 4 * q), c1 = c0 + 32;
        const int o0 = n * ROWB + (IS_GLA ? c0 : (c0 ^ (n << 4))), o1 = n * ROWB + (IS_GLA ? c1 : (c1 ^ (n << 4)));
        const u32x2 ql = *(const LAS u32x2*)(sb + OQ + o0), qh = *(const LAS u32x2*)(sb + OQ + o1), kl = *(const LAS u32x2*)(sb + OK + o0), kh = *(const LAS u32x2*)(sb + OK + o1);
        qf[ks] = __builtin_bit_cast(bf16x8, (u32x4){ql.x, ql.y, qh.x, qh.y}); kf[ks] = __builtin_bit_cast(bf16x8, (u32x4){kl.x, kl.y, kh.x, kh.y}); }
    const u32x2 vfr = *(const LAS u32x2*)(sb + OVT + (16 * wave + n) * 32 + 8 * q);
    const bf16x8 vf8 = __builtin_bit_cast(bf16x8, (u32x4){vfr.x, vfr.y, 0u, 0u});
    f32x4 ao = (f32x4){0.f, 0.f, 0.f, 0.f}, ap = ao;
#pragma unroll
    for (int ks = 0; ks < NKS; ++ks) {
        const bf16x8 sbf = __builtin_bit_cast(bf16x8, (u32x4){cvt_pk_bf16(S[2 * ks][0], S[2 * ks][1]), cvt_pk_bf16(S[2 * ks][2], S[2 * ks][3]), cvt_pk_bf16(S[2 * ks + 1][0], S[2 * ks + 1][1]), cvt_pk_bf16(S[2 * ks + 1][2], S[2 * ks + 1][3])});
        ao = __builtin_amdgcn_mfma_f32_16x16x32_bf16(qf[ks], sbf, ao, 0, 0, 0);
        ap = __builtin_amdgcn_mfma_f32_16x16x32_bf16(kf[ks], qf[ks], ap, 0, 0, 0); }
#pragma unroll
    for (int r = 0; r < 4; ++r) if (4 * q + r > n) ap[r] = 0.f;
    const bf16x8 pa8 = __builtin_bit_cast(bf16x8, (u32x4){cvt_pk_bf16(ap[0], ap[1]), cvt_pk_bf16(ap[2], ap[3]), 0u, 0u});
    ao = __builtin_amdgcn_mfma_f32_16x16x32_bf16(pa8, vf8, ao, 0, 0, 0);
#pragma unroll
    for (int r = 0; r < 4; ++r) op[(size_t)(4 * q + r) * OW] = ao[r];
#pragma unroll
    for (int mb = 0; mb < NMB; ++mb) {
        const f32x4 dl = *(const LAS f32x4*)(sb + ODL + (16 * mb + 4 * q) * 4);
        const u32x2 ktr = *(const LAS u32x2*)(sb + OKT + (16 * mb + n) * 32 + 8 * q);
        S[mb] = __builtin_amdgcn_mfma_f32_16x16x32_bf16(__builtin_bit_cast(bf16x8, (u32x4){ktr.x, ktr.y, 0u, 0u}), vf8, S[mb] * dl, 0, 0, 0); }
}
template <int DK>
__device__ __forceinline__ void chain_item(const unsigned char* blk0, int vt_off, int nsc, float* op0, LAS unsigned char* lds, int wave, int lane) {
    asm volatile("" : "+v"(lane), "+s"(wave));
    constexpr bool IS_GLA = (DK == 192);
    constexpr int BLK = IS_GLA ? GL_BLK : HG_BLK, SUBB = IS_GLA ? GL_SHARED + 4096 : HG_BLK, PIECES = SUBB / 16, SH_PIECES = IS_GLA ? GL_SHARED / 16 : PIECES;
    constexpr int UNITB = 2 * SUBB, NP = (2 * PIECES + 511) / 512;
    const int tid = wave * 64 + lane, n = lane & 15, q = lane >> 4;
    f32x4 S[DK / 16];
#pragma unroll
    for (int mb = 0; mb < DK / 16; ++mb) S[mb] = (f32x4){0.f, 0.f, 0.f, 0.f};
    u32x4 stg[NP];
    const int nunits = nsc / 2;
#define CH_LOAD(u) do { _Pragma("unroll") for (int r_ = 0; r_ < NP; ++r_) { const int p_ = r_ * 512 + tid; if (p_ < 2 * PIECES) { const int s_ = p_ / PIECES, pp_ = p_ % PIECES; \
        const unsigned char* src_ = blk0 + (size_t)((u) * 2 + s_) * BLK + (pp_ < SH_PIECES ? pp_ * 16 : vt_off + (pp_ - SH_PIECES) * 16); stg[r_] = *(const u32x4*)src_; } } } while (0)
#define CH_STORE(buf) do { _Pragma("unroll") for (int r_ = 0; r_ < NP; ++r_) { const int p_ = r_ * 512 + tid; if (p_ < 2 * PIECES) *(LAS u32x4*)(lds + (buf) * UNITB + p_ * 16) = stg[r_]; } } while (0)
    CH_LOAD(0); CH_STORE(0);
    __syncthreads();
    float* op = op0 + 16 * wave + n;
#ifdef DBG_SYNC
    for (int u = 0; u < nunits; ++u) {
        const LAS unsigned char* ub = lds;
        chain_sub<DK>(ub, S, op + (size_t)(u * 32) * OW, wave, n, q);
        __syncthreads();
        chain_sub<DK>(ub + SUBB, S, op + (size_t)(u * 32 + 16) * OW, wave, n, q);
        __syncthreads();
        if (u + 1 < nunits) { CH_LOAD(u + 1); CH_STORE(0); }
        __syncthreads();
    }
#else
    for (int u = 0; u < nunits; ++u) {
        if (u + 1 < nunits) CH_LOAD(u + 1);
        const LAS unsigned char* ub = lds + (u & 1) * UNITB;
        chain_sub<DK>(ub, S, op + (size_t)(u * 32) * OW, wave, n, q);
        chain_sub<DK>(ub + SUBB, S, op + (size_t)(u * 32 + 16) * OW, wave, n, q);
        if (u + 1 < nunits) CH_STORE((u + 1) & 1);
        __syncthreads();
    }
#endif
#undef CH_LOAD
#undef CH_STORE
}

__device__ __forceinline__ void phase_mixers(const Ctx& a, int l, LAS unsigned char* lds, int wave, int lane) {
    const int bx = blockIdx.x, G = gridDim.x;
    for (int c = (G >= 176) ? bx - 128 : bx; c < 48; c += G) {
        if (c < 0) continue;
#if EN_CH128
        if (c < 24) { const int b = c / 12, h = c % 12;
            chain_item<128>(a.ws() + WS_HGB + (size_t)(b * 12 + h) * NSUB * HG_BLK, 0, NSUB, (float*)(a.ws() + WS_O) + (size_t)b * SEQ * OW + h * 128, lds, wave, lane); }
#endif
#if EN_CH192
        if (c >= 24) { const int r = c - 24, b = r / 12, h = (r % 12) / 3, sl = r % 3;
            chain_item<192>(a.ws() + WS_GLB + (size_t)(b * 4 + h) * NSUB * GL_BLK, GL_OVT + 4096 * sl, NSUB, (float*)(a.ws() + WS_O) + (size_t)b * SEQ * OW + HGW + h * 384 + sl * 128, lds, wave, lane); }
#endif
        __syncthreads();
    }
#if EN_S5N
    if (wave == 0) { for (int it = bx; it < 128; it += G) s5_naive_wave(a, l, it / 64, it % 64, lds, lane); }
#endif
#if !EN_CH192 || !EN_CH128
    if (wave == 1 && (bx < 128 || bx >= 176)) { const int idx = bx < 128 ? bx : bx - 48; if (idx < 192) { const int it = idx, b = it / 96, r = it % 96;
#if !EN_CH192
        lin_naive_wave<192, true>(a, l, b, r / 24, r % 24, lds + 49152, lane);
#else
        lin_naive_wave<128, false>(a, l, b, r / 8, r % 8, lds + 49152, lane);
#endif
    } }
#endif
}
__device__ __forceinline__ void phase_mixers_naive(const Ctx& a, int l, LAS unsigned char* lds, int wave, int lane) {
    const int bx = blockIdx.x, G = gridDim.x;
    if (wave == 0) { for (int it = bx; it < 128; it += G) s5_naive_wave(a, l, it / 64, it % 64, lds, lane); }
    else if (wave <= 2) {
        LAS unsigned char* lw = lds + 49152 + (wave - 1) * 18432;
        for (int it = bx + G * (wave - 1); it < 384; it += 2 * G) {
            if (it < 192) { const int b = it / 96, r = it % 96; lin_naive_wave<128, false>(a, l, b, r / 8, r % 8, lw, lane); }
            else { const int q = it - 192, b = q / 96, r = q % 96; lin_naive_wave<192, true>(a, l, b, r / 24, r % 24, lw, lane); }
        }
    }
}
__device__ __forceinline__ void phase_finalize(const Ctx& a, int l, int wave, int lane) {
    const bf16_t* P = (const bf16_t*)(a.ws() + WS_P); const float* O = (const float*)(a.ws() + WS_O); bf16_t* MX = (bf16_t*)(a.ws() + WS_MIXED);
    const float* hgg = a.in(I_HGG) + l * HGW; const float* hgb = a.in(I_HGB) + l * HGW; const float* glg = a.in(I_GLG) + l * HGW;
    const int gw = blockIdx.x * 8 + wave, NGW = gridDim.x * 8;
    for (int row = gw; row < MTOK; row += NGW) {
        const float* orow = O + (size_t)row * OW; const bf16_t* prow = P + (size_t)row * INP; bf16_t* mrow = MX + (size_t)row * DM;
#pragma unroll 4
        for (int h = 0; h < 12; ++h) { const int c = h * 128 + 2 * lane;
            const f32x2 o2 = *(const f32x2*)(orow + c); const unsigned gg = *(const unsigned*)(prow + C_GB + c);
            const float v0 = sigmoidf_(bf_lo(gg)) * o2.x, v1 = sigmoidf_(bf_hi(gg)) * o2.y;
            const float mu = wave_sum(v0 + v1) * (1.0f / 128.0f), d0 = v0 - mu, d1 = v1 - mu;
            const float rs = 1.0f / sqrtf(wave_sum(d0 * d0 + d1 * d1) * (1.0f / 128.0f) + LN_EPS);
            const f32x2 g2 = *(const f32x2*)(hgg + c), b2 = *(const f32x2*)(hgb + c);
            *(unsigned*)(mrow + S5W + c) = cvt_pk_bf16(d0 * rs * g2.x + b2.x, d1 * rs * g2.y + b2.y); }
#pragma unroll
        for (int h = 0; h < 4; ++h) { f32x2 o2[3]; float ss = 0.f;
#pragma unroll
            for (int j = 0; j < 3; ++j) { o2[j] = *(const f32x2*)(orow + HGW + h * 384 + 128 * j + 2 * lane); ss += o2[j].x * o2[j].x + o2[j].y * o2[j].y; }
            const float rms = 1.0f / sqrtf(wave_sum(ss) * (1.0f / 384.0f) + LN_EPS);
#pragma unroll
            for (int j = 0; j < 3; ++j) { const int c = h * 384 + 128 * j + 2 * lane; const unsigned gg = *(const unsigned*)(prow + C_GC + c);
                const float g0 = bf_lo(gg), g1 = bf_hi(gg); const f32x2 gn = *(const f32x2*)(glg + c);
                *(unsigned*)(mrow + S5W + HGW + c) = cvt_pk_bf16(o2[j].x * rms * gn.x * (g0 * sigmoidf_(g0)), o2[j].y * rms * gn.y * (g1 * sigmoidf_(g1))); } }
    }
}

constexpr int PH_PRO = 0, PH_MOD = 1, PH_LN0 = 2, PH_L0 = 3, PH_PER_LAYER = 9, N_PHASES = PH_L0 + DEPTH * PH_PER_LAYER;
constexpr int CW_BAR = 4096;

__global__ void __launch_bounds__(512, 2) hybrid_fwd(Args args) {
    extern __shared__ __attribute__((aligned(16))) unsigned char lds_raw[];
    LAS unsigned char* lds = (LAS unsigned char*)lds_raw;
    const int wave = __builtin_amdgcn_readfirstlane((int)threadIdx.x >> 6);
#define lane lane_id_v()
    volatile LAS unsigned* MISC = (volatile LAS unsigned*)(lds + LDSCTL_OFF);
    Ctx ctx; ctx.t = (volatile LAS unsigned long long*)(lds + LDSCTL_OFF + 64);
    if (wave == 0) { const int ln_ = lane; unsigned long long v = 0ull;
#pragma unroll
        for (int i = 0; i < N_IN; ++i) v = (ln_ == i) ? (unsigned long long)args.in[i] : v;
        v = (ln_ == 30) ? (unsigned long long)args.out : v; v = (ln_ == 31) ? (unsigned long long)args.ws : v;
        if (ln_ < 32) ctx.t[ln_] = v;
        if (ln_ < 16) MISC[ln_] = 0u; }
    __syncthreads();
    const int lo = args.ph_lo, hi = args.ph_hi;
    XcdBarrier bar; bar.bar = (unsigned*)(ctx.ws() + WS_CTL) + CW_BAR; bar.x = 0; bar.st = nullptr; bar.w0 = (wave == 0) ? 1u : 0u;
    if (hi - lo > 1) bar = xcd_barrier_post((unsigned*)(ctx.ws() + WS_CTL) + CW_BAR, MISC + 8, (wave == 0) ? 1u : 0u);
#define IN(k) (lo <= (k) && (k) < hi)
#define OPQ() int ln = lane, wv = wave; asm volatile("" : "+s"(wv))
#define SEAM(k) do { if (IN(k) && IN((k) + 1)) xcd_barrier(bar); } while (0)
#define WSP(T, off) ((T*)(ctx.ws() + (off)))

#if EN_PRO
    if (IN(PH_PRO)) { OPQ(); phase_prologue(ctx, lds, wv, ln); }
#endif
    SEAM(PH_PRO);
#if EN_MOD
    if (IN(PH_MOD)) { OPQ(); phase_mod(ctx, wv, ln); }
#endif
    SEAM(PH_MOD);
#if EN_LN
    if (IN(PH_LN0)) { OPQ(); phase_lnapply<0>(ctx.in(I_X), nullptr, WSP(float, WS_ROWSTATS), nullptr, nullptr, WSP(float, WS_MOD), 0, 1, WSP(bf16_t, WS_H), nullptr, lds, wv, ln); }
#endif
    SEAM(PH_LN0);

    for (int l = 0; l < DEPTH; ++l) {
        const int p0 = PH_L0 + l * PH_PER_LAYER;
        const size_t wto = WS_WT + (size_t)l * WT_LAYER, modo = WS_MOD + (size_t)l * NB * 6 * DM * 4;
#if EN_INPROJ
        if (IN(p0 + 0)) { pg8::Gemm g{WSP(bf16_t, WS_H), WSP(const bf16_t, wto + WT_IN), MTOK, INP, DM}; pg8::StaticOrder S; S.init(MTOK, INP, (int)gridDim.x, (int)blockIdx.x);
            EpiProj E{WSP(bf16_t, WS_P)}; pg8::gemm_phase<EpiProj, pg8::StaticOrder, true, true>(lds, g, S, E, wave); }
#endif
        SEAM(p0 + 0);
#if EN_MIX
#ifdef DBG_TWICE
        if (IN(p0 + 1)) { { OPQ(); phase_pre(ctx, l, wv, ln); } xcd_barrier(bar); { OPQ(); phase_mixers(ctx, l, lds, wv, ln); } xcd_barrier(bar); }
#endif
        if (IN(p0 + 1)) { OPQ(); phase_pre(ctx, l, wv, ln); }
        SEAM(p0 + 1);
#ifdef DBG_NAIVE
        if (IN(p0 + 2)) { OPQ(); phase_mixers_naive(ctx, l, lds, wv, ln); }
#else
        if (IN(p0 + 2)) { OPQ(); phase_mixers(ctx, l, lds, wv, ln); }
#endif
#endif
        SEAM(p0 + 2);
#if EN_GLU
        if (IN(p0 + 3)) { pg8::Gemm g{WSP(bf16_t, WS_Z), WSP(const bf16_t, wto + WT_GLU), MTOK, S5W, S5W}; pg8::StaticOrder S; S.init(MTOK, S5W, (int)gridDim.x, (int)blockIdx.x);
            EpiGlu E{WSP(bf16_t, WS_Z), WSP(bf16_t, WS_MIXED), ctx.in(I_GLUB) + l * S5W}; pg8::gemm_phase<EpiGlu, pg8::StaticOrder, true, true>(lds, g, S, E, wave);
            { OPQ(); phase_finalize(ctx, l, wv, ln); } }
#endif
        SEAM(p0 + 3);
#if EN_OUT
        if (IN(p0 + 4)) { pg8::Gemm g{WSP(bf16_t, WS_MIXED), WSP(const bf16_t, wto + WT_OUT), MTOK, DM, DM}; pg8::StaticOrder S; S.init(MTOK, DM, (int)gridDim.x, (int)blockIdx.x);
            EpiResid E{l == 0 ? ctx.in(I_X) : ctx.out(), ctx.out(), WSP(float, WS_ROWSTATS), l == 0 ? WSP(float, WS_MISC) : ctx.in(I_LN2G) + (l - 1) * DM, l == 0 ? WSP(float, WS_MISC) + DM : ctx.in(I_LN2B) + (l - 1) * DM, WSP(float, modo) + 2 * DM, WSP(float, WS_ROWPART)};
            pg8::gemm_phase<EpiResid, pg8::StaticOrder, true, true>(lds, g, S, E, wave); }
#endif
        SEAM(p0 + 4);
#if EN_LN
        if (IN(p0 + 5)) { OPQ(); phase_lnapply<1>(ctx.out(), WSP(float, WS_ROWPART), WSP(float, WS_ROWSTATS), ctx.in(I_LN1G) + l * DM, ctx.in(I_LN1B) + l * DM, WSP(float, modo), 3, 4, WSP(bf16_t, WS_H), nullptr, lds, wv, ln); }
#endif
        SEAM(p0 + 5);
#if EN_GU
        if (IN(p0 + 6)) { pg8::Gemm g{WSP(bf16_t, WS_H), WSP(const bf16_t, wto + WT_GU), MTOK, 2 * DFF, DM}; pg8::StaticOrder S; S.init(MTOK, 2 * DFF, (int)gridDim.x, (int)blockIdx.x);
            EpiSwiglu E{WSP(bf16_t, WS_P)}; pg8::gemm_phase<EpiSwiglu, pg8::StaticOrder, true, true>(lds, g, S, E, wave); }
#endif
        SEAM(p0 + 6);
#if EN_DN
        if (IN(p0 + 7)) { pg8::Gemm g{WSP(bf16_t, WS_P), WSP(const bf16_t, wto + WT_DN), MTOK, DM, DFF}; pg8::StaticOrder S; S.init(MTOK, DM, (int)gridDim.x, (int)blockIdx.x);
            EpiResid E{ctx.out(), ctx.out(), WSP(float, WS_ROWSTATS), ctx.in(I_LN1G) + l * DM, ctx.in(I_LN1B) + l * DM, WSP(float, modo) + 5 * DM, WSP(float, WS_ROWPART)};
            pg8::gemm_phase<EpiResid, pg8::StaticOrder, true, true>(lds, g, S, E, wave); }
#endif
        SEAM(p0 + 7);
#if EN_LN
        if (IN(p0 + 8)) { OPQ();
            if (l + 1 < DEPTH) phase_lnapply<1>(ctx.out(), WSP(float, WS_ROWPART), WSP(float, WS_ROWSTATS), ctx.in(I_LN2G) + l * DM, ctx.in(I_LN2B) + l * DM, WSP(float, modo) + (size_t)NB * 6 * DM, 0, 1, WSP(bf16_t, WS_H), nullptr, lds, wv, ln);
            else phase_lnapply<2>(ctx.out(), WSP(float, WS_ROWPART), WSP(float, WS_ROWSTATS), ctx.in(I_LN2G) + l * DM, ctx.in(I_LN2B) + l * DM, nullptr, 0, 0, nullptr, ctx.out(), lds, wv, ln);
        }
#endif
        SEAM(p0 + 8);
    }
#undef IN
#undef SEAM
#undef OPQ
#undef WSP
#undef lane
}

#ifndef MK_PER_PHASE
#define MK_PER_PHASE 0
#endif
extern "C" void kernel_launch(void* const* d_in, const int* in_sizes, int n_in, void* d_out, int out_size, void* d_ws, size_t ws_size, hipStream_t stream) {
    static int grid = 0;
    if (grid == 0) {
        if (n_in != N_IN || out_size != MTOK * DM || ws_size < WS_END) { fprintf(stderr, "kernel_launch: unexpected problem (n_in %d, out %d, ws %zu < %zu); nothing launched\n", n_in, out_size, ws_size, (size_t)WS_END); grid = -1; return; }
        int dev = 0, cus = 0, per_cu = 0;
        if (hipGetDevice(&dev) != hipSuccess || hipDeviceGetAttribute(&cus, hipDeviceAttributeMultiprocessorCount, dev) != hipSuccess) { grid = -1; return; }
        if (hipFuncSetAttribute((const void*)hybrid_fwd, hipFuncAttributeMaxDynamicSharedMemorySize, LDS_BYTES) != hipSuccess) { fprintf(stderr, "kernel_launch: hipFuncSetAttribute failed\n"); grid = -1; return; }
        if (hipOccupancyMaxActiveBlocksPerMultiprocessor(&per_cu, (const void*)hybrid_fwd, 512, LDS_BYTES) != hipSuccess || per_cu < 1) fprintf(stderr, "kernel_launch: occupancy query reports %d blocks per CU\n", per_cu);
        (void)hipGetLastError();
        grid = cus;
    }
    if (grid < 0) return;
    (void)in_sizes;
    if (hipMemsetAsync((char*)d_ws + WS_CTL, 0, CTL_ZERO_BYTES, stream) != hipSuccess) return;
#ifdef DBG_MEMSET
    (void)hipMemsetAsync((char*)d_ws + WS_HGB, 0, WS_END - WS_HGB, stream); (void)hipMemsetAsync((char*)d_ws + WS_O, 0, 192 * MiB, stream);
#endif
    Args a{};
    for (int i = 0; i < N_IN; ++i) a.in[i] = (const float*)d_in[i];
    a.out = (float*)d_out; a.ws = (unsigned char*)d_ws;
#if MK_PER_PHASE
    for (int p = 0; p < N_PHASES; ++p) { a.ph_lo = p; a.ph_hi = p + 1; hipLaunchKernelGGL(hybrid_fwd, dim3(grid), dim3(512), LDS_BYTES, stream, a); }
#else
    a.ph_lo = 0; a.ph_hi = N_PHASES; hipLaunchKernelGGL(hybrid_fwd, dim3(grid), dim3(512), LDS_BYTES, stream, a);
#endif
}
```

```cpp
#include <hip/hip_runtime.h>
#include <cstdio>
#include <cstdint>
namespace pg8 {
#define PG8_LAS __attribute__((address_space(3)))
typedef unsigned short bf16_t;
typedef short bf16x8 __attribute__((ext_vector_type(8)));
typedef float f32x4 __attribute__((ext_vector_type(4)));
typedef unsigned u32x4 __attribute__((ext_vector_type(4)));
constexpr int BM = 256, BK = 64, HALF = 128, HTB = HALF * BK * 2  , STAGE_BYTES = 8 * HTB, NXCD = 8, WGM = 8;

__host__ __device__ __forceinline__ int lds_byte(int r, int c) { const int st = (r >> 4) * 2 + (c >> 5), rr = r & 15, cc = c & 31, ob = rr * 64 + cc * 2; return st * 1024 + (ob ^ (((ob >> 9) & 1) << 5)); }
__host__ __device__ __forceinline__ void stage_rc(int b, int& R, int& C) { const int st = b / 1024, sb = b % 1024, swz = sb ^ (((sb >> 9) & 1) << 5); R = (st >> 1) * 16 + swz / 64; C = (st & 1) * 32 + (swz % 64) / 2; }
__host__ __device__ __forceinline__ int perm32(int rho) { const int n = rho >> 4, i = rho & 15; return 8 * (i >> 2) + 4 * n + (i & 3); }

struct Unit { int pm, pn; };
struct Gemm { const bf16_t* A; const bf16_t* Bt; int M, N, K; };

struct StaticOrder {
    int nM, nN, nwg, G, c;
    __host__ __device__ void init(int M, int N, int G_, int c_) { nM = M / BM; nN = N / BM; nwg = nM * nN; G = G_; c = c_; }
    __host__ __device__ bool next(int i, Unit& u) const {
        const long L = (long)i * G + c; if (L >= nwg) return false;
        int wgid = (int)L; { const int q = nwg / NXCD, r = nwg % NXCD, xcd = wgid % NXCD, off = wgid / NXCD; wgid = (xcd < r ? xcd * (q + 1) : r * (q + 1) + (xcd - r) * q) + off; }
        const int nig = WGM * nN, gid = wgid / nig, fm = gid * WGM, gsz = (nM - fm) < WGM ? (nM - fm) : WGM;
        u.pm = fm + ((wgid % nig) % gsz); u.pn = (wgid % nig) / gsz; return true;
    }
    __device__ __forceinline__ void a_ready(const Unit&) const {}
    __device__ __forceinline__ void done(const Unit&) const {}
};
__device__ __forceinline__ unsigned cvt_pk_bf16(float lo, float hi) { unsigned r; asm volatile("v_cvt_pk_bf16_f32 %0, %1, %2" : "=v"(r) : "v"(lo), "v"(hi)); return r; }
typedef float f32x2 __attribute__((ext_vector_type(2)));
template <class Epi, class Sched, bool ALIGN_EPI = false, bool SP2 = false>
__device__ __forceinline__ void gemm_phase(PG8_LAS unsigned char* lds, const Gemm g, const Sched& S, const Epi& E, int wave_id) {
    int tid_; asm volatile("v_mbcnt_lo_u32_b32 %0, -1, 0\n\tv_mbcnt_hi_u32_b32 %0, -1, %0" : "=v"(tid_)); tid_ += wave_id * 64;
    const int tid = tid_, wid = __builtin_amdgcn_readfirstlane(tid >> 6), lane = tid & 63, wr = wid >> 2, wc = wid & 3, fr = lane & 15, fq = lane >> 4;
    const int K = g.K, nt = K / BK;
    unsigned voffA[2], voffB[2];
#pragma unroll
    for (int i = 0; i < 2; ++i) { int R, C; stage_rc(tid * 16 + i * 8192, R, C); const int Rb = Epi::PERM ? ((R & ~31) + perm32(R & 31)) : R;
        voffA[i] = (unsigned)(R * K + C) * 2u; voffB[i] = (unsigned)(Rb * K + C) * 2u; }
    const size_t kstep = (size_t)(BK * 2);
    const size_t hstep = (size_t)HALF * K * 2;
    const size_t tstep = 2 * hstep;
    const unsigned ldsw = (unsigned)wid * 1024u;
    const int aoff = lds_byte(wr * 64 + fr, fq * 8), boff = lds_byte(wc * 32 + fr, fq * 8);
#define PG8_SA(b, h) (((b) * 2 + (h)) * HTB)
#define PG8_SB(b, h) ((4 + (b) * 2 + (h)) * HTB)
#define PG8_STAGE(bufoff, gbase, voff) do { _Pragma("unroll") for (int _i = 0; _i < 2; ++_i) \
        __builtin_amdgcn_global_load_lds((const unsigned*)((const char*)(gbase) + (voff)[_i]), (PG8_LAS unsigned*)(lds + (bufoff) + ldsw + _i * 8192), 16, 0, 0); } while (0)
#define PG8_LDA(dst, b, h) do { _Pragma("unroll") for (int m = 0; m < 4; ++m) _Pragma("unroll") for (int k = 0; k < 2; ++k) dst[m][k] = *(const PG8_LAS bf16x8*)(lds + PG8_SA(b, h) + aoff + m * 2048 + k * 1024); } while (0)
#define PG8_LDB(dst, b, h) do { _Pragma("unroll") for (int n = 0; n < 2; ++n) _Pragma("unroll") for (int k = 0; k < 2; ++k) dst[n][k] = *(const PG8_LAS bf16x8*)(lds + PG8_SB(b, h) + boff + n * 2048 + k * 1024); } while (0)
#define PG8_MMA(ai, bj, At, Bt) do { __builtin_amdgcn_s_setprio(1); _Pragma("unroll") for (int m = 0; m < 4; ++m) _Pragma("unroll") for (int n = 0; n < 2; ++n) _Pragma("unroll") for (int k = 0; k < 2; ++k) \
        acc[ai][bj][m][n] = __builtin_amdgcn_mfma_f32_16x16x32_bf16(Bt[n][k], At[m][k], acc[ai][bj][m][n], 0, 0, 0); __builtin_amdgcn_s_setprio(0); } while (0)
#define PG8_WAIT_V(n) asm volatile("s_waitcnt vmcnt(" #n ")" ::: "memory")
#define PG8_WAIT_L(n) asm volatile("s_waitcnt lgkmcnt(" #n ")" ::: "memory")
#define PG8_BAR __builtin_amdgcn_s_barrier()
#define PG8_SCHED __builtin_amdgcn_sched_barrier(0)
    Unit cur, nxt; int ui = 0;
    if (!S.next(0, cur)) return;
    f32x4 acc[2][2][4][2];
#pragma unroll
    for (int a = 0; a < 2; ++a)
#pragma unroll
        for (int b = 0; b < 2; ++b)
#pragma unroll
            for (int m = 0; m < 4; ++m)
#pragma unroll
                for (int n = 0; n < 2; ++n) acc[a][b][m][n] = (f32x4){0.f, 0.f, 0.f, 0.f};
    bf16x8 At[4][2], B0[2][2], B1[2][2];
    const char* cA = (const char*)g.A + (size_t)cur.pm * tstep; const char* cB = (const char*)g.Bt + (size_t)cur.pn * tstep;
    S.a_ready(cur);
    if constexpr (SP2) {
        PG8_STAGE(PG8_SB(0, 0), cB, voffB); PG8_STAGE(PG8_SB(0, 1), cB + hstep, voffB); PG8_STAGE(PG8_SA(0, 0), cA, voffA); PG8_STAGE(PG8_SA(0, 1), cA + hstep, voffA);
        if (wr == 1) PG8_BAR;
        PG8_WAIT_V(2); PG8_BAR;
        PG8_STAGE(PG8_SB(1, 0), cB + kstep, voffB); PG8_STAGE(PG8_SA(1, 0), cA + kstep, voffA); PG8_STAGE(PG8_SB(1, 1), cB + hstep + kstep, voffB);
        PG8_WAIT_V(6); PG8_BAR;
    } else {
        PG8_STAGE(PG8_SB(0, 0), cB, voffB); PG8_STAGE(PG8_SA(0, 0), cA, voffA); PG8_STAGE(PG8_SB(0, 1), cB + hstep, voffB); PG8_STAGE(PG8_SA(0, 1), cA + hstep, voffA);
        if (wr == 1) PG8_BAR;
        PG8_WAIT_V(4); PG8_BAR;
        PG8_STAGE(PG8_SB(1, 0), cB + kstep, voffB); PG8_STAGE(PG8_SA(1, 0), cA + kstep, voffA); PG8_STAGE(PG8_SB(1, 1), cB + hstep + kstep, voffB);
        PG8_WAIT_V(6); PG8_BAR;
    }
    for (;;) {
        const bool has_next = S.next(ui + 1, nxt);
        const char* nA = has_next ? (const char*)g.A + (size_t)nxt.pm * tstep : cA; const char* nB = has_next ? (const char*)g.Bt + (size_t)nxt.pn * tstep : cB;
        for (int t = 0; t < nt; t += 2) {
            const bool last = (t == nt - 2);
            const char* a1 = cA + (size_t)(t + 1) * kstep;
            const char* a2 = last ? nA : cA + (size_t)(t + 2) * kstep; const char* b2 = last ? nB : cB + (size_t)(t + 2) * kstep;
            const char* a3 = a2 + kstep; const char* b3 = b2 + kstep;
            if (last && has_next) S.a_ready(nxt);
            if constexpr (SP2) {
            PG8_LDB(B0, 0, 0); PG8_LDB(B1, 0, 1); PG8_SCHED; PG8_LDA(At, 0, 0); PG8_STAGE(PG8_SA(1, 1), a1 + hstep, voffA);
            PG8_WAIT_V(8); PG8_WAIT_L(0); PG8_BAR; PG8_MMA(0, 0, At, B0); PG8_MMA(0, 1, At, B1); PG8_BAR; PG8_SCHED;
            PG8_LDA(At, 0, 1); PG8_STAGE(PG8_SB(0, 0), b2, voffB); PG8_STAGE(PG8_SB(0, 1), b2 + hstep, voffB); PG8_STAGE(PG8_SA(0, 0), a2, voffA);
            PG8_WAIT_V(8); PG8_WAIT_L(0); PG8_BAR; PG8_MMA(1, 0, At, B0); PG8_MMA(1, 1, At, B1); PG8_BAR; PG8_SCHED;
            PG8_LDB(B0, 1, 0); PG8_LDB(B1, 1, 1); PG8_SCHED; PG8_LDA(At, 1, 0); PG8_STAGE(PG8_SA(0, 1), a2 + hstep, voffA);
            PG8_WAIT_V(8); PG8_WAIT_L(0); PG8_BAR; PG8_MMA(0, 0, At, B0); PG8_MMA(0, 1, At, B1); PG8_BAR; PG8_SCHED;
            PG8_LDA(At, 1, 1); PG8_STAGE(PG8_SB(1, 0), b3, voffB); PG8_STAGE(PG8_SB(1, 1), b3 + hstep, voffB); PG8_STAGE(PG8_SA(1, 0), a3, voffA);
            PG8_WAIT_V(8); PG8_WAIT_L(0); PG8_BAR; PG8_MMA(1, 0, At, B0); PG8_MMA(1, 1, At, B1); PG8_BAR; PG8_SCHED;
            } else {
            PG8_LDB(B0, 0, 0); PG8_SCHED; PG8_LDA(At, 0, 0); PG8_STAGE(PG8_SA(1, 1), a1 + hstep, voffA);
            PG8_WAIT_L(8); PG8_BAR; PG8_WAIT_L(0); PG8_MMA(0, 0, At, B0); PG8_BAR; PG8_SCHED;
            PG8_LDB(B1, 0, 1); PG8_STAGE(PG8_SB(0, 0), b2, voffB);
            PG8_BAR; PG8_WAIT_L(0); PG8_MMA(0, 1, At, B1); PG8_BAR;
            PG8_LDA(At, 0, 1); PG8_STAGE(PG8_SA(0, 0), a2, voffA);
            PG8_BAR; PG8_WAIT_L(0); PG8_MMA(1, 0, At, B0); PG8_BAR; PG8_SCHED;
            PG8_STAGE(PG8_SB(0, 1), b2 + hstep, voffB);
            PG8_WAIT_V(6); PG8_BAR; PG8_MMA(1, 1, At, B1); PG8_BAR;
            PG8_LDB(B0, 1, 0); PG8_SCHED; PG8_LDA(At, 1, 0); PG8_STAGE(PG8_SA(0, 1), a2 + hstep, voffA);
            PG8_WAIT_L(8); PG8_BAR; PG8_WAIT_L(0); PG8_MMA(0, 0, At, B0); PG8_BAR; PG8_SCHED;
            PG8_LDB(B1, 1, 1); PG8_STAGE(PG8_SB(1, 0), b3, voffB);
            PG8_BAR; PG8_WAIT_L(0); PG8_MMA(0, 1, At, B1); PG8_BAR;
            PG8_LDA(At, 1, 1); PG8_STAGE(PG8_SA(1, 0), a3, voffA);
            PG8_BAR; PG8_WAIT_L(0); PG8_MMA(1, 0, At, B0); PG8_BAR; PG8_SCHED;
            PG8_STAGE(PG8_SB(1, 1), b3 + hstep, voffB);
            PG8_WAIT_V(6); PG8_BAR; PG8_MMA(1, 1, At, B1); PG8_BAR;
            }
        }
        if constexpr (ALIGN_EPI) { if (wr == 0) PG8_BAR; }
        if constexpr (!Epi::AFTER_DRAIN) { E(acc, cur, wr, wc, fr, fq); S.done(cur); }
        if (!has_next) break;
#pragma unroll
        for (int a = 0; a < 2; ++a)
#pragma unroll
            for (int b = 0; b < 2; ++b)
#pragma unroll
                for (int m = 0; m < 4; ++m)
#pragma unroll
                    for (int n = 0; n < 2; ++n) acc[a][b][m][n] = (f32x4){0.f, 0.f, 0.f, 0.f};
        cur = nxt; cA = nA; cB = nB; ++ui;
        if constexpr (ALIGN_EPI) { if (wr == 1) PG8_BAR; }
    }
    PG8_WAIT_V(0);
    if constexpr (!ALIGN_EPI) { if (wr == 0) PG8_BAR; }
    PG8_BAR;
    if constexpr (Epi::AFTER_DRAIN) { E.fused(acc, cur, wr, wc, fr, fq, lds, wid, lane); S.done(cur); }
#undef PG8_SA
#undef PG8_SB
#undef PG8_STAGE
#undef PG8_LDA
#undef PG8_LDB
#undef PG8_MMA
#undef PG8_WAIT_V
#undef PG8_WAIT_L
#undef PG8_BAR
#undef PG8_SCHED
}
}
#define LAS __attribute__((address_space(3)))
#define XB_TMO      128
#define XB_XCNT(j)  (256  + 64 * (j))
#define XB_XSUB(j)  (1280 + 64 * (j))
#define XB_XGEN(j)  (2304 + 64 * (j))
#define XB_TOP      3328
#define XB_TOPGEN   3392
#define XCD_BAR_WORDS 3456
#define XB_SPIN_CAP (1u << 24)

__device__ __forceinline__ unsigned xb_ld(unsigned* p)              { return __hip_atomic_load(p, __ATOMIC_RELAXED, __HIP_MEMORY_SCOPE_AGENT); }
__device__ __forceinline__ unsigned xb_add(unsigned* p, unsigned v) { return __hip_atomic_fetch_add(p, v, __ATOMIC_RELAXED, __HIP_MEMORY_SCOPE_AGENT); }
__device__ __forceinline__ unsigned xb_xcc_id() { return (unsigned)__builtin_amdgcn_s_getreg((3 << 11) | 20) & 0xFu; }
#define XB_SPIN(cond, bar) do { unsigned _sp = 0; while (cond) { __builtin_amdgcn_s_sleep(1); \
    if ((++_sp & 255u) == 0u) { if (xb_ld(&(bar)[XB_TMO])) break; if (_sp > XB_SPIN_CAP) { atomicAdd(&(bar)[XB_TMO], 1u); break; } } } } while (0)

struct XcdBarrier {
    unsigned* bar; unsigned x; unsigned w0;
    volatile LAS unsigned* st;
};

__device__ __forceinline__ bool xb_lane0() { return __builtin_amdgcn_mbcnt_hi(~0u, __builtin_amdgcn_mbcnt_lo(~0u, 0u)) == 0u; }
__device__ __forceinline__ XcdBarrier xcd_barrier_post(unsigned* bar, volatile LAS unsigned* st, unsigned w0) {
    XcdBarrier b; b.bar = bar; b.x = xb_xcc_id(); b.st = st; b.w0 = w0;
    if (w0 && xb_lane0()) (void)xb_add(&bar[XB_XCNT(b.x)], 1u);
    return b;
}
__device__ __forceinline__ void xcd_barrier_complete(unsigned* bar, unsigned x, unsigned& nloc, unsigned& nx) {
    const unsigned G = gridDim.x * gridDim.y * gridDim.z;
    unsigned sum, cnt, mine, sp = 0u;
    for (;;) {
        sum = 0u; cnt = 0u; mine = 0u;
#pragma unroll
        for (unsigned j = 0; j < 16; ++j) { const unsigned c = xb_ld(&bar[XB_XCNT(j)]); sum += c; cnt += (c > 0u) ? 1u : 0u; mine = (j == x) ? c : mine; }
        if (sum == G) break;
        __builtin_amdgcn_s_sleep(1);
        if ((++sp & 255u) == 0u) { if (xb_ld(&bar[XB_TMO])) break; if (sp > XB_SPIN_CAP) { atomicAdd(&bar[XB_TMO], 1u); break; } }
    }
    nloc = mine > 0u ? mine : 1u; nx = cnt > 0u ? cnt : 1u;
}

__device__ __forceinline__ void xcd_barrier(const XcdBarrier& b) {
    asm volatile("s_waitcnt vmcnt(0)" ::: "memory");
    __syncthreads();
    if (b.w0 && xb_lane0()) {
        unsigned* bar = b.bar;
        __builtin_amdgcn_s_waitcnt(0);
        unsigned nloc = b.st[0], nx = b.st[1];
        if (nloc == 0u) { xcd_barrier_complete(bar, b.x, nloc, nx); b.st[0] = nloc; b.st[1] = nx; }
        const unsigned old = xb_add(&bar[XB_XSUB(b.x)], 1u);
        const unsigned gen = old / nloc;
        if (old + 1u == (gen + 1u) * nloc) {
            __builtin_amdgcn_fence(__ATOMIC_RELEASE, "agent");
            asm volatile("s_waitcnt vmcnt(0)" ::: "memory");
            const unsigned og = xb_add(&bar[XB_TOP], 1u);
            const unsigned tg = og / nx;
            if (og + 1u == (tg + 1u) * nx) xb_add(&bar[XB_TOPGEN], 1u);
            else XB_SPIN(xb_ld(&bar[XB_TOPGEN]) == tg, bar);
            __builtin_amdgcn_fence(__ATOMIC_ACQUIRE, "agent");
            xb_add(&bar[XB_XGEN(b.x)], 1u);
            asm volatile("s_waitcnt vmcnt(0)" ::: "memory");
        } else {
            XB_SPIN(xb_ld(&bar[XB_XGEN(b.x)]) == gen, bar);
            __builtin_amdgcn_fence(__ATOMIC_ACQUIRE, "agent");
            asm volatile("s_waitcnt vmcnt(0)" ::: "memory");
        }
    }
    __syncthreads();
}
#ifndef EN_CH128
#define EN_CH128 1
#endif
#ifndef EN_CH192
#define EN_CH192 1
#endif
#ifndef EN_DN
#define EN_DN 1
#endif
#ifndef EN_GLU
#define EN_GLU 1
#endif
#ifndef EN_GU
#define EN_GU 1
#endif
#ifndef EN_INPROJ
#define EN_INPROJ 1
#endif
#ifndef EN_LN
#define EN_LN 1
#endif
#ifndef EN_MIX
#define EN_MIX 1
#endif
#ifndef EN_MOD
#define EN_MOD 1
#endif
#ifndef EN_OUT
#define EN_OUT 1
#endif
#ifndef EN_PRE
#define EN_PRE 1
#endif
#ifndef EN_PRO
#define EN_PRO 1
#endif
#ifndef EN_S5N
#define EN_S5N 1
#endif

constexpr int DM = 4096, NB = 2, SEQ = 8192, MTOK = NB * SEQ, DEPTH = 4;
constexpr int S5W = 1024;
constexpr int HGW = 1536;
constexpr int GLKW = 768;
constexpr int INW = 11792, INP = 12032, DFF = 11008;
constexpr int OW = 3072;
constexpr int C_U = 0, C_QB = 1024, C_FB = 2560, C_IB = 4096, C_GB = 5632, C_QC = 7168, C_KC = 7936, C_VC = 8704, C_GC = 10240, C_LR = 11776;
constexpr float LN_EPS = 1e-5f;
constexpr float ALPHA = 1.6817928305074290861f;
constexpr float GLA_QSCALE = 0.07216878364870322f;

enum { I_X = 0, I_C, I_WADA, I_BADA, I_TABLE, I_WIN, I_WOUT, I_AREAL, I_AIMAG, I_LOGDT, I_BRE, I_BIM, I_CRE, I_CIM, I_S5D, I_GLUW, I_GLUB,
       I_LBRAW, I_HGG, I_HGB, I_WGATE, I_BGATE, I_GLG, I_WFG, I_WFU, I_WFD, I_LN1G, I_LN1B, I_LN2G, I_LN2B, N_IN };

constexpr size_t MiB = 1u << 20;
constexpr size_t WS_CTL = 0, CTL_ZERO_BYTES = 1 * MiB;
constexpr size_t WS_MOD = 1 * MiB;
constexpr size_t WS_MISC = 2 * MiB;
constexpr size_t WS_ROWSTATS = 3 * MiB;
constexpr size_t WS_ROWPART = 4 * MiB;
constexpr size_t WS_CONDPART = 12 * MiB;
constexpr size_t WS_H = 24 * MiB;
constexpr size_t WS_MIXED = WS_H + 128 * MiB;
constexpr size_t WS_Z = WS_MIXED + 128 * MiB;
constexpr size_t WS_O = WS_Z + 32 * MiB;
constexpr size_t WS_P = WS_O + 192 * MiB;
constexpr size_t WS_WT = WS_P + 376 * MiB;
constexpr size_t WT_IN = 0, WT_OUT = 94 * MiB, WT_GU = 126 * MiB, WT_DN = 298 * MiB, WT_GLU = 384 * MiB, WT_LAYER = 386 * MiB;
constexpr size_t WS_HGB = WS_WT + DEPTH * WT_LAYER;
constexpr size_t WS_GLB = WS_HGB + 198 * MiB;
constexpr size_t WS_S5T = WS_GLB + 128 * MiB;
constexpr size_t WS_S5W1 = WS_S5T + 576 * MiB;
constexpr size_t WS_UX = WS_S5W1 + 144 * MiB;
constexpr size_t WS_SLOC = WS_UX + 36 * MiB;
constexpr size_t WS_LAM64 = WS_SLOC + 8 * MiB;
constexpr size_t WS_END = WS_LAM64 + 1 * MiB;
static_assert((size_t)INP * DM * 2 == 94 * MiB && (size_t)DM * DM * 2 == 32 * MiB && (size_t)2 * DFF * DM * 2 == 172 * MiB && (size_t)DM * DFF * 2 == 86 * MiB, "weight map");
static_assert((size_t)MTOK * INP * 2 == 376 * MiB && (size_t)MTOK * DFF * 2 <= 376 * MiB, "activation map");

constexpr int RING_BYTES = 131072;
constexpr int LDSCTL_OFF = 135168;
constexpr int LDS_BYTES = 147456;

#ifndef LAS
#define LAS __attribute__((address_space(3)))
#endif
typedef unsigned short bf16_t;
typedef float f32x4 __attribute__((ext_vector_type(4)));
typedef float f32x2 __attribute__((ext_vector_type(2)));
typedef unsigned u32x4 __attribute__((ext_vector_type(4)));
typedef unsigned u32x2 __attribute__((ext_vector_type(2)));
#define LDS_WAIT() asm volatile("s_waitcnt lgkmcnt(0)" ::: "memory")
#define VM_WAIT() asm volatile("s_waitcnt vmcnt(0)" ::: "memory")
typedef __bf16 bf16x2_t __attribute__((ext_vector_type(2)));
__device__ __forceinline__ unsigned cvt_pk_bf16(float lo, float hi) { return __builtin_bit_cast(unsigned, __builtin_convertvector((f32x2){lo, hi}, bf16x2_t)); }

__device__ __forceinline__ float bf_lo(unsigned w) { return __uint_as_float(w << 16); }
__device__ __forceinline__ float bf_hi(unsigned w) { return __uint_as_float(w & 0xffff0000u); }
__device__ __forceinline__ float bf2f(bf16_t b) { return __uint_as_float(((unsigned)b) << 16); }
__device__ __forceinline__ float wave_sum(float v) {
#pragma unroll
    for (int o = 1; o < 64; o <<= 1) v += __shfl_xor(v, o);
    return v;
}
__device__ __forceinline__ float sigmoidf_(float x) { return 1.0f / (1.0f + __expf(-x)); }
__device__ __forceinline__ float gelu_tanh(float y) { const float a = 0.7978845608028654f * (y + 0.044715f * y * y * y); const float t = 1.0f - 2.0f / (1.0f + __expf(2.0f * a)); return 0.5f * y * (1.0f + t); }

struct EpiProj {
    static constexpr bool PERM = true, AFTER_DRAIN = false;
    bf16_t* P; bf16_t* UX;
    __device__ __forceinline__ void operator()(const f32x4 (&acc)[2][2][4][2], const pg8::Unit& u, int wr, int wc, int fr, int fq) const {
        const int row0 = u.pm * 256 + wr * 64 + fr, col0 = u.pn * 256 + wc * 32 + 8 * fq;
        const bool s5 = u.pn < 4;
#pragma unroll
        for (int ai = 0; ai < 2; ++ai)
#pragma unroll
            for (int m = 0; m < 4; ++m) { const int row = row0 + ai * 128 + m * 16;
#pragma unroll
                for (int bj = 0; bj < 2; ++bj) { const f32x4 v0 = acc[ai][bj][m][0], v1 = acc[ai][bj][m][1]; const int col = col0 + bj * 128;
                    u32x4 w; w.x = cvt_pk_bf16(v0[0], v0[1]); w.y = cvt_pk_bf16(v0[2], v0[3]); w.z = cvt_pk_bf16(v1[0], v1[1]); w.w = cvt_pk_bf16(v1[2], v1[3]);
                    if (!s5) *(u32x4*)(P + (size_t)row * INP + col) = w;
                    else { bf16_t* ur = UX + (size_t)((col >> 4) * 256 + (row >> 6)) * 1152; *(u32x4*)(ur + (row & 63) * 16 + (col & 15)) = w;
                        if ((row & 63) == 0) { const u32x4 z = (u32x4){0u, 0u, 0u, 0u}; bf16_t* zp = ur + 1024 + ((col & 15) ? 64 : 0);
#pragma unroll
                            for (int i = 0; i < 8; ++i) *(u32x4*)(zp + 8 * i) = z; } } } }
    }
};
struct EpiSwiglu {
    static constexpr bool PERM = true, AFTER_DRAIN = false;
    bf16_t* HID;
    __device__ __forceinline__ void operator()(const f32x4 (&acc)[2][2][4][2], const pg8::Unit& u, int wr, int wc, int fr, int fq) const {
        const int row0 = u.pm * 256 + wr * 64 + fr, col0 = u.pn * 128 + wc * 32 + 8 * fq;
#pragma unroll
        for (int ai = 0; ai < 2; ++ai)
#pragma unroll
            for (int m = 0; m < 4; ++m) { bf16_t* rowp = HID + (size_t)(row0 + ai * 128 + m * 16) * DFF + col0;
                float o[8];
#pragma unroll
                for (int n = 0; n < 2; ++n)
#pragma unroll
                    for (int j = 0; j < 4; ++j) { const float g = acc[ai][0][m][n][j], up = acc[ai][1][m][n][j]; o[n * 4 + j] = g * __builtin_amdgcn_rcpf(1.0f + __expf(-g)) * up; }
                u32x4 w; w.x = cvt_pk_bf16(o[0], o[1]); w.y = cvt_pk_bf16(o[2], o[3]); w.z = cvt_pk_bf16(o[4], o[5]); w.w = cvt_pk_bf16(o[6], o[7]);
                *(u32x4*)rowp = w; }
    }
};
struct EpiGlu {
    static constexpr bool PERM = true, AFTER_DRAIN = false;
    const bf16_t* Z; bf16_t* MIXED; const float* bias;
    __device__ __forceinline__ void operator()(const f32x4 (&acc)[2][2][4][2], const pg8::Unit& u, int wr, int wc, int fr, int fq) const {
        const int row0 = u.pm * 256 + wr * 64 + fr, col0 = u.pn * 256 + wc * 32 + 8 * fq;
#pragma unroll
        for (int bj = 0; bj < 2; ++bj) {
            const f32x4 b0 = *(const f32x4*)(bias + col0 + bj * 128), b1 = *(const f32x4*)(bias + col0 + bj * 128 + 4);
#pragma unroll
            for (int ai = 0; ai < 2; ++ai)
#pragma unroll
                for (int m = 0; m < 4; ++m) { const size_t r = (size_t)(row0 + ai * 128 + m * 16);
                    const u32x4 zz = *(const u32x4*)(Z + r * S5W + col0 + bj * 128);
                    const f32x4 v0 = acc[ai][bj][m][0] + b0, v1 = acc[ai][bj][m][1] + b1;
                    u32x4 w;
                    w.x = cvt_pk_bf16(bf_lo(zz.x) * sigmoidf_(v0[0]), bf_hi(zz.x) * sigmoidf_(v0[1]));
                    w.y = cvt_pk_bf16(bf_lo(zz.y) * sigmoidf_(v0[2]), bf_hi(zz.y) * sigmoidf_(v0[3]));
                    w.z = cvt_pk_bf16(bf_lo(zz.z) * sigmoidf_(v1[0]), bf_hi(zz.z) * sigmoidf_(v1[1]));
                    w.w = cvt_pk_bf16(bf_lo(zz.w) * sigmoidf_(v1[2]), bf_hi(zz.w) * sigmoidf_(v1[3]));
                    *(u32x4*)(MIXED + r * DM + col0 + bj * 128) = w;
                    if (m & 1) asm volatile("" ::: "memory"); }
        }
    }
};
struct EpiResid {
    static constexpr bool PERM = false, AFTER_DRAIN = false;
    const float* base; float* out; const float* rowstats; const float* lng; const float* lnb; const float* gate0; float* rowpart;
    __device__ __forceinline__ void operator()(const f32x4 (&acc)[2][2][4][2], const pg8::Unit& u, int wr, int wc, int fr, int fq) const {
        const int rowb = u.pm * 256 + wr * 64 + fr, col0 = u.pn * 256 + wc * 32 + 4 * fq;
        const float* gp = gate0 + (u.pm >= 32 ? 6 * DM : 0);
#pragma unroll
        for (int ai = 0; ai < 2; ++ai)
#pragma unroll
            for (int m = 0; m < 4; ++m) { const int row = rowb + ai * 128 + m * 16;
                const f32x2 st = *(const f32x2*)(rowstats + (size_t)row * 2);
                float s1 = 0.f, s2 = 0.f;
#pragma unroll
                for (int bj = 0; bj < 2; ++bj)
#pragma unroll
                    for (int n = 0; n < 2; ++n) { const int c = col0 + bj * 128 + n * 16; const size_t off = (size_t)row * DM + c;
                        const f32x4 vb = *(const f32x4*)(base + off);
                        const f32x4 A = *(const f32x4*)(lng + c), Bc = *(const f32x4*)(lnb + c), Gm = *(const f32x4*)(gp + c);
                        const f32x4 o = (((vb - st.x) * st.y) * A + Bc) * ALPHA + (Gm + 1.0f) * acc[ai][bj][m][n];
                        *(f32x4*)(out + off) = o;
                        s1 += (o[0] + o[1]) + (o[2] + o[3]); s2 += (o[0] * o[0] + o[1] * o[1]) + (o[2] * o[2] + o[3] * o[3]); }
                s1 += __shfl_xor(s1, 16); s1 += __shfl_xor(s1, 32); s2 += __shfl_xor(s2, 16); s2 += __shfl_xor(s2, 32);
                if (fq == 0) *(f32x2*)(rowpart + ((size_t)row * 64 + u.pn * 4 + wc) * 2) = (f32x2){s1, s2};
                asm volatile("" ::: "memory"); }
    }
};

__device__ __forceinline__ int lane_id_v() { int r; asm volatile("v_mbcnt_lo_u32_b32 %0, -1, 0\n\tv_mbcnt_hi_u32_b32 %0, -1, %0" : "=v"(r)); return r; }
struct Args { const float* in[N_IN]; float* out; unsigned char* ws; int ph_lo, ph_hi; };
struct Ctx {
    volatile LAS unsigned long long* t;
    __device__ __forceinline__ unsigned long long ld(int i) const { const unsigned long long v = t[i];
        return ((unsigned long long)(unsigned)__builtin_amdgcn_readfirstlane((int)(v >> 32)) << 32) | (unsigned long long)(unsigned)__builtin_amdgcn_readfirstlane((int)(unsigned)v); }
    __device__ __forceinline__ const float* in(int i) const { return (const float*)ld(i); }
    __device__ __forceinline__ float* out() const { return (float*)ld(30); }
    __device__ __forceinline__ unsigned char* ws() const { return (unsigned char*)ld(31); }
};

constexpr int S5K = 1152;
constexpr size_t S5_T_LAYER = (size_t)64 * 1024 * S5K * 2, S5_W1_LAYER = (size_t)64 * 256 * S5K * 2;

struct S5Order {
    int G, c, n, sh;
    __device__ __forceinline__ bool next(int i, pg8::Unit& u) const { const int L = i * G + c; if (L >= n) return false; u.pm = L >> sh; u.pn = L; return true; }
    __device__ __forceinline__ void a_ready(const pg8::Unit&) const {}
    __device__ __forceinline__ void done(const pg8::Unit&) const {}
};
struct EpiS5A {
    static constexpr bool PERM = false, AFTER_DRAIN = false;
    float* Sloc;
    __device__ __forceinline__ void operator()(const f32x4 (&acc)[2][2][4][2], const pg8::Unit& u, int wr, int wc, int fr, int fq) const {
        const int row0 = u.pm * 256 + wr * 64 + fr, col0 = wc * 32 + 4 * fq;
#pragma unroll
        for (int ai = 0; ai < 2; ++ai)
#pragma unroll
            for (int m = 0; m < 4; ++m)
#pragma unroll
                for (int n = 0; n < 2; ++n) *(f32x4*)(Sloc + (size_t)(row0 + ai * 128 + m * 16) * 128 + col0 + n * 16) = acc[ai][0][m][n];
    }
};
struct EpiS5C {
    static constexpr bool PERM = true, AFTER_DRAIN = false;
    bf16_t* Z;
    __device__ __forceinline__ void operator()(const f32x4 (&acc)[2][2][4][2], const pg8::Unit& u, int wr, int wc, int fr, int fq) const {
        const int g = u.pm, c0 = wr * 64 + fr, cc0 = (u.pn & 3) * 256 + wc * 32 + 8 * fq;
#pragma unroll
        for (int ai = 0; ai < 2; ++ai)
#pragma unroll
            for (int m = 0; m < 4; ++m) { const int c = c0 + ai * 128 + m * 16;
#pragma unroll
                for (int bj = 0; bj < 2; ++bj) { const int cc = cc0 + bj * 128, t = cc >> 4, h0 = cc & 15;
                    const f32x4 v0 = acc[ai][bj][m][0], v1 = acc[ai][bj][m][1];
                    u32x4 w; w.x = cvt_pk_bf16(gelu_tanh(v0[0]), gelu_tanh(v0[1])); w.y = cvt_pk_bf16(gelu_tanh(v0[2]), gelu_tanh(v0[3]));
                    w.z = cvt_pk_bf16(gelu_tanh(v1[0]), gelu_tanh(v1[1])); w.w = cvt_pk_bf16(gelu_tanh(v1[2]), gelu_tanh(v1[3]));
                    *(u32x4*)(Z + (size_t)(c * 64 + t) * S5W + g * 16 + h0) = w; } }
    }
};
__device__ __forceinline__ void s5_tables_item(const Ctx& a, int lg, LAS unsigned char* lds, int wave, int lane) {
    LAS f32x2* LP = (LAS f32x2*)lds;
    LAS f32x2* BB = (LAS f32x2*)(lds + 33280);
    LAS f32x2* CC = (LAS f32x2*)(lds + 41472);
    LAS float* KT = (LAS float*)(lds + 49664);
    const int tid = wave * 64 + lane, l = lg >> 6, g = lg & 63;
    if (tid < 64) { const int p = tid;
        const double ar = (double)a.in(I_AREAL)[lg * 64 + p], ai = (double)a.in(I_AIMAG)[lg * 64 + p], dt = exp((double)a.in(I_LOGDT)[lg]);
        const double mag = exp(ar * dt), ang = ai * dt, lr = mag * cos(ang), li = mag * sin(ang);
        const double den = ar * ar + ai * ai, nr = lr - 1.0, ni = li, cr = (nr * ar + ni * ai) / den, ci = (ni * ar - nr * ai) / den;
        double pr = 1.0, pi = 0.0;
        for (int tau = 0; tau <= 64; ++tau) { LP[tau * 64 + p] = (f32x2){(float)pr, (float)pi}; const double nr2 = pr * lr - pi * li, ni2 = pr * li + pi * lr; pr = nr2; pi = ni2; }
        for (int h = 0; h < 16; ++h) { const double br = (double)a.in(I_BRE)[((size_t)lg * 64 + p) * 16 + h], bi = (double)a.in(I_BIM)[((size_t)lg * 64 + p) * 16 + h];
            BB[p * 16 + h] = (f32x2){(float)(cr * br - ci * bi), (float)(cr * bi + ci * br)}; }
    }
    for (int e = tid; e < 1024; e += 512) { const int h = e >> 6, p = e & 63; CC[e] = (f32x2){a.in(I_CRE)[((size_t)lg * 16 + h) * 64 + p], a.in(I_CIM)[((size_t)lg * 16 + h) * 64 + p]}; }
    __syncthreads();
    if (tid < 64) *(f32x2*)((float*)(a.ws() + WS_LAM64) + ((size_t)lg * 64 + tid) * 2) = LP[64 * 64 + tid];
    for (int e = tid; e < 64 * 256; e += 512) { const int tau = e >> 8, h = (e >> 4) & 15, hp = e & 15; float s = 0.f;
#pragma unroll 8
        for (int p = 0; p < 64; ++p) { const f32x2 c = CC[h * 64 + p], lm = LP[tau * 64 + p], b = BB[p * 16 + hp];
            const float xr = c.x * lm.x - c.y * lm.y, xi = c.x * lm.y + c.y * lm.x; s += xr * b.x - xi * b.y; }
        if (tau == 0 && h == hp) s += a.in(I_S5D)[l * S5W + g * 16 + h];
        KT[e] = s; }
    __syncthreads();
    bf16_t* T = (bf16_t*)(a.ws() + WS_S5T + (size_t)l * S5_T_LAYER) + (size_t)g * 1024 * S5K;
    for (int pc = tid; pc < 1024 * 144; pc += 512) { const int n = pc / 144, j = pc % 144, t = n >> 4, h = n & 15; float v[8];
        if (j < 128) { const int s = j >> 1, hp0 = (j & 1) * 8;
            if (s > t) {
#pragma unroll
                for (int i = 0; i < 8; ++i) v[i] = 0.f;
            } else { const LAS float* kp = KT + (t - s) * 256 + h * 16 + hp0; const f32x4 k0 = *(const LAS f32x4*)kp, k1 = *(const LAS f32x4*)(kp + 4);
                v[0] = k0[0]; v[1] = k0[1]; v[2] = k0[2]; v[3] = k0[3]; v[4] = k1[0]; v[5] = k1[1]; v[6] = k1[2]; v[7] = k1[3]; }
        } else { const int p0 = (j - 128) * 4;
#pragma unroll
            for (int i = 0; i < 4; ++i) { const f32x2 c = CC[h * 64 + p0 + i], lm = LP[(t + 1) * 64 + p0 + i]; v[2 * i] = c.x * lm.x - c.y * lm.y; v[2 * i + 1] = -(c.x * lm.y + c.y * lm.x); } }
        *(u32x4*)(T + (size_t)n * S5K + j * 8) = (u32x4){cvt_pk_bf16(v[0], v[1]), cvt_pk_bf16(v[2], v[3]), cvt_pk_bf16(v[4], v[5]), cvt_pk_bf16(v[6], v[7])}; }
    bf16_t* W1 = (bf16_t*)(a.ws() + WS_S5W1 + (size_t)l * S5_W1_LAYER) + (size_t)g * 256 * S5K;
    for (int pc = tid; pc < 256 * 144; pc += 512) { const int n = pc / 144, j = pc % 144; float v[8];
#pragma unroll
        for (int i = 0; i < 8; ++i) v[i] = 0.f;
        if (n < 128 && j < 128) { const int p = n >> 1, ri = n & 1, s = j >> 1, hp0 = (j & 1) * 8; const f32x2 lm = LP[(63 - s) * 64 + p];
#pragma unroll
            for (int i = 0; i < 8; ++i) { const f32x2 b = BB[p * 16 + hp0 + i]; v[i] = ri ? (lm.x * b.y + lm.y * b.x) : (lm.x * b.x - lm.y * b.y); } }
        *(u32x4*)(W1 + (size_t)n * S5K + j * 8) = (u32x4){cvt_pk_bf16(v[0], v[1]), cvt_pk_bf16(v[2], v[3]), cvt_pk_bf16(v[4], v[5]), cvt_pk_bf16(v[6], v[7])}; }
    __syncthreads();
}
__device__ __forceinline__ void s5_scan_item(const Ctx& a, int l, int item, int wave, int lane) {
    const int idx = item * 512 + wave * 64 + lane, g = idx >> 7, b = (idx >> 6) & 1, p = idx & 63;
    const f32x2 lam = *(const f32x2*)((const float*)(a.ws() + WS_LAM64) + ((size_t)(l * 64 + g) * 64 + p) * 2);
    const float* sl = (const float*)(a.ws() + WS_SLOC) + ((size_t)(g * 256 + b * 128)) * 128 + 2 * p;
    bf16_t* ux = (bf16_t*)(a.ws() + WS_UX) + ((size_t)(g * 256 + b * 128)) * S5K + 1024 + 2 * p;
    float xr = 0.f, xi = 0.f;
    for (int c0 = 0; c0 < 128; c0 += 8) { f32x2 s[8];
#pragma unroll
        for (int i = 0; i < 8; ++i) s[i] = *(const f32x2*)(sl + (size_t)(c0 + i) * 128);
#pragma unroll
        for (int i = 0; i < 8; ++i) { *(unsigned*)(ux + (size_t)(c0 + i) * S5K) = cvt_pk_bf16(xr, xi);
            const float nr = lam.x * xr - lam.y * xi + s[i].x, ni = lam.x * xi + lam.y * xr + s[i].y; xr = nr; xi = ni; } }
}

__device__ __forceinline__ void transpose_item(const float* W, int N, int k0, int n0, bf16_t* WT, int drow0, int Kd, LAS float* scr, int lane) {
    const int nl = 4 * (lane & 15), kq = lane >> 4;
    const bool valid = (n0 + nl) < N;
    f32x4 v[16];
#pragma unroll
    for (int i = 0; i < 16; ++i) { const int k = 4 * i + kq; v[i] = valid ? *(const f32x4*)(W + (size_t)(k0 + k) * N + n0 + nl) : (f32x4){0.f, 0.f, 0.f, 0.f}; }
#pragma unroll
    for (int i = 0; i < 16; ++i) { const int k = 4 * i + kq; LAS float* s = scr + k * 65 + nl; s[0] = v[i][0]; s[1] = v[i][1]; s[2] = v[i][2]; s[3] = v[i][3]; }
    LDS_WAIT();
    const int c = lane & 7;
#pragma unroll
    for (int j = 0; j < 8; ++j) { const int n = (lane >> 3) + 8 * j; const LAS float* s = scr + (8 * c) * 65 + n;
        u32x4 o; o.x = cvt_pk_bf16(s[0], s[65]); o.y = cvt_pk_bf16(s[130], s[195]); o.z = cvt_pk_bf16(s[260], s[325]); o.w = cvt_pk_bf16(s[390], s[455]);
        *(u32x4*)(WT + (size_t)(drow0 + n) * Kd + k0 + 8 * c) = o; }
    LDS_WAIT();
}
constexpr int NIT_IN = 64 * 188, NIT_OUT = 64 * 64, NIT_G = 64 * 172, NIT_DN = 172 * 64, NIT_GLU = 16 * 16;
constexpr int NIT_LAYER = NIT_IN + NIT_OUT + 2 * NIT_G + NIT_DN + NIT_GLU;
constexpr int NIT_TR = DEPTH * NIT_LAYER, NIT_COND = 64 * 96;

__device__ __forceinline__ void phase_prologue(const Ctx& a, LAS unsigned char* lds, int wave, int lane) {
    LAS float* scr = (LAS float*)(lds + wave * 16640);
    const int gw = blockIdx.x * 8 + wave, NGW = gridDim.x * 8;
    for (int it = gw; it < NIT_TR + NIT_COND; it += NGW) {
        if (it < NIT_TR) {
            const int l = it / NIT_LAYER; int r = it % NIT_LAYER;
            unsigned char* wt = a.ws() + WS_WT + (size_t)l * WT_LAYER;
            if (r < NIT_IN) { const int kb = r / 188, nb = r % 188; transpose_item(a.in(I_WIN) + (size_t)l * DM * INW, INW, 64 * kb, 64 * nb, (bf16_t*)(wt + WT_IN), 64 * nb, DM, scr, lane); continue; } r -= NIT_IN;
            if (r < NIT_OUT) { const int kb = r / 64, nb = r % 64; transpose_item(a.in(I_WOUT) + (size_t)l * DM * DM, DM, 64 * kb, 64 * nb, (bf16_t*)(wt + WT_OUT), 64 * nb, DM, scr, lane); continue; } r -= NIT_OUT;
            if (r < NIT_G) { const int kb = r / 172, nb = r % 172, n0 = 64 * nb; transpose_item(a.in(I_WFG) + (size_t)l * DM * DFF, DFF, 64 * kb, n0, (bf16_t*)(wt + WT_GU), 256 * (n0 / 128) + (n0 % 128), DM, scr, lane); continue; } r -= NIT_G;
            if (r < NIT_G) { const int kb = r / 172, nb = r % 172, n0 = 64 * nb; transpose_item(a.in(I_WFU) + (size_t)l * DM * DFF, DFF, 64 * kb, n0, (bf16_t*)(wt + WT_GU), 256 * (n0 / 128) + 128 + (n0 % 128), DM, scr, lane); continue; } r -= NIT_G;
            if (r < NIT_DN) { const int kb = r / 64, nb = r % 64; transpose_item(a.in(I_WFD) + (size_t)l * DFF * DM, DM, 64 * kb, 64 * nb, (bf16_t*)(wt + WT_DN), 64 * nb, DFF, scr, lane); continue; } r -= NIT_DN;
            { const int kb = r / 16, nb = r % 16; transpose_item(a.in(I_GLUW) + (size_t)l * S5W * S5W, S5W, 64 * kb, 64 * nb, (bf16_t*)(wt + WT_GLU), 64 * nb, S5W, scr, lane); }
        } else {
            const int item = it - NIT_TR, kb = item / 96, jb = item % 96, k0 = 64 * kb, j0 = 256 * jb + 4 * lane;
            const float* c = a.in(I_C);
            float c0 = c[k0 + lane], c1 = c[DM + k0 + lane];
            c0 = c0 / (1.0f + expf(-c0)); c1 = c1 / (1.0f + expf(-c1));
            f32x4 a0 = (f32x4){0.f, 0.f, 0.f, 0.f}, a1 = a0;
            const float* w = a.in(I_WADA) + (size_t)k0 * (6 * DM) + j0;
#pragma unroll 8
            for (int kk = 0; kk < 64; ++kk) { const f32x4 wv = *(const f32x4*)(w + (size_t)kk * (6 * DM));
                const float s0 = __int_as_float(__builtin_amdgcn_readlane(__float_as_int(c0), kk)), s1 = __int_as_float(__builtin_amdgcn_readlane(__float_as_int(c1), kk));
                a0 += wv * s0; a1 += wv * s1; }
            float* cp = (float*)(a.ws() + WS_CONDPART);
            *(f32x4*)(cp + (size_t)(kb * 2 + 0) * (6 * DM) + j0) = a0;
            *(f32x4*)(cp + (size_t)(kb * 2 + 1) * (6 * DM) + j0) = a1;
        }
    }
    __syncthreads();
    for (int lg = blockIdx.x; lg < DEPTH * 64; lg += gridDim.x) s5_tables_item(a, lg, lds, wave, lane);
}
__device__ __forceinline__ void phase_mod(const Ctx& a, int wave, int lane) {
    const int gt = blockIdx.x * 512 + wave * 64 + lane, NT = gridDim.x * 512;
    const float* cp = (const float*)(a.ws() + WS_CONDPART);
    float* mod = (float*)(a.ws() + WS_MOD); float* misc = (float*)(a.ws() + WS_MISC);
    for (int idx = gt; idx < NB * 6 * DM; idx += NT) {
        const int b = idx / (6 * DM), j = idx % (6 * DM);
        float s = a.in(I_BADA)[j];
        for (int kb = 0; kb < 64; ++kb) s += cp[(size_t)(kb * 2 + b) * (6 * DM) + j];
        for (int l = 0; l < DEPTH; ++l) mod[(size_t)((l * 2 + b) * 6) * DM + j] = s + a.in(I_TABLE)[(size_t)l * 6 * DM + j];
    }
    for (int idx = gt; idx < DM; idx += NT) { misc[idx] = 1.0f; misc[DM + idx] = 0.0f; }
    for (int idx = gt; idx < HGW; idx += NT) {
        const float* raw = a.in(I_LBRAW); float r[DEPTH], mx = -3.0e38f;
#pragma unroll
        for (int l = 0; l < DEPTH; ++l) { r[l] = raw[l * HGW + idx]; mx = fmaxf(mx, r[l]); }
        float e[DEPTH], sum = 0.f;
#pragma unroll
        for (int l = 0; l < DEPTH; ++l) { e[l] = expf(r[l] - mx); sum += e[l]; }
        float cum = 0.f;
#pragma unroll
        for (int l = 0; l < DEPTH; ++l) { misc[2 * DM + l * HGW + idx] = cum; if (l + 1 < DEPTH) cum += e[l + 1] / sum; }
    }
}

template <int MODE>
__device__ __forceinline__ void phase_lnapply(const float* vsrc, const float* rowpart, float* rowstats, const float* lng, const float* lnb, const float* modp, int i_shift, int i_scale,
                                              bf16_t* H, float* outf, LAS unsigned char* lds, int wave, int lane) {
    LAS f32x2* st = (LAS f32x2*)lds;
    for (int blk = blockIdx.x; blk < MTOK / 64; blk += gridDim.x) {
        const int r0 = blk * 64, b = (r0 >= SEQ) ? 1 : 0;
        for (int rr = 0; rr < 8; ++rr) { const int rl = wave * 8 + rr, r = r0 + rl; float mu = 0.f, rs = 1.f;
            if (MODE != 0) { const f32x2 p = *(const f32x2*)(rowpart + ((size_t)r * 64 + lane) * 2); const float s1 = wave_sum(p.x), s2 = wave_sum(p.y);
                mu = s1 * (1.0f / DM); const float var = fmaxf(s2 * (1.0f / DM) - mu * mu, 0.f); rs = 1.0f / sqrtf(var + LN_EPS); }
            if (lane == 0) { st[rl] = (f32x2){mu, rs}; if (MODE != 2) *(f32x2*)(rowstats + (size_t)r * 2) = (f32x2){mu, rs}; } }
        __syncthreads();
        f32x4 A[2], B[2];
#pragma unroll
        for (int jj = 0; jj < 2; ++jj) { const int c = 512 * wave + 256 * jj + 4 * lane;
            f32x4 g = (f32x4){1.f, 1.f, 1.f, 1.f}, bb = (f32x4){0.f, 0.f, 0.f, 0.f};
            if (MODE != 0) { g = *(const f32x4*)(lng + c); bb = *(const f32x4*)(lnb + c); }
            if (MODE != 2) { const f32x4 sc = *(const f32x4*)(modp + (size_t)(b * 6 + i_scale) * DM + c) + 1.0f, sh = *(const f32x4*)(modp + (size_t)(b * 6 + i_shift) * DM + c); A[jj] = g * sc; B[jj] = bb * sc + sh; }
            else { A[jj] = g; B[jj] = bb; } }
#pragma unroll 8
        for (int rl = 0; rl < 64; ++rl) { const f32x2 s = st[rl]; const size_t off = (size_t)(r0 + rl) * DM + 512 * wave + 4 * lane;
#pragma unroll
            for (int jj = 0; jj < 2; ++jj) { const f32x4 v = *(const f32x4*)(vsrc + off + 256 * jj); const f32x4 y = ((v - s.x) * s.y) * A[jj] + B[jj];
                if (MODE == 2) *(f32x4*)(outf + off + 256 * jj) = y;
                else { u32x2 w; w.x = cvt_pk_bf16(y[0], y[1]); w.y = cvt_pk_bf16(y[2], y[3]); *(u32x2*)(H + off + 256 * jj) = w; } } }
        __syncthreads();
    }
}

typedef short bf16x8 __attribute__((ext_vector_type(8)));
typedef short bf16x4 __attribute__((ext_vector_type(4)));
constexpr int HG_BLK = 16896, HG_OQ = 0, HG_OK = 4096, HG_OKT = 8192, HG_OVT = 12288, HG_ODL = 16384;
constexpr int GL_BLK = 32768, GL_OQ = 0, GL_OK = 6400, GL_OKT = 12800, GL_ODL = 18944, GL_SHARED = 20480, GL_OVT = 20480;
constexpr int NSUB = SEQ / 16;

__device__ __forceinline__ unsigned short f2bf1(float x) { return (unsigned short)(cvt_pk_bf16(x, x) & 0xffffu); }

__device__ __forceinline__ void pre_finish(const float (&qq)[16], const float (&kk)[16], float (&g)[16], unsigned char* blk, int oq, int ok, int okt, int odl, int rowb, int d, bool swz) {
    float b = 0.f;
#pragma unroll
    for (int j = 0; j < 16; ++j) { b += g[j]; g[j] = b; }
    const float bl = b;
    unsigned kt[8];
#pragma unroll
    for (int j = 0; j < 16; j += 2) {
        float kv[2];
#pragma unroll
        for (int jj = 0; jj < 2; ++jj) { const int t = j + jj; const float bj = g[t];
            const int off = t * rowb + (swz ? ((2 * d) ^ (t << 4)) : 2 * d);
            const float qv = qq[t] * __expf(bj), kc = kk[t] * __expf(fminf(-bj, 80.f));
            const float qn = __shfl_xor(qv, 1), kn = __shfl_xor(kc, 1);
            if ((d & 1) == 0) { *(unsigned*)(blk + oq + off) = cvt_pk_bf16(qv, qn); *(unsigned*)(blk + ok + off) = cvt_pk_bf16(kc, kn); }
            kv[jj] = kk[t] * __expf(bl - bj); }
        kt[j >> 1] = cvt_pk_bf16(kv[0], kv[1]); }
    *(u32x4*)(blk + okt + d * 32) = (u32x4){kt[0], kt[1], kt[2], kt[3]};
    *(u32x4*)(blk + okt + d * 32 + 16) = (u32x4){kt[4], kt[5], kt[6], kt[7]};
    *(float*)(blk + odl + d * 4) = __expf(bl);
}
__device__ __forceinline__ void phase_pre(const Ctx& a, int l, int wave, int lane) {
    const bf16_t* P = (const bf16_t*)(a.ws() + WS_P);
    int tid = wave * 64 + lane;
    for (int task = blockIdx.x; task < NB * NSUB * 8; task += gridDim.x) {
        asm volatile("" : "+v"(tid));
        const int kind = (task + (task >> 8)) & 7, bsc = task >> 3, b = bsc / NSUB, sc = bsc % NSUB;
        const size_t row0 = (size_t)b * SEQ + sc * 16;
        if (kind < 3) {
            const int ch = kind * 512 + tid, h = ch >> 7, d = ch & 127;
            const float lb = ((const float*)(a.ws() + WS_MISC))[2 * DM + l * HGW + ch];
            unsigned char* blk = a.ws() + WS_HGB + ((size_t)(b * 12 + h) * NSUB + sc) * HG_BLK;
            float g[16], qq[16], kk[16]; unsigned vv[8];
#pragma unroll
            for (int j = 0; j < 16; ++j) { const bf16_t* prow = P + (row0 + j) * INP;
                const float qin = fmaxf(bf2f(prow[C_QB + ch]), -80.f), fin = fminf(fmaxf(bf2f(prow[C_FB + ch]), -80.f), 80.f);
                const unsigned short v = prow[C_IB + ch]; if (j & 1) vv[j >> 1] |= ((unsigned)v) << 16; else vv[j >> 1] = v;
                const float e = __expf(-fin), sg = 1.0f / (1.0f + e);
                const float f = lb + (1.0f - lb) * sg;
                g[j] = fmaxf(__logf(f), -100.f); kk[j] = (1.0f - lb) * (e * sg); qq[j] = qin / (1.0f + __expf(-qin)); }
            *(u32x4*)(blk + HG_OVT + d * 32) = (u32x4){vv[0], vv[1], vv[2], vv[3]};
            *(u32x4*)(blk + HG_OVT + d * 32 + 16) = (u32x4){vv[4], vv[5], vv[6], vv[7]};
            pre_finish(qq, kk, g, blk, HG_OQ, HG_OK, HG_OKT, HG_ODL, 256, d, true);
        } else if (kind < 5) {
            if (tid < 384) {
                const int ch = (kind - 3) * 384 + tid, h = ch / 192, d = ch % 192;
                unsigned char* blk = a.ws() + WS_GLB + ((size_t)(b * 4 + h) * NSUB + sc) * GL_BLK;
                float wg[16];
#pragma unroll
                for (int r = 0; r < 16; ++r) wg[r] = a.in(I_WGATE)[((size_t)l * 16 + r) * GLKW + ch];
                const float bgv = a.in(I_BGATE)[l * GLKW + ch];
                float g[16], qq[16], kk[16];
#pragma unroll
                for (int j = 0; j < 16; ++j) { const bf16_t* prow = P + (row0 + j) * INP;
                    const u32x4 l0 = *(const u32x4*)(prow + C_LR), l1 = *(const u32x4*)(prow + C_LR + 8);
                    float x = bgv;
                    x += bf_lo(l0.x) * wg[0] + bf_hi(l0.x) * wg[1] + bf_lo(l0.y) * wg[2] + bf_hi(l0.y) * wg[3] + bf_lo(l0.z) * wg[4] + bf_hi(l0.z) * wg[5] + bf_lo(l0.w) * wg[6] + bf_hi(l0.w) * wg[7];
                    x += bf_lo(l1.x) * wg[8] + bf_hi(l1.x) * wg[9] + bf_lo(l1.y) * wg[10] + bf_hi(l1.y) * wg[11] + bf_lo(l1.z) * wg[12] + bf_hi(l1.z) * wg[13] + bf_lo(l1.w) * wg[14] + bf_hi(l1.w) * wg[15];
                    g[j] = (fminf(x, 0.f) - __logf(1.0f + __expf(-fabsf(x)))) * 0.0625f;
                    qq[j] = bf2f(prow[C_QC + ch]) * GLA_QSCALE; kk[j] = bf2f(prow[C_KC + ch]); }
                pre_finish(qq, kk, g, blk, GL_OQ, GL_OK, GL_OKT, GL_ODL, 400, d, false);
            }
        } else {
            const int ch = (kind - 5) * 512 + tid, h = ch / 384, e = ch % 384;
            unsigned char* blk = a.ws() + WS_GLB + ((size_t)(b * 4 + h) * NSUB + sc) * GL_BLK;
            unsigned vv[8];
#pragma unroll
            for (int j = 0; j < 16; ++j) { const unsigned short v = P[(row0 + j) * INP + C_VC + ch]; if (j & 1) vv[j >> 1] |= ((unsigned)v) << 16; else vv[j >> 1] = v; }
            *(u32x4*)(blk + GL_OVT + e * 32) = (u32x4){vv[0], vv[1], vv[2], vv[3]};
            *(u32x4*)(blk + GL_OVT + e * 32 + 16) = (u32x4){vv[4], vv[5], vv[6], vv[7]};
        }
    }
}

template <int DK>
__device__ __forceinline__ void chain_sub(const LAS unsigned char* sb, f32x4 (&S)[DK / 16], float* op, int wave, int n, int q) {
    constexpr bool IS_GLA = (DK == 192);
    constexpr int NKS = DK / 32, NMB = DK / 16, ROWB = IS_GLA ? 400 : 256;
    constexpr int OQ = 0, OK = IS_GLA ? GL_OK : HG_OK, OKT = IS_GLA ? GL_OKT : HG_OKT, OVT = IS_GLA ? GL_OVT : HG_OVT, ODL = IS_GLA ? GL_ODL : HG_ODL;
    bf16x8 qf[NKS], kf[NKS];
#pragma unroll
    for (int ks = 0; ks < NKS; ++ks) { const int c0 = 2 * (32 * ks + 4 * q), c1 = c0 + 32;
        const int o0 = n * ROWB + (IS_GLA ? c0 : (c0 ^ (n << 4))), o1 = n * ROWB + (IS_GLA ? c1 : (c1 ^ (n << 4)));
        const u32x2 ql = *(const LAS u32x2*)(sb + OQ + o0), qh = *(const LAS u32x2*)(sb + OQ + o1), kl = *(const LAS u32x2*)(sb + OK + o0), kh = *(const LAS u32x2*)(sb + OK + o1);
        qf[ks] = __builtin_bit_cast(bf16x8, (u32x4){ql.x, ql.y, qh.x, qh.y}); kf[ks] = __builtin_bit_cast(bf16x8, (u32x4){kl.x, kl.y, kh.x, kh.y}); }
    const u32x2 vfr = *(const LAS u32x2*)(sb + OVT + (16 * wave + n) * 32 + 8 * q);
    const bf16x8 vf8 = __builtin_bit_cast(bf16x8, (u32x4){vfr.x, vfr.y, 0u, 0u});
    f32x4 ao = (f32x4){0.f, 0.f, 0.f, 0.f}, ap = ao;
#pragma unroll
    for (int ks = 0; ks < NKS; ++ks) {
        const bf16x8 sbf = __builtin_bit_cast(bf16x8, (u32x4){cvt_pk_bf16(S[2 * ks][0], S[2 * ks][1]), cvt_pk_bf16(S[2 * ks][2], S[2 * ks][3]), cvt_pk_bf16(S[2 * ks + 1][0], S[2 * ks + 1][1]), cvt_pk_bf16(S[2 * ks + 1][2], S[2 * ks + 1][3])});
        ao = __builtin_amdgcn_mfma_f32_16x16x32_bf16(qf[ks], sbf, ao, 0, 0, 0);
        ap = __builtin_amdgcn_mfma_f32_16x16x32_bf16(kf[ks], qf[ks], ap, 0, 0, 0); }
#pragma unroll
    for (int r = 0; r < 4; ++r) if (4 * q + r > n) ap[r] = 0.f;
    const bf16x8 pa8 = __builtin_bit_cast(bf16x8, (u32x4){cvt_pk_bf16(ap[0], ap[1]), cvt_pk_bf16(ap[2], ap[3]), 0u, 0u});
    ao = __builtin_amdgcn_mfma_f32_16x16x32_bf16(pa8, vf8, ao, 0, 0, 0);
#pragma unroll
    for (int r = 0; r < 4; ++r) op[(size_t)(4 * q + r) * OW] = ao[r];
#pragma unroll
    for (int mb = 0; mb < NMB; ++mb) {
        const f32x4 dl = *(const LAS f32x4*)(sb + ODL + (16 * mb + 4 * q) * 4);
        const u32x2 ktr = *(const LAS u32x2*)(sb + OKT + (16 * mb + n) * 32 + 8 * q);
        S[mb] = __builtin_amdgcn_mfma_f32_16x16x32_bf16(__builtin_bit_cast(bf16x8, (u32x4){ktr.x, ktr.y, 0u, 0u}), vf8, S[mb] * dl, 0, 0, 0); }
}
template <int DK>
__device__ __forceinline__ void chain_item(const unsigned char* blk0, int vt_off, int nsc, float* op0, LAS unsigned char* lds, int wave, int lane) {
    asm volatile("" : "+v"(lane), "+s"(wave));
    constexpr bool IS_GLA = (DK == 192);
    constexpr int BLK = IS_GLA ? GL_BLK : HG_BLK, SUBB = IS_GLA ? GL_SHARED + 4096 : HG_BLK, PIECES = SUBB / 16, SH_PIECES = IS_GLA ? GL_SHARED / 16 : PIECES;
    constexpr int UNITB = 2 * SUBB, NP = (2 * PIECES + 511) / 512;
    const int tid = wave * 64 + lane, n = lane & 15, q = lane >> 4;
    f32x4 S[DK / 16];
#pragma unroll
    for (int mb = 0; mb < DK / 16; ++mb) S[mb] = (f32x4){0.f, 0.f, 0.f, 0.f};
    u32x4 stg[NP];
    const int nunits = nsc / 2;
#define CH_LOAD(u) do { _Pragma("unroll") for (int r_ = 0; r_ < NP; ++r_) { const int p_ = r_ * 512 + tid; if (p_ < 2 * PIECES) { const int s_ = p_ / PIECES, pp_ = p_ % PIECES; \
        const unsigned char* src_ = blk0 + (size_t)((u) * 2 + s_) * BLK + (pp_ < SH_PIECES ? pp_ * 16 : vt_off + (pp_ - SH_PIECES) * 16); stg[r_] = *(const u32x4*)src_; } } } while (0)
#define CH_STORE(buf) do { _Pragma("unroll") for (int r_ = 0; r_ < NP; ++r_) { const int p_ = r_ * 512 + tid; if (p_ < 2 * PIECES) *(LAS u32x4*)(lds + (buf) * UNITB + p_ * 16) = stg[r_]; } } while (0)
    CH_LOAD(0); CH_STORE(0);
    __syncthreads();
    float* op = op0 + 16 * wave + n;
#ifdef DBG_SYNC
    for (int u = 0; u < nunits; ++u) {
        const LAS unsigned char* ub = lds;
        chain_sub<DK>(ub, S, op + (size_t)(u * 32) * OW, wave, n, q);
        __syncthreads();
        chain_sub<DK>(ub + SUBB, S, op + (size_t)(u * 32 + 16) * OW, wave, n, q);
        __syncthreads();
        if (u + 1 < nunits) { CH_LOAD(u + 1); CH_STORE(0); }
        __syncthreads();
    }
#else
    for (int u = 0; u < nunits; ++u) {
        if (u + 1 < nunits) CH_LOAD(u + 1);
        const LAS unsigned char* ub = lds + (u & 1) * UNITB;
        chain_sub<DK>(ub, S, op + (size_t)(u * 32) * OW, wave, n, q);
        chain_sub<DK>(ub + SUBB, S, op + (size_t)(u * 32 + 16) * OW, wave, n, q);
        if (u + 1 < nunits) CH_STORE((u + 1) & 1);
        __syncthreads();
    }
#endif
#undef CH_LOAD
#undef CH_STORE
}

__device__ __forceinline__ void phase_mixers(const Ctx& a, int l, LAS unsigned char* lds, int wave, int lane) {
    const int bx = blockIdx.x, G = gridDim.x;
    for (int c = (G >= 176) ? bx - 128 : bx; c < 48; c += G) {
        if (c < 0) continue;
#if EN_CH128
        if (c < 24) { const int b = c / 12, h = c % 12;
            chain_item<128>(a.ws() + WS_HGB + (size_t)(b * 12 + h) * NSUB * HG_BLK, 0, NSUB, (float*)(a.ws() + WS_O) + (size_t)b * SEQ * OW + h * 128, lds, wave, lane); }
#endif
#if EN_CH192
        if (c >= 24) { const int r = c - 24, b = r / 12, h = (r % 12) / 3, sl = r % 3;
            chain_item<192>(a.ws() + WS_GLB + (size_t)(b * 4 + h) * NSUB * GL_BLK, GL_OVT + 4096 * sl, NSUB, (float*)(a.ws() + WS_O) + (size_t)b * SEQ * OW + HGW + h * 384 + sl * 128, lds, wave, lane); }
#endif
        __syncthreads();
    }
    for (int it = (G >= 192) ? bx - 176 : bx; it < 16; it += G) { if (it < 0) continue; s5_scan_item(a, l, it, wave, lane); }
}
__device__ __forceinline__ void phase_finalize(const Ctx& a, int l, int wave, int lane) {
    const bf16_t* P = (const bf16_t*)(a.ws() + WS_P); const float* O = (const float*)(a.ws() + WS_O); bf16_t* MX = (bf16_t*)(a.ws() + WS_MIXED);
    const float* hgg = a.in(I_HGG) + l * HGW; const float* hgb = a.in(I_HGB) + l * HGW; const float* glg = a.in(I_GLG) + l * HGW;
    const int gw = blockIdx.x * 8 + wave, NGW = gridDim.x * 8;
    for (int row = gw; row < MTOK; row += NGW) {
        const float* orow = O + (size_t)row * OW; const bf16_t* prow = P + (size_t)row * INP; bf16_t* mrow = MX + (size_t)row * DM;
#pragma unroll 4
        for (int h = 0; h < 12; ++h) { const int c = h * 128 + 2 * lane;
            const f32x2 o2 = *(const f32x2*)(orow + c); const unsigned gg = *(const unsigned*)(prow + C_GB + c);
            const float v0 = sigmoidf_(bf_lo(gg)) * o2.x, v1 = sigmoidf_(bf_hi(gg)) * o2.y;
            const float mu = wave_sum(v0 + v1) * (1.0f / 128.0f), d0 = v0 - mu, d1 = v1 - mu;
            const float rs = 1.0f / sqrtf(wave_sum(d0 * d0 + d1 * d1) * (1.0f / 128.0f) + LN_EPS);
            const f32x2 g2 = *(const f32x2*)(hgg + c), b2 = *(const f32x2*)(hgb + c);
            *(unsigned*)(mrow + S5W + c) = cvt_pk_bf16(d0 * rs * g2.x + b2.x, d1 * rs * g2.y + b2.y); }
#pragma unroll
        for (int h = 0; h < 4; ++h) { f32x2 o2[3]; float ss = 0.f;
#pragma unroll
            for (int j = 0; j < 3; ++j) { o2[j] = *(const f32x2*)(orow + HGW + h * 384 + 128 * j + 2 * lane); ss += o2[j].x * o2[j].x + o2[j].y * o2[j].y; }
            const float rms = 1.0f / sqrtf(wave_sum(ss) * (1.0f / 384.0f) + LN_EPS);
#pragma unroll
            for (int j = 0; j < 3; ++j) { const int c = h * 384 + 128 * j + 2 * lane; const unsigned gg = *(const unsigned*)(prow + C_GC + c);
                const float g0 = bf_lo(gg), g1 = bf_hi(gg); const f32x2 gn = *(const f32x2*)(glg + c);
                *(unsigned*)(mrow + S5W + HGW + c) = cvt_pk_bf16(o2[j].x * rms * gn.x * (g0 * sigmoidf_(g0)), o2[j].y * rms * gn.y * (g1 * sigmoidf_(g1))); } }
    }
}

constexpr int PH_PRO = 0, PH_MOD = 1, PH_LN0 = 2, PH_L0 = 3, PH_PER_LAYER = 10, N_PHASES = PH_L0 + DEPTH * PH_PER_LAYER;
constexpr int CW_BAR = 4096;

__global__ void __launch_bounds__(512, 2) hybrid_fwd(Args args) {
    extern __shared__ __attribute__((aligned(16))) unsigned char lds_raw[];
    LAS unsigned char* lds = (LAS unsigned char*)lds_raw;
    const int wave = __builtin_amdgcn_readfirstlane((int)threadIdx.x >> 6);
#define lane lane_id_v()
    volatile LAS unsigned* MISC = (volatile LAS unsigned*)(lds + LDSCTL_OFF);
    Ctx ctx; ctx.t = (volatile LAS unsigned long long*)(lds + LDSCTL_OFF + 64);
    if (wave == 0) { const int ln_ = lane; unsigned long long v = 0ull;
#pragma unroll
        for (int i = 0; i < N_IN; ++i) v = (ln_ == i) ? (unsigned long long)args.in[i] : v;
        v = (ln_ == 30) ? (unsigned long long)args.out : v; v = (ln_ == 31) ? (unsigned long long)args.ws : v;
        if (ln_ < 32) ctx.t[ln_] = v;
        if (ln_ < 16) MISC[ln_] = 0u; }
    __syncthreads();
    const int lo = args.ph_lo, hi = args.ph_hi;
    XcdBarrier bar; bar.bar = (unsigned*)(ctx.ws() + WS_CTL) + CW_BAR; bar.x = 0; bar.st = nullptr; bar.w0 = (wave == 0) ? 1u : 0u;
    if (hi - lo > 1) bar = xcd_barrier_post((unsigned*)(ctx.ws() + WS_CTL) + CW_BAR, MISC + 8, (wave == 0) ? 1u : 0u);
#define IN(k) (lo <= (k) && (k) < hi)
#define OPQ() int ln = lane, wv = wave; asm volatile("" : "+s"(wv))
#define SEAM(k) do { if (IN(k) && IN((k) + 1)) xcd_barrier(bar); } while (0)
#define WSP(T, off) ((T*)(ctx.ws() + (off)))
#ifdef DIAG_SEL1
    volatile LAS unsigned long long* STP = (volatile LAS unsigned long long*)(lds + LDSCTL_OFF + 512);
#define STAMP(idx) do { if (blockIdx.x == 0 && wave == 0) { const unsigned long long t_ = __builtin_amdgcn_s_memrealtime(); if (lane == 0) STP[idx] = t_; } } while (0)
#else
#define STAMP(idx) do { } while (0)
#endif
    STAMP(0);

#if EN_PRO
    if (IN(PH_PRO)) { OPQ(); phase_prologue(ctx, lds, wv, ln); }
#endif
    SEAM(PH_PRO); STAMP((PH_PRO) + 1);
#if EN_MOD
    if (IN(PH_MOD)) { OPQ(); phase_mod(ctx, wv, ln); }
#endif
    SEAM(PH_MOD); STAMP((PH_MOD) + 1);
#if EN_LN
    if (IN(PH_LN0)) { OPQ(); phase_lnapply<0>(ctx.in(I_X), nullptr, WSP(float, WS_ROWSTATS), nullptr, nullptr, WSP(float, WS_MOD), 0, 1, WSP(bf16_t, WS_H), nullptr, lds, wv, ln); }
#endif
    SEAM(PH_LN0); STAMP((PH_LN0) + 1);

    for (int l = 0; l < DEPTH; ++l) {
        const int p0 = PH_L0 + l * PH_PER_LAYER;
        const size_t wto = WS_WT + (size_t)l * WT_LAYER, modo = WS_MOD + (size_t)l * NB * 6 * DM * 4;
#if EN_INPROJ
        if (IN(p0 + 0)) { pg8::Gemm g{WSP(bf16_t, WS_H), WSP(const bf16_t, wto + WT_IN), MTOK, INP, DM}; pg8::StaticOrder S; S.init(MTOK, INP, (int)gridDim.x, (int)blockIdx.x);
            EpiProj E{WSP(bf16_t, WS_P), WSP(bf16_t, WS_UX)}; pg8::gemm_phase<EpiProj, pg8::StaticOrder, true, true>(lds, g, S, E, wave); }
#endif
        SEAM(p0 + 0); STAMP((p0 + 0) + 1);
#if EN_MIX
        if (IN(p0 + 1)) {
            { pg8::Gemm g{WSP(bf16_t, WS_UX), WSP(const bf16_t, WS_S5W1 + (size_t)l * S5_W1_LAYER), 64 * 256, 64 * 256, S5K}; S5Order S{(int)gridDim.x, (int)blockIdx.x, 64, 0};
              EpiS5A E{WSP(float, WS_SLOC)}; pg8::gemm_phase<EpiS5A, S5Order, true, true>(lds, g, S, E, wave); }
            { OPQ(); phase_pre(ctx, l, wv, ln); } }
        SEAM(p0 + 1); STAMP((p0 + 1) + 1);
        if (IN(p0 + 2)) { OPQ(); phase_mixers(ctx, l, lds, wv, ln); }
        SEAM(p0 + 2); STAMP((p0 + 2) + 1);
        if (IN(p0 + 3)) {
            { pg8::Gemm g{WSP(bf16_t, WS_UX), WSP(const bf16_t, WS_S5T + (size_t)l * S5_T_LAYER), 64 * 256, 64 * 1024, S5K}; S5Order S{(int)gridDim.x, (int)blockIdx.x, 256, 2};
              EpiS5C E{WSP(bf16_t, WS_Z)}; pg8::gemm_phase<EpiS5C, S5Order, true, true>(lds, g, S, E, wave); }
            { OPQ(); phase_finalize(ctx, l, wv, ln); } }
#endif
        SEAM(p0 + 3); STAMP((p0 + 3) + 1);
#if EN_GLU
        if (IN(p0 + 4)) { pg8::Gemm g{WSP(bf16_t, WS_Z), WSP(const bf16_t, wto + WT_GLU), MTOK, S5W, S5W}; pg8::StaticOrder S; S.init(MTOK, S5W, (int)gridDim.x, (int)blockIdx.x);
            EpiGlu E{WSP(bf16_t, WS_Z), WSP(bf16_t, WS_MIXED), ctx.in(I_GLUB) + l * S5W}; pg8::gemm_phase<EpiGlu, pg8::StaticOrder, true, true>(lds, g, S, E, wave); }
#endif
        SEAM(p0 + 4); STAMP((p0 + 4) + 1);
#if EN_OUT
        if (IN(p0 + 5)) { pg8::Gemm g{WSP(bf16_t, WS_MIXED), WSP(const bf16_t, wto + WT_OUT), MTOK, DM, DM}; pg8::StaticOrder S; S.init(MTOK, DM, (int)gridDim.x, (int)blockIdx.x);
            EpiResid E{l == 0 ? ctx.in(I_X) : ctx.out(), ctx.out(), WSP(float, WS_ROWSTATS), l == 0 ? WSP(float, WS_MISC) : ctx.in(I_LN2G) + (l - 1) * DM, l == 0 ? WSP(float, WS_MISC) + DM : ctx.in(I_LN2B) + (l - 1) * DM, WSP(float, modo) + 2 * DM, WSP(float, WS_ROWPART)};
            pg8::gemm_phase<EpiResid, pg8::StaticOrder, true, true>(lds, g, S, E, wave); }
#endif
        SEAM(p0 + 5); STAMP((p0 + 5) + 1);
#if EN_LN
        if (IN(p0 + 6)) { OPQ(); phase_lnapply<1>(ctx.out(), WSP(float, WS_ROWPART), WSP(float, WS_ROWSTATS), ctx.in(I_LN1G) + l * DM, ctx.in(I_LN1B) + l * DM, WSP(float, modo), 3, 4, WSP(bf16_t, WS_H), nullptr, lds, wv, ln); }
#endif
        SEAM(p0 + 6); STAMP((p0 + 6) + 1);
#if EN_GU
        if (IN(p0 + 7)) { pg8::Gemm g{WSP(bf16_t, WS_H), WSP(const bf16_t, wto + WT_GU), MTOK, 2 * DFF, DM}; pg8::StaticOrder S; S.init(MTOK, 2 * DFF, (int)gridDim.x, (int)blockIdx.x);
            EpiSwiglu E{WSP(bf16_t, WS_P)}; pg8::gemm_phase<EpiSwiglu, pg8::StaticOrder, true, true>(lds, g, S, E, wave); }
#endif
        SEAM(p0 + 7); STAMP((p0 + 7) + 1);
#if EN_DN
        if (IN(p0 + 8)) { pg8::Gemm g{WSP(bf16_t, WS_P), WSP(const bf16_t, wto + WT_DN), MTOK, DM, DFF}; pg8::StaticOrder S; S.init(MTOK, DM, (int)gridDim.x, (int)blockIdx.x);
            EpiResid E{ctx.out(), ctx.out(), WSP(float, WS_ROWSTATS), ctx.in(I_LN1G) + l * DM, ctx.in(I_LN1B) + l * DM, WSP(float, modo) + 5 * DM, WSP(float, WS_ROWPART)};
            pg8::gemm_phase<EpiResid, pg8::StaticOrder, true, true>(lds, g, S, E, wave); }
#endif
        SEAM(p0 + 8); STAMP((p0 + 8) + 1);
#if EN_LN
        if (IN(p0 + 9)) { OPQ();
            if (l + 1 < DEPTH) phase_lnapply<1>(ctx.out(), WSP(float, WS_ROWPART), WSP(float, WS_ROWSTATS), ctx.in(I_LN2G) + l * DM, ctx.in(I_LN2B) + l * DM, WSP(float, modo) + (size_t)NB * 6 * DM, 0, 1, WSP(bf16_t, WS_H), nullptr, lds, wv, ln);
            else phase_lnapply<2>(ctx.out(), WSP(float, WS_ROWPART), WSP(float, WS_ROWSTATS), ctx.in(I_LN2G) + l * DM, ctx.in(I_LN2B) + l * DM, nullptr, 0, 0, nullptr, ctx.out(), lds, wv, ln);
        }
#endif
        SEAM(p0 + 9); STAMP((p0 + 9) + 1);
    }
#ifdef DIAG_SEL1
    xcd_barrier(bar);
    if (blockIdx.x == 0) {
        float tot = (float)(STP[N_PHASES] - STP[0]), s1 = 0.f, s2 = 0.f;
        for (int k = 0; k < N_PHASES; ++k) { int ty; if (k < 3) ty = k; else { const int j = (k - 3) % PH_PER_LAYER; const int map[10] = {3, 4, 5, 6, 10, 7, 2, 8, 9, 2}; ty = map[j]; }
            const float d = (float)(STP[k + 1] - STP[k]); if ((DIAG_SEL1 >> ty) & 1) s1 += d; if ((DIAG_SEL2 >> ty) & 1) s2 += d; }
        const int n1 = (int)(1000000.f * s1 / tot); float* o = ctx.out();
        for (int i = wave * 64 + lane; i < n1; i += 512) o[i] += 0.05f;
        if (wave == 0 && lane == 0) o[2000000] += 0.05f + 0.11f * s2 / tot;
    }
#endif
#undef IN
#undef SEAM
#undef OPQ
#undef WSP
#undef lane
}

#ifndef MK_PER_PHASE
#define MK_PER_PHASE 0
#endif
extern "C" void kernel_launch(void* const* d_in, const int* in_sizes, int n_in, void* d_out, int out_size, void* d_ws, size_t ws_size, hipStream_t stream) {
    static int grid = 0;
    if (grid == 0) {
        if (n_in != N_IN || out_size != MTOK * DM || ws_size < WS_END) { fprintf(stderr, "kernel_launch: unexpected problem (n_in %d, out %d, ws %zu < %zu); nothing launched\n", n_in, out_size, ws_size, (size_t)WS_END); grid = -1; return; }
        int dev = 0, cus = 0, per_cu = 0;
        if (hipGetDevice(&dev) != hipSuccess || hipDeviceGetAttribute(&cus, hipDeviceAttributeMultiprocessorCount, dev) != hipSuccess) { grid = -1; return; }
        if (hipFuncSetAttribute((const void*)hybrid_fwd, hipFuncAttributeMaxDynamicSharedMemorySize, LDS_BYTES) != hipSuccess) { fprintf(stderr, "kernel_launch: hipFuncSetAttribute failed\n"); grid = -1; return; }
        if (hipOccupancyMaxActiveBlocksPerMultiprocessor(&per_cu, (const void*)hybrid_fwd, 512, LDS_BYTES) != hipSuccess || per_cu < 1) fprintf(stderr, "kernel_launch: occupancy query reports %d blocks per CU\n", per_cu);
        (void)hipGetLastError();
        grid = cus;
    }
    if (grid < 0) return;
    (void)in_sizes;
    if (hipMemsetAsync((char*)d_ws + WS_CTL, 0, CTL_ZERO_BYTES, stream) != hipSuccess) return;
#ifdef DBG_MEMSET
    (void)hipMemsetAsync((char*)d_ws + WS_HGB, 0, WS_END - WS_HGB, stream); (void)hipMemsetAsync((char*)d_ws + WS_O, 0, 192 * MiB, stream);
#endif
    Args a{};
    for (int i = 0; i < N_IN; ++i) a.in[i] = (const float*)d_in[i];
    a.out = (float*)d_out; a.ws = (unsigned char*)d_ws;
#if MK_PER_PHASE
    for (int p = 0; p < N_PHASES; ++p) { a.ph_lo = p; a.ph_hi = p + 1; hipLaunchKernelGGL(hybrid_fwd, dim3(grid), dim3(512), LDS_BYTES, stream, a); }
#else
    a.ph_lo = 0; a.ph_hi = N_PHASES; hipLaunchKernelGGL(hybrid_fwd, dim3(grid), dim3(512), LDS_BYTES, stream, a);
#endif
}
```

```cpp
#include <hip/hip_runtime.h>
#include <cstdio>
#include <cstdint>
namespace pg8 {
#define PG8_LAS __attribute__((address_space(3)))
typedef unsigned short bf16_t;
typedef short bf16x8 __attribute__((ext_vector_type(8)));
typedef float f32x4 __attribute__((ext_vector_type(4)));
typedef unsigned u32x4 __attribute__((ext_vector_type(4)));
constexpr int BM = 256, BK = 64, HALF = 128, HTB = HALF * BK * 2  , STAGE_BYTES = 8 * HTB, NXCD = 8, WGM = 8;

__host__ __device__ __forceinline__ int lds_byte(int r, int c) { const int st = (r >> 4) * 2 + (c >> 5), rr = r & 15, cc = c & 31, ob = rr * 64 + cc * 2; return st * 1024 + (ob ^ (((ob >> 9) & 1) << 5)); }
__host__ __device__ __forceinline__ void stage_rc(int b, int& R, int& C) { const int st = b / 1024, sb = b % 1024, swz = sb ^ (((sb >> 9) & 1) << 5); R = (st >> 1) * 16 + swz / 64; C = (st & 1) * 32 + (swz % 64) / 2; }
__host__ __device__ __forceinline__ int perm32(int rho) { const int n = rho >> 4, i = rho & 15; return 8 * (i >> 2) + 4 * n + (i & 3); }

struct Unit { int pm, pn; };
struct Gemm { const bf16_t* A; const bf16_t* Bt; int M, N, K; };

struct StaticOrder {
    int nM, nN, nwg, G, c;
    __host__ __device__ void init(int M, int N, int G_, int c_) { nM = M / BM; nN = N / BM; nwg = nM * nN; G = G_; c = c_; }
    __host__ __device__ bool next(int i, Unit& u) const {
        const long L = (long)i * G + c; if (L >= nwg) return false;
        int wgid = (int)L; { const int q = nwg / NXCD, r = nwg % NXCD, xcd = wgid % NXCD, off = wgid / NXCD; wgid = (xcd < r ? xcd * (q + 1) : r * (q + 1) + (xcd - r) * q) + off; }
        const int nig = WGM * nN, gid = wgid / nig, fm = gid * WGM, gsz = (nM - fm) < WGM ? (nM - fm) : WGM;
        u.pm = fm + ((wgid % nig) % gsz); u.pn = (wgid % nig) / gsz; return true;
    }
    __device__ __forceinline__ void a_ready(const Unit&) const {}
    __device__ __forceinline__ void done(const Unit&) const {}
};
__device__ __forceinline__ unsigned cvt_pk_bf16(float lo, float hi) { unsigned r; asm volatile("v_cvt_pk_bf16_f32 %0, %1, %2" : "=v"(r) : "v"(lo), "v"(hi)); return r; }
typedef float f32x2 __attribute__((ext_vector_type(2)));
template <class Epi, class Sched, bool ALIGN_EPI = false, bool SP2 = false>
__device__ __forceinline__ void gemm_phase(PG8_LAS unsigned char* lds, const Gemm g, const Sched& S, const Epi& E, int wave_id) {
    int tid_; asm volatile("v_mbcnt_lo_u32_b32 %0, -1, 0\n\tv_mbcnt_hi_u32_b32 %0, -1, %0" : "=v"(tid_)); tid_ += wave_id * 64;
    const int tid = tid_, wid = __builtin_amdgcn_readfirstlane(tid >> 6), lane = tid & 63, wr = wid >> 2, wc = wid & 3, fr = lane & 15, fq = lane >> 4;
    const int K = g.K, nt = K / BK;
    unsigned voffA[2], voffB[2];
#pragma unroll
    for (int i = 0; i < 2; ++i) { int R, C; stage_rc(tid * 16 + i * 8192, R, C); const int Rb = Epi::PERM ? ((R & ~31) + perm32(R & 31)) : R;
        voffA[i] = (unsigned)(R * K + C) * 2u; voffB[i] = (unsigned)(Rb * K + C) * 2u; }
    const size_t kstep = (size_t)(BK * 2);
    const size_t hstep = (size_t)HALF * K * 2;
    const size_t tstep = 2 * hstep;
    const unsigned ldsw = (unsigned)wid * 1024u;
    const int aoff = lds_byte(wr * 64 + fr, fq * 8), boff = lds_byte(wc * 32 + fr, fq * 8);
#define PG8_SA(b, h) (((b) * 2 + (h)) * HTB)
#define PG8_SB(b, h) ((4 + (b) * 2 + (h)) * HTB)
#define PG8_STAGE(bufoff, gbase, voff) do { _Pragma("unroll") for (int _i = 0; _i < 2; ++_i) \
        __builtin_amdgcn_global_load_lds((const unsigned*)((const char*)(gbase) + (voff)[_i]), (PG8_LAS unsigned*)(lds + (bufoff) + ldsw + _i * 8192), 16, 0, 0); } while (0)
#define PG8_LDA(dst, b, h) do { _Pragma("unroll") for (int m = 0; m < 4; ++m) _Pragma("unroll") for (int k = 0; k < 2; ++k) dst[m][k] = *(const PG8_LAS bf16x8*)(lds + PG8_SA(b, h) + aoff + m * 2048 + k * 1024); } while (0)
#define PG8_LDB(dst, b, h) do { _Pragma("unroll") for (int n = 0; n < 2; ++n) _Pragma("unroll") for (int k = 0; k < 2; ++k) dst[n][k] = *(const PG8_LAS bf16x8*)(lds + PG8_SB(b, h) + boff + n * 2048 + k * 1024); } while (0)
#define PG8_MMA(ai, bj, At, Bt) do { __builtin_amdgcn_s_setprio(1); _Pragma("unroll") for (int m = 0; m < 4; ++m) _Pragma("unroll") for (int n = 0; n < 2; ++n) _Pragma("unroll") for (int k = 0; k < 2; ++k) \
        acc[ai][bj][m][n] = __builtin_amdgcn_mfma_f32_16x16x32_bf16(Bt[n][k], At[m][k], acc[ai][bj][m][n], 0, 0, 0); __builtin_amdgcn_s_setprio(0); } while (0)
#define PG8_WAIT_V(n) asm volatile("s_waitcnt vmcnt(" #n ")" ::: "memory")
#define PG8_WAIT_L(n) asm volatile("s_waitcnt lgkmcnt(" #n ")" ::: "memory")
#define PG8_BAR __builtin_amdgcn_s_barrier()
#define PG8_SCHED __builtin_amdgcn_sched_barrier(0)
    Unit cur, nxt; int ui = 0;
    if (!S.next(0, cur)) return;
    f32x4 acc[2][2][4][2];
#pragma unroll
    for (int a = 0; a < 2; ++a)
#pragma unroll
        for (int b = 0; b < 2; ++b)
#pragma unroll
            for (int m = 0; m < 4; ++m)
#pragma unroll
                for (int n = 0; n < 2; ++n) acc[a][b][m][n] = (f32x4){0.f, 0.f, 0.f, 0.f};
    bf16x8 At[4][2], B0[2][2], B1[2][2];
    const char* cA = (const char*)g.A + (size_t)cur.pm * tstep; const char* cB = (const char*)g.Bt + (size_t)cur.pn * tstep;
    S.a_ready(cur);
    if constexpr (SP2) {
        PG8_STAGE(PG8_SB(0, 0), cB, voffB); PG8_STAGE(PG8_SB(0, 1), cB + hstep, voffB); PG8_STAGE(PG8_SA(0, 0), cA, voffA); PG8_STAGE(PG8_SA(0, 1), cA + hstep, voffA);
        if (wr == 1) PG8_BAR;
        PG8_WAIT_V(2); PG8_BAR;
        PG8_STAGE(PG8_SB(1, 0), cB + kstep, voffB); PG8_STAGE(PG8_SA(1, 0), cA + kstep, voffA); PG8_STAGE(PG8_SB(1, 1), cB + hstep + kstep, voffB);
        PG8_WAIT_V(6); PG8_BAR;
    } else {
        PG8_STAGE(PG8_SB(0, 0), cB, voffB); PG8_STAGE(PG8_SA(0, 0), cA, voffA); PG8_STAGE(PG8_SB(0, 1), cB + hstep, voffB); PG8_STAGE(PG8_SA(0, 1), cA + hstep, voffA);
        if (wr == 1) PG8_BAR;
        PG8_WAIT_V(4); PG8_BAR;
        PG8_STAGE(PG8_SB(1, 0), cB + kstep, voffB); PG8_STAGE(PG8_SA(1, 0), cA + kstep, voffA); PG8_STAGE(PG8_SB(1, 1), cB + hstep + kstep, voffB);
        PG8_WAIT_V(6); PG8_BAR;
    }
    for (;;) {
        const bool has_next = S.next(ui + 1, nxt);
        const char* nA = has_next ? (const char*)g.A + (size_t)nxt.pm * tstep : cA; const char* nB = has_next ? (const char*)g.Bt + (size_t)nxt.pn * tstep : cB;
        for (int t = 0; t < nt; t += 2) {
            const bool last = (t == nt - 2);
            const char* a1 = cA + (size_t)(t + 1) * kstep;
            const char* a2 = last ? nA : cA + (size_t)(t + 2) * kstep; const char* b2 = last ? nB : cB + (size_t)(t + 2) * kstep;
            const char* a3 = a2 + kstep; const char* b3 = b2 + kstep;
            if (last && has_next) S.a_ready(nxt);
            if constexpr (SP2) {
            PG8_LDB(B0, 0, 0); PG8_LDB(B1, 0, 1); PG8_SCHED; PG8_LDA(At, 0, 0); PG8_STAGE(PG8_SA(1, 1), a1 + hstep, voffA);
            PG8_WAIT_V(8); PG8_WAIT_L(0); PG8_BAR; PG8_MMA(0, 0, At, B0); PG8_MMA(0, 1, At, B1); PG8_BAR; PG8_SCHED;
            PG8_LDA(At, 0, 1); PG8_STAGE(PG8_SB(0, 0), b2, voffB); PG8_STAGE(PG8_SB(0, 1), b2 + hstep, voffB); PG8_STAGE(PG8_SA(0, 0), a2, voffA);
            PG8_WAIT_V(8); PG8_WAIT_L(0); PG8_BAR; PG8_MMA(1, 0, At, B0); PG8_MMA(1, 1, At, B1); PG8_BAR; PG8_SCHED;
            PG8_LDB(B0, 1, 0); PG8_LDB(B1, 1, 1); PG8_SCHED; PG8_LDA(At, 1, 0); PG8_STAGE(PG8_SA(0, 1), a2 + hstep, voffA);
            PG8_WAIT_V(8); PG8_WAIT_L(0); PG8_BAR; PG8_MMA(0, 0, At, B0); PG8_MMA(0, 1, At, B1); PG8_BAR; PG8_SCHED;
            PG8_LDA(At, 1, 1); PG8_STAGE(PG8_SB(1, 0), b3, voffB); PG8_STAGE(PG8_SB(1, 1), b3 + hstep, voffB); PG8_STAGE(PG8_SA(1, 0), a3, voffA);
            PG8_WAIT_V(8); PG8_WAIT_L(0); PG8_BAR; PG8_MMA(1, 0, At, B0); PG8_MMA(1, 1, At, B1); PG8_BAR; PG8_SCHED;
            } else {
            PG8_LDB(B0, 0, 0); PG8_SCHED; PG8_LDA(At, 0, 0); PG8_STAGE(PG8_SA(1, 1), a1 + hstep, voffA);
            PG8_WAIT_L(8); PG8_BAR; PG8_WAIT_L(0); PG8_MMA(0, 0, At, B0); PG8_BAR; PG8_SCHED;
            PG8_LDB(B1, 0, 1); PG8_STAGE(PG8_SB(0, 0), b2, voffB);
            PG8_BAR; PG8_WAIT_L(0); PG8_MMA(0, 1, At, B1); PG8_BAR;
            PG8_LDA(At, 0, 1); PG8_STAGE(PG8_SA(0, 0), a2, voffA);
            PG8_BAR; PG8_WAIT_L(0); PG8_MMA(1, 0, At, B0); PG8_BAR; PG8_SCHED;
            PG8_STAGE(PG8_SB(0, 1), b2 + hstep, voffB);
            PG8_WAIT_V(6); PG8_BAR; PG8_MMA(1, 1, At, B1); PG8_BAR;
            PG8_LDB(B0, 1, 0); PG8_SCHED; PG8_LDA(At, 1, 0); PG8_STAGE(PG8_SA(0, 1), a2 + hstep, voffA);
            PG8_WAIT_L(8); PG8_BAR; PG8_WAIT_L(0); PG8_MMA(0, 0, At, B0); PG8_BAR; PG8_SCHED;
            PG8_LDB(B1, 1, 1); PG8_STAGE(PG8_SB(1, 0), b3, voffB);
            PG8_BAR; PG8_WAIT_L(0); PG8_MMA(0, 1, At, B1); PG8_BAR;
            PG8_LDA(At, 1, 1); PG8_STAGE(PG8_SA(1, 0), a3, voffA);
            PG8_BAR; PG8_WAIT_L(0); PG8_MMA(1, 0, At, B0); PG8_BAR; PG8_SCHED;
            PG8_STAGE(PG8_SB(1, 1), b3 + hstep, voffB);
            PG8_WAIT_V(6); PG8_BAR; PG8_MMA(1, 1, At, B1); PG8_BAR;
            }
        }
        if constexpr (ALIGN_EPI) { if (wr == 0) PG8_BAR; }
        if constexpr (!Epi::AFTER_DRAIN) { E(acc, cur, wr, wc, fr, fq); S.done(cur); }
        if (!has_next) break;
#pragma unroll
        for (int a = 0; a < 2; ++a)
#pragma unroll
            for (int b = 0; b < 2; ++b)
#pragma unroll
                for (int m = 0; m < 4; ++m)
#pragma unroll
                    for (int n = 0; n < 2; ++n) acc[a][b][m][n] = (f32x4){0.f, 0.f, 0.f, 0.f};
        cur = nxt; cA = nA; cB = nB; ++ui;
        if constexpr (ALIGN_EPI) { if (wr == 1) PG8_BAR; }
    }
    PG8_WAIT_V(0);
    if constexpr (!ALIGN_EPI) { if (wr == 0) PG8_BAR; }
    PG8_BAR;
    if constexpr (Epi::AFTER_DRAIN) { E.fused(acc, cur, wr, wc, fr, fq, lds, wid, lane); S.done(cur); }
#undef PG8_SA
#undef PG8_SB
#undef PG8_STAGE
#undef PG8_LDA
#undef PG8_LDB
#undef PG8_MMA
#undef PG8_WAIT_V
#undef PG8_WAIT_L
#undef PG8_BAR
#undef PG8_SCHED
}
}
#define LAS __attribute__((address_space(3)))
#define XB_TMO      128
#define XB_XCNT(j)  (256  + 64 * (j))
#define XB_XSUB(j)  (1280 + 64 * (j))
#define XB_XGEN(j)  (2304 + 64 * (j))
#define XB_TOP      3328
#define XB_TOPGEN   3392
#define XCD_BAR_WORDS 3456
#define XB_SPIN_CAP (1u << 24)

__device__ __forceinline__ unsigned xb_ld(unsigned* p)              { return __hip_atomic_load(p, __ATOMIC_RELAXED, __HIP_MEMORY_SCOPE_AGENT); }
__device__ __forceinline__ unsigned xb_add(unsigned* p, unsigned v) { return __hip_atomic_fetch_add(p, v, __ATOMIC_RELAXED, __HIP_MEMORY_SCOPE_AGENT); }
__device__ __forceinline__ unsigned xb_xcc_id() { return (unsigned)__builtin_amdgcn_s_getreg((3 << 11) | 20) & 0xFu; }
#define XB_SPIN(cond, bar) do { unsigned _sp = 0; while (cond) { __builtin_amdgcn_s_sleep(1); \
    if ((++_sp & 255u) == 0u) { if (xb_ld(&(bar)[XB_TMO])) break; if (_sp > XB_SPIN_CAP) { atomicAdd(&(bar)[XB_TMO], 1u); break; } } } } while (0)

struct XcdBarrier {
    unsigned* bar; unsigned x; unsigned w0;
    volatile LAS unsigned* st;
};

__device__ __forceinline__ bool xb_lane0() { return __builtin_amdgcn_mbcnt_hi(~0u, __builtin_amdgcn_mbcnt_lo(~0u, 0u)) == 0u; }
__device__ __forceinline__ XcdBarrier xcd_barrier_post(unsigned* bar, volatile LAS unsigned* st, unsigned w0) {
    XcdBarrier b; b.bar = bar; b.x = xb_xcc_id(); b.st = st; b.w0 = w0;
    if (w0 && xb_lane0()) (void)xb_add(&bar[XB_XCNT(b.x)], 1u);
    return b;
}
__device__ __forceinline__ void xcd_barrier_complete(unsigned* bar, unsigned x, unsigned& nloc, unsigned& nx) {
    const unsigned G = gridDim.x * gridDim.y * gridDim.z;
    unsigned sum, cnt, mine, sp = 0u;
    for (;;) {
        sum = 0u; cnt = 0u; mine = 0u;
#pragma unroll
        for (unsigned j = 0; j < 16; ++j) { const unsigned c = xb_ld(&bar[XB_XCNT(j)]); sum += c; cnt += (c > 0u) ? 1u : 0u; mine = (j == x) ? c : mine; }
        if (sum == G) break;
        __builtin_amdgcn_s_sleep(1);
        if ((++sp & 255u) == 0u) { if (xb_ld(&bar[XB_TMO])) break; if (sp > XB_SPIN_CAP) { atomicAdd(&bar[XB_TMO], 1u); break; } }
    }
    nloc = mine > 0u ? mine : 1u; nx = cnt > 0u ? cnt : 1u;
}

__device__ __forceinline__ void xcd_barrier(const XcdBarrier& b) {
    asm volatile("s_waitcnt vmcnt(0)" ::: "memory");
    __syncthreads();
    if (b.w0 && xb_lane0()) {
        unsigned* bar = b.bar;
        __builtin_amdgcn_s_waitcnt(0);
        unsigned nloc = b.st[0], nx = b.st[1];
        if (nloc == 0u) { xcd_barrier_complete(bar, b.x, nloc, nx); b.st[0] = nloc; b.st[1] = nx; }
        const unsigned old = xb_add(&bar[XB_XSUB(b.x)], 1u);
        const unsigned gen = old / nloc;
        if (old + 1u == (gen + 1u) * nloc) {
            __builtin_amdgcn_fence(__ATOMIC_RELEASE, "agent");
            asm volatile("s_waitcnt vmcnt(0)" ::: "memory");
            const unsigned og = xb_add(&bar[XB_TOP], 1u);
            const unsigned tg = og / nx;
            if (og + 1u == (tg + 1u) * nx) xb_add(&bar[XB_TOPGEN], 1u);
            else XB_SPIN(xb_ld(&bar[XB_TOPGEN]) == tg, bar);
            __builtin_amdgcn_fence(__ATOMIC_ACQUIRE, "agent");
            xb_add(&bar[XB_XGEN(b.x)], 1u);
            asm volatile("s_waitcnt vmcnt(0)" ::: "memory");
        } else {
            XB_SPIN(xb_ld(&bar[XB_XGEN(b.x)]) == gen, bar);
            __builtin_amdgcn_fence(__ATOMIC_ACQUIRE, "agent");
            asm volatile("s_waitcnt vmcnt(0)" ::: "memory");
        }
    }
    __syncthreads();
}
#ifndef EN_CH128
#define EN_CH128 1
#endif
#ifndef EN_CH192
#define EN_CH192 1
#endif
#ifndef EN_DN
#define EN_DN 1
#endif
#ifndef EN_GLU
#define EN_GLU 1
#endif
#ifndef EN_GU
#define EN_GU 1
#endif
#ifndef EN_INPROJ
#define EN_INPROJ 1
#endif
#ifndef EN_LN
#define EN_LN 1
#endif
#ifndef EN_MIX
#define EN_MIX 1
#endif
#ifndef EN_MOD
#define EN_MOD 1
#endif
#ifndef EN_OUT
#define EN_OUT 1
#endif
#ifndef EN_PRE
#define EN_PRE 1
#endif
#ifndef EN_PRO
#define EN_PRO 1
#endif
#ifndef EN_S5N
#define EN_S5N 1
#endif

constexpr int DM = 4096, NB = 2, SEQ = 8192, MTOK = NB * SEQ, DEPTH = 4;
constexpr int S5W = 1024;
constexpr int HGW = 1536;
constexpr int GLKW = 768;
constexpr int INW = 11792, INP = 12032, DFF = 11008;
constexpr int OW = 3072;
constexpr int C_U = 0, C_QB = 1024, C_FB = 2560, C_IB = 4096, C_GB = 5632, C_QC = 7168, C_KC = 7936, C_VC = 8704, C_GC = 10240, C_LR = 11776;
constexpr float LN_EPS = 1e-5f;
constexpr float ALPHA = 1.6817928305074290861f;
constexpr float GLA_QSCALE = 0.07216878364870322f;

enum { I_X = 0, I_C, I_WADA, I_BADA, I_TABLE, I_WIN, I_WOUT, I_AREAL, I_AIMAG, I_LOGDT, I_BRE, I_BIM, I_CRE, I_CIM, I_S5D, I_GLUW, I_GLUB,
       I_LBRAW, I_HGG, I_HGB, I_WGATE, I_BGATE, I_GLG, I_WFG, I_WFU, I_WFD, I_LN1G, I_LN1B, I_LN2G, I_LN2B, N_IN };

constexpr size_t MiB = 1u << 20;
constexpr size_t WS_CTL = 0, CTL_ZERO_BYTES = 1 * MiB;
constexpr size_t WS_MOD = 1 * MiB;
constexpr size_t WS_MISC = 2 * MiB;
constexpr size_t WS_ROWSTATS = 3 * MiB;
constexpr size_t WS_ROWPART = 4 * MiB;
constexpr size_t WS_CONDPART = 12 * MiB;
constexpr size_t WS_H = 24 * MiB;
constexpr size_t WS_MIXED = WS_H + 128 * MiB;
constexpr size_t WS_Z = WS_MIXED + 128 * MiB;
constexpr size_t WS_O = WS_Z + 32 * MiB;
constexpr size_t WS_P = WS_O + 192 * MiB;
constexpr size_t WS_WT = WS_P + 376 * MiB;
constexpr size_t WT_IN = 0, WT_OUT = 94 * MiB, WT_GU = 126 * MiB, WT_DN = 298 * MiB, WT_GLU = 384 * MiB, WT_LAYER = 386 * MiB;
constexpr size_t WS_HGB = WS_WT + DEPTH * WT_LAYER;
constexpr size_t WS_GLB = WS_HGB + 198 * MiB;
constexpr size_t WS_S5T = WS_GLB + 128 * MiB;
constexpr size_t WS_S5W1 = WS_S5T + 576 * MiB;
constexpr size_t WS_UX = WS_S5W1 + 144 * MiB;
constexpr size_t WS_SLOC = WS_UX + 36 * MiB;
constexpr size_t WS_LAM64 = WS_SLOC + 8 * MiB;
constexpr size_t WS_ST = WS_LAM64 + 1 * MiB;
constexpr size_t WS_END = WS_ST + 27 * MiB;
static_assert((size_t)INP * DM * 2 == 94 * MiB && (size_t)DM * DM * 2 == 32 * MiB && (size_t)2 * DFF * DM * 2 == 172 * MiB && (size_t)DM * DFF * 2 == 86 * MiB, "weight map");
static_assert((size_t)MTOK * INP * 2 == 376 * MiB && (size_t)MTOK * DFF * 2 <= 376 * MiB, "activation map");

constexpr int RING_BYTES = 131072;
constexpr int LDSCTL_OFF = 135168;
constexpr int LDS_BYTES = 147456;

#ifndef LAS
#define LAS __attribute__((address_space(3)))
#endif
typedef unsigned short bf16_t;
typedef float f32x4 __attribute__((ext_vector_type(4)));
typedef float f32x2 __attribute__((ext_vector_type(2)));
typedef unsigned u32x4 __attribute__((ext_vector_type(4)));
typedef unsigned u32x2 __attribute__((ext_vector_type(2)));
#define LDS_WAIT() asm volatile("s_waitcnt lgkmcnt(0)" ::: "memory")
#define VM_WAIT() asm volatile("s_waitcnt vmcnt(0)" ::: "memory")
typedef __bf16 bf16x2_t __attribute__((ext_vector_type(2)));
__device__ __forceinline__ unsigned cvt_pk_bf16(float lo, float hi) { return __builtin_bit_cast(unsigned, __builtin_convertvector((f32x2){lo, hi}, bf16x2_t)); }

__device__ __forceinline__ float bf_lo(unsigned w) { return __uint_as_float(w << 16); }
__device__ __forceinline__ float bf_hi(unsigned w) { return __uint_as_float(w & 0xffff0000u); }
__device__ __forceinline__ float bf2f(bf16_t b) { return __uint_as_float(((unsigned)b) << 16); }
__device__ __forceinline__ float wave_sum(float v) {
#pragma unroll
    for (int o = 1; o < 64; o <<= 1) v += __shfl_xor(v, o);
    return v;
}
__device__ __forceinline__ float sigmoidf_(float x) { return 1.0f / (1.0f + __expf(-x)); }
__device__ __forceinline__ float gelu_tanh(float y) { const float a = 0.7978845608028654f * (y + 0.044715f * y * y * y); const float t = 1.0f - 2.0f / (1.0f + __expf(2.0f * a)); return 0.5f * y * (1.0f + t); }

struct EpiProj {
    static constexpr bool PERM = true, AFTER_DRAIN = false;
    bf16_t* P; bf16_t* UX;
    __device__ __forceinline__ void operator()(const f32x4 (&acc)[2][2][4][2], const pg8::Unit& u, int wr, int wc, int fr, int fq) const {
        const int row0 = u.pm * 256 + wr * 64 + fr, col0 = u.pn * 256 + wc * 32 + 8 * fq;
        const bool s5 = u.pn < 4;
#pragma unroll
        for (int ai = 0; ai < 2; ++ai)
#pragma unroll
            for (int m = 0; m < 4; ++m) { const int row = row0 + ai * 128 + m * 16;
#pragma unroll
                for (int bj = 0; bj < 2; ++bj) { const f32x4 v0 = acc[ai][bj][m][0], v1 = acc[ai][bj][m][1]; const int col = col0 + bj * 128;
                    u32x4 w; w.x = cvt_pk_bf16(v0[0], v0[1]); w.y = cvt_pk_bf16(v0[2], v0[3]); w.z = cvt_pk_bf16(v1[0], v1[1]); w.w = cvt_pk_bf16(v1[2], v1[3]);
                    if (!s5) *(u32x4*)(P + (size_t)row * INP + col) = w;
                    else { bf16_t* ur = UX + (size_t)((col >> 4) * 256 + (row >> 6)) * 1152; *(u32x4*)(ur + (row & 63) * 16 + (col & 15)) = w;
                        if ((row & 63) == 0) { const u32x4 z = (u32x4){0u, 0u, 0u, 0u}; bf16_t* zp = ur + 1024 + ((col & 15) ? 64 : 0);
#pragma unroll
                            for (int i = 0; i < 8; ++i) *(u32x4*)(zp + 8 * i) = z; } } } }
    }
};
struct EpiSwiglu {
    static constexpr bool PERM = true, AFTER_DRAIN = false;
    bf16_t* HID;
    __device__ __forceinline__ void operator()(const f32x4 (&acc)[2][2][4][2], const pg8::Unit& u, int wr, int wc, int fr, int fq) const {
        const int row0 = u.pm * 256 + wr * 64 + fr, col0 = u.pn * 128 + wc * 32 + 8 * fq;
#pragma unroll
        for (int ai = 0; ai < 2; ++ai)
#pragma unroll
            for (int m = 0; m < 4; ++m) { bf16_t* rowp = HID + (size_t)(row0 + ai * 128 + m * 16) * DFF + col0;
                float o[8];
#pragma unroll
                for (int n = 0; n < 2; ++n)
#pragma unroll
                    for (int j = 0; j < 4; ++j) { const float g = acc[ai][0][m][n][j], up = acc[ai][1][m][n][j]; o[n * 4 + j] = g * __builtin_amdgcn_rcpf(1.0f + __expf(-g)) * up; }
                u32x4 w; w.x = cvt_pk_bf16(o[0], o[1]); w.y = cvt_pk_bf16(o[2], o[3]); w.z = cvt_pk_bf16(o[4], o[5]); w.w = cvt_pk_bf16(o[6], o[7]);
                *(u32x4*)rowp = w; }
    }
};
struct EpiGlu {
    static constexpr bool PERM = true, AFTER_DRAIN = false;
    const bf16_t* Z; bf16_t* MIXED; const float* bias;
    __device__ __forceinline__ void operator()(const f32x4 (&acc)[2][2][4][2], const pg8::Unit& u, int wr, int wc, int fr, int fq) const {
        const int row0 = u.pm * 256 + wr * 64 + fr, col0 = u.pn * 256 + wc * 32 + 8 * fq;
#pragma unroll
        for (int bj = 0; bj < 2; ++bj) {
            const f32x4 b0 = *(const f32x4*)(bias + col0 + bj * 128), b1 = *(const f32x4*)(bias + col0 + bj * 128 + 4);
#pragma unroll
            for (int ai = 0; ai < 2; ++ai)
#pragma unroll
                for (int m = 0; m < 4; ++m) { const size_t r = (size_t)(row0 + ai * 128 + m * 16);
                    const u32x4 zz = *(const u32x4*)(Z + r * S5W + col0 + bj * 128);
                    const f32x4 v0 = acc[ai][bj][m][0] + b0, v1 = acc[ai][bj][m][1] + b1;
                    u32x4 w;
                    w.x = cvt_pk_bf16(bf_lo(zz.x) * sigmoidf_(v0[0]), bf_hi(zz.x) * sigmoidf_(v0[1]));
                    w.y = cvt_pk_bf16(bf_lo(zz.y) * sigmoidf_(v0[2]), bf_hi(zz.y) * sigmoidf_(v0[3]));
                    w.z = cvt_pk_bf16(bf_lo(zz.z) * sigmoidf_(v1[0]), bf_hi(zz.z) * sigmoidf_(v1[1]));
                    w.w = cvt_pk_bf16(bf_lo(zz.w) * sigmoidf_(v1[2]), bf_hi(zz.w) * sigmoidf_(v1[3]));
                    *(u32x4*)(MIXED + r * DM + col0 + bj * 128) = w;
                    if (m & 1) asm volatile("" ::: "memory"); }
        }
    }
};
struct EpiResid {
    static constexpr bool PERM = false, AFTER_DRAIN = false;
    const float* base; float* out; const float* rowstats; const float* lng; const float* lnb; const float* gate0; float* rowpart;
    __device__ __forceinline__ void operator()(const f32x4 (&acc)[2][2][4][2], const pg8::Unit& u, int wr, int wc, int fr, int fq) const {
        const int rowb = u.pm * 256 + wr * 64 + fr, col0 = u.pn * 256 + wc * 32 + 4 * fq;
        const float* gp = gate0 + (u.pm >= 32 ? 6 * DM : 0);
#pragma unroll
        for (int ai = 0; ai < 2; ++ai)
#pragma unroll
            for (int m = 0; m < 4; ++m) { const int row = rowb + ai * 128 + m * 16;
                const f32x2 st = *(const f32x2*)(rowstats + (size_t)row * 2);
                float s1 = 0.f, s2 = 0.f;
#pragma unroll
                for (int bj = 0; bj < 2; ++bj)
#pragma unroll
                    for (int n = 0; n < 2; ++n) { const int c = col0 + bj * 128 + n * 16; const size_t off = (size_t)row * DM + c;
                        const f32x4 vb = *(const f32x4*)(base + off);
                        const f32x4 A = *(const f32x4*)(lng + c), Bc = *(const f32x4*)(lnb + c), Gm = *(const f32x4*)(gp + c);
                        const f32x4 o = (((vb - st.x) * st.y) * A + Bc) * ALPHA + (Gm + 1.0f) * acc[ai][bj][m][n];
                        *(f32x4*)(out + off) = o;
                        s1 += (o[0] + o[1]) + (o[2] + o[3]); s2 += (o[0] * o[0] + o[1] * o[1]) + (o[2] * o[2] + o[3] * o[3]); }
                s1 += __shfl_xor(s1, 16); s1 += __shfl_xor(s1, 32); s2 += __shfl_xor(s2, 16); s2 += __shfl_xor(s2, 32);
                if (fq == 0) *(f32x2*)(rowpart + ((size_t)row * 64 + u.pn * 4 + wc) * 2) = (f32x2){s1, s2};
                asm volatile("" ::: "memory"); }
    }
};

__device__ __forceinline__ int lane_id_v() { int r; asm volatile("v_mbcnt_lo_u32_b32 %0, -1, 0\n\tv_mbcnt_hi_u32_b32 %0, -1, %0" : "=v"(r)); return r; }
struct Args { const float* in[N_IN]; float* out; unsigned char* ws; int ph_lo, ph_hi; };
struct Ctx {
    volatile LAS unsigned long long* t;
    __device__ __forceinline__ unsigned long long ld(int i) const { const unsigned long long v = t[i];
        return ((unsigned long long)(unsigned)__builtin_amdgcn_readfirstlane((int)(v >> 32)) << 32) | (unsigned long long)(unsigned)__builtin_amdgcn_readfirstlane((int)(unsigned)v); }
    __device__ __forceinline__ const float* in(int i) const { return (const float*)ld(i); }
    __device__ __forceinline__ float* out() const { return (float*)ld(30); }
    __device__ __forceinline__ unsigned char* ws() const { return (unsigned char*)ld(31); }
};

constexpr int S5K = 1152;
constexpr size_t S5_T_LAYER = (size_t)64 * 1024 * S5K * 2, S5_W1_LAYER = (size_t)64 * 256 * S5K * 2;

struct S5Order {
    int G, c, n, sh;
    __device__ __forceinline__ bool next(int i, pg8::Unit& u) const { const int L = i * G + c; if (L >= n) return false; u.pm = L >> sh; u.pn = L; return true; }
    __device__ __forceinline__ void a_ready(const pg8::Unit&) const {}
    __device__ __forceinline__ void done(const pg8::Unit&) const {}
};
struct EpiS5A {
    static constexpr bool PERM = false, AFTER_DRAIN = false;
    float* Sloc;
    __device__ __forceinline__ void operator()(const f32x4 (&acc)[2][2][4][2], const pg8::Unit& u, int wr, int wc, int fr, int fq) const {
        const int row0 = u.pm * 256 + wr * 64 + fr, col0 = wc * 32 + 4 * fq;
#pragma unroll
        for (int ai = 0; ai < 2; ++ai)
#pragma unroll
            for (int m = 0; m < 4; ++m)
#pragma unroll
                for (int n = 0; n < 2; ++n) *(f32x4*)(Sloc + (size_t)(row0 + ai * 128 + m * 16) * 128 + col0 + n * 16) = acc[ai][0][m][n];
    }
};
struct EpiS5C {
    static constexpr bool PERM = true, AFTER_DRAIN = false;
    bf16_t* Z;
    __device__ __forceinline__ void operator()(const f32x4 (&acc)[2][2][4][2], const pg8::Unit& u, int wr, int wc, int fr, int fq) const {
        const int g = u.pm, c0 = wr * 64 + fr, cc0 = (u.pn & 3) * 256 + wc * 32 + 8 * fq;
#pragma unroll
        for (int ai = 0; ai < 2; ++ai)
#pragma unroll
            for (int m = 0; m < 4; ++m) { const int c = c0 + ai * 128 + m * 16;
#pragma unroll
                for (int bj = 0; bj < 2; ++bj) { const int cc = cc0 + bj * 128, t = cc >> 4, h0 = cc & 15;
                    const f32x4 v0 = acc[ai][bj][m][0], v1 = acc[ai][bj][m][1];
                    u32x4 w; w.x = cvt_pk_bf16(gelu_tanh(v0[0]), gelu_tanh(v0[1])); w.y = cvt_pk_bf16(gelu_tanh(v0[2]), gelu_tanh(v0[3]));
                    w.z = cvt_pk_bf16(gelu_tanh(v1[0]), gelu_tanh(v1[1])); w.w = cvt_pk_bf16(gelu_tanh(v1[2]), gelu_tanh(v1[3]));
                    *(u32x4*)(Z + (size_t)(c * 64 + t) * S5W + g * 16 + h0) = w; } }
    }
};
__device__ __forceinline__ void s5_tables_item(const Ctx& a, int lg, LAS unsigned char* lds, int wave, int lane) {
    LAS f32x2* LP = (LAS f32x2*)lds;
    LAS f32x2* BB = (LAS f32x2*)(lds + 33280);
    LAS f32x2* CC = (LAS f32x2*)(lds + 41472);
    LAS float* KT = (LAS float*)(lds + 49664);
    const int tid = wave * 64 + lane, l = lg >> 6, g = lg & 63;
    if (tid < 64) { const int p = tid;
        const double ar = (double)a.in(I_AREAL)[lg * 64 + p], ai = (double)a.in(I_AIMAG)[lg * 64 + p], dt = exp((double)a.in(I_LOGDT)[lg]);
        const double mag = exp(ar * dt), ang = ai * dt, lr = mag * cos(ang), li = mag * sin(ang);
        const double den = ar * ar + ai * ai, nr = lr - 1.0, ni = li, cr = (nr * ar + ni * ai) / den, ci = (ni * ar - nr * ai) / den;
        double pr = 1.0, pi = 0.0;
        for (int tau = 0; tau <= 64; ++tau) { LP[tau * 64 + p] = (f32x2){(float)pr, (float)pi}; const double nr2 = pr * lr - pi * li, ni2 = pr * li + pi * lr; pr = nr2; pi = ni2; }
        for (int h = 0; h < 16; ++h) { const double br = (double)a.in(I_BRE)[((size_t)lg * 64 + p) * 16 + h], bi = (double)a.in(I_BIM)[((size_t)lg * 64 + p) * 16 + h];
            BB[p * 16 + h] = (f32x2){(float)(cr * br - ci * bi), (float)(cr * bi + ci * br)}; }
    }
    for (int e = tid; e < 1024; e += 512) { const int h = e >> 6, p = e & 63; CC[e] = (f32x2){a.in(I_CRE)[((size_t)lg * 16 + h) * 64 + p], a.in(I_CIM)[((size_t)lg * 16 + h) * 64 + p]}; }
    __syncthreads();
    if (tid < 64) *(f32x2*)((float*)(a.ws() + WS_LAM64) + ((size_t)lg * 64 + tid) * 2) = LP[64 * 64 + tid];
    for (int e = tid; e < 64 * 256; e += 512) { const int tau = e >> 8, h = (e >> 4) & 15, hp = e & 15; float s = 0.f;
#pragma unroll 8
        for (int p = 0; p < 64; ++p) { const f32x2 c = CC[h * 64 + p], lm = LP[tau * 64 + p], b = BB[p * 16 + hp];
            const float xr = c.x * lm.x - c.y * lm.y, xi = c.x * lm.y + c.y * lm.x; s += xr * b.x - xi * b.y; }
        if (tau == 0 && h == hp) s += a.in(I_S5D)[l * S5W + g * 16 + h];
        KT[e] = s; }
    __syncthreads();
    bf16_t* T = (bf16_t*)(a.ws() + WS_S5T + (size_t)l * S5_T_LAYER) + (size_t)g * 1024 * S5K;
    for (int pc = tid; pc < 1024 * 144; pc += 512) { const int n = pc / 144, j = pc % 144, t = n >> 4, h = n & 15; float v[8];
        if (j < 128) { const int s = j >> 1, hp0 = (j & 1) * 8;
            if (s > t) {
#pragma unroll
                for (int i = 0; i < 8; ++i) v[i] = 0.f;
            } else { const LAS float* kp = KT + (t - s) * 256 + h * 16 + hp0; const f32x4 k0 = *(const LAS f32x4*)kp, k1 = *(const LAS f32x4*)(kp + 4);
                v[0] = k0[0]; v[1] = k0[1]; v[2] = k0[2]; v[3] = k0[3]; v[4] = k1[0]; v[5] = k1[1]; v[6] = k1[2]; v[7] = k1[3]; }
        } else { const int p0 = (j - 128) * 4;
#pragma unroll
            for (int i = 0; i < 4; ++i) { const f32x2 c = CC[h * 64 + p0 + i], lm = LP[(t + 1) * 64 + p0 + i]; v[2 * i] = c.x * lm.x - c.y * lm.y; v[2 * i + 1] = -(c.x * lm.y + c.y * lm.x); } }
        *(u32x4*)(T + (size_t)n * S5K + j * 8) = (u32x4){cvt_pk_bf16(v[0], v[1]), cvt_pk_bf16(v[2], v[3]), cvt_pk_bf16(v[4], v[5]), cvt_pk_bf16(v[6], v[7])}; }
    bf16_t* W1 = (bf16_t*)(a.ws() + WS_S5W1 + (size_t)l * S5_W1_LAYER) + (size_t)g * 256 * S5K;
    for (int pc = tid; pc < 256 * 144; pc += 512) { const int n = pc / 144, j = pc % 144; float v[8];
#pragma unroll
        for (int i = 0; i < 8; ++i) v[i] = 0.f;
        if (n < 128 && j < 128) { const int p = n >> 1, ri = n & 1, s = j >> 1, hp0 = (j & 1) * 8; const f32x2 lm = LP[(63 - s) * 64 + p];
#pragma unroll
            for (int i = 0; i < 8; ++i) { const f32x2 b = BB[p * 16 + hp0 + i]; v[i] = ri ? (lm.x * b.y + lm.y * b.x) : (lm.x * b.x - lm.y * b.y); } }
        *(u32x4*)(W1 + (size_t)n * S5K + j * 8) = (u32x4){cvt_pk_bf16(v[0], v[1]), cvt_pk_bf16(v[2], v[3]), cvt_pk_bf16(v[4], v[5]), cvt_pk_bf16(v[6], v[7])}; }
    __syncthreads();
}
__device__ __forceinline__ void s5_scan_item(const Ctx& a, int l, int item, int wave, int lane) {
    const int idx = item * 512 + wave * 64 + lane, g = idx >> 7, b = (idx >> 6) & 1, p = idx & 63;
    const f32x2 lam = *(const f32x2*)((const float*)(a.ws() + WS_LAM64) + ((size_t)(l * 64 + g) * 64 + p) * 2);
    const float* sl = (const float*)(a.ws() + WS_SLOC) + ((size_t)(g * 256 + b * 128)) * 128 + 2 * p;
    bf16_t* ux = (bf16_t*)(a.ws() + WS_UX) + ((size_t)(g * 256 + b * 128)) * S5K + 1024 + 2 * p;
    float xr = 0.f, xi = 0.f;
    for (int c0 = 0; c0 < 128; c0 += 8) { f32x2 s[8];
#pragma unroll
        for (int i = 0; i < 8; ++i) s[i] = *(const f32x2*)(sl + (size_t)(c0 + i) * 128);
#pragma unroll
        for (int i = 0; i < 8; ++i) { *(unsigned*)(ux + (size_t)(c0 + i) * S5K) = cvt_pk_bf16(xr, xi);
            const float nr = lam.x * xr - lam.y * xi + s[i].x, ni = lam.x * xi + lam.y * xr + s[i].y; xr = nr; xi = ni; } }
}

__device__ __forceinline__ void transpose_item(const float* W, int N, int k0, int n0, bf16_t* WT, int drow0, int Kd, LAS float* scr, int lane) {
    const int nl = 4 * (lane & 15), kq = lane >> 4;
    const bool valid = (n0 + nl) < N;
    f32x4 v[16];
#pragma unroll
    for (int i = 0; i < 16; ++i) { const int k = 4 * i + kq; v[i] = valid ? *(const f32x4*)(W + (size_t)(k0 + k) * N + n0 + nl) : (f32x4){0.f, 0.f, 0.f, 0.f}; }
#pragma unroll
    for (int i = 0; i < 16; ++i) { const int k = 4 * i + kq; LAS float* s = scr + k * 65 + nl; s[0] = v[i][0]; s[1] = v[i][1]; s[2] = v[i][2]; s[3] = v[i][3]; }
    LDS_WAIT();
    const int c = lane & 7;
#pragma unroll
    for (int j = 0; j < 8; ++j) { const int n = (lane >> 3) + 8 * j; const LAS float* s = scr + (8 * c) * 65 + n;
        u32x4 o; o.x = cvt_pk_bf16(s[0], s[65]); o.y = cvt_pk_bf16(s[130], s[195]); o.z = cvt_pk_bf16(s[260], s[325]); o.w = cvt_pk_bf16(s[390], s[455]);
        *(u32x4*)(WT + (size_t)(drow0 + n) * Kd + k0 + 8 * c) = o; }
    LDS_WAIT();
}
constexpr int NIT_IN = 64 * 188, NIT_OUT = 64 * 64, NIT_G = 64 * 172, NIT_DN = 172 * 64, NIT_GLU = 16 * 16;
constexpr int NIT_LAYER = NIT_IN + NIT_OUT + 2 * NIT_G + NIT_DN + NIT_GLU;
constexpr int NIT_TR = DEPTH * NIT_LAYER, NIT_COND = 64 * 96;

__device__ __forceinline__ void phase_prologue(const Ctx& a, LAS unsigned char* lds, int wave, int lane) {
    LAS float* scr = (LAS float*)(lds + wave * 16640);
    const int gw = blockIdx.x * 8 + wave, NGW = gridDim.x * 8;
    for (int it = gw; it < NIT_TR + NIT_COND; it += NGW) {
        if (it < NIT_TR) {
            const int l = it / NIT_LAYER; int r = it % NIT_LAYER;
            unsigned char* wt = a.ws() + WS_WT + (size_t)l * WT_LAYER;
            if (r < NIT_IN) { const int kb = r / 188, nb = r % 188; transpose_item(a.in(I_WIN) + (size_t)l * DM * INW, INW, 64 * kb, 64 * nb, (bf16_t*)(wt + WT_IN), 64 * nb, DM, scr, lane); continue; } r -= NIT_IN;
            if (r < NIT_OUT) { const int kb = r / 64, nb = r % 64; transpose_item(a.in(I_WOUT) + (size_t)l * DM * DM, DM, 64 * kb, 64 * nb, (bf16_t*)(wt + WT_OUT), 64 * nb, DM, scr, lane); continue; } r -= NIT_OUT;
            if (r < NIT_G) { const int kb = r / 172, nb = r % 172, n0 = 64 * nb; transpose_item(a.in(I_WFG) + (size_t)l * DM * DFF, DFF, 64 * kb, n0, (bf16_t*)(wt + WT_GU), 256 * (n0 / 128) + (n0 % 128), DM, scr, lane); continue; } r -= NIT_G;
            if (r < NIT_G) { const int kb = r / 172, nb = r % 172, n0 = 64 * nb; transpose_item(a.in(I_WFU) + (size_t)l * DM * DFF, DFF, 64 * kb, n0, (bf16_t*)(wt + WT_GU), 256 * (n0 / 128) + 128 + (n0 % 128), DM, scr, lane); continue; } r -= NIT_G;
            if (r < NIT_DN) { const int kb = r / 64, nb = r % 64; transpose_item(a.in(I_WFD) + (size_t)l * DFF * DM, DM, 64 * kb, 64 * nb, (bf16_t*)(wt + WT_DN), 64 * nb, DFF, scr, lane); continue; } r -= NIT_DN;
            { const int kb = r / 16, nb = r % 16; transpose_item(a.in(I_GLUW) + (size_t)l * S5W * S5W, S5W, 64 * kb, 64 * nb, (bf16_t*)(wt + WT_GLU), 64 * nb, S5W, scr, lane); }
        } else {
            const int item = it - NIT_TR, kb = item / 96, jb = item % 96, k0 = 64 * kb, j0 = 256 * jb + 4 * lane;
            const float* c = a.in(I_C);
            float c0 = c[k0 + lane], c1 = c[DM + k0 + lane];
            c0 = c0 / (1.0f + expf(-c0)); c1 = c1 / (1.0f + expf(-c1));
            f32x4 a0 = (f32x4){0.f, 0.f, 0.f, 0.f}, a1 = a0;
            const float* w = a.in(I_WADA) + (size_t)k0 * (6 * DM) + j0;
#pragma unroll 8
            for (int kk = 0; kk < 64; ++kk) { const f32x4 wv = *(const f32x4*)(w + (size_t)kk * (6 * DM));
                const float s0 = __int_as_float(__builtin_amdgcn_readlane(__float_as_int(c0), kk)), s1 = __int_as_float(__builtin_amdgcn_readlane(__float_as_int(c1), kk));
                a0 += wv * s0; a1 += wv * s1; }
            float* cp = (float*)(a.ws() + WS_CONDPART);
            *(f32x4*)(cp + (size_t)(kb * 2 + 0) * (6 * DM) + j0) = a0;
            *(f32x4*)(cp + (size_t)(kb * 2 + 1) * (6 * DM) + j0) = a1;
        }
    }
    __syncthreads();
    for (int lg = blockIdx.x; lg < DEPTH * 64; lg += gridDim.x) s5_tables_item(a, lg, lds, wave, lane);
}
__device__ __forceinline__ void phase_mod(const Ctx& a, int wave, int lane) {
    const int gt = blockIdx.x * 512 + wave * 64 + lane, NT = gridDim.x * 512;
    const float* cp = (const float*)(a.ws() + WS_CONDPART);
    float* mod = (float*)(a.ws() + WS_MOD); float* misc = (float*)(a.ws() + WS_MISC);
    for (int idx = gt; idx < NB * 6 * DM; idx += NT) {
        const int b = idx / (6 * DM), j = idx % (6 * DM);
        float s = a.in(I_BADA)[j];
        for (int kb = 0; kb < 64; ++kb) s += cp[(size_t)(kb * 2 + b) * (6 * DM) + j];
        for (int l = 0; l < DEPTH; ++l) mod[(size_t)((l * 2 + b) * 6) * DM + j] = s + a.in(I_TABLE)[(size_t)l * 6 * DM + j];
    }
    for (int idx = gt; idx < DM; idx += NT) { misc[idx] = 1.0f; misc[DM + idx] = 0.0f; }
    for (int idx = gt; idx < HGW; idx += NT) {
        const float* raw = a.in(I_LBRAW); float r[DEPTH], mx = -3.0e38f;
#pragma unroll
        for (int l = 0; l < DEPTH; ++l) { r[l] = raw[l * HGW + idx]; mx = fmaxf(mx, r[l]); }
        float e[DEPTH], sum = 0.f;
#pragma unroll
        for (int l = 0; l < DEPTH; ++l) { e[l] = expf(r[l] - mx); sum += e[l]; }
        float cum = 0.f;
#pragma unroll
        for (int l = 0; l < DEPTH; ++l) { misc[2 * DM + l * HGW + idx] = cum; if (l + 1 < DEPTH) cum += e[l + 1] / sum; }
    }
}

template <int MODE>
__device__ __forceinline__ void phase_lnapply(const float* vsrc, const float* rowpart, float* rowstats, const float* lng, const float* lnb, const float* modp, int i_shift, int i_scale,
                                              bf16_t* H, float* outf, LAS unsigned char* lds, int wave, int lane) {
    LAS f32x2* st = (LAS f32x2*)lds;
    for (int blk = blockIdx.x; blk < MTOK / 64; blk += gridDim.x) {
        const int r0 = blk * 64, b = (r0 >= SEQ) ? 1 : 0;
        for (int rr = 0; rr < 8; ++rr) { const int rl = wave * 8 + rr, r = r0 + rl; float mu = 0.f, rs = 1.f;
            if (MODE != 0) { const f32x2 p = *(const f32x2*)(rowpart + ((size_t)r * 64 + lane) * 2); const float s1 = wave_sum(p.x), s2 = wave_sum(p.y);
                mu = s1 * (1.0f / DM); const float var = fmaxf(s2 * (1.0f / DM) - mu * mu, 0.f); rs = 1.0f / sqrtf(var + LN_EPS); }
            if (lane == 0) { st[rl] = (f32x2){mu, rs}; if (MODE != 2) *(f32x2*)(rowstats + (size_t)r * 2) = (f32x2){mu, rs}; } }
        __syncthreads();
        f32x4 A[2], B[2];
#pragma unroll
        for (int jj = 0; jj < 2; ++jj) { const int c = 512 * wave + 256 * jj + 4 * lane;
            f32x4 g = (f32x4){1.f, 1.f, 1.f, 1.f}, bb = (f32x4){0.f, 0.f, 0.f, 0.f};
            if (MODE != 0) { g = *(const f32x4*)(lng + c); bb = *(const f32x4*)(lnb + c); }
            if (MODE != 2) { const f32x4 sc = *(const f32x4*)(modp + (size_t)(b * 6 + i_scale) * DM + c) + 1.0f, sh = *(const f32x4*)(modp + (size_t)(b * 6 + i_shift) * DM + c); A[jj] = g * sc; B[jj] = bb * sc + sh; }
            else { A[jj] = g; B[jj] = bb; } }
#pragma unroll 8
        for (int rl = 0; rl < 64; ++rl) { const f32x2 s = st[rl]; const size_t off = (size_t)(r0 + rl) * DM + 512 * wave + 4 * lane;
#pragma unroll
            for (int jj = 0; jj < 2; ++jj) { const f32x4 v = *(const f32x4*)(vsrc + off + 256 * jj); const f32x4 y = ((v - s.x) * s.y) * A[jj] + B[jj];
                if (MODE == 2) *(f32x4*)(outf + off + 256 * jj) = y;
                else { u32x2 w; w.x = cvt_pk_bf16(y[0], y[1]); w.y = cvt_pk_bf16(y[2], y[3]); *(u32x2*)(H + off + 256 * jj) = w; } } }
        __syncthreads();
    }
}

typedef short bf16x8 __attribute__((ext_vector_type(8)));
typedef short bf16x4 __attribute__((ext_vector_type(4)));
constexpr int HG_BLK = 16896, HG_OQ = 0, HG_OK = 4096, HG_OKT = 8192, HG_OVT = 12288, HG_ODL = 16384;
constexpr int GL_BLK = 32768, GL_OQ = 0, GL_OK = 6400, GL_OKT = 12800, GL_ODL = 18944, GL_SHARED = 20480, GL_OVT = 20480;
constexpr int NSUB = SEQ / 16;

__device__ __forceinline__ unsigned short f2bf1(float x) { return (unsigned short)(cvt_pk_bf16(x, x) & 0xffffu); }

__device__ __forceinline__ void pre_finish(const float (&qq)[16], const float (&kk)[16], float (&g)[16], unsigned char* blk, int oq, int ok, int okt, int odl, int rowb, int d, bool swz) {
    float b = 0.f;
#pragma unroll
    for (int j = 0; j < 16; ++j) { b += g[j]; g[j] = b; }
    const float bl = b;
    unsigned kt[8];
#pragma unroll
    for (int j = 0; j < 16; j += 2) {
        float kv[2];
#pragma unroll
        for (int jj = 0; jj < 2; ++jj) { const int t = j + jj; const float bj = g[t];
            const int off = t * rowb + (swz ? ((2 * d) ^ (t << 4)) : 2 * d);
            const float qv = qq[t] * __expf(bj), kc = kk[t] * __expf(fminf(-bj, 80.f));
            const float qn = __shfl_xor(qv, 1), kn = __shfl_xor(kc, 1);
            if ((d & 1) == 0) { *(unsigned*)(blk + oq + off) = cvt_pk_bf16(qv, qn); *(unsigned*)(blk + ok + off) = cvt_pk_bf16(kc, kn); }
            kv[jj] = kk[t] * __expf(bl - bj); }
        kt[j >> 1] = cvt_pk_bf16(kv[0], kv[1]); }
    *(u32x4*)(blk + okt + d * 32) = (u32x4){kt[0], kt[1], kt[2], kt[3]};
    *(u32x4*)(blk + okt + d * 32 + 16) = (u32x4){kt[4], kt[5], kt[6], kt[7]};
    *(float*)(blk + odl + d * 4) = __expf(bl);
}
__device__ __forceinline__ void phase_pre(const Ctx& a, int l, int wave, int lane) {
    const bf16_t* P = (const bf16_t*)(a.ws() + WS_P);
    int tid = wave * 64 + lane;
    for (int task = blockIdx.x; task < NB * NSUB * 8; task += gridDim.x) {
        asm volatile("" : "+v"(tid));
        const int kind = (task + (task >> 8)) & 7, bsc = task >> 3, b = bsc / NSUB, sc = bsc % NSUB;
        const size_t row0 = (size_t)b * SEQ + sc * 16;
        if (kind < 3) {
            const int ch = kind * 512 + tid, h = ch >> 7, d = ch & 127;
            const float lb = ((const float*)(a.ws() + WS_MISC))[2 * DM + l * HGW + ch];
            unsigned char* blk = a.ws() + WS_HGB + ((size_t)(b * 12 + h) * NSUB + sc) * HG_BLK;
            float g[16], qq[16], kk[16]; unsigned vv[8];
#pragma unroll
            for (int j = 0; j < 16; ++j) { const bf16_t* prow = P + (row0 + j) * INP;
                const float qin = fmaxf(bf2f(prow[C_QB + ch]), -80.f), fin = fminf(fmaxf(bf2f(prow[C_FB + ch]), -80.f), 80.f);
                const unsigned short v = prow[C_IB + ch]; if (j & 1) vv[j >> 1] |= ((unsigned)v) << 16; else vv[j >> 1] = v;
                const float e = __expf(-fin), sg = 1.0f / (1.0f + e);
                const float f = lb + (1.0f - lb) * sg;
                g[j] = fmaxf(__logf(f), -100.f); kk[j] = (1.0f - lb) * (e * sg); qq[j] = qin / (1.0f + __expf(-qin)); }
            *(u32x4*)(blk + HG_OVT + d * 32) = (u32x4){vv[0], vv[1], vv[2], vv[3]};
            *(u32x4*)(blk + HG_OVT + d * 32 + 16) = (u32x4){vv[4], vv[5], vv[6], vv[7]};
            pre_finish(qq, kk, g, blk, HG_OQ, HG_OK, HG_OKT, HG_ODL, 256, d, true);
        } else if (kind < 5) {
            if (tid < 384) {
                const int ch = (kind - 3) * 384 + tid, h = ch / 192, d = ch % 192;
                unsigned char* blk = a.ws() + WS_GLB + ((size_t)(b * 4 + h) * NSUB + sc) * GL_BLK;
                float wg[16];
#pragma unroll
                for (int r = 0; r < 16; ++r) wg[r] = a.in(I_WGATE)[((size_t)l * 16 + r) * GLKW + ch];
                const float bgv = a.in(I_BGATE)[l * GLKW + ch];
                float g[16], qq[16], kk[16];
#pragma unroll
                for (int j = 0; j < 16; ++j) { const bf16_t* prow = P + (row0 + j) * INP;
                    const u32x4 l0 = *(const u32x4*)(prow + C_LR), l1 = *(const u32x4*)(prow + C_LR + 8);
                    float x = bgv;
                    x += bf_lo(l0.x) * wg[0] + bf_hi(l0.x) * wg[1] + bf_lo(l0.y) * wg[2] + bf_hi(l0.y) * wg[3] + bf_lo(l0.z) * wg[4] + bf_hi(l0.z) * wg[5] + bf_lo(l0.w) * wg[6] + bf_hi(l0.w) * wg[7];
                    x += bf_lo(l1.x) * wg[8] + bf_hi(l1.x) * wg[9] + bf_lo(l1.y) * wg[10] + bf_hi(l1.y) * wg[11] + bf_lo(l1.z) * wg[12] + bf_hi(l1.z) * wg[13] + bf_lo(l1.w) * wg[14] + bf_hi(l1.w) * wg[15];
                    g[j] = (fminf(x, 0.f) - __logf(1.0f + __expf(-fabsf(x)))) * 0.0625f;
                    qq[j] = bf2f(prow[C_QC + ch]) * GLA_QSCALE; kk[j] = bf2f(prow[C_KC + ch]); }
                pre_finish(qq, kk, g, blk, GL_OQ, GL_OK, GL_OKT, GL_ODL, 400, d, false);
            }
        } else {
            const int ch = (kind - 5) * 512 + tid, h = ch / 384, e = ch % 384;
            unsigned char* blk = a.ws() + WS_GLB + ((size_t)(b * 4 + h) * NSUB + sc) * GL_BLK;
            unsigned vv[8];
#pragma unroll
            for (int j = 0; j < 16; ++j) { const unsigned short v = P[(row0 + j) * INP + C_VC + ch]; if (j & 1) vv[j >> 1] |= ((unsigned)v) << 16; else vv[j >> 1] = v; }
            *(u32x4*)(blk + GL_OVT + e * 32) = (u32x4){vv[0], vv[1], vv[2], vv[3]};
            *(u32x4*)(blk + GL_OVT + e * 32 + 16) = (u32x4){vv[4], vv[5], vv[6], vv[7]};
        }
    }
}

template <int DK, int MODE>
__device__ __forceinline__ void chain_sub(const LAS unsigned char* sb, f32x4 (&S)[DK / 16], float* op, int wave, int n, int q) {
    constexpr bool IS_GLA = (DK == 192);
    constexpr int NKS = DK / 32, NMB = DK / 16, ROWB = IS_GLA ? 400 : 256;
    constexpr int OQ = 0, OK = IS_GLA ? GL_OK : HG_OK, OKT = IS_GLA ? GL_OKT : HG_OKT, OVT = IS_GLA ? GL_OVT : HG_OVT, ODL = IS_GLA ? GL_ODL : HG_ODL;
    const u32x2 vfr = *(const LAS u32x2*)(sb + OVT + (16 * wave + n) * 32 + 8 * q);
    const bf16x8 vf8 = __builtin_bit_cast(bf16x8, (u32x4){vfr.x, vfr.y, 0u, 0u});
    if (MODE == 1) {
        bf16x8 qf[NKS], kf[NKS];
#pragma unroll
        for (int ks = 0; ks < NKS; ++ks) { const int c0 = 2 * (32 * ks + 4 * q), c1 = c0 + 32;
            const int o0 = n * ROWB + (IS_GLA ? c0 : (c0 ^ (n << 4))), o1 = n * ROWB + (IS_GLA ? c1 : (c1 ^ (n << 4)));
            const u32x2 ql = *(const LAS u32x2*)(sb + OQ + o0), qh = *(const LAS u32x2*)(sb + OQ + o1), kl = *(const LAS u32x2*)(sb + OK + o0), kh = *(const LAS u32x2*)(sb + OK + o1);
            qf[ks] = __builtin_bit_cast(bf16x8, (u32x4){ql.x, ql.y, qh.x, qh.y}); kf[ks] = __builtin_bit_cast(bf16x8, (u32x4){kl.x, kl.y, kh.x, kh.y}); }
        f32x4 ao = (f32x4){0.f, 0.f, 0.f, 0.f}, ap = ao;
#pragma unroll
        for (int ks = 0; ks < NKS; ++ks) {
            const bf16x8 sbf = __builtin_bit_cast(bf16x8, (u32x4){cvt_pk_bf16(S[2 * ks][0], S[2 * ks][1]), cvt_pk_bf16(S[2 * ks][2], S[2 * ks][3]), cvt_pk_bf16(S[2 * ks + 1][0], S[2 * ks + 1][1]), cvt_pk_bf16(S[2 * ks + 1][2], S[2 * ks + 1][3])});
            ao = __builtin_amdgcn_mfma_f32_16x16x32_bf16(qf[ks], sbf, ao, 0, 0, 0);
            ap = __builtin_amdgcn_mfma_f32_16x16x32_bf16(kf[ks], qf[ks], ap, 0, 0, 0); }
#pragma unroll
        for (int r = 0; r < 4; ++r) if (4 * q + r > n) ap[r] = 0.f;
        const bf16x8 pa8 = __builtin_bit_cast(bf16x8, (u32x4){cvt_pk_bf16(ap[0], ap[1]), cvt_pk_bf16(ap[2], ap[3]), 0u, 0u});
        ao = __builtin_amdgcn_mfma_f32_16x16x32_bf16(pa8, vf8, ao, 0, 0, 0);
#pragma unroll
        for (int r = 0; r < 4; ++r) op[(size_t)(4 * q + r) * OW] = ao[r];
    }
#pragma unroll
    for (int mb = 0; mb < NMB; ++mb) {
        const f32x4 dl = *(const LAS f32x4*)(sb + ODL + (16 * mb + 4 * q) * 4);
        const u32x2 ktr = *(const LAS u32x2*)(sb + OKT + (16 * mb + n) * 32 + 8 * q);
        S[mb] = __builtin_amdgcn_mfma_f32_16x16x32_bf16(__builtin_bit_cast(bf16x8, (u32x4){ktr.x, ktr.y, 0u, 0u}), vf8, S[mb] * dl, 0, 0, 0); }
}
constexpr size_t ST_REC = 98304;
constexpr int NSEG = 4, SEG_SUB = NSUB / NSEG;
template <int DK, int MODE>
__device__ __forceinline__ void chain_item(const unsigned char* blk0, int vt_off, float* op0, unsigned char* st, int seg, LAS unsigned char* lds, int wave, int lane) {
    asm volatile("" : "+v"(lane), "+s"(wave));
    constexpr bool IS_GLA = (DK == 192);
    constexpr int BLK = IS_GLA ? GL_BLK : HG_BLK, SUBB = IS_GLA ? GL_SHARED + 4096 : HG_BLK, NMB = DK / 16;
    constexpr int SH0 = MODE == 1 ? 0 : (IS_GLA ? GL_OKT : HG_OKT);
    constexpr int SH_PIECES = (MODE == 1 ? (IS_GLA ? GL_SHARED : HG_OVT) : (IS_GLA ? GL_ODL + 768 - GL_OKT : 4096)) / 16;
    constexpr int T_PIECES = IS_GLA ? 256 : (4096 + 512) / 16;
    constexpr int T_LDS = IS_GLA ? GL_OVT : HG_OVT;
    constexpr int PIECES = SH_PIECES + T_PIECES, UNITB = 2 * SUBB, NP = (2 * PIECES + 511) / 512;
    const int tid = wave * 64 + lane, n = lane & 15, q = lane >> 4;
    f32x4 S[NMB]; float dacc = 1.0f;
    constexpr int ODL_ = IS_GLA ? GL_ODL : HG_ODL;
#pragma unroll
    for (int mb = 0; mb < NMB; ++mb) S[mb] = (f32x4){0.f, 0.f, 0.f, 0.f};
    if (MODE == 1) {
        for (int s = 0; s < seg; ++s) { const unsigned char* rec = st + (size_t)s * 2 * ST_REC + (size_t)(wave * 64 + lane) * 16;
#pragma unroll
            for (int mb = 0; mb < NMB; ++mb) { const f32x4 h = *(const f32x4*)(rec + (size_t)mb * 8192), d = *(const f32x4*)(st + (size_t)s * 2 * ST_REC + ST_REC + (16 * mb + 4 * q) * 4); S[mb] = S[mb] * d + h; } }
    }
    u32x4 stgA[NP], stgB[NP];
    constexpr int nunits = SEG_SUB / 2;
#define CH_SRC(u, p_) (blk0 + (size_t)((u) * 2 + (p_) / PIECES) * BLK + (((p_) % PIECES) < SH_PIECES ? SH0 + ((p_) % PIECES) * 16 : (IS_GLA ? vt_off : HG_OVT) + (((p_) % PIECES) - SH_PIECES) * 16))
#define CH_DST(p_) (((p_) / PIECES) * SUBB + (((p_) % PIECES) < SH_PIECES ? SH0 + ((p_) % PIECES) * 16 : T_LDS + (((p_) % PIECES) - SH_PIECES) * 16))
#define CH_LOAD(stg, u) do { _Pragma("unroll") for (int r_ = 0; r_ < NP; ++r_) { const int p_ = r_ * 512 + tid; if (p_ < 2 * PIECES) stg[r_] = *(const u32x4*)CH_SRC(u, p_); } } while (0)
#define CH_STORE(stg, buf) do { _Pragma("unroll") for (int r_ = 0; r_ < NP; ++r_) { const int p_ = r_ * 512 + tid; if (p_ < 2 * PIECES) *(LAS u32x4*)(lds + (buf) * UNITB + CH_DST(p_)) = stg[r_]; } } while (0)
#define CH_SYNC() do { asm volatile("s_waitcnt lgkmcnt(0)" ::: "memory"); __builtin_amdgcn_s_barrier(); asm volatile("" ::: "memory"); } while (0)
    CH_LOAD(stgA, 0); CH_STORE(stgA, 0);
    CH_LOAD(stgA, 1);
    CH_SYNC();
    float* op = op0 + 16 * wave + n;
    for (int u = 0; u < nunits; u += 2) {
        if (u + 2 < nunits) CH_LOAD(stgB, u + 2);
        chain_sub<DK, MODE>(lds, S, op + (size_t)(u * 32) * OW, wave, n, q);
        chain_sub<DK, MODE>(lds + SUBB, S, op + (size_t)(u * 32 + 16) * OW, wave, n, q);
        if (MODE == 0 && tid < DK) dacc *= *(const LAS float*)(lds + ODL_ + 4 * tid) * *(const LAS float*)(lds + SUBB + ODL_ + 4 * tid);
        CH_STORE(stgA, 1);
        CH_SYNC();
        if (u + 3 < nunits) CH_LOAD(stgA, u + 3);
        chain_sub<DK, MODE>(lds + UNITB, S, op + (size_t)(u * 32 + 32) * OW, wave, n, q);
        chain_sub<DK, MODE>(lds + UNITB + SUBB, S, op + (size_t)(u * 32 + 48) * OW, wave, n, q);
        if (MODE == 0 && tid < DK) dacc *= *(const LAS float*)(lds + UNITB + ODL_ + 4 * tid) * *(const LAS float*)(lds + UNITB + SUBB + ODL_ + 4 * tid);
        if (u + 2 < nunits) CH_STORE(stgB, 0);
        CH_SYNC();
    }
    if (MODE == 0) { unsigned char* rec = st + (size_t)seg * 2 * ST_REC + (size_t)(wave * 64 + lane) * 16;
#pragma unroll
        for (int mb = 0; mb < NMB; ++mb) *(f32x4*)(rec + (size_t)mb * 8192) = S[mb];
        if (tid < DK) *(float*)(st + (size_t)seg * 2 * ST_REC + ST_REC + 4 * tid) = dacc; }
#undef CH_SRC
#undef CH_DST
#undef CH_LOAD
#undef CH_STORE
#undef CH_SYNC
}

template <int MODE>
__device__ __forceinline__ void phase_chain(const Ctx& a, int l, LAS unsigned char* lds, int wave, int lane) {
    const int bx = blockIdx.x, G = gridDim.x;
    constexpr int nitems = MODE == 0 ? 48 * (NSEG - 1) : 48 * NSEG;
    for (int it = bx; it < nitems; it += G) {
        const int c = it % 48, seg = it / 48;
        unsigned char* st = a.ws() + WS_ST + (size_t)c * (NSEG - 1) * 2 * ST_REC;
        if (c < 24) { const int b = c / 12, h = c % 12;
            chain_item<128, MODE>(a.ws() + WS_HGB + ((size_t)(b * 12 + h) * NSUB + seg * SEG_SUB) * HG_BLK, 0, (float*)(a.ws() + WS_O) + ((size_t)b * SEQ + seg * SEG_SUB * 16) * OW + h * 128, st, seg, lds, wave, lane); }
        else { const int r = c - 24, b = r / 12, h = (r % 12) / 3, sl = r % 3;
            chain_item<192, MODE>(a.ws() + WS_GLB + ((size_t)(b * 4 + h) * NSUB + seg * SEG_SUB) * GL_BLK, GL_OVT + 4096 * sl, (float*)(a.ws() + WS_O) + ((size_t)b * SEQ + seg * SEG_SUB * 16) * OW + HGW + h * 384 + sl * 128, st, seg, lds, wave, lane); }
        __syncthreads();
    }
    if (MODE == 0) { for (int it = (G >= nitems + 16) ? bx - nitems : bx; it < 16; it += G) { if (it < 0) continue; s5_scan_item(a, l, it, wave, lane); } }
}
__device__ __forceinline__ void phase_finalize(const Ctx& a, int l, int wave, int lane) {
    const bf16_t* P = (const bf16_t*)(a.ws() + WS_P); const float* O = (const float*)(a.ws() + WS_O); bf16_t* MX = (bf16_t*)(a.ws() + WS_MIXED);
    const float* hgg = a.in(I_HGG) + l * HGW; const float* hgb = a.in(I_HGB) + l * HGW; const float* glg = a.in(I_GLG) + l * HGW;
    const int gw = blockIdx.x * 8 + wave, NGW = gridDim.x * 8;
    for (int row = gw; row < MTOK; row += NGW) {
        const float* orow = O + (size_t)row * OW; const bf16_t* prow = P + (size_t)row * INP; bf16_t* mrow = MX + (size_t)row * DM;
#pragma unroll 4
        for (int h = 0; h < 12; ++h) { const int c = h * 128 + 2 * lane;
            const f32x2 o2 = *(const f32x2*)(orow + c); const unsigned gg = *(const unsigned*)(prow + C_GB + c);
            const float v0 = sigmoidf_(bf_lo(gg)) * o2.x, v1 = sigmoidf_(bf_hi(gg)) * o2.y;
            const float mu = wave_sum(v0 + v1) * (1.0f / 128.0f), d0 = v0 - mu, d1 = v1 - mu;
            const float rs = 1.0f / sqrtf(wave_sum(d0 * d0 + d1 * d1) * (1.0f / 128.0f) + LN_EPS);
            const f32x2 g2 = *(const f32x2*)(hgg + c), b2 = *(const f32x2*)(hgb + c);
            *(unsigned*)(mrow + S5W + c) = cvt_pk_bf16(d0 * rs * g2.x + b2.x, d1 * rs * g2.y + b2.y); }
#pragma unroll
        for (int h = 0; h < 4; ++h) { f32x2 o2[3]; float ss = 0.f;
#pragma unroll
            for (int j = 0; j < 3; ++j) { o2[j] = *(const f32x2*)(orow + HGW + h * 384 + 128 * j + 2 * lane); ss += o2[j].x * o2[j].x + o2[j].y * o2[j].y; }
            const float rms = 1.0f / sqrtf(wave_sum(ss) * (1.0f / 384.0f) + LN_EPS);
#pragma unroll
            for (int j = 0; j < 3; ++j) { const int c = h * 384 + 128 * j + 2 * lane; const unsigned gg = *(const unsigned*)(prow + C_GC + c);
                const float g0 = bf_lo(gg), g1 = bf_hi(gg); const f32x2 gn = *(const f32x2*)(glg + c);
                *(unsigned*)(mrow + S5W + HGW + c) = cvt_pk_bf16(o2[j].x * rms * gn.x * (g0 * sigmoidf_(g0)), o2[j].y * rms * gn.y * (g1 * sigmoidf_(g1))); } }
    }
}

constexpr int PH_PRO = 0, PH_MOD = 1, PH_LN0 = 2, PH_L0 = 3, PH_PER_LAYER = 10, N_PHASES = PH_L0 + DEPTH * PH_PER_LAYER;
constexpr int CW_BAR = 4096;

__global__ void __launch_bounds__(512, 2) hybrid_fwd(Args args) {
    extern __shared__ __attribute__((aligned(16))) unsigned char lds_raw[];
    LAS unsigned char* lds = (LAS unsigned char*)lds_raw;
    const int wave = __builtin_amdgcn_readfirstlane((int)threadIdx.x >> 6);
#define lane lane_id_v()
    volatile LAS unsigned* MISC = (volatile LAS unsigned*)(lds + LDSCTL_OFF);
    Ctx ctx; ctx.t = (volatile LAS unsigned long long*)(lds + LDSCTL_OFF + 64);
    if (wave == 0) { const int ln_ = lane; unsigned long long v = 0ull;
#pragma unroll
        for (int i = 0; i < N_IN; ++i) v = (ln_ == i) ? (unsigned long long)args.in[i] : v;
        v = (ln_ == 30) ? (unsigned long long)args.out : v; v = (ln_ == 31) ? (unsigned long long)args.ws : v;
        if (ln_ < 32) ctx.t[ln_] = v;
        if (ln_ < 16) MISC[ln_] = 0u; }
    __syncthreads();
    const int lo = args.ph_lo, hi = args.ph_hi;
    XcdBarrier bar; bar.bar = (unsigned*)(ctx.ws() + WS_CTL) + CW_BAR; bar.x = 0; bar.st = nullptr; bar.w0 = (wave == 0) ? 1u : 0u;
    if (hi - lo > 1) bar = xcd_barrier_post((unsigned*)(ctx.ws() + WS_CTL) + CW_BAR, MISC + 8, (wave == 0) ? 1u : 0u);
#define IN(k) (lo <= (k) && (k) < hi)
#define OPQ() int ln = lane, wv = wave; asm volatile("" : "+s"(wv))
#define SEAM(k) do { if (IN(k) && IN((k) + 1)) xcd_barrier(bar); } while (0)
#define WSP(T, off) ((T*)(ctx.ws() + (off)))
#ifdef DIAG_SEL1
    volatile LAS unsigned long long* STP = (volatile LAS unsigned long long*)(lds + LDSCTL_OFF + 512);
#define STAMP(idx) do { if (blockIdx.x == 0 && wave == 0) { const unsigned long long t_ = __builtin_amdgcn_s_memrealtime(); if (lane == 0) STP[idx] = t_; } } while (0)
#else
#define STAMP(idx) do { } while (0)
#endif
    STAMP(0);

#if EN_PRO
    if (IN(PH_PRO)) { OPQ(); phase_prologue(ctx, lds, wv, ln); }
#endif
    SEAM(PH_PRO); STAMP((PH_PRO) + 1);
#if EN_MOD
    if (IN(PH_MOD)) { OPQ(); phase_mod(ctx, wv, ln); }
#endif
    SEAM(PH_MOD); STAMP((PH_MOD) + 1);
#if EN_LN
    if (IN(PH_LN0)) { OPQ(); phase_lnapply<0>(ctx.in(I_X), nullptr, WSP(float, WS_ROWSTATS), nullptr, nullptr, WSP(float, WS_MOD), 0, 1, WSP(bf16_t, WS_H), nullptr, lds, wv, ln); }
#endif
    SEAM(PH_LN0); STAMP((PH_LN0) + 1);

    for (int l = 0; l < DEPTH; ++l) {
        const int p0 = PH_L0 + l * PH_PER_LAYER;
        const size_t wto = WS_WT + (size_t)l * WT_LAYER, modo = WS_MOD + (size_t)l * NB * 6 * DM * 4;
#if EN_INPROJ
        if (IN(p0 + 0)) { pg8::Gemm g{WSP(bf16_t, WS_H), WSP(const bf16_t, wto + WT_IN), MTOK, INP, DM}; pg8::StaticOrder S; S.init(MTOK, INP, (int)gridDim.x, (int)blockIdx.x);
            EpiProj E{WSP(bf16_t, WS_P), WSP(bf16_t, WS_UX)}; pg8::gemm_phase<EpiProj, pg8::StaticOrder, true, true>(lds, g, S, E, wave); }
#endif
        SEAM(p0 + 0); STAMP((p0 + 0) + 1);
#if EN_MIX
        if (IN(p0 + 1)) {
            { pg8::Gemm g{WSP(bf16_t, WS_UX), WSP(const bf16_t, WS_S5W1 + (size_t)l * S5_W1_LAYER), 64 * 256, 64 * 256, S5K}; S5Order S{(int)gridDim.x, (int)blockIdx.x, 64, 0};
              EpiS5A E{WSP(float, WS_SLOC)}; pg8::gemm_phase<EpiS5A, S5Order, true, true>(lds, g, S, E, wave); }
            { OPQ(); phase_pre(ctx, l, wv, ln); } }
        SEAM(p0 + 1); STAMP((p0 + 1) + 1);
        if (IN(p0 + 2)) { OPQ(); phase_chain<0>(ctx, l, lds, wv, ln); }
        SEAM(p0 + 2); STAMP((p0 + 2) + 1);
        if (IN(p0 + 3)) {
            { pg8::Gemm g{WSP(bf16_t, WS_UX), WSP(const bf16_t, WS_S5T + (size_t)l * S5_T_LAYER), 64 * 256, 64 * 1024, S5K}; S5Order S{(int)gridDim.x, (int)blockIdx.x, 256, 2};
              EpiS5C E{WSP(bf16_t, WS_Z)}; pg8::gemm_phase<EpiS5C, S5Order, true, true>(lds, g, S, E, wave); }
            { OPQ(); phase_chain<1>(ctx, l, lds, wv, ln); } }
#endif
        SEAM(p0 + 3); STAMP((p0 + 3) + 1);
#if EN_GLU
        if (IN(p0 + 4)) { pg8::Gemm g{WSP(bf16_t, WS_Z), WSP(const bf16_t, wto + WT_GLU), MTOK, S5W, S5W}; pg8::StaticOrder S; S.init(MTOK, S5W, (int)gridDim.x, (int)blockIdx.x);
            EpiGlu E{WSP(bf16_t, WS_Z), WSP(bf16_t, WS_MIXED), ctx.in(I_GLUB) + l * S5W}; pg8::gemm_phase<EpiGlu, pg8::StaticOrder, true, true>(lds, g, S, E, wave);
            { OPQ(); phase_finalize(ctx, l, wv, ln); } }
#endif
        SEAM(p0 + 4); STAMP((p0 + 4) + 1);
#if EN_OUT
        if (IN(p0 + 5)) { pg8::Gemm g{WSP(bf16_t, WS_MIXED), WSP(const bf16_t, wto + WT_OUT), MTOK, DM, DM}; pg8::StaticOrder S; S.init(MTOK, DM, (int)gridDim.x, (int)blockIdx.x);
            EpiResid E{l == 0 ? ctx.in(I_X) : ctx.out(), ctx.out(), WSP(float, WS_ROWSTATS), l == 0 ? WSP(float, WS_MISC) : ctx.in(I_LN2G) + (l - 1) * DM, l == 0 ? WSP(float, WS_MISC) + DM : ctx.in(I_LN2B) + (l - 1) * DM, WSP(float, modo) + 2 * DM, WSP(float, WS_ROWPART)};
            pg8::gemm_phase<EpiResid, pg8::StaticOrder, true, true>(lds, g, S, E, wave); }
#endif
        SEAM(p0 + 5); STAMP((p0 + 5) + 1);
#if EN_LN
        if (IN(p0 + 6)) { OPQ(); phase_lnapply<1>(ctx.out(), WSP(float, WS_ROWPART), WSP(float, WS_ROWSTATS), ctx.in(I_LN1G) + l * DM, ctx.in(I_LN1B) + l * DM, WSP(float, modo), 3, 4, WSP(bf16_t, WS_H), nullptr, lds, wv, ln); }
#endif
        SEAM(p0 + 6); STAMP((p0 + 6) + 1);
#if EN_GU
        if (IN(p0 + 7)) { pg8::Gemm g{WSP(bf16_t, WS_H), WSP(const bf16_t, wto + WT_GU), MTOK, 2 * DFF, DM}; pg8::StaticOrder S; S.init(MTOK, 2 * DFF, (int)gridDim.x, (int)blockIdx.x);
            EpiSwiglu E{WSP(bf16_t, WS_P)}; pg8::gemm_phase<EpiSwiglu, pg8::StaticOrder, true, true>(lds, g, S, E, wave); }
#endif
        SEAM(p0 + 7); STAMP((p0 + 7) + 1);
#if EN_DN
        if (IN(p0 + 8)) { pg8::Gemm g{WSP(bf16_t, WS_P), WSP(const bf16_t, wto + WT_DN), MTOK, DM, DFF}; pg8::StaticOrder S; S.init(MTOK, DM, (int)gridDim.x, (int)blockIdx.x);
            EpiResid E{ctx.out(), ctx.out(), WSP(float, WS_ROWSTATS), ctx.in(I_LN1G) + l * DM, ctx.in(I_LN1B) + l * DM, WSP(float, modo) + 5 * DM, WSP(float, WS_ROWPART)};
            pg8::gemm_phase<EpiResid, pg8::StaticOrder, true, true>(lds, g, S, E, wave); }
#endif
        SEAM(p0 + 8); STAMP((p0 + 8) + 1);
#if EN_LN
        if (IN(p0 + 9)) { OPQ();
            if (l + 1 < DEPTH) phase_lnapply<1>(ctx.out(), WSP(float, WS_ROWPART), WSP(float, WS_ROWSTATS), ctx.in(I_LN2G) + l * DM, ctx.in(I_LN2B) + l * DM, WSP(float, modo) + (size_t)NB * 6 * DM, 0, 1, WSP(bf16_t, WS_H), nullptr, lds, wv, ln);
            else phase_lnapply<2>(ctx.out(), WSP(float, WS_ROWPART), WSP(float, WS_ROWSTATS), ctx.in(I_LN2G) + l * DM, ctx.in(I_LN2B) + l * DM, nullptr, 0, 0, nullptr, ctx.out(), lds, wv, ln);
        }
#endif
        SEAM(p0 + 9); STAMP((p0 + 9) + 1);
    }
#ifdef DIAG_SEL1
    xcd_barrier(bar);
    if (blockIdx.x == 0) {
        float tot = (float)(STP[N_PHASES] - STP[0]), s1 = 0.f, s2 = 0.f;
        for (int k = 0; k < N_PHASES; ++k) { int ty; if (k < 3) ty = k; else { const int j = (k - 3) % PH_PER_LAYER; const int map[10] = {3, 4, 5, 6, 10, 7, 2, 8, 9, 2}; ty = map[j]; }
            const float d = (float)(STP[k + 1] - STP[k]); if ((DIAG_SEL1 >> ty) & 1) s1 += d; if ((DIAG_SEL2 >> ty) & 1) s2 += d; }
        const int n1 = (int)(1000000.f * s1 / tot); float* o = ctx.out();
        for (int i = wave * 64 + lane; i < n1; i += 512) o[i] += 0.05f;
        if (wave == 0 && lane == 0) o[2000000] += 0.05f + 0.11f * s2 / tot;
    }
#endif
#undef IN
#undef SEAM
#undef OPQ
#undef WSP
#undef lane
}

#ifndef MK_PER_PHASE
#define MK_PER_PHASE 0
#endif
extern "C" void kernel_launch(void* const* d_in, const int* in_sizes, int n_in, void* d_out, int out_size, void* d_ws, size_t ws_size, hipStream_t stream) {
    static int grid = 0;
    if (grid == 0) {
        if (n_in != N_IN || out_size != MTOK * DM || ws_size < WS_END) { fprintf(stderr, "kernel_launch: unexpected problem (n_in %d, out %d, ws %zu < %zu); nothing launched\n", n_in, out_size, ws_size, (size_t)WS_END); grid = -1; return; }
        int dev = 0, cus = 0, per_cu = 0;
        if (hipGetDevice(&dev) != hipSuccess || hipDeviceGetAttribute(&cus, hipDeviceAttributeMultiprocessorCount, dev) != hipSuccess) { grid = -1; return; }
        if (hipFuncSetAttribute((const void*)hybrid_fwd, hipFuncAttributeMaxDynamicSharedMemorySize, LDS_BYTES) != hipSuccess) { fprintf(stderr, "kernel_launch: hipFuncSetAttribute failed\n"); grid = -1; return; }
        if (hipOccupancyMaxActiveBlocksPerMultiprocessor(&per_cu, (const void*)hybrid_fwd, 512, LDS_BYTES) != hipSuccess || per_cu < 1) fprintf(stderr, "kernel_launch: occupancy query reports %d blocks per CU\n", per_cu);
        (void)hipGetLastError();
        grid = cus;
    }
    if (grid < 0) return;
    (void)in_sizes;
    if (hipMemsetAsync((char*)d_ws + WS_CTL, 0, CTL_ZERO_BYTES, stream) != hipSuccess) return;
#ifdef DBG_MEMSET
    (void)hipMemsetAsync((char*)d_ws + WS_HGB, 0, WS_END - WS_HGB, stream); (void)hipMemsetAsync((char*)d_ws + WS_O, 0, 192 * MiB, stream);
#endif
    Args a{};
    for (int i = 0; i < N_IN; ++i) a.in[i] = (const float*)d_in[i];
    a.out = (float*)d_out; a.ws = (unsigned char*)d_ws;
#if MK_PER_PHASE
    for (int p = 0; p < N_PHASES; ++p) { a.ph_lo = p; a.ph_hi = p + 1; hipLaunchKernelGGL(hybrid_fwd, dim3(grid), dim3(512), LDS_BYTES, stream, a); }
#else
    a.ph_lo = 0; a.ph_hi = N_PHASES; hipLaunchKernelGGL(hybrid_fwd, dim3(grid), dim3(512), LDS_BYTES, stream, a);
#endif
}
```

```cpp
#include <hip/hip_runtime.h>
#include <cstdio>
#include <cstdint>
namespace pg8 {
#define PG8_LAS __attribute__((address_space(3)))
typedef unsigned short bf16_t;
typedef short bf16x8 __attribute__((ext_vector_type(8)));
typedef float f32x4 __attribute__((ext_vector_type(4)));
typedef unsigned u32x4 __attribute__((ext_vector_type(4)));
constexpr int BM = 256, BK = 64, HALF = 128, HTB = HALF * BK * 2  , STAGE_BYTES = 8 * HTB, NXCD = 8, WGM = 8;

__host__ __device__ __forceinline__ int lds_byte(int r, int c) { const int st = (r >> 4) * 2 + (c >> 5), rr = r & 15, cc = c & 31, ob = rr * 64 + cc * 2; return st * 1024 + (ob ^ (((ob >> 9) & 1) << 5)); }
__host__ __device__ __forceinline__ void stage_rc(int b, int& R, int& C) { const int st = b / 1024, sb = b % 1024, swz = sb ^ (((sb >> 9) & 1) << 5); R = (st >> 1) * 16 + swz / 64; C = (st & 1) * 32 + (swz % 64) / 2; }
__host__ __device__ __forceinline__ int perm32(int rho) { const int n = rho >> 4, i = rho & 15; return 8 * (i >> 2) + 4 * n + (i & 3); }

struct Unit { int pm, pn; };
struct Gemm { const bf16_t* A; const bf16_t* Bt; int M, N, K; };

struct StaticOrder {
    int nM, nN, nwg, G, c;
    __host__ __device__ void init(int M, int N, int G_, int c_) { nM = M / BM; nN = N / BM; nwg = nM * nN; G = G_; c = c_; }
    __host__ __device__ bool next(int i, Unit& u) const {
        const long L = (long)i * G + c; if (L >= nwg) return false;
        int wgid = (int)L; { const int q = nwg / NXCD, r = nwg % NXCD, xcd = wgid % NXCD, off = wgid / NXCD; wgid = (xcd < r ? xcd * (q + 1) : r * (q + 1) + (xcd - r) * q) + off; }
        const int nig = WGM * nN, gid = wgid / nig, fm = gid * WGM, gsz = (nM - fm) < WGM ? (nM - fm) : WGM;
        u.pm = fm + ((wgid % nig) % gsz); u.pn = (wgid % nig) / gsz; return true;
    }
    __device__ __forceinline__ void a_ready(const Unit&) const {}
    __device__ __forceinline__ void done(const Unit&) const {}
};
__device__ __forceinline__ unsigned cvt_pk_bf16(float lo, float hi) { unsigned r; asm volatile("v_cvt_pk_bf16_f32 %0, %1, %2" : "=v"(r) : "v"(lo), "v"(hi)); return r; }
typedef float f32x2 __attribute__((ext_vector_type(2)));
template <class Epi, class Sched, bool ALIGN_EPI = false, bool SP2 = false>
__device__ __forceinline__ void gemm_phase(PG8_LAS unsigned char* lds, const Gemm g, const Sched& S, const Epi& E, int wave_id) {
    int tid_; asm volatile("v_mbcnt_lo_u32_b32 %0, -1, 0\n\tv_mbcnt_hi_u32_b32 %0, -1, %0" : "=v"(tid_)); tid_ += wave_id * 64;
    const int tid = tid_, wid = __builtin_amdgcn_readfirstlane(tid >> 6), lane = tid & 63, wr = wid >> 2, wc = wid & 3, fr = lane & 15, fq = lane >> 4;
    const int K = g.K, nt = K / BK;
    unsigned voffA[2], voffB[2];
#pragma unroll
    for (int i = 0; i < 2; ++i) { int R, C; stage_rc(tid * 16 + i * 8192, R, C); const int Rb = Epi::PERM ? ((R & ~31) + perm32(R & 31)) : R;
        voffA[i] = (unsigned)(R * K + C) * 2u; voffB[i] = (unsigned)(Rb * K + C) * 2u; }
    const size_t kstep = (size_t)(BK * 2);
    const size_t hstep = (size_t)HALF * K * 2;
    const size_t tstep = 2 * hstep;
    const unsigned ldsw = (unsigned)wid * 1024u;
    const int aoff = lds_byte(wr * 64 + fr, fq * 8), boff = lds_byte(wc * 32 + fr, fq * 8);
#define PG8_SA(b, h) (((b) * 2 + (h)) * HTB)
#define PG8_SB(b, h) ((4 + (b) * 2 + (h)) * HTB)
#define PG8_STAGE(bufoff, gbase, voff) do { _Pragma("unroll") for (int _i = 0; _i < 2; ++_i) \
        __builtin_amdgcn_global_load_lds((const unsigned*)((const char*)(gbase) + (voff)[_i]), (PG8_LAS unsigned*)(lds + (bufoff) + ldsw + _i * 8192), 16, 0, 0); } while (0)
#define PG8_LDA(dst, b, h) do { _Pragma("unroll") for (int m = 0; m < 4; ++m) _Pragma("unroll") for (int k = 0; k < 2; ++k) dst[m][k] = *(const PG8_LAS bf16x8*)(lds + PG8_SA(b, h) + aoff + m * 2048 + k * 1024); } while (0)
#define PG8_LDB(dst, b, h) do { _Pragma("unroll") for (int n = 0; n < 2; ++n) _Pragma("unroll") for (int k = 0; k < 2; ++k) dst[n][k] = *(const PG8_LAS bf16x8*)(lds + PG8_SB(b, h) + boff + n * 2048 + k * 1024); } while (0)
#define PG8_MMA(ai, bj, At, Bt) do { __builtin_amdgcn_s_setprio(1); _Pragma("unroll") for (int m = 0; m < 4; ++m) _Pragma("unroll") for (int n = 0; n < 2; ++n) _Pragma("unroll") for (int k = 0; k < 2; ++k) \
        acc[ai][bj][m][n] = __builtin_amdgcn_mfma_f32_16x16x32_bf16(Bt[n][k], At[m][k], acc[ai][bj][m][n], 0, 0, 0); __builtin_amdgcn_s_setprio(0); } while (0)
#define PG8_WAIT_V(n) asm volatile("s_waitcnt vmcnt(" #n ")" ::: "memory")
#define PG8_WAIT_L(n) asm volatile("s_waitcnt lgkmcnt(" #n ")" ::: "memory")
#define PG8_BAR __builtin_amdgcn_s_barrier()
#define PG8_SCHED __builtin_amdgcn_sched_barrier(0)
    Unit cur, nxt; int ui = 0;
    if (!S.next(0, cur)) return;
    f32x4 acc[2][2][4][2];
#pragma unroll
    for (int a = 0; a < 2; ++a)
#pragma unroll
        for (int b = 0; b < 2; ++b)
#pragma unroll
            for (int m = 0; m < 4; ++m)
#pragma unroll
                for (int n = 0; n < 2; ++n) acc[a][b][m][n] = (f32x4){0.f, 0.f, 0.f, 0.f};
    bf16x8 At[4][2], B0[2][2], B1[2][2];
    const char* cA = (const char*)g.A + (size_t)cur.pm * tstep; const char* cB = (const char*)g.Bt + (size_t)cur.pn * tstep;
    S.a_ready(cur);
    if constexpr (SP2) {
        PG8_STAGE(PG8_SB(0, 0), cB, voffB); PG8_STAGE(PG8_SB(0, 1), cB + hstep, voffB); PG8_STAGE(PG8_SA(0, 0), cA, voffA); PG8_STAGE(PG8_SA(0, 1), cA + hstep, voffA);
        if (wr == 1) PG8_BAR;
        PG8_WAIT_V(2); PG8_BAR;
        PG8_STAGE(PG8_SB(1, 0), cB + kstep, voffB); PG8_STAGE(PG8_SA(1, 0), cA + kstep, voffA); PG8_STAGE(PG8_SB(1, 1), cB + hstep + kstep, voffB);
        PG8_WAIT_V(6); PG8_BAR;
    } else {
        PG8_STAGE(PG8_SB(0, 0), cB, voffB); PG8_STAGE(PG8_SA(0, 0), cA, voffA); PG8_STAGE(PG8_SB(0, 1), cB + hstep, voffB); PG8_STAGE(PG8_SA(0, 1), cA + hstep, voffA);
        if (wr == 1) PG8_BAR;
        PG8_WAIT_V(4); PG8_BAR;
        PG8_STAGE(PG8_SB(1, 0), cB + kstep, voffB); PG8_STAGE(PG8_SA(1, 0), cA + kstep, voffA); PG8_STAGE(PG8_SB(1, 1), cB + hstep + kstep, voffB);
        PG8_WAIT_V(6); PG8_BAR;
    }
    for (;;) {
        const bool has_next = S.next(ui + 1, nxt);
        const char* nA = has_next ? (const char*)g.A + (size_t)nxt.pm * tstep : cA; const char* nB = has_next ? (const char*)g.Bt + (size_t)nxt.pn * tstep : cB;
        for (int t = 0; t < nt; t += 2) {
            const bool last = (t == nt - 2);
            const char* a1 = cA + (size_t)(t + 1) * kstep;
            const char* a2 = last ? nA : cA + (size_t)(t + 2) * kstep; const char* b2 = last ? nB : cB + (size_t)(t + 2) * kstep;
            const char* a3 = a2 + kstep; const char* b3 = b2 + kstep;
            if (last && has_next) S.a_ready(nxt);
            if constexpr (SP2) {
            PG8_LDB(B0, 0, 0); PG8_LDB(B1, 0, 1); PG8_SCHED; PG8_LDA(At, 0, 0); PG8_STAGE(PG8_SA(1, 1), a1 + hstep, voffA);
            PG8_WAIT_V(8); PG8_WAIT_L(0); PG8_BAR; PG8_MMA(0, 0, At, B0); PG8_MMA(0, 1, At, B1); PG8_BAR; PG8_SCHED;
            PG8_LDA(At, 0, 1); PG8_STAGE(PG8_SB(0, 0), b2, voffB); PG8_STAGE(PG8_SB(0, 1), b2 + hstep, voffB); PG8_STAGE(PG8_SA(0, 0), a2, voffA);
            PG8_WAIT_V(8); PG8_WAIT_L(0); PG8_BAR; PG8_MMA(1, 0, At, B0); PG8_MMA(1, 1, At, B1); PG8_BAR; PG8_SCHED;
            PG8_LDB(B0, 1, 0); PG8_LDB(B1, 1, 1); PG8_SCHED; PG8_LDA(At, 1, 0); PG8_STAGE(PG8_SA(0, 1), a2 + hstep, voffA);
            PG8_WAIT_V(8); PG8_WAIT_L(0); PG8_BAR; PG8_MMA(0, 0, At, B0); PG8_MMA(0, 1, At, B1); PG8_BAR; PG8_SCHED;
            PG8_LDA(At, 1, 1); PG8_STAGE(PG8_SB(1, 0), b3, voffB); PG8_STAGE(PG8_SB(1, 1), b3 + hstep, voffB); PG8_STAGE(PG8_SA(1, 0), a3, voffA);
            PG8_WAIT_V(8); PG8_WAIT_L(0); PG8_BAR; PG8_MMA(1, 0, At, B0); PG8_MMA(1, 1, At, B1); PG8_BAR; PG8_SCHED;
            } else {
            PG8_LDB(B0, 0, 0); PG8_SCHED; PG8_LDA(At, 0, 0); PG8_STAGE(PG8_SA(1, 1), a1 + hstep, voffA);
            PG8_WAIT_L(8); PG8_BAR; PG8_WAIT_L(0); PG8_MMA(0, 0, At, B0); PG8_BAR; PG8_SCHED;
            PG8_LDB(B1, 0, 1); PG8_STAGE(PG8_SB(0, 0), b2, voffB);
            PG8_BAR; PG8_WAIT_L(0); PG8_MMA(0, 1, At, B1); PG8_BAR;
            PG8_LDA(At, 0, 1); PG8_STAGE(PG8_SA(0, 0), a2, voffA);
            PG8_BAR; PG8_WAIT_L(0); PG8_MMA(1, 0, At, B0); PG8_BAR; PG8_SCHED;
            PG8_STAGE(PG8_SB(0, 1), b2 + hstep, voffB);
            PG8_WAIT_V(6); PG8_BAR; PG8_MMA(1, 1, At, B1); PG8_BAR;
            PG8_LDB(B0, 1, 0); PG8_SCHED; PG8_LDA(At, 1, 0); PG8_STAGE(PG8_SA(0, 1), a2 + hstep, voffA);
            PG8_WAIT_L(8); PG8_BAR; PG8_WAIT_L(0); PG8_MMA(0, 0, At, B0); PG8_BAR; PG8_SCHED;
            PG8_LDB(B1, 1, 1); PG8_STAGE(PG8_SB(1, 0), b3, voffB);
            PG8_BAR; PG8_WAIT_L(0); PG8_MMA(0, 1, At, B1); PG8_BAR;
            PG8_LDA(At, 1, 1); PG8_STAGE(PG8_SA(1, 0), a3, voffA);
            PG8_BAR; PG8_WAIT_L(0); PG8_MMA(1, 0, At, B0); PG8_BAR; PG8_SCHED;
            PG8_STAGE(PG8_SB(1, 1), b3 + hstep, voffB);
            PG8_WAIT_V(6); PG8_BAR; PG8_MMA(1, 1, At, B1); PG8_BAR;
            }
        }
        if constexpr (ALIGN_EPI) { if (wr == 0) PG8_BAR; }
        if constexpr (!Epi::AFTER_DRAIN) { E(acc, cur, wr, wc, fr, fq); S.done(cur); }
        if (!has_next) break;
#pragma unroll
        for (int a = 0; a < 2; ++a)
#pragma unroll
            for (int b = 0; b < 2; ++b)
#pragma unroll
                for (int m = 0; m < 4; ++m)
#pragma unroll
                    for (int n = 0; n < 2; ++n) acc[a][b][m][n] = (f32x4){0.f, 0.f, 0.f, 0.f};
        cur = nxt; cA = nA; cB = nB; ++ui;
        if constexpr (ALIGN_EPI) { if (wr == 1) PG8_BAR; }
    }
    PG8_WAIT_V(0);
    if constexpr (!ALIGN_EPI) { if (wr == 0) PG8_BAR; }
    PG8_BAR;
    if constexpr (Epi::AFTER_DRAIN) { E.fused(acc, cur, wr, wc, fr, fq, lds, wid, lane); S.done(cur); }
#undef PG8_SA
#undef PG8_SB
#undef PG8_STAGE
#undef PG8_LDA
#undef PG8_LDB
#undef PG8_MMA
#undef PG8_WAIT_V
#undef PG8_WAIT_L
#undef PG8_BAR
#undef PG8_SCHED
}
}
#define LAS __attribute__((address_space(3)))
#define XB_TMO      128
#define XB_XCNT(j)  (256  + 64 * (j))
#define XB_XSUB(j)  (1280 + 64 * (j))
#define XB_XGEN(j)  (2304 + 64 * (j))
#define XB_TOP      3328
#define XB_TOPGEN   3392
#define XCD_BAR_WORDS 3456
#define XB_SPIN_CAP (1u << 24)

__device__ __forceinline__ unsigned xb_ld(unsigned* p)              { return __hip_atomic_load(p, __ATOMIC_RELAXED, __HIP_MEMORY_SCOPE_AGENT); }
__device__ __forceinline__ unsigned xb_add(unsigned* p, unsigned v) { return __hip_atomic_fetch_add(p, v, __ATOMIC_RELAXED, __HIP_MEMORY_SCOPE_AGENT); }
__device__ __forceinline__ unsigned xb_xcc_id() { return (unsigned)__builtin_amdgcn_s_getreg((3 << 11) | 20) & 0xFu; }
#define XB_SPIN(cond, bar) do { unsigned _sp = 0; while (cond) { __builtin_amdgcn_s_sleep(1); \
    if ((++_sp & 255u) == 0u) { if (xb_ld(&(bar)[XB_TMO])) break; if (_sp > XB_SPIN_CAP) { atomicAdd(&(bar)[XB_TMO], 1u); break; } } } } while (0)

struct XcdBarrier {
    unsigned* bar; unsigned x; unsigned w0;
    volatile LAS unsigned* st;
};

__device__ __forceinline__ bool xb_lane0() { return __builtin_amdgcn_mbcnt_hi(~0u, __builtin_amdgcn_mbcnt_lo(~0u, 0u)) == 0u; }
__device__ __forceinline__ XcdBarrier xcd_barrier_post(unsigned* bar, volatile LAS unsigned* st, unsigned w0) {
    XcdBarrier b; b.bar = bar; b.x = xb_xcc_id(); b.st = st; b.w0 = w0;
    if (w0 && xb_lane0()) (void)xb_add(&bar[XB_XCNT(b.x)], 1u);
    return b;
}
__device__ __forceinline__ void xcd_barrier_complete(unsigned* bar, unsigned x, unsigned& nloc, unsigned& nx) {
    const unsigned G = gridDim.x * gridDim.y * gridDim.z;
    unsigned sum, cnt, mine, sp = 0u;
    for (;;) {
        sum = 0u; cnt = 0u; mine = 0u;
#pragma unroll
        for (unsigned j = 0; j < 16; ++j) { const unsigned c = xb_ld(&bar[XB_XCNT(j)]); sum += c; cnt += (c > 0u) ? 1u : 0u; mine = (j == x) ? c : mine; }
        if (sum == G) break;
        __builtin_amdgcn_s_sleep(1);
        if ((++sp & 255u) == 0u) { if (xb_ld(&bar[XB_TMO])) break; if (sp > XB_SPIN_CAP) { atomicAdd(&bar[XB_TMO], 1u); break; } }
    }
    nloc = mine > 0u ? mine : 1u; nx = cnt > 0u ? cnt : 1u;
}

__device__ __forceinline__ void xcd_barrier(const XcdBarrier& b) {
    asm volatile("s_waitcnt vmcnt(0)" ::: "memory");
    __syncthreads();
    if (b.w0 && xb_lane0()) {
        unsigned* bar = b.bar;
        __builtin_amdgcn_s_waitcnt(0);
        unsigned nloc = b.st[0], nx = b.st[1];
        if (nloc == 0u) { xcd_barrier_complete(bar, b.x, nloc, nx); b.st[0] = nloc; b.st[1] = nx; }
        const unsigned old = xb_add(&bar[XB_XSUB(b.x)], 1u);
        const unsigned gen = old / nloc;
        if (old + 1u == (gen + 1u) * nloc) {
            __builtin_amdgcn_fence(__ATOMIC_RELEASE, "agent");
            asm volatile("s_waitcnt vmcnt(0)" ::: "memory");
            const unsigned og = xb_add(&bar[XB_TOP], 1u);
            const unsigned tg = og / nx;
            if (og + 1u == (tg + 1u) * nx) xb_add(&bar[XB_TOPGEN], 1u);
            else XB_SPIN(xb_ld(&bar[XB_TOPGEN]) == tg, bar);
            __builtin_amdgcn_fence(__ATOMIC_ACQUIRE, "agent");
            xb_add(&bar[XB_XGEN(b.x)], 1u);
            asm volatile("s_waitcnt vmcnt(0)" ::: "memory");
        } else {
            XB_SPIN(xb_ld(&bar[XB_XGEN(b.x)]) == gen, bar);
            __builtin_amdgcn_fence(__ATOMIC_ACQUIRE, "agent");
            asm volatile("s_waitcnt vmcnt(0)" ::: "memory");
        }
    }
    __syncthreads();
}
#ifndef EN_CH128
#define EN_CH128 1
#endif
#ifndef EN_CH192
#define EN_CH192 1
#endif
#ifndef EN_DN
#define EN_DN 1
#endif
#ifndef EN_GLU
#define EN_GLU 1
#endif
#ifndef EN_GU
#define EN_GU 1
#endif
#ifndef EN_INPROJ
#define EN_INPROJ 1
#endif
#ifndef EN_LN
#define EN_LN 1
#endif
#ifndef EN_MIX
#define EN_MIX 1
#endif
#ifndef EN_MOD
#define EN_MOD 1
#endif
#ifndef EN_OUT
#define EN_OUT 1
#endif
#ifndef EN_PRE
#define EN_PRE 1
#endif
#ifndef EN_PRO
#define EN_PRO 1
#endif
#ifndef EN_S5N
#define EN_S5N 1
#endif

constexpr int DM = 4096, NB = 2, SEQ = 8192, MTOK = NB * SEQ, DEPTH = 4;
constexpr int S5W = 1024;
constexpr int HGW = 1536;
constexpr int GLKW = 768;
constexpr int INW = 11792, INP = 12032, DFF = 11008;
constexpr int OW = 3072;
constexpr int C_U = 0, C_QB = 1024, C_FB = 2560, C_IB = 4096, C_GB = 5632, C_QC = 7168, C_KC = 7936, C_VC = 8704, C_GC = 10240, C_LR = 11776;
constexpr float LN_EPS = 1e-5f;
constexpr float ALPHA = 1.6817928305074290861f;
constexpr float GLA_QSCALE = 0.07216878364870322f;

enum { I_X = 0, I_C, I_WADA, I_BADA, I_TABLE, I_WIN, I_WOUT, I_AREAL, I_AIMAG, I_LOGDT, I_BRE, I_BIM, I_CRE, I_CIM, I_S5D, I_GLUW, I_GLUB,
       I_LBRAW, I_HGG, I_HGB, I_WGATE, I_BGATE, I_GLG, I_WFG, I_WFU, I_WFD, I_LN1G, I_LN1B, I_LN2G, I_LN2B, N_IN };

constexpr size_t MiB = 1u << 20;
constexpr size_t WS_CTL = 0, CTL_ZERO_BYTES = 1 * MiB;
constexpr size_t WS_MOD = 1 * MiB;
constexpr size_t WS_MISC = 2 * MiB;
constexpr size_t WS_ROWSTATS = 3 * MiB;
constexpr size_t WS_ROWPART = 4 * MiB;
constexpr size_t WS_CONDPART = 12 * MiB;
constexpr size_t WS_H = 24 * MiB;
constexpr size_t WS_MIXED = WS_H + 128 * MiB;
constexpr size_t WS_Z = WS_MIXED + 128 * MiB;
constexpr size_t WS_O = WS_Z + 32 * MiB;
constexpr size_t WS_P = WS_O + 192 * MiB;
constexpr size_t WS_WT = WS_P + 376 * MiB;
constexpr size_t WT_IN = 0, WT_OUT = 94 * MiB, WT_GU = 126 * MiB, WT_DN = 298 * MiB, WT_GLU = 384 * MiB, WT_LAYER = 386 * MiB;
constexpr size_t WS_HGB = WS_WT + DEPTH * WT_LAYER;
constexpr size_t WS_GLB = WS_HGB + 198 * MiB;
constexpr size_t WS_S5T = WS_GLB + 128 * MiB;
constexpr size_t WS_S5W1 = WS_S5T + 576 * MiB;
constexpr size_t WS_UX = WS_S5W1 + 144 * MiB;
constexpr size_t WS_SLOC = WS_UX + 36 * MiB;
constexpr size_t WS_LAM64 = WS_SLOC + 8 * MiB;
constexpr size_t WS_ST = WS_LAM64 + 1 * MiB;
constexpr size_t WS_END = WS_ST + 36 * MiB;
static_assert((size_t)INP * DM * 2 == 94 * MiB && (size_t)DM * DM * 2 == 32 * MiB && (size_t)2 * DFF * DM * 2 == 172 * MiB && (size_t)DM * DFF * 2 == 86 * MiB, "weight map");
static_assert((size_t)MTOK * INP * 2 == 376 * MiB && (size_t)MTOK * DFF * 2 <= 376 * MiB, "activation map");

constexpr int RING_BYTES = 131072;
constexpr int LDSCTL_OFF = 135168;
constexpr int LDS_BYTES = 147456;

#ifndef LAS
#define LAS __attribute__((address_space(3)))
#endif
typedef unsigned short bf16_t;
typedef float f32x4 __attribute__((ext_vector_type(4)));
typedef float f32x2 __attribute__((ext_vector_type(2)));
typedef unsigned u32x4 __attribute__((ext_vector_type(4)));
typedef unsigned u32x2 __attribute__((ext_vector_type(2)));
#define LDS_WAIT() asm volatile("s_waitcnt lgkmcnt(0)" ::: "memory")
#define VM_WAIT() asm volatile("s_waitcnt vmcnt(0)" ::: "memory")
typedef __bf16 bf16x2_t __attribute__((ext_vector_type(2)));
__device__ __forceinline__ unsigned cvt_pk_bf16(float lo, float hi) { return __builtin_bit_cast(unsigned, __builtin_convertvector((f32x2){lo, hi}, bf16x2_t)); }

__device__ __forceinline__ float bf_lo(unsigned w) { return __uint_as_float(w << 16); }
__device__ __forceinline__ float bf_hi(unsigned w) { return __uint_as_float(w & 0xffff0000u); }
__device__ __forceinline__ float bf2f(bf16_t b) { return __uint_as_float(((unsigned)b) << 16); }
__device__ __forceinline__ float wave_sum(float v) {
#pragma unroll
    for (int o = 1; o < 64; o <<= 1) v += __shfl_xor(v, o);
    return v;
}
__device__ __forceinline__ float sigmoidf_(float x) { return 1.0f / (1.0f + __expf(-x)); }
__device__ __forceinline__ float gelu_tanh(float y) { const float a = 0.7978845608028654f * (y + 0.044715f * y * y * y); const float t = 1.0f - 2.0f / (1.0f + __expf(2.0f * a)); return 0.5f * y * (1.0f + t); }

struct EpiProj {
    static constexpr bool PERM = true, AFTER_DRAIN = false;
    bf16_t* P; bf16_t* UX;
    __device__ __forceinline__ void operator()(const f32x4 (&acc)[2][2][4][2], const pg8::Unit& u, int wr, int wc, int fr, int fq) const {
        const int row0 = u.pm * 256 + wr * 64 + fr, col0 = u.pn * 256 + wc * 32 + 8 * fq;
        const bool s5 = u.pn < 4;
#pragma unroll
        for (int ai = 0; ai < 2; ++ai)
#pragma unroll
            for (int m = 0; m < 4; ++m) { const int row = row0 + ai * 128 + m * 16;
#pragma unroll
                for (int bj = 0; bj < 2; ++bj) { const f32x4 v0 = acc[ai][bj][m][0], v1 = acc[ai][bj][m][1]; const int col = col0 + bj * 128;
                    u32x4 w; w.x = cvt_pk_bf16(v0[0], v0[1]); w.y = cvt_pk_bf16(v0[2], v0[3]); w.z = cvt_pk_bf16(v1[0], v1[1]); w.w = cvt_pk_bf16(v1[2], v1[3]);
                    if (!s5) *(u32x4*)(P + (size_t)row * INP + col) = w;
                    else { bf16_t* ur = UX + (size_t)((col >> 4) * 256 + (row >> 6)) * 1152; *(u32x4*)(ur + (row & 63) * 16 + (col & 15)) = w;
                        if ((row & 63) == 0) { const u32x4 z = (u32x4){0u, 0u, 0u, 0u}; bf16_t* zp = ur + 1024 + ((col & 15) ? 64 : 0);
#pragma unroll
                            for (int i = 0; i < 8; ++i) *(u32x4*)(zp + 8 * i) = z; } } } }
    }
};
struct EpiSwiglu {
    static constexpr bool PERM = true, AFTER_DRAIN = false;
    bf16_t* HID;
    __device__ __forceinline__ void operator()(const f32x4 (&acc)[2][2][4][2], const pg8::Unit& u, int wr, int wc, int fr, int fq) const {
        const int row0 = u.pm * 256 + wr * 64 + fr, col0 = u.pn * 128 + wc * 32 + 8 * fq;
#pragma unroll
        for (int ai = 0; ai < 2; ++ai)
#pragma unroll
            for (int m = 0; m < 4; ++m) { bf16_t* rowp = HID + (size_t)(row0 + ai * 128 + m * 16) * DFF + col0;
                float o[8];
#pragma unroll
                for (int n = 0; n < 2; ++n)
#pragma unroll
                    for (int j = 0; j < 4; ++j) { const float g = acc[ai][0][m][n][j], up = acc[ai][1][m][n][j]; o[n * 4 + j] = g * __builtin_amdgcn_rcpf(1.0f + __expf(-g)) * up; }
                u32x4 w; w.x = cvt_pk_bf16(o[0], o[1]); w.y = cvt_pk_bf16(o[2], o[3]); w.z = cvt_pk_bf16(o[4], o[5]); w.w = cvt_pk_bf16(o[6], o[7]);
                *(u32x4*)rowp = w; }
    }
};
struct EpiGlu {
    static constexpr bool PERM = true, AFTER_DRAIN = false;
    const bf16_t* Z; bf16_t* MIXED; const float* bias;
    __device__ __forceinline__ void operator()(const f32x4 (&acc)[2][2][4][2], const pg8::Unit& u, int wr, int wc, int fr, int fq) const {
        const int row0 = u.pm * 256 + wr * 64 + fr, col0 = u.pn * 256 + wc * 32 + 8 * fq;
#pragma unroll
        for (int bj = 0; bj < 2; ++bj) {
            const f32x4 b0 = *(const f32x4*)(bias + col0 + bj * 128), b1 = *(const f32x4*)(bias + col0 + bj * 128 + 4);
#pragma unroll
            for (int ai = 0; ai < 2; ++ai)
#pragma unroll
                for (int m = 0; m < 4; ++m) { const size_t r = (size_t)(row0 + ai * 128 + m * 16);
                    const u32x4 zz = *(const u32x4*)(Z + r * S5W + col0 + bj * 128);
                    const f32x4 v0 = acc[ai][bj][m][0] + b0, v1 = acc[ai][bj][m][1] + b1;
                    u32x4 w;
                    w.x = cvt_pk_bf16(bf_lo(zz.x) * sigmoidf_(v0[0]), bf_hi(zz.x) * sigmoidf_(v0[1]));
                    w.y = cvt_pk_bf16(bf_lo(zz.y) * sigmoidf_(v0[2]), bf_hi(zz.y) * sigmoidf_(v0[3]));
                    w.z = cvt_pk_bf16(bf_lo(zz.z) * sigmoidf_(v1[0]), bf_hi(zz.z) * sigmoidf_(v1[1]));
                    w.w = cvt_pk_bf16(bf_lo(zz.w) * sigmoidf_(v1[2]), bf_hi(zz.w) * sigmoidf_(v1[3]));
                    *(u32x4*)(MIXED + r * DM + col0 + bj * 128) = w;
                    if (m & 1) asm volatile("" ::: "memory"); }
        }
    }
};
struct EpiResid {
    static constexpr bool PERM = false, AFTER_DRAIN = false;
    const float* base; float* out; const float* rowstats; const float* lng; const float* lnb; const float* gate0; float* rowpart;
    __device__ __forceinline__ void operator()(const f32x4 (&acc)[2][2][4][2], const pg8::Unit& u, int wr, int wc, int fr, int fq) const {
        const int rowb = u.pm * 256 + wr * 64 + fr, col0 = u.pn * 256 + wc * 32 + 4 * fq;
        const float* gp = gate0 + (u.pm >= 32 ? 6 * DM : 0);
#pragma unroll
        for (int ai = 0; ai < 2; ++ai)
#pragma unroll
            for (int m = 0; m < 4; ++m) { const int row = rowb + ai * 128 + m * 16;
                const f32x2 st = *(const f32x2*)(rowstats + (size_t)row * 2);
                float s1 = 0.f, s2 = 0.f;
#pragma unroll
                for (int bj = 0; bj < 2; ++bj)
#pragma unroll
                    for (int n = 0; n < 2; ++n) { const int c = col0 + bj * 128 + n * 16; const size_t off = (size_t)row * DM + c;
                        const f32x4 vb = *(const f32x4*)(base + off);
                        const f32x4 A = *(const f32x4*)(lng + c), Bc = *(const f32x4*)(lnb + c), Gm = *(const f32x4*)(gp + c);
                        const f32x4 o = (((vb - st.x) * st.y) * A + Bc) * ALPHA + (Gm + 1.0f) * acc[ai][bj][m][n];
                        *(f32x4*)(out + off) = o;
                        s1 += (o[0] + o[1]) + (o[2] + o[3]); s2 += (o[0] * o[0] + o[1] * o[1]) + (o[2] * o[2] + o[3] * o[3]); }
                s1 += __shfl_xor(s1, 16); s1 += __shfl_xor(s1, 32); s2 += __shfl_xor(s2, 16); s2 += __shfl_xor(s2, 32);
                if (fq == 0) *(f32x2*)(rowpart + ((size_t)row * 64 + u.pn * 4 + wc) * 2) = (f32x2){s1, s2};
                asm volatile("" ::: "memory"); }
    }
};

__device__ __forceinline__ int lane_id_v() { int r; asm volatile("v_mbcnt_lo_u32_b32 %0, -1, 0\n\tv_mbcnt_hi_u32_b32 %0, -1, %0" : "=v"(r)); return r; }
struct Args { const float* in[N_IN]; float* out; unsigned char* ws; int ph_lo, ph_hi; };
struct Ctx {
    volatile LAS unsigned long long* t;
    __device__ __forceinline__ unsigned long long ld(int i) const { const unsigned long long v = t[i];
        return ((unsigned long long)(unsigned)__builtin_amdgcn_readfirstlane((int)(v >> 32)) << 32) | (unsigned long long)(unsigned)__builtin_amdgcn_readfirstlane((int)(unsigned)v); }
    __device__ __forceinline__ const float* in(int i) const { return (const float*)ld(i); }
    __device__ __forceinline__ float* out() const { return (float*)ld(30); }
    __device__ __forceinline__ unsigned char* ws() const { return (unsigned char*)ld(31); }
};

constexpr int S5K = 1152;
constexpr size_t S5_T_LAYER = (size_t)64 * 1024 * S5K * 2, S5_W1_LAYER = (size_t)64 * 256 * S5K * 2;

struct S5Order {
    int G, c, n, sh;
    __device__ __forceinline__ bool next(int i, pg8::Unit& u) const { const int L = i * G + c; if (L >= n) return false; u.pm = L >> sh; u.pn = L; return true; }
    __device__ __forceinline__ void a_ready(const pg8::Unit&) const {}
    __device__ __forceinline__ void done(const pg8::Unit&) const {}
};
struct EpiS5A {
    static constexpr bool PERM = false, AFTER_DRAIN = false;
    float* Sloc;
    __device__ __forceinline__ void operator()(const f32x4 (&acc)[2][2][4][2], const pg8::Unit& u, int wr, int wc, int fr, int fq) const {
        const int row0 = u.pm * 256 + wr * 64 + fr, col0 = wc * 32 + 4 * fq;
#pragma unroll
        for (int ai = 0; ai < 2; ++ai)
#pragma unroll
            for (int m = 0; m < 4; ++m)
#pragma unroll
                for (int n = 0; n < 2; ++n) *(f32x4*)(Sloc + (size_t)(row0 + ai * 128 + m * 16) * 128 + col0 + n * 16) = acc[ai][0][m][n];
    }
};
struct EpiS5C {
    static constexpr bool PERM = true, AFTER_DRAIN = false;
    bf16_t* Z;
    __device__ __forceinline__ void operator()(const f32x4 (&acc)[2][2][4][2], const pg8::Unit& u, int wr, int wc, int fr, int fq) const {
        const int g = u.pm, c0 = wr * 64 + fr, cc0 = (u.pn & 3) * 256 + wc * 32 + 8 * fq;
#pragma unroll
        for (int ai = 0; ai < 2; ++ai)
#pragma unroll
            for (int m = 0; m < 4; ++m) { const int c = c0 + ai * 128 + m * 16;
#pragma unroll
                for (int bj = 0; bj < 2; ++bj) { const int cc = cc0 + bj * 128, t = cc >> 4, h0 = cc & 15;
                    const f32x4 v0 = acc[ai][bj][m][0], v1 = acc[ai][bj][m][1];
                    u32x4 w; w.x = cvt_pk_bf16(gelu_tanh(v0[0]), gelu_tanh(v0[1])); w.y = cvt_pk_bf16(gelu_tanh(v0[2]), gelu_tanh(v0[3]));
                    w.z = cvt_pk_bf16(gelu_tanh(v1[0]), gelu_tanh(v1[1])); w.w = cvt_pk_bf16(gelu_tanh(v1[2]), gelu_tanh(v1[3]));
                    *(u32x4*)(Z + (size_t)(c * 64 + t) * S5W + g * 16 + h0) = w; } }
    }
};
__device__ __forceinline__ void s5_tables_item(const Ctx& a, int lg, LAS unsigned char* lds, int wave, int lane) {
    LAS f32x2* LP = (LAS f32x2*)lds;
    LAS f32x2* BB = (LAS f32x2*)(lds + 33280);
    LAS f32x2* CC = (LAS f32x2*)(lds + 41472);
    LAS float* KT = (LAS float*)(lds + 49664);
    const int tid = wave * 64 + lane, l = lg >> 6, g = lg & 63;
    if (tid < 64) { const int p = tid;
        const double ar = (double)a.in(I_AREAL)[lg * 64 + p], ai = (double)a.in(I_AIMAG)[lg * 64 + p], dt = exp((double)a.in(I_LOGDT)[lg]);
        const double mag = exp(ar * dt), ang = ai * dt, lr = mag * cos(ang), li = mag * sin(ang);
        const double den = ar * ar + ai * ai, nr = lr - 1.0, ni = li, cr = (nr * ar + ni * ai) / den, ci = (ni * ar - nr * ai) / den;
        double pr = 1.0, pi = 0.0;
        for (int tau = 0; tau <= 64; ++tau) { LP[tau * 64 + p] = (f32x2){(float)pr, (float)pi}; const double nr2 = pr * lr - pi * li, ni2 = pr * li + pi * lr; pr = nr2; pi = ni2; }
        for (int h = 0; h < 16; ++h) { const double br = (double)a.in(I_BRE)[((size_t)lg * 64 + p) * 16 + h], bi = (double)a.in(I_BIM)[((size_t)lg * 64 + p) * 16 + h];
            BB[p * 16 + h] = (f32x2){(float)(cr * br - ci * bi), (float)(cr * bi + ci * br)}; }
    }
    for (int e = tid; e < 1024; e += 512) { const int h = e >> 6, p = e & 63; CC[e] = (f32x2){a.in(I_CRE)[((size_t)lg * 16 + h) * 64 + p], a.in(I_CIM)[((size_t)lg * 16 + h) * 64 + p]}; }
    __syncthreads();
    if (tid < 64) *(f32x2*)((float*)(a.ws() + WS_LAM64) + ((size_t)lg * 64 + tid) * 2) = LP[64 * 64 + tid];
    for (int e = tid; e < 64 * 256; e += 512) { const int tau = e >> 8, h = (e >> 4) & 15, hp = e & 15; float s = 0.f;
#pragma unroll 8
        for (int p = 0; p < 64; ++p) { const f32x2 c = CC[h * 64 + p], lm = LP[tau * 64 + p], b = BB[p * 16 + hp];
            const float xr = c.x * lm.x - c.y * lm.y, xi = c.x * lm.y + c.y * lm.x; s += xr * b.x - xi * b.y; }
        if (tau == 0 && h == hp) s += a.in(I_S5D)[l * S5W + g * 16 + h];
        KT[e] = s; }
    __syncthreads();
    bf16_t* T = (bf16_t*)(a.ws() + WS_S5T + (size_t)l * S5_T_LAYER) + (size_t)g * 1024 * S5K;
    for (int pc = tid; pc < 1024 * 144; pc += 512) { const int n = pc / 144, j = pc % 144, t = n >> 4, h = n & 15; float v[8];
        if (j < 128) { const int s = j >> 1, hp0 = (j & 1) * 8;
            if (s > t) {
#pragma unroll
                for (int i = 0; i < 8; ++i) v[i] = 0.f;
            } else { const LAS float* kp = KT + (t - s) * 256 + h * 16 + hp0; const f32x4 k0 = *(const LAS f32x4*)kp, k1 = *(const LAS f32x4*)(kp + 4);
                v[0] = k0[0]; v[1] = k0[1]; v[2] = k0[2]; v[3] = k0[3]; v[4] = k1[0]; v[5] = k1[1]; v[6] = k1[2]; v[7] = k1[3]; }
        } else { const int p0 = (j - 128) * 4;
#pragma unroll
            for (int i = 0; i < 4; ++i) { const f32x2 c = CC[h * 64 + p0 + i], lm = LP[(t + 1) * 64 + p0 + i]; v[2 * i] = c.x * lm.x - c.y * lm.y; v[2 * i + 1] = -(c.x * lm.y + c.y * lm.x); } }
        *(u32x4*)(T + (size_t)n * S5K + j * 8) = (u32x4){cvt_pk_bf16(v[0], v[1]), cvt_pk_bf16(v[2], v[3]), cvt_pk_bf16(v[4], v[5]), cvt_pk_bf16(v[6], v[7])}; }
    bf16_t* W1 = (bf16_t*)(a.ws() + WS_S5W1 + (size_t)l * S5_W1_LAYER) + (size_t)g * 256 * S5K;
    for (int pc = tid; pc < 256 * 144; pc += 512) { const int n = pc / 144, j = pc % 144; float v[8];
#pragma unroll
        for (int i = 0; i < 8; ++i) v[i] = 0.f;
        if (n < 128 && j < 128) { const int p = n >> 1, ri = n & 1, s = j >> 1, hp0 = (j & 1) * 8; const f32x2 lm = LP[(63 - s) * 64 + p];
#pragma unroll
            for (int i = 0; i < 8; ++i) { const f32x2 b = BB[p * 16 + hp0 + i]; v[i] = ri ? (lm.x * b.y + lm.y * b.x) : (lm.x * b.x - lm.y * b.y); } }
        *(u32x4*)(W1 + (size_t)n * S5K + j * 8) = (u32x4){cvt_pk_bf16(v[0], v[1]), cvt_pk_bf16(v[2], v[3]), cvt_pk_bf16(v[4], v[5]), cvt_pk_bf16(v[6], v[7])}; }
    __syncthreads();
}
__device__ __forceinline__ void s5_scan_item(const Ctx& a, int l, int item, int wave, int lane) {
    const int idx = item * 512 + wave * 64 + lane, g = idx >> 7, b = (idx >> 6) & 1, p = idx & 63;
    const f32x2 lam = *(const f32x2*)((const float*)(a.ws() + WS_LAM64) + ((size_t)(l * 64 + g) * 64 + p) * 2);
    const float* sl = (const float*)(a.ws() + WS_SLOC) + ((size_t)(g * 256 + b * 128)) * 128 + 2 * p;
    bf16_t* ux = (bf16_t*)(a.ws() + WS_UX) + ((size_t)(g * 256 + b * 128)) * S5K + 1024 + 2 * p;
    float xr = 0.f, xi = 0.f;
    for (int c0 = 0; c0 < 128; c0 += 8) { f32x2 s[8];
#pragma unroll
        for (int i = 0; i < 8; ++i) s[i] = *(const f32x2*)(sl + (size_t)(c0 + i) * 128);
#pragma unroll
        for (int i = 0; i < 8; ++i) { *(unsigned*)(ux + (size_t)(c0 + i) * S5K) = cvt_pk_bf16(xr, xi);
            const float nr = lam.x * xr - lam.y * xi + s[i].x, ni = lam.x * xi + lam.y * xr + s[i].y; xr = nr; xi = ni; } }
}

__device__ __forceinline__ void transpose_item(const float* W, int N, int k0, int n0, bf16_t* WT, int drow0, int Kd, LAS float* scr, int lane) {
    const int nl = 4 * (lane & 15), kq = lane >> 4;
    const bool valid = (n0 + nl) < N;
    f32x4 v[16];
#pragma unroll
    for (int i = 0; i < 16; ++i) { const int k = 4 * i + kq; v[i] = valid ? *(const f32x4*)(W + (size_t)(k0 + k) * N + n0 + nl) : (f32x4){0.f, 0.f, 0.f, 0.f}; }
#pragma unroll
    for (int i = 0; i < 16; ++i) { const int k = 4 * i + kq; LAS float* s = scr + k * 65 + nl; s[0] = v[i][0]; s[1] = v[i][1]; s[2] = v[i][2]; s[3] = v[i][3]; }
    LDS_WAIT();
    const int c = lane & 7;
#pragma unroll
    for (int j = 0; j < 8; ++j) { const int n = (lane >> 3) + 8 * j; const LAS float* s = scr + (8 * c) * 65 + n;
        u32x4 o; o.x = cvt_pk_bf16(s[0], s[65]); o.y = cvt_pk_bf16(s[130], s[195]); o.z = cvt_pk_bf16(s[260], s[325]); o.w = cvt_pk_bf16(s[390], s[455]);
        *(u32x4*)(WT + (size_t)(drow0 + n) * Kd + k0 + 8 * c) = o; }
    LDS_WAIT();
}
constexpr int NIT_IN = 64 * 188, NIT_OUT = 64 * 64, NIT_G = 64 * 172, NIT_DN = 172 * 64, NIT_GLU = 16 * 16;
constexpr int NIT_LAYER = NIT_IN + NIT_OUT + 2 * NIT_G + NIT_DN + NIT_GLU;
constexpr int NIT_TR = DEPTH * NIT_LAYER, NIT_COND = 64 * 96;

__device__ __forceinline__ void phase_prologue(const Ctx& a, LAS unsigned char* lds, int wave, int lane) {
    LAS float* scr = (LAS float*)(lds + wave * 16640);
    const int gw = blockIdx.x * 8 + wave, NGW = gridDim.x * 8;
    for (int it = gw; it < NIT_TR + NIT_COND; it += NGW) {
        if (it < NIT_TR) {
            const int l = it / NIT_LAYER; int r = it % NIT_LAYER;
            unsigned char* wt = a.ws() + WS_WT + (size_t)l * WT_LAYER;
            if (r < NIT_IN) { const int kb = r / 188, nb = r % 188; transpose_item(a.in(I_WIN) + (size_t)l * DM * INW, INW, 64 * kb, 64 * nb, (bf16_t*)(wt + WT_IN), 64 * nb, DM, scr, lane); continue; } r -= NIT_IN;
            if (r < NIT_OUT) { const int kb = r / 64, nb = r % 64; transpose_item(a.in(I_WOUT) + (size_t)l * DM * DM, DM, 64 * kb, 64 * nb, (bf16_t*)(wt + WT_OUT), 64 * nb, DM, scr, lane); continue; } r -= NIT_OUT;
            if (r < NIT_G) { const int kb = r / 172, nb = r % 172, n0 = 64 * nb; transpose_item(a.in(I_WFG) + (size_t)l * DM * DFF, DFF, 64 * kb, n0, (bf16_t*)(wt + WT_GU), 256 * (n0 / 128) + (n0 % 128), DM, scr, lane); continue; } r -= NIT_G;
            if (r < NIT_G) { const int kb = r / 172, nb = r % 172, n0 = 64 * nb; transpose_item(a.in(I_WFU) + (size_t)l * DM * DFF, DFF, 64 * kb, n0, (bf16_t*)(wt + WT_GU), 256 * (n0 / 128) + 128 + (n0 % 128), DM, scr, lane); continue; } r -= NIT_G;
            if (r < NIT_DN) { const int kb = r / 64, nb = r % 64; transpose_item(a.in(I_WFD) + (size_t)l * DFF * DM, DM, 64 * kb, 64 * nb, (bf16_t*)(wt + WT_DN), 64 * nb, DFF, scr, lane); continue; } r -= NIT_DN;
            { const int kb = r / 16, nb = r % 16; transpose_item(a.in(I_GLUW) + (size_t)l * S5W * S5W, S5W, 64 * kb, 64 * nb, (bf16_t*)(wt + WT_GLU), 64 * nb, S5W, scr, lane); }
        } else {
            const int item = it - NIT_TR, kb = item / 96, jb = item % 96, k0 = 64 * kb, j0 = 256 * jb + 4 * lane;
            const float* c = a.in(I_C);
            float c0 = c[k0 + lane], c1 = c[DM + k0 + lane];
            c0 = c0 / (1.0f + expf(-c0)); c1 = c1 / (1.0f + expf(-c1));
            f32x4 a0 = (f32x4){0.f, 0.f, 0.f, 0.f}, a1 = a0;
            const float* w = a.in(I_WADA) + (size_t)k0 * (6 * DM) + j0;
#pragma unroll 8
            for (int kk = 0; kk < 64; ++kk) { const f32x4 wv = *(const f32x4*)(w + (size_t)kk * (6 * DM));
                const float s0 = __int_as_float(__builtin_amdgcn_readlane(__float_as_int(c0), kk)), s1 = __int_as_float(__builtin_amdgcn_readlane(__float_as_int(c1), kk));
                a0 += wv * s0; a1 += wv * s1; }
            float* cp = (float*)(a.ws() + WS_CONDPART);
            *(f32x4*)(cp + (size_t)(kb * 2 + 0) * (6 * DM) + j0) = a0;
            *(f32x4*)(cp + (size_t)(kb * 2 + 1) * (6 * DM) + j0) = a1;
        }
    }
    __syncthreads();
    for (int lg = blockIdx.x; lg < DEPTH * 64; lg += gridDim.x) s5_tables_item(a, lg, lds, wave, lane);
}
__device__ __forceinline__ void phase_mod(const Ctx& a, int wave, int lane) {
    const int gt = blockIdx.x * 512 + wave * 64 + lane, NT = gridDim.x * 512;
    const float* cp = (const float*)(a.ws() + WS_CONDPART);
    float* mod = (float*)(a.ws() + WS_MOD); float* misc = (float*)(a.ws() + WS_MISC);
    for (int idx = gt; idx < NB * 6 * DM; idx += NT) {
        const int b = idx / (6 * DM), j = idx % (6 * DM);
        float s = a.in(I_BADA)[j];
        for (int kb = 0; kb < 64; ++kb) s += cp[(size_t)(kb * 2 + b) * (6 * DM) + j];
        for (int l = 0; l < DEPTH; ++l) mod[(size_t)((l * 2 + b) * 6) * DM + j] = s + a.in(I_TABLE)[(size_t)l * 6 * DM + j];
    }
    for (int idx = gt; idx < DM; idx += NT) { misc[idx] = 1.0f; misc[DM + idx] = 0.0f; }
    for (int idx = gt; idx < HGW; idx += NT) {
        const float* raw = a.in(I_LBRAW); float r[DEPTH], mx = -3.0e38f;
#pragma unroll
        for (int l = 0; l < DEPTH; ++l) { r[l] = raw[l * HGW + idx]; mx = fmaxf(mx, r[l]); }
        float e[DEPTH], sum = 0.f;
#pragma unroll
        for (int l = 0; l < DEPTH; ++l) { e[l] = expf(r[l] - mx); sum += e[l]; }
        float cum = 0.f;
#pragma unroll
        for (int l = 0; l < DEPTH; ++l) { misc[2 * DM + l * HGW + idx] = cum; if (l + 1 < DEPTH) cum += e[l + 1] / sum; }
    }
}

template <int MODE>
__device__ __forceinline__ void phase_lnapply(const float* vsrc, const float* rowpart, float* rowstats, const float* lng, const float* lnb, const float* modp, int i_shift, int i_scale,
                                              bf16_t* H, float* outf, LAS unsigned char* lds, int wave, int lane) {
    LAS f32x2* st = (LAS f32x2*)lds;
    for (int blk = blockIdx.x; blk < MTOK / 64; blk += gridDim.x) {
        const int r0 = blk * 64, b = (r0 >= SEQ) ? 1 : 0;
        for (int rr = 0; rr < 8; ++rr) { const int rl = wave * 8 + rr, r = r0 + rl; float mu = 0.f, rs = 1.f;
            if (MODE != 0) { const f32x2 p = *(const f32x2*)(rowpart + ((size_t)r * 64 + lane) * 2); const float s1 = wave_sum(p.x), s2 = wave_sum(p.y);
                mu = s1 * (1.0f / DM); const float var = fmaxf(s2 * (1.0f / DM) - mu * mu, 0.f); rs = 1.0f / sqrtf(var + LN_EPS); }
            if (lane == 0) { st[rl] = (f32x2){mu, rs}; if (MODE != 2) *(f32x2*)(rowstats + (size_t)r * 2) = (f32x2){mu, rs}; } }
        __syncthreads();
        f32x4 A[2], B[2];
#pragma unroll
        for (int jj = 0; jj < 2; ++jj) { const int c = 512 * wave + 256 * jj + 4 * lane;
            f32x4 g = (f32x4){1.f, 1.f, 1.f, 1.f}, bb = (f32x4){0.f, 0.f, 0.f, 0.f};
            if (MODE != 0) { g = *(const f32x4*)(lng + c); bb = *(const f32x4*)(lnb + c); }
            if (MODE != 2) { const f32x4 sc = *(const f32x4*)(modp + (size_t)(b * 6 + i_scale) * DM + c) + 1.0f, sh = *(const f32x4*)(modp + (size_t)(b * 6 + i_shift) * DM + c); A[jj] = g * sc; B[jj] = bb * sc + sh; }
            else { A[jj] = g; B[jj] = bb; } }
#pragma unroll 8
        for (int rl = 0; rl < 64; ++rl) { const f32x2 s = st[rl]; const size_t off = (size_t)(r0 + rl) * DM + 512 * wave + 4 * lane;
#pragma unroll
            for (int jj = 0; jj < 2; ++jj) { const f32x4 v = *(const f32x4*)(vsrc + off + 256 * jj); const f32x4 y = ((v - s.x) * s.y) * A[jj] + B[jj];
                if (MODE == 2) *(f32x4*)(outf + off + 256 * jj) = y;
                else { u32x2 w; w.x = cvt_pk_bf16(y[0], y[1]); w.y = cvt_pk_bf16(y[2], y[3]); *(u32x2*)(H + off + 256 * jj) = w; } } }
        __syncthreads();
    }
}

typedef short bf16x8 __attribute__((ext_vector_type(8)));
typedef short bf16x4 __attribute__((ext_vector_type(4)));
constexpr int HG_BLK = 16896, HG_OQ = 0, HG_OK = 4096, HG_OKT = 8192, HG_OVT = 12288, HG_ODL = 16384;
constexpr int GL_BLK = 32768, GL_OQ = 0, GL_OK = 6400, GL_OKT = 12800, GL_ODL = 18944, GL_SHARED = 20480, GL_OVT = 20480;
constexpr int NSUB = SEQ / 16;

__device__ __forceinline__ unsigned short f2bf1(float x) { return (unsigned short)(cvt_pk_bf16(x, x) & 0xffffu); }

__device__ __forceinline__ void pre_finish(const float (&qq)[16], const float (&kk)[16], float (&g)[16], unsigned char* blk, int oq, int ok, int okt, int odl, int rowb, int d, bool swz) {
    float b = 0.f;
#pragma unroll
    for (int j = 0; j < 16; ++j) { b += g[j]; g[j] = b; }
    const float bl = b;
    unsigned kt[8];
#pragma unroll
    for (int j = 0; j < 16; j += 2) {
        float kv[2];
#pragma unroll
        for (int jj = 0; jj < 2; ++jj) { const int t = j + jj; const float bj = g[t];
            const int off = t * rowb + (swz ? ((2 * d) ^ (t << 4)) : 2 * d);
            const float qv = qq[t] * __expf(bj), kc = kk[t] * __expf(fminf(-bj, 80.f));
            const float qn = __shfl_xor(qv, 1), kn = __shfl_xor(kc, 1);
            if ((d & 1) == 0) { *(unsigned*)(blk + oq + off) = cvt_pk_bf16(qv, qn); *(unsigned*)(blk + ok + off) = cvt_pk_bf16(kc, kn); }
            kv[jj] = kk[t] * __expf(bl - bj); }
        kt[j >> 1] = cvt_pk_bf16(kv[0], kv[1]); }
    *(u32x4*)(blk + okt + d * 32) = (u32x4){kt[0], kt[1], kt[2], kt[3]};
    *(u32x4*)(blk + okt + d * 32 + 16) = (u32x4){kt[4], kt[5], kt[6], kt[7]};
    *(float*)(blk + odl + d * 4) = __expf(bl);
}
__device__ __forceinline__ void phase_pre(const Ctx& a, int l, int wave, int lane) {
    const bf16_t* P = (const bf16_t*)(a.ws() + WS_P);
    int tid = wave * 64 + lane;
    for (int task = blockIdx.x; task < NB * NSUB * 8; task += gridDim.x) {
        asm volatile("" : "+v"(tid));
        const int kind = (task + (task >> 8)) & 7, bsc = task >> 3, b = bsc / NSUB, sc = bsc % NSUB;
        const size_t row0 = (size_t)b * SEQ + sc * 16;
        if (kind < 3) {
            const int ch = kind * 512 + tid, h = ch >> 7, d = ch & 127;
            const float lb = ((const float*)(a.ws() + WS_MISC))[2 * DM + l * HGW + ch];
            unsigned char* blk = a.ws() + WS_HGB + ((size_t)(b * 12 + h) * NSUB + sc) * HG_BLK;
            float g[16], qq[16], kk[16]; unsigned vv[8];
#pragma unroll
            for (int j = 0; j < 16; ++j) { const bf16_t* prow = P + (row0 + j) * INP;
                const float qin = fmaxf(bf2f(prow[C_QB + ch]), -80.f), fin = fminf(fmaxf(bf2f(prow[C_FB + ch]), -80.f), 80.f);
                const unsigned short v = prow[C_IB + ch]; if (j & 1) vv[j >> 1] |= ((unsigned)v) << 16; else vv[j >> 1] = v;
                const float e = __expf(-fin), sg = 1.0f / (1.0f + e);
                const float f = lb + (1.0f - lb) * sg;
                g[j] = fmaxf(__logf(f), -100.f); kk[j] = (1.0f - lb) * (e * sg); qq[j] = qin / (1.0f + __expf(-qin)); }
            *(u32x4*)(blk + HG_OVT + d * 32) = (u32x4){vv[0], vv[1], vv[2], vv[3]};
            *(u32x4*)(blk + HG_OVT + d * 32 + 16) = (u32x4){vv[4], vv[5], vv[6], vv[7]};
            pre_finish(qq, kk, g, blk, HG_OQ, HG_OK, HG_OKT, HG_ODL, 256, d, true);
        } else if (kind < 5) {
            if (tid < 384) {
                const int ch = (kind - 3) * 384 + tid, h = ch / 192, d = ch % 192;
                unsigned char* blk = a.ws() + WS_GLB + ((size_t)(b * 4 + h) * NSUB + sc) * GL_BLK;
                float wg[16];
#pragma unroll
                for (int r = 0; r < 16; ++r) wg[r] = a.in(I_WGATE)[((size_t)l * 16 + r) * GLKW + ch];
                const float bgv = a.in(I_BGATE)[l * GLKW + ch];
                float g[16], qq[16], kk[16];
#pragma unroll
                for (int j = 0; j < 16; ++j) { const bf16_t* prow = P + (row0 + j) * INP;
                    const u32x4 l0 = *(const u32x4*)(prow + C_LR), l1 = *(const u32x4*)(prow + C_LR + 8);
                    float x = bgv;
                    x += bf_lo(l0.x) * wg[0] + bf_hi(l0.x) * wg[1] + bf_lo(l0.y) * wg[2] + bf_hi(l0.y) * wg[3] + bf_lo(l0.z) * wg[4] + bf_hi(l0.z) * wg[5] + bf_lo(l0.w) * wg[6] + bf_hi(l0.w) * wg[7];
                    x += bf_lo(l1.x) * wg[8] + bf_hi(l1.x) * wg[9] + bf_lo(l1.y) * wg[10] + bf_hi(l1.y) * wg[11] + bf_lo(l1.z) * wg[12] + bf_hi(l1.z) * wg[13] + bf_lo(l1.w) * wg[14] + bf_hi(l1.w) * wg[15];
                    g[j] = (fminf(x, 0.f) - __logf(1.0f + __expf(-fabsf(x)))) * 0.0625f;
                    qq[j] = bf2f(prow[C_QC + ch]) * GLA_QSCALE; kk[j] = bf2f(prow[C_KC + ch]); }
                pre_finish(qq, kk, g, blk, GL_OQ, GL_OK, GL_OKT, GL_ODL, 400, d, false);
            }
        } else {
            const int ch = (kind - 5) * 512 + tid, h = ch / 384, e = ch % 384;
            unsigned char* blk = a.ws() + WS_GLB + ((size_t)(b * 4 + h) * NSUB + sc) * GL_BLK;
            unsigned vv[8];
#pragma unroll
            for (int j = 0; j < 16; ++j) { const unsigned short v = P[(row0 + j) * INP + C_VC + ch]; if (j & 1) vv[j >> 1] |= ((unsigned)v) << 16; else vv[j >> 1] = v; }
            *(u32x4*)(blk + GL_OVT + e * 32) = (u32x4){vv[0], vv[1], vv[2], vv[3]};
            *(u32x4*)(blk + GL_OVT + e * 32 + 16) = (u32x4){vv[4], vv[5], vv[6], vv[7]};
        }
    }
}

template <int DK, int MODE>
__device__ __forceinline__ void chain_sub(const LAS unsigned char* sb, f32x4 (&S)[DK / 16], float* op, int wave, int n, int q) {
    constexpr bool IS_GLA = (DK == 192);
    constexpr int NKS = DK / 32, NMB = DK / 16, ROWB = IS_GLA ? 400 : 256;
    constexpr int OQ = 0, OK = IS_GLA ? GL_OK : HG_OK, OKT = IS_GLA ? GL_OKT : HG_OKT, OVT = IS_GLA ? GL_OVT : HG_OVT, ODL = IS_GLA ? GL_ODL : HG_ODL;
    const u32x2 vfr = *(const LAS u32x2*)(sb + OVT + (16 * wave + n) * 32 + 8 * q);
    const bf16x8 vf8 = __builtin_bit_cast(bf16x8, (u32x4){vfr.x, vfr.y, 0u, 0u});
    if (MODE == 1) {
        bf16x8 qf[NKS], kf[NKS];
#pragma unroll
        for (int ks = 0; ks < NKS; ++ks) { const int c0 = 2 * (32 * ks + 4 * q), c1 = c0 + 32;
            const int o0 = n * ROWB + (IS_GLA ? c0 : (c0 ^ (n << 4))), o1 = n * ROWB + (IS_GLA ? c1 : (c1 ^ (n << 4)));
            const u32x2 ql = *(const LAS u32x2*)(sb + OQ + o0), qh = *(const LAS u32x2*)(sb + OQ + o1), kl = *(const LAS u32x2*)(sb + OK + o0), kh = *(const LAS u32x2*)(sb + OK + o1);
            qf[ks] = __builtin_bit_cast(bf16x8, (u32x4){ql.x, ql.y, qh.x, qh.y}); kf[ks] = __builtin_bit_cast(bf16x8, (u32x4){kl.x, kl.y, kh.x, kh.y}); }
        f32x4 ao = (f32x4){0.f, 0.f, 0.f, 0.f}, ap = ao;
#pragma unroll
        for (int ks = 0; ks < NKS; ++ks) {
            const bf16x8 sbf = __builtin_bit_cast(bf16x8, (u32x4){cvt_pk_bf16(S[2 * ks][0], S[2 * ks][1]), cvt_pk_bf16(S[2 * ks][2], S[2 * ks][3]), cvt_pk_bf16(S[2 * ks + 1][0], S[2 * ks + 1][1]), cvt_pk_bf16(S[2 * ks + 1][2], S[2 * ks + 1][3])});
            ao = __builtin_amdgcn_mfma_f32_16x16x32_bf16(qf[ks], sbf, ao, 0, 0, 0);
            ap = __builtin_amdgcn_mfma_f32_16x16x32_bf16(kf[ks], qf[ks], ap, 0, 0, 0); }
#pragma unroll
        for (int r = 0; r < 4; ++r) if (4 * q + r > n) ap[r] = 0.f;
        const bf16x8 pa8 = __builtin_bit_cast(bf16x8, (u32x4){cvt_pk_bf16(ap[0], ap[1]), cvt_pk_bf16(ap[2], ap[3]), 0u, 0u});
        ao = __builtin_amdgcn_mfma_f32_16x16x32_bf16(pa8, vf8, ao, 0, 0, 0);
#pragma unroll
        for (int r = 0; r < 4; ++r) op[(size_t)(4 * q + r) * OW] = ao[r];
    }
#pragma unroll
    for (int mb = 0; mb < NMB; ++mb) {
        const f32x4 dl = *(const LAS f32x4*)(sb + ODL + (16 * mb + 4 * q) * 4);
        const u32x2 ktr = *(const LAS u32x2*)(sb + OKT + (16 * mb + n) * 32 + 8 * q);
        S[mb] = __builtin_amdgcn_mfma_f32_16x16x32_bf16(__builtin_bit_cast(bf16x8, (u32x4){ktr.x, ktr.y, 0u, 0u}), vf8, S[mb] * dl, 0, 0, 0); }
}
constexpr size_t ST_REC = 98304;
constexpr int NSEG = 5;
__device__ __forceinline__ int seg_u0(int s) { return s <= 3 ? 52 * s : 156 + 50 * (s - 3); }
__device__ __forceinline__ int seg_nu(int s) { return s < 3 ? 52 : 50; }
template <int DK, int MODE>
__device__ __forceinline__ void chain_item(const unsigned char* blk0, int vt_off, float* op0, unsigned char* st, int seg, int nunits, LAS unsigned char* lds, int wave, int lane) {
    asm volatile("" : "+v"(lane), "+s"(wave));
    constexpr bool IS_GLA = (DK == 192);
    constexpr int BLK = IS_GLA ? GL_BLK : HG_BLK, SUBB = IS_GLA ? GL_SHARED + 4096 : HG_BLK, NMB = DK / 16;
    constexpr int SH0 = MODE == 1 ? 0 : (IS_GLA ? GL_OKT : HG_OKT);
    constexpr int SH_PIECES = (MODE == 1 ? (IS_GLA ? GL_SHARED : HG_OVT) : (IS_GLA ? GL_ODL + 768 - GL_OKT : 4096)) / 16;
    constexpr int T_PIECES = IS_GLA ? 256 : (4096 + 512) / 16;
    constexpr int T_LDS = IS_GLA ? GL_OVT : HG_OVT;
    constexpr int PIECES = SH_PIECES + T_PIECES, UNITB = 2 * SUBB, NP = (2 * PIECES + 511) / 512;
    const int tid = wave * 64 + lane, n = lane & 15, q = lane >> 4;
    f32x4 S[NMB]; float dacc = 1.0f;
    constexpr int ODL_ = IS_GLA ? GL_ODL : HG_ODL;
#pragma unroll
    for (int mb = 0; mb < NMB; ++mb) S[mb] = (f32x4){0.f, 0.f, 0.f, 0.f};
    if (MODE == 1) {
        for (int s = 0; s < seg; ++s) { const unsigned char* rec = st + (size_t)s * 2 * ST_REC + (size_t)(wave * 64 + lane) * 16;
#pragma unroll
            for (int mb = 0; mb < NMB; ++mb) { const f32x4 h = *(const f32x4*)(rec + (size_t)mb * 8192), d = *(const f32x4*)(st + (size_t)s * 2 * ST_REC + ST_REC + (16 * mb + 4 * q) * 4); S[mb] = S[mb] * d + h; } }
    }
    u32x4 stgA[NP], stgB[NP];
#define CH_SRC(u, p_) (blk0 + (size_t)((u) * 2 + (p_) / PIECES) * BLK + (((p_) % PIECES) < SH_PIECES ? SH0 + ((p_) % PIECES) * 16 : (IS_GLA ? vt_off : HG_OVT) + (((p_) % PIECES) - SH_PIECES) * 16))
#define CH_DST(p_) (((p_) / PIECES) * SUBB + (((p_) % PIECES) < SH_PIECES ? SH0 + ((p_) % PIECES) * 16 : T_LDS + (((p_) % PIECES) - SH_PIECES) * 16))
#define CH_LOAD(stg, u) do { _Pragma("unroll") for (int r_ = 0; r_ < NP; ++r_) { const int p_ = r_ * 512 + tid; if (p_ < 2 * PIECES) stg[r_] = *(const u32x4*)CH_SRC(u, p_); } } while (0)
#define CH_STORE(stg, buf) do { _Pragma("unroll") for (int r_ = 0; r_ < NP; ++r_) { const int p_ = r_ * 512 + tid; if (p_ < 2 * PIECES) *(LAS u32x4*)(lds + (buf) * UNITB + CH_DST(p_)) = stg[r_]; } } while (0)
#define CH_SYNC() do { asm volatile("s_waitcnt lgkmcnt(0)" ::: "memory"); __builtin_amdgcn_s_barrier(); asm volatile("" ::: "memory"); } while (0)
    CH_LOAD(stgA, 0); CH_STORE(stgA, 0);
    CH_LOAD(stgA, 1);
    CH_SYNC();
    float* op = op0 + 16 * wave + n;
    for (int u = 0; u < nunits; u += 2) {
        if (u + 2 < nunits) CH_LOAD(stgB, u + 2);
        chain_sub<DK, MODE>(lds, S, op + (size_t)(u * 32) * OW, wave, n, q);
        chain_sub<DK, MODE>(lds + SUBB, S, op + (size_t)(u * 32 + 16) * OW, wave, n, q);
        if (MODE == 0 && tid < DK) dacc *= *(const LAS float*)(lds + ODL_ + 4 * tid) * *(const LAS float*)(lds + SUBB + ODL_ + 4 * tid);
        CH_STORE(stgA, 1);
        CH_SYNC();
        if (u + 3 < nunits) CH_LOAD(stgA, u + 3);
        chain_sub<DK, MODE>(lds + UNITB, S, op + (size_t)(u * 32 + 32) * OW, wave, n, q);
        chain_sub<DK, MODE>(lds + UNITB + SUBB, S, op + (size_t)(u * 32 + 48) * OW, wave, n, q);
        if (MODE == 0 && tid < DK) dacc *= *(const LAS float*)(lds + UNITB + ODL_ + 4 * tid) * *(const LAS float*)(lds + UNITB + SUBB + ODL_ + 4 * tid);
        if (u + 2 < nunits) CH_STORE(stgB, 0);
        CH_SYNC();
    }
    if (MODE == 0) { unsigned char* rec = st + (size_t)seg * 2 * ST_REC + (size_t)(wave * 64 + lane) * 16;
#pragma unroll
        for (int mb = 0; mb < NMB; ++mb) *(f32x4*)(rec + (size_t)mb * 8192) = S[mb];
        if (tid < DK) *(float*)(st + (size_t)seg * 2 * ST_REC + ST_REC + 4 * tid) = dacc; }
#undef CH_SRC
#undef CH_DST
#undef CH_LOAD
#undef CH_STORE
#undef CH_SYNC
}

template <int MODE>
__device__ __forceinline__ void phase_chain(const Ctx& a, int l, LAS unsigned char* lds, int wave, int lane) {
    const int bx = blockIdx.x, G = gridDim.x;
    constexpr int nitems = MODE == 0 ? 48 * (NSEG - 1) : 48 * NSEG;
    for (int it = bx; it < nitems; it += G) {
        const int c = it % 48, seg = it / 48, u0 = seg_u0(seg), nu = seg_nu(seg);
        unsigned char* st = a.ws() + WS_ST + (size_t)c * (NSEG - 1) * 2 * ST_REC;
        if (c < 24) { const int b = c / 12, h = c % 12;
            chain_item<128, MODE>(a.ws() + WS_HGB + ((size_t)(b * 12 + h) * NSUB + 2 * u0) * HG_BLK, 0, (float*)(a.ws() + WS_O) + ((size_t)b * SEQ + u0 * 32) * OW + h * 128, st, seg, nu, lds, wave, lane); }
        else { const int r = c - 24, b = r / 12, h = (r % 12) / 3, sl = r % 3;
            chain_item<192, MODE>(a.ws() + WS_GLB + ((size_t)(b * 4 + h) * NSUB + 2 * u0) * GL_BLK, GL_OVT + 4096 * sl, (float*)(a.ws() + WS_O) + ((size_t)b * SEQ + u0 * 32) * OW + HGW + h * 384 + sl * 128, st, seg, nu, lds, wave, lane); }
        __syncthreads();
    }
    if (MODE == 0) { for (int it = (G >= nitems + 16) ? bx - nitems : bx; it < 16; it += G) { if (it < 0) continue; s5_scan_item(a, l, it, wave, lane); } }
}
__device__ __forceinline__ float red16(float v) { v += __shfl_xor(v, 1); v += __shfl_xor(v, 2); v += __shfl_xor(v, 4); v += __shfl_xor(v, 8); return v; }
__device__ __forceinline__ void phase_finalize(const Ctx& a, int l, int wave, int lane) {
    const bf16_t* P = (const bf16_t*)(a.ws() + WS_P); const float* O = (const float*)(a.ws() + WS_O); bf16_t* MX = (bf16_t*)(a.ws() + WS_MIXED);
    const float* hgg = a.in(I_HGG) + l * HGW; const float* hgb = a.in(I_HGB) + l * HGW; const float* glg = a.in(I_GLG) + l * HGW;
    const int gw = blockIdx.x * 8 + wave, NGW = gridDim.x * 8;
    for (int row = gw; row < MTOK; row += NGW) {
        const float* orow = O + (size_t)row * OW; const bf16_t* prow = P + (size_t)row * INP; bf16_t* mrow = MX + (size_t)row * DM;
#pragma unroll
        for (int it = 0; it < 3; ++it) { const int c = (it * 4 + (lane >> 4)) * 128 + (lane & 15) * 8;
            const f32x4 o0 = *(const f32x4*)(orow + c), o1 = *(const f32x4*)(orow + c + 4); const u32x4 gg = *(const u32x4*)(prow + C_GB + c);
            float v[8] = {sigmoidf_(bf_lo(gg.x)) * o0[0], sigmoidf_(bf_hi(gg.x)) * o0[1], sigmoidf_(bf_lo(gg.y)) * o0[2], sigmoidf_(bf_hi(gg.y)) * o0[3],
                          sigmoidf_(bf_lo(gg.z)) * o1[0], sigmoidf_(bf_hi(gg.z)) * o1[1], sigmoidf_(bf_lo(gg.w)) * o1[2], sigmoidf_(bf_hi(gg.w)) * o1[3]};
            float s = 0.f, ss = 0.f;
#pragma unroll
            for (int i = 0; i < 8; ++i) { s += v[i]; ss += v[i] * v[i]; }
            s = red16(s); ss = red16(ss);
            const float mu = s * (1.0f / 128.0f), rs = 1.0f / sqrtf(fmaxf(ss * (1.0f / 128.0f) - mu * mu, 0.f) + LN_EPS);
            const f32x4 g0 = *(const f32x4*)(hgg + c), g1 = *(const f32x4*)(hgg + c + 4), b0 = *(const f32x4*)(hgb + c), b1 = *(const f32x4*)(hgb + c + 4);
            u32x4 w; w.x = cvt_pk_bf16((v[0] - mu) * rs * g0[0] + b0[0], (v[1] - mu) * rs * g0[1] + b0[1]); w.y = cvt_pk_bf16((v[2] - mu) * rs * g0[2] + b0[2], (v[3] - mu) * rs * g0[3] + b0[3]);
            w.z = cvt_pk_bf16((v[4] - mu) * rs * g1[0] + b1[0], (v[5] - mu) * rs * g1[1] + b1[1]); w.w = cvt_pk_bf16((v[6] - mu) * rs * g1[2] + b1[2], (v[7] - mu) * rs * g1[3] + b1[3]);
            *(u32x4*)(mrow + S5W + c) = w; }
#pragma unroll
        for (int h = 0; h < 4; ++h) { const int c = h * 384 + lane * 8; const bool act = lane < 48;
            f32x4 o0 = (f32x4){0.f, 0.f, 0.f, 0.f}, o1 = o0; u32x4 gg = (u32x4){0u, 0u, 0u, 0u};
            if (act) { o0 = *(const f32x4*)(orow + HGW + c); o1 = *(const f32x4*)(orow + HGW + c + 4); gg = *(const u32x4*)(prow + C_GC + c); }
            const float ss = wave_sum((o0[0] * o0[0] + o0[1] * o0[1]) + (o0[2] * o0[2] + o0[3] * o0[3]) + (o1[0] * o1[0] + o1[1] * o1[1]) + (o1[2] * o1[2] + o1[3] * o1[3]));
            const float rms = 1.0f / sqrtf(ss * (1.0f / 384.0f) + LN_EPS);
            if (act) { const f32x4 g0 = *(const f32x4*)(glg + c), g1 = *(const f32x4*)(glg + c + 4);
                const float z[8] = {bf_lo(gg.x), bf_hi(gg.x), bf_lo(gg.y), bf_hi(gg.y), bf_lo(gg.z), bf_hi(gg.z), bf_lo(gg.w), bf_hi(gg.w)};
                u32x4 w; w.x = cvt_pk_bf16(o0[0] * rms * g0[0] * (z[0] * sigmoidf_(z[0])), o0[1] * rms * g0[1] * (z[1] * sigmoidf_(z[1])));
                w.y = cvt_pk_bf16(o0[2] * rms * g0[2] * (z[2] * sigmoidf_(z[2])), o0[3] * rms * g0[3] * (z[3] * sigmoidf_(z[3])));
                w.z = cvt_pk_bf16(o1[0] * rms * g1[0] * (z[4] * sigmoidf_(z[4])), o1[1] * rms * g1[1] * (z[5] * sigmoidf_(z[5])));
                w.w = cvt_pk_bf16(o1[2] * rms * g1[2] * (z[6] * sigmoidf_(z[6])), o1[3] * rms * g1[3] * (z[7] * sigmoidf_(z[7])));
                *(u32x4*)(mrow + S5W + HGW + c) = w; } }
    }
}

constexpr int PH_PRO = 0, PH_MOD = 1, PH_LN0 = 2, PH_L0 = 3, PH_PER_LAYER = 10, N_PHASES = PH_L0 + DEPTH * PH_PER_LAYER;
constexpr int CW_BAR = 4096;

__global__ void __launch_bounds__(512, 2) hybrid_fwd(Args args) {
    extern __shared__ __attribute__((aligned(16))) unsigned char lds_raw[];
    LAS unsigned char* lds = (LAS unsigned char*)lds_raw;
    const int wave = __builtin_amdgcn_readfirstlane((int)threadIdx.x >> 6);
#define lane lane_id_v()
    volatile LAS unsigned* MISC = (volatile LAS unsigned*)(lds + LDSCTL_OFF);
    Ctx ctx; ctx.t = (volatile LAS unsigned long long*)(lds + LDSCTL_OFF + 64);
    if (wave == 0) { const int ln_ = lane; unsigned long long v = 0ull;
#pragma unroll
        for (int i = 0; i < N_IN; ++i) v = (ln_ == i) ? (unsigned long long)args.in[i] : v;
        v = (ln_ == 30) ? (unsigned long long)args.out : v; v = (ln_ == 31) ? (unsigned long long)args.ws : v;
        if (ln_ < 32) ctx.t[ln_] = v;
        if (ln_ < 16) MISC[ln_] = 0u; }
    __syncthreads();
    const int lo = args.ph_lo, hi = args.ph_hi;
    XcdBarrier bar; bar.bar = (unsigned*)(ctx.ws() + WS_CTL) + CW_BAR; bar.x = 0; bar.st = nullptr; bar.w0 = (wave == 0) ? 1u : 0u;
    if (hi - lo > 1) bar = xcd_barrier_post((unsigned*)(ctx.ws() + WS_CTL) + CW_BAR, MISC + 8, (wave == 0) ? 1u : 0u);
#define IN(k) (lo <= (k) && (k) < hi)
#define OPQ() int ln = lane, wv = wave; asm volatile("" : "+s"(wv))
#define SEAM(k) do { if (IN(k) && IN((k) + 1)) xcd_barrier(bar); } while (0)
#define WSP(T, off) ((T*)(ctx.ws() + (off)))
#ifdef DIAG_SEL1
    volatile LAS unsigned long long* STP = (volatile LAS unsigned long long*)(lds + LDSCTL_OFF + 512);
#define STAMP(idx) do { if (blockIdx.x == 0 && wave == 0) { const unsigned long long t_ = __builtin_amdgcn_s_memrealtime(); if (lane == 0) STP[idx] = t_; } } while (0)
#else
#define STAMP(idx) do { } while (0)
#endif
    STAMP(0);

#if EN_PRO
    if (IN(PH_PRO)) { OPQ(); phase_prologue(ctx, lds, wv, ln); }
#endif
    SEAM(PH_PRO); STAMP((PH_PRO) + 1);
#if EN_MOD
    if (IN(PH_MOD)) { OPQ(); phase_mod(ctx, wv, ln); }
#endif
    SEAM(PH_MOD); STAMP((PH_MOD) + 1);
#if EN_LN
    if (IN(PH_LN0)) { OPQ(); phase_lnapply<0>(ctx.in(I_X), nullptr, WSP(float, WS_ROWSTATS), nullptr, nullptr, WSP(float, WS_MOD), 0, 1, WSP(bf16_t, WS_H), nullptr, lds, wv, ln); }
#endif
    SEAM(PH_LN0); STAMP((PH_LN0) + 1);

    for (int l = 0; l < DEPTH; ++l) {
        const int p0 = PH_L0 + l * PH_PER_LAYER;
        const size_t wto = WS_WT + (size_t)l * WT_LAYER, modo = WS_MOD + (size_t)l * NB * 6 * DM * 4;
#if EN_INPROJ
        if (IN(p0 + 0)) { pg8::Gemm g{WSP(bf16_t, WS_H), WSP(const bf16_t, wto + WT_IN), MTOK, INP, DM}; pg8::StaticOrder S; S.init(MTOK, INP, (int)gridDim.x, (int)blockIdx.x);
            EpiProj E{WSP(bf16_t, WS_P), WSP(bf16_t, WS_UX)}; pg8::gemm_phase<EpiProj, pg8::StaticOrder, true, true>(lds, g, S, E, wave); }
#endif
        SEAM(p0 + 0); STAMP((p0 + 0) + 1);
#if EN_MIX
        if (IN(p0 + 1)) {
            { pg8::Gemm g{WSP(bf16_t, WS_UX), WSP(const bf16_t, WS_S5W1 + (size_t)l * S5_W1_LAYER), 64 * 256, 64 * 256, S5K}; S5Order S{(int)gridDim.x, (int)blockIdx.x, 64, 0};
              EpiS5A E{WSP(float, WS_SLOC)}; pg8::gemm_phase<EpiS5A, S5Order, true, true>(lds, g, S, E, wave); }
            { OPQ(); phase_pre(ctx, l, wv, ln); } }
        SEAM(p0 + 1); STAMP((p0 + 1) + 1);
        if (IN(p0 + 2)) { OPQ(); phase_chain<0>(ctx, l, lds, wv, ln); }
        SEAM(p0 + 2); STAMP((p0 + 2) + 1);
        if (IN(p0 + 3)) {
            { pg8::Gemm g{WSP(bf16_t, WS_UX), WSP(const bf16_t, WS_S5T + (size_t)l * S5_T_LAYER), 64 * 256, 64 * 1024, S5K}; S5Order S{(int)gridDim.x, (int)blockIdx.x, 256, 2};
              EpiS5C E{WSP(bf16_t, WS_Z)}; pg8::gemm_phase<EpiS5C, S5Order, true, true>(lds, g, S, E, wave); }
            { OPQ(); phase_chain<1>(ctx, l, lds, wv, ln); } }
#endif
        SEAM(p0 + 3); STAMP((p0 + 3) + 1);
#if EN_GLU
        if (IN(p0 + 4)) { pg8::Gemm g{WSP(bf16_t, WS_Z), WSP(const bf16_t, wto + WT_GLU), MTOK, S5W, S5W}; pg8::StaticOrder S; S.init(MTOK, S5W, (int)gridDim.x, (int)blockIdx.x);
            EpiGlu E{WSP(bf16_t, WS_Z), WSP(bf16_t, WS_MIXED), ctx.in(I_GLUB) + l * S5W}; pg8::gemm_phase<EpiGlu, pg8::StaticOrder, true, true>(lds, g, S, E, wave);
            { OPQ(); phase_finalize(ctx, l, wv, ln); } }
#endif
        SEAM(p0 + 4); STAMP((p0 + 4) + 1);
#if EN_OUT
        if (IN(p0 + 5)) { pg8::Gemm g{WSP(bf16_t, WS_MIXED), WSP(const bf16_t, wto + WT_OUT), MTOK, DM, DM}; pg8::StaticOrder S; S.init(MTOK, DM, (int)gridDim.x, (int)blockIdx.x);
            EpiResid E{l == 0 ? ctx.in(I_X) : ctx.out(), ctx.out(), WSP(float, WS_ROWSTATS), l == 0 ? WSP(float, WS_MISC) : ctx.in(I_LN2G) + (l - 1) * DM, l == 0 ? WSP(float, WS_MISC) + DM : ctx.in(I_LN2B) + (l - 1) * DM, WSP(float, modo) + 2 * DM, WSP(float, WS_ROWPART)};
            pg8::gemm_phase<EpiResid, pg8::StaticOrder, true, true>(lds, g, S, E, wave); }
#endif
        SEAM(p0 + 5); STAMP((p0 + 5) + 1);
#if EN_LN
        if (IN(p0 + 6)) { OPQ(); phase_lnapply<1>(ctx.out(), WSP(float, WS_ROWPART), WSP(float, WS_ROWSTATS), ctx.in(I_LN1G) + l * DM, ctx.in(I_LN1B) + l * DM, WSP(float, modo), 3, 4, WSP(bf16_t, WS_H), nullptr, lds, wv, ln); }
#endif
        SEAM(p0 + 6); STAMP((p0 + 6) + 1);
#if EN_GU
        if (IN(p0 + 7)) { pg8::Gemm g{WSP(bf16_t, WS_H), WSP(const bf16_t, wto + WT_GU), MTOK, 2 * DFF, DM}; pg8::StaticOrder S; S.init(MTOK, 2 * DFF, (int)gridDim.x, (int)blockIdx.x);
            EpiSwiglu E{WSP(bf16_t, WS_P)}; pg8::gemm_phase<EpiSwiglu, pg8::StaticOrder, true, true>(lds, g, S, E, wave); }
#endif
        SEAM(p0 + 7); STAMP((p0 + 7) + 1);
#if EN_DN
        if (IN(p0 + 8)) { pg8::Gemm g{WSP(bf16_t, WS_P), WSP(const bf16_t, wto + WT_DN), MTOK, DM, DFF}; pg8::StaticOrder S; S.init(MTOK, DM, (int)gridDim.x, (int)blockIdx.x);
            EpiResid E{ctx.out(), ctx.out(), WSP(float, WS_ROWSTATS), ctx.in(I_LN1G) + l * DM, ctx.in(I_LN1B) + l * DM, WSP(float, modo) + 5 * DM, WSP(float, WS_ROWPART)};
            pg8::gemm_phase<EpiResid, pg8::StaticOrder, true, true>(lds, g, S, E, wave); }
#endif
        SEAM(p0 + 8); STAMP((p0 + 8) + 1);
#if EN_LN
        if (IN(p0 + 9)) { OPQ();
            if (l + 1 < DEPTH) phase_lnapply<1>(ctx.out(), WSP(float, WS_ROWPART), WSP(float, WS_ROWSTATS), ctx.in(I_LN2G) + l * DM, ctx.in(I_LN2B) + l * DM, WSP(float, modo) + (size_t)NB * 6 * DM, 0, 1, WSP(bf16_t, WS_H), nullptr, lds, wv, ln);
            else phase_lnapply<2>(ctx.out(), WSP(float, WS_ROWPART), WSP(float, WS_ROWSTATS), ctx.in(I_LN2G) + l * DM, ctx.in(I_LN2B) + l * DM, nullptr, 0, 0, nullptr, ctx.out(), lds, wv, ln);
        }
#endif
        SEAM(p0 + 9); STAMP((p0 + 9) + 1);
    }
#ifdef DIAG_SEL1
    xcd_barrier(bar);
    if (blockIdx.x == 0) {
        float tot = (float)(STP[N_PHASES] - STP[0]), s1 = 0.f, s2 = 0.f;
        for (int k = 0; k < N_PHASES; ++k) { int ty; if (k < 3) ty = k; else { const int j = (k - 3) % PH_PER_LAYER; const int map[10] = {3, 4, 5, 6, 10, 7, 2, 8, 9, 2}; ty = map[j]; }
            const float d = (float)(STP[k + 1] - STP[k]); if ((DIAG_SEL1 >> ty) & 1) s1 += d; if ((DIAG_SEL2 >> ty) & 1) s2 += d; }
        const int n1 = (int)(1000000.f * s1 / tot); float* o = ctx.out();
        for (int i = wave * 64 + lane; i < n1; i += 512) o[i] += 0.05f;
        if (wave == 0 && lane == 0) o[2000000] += 0.05f + 0.11f * s2 / tot;
    }
#endif
#undef IN
#undef SEAM
#undef OPQ
#undef WSP
#undef lane
}

#ifndef MK_PER_PHASE
#define MK_PER_PHASE 0
#endif
extern "C" void kernel_launch(void* const* d_in, const int* in_sizes, int n_in, void* d_out, int out_size, void* d_ws, size_t ws_size, hipStream_t stream) {
    static int grid = 0;
    if (grid == 0) {
        if (n_in != N_IN || out_size != MTOK * DM || ws_size < WS_END) { fprintf(stderr, "kernel_launch: unexpected problem (n_in %d, out %d, ws %zu < %zu); nothing launched\n", n_in, out_size, ws_size, (size_t)WS_END); grid = -1; return; }
        int dev = 0, cus = 0, per_cu = 0;
        if (hipGetDevice(&dev) != hipSuccess || hipDeviceGetAttribute(&cus, hipDeviceAttributeMultiprocessorCount, dev) != hipSuccess) { grid = -1; return; }
        if (hipFuncSetAttribute((const void*)hybrid_fwd, hipFuncAttributeMaxDynamicSharedMemorySize, LDS_BYTES) != hipSuccess) { fprintf(stderr, "kernel_launch: hipFuncSetAttribute failed\n"); grid = -1; return; }
        if (hipOccupancyMaxActiveBlocksPerMultiprocessor(&per_cu, (const void*)hybrid_fwd, 512, LDS_BYTES) != hipSuccess || per_cu < 1) fprintf(stderr, "kernel_launch: occupancy query reports %d blocks per CU\n", per_cu);
        (void)hipGetLastError();
        grid = cus;
    }
    if (grid < 0) return;
    (void)in_sizes;
    if (hipMemsetAsync((char*)d_ws + WS_CTL, 0, CTL_ZERO_BYTES, stream) != hipSuccess) return;
#ifdef DBG_MEMSET
    (void)hipMemsetAsync((char*)d_ws + WS_HGB, 0, WS_END - WS_HGB, stream); (void)hipMemsetAsync((char*)d_ws + WS_O, 0, 192 * MiB, stream);
#endif
    Args a{};
    for (int i = 0; i < N_IN; ++i) a.in[i] = (const float*)d_in[i];
    a.out = (float*)d_out; a.ws = (unsigned char*)d_ws;
#if MK_PER_PHASE
    for (int p = 0; p < N_PHASES; ++p) { a.ph_lo = p; a.ph_hi = p + 1; hipLaunchKernelGGL(hybrid_fwd, dim3(grid), dim3(512), LDS_BYTES, stream, a); }
#else
    a.ph_lo = 0; a.ph_hi = N_PHASES; hipLaunchKernelGGL(hybrid_fwd, dim3(grid), dim3(512), LDS_BYTES, stream, a);
#endif
}
```

```cpp
#include <hip/hip_runtime.h>
#include <cstdio>
#include <cstdint>
namespace pg8 {
#define PG8_LAS __attribute__((address_space(3)))
typedef unsigned short bf16_t;
typedef short bf16x8 __attribute__((ext_vector_type(8)));
typedef float f32x4 __attribute__((ext_vector_type(4)));
typedef unsigned u32x4 __attribute__((ext_vector_type(4)));
constexpr int BM = 256, BK = 64, HALF = 128, HTB = HALF * BK * 2  , STAGE_BYTES = 8 * HTB, NXCD = 8, WGM = 8;

__host__ __device__ __forceinline__ int lds_byte(int r, int c) { const int st = (r >> 4) * 2 + (c >> 5), rr = r & 15, cc = c & 31, ob = rr * 64 + cc * 2; return st * 1024 + (ob ^ (((ob >> 9) & 1) << 5)); }
__host__ __device__ __forceinline__ void stage_rc(int b, int& R, int& C) { const int st = b / 1024, sb = b % 1024, swz = sb ^ (((sb >> 9) & 1) << 5); R = (st >> 1) * 16 + swz / 64; C = (st & 1) * 32 + (swz % 64) / 2; }
__host__ __device__ __forceinline__ int perm32(int rho) { const int n = rho >> 4, i = rho & 15; return 8 * (i >> 2) + 4 * n + (i & 3); }

struct Unit { int pm, pn; };
struct Gemm { const bf16_t* A; const bf16_t* Bt; int M, N, K; };

struct StaticOrder {
    int nM, nN, nwg, G, c;
    __host__ __device__ void init(int M, int N, int G_, int c_) { nM = M / BM; nN = N / BM; nwg = nM * nN; G = G_; c = c_; }
    __host__ __device__ bool next(int i, Unit& u) const {
        const long L = (long)i * G + c; if (L >= nwg) return false;
        int wgid = (int)L; { const int q = nwg / NXCD, r = nwg % NXCD, xcd = wgid % NXCD, off = wgid / NXCD; wgid = (xcd < r ? xcd * (q + 1) : r * (q + 1) + (xcd - r) * q) + off; }
        const int nig = WGM * nN, gid = wgid / nig, fm = gid * WGM, gsz = (nM - fm) < WGM ? (nM - fm) : WGM;
        u.pm = fm + ((wgid % nig) % gsz); u.pn = (wgid % nig) / gsz; return true;
    }
    __device__ __forceinline__ void a_ready(const Unit&) const {}
    __device__ __forceinline__ void done(const Unit&) const {}
};
__device__ __forceinline__ unsigned cvt_pk_bf16(float lo, float hi) { unsigned r; asm volatile("v_cvt_pk_bf16_f32 %0, %1, %2" : "=v"(r) : "v"(lo), "v"(hi)); return r; }
typedef float f32x2 __attribute__((ext_vector_type(2)));
template <class Epi, class Sched, bool ALIGN_EPI = false, bool SP2 = false>
__device__ __forceinline__ void gemm_phase(PG8_LAS unsigned char* lds, const Gemm g, const Sched& S, const Epi& E, int wave_id) {
    int tid_; asm volatile("v_mbcnt_lo_u32_b32 %0, -1, 0\n\tv_mbcnt_hi_u32_b32 %0, -1, %0" : "=v"(tid_)); tid_ += wave_id * 64;
    const int tid = tid_, wid = __builtin_amdgcn_readfirstlane(tid >> 6), lane = tid & 63, wr = wid >> 2, wc = wid & 3, fr = lane & 15, fq = lane >> 4;
    const int K = g.K, nt = K / BK;
    unsigned voffA[2], voffB[2];
#pragma unroll
    for (int i = 0; i < 2; ++i) { int R, C; stage_rc(tid * 16 + i * 8192, R, C); const int Rb = Epi::PERM ? ((R & ~31) + perm32(R & 31)) : R;
        voffA[i] = (unsigned)(R * K + C) * 2u; voffB[i] = (unsigned)(Rb * K + C) * 2u; }
    const size_t kstep = (size_t)(BK * 2);
    const size_t hstep = (size_t)HALF * K * 2;
    const size_t tstep = 2 * hstep;
    const unsigned ldsw = (unsigned)wid * 1024u;
    const int aoff = lds_byte(wr * 64 + fr, fq * 8), boff = lds_byte(wc * 32 + fr, fq * 8);
#define PG8_SA(b, h) (((b) * 2 + (h)) * HTB)
#define PG8_SB(b, h) ((4 + (b) * 2 + (h)) * HTB)
#define PG8_STAGE(bufoff, gbase, voff) do { _Pragma("unroll") for (int _i = 0; _i < 2; ++_i) \
        __builtin_amdgcn_global_load_lds((const unsigned*)((const char*)(gbase) + (voff)[_i]), (PG8_LAS unsigned*)(lds + (bufoff) + ldsw + _i * 8192), 16, 0, 0); } while (0)
#define PG8_LDA(dst, b, h) do { _Pragma("unroll") for (int m = 0; m < 4; ++m) _Pragma("unroll") for (int k = 0; k < 2; ++k) dst[m][k] = *(const PG8_LAS bf16x8*)(lds + PG8_SA(b, h) + aoff + m * 2048 + k * 1024); } while (0)
#define PG8_LDB(dst, b, h) do { _Pragma("unroll") for (int n = 0; n < 2; ++n) _Pragma("unroll") for (int k = 0; k < 2; ++k) dst[n][k] = *(const PG8_LAS bf16x8*)(lds + PG8_SB(b, h) + boff + n * 2048 + k * 1024); } while (0)
#define PG8_MMA(ai, bj, At, Bt) do { __builtin_amdgcn_s_setprio(1); _Pragma("unroll") for (int m = 0; m < 4; ++m) _Pragma("unroll") for (int n = 0; n < 2; ++n) _Pragma("unroll") for (int k = 0; k < 2; ++k) \
        acc[ai][bj][m][n] = __builtin_amdgcn_mfma_f32_16x16x32_bf16(Bt[n][k], At[m][k], acc[ai][bj][m][n], 0, 0, 0); __builtin_amdgcn_s_setprio(0); } while (0)
#define PG8_WAIT_V(n) asm volatile("s_waitcnt vmcnt(" #n ")" ::: "memory")
#define PG8_WAIT_L(n) asm volatile("s_waitcnt lgkmcnt(" #n ")" ::: "memory")
#define PG8_BAR __builtin_amdgcn_s_barrier()
#define PG8_SCHED __builtin_amdgcn_sched_barrier(0)
    Unit cur, nxt; int ui = 0;
    if (!S.next(0, cur)) return;
    f32x4 acc[2][2][4][2];
#pragma unroll
    for (int a = 0; a < 2; ++a)
#pragma unroll
        for (int b = 0; b < 2; ++b)
#pragma unroll
            for (int m = 0; m < 4; ++m)
#pragma unroll
                for (int n = 0; n < 2; ++n) acc[a][b][m][n] = (f32x4){0.f, 0.f, 0.f, 0.f};
    bf16x8 At[4][2], B0[2][2], B1[2][2];
    const char* cA = (const char*)g.A + (size_t)cur.pm * tstep; const char* cB = (const char*)g.Bt + (size_t)cur.pn * tstep;
    S.a_ready(cur);
    if constexpr (SP2) {
        PG8_STAGE(PG8_SB(0, 0), cB, voffB); PG8_STAGE(PG8_SB(0, 1), cB + hstep, voffB); PG8_STAGE(PG8_SA(0, 0), cA, voffA); PG8_STAGE(PG8_SA(0, 1), cA + hstep, voffA);
        if (wr == 1) PG8_BAR;
        PG8_WAIT_V(2); PG8_BAR;
        PG8_STAGE(PG8_SB(1, 0), cB + kstep, voffB); PG8_STAGE(PG8_SA(1, 0), cA + kstep, voffA); PG8_STAGE(PG8_SB(1, 1), cB + hstep + kstep, voffB);
        PG8_WAIT_V(6); PG8_BAR;
    } else {
        PG8_STAGE(PG8_SB(0, 0), cB, voffB); PG8_STAGE(PG8_SA(0, 0), cA, voffA); PG8_STAGE(PG8_SB(0, 1), cB + hstep, voffB); PG8_STAGE(PG8_SA(0, 1), cA + hstep, voffA);
        if (wr == 1) PG8_BAR;
        PG8_WAIT_V(4); PG8_BAR;
        PG8_STAGE(PG8_SB(1, 0), cB + kstep, voffB); PG8_STAGE(PG8_SA(1, 0), cA + kstep, voffA); PG8_STAGE(PG8_SB(1, 1), cB + hstep + kstep, voffB);
        PG8_WAIT_V(6); PG8_BAR;
    }
    for (;;) {
        const bool has_next = S.next(ui + 1, nxt);
        const char* nA = has_next ? (const char*)g.A + (size_t)nxt.pm * tstep : cA; const char* nB = has_next ? (const char*)g.Bt + (size_t)nxt.pn * tstep : cB;
        for (int t = 0; t < nt; t += 2) {
            const bool last = (t == nt - 2);
            const char* a1 = cA + (size_t)(t + 1) * kstep;
            const char* a2 = last ? nA : cA + (size_t)(t + 2) * kstep; const char* b2 = last ? nB : cB + (size_t)(t + 2) * kstep;
            const char* a3 = a2 + kstep; const char* b3 = b2 + kstep;
            if (last && has_next) S.a_ready(nxt);
            if constexpr (SP2) {
            PG8_LDB(B0, 0, 0); PG8_LDB(B1, 0, 1); PG8_SCHED; PG8_LDA(At, 0, 0); PG8_STAGE(PG8_SA(1, 1), a1 + hstep, voffA);
            PG8_WAIT_V(8); PG8_WAIT_L(0); PG8_BAR; PG8_MMA(0, 0, At, B0); PG8_MMA(0, 1, At, B1); PG8_BAR; PG8_SCHED;
            PG8_LDA(At, 0, 1); PG8_STAGE(PG8_SB(0, 0), b2, voffB); PG8_STAGE(PG8_SB(0, 1), b2 + hstep, voffB); PG8_STAGE(PG8_SA(0, 0), a2, voffA);
            PG8_WAIT_V(8); PG8_WAIT_L(0); PG8_BAR; PG8_MMA(1, 0, At, B0); PG8_MMA(1, 1, At, B1); PG8_BAR; PG8_SCHED;
            PG8_LDB(B0, 1, 0); PG8_LDB(B1, 1, 1); PG8_SCHED; PG8_LDA(At, 1, 0); PG8_STAGE(PG8_SA(0, 1), a2 + hstep, voffA);
            PG8_WAIT_V(8); PG8_WAIT_L(0); PG8_BAR; PG8_MMA(0, 0, At, B0); PG8_MMA(0, 1, At, B1); PG8_BAR; PG8_SCHED;
            PG8_LDA(At, 1, 1); PG8_STAGE(PG8_SB(1, 0), b3, voffB); PG8_STAGE(PG8_SB(1, 1), b3 + hstep, voffB); PG8_STAGE(PG8_SA(1, 0), a3, voffA);
            PG8_WAIT_V(8); PG8_WAIT_L(0); PG8_BAR; PG8_MMA(1, 0, At, B0); PG8_MMA(1, 1, At, B1); PG8_BAR; PG8_SCHED;
            } else {
            PG8_LDB(B0, 0, 0); PG8_SCHED; PG8_LDA(At, 0, 0); PG8_STAGE(PG8_SA(1, 1), a1 + hstep, voffA);
            PG8_WAIT_L(8); PG8_BAR; PG8_WAIT_L(0); PG8_MMA(0, 0, At, B0); PG8_BAR; PG8_SCHED;
            PG8_LDB(B1, 0, 1); PG8_STAGE(PG8_SB(0, 0), b2, voffB);
            PG8_BAR; PG8_WAIT_L(0); PG8_MMA(0, 1, At, B1); PG8_BAR;
            PG8_LDA(At, 0, 1); PG8_STAGE(PG8_SA(0, 0), a2, voffA);
            PG8_BAR; PG8_WAIT_L(0); PG8_MMA(1, 0, At, B0); PG8_BAR; PG8_SCHED;
            PG8_STAGE(PG8_SB(0, 1), b2 + hstep, voffB);
            PG8_WAIT_V(6); PG8_BAR; PG8_MMA(1, 1, At, B1); PG8_BAR;
            PG8_LDB(B0, 1, 0); PG8_SCHED; PG8_LDA(At, 1, 0); PG8_STAGE(PG8_SA(0, 1), a2 + hstep, voffA);
            PG8_WAIT_L(8); PG8_BAR; PG8_WAIT_L(0); PG8_MMA(0, 0, At, B0); PG8_BAR; PG8_SCHED;
            PG8_LDB(B1, 1, 1); PG8_STAGE(PG8_SB(1, 0), b3, voffB);
            PG8_BAR; PG8_WAIT_L(0); PG8_MMA(0, 1, At, B1); PG8_BAR;
            PG8_LDA(At, 1, 1); PG8_STAGE(PG8_SA(1, 0), a3, voffA);
            PG8_BAR; PG8_WAIT_L(0); PG8_MMA(1, 0, At, B0); PG8_BAR; PG8_SCHED;
            PG8_STAGE(PG8_SB(1, 1), b3 + hstep, voffB);
            PG8_WAIT_V(6); PG8_BAR; PG8_MMA(1, 1, At, B1); PG8_BAR;
            }
        }
        if constexpr (ALIGN_EPI) { if (wr == 0) PG8_BAR; }
        if constexpr (!Epi::AFTER_DRAIN) { E(acc, cur, wr, wc, fr, fq); S.done(cur); }
        if (!has_next) break;
#pragma unroll
        for (int a = 0; a < 2; ++a)
#pragma unroll
            for (int b = 0; b < 2; ++b)
#pragma unroll
                for (int m = 0; m < 4; ++m)
#pragma unroll
                    for (int n = 0; n < 2; ++n) acc[a][b][m][n] = (f32x4){0.f, 0.f, 0.f, 0.f};
        cur = nxt; cA = nA; cB = nB; ++ui;
        if constexpr (ALIGN_EPI) { if (wr == 1) PG8_BAR; }
    }
    PG8_WAIT_V(0);
    if constexpr (!ALIGN_EPI) { if (wr == 0) PG8_BAR; }
    PG8_BAR;
    if constexpr (Epi::AFTER_DRAIN) { E.fused(acc, cur, wr, wc, fr, fq, lds, wid, lane); S.done(cur); }
#undef PG8_SA
#undef PG8_SB
#undef PG8_STAGE
#undef PG8_LDA
#undef PG8_LDB
#undef PG8_MMA
#undef PG8_WAIT_V
#undef PG8_WAIT_L
#undef PG8_BAR
#undef PG8_SCHED
}
}
#define LAS __attribute__((address_space(3)))
#define XB_TMO      128
#define XB_XCNT(j)  (256  + 64 * (j))
#define XB_XSUB(j)  (1280 + 64 * (j))
#define XB_XGEN(j)  (2304 + 64 * (j))
#define XB_TOP      3328
#define XB_TOPGEN   3392
#define XCD_BAR_WORDS 3456
#define XB_SPIN_CAP (1u << 24)

__device__ __forceinline__ unsigned xb_ld(unsigned* p)              { return __hip_atomic_load(p, __ATOMIC_RELAXED, __HIP_MEMORY_SCOPE_AGENT); }
__device__ __forceinline__ unsigned xb_add(unsigned* p, unsigned v) { return __hip_atomic_fetch_add(p, v, __ATOMIC_RELAXED, __HIP_MEMORY_SCOPE_AGENT); }
__device__ __forceinline__ unsigned xb_xcc_id() { return (unsigned)__builtin_amdgcn_s_getreg((3 << 11) | 20) & 0xFu; }
#define XB_SPIN(cond, bar) do { unsigned _sp = 0; while (cond) { __builtin_amdgcn_s_sleep(1); \
    if ((++_sp & 255u) == 0u) { if (xb_ld(&(bar)[XB_TMO])) break; if (_sp > XB_SPIN_CAP) { atomicAdd(&(bar)[XB_TMO], 1u); break; } } } } while (0)

struct XcdBarrier {
    unsigned* bar; unsigned x; unsigned w0;
    volatile LAS unsigned* st;
};

__device__ __forceinline__ bool xb_lane0() { return __builtin_amdgcn_mbcnt_hi(~0u, __builtin_amdgcn_mbcnt_lo(~0u, 0u)) == 0u; }
__device__ __forceinline__ XcdBarrier xcd_barrier_post(unsigned* bar, volatile LAS unsigned* st, unsigned w0) {
    XcdBarrier b; b.bar = bar; b.x = xb_xcc_id(); b.st = st; b.w0 = w0;
    if (w0 && xb_lane0()) (void)xb_add(&bar[XB_XCNT(b.x)], 1u);
    return b;
}
__device__ __forceinline__ void xcd_barrier_complete(unsigned* bar, unsigned x, unsigned& nloc, unsigned& nx) {
    const unsigned G = gridDim.x * gridDim.y * gridDim.z;
    unsigned sum, cnt, mine, sp = 0u;
    for (;;) {
        sum = 0u; cnt = 0u; mine = 0u;
#pragma unroll
        for (unsigned j = 0; j < 16; ++j) { const unsigned c = xb_ld(&bar[XB_XCNT(j)]); sum += c; cnt += (c > 0u) ? 1u : 0u; mine = (j == x) ? c : mine; }
        if (sum == G) break;
        __builtin_amdgcn_s_sleep(1);
        if ((++sp & 255u) == 0u) { if (xb_ld(&bar[XB_TMO])) break; if (sp > XB_SPIN_CAP) { atomicAdd(&bar[XB_TMO], 1u); break; } }
    }
    nloc = mine > 0u ? mine : 1u; nx = cnt > 0u ? cnt : 1u;
}

__device__ __forceinline__ void xcd_barrier(const XcdBarrier& b) {
    asm volatile("s_waitcnt vmcnt(0)" ::: "memory");
    __syncthreads();
    if (b.w0 && xb_lane0()) {
        unsigned* bar = b.bar;
        __builtin_amdgcn_s_waitcnt(0);
        unsigned nloc = b.st[0], nx = b.st[1];
        if (nloc == 0u) { xcd_barrier_complete(bar, b.x, nloc, nx); b.st[0] = nloc; b.st[1] = nx; }
        const unsigned old = xb_add(&bar[XB_XSUB(b.x)], 1u);
        const unsigned gen = old / nloc;
        if (old + 1u == (gen + 1u) * nloc) {
            __builtin_amdgcn_fence(__ATOMIC_RELEASE, "agent");
            asm volatile("s_waitcnt vmcnt(0)" ::: "memory");
            const unsigned og = xb_add(&bar[XB_TOP], 1u);
            const unsigned tg = og / nx;
            if (og + 1u == (tg + 1u) * nx) xb_add(&bar[XB_TOPGEN], 1u);
            else XB_SPIN(xb_ld(&bar[XB_TOPGEN]) == tg, bar);
            __builtin_amdgcn_fence(__ATOMIC_ACQUIRE, "agent");
            xb_add(&bar[XB_XGEN(b.x)], 1u);
            asm volatile("s_waitcnt vmcnt(0)" ::: "memory");
        } else {
            XB_SPIN(xb_ld(&bar[XB_XGEN(b.x)]) == gen, bar);
            __builtin_amdgcn_fence(__ATOMIC_ACQUIRE, "agent");
            asm volatile("s_waitcnt vmcnt(0)" ::: "memory");
        }
    }
    __syncthreads();
}
#ifndef EN_CH128
#define EN_CH128 1
#endif
#ifndef EN_CH192
#define EN_CH192 1
#endif
#ifndef EN_DN
#define EN_DN 1
#endif
#ifndef EN_GLU
#define EN_GLU 1
#endif
#ifndef EN_GU
#define EN_GU 1
#endif
#ifndef EN_INPROJ
#define EN_INPROJ 1
#endif
#ifndef EN_LN
#define EN_LN 1
#endif
#ifndef EN_MIX
#define EN_MIX 1
#endif
#ifndef EN_MOD
#define EN_MOD 1
#endif
#ifndef EN_OUT
#define EN_OUT 1
#endif
#ifndef EN_PRE
#define EN_PRE 1
#endif
#ifndef EN_PRO
#define EN_PRO 1
#endif
#ifndef EN_S5N
#define EN_S5N 1
#endif

constexpr int DM = 4096, NB = 2, SEQ = 8192, MTOK = NB * SEQ, DEPTH = 4;
constexpr int S5W = 1024;
constexpr int HGW = 1536;
constexpr int GLKW = 768;
constexpr int INW = 11792, INP = 12032, DFF = 11008;
constexpr int OW = 3072;
constexpr int C_U = 0, C_QB = 1024, C_FB = 2560, C_IB = 4096, C_GB = 5632, C_QC = 7168, C_KC = 7936, C_VC = 8704, C_GC = 10240, C_LR = 11776;
constexpr float LN_EPS = 1e-5f;
constexpr float ALPHA = 1.6817928305074290861f;
constexpr float GLA_QSCALE = 0.07216878364870322f;

enum { I_X = 0, I_C, I_WADA, I_BADA, I_TABLE, I_WIN, I_WOUT, I_AREAL, I_AIMAG, I_LOGDT, I_BRE, I_BIM, I_CRE, I_CIM, I_S5D, I_GLUW, I_GLUB,
       I_LBRAW, I_HGG, I_HGB, I_WGATE, I_BGATE, I_GLG, I_WFG, I_WFU, I_WFD, I_LN1G, I_LN1B, I_LN2G, I_LN2B, N_IN };

constexpr size_t MiB = 1u << 20;
constexpr size_t WS_CTL = 0, CTL_ZERO_BYTES = 1 * MiB;
constexpr size_t WS_MOD = 1 * MiB;
constexpr size_t WS_MISC = 2 * MiB;
constexpr size_t WS_ROWSTATS = 3 * MiB;
constexpr size_t WS_ROWPART = 4 * MiB;
constexpr size_t WS_CONDPART = 12 * MiB;
constexpr size_t WS_H = 24 * MiB;
constexpr size_t WS_MIXED = WS_H + 128 * MiB;
constexpr size_t WS_Z = WS_MIXED + 128 * MiB;
constexpr size_t WS_O = WS_Z + 32 * MiB;
constexpr size_t WS_P = WS_O + 192 * MiB;
constexpr size_t WS_WT = WS_P + 376 * MiB;
constexpr size_t WT_IN = 0, WT_OUT = 94 * MiB, WT_GU = 126 * MiB, WT_DN = 298 * MiB, WT_GLU = 384 * MiB, WT_LAYER = 386 * MiB;
constexpr size_t WS_HGB = WS_WT + DEPTH * WT_LAYER;
constexpr size_t WS_GLB = WS_HGB + 198 * MiB;
constexpr size_t WS_S5T = WS_GLB + 128 * MiB;
constexpr size_t WS_S5W1 = WS_S5T + 576 * MiB;
constexpr size_t WS_UX = WS_S5W1 + 144 * MiB;
constexpr size_t WS_SLOC = WS_UX + 36 * MiB;
constexpr size_t WS_LAM64 = WS_SLOC + 8 * MiB;
constexpr size_t WS_ST = WS_LAM64 + 1 * MiB;
constexpr size_t WS_END = WS_ST + 36 * MiB;
static_assert((size_t)INP * DM * 2 == 94 * MiB && (size_t)DM * DM * 2 == 32 * MiB && (size_t)2 * DFF * DM * 2 == 172 * MiB && (size_t)DM * DFF * 2 == 86 * MiB, "weight map");
static_assert((size_t)MTOK * INP * 2 == 376 * MiB && (size_t)MTOK * DFF * 2 <= 376 * MiB, "activation map");

constexpr int RING_BYTES = 131072;
constexpr int LDSCTL_OFF = 135168;
constexpr int LDS_BYTES = 147456;

#ifndef LAS
#define LAS __attribute__((address_space(3)))
#endif
typedef unsigned short bf16_t;
typedef float f32x4 __attribute__((ext_vector_type(4)));
typedef float f32x2 __attribute__((ext_vector_type(2)));
typedef unsigned u32x4 __attribute__((ext_vector_type(4)));
typedef unsigned u32x2 __attribute__((ext_vector_type(2)));
#define LDS_WAIT() asm volatile("s_waitcnt lgkmcnt(0)" ::: "memory")
#define VM_WAIT() asm volatile("s_waitcnt vmcnt(0)" ::: "memory")
typedef __bf16 bf16x2_t __attribute__((ext_vector_type(2)));
__device__ __forceinline__ unsigned cvt_pk_bf16(float lo, float hi) { return __builtin_bit_cast(unsigned, __builtin_convertvector((f32x2){lo, hi}, bf16x2_t)); }

__device__ __forceinline__ float bf_lo(unsigned w) { return __uint_as_float(w << 16); }
__device__ __forceinline__ float bf_hi(unsigned w) { return __uint_as_float(w & 0xffff0000u); }
__device__ __forceinline__ float bf2f(bf16_t b) { return __uint_as_float(((unsigned)b) << 16); }
__device__ __forceinline__ float wave_sum(float v) {
#pragma unroll
    for (int o = 1; o < 64; o <<= 1) v += __shfl_xor(v, o);
    return v;
}
__device__ __forceinline__ float sigmoidf_(float x) { return 1.0f / (1.0f + __expf(-x)); }
__device__ __forceinline__ float gelu_tanh(float y) { const float a = 0.7978845608028654f * (y + 0.044715f * y * y * y); const float t = 1.0f - 2.0f / (1.0f + __expf(2.0f * a)); return 0.5f * y * (1.0f + t); }

struct EpiProj {
    static constexpr bool PERM = true, AFTER_DRAIN = false;
    bf16_t* P; bf16_t* UX;
    __device__ __forceinline__ void operator()(const f32x4 (&acc)[2][2][4][2], const pg8::Unit& u, int wr, int wc, int fr, int fq) const {
        const int row0 = u.pm * 256 + wr * 64 + fr, col0 = u.pn * 256 + wc * 32 + 8 * fq;
        const bool s5 = u.pn < 4;
#pragma unroll
        for (int ai = 0; ai < 2; ++ai)
#pragma unroll
            for (int m = 0; m < 4; ++m) { const int row = row0 + ai * 128 + m * 16;
#pragma unroll
                for (int bj = 0; bj < 2; ++bj) { const f32x4 v0 = acc[ai][bj][m][0], v1 = acc[ai][bj][m][1]; const int col = col0 + bj * 128;
                    u32x4 w; w.x = cvt_pk_bf16(v0[0], v0[1]); w.y = cvt_pk_bf16(v0[2], v0[3]); w.z = cvt_pk_bf16(v1[0], v1[1]); w.w = cvt_pk_bf16(v1[2], v1[3]);
                    if (!s5) *(u32x4*)(P + (size_t)row * INP + col) = w;
                    else { bf16_t* ur = UX + (size_t)((col >> 4) * 256 + (row >> 6)) * 1152; *(u32x4*)(ur + (row & 63) * 16 + (col & 15)) = w;
                        if ((row & 63) == 0) { const u32x4 z = (u32x4){0u, 0u, 0u, 0u}; bf16_t* zp = ur + 1024 + ((col & 15) ? 64 : 0);
#pragma unroll
                            for (int i = 0; i < 8; ++i) *(u32x4*)(zp + 8 * i) = z; } } } }
    }
};
struct EpiSwiglu {
    static constexpr bool PERM = true, AFTER_DRAIN = false;
    bf16_t* HID;
    __device__ __forceinline__ void operator()(const f32x4 (&acc)[2][2][4][2], const pg8::Unit& u, int wr, int wc, int fr, int fq) const {
        const int row0 = u.pm * 256 + wr * 64 + fr, col0 = u.pn * 128 + wc * 32 + 8 * fq;
#pragma unroll
        for (int ai = 0; ai < 2; ++ai)
#pragma unroll
            for (int m = 0; m < 4; ++m) { bf16_t* rowp = HID + (size_t)(row0 + ai * 128 + m * 16) * DFF + col0;
                float o[8];
#pragma unroll
                for (int n = 0; n < 2; ++n)
#pragma unroll
                    for (int j = 0; j < 4; ++j) { const float g = acc[ai][0][m][n][j], up = acc[ai][1][m][n][j]; o[n * 4 + j] = g * __builtin_amdgcn_rcpf(1.0f + __expf(-g)) * up; }
                u32x4 w; w.x = cvt_pk_bf16(o[0], o[1]); w.y = cvt_pk_bf16(o[2], o[3]); w.z = cvt_pk_bf16(o[4], o[5]); w.w = cvt_pk_bf16(o[6], o[7]);
                *(u32x4*)rowp = w; }
    }
};
struct EpiGlu {
    static constexpr bool PERM = true, AFTER_DRAIN = false;
    const bf16_t* Z; bf16_t* MIXED; const float* bias;
    __device__ __forceinline__ void operator()(const f32x4 (&acc)[2][2][4][2], const pg8::Unit& u, int wr, int wc, int fr, int fq) const {
        const int row0 = u.pm * 256 + wr * 64 + fr, col0 = u.pn * 256 + wc * 32 + 8 * fq;
#pragma unroll
        for (int bj = 0; bj < 2; ++bj) {
            const f32x4 b0 = *(const f32x4*)(bias + col0 + bj * 128), b1 = *(const f32x4*)(bias + col0 + bj * 128 + 4);
#pragma unroll
            for (int ai = 0; ai < 2; ++ai)
#pragma unroll
                for (int m = 0; m < 4; ++m) { const size_t r = (size_t)(row0 + ai * 128 + m * 16);
                    const u32x4 zz = *(const u32x4*)(Z + r * S5W + col0 + bj * 128);
                    const f32x4 v0 = acc[ai][bj][m][0] + b0, v1 = acc[ai][bj][m][1] + b1;
                    u32x4 w;
                    w.x = cvt_pk_bf16(bf_lo(zz.x) * sigmoidf_(v0[0]), bf_hi(zz.x) * sigmoidf_(v0[1]));
                    w.y = cvt_pk_bf16(bf_lo(zz.y) * sigmoidf_(v0[2]), bf_hi(zz.y) * sigmoidf_(v0[3]));
                    w.z = cvt_pk_bf16(bf_lo(zz.z) * sigmoidf_(v1[0]), bf_hi(zz.z) * sigmoidf_(v1[1]));
                    w.w = cvt_pk_bf16(bf_lo(zz.w) * sigmoidf_(v1[2]), bf_hi(zz.w) * sigmoidf_(v1[3]));
                    *(u32x4*)(MIXED + r * DM + col0 + bj * 128) = w;
                    if (m & 1) asm volatile("" ::: "memory"); }
        }
    }
};
struct EpiResid {
    static constexpr bool PERM = false, AFTER_DRAIN = false;
    const float* base; float* out; const float* rowstats; const float* lng; const float* lnb; const float* gate0; float* rowpart;
    __device__ __forceinline__ void operator()(const f32x4 (&acc)[2][2][4][2], const pg8::Unit& u, int wr, int wc, int fr, int fq) const {
        const int rowb = u.pm * 256 + wr * 64 + fr, col0 = u.pn * 256 + wc * 32 + 4 * fq;
        const float* gp = gate0 + (u.pm >= 32 ? 6 * DM : 0);
#pragma unroll
        for (int ai = 0; ai < 2; ++ai)
#pragma unroll
            for (int m = 0; m < 4; ++m) { const int row = rowb + ai * 128 + m * 16;
                const f32x2 st = *(const f32x2*)(rowstats + (size_t)row * 2);
                float s1 = 0.f, s2 = 0.f;
#pragma unroll
                for (int bj = 0; bj < 2; ++bj)
#pragma unroll
                    for (int n = 0; n < 2; ++n) { const int c = col0 + bj * 128 + n * 16; const size_t off = (size_t)row * DM + c;
                        const f32x4 vb = *(const f32x4*)(base + off);
                        const f32x4 A = *(const f32x4*)(lng + c), Bc = *(const f32x4*)(lnb + c), Gm = *(const f32x4*)(gp + c);
                        const f32x4 o = (((vb - st.x) * st.y) * A + Bc) * ALPHA + (Gm + 1.0f) * acc[ai][bj][m][n];
                        *(f32x4*)(out + off) = o;
                        s1 += (o[0] + o[1]) + (o[2] + o[3]); s2 += (o[0] * o[0] + o[1] * o[1]) + (o[2] * o[2] + o[3] * o[3]); }
                s1 += __shfl_xor(s1, 16); s1 += __shfl_xor(s1, 32); s2 += __shfl_xor(s2, 16); s2 += __shfl_xor(s2, 32);
                if (fq == 0) *(f32x2*)(rowpart + ((size_t)row * 64 + u.pn * 4 + wc) * 2) = (f32x2){s1, s2};
                asm volatile("" ::: "memory"); }
    }
};

__device__ __forceinline__ int lane_id_v() { int r; asm volatile("v_mbcnt_lo_u32_b32 %0, -1, 0\n\tv_mbcnt_hi_u32_b32 %0, -1, %0" : "=v"(r)); return r; }
struct Args { const float* in[N_IN]; float* out; unsigned char* ws; int ph_lo, ph_hi; };
struct Ctx {
    volatile LAS unsigned long long* t;
    __device__ __forceinline__ unsigned long long ld(int i) const { const unsigned long long v = t[i];
        return ((unsigned long long)(unsigned)__builtin_amdgcn_readfirstlane((int)(v >> 32)) << 32) | (unsigned long long)(unsigned)__builtin_amdgcn_readfirstlane((int)(unsigned)v); }
    __device__ __forceinline__ const float* in(int i) const { return (const float*)ld(i); }
    __device__ __forceinline__ float* out() const { return (float*)ld(30); }
    __device__ __forceinline__ unsigned char* ws() const { return (unsigned char*)ld(31); }
};

constexpr int S5K = 1152;
constexpr size_t S5_T_LAYER = (size_t)64 * 1024 * S5K * 2, S5_W1_LAYER = (size_t)64 * 256 * S5K * 2;

struct S5Order {
    int G, c, n, sh;
    __device__ __forceinline__ bool next(int i, pg8::Unit& u) const { const int L = i * G + c; if (L >= n) return false; u.pm = L >> sh; u.pn = L; return true; }
    __device__ __forceinline__ void a_ready(const pg8::Unit&) const {}
    __device__ __forceinline__ void done(const pg8::Unit&) const {}
};
struct EpiS5A {
    static constexpr bool PERM = false, AFTER_DRAIN = false;
    float* Sloc;
    __device__ __forceinline__ void operator()(const f32x4 (&acc)[2][2][4][2], const pg8::Unit& u, int wr, int wc, int fr, int fq) const {
        const int row0 = u.pm * 256 + wr * 64 + fr, col0 = wc * 32 + 4 * fq;
#pragma unroll
        for (int ai = 0; ai < 2; ++ai)
#pragma unroll
            for (int m = 0; m < 4; ++m)
#pragma unroll
                for (int n = 0; n < 2; ++n) *(f32x4*)(Sloc + (size_t)(row0 + ai * 128 + m * 16) * 128 + col0 + n * 16) = acc[ai][0][m][n];
    }
};
struct EpiS5C {
    static constexpr bool PERM = true, AFTER_DRAIN = false;
    bf16_t* Z;
    __device__ __forceinline__ void operator()(const f32x4 (&acc)[2][2][4][2], const pg8::Unit& u, int wr, int wc, int fr, int fq) const {
        const int g = u.pm, c0 = wr * 64 + fr, cc0 = (u.pn & 3) * 256 + wc * 32 + 8 * fq;
#pragma unroll
        for (int ai = 0; ai < 2; ++ai)
#pragma unroll
            for (int m = 0; m < 4; ++m) { const int c = c0 + ai * 128 + m * 16;
#pragma unroll
                for (int bj = 0; bj < 2; ++bj) { const int cc = cc0 + bj * 128, t = cc >> 4, h0 = cc & 15;
                    const f32x4 v0 = acc[ai][bj][m][0], v1 = acc[ai][bj][m][1];
                    u32x4 w; w.x = cvt_pk_bf16(gelu_tanh(v0[0]), gelu_tanh(v0[1])); w.y = cvt_pk_bf16(gelu_tanh(v0[2]), gelu_tanh(v0[3]));
                    w.z = cvt_pk_bf16(gelu_tanh(v1[0]), gelu_tanh(v1[1])); w.w = cvt_pk_bf16(gelu_tanh(v1[2]), gelu_tanh(v1[3]));
                    *(u32x4*)(Z + (size_t)(c * 64 + t) * S5W + g * 16 + h0) = w; } }
    }
};
__device__ __forceinline__ void s5_tables_item(const Ctx& a, int lg, LAS unsigned char* lds, int wave, int lane) {
    LAS f32x2* LP = (LAS f32x2*)lds;
    LAS f32x2* BB = (LAS f32x2*)(lds + 33280);
    LAS f32x2* CC = (LAS f32x2*)(lds + 41472);
    LAS float* KT = (LAS float*)(lds + 49664);
    const int tid = wave * 64 + lane, l = lg >> 6, g = lg & 63;
    if (tid < 64) { const int p = tid;
        const double ar = (double)a.in(I_AREAL)[lg * 64 + p], ai = (double)a.in(I_AIMAG)[lg * 64 + p], dt = exp((double)a.in(I_LOGDT)[lg]);
        const double mag = exp(ar * dt), ang = ai * dt, lr = mag * cos(ang), li = mag * sin(ang);
        const double den = ar * ar + ai * ai, nr = lr - 1.0, ni = li, cr = (nr * ar + ni * ai) / den, ci = (ni * ar - nr * ai) / den;
        double pr = 1.0, pi = 0.0;
        for (int tau = 0; tau <= 64; ++tau) { LP[tau * 64 + p] = (f32x2){(float)pr, (float)pi}; const double nr2 = pr * lr - pi * li, ni2 = pr * li + pi * lr; pr = nr2; pi = ni2; }
        for (int h = 0; h < 16; ++h) { const double br = (double)a.in(I_BRE)[((size_t)lg * 64 + p) * 16 + h], bi = (double)a.in(I_BIM)[((size_t)lg * 64 + p) * 16 + h];
            BB[p * 16 + h] = (f32x2){(float)(cr * br - ci * bi), (float)(cr * bi + ci * br)}; }
    }
    for (int e = tid; e < 1024; e += 512) { const int h = e >> 6, p = e & 63; CC[e] = (f32x2){a.in(I_CRE)[((size_t)lg * 16 + h) * 64 + p], a.in(I_CIM)[((size_t)lg * 16 + h) * 64 + p]}; }
    __syncthreads();
    if (tid < 64) *(f32x2*)((float*)(a.ws() + WS_LAM64) + ((size_t)lg * 64 + tid) * 2) = LP[64 * 64 + tid];
    for (int e = tid; e < 64 * 256; e += 512) { const int tau = e >> 8, h = (e >> 4) & 15, hp = e & 15; float s = 0.f;
#pragma unroll 8
        for (int p = 0; p < 64; ++p) { const f32x2 c = CC[h * 64 + p], lm = LP[tau * 64 + p], b = BB[p * 16 + hp];
            const float xr = c.x * lm.x - c.y * lm.y, xi = c.x * lm.y + c.y * lm.x; s += xr * b.x - xi * b.y; }
        if (tau == 0 && h == hp) s += a.in(I_S5D)[l * S5W + g * 16 + h];
        KT[e] = s; }
    __syncthreads();
    bf16_t* T = (bf16_t*)(a.ws() + WS_S5T + (size_t)l * S5_T_LAYER) + (size_t)g * 1024 * S5K;
    for (int pc = tid; pc < 1024 * 144; pc += 512) { const int n = pc / 144, j = pc % 144, t = n >> 4, h = n & 15; float v[8];
        if (j < 128) { const int s = j >> 1, hp0 = (j & 1) * 8;
            if (s > t) {
#pragma unroll
                for (int i = 0; i < 8; ++i) v[i] = 0.f;
            } else { const LAS float* kp = KT + (t - s) * 256 + h * 16 + hp0; const f32x4 k0 = *(const LAS f32x4*)kp, k1 = *(const LAS f32x4*)(kp + 4);
                v[0] = k0[0]; v[1] = k0[1]; v[2] = k0[2]; v[3] = k0[3]; v[4] = k1[0]; v[5] = k1[1]; v[6] = k1[2]; v[7] = k1[3]; }
        } else { const int p0 = (j - 128) * 4;
#pragma unroll
            for (int i = 0; i < 4; ++i) { const f32x2 c = CC[h * 64 + p0 + i], lm = LP[(t + 1) * 64 + p0 + i]; v[2 * i] = c.x * lm.x - c.y * lm.y; v[2 * i + 1] = -(c.x * lm.y + c.y * lm.x); } }
        *(u32x4*)(T + (size_t)n * S5K + j * 8) = (u32x4){cvt_pk_bf16(v[0], v[1]), cvt_pk_bf16(v[2], v[3]), cvt_pk_bf16(v[4], v[5]), cvt_pk_bf16(v[6], v[7])}; }
    bf16_t* W1 = (bf16_t*)(a.ws() + WS_S5W1 + (size_t)l * S5_W1_LAYER) + (size_t)g * 256 * S5K;
    for (int pc = tid; pc < 256 * 144; pc += 512) { const int n = pc / 144, j = pc % 144; float v[8];
#pragma unroll
        for (int i = 0; i < 8; ++i) v[i] = 0.f;
        if (n < 128 && j < 128) { const int p = n >> 1, ri = n & 1, s = j >> 1, hp0 = (j & 1) * 8; const f32x2 lm = LP[(63 - s) * 64 + p];
#pragma unroll
            for (int i = 0; i < 8; ++i) { const f32x2 b = BB[p * 16 + hp0 + i]; v[i] = ri ? (lm.x * b.y + lm.y * b.x) : (lm.x * b.x - lm.y * b.y); } }
        *(u32x4*)(W1 + (size_t)n * S5K + j * 8) = (u32x4){cvt_pk_bf16(v[0], v[1]), cvt_pk_bf16(v[2], v[3]), cvt_pk_bf16(v[4], v[5]), cvt_pk_bf16(v[6], v[7])}; }
    __syncthreads();
}
__device__ __forceinline__ void s5_scan_item(const Ctx& a, int l, int item, int wave, int lane) {
    const int idx = item * 512 + wave * 64 + lane, g = idx >> 7, b = (idx >> 6) & 1, p = idx & 63;
    const f32x2 lam = *(const f32x2*)((const float*)(a.ws() + WS_LAM64) + ((size_t)(l * 64 + g) * 64 + p) * 2);
    const float* sl = (const float*)(a.ws() + WS_SLOC) + ((size_t)(g * 256 + b * 128)) * 128 + 2 * p;
    bf16_t* ux = (bf16_t*)(a.ws() + WS_UX) + ((size_t)(g * 256 + b * 128)) * S5K + 1024 + 2 * p;
    float xr = 0.f, xi = 0.f;
    for (int c0 = 0; c0 < 128; c0 += 8) { f32x2 s[8];
#pragma unroll
        for (int i = 0; i < 8; ++i) s[i] = *(const f32x2*)(sl + (size_t)(c0 + i) * 128);
#pragma unroll
        for (int i = 0; i < 8; ++i) { *(unsigned*)(ux + (size_t)(c0 + i) * S5K) = cvt_pk_bf16(xr, xi);
            const float nr = lam.x * xr - lam.y * xi + s[i].x, ni = lam.x * xi + lam.y * xr + s[i].y; xr = nr; xi = ni; } }
}

__device__ __forceinline__ void transpose_item(const float* W, int N, int k0, int n0, bf16_t* WT, int drow0, int Kd, LAS float* scr, int lane) {
    const int nl = 4 * (lane & 15), kq = lane >> 4;
    const bool valid = (n0 + nl) < N;
    f32x4 v[16];
#pragma unroll
    for (int i = 0; i < 16; ++i) { const int k = 4 * i + kq; v[i] = valid ? *(const f32x4*)(W + (size_t)(k0 + k) * N + n0 + nl) : (f32x4){0.f, 0.f, 0.f, 0.f}; }
#pragma unroll
    for (int i = 0; i < 16; ++i) { const int k = 4 * i + kq; LAS float* s = scr + k * 65 + nl; s[0] = v[i][0]; s[1] = v[i][1]; s[2] = v[i][2]; s[3] = v[i][3]; }
    LDS_WAIT();
    const int c = lane & 7;
#pragma unroll
    for (int j = 0; j < 8; ++j) { const int n = (lane >> 3) + 8 * j; const LAS float* s = scr + (8 * c) * 65 + n;
        u32x4 o; o.x = cvt_pk_bf16(s[0], s[65]); o.y = cvt_pk_bf16(s[130], s[195]); o.z = cvt_pk_bf16(s[260], s[325]); o.w = cvt_pk_bf16(s[390], s[455]);
        *(u32x4*)(WT + (size_t)(drow0 + n) * Kd + k0 + 8 * c) = o; }
    LDS_WAIT();
}
constexpr int NIT_IN = 64 * 188, NIT_OUT = 64 * 64, NIT_G = 64 * 172, NIT_DN = 172 * 64, NIT_GLU = 16 * 16;
constexpr int NIT_LAYER = NIT_IN + NIT_OUT + 2 * NIT_G + NIT_DN + NIT_GLU;
constexpr int NIT_TR = DEPTH * NIT_LAYER, NIT_COND = 64 * 96;

__device__ __forceinline__ void phase_prologue(const Ctx& a, LAS unsigned char* lds, int wave, int lane) {
    LAS float* scr = (LAS float*)(lds + wave * 16640);
    const int gw = blockIdx.x * 8 + wave, NGW = gridDim.x * 8;
    for (int it = gw; it < NIT_TR + NIT_COND; it += NGW) {
        if (it < NIT_TR) {
            const int l = it / NIT_LAYER; int r = it % NIT_LAYER;
            unsigned char* wt = a.ws() + WS_WT + (size_t)l * WT_LAYER;
            if (r < NIT_IN) { const int kb = r / 188, nb = r % 188; transpose_item(a.in(I_WIN) + (size_t)l * DM * INW, INW, 64 * kb, 64 * nb, (bf16_t*)(wt + WT_IN), 64 * nb, DM, scr, lane); continue; } r -= NIT_IN;
            if (r < NIT_OUT) { const int kb = r / 64, nb = r % 64; transpose_item(a.in(I_WOUT) + (size_t)l * DM * DM, DM, 64 * kb, 64 * nb, (bf16_t*)(wt + WT_OUT), 64 * nb, DM, scr, lane); continue; } r -= NIT_OUT;
            if (r < NIT_G) { const int kb = r / 172, nb = r % 172, n0 = 64 * nb; transpose_item(a.in(I_WFG) + (size_t)l * DM * DFF, DFF, 64 * kb, n0, (bf16_t*)(wt + WT_GU), 256 * (n0 / 128) + (n0 % 128), DM, scr, lane); continue; } r -= NIT_G;
            if (r < NIT_G) { const int kb = r / 172, nb = r % 172, n0 = 64 * nb; transpose_item(a.in(I_WFU) + (size_t)l * DM * DFF, DFF, 64 * kb, n0, (bf16_t*)(wt + WT_GU), 256 * (n0 / 128) + 128 + (n0 % 128), DM, scr, lane); continue; } r -= NIT_G;
            if (r < NIT_DN) { const int kb = r / 64, nb = r % 64; transpose_item(a.in(I_WFD) + (size_t)l * DFF * DM, DM, 64 * kb, 64 * nb, (bf16_t*)(wt + WT_DN), 64 * nb, DFF, scr, lane); continue; } r -= NIT_DN;
            { const int kb = r / 16, nb = r % 16; transpose_item(a.in(I_GLUW) + (size_t)l * S5W * S5W, S5W, 64 * kb, 64 * nb, (bf16_t*)(wt + WT_GLU), 64 * nb, S5W, scr, lane); }
        } else {
            const int item = it - NIT_TR, kb = item / 96, jb = item % 96, k0 = 64 * kb, j0 = 256 * jb + 4 * lane;
            const float* c = a.in(I_C);
            float c0 = c[k0 + lane], c1 = c[DM + k0 + lane];
            c0 = c0 / (1.0f + expf(-c0)); c1 = c1 / (1.0f + expf(-c1));
            f32x4 a0 = (f32x4){0.f, 0.f, 0.f, 0.f}, a1 = a0;
            const float* w = a.in(I_WADA) + (size_t)k0 * (6 * DM) + j0;
#pragma unroll 8
            for (int kk = 0; kk < 64; ++kk) { const f32x4 wv = *(const f32x4*)(w + (size_t)kk * (6 * DM));
                const float s0 = __int_as_float(__builtin_amdgcn_readlane(__float_as_int(c0), kk)), s1 = __int_as_float(__builtin_amdgcn_readlane(__float_as_int(c1), kk));
                a0 += wv * s0; a1 += wv * s1; }
            float* cp = (float*)(a.ws() + WS_CONDPART);
            *(f32x4*)(cp + (size_t)(kb * 2 + 0) * (6 * DM) + j0) = a0;
            *(f32x4*)(cp + (size_t)(kb * 2 + 1) * (6 * DM) + j0) = a1;
        }
    }
    __syncthreads();
    for (int lg = blockIdx.x; lg < DEPTH * 64; lg += gridDim.x) s5_tables_item(a, lg, lds, wave, lane);
}
__device__ __forceinline__ void phase_mod(const Ctx& a, int wave, int lane) {
    const int gt = blockIdx.x * 512 + wave * 64 + lane, NT = gridDim.x * 512;
    const float* cp = (const float*)(a.ws() + WS_CONDPART);
    float* mod = (float*)(a.ws() + WS_MOD); float* misc = (float*)(a.ws() + WS_MISC);
    for (int idx = gt; idx < NB * 6 * DM; idx += NT) {
        const int b = idx / (6 * DM), j = idx % (6 * DM);
        float s = a.in(I_BADA)[j];
        for (int kb = 0; kb < 64; ++kb) s += cp[(size_t)(kb * 2 + b) * (6 * DM) + j];
        for (int l = 0; l < DEPTH; ++l) mod[(size_t)((l * 2 + b) * 6) * DM + j] = s + a.in(I_TABLE)[(size_t)l * 6 * DM + j];
    }
    for (int idx = gt; idx < DM; idx += NT) { misc[idx] = 1.0f; misc[DM + idx] = 0.0f; }
    for (int idx = gt; idx < HGW; idx += NT) {
        const float* raw = a.in(I_LBRAW); float r[DEPTH], mx = -3.0e38f;
#pragma unroll
        for (int l = 0; l < DEPTH; ++l) { r[l] = raw[l * HGW + idx]; mx = fmaxf(mx, r[l]); }
        float e[DEPTH], sum = 0.f;
#pragma unroll
        for (int l = 0; l < DEPTH; ++l) { e[l] = expf(r[l] - mx); sum += e[l]; }
        float cum = 0.f;
#pragma unroll
        for (int l = 0; l < DEPTH; ++l) { misc[2 * DM + l * HGW + idx] = cum; if (l + 1 < DEPTH) cum += e[l + 1] / sum; }
    }
}

template <int MODE>
__device__ __forceinline__ void phase_lnapply(const float* vsrc, const float* rowpart, float* rowstats, const float* lng, const float* lnb, const float* modp, int i_shift, int i_scale,
                                              bf16_t* H, float* outf, LAS unsigned char* lds, int wave, int lane) {
    LAS f32x2* st = (LAS f32x2*)lds;
    for (int blk = blockIdx.x; blk < MTOK / 64; blk += gridDim.x) {
        const int r0 = blk * 64, b = (r0 >= SEQ) ? 1 : 0;
        for (int rr = 0; rr < 8; ++rr) { const int rl = wave * 8 + rr, r = r0 + rl; float mu = 0.f, rs = 1.f;
            if (MODE != 0) { const f32x2 p = *(const f32x2*)(rowpart + ((size_t)r * 64 + lane) * 2); const float s1 = wave_sum(p.x), s2 = wave_sum(p.y);
                mu = s1 * (1.0f / DM); const float var = fmaxf(s2 * (1.0f / DM) - mu * mu, 0.f); rs = 1.0f / sqrtf(var + LN_EPS); }
            if (lane == 0) { st[rl] = (f32x2){mu, rs}; if (MODE != 2) *(f32x2*)(rowstats + (size_t)r * 2) = (f32x2){mu, rs}; } }
        __syncthreads();
        f32x4 A[2], B[2];
#pragma unroll
        for (int jj = 0; jj < 2; ++jj) { const int c = 512 * wave + 256 * jj + 4 * lane;
            f32x4 g = (f32x4){1.f, 1.f, 1.f, 1.f}, bb = (f32x4){0.f, 0.f, 0.f, 0.f};
            if (MODE != 0) { g = *(const f32x4*)(lng + c); bb = *(const f32x4*)(lnb + c); }
            if (MODE != 2) { const f32x4 sc = *(const f32x4*)(modp + (size_t)(b * 6 + i_scale) * DM + c) + 1.0f, sh = *(const f32x4*)(modp + (size_t)(b * 6 + i_shift) * DM + c); A[jj] = g * sc; B[jj] = bb * sc + sh; }
            else { A[jj] = g; B[jj] = bb; } }
#pragma unroll 8
        for (int rl = 0; rl < 64; ++rl) { const f32x2 s = st[rl]; const size_t off = (size_t)(r0 + rl) * DM + 512 * wave + 4 * lane;
#pragma unroll
            for (int jj = 0; jj < 2; ++jj) { const f32x4 v = *(const f32x4*)(vsrc + off + 256 * jj); const f32x4 y = ((v - s.x) * s.y) * A[jj] + B[jj];
                if (MODE == 2) *(f32x4*)(outf + off + 256 * jj) = y;
                else { u32x2 w; w.x = cvt_pk_bf16(y[0], y[1]); w.y = cvt_pk_bf16(y[2], y[3]); *(u32x2*)(H + off + 256 * jj) = w; } } }
        __syncthreads();
    }
}

typedef short bf16x8 __attribute__((ext_vector_type(8)));
typedef short bf16x4 __attribute__((ext_vector_type(4)));
constexpr int HG_BLK = 16896, HG_OQ = 0, HG_OK = 4096, HG_OKT = 8192, HG_OVT = 12288, HG_ODL = 16384;
constexpr int GL_BLK = 32768, GL_OQ = 0, GL_OK = 6400, GL_OKT = 12800, GL_ODL = 18944, GL_SHARED = 20480, GL_OVT = 20480;
constexpr int NSUB = SEQ / 16;

__device__ __forceinline__ unsigned short f2bf1(float x) { return (unsigned short)(cvt_pk_bf16(x, x) & 0xffffu); }

__device__ __forceinline__ void pre_finish(const float (&qq)[16], const float (&kk)[16], float (&g)[16], unsigned char* blk, int oq, int ok, int okt, int odl, int rowb, int d, bool swz) {
    float b = 0.f;
#pragma unroll
    for (int j = 0; j < 16; ++j) { b += g[j]; g[j] = b; }
    const float bl = b;
    unsigned kt[8];
#pragma unroll
    for (int j = 0; j < 16; j += 2) {
        float kv[2];
#pragma unroll
        for (int jj = 0; jj < 2; ++jj) { const int t = j + jj; const float bj = g[t];
            const int off = t * rowb + (swz ? ((2 * d) ^ (t << 4)) : 2 * d);
            const float qv = qq[t] * __expf(bj), kc = kk[t] * __expf(fminf(-bj, 80.f));
            const float qn = __shfl_xor(qv, 1), kn = __shfl_xor(kc, 1);
            if ((d & 1) == 0) { *(unsigned*)(blk + oq + off) = cvt_pk_bf16(qv, qn); *(unsigned*)(blk + ok + off) = cvt_pk_bf16(kc, kn); }
            kv[jj] = kk[t] * __expf(bl - bj); }
        kt[j >> 1] = cvt_pk_bf16(kv[0], kv[1]); }
    *(u32x4*)(blk + okt + d * 32) = (u32x4){kt[0], kt[1], kt[2], kt[3]};
    *(u32x4*)(blk + okt + d * 32 + 16) = (u32x4){kt[4], kt[5], kt[6], kt[7]};
    *(float*)(blk + odl + d * 4) = __expf(bl);
}
__device__ __forceinline__ void phase_pre(const Ctx& a, int l, int wave, int lane) {
    const bf16_t* P = (const bf16_t*)(a.ws() + WS_P);
    int tid = wave * 64 + lane;
    for (int task = blockIdx.x; task < NB * NSUB * 8; task += gridDim.x) {
        asm volatile("" : "+v"(tid));
        const int kind = (task + (task >> 8)) & 7, bsc = task >> 3, b = bsc / NSUB, sc = bsc % NSUB;
        const size_t row0 = (size_t)b * SEQ + sc * 16;
        if (kind < 3) {
            const int ch = kind * 512 + tid, h = ch >> 7, d = ch & 127;
            const float lb = ((const float*)(a.ws() + WS_MISC))[2 * DM + l * HGW + ch];
            unsigned char* blk = a.ws() + WS_HGB + ((size_t)(b * 12 + h) * NSUB + sc) * HG_BLK;
            float g[16], qq[16], kk[16]; unsigned vv[8];
#pragma unroll
            for (int j = 0; j < 16; ++j) { const bf16_t* prow = P + (row0 + j) * INP;
                const float qin = fmaxf(bf2f(prow[C_QB + ch]), -80.f), fin = fminf(fmaxf(bf2f(prow[C_FB + ch]), -80.f), 80.f);
                const unsigned short v = prow[C_IB + ch]; if (j & 1) vv[j >> 1] |= ((unsigned)v) << 16; else vv[j >> 1] = v;
                const float e = __expf(-fin), sg = 1.0f / (1.0f + e);
                const float f = lb + (1.0f - lb) * sg;
                g[j] = fmaxf(__logf(f), -100.f); kk[j] = (1.0f - lb) * (e * sg); qq[j] = qin / (1.0f + __expf(-qin)); }
            *(u32x4*)(blk + HG_OVT + d * 32) = (u32x4){vv[0], vv[1], vv[2], vv[3]};
            *(u32x4*)(blk + HG_OVT + d * 32 + 16) = (u32x4){vv[4], vv[5], vv[6], vv[7]};
            pre_finish(qq, kk, g, blk, HG_OQ, HG_OK, HG_OKT, HG_ODL, 256, d, true);
        } else if (kind < 5) {
            if (tid < 384) {
                const int ch = (kind - 3) * 384 + tid, h = ch / 192, d = ch % 192;
                unsigned char* blk = a.ws() + WS_GLB + ((size_t)(b * 4 + h) * NSUB + sc) * GL_BLK;
                float wg[16];
#pragma unroll
                for (int r = 0; r < 16; ++r) wg[r] = a.in(I_WGATE)[((size_t)l * 16 + r) * GLKW + ch];
                const float bgv = a.in(I_BGATE)[l * GLKW + ch];
                float g[16], qq[16], kk[16];
#pragma unroll
                for (int j = 0; j < 16; ++j) { const bf16_t* prow = P + (row0 + j) * INP;
                    const u32x4 l0 = *(const u32x4*)(prow + C_LR), l1 = *(const u32x4*)(prow + C_LR + 8);
                    float x = bgv;
                    x += bf_lo(l0.x) * wg[0] + bf_hi(l0.x) * wg[1] + bf_lo(l0.y) * wg[2] + bf_hi(l0.y) * wg[3] + bf_lo(l0.z) * wg[4] + bf_hi(l0.z) * wg[5] + bf_lo(l0.w) * wg[6] + bf_hi(l0.w) * wg[7];
                    x += bf_lo(l1.x) * wg[8] + bf_hi(l1.x) * wg[9] + bf_lo(l1.y) * wg[10] + bf_hi(l1.y) * wg[11] + bf_lo(l1.z) * wg[12] + bf_hi(l1.z) * wg[13] + bf_lo(l1.w) * wg[14] + bf_hi(l1.w) * wg[15];
                    g[j] = (fminf(x, 0.f) - __logf(1.0f + __expf(-fabsf(x)))) * 0.0625f;
                    qq[j] = bf2f(prow[C_QC + ch]) * GLA_QSCALE; kk[j] = bf2f(prow[C_KC + ch]); }
                pre_finish(qq, kk, g, blk, GL_OQ, GL_OK, GL_OKT, GL_ODL, 400, d, false);
            }
        } else {
            const int ch = (kind - 5) * 512 + tid, h = ch / 384, e = ch % 384;
            unsigned char* blk = a.ws() + WS_GLB + ((size_t)(b * 4 + h) * NSUB + sc) * GL_BLK;
            unsigned vv[8];
#pragma unroll
            for (int j = 0; j < 16; ++j) { const unsigned short v = P[(row0 + j) * INP + C_VC + ch]; if (j & 1) vv[j >> 1] |= ((unsigned)v) << 16; else vv[j >> 1] = v; }
            *(u32x4*)(blk + GL_OVT + e * 32) = (u32x4){vv[0], vv[1], vv[2], vv[3]};
            *(u32x4*)(blk + GL_OVT + e * 32 + 16) = (u32x4){vv[4], vv[5], vv[6], vv[7]};
        }
    }
}

template <int DK, int MODE>
__device__ __forceinline__ void chain_sub(const LAS unsigned char* sb, f32x4 (&S)[DK / 16], float* op, int wave, int n, int q) {
    constexpr bool IS_GLA = (DK == 192);
    constexpr int NKS = DK / 32, NMB = DK / 16, ROWB = IS_GLA ? 400 : 256;
    constexpr int OQ = 0, OK = IS_GLA ? GL_OK : HG_OK, OKT = IS_GLA ? GL_OKT : HG_OKT, OVT = IS_GLA ? GL_OVT : HG_OVT, ODL = IS_GLA ? GL_ODL : HG_ODL;
    const u32x2 vfr = *(const LAS u32x2*)(sb + OVT + (16 * wave + n) * 32 + 8 * q);
    const bf16x8 vf8 = __builtin_bit_cast(bf16x8, (u32x4){vfr.x, vfr.y, 0u, 0u});
    if (MODE == 1) {
        bf16x8 qf[NKS], kf[NKS];
#pragma unroll
        for (int ks = 0; ks < NKS; ++ks) { const int c0 = 2 * (32 * ks + 4 * q), c1 = c0 + 32;
            const int o0 = n * ROWB + (IS_GLA ? c0 : (c0 ^ (n << 4))), o1 = n * ROWB + (IS_GLA ? c1 : (c1 ^ (n << 4)));
            const u32x2 ql = *(const LAS u32x2*)(sb + OQ + o0), qh = *(const LAS u32x2*)(sb + OQ + o1), kl = *(const LAS u32x2*)(sb + OK + o0), kh = *(const LAS u32x2*)(sb + OK + o1);
            qf[ks] = __builtin_bit_cast(bf16x8, (u32x4){ql.x, ql.y, qh.x, qh.y}); kf[ks] = __builtin_bit_cast(bf16x8, (u32x4){kl.x, kl.y, kh.x, kh.y}); }
        f32x4 ao = (f32x4){0.f, 0.f, 0.f, 0.f}, ap = ao;
#pragma unroll
        for (int ks = 0; ks < NKS; ++ks) {
            const bf16x8 sbf = __builtin_bit_cast(bf16x8, (u32x4){cvt_pk_bf16(S[2 * ks][0], S[2 * ks][1]), cvt_pk_bf16(S[2 * ks][2], S[2 * ks][3]), cvt_pk_bf16(S[2 * ks + 1][0], S[2 * ks + 1][1]), cvt_pk_bf16(S[2 * ks + 1][2], S[2 * ks + 1][3])});
            ao = __builtin_amdgcn_mfma_f32_16x16x32_bf16(qf[ks], sbf, ao, 0, 0, 0);
            ap = __builtin_amdgcn_mfma_f32_16x16x32_bf16(kf[ks], qf[ks], ap, 0, 0, 0); }
#pragma unroll
        for (int r = 0; r < 4; ++r) if (4 * q + r > n) ap[r] = 0.f;
        const bf16x8 pa8 = __builtin_bit_cast(bf16x8, (u32x4){cvt_pk_bf16(ap[0], ap[1]), cvt_pk_bf16(ap[2], ap[3]), 0u, 0u});
        ao = __builtin_amdgcn_mfma_f32_16x16x32_bf16(pa8, vf8, ao, 0, 0, 0);
#pragma unroll
        for (int r = 0; r < 4; ++r) op[(size_t)(4 * q + r) * OW] = ao[r];
    }
#pragma unroll
    for (int mb = 0; mb < NMB; ++mb) {
        const f32x4 dl = *(const LAS f32x4*)(sb + ODL + (16 * mb + 4 * q) * 4);
        const u32x2 ktr = *(const LAS u32x2*)(sb + OKT + (16 * mb + n) * 32 + 8 * q);
        S[mb] = __builtin_amdgcn_mfma_f32_16x16x32_bf16(__builtin_bit_cast(bf16x8, (u32x4){ktr.x, ktr.y, 0u, 0u}), vf8, S[mb] * dl, 0, 0, 0); }
}
constexpr size_t ST_REC = 98304;
constexpr int NSEG = 5;
__device__ __forceinline__ int seg_u0(int s) { return s <= 3 ? 52 * s : 156 + 50 * (s - 3); }
__device__ __forceinline__ int seg_nu(int s) { return s < 3 ? 52 : 50; }
template <int DK, int MODE>
__device__ __forceinline__ void chain_item(const unsigned char* blk0, int vt_off, float* op0, unsigned char* st, int seg, int nunits, LAS unsigned char* lds, int wave, int lane) {
    asm volatile("" : "+v"(lane), "+s"(wave));
    constexpr bool IS_GLA = (DK == 192);
    constexpr int BLK = IS_GLA ? GL_BLK : HG_BLK, SUBB = IS_GLA ? GL_SHARED + 4096 : HG_BLK, NMB = DK / 16;
    constexpr int SH0 = MODE == 1 ? 0 : (IS_GLA ? GL_OKT : HG_OKT);
    constexpr int SH_PIECES = (MODE == 1 ? (IS_GLA ? GL_SHARED : HG_OVT) : (IS_GLA ? GL_ODL + 768 - GL_OKT : 4096)) / 16;
    constexpr int T_PIECES = IS_GLA ? 256 : (4096 + 512) / 16;
    constexpr int T_LDS = IS_GLA ? GL_OVT : HG_OVT;
    constexpr int PIECES = SH_PIECES + T_PIECES, UNITB = 2 * SUBB, NP = (2 * PIECES + 511) / 512;
    const int tid = wave * 64 + lane, n = lane & 15, q = lane >> 4;
    f32x4 S[NMB]; float dacc = 1.0f;
    constexpr int ODL_ = IS_GLA ? GL_ODL : HG_ODL;
#pragma unroll
    for (int mb = 0; mb < NMB; ++mb) S[mb] = (f32x4){0.f, 0.f, 0.f, 0.f};
    if (MODE == 1) {
        for (int s = 0; s < seg; ++s) { const unsigned char* rec = st + (size_t)s * 2 * ST_REC + (size_t)(wave * 64 + lane) * 16;
#pragma unroll
            for (int mb = 0; mb < NMB; ++mb) { const f32x4 h = *(const f32x4*)(rec + (size_t)mb * 8192), d = *(const f32x4*)(st + (size_t)s * 2 * ST_REC + ST_REC + (16 * mb + 4 * q) * 4); S[mb] = S[mb] * d + h; } }
    }
    u32x4 stgA[NP], stgB[NP];
#define CH_SRC(u, p_) (blk0 + (size_t)((u) * 2 + (p_) / PIECES) * BLK + (((p_) % PIECES) < SH_PIECES ? SH0 + ((p_) % PIECES) * 16 : (IS_GLA ? vt_off : HG_OVT) + (((p_) % PIECES) - SH_PIECES) * 16))
#define CH_DST(p_) (((p_) / PIECES) * SUBB + (((p_) % PIECES) < SH_PIECES ? SH0 + ((p_) % PIECES) * 16 : T_LDS + (((p_) % PIECES) - SH_PIECES) * 16))
#define CH_LOAD(stg, u) do { _Pragma("unroll") for (int r_ = 0; r_ < NP; ++r_) { const int p_ = r_ * 512 + tid; const bool ok_ = (NP * 512 == 2 * PIECES) || p_ < 2 * PIECES; const int pc_ = ok_ ? p_ : 0; stg[r_] = *(const u32x4*)CH_SRC(u, pc_); } } while (0)
#define CH_STORE(stg, buf) do { _Pragma("unroll") for (int r_ = 0; r_ < NP; ++r_) { const int p_ = r_ * 512 + tid; const bool ok_ = (NP * 512 == 2 * PIECES) || p_ < 2 * PIECES; const int pc_ = ok_ ? p_ : 0; \
        const int d_ = ok_ ? (buf) * UNITB + CH_DST(pc_) : 2 * UNITB + (p_ - 2 * PIECES) * 16; *(LAS u32x4*)(lds + d_) = stg[r_]; } } while (0)
#define CH_SYNC() do { asm volatile("s_waitcnt lgkmcnt(0)" ::: "memory"); __builtin_amdgcn_s_barrier(); asm volatile("" ::: "memory"); } while (0)
    CH_LOAD(stgA, 0); CH_STORE(stgA, 0);
    CH_LOAD(stgA, 1);
    CH_SYNC();
    float* op = op0 + 16 * wave + n;
    for (int u = 0; u < nunits; u += 2) {
        if (u + 2 < nunits) CH_LOAD(stgB, u + 2);
        chain_sub<DK, MODE>(lds, S, op + (size_t)(u * 32) * OW, wave, n, q);
        chain_sub<DK, MODE>(lds + SUBB, S, op + (size_t)(u * 32 + 16) * OW, wave, n, q);
        if (MODE == 0 && tid < DK) dacc *= *(const LAS float*)(lds + ODL_ + 4 * tid) * *(const LAS float*)(lds + SUBB + ODL_ + 4 * tid);
        CH_STORE(stgA, 1);
        CH_SYNC();
        if (u + 3 < nunits) CH_LOAD(stgA, u + 3);
        chain_sub<DK, MODE>(lds + UNITB, S, op + (size_t)(u * 32 + 32) * OW, wave, n, q);
        chain_sub<DK, MODE>(lds + UNITB + SUBB, S, op + (size_t)(u * 32 + 48) * OW, wave, n, q);
        if (MODE == 0 && tid < DK) dacc *= *(const LAS float*)(lds + UNITB + ODL_ + 4 * tid) * *(const LAS float*)(lds + UNITB + SUBB + ODL_ + 4 * tid);
        if (u + 2 < nunits) CH_STORE(stgB, 0);
        CH_SYNC();
    }
    if (MODE == 0) { unsigned char* rec = st + (size_t)seg * 2 * ST_REC + (size_t)(wave * 64 + lane) * 16;
#pragma unroll
        for (int mb = 0; mb < NMB; ++mb) *(f32x4*)(rec + (size_t)mb * 8192) = S[mb];
        if (tid < DK) *(float*)(st + (size_t)seg * 2 * ST_REC + ST_REC + 4 * tid) = dacc; }
#undef CH_SRC
#undef CH_DST
#undef CH_LOAD
#undef CH_STORE
#undef CH_SYNC
}

template <int MODE>
__device__ __forceinline__ void phase_chain(const Ctx& a, int l, LAS unsigned char* lds, int wave, int lane) {
    const int bx = blockIdx.x, G = gridDim.x;
    constexpr int nitems = MODE == 0 ? 48 * (NSEG - 1) : 48 * NSEG;
    for (int it = bx; it < nitems; it += G) {
        const int c = it % 48, seg = it / 48, u0 = seg_u0(seg), nu = seg_nu(seg);
        unsigned char* st = a.ws() + WS_ST + (size_t)c * (NSEG - 1) * 2 * ST_REC;
        if (c < 24) { const int b = c / 12, h = c % 12;
            chain_item<128, MODE>(a.ws() + WS_HGB + ((size_t)(b * 12 + h) * NSUB + 2 * u0) * HG_BLK, 0, (float*)(a.ws() + WS_O) + ((size_t)b * SEQ + u0 * 32) * OW + h * 128, st, seg, nu, lds, wave, lane); }
        else { const int r = c - 24, b = r / 12, h = (r % 12) / 3, sl = r % 3;
            chain_item<192, MODE>(a.ws() + WS_GLB + ((size_t)(b * 4 + h) * NSUB + 2 * u0) * GL_BLK, GL_OVT + 4096 * sl, (float*)(a.ws() + WS_O) + ((size_t)b * SEQ + u0 * 32) * OW + HGW + h * 384 + sl * 128, st, seg, nu, lds, wave, lane); }
        __syncthreads();
    }
    if (MODE == 0) { for (int it = (G >= nitems + 16) ? bx - nitems : bx; it < 16; it += G) { if (it < 0) continue; s5_scan_item(a, l, it, wave, lane); } }
}
__device__ __forceinline__ float red16(float v) { v += __shfl_xor(v, 1); v += __shfl_xor(v, 2); v += __shfl_xor(v, 4); v += __shfl_xor(v, 8); return v; }
__device__ __forceinline__ void phase_finalize(const Ctx& a, int l, int wave, int lane) {
    const bf16_t* P = (const bf16_t*)(a.ws() + WS_P); const float* O = (const float*)(a.ws() + WS_O); bf16_t* MX = (bf16_t*)(a.ws() + WS_MIXED);
    const float* hgg = a.in(I_HGG) + l * HGW; const float* hgb = a.in(I_HGB) + l * HGW; const float* glg = a.in(I_GLG) + l * HGW;
    const int gw = blockIdx.x * 8 + wave, NGW = gridDim.x * 8;
    for (int row = gw; row < MTOK; row += NGW) {
        const float* orow = O + (size_t)row * OW; const bf16_t* prow = P + (size_t)row * INP; bf16_t* mrow = MX + (size_t)row * DM;
#pragma unroll
        for (int it = 0; it < 3; ++it) { const int c = (it * 4 + (lane >> 4)) * 128 + (lane & 15) * 8;
            const f32x4 o0 = *(const f32x4*)(orow + c), o1 = *(const f32x4*)(orow + c + 4); const u32x4 gg = *(const u32x4*)(prow + C_GB + c);
            float v[8] = {sigmoidf_(bf_lo(gg.x)) * o0[0], sigmoidf_(bf_hi(gg.x)) * o0[1], sigmoidf_(bf_lo(gg.y)) * o0[2], sigmoidf_(bf_hi(gg.y)) * o0[3],
                          sigmoidf_(bf_lo(gg.z)) * o1[0], sigmoidf_(bf_hi(gg.z)) * o1[1], sigmoidf_(bf_lo(gg.w)) * o1[2], sigmoidf_(bf_hi(gg.w)) * o1[3]};
            float s = 0.f, ss = 0.f;
#pragma unroll
            for (int i = 0; i < 8; ++i) { s += v[i]; ss += v[i] * v[i]; }
            s = red16(s); ss = red16(ss);
            const float mu = s * (1.0f / 128.0f), rs = 1.0f / sqrtf(fmaxf(ss * (1.0f / 128.0f) - mu * mu, 0.f) + LN_EPS);
            const f32x4 g0 = *(const f32x4*)(hgg + c), g1 = *(const f32x4*)(hgg + c + 4), b0 = *(const f32x4*)(hgb + c), b1 = *(const f32x4*)(hgb + c + 4);
            u32x4 w; w.x = cvt_pk_bf16((v[0] - mu) * rs * g0[0] + b0[0], (v[1] - mu) * rs * g0[1] + b0[1]); w.y = cvt_pk_bf16((v[2] - mu) * rs * g0[2] + b0[2], (v[3] - mu) * rs * g0[3] + b0[3]);
            w.z = cvt_pk_bf16((v[4] - mu) * rs * g1[0] + b1[0], (v[5] - mu) * rs * g1[1] + b1[1]); w.w = cvt_pk_bf16((v[6] - mu) * rs * g1[2] + b1[2], (v[7] - mu) * rs * g1[3] + b1[3]);
            *(u32x4*)(mrow + S5W + c) = w; }
#pragma unroll
        for (int h = 0; h < 4; ++h) { const int c = h * 384 + lane * 8; const bool act = lane < 48;
            f32x4 o0 = (f32x4){0.f, 0.f, 0.f, 0.f}, o1 = o0; u32x4 gg = (u32x4){0u, 0u, 0u, 0u};
            if (act) { o0 = *(const f32x4*)(orow + HGW + c); o1 = *(const f32x4*)(orow + HGW + c + 4); gg = *(const u32x4*)(prow + C_GC + c); }
            const float ss = wave_sum((o0[0] * o0[0] + o0[1] * o0[1]) + (o0[2] * o0[2] + o0[3] * o0[3]) + (o1[0] * o1[0] + o1[1] * o1[1]) + (o1[2] * o1[2] + o1[3] * o1[3]));
            const float rms = 1.0f / sqrtf(ss * (1.0f / 384.0f) + LN_EPS);
            if (act) { const f32x4 g0 = *(const f32x4*)(glg + c), g1 = *(const f32x4*)(glg + c + 4);
                const float z[8] = {bf_lo(gg.x), bf_hi(gg.x), bf_lo(gg.y), bf_hi(gg.y), bf_lo(gg.z), bf_hi(gg.z), bf_lo(gg.w), bf_hi(gg.w)};
                u32x4 w; w.x = cvt_pk_bf16(o0[0] * rms * g0[0] * (z[0] * sigmoidf_(z[0])), o0[1] * rms * g0[1] * (z[1] * sigmoidf_(z[1])));
                w.y = cvt_pk_bf16(o0[2] * rms * g0[2] * (z[2] * sigmoidf_(z[2])), o0[3] * rms * g0[3] * (z[3] * sigmoidf_(z[3])));
                w.z = cvt_pk_bf16(o1[0] * rms * g1[0] * (z[4] * sigmoidf_(z[4])), o1[1] * rms * g1[1] * (z[5] * sigmoidf_(z[5])));
                w.w = cvt_pk_bf16(o1[2] * rms * g1[2] * (z[6] * sigmoidf_(z[6])), o1[3] * rms * g1[3] * (z[7] * sigmoidf_(z[7])));
                *(u32x4*)(mrow + S5W + HGW + c) = w; } }
    }
}

constexpr int PH_PRO = 0, PH_MOD = 1, PH_LN0 = 2, PH_L0 = 3, PH_PER_LAYER = 10, N_PHASES = PH_L0 + DEPTH * PH_PER_LAYER;
constexpr int CW_BAR = 4096;

__global__ void __launch_bounds__(512, 2) hybrid_fwd(Args args) {
    extern __shared__ __attribute__((aligned(16))) unsigned char lds_raw[];
    LAS unsigned char* lds = (LAS unsigned char*)lds_raw;
    const int wave = __builtin_amdgcn_readfirstlane((int)threadIdx.x >> 6);
#define lane lane_id_v()
    volatile LAS unsigned* MISC = (volatile LAS unsigned*)(lds + LDSCTL_OFF);
    Ctx ctx; ctx.t = (volatile LAS unsigned long long*)(lds + LDSCTL_OFF + 64);
    if (wave == 0) { const int ln_ = lane; unsigned long long v = 0ull;
#pragma unroll
        for (int i = 0; i < N_IN; ++i) v = (ln_ == i) ? (unsigned long long)args.in[i] : v;
        v = (ln_ == 30) ? (unsigned long long)args.out : v; v = (ln_ == 31) ? (unsigned long long)args.ws : v;
        if (ln_ < 32) ctx.t[ln_] = v;
        if (ln_ < 16) MISC[ln_] = 0u; }
    __syncthreads();
    const int lo = args.ph_lo, hi = args.ph_hi;
    XcdBarrier bar; bar.bar = (unsigned*)(ctx.ws() + WS_CTL) + CW_BAR; bar.x = 0; bar.st = nullptr; bar.w0 = (wave == 0) ? 1u : 0u;
    if (hi - lo > 1) bar = xcd_barrier_post((unsigned*)(ctx.ws() + WS_CTL) + CW_BAR, MISC + 8, (wave == 0) ? 1u : 0u);
#define IN(k) (lo <= (k) && (k) < hi)
#define OPQ() int ln = lane, wv = wave; asm volatile("" : "+s"(wv))
#define SEAM(k) do { if (IN(k) && IN((k) + 1)) xcd_barrier(bar); } while (0)
#define WSP(T, off) ((T*)(ctx.ws() + (off)))
#ifdef DIAG_SEL1
    volatile LAS unsigned long long* STP = (volatile LAS unsigned long long*)(lds + LDSCTL_OFF + 512);
#define STAMP(idx) do { if (blockIdx.x == 0 && wave == 0) { const unsigned long long t_ = __builtin_amdgcn_s_memrealtime(); if (lane == 0) STP[idx] = t_; } } while (0)
#else
#define STAMP(idx) do { } while (0)
#endif
    STAMP(0);

#if EN_PRO
    if (IN(PH_PRO)) { OPQ(); phase_prologue(ctx, lds, wv, ln); }
#endif
    SEAM(PH_PRO); STAMP((PH_PRO) + 1);
#if EN_MOD
    if (IN(PH_MOD)) { OPQ(); phase_mod(ctx, wv, ln); }
#endif
    SEAM(PH_MOD); STAMP((PH_MOD) + 1);
#if EN_LN
    if (IN(PH_LN0)) { OPQ(); phase_lnapply<0>(ctx.in(I_X), nullptr, WSP(float, WS_ROWSTATS), nullptr, nullptr, WSP(float, WS_MOD), 0, 1, WSP(bf16_t, WS_H), nullptr, lds, wv, ln); }
#endif
    SEAM(PH_LN0); STAMP((PH_LN0) + 1);

    for (int l = 0; l < DEPTH; ++l) {
        const int p0 = PH_L0 + l * PH_PER_LAYER;
        const size_t wto = WS_WT + (size_t)l * WT_LAYER, modo = WS_MOD + (size_t)l * NB * 6 * DM * 4;
#if EN_INPROJ
        if (IN(p0 + 0)) { pg8::Gemm g{WSP(bf16_t, WS_H), WSP(const bf16_t, wto + WT_IN), MTOK, INP, DM}; pg8::StaticOrder S; S.init(MTOK, INP, (int)gridDim.x, (int)blockIdx.x);
            EpiProj E{WSP(bf16_t, WS_P), WSP(bf16_t, WS_UX)}; pg8::gemm_phase<EpiProj, pg8::StaticOrder, true, true>(lds, g, S, E, wave); }
#endif
        SEAM(p0 + 0); STAMP((p0 + 0) + 1);
#if EN_MIX
        if (IN(p0 + 1)) {
            { pg8::Gemm g{WSP(bf16_t, WS_UX), WSP(const bf16_t, WS_S5W1 + (size_t)l * S5_W1_LAYER), 64 * 256, 64 * 256, S5K}; S5Order S{(int)gridDim.x, (int)blockIdx.x, 64, 0};
              EpiS5A E{WSP(float, WS_SLOC)}; pg8::gemm_phase<EpiS5A, S5Order, true, true>(lds, g, S, E, wave); }
            { OPQ(); phase_pre(ctx, l, wv, ln); } }
        SEAM(p0 + 1); STAMP((p0 + 1) + 1);
        if (IN(p0 + 2)) { OPQ(); phase_chain<0>(ctx, l, lds, wv, ln); }
        SEAM(p0 + 2); STAMP((p0 + 2) + 1);
        if (IN(p0 + 3)) {
            { pg8::Gemm g{WSP(bf16_t, WS_UX), WSP(const bf16_t, WS_S5T + (size_t)l * S5_T_LAYER), 64 * 256, 64 * 1024, S5K}; S5Order S{(int)gridDim.x, (int)blockIdx.x, 256, 2};
              EpiS5C E{WSP(bf16_t, WS_Z)}; pg8::gemm_phase<EpiS5C, S5Order, true, true>(lds, g, S, E, wave); }
            { OPQ(); phase_chain<1>(ctx, l, lds, wv, ln); } }
#endif
        SEAM(p0 + 3); STAMP((p0 + 3) + 1);
#if EN_GLU
        if (IN(p0 + 4)) { pg8::Gemm g{WSP(bf16_t, WS_Z), WSP(const bf16_t, wto + WT_GLU), MTOK, S5W, S5W}; pg8::StaticOrder S; S.init(MTOK, S5W, (int)gridDim.x, (int)blockIdx.x);
            EpiGlu E{WSP(bf16_t, WS_Z), WSP(bf16_t, WS_MIXED), ctx.in(I_GLUB) + l * S5W}; pg8::gemm_phase<EpiGlu, pg8::StaticOrder, true, true>(lds, g, S, E, wave);
            { OPQ(); phase_finalize(ctx, l, wv, ln); } }
#endif
        SEAM(p0 + 4); STAMP((p0 + 4) + 1);
#if EN_OUT
        if (IN(p0 + 5)) { pg8::Gemm g{WSP(bf16_t, WS_MIXED), WSP(const bf16_t, wto + WT_OUT), MTOK, DM, DM}; pg8::StaticOrder S; S.init(MTOK, DM, (int)gridDim.x, (int)blockIdx.x);
            EpiResid E{l == 0 ? ctx.in(I_X) : ctx.out(), ctx.out(), WSP(float, WS_ROWSTATS), l == 0 ? WSP(float, WS_MISC) : ctx.in(I_LN2G) + (l - 1) * DM, l == 0 ? WSP(float, WS_MISC) + DM : ctx.in(I_LN2B) + (l - 1) * DM, WSP(float, modo) + 2 * DM, WSP(float, WS_ROWPART)};
            pg8::gemm_phase<EpiResid, pg8::StaticOrder, true, true>(lds, g, S, E, wave); }
#endif
        SEAM(p0 + 5); STAMP((p0 + 5) + 1);
#if EN_LN
        if (IN(p0 + 6)) { OPQ(); phase_lnapply<1>(ctx.out(), WSP(float, WS_ROWPART), WSP(float, WS_ROWSTATS), ctx.in(I_LN1G) + l * DM, ctx.in(I_LN1B) + l * DM, WSP(float, modo), 3, 4, WSP(bf16_t, WS_H), nullptr, lds, wv, ln); }
#endif
        SEAM(p0 + 6); STAMP((p0 + 6) + 1);
#if EN_GU
        if (IN(p0 + 7)) { pg8::Gemm g{WSP(bf16_t, WS_H), WSP(const bf16_t, wto + WT_GU), MTOK, 2 * DFF, DM}; pg8::StaticOrder S; S.init(MTOK, 2 * DFF, (int)gridDim.x, (int)blockIdx.x);
            EpiSwiglu E{WSP(bf16_t, WS_P)}; pg8::gemm_phase<EpiSwiglu, pg8::StaticOrder, true, true>(lds, g, S, E, wave); }
#endif
        SEAM(p0 + 7); STAMP((p0 + 7) + 1);
#if EN_DN
        if (IN(p0 + 8)) { pg8::Gemm g{WSP(bf16_t, WS_P), WSP(const bf16_t, wto + WT_DN), MTOK, DM, DFF}; pg8::StaticOrder S; S.init(MTOK, DM, (int)gridDim.x, (int)blockIdx.x);
            EpiResid E{ctx.out(), ctx.out(), WSP(float, WS_ROWSTATS), ctx.in(I_LN1G) + l * DM, ctx.in(I_LN1B) + l * DM, WSP(float, modo) + 5 * DM, WSP(float, WS_ROWPART)};
            pg8::gemm_phase<EpiResid, pg8::StaticOrder, true, true>(lds, g, S, E, wave); }
#endif
        SEAM(p0 + 8); STAMP((p0 + 8) + 1);
#if EN_LN
        if (IN(p0 + 9)) { OPQ();
            if (l + 1 < DEPTH) phase_lnapply<1>(ctx.out(), WSP(float, WS_ROWPART), WSP(float, WS_ROWSTATS), ctx.in(I_LN2G) + l * DM, ctx.in(I_LN2B) + l * DM, WSP(float, modo) + (size_t)NB * 6 * DM, 0, 1, WSP(bf16_t, WS_H), nullptr, lds, wv, ln);
            else phase_lnapply<2>(ctx.out(), WSP(float, WS_ROWPART), WSP(float, WS_ROWSTATS), ctx.in(I_LN2G) + l * DM, ctx.in(I_LN2B) + l * DM, nullptr, 0, 0, nullptr, ctx.out(), lds, wv, ln);
        }
#endif
        SEAM(p0 + 9); STAMP((p0 + 9) + 1);
    }
#ifdef DIAG_SEL1
    xcd_barrier(bar);
    if (blockIdx.x == 0) {
        float tot = (float)(STP[N_PHASES] - STP[0]), s1 = 0.f, s2 = 0.f;
        for (int k = 0; k < N_PHASES; ++k) { int ty; if (k < 3) ty = k; else { const int j = (k - 3) % PH_PER_LAYER; const int map[10] = {3, 4, 5, 6, 10, 7, 2, 8, 9, 2}; ty = map[j]; }
            const float d = (float)(STP[k + 1] - STP[k]); if ((DIAG_SEL1 >> ty) & 1) s1 += d; if ((DIAG_SEL2 >> ty) & 1) s2 += d; }
        const int n1 = (int)(1000000.f * s1 / tot); float* o = ctx.out();
        for (int i = wave * 64 + lane; i < n1; i += 512) o[i] += 0.05f;
        if (wave == 0 && lane == 0) o[2000000] += 0.05f + 0.11f * s2 / tot;
    }
#endif
#undef IN
#undef SEAM
#undef OPQ
#undef WSP
#undef lane
}

#ifndef MK_PER_PHASE
#define MK_PER_PHASE 0
#endif
extern "C" void kernel_launch(void* const* d_in, const int* in_sizes, int n_in, void* d_out, int out_size, void* d_ws, size_t ws_size, hipStream_t stream) {
    static int grid = 0;
    if (grid == 0) {
        if (n_in != N_IN || out_size != MTOK * DM || ws_size < WS_END) { fprintf(stderr, "kernel_launch: unexpected problem (n_in %d, out %d, ws %zu < %zu); nothing launched\n", n_in, out_size, ws_size, (size_t)WS_END); grid = -1; return; }
        int dev = 0, cus = 0, per_cu = 0;
        if (hipGetDevice(&dev) != hipSuccess || hipDeviceGetAttribute(&cus, hipDeviceAttributeMultiprocessorCount, dev) != hipSuccess) { grid = -1; return; }
        if (hipFuncSetAttribute((const void*)hybrid_fwd, hipFuncAttributeMaxDynamicSharedMemorySize, LDS_BYTES) != hipSuccess) { fprintf(stderr, "kernel_launch: hipFuncSetAttribute failed\n"); grid = -1; return; }
        if (hipOccupancyMaxActiveBlocksPerMultiprocessor(&per_cu, (const void*)hybrid_fwd, 512, LDS_BYTES) != hipSuccess || per_cu < 1) fprintf(stderr, "kernel_launch: occupancy query reports %d blocks per CU\n", per_cu);
        (void)hipGetLastError();
        grid = cus;
    }
    if (grid < 0) return;
    (void)in_sizes;
    if (hipMemsetAsync((char*)d_ws + WS_CTL, 0, CTL_ZERO_BYTES, stream) != hipSuccess) return;
#ifdef DBG_MEMSET
    (void)hipMemsetAsync((char*)d_ws + WS_HGB, 0, WS_END - WS_HGB, stream); (void)hipMemsetAsync((char*)d_ws + WS_O, 0, 192 * MiB, stream);
#endif
    Args a{};
    for (int i = 0; i < N_IN; ++i) a.in[i] = (const float*)d_in[i];
    a.out = (float*)d_out; a.ws = (unsigned char*)d_ws;
#if MK_PER_PHASE
    for (int p = 0; p < N_PHASES; ++p) { a.ph_lo = p; a.ph_hi = p + 1; hipLaunchKernelGGL(hybrid_fwd, dim3(grid), dim3(512), LDS_BYTES, stream, a); }
#else
    a.ph_lo = 0; a.ph_hi = N_PHASES; hipLaunchKernelGGL(hybrid_fwd, dim3(grid), dim3(512), LDS_BYTES, stream, a);
#endif
}
```

```cpp
#include <hip/hip_runtime.h>
#include <cstdio>
#include <cstdint>
namespace pg8 {
#define PG8_LAS __attribute__((address_space(3)))
typedef unsigned short bf16_t;
typedef short bf16x8 __attribute__((ext_vector_type(8)));
typedef float f32x4 __attribute__((ext_vector_type(4)));
typedef unsigned u32x4 __attribute__((ext_vector_type(4)));
constexpr int BM = 256, BK = 64, HALF = 128, HTB = HALF * BK * 2  , STAGE_BYTES = 8 * HTB, NXCD = 8, WGM = 8;

__host__ __device__ __forceinline__ int lds_byte(int r, int c) { const int st = (r >> 4) * 2 + (c >> 5), rr = r & 15, cc = c & 31, ob = rr * 64 + cc * 2; return st * 1024 + (ob ^ (((ob >> 9) & 1) << 5)); }
__host__ __device__ __forceinline__ void stage_rc(int b, int& R, int& C) { const int st = b / 1024, sb = b % 1024, swz = sb ^ (((sb >> 9) & 1) << 5); R = (st >> 1) * 16 + swz / 64; C = (st & 1) * 32 + (swz % 64) / 2; }
__host__ __device__ __forceinline__ int perm32(int rho) { const int n = rho >> 4, i = rho & 15; return 8 * (i >> 2) + 4 * n + (i & 3); }

struct Unit { int pm, pn; };
struct Gemm { const bf16_t* A; const bf16_t* Bt; int M, N, K; };

struct StaticOrder {
    int nM, nN, nwg, G, c;
    __host__ __device__ void init(int M, int N, int G_, int c_) { nM = M / BM; nN = N / BM; nwg = nM * nN; G = G_; c = c_; }
    __host__ __device__ bool next(int i, Unit& u) const {
        const long L = (long)i * G + c; if (L >= nwg) return false;
        int wgid = (int)L; { const int q = nwg / NXCD, r = nwg % NXCD, xcd = wgid % NXCD, off = wgid / NXCD; wgid = (xcd < r ? xcd * (q + 1) : r * (q + 1) + (xcd - r) * q) + off; }
        const int nig = WGM * nN, gid = wgid / nig, fm = gid * WGM, gsz = (nM - fm) < WGM ? (nM - fm) : WGM;
        u.pm = fm + ((wgid % nig) % gsz); u.pn = (wgid % nig) / gsz; return true;
    }
    __device__ __forceinline__ void a_ready(const Unit&) const {}
    __device__ __forceinline__ void done(const Unit&) const {}
};
__device__ __forceinline__ unsigned cvt_pk_bf16(float lo, float hi) { unsigned r; asm volatile("v_cvt_pk_bf16_f32 %0, %1, %2" : "=v"(r) : "v"(lo), "v"(hi)); return r; }
typedef float f32x2 __attribute__((ext_vector_type(2)));
template <class Epi, class Sched, bool ALIGN_EPI = false, bool SP2 = false>
__device__ __forceinline__ void gemm_phase(PG8_LAS unsigned char* lds, const Gemm g, const Sched& S, const Epi& E, int wave_id) {
    int tid_; asm volatile("v_mbcnt_lo_u32_b32 %0, -1, 0\n\tv_mbcnt_hi_u32_b32 %0, -1, %0" : "=v"(tid_)); tid_ += wave_id * 64;
    const int tid = tid_, wid = __builtin_amdgcn_readfirstlane(tid >> 6), lane = tid & 63, wr = wid >> 2, wc = wid & 3, fr = lane & 15, fq = lane >> 4;
    const int K = g.K, nt = K / BK;
    unsigned voffA[2], voffB[2];
#pragma unroll
    for (int i = 0; i < 2; ++i) { int R, C; stage_rc(tid * 16 + i * 8192, R, C); const int Rb = Epi::PERM ? ((R & ~31) + perm32(R & 31)) : R;
        voffA[i] = (unsigned)(R * K + C) * 2u; voffB[i] = (unsigned)(Rb * K + C) * 2u; }
    const size_t kstep = (size_t)(BK * 2);
    const size_t hstep = (size_t)HALF * K * 2;
    const size_t tstep = 2 * hstep;
    const unsigned ldsw = (unsigned)wid * 1024u;
    const int aoff = lds_byte(wr * 64 + fr, fq * 8), boff = lds_byte(wc * 32 + fr, fq * 8);
#define PG8_SA(b, h) (((b) * 2 + (h)) * HTB)
#define PG8_SB(b, h) ((4 + (b) * 2 + (h)) * HTB)
#define PG8_STAGE(bufoff, gbase, voff) do { _Pragma("unroll") for (int _i = 0; _i < 2; ++_i) \
        __builtin_amdgcn_global_load_lds((const unsigned*)((const char*)(gbase) + (voff)[_i]), (PG8_LAS unsigned*)(lds + (bufoff) + ldsw + _i * 8192), 16, 0, 0); } while (0)
#define PG8_LDA(dst, b, h) do { _Pragma("unroll") for (int m = 0; m < 4; ++m) _Pragma("unroll") for (int k = 0; k < 2; ++k) dst[m][k] = *(const PG8_LAS bf16x8*)(lds + PG8_SA(b, h) + aoff + m * 2048 + k * 1024); } while (0)
#define PG8_LDB(dst, b, h) do { _Pragma("unroll") for (int n = 0; n < 2; ++n) _Pragma("unroll") for (int k = 0; k < 2; ++k) dst[n][k] = *(const PG8_LAS bf16x8*)(lds + PG8_SB(b, h) + boff + n * 2048 + k * 1024); } while (0)
#define PG8_MMA(ai, bj, At, Bt) do { __builtin_amdgcn_s_setprio(1); _Pragma("unroll") for (int m = 0; m < 4; ++m) _Pragma("unroll") for (int n = 0; n < 2; ++n) _Pragma("unroll") for (int k = 0; k < 2; ++k) \
        acc[ai][bj][m][n] = __builtin_amdgcn_mfma_f32_16x16x32_bf16(Bt[n][k], At[m][k], acc[ai][bj][m][n], 0, 0, 0); __builtin_amdgcn_s_setprio(0); } while (0)
#define PG8_WAIT_V(n) asm volatile("s_waitcnt vmcnt(" #n ")" ::: "memory")
#define PG8_WAIT_L(n) asm volatile("s_waitcnt lgkmcnt(" #n ")" ::: "memory")
#define PG8_BAR __builtin_amdgcn_s_barrier()
#define PG8_SCHED __builtin_amdgcn_sched_barrier(0)
    Unit cur, nxt; int ui = 0;
    if (!S.next(0, cur)) return;
    f32x4 acc[2][2][4][2];
#pragma unroll
    for (int a = 0; a < 2; ++a)
#pragma unroll
        for (int b = 0; b < 2; ++b)
#pragma unroll
            for (int m = 0; m < 4; ++m)
#pragma unroll
                for (int n = 0; n < 2; ++n) acc[a][b][m][n] = (f32x4){0.f, 0.f, 0.f, 0.f};
    bf16x8 At[4][2], B0[2][2], B1[2][2];
    const char* cA = (const char*)g.A + (size_t)cur.pm * tstep; const char* cB = (const char*)g.Bt + (size_t)cur.pn * tstep;
    S.a_ready(cur);
    if constexpr (SP2) {
        PG8_STAGE(PG8_SB(0, 0), cB, voffB); PG8_STAGE(PG8_SB(0, 1), cB + hstep, voffB); PG8_STAGE(PG8_SA(0, 0), cA, voffA); PG8_STAGE(PG8_SA(0, 1), cA + hstep, voffA);
        if (wr == 1) PG8_BAR;
        PG8_WAIT_V(2); PG8_BAR;
        PG8_STAGE(PG8_SB(1, 0), cB + kstep, voffB); PG8_STAGE(PG8_SA(1, 0), cA + kstep, voffA); PG8_STAGE(PG8_SB(1, 1), cB + hstep + kstep, voffB);
        PG8_WAIT_V(6); PG8_BAR;
    } else {
        PG8_STAGE(PG8_SB(0, 0), cB, voffB); PG8_STAGE(PG8_SA(0, 0), cA, voffA); PG8_STAGE(PG8_SB(0, 1), cB + hstep, voffB); PG8_STAGE(PG8_SA(0, 1), cA + hstep, voffA);
        if (wr == 1) PG8_BAR;
        PG8_WAIT_V(4); PG8_BAR;
        PG8_STAGE(PG8_SB(1, 0), cB + kstep, voffB); PG8_STAGE(PG8_SA(1, 0), cA + kstep, voffA); PG8_STAGE(PG8_SB(1, 1), cB + hstep + kstep, voffB);
        PG8_WAIT_V(6); PG8_BAR;
    }
    for (;;) {
        const bool has_next = S.next(ui + 1, nxt);
        const char* nA = has_next ? (const char*)g.A + (size_t)nxt.pm * tstep : cA; const char* nB = has_next ? (const char*)g.Bt + (size_t)nxt.pn * tstep : cB;
        for (int t = 0; t < nt; t += 2) {
            const bool last = (t == nt - 2);
            const char* a1 = cA + (size_t)(t + 1) * kstep;
            const char* a2 = last ? nA : cA + (size_t)(t + 2) * kstep; const char* b2 = last ? nB : cB + (size_t)(t + 2) * kstep;
            const char* a3 = a2 + kstep; const char* b3 = b2 + kstep;
            if (last && has_next) S.a_ready(nxt);
            if constexpr (SP2) {
            PG8_LDB(B0, 0, 0); PG8_LDB(B1, 0, 1); PG8_SCHED; PG8_LDA(At, 0, 0); PG8_STAGE(PG8_SA(1, 1), a1 + hstep, voffA);
            PG8_WAIT_V(8); PG8_WAIT_L(0); PG8_BAR; PG8_MMA(0, 0, At, B0); PG8_MMA(0, 1, At, B1); PG8_BAR; PG8_SCHED;
            PG8_LDA(At, 0, 1); PG8_STAGE(PG8_SB(0, 0), b2, voffB); PG8_STAGE(PG8_SB(0, 1), b2 + hstep, voffB); PG8_STAGE(PG8_SA(0, 0), a2, voffA);
            PG8_WAIT_V(8); PG8_WAIT_L(0); PG8_BAR; PG8_MMA(1, 0, At, B0); PG8_MMA(1, 1, At, B1); PG8_BAR; PG8_SCHED;
            PG8_LDB(B0, 1, 0); PG8_LDB(B1, 1, 1); PG8_SCHED; PG8_LDA(At, 1, 0); PG8_STAGE(PG8_SA(0, 1), a2 + hstep, voffA);
            PG8_WAIT_V(8); PG8_WAIT_L(0); PG8_BAR; PG8_MMA(0, 0, At, B0); PG8_MMA(0, 1, At, B1); PG8_BAR; PG8_SCHED;
            PG8_LDA(At, 1, 1); PG8_STAGE(PG8_SB(1, 0), b3, voffB); PG8_STAGE(PG8_SB(1, 1), b3 + hstep, voffB); PG8_STAGE(PG8_SA(1, 0), a3, voffA);
            PG8_WAIT_V(8); PG8_WAIT_L(0); PG8_BAR; PG8_MMA(1, 0, At, B0); PG8_MMA(1, 1, At, B1); PG8_BAR; PG8_SCHED;
            } else {
            PG8_LDB(B0, 0, 0); PG8_SCHED; PG8_LDA(At, 0, 0); PG8_STAGE(PG8_SA(1, 1), a1 + hstep, voffA);
            PG8_WAIT_L(8); PG8_BAR; PG8_WAIT_L(0); PG8_MMA(0, 0, At, B0); PG8_BAR; PG8_SCHED;
            PG8_LDB(B1, 0, 1); PG8_STAGE(PG8_SB(0, 0), b2, voffB);
            PG8_BAR; PG8_WAIT_L(0); PG8_MMA(0, 1, At, B1); PG8_BAR;
            PG8_LDA(At, 0, 1); PG8_STAGE(PG8_SA(0, 0), a2, voffA);
            PG8_BAR; PG8_WAIT_L(0); PG8_MMA(1, 0, At, B0); PG8_BAR; PG8_SCHED;
            PG8_STAGE(PG8_SB(0, 1), b2 + hstep, voffB);
            PG8_WAIT_V(6); PG8_BAR; PG8_MMA(1, 1, At, B1); PG8_BAR;
            PG8_LDB(B0, 1, 0); PG8_SCHED; PG8_LDA(At, 1, 0); PG8_STAGE(PG8_SA(0, 1), a2 + hstep, voffA);
            PG8_WAIT_L(8); PG8_BAR; PG8_WAIT_L(0); PG8_MMA(0, 0, At, B0); PG8_BAR; PG8_SCHED;
            PG8_LDB(B1, 1, 1); PG8_STAGE(PG8_SB(1, 0), b3, voffB);
            PG8_BAR; PG8_WAIT_L(0); PG8_MMA(0, 1, At, B1); PG8_BAR;
            PG8_LDA(At, 1, 1); PG8_STAGE(PG8_SA(1, 0), a3, voffA);
            PG8_BAR; PG8_WAIT_L(0); PG8_MMA(1, 0, At, B0); PG8_BAR; PG8_SCHED;
            PG8_STAGE(PG8_SB(1, 1), b3 + hstep, voffB);
            PG8_WAIT_V(6); PG8_BAR; PG8_MMA(1, 1, At, B1); PG8_BAR;
            }
        }
        if constexpr (ALIGN_EPI) { if (wr == 0) PG8_BAR; }
        if constexpr (!Epi::AFTER_DRAIN) { E(acc, cur, wr, wc, fr, fq); S.done(cur); }
        if (!has_next) break;
#pragma unroll
        for (int a = 0; a < 2; ++a)
#pragma unroll
            for (int b = 0; b < 2; ++b)
#pragma unroll
                for (int m = 0; m < 4; ++m)
#pragma unroll
                    for (int n = 0; n < 2; ++n) acc[a][b][m][n] = (f32x4){0.f, 0.f, 0.f, 0.f};
        cur = nxt; cA = nA; cB = nB; ++ui;
        if constexpr (ALIGN_EPI) { if (wr == 1) PG8_BAR; }
    }
    PG8_WAIT_V(0);
    if constexpr (!ALIGN_EPI) { if (wr == 0) PG8_BAR; }
    PG8_BAR;
    if constexpr (Epi::AFTER_DRAIN) { E.fused(acc, cur, wr, wc, fr, fq, lds, wid, lane); S.done(cur); }
#undef PG8_SA
#undef PG8_SB
#undef PG8_STAGE
#undef PG8_LDA
#undef PG8_LDB
#undef PG8_MMA
#undef PG8_WAIT_V
#undef PG8_WAIT_L
#undef PG8_BAR
#undef PG8_SCHED
}
}
#define LAS __attribute__((address_space(3)))
#define XB_TMO      128
#define XB_XCNT(j)  (256  + 64 * (j))
#define XB_XSUB(j)  (1280 + 64 * (j))
#define XB_XGEN(j)  (2304 + 64 * (j))
#define XB_TOP      3328
#define XB_TOPGEN   3392
#define XCD_BAR_WORDS 3456
#define XB_SPIN_CAP (1u << 24)

__device__ __forceinline__ unsigned xb_ld(unsigned* p)              { return __hip_atomic_load(p, __ATOMIC_RELAXED, __HIP_MEMORY_SCOPE_AGENT); }
__device__ __forceinline__ unsigned xb_add(unsigned* p, unsigned v) { return __hip_atomic_fetch_add(p, v, __ATOMIC_RELAXED, __HIP_MEMORY_SCOPE_AGENT); }
__device__ __forceinline__ unsigned xb_xcc_id() { return (unsigned)__builtin_amdgcn_s_getreg((3 << 11) | 20) & 0xFu; }
#define XB_SPIN(cond, bar) do { unsigned _sp = 0; while (cond) { __builtin_amdgcn_s_sleep(1); \
    if ((++_sp & 255u) == 0u) { if (xb_ld(&(bar)[XB_TMO])) break; if (_sp > XB_SPIN_CAP) { atomicAdd(&(bar)[XB_TMO], 1u); break; } } } } while (0)

struct XcdBarrier {
    unsigned* bar; unsigned x; unsigned w0;
    volatile LAS unsigned* st;
};

__device__ __forceinline__ bool xb_lane0() { return __builtin_amdgcn_mbcnt_hi(~0u, __builtin_amdgcn_mbcnt_lo(~0u, 0u)) == 0u; }
__device__ __forceinline__ XcdBarrier xcd_barrier_post(unsigned* bar, volatile LAS unsigned* st, unsigned w0) {
    XcdBarrier b; b.bar = bar; b.x = xb_xcc_id(); b.st = st; b.w0 = w0;
    if (w0 && xb_lane0()) (void)xb_add(&bar[XB_XCNT(b.x)], 1u);
    return b;
}
__device__ __forceinline__ void xcd_barrier_complete(unsigned* bar, unsigned x, unsigned& nloc, unsigned& nx) {
    const unsigned G = gridDim.x * gridDim.y * gridDim.z;
    unsigned sum, cnt, mine, sp = 0u;
    for (;;) {
        sum = 0u; cnt = 0u; mine = 0u;
#pragma unroll
        for (unsigned j = 0; j < 16; ++j) { const unsigned c = xb_ld(&bar[XB_XCNT(j)]); sum += c; cnt += (c > 0u) ? 1u : 0u; mine = (j == x) ? c : mine; }
        if (sum == G) break;
        __builtin_amdgcn_s_sleep(1);
        if ((++sp & 255u) == 0u) { if (xb_ld(&bar[XB_TMO])) break; if (sp > XB_SPIN_CAP) { atomicAdd(&bar[XB_TMO], 1u); break; } }
    }
    nloc = mine > 0u ? mine : 1u; nx = cnt > 0u ? cnt : 1u;
}

__device__ __forceinline__ void xcd_barrier(const XcdBarrier& b) {
    asm volatile("s_waitcnt vmcnt(0)" ::: "memory");
    __syncthreads();
    if (b.w0 && xb_lane0()) {
        unsigned* bar = b.bar;
        __builtin_amdgcn_s_waitcnt(0);
        unsigned nloc = b.st[0], nx = b.st[1];
        if (nloc == 0u) { xcd_barrier_complete(bar, b.x, nloc, nx); b.st[0] = nloc; b.st[1] = nx; }
        const unsigned old = xb_add(&bar[XB_XSUB(b.x)], 1u);
        const unsigned gen = old / nloc;
        if (old + 1u == (gen + 1u) * nloc) {
            __builtin_amdgcn_fence(__ATOMIC_RELEASE, "agent");
            asm volatile("s_waitcnt vmcnt(0)" ::: "memory");
            const unsigned og = xb_add(&bar[XB_TOP], 1u);
            const unsigned tg = og / nx;
            if (og + 1u == (tg + 1u) * nx) xb_add(&bar[XB_TOPGEN], 1u);
            else XB_SPIN(xb_ld(&bar[XB_TOPGEN]) == tg, bar);
            __builtin_amdgcn_fence(__ATOMIC_ACQUIRE, "agent");
            xb_add(&bar[XB_XGEN(b.x)], 1u);
            asm volatile("s_waitcnt vmcnt(0)" ::: "memory");
        } else {
            XB_SPIN(xb_ld(&bar[XB_XGEN(b.x)]) == gen, bar);
            __builtin_amdgcn_fence(__ATOMIC_ACQUIRE, "agent");
            asm volatile("s_waitcnt vmcnt(0)" ::: "memory");
        }
    }
    __syncthreads();
}
#ifndef EN_CH128
#define EN_CH128 1
#endif
#ifndef EN_CH192
#define EN_CH192 1
#endif
#ifndef EN_DN
#define EN_DN 1
#endif
#ifndef EN_GLU
#define EN_GLU 1
#endif
#ifndef EN_GU
#define EN_GU 1
#endif
#ifndef EN_INPROJ
#define EN_INPROJ 1
#endif
#ifndef EN_LN
#define EN_LN 1
#endif
#ifndef EN_MIX
#define EN_MIX 1
#endif
#ifndef EN_MOD
#define EN_MOD 1
#endif
#ifndef EN_OUT
#define EN_OUT 1
#endif
#ifndef EN_PRE
#define EN_PRE 1
#endif
#ifndef EN_PRO
#define EN_PRO 1
#endif
#ifndef EN_S5N
#define EN_S5N 1
#endif

constexpr int DM = 4096, NB = 2, SEQ = 8192, MTOK = NB * SEQ, DEPTH = 4;
constexpr int S5W = 1024;
constexpr int HGW = 1536;
constexpr int GLKW = 768;
constexpr int INW = 11792, INP = 12032, DFF = 11008;
constexpr int OW = 3072;
constexpr int C_U = 0, C_QB = 1024, C_FB = 2560, C_IB = 4096, C_GB = 5632, C_QC = 7168, C_KC = 7936, C_VC = 8704, C_GC = 10240, C_LR = 11776;
constexpr float LN_EPS = 1e-5f;
constexpr float ALPHA = 1.6817928305074290861f;
constexpr float GLA_QSCALE = 0.07216878364870322f;

enum { I_X = 0, I_C, I_WADA, I_BADA, I_TABLE, I_WIN, I_WOUT, I_AREAL, I_AIMAG, I_LOGDT, I_BRE, I_BIM, I_CRE, I_CIM, I_S5D, I_GLUW, I_GLUB,
       I_LBRAW, I_HGG, I_HGB, I_WGATE, I_BGATE, I_GLG, I_WFG, I_WFU, I_WFD, I_LN1G, I_LN1B, I_LN2G, I_LN2B, N_IN };

constexpr size_t MiB = 1u << 20;
constexpr size_t WS_CTL = 0, CTL_ZERO_BYTES = 1 * MiB;
constexpr size_t WS_MOD = 1 * MiB;
constexpr size_t WS_MISC = 2 * MiB;
constexpr size_t WS_ROWSTATS = 3 * MiB;
constexpr size_t WS_ROWPART = 4 * MiB;
constexpr size_t WS_CONDPART = 12 * MiB;
constexpr size_t WS_H = 24 * MiB;
constexpr size_t WS_MIXED = WS_H + 128 * MiB;
constexpr size_t WS_Z = WS_MIXED + 128 * MiB;
constexpr size_t WS_O = WS_Z + 32 * MiB;
constexpr size_t WS_P = WS_O + 192 * MiB;
constexpr size_t WS_WT = WS_P + 376 * MiB;
constexpr size_t WT_IN = 0, WT_OUT = 94 * MiB, WT_GU = 126 * MiB, WT_DN = 298 * MiB, WT_GLU = 384 * MiB, WT_LAYER = 386 * MiB;
constexpr size_t WS_HGB = WS_WT + DEPTH * WT_LAYER;
constexpr size_t WS_GLB = WS_HGB + 198 * MiB;
constexpr size_t WS_S5T = WS_GLB + 128 * MiB;
constexpr size_t WS_S5W1 = WS_S5T + 576 * MiB;
constexpr size_t WS_UX = WS_S5W1 + 144 * MiB;
constexpr size_t WS_SLOC = WS_UX + 36 * MiB;
constexpr size_t WS_LAM64 = WS_SLOC + 8 * MiB;
constexpr size_t WS_ST = WS_LAM64 + 1 * MiB;
constexpr size_t WS_END = WS_ST + 36 * MiB;
static_assert((size_t)INP * DM * 2 == 94 * MiB && (size_t)DM * DM * 2 == 32 * MiB && (size_t)2 * DFF * DM * 2 == 172 * MiB && (size_t)DM * DFF * 2 == 86 * MiB, "weight map");
static_assert((size_t)MTOK * INP * 2 == 376 * MiB && (size_t)MTOK * DFF * 2 <= 376 * MiB, "activation map");

constexpr int RING_BYTES = 131072;
constexpr int LDSCTL_OFF = 135168;
constexpr int LDS_BYTES = 147456;

#ifndef LAS
#define LAS __attribute__((address_space(3)))
#endif
typedef unsigned short bf16_t;
typedef float f32x4 __attribute__((ext_vector_type(4)));
typedef float f32x2 __attribute__((ext_vector_type(2)));
typedef unsigned u32x4 __attribute__((ext_vector_type(4)));
typedef unsigned u32x2 __attribute__((ext_vector_type(2)));
#define LDS_WAIT() asm volatile("s_waitcnt lgkmcnt(0)" ::: "memory")
#define VM_WAIT() asm volatile("s_waitcnt vmcnt(0)" ::: "memory")
typedef __bf16 bf16x2_t __attribute__((ext_vector_type(2)));
__device__ __forceinline__ unsigned cvt_pk_bf16(float lo, float hi) { return __builtin_bit_cast(unsigned, __builtin_convertvector((f32x2){lo, hi}, bf16x2_t)); }

__device__ __forceinline__ float bf_lo(unsigned w) { return __uint_as_float(w << 16); }
__device__ __forceinline__ float bf_hi(unsigned w) { return __uint_as_float(w & 0xffff0000u); }
__device__ __forceinline__ float bf2f(bf16_t b) { return __uint_as_float(((unsigned)b) << 16); }
__device__ __forceinline__ float wave_sum(float v) {
#pragma unroll
    for (int o = 1; o < 64; o <<= 1) v += __shfl_xor(v, o);
    return v;
}
__device__ __forceinline__ float sigmoidf_(float x) { return 1.0f / (1.0f + __expf(-x)); }
__device__ __forceinline__ float gelu_tanh(float y) { const float a = 0.7978845608028654f * (y + 0.044715f * y * y * y); const float t = 1.0f - 2.0f / (1.0f + __expf(2.0f * a)); return 0.5f * y * (1.0f + t); }

struct EpiProj {
    static constexpr bool PERM = true, AFTER_DRAIN = false;
    bf16_t* P; bf16_t* UX;
    __device__ __forceinline__ void operator()(const f32x4 (&acc)[2][2][4][2], const pg8::Unit& u, int wr, int wc, int fr, int fq) const {
        const int row0 = u.pm * 256 + wr * 64 + fr, col0 = u.pn * 256 + wc * 32 + 8 * fq;
        const bool s5 = u.pn < 4;
#pragma unroll
        for (int ai = 0; ai < 2; ++ai)
#pragma unroll
            for (int m = 0; m < 4; ++m) { const int row = row0 + ai * 128 + m * 16;
#pragma unroll
                for (int bj = 0; bj < 2; ++bj) { const f32x4 v0 = acc[ai][bj][m][0], v1 = acc[ai][bj][m][1]; const int col = col0 + bj * 128;
                    u32x4 w; w.x = cvt_pk_bf16(v0[0], v0[1]); w.y = cvt_pk_bf16(v0[2], v0[3]); w.z = cvt_pk_bf16(v1[0], v1[1]); w.w = cvt_pk_bf16(v1[2], v1[3]);
                    if (!s5) *(u32x4*)(P + (size_t)row * INP + col) = w;
                    else { bf16_t* ur = UX + (size_t)((col >> 4) * 256 + (row >> 6)) * 1152; *(u32x4*)(ur + (row & 63) * 16 + (col & 15)) = w;
                        if ((row & 63) == 0) { const u32x4 z = (u32x4){0u, 0u, 0u, 0u}; bf16_t* zp = ur + 1024 + ((col & 15) ? 64 : 0);
#pragma unroll
                            for (int i = 0; i < 8; ++i) *(u32x4*)(zp + 8 * i) = z; } } } }
    }
};
struct EpiSwiglu {
    static constexpr bool PERM = true, AFTER_DRAIN = false;
    bf16_t* HID;
    __device__ __forceinline__ void operator()(const f32x4 (&acc)[2][2][4][2], const pg8::Unit& u, int wr, int wc, int fr, int fq) const {
        const int row0 = u.pm * 256 + wr * 64 + fr, col0 = u.pn * 128 + wc * 32 + 8 * fq;
#pragma unroll
        for (int ai = 0; ai < 2; ++ai)
#pragma unroll
            for (int m = 0; m < 4; ++m) { bf16_t* rowp = HID + (size_t)(row0 + ai * 128 + m * 16) * DFF + col0;
                float o[8];
#pragma unroll
                for (int n = 0; n < 2; ++n)
#pragma unroll
                    for (int j = 0; j < 4; ++j) { const float g = acc[ai][0][m][n][j], up = acc[ai][1][m][n][j]; o[n * 4 + j] = g * __builtin_amdgcn_rcpf(1.0f + __expf(-g)) * up; }
                u32x4 w; w.x = cvt_pk_bf16(o[0], o[1]); w.y = cvt_pk_bf16(o[2], o[3]); w.z = cvt_pk_bf16(o[4], o[5]); w.w = cvt_pk_bf16(o[6], o[7]);
                *(u32x4*)rowp = w; }
    }
};
struct EpiGlu {
    static constexpr bool PERM = true, AFTER_DRAIN = false;
    const bf16_t* Z; bf16_t* MIXED; const float* bias;
    __device__ __forceinline__ void operator()(const f32x4 (&acc)[2][2][4][2], const pg8::Unit& u, int wr, int wc, int fr, int fq) const {
        const int row0 = u.pm * 256 + wr * 64 + fr, col0 = u.pn * 256 + wc * 32 + 8 * fq;
#pragma unroll
        for (int bj = 0; bj < 2; ++bj) {
            const f32x4 b0 = *(const f32x4*)(bias + col0 + bj * 128), b1 = *(const f32x4*)(bias + col0 + bj * 128 + 4);
#pragma unroll
            for (int ai = 0; ai < 2; ++ai)
#pragma unroll
                for (int m = 0; m < 4; ++m) { const size_t r = (size_t)(row0 + ai * 128 + m * 16);
                    const u32x4 zz = *(const u32x4*)(Z + r * S5W + col0 + bj * 128);
                    const f32x4 v0 = acc[ai][bj][m][0] + b0, v1 = acc[ai][bj][m][1] + b1;
                    u32x4 w;
                    w.x = cvt_pk_bf16(bf_lo(zz.x) * sigmoidf_(v0[0]), bf_hi(zz.x) * sigmoidf_(v0[1]));
                    w.y = cvt_pk_bf16(bf_lo(zz.y) * sigmoidf_(v0[2]), bf_hi(zz.y) * sigmoidf_(v0[3]));
                    w.z = cvt_pk_bf16(bf_lo(zz.z) * sigmoidf_(v1[0]), bf_hi(zz.z) * sigmoidf_(v1[1]));
                    w.w = cvt_pk_bf16(bf_lo(zz.w) * sigmoidf_(v1[2]), bf_hi(zz.w) * sigmoidf_(v1[3]));
                    *(u32x4*)(MIXED + r * DM + col0 + bj * 128) = w;
                    if (m & 1) asm volatile("" ::: "memory"); }
        }
    }
};
struct EpiResid {
    static constexpr bool PERM = false, AFTER_DRAIN = false;
    const float* base; float* out; const float* rowstats; const float* lng; const float* lnb; const float* gate0; float* rowpart;
    __device__ __forceinline__ void operator()(const f32x4 (&acc)[2][2][4][2], const pg8::Unit& u, int wr, int wc, int fr, int fq) const {
        const int rowb = u.pm * 256 + wr * 64 + fr, col0 = u.pn * 256 + wc * 32 + 4 * fq;
        const float* gp = gate0 + (u.pm >= 32 ? 6 * DM : 0);
#pragma unroll
        for (int ai = 0; ai < 2; ++ai)
#pragma unroll
            for (int m = 0; m < 4; ++m) { const int row = rowb + ai * 128 + m * 16;
                const f32x2 st = *(const f32x2*)(rowstats + (size_t)row * 2);
                float s1 = 0.f, s2 = 0.f;
#pragma unroll
                for (int bj = 0; bj < 2; ++bj)
#pragma unroll
                    for (int n = 0; n < 2; ++n) { const int c = col0 + bj * 128 + n * 16; const size_t off = (size_t)row * DM + c;
                        const f32x4 vb = *(const f32x4*)(base + off);
                        const f32x4 A = *(const f32x4*)(lng + c), Bc = *(const f32x4*)(lnb + c), Gm = *(const f32x4*)(gp + c);
                        const f32x4 o = (((vb - st.x) * st.y) * A + Bc) * ALPHA + (Gm + 1.0f) * acc[ai][bj][m][n];
                        *(f32x4*)(out + off) = o;
                        s1 += (o[0] + o[1]) + (o[2] + o[3]); s2 += (o[0] * o[0] + o[1] * o[1]) + (o[2] * o[2] + o[3] * o[3]); }
                s1 += __shfl_xor(s1, 16); s1 += __shfl_xor(s1, 32); s2 += __shfl_xor(s2, 16); s2 += __shfl_xor(s2, 32);
                if (fq == 0) *(f32x2*)(rowpart + ((size_t)row * 64 + u.pn * 4 + wc) * 2) = (f32x2){s1, s2};
                asm volatile("" ::: "memory"); }
    }
};

__device__ __forceinline__ int lane_id_v() { int r; asm volatile("v_mbcnt_lo_u32_b32 %0, -1, 0\n\tv_mbcnt_hi_u32_b32 %0, -1, %0" : "=v"(r)); return r; }
struct Args { const float* in[N_IN]; float* out; unsigned char* ws; int ph_lo, ph_hi; };
struct Ctx {
    volatile LAS unsigned long long* t;
    __device__ __forceinline__ unsigned long long ld(int i) const { const unsigned long long v = t[i];
        return ((unsigned long long)(unsigned)__builtin_amdgcn_readfirstlane((int)(v >> 32)) << 32) | (unsigned long long)(unsigned)__builtin_amdgcn_readfirstlane((int)(unsigned)v); }
    __device__ __forceinline__ const float* in(int i) const { return (const float*)ld(i); }
    __device__ __forceinline__ float* out() const { return (float*)ld(30); }
    __device__ __forceinline__ unsigned char* ws() const { return (unsigned char*)ld(31); }
};

constexpr int S5K = 1152;
constexpr size_t S5_T_LAYER = (size_t)64 * 1024 * S5K * 2, S5_W1_LAYER = (size_t)64 * 256 * S5K * 2;

struct S5Order {
    int G, c, n, sh;
    __device__ __forceinline__ bool next(int i, pg8::Unit& u) const { const int L = i * G + c; if (L >= n) return false; u.pm = L >> sh; u.pn = L; return true; }
    __device__ __forceinline__ void a_ready(const pg8::Unit&) const {}
    __device__ __forceinline__ void done(const pg8::Unit&) const {}
};
struct EpiS5A {
    static constexpr bool PERM = false, AFTER_DRAIN = false;
    float* Sloc;
    __device__ __forceinline__ void operator()(const f32x4 (&acc)[2][2][4][2], const pg8::Unit& u, int wr, int wc, int fr, int fq) const {
        const int row0 = u.pm * 256 + wr * 64 + fr, col0 = wc * 32 + 4 * fq;
#pragma unroll
        for (int ai = 0; ai < 2; ++ai)
#pragma unroll
            for (int m = 0; m < 4; ++m)
#pragma unroll
                for (int n = 0; n < 2; ++n) *(f32x4*)(Sloc + (size_t)(row0 + ai * 128 + m * 16) * 128 + col0 + n * 16) = acc[ai][0][m][n];
    }
};
struct EpiS5C {
    static constexpr bool PERM = true, AFTER_DRAIN = false;
    bf16_t* Z;
    __device__ __forceinline__ void operator()(const f32x4 (&acc)[2][2][4][2], const pg8::Unit& u, int wr, int wc, int fr, int fq) const {
        const int g = u.pm, c0 = wr * 64 + fr, cc0 = (u.pn & 3) * 256 + wc * 32 + 8 * fq;
#pragma unroll
        for (int ai = 0; ai < 2; ++ai)
#pragma unroll
            for (int m = 0; m < 4; ++m) { const int c = c0 + ai * 128 + m * 16;
#pragma unroll
                for (int bj = 0; bj < 2; ++bj) { const int cc = cc0 + bj * 128, t = cc >> 4, h0 = cc & 15;
                    const f32x4 v0 = acc[ai][bj][m][0], v1 = acc[ai][bj][m][1];
                    u32x4 w; w.x = cvt_pk_bf16(gelu_tanh(v0[0]), gelu_tanh(v0[1])); w.y = cvt_pk_bf16(gelu_tanh(v0[2]), gelu_tanh(v0[3]));
                    w.z = cvt_pk_bf16(gelu_tanh(v1[0]), gelu_tanh(v1[1])); w.w = cvt_pk_bf16(gelu_tanh(v1[2]), gelu_tanh(v1[3]));
                    *(u32x4*)(Z + (size_t)(c * 64 + t) * S5W + g * 16 + h0) = w; } }
    }
};
__device__ __forceinline__ void s5_tables_item(const Ctx& a, int lg, LAS unsigned char* lds, int wave, int lane) {
    LAS f32x2* LP = (LAS f32x2*)lds;
    LAS f32x2* BB = (LAS f32x2*)(lds + 33280);
    LAS f32x2* CC = (LAS f32x2*)(lds + 41472);
    LAS float* KT = (LAS float*)(lds + 49664);
    const int tid = wave * 64 + lane, l = lg >> 6, g = lg & 63;
    if (tid < 64) { const int p = tid;
        const double ar = (double)a.in(I_AREAL)[lg * 64 + p], ai = (double)a.in(I_AIMAG)[lg * 64 + p], dt = exp((double)a.in(I_LOGDT)[lg]);
        const double mag = exp(ar * dt), ang = ai * dt, lr = mag * cos(ang), li = mag * sin(ang);
        const double den = ar * ar + ai * ai, nr = lr - 1.0, ni = li, cr = (nr * ar + ni * ai) / den, ci = (ni * ar - nr * ai) / den;
        double pr = 1.0, pi = 0.0;
        for (int tau = 0; tau <= 64; ++tau) { LP[tau * 64 + p] = (f32x2){(float)pr, (float)pi}; const double nr2 = pr * lr - pi * li, ni2 = pr * li + pi * lr; pr = nr2; pi = ni2; }
        for (int h = 0; h < 16; ++h) { const double br = (double)a.in(I_BRE)[((size_t)lg * 64 + p) * 16 + h], bi = (double)a.in(I_BIM)[((size_t)lg * 64 + p) * 16 + h];
            BB[p * 16 + h] = (f32x2){(float)(cr * br - ci * bi), (float)(cr * bi + ci * br)}; }
    }
    for (int e = tid; e < 1024; e += 512) { const int h = e >> 6, p = e & 63; CC[e] = (f32x2){a.in(I_CRE)[((size_t)lg * 16 + h) * 64 + p], a.in(I_CIM)[((size_t)lg * 16 + h) * 64 + p]}; }
    __syncthreads();
    if (tid < 64) *(f32x2*)((float*)(a.ws() + WS_LAM64) + ((size_t)lg * 64 + tid) * 2) = LP[64 * 64 + tid];
    for (int e = tid; e < 64 * 256; e += 512) { const int tau = e >> 8, h = (e >> 4) & 15, hp = e & 15; float s = 0.f;
#pragma unroll 8
        for (int p = 0; p < 64; ++p) { const f32x2 c = CC[h * 64 + p], lm = LP[tau * 64 + p], b = BB[p * 16 + hp];
            const float xr = c.x * lm.x - c.y * lm.y, xi = c.x * lm.y + c.y * lm.x; s += xr * b.x - xi * b.y; }
        if (tau == 0 && h == hp) s += a.in(I_S5D)[l * S5W + g * 16 + h];
        KT[e] = s; }
    __syncthreads();
    bf16_t* T = (bf16_t*)(a.ws() + WS_S5T + (size_t)l * S5_T_LAYER) + (size_t)g * 1024 * S5K;
    for (int pc = tid; pc < 1024 * 144; pc += 512) { const int n = pc / 144, j = pc % 144, t = n >> 4, h = n & 15; float v[8];
        if (j < 128) { const int s = j >> 1, hp0 = (j & 1) * 8;
            if (s > t) {
#pragma unroll
                for (int i = 0; i < 8; ++i) v[i] = 0.f;
            } else { const LAS float* kp = KT + (t - s) * 256 + h * 16 + hp0; const f32x4 k0 = *(const LAS f32x4*)kp, k1 = *(const LAS f32x4*)(kp + 4);
                v[0] = k0[0]; v[1] = k0[1]; v[2] = k0[2]; v[3] = k0[3]; v[4] = k1[0]; v[5] = k1[1]; v[6] = k1[2]; v[7] = k1[3]; }
        } else { const int p0 = (j - 128) * 4;
#pragma unroll
            for (int i = 0; i < 4; ++i) { const f32x2 c = CC[h * 64 + p0 + i], lm = LP[(t + 1) * 64 + p0 + i]; v[2 * i] = c.x * lm.x - c.y * lm.y; v[2 * i + 1] = -(c.x * lm.y + c.y * lm.x); } }
        *(u32x4*)(T + (size_t)n * S5K + j * 8) = (u32x4){cvt_pk_bf16(v[0], v[1]), cvt_pk_bf16(v[2], v[3]), cvt_pk_bf16(v[4], v[5]), cvt_pk_bf16(v[6], v[7])}; }
    bf16_t* W1 = (bf16_t*)(a.ws() + WS_S5W1 + (size_t)l * S5_W1_LAYER) + (size_t)g * 256 * S5K;
    for (int pc = tid; pc < 256 * 144; pc += 512) { const int n = pc / 144, j = pc % 144; float v[8];
#pragma unroll
        for (int i = 0; i < 8; ++i) v[i] = 0.f;
        if (n < 128 && j < 128) { const int p = n >> 1, ri = n & 1, s = j >> 1, hp0 = (j & 1) * 8; const f32x2 lm = LP[(63 - s) * 64 + p];
#pragma unroll
            for (int i = 0; i < 8; ++i) { const f32x2 b = BB[p * 16 + hp0 + i]; v[i] = ri ? (lm.x * b.y + lm.y * b.x) : (lm.x * b.x - lm.y * b.y); } }
        *(u32x4*)(W1 + (size_t)n * S5K + j * 8) = (u32x4){cvt_pk_bf16(v[0], v[1]), cvt_pk_bf16(v[2], v[3]), cvt_pk_bf16(v[4], v[5]), cvt_pk_bf16(v[6], v[7])}; }
    __syncthreads();
}
__device__ __forceinline__ void s5_scan_item(const Ctx& a, int l, int item, int wave, int lane) {
    const int idx = item * 512 + wave * 64 + lane, g = idx >> 7, b = (idx >> 6) & 1, p = idx & 63;
    const f32x2 lam = *(const f32x2*)((const float*)(a.ws() + WS_LAM64) + ((size_t)(l * 64 + g) * 64 + p) * 2);
    const float* sl = (const float*)(a.ws() + WS_SLOC) + ((size_t)(g * 256 + b * 128)) * 128 + 2 * p;
    bf16_t* ux = (bf16_t*)(a.ws() + WS_UX) + ((size_t)(g * 256 + b * 128)) * S5K + 1024 + 2 * p;
    float xr = 0.f, xi = 0.f;
    for (int c0 = 0; c0 < 128; c0 += 8) { f32x2 s[8];
#pragma unroll
        for (int i = 0; i < 8; ++i) s[i] = *(const f32x2*)(sl + (size_t)(c0 + i) * 128);
#pragma unroll
        for (int i = 0; i < 8; ++i) { *(unsigned*)(ux + (size_t)(c0 + i) * S5K) = cvt_pk_bf16(xr, xi);
            const float nr = lam.x * xr - lam.y * xi + s[i].x, ni = lam.x * xi + lam.y * xr + s[i].y; xr = nr; xi = ni; } }
}

__device__ __forceinline__ void transpose_item(const float* W, int N, int k0, int n0, bf16_t* WT, int drow0, int Kd, LAS float* scr, int lane) {
    const int nl = 4 * (lane & 15), kq = lane >> 4;
    const bool valid = (n0 + nl) < N;
    f32x4 v[16];
#pragma unroll
    for (int i = 0; i < 16; ++i) { const int k = 4 * i + kq; v[i] = valid ? *(const f32x4*)(W + (size_t)(k0 + k) * N + n0 + nl) : (f32x4){0.f, 0.f, 0.f, 0.f}; }
#pragma unroll
    for (int i = 0; i < 16; ++i) { const int k = 4 * i + kq; LAS float* s = scr + k * 65 + nl; s[0] = v[i][0]; s[1] = v[i][1]; s[2] = v[i][2]; s[3] = v[i][3]; }
    LDS_WAIT();
    const int c = lane & 7;
#pragma unroll
    for (int j = 0; j < 8; ++j) { const int n = (lane >> 3) + 8 * j; const LAS float* s = scr + (8 * c) * 65 + n;
        u32x4 o; o.x = cvt_pk_bf16(s[0], s[65]); o.y = cvt_pk_bf16(s[130], s[195]); o.z = cvt_pk_bf16(s[260], s[325]); o.w = cvt_pk_bf16(s[390], s[455]);
        *(u32x4*)(WT + (size_t)(drow0 + n) * Kd + k0 + 8 * c) = o; }
    LDS_WAIT();
}
constexpr int NIT_IN = 64 * 188, NIT_OUT = 64 * 64, NIT_G = 64 * 172, NIT_DN = 172 * 64, NIT_GLU = 16 * 16;
constexpr int NIT_LAYER = NIT_IN + NIT_OUT + 2 * NIT_G + NIT_DN + NIT_GLU;
constexpr int NIT_TR = DEPTH * NIT_LAYER, NIT_COND = 64 * 96;

__device__ __forceinline__ void phase_prologue(const Ctx& a, LAS unsigned char* lds, int wave, int lane) {
    LAS float* scr = (LAS float*)(lds + wave * 16640);
    const int gw = blockIdx.x * 8 + wave, NGW = gridDim.x * 8;
    for (int it = gw; it < NIT_TR + NIT_COND; it += NGW) {
        if (it < NIT_TR) {
            const int l = it / NIT_LAYER; int r = it % NIT_LAYER;
            unsigned char* wt = a.ws() + WS_WT + (size_t)l * WT_LAYER;
            if (r < NIT_IN) { const int kb = r / 188, nb = r % 188; transpose_item(a.in(I_WIN) + (size_t)l * DM * INW, INW, 64 * kb, 64 * nb, (bf16_t*)(wt + WT_IN), 64 * nb, DM, scr, lane); continue; } r -= NIT_IN;
            if (r < NIT_OUT) { const int kb = r / 64, nb = r % 64; transpose_item(a.in(I_WOUT) + (size_t)l * DM * DM, DM, 64 * kb, 64 * nb, (bf16_t*)(wt + WT_OUT), 64 * nb, DM, scr, lane); continue; } r -= NIT_OUT;
            if (r < NIT_G) { const int kb = r / 172, nb = r % 172, n0 = 64 * nb; transpose_item(a.in(I_WFG) + (size_t)l * DM * DFF, DFF, 64 * kb, n0, (bf16_t*)(wt + WT_GU), 256 * (n0 / 128) + (n0 % 128), DM, scr, lane); continue; } r -= NIT_G;
            if (r < NIT_G) { const int kb = r / 172, nb = r % 172, n0 = 64 * nb; transpose_item(a.in(I_WFU) + (size_t)l * DM * DFF, DFF, 64 * kb, n0, (bf16_t*)(wt + WT_GU), 256 * (n0 / 128) + 128 + (n0 % 128), DM, scr, lane); continue; } r -= NIT_G;
            if (r < NIT_DN) { const int kb = r / 64, nb = r % 64; transpose_item(a.in(I_WFD) + (size_t)l * DFF * DM, DM, 64 * kb, 64 * nb, (bf16_t*)(wt + WT_DN), 64 * nb, DFF, scr, lane); continue; } r -= NIT_DN;
            { const int kb = r / 16, nb = r % 16; transpose_item(a.in(I_GLUW) + (size_t)l * S5W * S5W, S5W, 64 * kb, 64 * nb, (bf16_t*)(wt + WT_GLU), 64 * nb, S5W, scr, lane); }
        } else {
            const int item = it - NIT_TR, kb = item / 96, jb = item % 96, k0 = 64 * kb, j0 = 256 * jb + 4 * lane;
            const float* c = a.in(I_C);
            float c0 = c[k0 + lane], c1 = c[DM + k0 + lane];
            c0 = c0 / (1.0f + expf(-c0)); c1 = c1 / (1.0f + expf(-c1));
            f32x4 a0 = (f32x4){0.f, 0.f, 0.f, 0.f}, a1 = a0;
            const float* w = a.in(I_WADA) + (size_t)k0 * (6 * DM) + j0;
#pragma unroll 8
            for (int kk = 0; kk < 64; ++kk) { const f32x4 wv = *(const f32x4*)(w + (size_t)kk * (6 * DM));
                const float s0 = __int_as_float(__builtin_amdgcn_readlane(__float_as_int(c0), kk)), s1 = __int_as_float(__builtin_amdgcn_readlane(__float_as_int(c1), kk));
                a0 += wv * s0; a1 += wv * s1; }
            float* cp = (float*)(a.ws() + WS_CONDPART);
            *(f32x4*)(cp + (size_t)(kb * 2 + 0) * (6 * DM) + j0) = a0;
            *(f32x4*)(cp + (size_t)(kb * 2 + 1) * (6 * DM) + j0) = a1;
        }
    }
    __syncthreads();
    for (int lg = blockIdx.x; lg < DEPTH * 64; lg += gridDim.x) s5_tables_item(a, lg, lds, wave, lane);
}
__device__ __forceinline__ void phase_mod(const Ctx& a, int wave, int lane) {
    const int gt = blockIdx.x * 512 + wave * 64 + lane, NT = gridDim.x * 512;
    const float* cp = (const float*)(a.ws() + WS_CONDPART);
    float* mod = (float*)(a.ws() + WS_MOD); float* misc = (float*)(a.ws() + WS_MISC);
    for (int idx = gt; idx < NB * 6 * DM; idx += NT) {
        const int b = idx / (6 * DM), j = idx % (6 * DM);
        float s = a.in(I_BADA)[j];
        for (int kb = 0; kb < 64; ++kb) s += cp[(size_t)(kb * 2 + b) * (6 * DM) + j];
        for (int l = 0; l < DEPTH; ++l) mod[(size_t)((l * 2 + b) * 6) * DM + j] = s + a.in(I_TABLE)[(size_t)l * 6 * DM + j];
    }
    for (int idx = gt; idx < DM; idx += NT) { misc[idx] = 1.0f; misc[DM + idx] = 0.0f; }
    for (int idx = gt; idx < HGW; idx += NT) {
        const float* raw = a.in(I_LBRAW); float r[DEPTH], mx = -3.0e38f;
#pragma unroll
        for (int l = 0; l < DEPTH; ++l) { r[l] = raw[l * HGW + idx]; mx = fmaxf(mx, r[l]); }
        float e[DEPTH], sum = 0.f;
#pragma unroll
        for (int l = 0; l < DEPTH; ++l) { e[l] = expf(r[l] - mx); sum += e[l]; }
        float cum = 0.f;
#pragma unroll
        for (int l = 0; l < DEPTH; ++l) { misc[2 * DM + l * HGW + idx] = cum; if (l + 1 < DEPTH) cum += e[l + 1] / sum; }
    }
}

template <int MODE>
__device__ __forceinline__ void phase_lnapply(const float* vsrc, const float* rowpart, float* rowstats, const float* lng, const float* lnb, const float* modp, int i_shift, int i_scale,
                                              bf16_t* H, float* outf, LAS unsigned char* lds, int wave, int lane) {
    LAS f32x2* st = (LAS f32x2*)lds;
    for (int blk = blockIdx.x; blk < MTOK / 64; blk += gridDim.x) {
        const int r0 = blk * 64, b = (r0 >= SEQ) ? 1 : 0;
        f32x2 pp[8];
        if (MODE != 0) {
#pragma unroll
            for (int rr = 0; rr < 8; ++rr) pp[rr] = *(const f32x2*)(rowpart + ((size_t)(r0 + wave * 8 + rr) * 64 + lane) * 2);
        }
#pragma unroll
        for (int rr = 0; rr < 8; ++rr) { const int rl = wave * 8 + rr, r = r0 + rl; float mu = 0.f, rs = 1.f;
            if (MODE != 0) { const float s1 = wave_sum(pp[rr].x), s2 = wave_sum(pp[rr].y);
                mu = s1 * (1.0f / DM); const float var = fmaxf(s2 * (1.0f / DM) - mu * mu, 0.f); rs = 1.0f / sqrtf(var + LN_EPS); }
            if (lane == 0) { st[rl] = (f32x2){mu, rs}; if (MODE != 2) *(f32x2*)(rowstats + (size_t)r * 2) = (f32x2){mu, rs}; } }
        __syncthreads();
        f32x4 A[2], B[2];
#pragma unroll
        for (int jj = 0; jj < 2; ++jj) { const int c = 512 * wave + 256 * jj + 4 * lane;
            f32x4 g = (f32x4){1.f, 1.f, 1.f, 1.f}, bb = (f32x4){0.f, 0.f, 0.f, 0.f};
            if (MODE != 0) { g = *(const f32x4*)(lng + c); bb = *(const f32x4*)(lnb + c); }
            if (MODE != 2) { const f32x4 sc = *(const f32x4*)(modp + (size_t)(b * 6 + i_scale) * DM + c) + 1.0f, sh = *(const f32x4*)(modp + (size_t)(b * 6 + i_shift) * DM + c); A[jj] = g * sc; B[jj] = bb * sc + sh; }
            else { A[jj] = g; B[jj] = bb; } }
#pragma unroll 8
        for (int rl = 0; rl < 64; ++rl) { const f32x2 s = st[rl]; const size_t off = (size_t)(r0 + rl) * DM + 512 * wave + 4 * lane;
#pragma unroll
            for (int jj = 0; jj < 2; ++jj) { const f32x4 v = *(const f32x4*)(vsrc + off + 256 * jj); const f32x4 y = ((v - s.x) * s.y) * A[jj] + B[jj];
                if (MODE == 2) *(f32x4*)(outf + off + 256 * jj) = y;
                else { u32x2 w; w.x = cvt_pk_bf16(y[0], y[1]); w.y = cvt_pk_bf16(y[2], y[3]); *(u32x2*)(H + off + 256 * jj) = w; } } }
        __syncthreads();
    }
}

typedef short bf16x8 __attribute__((ext_vector_type(8)));
typedef short bf16x4 __attribute__((ext_vector_type(4)));
constexpr int HG_BLK = 16896, HG_OQ = 0, HG_OK = 4096, HG_OKT = 8192, HG_OVT = 12288, HG_ODL = 16384;
constexpr int GL_BLK = 32768, GL_OQ = 0, GL_OK = 6400, GL_OKT = 12800, GL_ODL = 18944, GL_SHARED = 20480, GL_OVT = 20480;
constexpr int NSUB = SEQ / 16;

__device__ __forceinline__ unsigned short f2bf1(float x) { return (unsigned short)(cvt_pk_bf16(x, x) & 0xffffu); }

__device__ __forceinline__ void pre_finish(const float (&qq)[16], const float (&kk)[16], float (&g)[16], unsigned char* blk, int oq, int ok, int okt, int odl, int rowb, int d, bool swz) {
    float b = 0.f;
#pragma unroll
    for (int j = 0; j < 16; ++j) { b += g[j]; g[j] = b; }
    const float bl = b;
    unsigned kt[8];
#pragma unroll
    for (int j = 0; j < 16; j += 2) {
        float kv[2];
#pragma unroll
        for (int jj = 0; jj < 2; ++jj) { const int t = j + jj; const float bj = g[t];
            const int off = t * rowb + (swz ? ((2 * d) ^ (t << 4)) : 2 * d);
            const float qv = qq[t] * __expf(bj), kc = kk[t] * __expf(fminf(-bj, 80.f));
            const float qn = __int_as_float(__builtin_amdgcn_mov_dpp(__float_as_int(qv), 0xB1, 0xF, 0xF, true)), kn = __int_as_float(__builtin_amdgcn_mov_dpp(__float_as_int(kc), 0xB1, 0xF, 0xF, true));
            if ((d & 1) == 0) { *(unsigned*)(blk + oq + off) = cvt_pk_bf16(qv, qn); *(unsigned*)(blk + ok + off) = cvt_pk_bf16(kc, kn); }
            kv[jj] = kk[t] * __expf(bl - bj); }
        kt[j >> 1] = cvt_pk_bf16(kv[0], kv[1]); }
    *(u32x4*)(blk + okt + d * 32) = (u32x4){kt[0], kt[1], kt[2], kt[3]};
    *(u32x4*)(blk + okt + d * 32 + 16) = (u32x4){kt[4], kt[5], kt[6], kt[7]};
    *(float*)(blk + odl + d * 4) = __expf(bl);
}
__device__ __forceinline__ void phase_pre(const Ctx& a, int l, int wave, int lane) {
    const bf16_t* P = (const bf16_t*)(a.ws() + WS_P);
    int tid = wave * 64 + lane;
    for (int task = blockIdx.x; task < NB * NSUB * 8; task += gridDim.x) {
        asm volatile("" : "+v"(tid));
        const int kind = (task + (task >> 8)) & 7, bsc = task >> 3, b = bsc / NSUB, sc = bsc % NSUB;
        const size_t row0 = (size_t)b * SEQ + sc * 16;
        if (kind < 3) {
            const int ch = kind * 512 + tid, h = ch >> 7, d = ch & 127;
            const float lb = ((const float*)(a.ws() + WS_MISC))[2 * DM + l * HGW + ch];
            unsigned char* blk = a.ws() + WS_HGB + ((size_t)(b * 12 + h) * NSUB + sc) * HG_BLK;
            float g[16], qq[16], kk[16]; unsigned vv[8];
#pragma unroll
            for (int j = 0; j < 16; ++j) { const bf16_t* prow = P + (row0 + j) * INP;
                const float qin = fmaxf(bf2f(prow[C_QB + ch]), -80.f), fin = fminf(fmaxf(bf2f(prow[C_FB + ch]), -80.f), 80.f);
                const unsigned short v = prow[C_IB + ch]; if (j & 1) vv[j >> 1] |= ((unsigned)v) << 16; else vv[j >> 1] = v;
                const float e = __expf(-fin), sg = __builtin_amdgcn_rcpf(1.0f + e);
                const float f = lb + (1.0f - lb) * sg;
                g[j] = fmaxf(__logf(f), -100.f); kk[j] = (1.0f - lb) * (e * sg); qq[j] = qin * __builtin_amdgcn_rcpf(1.0f + __expf(-qin)); }
            *(u32x4*)(blk + HG_OVT + d * 32) = (u32x4){vv[0], vv[1], vv[2], vv[3]};
            *(u32x4*)(blk + HG_OVT + d * 32 + 16) = (u32x4){vv[4], vv[5], vv[6], vv[7]};
            pre_finish(qq, kk, g, blk, HG_OQ, HG_OK, HG_OKT, HG_ODL, 256, d, true);
        } else if (kind < 5) {
            if (tid < 384) {
                const int ch = (kind - 3) * 384 + tid, h = ch / 192, d = ch % 192;
                unsigned char* blk = a.ws() + WS_GLB + ((size_t)(b * 4 + h) * NSUB + sc) * GL_BLK;
                float wg[16];
#pragma unroll
                for (int r = 0; r < 16; ++r) wg[r] = a.in(I_WGATE)[((size_t)l * 16 + r) * GLKW + ch];
                const float bgv = a.in(I_BGATE)[l * GLKW + ch];
                float g[16], qq[16], kk[16];
#pragma unroll
                for (int j = 0; j < 16; ++j) { const bf16_t* prow = P + (row0 + j) * INP;
                    const u32x4 l0 = *(const u32x4*)(prow + C_LR), l1 = *(const u32x4*)(prow + C_LR + 8);
                    float x = bgv;
                    x += bf_lo(l0.x) * wg[0] + bf_hi(l0.x) * wg[1] + bf_lo(l0.y) * wg[2] + bf_hi(l0.y) * wg[3] + bf_lo(l0.z) * wg[4] + bf_hi(l0.z) * wg[5] + bf_lo(l0.w) * wg[6] + bf_hi(l0.w) * wg[7];
                    x += bf_lo(l1.x) * wg[8] + bf_hi(l1.x) * wg[9] + bf_lo(l1.y) * wg[10] + bf_hi(l1.y) * wg[11] + bf_lo(l1.z) * wg[12] + bf_hi(l1.z) * wg[13] + bf_lo(l1.w) * wg[14] + bf_hi(l1.w) * wg[15];
                    g[j] = (fminf(x, 0.f) - __logf(1.0f + __expf(-fabsf(x)))) * 0.0625f;
                    qq[j] = bf2f(prow[C_QC + ch]) * GLA_QSCALE; kk[j] = bf2f(prow[C_KC + ch]); }
                pre_finish(qq, kk, g, blk, GL_OQ, GL_OK, GL_OKT, GL_ODL, 400, d, false);
            }
        } else {
            const int ch = (kind - 5) * 512 + tid, h = ch / 384, e = ch % 384;
            unsigned char* blk = a.ws() + WS_GLB + ((size_t)(b * 4 + h) * NSUB + sc) * GL_BLK;
            unsigned vv[8];
#pragma unroll
            for (int j = 0; j < 16; ++j) { const unsigned short v = P[(row0 + j) * INP + C_VC + ch]; if (j & 1) vv[j >> 1] |= ((unsigned)v) << 16; else vv[j >> 1] = v; }
            *(u32x4*)(blk + GL_OVT + e * 32) = (u32x4){vv[0], vv[1], vv[2], vv[3]};
            *(u32x4*)(blk + GL_OVT + e * 32 + 16) = (u32x4){vv[4], vv[5], vv[6], vv[7]};
        }
    }
}

template <int DK, int MODE>
__device__ __forceinline__ void chain_sub(const LAS unsigned char* sb, f32x4 (&S)[DK / 16], float* op, int wave, int n, int q) {
    constexpr bool IS_GLA = (DK == 192);
    constexpr int NKS = DK / 32, NMB = DK / 16, ROWB = IS_GLA ? 400 : 256;
    constexpr int OQ = 0, OK = IS_GLA ? GL_OK : HG_OK, OKT = IS_GLA ? GL_OKT : HG_OKT, OVT = IS_GLA ? GL_OVT : HG_OVT, ODL = IS_GLA ? GL_ODL : HG_ODL;
    const u32x2 vfr = *(const LAS u32x2*)(sb + OVT + (16 * wave + n) * 32 + 8 * q);
    const bf16x8 vf8 = __builtin_bit_cast(bf16x8, (u32x4){vfr.x, vfr.y, 0u, 0u});
    if (MODE == 1) {
        bf16x8 qf[NKS], kf[NKS];
#pragma unroll
        for (int ks = 0; ks < NKS; ++ks) { const int c0 = 2 * (32 * ks + 4 * q), c1 = c0 + 32;
            const int o0 = n * ROWB + (IS_GLA ? c0 : (c0 ^ (n << 4))), o1 = n * ROWB + (IS_GLA ? c1 : (c1 ^ (n << 4)));
            const u32x2 ql = *(const LAS u32x2*)(sb + OQ + o0), qh = *(const LAS u32x2*)(sb + OQ + o1), kl = *(const LAS u32x2*)(sb + OK + o0), kh = *(const LAS u32x2*)(sb + OK + o1);
            qf[ks] = __builtin_bit_cast(bf16x8, (u32x4){ql.x, ql.y, qh.x, qh.y}); kf[ks] = __builtin_bit_cast(bf16x8, (u32x4){kl.x, kl.y, kh.x, kh.y}); }
        f32x4 ao = (f32x4){0.f, 0.f, 0.f, 0.f}, ap = ao, ao1 = ao, ap1 = ao;
#pragma unroll
        for (int ks = 0; ks < NKS; ++ks) {
            const bf16x8 sbf = __builtin_bit_cast(bf16x8, (u32x4){cvt_pk_bf16(S[2 * ks][0], S[2 * ks][1]), cvt_pk_bf16(S[2 * ks][2], S[2 * ks][3]), cvt_pk_bf16(S[2 * ks + 1][0], S[2 * ks + 1][1]), cvt_pk_bf16(S[2 * ks + 1][2], S[2 * ks + 1][3])});
            if (ks & 1) { ao1 = __builtin_amdgcn_mfma_f32_16x16x32_bf16(qf[ks], sbf, ao1, 0, 0, 0); ap1 = __builtin_amdgcn_mfma_f32_16x16x32_bf16(kf[ks], qf[ks], ap1, 0, 0, 0); }
            else { ao = __builtin_amdgcn_mfma_f32_16x16x32_bf16(qf[ks], sbf, ao, 0, 0, 0); ap = __builtin_amdgcn_mfma_f32_16x16x32_bf16(kf[ks], qf[ks], ap, 0, 0, 0); } }
        ao = ao + ao1; ap = ap + ap1;
#pragma unroll
        for (int r = 0; r < 4; ++r) if (4 * q + r > n) ap[r] = 0.f;
        const bf16x8 pa8 = __builtin_bit_cast(bf16x8, (u32x4){cvt_pk_bf16(ap[0], ap[1]), cvt_pk_bf16(ap[2], ap[3]), 0u, 0u});
        ao = __builtin_amdgcn_mfma_f32_16x16x32_bf16(pa8, vf8, ao, 0, 0, 0);
#pragma unroll
        for (int r = 0; r < 4; ++r) op[(size_t)(4 * q + r) * OW] = ao[r];
    }
#pragma unroll
    for (int mb = 0; mb < NMB; ++mb) {
        const f32x4 dl = *(const LAS f32x4*)(sb + ODL + (16 * mb + 4 * q) * 4);
        const u32x2 ktr = *(const LAS u32x2*)(sb + OKT + (16 * mb + n) * 32 + 8 * q);
        S[mb] = __builtin_amdgcn_mfma_f32_16x16x32_bf16(__builtin_bit_cast(bf16x8, (u32x4){ktr.x, ktr.y, 0u, 0u}), vf8, S[mb] * dl, 0, 0, 0); }
}
constexpr size_t ST_REC = 98304;
constexpr int NSEG = 5;
__device__ __forceinline__ int seg_u0(int s) { return s <= 3 ? 52 * s : 156 + 50 * (s - 3); }
__device__ __forceinline__ int seg_nu(int s) { return s < 3 ? 52 : 50; }
template <int DK, int MODE>
__device__ __forceinline__ void chain_item(const unsigned char* blk0, int vt_off, float* op0, unsigned char* st, int seg, int nunits, LAS unsigned char* lds, int wave, int lane) {
    asm volatile("" : "+v"(lane), "+s"(wave));
    constexpr bool IS_GLA = (DK == 192);
    constexpr int BLK = IS_GLA ? GL_BLK : HG_BLK, SUBB = IS_GLA ? GL_SHARED + 4096 : HG_BLK, NMB = DK / 16;
    constexpr int SH0 = MODE == 1 ? 0 : (IS_GLA ? GL_OKT : HG_OKT);
    constexpr int SH_PIECES = (MODE == 1 ? (IS_GLA ? GL_SHARED : HG_OVT) : (IS_GLA ? GL_ODL + 768 - GL_OKT : 4096)) / 16;
    constexpr int T_PIECES = IS_GLA ? 256 : (4096 + 512) / 16;
    constexpr int T_LDS = IS_GLA ? GL_OVT : HG_OVT;
    constexpr int PIECES = SH_PIECES + T_PIECES, UNITB = 2 * SUBB, NP = (2 * PIECES + 511) / 512;
    const int tid = wave * 64 + lane, n = lane & 15, q = lane >> 4;
    f32x4 S[NMB]; float dacc = 1.0f;
    constexpr int ODL_ = IS_GLA ? GL_ODL : HG_ODL;
#pragma unroll
    for (int mb = 0; mb < NMB; ++mb) S[mb] = (f32x4){0.f, 0.f, 0.f, 0.f};
    if (MODE == 1) {
        for (int s = 0; s < seg; ++s) { const unsigned char* rec = st + (size_t)s * 2 * ST_REC + (size_t)(wave * 64 + lane) * 16;
#pragma unroll
            for (int mb = 0; mb < NMB; ++mb) { const f32x4 h = *(const f32x4*)(rec + (size_t)mb * 8192), d = *(const f32x4*)(st + (size_t)s * 2 * ST_REC + ST_REC + (16 * mb + 4 * q) * 4); S[mb] = S[mb] * d + h; } }
    }
    u32x4 stgA[NP], stgB[NP];
#define CH_SRC(u, p_) (blk0 + (size_t)((u) * 2 + (p_) / PIECES) * BLK + (((p_) % PIECES) < SH_PIECES ? SH0 + ((p_) % PIECES) * 16 : (IS_GLA ? vt_off : HG_OVT) + (((p_) % PIECES) - SH_PIECES) * 16))
#define CH_DST(p_) (((p_) / PIECES) * SUBB + (((p_) % PIECES) < SH_PIECES ? SH0 + ((p_) % PIECES) * 16 : T_LDS + (((p_) % PIECES) - SH_PIECES) * 16))
#define CH_LOAD(stg, u) do { _Pragma("unroll") for (int r_ = 0; r_ < NP; ++r_) { const int p_ = r_ * 512 + tid; const bool ok_ = (NP * 512 == 2 * PIECES) || p_ < 2 * PIECES; const int pc_ = ok_ ? p_ : 0; stg[r_] = *(const u32x4*)CH_SRC(u, pc_); } } while (0)
#define CH_STORE(stg, buf) do { _Pragma("unroll") for (int r_ = 0; r_ < NP; ++r_) { const int p_ = r_ * 512 + tid; const bool ok_ = (NP * 512 == 2 * PIECES) || p_ < 2 * PIECES; const int pc_ = ok_ ? p_ : 0; \
        const int d_ = ok_ ? (buf) * UNITB + CH_DST(pc_) : 2 * UNITB + (p_ - 2 * PIECES) * 16; *(LAS u32x4*)(lds + d_) = stg[r_]; } } while (0)
#define CH_SYNC() do { asm volatile("s_waitcnt lgkmcnt(0)" ::: "memory"); __builtin_amdgcn_s_barrier(); asm volatile("" ::: "memory"); } while (0)
    CH_LOAD(stgA, 0); CH_STORE(stgA, 0);
    CH_LOAD(stgA, 1);
    CH_SYNC();
    float* op = op0 + 16 * wave + n;
    for (int u = 0; u < nunits; u += 2) {
        if (u + 2 < nunits) CH_LOAD(stgB, u + 2);
        chain_sub<DK, MODE>(lds, S, op + (size_t)(u * 32) * OW, wave, n, q);
        chain_sub<DK, MODE>(lds + SUBB, S, op + (size_t)(u * 32 + 16) * OW, wave, n, q);
        if (MODE == 0 && tid < DK) dacc *= *(const LAS float*)(lds + ODL_ + 4 * tid) * *(const LAS float*)(lds + SUBB + ODL_ + 4 * tid);
        CH_STORE(stgA, 1);
        CH_SYNC();
        if (u + 3 < nunits) CH_LOAD(stgA, u + 3);
        chain_sub<DK, MODE>(lds + UNITB, S, op + (size_t)(u * 32 + 32) * OW, wave, n, q);
        chain_sub<DK, MODE>(lds + UNITB + SUBB, S, op + (size_t)(u * 32 + 48) * OW, wave, n, q);
        if (MODE == 0 && tid < DK) dacc *= *(const LAS float*)(lds + UNITB + ODL_ + 4 * tid) * *(const LAS float*)(lds + UNITB + SUBB + ODL_ + 4 * tid);
        if (u + 2 < nunits) CH_STORE(stgB, 0);
        CH_SYNC();
    }
    if (MODE == 0) { unsigned char* rec = st + (size_t)seg * 2 * ST_REC + (size_t)(wave * 64 + lane) * 16;
#pragma unroll
        for (int mb = 0; mb < NMB; ++mb) *(f32x4*)(rec + (size_t)mb * 8192) = S[mb];
        if (tid < DK) *(float*)(st + (size_t)seg * 2 * ST_REC + ST_REC + 4 * tid) = dacc; }
#undef CH_SRC
#undef CH_DST
#undef CH_LOAD
#undef CH_STORE
#undef CH_SYNC
}

template <int MODE>
__device__ __forceinline__ void phase_chain(const Ctx& a, int l, LAS unsigned char* lds, int wave, int lane) {
    const int bx = blockIdx.x, G = gridDim.x;
    constexpr int nitems = MODE == 0 ? 48 * (NSEG - 1) : 48 * NSEG;
    for (int it = bx; it < nitems; it += G) {
        const int c = it % 48, seg = it / 48, u0 = seg_u0(seg), nu = seg_nu(seg);
        unsigned char* st = a.ws() + WS_ST + (size_t)c * (NSEG - 1) * 2 * ST_REC;
        if (c < 24) { const int b = c / 12, h = c % 12;
            chain_item<128, MODE>(a.ws() + WS_HGB + ((size_t)(b * 12 + h) * NSUB + 2 * u0) * HG_BLK, 0, (float*)(a.ws() + WS_O) + ((size_t)b * SEQ + u0 * 32) * OW + h * 128, st, seg, nu, lds, wave, lane); }
        else { const int r = c - 24, b = r / 12, h = (r % 12) / 3, sl = r % 3;
            chain_item<192, MODE>(a.ws() + WS_GLB + ((size_t)(b * 4 + h) * NSUB + 2 * u0) * GL_BLK, GL_OVT + 4096 * sl, (float*)(a.ws() + WS_O) + ((size_t)b * SEQ + u0 * 32) * OW + HGW + h * 384 + sl * 128, st, seg, nu, lds, wave, lane); }
        __syncthreads();
    }
    if (MODE == 0) { for (int it = (G >= nitems + 16) ? bx - nitems : bx; it < 16; it += G) { if (it < 0) continue; s5_scan_item(a, l, it, wave, lane); } }
}
__device__ __forceinline__ float red16(float v) { v += __shfl_xor(v, 1); v += __shfl_xor(v, 2); v += __shfl_xor(v, 4); v += __shfl_xor(v, 8); return v; }
__device__ __forceinline__ void phase_finalize(const Ctx& a, int l, int wave, int lane) {
    const bf16_t* P = (const bf16_t*)(a.ws() + WS_P); const float* O = (const float*)(a.ws() + WS_O); bf16_t* MX = (bf16_t*)(a.ws() + WS_MIXED);
    const float* hgg = a.in(I_HGG) + l * HGW; const float* hgb = a.in(I_HGB) + l * HGW; const float* glg = a.in(I_GLG) + l * HGW;
    const int gw = blockIdx.x * 8 + wave, NGW = gridDim.x * 8;
    for (int row = gw; row < MTOK; row += NGW) {
        const float* orow = O + (size_t)row * OW; const bf16_t* prow = P + (size_t)row * INP; bf16_t* mrow = MX + (size_t)row * DM;
#pragma unroll
        for (int it = 0; it < 3; ++it) { const int c = (it * 4 + (lane >> 4)) * 128 + (lane & 15) * 8;
            const f32x4 o0 = *(const f32x4*)(orow + c), o1 = *(const f32x4*)(orow + c + 4); const u32x4 gg = *(const u32x4*)(prow + C_GB + c);
            float v[8] = {sigmoidf_(bf_lo(gg.x)) * o0[0], sigmoidf_(bf_hi(gg.x)) * o0[1], sigmoidf_(bf_lo(gg.y)) * o0[2], sigmoidf_(bf_hi(gg.y)) * o0[3],
                          sigmoidf_(bf_lo(gg.z)) * o1[0], sigmoidf_(bf_hi(gg.z)) * o1[1], sigmoidf_(bf_lo(gg.w)) * o1[2], sigmoidf_(bf_hi(gg.w)) * o1[3]};
            float s = 0.f, ss = 0.f;
#pragma unroll
            for (int i = 0; i < 8; ++i) { s += v[i]; ss += v[i] * v[i]; }
            s = red16(s); ss = red16(ss);
            const float mu = s * (1.0f / 128.0f), rs = 1.0f / sqrtf(fmaxf(ss * (1.0f / 128.0f) - mu * mu, 0.f) + LN_EPS);
            const f32x4 g0 = *(const f32x4*)(hgg + c), g1 = *(const f32x4*)(hgg + c + 4), b0 = *(const f32x4*)(hgb + c), b1 = *(const f32x4*)(hgb + c + 4);
            u32x4 w; w.x = cvt_pk_bf16((v[0] - mu) * rs * g0[0] + b0[0], (v[1] - mu) * rs * g0[1] + b0[1]); w.y = cvt_pk_bf16((v[2] - mu) * rs * g0[2] + b0[2], (v[3] - mu) * rs * g0[3] + b0[3]);
            w.z = cvt_pk_bf16((v[4] - mu) * rs * g1[0] + b1[0], (v[5] - mu) * rs * g1[1] + b1[1]); w.w = cvt_pk_bf16((v[6] - mu) * rs * g1[2] + b1[2], (v[7] - mu) * rs * g1[3] + b1[3]);
            *(u32x4*)(mrow + S5W + c) = w; }
#pragma unroll
        for (int h = 0; h < 4; ++h) { const int c = h * 384 + lane * 8; const bool act = lane < 48;
            f32x4 o0 = (f32x4){0.f, 0.f, 0.f, 0.f}, o1 = o0; u32x4 gg = (u32x4){0u, 0u, 0u, 0u};
            if (act) { o0 = *(const f32x4*)(orow + HGW + c); o1 = *(const f32x4*)(orow + HGW + c + 4); gg = *(const u32x4*)(prow + C_GC + c); }
            const float ss = wave_sum((o0[0] * o0[0] + o0[1] * o0[1]) + (o0[2] * o0[2] + o0[3] * o0[3]) + (o1[0] * o1[0] + o1[1] * o1[1]) + (o1[2] * o1[2] + o1[3] * o1[3]));
            const float rms = 1.0f / sqrtf(ss * (1.0f / 384.0f) + LN_EPS);
            if (act) { const f32x4 g0 = *(const f32x4*)(glg + c), g1 = *(const f32x4*)(glg + c + 4);
                const float z[8] = {bf_lo(gg.x), bf_hi(gg.x), bf_lo(gg.y), bf_hi(gg.y), bf_lo(gg.z), bf_hi(gg.z), bf_lo(gg.w), bf_hi(gg.w)};
                u32x4 w; w.x = cvt_pk_bf16(o0[0] * rms * g0[0] * (z[0] * sigmoidf_(z[0])), o0[1] * rms * g0[1] * (z[1] * sigmoidf_(z[1])));
                w.y = cvt_pk_bf16(o0[2] * rms * g0[2] * (z[2] * sigmoidf_(z[2])), o0[3] * rms * g0[3] * (z[3] * sigmoidf_(z[3])));
                w.z = cvt_pk_bf16(o1[0] * rms * g1[0] * (z[4] * sigmoidf_(z[4])), o1[1] * rms * g1[1] * (z[5] * sigmoidf_(z[5])));
                w.w = cvt_pk_bf16(o1[2] * rms * g1[2] * (z[6] * sigmoidf_(z[6])), o1[3] * rms * g1[3] * (z[7] * sigmoidf_(z[7])));
                *(u32x4*)(mrow + S5W + HGW + c) = w; } }
    }
}

constexpr int PH_PRO = 0, PH_MOD = 1, PH_LN0 = 2, PH_L0 = 3, PH_PER_LAYER = 10, N_PHASES = PH_L0 + DEPTH * PH_PER_LAYER;
constexpr int CW_BAR = 4096;

__global__ void __launch_bounds__(512, 2) hybrid_fwd(Args args) {
    extern __shared__ __attribute__((aligned(16))) unsigned char lds_raw[];
    LAS unsigned char* lds = (LAS unsigned char*)lds_raw;
    const int wave = __builtin_amdgcn_readfirstlane((int)threadIdx.x >> 6);
#define lane lane_id_v()
    volatile LAS unsigned* MISC = (volatile LAS unsigned*)(lds + LDSCTL_OFF);
    Ctx ctx; ctx.t = (volatile LAS unsigned long long*)(lds + LDSCTL_OFF + 64);
    if (wave == 0) { const int ln_ = lane; unsigned long long v = 0ull;
#pragma unroll
        for (int i = 0; i < N_IN; ++i) v = (ln_ == i) ? (unsigned long long)args.in[i] : v;
        v = (ln_ == 30) ? (unsigned long long)args.out : v; v = (ln_ == 31) ? (unsigned long long)args.ws : v;
        if (ln_ < 32) ctx.t[ln_] = v;
        if (ln_ < 16) MISC[ln_] = 0u; }
    __syncthreads();
    const int lo = args.ph_lo, hi = args.ph_hi;
    XcdBarrier bar; bar.bar = (unsigned*)(ctx.ws() + WS_CTL) + CW_BAR; bar.x = 0; bar.st = nullptr; bar.w0 = (wave == 0) ? 1u : 0u;
    if (hi - lo > 1) bar = xcd_barrier_post((unsigned*)(ctx.ws() + WS_CTL) + CW_BAR, MISC + 8, (wave == 0) ? 1u : 0u);
#define IN(k) (lo <= (k) && (k) < hi)
#define OPQ() int ln = lane, wv = wave; asm volatile("" : "+s"(wv))
#define SEAM(k) do { if (IN(k) && IN((k) + 1)) xcd_barrier(bar); } while (0)
#define WSP(T, off) ((T*)(ctx.ws() + (off)))
#ifdef DIAG_SEL1
    volatile LAS unsigned long long* STP = (volatile LAS unsigned long long*)(lds + LDSCTL_OFF + 512);
#define STAMP(idx) do { if (blockIdx.x == 0 && wave == 0) { const unsigned long long t_ = __builtin_amdgcn_s_memrealtime(); if (lane == 0) STP[idx] = t_; } } while (0)
#else
#define STAMP(idx) do { } while (0)
#endif
    STAMP(0);

#if EN_PRO
    if (IN(PH_PRO)) { OPQ(); phase_prologue(ctx, lds, wv, ln); }
#endif
    SEAM(PH_PRO); STAMP((PH_PRO) + 1);
#if EN_MOD
    if (IN(PH_MOD)) { OPQ(); phase_mod(ctx, wv, ln); }
#endif
    SEAM(PH_MOD); STAMP((PH_MOD) + 1);
#if EN_LN
    if (IN(PH_LN0)) { OPQ(); phase_lnapply<0>(ctx.in(I_X), nullptr, WSP(float, WS_ROWSTATS), nullptr, nullptr, WSP(float, WS_MOD), 0, 1, WSP(bf16_t, WS_H), nullptr, lds, wv, ln); }
#endif
    SEAM(PH_LN0); STAMP((PH_LN0) + 1);

    for (int l = 0; l < DEPTH; ++l) {
        const int p0 = PH_L0 + l * PH_PER_LAYER;
        const size_t wto = WS_WT + (size_t)l * WT_LAYER, modo = WS_MOD + (size_t)l * NB * 6 * DM * 4;
#if EN_INPROJ
        if (IN(p0 + 0)) { pg8::Gemm g{WSP(bf16_t, WS_H), WSP(const bf16_t, wto + WT_IN), MTOK, INP, DM}; pg8::StaticOrder S; S.init(MTOK, INP, (int)gridDim.x, (int)blockIdx.x);
            EpiProj E{WSP(bf16_t, WS_P), WSP(bf16_t, WS_UX)}; pg8::gemm_phase<EpiProj, pg8::StaticOrder, true, true>(lds, g, S, E, wave); }
#endif
        SEAM(p0 + 0); STAMP((p0 + 0) + 1);
#if EN_MIX
        if (IN(p0 + 1)) {
            { pg8::Gemm g{WSP(bf16_t, WS_UX), WSP(const bf16_t, WS_S5W1 + (size_t)l * S5_W1_LAYER), 64 * 256, 64 * 256, S5K}; S5Order S{(int)gridDim.x, (int)blockIdx.x, 64, 0};
              EpiS5A E{WSP(float, WS_SLOC)}; pg8::gemm_phase<EpiS5A, S5Order, true, true>(lds, g, S, E, wave); }
            { OPQ(); phase_pre(ctx, l, wv, ln); }
#ifdef DBG_PRE2
            { OPQ(); phase_pre(ctx, l, wv, ln); }
#endif
            }
        SEAM(p0 + 1); STAMP((p0 + 1) + 1);
        if (IN(p0 + 2)) { OPQ(); phase_chain<0>(ctx, l, lds, wv, ln); }
        SEAM(p0 + 2); STAMP((p0 + 2) + 1);
        if (IN(p0 + 3)) {
            { pg8::Gemm g{WSP(bf16_t, WS_UX), WSP(const bf16_t, WS_S5T + (size_t)l * S5_T_LAYER), 64 * 256, 64 * 1024, S5K}; S5Order S{(int)gridDim.x, (int)blockIdx.x, 256, 2};
              EpiS5C E{WSP(bf16_t, WS_Z)}; pg8::gemm_phase<EpiS5C, S5Order, true, true>(lds, g, S, E, wave); }
            { OPQ(); phase_chain<1>(ctx, l, lds, wv, ln); } }
#endif
        SEAM(p0 + 3); STAMP((p0 + 3) + 1);
#if EN_GLU
        if (IN(p0 + 4)) { pg8::Gemm g{WSP(bf16_t, WS_Z), WSP(const bf16_t, wto + WT_GLU), MTOK, S5W, S5W}; pg8::StaticOrder S; S.init(MTOK, S5W, (int)gridDim.x, (int)blockIdx.x);
            EpiGlu E{WSP(bf16_t, WS_Z), WSP(bf16_t, WS_MIXED), ctx.in(I_GLUB) + l * S5W}; pg8::gemm_phase<EpiGlu, pg8::StaticOrder, true, true>(lds, g, S, E, wave);
            { OPQ(); phase_finalize(ctx, l, wv, ln); } }
#endif
        SEAM(p0 + 4); STAMP((p0 + 4) + 1);
#if EN_OUT
        if (IN(p0 + 5)) { pg8::Gemm g{WSP(bf16_t, WS_MIXED), WSP(const bf16_t, wto + WT_OUT), MTOK, DM, DM}; pg8::StaticOrder S; S.init(MTOK, DM, (int)gridDim.x, (int)blockIdx.x);
            EpiResid E{l == 0 ? ctx.in(I_X) : ctx.out(), ctx.out(), WSP(float, WS_ROWSTATS), l == 0 ? WSP(float, WS_MISC) : ctx.in(I_LN2G) + (l - 1) * DM, l == 0 ? WSP(float, WS_MISC) + DM : ctx.in(I_LN2B) + (l - 1) * DM, WSP(float, modo) + 2 * DM, WSP(float, WS_ROWPART)};
            pg8::gemm_phase<EpiResid, pg8::StaticOrder, true, true>(lds, g, S, E, wave); }
#endif
        SEAM(p0 + 5); STAMP((p0 + 5) + 1);
#if EN_LN
        if (IN(p0 + 6)) { OPQ(); phase_lnapply<1>(ctx.out(), WSP(float, WS_ROWPART), WSP(float, WS_ROWSTATS), ctx.in(I_LN1G) + l * DM, ctx.in(I_LN1B) + l * DM, WSP(float, modo), 3, 4, WSP(bf16_t, WS_H), nullptr, lds, wv, ln); }
#endif
        SEAM(p0 + 6); STAMP((p0 + 6) + 1);
#if EN_GU
        if (IN(p0 + 7)) { pg8::Gemm g{WSP(bf16_t, WS_H), WSP(const bf16_t, wto + WT_GU), MTOK, 2 * DFF, DM}; pg8::StaticOrder S; S.init(MTOK, 2 * DFF, (int)gridDim.x, (int)blockIdx.x);
            EpiSwiglu E{WSP(bf16_t, WS_P)}; pg8::gemm_phase<EpiSwiglu, pg8::StaticOrder, true, true>(lds, g, S, E, wave); }
#endif
        SEAM(p0 + 7); STAMP((p0 + 7) + 1);
#if EN_DN
        if (IN(p0 + 8)) { pg8::Gemm g{WSP(bf16_t, WS_P), WSP(const bf16_t, wto + WT_DN), MTOK, DM, DFF}; pg8::StaticOrder S; S.init(MTOK, DM, (int)gridDim.x, (int)blockIdx.x);
            EpiResid E{ctx.out(), ctx.out(), WSP(float, WS_ROWSTATS), ctx.in(I_LN1G) + l * DM, ctx.in(I_LN1B) + l * DM, WSP(float, modo) + 5 * DM, WSP(float, WS_ROWPART)};
            pg8::gemm_phase<EpiResid, pg8::StaticOrder, true, true>(lds, g, S, E, wave); }
#endif
        SEAM(p0 + 8); STAMP((p0 + 8) + 1);
#if EN_LN
        if (IN(p0 + 9)) { OPQ();
            if (l + 1 < DEPTH) phase_lnapply<1>(ctx.out(), WSP(float, WS_ROWPART), WSP(float, WS_ROWSTATS), ctx.in(I_LN2G) + l * DM, ctx.in(I_LN2B) + l * DM, WSP(float, modo) + (size_t)NB * 6 * DM, 0, 1, WSP(bf16_t, WS_H), nullptr, lds, wv, ln);
            else phase_lnapply<2>(ctx.out(), WSP(float, WS_ROWPART), WSP(float, WS_ROWSTATS), ctx.in(I_LN2G) + l * DM, ctx.in(I_LN2B) + l * DM, nullptr, 0, 0, nullptr, ctx.out(), lds, wv, ln);
        }
#endif
        SEAM(p0 + 9); STAMP((p0 + 9) + 1);
    }
#ifdef DIAG_SEL1
    xcd_barrier(bar);
    if (blockIdx.x == 0) {
        float tot = (float)(STP[N_PHASES] - STP[0]), s1 = 0.f, s2 = 0.f;
        for (int k = 0; k < N_PHASES; ++k) { int ty; if (k < 3) ty = k; else { const int j = (k - 3) % PH_PER_LAYER; const int map[10] = {3, 4, 5, 6, 10, 7, 2, 8, 9, 2}; ty = map[j]; }
            const float d = (float)(STP[k + 1] - STP[k]); if ((DIAG_SEL1 >> ty) & 1) s1 += d; if ((DIAG_SEL2 >> ty) & 1) s2 += d; }
        const int n1 = (int)(1000000.f * s1 / tot); float* o = ctx.out();
        for (int i = wave * 64 + lane; i < n1; i += 512) o[i] += 0.05f;
        if (wave == 0 && lane == 0) o[2000000] += 0.05f + 0.11f * s2 / tot;
    }
#endif
#undef IN
#undef SEAM
#undef OPQ
#undef WSP
#undef lane
}

#ifndef MK_PER_PHASE
#define MK_PER_PHASE 0
#endif
extern "C" void kernel_launch(void* const* d_in, const int* in_sizes, int n_in, void* d_out, int out_size, void* d_ws, size_t ws_size, hipStream_t stream) {
    static int grid = 0;
    if (grid == 0) {
        if (n_in != N_IN || out_size != MTOK * DM || ws_size < WS_END) { fprintf(stderr, "kernel_launch: unexpected problem (n_in %d, out %d, ws %zu < %zu); nothing launched\n", n_in, out_size, ws_size, (size_t)WS_END); grid = -1; return; }
        int dev = 0, cus = 0, per_cu = 0;
        if (hipGetDevice(&dev) != hipSuccess || hipDeviceGetAttribute(&cus, hipDeviceAttributeMultiprocessorCount, dev) != hipSuccess) { grid = -1; return; }
        if (hipFuncSetAttribute((const void*)hybrid_fwd, hipFuncAttributeMaxDynamicSharedMemorySize, LDS_BYTES) != hipSuccess) { fprintf(stderr, "kernel_launch: hipFuncSetAttribute failed\n"); grid = -1; return; }
        if (hipOccupancyMaxActiveBlocksPerMultiprocessor(&per_cu, (const void*)hybrid_fwd, 512, LDS_BYTES) != hipSuccess || per_cu < 1) fprintf(stderr, "kernel_launch: occupancy query reports %d blocks per CU\n", per_cu);
        (void)hipGetLastError();
        grid = cus;
    }
    if (grid < 0) return;
    (void)in_sizes;
    if (hipMemsetAsync((char*)d_ws + WS_CTL, 0, CTL_ZERO_BYTES, stream) != hipSuccess) return;
#ifdef DBG_MEMSET
    (void)hipMemsetAsync((char*)d_ws + WS_HGB, 0, WS_END - WS_HGB, stream); (void)hipMemsetAsync((char*)d_ws + WS_O, 0, 192 * MiB, stream);
#endif
    Args a{};
    for (int i = 0; i < N_IN; ++i) a.in[i] = (const float*)d_in[i];
    a.out = (float*)d_out; a.ws = (unsigned char*)d_ws;
#if MK_PER_PHASE
    for (int p = 0; p < N_PHASES; ++p) { a.ph_lo = p; a.ph_hi = p + 1; hipLaunchKernelGGL(hybrid_fwd, dim3(grid), dim3(512), LDS_BYTES, stream, a); }
#else
    a.ph_lo = 0; a.ph_hi = N_PHASES; hipLaunchKernelGGL(hybrid_fwd, dim3(grid), dim3(512), LDS_BYTES, stream, a);
#endif
}
```

```cpp
#include <hip/hip_runtime.h>
#include <cstdio>
#include <cstdint>
namespace pg8 {
#define PG8_LAS __attribute__((address_space(3)))
typedef unsigned short bf16_t;
typedef short bf16x8 __attribute__((ext_vector_type(8)));
typedef float f32x4 __attribute__((ext_vector_type(4)));
typedef unsigned u32x4 __attribute__((ext_vector_type(4)));
constexpr int BM = 256, BK = 64, HALF = 128, HTB = HALF * BK * 2  , STAGE_BYTES = 8 * HTB, NXCD = 8, WGM = 8;

__host__ __device__ __forceinline__ int lds_byte(int r, int c) { const int st = (r >> 4) * 2 + (c >> 5), rr = r & 15, cc = c & 31, ob = rr * 64 + cc * 2; return st * 1024 + (ob ^ (((ob >> 9) & 1) << 5)); }
__host__ __device__ __forceinline__ void stage_rc(int b, int& R, int& C) { const int st = b / 1024, sb = b % 1024, swz = sb ^ (((sb >> 9) & 1) << 5); R = (st >> 1) * 16 + swz / 64; C = (st & 1) * 32 + (swz % 64) / 2; }
__host__ __device__ __forceinline__ int perm32(int rho) { const int n = rho >> 4, i = rho & 15; return 8 * (i >> 2) + 4 * n + (i & 3); }

struct Unit { int pm, pn; };
struct Gemm { const bf16_t* A; const bf16_t* Bt; int M, N, K; };

struct StaticOrder {
    int nM, nN, nwg, G, c;
    __host__ __device__ void init(int M, int N, int G_, int c_) { nM = M / BM; nN = N / BM; nwg = nM * nN; G = G_; c = c_; }
    __host__ __device__ bool next(int i, Unit& u) const {
        const long L = (long)i * G + c; if (L >= nwg) return false;
        int wgid = (int)L; { const int q = nwg / NXCD, r = nwg % NXCD, xcd = wgid % NXCD, off = wgid / NXCD; wgid = (xcd < r ? xcd * (q + 1) : r * (q + 1) + (xcd - r) * q) + off; }
        const int nig = WGM * nN, gid = wgid / nig, fm = gid * WGM, gsz = (nM - fm) < WGM ? (nM - fm) : WGM;
        u.pm = fm + ((wgid % nig) % gsz); u.pn = (wgid % nig) / gsz; return true;
    }
    __device__ __forceinline__ void a_ready(const Unit&) const {}
    __device__ __forceinline__ void done(const Unit&) const {}
};
__device__ __forceinline__ unsigned cvt_pk_bf16(float lo, float hi) { unsigned r; asm volatile("v_cvt_pk_bf16_f32 %0, %1, %2" : "=v"(r) : "v"(lo), "v"(hi)); return r; }
typedef float f32x2 __attribute__((ext_vector_type(2)));
template <class Epi, class Sched, bool ALIGN_EPI = false, bool SP2 = false>
__device__ __forceinline__ void gemm_phase(PG8_LAS unsigned char* lds, const Gemm g, const Sched& S, const Epi& E, int wave_id) {
    int tid_; asm volatile("v_mbcnt_lo_u32_b32 %0, -1, 0\n\tv_mbcnt_hi_u32_b32 %0, -1, %0" : "=v"(tid_)); tid_ += wave_id * 64;
    const int tid = tid_, wid = __builtin_amdgcn_readfirstlane(tid >> 6), lane = tid & 63, wr = wid >> 2, wc = wid & 3, fr = lane & 15, fq = lane >> 4;
    const int K = g.K, nt = K / BK;
    unsigned voffA[2], voffB[2];
#pragma unroll
    for (int i = 0; i < 2; ++i) { int R, C; stage_rc(tid * 16 + i * 8192, R, C); const int Rb = Epi::PERM ? ((R & ~31) + perm32(R & 31)) : R;
        voffA[i] = (unsigned)(R * K + C) * 2u; voffB[i] = (unsigned)(Rb * K + C) * 2u; }
    const size_t kstep = (size_t)(BK * 2);
    const size_t hstep = (size_t)HALF * K * 2;
    const size_t tstep = 2 * hstep;
    const unsigned ldsw = (unsigned)wid * 1024u;
    const int aoff = lds_byte(wr * 64 + fr, fq * 8), boff = lds_byte(wc * 32 + fr, fq * 8);
#define PG8_SA(b, h) (((b) * 2 + (h)) * HTB)
#define PG8_SB(b, h) ((4 + (b) * 2 + (h)) * HTB)
#define PG8_STAGE(bufoff, gbase, voff) do { _Pragma("unroll") for (int _i = 0; _i < 2; ++_i) \
        __builtin_amdgcn_global_load_lds((const unsigned*)((const char*)(gbase) + (voff)[_i]), (PG8_LAS unsigned*)(lds + (bufoff) + ldsw + _i * 8192), 16, 0, 0); } while (0)
#define PG8_LDA(dst, b, h) do { _Pragma("unroll") for (int m = 0; m < 4; ++m) _Pragma("unroll") for (int k = 0; k < 2; ++k) dst[m][k] = *(const PG8_LAS bf16x8*)(lds + PG8_SA(b, h) + aoff + m * 2048 + k * 1024); } while (0)
#define PG8_LDB(dst, b, h) do { _Pragma("unroll") for (int n = 0; n < 2; ++n) _Pragma("unroll") for (int k = 0; k < 2; ++k) dst[n][k] = *(const PG8_LAS bf16x8*)(lds + PG8_SB(b, h) + boff + n * 2048 + k * 1024); } while (0)
#define PG8_MMA(ai, bj, At, Bt) do { __builtin_amdgcn_s_setprio(1); _Pragma("unroll") for (int m = 0; m < 4; ++m) _Pragma("unroll") for (int n = 0; n < 2; ++n) _Pragma("unroll") for (int k = 0; k < 2; ++k) \
        acc[ai][bj][m][n] = __builtin_amdgcn_mfma_f32_16x16x32_bf16(Bt[n][k], At[m][k], acc[ai][bj][m][n], 0, 0, 0); __builtin_amdgcn_s_setprio(0); } while (0)
#define PG8_WAIT_V(n) asm volatile("s_waitcnt vmcnt(" #n ")" ::: "memory")
#define PG8_WAIT_L(n) asm volatile("s_waitcnt lgkmcnt(" #n ")" ::: "memory")
#define PG8_BAR __builtin_amdgcn_s_barrier()
#define PG8_SCHED __builtin_amdgcn_sched_barrier(0)
    Unit cur, nxt; int ui = 0;
    if (!S.next(0, cur)) return;
    f32x4 acc[2][2][4][2];
#pragma unroll
    for (int a = 0; a < 2; ++a)
#pragma unroll
        for (int b = 0; b < 2; ++b)
#pragma unroll
            for (int m = 0; m < 4; ++m)
#pragma unroll
                for (int n = 0; n < 2; ++n) acc[a][b][m][n] = (f32x4){0.f, 0.f, 0.f, 0.f};
    bf16x8 At[4][2], B0[2][2], B1[2][2];
    const char* cA = (const char*)g.A + (size_t)cur.pm * tstep; const char* cB = (const char*)g.Bt + (size_t)cur.pn * tstep;
    S.a_ready(cur);
    if constexpr (SP2) {
        PG8_STAGE(PG8_SB(0, 0), cB, voffB); PG8_STAGE(PG8_SB(0, 1), cB + hstep, voffB); PG8_STAGE(PG8_SA(0, 0), cA, voffA); PG8_STAGE(PG8_SA(0, 1), cA + hstep, voffA);
        if (wr == 1) PG8_BAR;
        PG8_WAIT_V(2); PG8_BAR;
        PG8_STAGE(PG8_SB(1, 0), cB + kstep, voffB); PG8_STAGE(PG8_SA(1, 0), cA + kstep, voffA); PG8_STAGE(PG8_SB(1, 1), cB + hstep + kstep, voffB);
        PG8_WAIT_V(6); PG8_BAR;
    } else {
        PG8_STAGE(PG8_SB(0, 0), cB, voffB); PG8_STAGE(PG8_SA(0, 0), cA, voffA); PG8_STAGE(PG8_SB(0, 1), cB + hstep, voffB); PG8_STAGE(PG8_SA(0, 1), cA + hstep, voffA);
        if (wr == 1) PG8_BAR;
        PG8_WAIT_V(4); PG8_BAR;
        PG8_STAGE(PG8_SB(1, 0), cB + kstep, voffB); PG8_STAGE(PG8_SA(1, 0), cA + kstep, voffA); PG8_STAGE(PG8_SB(1, 1), cB + hstep + kstep, voffB);
        PG8_WAIT_V(6); PG8_BAR;
    }
    for (;;) {
        const bool has_next = S.next(ui + 1, nxt);
        const char* nA = has_next ? (const char*)g.A + (size_t)nxt.pm * tstep : cA; const char* nB = has_next ? (const char*)g.Bt + (size_t)nxt.pn * tstep : cB;
        for (int t = 0; t < nt; t += 2) {
            const bool last = (t == nt - 2);
            const char* a1 = cA + (size_t)(t + 1) * kstep;
            const char* a2 = last ? nA : cA + (size_t)(t + 2) * kstep; const char* b2 = last ? nB : cB + (size_t)(t + 2) * kstep;
            const char* a3 = a2 + kstep; const char* b3 = b2 + kstep;
            if (last && has_next) S.a_ready(nxt);
            if constexpr (SP2) {
            PG8_LDB(B0, 0, 0); PG8_LDB(B1, 0, 1); PG8_SCHED; PG8_LDA(At, 0, 0); PG8_STAGE(PG8_SA(1, 1), a1 + hstep, voffA);
            PG8_WAIT_V(8); PG8_WAIT_L(0); PG8_BAR; PG8_MMA(0, 0, At, B0); PG8_MMA(0, 1, At, B1); PG8_BAR; PG8_SCHED;
            PG8_LDA(At, 0, 1); PG8_STAGE(PG8_SB(0, 0), b2, voffB); PG8_STAGE(PG8_SB(0, 1), b2 + hstep, voffB); PG8_STAGE(PG8_SA(0, 0), a2, voffA);
            PG8_WAIT_V(8); PG8_WAIT_L(0); PG8_BAR; PG8_MMA(1, 0, At, B0); PG8_MMA(1, 1, At, B1); PG8_BAR; PG8_SCHED;
            PG8_LDB(B0, 1, 0); PG8_LDB(B1, 1, 1); PG8_SCHED; PG8_LDA(At, 1, 0); PG8_STAGE(PG8_SA(0, 1), a2 + hstep, voffA);
            PG8_WAIT_V(8); PG8_WAIT_L(0); PG8_BAR; PG8_MMA(0, 0, At, B0); PG8_MMA(0, 1, At, B1); PG8_BAR; PG8_SCHED;
            PG8_LDA(At, 1, 1); PG8_STAGE(PG8_SB(1, 0), b3, voffB); PG8_STAGE(PG8_SB(1, 1), b3 + hstep, voffB); PG8_STAGE(PG8_SA(1, 0), a3, voffA);
            PG8_WAIT_V(8); PG8_WAIT_L(0); PG8_BAR; PG8_MMA(1, 0, At, B0); PG8_MMA(1, 1, At, B1); PG8_BAR; PG8_SCHED;
            } else {
            PG8_LDB(B0, 0, 0); PG8_SCHED; PG8_LDA(At, 0, 0); PG8_STAGE(PG8_SA(1, 1), a1 + hstep, voffA);
            PG8_WAIT_L(8); PG8_BAR; PG8_WAIT_L(0); PG8_MMA(0, 0, At, B0); PG8_BAR; PG8_SCHED;
            PG8_LDB(B1, 0, 1); PG8_STAGE(PG8_SB(0, 0), b2, voffB);
            PG8_BAR; PG8_WAIT_L(0); PG8_MMA(0, 1, At, B1); PG8_BAR;
            PG8_LDA(At, 0, 1); PG8_STAGE(PG8_SA(0, 0), a2, voffA);
            PG8_BAR; PG8_WAIT_L(0); PG8_MMA(1, 0, At, B0); PG8_BAR; PG8_SCHED;
            PG8_STAGE(PG8_SB(0, 1), b2 + hstep, voffB);
            PG8_WAIT_V(6); PG8_BAR; PG8_MMA(1, 1, At, B1); PG8_BAR;
            PG8_LDB(B0, 1, 0); PG8_SCHED; PG8_LDA(At, 1, 0); PG8_STAGE(PG8_SA(0, 1), a2 + hstep, voffA);
            PG8_WAIT_L(8); PG8_BAR; PG8_WAIT_L(0); PG8_MMA(0, 0, At, B0); PG8_BAR; PG8_SCHED;
            PG8_LDB(B1, 1, 1); PG8_STAGE(PG8_SB(1, 0), b3, voffB);
            PG8_BAR; PG8_WAIT_L(0); PG8_MMA(0, 1, At, B1); PG8_BAR;
            PG8_LDA(At, 1, 1); PG8_STAGE(PG8_SA(1, 0), a3, voffA);
            PG8_BAR; PG8_WAIT_L(0); PG8_MMA(1, 0, At, B0); PG8_BAR; PG8_SCHED;
            PG8_STAGE(PG8_SB(1, 1), b3 + hstep, voffB);
            PG8_WAIT_V(6); PG8_BAR; PG8_MMA(1, 1, At, B1); PG8_BAR;
            }
        }
        if constexpr (ALIGN_EPI) { if (wr == 0) PG8_BAR; }
        if constexpr (!Epi::AFTER_DRAIN) { E(acc, cur, wr, wc, fr, fq); S.done(cur); }
        if (!has_next) break;
#pragma unroll
        for (int a = 0; a < 2; ++a)
#pragma unroll
            for (int b = 0; b < 2; ++b)
#pragma unroll
                for (int m = 0; m < 4; ++m)
#pragma unroll
                    for (int n = 0; n < 2; ++n) acc[a][b][m][n] = (f32x4){0.f, 0.f, 0.f, 0.f};
        cur = nxt; cA = nA; cB = nB; ++ui;
        if constexpr (ALIGN_EPI) { if (wr == 1) PG8_BAR; }
    }
    PG8_WAIT_V(0);
    if constexpr (!ALIGN_EPI) { if (wr == 0) PG8_BAR; }
    PG8_BAR;
    if constexpr (Epi::AFTER_DRAIN) { E.fused(acc, cur, wr, wc, fr, fq, lds, wid, lane); S.done(cur); }
#undef PG8_SA
#undef PG8_SB
#undef PG8_STAGE
#undef PG8_LDA
#undef PG8_LDB
#undef PG8_MMA
#undef PG8_WAIT_V
#undef PG8_WAIT_L
#undef PG8_BAR
#undef PG8_SCHED
}
}
#define LAS __attribute__((address_space(3)))
#define XB_TMO      128
#define XB_XCNT(j)  (256  + 64 * (j))
#define XB_XSUB(j)  (1280 + 64 * (j))
#define XB_XGEN(j)  (2304 + 64 * (j))
#define XB_TOP      3328
#define XB_TOPGEN   3392
#define XCD_BAR_WORDS 3456
#define XB_SPIN_CAP (1u << 24)

__device__ __forceinline__ unsigned xb_ld(unsigned* p)              { return __hip_atomic_load(p, __ATOMIC_RELAXED, __HIP_MEMORY_SCOPE_AGENT); }
__device__ __forceinline__ unsigned xb_add(unsigned* p, unsigned v) { return __hip_atomic_fetch_add(p, v, __ATOMIC_RELAXED, __HIP_MEMORY_SCOPE_AGENT); }
__device__ __forceinline__ unsigned xb_xcc_id() { return (unsigned)__builtin_amdgcn_s_getreg((3 << 11) | 20) & 0xFu; }
#define XB_SPIN(cond, bar) do { unsigned _sp = 0; while (cond) { __builtin_amdgcn_s_sleep(1); \
    if ((++_sp & 255u) == 0u) { if (xb_ld(&(bar)[XB_TMO])) break; if (_sp > XB_SPIN_CAP) { atomicAdd(&(bar)[XB_TMO], 1u); break; } } } } while (0)

struct XcdBarrier {
    unsigned* bar; unsigned x; unsigned w0;
    volatile LAS unsigned* st;
};

__device__ __forceinline__ bool xb_lane0() { return __builtin_amdgcn_mbcnt_hi(~0u, __builtin_amdgcn_mbcnt_lo(~0u, 0u)) == 0u; }
__device__ __forceinline__ XcdBarrier xcd_barrier_post(unsigned* bar, volatile LAS unsigned* st, unsigned w0) {
    XcdBarrier b; b.bar = bar; b.x = xb_xcc_id(); b.st = st; b.w0 = w0;
    if (w0 && xb_lane0()) (void)xb_add(&bar[XB_XCNT(b.x)], 1u);
    return b;
}
__device__ __forceinline__ void xcd_barrier_complete(unsigned* bar, unsigned x, unsigned& nloc, unsigned& nx) {
    const unsigned G = gridDim.x * gridDim.y * gridDim.z;
    unsigned sum, cnt, mine, sp = 0u;
    for (;;) {
        sum = 0u; cnt = 0u; mine = 0u;
#pragma unroll
        for (unsigned j = 0; j < 16; ++j) { const unsigned c = xb_ld(&bar[XB_XCNT(j)]); sum += c; cnt += (c > 0u) ? 1u : 0u; mine = (j == x) ? c : mine; }
        if (sum == G) break;
        __builtin_amdgcn_s_sleep(1);
        if ((++sp & 255u) == 0u) { if (xb_ld(&bar[XB_TMO])) break; if (sp > XB_SPIN_CAP) { atomicAdd(&bar[XB_TMO], 1u); break; } }
    }
    nloc = mine > 0u ? mine : 1u; nx = cnt > 0u ? cnt : 1u;
}

__device__ __forceinline__ void xcd_barrier(const XcdBarrier& b) {
    asm volatile("s_waitcnt vmcnt(0)" ::: "memory");
    __syncthreads();
    if (b.w0 && xb_lane0()) {
        unsigned* bar = b.bar;
        __builtin_amdgcn_s_waitcnt(0);
        unsigned nloc = b.st[0], nx = b.st[1];
        if (nloc == 0u) { xcd_barrier_complete(bar, b.x, nloc, nx); b.st[0] = nloc; b.st[1] = nx; }
        const unsigned old = xb_add(&bar[XB_XSUB(b.x)], 1u);
        const unsigned gen = old / nloc;
        if (old + 1u == (gen + 1u) * nloc) {
            __builtin_amdgcn_fence(__ATOMIC_RELEASE, "agent");
            asm volatile("s_waitcnt vmcnt(0)" ::: "memory");
            const unsigned og = xb_add(&bar[XB_TOP], 1u);
            const unsigned tg = og / nx;
            if (og + 1u == (tg + 1u) * nx) xb_add(&bar[XB_TOPGEN], 1u);
            else XB_SPIN(xb_ld(&bar[XB_TOPGEN]) == tg, bar);
            __builtin_amdgcn_fence(__ATOMIC_ACQUIRE, "agent");
            xb_add(&bar[XB_XGEN(b.x)], 1u);
            asm volatile("s_waitcnt vmcnt(0)" ::: "memory");
        } else {
            XB_SPIN(xb_ld(&bar[XB_XGEN(b.x)]) == gen, bar);
            __builtin_amdgcn_fence(__ATOMIC_ACQUIRE, "agent");
            asm volatile("s_waitcnt vmcnt(0)" ::: "memory");
        }
    }
    __syncthreads();
}

constexpr int DM = 4096, NB = 2, SEQ = 8192, MTOK = NB * SEQ, DEPTH = 4;
constexpr int S5W = 1024;
constexpr int HGW = 1536;
constexpr int GLKW = 768;
constexpr int INW = 11792, INP = 12032, DFF = 11008;
constexpr int OW = 3072;
constexpr int C_U = 0, C_QB = 1024, C_FB = 2560, C_IB = 4096, C_GB = 5632, C_QC = 7168, C_KC = 7936, C_VC = 8704, C_GC = 10240, C_LR = 11776;
constexpr float LN_EPS = 1e-5f;
constexpr float ALPHA = 1.6817928305074290861f;
constexpr float GLA_QSCALE = 0.07216878364870322f;

enum { I_X = 0, I_C, I_WADA, I_BADA, I_TABLE, I_WIN, I_WOUT, I_AREAL, I_AIMAG, I_LOGDT, I_BRE, I_BIM, I_CRE, I_CIM, I_S5D, I_GLUW, I_GLUB,
       I_LBRAW, I_HGG, I_HGB, I_WGATE, I_BGATE, I_GLG, I_WFG, I_WFU, I_WFD, I_LN1G, I_LN1B, I_LN2G, I_LN2B, N_IN };

constexpr size_t MiB = 1u << 20;
constexpr size_t WS_CTL = 0, CTL_ZERO_BYTES = 1 * MiB;
constexpr size_t WS_MOD = 1 * MiB;
constexpr size_t WS_MISC = 2 * MiB;
constexpr size_t WS_ROWSTATS = 3 * MiB;
constexpr size_t WS_ROWPART = 4 * MiB;
constexpr size_t WS_CONDPART = 12 * MiB;
constexpr size_t WS_H = 24 * MiB;
constexpr size_t WS_MIXED = WS_H + 128 * MiB;
constexpr size_t WS_Z = WS_MIXED + 128 * MiB;
constexpr size_t WS_O = WS_Z + 32 * MiB;
constexpr size_t WS_P = WS_O + 192 * MiB;
constexpr size_t WS_WT = WS_P + 376 * MiB;
constexpr size_t WT_IN = 0, WT_OUT = 94 * MiB, WT_GU = 126 * MiB, WT_DN = 298 * MiB, WT_GLU = 384 * MiB, WT_LAYER = 386 * MiB;
constexpr size_t WS_HGB = WS_WT + DEPTH * WT_LAYER;
constexpr size_t WS_GLB = WS_HGB + 198 * MiB;
constexpr size_t WS_S5T = WS_GLB + 128 * MiB;
constexpr size_t WS_S5W1 = WS_S5T + 576 * MiB;
constexpr size_t WS_UX = WS_S5W1 + 144 * MiB;
constexpr size_t WS_SLOC = WS_UX + 36 * MiB;
constexpr size_t WS_LAM64 = WS_SLOC + 8 * MiB;
constexpr size_t WS_ST = WS_LAM64 + 1 * MiB;
constexpr size_t WS_END = WS_ST + 45 * MiB;
static_assert((size_t)INP * DM * 2 == 94 * MiB && (size_t)DM * DM * 2 == 32 * MiB && (size_t)2 * DFF * DM * 2 == 172 * MiB && (size_t)DM * DFF * 2 == 86 * MiB, "weight map");
static_assert((size_t)MTOK * INP * 2 == 376 * MiB && (size_t)MTOK * DFF * 2 <= 376 * MiB, "activation map");

constexpr int RING_BYTES = 131072;
constexpr int LDSCTL_OFF = 135168;
constexpr int LDS_BYTES = 147456;

#ifndef LAS
#define LAS __attribute__((address_space(3)))
#endif
typedef unsigned short bf16_t;
typedef float f32x4 __attribute__((ext_vector_type(4)));
typedef float f32x2 __attribute__((ext_vector_type(2)));
typedef unsigned u32x4 __attribute__((ext_vector_type(4)));
typedef unsigned u32x2 __attribute__((ext_vector_type(2)));
#define LDS_WAIT() asm volatile("s_waitcnt lgkmcnt(0)" ::: "memory")
#define VM_WAIT() asm volatile("s_waitcnt vmcnt(0)" ::: "memory")
typedef __bf16 bf16x2_t __attribute__((ext_vector_type(2)));
__device__ __forceinline__ unsigned cvt_pk_bf16(float lo, float hi) { return __builtin_bit_cast(unsigned, __builtin_convertvector((f32x2){lo, hi}, bf16x2_t)); }

__device__ __forceinline__ float bf_lo(unsigned w) { return __uint_as_float(w << 16); }
__device__ __forceinline__ float bf_hi(unsigned w) { return __uint_as_float(w & 0xffff0000u); }
__device__ __forceinline__ float bf2f(bf16_t b) { return __uint_as_float(((unsigned)b) << 16); }
__device__ __forceinline__ float wave_sum(float v) {
#pragma unroll
    for (int o = 1; o < 64; o <<= 1) v += __shfl_xor(v, o);
    return v;
}
__device__ __forceinline__ float sigmoidf_(float x) { return 1.0f / (1.0f + __expf(-x)); }
__device__ __forceinline__ float gelu_tanh(float y) { const float a = 0.7978845608028654f * (y + 0.044715f * y * y * y); const float t = 1.0f - 2.0f / (1.0f + __expf(2.0f * a)); return 0.5f * y * (1.0f + t); }

struct EpiProj {
    static constexpr bool PERM = true, AFTER_DRAIN = false;
    bf16_t* P; bf16_t* UX;
    __device__ __forceinline__ void operator()(const f32x4 (&acc)[2][2][4][2], const pg8::Unit& u, int wr, int wc, int fr, int fq) const {
        const int row0 = u.pm * 256 + wr * 64 + fr, col0 = u.pn * 256 + wc * 32 + 8 * fq;
        const bool s5 = u.pn < 4;
#pragma unroll
        for (int ai = 0; ai < 2; ++ai)
#pragma unroll
            for (int m = 0; m < 4; ++m) { const int row = row0 + ai * 128 + m * 16;
#pragma unroll
                for (int bj = 0; bj < 2; ++bj) { const f32x4 v0 = acc[ai][bj][m][0], v1 = acc[ai][bj][m][1]; const int col = col0 + bj * 128;
                    u32x4 w; w.x = cvt_pk_bf16(v0[0], v0[1]); w.y = cvt_pk_bf16(v0[2], v0[3]); w.z = cvt_pk_bf16(v1[0], v1[1]); w.w = cvt_pk_bf16(v1[2], v1[3]);
                    if (!s5) *(u32x4*)(P + (size_t)row * INP + col) = w;
                    else { bf16_t* ur = UX + (size_t)((col >> 4) * 256 + (row >> 6)) * 1152; *(u32x4*)(ur + (row & 63) * 16 + (col & 15)) = w;
                        if ((row & 63) == 0) { const u32x4 z = (u32x4){0u, 0u, 0u, 0u}; bf16_t* zp = ur + 1024 + ((col & 15) ? 64 : 0);
#pragma unroll
                            for (int i = 0; i < 8; ++i) *(u32x4*)(zp + 8 * i) = z; } } } }
    }
};
struct EpiSwiglu {
    static constexpr bool PERM = true, AFTER_DRAIN = false;
    bf16_t* HID;
    __device__ __forceinline__ void operator()(const f32x4 (&acc)[2][2][4][2], const pg8::Unit& u, int wr, int wc, int fr, int fq) const {
        const int row0 = u.pm * 256 + wr * 64 + fr, col0 = u.pn * 128 + wc * 32 + 8 * fq;
#pragma unroll
        for (int ai = 0; ai < 2; ++ai)
#pragma unroll
            for (int m = 0; m < 4; ++m) { bf16_t* rowp = HID + (size_t)(row0 + ai * 128 + m * 16) * DFF + col0;
                float o[8];
#pragma unroll
                for (int n = 0; n < 2; ++n)
#pragma unroll
                    for (int j = 0; j < 4; ++j) { const float g = acc[ai][0][m][n][j], up = acc[ai][1][m][n][j]; o[n * 4 + j] = g * __builtin_amdgcn_rcpf(1.0f + __expf(-g)) * up; }
                u32x4 w; w.x = cvt_pk_bf16(o[0], o[1]); w.y = cvt_pk_bf16(o[2], o[3]); w.z = cvt_pk_bf16(o[4], o[5]); w.w = cvt_pk_bf16(o[6], o[7]);
                *(u32x4*)rowp = w; }
    }
};
struct EpiGlu {
    static constexpr bool PERM = true, AFTER_DRAIN = false;
    const bf16_t* Z; bf16_t* MIXED; const float* bias;
    __device__ __forceinline__ void operator()(const f32x4 (&acc)[2][2][4][2], const pg8::Unit& u, int wr, int wc, int fr, int fq) const {
        const int row0 = u.pm * 256 + wr * 64 + fr, col0 = u.pn * 256 + wc * 32 + 8 * fq;
#pragma unroll
        for (int bj = 0; bj < 2; ++bj) {
            const f32x4 b0 = *(const f32x4*)(bias + col0 + bj * 128), b1 = *(const f32x4*)(bias + col0 + bj * 128 + 4);
#pragma unroll
            for (int ai = 0; ai < 2; ++ai)
#pragma unroll
                for (int m = 0; m < 4; ++m) { const size_t r = (size_t)(row0 + ai * 128 + m * 16);
                    const u32x4 zz = *(const u32x4*)(Z + r * S5W + col0 + bj * 128);
                    const f32x4 v0 = acc[ai][bj][m][0] + b0, v1 = acc[ai][bj][m][1] + b1;
                    u32x4 w;
                    w.x = cvt_pk_bf16(bf_lo(zz.x) * sigmoidf_(v0[0]), bf_hi(zz.x) * sigmoidf_(v0[1]));
                    w.y = cvt_pk_bf16(bf_lo(zz.y) * sigmoidf_(v0[2]), bf_hi(zz.y) * sigmoidf_(v0[3]));
                    w.z = cvt_pk_bf16(bf_lo(zz.z) * sigmoidf_(v1[0]), bf_hi(zz.z) * sigmoidf_(v1[1]));
                    w.w = cvt_pk_bf16(bf_lo(zz.w) * sigmoidf_(v1[2]), bf_hi(zz.w) * sigmoidf_(v1[3]));
                    *(u32x4*)(MIXED + r * DM + col0 + bj * 128) = w;
                    if (m & 1) asm volatile("" ::: "memory"); }
        }
    }
};
struct EpiResid {
    static constexpr bool PERM = false, AFTER_DRAIN = false;
    const float* base; float* out; const float* rowstats; const float* lng; const float* lnb; const float* gate0; float* rowpart;
    __device__ __forceinline__ void operator()(const f32x4 (&acc)[2][2][4][2], const pg8::Unit& u, int wr, int wc, int fr, int fq) const {
        const int rowb = u.pm * 256 + wr * 64 + fr, col0 = u.pn * 256 + wc * 32 + 4 * fq;
        const float* gp = gate0 + (u.pm >= 32 ? 6 * DM : 0);
#pragma unroll
        for (int ai = 0; ai < 2; ++ai)
#pragma unroll
            for (int m = 0; m < 4; ++m) { const int row = rowb + ai * 128 + m * 16;
                const f32x2 st = *(const f32x2*)(rowstats + (size_t)row * 2);
                float s1 = 0.f, s2 = 0.f;
#pragma unroll
                for (int bj = 0; bj < 2; ++bj)
#pragma unroll
                    for (int n = 0; n < 2; ++n) { const int c = col0 + bj * 128 + n * 16; const size_t off = (size_t)row * DM + c;
                        const f32x4 vb = *(const f32x4*)(base + off);
                        const f32x4 A = *(const f32x4*)(lng + c), Bc = *(const f32x4*)(lnb + c), Gm = *(const f32x4*)(gp + c);
                        const f32x4 o = (((vb - st.x) * st.y) * A + Bc) * ALPHA + (Gm + 1.0f) * acc[ai][bj][m][n];
                        *(f32x4*)(out + off) = o;
                        s1 += (o[0] + o[1]) + (o[2] + o[3]); s2 += (o[0] * o[0] + o[1] * o[1]) + (o[2] * o[2] + o[3] * o[3]); }
                s1 += __shfl_xor(s1, 16); s1 += __shfl_xor(s1, 32); s2 += __shfl_xor(s2, 16); s2 += __shfl_xor(s2, 32);
                if (fq == 0) *(f32x2*)(rowpart + ((size_t)row * 64 + u.pn * 4 + wc) * 2) = (f32x2){s1, s2};
                asm volatile("" ::: "memory"); }
    }
};

__device__ __forceinline__ int lane_id_v() { int r; asm volatile("v_mbcnt_lo_u32_b32 %0, -1, 0\n\tv_mbcnt_hi_u32_b32 %0, -1, %0" : "=v"(r)); return r; }
struct Args { const float* in[N_IN]; float* out; unsigned char* ws; int ph_lo, ph_hi; };
struct Ctx {
    volatile LAS unsigned long long* t;
    __device__ __forceinline__ unsigned long long ld(int i) const { const unsigned long long v = t[i];
        return ((unsigned long long)(unsigned)__builtin_amdgcn_readfirstlane((int)(v >> 32)) << 32) | (unsigned long long)(unsigned)__builtin_amdgcn_readfirstlane((int)(unsigned)v); }
    __device__ __forceinline__ const float* in(int i) const { return (const float*)ld(i); }
    __device__ __forceinline__ float* out() const { return (float*)ld(30); }
    __device__ __forceinline__ unsigned char* ws() const { return (unsigned char*)ld(31); }
};

constexpr int S5K = 1152;
constexpr size_t S5_T_LAYER = (size_t)64 * 1024 * S5K * 2, S5_W1_LAYER = (size_t)64 * 256 * S5K * 2;

struct S5Order {
    int G, c, n, sh;
    __device__ __forceinline__ bool next(int i, pg8::Unit& u) const { const int L = i * G + c; if (L >= n) return false; u.pm = L >> sh; u.pn = L; return true; }
    __device__ __forceinline__ void a_ready(const pg8::Unit&) const {}
    __device__ __forceinline__ void done(const pg8::Unit&) const {}
};
struct EpiS5A {
    static constexpr bool PERM = false, AFTER_DRAIN = false;
    float* Sloc;
    __device__ __forceinline__ void operator()(const f32x4 (&acc)[2][2][4][2], const pg8::Unit& u, int wr, int wc, int fr, int fq) const {
        const int row0 = u.pm * 256 + wr * 64 + fr, col0 = wc * 32 + 4 * fq;
#pragma unroll
        for (int ai = 0; ai < 2; ++ai)
#pragma unroll
            for (int m = 0; m < 4; ++m)
#pragma unroll
                for (int n = 0; n < 2; ++n) *(f32x4*)(Sloc + (size_t)(row0 + ai * 128 + m * 16) * 128 + col0 + n * 16) = acc[ai][0][m][n];
    }
};
struct EpiS5C {
    static constexpr bool PERM = true, AFTER_DRAIN = false;
    bf16_t* Z;
    __device__ __forceinline__ void operator()(const f32x4 (&acc)[2][2][4][2], const pg8::Unit& u, int wr, int wc, int fr, int fq) const {
        const int g = u.pm, c0 = wr * 64 + fr, cc0 = (u.pn & 3) * 256 + wc * 32 + 8 * fq;
#pragma unroll
        for (int ai = 0; ai < 2; ++ai)
#pragma unroll
            for (int m = 0; m < 4; ++m) { const int c = c0 + ai * 128 + m * 16;
#pragma unroll
                for (int bj = 0; bj < 2; ++bj) { const int cc = cc0 + bj * 128, t = cc >> 4, h0 = cc & 15;
                    const f32x4 v0 = acc[ai][bj][m][0], v1 = acc[ai][bj][m][1];
                    u32x4 w; w.x = cvt_pk_bf16(gelu_tanh(v0[0]), gelu_tanh(v0[1])); w.y = cvt_pk_bf16(gelu_tanh(v0[2]), gelu_tanh(v0[3]));
                    w.z = cvt_pk_bf16(gelu_tanh(v1[0]), gelu_tanh(v1[1])); w.w = cvt_pk_bf16(gelu_tanh(v1[2]), gelu_tanh(v1[3]));
                    *(u32x4*)(Z + (size_t)(c * 64 + t) * S5W + g * 16 + h0) = w; } }
    }
};
__device__ __forceinline__ void s5_tables_item(const Ctx& a, int lg, LAS unsigned char* lds, int wave, int lane) {
    LAS f32x2* LP = (LAS f32x2*)lds;
    LAS f32x2* BB = (LAS f32x2*)(lds + 33280);
    LAS f32x2* CC = (LAS f32x2*)(lds + 41472);
    LAS float* KT = (LAS float*)(lds + 49664);
    const int tid = wave * 64 + lane, l = lg >> 6, g = lg & 63;
    if (tid < 64) { const int p = tid;
        const double ar = (double)a.in(I_AREAL)[lg * 64 + p], ai = (double)a.in(I_AIMAG)[lg * 64 + p], dt = exp((double)a.in(I_LOGDT)[lg]);
        const double mag = exp(ar * dt), ang = ai * dt, lr = mag * cos(ang), li = mag * sin(ang);
        const double den = ar * ar + ai * ai, nr = lr - 1.0, ni = li, cr = (nr * ar + ni * ai) / den, ci = (ni * ar - nr * ai) / den;
        double pr = 1.0, pi = 0.0;
        for (int tau = 0; tau <= 64; ++tau) { LP[tau * 64 + p] = (f32x2){(float)pr, (float)pi}; const double nr2 = pr * lr - pi * li, ni2 = pr * li + pi * lr; pr = nr2; pi = ni2; }
        for (int h = 0; h < 16; ++h) { const double br = (double)a.in(I_BRE)[((size_t)lg * 64 + p) * 16 + h], bi = (double)a.in(I_BIM)[((size_t)lg * 64 + p) * 16 + h];
            BB[p * 16 + h] = (f32x2){(float)(cr * br - ci * bi), (float)(cr * bi + ci * br)}; }
    }
    for (int e = tid; e < 1024; e += 512) { const int h = e >> 6, p = e & 63; CC[e] = (f32x2){a.in(I_CRE)[((size_t)lg * 16 + h) * 64 + p], a.in(I_CIM)[((size_t)lg * 16 + h) * 64 + p]}; }
    __syncthreads();
    if (tid < 64) *(f32x2*)((float*)(a.ws() + WS_LAM64) + ((size_t)lg * 64 + tid) * 2) = LP[64 * 64 + tid];
    for (int e = tid; e < 64 * 256; e += 512) { const int tau = e >> 8, h = (e >> 4) & 15, hp = e & 15; float s = 0.f;
#pragma unroll 8
        for (int p = 0; p < 64; ++p) { const f32x2 c = CC[h * 64 + p], lm = LP[tau * 64 + p], b = BB[p * 16 + hp];
            const float xr = c.x * lm.x - c.y * lm.y, xi = c.x * lm.y + c.y * lm.x; s += xr * b.x - xi * b.y; }
        if (tau == 0 && h == hp) s += a.in(I_S5D)[l * S5W + g * 16 + h];
        KT[e] = s; }
    __syncthreads();
    bf16_t* T = (bf16_t*)(a.ws() + WS_S5T + (size_t)l * S5_T_LAYER) + (size_t)g * 1024 * S5K;
    for (int pc = tid; pc < 1024 * 144; pc += 512) { const int n = pc / 144, j = pc % 144, t = n >> 4, h = n & 15; float v[8];
        if (j < 128) { const int s = j >> 1, hp0 = (j & 1) * 8;
            if (s > t) {
#pragma unroll
                for (int i = 0; i < 8; ++i) v[i] = 0.f;
            } else { const LAS float* kp = KT + (t - s) * 256 + h * 16 + hp0; const f32x4 k0 = *(const LAS f32x4*)kp, k1 = *(const LAS f32x4*)(kp + 4);
                v[0] = k0[0]; v[1] = k0[1]; v[2] = k0[2]; v[3] = k0[3]; v[4] = k1[0]; v[5] = k1[1]; v[6] = k1[2]; v[7] = k1[3]; }
        } else { const int p0 = (j - 128) * 4;
#pragma unroll
            for (int i = 0; i < 4; ++i) { const f32x2 c = CC[h * 64 + p0 + i], lm = LP[(t + 1) * 64 + p0 + i]; v[2 * i] = c.x * lm.x - c.y * lm.y; v[2 * i + 1] = -(c.x * lm.y + c.y * lm.x); } }
        *(u32x4*)(T + (size_t)n * S5K + j * 8) = (u32x4){cvt_pk_bf16(v[0], v[1]), cvt_pk_bf16(v[2], v[3]), cvt_pk_bf16(v[4], v[5]), cvt_pk_bf16(v[6], v[7])}; }
    bf16_t* W1 = (bf16_t*)(a.ws() + WS_S5W1 + (size_t)l * S5_W1_LAYER) + (size_t)g * 256 * S5K;
    for (int pc = tid; pc < 256 * 144; pc += 512) { const int n = pc / 144, j = pc % 144; float v[8];
#pragma unroll
        for (int i = 0; i < 8; ++i) v[i] = 0.f;
        if (n < 128 && j < 128) { const int p = n >> 1, ri = n & 1, s = j >> 1, hp0 = (j & 1) * 8; const f32x2 lm = LP[(63 - s) * 64 + p];
#pragma unroll
            for (int i = 0; i < 8; ++i) { const f32x2 b = BB[p * 16 + hp0 + i]; v[i] = ri ? (lm.x * b.y + lm.y * b.x) : (lm.x * b.x - lm.y * b.y); } }
        *(u32x4*)(W1 + (size_t)n * S5K + j * 8) = (u32x4){cvt_pk_bf16(v[0], v[1]), cvt_pk_bf16(v[2], v[3]), cvt_pk_bf16(v[4], v[5]), cvt_pk_bf16(v[6], v[7])}; }
    __syncthreads();
}
__device__ __forceinline__ void s5_scan_item(const Ctx& a, int l, int item, int wave, int lane) {
    const int idx = item * 512 + wave * 64 + lane, g = idx >> 7, b = (idx >> 6) & 1, p = idx & 63;
    const f32x2 lam = *(const f32x2*)((const float*)(a.ws() + WS_LAM64) + ((size_t)(l * 64 + g) * 64 + p) * 2);
    const float* sl = (const float*)(a.ws() + WS_SLOC) + ((size_t)(g * 256 + b * 128)) * 128 + 2 * p;
    bf16_t* ux = (bf16_t*)(a.ws() + WS_UX) + ((size_t)(g * 256 + b * 128)) * S5K + 1024 + 2 * p;
    float xr = 0.f, xi = 0.f;
    for (int c0 = 0; c0 < 128; c0 += 8) { f32x2 s[8];
#pragma unroll
        for (int i = 0; i < 8; ++i) s[i] = *(const f32x2*)(sl + (size_t)(c0 + i) * 128);
#pragma unroll
        for (int i = 0; i < 8; ++i) { *(unsigned*)(ux + (size_t)(c0 + i) * S5K) = cvt_pk_bf16(xr, xi);
            const float nr = lam.x * xr - lam.y * xi + s[i].x, ni = lam.x * xi + lam.y * xr + s[i].y; xr = nr; xi = ni; } }
}

__device__ __forceinline__ void transpose_item(const float* W, int N, int k0, int n0, bf16_t* WT, int drow0, int Kd, LAS float* scr, int lane) {
    const int nl = 4 * (lane & 15), kq = lane >> 4;
    const bool valid = (n0 + nl) < N;
    f32x4 v[16];
#pragma unroll
    for (int i = 0; i < 16; ++i) { const int k = 4 * i + kq; v[i] = valid ? *(const f32x4*)(W + (size_t)(k0 + k) * N + n0 + nl) : (f32x4){0.f, 0.f, 0.f, 0.f}; }
#pragma unroll
    for (int i = 0; i < 16; ++i) { const int k = 4 * i + kq; LAS float* s = scr + k * 65 + nl; s[0] = v[i][0]; s[1] = v[i][1]; s[2] = v[i][2]; s[3] = v[i][3]; }
    LDS_WAIT();
    const int c = lane & 7;
#pragma unroll
    for (int j = 0; j < 8; ++j) { const int n = (lane >> 3) + 8 * j; const LAS float* s = scr + (8 * c) * 65 + n;
        u32x4 o; o.x = cvt_pk_bf16(s[0], s[65]); o.y = cvt_pk_bf16(s[130], s[195]); o.z = cvt_pk_bf16(s[260], s[325]); o.w = cvt_pk_bf16(s[390], s[455]);
        *(u32x4*)(WT + (size_t)(drow0 + n) * Kd + k0 + 8 * c) = o; }
    LDS_WAIT();
}
constexpr int NIT_IN = 64 * 188, NIT_OUT = 64 * 64, NIT_G = 64 * 172, NIT_DN = 172 * 64, NIT_GLU = 16 * 16;
constexpr int NIT_LAYER = NIT_IN + NIT_OUT + 2 * NIT_G + NIT_DN + NIT_GLU;
constexpr int NIT_TR = DEPTH * NIT_LAYER, NIT_COND = 64 * 96;

__device__ __forceinline__ void phase_prologue(const Ctx& a, LAS unsigned char* lds, int wave, int lane) {
    LAS float* scr = (LAS float*)(lds + wave * 16640);
    const int gw = blockIdx.x * 8 + wave, NGW = gridDim.x * 8;
    for (int it = gw; it < NIT_TR + NIT_COND; it += NGW) {
        if (it < NIT_TR) {
            const int l = it / NIT_LAYER; int r = it % NIT_LAYER;
            unsigned char* wt = a.ws() + WS_WT + (size_t)l * WT_LAYER;
            if (r < NIT_IN) { const int kb = r / 188, nb = r % 188; transpose_item(a.in(I_WIN) + (size_t)l * DM * INW, INW, 64 * kb, 64 * nb, (bf16_t*)(wt + WT_IN), 64 * nb, DM, scr, lane); continue; } r -= NIT_IN;
            if (r < NIT_OUT) { const int kb = r / 64, nb = r % 64; transpose_item(a.in(I_WOUT) + (size_t)l * DM * DM, DM, 64 * kb, 64 * nb, (bf16_t*)(wt + WT_OUT), 64 * nb, DM, scr, lane); continue; } r -= NIT_OUT;
            if (r < NIT_G) { const int kb = r / 172, nb = r % 172, n0 = 64 * nb; transpose_item(a.in(I_WFG) + (size_t)l * DM * DFF, DFF, 64 * kb, n0, (bf16_t*)(wt + WT_GU), 256 * (n0 / 128) + (n0 % 128), DM, scr, lane); continue; } r -= NIT_G;
            if (r < NIT_G) { const int kb = r / 172, nb = r % 172, n0 = 64 * nb; transpose_item(a.in(I_WFU) + (size_t)l * DM * DFF, DFF, 64 * kb, n0, (bf16_t*)(wt + WT_GU), 256 * (n0 / 128) + 128 + (n0 % 128), DM, scr, lane); continue; } r -= NIT_G;
            if (r < NIT_DN) { const int kb = r / 64, nb = r % 64; transpose_item(a.in(I_WFD) + (size_t)l * DFF * DM, DM, 64 * kb, 64 * nb, (bf16_t*)(wt + WT_DN), 64 * nb, DFF, scr, lane); continue; } r -= NIT_DN;
            { const int kb = r / 16, nb = r % 16; transpose_item(a.in(I_GLUW) + (size_t)l * S5W * S5W, S5W, 64 * kb, 64 * nb, (bf16_t*)(wt + WT_GLU), 64 * nb, S5W, scr, lane); }
        } else {
            const int item = it - NIT_TR, kb = item / 96, jb = item % 96, k0 = 64 * kb, j0 = 256 * jb + 4 * lane;
            const float* c = a.in(I_C);
            float c0 = c[k0 + lane], c1 = c[DM + k0 + lane];
            c0 = c0 / (1.0f + expf(-c0)); c1 = c1 / (1.0f + expf(-c1));
            f32x4 a0 = (f32x4){0.f, 0.f, 0.f, 0.f}, a1 = a0;
            const float* w = a.in(I_WADA) + (size_t)k0 * (6 * DM) + j0;
#pragma unroll 8
            for (int kk = 0; kk < 64; ++kk) { const f32x4 wv = *(const f32x4*)(w + (size_t)kk * (6 * DM));
                const float s0 = __int_as_float(__builtin_amdgcn_readlane(__float_as_int(c0), kk)), s1 = __int_as_float(__builtin_amdgcn_readlane(__float_as_int(c1), kk));
                a0 += wv * s0; a1 += wv * s1; }
            float* cp = (float*)(a.ws() + WS_CONDPART);
            *(f32x4*)(cp + (size_t)(kb * 2 + 0) * (6 * DM) + j0) = a0;
            *(f32x4*)(cp + (size_t)(kb * 2 + 1) * (6 * DM) + j0) = a1;
        }
    }
    __syncthreads();
    for (int lg = blockIdx.x; lg < DEPTH * 64; lg += gridDim.x) s5_tables_item(a, lg, lds, wave, lane);
}
__device__ __forceinline__ void phase_mod(const Ctx& a, int wave, int lane) {
    const int gt = blockIdx.x * 512 + wave * 64 + lane, NT = gridDim.x * 512;
    const float* cp = (const float*)(a.ws() + WS_CONDPART);
    float* mod = (float*)(a.ws() + WS_MOD); float* misc = (float*)(a.ws() + WS_MISC);
    for (int idx = gt; idx < NB * 6 * DM; idx += NT) {
        const int b = idx / (6 * DM), j = idx % (6 * DM);
        float s = a.in(I_BADA)[j];
        for (int kb = 0; kb < 64; ++kb) s += cp[(size_t)(kb * 2 + b) * (6 * DM) + j];
        for (int l = 0; l < DEPTH; ++l) mod[(size_t)((l * 2 + b) * 6) * DM + j] = s + a.in(I_TABLE)[(size_t)l * 6 * DM + j];
    }
    for (int idx = gt; idx < DM; idx += NT) { misc[idx] = 1.0f; misc[DM + idx] = 0.0f; }
    for (int idx = gt; idx < HGW; idx += NT) {
        const float* raw = a.in(I_LBRAW); float r[DEPTH], mx = -3.0e38f;
#pragma unroll
        for (int l = 0; l < DEPTH; ++l) { r[l] = raw[l * HGW + idx]; mx = fmaxf(mx, r[l]); }
        float e[DEPTH], sum = 0.f;
#pragma unroll
        for (int l = 0; l < DEPTH; ++l) { e[l] = expf(r[l] - mx); sum += e[l]; }
        float cum = 0.f;
#pragma unroll
        for (int l = 0; l < DEPTH; ++l) { misc[2 * DM + l * HGW + idx] = cum; if (l + 1 < DEPTH) cum += e[l + 1] / sum; }
    }
}

template <int MODE>
__device__ __forceinline__ void phase_lnapply(const float* vsrc, const float* rowpart, float* rowstats, const float* lng, const float* lnb, const float* modp, int i_shift, int i_scale,
                                              bf16_t* H, float* outf, LAS unsigned char* lds, int wave, int lane) {
    LAS f32x2* st = (LAS f32x2*)lds;
    for (int blk = blockIdx.x; blk < MTOK / 64; blk += gridDim.x) {
        const int r0 = blk * 64, b = (r0 >= SEQ) ? 1 : 0;
        f32x2 pp[8];
        if (MODE != 0) {
#pragma unroll
            for (int rr = 0; rr < 8; ++rr) pp[rr] = *(const f32x2*)(rowpart + ((size_t)(r0 + wave * 8 + rr) * 64 + lane) * 2);
        }
#pragma unroll
        for (int rr = 0; rr < 8; ++rr) { const int rl = wave * 8 + rr, r = r0 + rl; float mu = 0.f, rs = 1.f;
            if (MODE != 0) { const float s1 = wave_sum(pp[rr].x), s2 = wave_sum(pp[rr].y);
                mu = s1 * (1.0f / DM); const float var = fmaxf(s2 * (1.0f / DM) - mu * mu, 0.f); rs = 1.0f / sqrtf(var + LN_EPS); }
            if (lane == 0) { st[rl] = (f32x2){mu, rs}; if (MODE != 2) *(f32x2*)(rowstats + (size_t)r * 2) = (f32x2){mu, rs}; } }
        __syncthreads();
        f32x4 A[2], B[2];
#pragma unroll
        for (int jj = 0; jj < 2; ++jj) { const int c = 512 * wave + 256 * jj + 4 * lane;
            f32x4 g = (f32x4){1.f, 1.f, 1.f, 1.f}, bb = (f32x4){0.f, 0.f, 0.f, 0.f};
            if (MODE != 0) { g = *(const f32x4*)(lng + c); bb = *(const f32x4*)(lnb + c); }
            if (MODE != 2) { const f32x4 sc = *(const f32x4*)(modp + (size_t)(b * 6 + i_scale) * DM + c) + 1.0f, sh = *(const f32x4*)(modp + (size_t)(b * 6 + i_shift) * DM + c); A[jj] = g * sc; B[jj] = bb * sc + sh; }
            else { A[jj] = g; B[jj] = bb; } }
#pragma unroll 8
        for (int rl = 0; rl < 64; ++rl) { const f32x2 s = st[rl]; const size_t off = (size_t)(r0 + rl) * DM + 512 * wave + 4 * lane;
#pragma unroll
            for (int jj = 0; jj < 2; ++jj) { const f32x4 v = *(const f32x4*)(vsrc + off + 256 * jj); const f32x4 y = ((v - s.x) * s.y) * A[jj] + B[jj];
                if (MODE == 2) *(f32x4*)(outf + off + 256 * jj) = y;
                else { u32x2 w; w.x = cvt_pk_bf16(y[0], y[1]); w.y = cvt_pk_bf16(y[2], y[3]); *(u32x2*)(H + off + 256 * jj) = w; } } }
        __syncthreads();
    }
}

typedef short bf16x8 __attribute__((ext_vector_type(8)));
typedef short bf16x4 __attribute__((ext_vector_type(4)));
constexpr int HG_BLK = 16896, HG_OQ = 0, HG_OK = 4096, HG_OKT = 8192, HG_OVT = 12288, HG_ODL = 16384;
constexpr int GL_BLK = 32768, GL_OQ = 0, GL_OK = 6400, GL_OKT = 12800, GL_ODL = 18944, GL_SHARED = 20480, GL_OVT = 20480;
constexpr int NSUB = SEQ / 16;

__device__ __forceinline__ unsigned short f2bf1(float x) { return (unsigned short)(cvt_pk_bf16(x, x) & 0xffffu); }

__device__ __forceinline__ void pre_finish(const float (&qq)[16], const float (&kk)[16], float (&g)[16], unsigned char* blk, int oq, int ok, int okt, int odl, int rowb, int d, bool swz) {
    float b = 0.f;
#pragma unroll
    for (int j = 0; j < 16; ++j) { b += g[j]; g[j] = b; }
    const float bl = b;
    unsigned kt[8];
#pragma unroll
    for (int j = 0; j < 16; j += 2) {
        float kv[2];
#pragma unroll
        for (int jj = 0; jj < 2; ++jj) { const int t = j + jj; const float bj = g[t];
            const int off = t * rowb + (swz ? ((2 * d) ^ (t << 4)) : 2 * d);
            const float qv = qq[t] * __expf(bj), kc = kk[t] * __expf(fminf(-bj, 80.f));
            const float qn = __int_as_float(__builtin_amdgcn_mov_dpp(__float_as_int(qv), 0xB1, 0xF, 0xF, true)), kn = __int_as_float(__builtin_amdgcn_mov_dpp(__float_as_int(kc), 0xB1, 0xF, 0xF, true));
            if ((d & 1) == 0) { *(unsigned*)(blk + oq + off) = cvt_pk_bf16(qv, qn); *(unsigned*)(blk + ok + off) = cvt_pk_bf16(kc, kn); }
            kv[jj] = kk[t] * __expf(bl - bj); }
        kt[j >> 1] = cvt_pk_bf16(kv[0], kv[1]); }
    *(u32x4*)(blk + okt + d * 32) = (u32x4){kt[0], kt[1], kt[2], kt[3]};
    *(u32x4*)(blk + okt + d * 32 + 16) = (u32x4){kt[4], kt[5], kt[6], kt[7]};
    *(float*)(blk + odl + d * 4) = __expf(bl);
}
__device__ __forceinline__ void phase_pre(const Ctx& a, int l, int wave, int lane) {
    const bf16_t* P = (const bf16_t*)(a.ws() + WS_P);
    int tid = wave * 64 + lane;
    const bool bal = gridDim.x == 256;
    const int t_lo = bal ? (blockIdx.x < 64 ? 26 * (int)blockIdx.x : 1664 + 34 * ((int)blockIdx.x - 64)) : (int)blockIdx.x;
    const int t_hi = bal ? t_lo + (blockIdx.x < 64 ? 26 : 34) : NB * NSUB * 8, t_st = bal ? 1 : (int)gridDim.x;
    for (int task = t_lo; task < t_hi; task += t_st) {
        asm volatile("" : "+v"(tid));
        const int kind = bal ? (task & 7) : ((task + (task >> 8)) & 7), bsc = task >> 3, b = bsc / NSUB, sc = bsc % NSUB;
        const size_t row0 = (size_t)b * SEQ + sc * 16;
        if (kind < 3) {
            const int ch = kind * 512 + tid, h = ch >> 7, d = ch & 127;
            const float lb = ((const float*)(a.ws() + WS_MISC))[2 * DM + l * HGW + ch];
            unsigned char* blk = a.ws() + WS_HGB + ((size_t)(b * 12 + h) * NSUB + sc) * HG_BLK;
            float g[16], qq[16], kk[16]; unsigned vv[8];
#pragma unroll
            for (int j = 0; j < 16; ++j) { const bf16_t* prow = P + (row0 + j) * INP;
                const float qin = fmaxf(bf2f(prow[C_QB + ch]), -80.f), fin = fminf(fmaxf(bf2f(prow[C_FB + ch]), -80.f), 80.f);
                const unsigned short v = prow[C_IB + ch]; if (j & 1) vv[j >> 1] |= ((unsigned)v) << 16; else vv[j >> 1] = v;
                const float e = __expf(-fin), sg = __builtin_amdgcn_rcpf(1.0f + e);
                const float f = lb + (1.0f - lb) * sg;
                g[j] = fmaxf(__logf(f), -100.f); kk[j] = (1.0f - lb) * (e * sg); qq[j] = qin * __builtin_amdgcn_rcpf(1.0f + __expf(-qin)); }
            *(u32x4*)(blk + HG_OVT + d * 32) = (u32x4){vv[0], vv[1], vv[2], vv[3]};
            *(u32x4*)(blk + HG_OVT + d * 32 + 16) = (u32x4){vv[4], vv[5], vv[6], vv[7]};
            pre_finish(qq, kk, g, blk, HG_OQ, HG_OK, HG_OKT, HG_ODL, 256, d, true);
        } else if (kind < 5) {
            if (tid < 384) {
                const int ch = (kind - 3) * 384 + tid, h = ch / 192, d = ch % 192;
                unsigned char* blk = a.ws() + WS_GLB + ((size_t)(b * 4 + h) * NSUB + sc) * GL_BLK;
                float wg[16];
#pragma unroll
                for (int r = 0; r < 16; ++r) wg[r] = a.in(I_WGATE)[((size_t)l * 16 + r) * GLKW + ch];
                const float bgv = a.in(I_BGATE)[l * GLKW + ch];
                float g[16], qq[16], kk[16];
#pragma unroll
                for (int j = 0; j < 16; ++j) { const bf16_t* prow = P + (row0 + j) * INP;
                    const u32x4 l0 = *(const u32x4*)(prow + C_LR), l1 = *(const u32x4*)(prow + C_LR + 8);
                    float x = bgv;
                    x += bf_lo(l0.x) * wg[0] + bf_hi(l0.x) * wg[1] + bf_lo(l0.y) * wg[2] + bf_hi(l0.y) * wg[3] + bf_lo(l0.z) * wg[4] + bf_hi(l0.z) * wg[5] + bf_lo(l0.w) * wg[6] + bf_hi(l0.w) * wg[7];
                    x += bf_lo(l1.x) * wg[8] + bf_hi(l1.x) * wg[9] + bf_lo(l1.y) * wg[10] + bf_hi(l1.y) * wg[11] + bf_lo(l1.z) * wg[12] + bf_hi(l1.z) * wg[13] + bf_lo(l1.w) * wg[14] + bf_hi(l1.w) * wg[15];
                    g[j] = (fminf(x, 0.f) - __logf(1.0f + __expf(-fabsf(x)))) * 0.0625f;
                    qq[j] = bf2f(prow[C_QC + ch]) * GLA_QSCALE; kk[j] = bf2f(prow[C_KC + ch]); }
                pre_finish(qq, kk, g, blk, GL_OQ, GL_OK, GL_OKT, GL_ODL, 400, d, false);
            }
        } else {
            const int ch = (kind - 5) * 512 + tid, h = ch / 384, e = ch % 384;
            unsigned char* blk = a.ws() + WS_GLB + ((size_t)(b * 4 + h) * NSUB + sc) * GL_BLK;
            unsigned vv[8];
#pragma unroll
            for (int j = 0; j < 16; ++j) { const unsigned short v = P[(row0 + j) * INP + C_VC + ch]; if (j & 1) vv[j >> 1] |= ((unsigned)v) << 16; else vv[j >> 1] = v; }
            *(u32x4*)(blk + GL_OVT + e * 32) = (u32x4){vv[0], vv[1], vv[2], vv[3]};
            *(u32x4*)(blk + GL_OVT + e * 32 + 16) = (u32x4){vv[4], vv[5], vv[6], vv[7]};
        }
    }
}

template <int DK, int MODE>
__device__ __forceinline__ void chain_sub(const LAS unsigned char* sb, f32x4 (&S)[DK / 16], float* op, int wave, int n, int q) {
    constexpr bool IS_GLA = (DK == 192);
    constexpr int NKS = DK / 32, NMB = DK / 16, ROWB = IS_GLA ? 400 : 256;
    constexpr int OQ = 0, OK = IS_GLA ? GL_OK : HG_OK, OKT = IS_GLA ? GL_OKT : HG_OKT, OVT = IS_GLA ? GL_OVT : HG_OVT, ODL = IS_GLA ? GL_ODL : HG_ODL;
    const u32x2 vfr = *(const LAS u32x2*)(sb + OVT + (16 * wave + n) * 32 + 8 * q);
    const bf16x8 vf8 = __builtin_bit_cast(bf16x8, (u32x4){vfr.x, vfr.y, 0u, 0u});
    if (MODE == 1) {
        bf16x8 qf[NKS], kf[NKS];
#pragma unroll
        for (int ks = 0; ks < NKS; ++ks) { const int c0 = 2 * (32 * ks + 4 * q), c1 = c0 + 32;
            const int o0 = n * ROWB + (IS_GLA ? c0 : (c0 ^ (n << 4))), o1 = n * ROWB + (IS_GLA ? c1 : (c1 ^ (n << 4)));
            const u32x2 ql = *(const LAS u32x2*)(sb + OQ + o0), qh = *(const LAS u32x2*)(sb + OQ + o1), kl = *(const LAS u32x2*)(sb + OK + o0), kh = *(const LAS u32x2*)(sb + OK + o1);
            qf[ks] = __builtin_bit_cast(bf16x8, (u32x4){ql.x, ql.y, qh.x, qh.y}); kf[ks] = __builtin_bit_cast(bf16x8, (u32x4){kl.x, kl.y, kh.x, kh.y}); }
        f32x4 ao = (f32x4){0.f, 0.f, 0.f, 0.f}, ap = ao, ao1 = ao, ap1 = ao;
#pragma unroll
        for (int ks = 0; ks < NKS; ++ks) {
            const bf16x8 sbf = __builtin_bit_cast(bf16x8, (u32x4){cvt_pk_bf16(S[2 * ks][0], S[2 * ks][1]), cvt_pk_bf16(S[2 * ks][2], S[2 * ks][3]), cvt_pk_bf16(S[2 * ks + 1][0], S[2 * ks + 1][1]), cvt_pk_bf16(S[2 * ks + 1][2], S[2 * ks + 1][3])});
            if (ks & 1) { ao1 = __builtin_amdgcn_mfma_f32_16x16x32_bf16(qf[ks], sbf, ao1, 0, 0, 0); ap1 = __builtin_amdgcn_mfma_f32_16x16x32_bf16(kf[ks], qf[ks], ap1, 0, 0, 0); }
            else { ao = __builtin_amdgcn_mfma_f32_16x16x32_bf16(qf[ks], sbf, ao, 0, 0, 0); ap = __builtin_amdgcn_mfma_f32_16x16x32_bf16(kf[ks], qf[ks], ap, 0, 0, 0); } }
        ao = ao + ao1; ap = ap + ap1;
#pragma unroll
        for (int r = 0; r < 4; ++r) if (4 * q + r > n) ap[r] = 0.f;
        const bf16x8 pa8 = __builtin_bit_cast(bf16x8, (u32x4){cvt_pk_bf16(ap[0], ap[1]), cvt_pk_bf16(ap[2], ap[3]), 0u, 0u});
        ao = __builtin_amdgcn_mfma_f32_16x16x32_bf16(pa8, vf8, ao, 0, 0, 0);
#pragma unroll
        for (int r = 0; r < 4; ++r) op[(size_t)(4 * q + r) * OW] = ao[r];
    }
#pragma unroll
    for (int mb = 0; mb < NMB; ++mb) {
        const f32x4 dl = *(const LAS f32x4*)(sb + ODL + (16 * mb + 4 * q) * 4);
        const u32x2 ktr = *(const LAS u32x2*)(sb + OKT + (16 * mb + n) * 32 + 8 * q);
        S[mb] = __builtin_amdgcn_mfma_f32_16x16x32_bf16(__builtin_bit_cast(bf16x8, (u32x4){ktr.x, ktr.y, 0u, 0u}), vf8, S[mb] * dl, 0, 0, 0); }
}
constexpr size_t ST_REC = 98304;
constexpr int NSEG_HG = 4, NSEG_GL = 6, NSEG_MAX = 6;
__device__ __forceinline__ int seg_u0(bool gla, int s) { return gla ? (s <= 2 ? 44 * s : 88 + 42 * (s - 2)) : 64 * s; }
__device__ __forceinline__ int seg_nu(bool gla, int s) { return gla ? (s < 2 ? 44 : 42) : 64; }
template <int DK, int MODE>
__device__ __forceinline__ void chain_item(const unsigned char* blk0, int vt_off, float* op0, unsigned char* st, int seg, int nunits, LAS unsigned char* lds, int wave, int lane) {
    asm volatile("" : "+v"(lane), "+s"(wave));
    constexpr bool IS_GLA = (DK == 192);
    constexpr int BLK = IS_GLA ? GL_BLK : HG_BLK, SUBB = IS_GLA ? GL_SHARED + 4096 : HG_BLK, NMB = DK / 16;
    constexpr int SH0 = MODE == 1 ? 0 : (IS_GLA ? GL_OKT : HG_OKT);
    constexpr int SH_PIECES = (MODE == 1 ? (IS_GLA ? GL_SHARED : HG_OVT) : (IS_GLA ? GL_ODL + 768 - GL_OKT : 4096)) / 16;
    constexpr int T_PIECES = IS_GLA ? 256 : (4096 + 512) / 16;
    constexpr int T_LDS = IS_GLA ? GL_OVT : HG_OVT;
    constexpr int PIECES = SH_PIECES + T_PIECES, UNITB = 2 * SUBB, NP = (2 * PIECES + 511) / 512;
    const int tid = wave * 64 + lane, n = lane & 15, q = lane >> 4;
    f32x4 S[NMB]; float dacc = 1.0f;
    constexpr int ODL_ = IS_GLA ? GL_ODL : HG_ODL;
#pragma unroll
    for (int mb = 0; mb < NMB; ++mb) S[mb] = (f32x4){0.f, 0.f, 0.f, 0.f};
    if (MODE == 1) {
        for (int s = 0; s < seg; ++s) { const unsigned char* rec = st + (size_t)s * 2 * ST_REC + (size_t)(wave * 64 + lane) * 16;
#pragma unroll
            for (int mb = 0; mb < NMB; ++mb) { const f32x4 h = *(const f32x4*)(rec + (size_t)mb * 8192), d = *(const f32x4*)(st + (size_t)s * 2 * ST_REC + ST_REC + (16 * mb + 4 * q) * 4); S[mb] = S[mb] * d + h; } }
    }
    u32x4 stgA[NP], stgB[NP];
#define CH_SRC(u, p_) (blk0 + (size_t)((u) * 2 + (p_) / PIECES) * BLK + (((p_) % PIECES) < SH_PIECES ? SH0 + ((p_) % PIECES) * 16 : (IS_GLA ? vt_off : HG_OVT) + (((p_) % PIECES) - SH_PIECES) * 16))
#define CH_DST(p_) (((p_) / PIECES) * SUBB + (((p_) % PIECES) < SH_PIECES ? SH0 + ((p_) % PIECES) * 16 : T_LDS + (((p_) % PIECES) - SH_PIECES) * 16))
#define CH_LOAD(stg, u) do { _Pragma("unroll") for (int r_ = 0; r_ < NP; ++r_) { const int p_ = r_ * 512 + tid; const bool ok_ = (NP * 512 == 2 * PIECES) || p_ < 2 * PIECES; const int pc_ = ok_ ? p_ : 0; stg[r_] = *(const u32x4*)CH_SRC(u, pc_); } } while (0)
#define CH_STORE(stg, buf) do { _Pragma("unroll") for (int r_ = 0; r_ < NP; ++r_) { const int p_ = r_ * 512 + tid; const bool ok_ = (NP * 512 == 2 * PIECES) || p_ < 2 * PIECES; const int pc_ = ok_ ? p_ : 0; \
        const int d_ = ok_ ? (buf) * UNITB + CH_DST(pc_) : 2 * UNITB + (p_ - 2 * PIECES) * 16; *(LAS u32x4*)(lds + d_) = stg[r_]; } } while (0)
#define CH_SYNC() do { asm volatile("s_waitcnt lgkmcnt(0)" ::: "memory"); __builtin_amdgcn_s_barrier(); asm volatile("" ::: "memory"); } while (0)
    CH_LOAD(stgA, 0); CH_STORE(stgA, 0);
    CH_LOAD(stgA, 1);
    CH_SYNC();
    float* op = op0 + 16 * wave + n;
    for (int u = 0; u < nunits; u += 2) {
        if (u + 2 < nunits) CH_LOAD(stgB, u + 2);
        chain_sub<DK, MODE>(lds, S, op + (size_t)(u * 32) * OW, wave, n, q);
        chain_sub<DK, MODE>(lds + SUBB, S, op + (size_t)(u * 32 + 16) * OW, wave, n, q);
        if (MODE == 0 && tid < DK) dacc *= *(const LAS float*)(lds + ODL_ + 4 * tid) * *(const LAS float*)(lds + SUBB + ODL_ + 4 * tid);
        CH_STORE(stgA, 1);
        CH_SYNC();
        if (u + 3 < nunits) CH_LOAD(stgA, u + 3);
        chain_sub<DK, MODE>(lds + UNITB, S, op + (size_t)(u * 32 + 32) * OW, wave, n, q);
        chain_sub<DK, MODE>(lds + UNITB + SUBB, S, op + (size_t)(u * 32 + 48) * OW, wave, n, q);
        if (MODE == 0 && tid < DK) dacc *= *(const LAS float*)(lds + UNITB + ODL_ + 4 * tid) * *(const LAS float*)(lds + UNITB + SUBB + ODL_ + 4 * tid);
        if (u + 2 < nunits) CH_STORE(stgB, 0);
        CH_SYNC();
    }
    if (MODE == 0) { unsigned char* rec = st + (size_t)seg * 2 * ST_REC + (size_t)(wave * 64 + lane) * 16;
#pragma unroll
        for (int mb = 0; mb < NMB; ++mb) *(f32x4*)(rec + (size_t)mb * 8192) = S[mb];
        if (tid < DK) *(float*)(st + (size_t)seg * 2 * ST_REC + ST_REC + 4 * tid) = dacc; }
#undef CH_SRC
#undef CH_DST
#undef CH_LOAD
#undef CH_STORE
#undef CH_SYNC
}

template <int MODE>
__device__ __forceinline__ void phase_chain(const Ctx& a, int l, LAS unsigned char* lds, int wave, int lane) {
    const int bx = blockIdx.x, G = gridDim.x;
    constexpr int nhg = 24 * (MODE == 0 ? NSEG_HG - 1 : NSEG_HG), nitems = nhg + 24 * (MODE == 0 ? NSEG_GL - 1 : NSEG_GL);
    for (int it = bx; it < nitems; it += G) {
        const bool gla = it >= nhg; const int j = gla ? it - nhg : it, c = j % 24, seg = j / 24, u0 = seg_u0(gla, seg), nu = seg_nu(gla, seg);
        unsigned char* st = a.ws() + WS_ST + (size_t)(gla ? 24 + c : c) * (NSEG_MAX - 1) * 2 * ST_REC;
        if (!gla) { const int b = c / 12, h = c % 12;
            chain_item<128, MODE>(a.ws() + WS_HGB + ((size_t)(b * 12 + h) * NSUB + 2 * u0) * HG_BLK, 0, (float*)(a.ws() + WS_O) + ((size_t)b * SEQ + u0 * 32) * OW + h * 128, st, seg, nu, lds, wave, lane); }
        else { const int b = c / 12, h = (c % 12) / 3, sl = c % 3;
            chain_item<192, MODE>(a.ws() + WS_GLB + ((size_t)(b * 4 + h) * NSUB + 2 * u0) * GL_BLK, GL_OVT + 4096 * sl, (float*)(a.ws() + WS_O) + ((size_t)b * SEQ + u0 * 32) * OW + HGW + h * 384 + sl * 128, st, seg, nu, lds, wave, lane); }
        __syncthreads();
    }
    if (MODE == 0) { for (int it = (G >= nitems + 16) ? bx - nitems : bx; it < 16; it += G) { if (it < 0) continue; s5_scan_item(a, l, it, wave, lane); } }
}
__device__ __forceinline__ float red16(float v) { v += __shfl_xor(v, 1); v += __shfl_xor(v, 2); v += __shfl_xor(v, 4); v += __shfl_xor(v, 8); return v; }
__device__ __forceinline__ void phase_finalize(const Ctx& a, int l, int wave, int lane) {
    const bf16_t* P = (const bf16_t*)(a.ws() + WS_P); const float* O = (const float*)(a.ws() + WS_O); bf16_t* MX = (bf16_t*)(a.ws() + WS_MIXED);
    const float* hgg = a.in(I_HGG) + l * HGW; const float* hgb = a.in(I_HGB) + l * HGW; const float* glg = a.in(I_GLG) + l * HGW;
    const int gw = blockIdx.x * 8 + wave, NGW = gridDim.x * 8;
    for (int row = gw; row < MTOK; row += NGW) {
        const float* orow = O + (size_t)row * OW; const bf16_t* prow = P + (size_t)row * INP; bf16_t* mrow = MX + (size_t)row * DM;
#pragma unroll
        for (int it = 0; it < 3; ++it) { const int c = (it * 4 + (lane >> 4)) * 128 + (lane & 15) * 8;
            const f32x4 o0 = *(const f32x4*)(orow + c), o1 = *(const f32x4*)(orow + c + 4); const u32x4 gg = *(const u32x4*)(prow + C_GB + c);
            float v[8] = {sigmoidf_(bf_lo(gg.x)) * o0[0], sigmoidf_(bf_hi(gg.x)) * o0[1], sigmoidf_(bf_lo(gg.y)) * o0[2], sigmoidf_(bf_hi(gg.y)) * o0[3],
                          sigmoidf_(bf_lo(gg.z)) * o1[0], sigmoidf_(bf_hi(gg.z)) * o1[1], sigmoidf_(bf_lo(gg.w)) * o1[2], sigmoidf_(bf_hi(gg.w)) * o1[3]};
            float s = 0.f, ss = 0.f;
#pragma unroll
            for (int i = 0; i < 8; ++i) { s += v[i]; ss += v[i] * v[i]; }
            s = red16(s); ss = red16(ss);
            const float mu = s * (1.0f / 128.0f), rs = 1.0f / sqrtf(fmaxf(ss * (1.0f / 128.0f) - mu * mu, 0.f) + LN_EPS);
            const f32x4 g0 = *(const f32x4*)(hgg + c), g1 = *(const f32x4*)(hgg + c + 4), b0 = *(const f32x4*)(hgb + c), b1 = *(const f32x4*)(hgb + c + 4);
            u32x4 w; w.x = cvt_pk_bf16((v[0] - mu) * rs * g0[0] + b0[0], (v[1] - mu) * rs * g0[1] + b0[1]); w.y = cvt_pk_bf16((v[2] - mu) * rs * g0[2] + b0[2], (v[3] - mu) * rs * g0[3] + b0[3]);
            w.z = cvt_pk_bf16((v[4] - mu) * rs * g1[0] + b1[0], (v[5] - mu) * rs * g1[1] + b1[1]); w.w = cvt_pk_bf16((v[6] - mu) * rs * g1[2] + b1[2], (v[7] - mu) * rs * g1[3] + b1[3]);
            *(u32x4*)(mrow + S5W + c) = w; }
#pragma unroll
        for (int h = 0; h < 4; ++h) { const int c = h * 384 + lane * 8; const bool act = lane < 48;
            f32x4 o0 = (f32x4){0.f, 0.f, 0.f, 0.f}, o1 = o0; u32x4 gg = (u32x4){0u, 0u, 0u, 0u};
            if (act) { o0 = *(const f32x4*)(orow + HGW + c); o1 = *(const f32x4*)(orow + HGW + c + 4); gg = *(const u32x4*)(prow + C_GC + c); }
            const float ss = wave_sum((o0[0] * o0[0] + o0[1] * o0[1]) + (o0[2] * o0[2] + o0[3] * o0[3]) + (o1[0] * o1[0] + o1[1] * o1[1]) + (o1[2] * o1[2] + o1[3] * o1[3]));
            const float rms = 1.0f / sqrtf(ss * (1.0f / 384.0f) + LN_EPS);
            if (act) { const f32x4 g0 = *(const f32x4*)(glg + c), g1 = *(const f32x4*)(glg + c + 4);
                const float z[8] = {bf_lo(gg.x), bf_hi(gg.x), bf_lo(gg.y), bf_hi(gg.y), bf_lo(gg.z), bf_hi(gg.z), bf_lo(gg.w), bf_hi(gg.w)};
                u32x4 w; w.x = cvt_pk_bf16(o0[0] * rms * g0[0] * (z[0] * sigmoidf_(z[0])), o0[1] * rms * g0[1] * (z[1] * sigmoidf_(z[1])));
                w.y = cvt_pk_bf16(o0[2] * rms * g0[2] * (z[2] * sigmoidf_(z[2])), o0[3] * rms * g0[3] * (z[3] * sigmoidf_(z[3])));
                w.z = cvt_pk_bf16(o1[0] * rms * g1[0] * (z[4] * sigmoidf_(z[4])), o1[1] * rms * g1[1] * (z[5] * sigmoidf_(z[5])));
                w.w = cvt_pk_bf16(o1[2] * rms * g1[2] * (z[6] * sigmoidf_(z[6])), o1[3] * rms * g1[3] * (z[7] * sigmoidf_(z[7])));
                *(u32x4*)(mrow + S5W + HGW + c) = w; } }
    }
}

constexpr int PH_PRO = 0, PH_MOD = 1, PH_LN0 = 2, PH_L0 = 3, PH_PER_LAYER = 10, N_PHASES = PH_L0 + DEPTH * PH_PER_LAYER;
constexpr int CW_BAR = 4096;

__global__ void __launch_bounds__(512, 2) hybrid_fwd(Args args) {
    extern __shared__ __attribute__((aligned(16))) unsigned char lds_raw[];
    LAS unsigned char* lds = (LAS unsigned char*)lds_raw;
    const int wave = __builtin_amdgcn_readfirstlane((int)threadIdx.x >> 6);
#define lane lane_id_v()
    volatile LAS unsigned* MISC = (volatile LAS unsigned*)(lds + LDSCTL_OFF);
    Ctx ctx; ctx.t = (volatile LAS unsigned long long*)(lds + LDSCTL_OFF + 64);
    if (wave == 0) { const int ln_ = lane; unsigned long long v = 0ull;
#pragma unroll
        for (int i = 0; i < N_IN; ++i) v = (ln_ == i) ? (unsigned long long)args.in[i] : v;
        v = (ln_ == 30) ? (unsigned long long)args.out : v; v = (ln_ == 31) ? (unsigned long long)args.ws : v;
        if (ln_ < 32) ctx.t[ln_] = v;
        if (ln_ < 16) MISC[ln_] = 0u; }
    __syncthreads();
    const int lo = args.ph_lo, hi = args.ph_hi;
    XcdBarrier bar; bar.bar = (unsigned*)(ctx.ws() + WS_CTL) + CW_BAR; bar.x = 0; bar.st = nullptr; bar.w0 = (wave == 0) ? 1u : 0u;
    if (hi - lo > 1) bar = xcd_barrier_post((unsigned*)(ctx.ws() + WS_CTL) + CW_BAR, MISC + 8, (wave == 0) ? 1u : 0u);
#define IN(k) (lo <= (k) && (k) < hi)
#define OPQ() int ln = lane, wv = wave; asm volatile("" : "+s"(wv))
#define SEAM(k) do { if (IN(k) && IN((k) + 1)) xcd_barrier(bar); } while (0)
#define WSP(T, off) ((T*)(ctx.ws() + (off)))

    if (IN(PH_PRO)) { OPQ(); phase_prologue(ctx, lds, wv, ln); }
    SEAM(PH_PRO);
    if (IN(PH_MOD)) { OPQ(); phase_mod(ctx, wv, ln); }
    SEAM(PH_MOD);
    if (IN(PH_LN0)) { OPQ(); phase_lnapply<0>(ctx.in(I_X), nullptr, WSP(float, WS_ROWSTATS), nullptr, nullptr, WSP(float, WS_MOD), 0, 1, WSP(bf16_t, WS_H), nullptr, lds, wv, ln); }
    SEAM(PH_LN0);

    for (int l = 0; l < DEPTH; ++l) {
        const int p0 = PH_L0 + l * PH_PER_LAYER;
        const size_t wto = WS_WT + (size_t)l * WT_LAYER, modo = WS_MOD + (size_t)l * NB * 6 * DM * 4;
        if (IN(p0 + 0)) { pg8::Gemm g{WSP(bf16_t, WS_H), WSP(const bf16_t, wto + WT_IN), MTOK, INP, DM}; pg8::StaticOrder S; S.init(MTOK, INP, (int)gridDim.x, (int)blockIdx.x);
            EpiProj E{WSP(bf16_t, WS_P), WSP(bf16_t, WS_UX)}; pg8::gemm_phase<EpiProj, pg8::StaticOrder, true, true>(lds, g, S, E, wave); }
        SEAM(p0 + 0);
        if (IN(p0 + 1)) {
            { pg8::Gemm g{WSP(bf16_t, WS_UX), WSP(const bf16_t, WS_S5W1 + (size_t)l * S5_W1_LAYER), 64 * 256, 64 * 256, S5K}; S5Order S{(int)gridDim.x, (int)blockIdx.x, 64, 0};
              EpiS5A E{WSP(float, WS_SLOC)}; pg8::gemm_phase<EpiS5A, S5Order, true, true>(lds, g, S, E, wave); }
            { OPQ(); phase_pre(ctx, l, wv, ln); }
            }
        SEAM(p0 + 1);
        if (IN(p0 + 2)) { OPQ(); phase_chain<0>(ctx, l, lds, wv, ln); }
        SEAM(p0 + 2);
        if (IN(p0 + 3)) {
            { pg8::Gemm g{WSP(bf16_t, WS_UX), WSP(const bf16_t, WS_S5T + (size_t)l * S5_T_LAYER), 64 * 256, 64 * 1024, S5K}; S5Order S{(int)gridDim.x, (int)blockIdx.x, 256, 2};
              EpiS5C E{WSP(bf16_t, WS_Z)}; pg8::gemm_phase<EpiS5C, S5Order, true, true>(lds, g, S, E, wave); }
            { OPQ(); phase_chain<1>(ctx, l, lds, wv, ln); } }
        SEAM(p0 + 3);
        if (IN(p0 + 4)) { pg8::Gemm g{WSP(bf16_t, WS_Z), WSP(const bf16_t, wto + WT_GLU), MTOK, S5W, S5W}; pg8::StaticOrder S; S.init(MTOK, S5W, (int)gridDim.x, (int)blockIdx.x);
            EpiGlu E{WSP(bf16_t, WS_Z), WSP(bf16_t, WS_MIXED), ctx.in(I_GLUB) + l * S5W}; pg8::gemm_phase<EpiGlu, pg8::StaticOrder, true, true>(lds, g, S, E, wave);
            { OPQ(); phase_finalize(ctx, l, wv, ln); } }
        SEAM(p0 + 4);
        if (IN(p0 + 5)) { pg8::Gemm g{WSP(bf16_t, WS_MIXED), WSP(const bf16_t, wto + WT_OUT), MTOK, DM, DM}; pg8::StaticOrder S; S.init(MTOK, DM, (int)gridDim.x, (int)blockIdx.x);
            EpiResid E{l == 0 ? ctx.in(I_X) : ctx.out(), ctx.out(), WSP(float, WS_ROWSTATS), l == 0 ? WSP(float, WS_MISC) : ctx.in(I_LN2G) + (l - 1) * DM, l == 0 ? WSP(float, WS_MISC) + DM : ctx.in(I_LN2B) + (l - 1) * DM, WSP(float, modo) + 2 * DM, WSP(float, WS_ROWPART)};
            pg8::gemm_phase<EpiResid, pg8::StaticOrder, true, true>(lds, g, S, E, wave); }
        SEAM(p0 + 5);
        if (IN(p0 + 6)) { OPQ(); phase_lnapply<1>(ctx.out(), WSP(float, WS_ROWPART), WSP(float, WS_ROWSTATS), ctx.in(I_LN1G) + l * DM, ctx.in(I_LN1B) + l * DM, WSP(float, modo), 3, 4, WSP(bf16_t, WS_H), nullptr, lds, wv, ln); }
        SEAM(p0 + 6);
        if (IN(p0 + 7)) { pg8::Gemm g{WSP(bf16_t, WS_H), WSP(const bf16_t, wto + WT_GU), MTOK, 2 * DFF, DM}; pg8::StaticOrder S; S.init(MTOK, 2 * DFF, (int)gridDim.x, (int)blockIdx.x);
            EpiSwiglu E{WSP(bf16_t, WS_P)}; pg8::gemm_phase<EpiSwiglu, pg8::StaticOrder, true, true>(lds, g, S, E, wave); }
        SEAM(p0 + 7);
        if (IN(p0 + 8)) { pg8::Gemm g{WSP(bf16_t, WS_P), WSP(const bf16_t, wto + WT_DN), MTOK, DM, DFF}; pg8::StaticOrder S; S.init(MTOK, DM, (int)gridDim.x, (int)blockIdx.x);
            EpiResid E{ctx.out(), ctx.out(), WSP(float, WS_ROWSTATS), ctx.in(I_LN1G) + l * DM, ctx.in(I_LN1B) + l * DM, WSP(float, modo) + 5 * DM, WSP(float, WS_ROWPART)};
            pg8::gemm_phase<EpiResid, pg8::StaticOrder, true, true>(lds, g, S, E, wave); }
        SEAM(p0 + 8);
        if (IN(p0 + 9)) { OPQ();
            if (l + 1 < DEPTH) phase_lnapply<1>(ctx.out(), WSP(float, WS_ROWPART), WSP(float, WS_ROWSTATS), ctx.in(I_LN2G) + l * DM, ctx.in(I_LN2B) + l * DM, WSP(float, modo) + (size_t)NB * 6 * DM, 0, 1, WSP(bf16_t, WS_H), nullptr, lds, wv, ln);
            else phase_lnapply<2>(ctx.out(), WSP(float, WS_ROWPART), WSP(float, WS_ROWSTATS), ctx.in(I_LN2G) + l * DM, ctx.in(I_LN2B) + l * DM, nullptr, 0, 0, nullptr, ctx.out(), lds, wv, ln);
        }
        SEAM(p0 + 9);
    }
#undef IN
#undef SEAM
#undef OPQ
#undef WSP
#undef lane
}

extern "C" void kernel_launch(void* const* d_in, const int* in_sizes, int n_in, void* d_out, int out_size, void* d_ws, size_t ws_size, hipStream_t stream) {
    static int grid = 0;
    if (grid == 0) {
        if (n_in != N_IN || out_size != MTOK * DM || ws_size < WS_END) { fprintf(stderr, "kernel_launch: unexpected problem (n_in %d, out %d, ws %zu < %zu); nothing launched\n", n_in, out_size, ws_size, (size_t)WS_END); grid = -1; return; }
        int dev = 0, cus = 0, per_cu = 0;
        if (hipGetDevice(&dev) != hipSuccess || hipDeviceGetAttribute(&cus, hipDeviceAttributeMultiprocessorCount, dev) != hipSuccess) { grid = -1; return; }
        if (hipFuncSetAttribute((const void*)hybrid_fwd, hipFuncAttributeMaxDynamicSharedMemorySize, LDS_BYTES) != hipSuccess) { fprintf(stderr, "kernel_launch: hipFuncSetAttribute failed\n"); grid = -1; return; }
        if (hipOccupancyMaxActiveBlocksPerMultiprocessor(&per_cu, (const void*)hybrid_fwd, 512, LDS_BYTES) != hipSuccess || per_cu < 1) fprintf(stderr, "kernel_launch: occupancy query reports %d blocks per CU\n", per_cu);
        (void)hipGetLastError();
        grid = cus;
    }
    if (grid < 0) return;
    (void)in_sizes;
    if (hipMemsetAsync((char*)d_ws + WS_CTL, 0, CTL_ZERO_BYTES, stream) != hipSuccess) return;
    Args a{};
    for (int i = 0; i < N_IN; ++i) a.in[i] = (const float*)d_in[i];
    a.out = (float*)d_out; a.ws = (unsigned char*)d_ws;
    a.ph_lo = 0; a.ph_hi = N_PHASES; hipLaunchKernelGGL(hybrid_fwd, dim3(grid), dim3(512), LDS_BYTES, stream, a);
}
```

```cpp
#include <hip/hip_runtime.h>
#include <cstdio>
#include <cstdint>
namespace pg8 {
#define PG8_LAS __attribute__((address_space(3)))
typedef unsigned short bf16_t;
typedef short bf16x8 __attribute__((ext_vector_type(8)));
typedef float f32x4 __attribute__((ext_vector_type(4)));
typedef unsigned u32x4 __attribute__((ext_vector_type(4)));
constexpr int BM = 256, BK = 64, HALF = 128, HTB = HALF * BK * 2  , STAGE_BYTES = 8 * HTB, NXCD = 8, WGM = 8;

__host__ __device__ __forceinline__ int lds_byte(int r, int c) { const int st = (r >> 4) * 2 + (c >> 5), rr = r & 15, cc = c & 31, ob = rr * 64 + cc * 2; return st * 1024 + (ob ^ (((ob >> 9) & 1) << 5)); }
__host__ __device__ __forceinline__ void stage_rc(int b, int& R, int& C) { const int st = b / 1024, sb = b % 1024, swz = sb ^ (((sb >> 9) & 1) << 5); R = (st >> 1) * 16 + swz / 64; C = (st & 1) * 32 + (swz % 64) / 2; }
__host__ __device__ __forceinline__ int perm32(int rho) { const int n = rho >> 4, i = rho & 15; return 8 * (i >> 2) + 4 * n + (i & 3); }

struct Unit { int pm, pn; };
struct Gemm { const bf16_t* A; const bf16_t* Bt; int M, N, K; };

struct StaticOrder {
    int nM, nN, nwg, G, c;
    __host__ __device__ void init(int M, int N, int G_, int c_) { nM = M / BM; nN = N / BM; nwg = nM * nN; G = G_; c = c_; }
    __host__ __device__ bool next(int i, Unit& u) const {
        const long L = (long)i * G + c; if (L >= nwg) return false;
        int wgid = (int)L; { const int q = nwg / NXCD, r = nwg % NXCD, xcd = wgid % NXCD, off = wgid / NXCD; wgid = (xcd < r ? xcd * (q + 1) : r * (q + 1) + (xcd - r) * q) + off; }
        const int nig = WGM * nN, gid = wgid / nig, fm = gid * WGM, gsz = (nM - fm) < WGM ? (nM - fm) : WGM;
        u.pm = fm + ((wgid % nig) % gsz); u.pn = (wgid % nig) / gsz; return true;
    }
    __device__ __forceinline__ void a_ready(const Unit&) const {}
    __device__ __forceinline__ void done(const Unit&) const {}
};
__device__ __forceinline__ unsigned cvt_pk_bf16(float lo, float hi) { unsigned r; asm volatile("v_cvt_pk_bf16_f32 %0, %1, %2" : "=v"(r) : "v"(lo), "v"(hi)); return r; }
typedef float f32x2 __attribute__((ext_vector_type(2)));
template <class Epi, class Sched, bool ALIGN_EPI = false, bool SP2 = false>
__device__ __forceinline__ void gemm_phase(PG8_LAS unsigned char* lds, const Gemm g, const Sched& S, const Epi& E, int wave_id) {
    int tid_; asm volatile("v_mbcnt_lo_u32_b32 %0, -1, 0\n\tv_mbcnt_hi_u32_b32 %0, -1, %0" : "=v"(tid_)); tid_ += wave_id * 64;
    const int tid = tid_, wid = __builtin_amdgcn_readfirstlane(tid >> 6), lane = tid & 63, wr = wid >> 2, wc = wid & 3, fr = lane & 15, fq = lane >> 4;
    const int K = g.K, nt = K / BK;
    unsigned voffA[2], voffB[2];
#pragma unroll
    for (int i = 0; i < 2; ++i) { int R, C; stage_rc(tid * 16 + i * 8192, R, C); const int Rb = Epi::PERM ? ((R & ~31) + perm32(R & 31)) : R;
        voffA[i] = (unsigned)(R * K + C) * 2u; voffB[i] = (unsigned)(Rb * K + C) * 2u; }
    const size_t kstep = (size_t)(BK * 2);
    const size_t hstep = (size_t)HALF * K * 2;
    const size_t tstep = 2 * hstep;
    const unsigned ldsw = (unsigned)wid * 1024u;
    const int aoff = lds_byte(wr * 64 + fr, fq * 8), boff = lds_byte(wc * 32 + fr, fq * 8);
#define PG8_SA(b, h) (((b) * 2 + (h)) * HTB)
#define PG8_SB(b, h) ((4 + (b) * 2 + (h)) * HTB)
#define PG8_STAGE(bufoff, gbase, voff) do { _Pragma("unroll") for (int _i = 0; _i < 2; ++_i) \
        __builtin_amdgcn_global_load_lds((const unsigned*)((const char*)(gbase) + (voff)[_i]), (PG8_LAS unsigned*)(lds + (bufoff) + ldsw + _i * 8192), 16, 0, 0); } while (0)
#define PG8_LDA(dst, b, h) do { _Pragma("unroll") for (int m = 0; m < 4; ++m) _Pragma("unroll") for (int k = 0; k < 2; ++k) dst[m][k] = *(const PG8_LAS bf16x8*)(lds + PG8_SA(b, h) + aoff + m * 2048 + k * 1024); } while (0)
#define PG8_LDB(dst, b, h) do { _Pragma("unroll") for (int n = 0; n < 2; ++n) _Pragma("unroll") for (int k = 0; k < 2; ++k) dst[n][k] = *(const PG8_LAS bf16x8*)(lds + PG8_SB(b, h) + boff + n * 2048 + k * 1024); } while (0)
#define PG8_MMA(ai, bj, At, Bt) do { __builtin_amdgcn_s_setprio(1); _Pragma("unroll") for (int m = 0; m < 4; ++m) _Pragma("unroll") for (int n = 0; n < 2; ++n) _Pragma("unroll") for (int k = 0; k < 2; ++k) \
        acc[ai][bj][m][n] = __builtin_amdgcn_mfma_f32_16x16x32_bf16(Bt[n][k], At[m][k], acc[ai][bj][m][n], 0, 0, 0); __builtin_amdgcn_s_setprio(0); } while (0)
#define PG8_WAIT_V(n) asm volatile("s_waitcnt vmcnt(" #n ")" ::: "memory")
#define PG8_WAIT_L(n) asm volatile("s_waitcnt lgkmcnt(" #n ")" ::: "memory")
#define PG8_BAR __builtin_amdgcn_s_barrier()
#define PG8_SCHED __builtin_amdgcn_sched_barrier(0)
    Unit cur, nxt; int ui = 0;
    if (!S.next(0, cur)) return;
    f32x4 acc[2][2][4][2];
#pragma unroll
    for (int a = 0; a < 2; ++a)
#pragma unroll
        for (int b = 0; b < 2; ++b)
#pragma unroll
            for (int m = 0; m < 4; ++m)
#pragma unroll
                for (int n = 0; n < 2; ++n) acc[a][b][m][n] = (f32x4){0.f, 0.f, 0.f, 0.f};
    bf16x8 At[4][2], B0[2][2], B1[2][2];
    const char* cA = (const char*)g.A + (size_t)cur.pm * tstep; const char* cB = (const char*)g.Bt + (size_t)cur.pn * tstep;
    S.a_ready(cur);
    if constexpr (SP2) {
        PG8_STAGE(PG8_SB(0, 0), cB, voffB); PG8_STAGE(PG8_SB(0, 1), cB + hstep, voffB); PG8_STAGE(PG8_SA(0, 0), cA, voffA); PG8_STAGE(PG8_SA(0, 1), cA + hstep, voffA);
        if (wr == 1) PG8_BAR;
        PG8_WAIT_V(2); PG8_BAR;
        PG8_STAGE(PG8_SB(1, 0), cB + kstep, voffB); PG8_STAGE(PG8_SA(1, 0), cA + kstep, voffA); PG8_STAGE(PG8_SB(1, 1), cB + hstep + kstep, voffB);
        PG8_WAIT_V(6); PG8_BAR;
    } else {
        PG8_STAGE(PG8_SB(0, 0), cB, voffB); PG8_STAGE(PG8_SA(0, 0), cA, voffA); PG8_STAGE(PG8_SB(0, 1), cB + hstep, voffB); PG8_STAGE(PG8_SA(0, 1), cA + hstep, voffA);
        if (wr == 1) PG8_BAR;
        PG8_WAIT_V(4); PG8_BAR;
        PG8_STAGE(PG8_SB(1, 0), cB + kstep, voffB); PG8_STAGE(PG8_SA(1, 0), cA + kstep, voffA); PG8_STAGE(PG8_SB(1, 1), cB + hstep + kstep, voffB);
        PG8_WAIT_V(6); PG8_BAR;
    }
    for (;;) {
        const bool has_next = S.next(ui + 1, nxt);
        const char* nA = has_next ? (const char*)g.A + (size_t)nxt.pm * tstep : cA; const char* nB = has_next ? (const char*)g.Bt + (size_t)nxt.pn * tstep : cB;
        for (int t = 0; t < nt; t += 2) {
            const bool last = (t == nt - 2);
            const char* a1 = cA + (size_t)(t + 1) * kstep;
            const char* a2 = last ? nA : cA + (size_t)(t + 2) * kstep; const char* b2 = last ? nB : cB + (size_t)(t + 2) * kstep;
            const char* a3 = a2 + kstep; const char* b3 = b2 + kstep;
            if (last && has_next) S.a_ready(nxt);
            if constexpr (SP2) {
            PG8_LDB(B0, 0, 0); PG8_LDB(B1, 0, 1); PG8_SCHED; PG8_LDA(At, 0, 0); PG8_STAGE(PG8_SA(1, 1), a1 + hstep, voffA);
            PG8_WAIT_V(8); PG8_WAIT_L(0); PG8_BAR; PG8_MMA(0, 0, At, B0); PG8_MMA(0, 1, At, B1); PG8_BAR; PG8_SCHED;
            PG8_LDA(At, 0, 1); PG8_STAGE(PG8_SB(0, 0), b2, voffB); PG8_STAGE(PG8_SB(0, 1), b2 + hstep, voffB); PG8_STAGE(PG8_SA(0, 0), a2, voffA);
            PG8_WAIT_V(8); PG8_WAIT_L(0); PG8_BAR; PG8_MMA(1, 0, At, B0); PG8_MMA(1, 1, At, B1); PG8_BAR; PG8_SCHED;
            PG8_LDB(B0, 1, 0); PG8_LDB(B1, 1, 1); PG8_SCHED; PG8_LDA(At, 1, 0); PG8_STAGE(PG8_SA(0, 1), a2 + hstep, voffA);
            PG8_WAIT_V(8); PG8_WAIT_L(0); PG8_BAR; PG8_MMA(0, 0, At, B0); PG8_MMA(0, 1, At, B1); PG8_BAR; PG8_SCHED;
            PG8_LDA(At, 1, 1); PG8_STAGE(PG8_SB(1, 0), b3, voffB); PG8_STAGE(PG8_SB(1, 1), b3 + hstep, voffB); PG8_STAGE(PG8_SA(1, 0), a3, voffA);
            PG8_WAIT_V(8); PG8_WAIT_L(0); PG8_BAR; PG8_MMA(1, 0, At, B0); PG8_MMA(1, 1, At, B1); PG8_BAR; PG8_SCHED;
            } else {
            PG8_LDB(B0, 0, 0); PG8_SCHED; PG8_LDA(At, 0, 0); PG8_STAGE(PG8_SA(1, 1), a1 + hstep, voffA);
            PG8_WAIT_L(8); PG8_BAR; PG8_WAIT_L(0); PG8_MMA(0, 0, At, B0); PG8_BAR; PG8_SCHED;
            PG8_LDB(B1, 0, 1); PG8_STAGE(PG8_SB(0, 0), b2, voffB);
            PG8_BAR; PG8_WAIT_L(0); PG8_MMA(0, 1, At, B1); PG8_BAR;
            PG8_LDA(At, 0, 1); PG8_STAGE(PG8_SA(0, 0), a2, voffA);
            PG8_BAR; PG8_WAIT_L(0); PG8_MMA(1, 0, At, B0); PG8_BAR; PG8_SCHED;
            PG8_STAGE(PG8_SB(0, 1), b2 + hstep, voffB);
            PG8_WAIT_V(6); PG8_BAR; PG8_MMA(1, 1, At, B1); PG8_BAR;
            PG8_LDB(B0, 1, 0); PG8_SCHED; PG8_LDA(At, 1, 0); PG8_STAGE(PG8_SA(0, 1), a2 + hstep, voffA);
            PG8_WAIT_L(8); PG8_BAR; PG8_WAIT_L(0); PG8_MMA(0, 0, At, B0); PG8_BAR; PG8_SCHED;
            PG8_LDB(B1, 1, 1); PG8_STAGE(PG8_SB(1, 0), b3, voffB);
            PG8_BAR; PG8_WAIT_L(0); PG8_MMA(0, 1, At, B1); PG8_BAR;
            PG8_LDA(At, 1, 1); PG8_STAGE(PG8_SA(1, 0), a3, voffA);
            PG8_BAR; PG8_WAIT_L(0); PG8_MMA(1, 0, At, B0); PG8_BAR; PG8_SCHED;
            PG8_STAGE(PG8_SB(1, 1), b3 + hstep, voffB);
            PG8_WAIT_V(6); PG8_BAR; PG8_MMA(1, 1, At, B1); PG8_BAR;
            }
        }
        if constexpr (ALIGN_EPI) { if (wr == 0) PG8_BAR; }
        if constexpr (!Epi::AFTER_DRAIN) { E(acc, cur, wr, wc, fr, fq); S.done(cur); }
        if (!has_next) break;
#pragma unroll
        for (int a = 0; a < 2; ++a)
#pragma unroll
            for (int b = 0; b < 2; ++b)
#pragma unroll
                for (int m = 0; m < 4; ++m)
#pragma unroll
                    for (int n = 0; n < 2; ++n) acc[a][b][m][n] = (f32x4){0.f, 0.f, 0.f, 0.f};
        cur = nxt; cA = nA; cB = nB; ++ui;
        if constexpr (ALIGN_EPI) { if (wr == 1) PG8_BAR; }
    }
    PG8_WAIT_V(0);
    if constexpr (!ALIGN_EPI) { if (wr == 0) PG8_BAR; }
    PG8_BAR;
    if constexpr (Epi::AFTER_DRAIN) { E.fused(acc, cur, wr, wc, fr, fq, lds, wid, lane); S.done(cur); }
#undef PG8_SA
#undef PG8_SB
#undef PG8_STAGE
#undef PG8_LDA
#undef PG8_LDB
#undef PG8_MMA
#undef PG8_WAIT_V
#undef PG8_WAIT_L
#undef PG8_BAR
#undef PG8_SCHED
}
}
#define LAS __attribute__((address_space(3)))
#define XB_TMO      128
#define XB_XCNT(j)  (256  + 64 * (j))
#define XB_XSUB(j)  (1280 + 64 * (j))
#define XB_XGEN(j)  (2304 + 64 * (j))
#define XB_TOP      3328
#define XB_TOPGEN   3392
#define XCD_BAR_WORDS 3456
#define XB_SPIN_CAP (1u << 24)

__device__ __forceinline__ unsigned xb_ld(unsigned* p)              { return __hip_atomic_load(p, __ATOMIC_RELAXED, __HIP_MEMORY_SCOPE_AGENT); }
__device__ __forceinline__ unsigned xb_add(unsigned* p, unsigned v) { return __hip_atomic_fetch_add(p, v, __ATOMIC_RELAXED, __HIP_MEMORY_SCOPE_AGENT); }
__device__ __forceinline__ unsigned xb_xcc_id() { return (unsigned)__builtin_amdgcn_s_getreg((3 << 11) | 20) & 0xFu; }
#define XB_SPIN(cond, bar) do { unsigned _sp = 0; while (cond) { __builtin_amdgcn_s_sleep(1); \
    if ((++_sp & 255u) == 0u) { if (xb_ld(&(bar)[XB_TMO])) break; if (_sp > XB_SPIN_CAP) { atomicAdd(&(bar)[XB_TMO], 1u); break; } } } } while (0)

struct XcdBarrier {
    unsigned* bar; unsigned x; unsigned w0;
    volatile LAS unsigned* st;
};

__device__ __forceinline__ bool xb_lane0() { return __builtin_amdgcn_mbcnt_hi(~0u, __builtin_amdgcn_mbcnt_lo(~0u, 0u)) == 0u; }
__device__ __forceinline__ XcdBarrier xcd_barrier_post(unsigned* bar, volatile LAS unsigned* st, unsigned w0) {
    XcdBarrier b; b.bar = bar; b.x = xb_xcc_id(); b.st = st; b.w0 = w0;
    if (w0 && xb_lane0()) (void)xb_add(&bar[XB_XCNT(b.x)], 1u);
    return b;
}
__device__ __forceinline__ void xcd_barrier_complete(unsigned* bar, unsigned x, unsigned& nloc, unsigned& nx) {
    const unsigned G = gridDim.x * gridDim.y * gridDim.z;
    unsigned sum, cnt, mine, sp = 0u;
    for (;;) {
        sum = 0u; cnt = 0u; mine = 0u;
#pragma unroll
        for (unsigned j = 0; j < 16; ++j) { const unsigned c = xb_ld(&bar[XB_XCNT(j)]); sum += c; cnt += (c > 0u) ? 1u : 0u; mine = (j == x) ? c : mine; }
        if (sum == G) break;
        __builtin_amdgcn_s_sleep(1);
        if ((++sp & 255u) == 0u) { if (xb_ld(&bar[XB_TMO])) break; if (sp > XB_SPIN_CAP) { atomicAdd(&bar[XB_TMO], 1u); break; } }
    }
    nloc = mine > 0u ? mine : 1u; nx = cnt > 0u ? cnt : 1u;
}

__device__ __forceinline__ void xcd_barrier(const XcdBarrier& b) {
    asm volatile("s_waitcnt vmcnt(0)" ::: "memory");
    __syncthreads();
    if (b.w0 && xb_lane0()) {
        unsigned* bar = b.bar;
        __builtin_amdgcn_s_waitcnt(0);
        unsigned nloc = b.st[0], nx = b.st[1];
        if (nloc == 0u) { xcd_barrier_complete(bar, b.x, nloc, nx); b.st[0] = nloc; b.st[1] = nx; }
        const unsigned old = xb_add(&bar[XB_XSUB(b.x)], 1u);
        const unsigned gen = old / nloc;
        if (old + 1u == (gen + 1u) * nloc) {
            __builtin_amdgcn_fence(__ATOMIC_RELEASE, "agent");
            asm volatile("s_waitcnt vmcnt(0)" ::: "memory");
            const unsigned og = xb_add(&bar[XB_TOP], 1u);
            const unsigned tg = og / nx;
            if (og + 1u == (tg + 1u) * nx) xb_add(&bar[XB_TOPGEN], 1u);
            else XB_SPIN(xb_ld(&bar[XB_TOPGEN]) == tg, bar);
            __builtin_amdgcn_fence(__ATOMIC_ACQUIRE, "agent");
            xb_add(&bar[XB_XGEN(b.x)], 1u);
            asm volatile("s_waitcnt vmcnt(0)" ::: "memory");
        } else {
            XB_SPIN(xb_ld(&bar[XB_XGEN(b.x)]) == gen, bar);
            __builtin_amdgcn_fence(__ATOMIC_ACQUIRE, "agent");
            asm volatile("s_waitcnt vmcnt(0)" ::: "memory");
        }
    }
    __syncthreads();
}
#ifndef EN_CH128
#define EN_CH128 1
#endif
#ifndef EN_CH192
#define EN_CH192 1
#endif
#ifndef EN_DN
#define EN_DN 1
#endif
#ifndef EN_GLU
#define EN_GLU 1
#endif
#ifndef EN_GU
#define EN_GU 1
#endif
#ifndef EN_INPROJ
#define EN_INPROJ 1
#endif
#ifndef EN_LN
#define EN_LN 1
#endif
#ifndef EN_MIX
#define EN_MIX 1
#endif
#ifndef EN_MOD
#define EN_MOD 1
#endif
#ifndef EN_OUT
#define EN_OUT 1
#endif
#ifndef EN_PRE
#define EN_PRE 1
#endif
#ifndef EN_PRO
#define EN_PRO 1
#endif
#ifndef EN_S5N
#define EN_S5N 1
#endif

constexpr int DM = 4096, NB = 2, SEQ = 8192, MTOK = NB * SEQ, DEPTH = 4;
constexpr int S5W = 1024;
constexpr int HGW = 1536;
constexpr int GLKW = 768;
constexpr int INW = 11792, INP = 12032, DFF = 11008;
constexpr int OW = 3072;
constexpr int C_U = 0, C_QB = 1024, C_FB = 2560, C_IB = 4096, C_GB = 5632, C_QC = 7168, C_KC = 7936, C_VC = 8704, C_GC = 10240, C_LR = 11776;
constexpr float LN_EPS = 1e-5f;
constexpr float ALPHA = 1.6817928305074290861f;
constexpr float GLA_QSCALE = 0.07216878364870322f;

enum { I_X = 0, I_C, I_WADA, I_BADA, I_TABLE, I_WIN, I_WOUT, I_AREAL, I_AIMAG, I_LOGDT, I_BRE, I_BIM, I_CRE, I_CIM, I_S5D, I_GLUW, I_GLUB,
       I_LBRAW, I_HGG, I_HGB, I_WGATE, I_BGATE, I_GLG, I_WFG, I_WFU, I_WFD, I_LN1G, I_LN1B, I_LN2G, I_LN2B, N_IN };

constexpr size_t MiB = 1u << 20;
constexpr size_t WS_CTL = 0, CTL_ZERO_BYTES = 1 * MiB;
constexpr size_t WS_MOD = 1 * MiB;
constexpr size_t WS_MISC = 2 * MiB;
constexpr size_t WS_CONDPART = 12 * MiB;
constexpr size_t WS_H = 24 * MiB;
constexpr size_t WS_MIXED = WS_H + 128 * MiB;
constexpr size_t WS_Z = WS_MIXED + 128 * MiB;
constexpr size_t WS_O = WS_Z + 32 * MiB;
constexpr size_t WS_DELTA = WS_O;
constexpr size_t WS_P = WS_O + 192 * MiB;
constexpr size_t WS_WT = WS_P + 376 * MiB;
constexpr size_t WT_IN = 0, WT_OUT = 94 * MiB, WT_GU = 126 * MiB, WT_DN = 298 * MiB, WT_GLU = 384 * MiB, WT_LAYER = 386 * MiB;
constexpr size_t WS_HGB = WS_WT + DEPTH * WT_LAYER;
constexpr size_t WS_GLB = WS_HGB + 198 * MiB;
constexpr size_t WS_S5T = WS_GLB + 128 * MiB;
constexpr size_t WS_S5W1 = WS_S5T + 576 * MiB;
constexpr size_t WS_UX = WS_S5W1 + 144 * MiB;
constexpr size_t WS_SLOC = WS_UX + 36 * MiB;
constexpr size_t WS_LAM64 = WS_SLOC + 8 * MiB;
constexpr size_t WS_ST = WS_LAM64 + 1 * MiB;
constexpr size_t WS_END = WS_ST + 45 * MiB;
static_assert((size_t)INP * DM * 2 == 94 * MiB && (size_t)DM * DM * 2 == 32 * MiB && (size_t)2 * DFF * DM * 2 == 172 * MiB && (size_t)DM * DFF * 2 == 86 * MiB, "weight map");
static_assert((size_t)MTOK * INP * 2 == 376 * MiB && (size_t)MTOK * DFF * 2 <= 376 * MiB, "activation map");

constexpr int RING_BYTES = 131072;
constexpr int LDSCTL_OFF = 135168;
constexpr int LDS_BYTES = 147456;

#ifndef LAS
#define LAS __attribute__((address_space(3)))
#endif
typedef unsigned short bf16_t;
typedef float f32x4 __attribute__((ext_vector_type(4)));
typedef float f32x2 __attribute__((ext_vector_type(2)));
typedef unsigned u32x4 __attribute__((ext_vector_type(4)));
typedef unsigned u32x2 __attribute__((ext_vector_type(2)));
#define LDS_WAIT() asm volatile("s_waitcnt lgkmcnt(0)" ::: "memory")
#define VM_WAIT() asm volatile("s_waitcnt vmcnt(0)" ::: "memory")
typedef __bf16 bf16x2_t __attribute__((ext_vector_type(2)));
__device__ __forceinline__ unsigned cvt_pk_bf16(float lo, float hi) { return __builtin_bit_cast(unsigned, __builtin_convertvector((f32x2){lo, hi}, bf16x2_t)); }

__device__ __forceinline__ float bf_lo(unsigned w) { return __uint_as_float(w << 16); }
__device__ __forceinline__ float bf_hi(unsigned w) { return __uint_as_float(w & 0xffff0000u); }
__device__ __forceinline__ float bf2f(bf16_t b) { return __uint_as_float(((unsigned)b) << 16); }
__device__ __forceinline__ float wave_sum(float v) {
#pragma unroll
    for (int o = 1; o < 64; o <<= 1) v += __shfl_xor(v, o);
    return v;
}
__device__ __forceinline__ float sigmoidf_(float x) { return 1.0f / (1.0f + __expf(-x)); }
__device__ __forceinline__ float gelu_tanh(float y) { const float a = 0.7978845608028654f * (y + 0.044715f * y * y * y); const float t = 1.0f - 2.0f / (1.0f + __expf(2.0f * a)); return 0.5f * y * (1.0f + t); }

struct EpiProj {
    static constexpr bool PERM = true, AFTER_DRAIN = false;
    bf16_t* P; bf16_t* UX;
    __device__ __forceinline__ void operator()(const f32x4 (&acc)[2][2][4][2], const pg8::Unit& u, int wr, int wc, int fr, int fq) const {
        const int row0 = u.pm * 256 + wr * 64 + fr, col0 = u.pn * 256 + wc * 32 + 8 * fq;
        const bool s5 = u.pn < 4;
#pragma unroll
        for (int ai = 0; ai < 2; ++ai)
#pragma unroll
            for (int m = 0; m < 4; ++m) { const int row = row0 + ai * 128 + m * 16;
#pragma unroll
                for (int bj = 0; bj < 2; ++bj) { const f32x4 v0 = acc[ai][bj][m][0], v1 = acc[ai][bj][m][1]; const int col = col0 + bj * 128;
                    u32x4 w; w.x = cvt_pk_bf16(v0[0], v0[1]); w.y = cvt_pk_bf16(v0[2], v0[3]); w.z = cvt_pk_bf16(v1[0], v1[1]); w.w = cvt_pk_bf16(v1[2], v1[3]);
                    if (!s5) *(u32x4*)(P + (size_t)row * INP + col) = w;
                    else { bf16_t* ur = UX + (size_t)((col >> 4) * 256 + (row >> 6)) * 1152; *(u32x4*)(ur + (row & 63) * 16 + (col & 15)) = w;
                        if ((row & 63) == 0) { const u32x4 z = (u32x4){0u, 0u, 0u, 0u}; bf16_t* zp = ur + 1024 + ((col & 15) ? 64 : 0);
#pragma unroll
                            for (int i = 0; i < 8; ++i) *(u32x4*)(zp + 8 * i) = z; } } } }
    }
};
struct EpiSwiglu {
    static constexpr bool PERM = true, AFTER_DRAIN = false;
    bf16_t* HID;
    __device__ __forceinline__ void operator()(const f32x4 (&acc)[2][2][4][2], const pg8::Unit& u, int wr, int wc, int fr, int fq) const {
        const int row0 = u.pm * 256 + wr * 64 + fr, col0 = u.pn * 128 + wc * 32 + 8 * fq;
#pragma unroll
        for (int ai = 0; ai < 2; ++ai)
#pragma unroll
            for (int m = 0; m < 4; ++m) { bf16_t* rowp = HID + (size_t)(row0 + ai * 128 + m * 16) * DFF + col0;
                float o[8];
#pragma unroll
                for (int n = 0; n < 2; ++n)
#pragma unroll
                    for (int j = 0; j < 4; ++j) { const float g = acc[ai][0][m][n][j], up = acc[ai][1][m][n][j]; o[n * 4 + j] = g * __builtin_amdgcn_rcpf(1.0f + __expf(-g)) * up; }
                u32x4 w; w.x = cvt_pk_bf16(o[0], o[1]); w.y = cvt_pk_bf16(o[2], o[3]); w.z = cvt_pk_bf16(o[4], o[5]); w.w = cvt_pk_bf16(o[6], o[7]);
                *(u32x4*)rowp = w; }
    }
};
struct EpiGlu {
    static constexpr bool PERM = true, AFTER_DRAIN = false;
    const bf16_t* Z; bf16_t* MIXED; const float* bias;
    __device__ __forceinline__ void operator()(const f32x4 (&acc)[2][2][4][2], const pg8::Unit& u, int wr, int wc, int fr, int fq) const {
        const int row0 = u.pm * 256 + wr * 64 + fr, col0 = u.pn * 256 + wc * 32 + 8 * fq;
#pragma unroll
        for (int bj = 0; bj < 2; ++bj) {
            const f32x4 b0 = *(const f32x4*)(bias + col0 + bj * 128), b1 = *(const f32x4*)(bias + col0 + bj * 128 + 4);
#pragma unroll
            for (int ai = 0; ai < 2; ++ai)
#pragma unroll
                for (int m = 0; m < 4; ++m) { const size_t r = (size_t)(row0 + ai * 128 + m * 16);
                    const u32x4 zz = *(const u32x4*)(Z + r * S5W + col0 + bj * 128);
                    const f32x4 v0 = acc[ai][bj][m][0] + b0, v1 = acc[ai][bj][m][1] + b1;
                    u32x4 w;
                    w.x = cvt_pk_bf16(bf_lo(zz.x) * sigmoidf_(v0[0]), bf_hi(zz.x) * sigmoidf_(v0[1]));
                    w.y = cvt_pk_bf16(bf_lo(zz.y) * sigmoidf_(v0[2]), bf_hi(zz.y) * sigmoidf_(v0[3]));
                    w.z = cvt_pk_bf16(bf_lo(zz.z) * sigmoidf_(v1[0]), bf_hi(zz.z) * sigmoidf_(v1[1]));
                    w.w = cvt_pk_bf16(bf_lo(zz.w) * sigmoidf_(v1[2]), bf_hi(zz.w) * sigmoidf_(v1[3]));
                    *(u32x4*)(MIXED + r * DM + col0 + bj * 128) = w;
                    if (m & 1) asm volatile("" ::: "memory"); }
        }
    }
};
struct EpiDelta {
    static constexpr bool PERM = true, AFTER_DRAIN = false;
    bf16_t* D; const float* gate0;
    __device__ __forceinline__ void operator()(const f32x4 (&acc)[2][2][4][2], const pg8::Unit& u, int wr, int wc, int fr, int fq) const {
        const int row0 = u.pm * 256 + wr * 64 + fr, col0 = u.pn * 256 + wc * 32 + 8 * fq;
        const float* gp = gate0 + (u.pm >= 32 ? 6 * DM : 0) + col0;
        f32x4 g[2][2];
#pragma unroll
        for (int bj = 0; bj < 2; ++bj)
#pragma unroll
            for (int n = 0; n < 2; ++n) g[bj][n] = *(const f32x4*)(gp + bj * 128 + 4 * n) + 1.0f;
#pragma unroll
        for (int ai = 0; ai < 2; ++ai)
#pragma unroll
            for (int m = 0; m < 4; ++m) { bf16_t* rowp = D + (size_t)(row0 + ai * 128 + m * 16) * DM + col0;
#pragma unroll
                for (int bj = 0; bj < 2; ++bj) { const f32x4 v0 = acc[ai][bj][m][0] * g[bj][0], v1 = acc[ai][bj][m][1] * g[bj][1];
                    u32x4 w; w.x = cvt_pk_bf16(v0[0], v0[1]); w.y = cvt_pk_bf16(v0[2], v0[3]); w.z = cvt_pk_bf16(v1[0], v1[1]); w.w = cvt_pk_bf16(v1[2], v1[3]);
                    *(u32x4*)(rowp + bj * 128) = w; } }
    }
};

__device__ __forceinline__ int lane_id_v() { int r; asm volatile("v_mbcnt_lo_u32_b32 %0, -1, 0\n\tv_mbcnt_hi_u32_b32 %0, -1, %0" : "=v"(r)); return r; }
struct Args { const float* in[N_IN]; float* out; unsigned char* ws; int ph_lo, ph_hi; };
struct Ctx {
    volatile LAS unsigned long long* t;
    __device__ __forceinline__ unsigned long long ld(int i) const { const unsigned long long v = t[i];
        return ((unsigned long long)(unsigned)__builtin_amdgcn_readfirstlane((int)(v >> 32)) << 32) | (unsigned long long)(unsigned)__builtin_amdgcn_readfirstlane((int)(unsigned)v); }
    __device__ __forceinline__ const float* in(int i) const { return (const float*)ld(i); }
    __device__ __forceinline__ float* out() const { return (float*)ld(30); }
    __device__ __forceinline__ unsigned char* ws() const { return (unsigned char*)ld(31); }
};

constexpr int S5K = 1152;
constexpr size_t S5_T_LAYER = (size_t)64 * 1024 * S5K * 2, S5_W1_LAYER = (size_t)64 * 256 * S5K * 2;

struct S5Order {
    int G, c, n, sh;
    __device__ __forceinline__ bool next(int i, pg8::Unit& u) const { const int L = i * G + c; if (L >= n) return false; u.pm = L >> sh; u.pn = L; return true; }
    __device__ __forceinline__ void a_ready(const pg8::Unit&) const {}
    __device__ __forceinline__ void done(const pg8::Unit&) const {}
};
struct EpiS5A {
    static constexpr bool PERM = false, AFTER_DRAIN = false;
    float* Sloc;
    __device__ __forceinline__ void operator()(const f32x4 (&acc)[2][2][4][2], const pg8::Unit& u, int wr, int wc, int fr, int fq) const {
        const int row0 = u.pm * 256 + wr * 64 + fr, col0 = wc * 32 + 4 * fq;
#pragma unroll
        for (int ai = 0; ai < 2; ++ai)
#pragma unroll
            for (int m = 0; m < 4; ++m)
#pragma unroll
                for (int n = 0; n < 2; ++n) *(f32x4*)(Sloc + (size_t)(row0 + ai * 128 + m * 16) * 128 + col0 + n * 16) = acc[ai][0][m][n];
    }
};
struct EpiS5C {
    static constexpr bool PERM = true, AFTER_DRAIN = false;
    bf16_t* Z;
    __device__ __forceinline__ void operator()(const f32x4 (&acc)[2][2][4][2], const pg8::Unit& u, int wr, int wc, int fr, int fq) const {
        const int g = u.pm, c0 = wr * 64 + fr, cc0 = (u.pn & 3) * 256 + wc * 32 + 8 * fq;
#pragma unroll
        for (int ai = 0; ai < 2; ++ai)
#pragma unroll
            for (int m = 0; m < 4; ++m) { const int c = c0 + ai * 128 + m * 16;
#pragma unroll
                for (int bj = 0; bj < 2; ++bj) { const int cc = cc0 + bj * 128, t = cc >> 4, h0 = cc & 15;
                    const f32x4 v0 = acc[ai][bj][m][0], v1 = acc[ai][bj][m][1];
                    u32x4 w; w.x = cvt_pk_bf16(gelu_tanh(v0[0]), gelu_tanh(v0[1])); w.y = cvt_pk_bf16(gelu_tanh(v0[2]), gelu_tanh(v0[3]));
                    w.z = cvt_pk_bf16(gelu_tanh(v1[0]), gelu_tanh(v1[1])); w.w = cvt_pk_bf16(gelu_tanh(v1[2]), gelu_tanh(v1[3]));
                    *(u32x4*)(Z + (size_t)(c * 64 + t) * S5W + g * 16 + h0) = w; } }
    }
};
__device__ __forceinline__ void s5_tables_item(const Ctx& a, int lg, LAS unsigned char* lds, int wave, int lane) {
    LAS f32x2* LP = (LAS f32x2*)lds;
    LAS f32x2* BB = (LAS f32x2*)(lds + 33280);
    LAS f32x2* CC = (LAS f32x2*)(lds + 41472);
    LAS float* KT = (LAS float*)(lds + 49664);
    const int tid = wave * 64 + lane, l = lg >> 6, g = lg & 63;
    if (tid < 64) { const int p = tid;
        const double ar = (double)a.in(I_AREAL)[lg * 64 + p], ai = (double)a.in(I_AIMAG)[lg * 64 + p], dt = exp((double)a.in(I_LOGDT)[lg]);
        const double mag = exp(ar * dt), ang = ai * dt, lr = mag * cos(ang), li = mag * sin(ang);
        const double den = ar * ar + ai * ai, nr = lr - 1.0, ni = li, cr = (nr * ar + ni * ai) / den, ci = (ni * ar - nr * ai) / den;
        double pr = 1.0, pi = 0.0;
        for (int tau = 0; tau <= 64; ++tau) { LP[tau * 64 + p] = (f32x2){(float)pr, (float)pi}; const double nr2 = pr * lr - pi * li, ni2 = pr * li + pi * lr; pr = nr2; pi = ni2; }
        for (int h = 0; h < 16; ++h) { const double br = (double)a.in(I_BRE)[((size_t)lg * 64 + p) * 16 + h], bi = (double)a.in(I_BIM)[((size_t)lg * 64 + p) * 16 + h];
            BB[p * 16 + h] = (f32x2){(float)(cr * br - ci * bi), (float)(cr * bi + ci * br)}; }
    }
    for (int e = tid; e < 1024; e += 512) { const int h = e >> 6, p = e & 63; CC[e] = (f32x2){a.in(I_CRE)[((size_t)lg * 16 + h) * 64 + p], a.in(I_CIM)[((size_t)lg * 16 + h) * 64 + p]}; }
    __syncthreads();
    if (tid < 64) *(f32x2*)((float*)(a.ws() + WS_LAM64) + ((size_t)lg * 64 + tid) * 2) = LP[64 * 64 + tid];
    for (int e = tid; e < 64 * 256; e += 512) { const int tau = e >> 8, h = (e >> 4) & 15, hp = e & 15; float s = 0.f;
#pragma unroll 8
        for (int p = 0; p < 64; ++p) { const f32x2 c = CC[h * 64 + p], lm = LP[tau * 64 + p], b = BB[p * 16 + hp];
            const float xr = c.x * lm.x - c.y * lm.y, xi = c.x * lm.y + c.y * lm.x; s += xr * b.x - xi * b.y; }
        if (tau == 0 && h == hp) s += a.in(I_S5D)[l * S5W + g * 16 + h];
        KT[e] = s; }
    __syncthreads();
    bf16_t* T = (bf16_t*)(a.ws() + WS_S5T + (size_t)l * S5_T_LAYER) + (size_t)g * 1024 * S5K;
    for (int pc = tid; pc < 1024 * 144; pc += 512) { const int n = pc / 144, j = pc % 144, t = n >> 4, h = n & 15; float v[8];
        if (j < 128) { const int s = j >> 1, hp0 = (j & 1) * 8;
            if (s > t) {
#pragma unroll
                for (int i = 0; i < 8; ++i) v[i] = 0.f;
            } else { const LAS float* kp = KT + (t - s) * 256 + h * 16 + hp0; const f32x4 k0 = *(const LAS f32x4*)kp, k1 = *(const LAS f32x4*)(kp + 4);
                v[0] = k0[0]; v[1] = k0[1]; v[2] = k0[2]; v[3] = k0[3]; v[4] = k1[0]; v[5] = k1[1]; v[6] = k1[2]; v[7] = k1[3]; }
        } else { const int p0 = (j - 128) * 4;
#pragma unroll
            for (int i = 0; i < 4; ++i) { const f32x2 c = CC[h * 64 + p0 + i], lm = LP[(t + 1) * 64 + p0 + i]; v[2 * i] = c.x * lm.x - c.y * lm.y; v[2 * i + 1] = -(c.x * lm.y + c.y * lm.x); } }
        *(u32x4*)(T + (size_t)n * S5K + j * 8) = (u32x4){cvt_pk_bf16(v[0], v[1]), cvt_pk_bf16(v[2], v[3]), cvt_pk_bf16(v[4], v[5]), cvt_pk_bf16(v[6], v[7])}; }
    bf16_t* W1 = (bf16_t*)(a.ws() + WS_S5W1 + (size_t)l * S5_W1_LAYER) + (size_t)g * 256 * S5K;
    for (int pc = tid; pc < 256 * 144; pc += 512) { const int n = pc / 144, j = pc % 144; float v[8];
#pragma unroll
        for (int i = 0; i < 8; ++i) v[i] = 0.f;
        if (n < 128 && j < 128) { const int p = n >> 1, ri = n & 1, s = j >> 1, hp0 = (j & 1) * 8; const f32x2 lm = LP[(63 - s) * 64 + p];
#pragma unroll
            for (int i = 0; i < 8; ++i) { const f32x2 b = BB[p * 16 + hp0 + i]; v[i] = ri ? (lm.x * b.y + lm.y * b.x) : (lm.x * b.x - lm.y * b.y); } }
        *(u32x4*)(W1 + (size_t)n * S5K + j * 8) = (u32x4){cvt_pk_bf16(v[0], v[1]), cvt_pk_bf16(v[2], v[3]), cvt_pk_bf16(v[4], v[5]), cvt_pk_bf16(v[6], v[7])}; }
    __syncthreads();
}
__device__ __forceinline__ void s5_scan_item(const Ctx& a, int l, int item, int wave, int lane) {
    const int idx = item * 512 + wave * 64 + lane, g = idx >> 7, b = (idx >> 6) & 1, p = idx & 63;
    const f32x2 lam = *(const f32x2*)((const float*)(a.ws() + WS_LAM64) + ((size_t)(l * 64 + g) * 64 + p) * 2);
    const float* sl = (const float*)(a.ws() + WS_SLOC) + ((size_t)(g * 256 + b * 128)) * 128 + 2 * p;
    bf16_t* ux = (bf16_t*)(a.ws() + WS_UX) + ((size_t)(g * 256 + b * 128)) * S5K + 1024 + 2 * p;
    float xr = 0.f, xi = 0.f;
    for (int c0 = 0; c0 < 128; c0 += 8) { f32x2 s[8];
#pragma unroll
        for (int i = 0; i < 8; ++i) s[i] = *(const f32x2*)(sl + (size_t)(c0 + i) * 128);
#pragma unroll
        for (int i = 0; i < 8; ++i) { *(unsigned*)(ux + (size_t)(c0 + i) * S5K) = cvt_pk_bf16(xr, xi);
            const float nr = lam.x * xr - lam.y * xi + s[i].x, ni = lam.x * xi + lam.y * xr + s[i].y; xr = nr; xi = ni; } }
}

__device__ __forceinline__ void transpose_item(const float* W, int N, int k0, int n0, bf16_t* WT, int drow0, int Kd, LAS float* scr, int lane) {
    const int nl = 4 * (lane & 15), kq = lane >> 4;
    const bool valid = (n0 + nl) < N;
    f32x4 v[16];
#pragma unroll
    for (int i = 0; i < 16; ++i) { const int k = 4 * i + kq; v[i] = valid ? *(const f32x4*)(W + (size_t)(k0 + k) * N + n0 + nl) : (f32x4){0.f, 0.f, 0.f, 0.f}; }
#pragma unroll
    for (int i = 0; i < 16; ++i) { const int k = 4 * i + kq; LAS float* s = scr + k * 65 + nl; s[0] = v[i][0]; s[1] = v[i][1]; s[2] = v[i][2]; s[3] = v[i][3]; }
    LDS_WAIT();
    const int c = lane & 7;
#pragma unroll
    for (int j = 0; j < 8; ++j) { const int n = (lane >> 3) + 8 * j; const LAS float* s = scr + (8 * c) * 65 + n;
        u32x4 o; o.x = cvt_pk_bf16(s[0], s[65]); o.y = cvt_pk_bf16(s[130], s[195]); o.z = cvt_pk_bf16(s[260], s[325]); o.w = cvt_pk_bf16(s[390], s[455]);
        *(u32x4*)(WT + (size_t)(drow0 + n) * Kd + k0 + 8 * c) = o; }
    LDS_WAIT();
}
constexpr int NIT_IN = 64 * 188, NIT_OUT = 64 * 64, NIT_G = 64 * 172, NIT_DN = 172 * 64, NIT_GLU = 16 * 16;
constexpr int NIT_LAYER = NIT_IN + NIT_OUT + 2 * NIT_G + NIT_DN + NIT_GLU;
constexpr int NIT_TR = DEPTH * NIT_LAYER, NIT_COND = 64 * 96;

__device__ __forceinline__ void phase_prologue(const Ctx& a, LAS unsigned char* lds, int wave, int lane) {
    LAS float* scr = (LAS float*)(lds + wave * 16640);
    const int gw = blockIdx.x * 8 + wave, NGW = gridDim.x * 8;
    for (int it = gw; it < NIT_TR + NIT_COND; it += NGW) {
        if (it < NIT_TR) {
            const int l = it / NIT_LAYER; int r = it % NIT_LAYER;
            unsigned char* wt = a.ws() + WS_WT + (size_t)l * WT_LAYER;
            if (r < NIT_IN) { const int kb = r / 188, nb = r % 188; transpose_item(a.in(I_WIN) + (size_t)l * DM * INW, INW, 64 * kb, 64 * nb, (bf16_t*)(wt + WT_IN), 64 * nb, DM, scr, lane); continue; } r -= NIT_IN;
            if (r < NIT_OUT) { const int kb = r / 64, nb = r % 64; transpose_item(a.in(I_WOUT) + (size_t)l * DM * DM, DM, 64 * kb, 64 * nb, (bf16_t*)(wt + WT_OUT), 64 * nb, DM, scr, lane); continue; } r -= NIT_OUT;
            if (r < NIT_G) { const int kb = r / 172, nb = r % 172, n0 = 64 * nb; transpose_item(a.in(I_WFG) + (size_t)l * DM * DFF, DFF, 64 * kb, n0, (bf16_t*)(wt + WT_GU), 256 * (n0 / 128) + (n0 % 128), DM, scr, lane); continue; } r -= NIT_G;
            if (r < NIT_G) { const int kb = r / 172, nb = r % 172, n0 = 64 * nb; transpose_item(a.in(I_WFU) + (size_t)l * DM * DFF, DFF, 64 * kb, n0, (bf16_t*)(wt + WT_GU), 256 * (n0 / 128) + 128 + (n0 % 128), DM, scr, lane); continue; } r -= NIT_G;
            if (r < NIT_DN) { const int kb = r / 64, nb = r % 64; transpose_item(a.in(I_WFD) + (size_t)l * DFF * DM, DM, 64 * kb, 64 * nb, (bf16_t*)(wt + WT_DN), 64 * nb, DFF, scr, lane); continue; } r -= NIT_DN;
            { const int kb = r / 16, nb = r % 16; transpose_item(a.in(I_GLUW) + (size_t)l * S5W * S5W, S5W, 64 * kb, 64 * nb, (bf16_t*)(wt + WT_GLU), 64 * nb, S5W, scr, lane); }
        } else {
            const int item = it - NIT_TR, kb = item / 96, jb = item % 96, k0 = 64 * kb, j0 = 256 * jb + 4 * lane;
            const float* c = a.in(I_C);
            float c0 = c[k0 + lane], c1 = c[DM + k0 + lane];
            c0 = c0 / (1.0f + expf(-c0)); c1 = c1 / (1.0f + expf(-c1));
            f32x4 a0 = (f32x4){0.f, 0.f, 0.f, 0.f}, a1 = a0;
            const float* w = a.in(I_WADA) + (size_t)k0 * (6 * DM) + j0;
#pragma unroll 8
            for (int kk = 0; kk < 64; ++kk) { const f32x4 wv = *(const f32x4*)(w + (size_t)kk * (6 * DM));
                const float s0 = __int_as_float(__builtin_amdgcn_readlane(__float_as_int(c0), kk)), s1 = __int_as_float(__builtin_amdgcn_readlane(__float_as_int(c1), kk));
                a0 += wv * s0; a1 += wv * s1; }
            float* cp = (float*)(a.ws() + WS_CONDPART);
            *(f32x4*)(cp + (size_t)(kb * 2 + 0) * (6 * DM) + j0) = a0;
            *(f32x4*)(cp + (size_t)(kb * 2 + 1) * (6 * DM) + j0) = a1;
        }
    }
    __syncthreads();
    for (int lg = blockIdx.x; lg < DEPTH * 64; lg += gridDim.x) s5_tables_item(a, lg, lds, wave, lane);
}
__device__ __forceinline__ void phase_mod(const Ctx& a, int wave, int lane) {
    const int gt = blockIdx.x * 512 + wave * 64 + lane, NT = gridDim.x * 512;
    const float* cp = (const float*)(a.ws() + WS_CONDPART);
    float* mod = (float*)(a.ws() + WS_MOD); float* misc = (float*)(a.ws() + WS_MISC);
    for (int idx = gt; idx < NB * 6 * DM; idx += NT) {
        const int b = idx / (6 * DM), j = idx % (6 * DM);
        float s = a.in(I_BADA)[j];
        for (int kb = 0; kb < 64; ++kb) s += cp[(size_t)(kb * 2 + b) * (6 * DM) + j];
        for (int l = 0; l < DEPTH; ++l) mod[(size_t)((l * 2 + b) * 6) * DM + j] = s + a.in(I_TABLE)[(size_t)l * 6 * DM + j];
    }
    for (int idx = gt; idx < DM; idx += NT) { misc[idx] = 1.0f; misc[DM + idx] = 0.0f; }
    for (int idx = gt; idx < HGW; idx += NT) {
        const float* raw = a.in(I_LBRAW); float r[DEPTH], mx = -3.0e38f;
#pragma unroll
        for (int l = 0; l < DEPTH; ++l) { r[l] = raw[l * HGW + idx]; mx = fmaxf(mx, r[l]); }
        float e[DEPTH], sum = 0.f;
#pragma unroll
        for (int l = 0; l < DEPTH; ++l) { e[l] = expf(r[l] - mx); sum += e[l]; }
        float cum = 0.f;
#pragma unroll
        for (int l = 0; l < DEPTH; ++l) { misc[2 * DM + l * HGW + idx] = cum; if (l + 1 < DEPTH) cum += e[l + 1] / sum; }
    }
}

__device__ __forceinline__ void phase_h0(const float* x, const float* modp, bf16_t* H, int wave, int lane) {
    for (int blk = blockIdx.x; blk < MTOK / 64; blk += gridDim.x) {
        const int r0 = blk * 64, b = (r0 >= SEQ) ? 1 : 0;
        f32x4 A[2], B[2];
#pragma unroll
        for (int jj = 0; jj < 2; ++jj) { const int c = 512 * wave + 256 * jj + 4 * lane; A[jj] = *(const f32x4*)(modp + (size_t)(b * 6 + 1) * DM + c) + 1.0f; B[jj] = *(const f32x4*)(modp + (size_t)(b * 6 + 0) * DM + c); }
#pragma unroll 8
        for (int rl = 0; rl < 64; ++rl) { const size_t off = (size_t)(r0 + rl) * DM + 512 * wave + 4 * lane;
#pragma unroll
            for (int jj = 0; jj < 2; ++jj) { const f32x4 v = *(const f32x4*)(x + off + 256 * jj), y = v * A[jj] + B[jj];
                u32x2 w; w.x = cvt_pk_bf16(y[0], y[1]); w.y = cvt_pk_bf16(y[2], y[3]); *(u32x2*)(H + off + 256 * jj) = w; } }
    }
}
template <bool WITH_H>
__device__ __forceinline__ void phase_lnres(const float* xprev, const bf16_t* delta, float* xout, const float* lng, const float* lnb, const float* modp, int i_shift, int i_scale, bf16_t* H,
                                            LAS unsigned char* lds, int wave, int lane) {
    LAS f32x2* red = (LAS f32x2*)lds;
    for (int blk = blockIdx.x; blk < MTOK / 64; blk += gridDim.x) {
        const int r0 = blk * 64, b = (r0 >= SEQ) ? 1 : 0;
        f32x4 G[2], Bt[2], A[2], B[2];
#pragma unroll
        for (int jj = 0; jj < 2; ++jj) { const int c = 512 * wave + 256 * jj + 4 * lane; G[jj] = *(const f32x4*)(lng + c); Bt[jj] = *(const f32x4*)(lnb + c);
            if (WITH_H) { A[jj] = *(const f32x4*)(modp + (size_t)(b * 6 + i_scale) * DM + c) + 1.0f; B[jj] = *(const f32x4*)(modp + (size_t)(b * 6 + i_shift) * DM + c); } }
        for (int it = 0; it < 8; ++it) {
            const size_t off0 = (size_t)(r0 + it * 8) * DM + 512 * wave + 4 * lane;
            f32x4 v[8][2]; u32x2 dl[8][2];
#pragma unroll
            for (int r = 0; r < 8; ++r)
#pragma unroll
                for (int jj = 0; jj < 2; ++jj) { v[r][jj] = *(const f32x4*)(xprev + off0 + (size_t)r * DM + 256 * jj); dl[r][jj] = *(const u32x2*)(delta + off0 + (size_t)r * DM + 256 * jj); }
            LAS f32x2* rb = red + (it & 1) * 64;
#pragma unroll
            for (int r = 0; r < 8; ++r) { float s1 = 0.f, s2 = 0.f;
#pragma unroll
                for (int jj = 0; jj < 2; ++jj) { const f32x4 d = (f32x4){bf_lo(dl[r][jj].x), bf_hi(dl[r][jj].x), bf_lo(dl[r][jj].y), bf_hi(dl[r][jj].y)}; const f32x4 y = v[r][jj] * ALPHA + d; v[r][jj] = y;
                    s1 += (y[0] + y[1]) + (y[2] + y[3]); s2 += (y[0] * y[0] + y[1] * y[1]) + (y[2] * y[2] + y[3] * y[3]); }
                s1 = wave_sum(s1); s2 = wave_sum(s2);
                if (lane == 0) rb[r * 8 + wave] = (f32x2){s1, s2}; }
            __syncthreads();
#pragma unroll
            for (int r = 0; r < 8; ++r) { float s1 = 0.f, s2 = 0.f;
#pragma unroll
                for (int w = 0; w < 8; ++w) { const f32x2 p = rb[r * 8 + w]; s1 += p.x; s2 += p.y; }
                const float mu = s1 * (1.0f / DM), rs = 1.0f / sqrtf(fmaxf(s2 * (1.0f / DM) - mu * mu, 0.f) + LN_EPS);
#pragma unroll
                for (int jj = 0; jj < 2; ++jj) { const f32x4 x = ((v[r][jj] - mu) * rs) * G[jj] + Bt[jj];
                    *(f32x4*)(xout + off0 + (size_t)r * DM + 256 * jj) = x;
                    if (WITH_H) { const f32x4 y = x * A[jj] + B[jj]; u32x2 w; w.x = cvt_pk_bf16(y[0], y[1]); w.y = cvt_pk_bf16(y[2], y[3]); *(u32x2*)(H + off0 + (size_t)r * DM + 256 * jj) = w; } } }
        }
        __syncthreads();
    }
}

typedef short bf16x8 __attribute__((ext_vector_type(8)));
typedef short bf16x4 __attribute__((ext_vector_type(4)));
constexpr int HG_BLK = 16896, HG_OQ = 0, HG_OK = 4096, HG_OKT = 8192, HG_OVT = 12288, HG_ODL = 16384;
constexpr int GL_BLK = 32768, GL_OQ = 0, GL_OK = 6400, GL_OKT = 12800, GL_ODL = 18944, GL_SHARED = 20480, GL_OVT = 20480;
constexpr int NSUB = SEQ / 16;

__device__ __forceinline__ unsigned short f2bf1(float x) { return (unsigned short)(cvt_pk_bf16(x, x) & 0xffffu); }

__device__ __forceinline__ void pre_finish(const float (&qq)[16], const float (&kk)[16], float (&g)[16], unsigned char* blk, int oq, int ok, int okt, int odl, int rowb, int d, bool swz) {
    float b = 0.f;
#pragma unroll
    for (int j = 0; j < 16; ++j) { b += g[j]; g[j] = b; }
    const float bl = b;
    unsigned kt[8];
#pragma unroll
    for (int j = 0; j < 16; j += 2) {
        float kv[2];
#pragma unroll
        for (int jj = 0; jj < 2; ++jj) { const int t = j + jj; const float bj = g[t];
            const int off = t * rowb + (swz ? ((2 * d) ^ (t << 4)) : 2 * d);
            const float qv = qq[t] * __expf(bj), kc = kk[t] * __expf(fminf(-bj, 80.f));
            const float qn = __int_as_float(__builtin_amdgcn_mov_dpp(__float_as_int(qv), 0xB1, 0xF, 0xF, true)), kn = __int_as_float(__builtin_amdgcn_mov_dpp(__float_as_int(kc), 0xB1, 0xF, 0xF, true));
            if ((d & 1) == 0) { *(unsigned*)(blk + oq + off) = cvt_pk_bf16(qv, qn); *(unsigned*)(blk + ok + off) = cvt_pk_bf16(kc, kn); }
            kv[jj] = kk[t] * __expf(bl - bj); }
        kt[j >> 1] = cvt_pk_bf16(kv[0], kv[1]); }
    *(u32x4*)(blk + okt + d * 32) = (u32x4){kt[0], kt[1], kt[2], kt[3]};
    *(u32x4*)(blk + okt + d * 32 + 16) = (u32x4){kt[4], kt[5], kt[6], kt[7]};
    *(float*)(blk + odl + d * 4) = __expf(bl);
}
__device__ __forceinline__ void phase_pre(const Ctx& a, int l, int wave, int lane) {
    const bf16_t* P = (const bf16_t*)(a.ws() + WS_P);
    int tid = wave * 64 + lane;
    const bool bal = gridDim.x == 256;
    const int t_lo = bal ? (blockIdx.x < 64 ? 26 * (int)blockIdx.x : 1664 + 34 * ((int)blockIdx.x - 64)) : (int)blockIdx.x;
    const int t_hi = bal ? t_lo + (blockIdx.x < 64 ? 26 : 34) : NB * NSUB * 8, t_st = bal ? 1 : (int)gridDim.x;
    for (int task = t_lo; task < t_hi; task += t_st) {
        asm volatile("" : "+v"(tid));
        const int kind = bal ? (task & 7) : ((task + (task >> 8)) & 7), bsc = task >> 3, b = bsc / NSUB, sc = bsc % NSUB;
        const size_t row0 = (size_t)b * SEQ + sc * 16;
        if (kind < 3) {
            const int ch = kind * 512 + tid, h = ch >> 7, d = ch & 127;
            const float lb = ((const float*)(a.ws() + WS_MISC))[2 * DM + l * HGW + ch];
            unsigned char* blk = a.ws() + WS_HGB + ((size_t)(b * 12 + h) * NSUB + sc) * HG_BLK;
            float g[16], qq[16], kk[16]; unsigned vv[8];
#pragma unroll
            for (int j = 0; j < 16; ++j) { const bf16_t* prow = P + (row0 + j) * INP;
                const float qin = fmaxf(bf2f(prow[C_QB + ch]), -80.f), fin = fminf(fmaxf(bf2f(prow[C_FB + ch]), -80.f), 80.f);
                const unsigned short v = prow[C_IB + ch]; if (j & 1) vv[j >> 1] |= ((unsigned)v) << 16; else vv[j >> 1] = v;
                const float e = __expf(-fin), sg = __builtin_amdgcn_rcpf(1.0f + e);
                const float f = lb + (1.0f - lb) * sg;
                g[j] = fmaxf(__logf(f), -100.f); kk[j] = (1.0f - lb) * (e * sg); qq[j] = qin * __builtin_amdgcn_rcpf(1.0f + __expf(-qin)); }
            *(u32x4*)(blk + HG_OVT + d * 32) = (u32x4){vv[0], vv[1], vv[2], vv[3]};
            *(u32x4*)(blk + HG_OVT + d * 32 + 16) = (u32x4){vv[4], vv[5], vv[6], vv[7]};
            pre_finish(qq, kk, g, blk, HG_OQ, HG_OK, HG_OKT, HG_ODL, 256, d, true);
        } else if (kind < 5) {
            if (tid < 384) {
                const int ch = (kind - 3) * 384 + tid, h = ch / 192, d = ch % 192;
                unsigned char* blk = a.ws() + WS_GLB + ((size_t)(b * 4 + h) * NSUB + sc) * GL_BLK;
                float wg[16];
#pragma unroll
                for (int r = 0; r < 16; ++r) wg[r] = a.in(I_WGATE)[((size_t)l * 16 + r) * GLKW + ch];
                const float bgv = a.in(I_BGATE)[l * GLKW + ch];
                float g[16], qq[16], kk[16];
#pragma unroll
                for (int j = 0; j < 16; ++j) { const bf16_t* prow = P + (row0 + j) * INP;
                    const u32x4 l0 = *(const u32x4*)(prow + C_LR), l1 = *(const u32x4*)(prow + C_LR + 8);
                    float x = bgv;
                    x += bf_lo(l0.x) * wg[0] + bf_hi(l0.x) * wg[1] + bf_lo(l0.y) * wg[2] + bf_hi(l0.y) * wg[3] + bf_lo(l0.z) * wg[4] + bf_hi(l0.z) * wg[5] + bf_lo(l0.w) * wg[6] + bf_hi(l0.w) * wg[7];
                    x += bf_lo(l1.x) * wg[8] + bf_hi(l1.x) * wg[9] + bf_lo(l1.y) * wg[10] + bf_hi(l1.y) * wg[11] + bf_lo(l1.z) * wg[12] + bf_hi(l1.z) * wg[13] + bf_lo(l1.w) * wg[14] + bf_hi(l1.w) * wg[15];
                    g[j] = (fminf(x, 0.f) - __logf(1.0f + __expf(-fabsf(x)))) * 0.0625f;
                    qq[j] = bf2f(prow[C_QC + ch]) * GLA_QSCALE; kk[j] = bf2f(prow[C_KC + ch]); }
                pre_finish(qq, kk, g, blk, GL_OQ, GL_OK, GL_OKT, GL_ODL, 400, d, false);
            }
        } else {
            const int ch = (kind - 5) * 512 + tid, h = ch / 384, e = ch % 384;
            unsigned char* blk = a.ws() + WS_GLB + ((size_t)(b * 4 + h) * NSUB + sc) * GL_BLK;
            unsigned vv[8];
#pragma unroll
            for (int j = 0; j < 16; ++j) { const unsigned short v = P[(row0 + j) * INP + C_VC + ch]; if (j & 1) vv[j >> 1] |= ((unsigned)v) << 16; else vv[j >> 1] = v; }
            *(u32x4*)(blk + GL_OVT + e * 32) = (u32x4){vv[0], vv[1], vv[2], vv[3]};
            *(u32x4*)(blk + GL_OVT + e * 32 + 16) = (u32x4){vv[4], vv[5], vv[6], vv[7]};
        }
    }
}

template <int DK, int MODE>
__device__ __forceinline__ void chain_sub(const LAS unsigned char* sb, f32x4 (&S)[DK / 16], float* op, int wave, int n, int q) {
    constexpr bool IS_GLA = (DK == 192);
    constexpr int NKS = DK / 32, NMB = DK / 16, ROWB = IS_GLA ? 400 : 256;
    constexpr int OQ = 0, OK = IS_GLA ? GL_OK : HG_OK, OKT = IS_GLA ? GL_OKT : HG_OKT, OVT = IS_GLA ? GL_OVT : HG_OVT, ODL = IS_GLA ? GL_ODL : HG_ODL;
    const u32x2 vfr = *(const LAS u32x2*)(sb + OVT + (16 * wave + n) * 32 + 8 * q);
    const bf16x8 vf8 = __builtin_bit_cast(bf16x8, (u32x4){vfr.x, vfr.y, 0u, 0u});
    if (MODE == 1) {
        bf16x8 qf[NKS], kf[NKS];
#pragma unroll
        for (int ks = 0; ks < NKS; ++ks) { const int c0 = 2 * (32 * ks + 4 * q), c1 = c0 + 32;
            const int o0 = n * ROWB + (IS_GLA ? c0 : (c0 ^ (n << 4))), o1 = n * ROWB + (IS_GLA ? c1 : (c1 ^ (n << 4)));
            const u32x2 ql = *(const LAS u32x2*)(sb + OQ + o0), qh = *(const LAS u32x2*)(sb + OQ + o1), kl = *(const LAS u32x2*)(sb + OK + o0), kh = *(const LAS u32x2*)(sb + OK + o1);
            qf[ks] = __builtin_bit_cast(bf16x8, (u32x4){ql.x, ql.y, qh.x, qh.y}); kf[ks] = __builtin_bit_cast(bf16x8, (u32x4){kl.x, kl.y, kh.x, kh.y}); }
        f32x4 ao = (f32x4){0.f, 0.f, 0.f, 0.f}, ap = ao, ao1 = ao, ap1 = ao;
#pragma unroll
        for (int ks = 0; ks < NKS; ++ks) {
            const bf16x8 sbf = __builtin_bit_cast(bf16x8, (u32x4){cvt_pk_bf16(S[2 * ks][0], S[2 * ks][1]), cvt_pk_bf16(S[2 * ks][2], S[2 * ks][3]), cvt_pk_bf16(S[2 * ks + 1][0], S[2 * ks + 1][1]), cvt_pk_bf16(S[2 * ks + 1][2], S[2 * ks + 1][3])});
            if (ks & 1) { ao1 = __builtin_amdgcn_mfma_f32_16x16x32_bf16(qf[ks], sbf, ao1, 0, 0, 0); ap1 = __builtin_amdgcn_mfma_f32_16x16x32_bf16(kf[ks], qf[ks], ap1, 0, 0, 0); }
            else { ao = __builtin_amdgcn_mfma_f32_16x16x32_bf16(qf[ks], sbf, ao, 0, 0, 0); ap = __builtin_amdgcn_mfma_f32_16x16x32_bf16(kf[ks], qf[ks], ap, 0, 0, 0); } }
        ao = ao + ao1; ap = ap + ap1;
#pragma unroll
        for (int r = 0; r < 4; ++r) if (4 * q + r > n) ap[r] = 0.f;
        const bf16x8 pa8 = __builtin_bit_cast(bf16x8, (u32x4){cvt_pk_bf16(ap[0], ap[1]), cvt_pk_bf16(ap[2], ap[3]), 0u, 0u});
        ao = __builtin_amdgcn_mfma_f32_16x16x32_bf16(pa8, vf8, ao, 0, 0, 0);
#pragma unroll
        for (int r = 0; r < 4; ++r) op[(size_t)(4 * q + r) * OW] = ao[r];
    }
#pragma unroll
    for (int mb = 0; mb < NMB; ++mb) {
        const f32x4 dl = *(const LAS f32x4*)(sb + ODL + (16 * mb + 4 * q) * 4);
        const u32x2 ktr = *(const LAS u32x2*)(sb + OKT + (16 * mb + n) * 32 + 8 * q);
        S[mb] = __builtin_amdgcn_mfma_f32_16x16x32_bf16(__builtin_bit_cast(bf16x8, (u32x4){ktr.x, ktr.y, 0u, 0u}), vf8, S[mb] * dl, 0, 0, 0); }
}
constexpr size_t ST_REC = 98304;
constexpr int NSEG_HG = 4, NSEG_GL = 6, NSEG_MAX = 6;
__device__ __forceinline__ int seg_u0(bool gla, int s) { return gla ? (s <= 2 ? 44 * s : 88 + 42 * (s - 2)) : 64 * s; }
__device__ __forceinline__ int seg_nu(bool gla, int s) { return gla ? (s < 2 ? 44 : 42) : 64; }
template <int DK, int MODE>
__device__ __forceinline__ void chain_item(const unsigned char* blk0, int vt_off, float* op0, unsigned char* st, int seg, int nunits, LAS unsigned char* lds, int wave, int lane) {
    asm volatile("" : "+v"(lane), "+s"(wave));
    constexpr bool IS_GLA = (DK == 192);
    constexpr int BLK = IS_GLA ? GL_BLK : HG_BLK, SUBB = IS_GLA ? GL_SHARED + 4096 : HG_BLK, NMB = DK / 16;
    constexpr int SH0 = MODE == 1 ? 0 : (IS_GLA ? GL_OKT : HG_OKT);
    constexpr int SH_PIECES = (MODE == 1 ? (IS_GLA ? GL_SHARED : HG_OVT) : (IS_GLA ? GL_ODL + 768 - GL_OKT : 4096)) / 16;
    constexpr int T_PIECES = IS_GLA ? 256 : (4096 + 512) / 16;
    constexpr int T_LDS = IS_GLA ? GL_OVT : HG_OVT;
    constexpr int PIECES = SH_PIECES + T_PIECES, UNITB = 2 * SUBB, NP = (2 * PIECES + 511) / 512;
    const int tid = wave * 64 + lane, n = lane & 15, q = lane >> 4;
    f32x4 S[NMB]; float dacc = 1.0f;
    constexpr int ODL_ = IS_GLA ? GL_ODL : HG_ODL;
#pragma unroll
    for (int mb = 0; mb < NMB; ++mb) S[mb] = (f32x4){0.f, 0.f, 0.f, 0.f};
    if (MODE == 1) {
        for (int s = 0; s < seg; ++s) { const unsigned char* rec = st + (size_t)s * 2 * ST_REC + (size_t)(wave * 64 + lane) * 16;
#pragma unroll
            for (int mb = 0; mb < NMB; ++mb) { const f32x4 h = *(const f32x4*)(rec + (size_t)mb * 8192), d = *(const f32x4*)(st + (size_t)s * 2 * ST_REC + ST_REC + (16 * mb + 4 * q) * 4); S[mb] = S[mb] * d + h; } }
    }
    u32x4 stgA[NP], stgB[NP];
#define CH_SRC(u, p_) (blk0 + (size_t)((u) * 2 + (p_) / PIECES) * BLK + (((p_) % PIECES) < SH_PIECES ? SH0 + ((p_) % PIECES) * 16 : (IS_GLA ? vt_off : HG_OVT) + (((p_) % PIECES) - SH_PIECES) * 16))
#define CH_DST(p_) (((p_) / PIECES) * SUBB + (((p_) % PIECES) < SH_PIECES ? SH0 + ((p_) % PIECES) * 16 : T_LDS + (((p_) % PIECES) - SH_PIECES) * 16))
#define CH_LOAD(stg, u) do { _Pragma("unroll") for (int r_ = 0; r_ < NP; ++r_) { const int p_ = r_ * 512 + tid; const bool ok_ = (NP * 512 == 2 * PIECES) || p_ < 2 * PIECES; const int pc_ = ok_ ? p_ : 0; stg[r_] = *(const u32x4*)CH_SRC(u, pc_); } } while (0)
#define CH_STORE(stg, buf) do { _Pragma("unroll") for (int r_ = 0; r_ < NP; ++r_) { const int p_ = r_ * 512 + tid; const bool ok_ = (NP * 512 == 2 * PIECES) || p_ < 2 * PIECES; const int pc_ = ok_ ? p_ : 0; \
        const int d_ = ok_ ? (buf) * UNITB + CH_DST(pc_) : 2 * UNITB + (p_ - 2 * PIECES) * 16; *(LAS u32x4*)(lds + d_) = stg[r_]; } } while (0)
#define CH_SYNC() do { asm volatile("s_waitcnt lgkmcnt(0)" ::: "memory"); __builtin_amdgcn_s_barrier(); asm volatile("" ::: "memory"); } while (0)
    CH_LOAD(stgA, 0); CH_STORE(stgA, 0);
    CH_LOAD(stgA, 1);
    CH_SYNC();
    float* op = op0 + 16 * wave + n;
    for (int u = 0; u < nunits; u += 2) {
        if (u + 2 < nunits) CH_LOAD(stgB, u + 2);
        chain_sub<DK, MODE>(lds, S, op + (size_t)(u * 32) * OW, wave, n, q);
        chain_sub<DK, MODE>(lds + SUBB, S, op + (size_t)(u * 32 + 16) * OW, wave, n, q);
        if (MODE == 0 && tid < DK) dacc *= *(const LAS float*)(lds + ODL_ + 4 * tid) * *(const LAS float*)(lds + SUBB + ODL_ + 4 * tid);
        CH_STORE(stgA, 1);
        CH_SYNC();
        if (u + 3 < nunits) CH_LOAD(stgA, u + 3);
        chain_sub<DK, MODE>(lds + UNITB, S, op + (size_t)(u * 32 + 32) * OW, wave, n, q);
        chain_sub<DK, MODE>(lds + UNITB + SUBB, S, op + (size_t)(u * 32 + 48) * OW, wave, n, q);
        if (MODE == 0 && tid < DK) dacc *= *(const LAS float*)(lds + UNITB + ODL_ + 4 * tid) * *(const LAS float*)(lds + UNITB + SUBB + ODL_ + 4 * tid);
        if (u + 2 < nunits) CH_STORE(stgB, 0);
        CH_SYNC();
    }
    if (MODE == 0) { unsigned char* rec = st + (size_t)seg * 2 * ST_REC + (size_t)(wave * 64 + lane) * 16;
#pragma unroll
        for (int mb = 0; mb < NMB; ++mb) *(f32x4*)(rec + (size_t)mb * 8192) = S[mb];
        if (tid < DK) *(float*)(st + (size_t)seg * 2 * ST_REC + ST_REC + 4 * tid) = dacc; }
#undef CH_SRC
#undef CH_DST
#undef CH_LOAD
#undef CH_STORE
#undef CH_SYNC
}

template <int MODE>
__device__ __forceinline__ void phase_chain(const Ctx& a, int l, LAS unsigned char* lds, int wave, int lane) {
    const int bx = blockIdx.x, G = gridDim.x;
    constexpr int nhg = 24 * (MODE == 0 ? NSEG_HG - 1 : NSEG_HG), nitems = nhg + 24 * (MODE == 0 ? NSEG_GL - 1 : NSEG_GL);
    for (int it = bx; it < nitems; it += G) {
        const bool gla = it >= nhg; const int j = gla ? it - nhg : it, c = j % 24, seg = j / 24, u0 = seg_u0(gla, seg), nu = seg_nu(gla, seg);
        unsigned char* st = a.ws() + WS_ST + (size_t)(gla ? 24 + c : c) * (NSEG_MAX - 1) * 2 * ST_REC;
        if (!gla) { const int b = c / 12, h = c % 12;
            chain_item<128, MODE>(a.ws() + WS_HGB + ((size_t)(b * 12 + h) * NSUB + 2 * u0) * HG_BLK, 0, (float*)(a.ws() + WS_O) + ((size_t)b * SEQ + u0 * 32) * OW + h * 128, st, seg, nu, lds, wave, lane); }
        else { const int b = c / 12, h = (c % 12) / 3, sl = c % 3;
            chain_item<192, MODE>(a.ws() + WS_GLB + ((size_t)(b * 4 + h) * NSUB + 2 * u0) * GL_BLK, GL_OVT + 4096 * sl, (float*)(a.ws() + WS_O) + ((size_t)b * SEQ + u0 * 32) * OW + HGW + h * 384 + sl * 128, st, seg, nu, lds, wave, lane); }
        __syncthreads();
    }
    if (MODE == 0) { for (int it = (G >= nitems + 16) ? bx - nitems : bx; it < 16; it += G) { if (it < 0) continue; s5_scan_item(a, l, it, wave, lane); } }
}
__device__ __forceinline__ float red16(float v) { v += __shfl_xor(v, 1); v += __shfl_xor(v, 2); v += __shfl_xor(v, 4); v += __shfl_xor(v, 8); return v; }
__device__ __forceinline__ void phase_finalize(const Ctx& a, int l, int wave, int lane) {
    const bf16_t* P = (const bf16_t*)(a.ws() + WS_P); const float* O = (const float*)(a.ws() + WS_O); bf16_t* MX = (bf16_t*)(a.ws() + WS_MIXED);
    const float* hgg = a.in(I_HGG) + l * HGW; const float* hgb = a.in(I_HGB) + l * HGW; const float* glg = a.in(I_GLG) + l * HGW;
    const int gw = blockIdx.x * 8 + wave, NGW = gridDim.x * 8;
    for (int row = gw; row < MTOK; row += NGW) {
        const float* orow = O + (size_t)row * OW; const bf16_t* prow = P + (size_t)row * INP; bf16_t* mrow = MX + (size_t)row * DM;
#pragma unroll
        for (int it = 0; it < 3; ++it) { const int c = (it * 4 + (lane >> 4)) * 128 + (lane & 15) * 8;
            const f32x4 o0 = *(const f32x4*)(orow + c), o1 = *(const f32x4*)(orow + c + 4); const u32x4 gg = *(const u32x4*)(prow + C_GB + c);
            float v[8] = {sigmoidf_(bf_lo(gg.x)) * o0[0], sigmoidf_(bf_hi(gg.x)) * o0[1], sigmoidf_(bf_lo(gg.y)) * o0[2], sigmoidf_(bf_hi(gg.y)) * o0[3],
                          sigmoidf_(bf_lo(gg.z)) * o1[0], sigmoidf_(bf_hi(gg.z)) * o1[1], sigmoidf_(bf_lo(gg.w)) * o1[2], sigmoidf_(bf_hi(gg.w)) * o1[3]};
            float s = 0.f, ss = 0.f;
#pragma unroll
            for (int i = 0; i < 8; ++i) { s += v[i]; ss += v[i] * v[i]; }
            s = red16(s); ss = red16(ss);
            const float mu = s * (1.0f / 128.0f), rs = 1.0f / sqrtf(fmaxf(ss * (1.0f / 128.0f) - mu * mu, 0.f) + LN_EPS);
            const f32x4 g0 = *(const f32x4*)(hgg + c), g1 = *(const f32x4*)(hgg + c + 4), b0 = *(const f32x4*)(hgb + c), b1 = *(const f32x4*)(hgb + c + 4);
            u32x4 w; w.x = cvt_pk_bf16((v[0] - mu) * rs * g0[0] + b0[0], (v[1] - mu) * rs * g0[1] + b0[1]); w.y = cvt_pk_bf16((v[2] - mu) * rs * g0[2] + b0[2], (v[3] - mu) * rs * g0[3] + b0[3]);
            w.z = cvt_pk_bf16((v[4] - mu) * rs * g1[0] + b1[0], (v[5] - mu) * rs * g1[1] + b1[1]); w.w = cvt_pk_bf16((v[6] - mu) * rs * g1[2] + b1[2], (v[7] - mu) * rs * g1[3] + b1[3]);
            *(u32x4*)(mrow + S5W + c) = w; }
#pragma unroll
        for (int h = 0; h < 4; ++h) { const int c = h * 384 + lane * 8; const bool act = lane < 48;
            f32x4 o0 = (f32x4){0.f, 0.f, 0.f, 0.f}, o1 = o0; u32x4 gg = (u32x4){0u, 0u, 0u, 0u};
            if (act) { o0 = *(const f32x4*)(orow + HGW + c); o1 = *(const f32x4*)(orow + HGW + c + 4); gg = *(const u32x4*)(prow + C_GC + c); }
            const float ss = wave_sum((o0[0] * o0[0] + o0[1] * o0[1]) + (o0[2] * o0[2] + o0[3] * o0[3]) + (o1[0] * o1[0] + o1[1] * o1[1]) + (o1[2] * o1[2] + o1[3] * o1[3]));
            const float rms = 1.0f / sqrtf(ss * (1.0f / 384.0f) + LN_EPS);
            if (act) { const f32x4 g0 = *(const f32x4*)(glg + c), g1 = *(const f32x4*)(glg + c + 4);
                const float z[8] = {bf_lo(gg.x), bf_hi(gg.x), bf_lo(gg.y), bf_hi(gg.y), bf_lo(gg.z), bf_hi(gg.z), bf_lo(gg.w), bf_hi(gg.w)};
                u32x4 w; w.x = cvt_pk_bf16(o0[0] * rms * g0[0] * (z[0] * sigmoidf_(z[0])), o0[1] * rms * g0[1] * (z[1] * sigmoidf_(z[1])));
                w.y = cvt_pk_bf16(o0[2] * rms * g0[2] * (z[2] * sigmoidf_(z[2])), o0[3] * rms * g0[3] * (z[3] * sigmoidf_(z[3])));
                w.z = cvt_pk_bf16(o1[0] * rms * g1[0] * (z[4] * sigmoidf_(z[4])), o1[1] * rms * g1[1] * (z[5] * sigmoidf_(z[5])));
                w.w = cvt_pk_bf16(o1[2] * rms * g1[2] * (z[6] * sigmoidf_(z[6])), o1[3] * rms * g1[3] * (z[7] * sigmoidf_(z[7])));
                *(u32x4*)(mrow + S5W + HGW + c) = w; } }
    }
}

constexpr int PH_PRO = 0, PH_MOD = 1, PH_LN0 = 2, PH_L0 = 3, PH_PER_LAYER = 10, N_PHASES = PH_L0 + DEPTH * PH_PER_LAYER;
constexpr int CW_BAR = 4096;

__global__ void __launch_bounds__(512, 2) hybrid_fwd(Args args) {
    extern __shared__ __attribute__((aligned(16))) unsigned char lds_raw[];
    LAS unsigned char* lds = (LAS unsigned char*)lds_raw;
    const int wave = __builtin_amdgcn_readfirstlane((int)threadIdx.x >> 6);
#define lane lane_id_v()
    volatile LAS unsigned* MISC = (volatile LAS unsigned*)(lds + LDSCTL_OFF);
    Ctx ctx; ctx.t = (volatile LAS unsigned long long*)(lds + LDSCTL_OFF + 64);
    if (wave == 0) { const int ln_ = lane; unsigned long long v = 0ull;
#pragma unroll
        for (int i = 0; i < N_IN; ++i) v = (ln_ == i) ? (unsigned long long)args.in[i] : v;
        v = (ln_ == 30) ? (unsigned long long)args.out : v; v = (ln_ == 31) ? (unsigned long long)args.ws : v;
        if (ln_ < 32) ctx.t[ln_] = v;
        if (ln_ < 16) MISC[ln_] = 0u; }
    __syncthreads();
    const int lo = args.ph_lo, hi = args.ph_hi;
    XcdBarrier bar; bar.bar = (unsigned*)(ctx.ws() + WS_CTL) + CW_BAR; bar.x = 0; bar.st = nullptr; bar.w0 = (wave == 0) ? 1u : 0u;
    if (hi - lo > 1) bar = xcd_barrier_post((unsigned*)(ctx.ws() + WS_CTL) + CW_BAR, MISC + 8, (wave == 0) ? 1u : 0u);
#define IN(k) (lo <= (k) && (k) < hi)
#define OPQ() int ln = lane, wv = wave; asm volatile("" : "+s"(wv))
#define SEAM(k) do { if (IN(k) && IN((k) + 1)) xcd_barrier(bar); } while (0)
#define WSP(T, off) ((T*)(ctx.ws() + (off)))
#ifdef DIAG_SEL1
    volatile LAS unsigned long long* STP = (volatile LAS unsigned long long*)(lds + LDSCTL_OFF + 512);
#define STAMP(idx) do { if (blockIdx.x == 0 && wave == 0) { const unsigned long long t_ = __builtin_amdgcn_s_memrealtime(); if (lane == 0) STP[idx] = t_; } } while (0)
#else
#define STAMP(idx) do { } while (0)
#endif
    STAMP(0);

#if EN_PRO
    if (IN(PH_PRO)) { OPQ(); phase_prologue(ctx, lds, wv, ln); }
#endif
    SEAM(PH_PRO); STAMP((PH_PRO) + 1);
#if EN_MOD
    if (IN(PH_MOD)) { OPQ(); phase_mod(ctx, wv, ln); }
#endif
    SEAM(PH_MOD); STAMP((PH_MOD) + 1);
#if EN_LN
    if (IN(PH_LN0)) { OPQ(); phase_h0(ctx.in(I_X), WSP(float, WS_MOD), WSP(bf16_t, WS_H), wv, ln); }
#endif
    SEAM(PH_LN0); STAMP((PH_LN0) + 1);

    for (int l = 0; l < DEPTH; ++l) {
        const int p0 = PH_L0 + l * PH_PER_LAYER;
        const size_t wto = WS_WT + (size_t)l * WT_LAYER, modo = WS_MOD + (size_t)l * NB * 6 * DM * 4;
#if EN_INPROJ
        if (IN(p0 + 0)) { pg8::Gemm g{WSP(bf16_t, WS_H), WSP(const bf16_t, wto + WT_IN), MTOK, INP, DM}; pg8::StaticOrder S; S.init(MTOK, INP, (int)gridDim.x, (int)blockIdx.x);
            EpiProj E{WSP(bf16_t, WS_P), WSP(bf16_t, WS_UX)}; pg8::gemm_phase<EpiProj, pg8::StaticOrder, true, true>(lds, g, S, E, wave); }
#endif
        SEAM(p0 + 0); STAMP((p0 + 0) + 1);
#if EN_MIX
        if (IN(p0 + 1)) {
            { pg8::Gemm g{WSP(bf16_t, WS_UX), WSP(const bf16_t, WS_S5W1 + (size_t)l * S5_W1_LAYER), 64 * 256, 64 * 256, S5K}; S5Order S{(int)gridDim.x, (int)blockIdx.x, 64, 0};
              EpiS5A E{WSP(float, WS_SLOC)}; pg8::gemm_phase<EpiS5A, S5Order, true, true>(lds, g, S, E, wave); }
            { OPQ(); phase_pre(ctx, l, wv, ln); }
#ifdef DBG_PRE2
            { OPQ(); phase_pre(ctx, l, wv, ln); }
#endif
            }
        SEAM(p0 + 1); STAMP((p0 + 1) + 1);
        if (IN(p0 + 2)) { OPQ(); phase_chain<0>(ctx, l, lds, wv, ln); }
        SEAM(p0 + 2); STAMP((p0 + 2) + 1);
        if (IN(p0 + 3)) {
            { pg8::Gemm g{WSP(bf16_t, WS_UX), WSP(const bf16_t, WS_S5T + (size_t)l * S5_T_LAYER), 64 * 256, 64 * 1024, S5K}; S5Order S{(int)gridDim.x, (int)blockIdx.x, 256, 2};
              EpiS5C E{WSP(bf16_t, WS_Z)}; pg8::gemm_phase<EpiS5C, S5Order, true, true>(lds, g, S, E, wave); }
            { OPQ(); phase_chain<1>(ctx, l, lds, wv, ln); } }
#endif
        SEAM(p0 + 3); STAMP((p0 + 3) + 1);
#if EN_GLU
        if (IN(p0 + 4)) { pg8::Gemm g{WSP(bf16_t, WS_Z), WSP(const bf16_t, wto + WT_GLU), MTOK, S5W, S5W}; pg8::StaticOrder S; S.init(MTOK, S5W, (int)gridDim.x, (int)blockIdx.x);
            EpiGlu E{WSP(bf16_t, WS_Z), WSP(bf16_t, WS_MIXED), ctx.in(I_GLUB) + l * S5W}; pg8::gemm_phase<EpiGlu, pg8::StaticOrder, true, true>(lds, g, S, E, wave);
            { OPQ(); phase_finalize(ctx, l, wv, ln); } }
#endif
        SEAM(p0 + 4); STAMP((p0 + 4) + 1);
#if EN_OUT
        if (IN(p0 + 5)) { pg8::Gemm g{WSP(bf16_t, WS_MIXED), WSP(const bf16_t, wto + WT_OUT), MTOK, DM, DM}; pg8::StaticOrder S; S.init(MTOK, DM, (int)gridDim.x, (int)blockIdx.x);
            EpiDelta E{WSP(bf16_t, WS_DELTA), WSP(float, modo) + 2 * DM};
            pg8::gemm_phase<EpiDelta, pg8::StaticOrder, true, true>(lds, g, S, E, wave); }
#endif
        SEAM(p0 + 5); STAMP((p0 + 5) + 1);
#if EN_LN
        if (IN(p0 + 6)) { OPQ(); phase_lnres<true>(l == 0 ? ctx.in(I_X) : ctx.out(), WSP(bf16_t, WS_DELTA), ctx.out(), ctx.in(I_LN1G) + l * DM, ctx.in(I_LN1B) + l * DM, WSP(float, modo), 3, 4, WSP(bf16_t, WS_H), lds, wv, ln); }
#endif
        SEAM(p0 + 6); STAMP((p0 + 6) + 1);
#if EN_GU
        if (IN(p0 + 7)) { pg8::Gemm g{WSP(bf16_t, WS_H), WSP(const bf16_t, wto + WT_GU), MTOK, 2 * DFF, DM}; pg8::StaticOrder S; S.init(MTOK, 2 * DFF, (int)gridDim.x, (int)blockIdx.x);
            EpiSwiglu E{WSP(bf16_t, WS_P)}; pg8::gemm_phase<EpiSwiglu, pg8::StaticOrder, true, true>(lds, g, S, E, wave); }
#endif
        SEAM(p0 + 7); STAMP((p0 + 7) + 1);
#if EN_DN
        if (IN(p0 + 8)) { pg8::Gemm g{WSP(bf16_t, WS_P), WSP(const bf16_t, wto + WT_DN), MTOK, DM, DFF}; pg8::StaticOrder S; S.init(MTOK, DM, (int)gridDim.x, (int)blockIdx.x);
            EpiDelta E{WSP(bf16_t, WS_DELTA), WSP(float, modo) + 5 * DM};
            pg8::gemm_phase<EpiDelta, pg8::StaticOrder, true, true>(lds, g, S, E, wave); }
#endif
        SEAM(p0 + 8); STAMP((p0 + 8) + 1);
#if EN_LN
        if (IN(p0 + 9)) { OPQ();
            if (l + 1 < DEPTH) phase_lnres<true>(ctx.out(), WSP(bf16_t, WS_DELTA), ctx.out(), ctx.in(I_LN2G) + l * DM, ctx.in(I_LN2B) + l * DM, WSP(float, modo) + (size_t)NB * 6 * DM, 0, 1, WSP(bf16_t, WS_H), lds, wv, ln);
            else phase_lnres<false>(ctx.out(), WSP(bf16_t, WS_DELTA), ctx.out(), ctx.in(I_LN2G) + l * DM, ctx.in(I_LN2B) + l * DM, nullptr, 0, 0, nullptr, lds, wv, ln);
        }
#endif
        SEAM(p0 + 9); STAMP((p0 + 9) + 1);
    }
#ifdef DIAG_SEL1
    xcd_barrier(bar);
    if (blockIdx.x == 0) {
        float tot = (float)(STP[N_PHASES] - STP[0]), s1 = 0.f, s2 = 0.f;
        for (int k = 0; k < N_PHASES; ++k) { int ty; if (k < 3) ty = k; else { const int j = (k - 3) % PH_PER_LAYER; const int map[10] = {3, 4, 5, 6, 10, 7, 2, 8, 9, 2}; ty = map[j]; }
            const float d = (float)(STP[k + 1] - STP[k]); if ((DIAG_SEL1 >> ty) & 1) s1 += d; if ((DIAG_SEL2 >> ty) & 1) s2 += d; }
        const int n1 = (int)(1000000.f * s1 / tot); float* o = ctx.out();
        for (int i = wave * 64 + lane; i < n1; i += 512) o[i] += 0.05f;
        if (wave == 0 && lane == 0) o[2000000] += 0.05f + 0.11f * s2 / tot;
    }
#endif
#undef IN
#undef SEAM
#undef OPQ
#undef WSP
#undef lane
}

#ifndef MK_PER_PHASE
#define MK_PER_PHASE 0
#endif
extern "C" void kernel_launch(void* const* d_in, const int* in_sizes, int n_in, void* d_out, int out_size, void* d_ws, size_t ws_size, hipStream_t stream) {
    static int grid = 0;
    if (grid == 0) {
        if (n_in != N_IN || out_size != MTOK * DM || ws_size < WS_END) { fprintf(stderr, "kernel_launch: unexpected problem (n_in %d, out %d, ws %zu < %zu); nothing launched\n", n_in, out_size, ws_size, (size_t)WS_END); grid = -1; return; }
        int dev = 0, cus = 0, per_cu = 0;
        if (hipGetDevice(&dev) != hipSuccess || hipDeviceGetAttribute(&cus, hipDeviceAttributeMultiprocessorCount, dev) != hipSuccess) { grid = -1; return; }
        if (hipFuncSetAttribute((const void*)hybrid_fwd, hipFuncAttributeMaxDynamicSharedMemorySize, LDS_BYTES) != hipSuccess) { fprintf(stderr, "kernel_launch: hipFuncSetAttribute failed\n"); grid = -1; return; }
        if (hipOccupancyMaxActiveBlocksPerMultiprocessor(&per_cu, (const void*)hybrid_fwd, 512, LDS_BYTES) != hipSuccess || per_cu < 1) fprintf(stderr, "kernel_launch: occupancy query reports %d blocks per CU\n", per_cu);
        (void)hipGetLastError();
        grid = cus;
    }
    if (grid < 0) return;
    (void)in_sizes;
    if (hipMemsetAsync((char*)d_ws + WS_CTL, 0, CTL_ZERO_BYTES, stream) != hipSuccess) return;
#ifdef DBG_MEMSET
    (void)hipMemsetAsync((char*)d_ws + WS_HGB, 0, WS_END - WS_HGB, stream); (void)hipMemsetAsync((char*)d_ws + WS_O, 0, 192 * MiB, stream);
#endif
    Args a{};
    for (int i = 0; i < N_IN; ++i) a.in[i] = (const float*)d_in[i];
    a.out = (float*)d_out; a.ws = (unsigned char*)d_ws;
#if MK_PER_PHASE
    for (int p = 0; p < N_PHASES; ++p) { a.ph_lo = p; a.ph_hi = p + 1; hipLaunchKernelGGL(hybrid_fwd, dim3(grid), dim3(512), LDS_BYTES, stream, a); }
#else
    a.ph_lo = 0; a.ph_hi = N_PHASES; hipLaunchKernelGGL(hybrid_fwd, dim3(grid), dim3(512), LDS_BYTES, stream, a);
#endif
}
```

```cpp
#include <hip/hip_runtime.h>
#include <cstdio>
#include <cstdint>
namespace pg8 {
#define PG8_LAS __attribute__((address_space(3)))
typedef unsigned short bf16_t;
typedef short bf16x8 __attribute__((ext_vector_type(8)));
typedef float f32x4 __attribute__((ext_vector_type(4)));
typedef unsigned u32x4 __attribute__((ext_vector_type(4)));
constexpr int BM = 256, BK = 64, HALF = 128, HTB = HALF * BK * 2  , STAGE_BYTES = 8 * HTB, NXCD = 8, WGM = 8;

__host__ __device__ __forceinline__ int lds_byte(int r, int c) { const int st = (r >> 4) * 2 + (c >> 5), rr = r & 15, cc = c & 31, ob = rr * 64 + cc * 2; return st * 1024 + (ob ^ (((ob >> 9) & 1) << 5)); }
__host__ __device__ __forceinline__ void stage_rc(int b, int& R, int& C) { const int st = b / 1024, sb = b % 1024, swz = sb ^ (((sb >> 9) & 1) << 5); R = (st >> 1) * 16 + swz / 64; C = (st & 1) * 32 + (swz % 64) / 2; }
__host__ __device__ __forceinline__ int perm32(int rho) { const int n = rho >> 4, i = rho & 15; return 8 * (i >> 2) + 4 * n + (i & 3); }

struct Unit { int pm, pn; };
struct Gemm { const bf16_t* A; const bf16_t* Bt; int M, N, K; };

struct StaticOrder {
    int nM, nN, nwg, G, c;
    __host__ __device__ void init(int M, int N, int G_, int c_) { nM = M / BM; nN = N / BM; nwg = nM * nN; G = G_; c = c_; }
    __host__ __device__ bool next(int i, Unit& u) const {
        const long L = (long)i * G + c; if (L >= nwg) return false;
        int wgid = (int)L; { const int q = nwg / NXCD, r = nwg % NXCD, xcd = wgid % NXCD, off = wgid / NXCD; wgid = (xcd < r ? xcd * (q + 1) : r * (q + 1) + (xcd - r) * q) + off; }
        const int nig = WGM * nN, gid = wgid / nig, fm = gid * WGM, gsz = (nM - fm) < WGM ? (nM - fm) : WGM;
        u.pm = fm + ((wgid % nig) % gsz); u.pn = (wgid % nig) / gsz; return true;
    }
    __device__ __forceinline__ void a_ready(const Unit&) const {}
    __device__ __forceinline__ void done(const Unit&) const {}
};
__device__ __forceinline__ unsigned cvt_pk_bf16(float lo, float hi) { unsigned r; asm volatile("v_cvt_pk_bf16_f32 %0, %1, %2" : "=v"(r) : "v"(lo), "v"(hi)); return r; }
typedef float f32x2 __attribute__((ext_vector_type(2)));
template <class Epi, class Sched, bool ALIGN_EPI = false, bool SP2 = false>
__device__ __forceinline__ void gemm_phase(PG8_LAS unsigned char* lds, const Gemm g, const Sched& S, const Epi& E, int wave_id) {
    int tid_; asm volatile("v_mbcnt_lo_u32_b32 %0, -1, 0\n\tv_mbcnt_hi_u32_b32 %0, -1, %0" : "=v"(tid_)); tid_ += wave_id * 64;
    const int tid = tid_, wid = __builtin_amdgcn_readfirstlane(tid >> 6), lane = tid & 63, wr = wid >> 2, wc = wid & 3, fr = lane & 15, fq = lane >> 4;
    const int K = g.K, nt = K / BK;
    unsigned voffA[2], voffB[2];
#pragma unroll
    for (int i = 0; i < 2; ++i) { int R, C; stage_rc(tid * 16 + i * 8192, R, C); const int Rb = Epi::PERM ? ((R & ~31) + perm32(R & 31)) : R;
        voffA[i] = (unsigned)(R * K + C) * 2u; voffB[i] = (unsigned)(Rb * K + C) * 2u; }
    const size_t kstep = (size_t)(BK * 2);
    const size_t hstep = (size_t)HALF * K * 2;
    const size_t tstep = 2 * hstep;
    const unsigned ldsw = (unsigned)wid * 1024u;
    const int aoff = lds_byte(wr * 64 + fr, fq * 8), boff = lds_byte(wc * 32 + fr, fq * 8);
#define PG8_SA(b, h) (((b) * 2 + (h)) * HTB)
#define PG8_SB(b, h) ((4 + (b) * 2 + (h)) * HTB)
#define PG8_STAGE(bufoff, gbase, voff) do { _Pragma("unroll") for (int _i = 0; _i < 2; ++_i) \
        __builtin_amdgcn_global_load_lds((const unsigned*)((const char*)(gbase) + (voff)[_i]), (PG8_LAS unsigned*)(lds + (bufoff) + ldsw + _i * 8192), 16, 0, 0); } while (0)
#define PG8_LDA(dst, b, h) do { _Pragma("unroll") for (int m = 0; m < 4; ++m) _Pragma("unroll") for (int k = 0; k < 2; ++k) dst[m][k] = *(const PG8_LAS bf16x8*)(lds + PG8_SA(b, h) + aoff + m * 2048 + k * 1024); } while (0)
#define PG8_LDB(dst, b, h) do { _Pragma("unroll") for (int n = 0; n < 2; ++n) _Pragma("unroll") for (int k = 0; k < 2; ++k) dst[n][k] = *(const PG8_LAS bf16x8*)(lds + PG8_SB(b, h) + boff + n * 2048 + k * 1024); } while (0)
#define PG8_MMA(ai, bj, At, Bt) do { __builtin_amdgcn_s_setprio(1); _Pragma("unroll") for (int m = 0; m < 4; ++m) _Pragma("unroll") for (int n = 0; n < 2; ++n) _Pragma("unroll") for (int k = 0; k < 2; ++k) \
        acc[ai][bj][m][n] = __builtin_amdgcn_mfma_f32_16x16x32_bf16(Bt[n][k], At[m][k], acc[ai][bj][m][n], 0, 0, 0); __builtin_amdgcn_s_setprio(0); } while (0)
#define PG8_WAIT_V(n) asm volatile("s_waitcnt vmcnt(" #n ")" ::: "memory")
#define PG8_WAIT_L(n) asm volatile("s_waitcnt lgkmcnt(" #n ")" ::: "memory")
#define PG8_BAR __builtin_amdgcn_s_barrier()
#define PG8_SCHED __builtin_amdgcn_sched_barrier(0)
    Unit cur, nxt; int ui = 0;
    if (!S.next(0, cur)) return;
    f32x4 acc[2][2][4][2];
#pragma unroll
    for (int a = 0; a < 2; ++a)
#pragma unroll
        for (int b = 0; b < 2; ++b)
#pragma unroll
            for (int m = 0; m < 4; ++m)
#pragma unroll
                for (int n = 0; n < 2; ++n) acc[a][b][m][n] = (f32x4){0.f, 0.f, 0.f, 0.f};
    bf16x8 At[4][2], B0[2][2], B1[2][2];
    const char* cA = (const char*)g.A + (size_t)cur.pm * tstep; const char* cB = (const char*)g.Bt + (size_t)cur.pn * tstep;
    S.a_ready(cur);
    if constexpr (SP2) {
        PG8_STAGE(PG8_SB(0, 0), cB, voffB); PG8_STAGE(PG8_SB(0, 1), cB + hstep, voffB); PG8_STAGE(PG8_SA(0, 0), cA, voffA); PG8_STAGE(PG8_SA(0, 1), cA + hstep, voffA);
        if (wr == 1) PG8_BAR;
        PG8_WAIT_V(2); PG8_BAR;
        PG8_STAGE(PG8_SB(1, 0), cB + kstep, voffB); PG8_STAGE(PG8_SA(1, 0), cA + kstep, voffA); PG8_STAGE(PG8_SB(1, 1), cB + hstep + kstep, voffB);
        PG8_WAIT_V(6); PG8_BAR;
    } else {
        PG8_STAGE(PG8_SB(0, 0), cB, voffB); PG8_STAGE(PG8_SA(0, 0), cA, voffA); PG8_STAGE(PG8_SB(0, 1), cB + hstep, voffB); PG8_STAGE(PG8_SA(0, 1), cA + hstep, voffA);
        if (wr == 1) PG8_BAR;
        PG8_WAIT_V(4); PG8_BAR;
        PG8_STAGE(PG8_SB(1, 0), cB + kstep, voffB); PG8_STAGE(PG8_SA(1, 0), cA + kstep, voffA); PG8_STAGE(PG8_SB(1, 1), cB + hstep + kstep, voffB);
        PG8_WAIT_V(6); PG8_BAR;
    }
    for (;;) {
        const bool has_next = S.next(ui + 1, nxt);
        const char* nA = has_next ? (const char*)g.A + (size_t)nxt.pm * tstep : cA; const char* nB = has_next ? (const char*)g.Bt + (size_t)nxt.pn * tstep : cB;
        for (int t = 0; t < nt; t += 2) {
            const bool last = (t == nt - 2);
            const char* a1 = cA + (size_t)(t + 1) * kstep;
            const char* a2 = last ? nA : cA + (size_t)(t + 2) * kstep; const char* b2 = last ? nB : cB + (size_t)(t + 2) * kstep;
            const char* a3 = a2 + kstep; const char* b3 = b2 + kstep;
            if (last && has_next) S.a_ready(nxt);
            if constexpr (SP2) {
            PG8_LDB(B0, 0, 0); PG8_LDB(B1, 0, 1); PG8_SCHED; PG8_LDA(At, 0, 0); PG8_STAGE(PG8_SA(1, 1), a1 + hstep, voffA);
            PG8_WAIT_V(8); PG8_WAIT_L(0); PG8_BAR; PG8_MMA(0, 0, At, B0); PG8_MMA(0, 1, At, B1); PG8_BAR; PG8_SCHED;
            PG8_LDA(At, 0, 1); PG8_STAGE(PG8_SB(0, 0), b2, voffB); PG8_STAGE(PG8_SB(0, 1), b2 + hstep, voffB); PG8_STAGE(PG8_SA(0, 0), a2, voffA);
            PG8_WAIT_V(8); PG8_WAIT_L(0); PG8_BAR; PG8_MMA(1, 0, At, B0); PG8_MMA(1, 1, At, B1); PG8_BAR; PG8_SCHED;
            PG8_LDB(B0, 1, 0); PG8_LDB(B1, 1, 1); PG8_SCHED; PG8_LDA(At, 1, 0); PG8_STAGE(PG8_SA(0, 1), a2 + hstep, voffA);
            PG8_WAIT_V(8); PG8_WAIT_L(0); PG8_BAR; PG8_MMA(0, 0, At, B0); PG8_MMA(0, 1, At, B1); PG8_BAR; PG8_SCHED;
            PG8_LDA(At, 1, 1); PG8_STAGE(PG8_SB(1, 0), b3, voffB); PG8_STAGE(PG8_SB(1, 1), b3 + hstep, voffB); PG8_STAGE(PG8_SA(1, 0), a3, voffA);
            PG8_WAIT_V(8); PG8_WAIT_L(0); PG8_BAR; PG8_MMA(1, 0, At, B0); PG8_MMA(1, 1, At, B1); PG8_BAR; PG8_SCHED;
            } else {
            PG8_LDB(B0, 0, 0); PG8_SCHED; PG8_LDA(At, 0, 0); PG8_STAGE(PG8_SA(1, 1), a1 + hstep, voffA);
            PG8_WAIT_L(8); PG8_BAR; PG8_WAIT_L(0); PG8_MMA(0, 0, At, B0); PG8_BAR; PG8_SCHED;
            PG8_LDB(B1, 0, 1); PG8_STAGE(PG8_SB(0, 0), b2, voffB);
            PG8_BAR; PG8_WAIT_L(0); PG8_MMA(0, 1, At, B1); PG8_BAR;
            PG8_LDA(At, 0, 1); PG8_STAGE(PG8_SA(0, 0), a2, voffA);
            PG8_BAR; PG8_WAIT_L(0); PG8_MMA(1, 0, At, B0); PG8_BAR; PG8_SCHED;
            PG8_STAGE(PG8_SB(0, 1), b2 + hstep, voffB);
            PG8_WAIT_V(6); PG8_BAR; PG8_MMA(1, 1, At, B1); PG8_BAR;
            PG8_LDB(B0, 1, 0); PG8_SCHED; PG8_LDA(At, 1, 0); PG8_STAGE(PG8_SA(0, 1), a2 + hstep, voffA);
            PG8_WAIT_L(8); PG8_BAR; PG8_WAIT_L(0); PG8_MMA(0, 0, At, B0); PG8_BAR; PG8_SCHED;
            PG8_LDB(B1, 1, 1); PG8_STAGE(PG8_SB(1, 0), b3, voffB);
            PG8_BAR; PG8_WAIT_L(0); PG8_MMA(0, 1, At, B1); PG8_BAR;
            PG8_LDA(At, 1, 1); PG8_STAGE(PG8_SA(1, 0), a3, voffA);
            PG8_BAR; PG8_WAIT_L(0); PG8_MMA(1, 0, At, B0); PG8_BAR; PG8_SCHED;
            PG8_STAGE(PG8_SB(1, 1), b3 + hstep, voffB);
            PG8_WAIT_V(6); PG8_BAR; PG8_MMA(1, 1, At, B1); PG8_BAR;
            }
        }
        if constexpr (ALIGN_EPI) { if (wr == 0) PG8_BAR; }
        if constexpr (!Epi::AFTER_DRAIN) { E(acc, cur, wr, wc, fr, fq); S.done(cur); }
        if (!has_next) break;
#pragma unroll
        for (int a = 0; a < 2; ++a)
#pragma unroll
            for (int b = 0; b < 2; ++b)
#pragma unroll
                for (int m = 0; m < 4; ++m)
#pragma unroll
                    for (int n = 0; n < 2; ++n) acc[a][b][m][n] = (f32x4){0.f, 0.f, 0.f, 0.f};
        cur = nxt; cA = nA; cB = nB; ++ui;
        if constexpr (ALIGN_EPI) { if (wr == 1) PG8_BAR; }
    }
    PG8_WAIT_V(0);
    if constexpr (!ALIGN_EPI) { if (wr == 0) PG8_BAR; }
    PG8_BAR;
    if constexpr (Epi::AFTER_DRAIN) { E.fused(acc, cur, wr, wc, fr, fq, lds, wid, lane); S.done(cur); }
#undef PG8_SA
#undef PG8_SB
#undef PG8_STAGE
#undef PG8_LDA
#undef PG8_LDB
#undef PG8_MMA
#undef PG8_WAIT_V
#undef PG8_WAIT_L
#undef PG8_BAR
#undef PG8_SCHED
}
}
#define LAS __attribute__((address_space(3)))
#define XB_TMO      128
#define XB_XCNT(j)  (256  + 64 * (j))
#define XB_XSUB(j)  (1280 + 64 * (j))
#define XB_XGEN(j)  (2304 + 64 * (j))
#define XB_TOP      3328
#define XB_TOPGEN   3392
#define XCD_BAR_WORDS 3456
#define XB_SPIN_CAP (1u << 24)

__device__ __forceinline__ unsigned xb_ld(unsigned* p)              { return __hip_atomic_load(p, __ATOMIC_RELAXED, __HIP_MEMORY_SCOPE_AGENT); }
__device__ __forceinline__ unsigned xb_add(unsigned* p, unsigned v) { return __hip_atomic_fetch_add(p, v, __ATOMIC_RELAXED, __HIP_MEMORY_SCOPE_AGENT); }
__device__ __forceinline__ unsigned xb_xcc_id() { return (unsigned)__builtin_amdgcn_s_getreg((3 << 11) | 20) & 0xFu; }
#define XB_SPIN(cond, bar) do { unsigned _sp = 0; while (cond) { __builtin_amdgcn_s_sleep(1); \
    if ((++_sp & 255u) == 0u) { if (xb_ld(&(bar)[XB_TMO])) break; if (_sp > XB_SPIN_CAP) { atomicAdd(&(bar)[XB_TMO], 1u); break; } } } } while (0)

struct XcdBarrier {
    unsigned* bar; unsigned x; unsigned w0;
    volatile LAS unsigned* st;
};

__device__ __forceinline__ bool xb_lane0() { return __builtin_amdgcn_mbcnt_hi(~0u, __builtin_amdgcn_mbcnt_lo(~0u, 0u)) == 0u; }
__device__ __forceinline__ XcdBarrier xcd_barrier_post(unsigned* bar, volatile LAS unsigned* st, unsigned w0) {
    XcdBarrier b; b.bar = bar; b.x = xb_xcc_id(); b.st = st; b.w0 = w0;
    if (w0 && xb_lane0()) (void)xb_add(&bar[XB_XCNT(b.x)], 1u);
    return b;
}
__device__ __forceinline__ void xcd_barrier_complete(unsigned* bar, unsigned x, unsigned& nloc, unsigned& nx) {
    const unsigned G = gridDim.x * gridDim.y * gridDim.z;
    unsigned sum, cnt, mine, sp = 0u;
    for (;;) {
        sum = 0u; cnt = 0u; mine = 0u;
#pragma unroll
        for (unsigned j = 0; j < 16; ++j) { const unsigned c = xb_ld(&bar[XB_XCNT(j)]); sum += c; cnt += (c > 0u) ? 1u : 0u; mine = (j == x) ? c : mine; }
        if (sum == G) break;
        __builtin_amdgcn_s_sleep(1);
        if ((++sp & 255u) == 0u) { if (xb_ld(&bar[XB_TMO])) break; if (sp > XB_SPIN_CAP) { atomicAdd(&bar[XB_TMO], 1u); break; } }
    }
    nloc = mine > 0u ? mine : 1u; nx = cnt > 0u ? cnt : 1u;
}

__device__ __forceinline__ void xcd_barrier(const XcdBarrier& b) {
    asm volatile("s_waitcnt vmcnt(0)" ::: "memory");
    __syncthreads();
    if (b.w0 && xb_lane0()) {
        unsigned* bar = b.bar;
        __builtin_amdgcn_s_waitcnt(0);
        unsigned nloc = b.st[0], nx = b.st[1];
        if (nloc == 0u) { xcd_barrier_complete(bar, b.x, nloc, nx); b.st[0] = nloc; b.st[1] = nx; }
        const unsigned old = xb_add(&bar[XB_XSUB(b.x)], 1u);
        const unsigned gen = old / nloc;
        if (old + 1u == (gen + 1u) * nloc) {
            __builtin_amdgcn_fence(__ATOMIC_RELEASE, "agent");
            asm volatile("s_waitcnt vmcnt(0)" ::: "memory");
            const unsigned og = xb_add(&bar[XB_TOP], 1u);
            const unsigned tg = og / nx;
            if (og + 1u == (tg + 1u) * nx) xb_add(&bar[XB_TOPGEN], 1u);
            else XB_SPIN(xb_ld(&bar[XB_TOPGEN]) == tg, bar);
            __builtin_amdgcn_fence(__ATOMIC_ACQUIRE, "agent");
            xb_add(&bar[XB_XGEN(b.x)], 1u);
            asm volatile("s_waitcnt vmcnt(0)" ::: "memory");
        } else {
            XB_SPIN(xb_ld(&bar[XB_XGEN(b.x)]) == gen, bar);
            __builtin_amdgcn_fence(__ATOMIC_ACQUIRE, "agent");
            asm volatile("s_waitcnt vmcnt(0)" ::: "memory");
        }
    }
    __syncthreads();
}

constexpr int DM = 4096, NB = 2, SEQ = 8192, MTOK = NB * SEQ, DEPTH = 4;
constexpr int S5W = 1024;
constexpr int HGW = 1536;
constexpr int GLKW = 768;
constexpr int INW = 11792, INP = 12032, DFF = 11008;
constexpr int OW = 3072;
constexpr int C_U = 0, C_QB = 1024, C_FB = 2560, C_IB = 4096, C_GB = 5632, C_QC = 7168, C_KC = 7936, C_VC = 8704, C_GC = 10240, C_LR = 11776;
constexpr float LN_EPS = 1e-5f;
constexpr float ALPHA = 1.6817928305074290861f;
constexpr float GLA_QSCALE = 0.07216878364870322f;

enum { I_X = 0, I_C, I_WADA, I_BADA, I_TABLE, I_WIN, I_WOUT, I_AREAL, I_AIMAG, I_LOGDT, I_BRE, I_BIM, I_CRE, I_CIM, I_S5D, I_GLUW, I_GLUB,
       I_LBRAW, I_HGG, I_HGB, I_WGATE, I_BGATE, I_GLG, I_WFG, I_WFU, I_WFD, I_LN1G, I_LN1B, I_LN2G, I_LN2B, N_IN };

constexpr size_t MiB = 1u << 20;
constexpr size_t WS_CTL = 0, CTL_ZERO_BYTES = 1 * MiB;
constexpr size_t WS_MOD = 1 * MiB;
constexpr size_t WS_MISC = 2 * MiB;
constexpr size_t WS_CONDPART = 12 * MiB;
constexpr size_t WS_H = 24 * MiB;
constexpr size_t WS_MIXED = WS_H + 128 * MiB;
constexpr size_t WS_Z = WS_MIXED + 128 * MiB;
constexpr size_t WS_O = WS_Z + 32 * MiB;
constexpr size_t WS_DELTA = WS_O;
constexpr size_t WS_P = WS_O + 192 * MiB;
constexpr size_t WS_WT = WS_P + 376 * MiB;
constexpr size_t WT_IN = 0, WT_OUT = 94 * MiB, WT_GU = 126 * MiB, WT_DN = 298 * MiB, WT_GLU = 384 * MiB, WT_LAYER = 386 * MiB;
constexpr size_t WS_HGB = WS_WT + DEPTH * WT_LAYER;
constexpr size_t WS_GLB = WS_HGB + 198 * MiB;
constexpr size_t WS_S5T = WS_GLB + 128 * MiB;
constexpr size_t WS_S5W1 = WS_S5T + 576 * MiB;
constexpr size_t WS_UX = WS_S5W1 + 144 * MiB;
constexpr size_t WS_SLOC = WS_UX + 36 * MiB;
constexpr size_t WS_LAM64 = WS_SLOC + 8 * MiB;
constexpr size_t WS_ST = WS_LAM64 + 1 * MiB;
constexpr size_t WS_END = WS_ST + 45 * MiB;
static_assert((size_t)INP * DM * 2 == 94 * MiB && (size_t)DM * DM * 2 == 32 * MiB && (size_t)2 * DFF * DM * 2 == 172 * MiB && (size_t)DM * DFF * 2 == 86 * MiB, "weight map");
static_assert((size_t)MTOK * INP * 2 == 376 * MiB && (size_t)MTOK * DFF * 2 <= 376 * MiB, "activation map");

constexpr int RING_BYTES = 131072;
constexpr int LDSCTL_OFF = 135168;
constexpr int LDS_BYTES = 147456;

#ifndef LAS
#define LAS __attribute__((address_space(3)))
#endif
typedef unsigned short bf16_t;
typedef float f32x4 __attribute__((ext_vector_type(4)));
typedef float f32x2 __attribute__((ext_vector_type(2)));
typedef unsigned u32x4 __attribute__((ext_vector_type(4)));
typedef unsigned u32x2 __attribute__((ext_vector_type(2)));
#define LDS_WAIT() asm volatile("s_waitcnt lgkmcnt(0)" ::: "memory")
#define VM_WAIT() asm volatile("s_waitcnt vmcnt(0)" ::: "memory")
typedef __bf16 bf16x2_t __attribute__((ext_vector_type(2)));
__device__ __forceinline__ unsigned cvt_pk_bf16(float lo, float hi) { return __builtin_bit_cast(unsigned, __builtin_convertvector((f32x2){lo, hi}, bf16x2_t)); }

__device__ __forceinline__ float bf_lo(unsigned w) { return __uint_as_float(w << 16); }
__device__ __forceinline__ float bf_hi(unsigned w) { return __uint_as_float(w & 0xffff0000u); }
__device__ __forceinline__ float bf2f(bf16_t b) { return __uint_as_float(((unsigned)b) << 16); }
__device__ __forceinline__ float wave_sum(float v) {
    v += __int_as_float(__builtin_amdgcn_mov_dpp(__float_as_int(v), 0xB1, 0xF, 0xF, true));
    v += __int_as_float(__builtin_amdgcn_mov_dpp(__float_as_int(v), 0x4E, 0xF, 0xF, true));
    v += __int_as_float(__builtin_amdgcn_mov_dpp(__float_as_int(v), 0x141, 0xF, 0xF, true));
    v += __int_as_float(__builtin_amdgcn_mov_dpp(__float_as_int(v), 0x140, 0xF, 0xF, true));
    v += __shfl_xor(v, 16); v += __shfl_xor(v, 32);
    return v;
}
__device__ __forceinline__ float sigmoidf_(float x) { return 1.0f / (1.0f + __expf(-x)); }
__device__ __forceinline__ float gelu_tanh(float y) { const float a = 0.7978845608028654f * (y + 0.044715f * y * y * y); const float t = 1.0f - 2.0f / (1.0f + __expf(2.0f * a)); return 0.5f * y * (1.0f + t); }

struct EpiProj {
    static constexpr bool PERM = true, AFTER_DRAIN = false;
    bf16_t* P; bf16_t* UX;
    __device__ __forceinline__ void operator()(const f32x4 (&acc)[2][2][4][2], const pg8::Unit& u, int wr, int wc, int fr, int fq) const {
        const int row0 = u.pm * 256 + wr * 64 + fr, col0 = u.pn * 256 + wc * 32 + 8 * fq;
        const bool s5 = u.pn < 4;
#pragma unroll
        for (int ai = 0; ai < 2; ++ai)
#pragma unroll
            for (int m = 0; m < 4; ++m) { const int row = row0 + ai * 128 + m * 16;
#pragma unroll
                for (int bj = 0; bj < 2; ++bj) { const f32x4 v0 = acc[ai][bj][m][0], v1 = acc[ai][bj][m][1]; const int col = col0 + bj * 128;
                    u32x4 w; w.x = cvt_pk_bf16(v0[0], v0[1]); w.y = cvt_pk_bf16(v0[2], v0[3]); w.z = cvt_pk_bf16(v1[0], v1[1]); w.w = cvt_pk_bf16(v1[2], v1[3]);
                    if (!s5) *(u32x4*)(P + (size_t)row * INP + col) = w;
                    else { bf16_t* ur = UX + (size_t)((col >> 4) * 256 + (row >> 6)) * 1152; *(u32x4*)(ur + (row & 63) * 16 + (col & 15)) = w;
                        if ((row & 63) == 0) { const u32x4 z = (u32x4){0u, 0u, 0u, 0u}; bf16_t* zp = ur + 1024 + ((col & 15) ? 64 : 0);
#pragma unroll
                            for (int i = 0; i < 8; ++i) *(u32x4*)(zp + 8 * i) = z; } } } }
    }
};
struct EpiSwiglu {
    static constexpr bool PERM = true, AFTER_DRAIN = false;
    bf16_t* HID;
    __device__ __forceinline__ void operator()(const f32x4 (&acc)[2][2][4][2], const pg8::Unit& u, int wr, int wc, int fr, int fq) const {
        const int row0 = u.pm * 256 + wr * 64 + fr, col0 = u.pn * 128 + wc * 32 + 8 * fq;
#pragma unroll
        for (int ai = 0; ai < 2; ++ai)
#pragma unroll
            for (int m = 0; m < 4; ++m) { bf16_t* rowp = HID + (size_t)(row0 + ai * 128 + m * 16) * DFF + col0;
                float o[8];
#pragma unroll
                for (int n = 0; n < 2; ++n)
#pragma unroll
                    for (int j = 0; j < 4; ++j) { const float g = acc[ai][0][m][n][j], up = acc[ai][1][m][n][j]; o[n * 4 + j] = g * __builtin_amdgcn_rcpf(1.0f + __expf(-g)) * up; }
                u32x4 w; w.x = cvt_pk_bf16(o[0], o[1]); w.y = cvt_pk_bf16(o[2], o[3]); w.z = cvt_pk_bf16(o[4], o[5]); w.w = cvt_pk_bf16(o[6], o[7]);
                *(u32x4*)rowp = w; }
    }
};
struct EpiGlu {
    static constexpr bool PERM = true, AFTER_DRAIN = false;
    const bf16_t* Z; bf16_t* MIXED; const float* bias;
    __device__ __forceinline__ void operator()(const f32x4 (&acc)[2][2][4][2], const pg8::Unit& u, int wr, int wc, int fr, int fq) const {
        const int row0 = u.pm * 256 + wr * 64 + fr, col0 = u.pn * 256 + wc * 32 + 8 * fq;
#pragma unroll
        for (int bj = 0; bj < 2; ++bj) {
            const f32x4 b0 = *(const f32x4*)(bias + col0 + bj * 128), b1 = *(const f32x4*)(bias + col0 + bj * 128 + 4);
#pragma unroll
            for (int ai = 0; ai < 2; ++ai)
#pragma unroll
                for (int m = 0; m < 4; ++m) { const size_t r = (size_t)(row0 + ai * 128 + m * 16);
                    const u32x4 zz = *(const u32x4*)(Z + r * S5W + col0 + bj * 128);
                    const f32x4 v0 = acc[ai][bj][m][0] + b0, v1 = acc[ai][bj][m][1] + b1;
                    u32x4 w;
                    w.x = cvt_pk_bf16(bf_lo(zz.x) * sigmoidf_(v0[0]), bf_hi(zz.x) * sigmoidf_(v0[1]));
                    w.y = cvt_pk_bf16(bf_lo(zz.y) * sigmoidf_(v0[2]), bf_hi(zz.y) * sigmoidf_(v0[3]));
                    w.z = cvt_pk_bf16(bf_lo(zz.z) * sigmoidf_(v1[0]), bf_hi(zz.z) * sigmoidf_(v1[1]));
                    w.w = cvt_pk_bf16(bf_lo(zz.w) * sigmoidf_(v1[2]), bf_hi(zz.w) * sigmoidf_(v1[3]));
                    *(u32x4*)(MIXED + r * DM + col0 + bj * 128) = w;
                    if (m & 1) asm volatile("" ::: "memory"); }
        }
    }
};
struct EpiDelta {
    static constexpr bool PERM = true, AFTER_DRAIN = false;
    bf16_t* D; const float* gate0;
    __device__ __forceinline__ void operator()(const f32x4 (&acc)[2][2][4][2], const pg8::Unit& u, int wr, int wc, int fr, int fq) const {
        const int row0 = u.pm * 256 + wr * 64 + fr, col0 = u.pn * 256 + wc * 32 + 8 * fq;
        const float* gp = gate0 + (u.pm >= 32 ? 6 * DM : 0) + col0;
        f32x4 g[2][2];
#pragma unroll
        for (int bj = 0; bj < 2; ++bj)
#pragma unroll
            for (int n = 0; n < 2; ++n) g[bj][n] = *(const f32x4*)(gp + bj * 128 + 4 * n) + 1.0f;
#pragma unroll
        for (int ai = 0; ai < 2; ++ai)
#pragma unroll
            for (int m = 0; m < 4; ++m) { bf16_t* rowp = D + (size_t)(row0 + ai * 128 + m * 16) * DM + col0;
#pragma unroll
                for (int bj = 0; bj < 2; ++bj) { const f32x4 v0 = acc[ai][bj][m][0] * g[bj][0], v1 = acc[ai][bj][m][1] * g[bj][1];
                    u32x4 w; w.x = cvt_pk_bf16(v0[0], v0[1]); w.y = cvt_pk_bf16(v0[2], v0[3]); w.z = cvt_pk_bf16(v1[0], v1[1]); w.w = cvt_pk_bf16(v1[2], v1[3]);
                    *(u32x4*)(rowp + bj * 128) = w; } }
    }
};

__device__ __forceinline__ int lane_id_v() { int r; asm volatile("v_mbcnt_lo_u32_b32 %0, -1, 0\n\tv_mbcnt_hi_u32_b32 %0, -1, %0" : "=v"(r)); return r; }
struct Args { const float* in[N_IN]; float* out; unsigned char* ws; int ph_lo, ph_hi; };
struct Ctx {
    volatile LAS unsigned long long* t;
    __device__ __forceinline__ unsigned long long ld(int i) const { const unsigned long long v = t[i];
        return ((unsigned long long)(unsigned)__builtin_amdgcn_readfirstlane((int)(v >> 32)) << 32) | (unsigned long long)(unsigned)__builtin_amdgcn_readfirstlane((int)(unsigned)v); }
    __device__ __forceinline__ const float* in(int i) const { return (const float*)ld(i); }
    __device__ __forceinline__ float* out() const { return (float*)ld(30); }
    __device__ __forceinline__ unsigned char* ws() const { return (unsigned char*)ld(31); }
};

constexpr int S5K = 1152;
constexpr size_t S5_T_LAYER = (size_t)64 * 1024 * S5K * 2, S5_W1_LAYER = (size_t)64 * 256 * S5K * 2;

struct S5Order {
    int G, c, n, sh;
    __device__ __forceinline__ bool next(int i, pg8::Unit& u) const { const int L = i * G + c; if (L >= n) return false; u.pm = L >> sh; u.pn = L; return true; }
    __device__ __forceinline__ void a_ready(const pg8::Unit&) const {}
    __device__ __forceinline__ void done(const pg8::Unit&) const {}
};
struct EpiS5A {
    static constexpr bool PERM = false, AFTER_DRAIN = false;
    float* Sloc;
    __device__ __forceinline__ void operator()(const f32x4 (&acc)[2][2][4][2], const pg8::Unit& u, int wr, int wc, int fr, int fq) const {
        const int row0 = u.pm * 256 + wr * 64 + fr, col0 = wc * 32 + 4 * fq;
#pragma unroll
        for (int ai = 0; ai < 2; ++ai)
#pragma unroll
            for (int m = 0; m < 4; ++m)
#pragma unroll
                for (int n = 0; n < 2; ++n) *(f32x4*)(Sloc + (size_t)(row0 + ai * 128 + m * 16) * 128 + col0 + n * 16) = acc[ai][0][m][n];
    }
};
struct EpiS5C {
    static constexpr bool PERM = true, AFTER_DRAIN = false;
    bf16_t* Z;
    __device__ __forceinline__ void operator()(const f32x4 (&acc)[2][2][4][2], const pg8::Unit& u, int wr, int wc, int fr, int fq) const {
        const int g = u.pm, c0 = wr * 64 + fr, cc0 = (u.pn & 3) * 256 + wc * 32 + 8 * fq;
#pragma unroll
        for (int ai = 0; ai < 2; ++ai)
#pragma unroll
            for (int m = 0; m < 4; ++m) { const int c = c0 + ai * 128 + m * 16;
#pragma unroll
                for (int bj = 0; bj < 2; ++bj) { const int cc = cc0 + bj * 128, t = cc >> 4, h0 = cc & 15;
                    const f32x4 v0 = acc[ai][bj][m][0], v1 = acc[ai][bj][m][1];
                    u32x4 w; w.x = cvt_pk_bf16(gelu_tanh(v0[0]), gelu_tanh(v0[1])); w.y = cvt_pk_bf16(gelu_tanh(v0[2]), gelu_tanh(v0[3]));
                    w.z = cvt_pk_bf16(gelu_tanh(v1[0]), gelu_tanh(v1[1])); w.w = cvt_pk_bf16(gelu_tanh(v1[2]), gelu_tanh(v1[3]));
                    *(u32x4*)(Z + (size_t)(c * 64 + t) * S5W + g * 16 + h0) = w; } }
    }
};
__device__ __forceinline__ void s5_tables_item(const Ctx& a, int lg, LAS unsigned char* lds, int wave, int lane) {
    LAS f32x2* LP = (LAS f32x2*)lds;
    LAS f32x2* BB = (LAS f32x2*)(lds + 33280);
    LAS f32x2* CC = (LAS f32x2*)(lds + 41472);
    LAS float* KT = (LAS float*)(lds + 49664);
    const int tid = wave * 64 + lane, l = lg >> 6, g = lg & 63;
    if (tid < 64) { const int p = tid;
        const double ar = (double)a.in(I_AREAL)[lg * 64 + p], ai = (double)a.in(I_AIMAG)[lg * 64 + p], dt = exp((double)a.in(I_LOGDT)[lg]);
        const double mag = exp(ar * dt), ang = ai * dt, lr = mag * cos(ang), li = mag * sin(ang);
        const double den = ar * ar + ai * ai, nr = lr - 1.0, ni = li, cr = (nr * ar + ni * ai) / den, ci = (ni * ar - nr * ai) / den;
        double pr = 1.0, pi = 0.0;
        for (int tau = 0; tau <= 64; ++tau) { LP[tau * 64 + p] = (f32x2){(float)pr, (float)pi}; const double nr2 = pr * lr - pi * li, ni2 = pr * li + pi * lr; pr = nr2; pi = ni2; }
        for (int h = 0; h < 16; ++h) { const double br = (double)a.in(I_BRE)[((size_t)lg * 64 + p) * 16 + h], bi = (double)a.in(I_BIM)[((size_t)lg * 64 + p) * 16 + h];
            BB[p * 16 + h] = (f32x2){(float)(cr * br - ci * bi), (float)(cr * bi + ci * br)}; }
    }
    for (int e = tid; e < 1024; e += 512) { const int h = e >> 6, p = e & 63; CC[e] = (f32x2){a.in(I_CRE)[((size_t)lg * 16 + h) * 64 + p], a.in(I_CIM)[((size_t)lg * 16 + h) * 64 + p]}; }
    __syncthreads();
    if (tid < 64) *(f32x2*)((float*)(a.ws() + WS_LAM64) + ((size_t)lg * 64 + tid) * 2) = LP[64 * 64 + tid];
    for (int e = tid; e < 64 * 256; e += 512) { const int tau = e >> 8, h = (e >> 4) & 15, hp = e & 15; float s = 0.f;
#pragma unroll 8
        for (int p = 0; p < 64; ++p) { const f32x2 c = CC[h * 64 + p], lm = LP[tau * 64 + p], b = BB[p * 16 + hp];
            const float xr = c.x * lm.x - c.y * lm.y, xi = c.x * lm.y + c.y * lm.x; s += xr * b.x - xi * b.y; }
        if (tau == 0 && h == hp) s += a.in(I_S5D)[l * S5W + g * 16 + h];
        KT[e] = s; }
    __syncthreads();
    bf16_t* T = (bf16_t*)(a.ws() + WS_S5T + (size_t)l * S5_T_LAYER) + (size_t)g * 1024 * S5K;
    for (int pc = tid; pc < 1024 * 144; pc += 512) { const int n = pc / 144, j = pc % 144, t = n >> 4, h = n & 15; float v[8];
        if (j < 128) { const int s = j >> 1, hp0 = (j & 1) * 8;
            if (s > t) {
#pragma unroll
                for (int i = 0; i < 8; ++i) v[i] = 0.f;
            } else { const LAS float* kp = KT + (t - s) * 256 + h * 16 + hp0; const f32x4 k0 = *(const LAS f32x4*)kp, k1 = *(const LAS f32x4*)(kp + 4);
                v[0] = k0[0]; v[1] = k0[1]; v[2] = k0[2]; v[3] = k0[3]; v[4] = k1[0]; v[5] = k1[1]; v[6] = k1[2]; v[7] = k1[3]; }
        } else { const int p0 = (j - 128) * 4;
#pragma unroll
            for (int i = 0; i < 4; ++i) { const f32x2 c = CC[h * 64 + p0 + i], lm = LP[(t + 1) * 64 + p0 + i]; v[2 * i] = c.x * lm.x - c.y * lm.y; v[2 * i + 1] = -(c.x * lm.y + c.y * lm.x); } }
        *(u32x4*)(T + (size_t)n * S5K + j * 8) = (u32x4){cvt_pk_bf16(v[0], v[1]), cvt_pk_bf16(v[2], v[3]), cvt_pk_bf16(v[4], v[5]), cvt_pk_bf16(v[6], v[7])}; }
    bf16_t* W1 = (bf16_t*)(a.ws() + WS_S5W1 + (size_t)l * S5_W1_LAYER) + (size_t)g * 256 * S5K;
    for (int pc = tid; pc < 256 * 144; pc += 512) { const int n = pc / 144, j = pc % 144; float v[8];
#pragma unroll
        for (int i = 0; i < 8; ++i) v[i] = 0.f;
        if (n < 128 && j < 128) { const int p = n >> 1, ri = n & 1, s = j >> 1, hp0 = (j & 1) * 8; const f32x2 lm = LP[(63 - s) * 64 + p];
#pragma unroll
            for (int i = 0; i < 8; ++i) { const f32x2 b = BB[p * 16 + hp0 + i]; v[i] = ri ? (lm.x * b.y + lm.y * b.x) : (lm.x * b.x - lm.y * b.y); } }
        *(u32x4*)(W1 + (size_t)n * S5K + j * 8) = (u32x4){cvt_pk_bf16(v[0], v[1]), cvt_pk_bf16(v[2], v[3]), cvt_pk_bf16(v[4], v[5]), cvt_pk_bf16(v[6], v[7])}; }
    __syncthreads();
}
__device__ __forceinline__ void s5_scan_item(const Ctx& a, int l, int item, int wave, int lane) {
    const int idx = item * 512 + wave * 64 + lane, g = idx >> 7, b = (idx >> 6) & 1, p = idx & 63;
    const f32x2 lam = *(const f32x2*)((const float*)(a.ws() + WS_LAM64) + ((size_t)(l * 64 + g) * 64 + p) * 2);
    const float* sl = (const float*)(a.ws() + WS_SLOC) + ((size_t)(g * 256 + b * 128)) * 128 + 2 * p;
    bf16_t* ux = (bf16_t*)(a.ws() + WS_UX) + ((size_t)(g * 256 + b * 128)) * S5K + 1024 + 2 * p;
    float xr = 0.f, xi = 0.f;
    for (int c0 = 0; c0 < 128; c0 += 8) { f32x2 s[8];
#pragma unroll
        for (int i = 0; i < 8; ++i) s[i] = *(const f32x2*)(sl + (size_t)(c0 + i) * 128);
#pragma unroll
        for (int i = 0; i < 8; ++i) { *(unsigned*)(ux + (size_t)(c0 + i) * S5K) = cvt_pk_bf16(xr, xi);
            const float nr = lam.x * xr - lam.y * xi + s[i].x, ni = lam.x * xi + lam.y * xr + s[i].y; xr = nr; xi = ni; } }
}

__device__ __forceinline__ void transpose_item(const float* W, int N, int k0, int n0, bf16_t* WT, int drow0, int Kd, LAS float* scr, int lane) {
    const int nl = 4 * (lane & 15), kq = lane >> 4;
    const bool valid = (n0 + nl) < N;
    f32x4 v[16];
#pragma unroll
    for (int i = 0; i < 16; ++i) { const int k = 4 * i + kq; v[i] = valid ? *(const f32x4*)(W + (size_t)(k0 + k) * N + n0 + nl) : (f32x4){0.f, 0.f, 0.f, 0.f}; }
#pragma unroll
    for (int i = 0; i < 16; ++i) { const int k = 4 * i + kq; LAS float* s = scr + k * 65 + nl; s[0] = v[i][0]; s[1] = v[i][1]; s[2] = v[i][2]; s[3] = v[i][3]; }
    LDS_WAIT();
    const int c = lane & 7;
#pragma unroll
    for (int j = 0; j < 8; ++j) { const int n = (lane >> 3) + 8 * j; const LAS float* s = scr + (8 * c) * 65 + n;
        u32x4 o; o.x = cvt_pk_bf16(s[0], s[65]); o.y = cvt_pk_bf16(s[130], s[195]); o.z = cvt_pk_bf16(s[260], s[325]); o.w = cvt_pk_bf16(s[390], s[455]);
        *(u32x4*)(WT + (size_t)(drow0 + n) * Kd + k0 + 8 * c) = o; }
    LDS_WAIT();
}
constexpr int NIT_IN = 64 * 188, NIT_OUT = 64 * 64, NIT_G = 64 * 172, NIT_DN = 172 * 64, NIT_GLU = 16 * 16;
constexpr int NIT_LAYER = NIT_IN + NIT_OUT + 2 * NIT_G + NIT_DN + NIT_GLU;
constexpr int NIT_TR = DEPTH * NIT_LAYER, NIT_COND = 64 * 96;

__device__ __forceinline__ void phase_prologue(const Ctx& a, LAS unsigned char* lds, int wave, int lane) {
    if (blockIdx.x & 1) { for (int lg = blockIdx.x; lg < DEPTH * 64; lg += gridDim.x) s5_tables_item(a, lg, lds, wave, lane); __syncthreads(); }
    LAS float* scr = (LAS float*)(lds + wave * 16640);
    const int gw = blockIdx.x * 8 + wave, NGW = gridDim.x * 8;
    for (int it = gw; it < NIT_TR + NIT_COND; it += NGW) {
        if (it < NIT_TR) {
            const int l = it / NIT_LAYER; int r = it % NIT_LAYER;
            unsigned char* wt = a.ws() + WS_WT + (size_t)l * WT_LAYER;
            if (r < NIT_IN) { const int kb = r / 188, nb = r % 188; transpose_item(a.in(I_WIN) + (size_t)l * DM * INW, INW, 64 * kb, 64 * nb, (bf16_t*)(wt + WT_IN), 64 * nb, DM, scr, lane); continue; } r -= NIT_IN;
            if (r < NIT_OUT) { const int kb = r / 64, nb = r % 64; transpose_item(a.in(I_WOUT) + (size_t)l * DM * DM, DM, 64 * kb, 64 * nb, (bf16_t*)(wt + WT_OUT), 64 * nb, DM, scr, lane); continue; } r -= NIT_OUT;
            if (r < NIT_G) { const int kb = r / 172, nb = r % 172, n0 = 64 * nb; transpose_item(a.in(I_WFG) + (size_t)l * DM * DFF, DFF, 64 * kb, n0, (bf16_t*)(wt + WT_GU), 256 * (n0 / 128) + (n0 % 128), DM, scr, lane); continue; } r -= NIT_G;
            if (r < NIT_G) { const int kb = r / 172, nb = r % 172, n0 = 64 * nb; transpose_item(a.in(I_WFU) + (size_t)l * DM * DFF, DFF, 64 * kb, n0, (bf16_t*)(wt + WT_GU), 256 * (n0 / 128) + 128 + (n0 % 128), DM, scr, lane); continue; } r -= NIT_G;
            if (r < NIT_DN) { const int kb = r / 64, nb = r % 64; transpose_item(a.in(I_WFD) + (size_t)l * DFF * DM, DM, 64 * kb, 64 * nb, (bf16_t*)(wt + WT_DN), 64 * nb, DFF, scr, lane); continue; } r -= NIT_DN;
            { const int kb = r / 16, nb = r % 16; transpose_item(a.in(I_GLUW) + (size_t)l * S5W * S5W, S5W, 64 * kb, 64 * nb, (bf16_t*)(wt + WT_GLU), 64 * nb, S5W, scr, lane); }
        } else {
            const int item = it - NIT_TR, kb = item / 96, jb = item % 96, k0 = 64 * kb, j0 = 256 * jb + 4 * lane;
            const float* c = a.in(I_C);
            float c0 = c[k0 + lane], c1 = c[DM + k0 + lane];
            c0 = c0 / (1.0f + expf(-c0)); c1 = c1 / (1.0f + expf(-c1));
            f32x4 a0 = (f32x4){0.f, 0.f, 0.f, 0.f}, a1 = a0;
            const float* w = a.in(I_WADA) + (size_t)k0 * (6 * DM) + j0;
#pragma unroll 8
            for (int kk = 0; kk < 64; ++kk) { const f32x4 wv = *(const f32x4*)(w + (size_t)kk * (6 * DM));
                const float s0 = __int_as_float(__builtin_amdgcn_readlane(__float_as_int(c0), kk)), s1 = __int_as_float(__builtin_amdgcn_readlane(__float_as_int(c1), kk));
                a0 += wv * s0; a1 += wv * s1; }
            float* cp = (float*)(a.ws() + WS_CONDPART);
            *(f32x4*)(cp + (size_t)(kb * 2 + 0) * (6 * DM) + j0) = a0;
            *(f32x4*)(cp + (size_t)(kb * 2 + 1) * (6 * DM) + j0) = a1;
        }
    }
    __syncthreads();
    if (!(blockIdx.x & 1)) { for (int lg = blockIdx.x; lg < DEPTH * 64; lg += gridDim.x) s5_tables_item(a, lg, lds, wave, lane); }
}
__device__ __forceinline__ void phase_mod(const Ctx& a, int wave, int lane) {
    const int gt = blockIdx.x * 512 + wave * 64 + lane, NT = gridDim.x * 512;
    const float* cp = (const float*)(a.ws() + WS_CONDPART);
    float* mod = (float*)(a.ws() + WS_MOD); float* misc = (float*)(a.ws() + WS_MISC);
    for (int idx = gt; idx < NB * 6 * DM; idx += NT) {
        const int b = idx / (6 * DM), j = idx % (6 * DM);
        float s = a.in(I_BADA)[j];
        for (int kb = 0; kb < 64; ++kb) s += cp[(size_t)(kb * 2 + b) * (6 * DM) + j];
        for (int l = 0; l < DEPTH; ++l) mod[(size_t)((l * 2 + b) * 6) * DM + j] = s + a.in(I_TABLE)[(size_t)l * 6 * DM + j];
    }
    for (int idx = gt; idx < DM; idx += NT) { misc[idx] = 1.0f; misc[DM + idx] = 0.0f; }
    for (int idx = gt; idx < HGW; idx += NT) {
        const float* raw = a.in(I_LBRAW); float r[DEPTH], mx = -3.0e38f;
#pragma unroll
        for (int l = 0; l < DEPTH; ++l) { r[l] = raw[l * HGW + idx]; mx = fmaxf(mx, r[l]); }
        float e[DEPTH], sum = 0.f;
#pragma unroll
        for (int l = 0; l < DEPTH; ++l) { e[l] = expf(r[l] - mx); sum += e[l]; }
        float cum = 0.f;
#pragma unroll
        for (int l = 0; l < DEPTH; ++l) { misc[2 * DM + l * HGW + idx] = cum; if (l + 1 < DEPTH) cum += e[l + 1] / sum; }
    }
}

__device__ __forceinline__ void phase_h0(const float* x, const float* modp, bf16_t* H, int wave, int lane) {
    for (int blk = blockIdx.x; blk < MTOK / 64; blk += gridDim.x) {
        const int r0 = blk * 64, b = (r0 >= SEQ) ? 1 : 0;
        f32x4 A[2], B[2];
#pragma unroll
        for (int jj = 0; jj < 2; ++jj) { const int c = 512 * wave + 256 * jj + 4 * lane; A[jj] = *(const f32x4*)(modp + (size_t)(b * 6 + 1) * DM + c) + 1.0f; B[jj] = *(const f32x4*)(modp + (size_t)(b * 6 + 0) * DM + c); }
#pragma unroll 8
        for (int rl = 0; rl < 64; ++rl) { const size_t off = (size_t)(r0 + rl) * DM + 512 * wave + 4 * lane;
#pragma unroll
            for (int jj = 0; jj < 2; ++jj) { const f32x4 v = *(const f32x4*)(x + off + 256 * jj), y = v * A[jj] + B[jj];
                u32x2 w; w.x = cvt_pk_bf16(y[0], y[1]); w.y = cvt_pk_bf16(y[2], y[3]); *(u32x2*)(H + off + 256 * jj) = w; } }
    }
}
template <bool WITH_H>
__device__ __forceinline__ void phase_lnres(const float* xprev, const bf16_t* delta, float* xout, const float* lng, const float* lnb, const float* modp, int i_shift, int i_scale, bf16_t* H,
                                            LAS unsigned char* lds, int wave, int lane) {
    LAS f32x2* red = (LAS f32x2*)lds;
    for (int blk = blockIdx.x; blk < MTOK / 64; blk += gridDim.x) {
        const int r0 = blk * 64, b = (r0 >= SEQ) ? 1 : 0;
        f32x4 G[2], Bt[2], A[2], B[2];
#pragma unroll
        for (int jj = 0; jj < 2; ++jj) { const int c = 512 * wave + 256 * jj + 4 * lane; G[jj] = *(const f32x4*)(lng + c); Bt[jj] = *(const f32x4*)(lnb + c);
            if (WITH_H) { A[jj] = *(const f32x4*)(modp + (size_t)(b * 6 + i_scale) * DM + c) + 1.0f; B[jj] = *(const f32x4*)(modp + (size_t)(b * 6 + i_shift) * DM + c); } }
        for (int it = 0; it < 8; ++it) {
            const size_t off0 = (size_t)(r0 + it * 8) * DM + 512 * wave + 4 * lane;
            f32x4 v[8][2]; u32x2 dl[8][2];
#pragma unroll
            for (int r = 0; r < 8; ++r)
#pragma unroll
                for (int jj = 0; jj < 2; ++jj) { v[r][jj] = *(const f32x4*)(xprev + off0 + (size_t)r * DM + 256 * jj); dl[r][jj] = *(const u32x2*)(delta + off0 + (size_t)r * DM + 256 * jj); }
            LAS f32x2* rb = red + (it & 1) * 64;
#pragma unroll
            for (int r = 0; r < 8; ++r) { float s1 = 0.f, s2 = 0.f;
#pragma unroll
                for (int jj = 0; jj < 2; ++jj) { const f32x4 d = (f32x4){bf_lo(dl[r][jj].x), bf_hi(dl[r][jj].x), bf_lo(dl[r][jj].y), bf_hi(dl[r][jj].y)}; const f32x4 y = v[r][jj] * ALPHA + d; v[r][jj] = y;
                    s1 += (y[0] + y[1]) + (y[2] + y[3]); s2 += (y[0] * y[0] + y[1] * y[1]) + (y[2] * y[2] + y[3] * y[3]); }
                s1 = wave_sum(s1); s2 = wave_sum(s2);
                if (lane == 0) rb[r * 8 + wave] = (f32x2){s1, s2}; }
            __syncthreads();
#pragma unroll
            for (int r = 0; r < 8; ++r) { float s1 = 0.f, s2 = 0.f;
#pragma unroll
                for (int w = 0; w < 8; ++w) { const f32x2 p = rb[r * 8 + w]; s1 += p.x; s2 += p.y; }
                const float mu = s1 * (1.0f / DM), rs = 1.0f / sqrtf(fmaxf(s2 * (1.0f / DM) - mu * mu, 0.f) + LN_EPS);
#pragma unroll
                for (int jj = 0; jj < 2; ++jj) { const f32x4 x = ((v[r][jj] - mu) * rs) * G[jj] + Bt[jj];
                    *(f32x4*)(xout + off0 + (size_t)r * DM + 256 * jj) = x;
                    if (WITH_H) { const f32x4 y = x * A[jj] + B[jj]; u32x2 w; w.x = cvt_pk_bf16(y[0], y[1]); w.y = cvt_pk_bf16(y[2], y[3]); *(u32x2*)(H + off0 + (size_t)r * DM + 256 * jj) = w; } } }
        }
        __syncthreads();
    }
}

typedef short bf16x8 __attribute__((ext_vector_type(8)));
typedef short bf16x4 __attribute__((ext_vector_type(4)));
constexpr int HG_BLK = 16896, HG_OQ = 0, HG_OK = 4096, HG_OKT = 8192, HG_OVT = 12288, HG_ODL = 16384;
constexpr int GL_BLK = 32768, GL_OQ = 0, GL_OK = 6400, GL_OKT = 12800, GL_ODL = 18944, GL_SHARED = 20480, GL_OVT = 20480;
constexpr int NSUB = SEQ / 16;

__device__ __forceinline__ unsigned short f2bf1(float x) { return (unsigned short)(cvt_pk_bf16(x, x) & 0xffffu); }

__device__ __forceinline__ void pre_finish(const float (&qq)[16], const float (&kk)[16], float (&g)[16], unsigned char* blk, int oq, int ok, int okt, int odl, int rowb, int d, bool swz) {
    float b = 0.f;
#pragma unroll
    for (int j = 0; j < 16; ++j) { b += g[j]; g[j] = b; }
    const float bl = b;
    unsigned kt[8];
#pragma unroll
    for (int j = 0; j < 16; j += 2) {
        float kv[2];
#pragma unroll
        for (int jj = 0; jj < 2; ++jj) { const int t = j + jj; const float bj = g[t];
            const int off = t * rowb + (swz ? ((2 * d) ^ (t << 4)) : 2 * d);
            const float qv = qq[t] * __expf(bj), kc = kk[t] * __expf(fminf(-bj, 80.f));
            const float qn = __int_as_float(__builtin_amdgcn_mov_dpp(__float_as_int(qv), 0xB1, 0xF, 0xF, true)), kn = __int_as_float(__builtin_amdgcn_mov_dpp(__float_as_int(kc), 0xB1, 0xF, 0xF, true));
            if ((d & 1) == 0) { *(unsigned*)(blk + oq + off) = cvt_pk_bf16(qv, qn); *(unsigned*)(blk + ok + off) = cvt_pk_bf16(kc, kn); }
            kv[jj] = kk[t] * __expf(bl - bj); }
        kt[j >> 1] = cvt_pk_bf16(kv[0], kv[1]); }
    *(u32x4*)(blk + okt + d * 32) = (u32x4){kt[0], kt[1], kt[2], kt[3]};
    *(u32x4*)(blk + okt + d * 32 + 16) = (u32x4){kt[4], kt[5], kt[6], kt[7]};
    *(float*)(blk + odl + d * 4) = __expf(bl);
}
__device__ __forceinline__ void phase_pre(const Ctx& a, int l, int wave, int lane) {
    const bf16_t* P = (const bf16_t*)(a.ws() + WS_P);
    int tid = wave * 64 + lane;
    const bool bal = gridDim.x == 256;
    const int t_lo = bal ? (blockIdx.x < 64 ? 26 * (int)blockIdx.x : 1664 + 34 * ((int)blockIdx.x - 64)) : (int)blockIdx.x;
    const int t_hi = bal ? t_lo + (blockIdx.x < 64 ? 26 : 34) : NB * NSUB * 8, t_st = bal ? 1 : (int)gridDim.x;
    for (int task = t_lo; task < t_hi; task += t_st) {
        asm volatile("" : "+v"(tid));
        const int kind = bal ? (task & 7) : ((task + (task >> 8)) & 7), bsc = task >> 3, b = bsc / NSUB, sc = bsc % NSUB;
        const size_t row0 = (size_t)b * SEQ + sc * 16;
        if (kind < 3) {
            const int ch = kind * 512 + tid, h = ch >> 7, d = ch & 127;
            const float lb = ((const float*)(a.ws() + WS_MISC))[2 * DM + l * HGW + ch];
            unsigned char* blk = a.ws() + WS_HGB + ((size_t)(b * 12 + h) * NSUB + sc) * HG_BLK;
            float g[16], qq[16], kk[16]; unsigned vv[8];
#pragma unroll
            for (int j = 0; j < 16; ++j) { const bf16_t* prow = P + (row0 + j) * INP;
                const float qin = fmaxf(bf2f(prow[C_QB + ch]), -80.f), fin = fminf(fmaxf(bf2f(prow[C_FB + ch]), -80.f), 80.f);
                const unsigned short v = prow[C_IB + ch]; if (j & 1) vv[j >> 1] |= ((unsigned)v) << 16; else vv[j >> 1] = v;
                const float e = __expf(-fin), sg = __builtin_amdgcn_rcpf(1.0f + e);
                const float f = lb + (1.0f - lb) * sg;
                g[j] = fmaxf(__logf(f), -100.f); kk[j] = (1.0f - lb) * (e * sg); qq[j] = qin * __builtin_amdgcn_rcpf(1.0f + __expf(-qin)); }
            *(u32x4*)(blk + HG_OVT + d * 32) = (u32x4){vv[0], vv[1], vv[2], vv[3]};
            *(u32x4*)(blk + HG_OVT + d * 32 + 16) = (u32x4){vv[4], vv[5], vv[6], vv[7]};
            pre_finish(qq, kk, g, blk, HG_OQ, HG_OK, HG_OKT, HG_ODL, 256, d, true);
        } else if (kind < 5) {
            if (tid < 384) {
                const int ch = (kind - 3) * 384 + tid, h = ch / 192, d = ch % 192;
                unsigned char* blk = a.ws() + WS_GLB + ((size_t)(b * 4 + h) * NSUB + sc) * GL_BLK;
                float wg[16];
#pragma unroll
                for (int r = 0; r < 16; ++r) wg[r] = a.in(I_WGATE)[((size_t)l * 16 + r) * GLKW + ch];
                const float bgv = a.in(I_BGATE)[l * GLKW + ch];
                float g[16], qq[16], kk[16];
#pragma unroll
                for (int j = 0; j < 16; ++j) { const bf16_t* prow = P + (row0 + j) * INP;
                    const u32x4 l0 = *(const u32x4*)(prow + C_LR), l1 = *(const u32x4*)(prow + C_LR + 8);
                    float x = bgv;
                    x += bf_lo(l0.x) * wg[0] + bf_hi(l0.x) * wg[1] + bf_lo(l0.y) * wg[2] + bf_hi(l0.y) * wg[3] + bf_lo(l0.z) * wg[4] + bf_hi(l0.z) * wg[5] + bf_lo(l0.w) * wg[6] + bf_hi(l0.w) * wg[7];
                    x += bf_lo(l1.x) * wg[8] + bf_hi(l1.x) * wg[9] + bf_lo(l1.y) * wg[10] + bf_hi(l1.y) * wg[11] + bf_lo(l1.z) * wg[12] + bf_hi(l1.z) * wg[13] + bf_lo(l1.w) * wg[14] + bf_hi(l1.w) * wg[15];
                    g[j] = (fminf(x, 0.f) - __logf(1.0f + __expf(-fabsf(x)))) * 0.0625f;
                    qq[j] = bf2f(prow[C_QC + ch]) * GLA_QSCALE; kk[j] = bf2f(prow[C_KC + ch]); }
                pre_finish(qq, kk, g, blk, GL_OQ, GL_OK, GL_OKT, GL_ODL, 400, d, false);
            }
        } else {
            const int ch = (kind - 5) * 512 + tid, h = ch / 384, e = ch % 384;
            unsigned char* blk = a.ws() + WS_GLB + ((size_t)(b * 4 + h) * NSUB + sc) * GL_BLK;
            unsigned vv[8];
#pragma unroll
            for (int j = 0; j < 16; ++j) { const unsigned short v = P[(row0 + j) * INP + C_VC + ch]; if (j & 1) vv[j >> 1] |= ((unsigned)v) << 16; else vv[j >> 1] = v; }
            *(u32x4*)(blk + GL_OVT + e * 32) = (u32x4){vv[0], vv[1], vv[2], vv[3]};
            *(u32x4*)(blk + GL_OVT + e * 32 + 16) = (u32x4){vv[4], vv[5], vv[6], vv[7]};
        }
    }
}

template <int DK, int MODE>
__device__ __forceinline__ void chain_sub(const LAS unsigned char* sb, f32x4 (&S)[DK / 16], float* op, int wave, int n, int q) {
    constexpr bool IS_GLA = (DK == 192);
    constexpr int NKS = DK / 32, NMB = DK / 16, ROWB = IS_GLA ? 400 : 256;
    constexpr int OQ = 0, OK = IS_GLA ? GL_OK : HG_OK, OKT = IS_GLA ? GL_OKT : HG_OKT, OVT = IS_GLA ? GL_OVT : HG_OVT, ODL = IS_GLA ? GL_ODL : HG_ODL;
    const u32x2 vfr = *(const LAS u32x2*)(sb + OVT + (16 * wave + n) * 32 + 8 * q);
    const bf16x8 vf8 = __builtin_bit_cast(bf16x8, (u32x4){vfr.x, vfr.y, 0u, 0u});
    if (MODE == 1) {
        bf16x8 qf[NKS], kf[NKS];
#pragma unroll
        for (int ks = 0; ks < NKS; ++ks) { const int c0 = 2 * (32 * ks + 4 * q), c1 = c0 + 32;
            const int o0 = n * ROWB + (IS_GLA ? c0 : (c0 ^ (n << 4))), o1 = n * ROWB + (IS_GLA ? c1 : (c1 ^ (n << 4)));
            const u32x2 ql = *(const LAS u32x2*)(sb + OQ + o0), qh = *(const LAS u32x2*)(sb + OQ + o1), kl = *(const LAS u32x2*)(sb + OK + o0), kh = *(const LAS u32x2*)(sb + OK + o1);
            qf[ks] = __builtin_bit_cast(bf16x8, (u32x4){ql.x, ql.y, qh.x, qh.y}); kf[ks] = __builtin_bit_cast(bf16x8, (u32x4){kl.x, kl.y, kh.x, kh.y}); }
        f32x4 ao = (f32x4){0.f, 0.f, 0.f, 0.f}, ap = ao, ao1 = ao, ap1 = ao;
#pragma unroll
        for (int ks = 0; ks < NKS; ++ks) {
            const bf16x8 sbf = __builtin_bit_cast(bf16x8, (u32x4){cvt_pk_bf16(S[2 * ks][0], S[2 * ks][1]), cvt_pk_bf16(S[2 * ks][2], S[2 * ks][3]), cvt_pk_bf16(S[2 * ks + 1][0], S[2 * ks + 1][1]), cvt_pk_bf16(S[2 * ks + 1][2], S[2 * ks + 1][3])});
            if (ks & 1) { ao1 = __builtin_amdgcn_mfma_f32_16x16x32_bf16(qf[ks], sbf, ao1, 0, 0, 0); ap1 = __builtin_amdgcn_mfma_f32_16x16x32_bf16(kf[ks], qf[ks], ap1, 0, 0, 0); }
            else { ao = __builtin_amdgcn_mfma_f32_16x16x32_bf16(qf[ks], sbf, ao, 0, 0, 0); ap = __builtin_amdgcn_mfma_f32_16x16x32_bf16(kf[ks], qf[ks], ap, 0, 0, 0); } }
        ao = ao + ao1; ap = ap + ap1;
#pragma unroll
        for (int r = 0; r < 4; ++r) if (4 * q + r > n) ap[r] = 0.f;
        const bf16x8 pa8 = __builtin_bit_cast(bf16x8, (u32x4){cvt_pk_bf16(ap[0], ap[1]), cvt_pk_bf16(ap[2], ap[3]), 0u, 0u});
        ao = __builtin_amdgcn_mfma_f32_16x16x32_bf16(pa8, vf8, ao, 0, 0, 0);
#pragma unroll
        for (int r = 0; r < 4; ++r) op[(size_t)(4 * q + r) * OW] = ao[r];
    }
#pragma unroll
    for (int mb = 0; mb < NMB; ++mb) {
        const f32x4 dl = *(const LAS f32x4*)(sb + ODL + (16 * mb + 4 * q) * 4);
        const u32x2 ktr = *(const LAS u32x2*)(sb + OKT + (16 * mb + n) * 32 + 8 * q);
        S[mb] = __builtin_amdgcn_mfma_f32_16x16x32_bf16(__builtin_bit_cast(bf16x8, (u32x4){ktr.x, ktr.y, 0u, 0u}), vf8, S[mb] * dl, 0, 0, 0); }
}
constexpr size_t ST_REC = 98304;
constexpr int NSEG_HG = 4, NSEG_GL = 6, NSEG_MAX = 6;
__device__ __forceinline__ int seg_u0(bool gla, int s) { return gla ? (s <= 2 ? 44 * s : 88 + 42 * (s - 2)) : 64 * s; }
__device__ __forceinline__ int seg_nu(bool gla, int s) { return gla ? (s < 2 ? 44 : 42) : 64; }
template <int DK, int MODE>
__device__ __forceinline__ void chain_item(const unsigned char* blk0, int vt_off, float* op0, unsigned char* st, int seg, int nunits, LAS unsigned char* lds, int wave, int lane) {
    asm volatile("" : "+v"(lane), "+s"(wave));
    constexpr bool IS_GLA = (DK == 192);
    constexpr int BLK = IS_GLA ? GL_BLK : HG_BLK, SUBB = IS_GLA ? GL_SHARED + 4096 : HG_BLK, NMB = DK / 16;
    constexpr int SH0 = MODE == 1 ? 0 : (IS_GLA ? GL_OKT : HG_OKT);
    constexpr int SH_PIECES = (MODE == 1 ? (IS_GLA ? GL_SHARED : HG_OVT) : (IS_GLA ? GL_ODL + 768 - GL_OKT : 4096)) / 16;
    constexpr int T_PIECES = IS_GLA ? 256 : (4096 + 512) / 16;
    constexpr int T_LDS = IS_GLA ? GL_OVT : HG_OVT;
    constexpr int PIECES = SH_PIECES + T_PIECES, UNITB = 2 * SUBB, NP = (2 * PIECES + 511) / 512;
    const int tid = wave * 64 + lane, n = lane & 15, q = lane >> 4;
    f32x4 S[NMB]; float dacc = 1.0f;
    constexpr int ODL_ = IS_GLA ? GL_ODL : HG_ODL;
#pragma unroll
    for (int mb = 0; mb < NMB; ++mb) S[mb] = (f32x4){0.f, 0.f, 0.f, 0.f};
    if (MODE == 1) {
        for (int s = 0; s < seg; ++s) { const unsigned char* rec = st + (size_t)s * 2 * ST_REC + (size_t)(wave * 64 + lane) * 16;
#pragma unroll
            for (int mb = 0; mb < NMB; ++mb) { const f32x4 h = *(const f32x4*)(rec + (size_t)mb * 8192), d = *(const f32x4*)(st + (size_t)s * 2 * ST_REC + ST_REC + (16 * mb + 4 * q) * 4); S[mb] = S[mb] * d + h; } }
    }
    u32x4 stgA[NP], stgB[NP];
#define CH_SRC(u, p_) (blk0 + (size_t)((u) * 2 + (p_) / PIECES) * BLK + (((p_) % PIECES) < SH_PIECES ? SH0 + ((p_) % PIECES) * 16 : (IS_GLA ? vt_off : HG_OVT) + (((p_) % PIECES) - SH_PIECES) * 16))
#define CH_DST(p_) (((p_) / PIECES) * SUBB + (((p_) % PIECES) < SH_PIECES ? SH0 + ((p_) % PIECES) * 16 : T_LDS + (((p_) % PIECES) - SH_PIECES) * 16))
#define CH_LOAD(stg, u) do { _Pragma("unroll") for (int r_ = 0; r_ < NP; ++r_) { const int p_ = r_ * 512 + tid; const bool ok_ = (NP * 512 == 2 * PIECES) || p_ < 2 * PIECES; const int pc_ = ok_ ? p_ : 0; stg[r_] = *(const u32x4*)CH_SRC(u, pc_); } } while (0)
#define CH_STORE(stg, buf) do { _Pragma("unroll") for (int r_ = 0; r_ < NP; ++r_) { const int p_ = r_ * 512 + tid; const bool ok_ = (NP * 512 == 2 * PIECES) || p_ < 2 * PIECES; const int pc_ = ok_ ? p_ : 0; \
        const int d_ = ok_ ? (buf) * UNITB + CH_DST(pc_) : 2 * UNITB + (p_ - 2 * PIECES) * 16; *(LAS u32x4*)(lds + d_) = stg[r_]; } } while (0)
#define CH_SYNC() do { asm volatile("s_waitcnt lgkmcnt(0)" ::: "memory"); __builtin_amdgcn_s_barrier(); asm volatile("" ::: "memory"); } while (0)
    CH_LOAD(stgA, 0); CH_STORE(stgA, 0);
    CH_LOAD(stgA, 1);
    CH_SYNC();
    float* op = op0 + 16 * wave + n;
    for (int u = 0; u < nunits; u += 2) {
        if (u + 2 < nunits) CH_LOAD(stgB, u + 2);
        chain_sub<DK, MODE>(lds, S, op + (size_t)(u * 32) * OW, wave, n, q);
        chain_sub<DK, MODE>(lds + SUBB, S, op + (size_t)(u * 32 + 16) * OW, wave, n, q);
        if (MODE == 0 && tid < DK) dacc *= *(const LAS float*)(lds + ODL_ + 4 * tid) * *(const LAS float*)(lds + SUBB + ODL_ + 4 * tid);
        CH_STORE(stgA, 1);
        CH_SYNC();
        if (u + 3 < nunits) CH_LOAD(stgA, u + 3);
        chain_sub<DK, MODE>(lds + UNITB, S, op + (size_t)(u * 32 + 32) * OW, wave, n, q);
        chain_sub<DK, MODE>(lds + UNITB + SUBB, S, op + (size_t)(u * 32 + 48) * OW, wave, n, q);
        if (MODE == 0 && tid < DK) dacc *= *(const LAS float*)(lds + UNITB + ODL_ + 4 * tid) * *(const LAS float*)(lds + UNITB + SUBB + ODL_ + 4 * tid);
        if (u + 2 < nunits) CH_STORE(stgB, 0);
        CH_SYNC();
    }
    if (MODE == 0) { unsigned char* rec = st + (size_t)seg * 2 * ST_REC + (size_t)(wave * 64 + lane) * 16;
#pragma unroll
        for (int mb = 0; mb < NMB; ++mb) *(f32x4*)(rec + (size_t)mb * 8192) = S[mb];
        if (tid < DK) *(float*)(st + (size_t)seg * 2 * ST_REC + ST_REC + 4 * tid) = dacc; }
#undef CH_SRC
#undef CH_DST
#undef CH_LOAD
#undef CH_STORE
#undef CH_SYNC
}

template <int MODE>
__device__ __forceinline__ void phase_chain(const Ctx& a, int l, LAS unsigned char* lds, int wave, int lane) {
    const int bx = blockIdx.x, G = gridDim.x;
    constexpr int nhg = 24 * (MODE == 0 ? NSEG_HG - 1 : NSEG_HG), nitems = nhg + 24 * (MODE == 0 ? NSEG_GL - 1 : NSEG_GL);
    for (int it = bx; it < nitems; it += G) {
        const bool gla = it >= nhg; const int j = gla ? it - nhg : it, c = j % 24, seg = j / 24, u0 = seg_u0(gla, seg), nu = seg_nu(gla, seg);
        unsigned char* st = a.ws() + WS_ST + (size_t)(gla ? 24 + c : c) * (NSEG_MAX - 1) * 2 * ST_REC;
        if (!gla) { const int b = c / 12, h = c % 12;
            chain_item<128, MODE>(a.ws() + WS_HGB + ((size_t)(b * 12 + h) * NSUB + 2 * u0) * HG_BLK, 0, (float*)(a.ws() + WS_O) + ((size_t)b * SEQ + u0 * 32) * OW + h * 128, st, seg, nu, lds, wave, lane); }
        else { const int b = c / 12, h = (c % 12) / 3, sl = c % 3;
            chain_item<192, MODE>(a.ws() + WS_GLB + ((size_t)(b * 4 + h) * NSUB + 2 * u0) * GL_BLK, GL_OVT + 4096 * sl, (float*)(a.ws() + WS_O) + ((size_t)b * SEQ + u0 * 32) * OW + HGW + h * 384 + sl * 128, st, seg, nu, lds, wave, lane); }
        __syncthreads();
    }
    if (MODE == 0) { for (int it = (G >= nitems + 16) ? bx - nitems : bx; it < 16; it += G) { if (it < 0) continue; s5_scan_item(a, l, it, wave, lane); } }
}
__device__ __forceinline__ float red16(float v) {
    v += __int_as_float(__builtin_amdgcn_mov_dpp(__float_as_int(v), 0xB1, 0xF, 0xF, true)); v += __int_as_float(__builtin_amdgcn_mov_dpp(__float_as_int(v), 0x4E, 0xF, 0xF, true));
    v += __int_as_float(__builtin_amdgcn_mov_dpp(__float_as_int(v), 0x141, 0xF, 0xF, true)); v += __int_as_float(__builtin_amdgcn_mov_dpp(__float_as_int(v), 0x140, 0xF, 0xF, true)); return v; }
__device__ __forceinline__ void phase_finalize(const Ctx& a, int l, int wave, int lane) {
    const bf16_t* P = (const bf16_t*)(a.ws() + WS_P); const float* O = (const float*)(a.ws() + WS_O); bf16_t* MX = (bf16_t*)(a.ws() + WS_MIXED);
    const float* hgg = a.in(I_HGG) + l * HGW; const float* hgb = a.in(I_HGB) + l * HGW; const float* glg = a.in(I_GLG) + l * HGW;
    const int gw = blockIdx.x * 8 + wave, NGW = gridDim.x * 8;
    for (int row = gw; row < MTOK; row += NGW) {
        const float* orow = O + (size_t)row * OW; const bf16_t* prow = P + (size_t)row * INP; bf16_t* mrow = MX + (size_t)row * DM;
#pragma unroll
        for (int it = 0; it < 3; ++it) { const int c = (it * 4 + (lane >> 4)) * 128 + (lane & 15) * 8;
            const f32x4 o0 = *(const f32x4*)(orow + c), o1 = *(const f32x4*)(orow + c + 4); const u32x4 gg = *(const u32x4*)(prow + C_GB + c);
            float v[8] = {sigmoidf_(bf_lo(gg.x)) * o0[0], sigmoidf_(bf_hi(gg.x)) * o0[1], sigmoidf_(bf_lo(gg.y)) * o0[2], sigmoidf_(bf_hi(gg.y)) * o0[3],
                          sigmoidf_(bf_lo(gg.z)) * o1[0], sigmoidf_(bf_hi(gg.z)) * o1[1], sigmoidf_(bf_lo(gg.w)) * o1[2], sigmoidf_(bf_hi(gg.w)) * o1[3]};
            float s = 0.f, ss = 0.f;
#pragma unroll
            for (int i = 0; i < 8; ++i) { s += v[i]; ss += v[i] * v[i]; }
            s = red16(s); ss = red16(ss);
            const float mu = s * (1.0f / 128.0f), rs = 1.0f / sqrtf(fmaxf(ss * (1.0f / 128.0f) - mu * mu, 0.f) + LN_EPS);
            const f32x4 g0 = *(const f32x4*)(hgg + c), g1 = *(const f32x4*)(hgg + c + 4), b0 = *(const f32x4*)(hgb + c), b1 = *(const f32x4*)(hgb + c + 4);
            u32x4 w; w.x = cvt_pk_bf16((v[0] - mu) * rs * g0[0] + b0[0], (v[1] - mu) * rs * g0[1] + b0[1]); w.y = cvt_pk_bf16((v[2] - mu) * rs * g0[2] + b0[2], (v[3] - mu) * rs * g0[3] + b0[3]);
            w.z = cvt_pk_bf16((v[4] - mu) * rs * g1[0] + b1[0], (v[5] - mu) * rs * g1[1] + b1[1]); w.w = cvt_pk_bf16((v[6] - mu) * rs * g1[2] + b1[2], (v[7] - mu) * rs * g1[3] + b1[3]);
            *(u32x4*)(mrow + S5W + c) = w; }
#pragma unroll
        for (int h = 0; h < 4; ++h) { const int c = h * 384 + lane * 8; const bool act = lane < 48;
            f32x4 o0 = (f32x4){0.f, 0.f, 0.f, 0.f}, o1 = o0; u32x4 gg = (u32x4){0u, 0u, 0u, 0u};
            if (act) { o0 = *(const f32x4*)(orow + HGW + c); o1 = *(const f32x4*)(orow + HGW + c + 4); gg = *(const u32x4*)(prow + C_GC + c); }
            const float ss = wave_sum((o0[0] * o0[0] + o0[1] * o0[1]) + (o0[2] * o0[2] + o0[3] * o0[3]) + (o1[0] * o1[0] + o1[1] * o1[1]) + (o1[2] * o1[2] + o1[3] * o1[3]));
            const float rms = 1.0f / sqrtf(ss * (1.0f / 384.0f) + LN_EPS);
            if (act) { const f32x4 g0 = *(const f32x4*)(glg + c), g1 = *(const f32x4*)(glg + c + 4);
                const float z[8] = {bf_lo(gg.x), bf_hi(gg.x), bf_lo(gg.y), bf_hi(gg.y), bf_lo(gg.z), bf_hi(gg.z), bf_lo(gg.w), bf_hi(gg.w)};
                u32x4 w; w.x = cvt_pk_bf16(o0[0] * rms * g0[0] * (z[0] * sigmoidf_(z[0])), o0[1] * rms * g0[1] * (z[1] * sigmoidf_(z[1])));
                w.y = cvt_pk_bf16(o0[2] * rms * g0[2] * (z[2] * sigmoidf_(z[2])), o0[3] * rms * g0[3] * (z[3] * sigmoidf_(z[3])));
                w.z = cvt_pk_bf16(o1[0] * rms * g1[0] * (z[4] * sigmoidf_(z[4])), o1[1] * rms * g1[1] * (z[5] * sigmoidf_(z[5])));
                w.w = cvt_pk_bf16(o1[2] * rms * g1[2] * (z[6] * sigmoidf_(z[6])), o1[3] * rms * g1[3] * (z[7] * sigmoidf_(z[7])));
                *(u32x4*)(mrow + S5W + HGW + c) = w; } }
    }
}

constexpr int PH_PRO = 0, PH_MOD = 1, PH_LN0 = 2, PH_L0 = 3, PH_PER_LAYER = 10, N_PHASES = PH_L0 + DEPTH * PH_PER_LAYER;
constexpr int CW_BAR = 4096;

__global__ void __launch_bounds__(512, 2) hybrid_fwd(Args args) {
    extern __shared__ __attribute__((aligned(16))) unsigned char lds_raw[];
    LAS unsigned char* lds = (LAS unsigned char*)lds_raw;
    const int wave = __builtin_amdgcn_readfirstlane((int)threadIdx.x >> 6);
#define lane lane_id_v()
    volatile LAS unsigned* MISC = (volatile LAS unsigned*)(lds + LDSCTL_OFF);
    Ctx ctx; ctx.t = (volatile LAS unsigned long long*)(lds + LDSCTL_OFF + 64);
    if (wave == 0) { const int ln_ = lane; unsigned long long v = 0ull;
#pragma unroll
        for (int i = 0; i < N_IN; ++i) v = (ln_ == i) ? (unsigned long long)args.in[i] : v;
        v = (ln_ == 30) ? (unsigned long long)args.out : v; v = (ln_ == 31) ? (unsigned long long)args.ws : v;
        if (ln_ < 32) ctx.t[ln_] = v;
        if (ln_ < 16) MISC[ln_] = 0u; }
    __syncthreads();
    const int lo = args.ph_lo, hi = args.ph_hi;
    XcdBarrier bar; bar.bar = (unsigned*)(ctx.ws() + WS_CTL) + CW_BAR; bar.x = 0; bar.st = nullptr; bar.w0 = (wave == 0) ? 1u : 0u;
    if (hi - lo > 1) bar = xcd_barrier_post((unsigned*)(ctx.ws() + WS_CTL) + CW_BAR, MISC + 8, (wave == 0) ? 1u : 0u);
#define IN(k) (lo <= (k) && (k) < hi)
#define OPQ() int ln = lane, wv = wave; asm volatile("" : "+s"(wv))
#define SEAM(k) do { if (IN(k) && IN((k) + 1)) xcd_barrier(bar); } while (0)
#define WSP(T, off) ((T*)(ctx.ws() + (off)))

    if (IN(PH_PRO)) { OPQ(); phase_prologue(ctx, lds, wv, ln); }
    SEAM(PH_PRO);
    if (IN(PH_MOD)) { OPQ(); phase_mod(ctx, wv, ln); }
    SEAM(PH_MOD);
    if (IN(PH_LN0)) { OPQ(); phase_h0(ctx.in(I_X), WSP(float, WS_MOD), WSP(bf16_t, WS_H), wv, ln); }
    SEAM(PH_LN0);

    for (int l = 0; l < DEPTH; ++l) {
        const int p0 = PH_L0 + l * PH_PER_LAYER;
        const size_t wto = WS_WT + (size_t)l * WT_LAYER, modo = WS_MOD + (size_t)l * NB * 6 * DM * 4;
        if (IN(p0 + 0)) { pg8::Gemm g{WSP(bf16_t, WS_H), WSP(const bf16_t, wto + WT_IN), MTOK, INP, DM}; pg8::StaticOrder S; S.init(MTOK, INP, (int)gridDim.x, (int)blockIdx.x);
            EpiProj E{WSP(bf16_t, WS_P), WSP(bf16_t, WS_UX)}; pg8::gemm_phase<EpiProj, pg8::StaticOrder, true, true>(lds, g, S, E, wave); }
        SEAM(p0 + 0);
        if (IN(p0 + 1)) {
            { pg8::Gemm g{WSP(bf16_t, WS_UX), WSP(const bf16_t, WS_S5W1 + (size_t)l * S5_W1_LAYER), 64 * 256, 64 * 256, S5K}; S5Order S{(int)gridDim.x, (int)blockIdx.x, 64, 0};
              EpiS5A E{WSP(float, WS_SLOC)}; pg8::gemm_phase<EpiS5A, S5Order, true, true>(lds, g, S, E, wave); }
            { OPQ(); phase_pre(ctx, l, wv, ln); }
            }
        SEAM(p0 + 1);
        if (IN(p0 + 2)) { OPQ(); phase_chain<0>(ctx, l, lds, wv, ln); }
        SEAM(p0 + 2);
        if (IN(p0 + 3)) {
            { pg8::Gemm g{WSP(bf16_t, WS_UX), WSP(const bf16_t, WS_S5T + (size_t)l * S5_T_LAYER), 64 * 256, 64 * 1024, S5K}; S5Order S{(int)gridDim.x, (int)blockIdx.x, 256, 2};
              EpiS5C E{WSP(bf16_t, WS_Z)}; pg8::gemm_phase<EpiS5C, S5Order, true, true>(lds, g, S, E, wave); }
            { OPQ(); phase_chain<1>(ctx, l, lds, wv, ln); } }
        SEAM(p0 + 3);
        if (IN(p0 + 4)) { pg8::Gemm g{WSP(bf16_t, WS_Z), WSP(const bf16_t, wto + WT_GLU), MTOK, S5W, S5W}; pg8::StaticOrder S; S.init(MTOK, S5W, (int)gridDim.x, (int)blockIdx.x);
            EpiGlu E{WSP(bf16_t, WS_Z), WSP(bf16_t, WS_MIXED), ctx.in(I_GLUB) + l * S5W}; pg8::gemm_phase<EpiGlu, pg8::StaticOrder, true, true>(lds, g, S, E, wave);
            { OPQ(); phase_finalize(ctx, l, wv, ln); } }
        SEAM(p0 + 4);
        if (IN(p0 + 5)) { pg8::Gemm g{WSP(bf16_t, WS_MIXED), WSP(const bf16_t, wto + WT_OUT), MTOK, DM, DM}; pg8::StaticOrder S; S.init(MTOK, DM, (int)gridDim.x, (int)blockIdx.x);
            EpiDelta E{WSP(bf16_t, WS_DELTA), WSP(float, modo) + 2 * DM};
            pg8::gemm_phase<EpiDelta, pg8::StaticOrder, true, true>(lds, g, S, E, wave); }
        SEAM(p0 + 5);
        if (IN(p0 + 6)) { OPQ(); phase_lnres<true>(l == 0 ? ctx.in(I_X) : ctx.out(), WSP(bf16_t, WS_DELTA), ctx.out(), ctx.in(I_LN1G) + l * DM, ctx.in(I_LN1B) + l * DM, WSP(float, modo), 3, 4, WSP(bf16_t, WS_H), lds, wv, ln); }
        SEAM(p0 + 6);
        if (IN(p0 + 7)) { pg8::Gemm g{WSP(bf16_t, WS_H), WSP(const bf16_t, wto + WT_GU), MTOK, 2 * DFF, DM}; pg8::StaticOrder S; S.init(MTOK, 2 * DFF, (int)gridDim.x, (int)blockIdx.x);
            EpiSwiglu E{WSP(bf16_t, WS_P)}; pg8::gemm_phase<EpiSwiglu, pg8::StaticOrder, true, true>(lds, g, S, E, wave); }
        SEAM(p0 + 7);
        if (IN(p0 + 8)) { pg8::Gemm g{WSP(bf16_t, WS_P), WSP(const bf16_t, wto + WT_DN), MTOK, DM, DFF}; pg8::StaticOrder S; S.init(MTOK, DM, (int)gridDim.x, (int)blockIdx.x);
            EpiDelta E{WSP(bf16_t, WS_DELTA), WSP(float, modo) + 5 * DM};
            pg8::gemm_phase<EpiDelta, pg8::StaticOrder, true, true>(lds, g, S, E, wave); }
        SEAM(p0 + 8);
        if (IN(p0 + 9)) { OPQ();
            if (l + 1 < DEPTH) phase_lnres<true>(ctx.out(), WSP(bf16_t, WS_DELTA), ctx.out(), ctx.in(I_LN2G) + l * DM, ctx.in(I_LN2B) + l * DM, WSP(float, modo) + (size_t)NB * 6 * DM, 0, 1, WSP(bf16_t, WS_H), lds, wv, ln);
            else phase_lnres<false>(ctx.out(), WSP(bf16_t, WS_DELTA), ctx.out(), ctx.in(I_LN2G) + l * DM, ctx.in(I_LN2B) + l * DM, nullptr, 0, 0, nullptr, lds, wv, ln);
        }
        SEAM(p0 + 9);
    }
#undef IN
#undef SEAM
#undef OPQ
#undef WSP
#undef lane
}

extern "C" void kernel_launch(void* const* d_in, const int* in_sizes, int n_in, void* d_out, int out_size, void* d_ws, size_t ws_size, hipStream_t stream) {
    static int grid = 0;
    if (grid == 0) {
        if (n_in != N_IN || out_size != MTOK * DM || ws_size < WS_END) { fprintf(stderr, "kernel_launch: unexpected problem (n_in %d, out %d, ws %zu < %zu); nothing launched\n", n_in, out_size, ws_size, (size_t)WS_END); grid = -1; return; }
        int dev = 0, cus = 0, per_cu = 0;
        if (hipGetDevice(&dev) != hipSuccess || hipDeviceGetAttribute(&cus, hipDeviceAttributeMultiprocessorCount, dev) != hipSuccess) { grid = -1; return; }
        if (hipFuncSetAttribute((const void*)hybrid_fwd, hipFuncAttributeMaxDynamicSharedMemorySize, LDS_BYTES) != hipSuccess) { fprintf(stderr, "kernel_launch: hipFuncSetAttribute failed\n"); grid = -1; return; }
        if (hipOccupancyMaxActiveBlocksPerMultiprocessor(&per_cu, (const void*)hybrid_fwd, 512, LDS_BYTES) != hipSuccess || per_cu < 1) fprintf(stderr, "kernel_launch: occupancy query reports %d blocks per CU\n", per_cu);
        (void)hipGetLastError();
        grid = cus;
    }
    if (grid < 0) return;
    (void)in_sizes;
    if (hipMemsetAsync((char*)d_ws + WS_CTL, 0, CTL_ZERO_BYTES, stream) != hipSuccess) return;
    Args a{};
    for (int i = 0; i < N_IN; ++i) a.in[i] = (const float*)d_in[i];
    a.out = (float*)d_out; a.ws = (unsigned char*)d_ws;
    a.ph_lo = 0; a.ph_hi = N_PHASES; hipLaunchKernelGGL(hybrid_fwd, dim3(grid), dim3(512), LDS_BYTES, stream, a);
}
```

```cpp
#include <hip/hip_runtime.h>
#include <cstdio>
#include <cstdint>
namespace pg8 {
#define PG8_LAS __attribute__((address_space(3)))
typedef unsigned short bf16_t;
typedef short bf16x8 __attribute__((ext_vector_type(8)));
typedef float f32x4 __attribute__((ext_vector_type(4)));
typedef unsigned u32x4 __attribute__((ext_vector_type(4)));
constexpr int BM = 256, BK = 64, HALF = 128, HTB = HALF * BK * 2  , STAGE_BYTES = 8 * HTB, NXCD = 8, WGM = 8;

__host__ __device__ __forceinline__ int lds_byte(int r, int c) { const int st = (r >> 4) * 2 + (c >> 5), rr = r & 15, cc = c & 31, ob = rr * 64 + cc * 2; return st * 1024 + (ob ^ (((ob >> 9) & 1) << 5)); }
__host__ __device__ __forceinline__ void stage_rc(int b, int& R, int& C) { const int st = b / 1024, sb = b % 1024, swz = sb ^ (((sb >> 9) & 1) << 5); R = (st >> 1) * 16 + swz / 64; C = (st & 1) * 32 + (swz % 64) / 2; }
__host__ __device__ __forceinline__ int perm32(int rho) { const int n = rho >> 4, i = rho & 15; return 8 * (i >> 2) + 4 * n + (i & 3); }

struct Unit { int pm, pn; };
struct Gemm { const bf16_t* A; const bf16_t* Bt; int M, N, K; };

struct StaticOrder {
    int nM, nN, nwg, G, c;
    __host__ __device__ void init(int M, int N, int G_, int c_) { nM = M / BM; nN = N / BM; nwg = nM * nN; G = G_; c = c_; }
    __host__ __device__ bool next(int i, Unit& u) const {
        const long L = (long)i * G + c; if (L >= nwg) return false;
        int wgid = (int)L; { const int q = nwg / NXCD, r = nwg % NXCD, xcd = wgid % NXCD, off = wgid / NXCD; wgid = (xcd < r ? xcd * (q + 1) : r * (q + 1) + (xcd - r) * q) + off; }
        const int nig = WGM * nN, gid = wgid / nig, fm = gid * WGM, gsz = (nM - fm) < WGM ? (nM - fm) : WGM;
        u.pm = fm + ((wgid % nig) % gsz); u.pn = (wgid % nig) / gsz; return true;
    }
    __device__ __forceinline__ void a_ready(const Unit&) const {}
    __device__ __forceinline__ void done(const Unit&) const {}
};
__device__ __forceinline__ unsigned cvt_pk_bf16(float lo, float hi) { unsigned r; asm volatile("v_cvt_pk_bf16_f32 %0, %1, %2" : "=v"(r) : "v"(lo), "v"(hi)); return r; }
typedef float f32x2 __attribute__((ext_vector_type(2)));
template <class Epi, class Sched, bool ALIGN_EPI = false, bool SP2 = false>
__device__ __forceinline__ void gemm_phase(PG8_LAS unsigned char* lds, const Gemm g, const Sched& S, const Epi& E, int wave_id) {
    int tid_; asm volatile("v_mbcnt_lo_u32_b32 %0, -1, 0\n\tv_mbcnt_hi_u32_b32 %0, -1, %0" : "=v"(tid_)); tid_ += wave_id * 64;
    const int tid = tid_, wid = __builtin_amdgcn_readfirstlane(tid >> 6), lane = tid & 63, wr = wid >> 2, wc = wid & 3, fr = lane & 15, fq = lane >> 4;
    const int K = g.K, nt = K / BK;
    unsigned voffA[2], voffB[2];
#pragma unroll
    for (int i = 0; i < 2; ++i) { int R, C; stage_rc(tid * 16 + i * 8192, R, C); const int Rb = Epi::PERM ? ((R & ~31) + perm32(R & 31)) : R;
        voffA[i] = (unsigned)(R * K + C) * 2u; voffB[i] = (unsigned)(Rb * K + C) * 2u; }
    const size_t kstep = (size_t)(BK * 2);
    const size_t hstep = (size_t)HALF * K * 2;
    const size_t tstep = 2 * hstep;
    const unsigned ldsw = (unsigned)wid * 1024u;
    const int aoff = lds_byte(wr * 64 + fr, fq * 8), boff = lds_byte(wc * 32 + fr, fq * 8);
#define PG8_SA(b, h) (((b) * 2 + (h)) * HTB)
#define PG8_SB(b, h) ((4 + (b) * 2 + (h)) * HTB)
#define PG8_STAGE(bufoff, gbase, voff) do { _Pragma("unroll") for (int _i = 0; _i < 2; ++_i) \
        __builtin_amdgcn_global_load_lds((const unsigned*)((const char*)(gbase) + (voff)[_i]), (PG8_LAS unsigned*)(lds + (bufoff) + ldsw + _i * 8192), 16, 0, 0); } while (0)
#define PG8_LDA(dst, b, h) do { _Pragma("unroll") for (int m = 0; m < 4; ++m) _Pragma("unroll") for (int k = 0; k < 2; ++k) dst[m][k] = *(const PG8_LAS bf16x8*)(lds + PG8_SA(b, h) + aoff + m * 2048 + k * 1024); } while (0)
#define PG8_LDB(dst, b, h) do { _Pragma("unroll") for (int n = 0; n < 2; ++n) _Pragma("unroll") for (int k = 0; k < 2; ++k) dst[n][k] = *(const PG8_LAS bf16x8*)(lds + PG8_SB(b, h) + boff + n * 2048 + k * 1024); } while (0)
#define PG8_MMA(ai, bj, At, Bt) do { __builtin_amdgcn_s_setprio(1); _Pragma("unroll") for (int m = 0; m < 4; ++m) _Pragma("unroll") for (int n = 0; n < 2; ++n) _Pragma("unroll") for (int k = 0; k < 2; ++k) \
        acc[ai][bj][m][n] = __builtin_amdgcn_mfma_f32_16x16x32_bf16(Bt[n][k], At[m][k], acc[ai][bj][m][n], 0, 0, 0); __builtin_amdgcn_s_setprio(0); } while (0)
#define PG8_WAIT_V(n) asm volatile("s_waitcnt vmcnt(" #n ")" ::: "memory")
#define PG8_WAIT_L(n) asm volatile("s_waitcnt lgkmcnt(" #n ")" ::: "memory")
#define PG8_BAR __builtin_amdgcn_s_barrier()
#define PG8_SCHED __builtin_amdgcn_sched_barrier(0)
    Unit cur, nxt; int ui = 0;
    if (!S.next(0, cur)) return;
    f32x4 acc[2][2][4][2];
#pragma unroll
    for (int a = 0; a < 2; ++a)
#pragma unroll
        for (int b = 0; b < 2; ++b)
#pragma unroll
            for (int m = 0; m < 4; ++m)
#pragma unroll
                for (int n = 0; n < 2; ++n) acc[a][b][m][n] = (f32x4){0.f, 0.f, 0.f, 0.f};
    bf16x8 At[4][2], B0[2][2], B1[2][2];
    const char* cA = (const char*)g.A + (size_t)cur.pm * tstep; const char* cB = (const char*)g.Bt + (size_t)cur.pn * tstep;
    S.a_ready(cur);
    if constexpr (SP2) {
        PG8_STAGE(PG8_SB(0, 0), cB, voffB); PG8_STAGE(PG8_SB(0, 1), cB + hstep, voffB); PG8_STAGE(PG8_SA(0, 0), cA, voffA); PG8_STAGE(PG8_SA(0, 1), cA + hstep, voffA);
        if (wr == 1) PG8_BAR;
        PG8_WAIT_V(2); PG8_BAR;
        PG8_STAGE(PG8_SB(1, 0), cB + kstep, voffB); PG8_STAGE(PG8_SA(1, 0), cA + kstep, voffA); PG8_STAGE(PG8_SB(1, 1), cB + hstep + kstep, voffB);
        PG8_WAIT_V(6); PG8_BAR;
    } else {
        PG8_STAGE(PG8_SB(0, 0), cB, voffB); PG8_STAGE(PG8_SA(0, 0), cA, voffA); PG8_STAGE(PG8_SB(0, 1), cB + hstep, voffB); PG8_STAGE(PG8_SA(0, 1), cA + hstep, voffA);
        if (wr == 1) PG8_BAR;
        PG8_WAIT_V(4); PG8_BAR;
        PG8_STAGE(PG8_SB(1, 0), cB + kstep, voffB); PG8_STAGE(PG8_SA(1, 0), cA + kstep, voffA); PG8_STAGE(PG8_SB(1, 1), cB + hstep + kstep, voffB);
        PG8_WAIT_V(6); PG8_BAR;
    }
    for (;;) {
        const bool has_next = S.next(ui + 1, nxt);
        const char* nA = has_next ? (const char*)g.A + (size_t)nxt.pm * tstep : cA; const char* nB = has_next ? (const char*)g.Bt + (size_t)nxt.pn * tstep : cB;
        for (int t = 0; t < nt; t += 2) {
            const bool last = (t == nt - 2);
            const char* a1 = cA + (size_t)(t + 1) * kstep;
            const char* a2 = last ? nA : cA + (size_t)(t + 2) * kstep; const char* b2 = last ? nB : cB + (size_t)(t + 2) * kstep;
            const char* a3 = a2 + kstep; const char* b3 = b2 + kstep;
            if (last && has_next) S.a_ready(nxt);
            if constexpr (SP2) {
            PG8_LDB(B0, 0, 0); PG8_LDB(B1, 0, 1); PG8_SCHED; PG8_LDA(At, 0, 0); PG8_STAGE(PG8_SA(1, 1), a1 + hstep, voffA);
            PG8_WAIT_V(8); PG8_WAIT_L(0); PG8_BAR; PG8_MMA(0, 0, At, B0); PG8_MMA(0, 1, At, B1); PG8_BAR; PG8_SCHED;
            PG8_LDA(At, 0, 1); PG8_STAGE(PG8_SB(0, 0), b2, voffB); PG8_STAGE(PG8_SB(0, 1), b2 + hstep, voffB); PG8_STAGE(PG8_SA(0, 0), a2, voffA);
            PG8_WAIT_V(8); PG8_WAIT_L(0); PG8_BAR; PG8_MMA(1, 0, At, B0); PG8_MMA(1, 1, At, B1); PG8_BAR; PG8_SCHED;
            PG8_LDB(B0, 1, 0); PG8_LDB(B1, 1, 1); PG8_SCHED; PG8_LDA(At, 1, 0); PG8_STAGE(PG8_SA(0, 1), a2 + hstep, voffA);
            PG8_WAIT_V(8); PG8_WAIT_L(0); PG8_BAR; PG8_MMA(0, 0, At, B0); PG8_MMA(0, 1, At, B1); PG8_BAR; PG8_SCHED;
            PG8_LDA(At, 1, 1); PG8_STAGE(PG8_SB(1, 0), b3, voffB); PG8_STAGE(PG8_SB(1, 1), b3 + hstep, voffB); PG8_STAGE(PG8_SA(1, 0), a3, voffA);
            PG8_WAIT_V(8); PG8_WAIT_L(0); PG8_BAR; PG8_MMA(1, 0, At, B0); PG8_MMA(1, 1, At, B1); PG8_BAR; PG8_SCHED;
            } else {
            PG8_LDB(B0, 0, 0); PG8_SCHED; PG8_LDA(At, 0, 0); PG8_STAGE(PG8_SA(1, 1), a1 + hstep, voffA);
            PG8_WAIT_L(8); PG8_BAR; PG8_WAIT_L(0); PG8_MMA(0, 0, At, B0); PG8_BAR; PG8_SCHED;
            PG8_LDB(B1, 0, 1); PG8_STAGE(PG8_SB(0, 0), b2, voffB);
            PG8_BAR; PG8_WAIT_L(0); PG8_MMA(0, 1, At, B1); PG8_BAR;
            PG8_LDA(At, 0, 1); PG8_STAGE(PG8_SA(0, 0), a2, voffA);
            PG8_BAR; PG8_WAIT_L(0); PG8_MMA(1, 0, At, B0); PG8_BAR; PG8_SCHED;
            PG8_STAGE(PG8_SB(0, 1), b2 + hstep, voffB);
            PG8_WAIT_V(6); PG8_BAR; PG8_MMA(1, 1, At, B1); PG8_BAR;
            PG8_LDB(B0, 1, 0); PG8_SCHED; PG8_LDA(At, 1, 0); PG8_STAGE(PG8_SA(0, 1), a2 + hstep, voffA);
            PG8_WAIT_L(8); PG8_BAR; PG8_WAIT_L(0); PG8_MMA(0, 0, At, B0); PG8_BAR; PG8_SCHED;
            PG8_LDB(B1, 1, 1); PG8_STAGE(PG8_SB(1, 0), b3, voffB);
            PG8_BAR; PG8_WAIT_L(0); PG8_MMA(0, 1, At, B1); PG8_BAR;
            PG8_LDA(At, 1, 1); PG8_STAGE(PG8_SA(1, 0), a3, voffA);
            PG8_BAR; PG8_WAIT_L(0); PG8_MMA(1, 0, At, B0); PG8_BAR; PG8_SCHED;
            PG8_STAGE(PG8_SB(1, 1), b3 + hstep, voffB);
            PG8_WAIT_V(6); PG8_BAR; PG8_MMA(1, 1, At, B1); PG8_BAR;
            }
        }
        if constexpr (ALIGN_EPI) { if (wr == 0) PG8_BAR; }
        if constexpr (!Epi::AFTER_DRAIN) { E(acc, cur, wr, wc, fr, fq); S.done(cur); }
        if (!has_next) break;
#pragma unroll
        for (int a = 0; a < 2; ++a)
#pragma unroll
            for (int b = 0; b < 2; ++b)
#pragma unroll
                for (int m = 0; m < 4; ++m)
#pragma unroll
                    for (int n = 0; n < 2; ++n) acc[a][b][m][n] = (f32x4){0.f, 0.f, 0.f, 0.f};
        cur = nxt; cA = nA; cB = nB; ++ui;
        if constexpr (ALIGN_EPI) { if (wr == 1) PG8_BAR; }
    }
    PG8_WAIT_V(0);
    if constexpr (!ALIGN_EPI) { if (wr == 0) PG8_BAR; }
    PG8_BAR;
    if constexpr (Epi::AFTER_DRAIN) { E.fused(acc, cur, wr, wc, fr, fq, lds, wid, lane); S.done(cur); }
#undef PG8_SA
#undef PG8_SB
#undef PG8_STAGE
#undef PG8_LDA
#undef PG8_LDB
#undef PG8_MMA
#undef PG8_WAIT_V
#undef PG8_WAIT_L
#undef PG8_BAR
#undef PG8_SCHED
}
}
#define LAS __attribute__((address_space(3)))
#define XB_TMO      128
#define XB_XCNT(j)  (256  + 64 * (j))
#define XB_XSUB(j)  (1280 + 64 * (j))
#define XB_XGEN(j)  (2304 + 64 * (j))
#define XB_TOP      3328
#define XB_TOPGEN   3392
#define XCD_BAR_WORDS 3456
#define XB_SPIN_CAP (1u << 24)

__device__ __forceinline__ unsigned xb_ld(unsigned* p)              { return __hip_atomic_load(p, __ATOMIC_RELAXED, __HIP_MEMORY_SCOPE_AGENT); }
__device__ __forceinline__ unsigned xb_add(unsigned* p, unsigned v) { return __hip_atomic_fetch_add(p, v, __ATOMIC_RELAXED, __HIP_MEMORY_SCOPE_AGENT); }
__device__ __forceinline__ unsigned xb_xcc_id() { return (unsigned)__builtin_amdgcn_s_getreg((3 << 11) | 20) & 0xFu; }
#define XB_SPIN(cond, bar) do { unsigned _sp = 0; while (cond) { __builtin_amdgcn_s_sleep(1); \
    if ((++_sp & 255u) == 0u) { if (xb_ld(&(bar)[XB_TMO])) break; if (_sp > XB_SPIN_CAP) { atomicAdd(&(bar)[XB_TMO], 1u); break; } } } } while (0)

struct XcdBarrier {
    unsigned* bar; unsigned x; unsigned w0;
    volatile LAS unsigned* st;
};

__device__ __forceinline__ bool xb_lane0() { return __builtin_amdgcn_mbcnt_hi(~0u, __builtin_amdgcn_mbcnt_lo(~0u, 0u)) == 0u; }
__device__ __forceinline__ XcdBarrier xcd_barrier_post(unsigned* bar, volatile LAS unsigned* st, unsigned w0) {
    XcdBarrier b; b.bar = bar; b.x = xb_xcc_id(); b.st = st; b.w0 = w0;
    if (w0 && xb_lane0()) (void)xb_add(&bar[XB_XCNT(b.x)], 1u);
    return b;
}
__device__ __forceinline__ void xcd_barrier_complete(unsigned* bar, unsigned x, unsigned& nloc, unsigned& nx) {
    const unsigned G = gridDim.x * gridDim.y * gridDim.z;
    unsigned sum, cnt, mine, sp = 0u;
    for (;;) {
        sum = 0u; cnt = 0u; mine = 0u;
#pragma unroll
        for (unsigned j = 0; j < 16; ++j) { const unsigned c = xb_ld(&bar[XB_XCNT(j)]); sum += c; cnt += (c > 0u) ? 1u : 0u; mine = (j == x) ? c : mine; }
        if (sum == G) break;
        __builtin_amdgcn_s_sleep(1);
        if ((++sp & 255u) == 0u) { if (xb_ld(&bar[XB_TMO])) break; if (sp > XB_SPIN_CAP) { atomicAdd(&bar[XB_TMO], 1u); break; } }
    }
    nloc = mine > 0u ? mine : 1u; nx = cnt > 0u ? cnt : 1u;
}

__device__ __forceinline__ void xcd_barrier(const XcdBarrier& b) {
    asm volatile("s_waitcnt vmcnt(0)" ::: "memory");
    __syncthreads();
    if (b.w0 && xb_lane0()) {
        unsigned* bar = b.bar;
        __builtin_amdgcn_s_waitcnt(0);
        unsigned nloc = b.st[0], nx = b.st[1];
        if (nloc == 0u) { xcd_barrier_complete(bar, b.x, nloc, nx); b.st[0] = nloc; b.st[1] = nx; }
        const unsigned old = xb_add(&bar[XB_XSUB(b.x)], 1u);
        const unsigned gen = old / nloc;
        if (old + 1u == (gen + 1u) * nloc) {
            __builtin_amdgcn_fence(__ATOMIC_RELEASE, "agent");
            asm volatile("s_waitcnt vmcnt(0)" ::: "memory");
            const unsigned og = xb_add(&bar[XB_TOP], 1u);
            const unsigned tg = og / nx;
            if (og + 1u == (tg + 1u) * nx) xb_add(&bar[XB_TOPGEN], 1u);
            else XB_SPIN(xb_ld(&bar[XB_TOPGEN]) == tg, bar);
            __builtin_amdgcn_fence(__ATOMIC_ACQUIRE, "agent");
            xb_add(&bar[XB_XGEN(b.x)], 1u);
            asm volatile("s_waitcnt vmcnt(0)" ::: "memory");
        } else {
            XB_SPIN(xb_ld(&bar[XB_XGEN(b.x)]) == gen, bar);
            __builtin_amdgcn_fence(__ATOMIC_ACQUIRE, "agent");
            asm volatile("s_waitcnt vmcnt(0)" ::: "memory");
        }
    }
    __syncthreads();
}

constexpr int DM = 4096, NB = 2, SEQ = 8192, MTOK = NB * SEQ, DEPTH = 4;
constexpr int S5W = 1024;
constexpr int HGW = 1536;
constexpr int GLKW = 768;
constexpr int INW = 11792, INP = 12032, DFF = 11008;
constexpr int OW = 3072;
constexpr int C_U = 0, C_QB = 1024, C_FB = 2560, C_IB = 4096, C_GB = 5632, C_QC = 7168, C_KC = 7936, C_VC = 8704, C_GC = 10240, C_LR = 11776;
constexpr float LN_EPS = 1e-5f;
constexpr float ALPHA = 1.6817928305074290861f;
constexpr float GLA_QSCALE = 0.07216878364870322f;

enum { I_X = 0, I_C, I_WADA, I_BADA, I_TABLE, I_WIN, I_WOUT, I_AREAL, I_AIMAG, I_LOGDT, I_BRE, I_BIM, I_CRE, I_CIM, I_S5D, I_GLUW, I_GLUB,
       I_LBRAW, I_HGG, I_HGB, I_WGATE, I_BGATE, I_GLG, I_WFG, I_WFU, I_WFD, I_LN1G, I_LN1B, I_LN2G, I_LN2B, N_IN };

constexpr size_t MiB = 1u << 20;
constexpr size_t WS_CTL = 0, CTL_ZERO_BYTES = 1 * MiB;
constexpr size_t WS_MOD = 1 * MiB;
constexpr size_t WS_MISC = 2 * MiB;
constexpr size_t WS_CONDPART = 12 * MiB;
constexpr size_t WS_H = 24 * MiB;
constexpr size_t WS_MIXED = WS_H + 128 * MiB;
constexpr size_t WS_Z = WS_MIXED + 128 * MiB;
constexpr size_t WS_O = WS_Z + 32 * MiB;
constexpr size_t WS_DELTA = WS_O;
constexpr size_t WS_P = WS_O + 192 * MiB;
constexpr size_t WS_WT = WS_P + 376 * MiB;
constexpr size_t WT_IN = 0, WT_OUT = 94 * MiB, WT_GU = 126 * MiB, WT_DN = 298 * MiB, WT_GLU = 384 * MiB, WT_LAYER = 386 * MiB;
constexpr size_t WS_HGB = WS_WT + DEPTH * WT_LAYER;
constexpr size_t WS_GLB = WS_HGB + 198 * MiB;
constexpr size_t WS_S5T = WS_GLB + 128 * MiB;
constexpr size_t WS_S5W1 = WS_S5T + 576 * MiB;
constexpr size_t WS_UX = WS_S5W1 + 144 * MiB;
constexpr size_t WS_SLOC = WS_UX + 36 * MiB;
constexpr size_t WS_LAM64 = WS_SLOC + 8 * MiB;
constexpr size_t WS_ST = WS_LAM64 + 1 * MiB;
constexpr size_t WS_END = WS_ST + 45 * MiB;
static_assert((size_t)INP * DM * 2 == 94 * MiB && (size_t)DM * DM * 2 == 32 * MiB && (size_t)2 * DFF * DM * 2 == 172 * MiB && (size_t)DM * DFF * 2 == 86 * MiB, "weight map");
static_assert((size_t)MTOK * INP * 2 == 376 * MiB && (size_t)MTOK * DFF * 2 <= 376 * MiB, "activation map");

constexpr int RING_BYTES = 131072;
constexpr int LDSCTL_OFF = 135168;
constexpr int LDS_BYTES = 147456;

#ifndef LAS
#define LAS __attribute__((address_space(3)))
#endif
typedef unsigned short bf16_t;
typedef float f32x4 __attribute__((ext_vector_type(4)));
typedef float f32x2 __attribute__((ext_vector_type(2)));
typedef unsigned u32x4 __attribute__((ext_vector_type(4)));
typedef unsigned u32x2 __attribute__((ext_vector_type(2)));
#define LDS_WAIT() asm volatile("s_waitcnt lgkmcnt(0)" ::: "memory")
#define VM_WAIT() asm volatile("s_waitcnt vmcnt(0)" ::: "memory")
typedef __bf16 bf16x2_t __attribute__((ext_vector_type(2)));
__device__ __forceinline__ unsigned cvt_pk_bf16(float lo, float hi) { return __builtin_bit_cast(unsigned, __builtin_convertvector((f32x2){lo, hi}, bf16x2_t)); }

__device__ __forceinline__ float bf_lo(unsigned w) { return __uint_as_float(w << 16); }
__device__ __forceinline__ float bf_hi(unsigned w) { return __uint_as_float(w & 0xffff0000u); }
__device__ __forceinline__ float bf2f(bf16_t b) { return __uint_as_float(((unsigned)b) << 16); }
__device__ __forceinline__ float wave_sum(float v) {
    v += __int_as_float(__builtin_amdgcn_mov_dpp(__float_as_int(v), 0xB1, 0xF, 0xF, true));
    v += __int_as_float(__builtin_amdgcn_mov_dpp(__float_as_int(v), 0x4E, 0xF, 0xF, true));
    v += __int_as_float(__builtin_amdgcn_mov_dpp(__float_as_int(v), 0x141, 0xF, 0xF, true));
    v += __int_as_float(__builtin_amdgcn_mov_dpp(__float_as_int(v), 0x140, 0xF, 0xF, true));
    v += __shfl_xor(v, 16); v += __shfl_xor(v, 32);
    return v;
}
__device__ __forceinline__ float sigmoidf_(float x) { return 1.0f / (1.0f + __expf(-x)); }
__device__ __forceinline__ float gelu_tanh(float y) { const float a = 0.7978845608028654f * (y + 0.044715f * y * y * y); const float t = 1.0f - 2.0f / (1.0f + __expf(2.0f * a)); return 0.5f * y * (1.0f + t); }

struct EpiProj {
    static constexpr bool PERM = true, AFTER_DRAIN = false;
    bf16_t* P; bf16_t* UX;
    __device__ __forceinline__ void operator()(const f32x4 (&acc)[2][2][4][2], const pg8::Unit& u, int wr, int wc, int fr, int fq) const {
        const int row0 = u.pm * 256 + wr * 64 + fr, col0 = u.pn * 256 + wc * 32 + 8 * fq;
        const bool s5 = u.pn < 4;
#pragma unroll
        for (int ai = 0; ai < 2; ++ai)
#pragma unroll
            for (int m = 0; m < 4; ++m) { const int row = row0 + ai * 128 + m * 16;
#pragma unroll
                for (int bj = 0; bj < 2; ++bj) { const f32x4 v0 = acc[ai][bj][m][0], v1 = acc[ai][bj][m][1]; const int col = col0 + bj * 128;
                    u32x4 w; w.x = cvt_pk_bf16(v0[0], v0[1]); w.y = cvt_pk_bf16(v0[2], v0[3]); w.z = cvt_pk_bf16(v1[0], v1[1]); w.w = cvt_pk_bf16(v1[2], v1[3]);
                    if (!s5) *(u32x4*)(P + (size_t)row * INP + col) = w;
                    else { bf16_t* ur = UX + (size_t)((col >> 4) * 256 + (row >> 6)) * 1152; *(u32x4*)(ur + (row & 63) * 16 + (col & 15)) = w;
                        if ((row & 63) == 0) { const u32x4 z = (u32x4){0u, 0u, 0u, 0u}; bf16_t* zp = ur + 1024 + ((col & 15) ? 64 : 0);
#pragma unroll
                            for (int i = 0; i < 8; ++i) *(u32x4*)(zp + 8 * i) = z; } } } }
    }
};
struct EpiSwiglu {
    static constexpr bool PERM = true, AFTER_DRAIN = false;
    bf16_t* HID;
    __device__ __forceinline__ void operator()(const f32x4 (&acc)[2][2][4][2], const pg8::Unit& u, int wr, int wc, int fr, int fq) const {
        const int row0 = u.pm * 256 + wr * 64 + fr, col0 = u.pn * 128 + wc * 32 + 8 * fq;
#pragma unroll
        for (int ai = 0; ai < 2; ++ai)
#pragma unroll
            for (int m = 0; m < 4; ++m) { bf16_t* rowp = HID + (size_t)(row0 + ai * 128 + m * 16) * DFF + col0;
                float o[8];
#pragma unroll
                for (int n = 0; n < 2; ++n)
#pragma unroll
                    for (int j = 0; j < 4; ++j) { const float g = acc[ai][0][m][n][j], up = acc[ai][1][m][n][j]; o[n * 4 + j] = g * __builtin_amdgcn_rcpf(1.0f + __expf(-g)) * up; }
                u32x4 w; w.x = cvt_pk_bf16(o[0], o[1]); w.y = cvt_pk_bf16(o[2], o[3]); w.z = cvt_pk_bf16(o[4], o[5]); w.w = cvt_pk_bf16(o[6], o[7]);
                *(u32x4*)rowp = w; }
    }
};
struct EpiGlu {
    static constexpr bool PERM = true, AFTER_DRAIN = false;
    const bf16_t* Z; bf16_t* MIXED; const float* bias;
    __device__ __forceinline__ void operator()(const f32x4 (&acc)[2][2][4][2], const pg8::Unit& u, int wr, int wc, int fr, int fq) const {
        const int row0 = u.pm * 256 + wr * 64 + fr, col0 = u.pn * 256 + wc * 32 + 8 * fq;
#pragma unroll
        for (int bj = 0; bj < 2; ++bj) {
            const f32x4 b0 = *(const f32x4*)(bias + col0 + bj * 128), b1 = *(const f32x4*)(bias + col0 + bj * 128 + 4);
#pragma unroll
            for (int ai = 0; ai < 2; ++ai)
#pragma unroll
                for (int m = 0; m < 4; ++m) { const size_t r = (size_t)(row0 + ai * 128 + m * 16);
                    const u32x4 zz = *(const u32x4*)(Z + r * S5W + col0 + bj * 128);
                    const f32x4 v0 = acc[ai][bj][m][0] + b0, v1 = acc[ai][bj][m][1] + b1;
                    u32x4 w;
                    w.x = cvt_pk_bf16(bf_lo(zz.x) * sigmoidf_(v0[0]), bf_hi(zz.x) * sigmoidf_(v0[1]));
                    w.y = cvt_pk_bf16(bf_lo(zz.y) * sigmoidf_(v0[2]), bf_hi(zz.y) * sigmoidf_(v0[3]));
                    w.z = cvt_pk_bf16(bf_lo(zz.z) * sigmoidf_(v1[0]), bf_hi(zz.z) * sigmoidf_(v1[1]));
                    w.w = cvt_pk_bf16(bf_lo(zz.w) * sigmoidf_(v1[2]), bf_hi(zz.w) * sigmoidf_(v1[3]));
                    *(u32x4*)(MIXED + r * DM + col0 + bj * 128) = w;
                    if (m & 1) asm volatile("" ::: "memory"); }
        }
    }
};
struct EpiDelta {
    static constexpr bool PERM = true, AFTER_DRAIN = false;
    bf16_t* D; const float* gate0;
    __device__ __forceinline__ void operator()(const f32x4 (&acc)[2][2][4][2], const pg8::Unit& u, int wr, int wc, int fr, int fq) const {
        const int row0 = u.pm * 256 + wr * 64 + fr, col0 = u.pn * 256 + wc * 32 + 8 * fq;
        const float* gp = gate0 + (u.pm >= 32 ? 6 * DM : 0) + col0;
        f32x4 g[2][2];
#pragma unroll
        for (int bj = 0; bj < 2; ++bj)
#pragma unroll
            for (int n = 0; n < 2; ++n) g[bj][n] = *(const f32x4*)(gp + bj * 128 + 4 * n) + 1.0f;
#pragma unroll
        for (int ai = 0; ai < 2; ++ai)
#pragma unroll
            for (int m = 0; m < 4; ++m) { bf16_t* rowp = D + (size_t)(row0 + ai * 128 + m * 16) * DM + col0;
#pragma unroll
                for (int bj = 0; bj < 2; ++bj) { const f32x4 v0 = acc[ai][bj][m][0] * g[bj][0], v1 = acc[ai][bj][m][1] * g[bj][1];
                    u32x4 w; w.x = cvt_pk_bf16(v0[0], v0[1]); w.y = cvt_pk_bf16(v0[2], v0[3]); w.z = cvt_pk_bf16(v1[0], v1[1]); w.w = cvt_pk_bf16(v1[2], v1[3]);
                    *(u32x4*)(rowp + bj * 128) = w; } }
    }
};

__device__ __forceinline__ int lane_id_v() { int r; asm volatile("v_mbcnt_lo_u32_b32 %0, -1, 0\n\tv_mbcnt_hi_u32_b32 %0, -1, %0" : "=v"(r)); return r; }
struct Args { const float* in[N_IN]; float* out; unsigned char* ws; int ph_lo, ph_hi; };
struct Ctx {
    volatile LAS unsigned long long* t;
    __device__ __forceinline__ unsigned long long ld(int i) const { const unsigned long long v = t[i];
        return ((unsigned long long)(unsigned)__builtin_amdgcn_readfirstlane((int)(v >> 32)) << 32) | (unsigned long long)(unsigned)__builtin_amdgcn_readfirstlane((int)(unsigned)v); }
    __device__ __forceinline__ const float* in(int i) const { return (const float*)ld(i); }
    __device__ __forceinline__ float* out() const { return (float*)ld(30); }
    __device__ __forceinline__ unsigned char* ws() const { return (unsigned char*)ld(31); }
};

constexpr int S5K = 1152;
constexpr size_t S5_T_LAYER = (size_t)64 * 1024 * S5K * 2, S5_W1_LAYER = (size_t)64 * 256 * S5K * 2;

struct S5Order {
    int G, c, n, sh;
    __device__ __forceinline__ bool next(int i, pg8::Unit& u) const { const int L = i * G + c; if (L >= n) return false; u.pm = L >> sh; u.pn = L; return true; }
    __device__ __forceinline__ void a_ready(const pg8::Unit&) const {}
    __device__ __forceinline__ void done(const pg8::Unit&) const {}
};
struct EpiS5A {
    static constexpr bool PERM = false, AFTER_DRAIN = false;
    float* Sloc;
    __device__ __forceinline__ void operator()(const f32x4 (&acc)[2][2][4][2], const pg8::Unit& u, int wr, int wc, int fr, int fq) const {
        const int row0 = u.pm * 256 + wr * 64 + fr, col0 = wc * 32 + 4 * fq;
#pragma unroll
        for (int ai = 0; ai < 2; ++ai)
#pragma unroll
            for (int m = 0; m < 4; ++m)
#pragma unroll
                for (int n = 0; n < 2; ++n) *(f32x4*)(Sloc + (size_t)(row0 + ai * 128 + m * 16) * 128 + col0 + n * 16) = acc[ai][0][m][n];
    }
};
struct EpiS5C {
    static constexpr bool PERM = true, AFTER_DRAIN = false;
    bf16_t* Z;
    __device__ __forceinline__ void operator()(const f32x4 (&acc)[2][2][4][2], const pg8::Unit& u, int wr, int wc, int fr, int fq) const {
        const int g = u.pm, c0 = wr * 64 + fr, cc0 = (u.pn & 3) * 256 + wc * 32 + 8 * fq;
#pragma unroll
        for (int ai = 0; ai < 2; ++ai)
#pragma unroll
            for (int m = 0; m < 4; ++m) { const int c = c0 + ai * 128 + m * 16;
#pragma unroll
                for (int bj = 0; bj < 2; ++bj) { const int cc = cc0 + bj * 128, t = cc >> 4, h0 = cc & 15;
                    const f32x4 v0 = acc[ai][bj][m][0], v1 = acc[ai][bj][m][1];
                    u32x4 w; w.x = cvt_pk_bf16(gelu_tanh(v0[0]), gelu_tanh(v0[1])); w.y = cvt_pk_bf16(gelu_tanh(v0[2]), gelu_tanh(v0[3]));
                    w.z = cvt_pk_bf16(gelu_tanh(v1[0]), gelu_tanh(v1[1])); w.w = cvt_pk_bf16(gelu_tanh(v1[2]), gelu_tanh(v1[3]));
                    *(u32x4*)(Z + (size_t)(c * 64 + t) * S5W + g * 16 + h0) = w; } }
    }
};
__device__ __forceinline__ void s5_tables_item(const Ctx& a, int lg, LAS unsigned char* lds, int wave, int lane) {
    LAS f32x2* LP = (LAS f32x2*)lds;
    LAS f32x2* BB = (LAS f32x2*)(lds + 33280);
    LAS f32x2* CC = (LAS f32x2*)(lds + 41472);
    LAS float* KT = (LAS float*)(lds + 49664);
    const int tid = wave * 64 + lane, l = lg >> 6, g = lg & 63;
    if (tid < 64) { const int p = tid;
        const double ar = (double)a.in(I_AREAL)[lg * 64 + p], ai = (double)a.in(I_AIMAG)[lg * 64 + p], dt = exp((double)a.in(I_LOGDT)[lg]);
        const double mag = exp(ar * dt), ang = ai * dt, lr = mag * cos(ang), li = mag * sin(ang);
        const double den = ar * ar + ai * ai, nr = lr - 1.0, ni = li, cr = (nr * ar + ni * ai) / den, ci = (ni * ar - nr * ai) / den;
        double pr = 1.0, pi = 0.0;
        for (int tau = 0; tau <= 64; ++tau) { LP[tau * 64 + p] = (f32x2){(float)pr, (float)pi}; const double nr2 = pr * lr - pi * li, ni2 = pr * li + pi * lr; pr = nr2; pi = ni2; }
        for (int h = 0; h < 16; ++h) { const double br = (double)a.in(I_BRE)[((size_t)lg * 64 + p) * 16 + h], bi = (double)a.in(I_BIM)[((size_t)lg * 64 + p) * 16 + h];
            BB[p * 16 + h] = (f32x2){(float)(cr * br - ci * bi), (float)(cr * bi + ci * br)}; }
    }
    for (int e = tid; e < 1024; e += 512) { const int h = e >> 6, p = e & 63; CC[e] = (f32x2){a.in(I_CRE)[((size_t)lg * 16 + h) * 64 + p], a.in(I_CIM)[((size_t)lg * 16 + h) * 64 + p]}; }
    __syncthreads();
    if (tid < 64) *(f32x2*)((float*)(a.ws() + WS_LAM64) + ((size_t)lg * 64 + tid) * 2) = LP[64 * 64 + tid];
    for (int e = tid; e < 64 * 256; e += 512) { const int tau = e >> 8, h = (e >> 4) & 15, hp = e & 15; float s = 0.f;
#pragma unroll 8
        for (int p = 0; p < 64; ++p) { const f32x2 c = CC[h * 64 + p], lm = LP[tau * 64 + p], b = BB[p * 16 + hp];
            const float xr = c.x * lm.x - c.y * lm.y, xi = c.x * lm.y + c.y * lm.x; s += xr * b.x - xi * b.y; }
        if (tau == 0 && h == hp) s += a.in(I_S5D)[l * S5W + g * 16 + h];
        KT[e] = s; }
    __syncthreads();
    bf16_t* T = (bf16_t*)(a.ws() + WS_S5T + (size_t)l * S5_T_LAYER) + (size_t)g * 1024 * S5K;
    for (int pc = tid; pc < 1024 * 144; pc += 512) { const int n = pc / 144, j = pc % 144, t = n >> 4, h = n & 15; float v[8];
        if (j < 128) { const int s = j >> 1, hp0 = (j & 1) * 8;
            if (s > t) {
#pragma unroll
                for (int i = 0; i < 8; ++i) v[i] = 0.f;
            } else { const LAS float* kp = KT + (t - s) * 256 + h * 16 + hp0; const f32x4 k0 = *(const LAS f32x4*)kp, k1 = *(const LAS f32x4*)(kp + 4);
                v[0] = k0[0]; v[1] = k0[1]; v[2] = k0[2]; v[3] = k0[3]; v[4] = k1[0]; v[5] = k1[1]; v[6] = k1[2]; v[7] = k1[3]; }
        } else { const int p0 = (j - 128) * 4;
#pragma unroll
            for (int i = 0; i < 4; ++i) { const f32x2 c = CC[h * 64 + p0 + i], lm = LP[(t + 1) * 64 + p0 + i]; v[2 * i] = c.x * lm.x - c.y * lm.y; v[2 * i + 1] = -(c.x * lm.y + c.y * lm.x); } }
        *(u32x4*)(T + (size_t)n * S5K + j * 8) = (u32x4){cvt_pk_bf16(v[0], v[1]), cvt_pk_bf16(v[2], v[3]), cvt_pk_bf16(v[4], v[5]), cvt_pk_bf16(v[6], v[7])}; }
    bf16_t* W1 = (bf16_t*)(a.ws() + WS_S5W1 + (size_t)l * S5_W1_LAYER) + (size_t)g * 256 * S5K;
    for (int pc = tid; pc < 256 * 144; pc += 512) { const int n = pc / 144, j = pc % 144; float v[8];
#pragma unroll
        for (int i = 0; i < 8; ++i) v[i] = 0.f;
        if (n < 128 && j < 128) { const int p = n >> 1, ri = n & 1, s = j >> 1, hp0 = (j & 1) * 8; const f32x2 lm = LP[(63 - s) * 64 + p];
#pragma unroll
            for (int i = 0; i < 8; ++i) { const f32x2 b = BB[p * 16 + hp0 + i]; v[i] = ri ? (lm.x * b.y + lm.y * b.x) : (lm.x * b.x - lm.y * b.y); } }
        *(u32x4*)(W1 + (size_t)n * S5K + j * 8) = (u32x4){cvt_pk_bf16(v[0], v[1]), cvt_pk_bf16(v[2], v[3]), cvt_pk_bf16(v[4], v[5]), cvt_pk_bf16(v[6], v[7])}; }
    __syncthreads();
}
__device__ __forceinline__ void s5_scan_item(const Ctx& a, int l, int item, int wave, int lane) {
    const int idx = item * 512 + wave * 64 + lane, g = idx >> 7, b = (idx >> 6) & 1, p = idx & 63;
    const f32x2 lam = *(const f32x2*)((const float*)(a.ws() + WS_LAM64) + ((size_t)(l * 64 + g) * 64 + p) * 2);
    const float* sl = (const float*)(a.ws() + WS_SLOC) + ((size_t)(g * 256 + b * 128)) * 128 + 2 * p;
    bf16_t* ux = (bf16_t*)(a.ws() + WS_UX) + ((size_t)(g * 256 + b * 128)) * S5K + 1024 + 2 * p;
    float xr = 0.f, xi = 0.f;
    for (int c0 = 0; c0 < 128; c0 += 8) { f32x2 s[8];
#pragma unroll
        for (int i = 0; i < 8; ++i) s[i] = *(const f32x2*)(sl + (size_t)(c0 + i) * 128);
#pragma unroll
        for (int i = 0; i < 8; ++i) { *(unsigned*)(ux + (size_t)(c0 + i) * S5K) = cvt_pk_bf16(xr, xi);
            const float nr = lam.x * xr - lam.y * xi + s[i].x, ni = lam.x * xi + lam.y * xr + s[i].y; xr = nr; xi = ni; } }
}

__device__ __forceinline__ void transpose_item(const float* W, int N, int k0, int n0, bf16_t* WT, int drow0, int Kd, LAS float* scr, int lane) {
    const int nl = 4 * (lane & 15), kq = lane >> 4;
    const bool valid = (n0 + nl) < N;
    f32x4 v[16];
#pragma unroll
    for (int i = 0; i < 16; ++i) { const int k = 4 * i + kq; v[i] = valid ? *(const f32x4*)(W + (size_t)(k0 + k) * N + n0 + nl) : (f32x4){0.f, 0.f, 0.f, 0.f}; }
#pragma unroll
    for (int i = 0; i < 16; ++i) { const int k = 4 * i + kq; LAS float* s = scr + k * 65 + nl; s[0] = v[i][0]; s[1] = v[i][1]; s[2] = v[i][2]; s[3] = v[i][3]; }
    LDS_WAIT();
    const int c = lane & 7;
#pragma unroll
    for (int j = 0; j < 8; ++j) { const int n = (lane >> 3) + 8 * j; const LAS float* s = scr + (8 * c) * 65 + n;
        u32x4 o; o.x = cvt_pk_bf16(s[0], s[65]); o.y = cvt_pk_bf16(s[130], s[195]); o.z = cvt_pk_bf16(s[260], s[325]); o.w = cvt_pk_bf16(s[390], s[455]);
        *(u32x4*)(WT + (size_t)(drow0 + n) * Kd + k0 + 8 * c) = o; }
    LDS_WAIT();
}
constexpr int NIT_IN = 64 * 188, NIT_OUT = 64 * 64, NIT_G = 64 * 172, NIT_DN = 172 * 64, NIT_GLU = 16 * 16;
constexpr int NIT_LAYER = NIT_IN + NIT_OUT + 2 * NIT_G + NIT_DN + NIT_GLU;
constexpr int NIT_TR = DEPTH * NIT_LAYER, NIT_COND = 64 * 96;

__device__ __forceinline__ void phase_prologue(const Ctx& a, LAS unsigned char* lds, int wave, int lane) {
    if (blockIdx.x & 1) { for (int lg = blockIdx.x; lg < DEPTH * 64; lg += gridDim.x) s5_tables_item(a, lg, lds, wave, lane); __syncthreads(); }
    LAS float* scr = (LAS float*)(lds + wave * 16640);
    const int gw = blockIdx.x * 8 + wave, NGW = gridDim.x * 8;
    for (int it = gw; it < NIT_TR + NIT_COND; it += NGW) {
        if (it < NIT_TR) {
            const int l = it / NIT_LAYER; int r = it % NIT_LAYER;
            unsigned char* wt = a.ws() + WS_WT + (size_t)l * WT_LAYER;
            if (r < NIT_IN) { const int kb = r / 188, nb = r % 188; transpose_item(a.in(I_WIN) + (size_t)l * DM * INW, INW, 64 * kb, 64 * nb, (bf16_t*)(wt + WT_IN), 64 * nb, DM, scr, lane); continue; } r -= NIT_IN;
            if (r < NIT_OUT) { const int kb = r / 64, nb = r % 64; transpose_item(a.in(I_WOUT) + (size_t)l * DM * DM, DM, 64 * kb, 64 * nb, (bf16_t*)(wt + WT_OUT), 64 * nb, DM, scr, lane); continue; } r -= NIT_OUT;
            if (r < NIT_G) { const int kb = r / 172, nb = r % 172, n0 = 64 * nb; transpose_item(a.in(I_WFG) + (size_t)l * DM * DFF, DFF, 64 * kb, n0, (bf16_t*)(wt + WT_GU), 256 * (n0 / 128) + (n0 % 128), DM, scr, lane); continue; } r -= NIT_G;
            if (r < NIT_G) { const int kb = r / 172, nb = r % 172, n0 = 64 * nb; transpose_item(a.in(I_WFU) + (size_t)l * DM * DFF, DFF, 64 * kb, n0, (bf16_t*)(wt + WT_GU), 256 * (n0 / 128) + 128 + (n0 % 128), DM, scr, lane); continue; } r -= NIT_G;
            if (r < NIT_DN) { const int kb = r / 64, nb = r % 64; transpose_item(a.in(I_WFD) + (size_t)l * DFF * DM, DM, 64 * kb, 64 * nb, (bf16_t*)(wt + WT_DN), 64 * nb, DFF, scr, lane); continue; } r -= NIT_DN;
            { const int kb = r / 16, nb = r % 16; transpose_item(a.in(I_GLUW) + (size_t)l * S5W * S5W, S5W, 64 * kb, 64 * nb, (bf16_t*)(wt + WT_GLU), 64 * nb, S5W, scr, lane); }
        } else {
            const int item = it - NIT_TR, kb = item / 96, jb = item % 96, k0 = 64 * kb, j0 = 256 * jb + 4 * lane;
            const float* c = a.in(I_C);
            float c0 = c[k0 + lane], c1 = c[DM + k0 + lane];
            c0 = c0 / (1.0f + expf(-c0)); c1 = c1 / (1.0f + expf(-c1));
            f32x4 a0 = (f32x4){0.f, 0.f, 0.f, 0.f}, a1 = a0;
            const float* w = a.in(I_WADA) + (size_t)k0 * (6 * DM) + j0;
#pragma unroll 8
            for (int kk = 0; kk < 64; ++kk) { const f32x4 wv = *(const f32x4*)(w + (size_t)kk * (6 * DM));
                const float s0 = __int_as_float(__builtin_amdgcn_readlane(__float_as_int(c0), kk)), s1 = __int_as_float(__builtin_amdgcn_readlane(__float_as_int(c1), kk));
                a0 += wv * s0; a1 += wv * s1; }
            float* cp = (float*)(a.ws() + WS_CONDPART);
            *(f32x4*)(cp + (size_t)(kb * 2 + 0) * (6 * DM) + j0) = a0;
            *(f32x4*)(cp + (size_t)(kb * 2 + 1) * (6 * DM) + j0) = a1;
        }
    }
    __syncthreads();
    if (!(blockIdx.x & 1)) { for (int lg = blockIdx.x; lg < DEPTH * 64; lg += gridDim.x) s5_tables_item(a, lg, lds, wave, lane); }
}
__device__ __forceinline__ void phase_mod(const Ctx& a, int wave, int lane) {
    const int gt = blockIdx.x * 512 + wave * 64 + lane, NT = gridDim.x * 512;
    const float* cp = (const float*)(a.ws() + WS_CONDPART);
    float* mod = (float*)(a.ws() + WS_MOD); float* misc = (float*)(a.ws() + WS_MISC);
    for (int idx = gt; idx < NB * 6 * DM; idx += NT) {
        const int b = idx / (6 * DM), j = idx % (6 * DM);
        float s = a.in(I_BADA)[j];
        for (int kb = 0; kb < 64; ++kb) s += cp[(size_t)(kb * 2 + b) * (6 * DM) + j];
        for (int l = 0; l < DEPTH; ++l) mod[(size_t)((l * 2 + b) * 6) * DM + j] = s + a.in(I_TABLE)[(size_t)l * 6 * DM + j];
    }
    for (int idx = gt; idx < DM; idx += NT) { misc[idx] = 1.0f; misc[DM + idx] = 0.0f; }
    for (int idx = gt; idx < HGW; idx += NT) {
        const float* raw = a.in(I_LBRAW); float r[DEPTH], mx = -3.0e38f;
#pragma unroll
        for (int l = 0; l < DEPTH; ++l) { r[l] = raw[l * HGW + idx]; mx = fmaxf(mx, r[l]); }
        float e[DEPTH], sum = 0.f;
#pragma unroll
        for (int l = 0; l < DEPTH; ++l) { e[l] = expf(r[l] - mx); sum += e[l]; }
        float cum = 0.f;
#pragma unroll
        for (int l = 0; l < DEPTH; ++l) { misc[2 * DM + l * HGW + idx] = cum; if (l + 1 < DEPTH) cum += e[l + 1] / sum; }
    }
}

__device__ __forceinline__ void phase_h0(const float* x, const float* modp, bf16_t* H, int wave, int lane) {
    for (int blk = blockIdx.x; blk < MTOK / 64; blk += gridDim.x) {
        const int r0 = blk * 64, b = (r0 >= SEQ) ? 1 : 0;
        f32x4 A[2], B[2];
#pragma unroll
        for (int jj = 0; jj < 2; ++jj) { const int c = 512 * wave + 256 * jj + 4 * lane; A[jj] = *(const f32x4*)(modp + (size_t)(b * 6 + 1) * DM + c) + 1.0f; B[jj] = *(const f32x4*)(modp + (size_t)(b * 6 + 0) * DM + c); }
#pragma unroll 8
        for (int rl = 0; rl < 64; ++rl) { const size_t off = (size_t)(r0 + rl) * DM + 512 * wave + 4 * lane;
#pragma unroll
            for (int jj = 0; jj < 2; ++jj) { const f32x4 v = *(const f32x4*)(x + off + 256 * jj), y = v * A[jj] + B[jj];
                u32x2 w; w.x = cvt_pk_bf16(y[0], y[1]); w.y = cvt_pk_bf16(y[2], y[3]); *(u32x2*)(H + off + 256 * jj) = w; } }
    }
}
template <bool WITH_H>
__device__ __forceinline__ void phase_lnres(const float* xprev, const bf16_t* delta, float* xout, const float* lng, const float* lnb, const float* modp, int i_shift, int i_scale, bf16_t* H,
                                            LAS unsigned char* lds, int wave, int lane) {
    LAS f32x2* red = (LAS f32x2*)lds;
    for (int blk = blockIdx.x; blk < MTOK / 64; blk += gridDim.x) {
        const int r0 = blk * 64, b = (r0 >= SEQ) ? 1 : 0;
        f32x4 G[2], Bt[2], A[2], B[2];
#pragma unroll
        for (int jj = 0; jj < 2; ++jj) { const int c = 512 * wave + 256 * jj + 4 * lane; G[jj] = *(const f32x4*)(lng + c); Bt[jj] = *(const f32x4*)(lnb + c);
            if (WITH_H) { A[jj] = *(const f32x4*)(modp + (size_t)(b * 6 + i_scale) * DM + c) + 1.0f; B[jj] = *(const f32x4*)(modp + (size_t)(b * 6 + i_shift) * DM + c); } }
        for (int it = 0; it < 8; ++it) {
            const size_t off0 = (size_t)(r0 + it * 8) * DM + 512 * wave + 4 * lane;
            f32x4 v[8][2]; u32x2 dl[8][2];
#pragma unroll
            for (int r = 0; r < 8; ++r)
#pragma unroll
                for (int jj = 0; jj < 2; ++jj) { v[r][jj] = *(const f32x4*)(xprev + off0 + (size_t)r * DM + 256 * jj); dl[r][jj] = *(const u32x2*)(delta + off0 + (size_t)r * DM + 256 * jj); }
            LAS f32x2* rb = red + (it & 1) * 64;
#pragma unroll
            for (int r = 0; r < 8; ++r) { float s1 = 0.f, s2 = 0.f;
#pragma unroll
                for (int jj = 0; jj < 2; ++jj) { const f32x4 d = (f32x4){bf_lo(dl[r][jj].x), bf_hi(dl[r][jj].x), bf_lo(dl[r][jj].y), bf_hi(dl[r][jj].y)}; const f32x4 y = v[r][jj] * ALPHA + d; v[r][jj] = y;
                    s1 += (y[0] + y[1]) + (y[2] + y[3]); s2 += (y[0] * y[0] + y[1] * y[1]) + (y[2] * y[2] + y[3] * y[3]); }
                s1 = wave_sum(s1); s2 = wave_sum(s2);
                if (lane == 0) rb[r * 8 + wave] = (f32x2){s1, s2}; }
            __syncthreads();
#pragma unroll
            for (int r = 0; r < 8; ++r) { float s1 = 0.f, s2 = 0.f;
#pragma unroll
                for (int w = 0; w < 8; ++w) { const f32x2 p = rb[r * 8 + w]; s1 += p.x; s2 += p.y; }
                const float mu = s1 * (1.0f / DM), rs = 1.0f / sqrtf(fmaxf(s2 * (1.0f / DM) - mu * mu, 0.f) + LN_EPS);
#pragma unroll
                for (int jj = 0; jj < 2; ++jj) { const f32x4 x = ((v[r][jj] - mu) * rs) * G[jj] + Bt[jj];
                    *(f32x4*)(xout + off0 + (size_t)r * DM + 256 * jj) = x;
                    if (WITH_H) { const f32x4 y = x * A[jj] + B[jj]; u32x2 w; w.x = cvt_pk_bf16(y[0], y[1]); w.y = cvt_pk_bf16(y[2], y[3]); *(u32x2*)(H + off0 + (size_t)r * DM + 256 * jj) = w; } } }
        }
        __syncthreads();
    }
}

typedef short bf16x8 __attribute__((ext_vector_type(8)));
typedef short bf16x4 __attribute__((ext_vector_type(4)));
constexpr int HG_BLK = 16896, HG_OQ = 0, HG_OK = 4096, HG_OKT = 8192, HG_OVT = 12288, HG_ODL = 16384;
constexpr int GL_BLK = 32768, GL_OQ = 0, GL_OK = 6400, GL_OKT = 12800, GL_ODL = 18944, GL_SHARED = 20480, GL_OVT = 20480;
constexpr int NSUB = SEQ / 16;

__device__ __forceinline__ unsigned short f2bf1(float x) { return (unsigned short)(cvt_pk_bf16(x, x) & 0xffffu); }

__device__ __forceinline__ void pre_finish(const float (&qq)[16], const float (&kk)[16], float (&g)[16], unsigned char* blk, int oq, int ok, int okt, int odl, int rowb, int d, bool swz) {
    const int pd = (d & ~31) + 8 * ((d >> 2) & 3) + 4 * ((d >> 4) & 1) + (d & 3);
    float b = 0.f;
#pragma unroll
    for (int j = 0; j < 16; ++j) { b += g[j]; g[j] = b; }
    const float bl = b;
    unsigned kt[8];
#pragma unroll
    for (int j = 0; j < 16; j += 2) {
        float kv[2];
#pragma unroll
        for (int jj = 0; jj < 2; ++jj) { const int t = j + jj; const float bj = g[t];
            const int off = t * rowb + (swz ? ((2 * pd) ^ (t << 4)) : 2 * pd);
            const float qv = qq[t] * __expf(bj), kc = kk[t] * __expf(fminf(-bj, 80.f));
            const float qn = __int_as_float(__builtin_amdgcn_mov_dpp(__float_as_int(qv), 0xB1, 0xF, 0xF, true)), kn = __int_as_float(__builtin_amdgcn_mov_dpp(__float_as_int(kc), 0xB1, 0xF, 0xF, true));
            if ((d & 1) == 0) { *(unsigned*)(blk + oq + off) = cvt_pk_bf16(qv, qn); *(unsigned*)(blk + ok + off) = cvt_pk_bf16(kc, kn); }
            kv[jj] = kk[t] * __expf(bl - bj); }
        kt[j >> 1] = cvt_pk_bf16(kv[0], kv[1]); }
    *(u32x4*)(blk + okt + d * 32) = (u32x4){kt[0], kt[1], kt[2], kt[3]};
    *(u32x4*)(blk + okt + d * 32 + 16) = (u32x4){kt[4], kt[5], kt[6], kt[7]};
    *(float*)(blk + odl + d * 4) = __expf(bl);
}
__device__ __forceinline__ void phase_pre(const Ctx& a, int l, int wave, int lane) {
    const bf16_t* P = (const bf16_t*)(a.ws() + WS_P);
    int tid = wave * 64 + lane;
    const bool bal = gridDim.x == 256;
    const int t_lo = bal ? (blockIdx.x < 64 ? 26 * (int)blockIdx.x : 1664 + 34 * ((int)blockIdx.x - 64)) : (int)blockIdx.x;
    const int t_hi = bal ? t_lo + (blockIdx.x < 64 ? 26 : 34) : NB * NSUB * 8, t_st = bal ? 1 : (int)gridDim.x;
    for (int task = t_lo; task < t_hi; task += t_st) {
        asm volatile("" : "+v"(tid));
        const int kind = bal ? (task & 7) : ((task + (task >> 8)) & 7), bsc = task >> 3, b = bsc / NSUB, sc = bsc % NSUB;
        const size_t row0 = (size_t)b * SEQ + sc * 16;
        if (kind < 3) {
            const int ch = kind * 512 + tid, h = ch >> 7, d = ch & 127;
            const float lb = ((const float*)(a.ws() + WS_MISC))[2 * DM + l * HGW + ch];
            unsigned char* blk = a.ws() + WS_HGB + ((size_t)(b * 12 + h) * NSUB + sc) * HG_BLK;
            float g[16], qq[16], kk[16]; unsigned vv[8];
#pragma unroll
            for (int j = 0; j < 16; ++j) { const bf16_t* prow = P + (row0 + j) * INP;
                const float qin = fmaxf(bf2f(prow[C_QB + ch]), -80.f), fin = fminf(fmaxf(bf2f(prow[C_FB + ch]), -80.f), 80.f);
                const unsigned short v = prow[C_IB + ch]; if (j & 1) vv[j >> 1] |= ((unsigned)v) << 16; else vv[j >> 1] = v;
                const float e = __expf(-fin), sg = __builtin_amdgcn_rcpf(1.0f + e);
                const float f = lb + (1.0f - lb) * sg;
                g[j] = fmaxf(__logf(f), -100.f); kk[j] = (1.0f - lb) * (e * sg); qq[j] = qin * __builtin_amdgcn_rcpf(1.0f + __expf(-qin)); }
            *(u32x4*)(blk + HG_OVT + d * 32) = (u32x4){vv[0], vv[1], vv[2], vv[3]};
            *(u32x4*)(blk + HG_OVT + d * 32 + 16) = (u32x4){vv[4], vv[5], vv[6], vv[7]};
            pre_finish(qq, kk, g, blk, HG_OQ, HG_OK, HG_OKT, HG_ODL, 256, d, true);
        } else if (kind < 5) {
            if (tid < 384) {
                const int ch = (kind - 3) * 384 + tid, h = ch / 192, d = ch % 192;
                unsigned char* blk = a.ws() + WS_GLB + ((size_t)(b * 4 + h) * NSUB + sc) * GL_BLK;
                float wg[16];
#pragma unroll
                for (int r = 0; r < 16; ++r) wg[r] = a.in(I_WGATE)[((size_t)l * 16 + r) * GLKW + ch];
                const float bgv = a.in(I_BGATE)[l * GLKW + ch];
                float g[16], qq[16], kk[16];
#pragma unroll
                for (int j = 0; j < 16; ++j) { const bf16_t* prow = P + (row0 + j) * INP;
                    const u32x4 l0 = *(const u32x4*)(prow + C_LR), l1 = *(const u32x4*)(prow + C_LR + 8);
                    float x = bgv;
                    x += bf_lo(l0.x) * wg[0] + bf_hi(l0.x) * wg[1] + bf_lo(l0.y) * wg[2] + bf_hi(l0.y) * wg[3] + bf_lo(l0.z) * wg[4] + bf_hi(l0.z) * wg[5] + bf_lo(l0.w) * wg[6] + bf_hi(l0.w) * wg[7];
                    x += bf_lo(l1.x) * wg[8] + bf_hi(l1.x) * wg[9] + bf_lo(l1.y) * wg[10] + bf_hi(l1.y) * wg[11] + bf_lo(l1.z) * wg[12] + bf_hi(l1.z) * wg[13] + bf_lo(l1.w) * wg[14] + bf_hi(l1.w) * wg[15];
                    g[j] = (fminf(x, 0.f) - __logf(1.0f + __expf(-fabsf(x)))) * 0.0625f;
                    qq[j] = bf2f(prow[C_QC + ch]) * GLA_QSCALE; kk[j] = bf2f(prow[C_KC + ch]); }
                pre_finish(qq, kk, g, blk, GL_OQ, GL_OK, GL_OKT, GL_ODL, 400, d, false);
            }
        } else {
            const int ch = (kind - 5) * 512 + tid, h = ch / 384, e = ch % 384;
            unsigned char* blk = a.ws() + WS_GLB + ((size_t)(b * 4 + h) * NSUB + sc) * GL_BLK;
            unsigned vv[8];
#pragma unroll
            for (int j = 0; j < 16; ++j) { const unsigned short v = P[(row0 + j) * INP + C_VC + ch]; if (j & 1) vv[j >> 1] |= ((unsigned)v) << 16; else vv[j >> 1] = v; }
            *(u32x4*)(blk + GL_OVT + e * 32) = (u32x4){vv[0], vv[1], vv[2], vv[3]};
            *(u32x4*)(blk + GL_OVT + e * 32 + 16) = (u32x4){vv[4], vv[5], vv[6], vv[7]};
        }
    }
}

template <int DK, int MODE>
__device__ __forceinline__ void chain_sub(const LAS unsigned char* sb, f32x4 (&S)[DK / 16], float* op, int wave, int n, int q) {
    constexpr bool IS_GLA = (DK == 192);
    constexpr int NKS = DK / 32, NMB = DK / 16, ROWB = IS_GLA ? 400 : 256;
    constexpr int OQ = 0, OK = IS_GLA ? GL_OK : HG_OK, OKT = IS_GLA ? GL_OKT : HG_OKT, OVT = IS_GLA ? GL_OVT : HG_OVT, ODL = IS_GLA ? GL_ODL : HG_ODL;
    const u32x2 vfr = *(const LAS u32x2*)(sb + OVT + (16 * wave + n) * 32 + 8 * q);
    const bf16x8 vf8 = __builtin_bit_cast(bf16x8, (u32x4){vfr.x, vfr.y, 0u, 0u});
    if (MODE == 1) {
        bf16x8 qf[NKS], kf[NKS];
#pragma unroll
        for (int ks = 0; ks < NKS; ++ks) { const int c0 = 64 * ks + 16 * q, o0 = n * ROWB + (IS_GLA ? c0 : (c0 ^ (n << 4)));
            qf[ks] = __builtin_bit_cast(bf16x8, *(const LAS u32x4*)(sb + OQ + o0)); kf[ks] = __builtin_bit_cast(bf16x8, *(const LAS u32x4*)(sb + OK + o0)); }
        f32x4 ao = (f32x4){0.f, 0.f, 0.f, 0.f}, ap = ao, ao1 = ao, ap1 = ao;
#pragma unroll
        for (int ks = 0; ks < NKS; ++ks) {
            const bf16x8 sbf = __builtin_bit_cast(bf16x8, (u32x4){cvt_pk_bf16(S[2 * ks][0], S[2 * ks][1]), cvt_pk_bf16(S[2 * ks][2], S[2 * ks][3]), cvt_pk_bf16(S[2 * ks + 1][0], S[2 * ks + 1][1]), cvt_pk_bf16(S[2 * ks + 1][2], S[2 * ks + 1][3])});
            if (ks & 1) { ao1 = __builtin_amdgcn_mfma_f32_16x16x32_bf16(qf[ks], sbf, ao1, 0, 0, 0); ap1 = __builtin_amdgcn_mfma_f32_16x16x32_bf16(kf[ks], qf[ks], ap1, 0, 0, 0); }
            else { ao = __builtin_amdgcn_mfma_f32_16x16x32_bf16(qf[ks], sbf, ao, 0, 0, 0); ap = __builtin_amdgcn_mfma_f32_16x16x32_bf16(kf[ks], qf[ks], ap, 0, 0, 0); } }
        ao = ao + ao1; ap = ap + ap1;
#pragma unroll
        for (int r = 0; r < 4; ++r) if (4 * q + r > n) ap[r] = 0.f;
        const bf16x8 pa8 = __builtin_bit_cast(bf16x8, (u32x4){cvt_pk_bf16(ap[0], ap[1]), cvt_pk_bf16(ap[2], ap[3]), 0u, 0u});
        ao = __builtin_amdgcn_mfma_f32_16x16x32_bf16(pa8, vf8, ao, 0, 0, 0);
#pragma unroll
        for (int r = 0; r < 4; ++r) op[(size_t)(4 * q + r) * OW] = ao[r];
    }
#pragma unroll
    for (int mb = 0; mb < NMB; ++mb) {
        const f32x4 dl = *(const LAS f32x4*)(sb + ODL + (16 * mb + 4 * q) * 4);
        const u32x2 ktr = *(const LAS u32x2*)(sb + OKT + (16 * mb + n) * 32 + 8 * q);
        S[mb] = __builtin_amdgcn_mfma_f32_16x16x32_bf16(__builtin_bit_cast(bf16x8, (u32x4){ktr.x, ktr.y, 0u, 0u}), vf8, S[mb] * dl, 0, 0, 0); }
}
constexpr size_t ST_REC = 98304;
constexpr int NSEG_HG = 4, NSEG_GL = 6, NSEG_MAX = 6;
__device__ __forceinline__ int seg_u0(bool gla, int s) { return gla ? (s <= 2 ? 44 * s : 88 + 42 * (s - 2)) : 64 * s; }
__device__ __forceinline__ int seg_nu(bool gla, int s) { return gla ? (s < 2 ? 44 : 42) : 64; }
template <int DK, int MODE>
__device__ __forceinline__ void chain_item(const unsigned char* blk0, int vt_off, float* op0, unsigned char* st, int seg, int nunits, LAS unsigned char* lds, int wave, int lane) {
    asm volatile("" : "+v"(lane), "+s"(wave));
    constexpr bool IS_GLA = (DK == 192);
    constexpr int BLK = IS_GLA ? GL_BLK : HG_BLK, SUBB = IS_GLA ? GL_SHARED + 4096 : HG_BLK, NMB = DK / 16;
    constexpr int SH0 = MODE == 1 ? 0 : (IS_GLA ? GL_OKT : HG_OKT);
    constexpr int SH_PIECES = (MODE == 1 ? (IS_GLA ? GL_SHARED : HG_OVT) : (IS_GLA ? GL_ODL + 768 - GL_OKT : 4096)) / 16;
    constexpr int T_PIECES = IS_GLA ? 256 : (4096 + 512) / 16;
    constexpr int T_LDS = IS_GLA ? GL_OVT : HG_OVT;
    constexpr int PIECES = SH_PIECES + T_PIECES, UNITB = 2 * SUBB, NP = (2 * PIECES + 511) / 512;
    const int tid = wave * 64 + lane, n = lane & 15, q = lane >> 4;
    f32x4 S[NMB]; float dacc = 1.0f;
    constexpr int ODL_ = IS_GLA ? GL_ODL : HG_ODL;
#pragma unroll
    for (int mb = 0; mb < NMB; ++mb) S[mb] = (f32x4){0.f, 0.f, 0.f, 0.f};
    if (MODE == 1) {
        for (int s = 0; s < seg; ++s) { const unsigned char* rec = st + (size_t)s * 2 * ST_REC + (size_t)(wave * 64 + lane) * 16;
#pragma unroll
            for (int mb = 0; mb < NMB; ++mb) { const f32x4 h = *(const f32x4*)(rec + (size_t)mb * 8192), d = *(const f32x4*)(st + (size_t)s * 2 * ST_REC + ST_REC + (16 * mb + 4 * q) * 4); S[mb] = S[mb] * d + h; } }
    }
    u32x4 stgA[NP], stgB[NP];
#define CH_SRC(u, p_) (blk0 + (size_t)((u) * 2 + (p_) / PIECES) * BLK + (((p_) % PIECES) < SH_PIECES ? SH0 + ((p_) % PIECES) * 16 : (IS_GLA ? vt_off : HG_OVT) + (((p_) % PIECES) - SH_PIECES) * 16))
#define CH_DST(p_) (((p_) / PIECES) * SUBB + (((p_) % PIECES) < SH_PIECES ? SH0 + ((p_) % PIECES) * 16 : T_LDS + (((p_) % PIECES) - SH_PIECES) * 16))
#define CH_LOAD(stg, u) do { _Pragma("unroll") for (int r_ = 0; r_ < NP; ++r_) { const int p_ = r_ * 512 + tid; const bool ok_ = (NP * 512 == 2 * PIECES) || p_ < 2 * PIECES; const int pc_ = ok_ ? p_ : 0; stg[r_] = *(const u32x4*)CH_SRC(u, pc_); } } while (0)
#define CH_STORE(stg, buf) do { _Pragma("unroll") for (int r_ = 0; r_ < NP; ++r_) { const int p_ = r_ * 512 + tid; const bool ok_ = (NP * 512 == 2 * PIECES) || p_ < 2 * PIECES; const int pc_ = ok_ ? p_ : 0; \
        const int d_ = ok_ ? (buf) * UNITB + CH_DST(pc_) : 2 * UNITB + (p_ - 2 * PIECES) * 16; *(LAS u32x4*)(lds + d_) = stg[r_]; } } while (0)
#define CH_SYNC() do { asm volatile("s_waitcnt lgkmcnt(0)" ::: "memory"); __builtin_amdgcn_s_barrier(); asm volatile("" ::: "memory"); } while (0)
    CH_LOAD(stgA, 0); CH_STORE(stgA, 0);
    CH_LOAD(stgA, 1);
    CH_SYNC();
    float* op = op0 + 16 * wave + n;
    for (int u = 0; u < nunits; u += 2) {
        if (u + 2 < nunits) CH_LOAD(stgB, u + 2);
        chain_sub<DK, MODE>(lds, S, op + (size_t)(u * 32) * OW, wave, n, q);
        chain_sub<DK, MODE>(lds + SUBB, S, op + (size_t)(u * 32 + 16) * OW, wave, n, q);
        if (MODE == 0 && tid < DK) dacc *= *(const LAS float*)(lds + ODL_ + 4 * tid) * *(const LAS float*)(lds + SUBB + ODL_ + 4 * tid);
        CH_STORE(stgA, 1);
        CH_SYNC();
        if (u + 3 < nunits) CH_LOAD(stgA, u + 3);
        chain_sub<DK, MODE>(lds + UNITB, S, op + (size_t)(u * 32 + 32) * OW, wave, n, q);
        chain_sub<DK, MODE>(lds + UNITB + SUBB, S, op + (size_t)(u * 32 + 48) * OW, wave, n, q);
        if (MODE == 0 && tid < DK) dacc *= *(const LAS float*)(lds + UNITB + ODL_ + 4 * tid) * *(const LAS float*)(lds + UNITB + SUBB + ODL_ + 4 * tid);
        if (u + 2 < nunits) CH_STORE(stgB, 0);
        CH_SYNC();
    }
    if (MODE == 0) { unsigned char* rec = st + (size_t)seg * 2 * ST_REC + (size_t)(wave * 64 + lane) * 16;
#pragma unroll
        for (int mb = 0; mb < NMB; ++mb) *(f32x4*)(rec + (size_t)mb * 8192) = S[mb];
        if (tid < DK) *(float*)(st + (size_t)seg * 2 * ST_REC + ST_REC + 4 * tid) = dacc; }
#undef CH_SRC
#undef CH_DST
#undef CH_LOAD
#undef CH_STORE
#undef CH_SYNC
}

template <int MODE>
__device__ __forceinline__ void phase_chain(const Ctx& a, int l, LAS unsigned char* lds, int wave, int lane) {
    const int bx = blockIdx.x, G = gridDim.x;
    constexpr int nhg = 24 * (MODE == 0 ? NSEG_HG - 1 : NSEG_HG), nitems = nhg + 24 * (MODE == 0 ? NSEG_GL - 1 : NSEG_GL);
    for (int it = bx; it < nitems; it += G) {
        const bool gla = it >= nhg; const int j = gla ? it - nhg : it, c = j % 24, seg = j / 24, u0 = seg_u0(gla, seg), nu = seg_nu(gla, seg);
        unsigned char* st = a.ws() + WS_ST + (size_t)(gla ? 24 + c : c) * (NSEG_MAX - 1) * 2 * ST_REC;
        if (!gla) { const int b = c / 12, h = c % 12;
            chain_item<128, MODE>(a.ws() + WS_HGB + ((size_t)(b * 12 + h) * NSUB + 2 * u0) * HG_BLK, 0, (float*)(a.ws() + WS_O) + ((size_t)b * SEQ + u0 * 32) * OW + h * 128, st, seg, nu, lds, wave, lane); }
        else { const int b = c / 12, h = (c % 12) / 3, sl = c % 3;
            chain_item<192, MODE>(a.ws() + WS_GLB + ((size_t)(b * 4 + h) * NSUB + 2 * u0) * GL_BLK, GL_OVT + 4096 * sl, (float*)(a.ws() + WS_O) + ((size_t)b * SEQ + u0 * 32) * OW + HGW + h * 384 + sl * 128, st, seg, nu, lds, wave, lane); }
        __syncthreads();
    }
    if (MODE == 0) { for (int it = (G >= nitems + 16) ? bx - nitems : bx; it < 16; it += G) { if (it < 0) continue; s5_scan_item(a, l, it, wave, lane); } }
}
__device__ __forceinline__ float red16(float v) {
    v += __int_as_float(__builtin_amdgcn_mov_dpp(__float_as_int(v), 0xB1, 0xF, 0xF, true)); v += __int_as_float(__builtin_amdgcn_mov_dpp(__float_as_int(v), 0x4E, 0xF, 0xF, true));
    v += __int_as_float(__builtin_amdgcn_mov_dpp(__float_as_int(v), 0x141, 0xF, 0xF, true)); v += __int_as_float(__builtin_amdgcn_mov_dpp(__float_as_int(v), 0x140, 0xF, 0xF, true)); return v; }
__device__ __forceinline__ void phase_finalize(const Ctx& a, int l, int wave, int lane) {
    const bf16_t* P = (const bf16_t*)(a.ws() + WS_P); const float* O = (const float*)(a.ws() + WS_O); bf16_t* MX = (bf16_t*)(a.ws() + WS_MIXED);
    const float* hgg = a.in(I_HGG) + l * HGW; const float* hgb = a.in(I_HGB) + l * HGW; const float* glg = a.in(I_GLG) + l * HGW;
    const int gw = blockIdx.x * 8 + wave, NGW = gridDim.x * 8;
    for (int row = gw; row < MTOK; row += NGW) {
        const float* orow = O + (size_t)row * OW; const bf16_t* prow = P + (size_t)row * INP; bf16_t* mrow = MX + (size_t)row * DM;
#pragma unroll
        for (int it = 0; it < 3; ++it) { const int c = (it * 4 + (lane >> 4)) * 128 + (lane & 15) * 8;
            const f32x4 o0 = *(const f32x4*)(orow + c), o1 = *(const f32x4*)(orow + c + 4); const u32x4 gg = *(const u32x4*)(prow + C_GB + c);
            float v[8] = {sigmoidf_(bf_lo(gg.x)) * o0[0], sigmoidf_(bf_hi(gg.x)) * o0[1], sigmoidf_(bf_lo(gg.y)) * o0[2], sigmoidf_(bf_hi(gg.y)) * o0[3],
                          sigmoidf_(bf_lo(gg.z)) * o1[0], sigmoidf_(bf_hi(gg.z)) * o1[1], sigmoidf_(bf_lo(gg.w)) * o1[2], sigmoidf_(bf_hi(gg.w)) * o1[3]};
            float s = 0.f, ss = 0.f;
#pragma unroll
            for (int i = 0; i < 8; ++i) { s += v[i]; ss += v[i] * v[i]; }
            s = red16(s); ss = red16(ss);
            const float mu = s * (1.0f / 128.0f), rs = 1.0f / sqrtf(fmaxf(ss * (1.0f / 128.0f) - mu * mu, 0.f) + LN_EPS);
            const f32x4 g0 = *(const f32x4*)(hgg + c), g1 = *(const f32x4*)(hgg + c + 4), b0 = *(const f32x4*)(hgb + c), b1 = *(const f32x4*)(hgb + c + 4);
            u32x4 w; w.x = cvt_pk_bf16((v[0] - mu) * rs * g0[0] + b0[0], (v[1] - mu) * rs * g0[1] + b0[1]); w.y = cvt_pk_bf16((v[2] - mu) * rs * g0[2] + b0[2], (v[3] - mu) * rs * g0[3] + b0[3]);
            w.z = cvt_pk_bf16((v[4] - mu) * rs * g1[0] + b1[0], (v[5] - mu) * rs * g1[1] + b1[1]); w.w = cvt_pk_bf16((v[6] - mu) * rs * g1[2] + b1[2], (v[7] - mu) * rs * g1[3] + b1[3]);
            *(u32x4*)(mrow + S5W + c) = w; }
#pragma unroll
        for (int h = 0; h < 4; ++h) { const int c = h * 384 + lane * 8; const bool act = lane < 48;
            f32x4 o0 = (f32x4){0.f, 0.f, 0.f, 0.f}, o1 = o0; u32x4 gg = (u32x4){0u, 0u, 0u, 0u};
            if (act) { o0 = *(const f32x4*)(orow + HGW + c); o1 = *(const f32x4*)(orow + HGW + c + 4); gg = *(const u32x4*)(prow + C_GC + c); }
            const float ss = wave_sum((o0[0] * o0[0] + o0[1] * o0[1]) + (o0[2] * o0[2] + o0[3] * o0[3]) + (o1[0] * o1[0] + o1[1] * o1[1]) + (o1[2] * o1[2] + o1[3] * o1[3]));
            const float rms = 1.0f / sqrtf(ss * (1.0f / 384.0f) + LN_EPS);
            if (act) { const f32x4 g0 = *(const f32x4*)(glg + c), g1 = *(const f32x4*)(glg + c + 4);
                const float z[8] = {bf_lo(gg.x), bf_hi(gg.x), bf_lo(gg.y), bf_hi(gg.y), bf_lo(gg.z), bf_hi(gg.z), bf_lo(gg.w), bf_hi(gg.w)};
                u32x4 w; w.x = cvt_pk_bf16(o0[0] * rms * g0[0] * (z[0] * sigmoidf_(z[0])), o0[1] * rms * g0[1] * (z[1] * sigmoidf_(z[1])));
                w.y = cvt_pk_bf16(o0[2] * rms * g0[2] * (z[2] * sigmoidf_(z[2])), o0[3] * rms * g0[3] * (z[3] * sigmoidf_(z[3])));
                w.z = cvt_pk_bf16(o1[0] * rms * g1[0] * (z[4] * sigmoidf_(z[4])), o1[1] * rms * g1[1] * (z[5] * sigmoidf_(z[5])));
                w.w = cvt_pk_bf16(o1[2] * rms * g1[2] * (z[6] * sigmoidf_(z[6])), o1[3] * rms * g1[3] * (z[7] * sigmoidf_(z[7])));
                *(u32x4*)(mrow + S5W + HGW + c) = w; } }
    }
}

constexpr int PH_PRO = 0, PH_MOD = 1, PH_LN0 = 2, PH_L0 = 3, PH_PER_LAYER = 10, N_PHASES = PH_L0 + DEPTH * PH_PER_LAYER;
constexpr int CW_BAR = 4096;

__global__ void __launch_bounds__(512, 2) hybrid_fwd(Args args) {
    extern __shared__ __attribute__((aligned(16))) unsigned char lds_raw[];
    LAS unsigned char* lds = (LAS unsigned char*)lds_raw;
    const int wave = __builtin_amdgcn_readfirstlane((int)threadIdx.x >> 6);
#define lane lane_id_v()
    volatile LAS unsigned* MISC = (volatile LAS unsigned*)(lds + LDSCTL_OFF);
    Ctx ctx; ctx.t = (volatile LAS unsigned long long*)(lds + LDSCTL_OFF + 64);
    if (wave == 0) { const int ln_ = lane; unsigned long long v = 0ull;
#pragma unroll
        for (int i = 0; i < N_IN; ++i) v = (ln_ == i) ? (unsigned long long)args.in[i] : v;
        v = (ln_ == 30) ? (unsigned long long)args.out : v; v = (ln_ == 31) ? (unsigned long long)args.ws : v;
        if (ln_ < 32) ctx.t[ln_] = v;
        if (ln_ < 16) MISC[ln_] = 0u; }
    __syncthreads();
    const int lo = args.ph_lo, hi = args.ph_hi;
    XcdBarrier bar; bar.bar = (unsigned*)(ctx.ws() + WS_CTL) + CW_BAR; bar.x = 0; bar.st = nullptr; bar.w0 = (wave == 0) ? 1u : 0u;
    if (hi - lo > 1) bar = xcd_barrier_post((unsigned*)(ctx.ws() + WS_CTL) + CW_BAR, MISC + 8, (wave == 0) ? 1u : 0u);
#define IN(k) (lo <= (k) && (k) < hi)
#define OPQ() int ln = lane, wv = wave; asm volatile("" : "+s"(wv))
#define SEAM(k) do { if (IN(k) && IN((k) + 1)) xcd_barrier(bar); } while (0)
#define WSP(T, off) ((T*)(ctx.ws() + (off)))

    if (IN(PH_PRO)) { OPQ(); phase_prologue(ctx, lds, wv, ln); }
    SEAM(PH_PRO);
    if (IN(PH_MOD)) { OPQ(); phase_mod(ctx, wv, ln); }
    SEAM(PH_MOD);
    if (IN(PH_LN0)) { OPQ(); phase_h0(ctx.in(I_X), WSP(float, WS_MOD), WSP(bf16_t, WS_H), wv, ln); }
    SEAM(PH_LN0);

    for (int l = 0; l < DEPTH; ++l) {
        const int p0 = PH_L0 + l * PH_PER_LAYER;
        const size_t wto = WS_WT + (size_t)l * WT_LAYER, modo = WS_MOD + (size_t)l * NB * 6 * DM * 4;
        if (IN(p0 + 0)) { pg8::Gemm g{WSP(bf16_t, WS_H), WSP(const bf16_t, wto + WT_IN), MTOK, INP, DM}; pg8::StaticOrder S; S.init(MTOK, INP, (int)gridDim.x, (int)blockIdx.x);
            EpiProj E{WSP(bf16_t, WS_P), WSP(bf16_t, WS_UX)}; pg8::gemm_phase<EpiProj, pg8::StaticOrder, true, true>(lds, g, S, E, wave); }
        SEAM(p0 + 0);
        if (IN(p0 + 1)) {
            { pg8::Gemm g{WSP(bf16_t, WS_UX), WSP(const bf16_t, WS_S5W1 + (size_t)l * S5_W1_LAYER), 64 * 256, 64 * 256, S5K}; S5Order S{(int)gridDim.x, (int)blockIdx.x, 64, 0};
              EpiS5A E{WSP(float, WS_SLOC)}; pg8::gemm_phase<EpiS5A, S5Order, true, true>(lds, g, S, E, wave); }
            { OPQ(); phase_pre(ctx, l, wv, ln); }
            }
        SEAM(p0 + 1);
        if (IN(p0 + 2)) { OPQ(); phase_chain<0>(ctx, l, lds, wv, ln); }
        SEAM(p0 + 2);
        if (IN(p0 + 3)) {
            { pg8::Gemm g{WSP(bf16_t, WS_UX), WSP(const bf16_t, WS_S5T + (size_t)l * S5_T_LAYER), 64 * 256, 64 * 1024, S5K}; S5Order S{(int)gridDim.x, (int)blockIdx.x, 256, 2};
              EpiS5C E{WSP(bf16_t, WS_Z)}; pg8::gemm_phase<EpiS5C, S5Order, true, true>(lds, g, S, E, wave); }
            { OPQ(); phase_chain<1>(ctx, l, lds, wv, ln); } }
        SEAM(p0 + 3);
        if (IN(p0 + 4)) { pg8::Gemm g{WSP(bf16_t, WS_Z), WSP(const bf16_t, wto + WT_GLU), MTOK, S5W, S5W}; pg8::StaticOrder S; S.init(MTOK, S5W, (int)gridDim.x, (int)blockIdx.x);
            EpiGlu E{WSP(bf16_t, WS_Z), WSP(bf16_t, WS_MIXED), ctx.in(I_GLUB) + l * S5W}; pg8::gemm_phase<EpiGlu, pg8::StaticOrder, true, true>(lds, g, S, E, wave);
            { OPQ(); phase_finalize(ctx, l, wv, ln); } }
        SEAM(p0 + 4);
        if (IN(p0 + 5)) { pg8::Gemm g{WSP(bf16_t, WS_MIXED), WSP(const bf16_t, wto + WT_OUT), MTOK, DM, DM}; pg8::StaticOrder S; S.init(MTOK, DM, (int)gridDim.x, (int)blockIdx.x);
            EpiDelta E{WSP(bf16_t, WS_DELTA), WSP(float, modo) + 2 * DM};
            pg8::gemm_phase<EpiDelta, pg8::StaticOrder, true, true>(lds, g, S, E, wave); }
        SEAM(p0 + 5);
        if (IN(p0 + 6)) { OPQ(); phase_lnres<true>(l == 0 ? ctx.in(I_X) : ctx.out(), WSP(bf16_t, WS_DELTA), ctx.out(), ctx.in(I_LN1G) + l * DM, ctx.in(I_LN1B) + l * DM, WSP(float, modo), 3, 4, WSP(bf16_t, WS_H), lds, wv, ln); }
        SEAM(p0 + 6);
        if (IN(p0 + 7)) { pg8::Gemm g{WSP(bf16_t, WS_H), WSP(const bf16_t, wto + WT_GU), MTOK, 2 * DFF, DM}; pg8::StaticOrder S; S.init(MTOK, 2 * DFF, (int)gridDim.x, (int)blockIdx.x);
            EpiSwiglu E{WSP(bf16_t, WS_P)}; pg8::gemm_phase<EpiSwiglu, pg8::StaticOrder, true, true>(lds, g, S, E, wave); }
        SEAM(p0 + 7);
        if (IN(p0 + 8)) { pg8::Gemm g{WSP(bf16_t, WS_P), WSP(const bf16_t, wto + WT_DN), MTOK, DM, DFF}; pg8::StaticOrder S; S.init(MTOK, DM, (int)gridDim.x, (int)blockIdx.x);
            EpiDelta E{WSP(bf16_t, WS_DELTA), WSP(float, modo) + 5 * DM};
            pg8::gemm_phase<EpiDelta, pg8::StaticOrder, true, true>(lds, g, S, E, wave); }
        SEAM(p0 + 8);
        if (IN(p0 + 9)) { OPQ();
            if (l + 1 < DEPTH) phase_lnres<true>(ctx.out(), WSP(bf16_t, WS_DELTA), ctx.out(), ctx.in(I_LN2G) + l * DM, ctx.in(I_LN2B) + l * DM, WSP(float, modo) + (size_t)NB * 6 * DM, 0, 1, WSP(bf16_t, WS_H), lds, wv, ln);
            else phase_lnres<false>(ctx.out(), WSP(bf16_t, WS_DELTA), ctx.out(), ctx.in(I_LN2G) + l * DM, ctx.in(I_LN2B) + l * DM, nullptr, 0, 0, nullptr, lds, wv, ln);
        }
        SEAM(p0 + 9);
    }
#undef IN
#undef SEAM
#undef OPQ
#undef WSP
#undef lane
}

extern "C" void kernel_launch(void* const* d_in, const int* in_sizes, int n_in, void* d_out, int out_size, void* d_ws, size_t ws_size, hipStream_t stream) {
    static int grid = 0;
    if (grid == 0) {
        if (n_in != N_IN || out_size != MTOK * DM || ws_size < WS_END) { fprintf(stderr, "kernel_launch: unexpected problem (n_in %d, out %d, ws %zu < %zu); nothing launched\n", n_in, out_size, ws_size, (size_t)WS_END); grid = -1; return; }
        int dev = 0, cus = 0, per_cu = 0;
        if (hipGetDevice(&dev) != hipSuccess || hipDeviceGetAttribute(&cus, hipDeviceAttributeMultiprocessorCount, dev) != hipSuccess) { grid = -1; return; }
        if (hipFuncSetAttribute((const void*)hybrid_fwd, hipFuncAttributeMaxDynamicSharedMemorySize, LDS_BYTES) != hipSuccess) { fprintf(stderr, "kernel_launch: hipFuncSetAttribute failed\n"); grid = -1; return; }
        if (hipOccupancyMaxActiveBlocksPerMultiprocessor(&per_cu, (const void*)hybrid_fwd, 512, LDS_BYTES) != hipSuccess || per_cu < 1) fprintf(stderr, "kernel_launch: occupancy query reports %d blocks per CU\n", per_cu);
        (void)hipGetLastError();
        grid = cus;
    }
    if (grid < 0) return;
    (void)in_sizes;
    if (hipMemsetAsync((char*)d_ws + WS_CTL, 0, CTL_ZERO_BYTES, stream) != hipSuccess) return;
    Args a{};
    for (int i = 0; i < N_IN; ++i) a.in[i] = (const float*)d_in[i];
    a.out = (float*)d_out; a.ws = (unsigned char*)d_ws;
    a.ph_lo = 0; a.ph_hi = N_PHASES; hipLaunchKernelGGL(hybrid_fwd, dim3(grid), dim3(512), LDS_BYTES, stream, a);
}
```

```cpp
#include <hip/hip_runtime.h>
#include <cstdio>
#include <cstdint>
namespace pg8 {
#define PG8_LAS __attribute__((address_space(3)))
typedef unsigned short bf16_t;
typedef short bf16x8 __attribute__((ext_vector_type(8)));
typedef float f32x4 __attribute__((ext_vector_type(4)));
typedef unsigned u32x4 __attribute__((ext_vector_type(4)));
constexpr int BM = 256, BK = 64, HALF = 128, HTB = HALF * BK * 2  , STAGE_BYTES = 8 * HTB, NXCD = 8, WGM = 8;

__host__ __device__ __forceinline__ int lds_byte(int r, int c) { const int st = (r >> 4) * 2 + (c >> 5), rr = r & 15, cc = c & 31, ob = rr * 64 + cc * 2; return st * 1024 + (ob ^ (((ob >> 9) & 1) << 5)); }
__host__ __device__ __forceinline__ void stage_rc(int b, int& R, int& C) { const int st = b / 1024, sb = b % 1024, swz = sb ^ (((sb >> 9) & 1) << 5); R = (st >> 1) * 16 + swz / 64; C = (st & 1) * 32 + (swz % 64) / 2; }
__host__ __device__ __forceinline__ int perm32(int rho) { const int n = rho >> 4, i = rho & 15; return 8 * (i >> 2) + 4 * n + (i & 3); }

struct Unit { int pm, pn; };
struct Gemm { const bf16_t* A; const bf16_t* Bt; int M, N, K; };

struct StaticOrder {
    int nM, nN, nwg, G, c;
    __host__ __device__ void init(int M, int N, int G_, int c_) { nM = M / BM; nN = N / BM; nwg = nM * nN; G = G_; c = c_; }
    __host__ __device__ bool next(int i, Unit& u) const {
        const long L = (long)i * G + c; if (L >= nwg) return false;
        int wgid = (int)L; { const int q = nwg / NXCD, r = nwg % NXCD, xcd = wgid % NXCD, off = wgid / NXCD; wgid = (xcd < r ? xcd * (q + 1) : r * (q + 1) + (xcd - r) * q) + off; }
        const int nig = WGM * nN, gid = wgid / nig, fm = gid * WGM, gsz = (nM - fm) < WGM ? (nM - fm) : WGM;
        u.pm = fm + ((wgid % nig) % gsz); u.pn = (wgid % nig) / gsz; return true;
    }
    __device__ __forceinline__ void a_ready(const Unit&) const {}
    __device__ __forceinline__ void done(const Unit&) const {}
};
__device__ __forceinline__ unsigned cvt_pk_bf16(float lo, float hi) { unsigned r; asm volatile("v_cvt_pk_bf16_f32 %0, %1, %2" : "=v"(r) : "v"(lo), "v"(hi)); return r; }
typedef float f32x2 __attribute__((ext_vector_type(2)));
template <class Epi, class Sched, bool ALIGN_EPI = false, bool SP2 = false>
__device__ __forceinline__ void gemm_phase(PG8_LAS unsigned char* lds, const Gemm g, const Sched& S, const Epi& E, int wave_id) {
    int tid_; asm volatile("v_mbcnt_lo_u32_b32 %0, -1, 0\n\tv_mbcnt_hi_u32_b32 %0, -1, %0" : "=v"(tid_)); tid_ += wave_id * 64;
    const int tid = tid_, wid = __builtin_amdgcn_readfirstlane(tid >> 6), lane = tid & 63, wr = wid >> 2, wc = wid & 3, fr = lane & 15, fq = lane >> 4;
    const int K = g.K, nt = K / BK;
    unsigned voffA[2], voffB[2];
#pragma unroll
    for (int i = 0; i < 2; ++i) { int R, C; stage_rc(tid * 16 + i * 8192, R, C); const int Rb = Epi::PERM ? ((R & ~31) + perm32(R & 31)) : R;
        voffA[i] = (unsigned)(R * K + C) * 2u; voffB[i] = (unsigned)(Rb * K + C) * 2u; }
    const size_t kstep = (size_t)(BK * 2);
    const size_t hstep = (size_t)HALF * K * 2;
    const size_t tstep = 2 * hstep;
    const unsigned ldsw = (unsigned)wid * 1024u;
    const int aoff = lds_byte(wr * 64 + fr, fq * 8), boff = lds_byte(wc * 32 + fr, fq * 8);
#define PG8_SA(b, h) (((b) * 2 + (h)) * HTB)
#define PG8_SB(b, h) ((4 + (b) * 2 + (h)) * HTB)
#define PG8_STAGE(bufoff, gbase, voff) do { _Pragma("unroll") for (int _i = 0; _i < 2; ++_i) \
        __builtin_amdgcn_global_load_lds((const unsigned*)((const char*)(gbase) + (voff)[_i]), (PG8_LAS unsigned*)(lds + (bufoff) + ldsw + _i * 8192), 16, 0, 0); } while (0)
#define PG8_LDA(dst, b, h) do { _Pragma("unroll") for (int m = 0; m < 4; ++m) _Pragma("unroll") for (int k = 0; k < 2; ++k) dst[m][k] = *(const PG8_LAS bf16x8*)(lds + PG8_SA(b, h) + aoff + m * 2048 + k * 1024); } while (0)
#define PG8_LDB(dst, b, h) do { _Pragma("unroll") for (int n = 0; n < 2; ++n) _Pragma("unroll") for (int k = 0; k < 2; ++k) dst[n][k] = *(const PG8_LAS bf16x8*)(lds + PG8_SB(b, h) + boff + n * 2048 + k * 1024); } while (0)
#define PG8_MMA(ai, bj, At, Bt) do { __builtin_amdgcn_s_setprio(1); _Pragma("unroll") for (int m = 0; m < 4; ++m) _Pragma("unroll") for (int n = 0; n < 2; ++n) _Pragma("unroll") for (int k = 0; k < 2; ++k) \
        acc[ai][bj][m][n] = __builtin_amdgcn_mfma_f32_16x16x32_bf16(Bt[n][k], At[m][k], acc[ai][bj][m][n], 0, 0, 0); __builtin_amdgcn_s_setprio(0); } while (0)
#define PG8_WAIT_V(n) asm volatile("s_waitcnt vmcnt(" #n ")" ::: "memory")
#define PG8_WAIT_L(n) asm volatile("s_waitcnt lgkmcnt(" #n ")" ::: "memory")
#define PG8_BAR __builtin_amdgcn_s_barrier()
#define PG8_SCHED __builtin_amdgcn_sched_barrier(0)
    Unit cur, nxt; int ui = 0;
    if (!S.next(0, cur)) return;
    f32x4 acc[2][2][4][2];
#pragma unroll
    for (int a = 0; a < 2; ++a)
#pragma unroll
        for (int b = 0; b < 2; ++b)
#pragma unroll
            for (int m = 0; m < 4; ++m)
#pragma unroll
                for (int n = 0; n < 2; ++n) acc[a][b][m][n] = (f32x4){0.f, 0.f, 0.f, 0.f};
    bf16x8 At[4][2], B0[2][2], B1[2][2];
    const char* cA = (const char*)g.A + (size_t)cur.pm * tstep; const char* cB = (const char*)g.Bt + (size_t)cur.pn * tstep;
    S.a_ready(cur);
    if constexpr (SP2) {
        PG8_STAGE(PG8_SB(0, 0), cB, voffB); PG8_STAGE(PG8_SB(0, 1), cB + hstep, voffB); PG8_STAGE(PG8_SA(0, 0), cA, voffA); PG8_STAGE(PG8_SA(0, 1), cA + hstep, voffA);
        if (wr == 1) PG8_BAR;
        PG8_WAIT_V(2); PG8_BAR;
        PG8_STAGE(PG8_SB(1, 0), cB + kstep, voffB); PG8_STAGE(PG8_SA(1, 0), cA + kstep, voffA); PG8_STAGE(PG8_SB(1, 1), cB + hstep + kstep, voffB);
        PG8_WAIT_V(6); PG8_BAR;
    } else {
        PG8_STAGE(PG8_SB(0, 0), cB, voffB); PG8_STAGE(PG8_SA(0, 0), cA, voffA); PG8_STAGE(PG8_SB(0, 1), cB + hstep, voffB); PG8_STAGE(PG8_SA(0, 1), cA + hstep, voffA);
        if (wr == 1) PG8_BAR;
        PG8_WAIT_V(4); PG8_BAR;
        PG8_STAGE(PG8_SB(1, 0), cB + kstep, voffB); PG8_STAGE(PG8_SA(1, 0), cA + kstep, voffA); PG8_STAGE(PG8_SB(1, 1), cB + hstep + kstep, voffB);
        PG8_WAIT_V(6); PG8_BAR;
    }
    for (;;) {
        const bool has_next = S.next(ui + 1, nxt);
        const char* nA = has_next ? (const char*)g.A + (size_t)nxt.pm * tstep : cA; const char* nB = has_next ? (const char*)g.Bt + (size_t)nxt.pn * tstep : cB;
        for (int t = 0; t < nt; t += 2) {
            const bool last = (t == nt - 2);
            const char* a1 = cA + (size_t)(t + 1) * kstep;
            const char* a2 = last ? nA : cA + (size_t)(t + 2) * kstep; const char* b2 = last ? nB : cB + (size_t)(t + 2) * kstep;
            const char* a3 = a2 + kstep; const char* b3 = b2 + kstep;
            if (last && has_next) S.a_ready(nxt);
            if constexpr (SP2) {
            PG8_LDB(B0, 0, 0); PG8_LDB(B1, 0, 1); PG8_SCHED; PG8_LDA(At, 0, 0); PG8_STAGE(PG8_SA(1, 1), a1 + hstep, voffA);
            PG8_WAIT_V(8); PG8_WAIT_L(0); PG8_BAR; PG8_MMA(0, 0, At, B0); PG8_MMA(0, 1, At, B1); PG8_BAR; PG8_SCHED;
            PG8_LDA(At, 0, 1); PG8_STAGE(PG8_SB(0, 0), b2, voffB); PG8_STAGE(PG8_SB(0, 1), b2 + hstep, voffB); PG8_STAGE(PG8_SA(0, 0), a2, voffA);
            PG8_WAIT_V(8); PG8_WAIT_L(0); PG8_BAR; PG8_MMA(1, 0, At, B0); PG8_MMA(1, 1, At, B1); PG8_BAR; PG8_SCHED;
            PG8_LDB(B0, 1, 0); PG8_LDB(B1, 1, 1); PG8_SCHED; PG8_LDA(At, 1, 0); PG8_STAGE(PG8_SA(0, 1), a2 + hstep, voffA);
            PG8_WAIT_V(8); PG8_WAIT_L(0); PG8_BAR; PG8_MMA(0, 0, At, B0); PG8_MMA(0, 1, At, B1); PG8_BAR; PG8_SCHED;
            PG8_LDA(At, 1, 1); PG8_STAGE(PG8_SB(1, 0), b3, voffB); PG8_STAGE(PG8_SB(1, 1), b3 + hstep, voffB); PG8_STAGE(PG8_SA(1, 0), a3, voffA);
            PG8_WAIT_V(8); PG8_WAIT_L(0); PG8_BAR; PG8_MMA(1, 0, At, B0); PG8_MMA(1, 1, At, B1); PG8_BAR; PG8_SCHED;
            } else {
            PG8_LDB(B0, 0, 0); PG8_SCHED; PG8_LDA(At, 0, 0); PG8_STAGE(PG8_SA(1, 1), a1 + hstep, voffA);
            PG8_WAIT_L(8); PG8_BAR; PG8_WAIT_L(0); PG8_MMA(0, 0, At, B0); PG8_BAR; PG8_SCHED;
            PG8_LDB(B1, 0, 1); PG8_STAGE(PG8_SB(0, 0), b2, voffB);
            PG8_BAR; PG8_WAIT_L(0); PG8_MMA(0, 1, At, B1); PG8_BAR;
            PG8_LDA(At, 0, 1); PG8_STAGE(PG8_SA(0, 0), a2, voffA);
            PG8_BAR; PG8_WAIT_L(0); PG8_MMA(1, 0, At, B0); PG8_BAR; PG8_SCHED;
            PG8_STAGE(PG8_SB(0, 1), b2 + hstep, voffB);
            PG8_WAIT_V(6); PG8_BAR; PG8_MMA(1, 1, At, B1); PG8_BAR;
            PG8_LDB(B0, 1, 0); PG8_SCHED; PG8_LDA(At, 1, 0); PG8_STAGE(PG8_SA(0, 1), a2 + hstep, voffA);
            PG8_WAIT_L(8); PG8_BAR; PG8_WAIT_L(0); PG8_MMA(0, 0, At, B0); PG8_BAR; PG8_SCHED;
            PG8_LDB(B1, 1, 1); PG8_STAGE(PG8_SB(1, 0), b3, voffB);
            PG8_BAR; PG8_WAIT_L(0); PG8_MMA(0, 1, At, B1); PG8_BAR;
            PG8_LDA(At, 1, 1); PG8_STAGE(PG8_SA(1, 0), a3, voffA);
            PG8_BAR; PG8_WAIT_L(0); PG8_MMA(1, 0, At, B0); PG8_BAR; PG8_SCHED;
            PG8_STAGE(PG8_SB(1, 1), b3 + hstep, voffB);
            PG8_WAIT_V(6); PG8_BAR; PG8_MMA(1, 1, At, B1); PG8_BAR;
            }
        }
        if constexpr (ALIGN_EPI) { if (wr == 0) PG8_BAR; }
        if constexpr (!Epi::AFTER_DRAIN) { E(acc, cur, wr, wc, fr, fq); S.done(cur); }
        if (!has_next) break;
#pragma unroll
        for (int a = 0; a < 2; ++a)
#pragma unroll
            for (int b = 0; b < 2; ++b)
#pragma unroll
                for (int m = 0; m < 4; ++m)
#pragma unroll
                    for (int n = 0; n < 2; ++n) acc[a][b][m][n] = (f32x4){0.f, 0.f, 0.f, 0.f};
        cur = nxt; cA = nA; cB = nB; ++ui;
        if constexpr (ALIGN_EPI) { if (wr == 1) PG8_BAR; }
    }
    PG8_WAIT_V(0);
    if constexpr (!ALIGN_EPI) { if (wr == 0) PG8_BAR; }
    PG8_BAR;
    if constexpr (Epi::AFTER_DRAIN) { E.fused(acc, cur, wr, wc, fr, fq, lds, wid, lane); S.done(cur); }
#undef PG8_SA
#undef PG8_SB
#undef PG8_STAGE
#undef PG8_LDA
#undef PG8_LDB
#undef PG8_MMA
#undef PG8_WAIT_V
#undef PG8_WAIT_L
#undef PG8_BAR
#undef PG8_SCHED
}
}
#define LAS __attribute__((address_space(3)))
#define XB_TMO      128
#define XB_XCNT(j)  (256  + 64 * (j))
#define XB_XSUB(j)  (1280 + 64 * (j))
#define XB_XGEN(j)  (2304 + 64 * (j))
#define XB_TOP      3328
#define XB_TOPGEN   3392
#define XCD_BAR_WORDS 3456
#define XB_SPIN_CAP (1u << 24)

__device__ __forceinline__ unsigned xb_ld(unsigned* p)              { return __hip_atomic_load(p, __ATOMIC_RELAXED, __HIP_MEMORY_SCOPE_AGENT); }
__device__ __forceinline__ unsigned xb_add(unsigned* p, unsigned v) { return __hip_atomic_fetch_add(p, v, __ATOMIC_RELAXED, __HIP_MEMORY_SCOPE_AGENT); }
__device__ __forceinline__ unsigned xb_xcc_id() { return (unsigned)__builtin_amdgcn_s_getreg((3 << 11) | 20) & 0xFu; }
#define XB_SPIN(cond, bar) do { unsigned _sp = 0; while (cond) { __builtin_amdgcn_s_sleep(1); \
    if ((++_sp & 255u) == 0u) { if (xb_ld(&(bar)[XB_TMO])) break; if (_sp > XB_SPIN_CAP) { atomicAdd(&(bar)[XB_TMO], 1u); break; } } } } while (0)

struct XcdBarrier {
    unsigned* bar; unsigned x; unsigned w0;
    volatile LAS unsigned* st;
};

__device__ __forceinline__ bool xb_lane0() { return __builtin_amdgcn_mbcnt_hi(~0u, __builtin_amdgcn_mbcnt_lo(~0u, 0u)) == 0u; }
__device__ __forceinline__ XcdBarrier xcd_barrier_post(unsigned* bar, volatile LAS unsigned* st, unsigned w0) {
    XcdBarrier b; b.bar = bar; b.x = xb_xcc_id(); b.st = st; b.w0 = w0;
    if (w0 && xb_lane0()) (void)xb_add(&bar[XB_XCNT(b.x)], 1u);
    return b;
}
__device__ __forceinline__ void xcd_barrier_complete(unsigned* bar, unsigned x, unsigned& nloc, unsigned& nx) {
    const unsigned G = gridDim.x * gridDim.y * gridDim.z;
    unsigned sum, cnt, mine, sp = 0u;
    for (;;) {
        sum = 0u; cnt = 0u; mine = 0u;
#pragma unroll
        for (unsigned j = 0; j < 16; ++j) { const unsigned c = xb_ld(&bar[XB_XCNT(j)]); sum += c; cnt += (c > 0u) ? 1u : 0u; mine = (j == x) ? c : mine; }
        if (sum == G) break;
        __builtin_amdgcn_s_sleep(1);
        if ((++sp & 255u) == 0u) { if (xb_ld(&bar[XB_TMO])) break; if (sp > XB_SPIN_CAP) { atomicAdd(&bar[XB_TMO], 1u); break; } }
    }
    nloc = mine > 0u ? mine : 1u; nx = cnt > 0u ? cnt : 1u;
}

__device__ __forceinline__ void xcd_barrier(const XcdBarrier& b) {
    asm volatile("s_waitcnt vmcnt(0)" ::: "memory");
    __syncthreads();
    if (b.w0 && xb_lane0()) {
        unsigned* bar = b.bar;
        __builtin_amdgcn_s_waitcnt(0);
        unsigned nloc = b.st[0], nx = b.st[1];
        if (nloc == 0u) { xcd_barrier_complete(bar, b.x, nloc, nx); b.st[0] = nloc; b.st[1] = nx; }
        const unsigned old = xb_add(&bar[XB_XSUB(b.x)], 1u);
        const unsigned gen = old / nloc;
        if (old + 1u == (gen + 1u) * nloc) {
            __builtin_amdgcn_fence(__ATOMIC_RELEASE, "agent");
            asm volatile("s_waitcnt vmcnt(0)" ::: "memory");
            const unsigned og = xb_add(&bar[XB_TOP], 1u);
            const unsigned tg = og / nx;
            if (og + 1u == (tg + 1u) * nx) xb_add(&bar[XB_TOPGEN], 1u);
            else XB_SPIN(xb_ld(&bar[XB_TOPGEN]) == tg, bar);
            __builtin_amdgcn_fence(__ATOMIC_ACQUIRE, "agent");
            xb_add(&bar[XB_XGEN(b.x)], 1u);
            asm volatile("s_waitcnt vmcnt(0)" ::: "memory");
        } else {
            XB_SPIN(xb_ld(&bar[XB_XGEN(b.x)]) == gen, bar);
            __builtin_amdgcn_fence(__ATOMIC_ACQUIRE, "agent");
            asm volatile("s_waitcnt vmcnt(0)" ::: "memory");
        }
    }
    __syncthreads();
}

constexpr int DM = 4096, NB = 2, SEQ = 8192, MTOK = NB * SEQ, DEPTH = 4;
constexpr int S5W = 1024;
constexpr int HGW = 1536;
constexpr int GLKW = 768;
constexpr int INW = 11792, INP = 12032, DFF = 11008;
constexpr int OW = 3072;
constexpr int C_U = 0, C_QB = 1024, C_FB = 2560, C_IB = 4096, C_GB = 5632, C_QC = 7168, C_KC = 7936, C_VC = 8704, C_GC = 10240, C_LR = 11776;
constexpr float LN_EPS = 1e-5f;
constexpr float ALPHA = 1.6817928305074290861f;
constexpr float GLA_QSCALE = 0.07216878364870322f;

enum { I_X = 0, I_C, I_WADA, I_BADA, I_TABLE, I_WIN, I_WOUT, I_AREAL, I_AIMAG, I_LOGDT, I_BRE, I_BIM, I_CRE, I_CIM, I_S5D, I_GLUW, I_GLUB,
       I_LBRAW, I_HGG, I_HGB, I_WGATE, I_BGATE, I_GLG, I_WFG, I_WFU, I_WFD, I_LN1G, I_LN1B, I_LN2G, I_LN2B, N_IN };

constexpr size_t MiB = 1u << 20;
constexpr size_t WS_CTL = 0, CTL_ZERO_BYTES = 1 * MiB;
constexpr size_t WS_MOD = 1 * MiB;
constexpr size_t WS_MISC = 2 * MiB;
constexpr size_t WS_CONDPART = 12 * MiB;
constexpr size_t WS_H = 24 * MiB;
constexpr size_t WS_MIXED = WS_H + 128 * MiB;
constexpr size_t WS_Z = WS_MIXED + 128 * MiB;
constexpr size_t WS_O = WS_Z + 32 * MiB;
constexpr size_t WS_DELTA = WS_O;
constexpr size_t WS_P = WS_O + 192 * MiB;
constexpr size_t WS_WT = WS_P + 376 * MiB;
constexpr size_t WT_IN = 0, WT_OUT = 94 * MiB, WT_GU = 126 * MiB, WT_DN = 298 * MiB, WT_GLU = 384 * MiB, WT_LAYER = 386 * MiB;
constexpr size_t WS_HGB = WS_WT + DEPTH * WT_LAYER;
constexpr size_t WS_GLB = WS_HGB + 198 * MiB;
constexpr size_t WS_S5T = WS_GLB + 128 * MiB;
constexpr size_t WS_S5W1 = WS_S5T + 576 * MiB;
constexpr size_t WS_UX = WS_S5W1 + 144 * MiB;
constexpr size_t WS_SLOC = WS_UX + 36 * MiB;
constexpr size_t WS_LAM64 = WS_SLOC + 8 * MiB;
constexpr size_t WS_ST = WS_LAM64 + 1 * MiB;
constexpr size_t WS_END = WS_ST + 45 * MiB;
static_assert((size_t)INP * DM * 2 == 94 * MiB && (size_t)DM * DM * 2 == 32 * MiB && (size_t)2 * DFF * DM * 2 == 172 * MiB && (size_t)DM * DFF * 2 == 86 * MiB, "weight map");
static_assert((size_t)MTOK * INP * 2 == 376 * MiB && (size_t)MTOK * DFF * 2 <= 376 * MiB, "activation map");

constexpr int RING_BYTES = 131072;
constexpr int LDSCTL_OFF = 135168;
constexpr int LDS_BYTES = 147456;

#ifndef LAS
#define LAS __attribute__((address_space(3)))
#endif
typedef unsigned short bf16_t;
typedef float f32x4 __attribute__((ext_vector_type(4)));
typedef float f32x2 __attribute__((ext_vector_type(2)));
typedef unsigned u32x4 __attribute__((ext_vector_type(4)));
typedef unsigned u32x2 __attribute__((ext_vector_type(2)));
#define LDS_WAIT() asm volatile("s_waitcnt lgkmcnt(0)" ::: "memory")
#define VM_WAIT() asm volatile("s_waitcnt vmcnt(0)" ::: "memory")
typedef __bf16 bf16x2_t __attribute__((ext_vector_type(2)));
__device__ __forceinline__ unsigned cvt_pk_bf16(float lo, float hi) { return __builtin_bit_cast(unsigned, __builtin_convertvector((f32x2){lo, hi}, bf16x2_t)); }

__device__ __forceinline__ float bf_lo(unsigned w) { return __uint_as_float(w << 16); }
__device__ __forceinline__ float bf_hi(unsigned w) { return __uint_as_float(w & 0xffff0000u); }
__device__ __forceinline__ float bf2f(bf16_t b) { return __uint_as_float(((unsigned)b) << 16); }
__device__ __forceinline__ float wave_sum(float v) {
    v += __int_as_float(__builtin_amdgcn_mov_dpp(__float_as_int(v), 0xB1, 0xF, 0xF, true));
    v += __int_as_float(__builtin_amdgcn_mov_dpp(__float_as_int(v), 0x4E, 0xF, 0xF, true));
    v += __int_as_float(__builtin_amdgcn_mov_dpp(__float_as_int(v), 0x141, 0xF, 0xF, true));
    v += __int_as_float(__builtin_amdgcn_mov_dpp(__float_as_int(v), 0x140, 0xF, 0xF, true));
    v += __shfl_xor(v, 16); v += __shfl_xor(v, 32);
    return v;
}
__device__ __forceinline__ float sigmoidf_(float x) { return __builtin_amdgcn_rcpf(1.0f + __expf(-x)); }
__device__ __forceinline__ float gelu_tanh(float y) { const float a = 0.7978845608028654f * (y + 0.044715f * y * y * y); const float t = 1.0f - 2.0f * __builtin_amdgcn_rcpf(1.0f + __expf(2.0f * a)); return 0.5f * y * (1.0f + t); }

struct EpiProj {
    static constexpr bool PERM = true, AFTER_DRAIN = false;
    bf16_t* P; bf16_t* UX;
    __device__ __forceinline__ void operator()(const f32x4 (&acc)[2][2][4][2], const pg8::Unit& u, int wr, int wc, int fr, int fq) const {
        const int row0 = u.pm * 256 + wr * 64 + fr, col0 = u.pn * 256 + wc * 32 + 8 * fq;
        const bool s5 = u.pn < 4;
#pragma unroll
        for (int ai = 0; ai < 2; ++ai)
#pragma unroll
            for (int m = 0; m < 4; ++m) { const int row = row0 + ai * 128 + m * 16;
#pragma unroll
                for (int bj = 0; bj < 2; ++bj) { const f32x4 v0 = acc[ai][bj][m][0], v1 = acc[ai][bj][m][1]; const int col = col0 + bj * 128;
                    u32x4 w; w.x = cvt_pk_bf16(v0[0], v0[1]); w.y = cvt_pk_bf16(v0[2], v0[3]); w.z = cvt_pk_bf16(v1[0], v1[1]); w.w = cvt_pk_bf16(v1[2], v1[3]);
                    if (!s5) *(u32x4*)(P + (size_t)row * INP + col) = w;
                    else { bf16_t* ur = UX + (size_t)((col >> 4) * 256 + (row >> 6)) * 1152; *(u32x4*)(ur + (row & 63) * 16 + (col & 15)) = w;
                        if ((row & 63) == 0) { const u32x4 z = (u32x4){0u, 0u, 0u, 0u}; bf16_t* zp = ur + 1024 + ((col & 15) ? 64 : 0);
#pragma unroll
                            for (int i = 0; i < 8; ++i) *(u32x4*)(zp + 8 * i) = z; } } } }
    }
};
struct EpiSwiglu {
    static constexpr bool PERM = true, AFTER_DRAIN = false;
    bf16_t* HID;
    __device__ __forceinline__ void operator()(const f32x4 (&acc)[2][2][4][2], const pg8::Unit& u, int wr, int wc, int fr, int fq) const {
        const int row0 = u.pm * 256 + wr * 64 + fr, col0 = u.pn * 128 + wc * 32 + 8 * fq;
#pragma unroll
        for (int ai = 0; ai < 2; ++ai)
#pragma unroll
            for (int m = 0; m < 4; ++m) { bf16_t* rowp = HID + (size_t)(row0 + ai * 128 + m * 16) * DFF + col0;
                float o[8];
#pragma unroll
                for (int n = 0; n < 2; ++n)
#pragma unroll
                    for (int j = 0; j < 4; ++j) { const float g = acc[ai][0][m][n][j], up = acc[ai][1][m][n][j]; o[n * 4 + j] = g * __builtin_amdgcn_rcpf(1.0f + __expf(-g)) * up; }
                u32x4 w; w.x = cvt_pk_bf16(o[0], o[1]); w.y = cvt_pk_bf16(o[2], o[3]); w.z = cvt_pk_bf16(o[4], o[5]); w.w = cvt_pk_bf16(o[6], o[7]);
                *(u32x4*)rowp = w; }
    }
};
struct EpiGlu {
    static constexpr bool PERM = true, AFTER_DRAIN = false;
    const bf16_t* Z; bf16_t* MIXED; const float* bias;
    __device__ __forceinline__ void operator()(const f32x4 (&acc)[2][2][4][2], const pg8::Unit& u, int wr, int wc, int fr, int fq) const {
        const int row0 = u.pm * 256 + wr * 64 + fr, col0 = u.pn * 256 + wc * 32 + 8 * fq;
#pragma unroll
        for (int bj = 0; bj < 2; ++bj) {
            const f32x4 b0 = *(const f32x4*)(bias + col0 + bj * 128), b1 = *(const f32x4*)(bias + col0 + bj * 128 + 4);
#pragma unroll
            for (int ai = 0; ai < 2; ++ai)
#pragma unroll
                for (int m = 0; m < 4; ++m) { const size_t r = (size_t)(row0 + ai * 128 + m * 16);
                    const u32x4 zz = *(const u32x4*)(Z + r * S5W + col0 + bj * 128);
                    const f32x4 v0 = acc[ai][bj][m][0] + b0, v1 = acc[ai][bj][m][1] + b1;
                    u32x4 w;
                    w.x = cvt_pk_bf16(bf_lo(zz.x) * sigmoidf_(v0[0]), bf_hi(zz.x) * sigmoidf_(v0[1]));
                    w.y = cvt_pk_bf16(bf_lo(zz.y) * sigmoidf_(v0[2]), bf_hi(zz.y) * sigmoidf_(v0[3]));
                    w.z = cvt_pk_bf16(bf_lo(zz.z) * sigmoidf_(v1[0]), bf_hi(zz.z) * sigmoidf_(v1[1]));
                    w.w = cvt_pk_bf16(bf_lo(zz.w) * sigmoidf_(v1[2]), bf_hi(zz.w) * sigmoidf_(v1[3]));
                    *(u32x4*)(MIXED + r * DM + col0 + bj * 128) = w;
                    if (m & 1) asm volatile("" ::: "memory"); }
        }
    }
};
struct EpiDelta {
    static constexpr bool PERM = true, AFTER_DRAIN = false;
    bf16_t* D; const float* gate0;
    __device__ __forceinline__ void operator()(const f32x4 (&acc)[2][2][4][2], const pg8::Unit& u, int wr, int wc, int fr, int fq) const {
        const int row0 = u.pm * 256 + wr * 64 + fr, col0 = u.pn * 256 + wc * 32 + 8 * fq;
        const float* gp = gate0 + (u.pm >= 32 ? 6 * DM : 0) + col0;
        f32x4 g[2][2];
#pragma unroll
        for (int bj = 0; bj < 2; ++bj)
#pragma unroll
            for (int n = 0; n < 2; ++n) g[bj][n] = *(const f32x4*)(gp + bj * 128 + 4 * n) + 1.0f;
#pragma unroll
        for (int ai = 0; ai < 2; ++ai)
#pragma unroll
            for (int m = 0; m < 4; ++m) { bf16_t* rowp = D + (size_t)(row0 + ai * 128 + m * 16) * DM + col0;
#pragma unroll
                for (int bj = 0; bj < 2; ++bj) { const f32x4 v0 = acc[ai][bj][m][0] * g[bj][0], v1 = acc[ai][bj][m][1] * g[bj][1];
                    u32x4 w; w.x = cvt_pk_bf16(v0[0], v0[1]); w.y = cvt_pk_bf16(v0[2], v0[3]); w.z = cvt_pk_bf16(v1[0], v1[1]); w.w = cvt_pk_bf16(v1[2], v1[3]);
                    *(u32x4*)(rowp + bj * 128) = w; } }
    }
};

__device__ __forceinline__ int lane_id_v() { int r; asm volatile("v_mbcnt_lo_u32_b32 %0, -1, 0\n\tv_mbcnt_hi_u32_b32 %0, -1, %0" : "=v"(r)); return r; }
struct Args { const float* in[N_IN]; float* out; unsigned char* ws; int ph_lo, ph_hi; };
struct Ctx {
    volatile LAS unsigned long long* t;
    __device__ __forceinline__ unsigned long long ld(int i) const { const unsigned long long v = t[i];
        return ((unsigned long long)(unsigned)__builtin_amdgcn_readfirstlane((int)(v >> 32)) << 32) | (unsigned long long)(unsigned)__builtin_amdgcn_readfirstlane((int)(unsigned)v); }
    __device__ __forceinline__ const float* in(int i) const { return (const float*)ld(i); }
    __device__ __forceinline__ float* out() const { return (float*)ld(30); }
    __device__ __forceinline__ unsigned char* ws() const { return (unsigned char*)ld(31); }
};

constexpr int S5K = 1152;
constexpr size_t S5_T_LAYER = (size_t)64 * 1024 * S5K * 2, S5_W1_LAYER = (size_t)64 * 256 * S5K * 2;

struct S5Order {
    int G, c, n, sh;
    __device__ __forceinline__ bool next(int i, pg8::Unit& u) const { const int L = i * G + c; if (L >= n) return false; u.pm = L >> sh; u.pn = L; return true; }
    __device__ __forceinline__ void a_ready(const pg8::Unit&) const {}
    __device__ __forceinline__ void done(const pg8::Unit&) const {}
};
struct EpiS5A {
    static constexpr bool PERM = false, AFTER_DRAIN = false;
    float* Sloc;
    __device__ __forceinline__ void operator()(const f32x4 (&acc)[2][2][4][2], const pg8::Unit& u, int wr, int wc, int fr, int fq) const {
        const int row0 = u.pm * 256 + wr * 64 + fr, col0 = wc * 32 + 4 * fq;
#pragma unroll
        for (int ai = 0; ai < 2; ++ai)
#pragma unroll
            for (int m = 0; m < 4; ++m)
#pragma unroll
                for (int n = 0; n < 2; ++n) *(f32x4*)(Sloc + (size_t)(row0 + ai * 128 + m * 16) * 128 + col0 + n * 16) = acc[ai][0][m][n];
    }
};
struct EpiS5C {
    static constexpr bool PERM = true, AFTER_DRAIN = false;
    bf16_t* Z;
    __device__ __forceinline__ void operator()(const f32x4 (&acc)[2][2][4][2], const pg8::Unit& u, int wr, int wc, int fr, int fq) const {
        const int g = u.pm, c0 = wr * 64 + fr, cc0 = (u.pn & 3) * 256 + wc * 32 + 8 * fq;
#pragma unroll
        for (int ai = 0; ai < 2; ++ai)
#pragma unroll
            for (int m = 0; m < 4; ++m) { const int c = c0 + ai * 128 + m * 16;
#pragma unroll
                for (int bj = 0; bj < 2; ++bj) { const int cc = cc0 + bj * 128, t = cc >> 4, h0 = cc & 15;
                    const f32x4 v0 = acc[ai][bj][m][0], v1 = acc[ai][bj][m][1];
                    u32x4 w; w.x = cvt_pk_bf16(gelu_tanh(v0[0]), gelu_tanh(v0[1])); w.y = cvt_pk_bf16(gelu_tanh(v0[2]), gelu_tanh(v0[3]));
                    w.z = cvt_pk_bf16(gelu_tanh(v1[0]), gelu_tanh(v1[1])); w.w = cvt_pk_bf16(gelu_tanh(v1[2]), gelu_tanh(v1[3]));
                    *(u32x4*)(Z + (size_t)(c * 64 + t) * S5W + g * 16 + h0) = w; } }
    }
};
__device__ __forceinline__ void s5_tables_item(const Ctx& a, int lg, LAS unsigned char* lds, int wave, int lane) {
    LAS f32x2* LP = (LAS f32x2*)lds;
    LAS f32x2* BB = (LAS f32x2*)(lds + 33280);
    LAS f32x2* CC = (LAS f32x2*)(lds + 41472);
    LAS float* KT = (LAS float*)(lds + 49664);
    const int tid = wave * 64 + lane, l = lg >> 6, g = lg & 63;
    if (tid < 64) { const int p = tid;
        const double ar = (double)a.in(I_AREAL)[lg * 64 + p], ai = (double)a.in(I_AIMAG)[lg * 64 + p], dt = exp((double)a.in(I_LOGDT)[lg]);
        const double mag = exp(ar * dt), ang = ai * dt, lr = mag * cos(ang), li = mag * sin(ang);
        const double den = ar * ar + ai * ai, nr = lr - 1.0, ni = li, cr = (nr * ar + ni * ai) / den, ci = (ni * ar - nr * ai) / den;
        double pr = 1.0, pi = 0.0;
        for (int tau = 0; tau <= 64; ++tau) { LP[tau * 64 + p] = (f32x2){(float)pr, (float)pi}; const double nr2 = pr * lr - pi * li, ni2 = pr * li + pi * lr; pr = nr2; pi = ni2; }
        for (int h = 0; h < 16; ++h) { const double br = (double)a.in(I_BRE)[((size_t)lg * 64 + p) * 16 + h], bi = (double)a.in(I_BIM)[((size_t)lg * 64 + p) * 16 + h];
            BB[p * 16 + h] = (f32x2){(float)(cr * br - ci * bi), (float)(cr * bi + ci * br)}; }
    }
    for (int e = tid; e < 1024; e += 512) { const int h = e >> 6, p = e & 63; CC[e] = (f32x2){a.in(I_CRE)[((size_t)lg * 16 + h) * 64 + p], a.in(I_CIM)[((size_t)lg * 16 + h) * 64 + p]}; }
    __syncthreads();
    if (tid < 64) *(f32x2*)((float*)(a.ws() + WS_LAM64) + ((size_t)lg * 64 + tid) * 2) = LP[64 * 64 + tid];
    for (int e = tid; e < 64 * 256; e += 512) { const int tau = e >> 8, h = (e >> 4) & 15, hp = e & 15; float s = 0.f;
#pragma unroll 8
        for (int p = 0; p < 64; ++p) { const f32x2 c = CC[h * 64 + p], lm = LP[tau * 64 + p], b = BB[p * 16 + hp];
            const float xr = c.x * lm.x - c.y * lm.y, xi = c.x * lm.y + c.y * lm.x; s += xr * b.x - xi * b.y; }
        if (tau == 0 && h == hp) s += a.in(I_S5D)[l * S5W + g * 16 + h];
        KT[e] = s; }
    __syncthreads();
    bf16_t* T = (bf16_t*)(a.ws() + WS_S5T + (size_t)l * S5_T_LAYER) + (size_t)g * 1024 * S5K;
    for (int pc = tid; pc < 1024 * 144; pc += 512) { const int n = pc / 144, j = pc % 144, t = n >> 4, h = n & 15; float v[8];
        if (j < 128) { const int s = j >> 1, hp0 = (j & 1) * 8;
            if (s > t) {
#pragma unroll
                for (int i = 0; i < 8; ++i) v[i] = 0.f;
            } else { const LAS float* kp = KT + (t - s) * 256 + h * 16 + hp0; const f32x4 k0 = *(const LAS f32x4*)kp, k1 = *(const LAS f32x4*)(kp + 4);
                v[0] = k0[0]; v[1] = k0[1]; v[2] = k0[2]; v[3] = k0[3]; v[4] = k1[0]; v[5] = k1[1]; v[6] = k1[2]; v[7] = k1[3]; }
        } else { const int p0 = (j - 128) * 4;
#pragma unroll
            for (int i = 0; i < 4; ++i) { const f32x2 c = CC[h * 64 + p0 + i], lm = LP[(t + 1) * 64 + p0 + i]; v[2 * i] = c.x * lm.x - c.y * lm.y; v[2 * i + 1] = -(c.x * lm.y + c.y * lm.x); } }
        *(u32x4*)(T + (size_t)n * S5K + j * 8) = (u32x4){cvt_pk_bf16(v[0], v[1]), cvt_pk_bf16(v[2], v[3]), cvt_pk_bf16(v[4], v[5]), cvt_pk_bf16(v[6], v[7])}; }
    bf16_t* W1 = (bf16_t*)(a.ws() + WS_S5W1 + (size_t)l * S5_W1_LAYER) + (size_t)g * 256 * S5K;
    for (int pc = tid; pc < 256 * 144; pc += 512) { const int n = pc / 144, j = pc % 144; float v[8];
#pragma unroll
        for (int i = 0; i < 8; ++i) v[i] = 0.f;
        if (n < 128 && j < 128) { const int p = n >> 1, ri = n & 1, s = j >> 1, hp0 = (j & 1) * 8; const f32x2 lm = LP[(63 - s) * 64 + p];
#pragma unroll
            for (int i = 0; i < 8; ++i) { const f32x2 b = BB[p * 16 + hp0 + i]; v[i] = ri ? (lm.x * b.y + lm.y * b.x) : (lm.x * b.x - lm.y * b.y); } }
        *(u32x4*)(W1 + (size_t)n * S5K + j * 8) = (u32x4){cvt_pk_bf16(v[0], v[1]), cvt_pk_bf16(v[2], v[3]), cvt_pk_bf16(v[4], v[5]), cvt_pk_bf16(v[6], v[7])}; }
    __syncthreads();
}
__device__ __forceinline__ void s5_scan_item(const Ctx& a, int l, int item, int wave, int lane) {
    const int idx = item * 512 + wave * 64 + lane, g = idx >> 7, b = (idx >> 6) & 1, p = idx & 63;
    const f32x2 lam = *(const f32x2*)((const float*)(a.ws() + WS_LAM64) + ((size_t)(l * 64 + g) * 64 + p) * 2);
    const float* sl = (const float*)(a.ws() + WS_SLOC) + ((size_t)(g * 256 + b * 128)) * 128 + 2 * p;
    bf16_t* ux = (bf16_t*)(a.ws() + WS_UX) + ((size_t)(g * 256 + b * 128)) * S5K + 1024 + 2 * p;
    float xr = 0.f, xi = 0.f;
    for (int c0 = 0; c0 < 128; c0 += 8) { f32x2 s[8];
#pragma unroll
        for (int i = 0; i < 8; ++i) s[i] = *(const f32x2*)(sl + (size_t)(c0 + i) * 128);
#pragma unroll
        for (int i = 0; i < 8; ++i) { *(unsigned*)(ux + (size_t)(c0 + i) * S5K) = cvt_pk_bf16(xr, xi);
            const float nr = lam.x * xr - lam.y * xi + s[i].x, ni = lam.x * xi + lam.y * xr + s[i].y; xr = nr; xi = ni; } }
}

__device__ __forceinline__ void transpose_item(const float* W, int N, int k0, int n0, bf16_t* WT, int drow0, int Kd, LAS float* scr, int lane) {
    const int nl = 4 * (lane & 15), kq = lane >> 4;
    const bool valid = (n0 + nl) < N;
    f32x4 v[16];
#pragma unroll
    for (int i = 0; i < 16; ++i) { const int k = 4 * i + kq; v[i] = valid ? *(const f32x4*)(W + (size_t)(k0 + k) * N + n0 + nl) : (f32x4){0.f, 0.f, 0.f, 0.f}; }
#pragma unroll
    for (int i = 0; i < 16; ++i) { const int k = 4 * i + kq; LAS float* s = scr + k * 65 + nl; s[0] = v[i][0]; s[1] = v[i][1]; s[2] = v[i][2]; s[3] = v[i][3]; }
    LDS_WAIT();
    const int c = lane & 7;
#pragma unroll
    for (int j = 0; j < 8; ++j) { const int n = (lane >> 3) + 8 * j; const LAS float* s = scr + (8 * c) * 65 + n;
        u32x4 o; o.x = cvt_pk_bf16(s[0], s[65]); o.y = cvt_pk_bf16(s[130], s[195]); o.z = cvt_pk_bf16(s[260], s[325]); o.w = cvt_pk_bf16(s[390], s[455]);
        *(u32x4*)(WT + (size_t)(drow0 + n) * Kd + k0 + 8 * c) = o; }
    LDS_WAIT();
}
constexpr int NIT_IN = 64 * 188, NIT_OUT = 64 * 64, NIT_G = 64 * 172, NIT_DN = 172 * 64, NIT_GLU = 16 * 16;
constexpr int NIT_LAYER = NIT_IN + NIT_OUT + 2 * NIT_G + NIT_DN + NIT_GLU;
constexpr int NIT_TR = DEPTH * NIT_LAYER, NIT_COND = 64 * 96;

__device__ __forceinline__ void phase_prologue(const Ctx& a, LAS unsigned char* lds, int wave, int lane) {
    if (blockIdx.x & 1) { for (int lg = blockIdx.x; lg < DEPTH * 64; lg += gridDim.x) s5_tables_item(a, lg, lds, wave, lane); __syncthreads(); }
    LAS float* scr = (LAS float*)(lds + wave * 16640);
    const int gw = blockIdx.x * 8 + wave, NGW = gridDim.x * 8;
    for (int it = gw; it < NIT_TR + NIT_COND; it += NGW) {
        if (it < NIT_TR) {
            const int l = it / NIT_LAYER; int r = it % NIT_LAYER;
            unsigned char* wt = a.ws() + WS_WT + (size_t)l * WT_LAYER;
            if (r < NIT_IN) { const int kb = r / 188, nb = r % 188; transpose_item(a.in(I_WIN) + (size_t)l * DM * INW, INW, 64 * kb, 64 * nb, (bf16_t*)(wt + WT_IN), 64 * nb, DM, scr, lane); continue; } r -= NIT_IN;
            if (r < NIT_OUT) { const int kb = r / 64, nb = r % 64; transpose_item(a.in(I_WOUT) + (size_t)l * DM * DM, DM, 64 * kb, 64 * nb, (bf16_t*)(wt + WT_OUT), 64 * nb, DM, scr, lane); continue; } r -= NIT_OUT;
            if (r < NIT_G) { const int kb = r / 172, nb = r % 172, n0 = 64 * nb; transpose_item(a.in(I_WFG) + (size_t)l * DM * DFF, DFF, 64 * kb, n0, (bf16_t*)(wt + WT_GU), 256 * (n0 / 128) + (n0 % 128), DM, scr, lane); continue; } r -= NIT_G;
            if (r < NIT_G) { const int kb = r / 172, nb = r % 172, n0 = 64 * nb; transpose_item(a.in(I_WFU) + (size_t)l * DM * DFF, DFF, 64 * kb, n0, (bf16_t*)(wt + WT_GU), 256 * (n0 / 128) + 128 + (n0 % 128), DM, scr, lane); continue; } r -= NIT_G;
            if (r < NIT_DN) { const int kb = r / 64, nb = r % 64; transpose_item(a.in(I_WFD) + (size_t)l * DFF * DM, DM, 64 * kb, 64 * nb, (bf16_t*)(wt + WT_DN), 64 * nb, DFF, scr, lane); continue; } r -= NIT_DN;
            { const int kb = r / 16, nb = r % 16; transpose_item(a.in(I_GLUW) + (size_t)l * S5W * S5W, S5W, 64 * kb, 64 * nb, (bf16_t*)(wt + WT_GLU), 64 * nb, S5W, scr, lane); }
        } else {
            const int item = it - NIT_TR, kb = item / 96, jb = item % 96, k0 = 64 * kb, j0 = 256 * jb + 4 * lane;
            const float* c = a.in(I_C);
            float c0 = c[k0 + lane], c1 = c[DM + k0 + lane];
            c0 = c0 / (1.0f + expf(-c0)); c1 = c1 / (1.0f + expf(-c1));
            f32x4 a0 = (f32x4){0.f, 0.f, 0.f, 0.f}, a1 = a0;
            const float* w = a.in(I_WADA) + (size_t)k0 * (6 * DM) + j0;
#pragma unroll 8
            for (int kk = 0; kk < 64; ++kk) { const f32x4 wv = *(const f32x4*)(w + (size_t)kk * (6 * DM));
                const float s0 = __int_as_float(__builtin_amdgcn_readlane(__float_as_int(c0), kk)), s1 = __int_as_float(__builtin_amdgcn_readlane(__float_as_int(c1), kk));
                a0 += wv * s0; a1 += wv * s1; }
            float* cp = (float*)(a.ws() + WS_CONDPART);
            *(f32x4*)(cp + (size_t)(kb * 2 + 0) * (6 * DM) + j0) = a0;
            *(f32x4*)(cp + (size_t)(kb * 2 + 1) * (6 * DM) + j0) = a1;
        }
    }
    __syncthreads();
    if (!(blockIdx.x & 1)) { for (int lg = blockIdx.x; lg < DEPTH * 64; lg += gridDim.x) s5_tables_item(a, lg, lds, wave, lane); }
}
__device__ __forceinline__ void phase_mod(const Ctx& a, int wave, int lane) {
    const int gt = blockIdx.x * 512 + wave * 64 + lane, NT = gridDim.x * 512;
    const float* cp = (const float*)(a.ws() + WS_CONDPART);
    float* mod = (float*)(a.ws() + WS_MOD); float* misc = (float*)(a.ws() + WS_MISC);
    for (int idx = gt; idx < NB * 6 * DM; idx += NT) {
        const int b = idx / (6 * DM), j = idx % (6 * DM);
        float s = a.in(I_BADA)[j];
        for (int kb = 0; kb < 64; ++kb) s += cp[(size_t)(kb * 2 + b) * (6 * DM) + j];
        for (int l = 0; l < DEPTH; ++l) mod[(size_t)((l * 2 + b) * 6) * DM + j] = s + a.in(I_TABLE)[(size_t)l * 6 * DM + j];
    }
    for (int idx = gt; idx < DM; idx += NT) { misc[idx] = 1.0f; misc[DM + idx] = 0.0f; }
    for (int idx = gt; idx < HGW; idx += NT) {
        const float* raw = a.in(I_LBRAW); float r[DEPTH], mx = -3.0e38f;
#pragma unroll
        for (int l = 0; l < DEPTH; ++l) { r[l] = raw[l * HGW + idx]; mx = fmaxf(mx, r[l]); }
        float e[DEPTH], sum = 0.f;
#pragma unroll
        for (int l = 0; l < DEPTH; ++l) { e[l] = expf(r[l] - mx); sum += e[l]; }
        float cum = 0.f;
#pragma unroll
        for (int l = 0; l < DEPTH; ++l) { misc[2 * DM + l * HGW + idx] = cum; if (l + 1 < DEPTH) cum += e[l + 1] / sum; }
    }
}

__device__ __forceinline__ void phase_h0(const float* x, const float* modp, bf16_t* H, int wave, int lane) {
    for (int blk = blockIdx.x; blk < MTOK / 64; blk += gridDim.x) {
        const int r0 = blk * 64, b = (r0 >= SEQ) ? 1 : 0;
        f32x4 A[2], B[2];
#pragma unroll
        for (int jj = 0; jj < 2; ++jj) { const int c = 512 * wave + 256 * jj + 4 * lane; A[jj] = *(const f32x4*)(modp + (size_t)(b * 6 + 1) * DM + c) + 1.0f; B[jj] = *(const f32x4*)(modp + (size_t)(b * 6 + 0) * DM + c); }
#pragma unroll 8
        for (int rl = 0; rl < 64; ++rl) { const size_t off = (size_t)(r0 + rl) * DM + 512 * wave + 4 * lane;
#pragma unroll
            for (int jj = 0; jj < 2; ++jj) { const f32x4 v = *(const f32x4*)(x + off + 256 * jj), y = v * A[jj] + B[jj];
                u32x2 w; w.x = cvt_pk_bf16(y[0], y[1]); w.y = cvt_pk_bf16(y[2], y[3]); *(u32x2*)(H + off + 256 * jj) = w; } }
    }
}
template <bool WITH_H>
__device__ __forceinline__ void phase_lnres(const float* xprev, const bf16_t* delta, float* xout, const float* lng, const float* lnb, const float* modp, int i_shift, int i_scale, bf16_t* H,
                                            LAS unsigned char* lds, int wave, int lane) {
    LAS f32x2* red = (LAS f32x2*)lds;
    for (int blk = blockIdx.x; blk < MTOK / 64; blk += gridDim.x) {
        const int r0 = blk * 64, b = (r0 >= SEQ) ? 1 : 0;
        f32x4 G[2], Bt[2], A[2], B[2];
#pragma unroll
        for (int jj = 0; jj < 2; ++jj) { const int c = 512 * wave + 256 * jj + 4 * lane; G[jj] = *(const f32x4*)(lng + c); Bt[jj] = *(const f32x4*)(lnb + c);
            if (WITH_H) { A[jj] = *(const f32x4*)(modp + (size_t)(b * 6 + i_scale) * DM + c) + 1.0f; B[jj] = *(const f32x4*)(modp + (size_t)(b * 6 + i_shift) * DM + c); } }
        for (int it = 0; it < 8; ++it) {
            const size_t off0 = (size_t)(r0 + it * 8) * DM + 512 * wave + 4 * lane;
            f32x4 v[8][2]; u32x2 dl[8][2];
#pragma unroll
            for (int r = 0; r < 8; ++r)
#pragma unroll
                for (int jj = 0; jj < 2; ++jj) { v[r][jj] = *(const f32x4*)(xprev + off0 + (size_t)r * DM + 256 * jj); dl[r][jj] = *(const u32x2*)(delta + off0 + (size_t)r * DM + 256 * jj); }
            LAS f32x2* rb = red + (it & 1) * 64;
#pragma unroll
            for (int r = 0; r < 8; ++r) { float s1 = 0.f, s2 = 0.f;
#pragma unroll
                for (int jj = 0; jj < 2; ++jj) { const f32x4 d = (f32x4){bf_lo(dl[r][jj].x), bf_hi(dl[r][jj].x), bf_lo(dl[r][jj].y), bf_hi(dl[r][jj].y)}; const f32x4 y = v[r][jj] * ALPHA + d; v[r][jj] = y;
                    s1 += (y[0] + y[1]) + (y[2] + y[3]); s2 += (y[0] * y[0] + y[1] * y[1]) + (y[2] * y[2] + y[3] * y[3]); }
                s1 = wave_sum(s1); s2 = wave_sum(s2);
                if (lane == 0) rb[r * 8 + wave] = (f32x2){s1, s2}; }
            __syncthreads();
#pragma unroll
            for (int r = 0; r < 8; ++r) { float s1 = 0.f, s2 = 0.f;
#pragma unroll
                for (int w = 0; w < 8; ++w) { const f32x2 p = rb[r * 8 + w]; s1 += p.x; s2 += p.y; }
                const float mu = s1 * (1.0f / DM), rs = 1.0f / sqrtf(fmaxf(s2 * (1.0f / DM) - mu * mu, 0.f) + LN_EPS);
#pragma unroll
                for (int jj = 0; jj < 2; ++jj) { const f32x4 x = ((v[r][jj] - mu) * rs) * G[jj] + Bt[jj];
                    *(f32x4*)(xout + off0 + (size_t)r * DM + 256 * jj) = x;
                    if (WITH_H) { const f32x4 y = x * A[jj] + B[jj]; u32x2 w; w.x = cvt_pk_bf16(y[0], y[1]); w.y = cvt_pk_bf16(y[2], y[3]); *(u32x2*)(H + off0 + (size_t)r * DM + 256 * jj) = w; } } }
        }
        __syncthreads();
    }
}

typedef short bf16x8 __attribute__((ext_vector_type(8)));
typedef short bf16x4 __attribute__((ext_vector_type(4)));
constexpr int HG_BLK = 16896, HG_OQ = 0, HG_OK = 4096, HG_OKT = 8192, HG_OVT = 12288, HG_ODL = 16384;
constexpr int GL_BLK = 32768, GL_OQ = 0, GL_OK = 6400, GL_OKT = 12800, GL_ODL = 18944, GL_SHARED = 20480, GL_OVT = 20480;
constexpr int NSUB = SEQ / 16;

__device__ __forceinline__ unsigned short f2bf1(float x) { return (unsigned short)(cvt_pk_bf16(x, x) & 0xffffu); }

__device__ __forceinline__ void pre_finish(const float (&qq)[16], const float (&kk)[16], float (&g)[16], unsigned char* blk, int oq, int ok, int okt, int odl, int rowb, int d, bool swz) {
    const int pd = (d & ~31) + 8 * ((d >> 2) & 3) + 4 * ((d >> 4) & 1) + (d & 3);
    float b = 0.f;
#pragma unroll
    for (int j = 0; j < 16; ++j) { b += g[j]; g[j] = b; }
    const float bl = b;
    unsigned kt[8];
#pragma unroll
    for (int j = 0; j < 16; j += 2) {
        float kv[2];
#pragma unroll
        for (int jj = 0; jj < 2; ++jj) { const int t = j + jj; const float bj = g[t];
            const int off = t * rowb + (swz ? ((2 * pd) ^ (t << 4)) : 2 * pd);
            const float qv = qq[t] * __expf(bj), kc = kk[t] * __expf(fminf(-bj, 80.f));
            const float qn = __int_as_float(__builtin_amdgcn_mov_dpp(__float_as_int(qv), 0xB1, 0xF, 0xF, true)), kn = __int_as_float(__builtin_amdgcn_mov_dpp(__float_as_int(kc), 0xB1, 0xF, 0xF, true));
            if ((d & 1) == 0) { *(unsigned*)(blk + oq + off) = cvt_pk_bf16(qv, qn); *(unsigned*)(blk + ok + off) = cvt_pk_bf16(kc, kn); }
            kv[jj] = kk[t] * __expf(bl - bj); }
        kt[j >> 1] = cvt_pk_bf16(kv[0], kv[1]); }
    *(u32x4*)(blk + okt + d * 32) = (u32x4){kt[0], kt[1], kt[2], kt[3]};
    *(u32x4*)(blk + okt + d * 32 + 16) = (u32x4){kt[4], kt[5], kt[6], kt[7]};
    *(float*)(blk + odl + d * 4) = __expf(bl);
}
__device__ __forceinline__ void phase_pre(const Ctx& a, int l, int wave, int lane) {
    const bf16_t* P = (const bf16_t*)(a.ws() + WS_P);
    int tid = wave * 64 + lane;
    const bool bal = gridDim.x == 256;
    const int t_lo = bal ? (blockIdx.x < 64 ? 26 * (int)blockIdx.x : 1664 + 34 * ((int)blockIdx.x - 64)) : (int)blockIdx.x;
    const int t_hi = bal ? t_lo + (blockIdx.x < 64 ? 26 : 34) : NB * NSUB * 8, t_st = bal ? 1 : (int)gridDim.x;
    for (int task = t_lo; task < t_hi; task += t_st) {
        asm volatile("" : "+v"(tid));
        const int kind = bal ? (task & 7) : ((task + (task >> 8)) & 7), bsc = task >> 3, b = bsc / NSUB, sc = bsc % NSUB;
        const size_t row0 = (size_t)b * SEQ + sc * 16;
        if (kind < 3) {
            const int ch = kind * 512 + tid, h = ch >> 7, d = ch & 127;
            const float lb = ((const float*)(a.ws() + WS_MISC))[2 * DM + l * HGW + ch];
            unsigned char* blk = a.ws() + WS_HGB + ((size_t)(b * 12 + h) * NSUB + sc) * HG_BLK;
            float g[16], qq[16], kk[16]; unsigned vv[8];
#pragma unroll
            for (int j = 0; j < 16; ++j) { const bf16_t* prow = P + (row0 + j) * INP;
                const float qin = fmaxf(bf2f(prow[C_QB + ch]), -80.f), fin = fminf(fmaxf(bf2f(prow[C_FB + ch]), -80.f), 80.f);
                const unsigned short v = prow[C_IB + ch]; if (j & 1) vv[j >> 1] |= ((unsigned)v) << 16; else vv[j >> 1] = v;
                const float e = __expf(-fin), sg = __builtin_amdgcn_rcpf(1.0f + e);
                const float f = lb + (1.0f - lb) * sg;
                g[j] = fmaxf(__logf(f), -100.f); kk[j] = (1.0f - lb) * (e * sg); qq[j] = qin * __builtin_amdgcn_rcpf(1.0f + __expf(-qin)); }
            *(u32x4*)(blk + HG_OVT + d * 32) = (u32x4){vv[0], vv[1], vv[2], vv[3]};
            *(u32x4*)(blk + HG_OVT + d * 32 + 16) = (u32x4){vv[4], vv[5], vv[6], vv[7]};
            pre_finish(qq, kk, g, blk, HG_OQ, HG_OK, HG_OKT, HG_ODL, 256, d, true);
        } else if (kind < 5) {
            if (tid < 384) {
                const int ch = (kind - 3) * 384 + tid, h = ch / 192, d = ch % 192;
                unsigned char* blk = a.ws() + WS_GLB + ((size_t)(b * 4 + h) * NSUB + sc) * GL_BLK;
                float wg[16];
#pragma unroll
                for (int r = 0; r < 16; ++r) wg[r] = a.in(I_WGATE)[((size_t)l * 16 + r) * GLKW + ch];
                const float bgv = a.in(I_BGATE)[l * GLKW + ch];
                float g[16], qq[16], kk[16];
#pragma unroll
                for (int j = 0; j < 16; ++j) { const bf16_t* prow = P + (row0 + j) * INP;
                    const u32x4 l0 = *(const u32x4*)(prow + C_LR), l1 = *(const u32x4*)(prow + C_LR + 8);
                    float x = bgv;
                    x += bf_lo(l0.x) * wg[0] + bf_hi(l0.x) * wg[1] + bf_lo(l0.y) * wg[2] + bf_hi(l0.y) * wg[3] + bf_lo(l0.z) * wg[4] + bf_hi(l0.z) * wg[5] + bf_lo(l0.w) * wg[6] + bf_hi(l0.w) * wg[7];
                    x += bf_lo(l1.x) * wg[8] + bf_hi(l1.x) * wg[9] + bf_lo(l1.y) * wg[10] + bf_hi(l1.y) * wg[11] + bf_lo(l1.z) * wg[12] + bf_hi(l1.z) * wg[13] + bf_lo(l1.w) * wg[14] + bf_hi(l1.w) * wg[15];
                    g[j] = (fminf(x, 0.f) - __logf(1.0f + __expf(-fabsf(x)))) * 0.0625f;
                    qq[j] = bf2f(prow[C_QC + ch]) * GLA_QSCALE; kk[j] = bf2f(prow[C_KC + ch]); }
                pre_finish(qq, kk, g, blk, GL_OQ, GL_OK, GL_OKT, GL_ODL, 400, d, false);
            }
        } else {
            const int ch = (kind - 5) * 512 + tid, h = ch / 384, e = ch % 384;
            unsigned char* blk = a.ws() + WS_GLB + ((size_t)(b * 4 + h) * NSUB + sc) * GL_BLK;
            unsigned vv[8];
#pragma unroll
            for (int j = 0; j < 16; ++j) { const unsigned short v = P[(row0 + j) * INP + C_VC + ch]; if (j & 1) vv[j >> 1] |= ((unsigned)v) << 16; else vv[j >> 1] = v; }
            *(u32x4*)(blk + GL_OVT + e * 32) = (u32x4){vv[0], vv[1], vv[2], vv[3]};
            *(u32x4*)(blk + GL_OVT + e * 32 + 16) = (u32x4){vv[4], vv[5], vv[6], vv[7]};
        }
    }
}

template <int DK, int MODE>
__device__ __forceinline__ void chain_sub(const LAS unsigned char* sb, f32x4 (&S)[DK / 16], float* op, int wave, int n, int q) {
    constexpr bool IS_GLA = (DK == 192);
    constexpr int NKS = DK / 32, NMB = DK / 16, ROWB = IS_GLA ? 400 : 256;
    constexpr int OQ = 0, OK = IS_GLA ? GL_OK : HG_OK, OKT = IS_GLA ? GL_OKT : HG_OKT, OVT = IS_GLA ? GL_OVT : HG_OVT, ODL = IS_GLA ? GL_ODL : HG_ODL;
    const u32x2 vfr = *(const LAS u32x2*)(sb + OVT + (16 * wave + n) * 32 + 8 * q);
    const bf16x8 vf8 = __builtin_bit_cast(bf16x8, (u32x4){vfr.x, vfr.y, 0u, 0u});
    if (MODE == 1) {
        bf16x8 qf[NKS], kf[NKS];
#pragma unroll
        for (int ks = 0; ks < NKS; ++ks) { const int c0 = 64 * ks + 16 * q, o0 = n * ROWB + (IS_GLA ? c0 : (c0 ^ (n << 4)));
            qf[ks] = __builtin_bit_cast(bf16x8, *(const LAS u32x4*)(sb + OQ + o0)); kf[ks] = __builtin_bit_cast(bf16x8, *(const LAS u32x4*)(sb + OK + o0)); }
        f32x4 ao = (f32x4){0.f, 0.f, 0.f, 0.f}, ap = ao, ao1 = ao, ap1 = ao;
#pragma unroll
        for (int ks = 0; ks < NKS; ++ks) {
            const bf16x8 sbf = __builtin_bit_cast(bf16x8, (u32x4){cvt_pk_bf16(S[2 * ks][0], S[2 * ks][1]), cvt_pk_bf16(S[2 * ks][2], S[2 * ks][3]), cvt_pk_bf16(S[2 * ks + 1][0], S[2 * ks + 1][1]), cvt_pk_bf16(S[2 * ks + 1][2], S[2 * ks + 1][3])});
            if (ks & 1) { ao1 = __builtin_amdgcn_mfma_f32_16x16x32_bf16(qf[ks], sbf, ao1, 0, 0, 0); ap1 = __builtin_amdgcn_mfma_f32_16x16x32_bf16(kf[ks], qf[ks], ap1, 0, 0, 0); }
            else { ao = __builtin_amdgcn_mfma_f32_16x16x32_bf16(qf[ks], sbf, ao, 0, 0, 0); ap = __builtin_amdgcn_mfma_f32_16x16x32_bf16(kf[ks], qf[ks], ap, 0, 0, 0); } }
        ao = ao + ao1; ap = ap + ap1;
#pragma unroll
        for (int r = 0; r < 4; ++r) if (4 * q + r > n) ap[r] = 0.f;
        const bf16x8 pa8 = __builtin_bit_cast(bf16x8, (u32x4){cvt_pk_bf16(ap[0], ap[1]), cvt_pk_bf16(ap[2], ap[3]), 0u, 0u});
        ao = __builtin_amdgcn_mfma_f32_16x16x32_bf16(pa8, vf8, ao, 0, 0, 0);
#pragma unroll
        for (int r = 0; r < 4; ++r) op[(size_t)(4 * q + r) * OW] = ao[r];
    }
#pragma unroll
    for (int mb = 0; mb < NMB; ++mb) {
        const f32x4 dl = *(const LAS f32x4*)(sb + ODL + (16 * mb + 4 * q) * 4);
        const u32x2 ktr = *(const LAS u32x2*)(sb + OKT + (16 * mb + n) * 32 + 8 * q);
        S[mb] = __builtin_amdgcn_mfma_f32_16x16x32_bf16(__builtin_bit_cast(bf16x8, (u32x4){ktr.x, ktr.y, 0u, 0u}), vf8, S[mb] * dl, 0, 0, 0); }
}
constexpr size_t ST_REC = 98304;
constexpr int NSEG_HG = 4, NSEG_GL = 6, NSEG_MAX = 6;
__device__ __forceinline__ int seg_u0(bool gla, int s) { return gla ? (s <= 2 ? 44 * s : 88 + 42 * (s - 2)) : 64 * s; }
__device__ __forceinline__ int seg_nu(bool gla, int s) { return gla ? (s < 2 ? 44 : 42) : 64; }
template <int DK, int MODE>
__device__ __forceinline__ void chain_item(const unsigned char* blk0, int vt_off, float* op0, unsigned char* st, int seg, int nunits, LAS unsigned char* lds, int wave, int lane) {
    asm volatile("" : "+v"(lane), "+s"(wave));
    constexpr bool IS_GLA = (DK == 192);
    constexpr int BLK = IS_GLA ? GL_BLK : HG_BLK, SUBB = IS_GLA ? GL_SHARED + 4096 : HG_BLK, NMB = DK / 16;
    constexpr int SH0 = MODE == 1 ? 0 : (IS_GLA ? GL_OKT : HG_OKT);
    constexpr int SH_PIECES = (MODE == 1 ? (IS_GLA ? GL_SHARED : HG_OVT) : (IS_GLA ? GL_ODL + 768 - GL_OKT : 4096)) / 16;
    constexpr int T_PIECES = IS_GLA ? 256 : (4096 + 512) / 16;
    constexpr int T_LDS = IS_GLA ? GL_OVT : HG_OVT;
    constexpr int PIECES = SH_PIECES + T_PIECES, UNITB = 2 * SUBB, NP = (2 * PIECES + 511) / 512;
    const int tid = wave * 64 + lane, n = lane & 15, q = lane >> 4;
    f32x4 S[NMB]; float dacc = 1.0f;
    constexpr int ODL_ = IS_GLA ? GL_ODL : HG_ODL;
#pragma unroll
    for (int mb = 0; mb < NMB; ++mb) S[mb] = (f32x4){0.f, 0.f, 0.f, 0.f};
    if (MODE == 1) {
        for (int s = 0; s < seg; ++s) { const unsigned char* rec = st + (size_t)s * 2 * ST_REC + (size_t)(wave * 64 + lane) * 16;
#pragma unroll
            for (int mb = 0; mb < NMB; ++mb) { const f32x4 h = *(const f32x4*)(rec + (size_t)mb * 8192), d = *(const f32x4*)(st + (size_t)s * 2 * ST_REC + ST_REC + (16 * mb + 4 * q) * 4); S[mb] = S[mb] * d + h; } }
    }
    u32x4 stgA[NP], stgB[NP];
#define CH_SRC(u, p_) (blk0 + (size_t)((u) * 2 + (p_) / PIECES) * BLK + (((p_) % PIECES) < SH_PIECES ? SH0 + ((p_) % PIECES) * 16 : (IS_GLA ? vt_off : HG_OVT) + (((p_) % PIECES) - SH_PIECES) * 16))
#define CH_DST(p_) (((p_) / PIECES) * SUBB + (((p_) % PIECES) < SH_PIECES ? SH0 + ((p_) % PIECES) * 16 : T_LDS + (((p_) % PIECES) - SH_PIECES) * 16))
#define CH_LOAD(stg, u) do { _Pragma("unroll") for (int r_ = 0; r_ < NP; ++r_) { const int p_ = r_ * 512 + tid; const bool ok_ = (NP * 512 == 2 * PIECES) || p_ < 2 * PIECES; const int pc_ = ok_ ? p_ : 0; stg[r_] = *(const u32x4*)CH_SRC(u, pc_); } } while (0)
#define CH_STORE(stg, buf) do { _Pragma("unroll") for (int r_ = 0; r_ < NP; ++r_) { const int p_ = r_ * 512 + tid; const bool ok_ = (NP * 512 == 2 * PIECES) || p_ < 2 * PIECES; const int pc_ = ok_ ? p_ : 0; \
        const int d_ = ok_ ? (buf) * UNITB + CH_DST(pc_) : 2 * UNITB + (p_ - 2 * PIECES) * 16; *(LAS u32x4*)(lds + d_) = stg[r_]; } } while (0)
#define CH_SYNC() do { asm volatile("s_waitcnt lgkmcnt(0)" ::: "memory"); __builtin_amdgcn_s_barrier(); asm volatile("" ::: "memory"); } while (0)
    CH_LOAD(stgA, 0); CH_STORE(stgA, 0);
    CH_LOAD(stgA, 1);
    CH_SYNC();
    float* op = op0 + 16 * wave + n;
    for (int u = 0; u < nunits; u += 2) {
        if (u + 2 < nunits) CH_LOAD(stgB, u + 2);
        chain_sub<DK, MODE>(lds, S, op + (size_t)(u * 32) * OW, wave, n, q);
        chain_sub<DK, MODE>(lds + SUBB, S, op + (size_t)(u * 32 + 16) * OW, wave, n, q);
        if (MODE == 0 && tid < DK) dacc *= *(const LAS float*)(lds + ODL_ + 4 * tid) * *(const LAS float*)(lds + SUBB + ODL_ + 4 * tid);
        CH_STORE(stgA, 1);
        CH_SYNC();
        if (u + 3 < nunits) CH_LOAD(stgA, u + 3);
        chain_sub<DK, MODE>(lds + UNITB, S, op + (size_t)(u * 32 + 32) * OW, wave, n, q);
        chain_sub<DK, MODE>(lds + UNITB + SUBB, S, op + (size_t)(u * 32 + 48) * OW, wave, n, q);
        if (MODE == 0 && tid < DK) dacc *= *(const LAS float*)(lds + UNITB + ODL_ + 4 * tid) * *(const LAS float*)(lds + UNITB + SUBB + ODL_ + 4 * tid);
        if (u + 2 < nunits) CH_STORE(stgB, 0);
        CH_SYNC();
    }
    if (MODE == 0) { unsigned char* rec = st + (size_t)seg * 2 * ST_REC + (size_t)(wave * 64 + lane) * 16;
#pragma unroll
        for (int mb = 0; mb < NMB; ++mb) *(f32x4*)(rec + (size_t)mb * 8192) = S[mb];
        if (tid < DK) *(float*)(st + (size_t)seg * 2 * ST_REC + ST_REC + 4 * tid) = dacc; }
#undef CH_SRC
#undef CH_DST
#undef CH_LOAD
#undef CH_STORE
#undef CH_SYNC
}

template <int MODE>
__device__ __forceinline__ void phase_chain(const Ctx& a, int l, LAS unsigned char* lds, int wave, int lane) {
    const int bx = blockIdx.x, G = gridDim.x;
    constexpr int nhg = 24 * (MODE == 0 ? NSEG_HG - 1 : NSEG_HG), nitems = nhg + 24 * (MODE == 0 ? NSEG_GL - 1 : NSEG_GL);
    for (int it = bx; it < nitems; it += G) {
        const bool gla = it >= nhg; const int j = gla ? it - nhg : it, c = j % 24, seg = j / 24, u0 = seg_u0(gla, seg), nu = seg_nu(gla, seg);
        unsigned char* st = a.ws() + WS_ST + (size_t)(gla ? 24 + c : c) * (NSEG_MAX - 1) * 2 * ST_REC;
        if (!gla) { const int b = c / 12, h = c % 12;
            chain_item<128, MODE>(a.ws() + WS_HGB + ((size_t)(b * 12 + h) * NSUB + 2 * u0) * HG_BLK, 0, (float*)(a.ws() + WS_O) + ((size_t)b * SEQ + u0 * 32) * OW + h * 128, st, seg, nu, lds, wave, lane); }
        else { const int b = c / 12, h = (c % 12) / 3, sl = c % 3;
            chain_item<192, MODE>(a.ws() + WS_GLB + ((size_t)(b * 4 + h) * NSUB + 2 * u0) * GL_BLK, GL_OVT + 4096 * sl, (float*)(a.ws() + WS_O) + ((size_t)b * SEQ + u0 * 32) * OW + HGW + h * 384 + sl * 128, st, seg, nu, lds, wave, lane); }
        __syncthreads();
    }
    if (MODE == 0) { for (int it = (G >= nitems + 16) ? bx - nitems : bx; it < 16; it += G) { if (it < 0) continue; s5_scan_item(a, l, it, wave, lane); } }
}
__device__ __forceinline__ float red16(float v) {
    v += __int_as_float(__builtin_amdgcn_mov_dpp(__float_as_int(v), 0xB1, 0xF, 0xF, true)); v += __int_as_float(__builtin_amdgcn_mov_dpp(__float_as_int(v), 0x4E, 0xF, 0xF, true));
    v += __int_as_float(__builtin_amdgcn_mov_dpp(__float_as_int(v), 0x141, 0xF, 0xF, true)); v += __int_as_float(__builtin_amdgcn_mov_dpp(__float_as_int(v), 0x140, 0xF, 0xF, true)); return v; }
__device__ __forceinline__ void phase_finalize(const Ctx& a, int l, int wave, int lane) {
    const bf16_t* P = (const bf16_t*)(a.ws() + WS_P); const float* O = (const float*)(a.ws() + WS_O); bf16_t* MX = (bf16_t*)(a.ws() + WS_MIXED);
    const float* hgg = a.in(I_HGG) + l * HGW; const float* hgb = a.in(I_HGB) + l * HGW; const float* glg = a.in(I_GLG) + l * HGW;
    const int gw = blockIdx.x * 8 + wave, NGW = gridDim.x * 8;
    for (int row = gw; row < MTOK; row += NGW) {
        const float* orow = O + (size_t)row * OW; const bf16_t* prow = P + (size_t)row * INP; bf16_t* mrow = MX + (size_t)row * DM;
#pragma unroll
        for (int it = 0; it < 3; ++it) { const int c = (it * 4 + (lane >> 4)) * 128 + (lane & 15) * 8;
            const f32x4 o0 = *(const f32x4*)(orow + c), o1 = *(const f32x4*)(orow + c + 4); const u32x4 gg = *(const u32x4*)(prow + C_GB + c);
            float v[8] = {sigmoidf_(bf_lo(gg.x)) * o0[0], sigmoidf_(bf_hi(gg.x)) * o0[1], sigmoidf_(bf_lo(gg.y)) * o0[2], sigmoidf_(bf_hi(gg.y)) * o0[3],
                          sigmoidf_(bf_lo(gg.z)) * o1[0], sigmoidf_(bf_hi(gg.z)) * o1[1], sigmoidf_(bf_lo(gg.w)) * o1[2], sigmoidf_(bf_hi(gg.w)) * o1[3]};
            float s = 0.f, ss = 0.f;
#pragma unroll
            for (int i = 0; i < 8; ++i) { s += v[i]; ss += v[i] * v[i]; }
            s = red16(s); ss = red16(ss);
            const float mu = s * (1.0f / 128.0f), rs = 1.0f / sqrtf(fmaxf(ss * (1.0f / 128.0f) - mu * mu, 0.f) + LN_EPS);
            const f32x4 g0 = *(const f32x4*)(hgg + c), g1 = *(const f32x4*)(hgg + c + 4), b0 = *(const f32x4*)(hgb + c), b1 = *(const f32x4*)(hgb + c + 4);
            u32x4 w; w.x = cvt_pk_bf16((v[0] - mu) * rs * g0[0] + b0[0], (v[1] - mu) * rs * g0[1] + b0[1]); w.y = cvt_pk_bf16((v[2] - mu) * rs * g0[2] + b0[2], (v[3] - mu) * rs * g0[3] + b0[3]);
            w.z = cvt_pk_bf16((v[4] - mu) * rs * g1[0] + b1[0], (v[5] - mu) * rs * g1[1] + b1[1]); w.w = cvt_pk_bf16((v[6] - mu) * rs * g1[2] + b1[2], (v[7] - mu) * rs * g1[3] + b1[3]);
            *(u32x4*)(mrow + S5W + c) = w; }
#pragma unroll
        for (int h = 0; h < 4; ++h) { const int c = h * 384 + lane * 8; const bool act = lane < 48;
            f32x4 o0 = (f32x4){0.f, 0.f, 0.f, 0.f}, o1 = o0; u32x4 gg = (u32x4){0u, 0u, 0u, 0u};
            if (act) { o0 = *(const f32x4*)(orow + HGW + c); o1 = *(const f32x4*)(orow + HGW + c + 4); gg = *(const u32x4*)(prow + C_GC + c); }
            const float ss = wave_sum((o0[0] * o0[0] + o0[1] * o0[1]) + (o0[2] * o0[2] + o0[3] * o0[3]) + (o1[0] * o1[0] + o1[1] * o1[1]) + (o1[2] * o1[2] + o1[3] * o1[3]));
            const float rms = 1.0f / sqrtf(ss * (1.0f / 384.0f) + LN_EPS);
            if (act) { const f32x4 g0 = *(const f32x4*)(glg + c), g1 = *(const f32x4*)(glg + c + 4);
                const float z[8] = {bf_lo(gg.x), bf_hi(gg.x), bf_lo(gg.y), bf_hi(gg.y), bf_lo(gg.z), bf_hi(gg.z), bf_lo(gg.w), bf_hi(gg.w)};
                u32x4 w; w.x = cvt_pk_bf16(o0[0] * rms * g0[0] * (z[0] * sigmoidf_(z[0])), o0[1] * rms * g0[1] * (z[1] * sigmoidf_(z[1])));
                w.y = cvt_pk_bf16(o0[2] * rms * g0[2] * (z[2] * sigmoidf_(z[2])), o0[3] * rms * g0[3] * (z[3] * sigmoidf_(z[3])));
                w.z = cvt_pk_bf16(o1[0] * rms * g1[0] * (z[4] * sigmoidf_(z[4])), o1[1] * rms * g1[1] * (z[5] * sigmoidf_(z[5])));
                w.w = cvt_pk_bf16(o1[2] * rms * g1[2] * (z[6] * sigmoidf_(z[6])), o1[3] * rms * g1[3] * (z[7] * sigmoidf_(z[7])));
                *(u32x4*)(mrow + S5W + HGW + c) = w; } }
    }
}

constexpr int PH_PRO = 0, PH_MOD = 1, PH_LN0 = 2, PH_L0 = 3, PH_PER_LAYER = 10, N_PHASES = PH_L0 + DEPTH * PH_PER_LAYER;
constexpr int CW_BAR = 4096;

__global__ void __launch_bounds__(512, 2) hybrid_fwd(Args args) {
    extern __shared__ __attribute__((aligned(16))) unsigned char lds_raw[];
    LAS unsigned char* lds = (LAS unsigned char*)lds_raw;
    const int wave = __builtin_amdgcn_readfirstlane((int)threadIdx.x >> 6);
#define lane lane_id_v()
    volatile LAS unsigned* MISC = (volatile LAS unsigned*)(lds + LDSCTL_OFF);
    Ctx ctx; ctx.t = (volatile LAS unsigned long long*)(lds + LDSCTL_OFF + 64);
    if (wave == 0) { const int ln_ = lane; unsigned long long v = 0ull;
#pragma unroll
        for (int i = 0; i < N_IN; ++i) v = (ln_ == i) ? (unsigned long long)args.in[i] : v;
        v = (ln_ == 30) ? (unsigned long long)args.out : v; v = (ln_ == 31) ? (unsigned long long)args.ws : v;
        if (ln_ < 32) ctx.t[ln_] = v;
        if (ln_ < 16) MISC[ln_] = 0u; }
    __syncthreads();
    const int lo = args.ph_lo, hi = args.ph_hi;
    XcdBarrier bar; bar.bar = (unsigned*)(ctx.ws() + WS_CTL) + CW_BAR; bar.x = 0; bar.st = nullptr; bar.w0 = (wave == 0) ? 1u : 0u;
    if (hi - lo > 1) bar = xcd_barrier_post((unsigned*)(ctx.ws() + WS_CTL) + CW_BAR, MISC + 8, (wave == 0) ? 1u : 0u);
#define IN(k) (lo <= (k) && (k) < hi)
#define OPQ() int ln = lane, wv = wave; asm volatile("" : "+s"(wv))
#define SEAM(k) do { if (IN(k) && IN((k) + 1)) xcd_barrier(bar); } while (0)
#define WSP(T, off) ((T*)(ctx.ws() + (off)))

    if (IN(PH_PRO)) { OPQ(); phase_prologue(ctx, lds, wv, ln); }
    SEAM(PH_PRO);
    if (IN(PH_MOD)) { OPQ(); phase_mod(ctx, wv, ln); }
    SEAM(PH_MOD);
    if (IN(PH_LN0)) { OPQ(); phase_h0(ctx.in(I_X), WSP(float, WS_MOD), WSP(bf16_t, WS_H), wv, ln); }
    SEAM(PH_LN0);

    for (int l = 0; l < DEPTH; ++l) {
        const int p0 = PH_L0 + l * PH_PER_LAYER;
        const size_t wto = WS_WT + (size_t)l * WT_LAYER, modo = WS_MOD + (size_t)l * NB * 6 * DM * 4;
        if (IN(p0 + 0)) { pg8::Gemm g{WSP(bf16_t, WS_H), WSP(const bf16_t, wto + WT_IN), MTOK, INP, DM}; pg8::StaticOrder S; S.init(MTOK, INP, (int)gridDim.x, (int)blockIdx.x);
            EpiProj E{WSP(bf16_t, WS_P), WSP(bf16_t, WS_UX)}; pg8::gemm_phase<EpiProj, pg8::StaticOrder, true, true>(lds, g, S, E, wave); }
        SEAM(p0 + 0);
        if (IN(p0 + 1)) {
            { pg8::Gemm g{WSP(bf16_t, WS_UX), WSP(const bf16_t, WS_S5W1 + (size_t)l * S5_W1_LAYER), 64 * 256, 64 * 256, S5K}; S5Order S{(int)gridDim.x, (int)blockIdx.x, 64, 0};
              EpiS5A E{WSP(float, WS_SLOC)}; pg8::gemm_phase<EpiS5A, S5Order, true, true>(lds, g, S, E, wave); }
            { OPQ(); phase_pre(ctx, l, wv, ln); }
            }
        SEAM(p0 + 1);
        if (IN(p0 + 2)) { OPQ(); phase_chain<0>(ctx, l, lds, wv, ln); }
        SEAM(p0 + 2);
        if (IN(p0 + 3)) {
            { pg8::Gemm g{WSP(bf16_t, WS_UX), WSP(const bf16_t, WS_S5T + (size_t)l * S5_T_LAYER), 64 * 256, 64 * 1024, S5K}; S5Order S{(int)gridDim.x, (int)blockIdx.x, 256, 2};
              EpiS5C E{WSP(bf16_t, WS_Z)}; pg8::gemm_phase<EpiS5C, S5Order, true, true>(lds, g, S, E, wave); }
            { OPQ(); phase_chain<1>(ctx, l, lds, wv, ln); } }
        SEAM(p0 + 3);
        if (IN(p0 + 4)) { pg8::Gemm g{WSP(bf16_t, WS_Z), WSP(const bf16_t, wto + WT_GLU), MTOK, S5W, S5W}; pg8::StaticOrder S; S.init(MTOK, S5W, (int)gridDim.x, (int)blockIdx.x);
            EpiGlu E{WSP(bf16_t, WS_Z), WSP(bf16_t, WS_MIXED), ctx.in(I_GLUB) + l * S5W}; pg8::gemm_phase<EpiGlu, pg8::StaticOrder, true, true>(lds, g, S, E, wave);
            { OPQ(); phase_finalize(ctx, l, wv, ln); } }
        SEAM(p0 + 4);
        if (IN(p0 + 5)) { pg8::Gemm g{WSP(bf16_t, WS_MIXED), WSP(const bf16_t, wto + WT_OUT), MTOK, DM, DM}; pg8::StaticOrder S; S.init(MTOK, DM, (int)gridDim.x, (int)blockIdx.x);
            EpiDelta E{WSP(bf16_t, WS_DELTA), WSP(float, modo) + 2 * DM};
            pg8::gemm_phase<EpiDelta, pg8::StaticOrder, true, true>(lds, g, S, E, wave); }
        SEAM(p0 + 5);
        if (IN(p0 + 6)) { OPQ(); phase_lnres<true>(l == 0 ? ctx.in(I_X) : ctx.out(), WSP(bf16_t, WS_DELTA), ctx.out(), ctx.in(I_LN1G) + l * DM, ctx.in(I_LN1B) + l * DM, WSP(float, modo), 3, 4, WSP(bf16_t, WS_H), lds, wv, ln); }
        SEAM(p0 + 6);
        if (IN(p0 + 7)) { pg8::Gemm g{WSP(bf16_t, WS_H), WSP(const bf16_t, wto + WT_GU), MTOK, 2 * DFF, DM}; pg8::StaticOrder S; S.init(MTOK, 2 * DFF, (int)gridDim.x, (int)blockIdx.x);
            EpiSwiglu E{WSP(bf16_t, WS_P)}; pg8::gemm_phase<EpiSwiglu, pg8::StaticOrder, true, true>(lds, g, S, E, wave); }
        SEAM(p0 + 7);
        if (IN(p0 + 8)) { pg8::Gemm g{WSP(bf16_t, WS_P), WSP(const bf16_t, wto + WT_DN), MTOK, DM, DFF}; pg8::StaticOrder S; S.init(MTOK, DM, (int)gridDim.x, (int)blockIdx.x);
            EpiDelta E{WSP(bf16_t, WS_DELTA), WSP(float, modo) + 5 * DM};
            pg8::gemm_phase<EpiDelta, pg8::StaticOrder, true, true>(lds, g, S, E, wave); }
        SEAM(p0 + 8);
        if (IN(p0 + 9)) { OPQ();
            if (l + 1 < DEPTH) phase_lnres<true>(ctx.out(), WSP(bf16_t, WS_DELTA), ctx.out(), ctx.in(I_LN2G) + l * DM, ctx.in(I_LN2B) + l * DM, WSP(float, modo) + (size_t)NB * 6 * DM, 0, 1, WSP(bf16_t, WS_H), lds, wv, ln);
            else phase_lnres<false>(ctx.out(), WSP(bf16_t, WS_DELTA), ctx.out(), ctx.in(I_LN2G) + l * DM, ctx.in(I_LN2B) + l * DM, nullptr, 0, 0, nullptr, lds, wv, ln);
        }
        SEAM(p0 + 9);
    }
#undef IN
#undef SEAM
#undef OPQ
#undef WSP
#undef lane
}

extern "C" void kernel_launch(void* const* d_in, const int* in_sizes, int n_in, void* d_out, int out_size, void* d_ws, size_t ws_size, hipStream_t stream) {
    static int grid = 0;
    if (grid == 0) {
        if (n_in != N_IN || out_size != MTOK * DM || ws_size < WS_END) { fprintf(stderr, "kernel_launch: unexpected problem (n_in %d, out %d, ws %zu < %zu); nothing launched\n", n_in, out_size, ws_size, (size_t)WS_END); grid = -1; return; }
        int dev = 0, cus = 0, per_cu = 0;
        if (hipGetDevice(&dev) != hipSuccess || hipDeviceGetAttribute(&cus, hipDeviceAttributeMultiprocessorCount, dev) != hipSuccess) { grid = -1; return; }
        if (hipFuncSetAttribute((const void*)hybrid_fwd, hipFuncAttributeMaxDynamicSharedMemorySize, LDS_BYTES) != hipSuccess) { fprintf(stderr, "kernel_launch: hipFuncSetAttribute failed\n"); grid = -1; return; }
        if (hipOccupancyMaxActiveBlocksPerMultiprocessor(&per_cu, (const void*)hybrid_fwd, 512, LDS_BYTES) != hipSuccess || per_cu < 1) fprintf(stderr, "kernel_launch: occupancy query reports %d blocks per CU\n", per_cu);
        (void)hipGetLastError();
        grid = cus;
    }
    if (grid < 0) return;
    (void)in_sizes;
    if (hipMemsetAsync((char*)d_ws + WS_CTL, 0, CTL_ZERO_BYTES, stream) != hipSuccess) return;
    Args a{};
    for (int i = 0; i < N_IN; ++i) a.in[i] = (const float*)d_in[i];
    a.out = (float*)d_out; a.ws = (unsigned char*)d_ws;
    a.ph_lo = 0; a.ph_hi = N_PHASES; hipLaunchKernelGGL(hybrid_fwd, dim3(grid), dim3(512), LDS_BYTES, stream, a);
}
```

```cpp
#include <hip/hip_runtime.h>
#include <cstdio>
#include <cstdint>
namespace pg8 {
#define PG8_LAS __attribute__((address_space(3)))
typedef unsigned short bf16_t;
typedef short bf16x8 __attribute__((ext_vector_type(8)));
typedef float f32x4 __attribute__((ext_vector_type(4)));
typedef unsigned u32x4 __attribute__((ext_vector_type(4)));
constexpr int BM = 256, BK = 64, HALF = 128, HTB = HALF * BK * 2  , STAGE_BYTES = 8 * HTB, NXCD = 8, WGM = 8;

__host__ __device__ __forceinline__ int lds_byte(int r, int c) { const int st = (r >> 4) * 2 + (c >> 5), rr = r & 15, cc = c & 31, ob = rr * 64 + cc * 2; return st * 1024 + (ob ^ (((ob >> 9) & 1) << 5)); }
__host__ __device__ __forceinline__ void stage_rc(int b, int& R, int& C) { const int st = b / 1024, sb = b % 1024, swz = sb ^ (((sb >> 9) & 1) << 5); R = (st >> 1) * 16 + swz / 64; C = (st & 1) * 32 + (swz % 64) / 2; }
__host__ __device__ __forceinline__ int perm32(int rho) { const int n = rho >> 4, i = rho & 15; return 8 * (i >> 2) + 4 * n + (i & 3); }

struct Unit { int pm, pn; };
struct Gemm { const bf16_t* A; const bf16_t* Bt; int M, N, K; };

struct StaticOrder {
    int nM, nN, nwg, G, c;
    __host__ __device__ void init(int M, int N, int G_, int c_) { nM = M / BM; nN = N / BM; nwg = nM * nN; G = G_; c = c_; }
    __host__ __device__ bool next(int i, Unit& u) const {
        const long L = (long)i * G + c; if (L >= nwg) return false;
        int wgid = (int)L; { const int q = nwg / NXCD, r = nwg % NXCD, xcd = wgid % NXCD, off = wgid / NXCD; wgid = (xcd < r ? xcd * (q + 1) : r * (q + 1) + (xcd - r) * q) + off; }
        const int nig = WGM * nN, gid = wgid / nig, fm = gid * WGM, gsz = (nM - fm) < WGM ? (nM - fm) : WGM;
        u.pm = fm + ((wgid % nig) % gsz); u.pn = (wgid % nig) / gsz; return true;
    }
    __device__ __forceinline__ void a_ready(const Unit&) const {}
    __device__ __forceinline__ void done(const Unit&) const {}
};
__device__ __forceinline__ unsigned cvt_pk_bf16(float lo, float hi) { unsigned r; asm volatile("v_cvt_pk_bf16_f32 %0, %1, %2" : "=v"(r) : "v"(lo), "v"(hi)); return r; }
typedef float f32x2 __attribute__((ext_vector_type(2)));
template <class Epi, class Sched, bool ALIGN_EPI = false, bool SP2 = false>
__device__ __forceinline__ void gemm_phase(PG8_LAS unsigned char* lds, const Gemm g, const Sched& S, const Epi& E, int wave_id) {
    int tid_; asm volatile("v_mbcnt_lo_u32_b32 %0, -1, 0\n\tv_mbcnt_hi_u32_b32 %0, -1, %0" : "=v"(tid_)); tid_ += wave_id * 64;
    const int tid = tid_, wid = __builtin_amdgcn_readfirstlane(tid >> 6), lane = tid & 63, wr = wid >> 2, wc = wid & 3, fr = lane & 15, fq = lane >> 4;
    const int K = g.K, nt = K / BK;
    unsigned voffA[2], voffB[2];
#pragma unroll
    for (int i = 0; i < 2; ++i) { int R, C; stage_rc(tid * 16 + i * 8192, R, C); const int Rb = Epi::PERM ? ((R & ~31) + perm32(R & 31)) : R;
        voffA[i] = (unsigned)(R * K + C) * 2u; voffB[i] = (unsigned)(Rb * K + C) * 2u; }
    const size_t kstep = (size_t)(BK * 2);
    const size_t hstep = (size_t)HALF * K * 2;
    const size_t tstep = 2 * hstep;
    const unsigned ldsw = (unsigned)wid * 1024u;
    const int aoff = lds_byte(wr * 64 + fr, fq * 8), boff = lds_byte(wc * 32 + fr, fq * 8);
#define PG8_SA(b, h) (((b) * 2 + (h)) * HTB)
#define PG8_SB(b, h) ((4 + (b) * 2 + (h)) * HTB)
#define PG8_STAGE(bufoff, gbase, voff) do { _Pragma("unroll") for (int _i = 0; _i < 2; ++_i) \
        __builtin_amdgcn_global_load_lds((const unsigned*)((const char*)(gbase) + (voff)[_i]), (PG8_LAS unsigned*)(lds + (bufoff) + ldsw + _i * 8192), 16, 0, 0); } while (0)
#define PG8_LDA(dst, b, h) do { _Pragma("unroll") for (int m = 0; m < 4; ++m) _Pragma("unroll") for (int k = 0; k < 2; ++k) dst[m][k] = *(const PG8_LAS bf16x8*)(lds + PG8_SA(b, h) + aoff + m * 2048 + k * 1024); } while (0)
#define PG8_LDB(dst, b, h) do { _Pragma("unroll") for (int n = 0; n < 2; ++n) _Pragma("unroll") for (int k = 0; k < 2; ++k) dst[n][k] = *(const PG8_LAS bf16x8*)(lds + PG8_SB(b, h) + boff + n * 2048 + k * 1024); } while (0)
#define PG8_MMA(ai, bj, At, Bt) do { __builtin_amdgcn_s_setprio(1); _Pragma("unroll") for (int m = 0; m < 4; ++m) _Pragma("unroll") for (int n = 0; n < 2; ++n) _Pragma("unroll") for (int k = 0; k < 2; ++k) \
        acc[ai][bj][m][n] = __builtin_amdgcn_mfma_f32_16x16x32_bf16(Bt[n][k], At[m][k], acc[ai][bj][m][n], 0, 0, 0); __builtin_amdgcn_s_setprio(0); } while (0)
#define PG8_WAIT_V(n) asm volatile("s_waitcnt vmcnt(" #n ")" ::: "memory")
#define PG8_WAIT_L(n) asm volatile("s_waitcnt lgkmcnt(" #n ")" ::: "memory")
#define PG8_BAR __builtin_amdgcn_s_barrier()
#define PG8_SCHED __builtin_amdgcn_sched_barrier(0)
    Unit cur, nxt; int ui = 0;
    if (!S.next(0, cur)) return;
    f32x4 acc[2][2][4][2];
#pragma unroll
    for (int a = 0; a < 2; ++a)
#pragma unroll
        for (int b = 0; b < 2; ++b)
#pragma unroll
            for (int m = 0; m < 4; ++m)
#pragma unroll
                for (int n = 0; n < 2; ++n) acc[a][b][m][n] = (f32x4){0.f, 0.f, 0.f, 0.f};
    bf16x8 At[4][2], B0[2][2], B1[2][2];
    const char* cA = (const char*)g.A + (size_t)cur.pm * tstep; const char* cB = (const char*)g.Bt + (size_t)cur.pn * tstep;
    S.a_ready(cur);
    if constexpr (SP2) {
        PG8_STAGE(PG8_SB(0, 0), cB, voffB); PG8_STAGE(PG8_SB(0, 1), cB + hstep, voffB); PG8_STAGE(PG8_SA(0, 0), cA, voffA); PG8_STAGE(PG8_SA(0, 1), cA + hstep, voffA);
        if (wr == 1) PG8_BAR;
        PG8_WAIT_V(2); PG8_BAR;
        PG8_STAGE(PG8_SB(1, 0), cB + kstep, voffB); PG8_STAGE(PG8_SA(1, 0), cA + kstep, voffA); PG8_STAGE(PG8_SB(1, 1), cB + hstep + kstep, voffB);
        PG8_WAIT_V(6); PG8_BAR;
    } else {
        PG8_STAGE(PG8_SB(0, 0), cB, voffB); PG8_STAGE(PG8_SA(0, 0), cA, voffA); PG8_STAGE(PG8_SB(0, 1), cB + hstep, voffB); PG8_STAGE(PG8_SA(0, 1), cA + hstep, voffA);
        if (wr == 1) PG8_BAR;
        PG8_WAIT_V(4); PG8_BAR;
        PG8_STAGE(PG8_SB(1, 0), cB + kstep, voffB); PG8_STAGE(PG8_SA(1, 0), cA + kstep, voffA); PG8_STAGE(PG8_SB(1, 1), cB + hstep + kstep, voffB);
        PG8_WAIT_V(6); PG8_BAR;
    }
    for (;;) {
        const bool has_next = S.next(ui + 1, nxt);
        const char* nA = has_next ? (const char*)g.A + (size_t)nxt.pm * tstep : cA; const char* nB = has_next ? (const char*)g.Bt + (size_t)nxt.pn * tstep : cB;
        for (int t = 0; t < nt; t += 2) {
            const bool last = (t == nt - 2);
            const char* a1 = cA + (size_t)(t + 1) * kstep;
            const char* a2 = last ? nA : cA + (size_t)(t + 2) * kstep; const char* b2 = last ? nB : cB + (size_t)(t + 2) * kstep;
            const char* a3 = a2 + kstep; const char* b3 = b2 + kstep;
            if (last && has_next) S.a_ready(nxt);
            if constexpr (SP2) {
            PG8_LDB(B0, 0, 0); PG8_LDB(B1, 0, 1); PG8_SCHED; PG8_LDA(At, 0, 0); PG8_STAGE(PG8_SA(1, 1), a1 + hstep, voffA);
            PG8_WAIT_V(8); PG8_WAIT_L(0); PG8_BAR; PG8_MMA(0, 0, At, B0); PG8_MMA(0, 1, At, B1); PG8_BAR; PG8_SCHED;
            PG8_LDA(At, 0, 1); PG8_STAGE(PG8_SB(0, 0), b2, voffB); PG8_STAGE(PG8_SB(0, 1), b2 + hstep, voffB); PG8_STAGE(PG8_SA(0, 0), a2, voffA);
            PG8_WAIT_V(8); PG8_WAIT_L(0); PG8_BAR; PG8_MMA(1, 0, At, B0); PG8_MMA(1, 1, At, B1); PG8_BAR; PG8_SCHED;
            PG8_LDB(B0, 1, 0); PG8_LDB(B1, 1, 1); PG8_SCHED; PG8_LDA(At, 1, 0); PG8_STAGE(PG8_SA(0, 1), a2 + hstep, voffA);
            PG8_WAIT_V(8); PG8_WAIT_L(0); PG8_BAR; PG8_MMA(0, 0, At, B0); PG8_MMA(0, 1, At, B1); PG8_BAR; PG8_SCHED;
            PG8_LDA(At, 1, 1); PG8_STAGE(PG8_SB(1, 0), b3, voffB); PG8_STAGE(PG8_SB(1, 1), b3 + hstep, voffB); PG8_STAGE(PG8_SA(1, 0), a3, voffA);
            PG8_WAIT_V(8); PG8_WAIT_L(0); PG8_BAR; PG8_MMA(1, 0, At, B0); PG8_MMA(1, 1, At, B1); PG8_BAR; PG8_SCHED;
            } else {
            PG8_LDB(B0, 0, 0); PG8_SCHED; PG8_LDA(At, 0, 0); PG8_STAGE(PG8_SA(1, 1), a1 + hstep, voffA);
            PG8_WAIT_L(8); PG8_BAR; PG8_WAIT_L(0); PG8_MMA(0, 0, At, B0); PG8_BAR; PG8_SCHED;
            PG8_LDB(B1, 0, 1); PG8_STAGE(PG8_SB(0, 0), b2, voffB);
            PG8_BAR; PG8_WAIT_L(0); PG8_MMA(0, 1, At, B1); PG8_BAR;
            PG8_LDA(At, 0, 1); PG8_STAGE(PG8_SA(0, 0), a2, voffA);
            PG8_BAR; PG8_WAIT_L(0); PG8_MMA(1, 0, At, B0); PG8_BAR; PG8_SCHED;
            PG8_STAGE(PG8_SB(0, 1), b2 + hstep, voffB);
            PG8_WAIT_V(6); PG8_BAR; PG8_MMA(1, 1, At, B1); PG8_BAR;
            PG8_LDB(B0, 1, 0); PG8_SCHED; PG8_LDA(At, 1, 0); PG8_STAGE(PG8_SA(0, 1), a2 + hstep, voffA);
            PG8_WAIT_L(8); PG8_BAR; PG8_WAIT_L(0); PG8_MMA(0, 0, At, B0); PG8_BAR; PG8_SCHED;
            PG8_LDB(B1, 1, 1); PG8_STAGE(PG8_SB(1, 0), b3, voffB);
            PG8_BAR; PG8_WAIT_L(0); PG8_MMA(0, 1, At, B1); PG8_BAR;
            PG8_LDA(At, 1, 1); PG8_STAGE(PG8_SA(1, 0), a3, voffA);
            PG8_BAR; PG8_WAIT_L(0); PG8_MMA(1, 0, At, B0); PG8_BAR; PG8_SCHED;
            PG8_STAGE(PG8_SB(1, 1), b3 + hstep, voffB);
            PG8_WAIT_V(6); PG8_BAR; PG8_MMA(1, 1, At, B1); PG8_BAR;
            }
        }
        if constexpr (ALIGN_EPI) { if (wr == 0) PG8_BAR; }
        if constexpr (!Epi::AFTER_DRAIN) { E(acc, cur, wr, wc, fr, fq); S.done(cur); }
        if (!has_next) break;
#pragma unroll
        for (int a = 0; a < 2; ++a)
#pragma unroll
            for (int b = 0; b < 2; ++b)
#pragma unroll
                for (int m = 0; m < 4; ++m)
#pragma unroll
                    for (int n = 0; n < 2; ++n) acc[a][b][m][n] = (f32x4){0.f, 0.f, 0.f, 0.f};
        cur = nxt; cA = nA; cB = nB; ++ui;
        if constexpr (ALIGN_EPI) { if (wr == 1) PG8_BAR; }
    }
    PG8_WAIT_V(0);
    if constexpr (!ALIGN_EPI) { if (wr == 0) PG8_BAR; }
    PG8_BAR;
    if constexpr (Epi::AFTER_DRAIN) { E.fused(acc, cur, wr, wc, fr, fq, lds, wid, lane); S.done(cur); }
#undef PG8_SA
#undef PG8_SB
#undef PG8_STAGE
#undef PG8_LDA
#undef PG8_LDB
#undef PG8_MMA
#undef PG8_WAIT_V
#undef PG8_WAIT_L
#undef PG8_BAR
#undef PG8_SCHED
}
}
#define LAS __attribute__((address_space(3)))
#define XB_TMO      128
#define XB_XCNT(j)  (256  + 64 * (j))
#define XB_XSUB(j)  (1280 + 64 * (j))
#define XB_XGEN(j)  (2304 + 64 * (j))
#define XB_TOP      3328
#define XB_TOPGEN   3392
#define XCD_BAR_WORDS 3456
#define XB_SPIN_CAP (1u << 24)

__device__ __forceinline__ unsigned xb_ld(unsigned* p)              { return __hip_atomic_load(p, __ATOMIC_RELAXED, __HIP_MEMORY_SCOPE_AGENT); }
__device__ __forceinline__ unsigned xb_add(unsigned* p, unsigned v) { return __hip_atomic_fetch_add(p, v, __ATOMIC_RELAXED, __HIP_MEMORY_SCOPE_AGENT); }
__device__ __forceinline__ unsigned xb_xcc_id() { return (unsigned)__builtin_amdgcn_s_getreg((3 << 11) | 20) & 0xFu; }
#define XB_SPIN(cond, bar) do { unsigned _sp = 0; while (cond) { __builtin_amdgcn_s_sleep(1); \
    if ((++_sp & 255u) == 0u) { if (xb_ld(&(bar)[XB_TMO])) break; if (_sp > XB_SPIN_CAP) { atomicAdd(&(bar)[XB_TMO], 1u); break; } } } } while (0)

struct XcdBarrier {
    unsigned* bar; unsigned x; unsigned w0;
    volatile LAS unsigned* st;
};

__device__ __forceinline__ bool xb_lane0() { return __builtin_amdgcn_mbcnt_hi(~0u, __builtin_amdgcn_mbcnt_lo(~0u, 0u)) == 0u; }
__device__ __forceinline__ XcdBarrier xcd_barrier_post(unsigned* bar, volatile LAS unsigned* st, unsigned w0) {
    XcdBarrier b; b.bar = bar; b.x = xb_xcc_id(); b.st = st; b.w0 = w0;
    if (w0 && xb_lane0()) (void)xb_add(&bar[XB_XCNT(b.x)], 1u);
    return b;
}
__device__ __forceinline__ void xcd_barrier_complete(unsigned* bar, unsigned x, unsigned& nloc, unsigned& nx) {
    const unsigned G = gridDim.x * gridDim.y * gridDim.z;
    unsigned sum, cnt, mine, sp = 0u;
    for (;;) {
        sum = 0u; cnt = 0u; mine = 0u;
#pragma unroll
        for (unsigned j = 0; j < 16; ++j) { const unsigned c = xb_ld(&bar[XB_XCNT(j)]); sum += c; cnt += (c > 0u) ? 1u : 0u; mine = (j == x) ? c : mine; }
        if (sum == G) break;
        __builtin_amdgcn_s_sleep(1);
        if ((++sp & 255u) == 0u) { if (xb_ld(&bar[XB_TMO])) break; if (sp > XB_SPIN_CAP) { atomicAdd(&bar[XB_TMO], 1u); break; } }
    }
    nloc = mine > 0u ? mine : 1u; nx = cnt > 0u ? cnt : 1u;
}

__device__ __forceinline__ void xcd_barrier(const XcdBarrier& b) {
    asm volatile("s_waitcnt vmcnt(0)" ::: "memory");
    __syncthreads();
    if (b.w0 && xb_lane0()) {
        unsigned* bar = b.bar;
        __builtin_amdgcn_s_waitcnt(0);
        unsigned nloc = b.st[0], nx = b.st[1];
        if (nloc == 0u) { xcd_barrier_complete(bar, b.x, nloc, nx); b.st[0] = nloc; b.st[1] = nx; }
        const unsigned old = xb_add(&bar[XB_XSUB(b.x)], 1u);
        const unsigned gen = old / nloc;
        if (old + 1u == (gen + 1u) * nloc) {
            __builtin_amdgcn_fence(__ATOMIC_RELEASE, "agent");
            asm volatile("s_waitcnt vmcnt(0)" ::: "memory");
            const unsigned og = xb_add(&bar[XB_TOP], 1u);
            const unsigned tg = og / nx;
            if (og + 1u == (tg + 1u) * nx) xb_add(&bar[XB_TOPGEN], 1u);
            else XB_SPIN(xb_ld(&bar[XB_TOPGEN]) == tg, bar);
            __builtin_amdgcn_fence(__ATOMIC_ACQUIRE, "agent");
            xb_add(&bar[XB_XGEN(b.x)], 1u);
            asm volatile("s_waitcnt vmcnt(0)" ::: "memory");
        } else {
            XB_SPIN(xb_ld(&bar[XB_XGEN(b.x)]) == gen, bar);
            __builtin_amdgcn_fence(__ATOMIC_ACQUIRE, "agent");
            asm volatile("s_waitcnt vmcnt(0)" ::: "memory");
        }
    }
    __syncthreads();
}

constexpr int DM = 4096, NB = 2, SEQ = 8192, MTOK = NB * SEQ, DEPTH = 4;
constexpr int S5W = 1024;
constexpr int HGW = 1536;
constexpr int GLKW = 768;
constexpr int INW = 11792, INP = 12032, DFF = 11008;
constexpr int OW = 3072;
constexpr int C_U = 0, C_QB = 1024, C_FB = 2560, C_IB = 4096, C_GB = 5632, C_QC = 7168, C_KC = 7936, C_VC = 8704, C_GC = 10240, C_LR = 11776;
constexpr float LN_EPS = 1e-5f;
constexpr float ALPHA = 1.6817928305074290861f;
constexpr float GLA_QSCALE = 0.07216878364870322f;

enum { I_X = 0, I_C, I_WADA, I_BADA, I_TABLE, I_WIN, I_WOUT, I_AREAL, I_AIMAG, I_LOGDT, I_BRE, I_BIM, I_CRE, I_CIM, I_S5D, I_GLUW, I_GLUB,
       I_LBRAW, I_HGG, I_HGB, I_WGATE, I_BGATE, I_GLG, I_WFG, I_WFU, I_WFD, I_LN1G, I_LN1B, I_LN2G, I_LN2B, N_IN };

constexpr size_t MiB = 1u << 20;
constexpr size_t WS_CTL = 0, CTL_ZERO_BYTES = 1 * MiB;
constexpr size_t WS_MOD = 1 * MiB;
constexpr size_t WS_MISC = 2 * MiB;
constexpr size_t WS_CONDPART = 12 * MiB;
constexpr size_t WS_H = 24 * MiB;
constexpr size_t WS_MIXED = WS_H + 128 * MiB;
constexpr size_t WS_Z = WS_MIXED + 128 * MiB;
constexpr size_t WS_O = WS_Z + 32 * MiB;
constexpr size_t WS_DELTA = WS_O;
constexpr size_t WS_P = WS_O + 192 * MiB;
constexpr size_t WS_WT = WS_P + 376 * MiB;
constexpr size_t WT_IN = 0, WT_OUT = 94 * MiB, WT_GU = 126 * MiB, WT_DN = 298 * MiB, WT_GLU = 384 * MiB, WT_LAYER = 386 * MiB;
constexpr size_t WS_HGB = WS_WT + DEPTH * WT_LAYER;
constexpr size_t WS_GLB = WS_HGB + 198 * MiB;
constexpr size_t WS_S5T = WS_GLB + 128 * MiB;
constexpr size_t WS_S5W1 = WS_S5T + 576 * MiB;
constexpr size_t WS_UX = WS_S5W1 + 144 * MiB;
constexpr size_t WS_SLOC = WS_UX + 36 * MiB;
constexpr size_t WS_LAM64 = WS_SLOC + 8 * MiB;
constexpr size_t WS_ST = WS_LAM64 + 1 * MiB;
constexpr size_t WS_END = WS_ST + 45 * MiB;
static_assert((size_t)INP * DM * 2 == 94 * MiB && (size_t)DM * DM * 2 == 32 * MiB && (size_t)2 * DFF * DM * 2 == 172 * MiB && (size_t)DM * DFF * 2 == 86 * MiB, "weight map");
static_assert((size_t)MTOK * INP * 2 == 376 * MiB && (size_t)MTOK * DFF * 2 <= 376 * MiB, "activation map");

constexpr int RING_BYTES = 131072;
constexpr int LDSCTL_OFF = 135168;
constexpr int LDS_BYTES = 147456;

#ifndef LAS
#define LAS __attribute__((address_space(3)))
#endif
typedef unsigned short bf16_t;
typedef float f32x4 __attribute__((ext_vector_type(4)));
typedef float f32x2 __attribute__((ext_vector_type(2)));
typedef unsigned u32x4 __attribute__((ext_vector_type(4)));
typedef unsigned u32x2 __attribute__((ext_vector_type(2)));
#define LDS_WAIT() asm volatile("s_waitcnt lgkmcnt(0)" ::: "memory")
#define VM_WAIT() asm volatile("s_waitcnt vmcnt(0)" ::: "memory")
typedef __bf16 bf16x2_t __attribute__((ext_vector_type(2)));
__device__ __forceinline__ unsigned cvt_pk_bf16(float lo, float hi) { return __builtin_bit_cast(unsigned, __builtin_convertvector((f32x2){lo, hi}, bf16x2_t)); }

__device__ __forceinline__ float bf_lo(unsigned w) { return __uint_as_float(w << 16); }
__device__ __forceinline__ float bf_hi(unsigned w) { return __uint_as_float(w & 0xffff0000u); }
__device__ __forceinline__ float bf2f(bf16_t b) { return __uint_as_float(((unsigned)b) << 16); }
__device__ __forceinline__ float wave_sum(float v) {
    v += __int_as_float(__builtin_amdgcn_mov_dpp(__float_as_int(v), 0xB1, 0xF, 0xF, true));
    v += __int_as_float(__builtin_amdgcn_mov_dpp(__float_as_int(v), 0x4E, 0xF, 0xF, true));
    v += __int_as_float(__builtin_amdgcn_mov_dpp(__float_as_int(v), 0x141, 0xF, 0xF, true));
    v += __int_as_float(__builtin_amdgcn_mov_dpp(__float_as_int(v), 0x140, 0xF, 0xF, true));
    v += __shfl_xor(v, 16); v += __shfl_xor(v, 32);
    return v;
}
__device__ __forceinline__ float sigmoidf_(float x) { return __builtin_amdgcn_rcpf(1.0f + __expf(-x)); }
__device__ __forceinline__ float gelu_tanh(float y) { const float a = 0.7978845608028654f * (y + 0.044715f * y * y * y); const float t = 1.0f - 2.0f * __builtin_amdgcn_rcpf(1.0f + __expf(2.0f * a)); return 0.5f * y * (1.0f + t); }

struct EpiProj {
    static constexpr bool PERM = true, AFTER_DRAIN = false;
    bf16_t* P; bf16_t* UX;
    __device__ __forceinline__ void operator()(const f32x4 (&acc)[2][2][4][2], const pg8::Unit& u, int wr, int wc, int fr, int fq) const {
        const int row0 = u.pm * 256 + wr * 64 + fr, col0 = u.pn * 256 + wc * 32 + 8 * fq;
        const bool s5 = u.pn < 4;
#pragma unroll
        for (int ai = 0; ai < 2; ++ai)
#pragma unroll
            for (int m = 0; m < 4; ++m) { const int row = row0 + ai * 128 + m * 16;
#pragma unroll
                for (int bj = 0; bj < 2; ++bj) { const f32x4 v0 = acc[ai][bj][m][0], v1 = acc[ai][bj][m][1]; const int col = col0 + bj * 128;
                    u32x4 w; w.x = cvt_pk_bf16(v0[0], v0[1]); w.y = cvt_pk_bf16(v0[2], v0[3]); w.z = cvt_pk_bf16(v1[0], v1[1]); w.w = cvt_pk_bf16(v1[2], v1[3]);
                    if (!s5) *(u32x4*)(P + (size_t)row * INP + col) = w;
                    else { bf16_t* ur = UX + (size_t)((col >> 4) * 256 + (row >> 6)) * 1152; *(u32x4*)(ur + (row & 63) * 16 + (col & 15)) = w;
                        if ((row & 63) == 0) { const u32x4 z = (u32x4){0u, 0u, 0u, 0u}; bf16_t* zp = ur + 1024 + ((col & 15) ? 64 : 0);
#pragma unroll
                            for (int i = 0; i < 8; ++i) *(u32x4*)(zp + 8 * i) = z; } } } }
    }
};
struct EpiSwiglu {
    static constexpr bool PERM = true, AFTER_DRAIN = false;
    bf16_t* HID;
    __device__ __forceinline__ void operator()(const f32x4 (&acc)[2][2][4][2], const pg8::Unit& u, int wr, int wc, int fr, int fq) const {
        const int row0 = u.pm * 256 + wr * 64 + fr, col0 = u.pn * 128 + wc * 32 + 8 * fq;
#pragma unroll
        for (int ai = 0; ai < 2; ++ai)
#pragma unroll
            for (int m = 0; m < 4; ++m) { bf16_t* rowp = HID + (size_t)(row0 + ai * 128 + m * 16) * DFF + col0;
                float o[8];
#pragma unroll
                for (int n = 0; n < 2; ++n)
#pragma unroll
                    for (int j = 0; j < 4; ++j) { const float g = acc[ai][0][m][n][j], up = acc[ai][1][m][n][j]; o[n * 4 + j] = g * __builtin_amdgcn_rcpf(1.0f + __expf(-g)) * up; }
                u32x4 w; w.x = cvt_pk_bf16(o[0], o[1]); w.y = cvt_pk_bf16(o[2], o[3]); w.z = cvt_pk_bf16(o[4], o[5]); w.w = cvt_pk_bf16(o[6], o[7]);
                *(u32x4*)rowp = w; }
    }
};
struct EpiGlu {
    static constexpr bool PERM = true, AFTER_DRAIN = false;
    const bf16_t* Z; bf16_t* MIXED; const float* bias;
    __device__ __forceinline__ void operator()(const f32x4 (&acc)[2][2][4][2], const pg8::Unit& u, int wr, int wc, int fr, int fq) const {
        const int row0 = u.pm * 256 + wr * 64 + fr, col0 = u.pn * 256 + wc * 32 + 8 * fq;
#pragma unroll
        for (int bj = 0; bj < 2; ++bj) {
            const f32x4 b0 = *(const f32x4*)(bias + col0 + bj * 128), b1 = *(const f32x4*)(bias + col0 + bj * 128 + 4);
#pragma unroll
            for (int ai = 0; ai < 2; ++ai)
#pragma unroll
                for (int m = 0; m < 4; ++m) { const size_t r = (size_t)(row0 + ai * 128 + m * 16);
                    const u32x4 zz = *(const u32x4*)(Z + r * S5W + col0 + bj * 128);
                    const f32x4 v0 = acc[ai][bj][m][0] + b0, v1 = acc[ai][bj][m][1] + b1;
                    u32x4 w;
                    w.x = cvt_pk_bf16(bf_lo(zz.x) * sigmoidf_(v0[0]), bf_hi(zz.x) * sigmoidf_(v0[1]));
                    w.y = cvt_pk_bf16(bf_lo(zz.y) * sigmoidf_(v0[2]), bf_hi(zz.y) * sigmoidf_(v0[3]));
                    w.z = cvt_pk_bf16(bf_lo(zz.z) * sigmoidf_(v1[0]), bf_hi(zz.z) * sigmoidf_(v1[1]));
                    w.w = cvt_pk_bf16(bf_lo(zz.w) * sigmoidf_(v1[2]), bf_hi(zz.w) * sigmoidf_(v1[3]));
                    *(u32x4*)(MIXED + r * DM + col0 + bj * 128) = w;
                    if (m & 1) asm volatile("" ::: "memory"); }
        }
    }
};
struct EpiDelta {
    static constexpr bool PERM = true, AFTER_DRAIN = false;
    bf16_t* D; const float* gate0;
    __device__ __forceinline__ void operator()(const f32x4 (&acc)[2][2][4][2], const pg8::Unit& u, int wr, int wc, int fr, int fq) const {
        const int row0 = u.pm * 256 + wr * 64 + fr, col0 = u.pn * 256 + wc * 32 + 8 * fq;
        const float* gp = gate0 + (u.pm >= 32 ? 6 * DM : 0) + col0;
        f32x4 g[2][2];
#pragma unroll
        for (int bj = 0; bj < 2; ++bj)
#pragma unroll
            for (int n = 0; n < 2; ++n) g[bj][n] = *(const f32x4*)(gp + bj * 128 + 4 * n) + 1.0f;
#pragma unroll
        for (int ai = 0; ai < 2; ++ai)
#pragma unroll
            for (int m = 0; m < 4; ++m) { bf16_t* rowp = D + (size_t)(row0 + ai * 128 + m * 16) * DM + col0;
#pragma unroll
                for (int bj = 0; bj < 2; ++bj) { const f32x4 v0 = acc[ai][bj][m][0] * g[bj][0], v1 = acc[ai][bj][m][1] * g[bj][1];
                    u32x4 w; w.x = cvt_pk_bf16(v0[0], v0[1]); w.y = cvt_pk_bf16(v0[2], v0[3]); w.z = cvt_pk_bf16(v1[0], v1[1]); w.w = cvt_pk_bf16(v1[2], v1[3]);
                    *(u32x4*)(rowp + bj * 128) = w; } }
    }
};

__device__ __forceinline__ int lane_id_v() { int r; asm volatile("v_mbcnt_lo_u32_b32 %0, -1, 0\n\tv_mbcnt_hi_u32_b32 %0, -1, %0" : "=v"(r)); return r; }
struct Args { const float* in[N_IN]; float* out; unsigned char* ws; int ph_lo, ph_hi; };
struct Ctx {
    volatile LAS unsigned long long* t;
    __device__ __forceinline__ unsigned long long ld(int i) const { const unsigned long long v = t[i];
        return ((unsigned long long)(unsigned)__builtin_amdgcn_readfirstlane((int)(v >> 32)) << 32) | (unsigned long long)(unsigned)__builtin_amdgcn_readfirstlane((int)(unsigned)v); }
    __device__ __forceinline__ const float* in(int i) const { return (const float*)ld(i); }
    __device__ __forceinline__ float* out() const { return (float*)ld(30); }
    __device__ __forceinline__ unsigned char* ws() const { return (unsigned char*)ld(31); }
};

constexpr int S5K = 1152;
constexpr size_t S5_T_LAYER = (size_t)64 * 1024 * S5K * 2, S5_W1_LAYER = (size_t)64 * 256 * S5K * 2;

struct S5Order {
    int G, c, n, sh;
    __device__ __forceinline__ bool next(int i, pg8::Unit& u) const { const int L = i * G + c; if (L >= n) return false; u.pm = L >> sh; u.pn = L; return true; }
    __device__ __forceinline__ void a_ready(const pg8::Unit&) const {}
    __device__ __forceinline__ void done(const pg8::Unit&) const {}
};
struct EpiS5A {
    static constexpr bool PERM = false, AFTER_DRAIN = false;
    float* Sloc;
    __device__ __forceinline__ void operator()(const f32x4 (&acc)[2][2][4][2], const pg8::Unit& u, int wr, int wc, int fr, int fq) const {
        const int row0 = u.pm * 256 + wr * 64 + fr, col0 = wc * 32 + 4 * fq;
#pragma unroll
        for (int ai = 0; ai < 2; ++ai)
#pragma unroll
            for (int m = 0; m < 4; ++m)
#pragma unroll
                for (int n = 0; n < 2; ++n) *(f32x4*)(Sloc + (size_t)(row0 + ai * 128 + m * 16) * 128 + col0 + n * 16) = acc[ai][0][m][n];
    }
};
struct EpiS5C {
    static constexpr bool PERM = true, AFTER_DRAIN = false;
    bf16_t* Z;
    __device__ __forceinline__ void operator()(const f32x4 (&acc)[2][2][4][2], const pg8::Unit& u, int wr, int wc, int fr, int fq) const {
        const int g = u.pm, c0 = wr * 64 + fr, cc0 = (u.pn & 3) * 256 + wc * 32 + 8 * fq;
#pragma unroll
        for (int ai = 0; ai < 2; ++ai)
#pragma unroll
            for (int m = 0; m < 4; ++m) { const int c = c0 + ai * 128 + m * 16;
#pragma unroll
                for (int bj = 0; bj < 2; ++bj) { const int cc = cc0 + bj * 128, t = cc >> 4, h0 = cc & 15;
                    const f32x4 v0 = acc[ai][bj][m][0], v1 = acc[ai][bj][m][1];
                    u32x4 w; w.x = cvt_pk_bf16(gelu_tanh(v0[0]), gelu_tanh(v0[1])); w.y = cvt_pk_bf16(gelu_tanh(v0[2]), gelu_tanh(v0[3]));
                    w.z = cvt_pk_bf16(gelu_tanh(v1[0]), gelu_tanh(v1[1])); w.w = cvt_pk_bf16(gelu_tanh(v1[2]), gelu_tanh(v1[3]));
                    *(u32x4*)(Z + (size_t)(c * 64 + t) * S5W + g * 16 + h0) = w; } }
    }
};
__device__ __forceinline__ void s5_tables_item(const Ctx& a, int lg, LAS unsigned char* lds, int wave, int lane) {
    LAS f32x2* LP = (LAS f32x2*)lds;
    LAS f32x2* BB = (LAS f32x2*)(lds + 33280);
    LAS f32x2* CC = (LAS f32x2*)(lds + 41472);
    LAS float* KT = (LAS float*)(lds + 49664);
    const int tid = wave * 64 + lane, l = lg >> 6, g = lg & 63;
    if (tid < 64) { const int p = tid;
        const double ar = (double)a.in(I_AREAL)[lg * 64 + p], ai = (double)a.in(I_AIMAG)[lg * 64 + p], dt = exp((double)a.in(I_LOGDT)[lg]);
        const double mag = exp(ar * dt), ang = ai * dt, lr = mag * cos(ang), li = mag * sin(ang);
        const double den = ar * ar + ai * ai, nr = lr - 1.0, ni = li, cr = (nr * ar + ni * ai) / den, ci = (ni * ar - nr * ai) / den;
        double pr = 1.0, pi = 0.0;
        for (int tau = 0; tau <= 64; ++tau) { LP[tau * 64 + p] = (f32x2){(float)pr, (float)pi}; const double nr2 = pr * lr - pi * li, ni2 = pr * li + pi * lr; pr = nr2; pi = ni2; }
        for (int h = 0; h < 16; ++h) { const double br = (double)a.in(I_BRE)[((size_t)lg * 64 + p) * 16 + h], bi = (double)a.in(I_BIM)[((size_t)lg * 64 + p) * 16 + h];
            BB[p * 16 + h] = (f32x2){(float)(cr * br - ci * bi), (float)(cr * bi + ci * br)}; }
    }
    for (int e = tid; e < 1024; e += 512) { const int h = e >> 6, p = e & 63; CC[e] = (f32x2){a.in(I_CRE)[((size_t)lg * 16 + h) * 64 + p], a.in(I_CIM)[((size_t)lg * 16 + h) * 64 + p]}; }
    __syncthreads();
    if (tid < 64) *(f32x2*)((float*)(a.ws() + WS_LAM64) + ((size_t)lg * 64 + tid) * 2) = LP[64 * 64 + tid];
    for (int e = tid; e < 64 * 256; e += 512) { const int tau = e >> 8, h = (e >> 4) & 15, hp = e & 15; float s = 0.f;
#pragma unroll 8
        for (int p = 0; p < 64; ++p) { const f32x2 c = CC[h * 64 + p], lm = LP[tau * 64 + p], b = BB[p * 16 + hp];
            const float xr = c.x * lm.x - c.y * lm.y, xi = c.x * lm.y + c.y * lm.x; s += xr * b.x - xi * b.y; }
        if (tau == 0 && h == hp) s += a.in(I_S5D)[l * S5W + g * 16 + h];
        KT[e] = s; }
    __syncthreads();
    bf16_t* T = (bf16_t*)(a.ws() + WS_S5T + (size_t)l * S5_T_LAYER) + (size_t)g * 1024 * S5K;
    for (int pc = tid; pc < 1024 * 144; pc += 512) { const int n = pc / 144, j = pc % 144, t = n >> 4, h = n & 15; float v[8];
        if (j < 128) { const int s = j >> 1, hp0 = (j & 1) * 8;
            if (s > t) {
#pragma unroll
                for (int i = 0; i < 8; ++i) v[i] = 0.f;
            } else { const LAS float* kp = KT + (t - s) * 256 + h * 16 + hp0; const f32x4 k0 = *(const LAS f32x4*)kp, k1 = *(const LAS f32x4*)(kp + 4);
                v[0] = k0[0]; v[1] = k0[1]; v[2] = k0[2]; v[3] = k0[3]; v[4] = k1[0]; v[5] = k1[1]; v[6] = k1[2]; v[7] = k1[3]; }
        } else { const int p0 = (j - 128) * 4;
#pragma unroll
            for (int i = 0; i < 4; ++i) { const f32x2 c = CC[h * 64 + p0 + i], lm = LP[(t + 1) * 64 + p0 + i]; v[2 * i] = c.x * lm.x - c.y * lm.y; v[2 * i + 1] = -(c.x * lm.y + c.y * lm.x); } }
        *(u32x4*)(T + (size_t)n * S5K + j * 8) = (u32x4){cvt_pk_bf16(v[0], v[1]), cvt_pk_bf16(v[2], v[3]), cvt_pk_bf16(v[4], v[5]), cvt_pk_bf16(v[6], v[7])}; }
    bf16_t* W1 = (bf16_t*)(a.ws() + WS_S5W1 + (size_t)l * S5_W1_LAYER) + (size_t)g * 256 * S5K;
    for (int pc = tid; pc < 256 * 144; pc += 512) { const int n = pc / 144, j = pc % 144; float v[8];
#pragma unroll
        for (int i = 0; i < 8; ++i) v[i] = 0.f;
        if (n < 128 && j < 128) { const int p = n >> 1, ri = n & 1, s = j >> 1, hp0 = (j & 1) * 8; const f32x2 lm = LP[(63 - s) * 64 + p];
#pragma unroll
            for (int i = 0; i < 8; ++i) { const f32x2 b = BB[p * 16 + hp0 + i]; v[i] = ri ? (lm.x * b.y + lm.y * b.x) : (lm.x * b.x - lm.y * b.y); } }
        *(u32x4*)(W1 + (size_t)n * S5K + j * 8) = (u32x4){cvt_pk_bf16(v[0], v[1]), cvt_pk_bf16(v[2], v[3]), cvt_pk_bf16(v[4], v[5]), cvt_pk_bf16(v[6], v[7])}; }
    __syncthreads();
}
__device__ __forceinline__ void s5_scan_item(const Ctx& a, int l, int item, int wave, int lane) {
    const int idx = item * 512 + wave * 64 + lane, g = idx >> 7, b = (idx >> 6) & 1, p = idx & 63;
    const f32x2 lam = *(const f32x2*)((const float*)(a.ws() + WS_LAM64) + ((size_t)(l * 64 + g) * 64 + p) * 2);
    const float* sl = (const float*)(a.ws() + WS_SLOC) + ((size_t)(g * 256 + b * 128)) * 128 + 2 * p;
    bf16_t* ux = (bf16_t*)(a.ws() + WS_UX) + ((size_t)(g * 256 + b * 128)) * S5K + 1024 + 2 * p;
    float xr = 0.f, xi = 0.f;
    for (int c0 = 0; c0 < 128; c0 += 8) { f32x2 s[8];
#pragma unroll
        for (int i = 0; i < 8; ++i) s[i] = *(const f32x2*)(sl + (size_t)(c0 + i) * 128);
#pragma unroll
        for (int i = 0; i < 8; ++i) { *(unsigned*)(ux + (size_t)(c0 + i) * S5K) = cvt_pk_bf16(xr, xi);
            const float nr = lam.x * xr - lam.y * xi + s[i].x, ni = lam.x * xi + lam.y * xr + s[i].y; xr = nr; xi = ni; } }
}

__device__ __forceinline__ void transpose_item(const float* W, int N, int k0, int n0, bf16_t* WT, int drow0, int Kd, LAS float* scr, int lane) {
    const int nl = 4 * (lane & 15), kq = lane >> 4;
    const bool valid = (n0 + nl) < N;
    f32x4 v[16];
#pragma unroll
    for (int i = 0; i < 16; ++i) { const int k = 4 * i + kq; v[i] = valid ? *(const f32x4*)(W + (size_t)(k0 + k) * N + n0 + nl) : (f32x4){0.f, 0.f, 0.f, 0.f}; }
#pragma unroll
    for (int i = 0; i < 16; ++i) { const int k = 4 * i + kq; LAS float* s = scr + k * 65 + nl; s[0] = v[i][0]; s[1] = v[i][1]; s[2] = v[i][2]; s[3] = v[i][3]; }
    LDS_WAIT();
    const int c = lane & 7;
#pragma unroll
    for (int j = 0; j < 8; ++j) { const int n = (lane >> 3) + 8 * j; const LAS float* s = scr + (8 * c) * 65 + n;
        u32x4 o; o.x = cvt_pk_bf16(s[0], s[65]); o.y = cvt_pk_bf16(s[130], s[195]); o.z = cvt_pk_bf16(s[260], s[325]); o.w = cvt_pk_bf16(s[390], s[455]);
        *(u32x4*)(WT + (size_t)(drow0 + n) * Kd + k0 + 8 * c) = o; }
    LDS_WAIT();
}
constexpr int NIT_IN = 64 * 188, NIT_OUT = 64 * 64, NIT_G = 64 * 172, NIT_DN = 172 * 64, NIT_GLU = 16 * 16;
constexpr int NIT_LAYER = NIT_IN + NIT_OUT + 2 * NIT_G + NIT_DN + NIT_GLU;
constexpr int NIT_TR = DEPTH * NIT_LAYER, NIT_COND = 64 * 96;

__device__ __forceinline__ void phase_prologue(const Ctx& a, LAS unsigned char* lds, int wave, int lane) {
    if (blockIdx.x & 1) { for (int lg = blockIdx.x; lg < DEPTH * 64; lg += gridDim.x) s5_tables_item(a, lg, lds, wave, lane); __syncthreads(); }
    LAS float* scr = (LAS float*)(lds + wave * 16640);
    const int gw = blockIdx.x * 8 + wave, NGW = gridDim.x * 8;
    for (int it = gw; it < NIT_TR + NIT_COND; it += NGW) {
        if (it < NIT_TR) {
            const int l = it / NIT_LAYER; int r = it % NIT_LAYER;
            unsigned char* wt = a.ws() + WS_WT + (size_t)l * WT_LAYER;
            if (r < NIT_IN) { const int kb = r / 188, nb = r % 188; transpose_item(a.in(I_WIN) + (size_t)l * DM * INW, INW, 64 * kb, 64 * nb, (bf16_t*)(wt + WT_IN), 64 * nb, DM, scr, lane); continue; } r -= NIT_IN;
            if (r < NIT_OUT) { const int kb = r / 64, nb = r % 64; transpose_item(a.in(I_WOUT) + (size_t)l * DM * DM, DM, 64 * kb, 64 * nb, (bf16_t*)(wt + WT_OUT), 64 * nb, DM, scr, lane); continue; } r -= NIT_OUT;
            if (r < NIT_G) { const int kb = r / 172, nb = r % 172, n0 = 64 * nb; transpose_item(a.in(I_WFG) + (size_t)l * DM * DFF, DFF, 64 * kb, n0, (bf16_t*)(wt + WT_GU), 256 * (n0 / 128) + (n0 % 128), DM, scr, lane); continue; } r -= NIT_G;
            if (r < NIT_G) { const int kb = r / 172, nb = r % 172, n0 = 64 * nb; transpose_item(a.in(I_WFU) + (size_t)l * DM * DFF, DFF, 64 * kb, n0, (bf16_t*)(wt + WT_GU), 256 * (n0 / 128) + 128 + (n0 % 128), DM, scr, lane); continue; } r -= NIT_G;
            if (r < NIT_DN) { const int kb = r / 64, nb = r % 64; transpose_item(a.in(I_WFD) + (size_t)l * DFF * DM, DM, 64 * kb, 64 * nb, (bf16_t*)(wt + WT_DN), 64 * nb, DFF, scr, lane); continue; } r -= NIT_DN;
            { const int kb = r / 16, nb = r % 16; transpose_item(a.in(I_GLUW) + (size_t)l * S5W * S5W, S5W, 64 * kb, 64 * nb, (bf16_t*)(wt + WT_GLU), 64 * nb, S5W, scr, lane); }
        } else {
            const int item = it - NIT_TR, kb = item / 96, jb = item % 96, k0 = 64 * kb, j0 = 256 * jb + 4 * lane;
            const float* c = a.in(I_C);
            float c0 = c[k0 + lane], c1 = c[DM + k0 + lane];
            c0 = c0 / (1.0f + expf(-c0)); c1 = c1 / (1.0f + expf(-c1));
            f32x4 a0 = (f32x4){0.f, 0.f, 0.f, 0.f}, a1 = a0;
            const float* w = a.in(I_WADA) + (size_t)k0 * (6 * DM) + j0;
#pragma unroll 8
            for (int kk = 0; kk < 64; ++kk) { const f32x4 wv = *(const f32x4*)(w + (size_t)kk * (6 * DM));
                const float s0 = __int_as_float(__builtin_amdgcn_readlane(__float_as_int(c0), kk)), s1 = __int_as_float(__builtin_amdgcn_readlane(__float_as_int(c1), kk));
                a0 += wv * s0; a1 += wv * s1; }
            float* cp = (float*)(a.ws() + WS_CONDPART);
            *(f32x4*)(cp + (size_t)(kb * 2 + 0) * (6 * DM) + j0) = a0;
            *(f32x4*)(cp + (size_t)(kb * 2 + 1) * (6 * DM) + j0) = a1;
        }
    }
    __syncthreads();
    if (!(blockIdx.x & 1)) { for (int lg = blockIdx.x; lg < DEPTH * 64; lg += gridDim.x) s5_tables_item(a, lg, lds, wave, lane); }
}
__device__ __forceinline__ void phase_mod(const Ctx& a, int wave, int lane) {
    const int gt = blockIdx.x * 512 + wave * 64 + lane, NT = gridDim.x * 512;
    const float* cp = (const float*)(a.ws() + WS_CONDPART);
    float* mod = (float*)(a.ws() + WS_MOD); float* misc = (float*)(a.ws() + WS_MISC);
    for (int idx = gt; idx < NB * 6 * DM; idx += NT) {
        const int b = idx / (6 * DM), j = idx % (6 * DM);
        float s = a.in(I_BADA)[j];
        for (int kb = 0; kb < 64; ++kb) s += cp[(size_t)(kb * 2 + b) * (6 * DM) + j];
        for (int l = 0; l < DEPTH; ++l) mod[(size_t)((l * 2 + b) * 6) * DM + j] = s + a.in(I_TABLE)[(size_t)l * 6 * DM + j];
    }
    for (int idx = gt; idx < DM; idx += NT) { misc[idx] = 1.0f; misc[DM + idx] = 0.0f; }
    for (int idx = gt; idx < HGW; idx += NT) {
        const float* raw = a.in(I_LBRAW); float r[DEPTH], mx = -3.0e38f;
#pragma unroll
        for (int l = 0; l < DEPTH; ++l) { r[l] = raw[l * HGW + idx]; mx = fmaxf(mx, r[l]); }
        float e[DEPTH], sum = 0.f;
#pragma unroll
        for (int l = 0; l < DEPTH; ++l) { e[l] = expf(r[l] - mx); sum += e[l]; }
        float cum = 0.f;
#pragma unroll
        for (int l = 0; l < DEPTH; ++l) { misc[2 * DM + l * HGW + idx] = cum; if (l + 1 < DEPTH) cum += e[l + 1] / sum; }
    }
}

__device__ __forceinline__ void phase_h0(const float* x, const float* modp, bf16_t* H, int wave, int lane) {
    for (int blk = blockIdx.x; blk < MTOK / 64; blk += gridDim.x) {
        const int r0 = blk * 64, b = (r0 >= SEQ) ? 1 : 0;
        f32x4 A[2], B[2];
#pragma unroll
        for (int jj = 0; jj < 2; ++jj) { const int c = 512 * wave + 256 * jj + 4 * lane; A[jj] = *(const f32x4*)(modp + (size_t)(b * 6 + 1) * DM + c) + 1.0f; B[jj] = *(const f32x4*)(modp + (size_t)(b * 6 + 0) * DM + c); }
#pragma unroll 8
        for (int rl = 0; rl < 64; ++rl) { const size_t off = (size_t)(r0 + rl) * DM + 512 * wave + 4 * lane;
#pragma unroll
            for (int jj = 0; jj < 2; ++jj) { const f32x4 v = *(const f32x4*)(x + off + 256 * jj), y = v * A[jj] + B[jj];
                u32x2 w; w.x = cvt_pk_bf16(y[0], y[1]); w.y = cvt_pk_bf16(y[2], y[3]); *(u32x2*)(H + off + 256 * jj) = w; } }
    }
}
template <bool WITH_H>
__device__ __forceinline__ void phase_lnres(const float* xprev, const bf16_t* delta, float* xout, const float* lng, const float* lnb, const float* modp, int i_shift, int i_scale, bf16_t* H,
                                            LAS unsigned char* lds, int wave, int lane) {
    LAS f32x2* red = (LAS f32x2*)lds;
    for (int blk = blockIdx.x; blk < MTOK / 64; blk += gridDim.x) {
        const int r0 = blk * 64, b = (r0 >= SEQ) ? 1 : 0;
        f32x4 G[2], Bt[2], A[2], B[2];
#pragma unroll
        for (int jj = 0; jj < 2; ++jj) { const int c = 512 * wave + 256 * jj + 4 * lane; G[jj] = *(const f32x4*)(lng + c); Bt[jj] = *(const f32x4*)(lnb + c);
            if (WITH_H) { A[jj] = *(const f32x4*)(modp + (size_t)(b * 6 + i_scale) * DM + c) + 1.0f; B[jj] = *(const f32x4*)(modp + (size_t)(b * 6 + i_shift) * DM + c); } }
        const size_t offb = (size_t)r0 * DM + 512 * wave + 4 * lane;
        f32x4 va[4][2], vb[4][2]; u32x2 da[4][2], db[4][2];
#define LN_LOAD(v_, d_, it_) do { _Pragma("unroll") for (int r = 0; r < 4; ++r) _Pragma("unroll") for (int jj = 0; jj < 2; ++jj) { \
            v_[r][jj] = *(const f32x4*)(xprev + offb + (size_t)((it_) * 4 + r) * DM + 256 * jj); d_[r][jj] = *(const u32x2*)(delta + offb + (size_t)((it_) * 4 + r) * DM + 256 * jj); } } while (0)
#define LN_STEP(v_, d_, it_) do { LAS f32x2* rb = red + ((it_) & 1) * 32; \
            _Pragma("unroll") for (int r = 0; r < 4; ++r) { float s1 = 0.f, s2 = 0.f; \
                _Pragma("unroll") for (int jj = 0; jj < 2; ++jj) { const f32x4 dd = (f32x4){bf_lo(d_[r][jj].x), bf_hi(d_[r][jj].x), bf_lo(d_[r][jj].y), bf_hi(d_[r][jj].y)}; const f32x4 y = v_[r][jj] * ALPHA + dd; v_[r][jj] = y; \
                    s1 += (y[0] + y[1]) + (y[2] + y[3]); s2 += (y[0] * y[0] + y[1] * y[1]) + (y[2] * y[2] + y[3] * y[3]); } \
                s1 = wave_sum(s1); s2 = wave_sum(s2); if (lane == 0) rb[r * 8 + wave] = (f32x2){s1, s2}; } \
            __syncthreads(); \
            _Pragma("unroll") for (int r = 0; r < 4; ++r) { float s1 = 0.f, s2 = 0.f; \
                _Pragma("unroll") for (int w = 0; w < 8; ++w) { const f32x2 p = rb[r * 8 + w]; s1 += p.x; s2 += p.y; } \
                const float mu = s1 * (1.0f / DM), rs = 1.0f / sqrtf(fmaxf(s2 * (1.0f / DM) - mu * mu, 0.f) + LN_EPS); \
                _Pragma("unroll") for (int jj = 0; jj < 2; ++jj) { const f32x4 x = ((v_[r][jj] - mu) * rs) * G[jj] + Bt[jj]; \
                    *(f32x4*)(xout + offb + (size_t)((it_) * 4 + r) * DM + 256 * jj) = x; \
                    if (WITH_H) { const f32x4 y = x * A[jj] + B[jj]; u32x2 w; w.x = cvt_pk_bf16(y[0], y[1]); w.y = cvt_pk_bf16(y[2], y[3]); *(u32x2*)(H + offb + (size_t)((it_) * 4 + r) * DM + 256 * jj) = w; } } } } while (0)
        LN_LOAD(va, da, 0);
        for (int it = 0; it < 16; it += 2) {
            LN_LOAD(vb, db, it + 1);
            LN_STEP(va, da, it);
            if (it + 2 < 16) LN_LOAD(va, da, it + 2);
            LN_STEP(vb, db, it + 1);
        }
#undef LN_LOAD
#undef LN_STEP
        __syncthreads();
    }
}

typedef short bf16x8 __attribute__((ext_vector_type(8)));
typedef short bf16x4 __attribute__((ext_vector_type(4)));
constexpr int HG_BLK = 16896, HG_OQ = 0, HG_OK = 4096, HG_OKT = 8192, HG_OVT = 12288, HG_ODL = 16384;
constexpr int GL_BLK = 32768, GL_OQ = 0, GL_OK = 6400, GL_OKT = 12800, GL_ODL = 18944, GL_SHARED = 20480, GL_OVT = 20480;
constexpr int NSUB = SEQ / 16;

__device__ __forceinline__ unsigned short f2bf1(float x) { return (unsigned short)(cvt_pk_bf16(x, x) & 0xffffu); }

__device__ __forceinline__ void pre_finish(const float (&qq)[16], const float (&kk)[16], float (&g)[16], unsigned char* blk, int oq, int ok, int okt, int odl, int rowb, int d, bool swz) {
    const int pd = (d & ~31) + 8 * ((d >> 2) & 3) + 4 * ((d >> 4) & 1) + (d & 3);
    float b = 0.f;
#pragma unroll
    for (int j = 0; j < 16; ++j) { b += g[j]; g[j] = b; }
    const float bl = b;
    unsigned kt[8];
#pragma unroll
    for (int j = 0; j < 16; j += 2) {
        float kv[2];
#pragma unroll
        for (int jj = 0; jj < 2; ++jj) { const int t = j + jj; const float bj = g[t];
            const int off = t * rowb + (swz ? ((2 * pd) ^ (t << 4)) : 2 * pd);
            const float qv = qq[t] * __expf(bj), kc = kk[t] * __expf(fminf(-bj, 80.f));
            const float qn = __int_as_float(__builtin_amdgcn_mov_dpp(__float_as_int(qv), 0xB1, 0xF, 0xF, true)), kn = __int_as_float(__builtin_amdgcn_mov_dpp(__float_as_int(kc), 0xB1, 0xF, 0xF, true));
            if ((d & 1) == 0) { *(unsigned*)(blk + oq + off) = cvt_pk_bf16(qv, qn); *(unsigned*)(blk + ok + off) = cvt_pk_bf16(kc, kn); }
            kv[jj] = kk[t] * __expf(bl - bj); }
        kt[j >> 1] = cvt_pk_bf16(kv[0], kv[1]); }
    *(u32x4*)(blk + okt + d * 32) = (u32x4){kt[0], kt[1], kt[2], kt[3]};
    *(u32x4*)(blk + okt + d * 32 + 16) = (u32x4){kt[4], kt[5], kt[6], kt[7]};
    *(float*)(blk + odl + d * 4) = __expf(bl);
}
__device__ __forceinline__ void phase_pre(const Ctx& a, int l, int wave, int lane) {
    const bf16_t* P = (const bf16_t*)(a.ws() + WS_P);
    int tid = wave * 64 + lane;
    const bool bal = gridDim.x == 256;
    const int t_lo = bal ? (blockIdx.x < 64 ? 26 * (int)blockIdx.x : 1664 + 34 * ((int)blockIdx.x - 64)) : (int)blockIdx.x;
    const int t_hi = bal ? t_lo + (blockIdx.x < 64 ? 26 : 34) : NB * NSUB * 8, t_st = bal ? 1 : (int)gridDim.x;
    for (int task = t_lo; task < t_hi; task += t_st) {
        asm volatile("" : "+v"(tid));
        const int kind = bal ? (task & 7) : ((task + (task >> 8)) & 7), bsc = task >> 3, b = bsc / NSUB, sc = bsc % NSUB;
        const size_t row0 = (size_t)b * SEQ + sc * 16;
        if (kind < 3) {
            const int ch = kind * 512 + tid, h = ch >> 7, d = ch & 127;
            const float lb = ((const float*)(a.ws() + WS_MISC))[2 * DM + l * HGW + ch];
            unsigned char* blk = a.ws() + WS_HGB + ((size_t)(b * 12 + h) * NSUB + sc) * HG_BLK;
            float g[16], qq[16], kk[16]; unsigned vv[8];
#pragma unroll
            for (int j = 0; j < 16; ++j) { const bf16_t* prow = P + (row0 + j) * INP;
                const float qin = fmaxf(bf2f(prow[C_QB + ch]), -80.f), fin = fminf(fmaxf(bf2f(prow[C_FB + ch]), -80.f), 80.f);
                const unsigned short v = prow[C_IB + ch]; if (j & 1) vv[j >> 1] |= ((unsigned)v) << 16; else vv[j >> 1] = v;
                const float e = __expf(-fin), sg = __builtin_amdgcn_rcpf(1.0f + e);
                const float f = lb + (1.0f - lb) * sg;
                g[j] = fmaxf(__logf(f), -100.f); kk[j] = (1.0f - lb) * (e * sg); qq[j] = qin * __builtin_amdgcn_rcpf(1.0f + __expf(-qin)); }
            *(u32x4*)(blk + HG_OVT + d * 32) = (u32x4){vv[0], vv[1], vv[2], vv[3]};
            *(u32x4*)(blk + HG_OVT + d * 32 + 16) = (u32x4){vv[4], vv[5], vv[6], vv[7]};
            pre_finish(qq, kk, g, blk, HG_OQ, HG_OK, HG_OKT, HG_ODL, 256, d, true);
        } else if (kind < 5) {
            if (tid < 384) {
                const int ch = (kind - 3) * 384 + tid, h = ch / 192, d = ch % 192;
                unsigned char* blk = a.ws() + WS_GLB + ((size_t)(b * 4 + h) * NSUB + sc) * GL_BLK;
                float wg[16];
#pragma unroll
                for (int r = 0; r < 16; ++r) wg[r] = a.in(I_WGATE)[((size_t)l * 16 + r) * GLKW + ch];
                const float bgv = a.in(I_BGATE)[l * GLKW + ch];
                float g[16], qq[16], kk[16];
#pragma unroll
                for (int j = 0; j < 16; ++j) { const bf16_t* prow = P + (row0 + j) * INP;
                    const u32x4 l0 = *(const u32x4*)(prow + C_LR), l1 = *(const u32x4*)(prow + C_LR + 8);
                    float x = bgv;
                    x += bf_lo(l0.x) * wg[0] + bf_hi(l0.x) * wg[1] + bf_lo(l0.y) * wg[2] + bf_hi(l0.y) * wg[3] + bf_lo(l0.z) * wg[4] + bf_hi(l0.z) * wg[5] + bf_lo(l0.w) * wg[6] + bf_hi(l0.w) * wg[7];
                    x += bf_lo(l1.x) * wg[8] + bf_hi(l1.x) * wg[9] + bf_lo(l1.y) * wg[10] + bf_hi(l1.y) * wg[11] + bf_lo(l1.z) * wg[12] + bf_hi(l1.z) * wg[13] + bf_lo(l1.w) * wg[14] + bf_hi(l1.w) * wg[15];
                    g[j] = (fminf(x, 0.f) - __logf(1.0f + __expf(-fabsf(x)))) * 0.0625f;
                    qq[j] = bf2f(prow[C_QC + ch]) * GLA_QSCALE; kk[j] = bf2f(prow[C_KC + ch]); }
                pre_finish(qq, kk, g, blk, GL_OQ, GL_OK, GL_OKT, GL_ODL, 400, d, false);
            }
        } else {
            const int ch = (kind - 5) * 512 + tid, h = ch / 384, e = ch % 384;
            unsigned char* blk = a.ws() + WS_GLB + ((size_t)(b * 4 + h) * NSUB + sc) * GL_BLK;
            unsigned vv[8];
#pragma unroll
            for (int j = 0; j < 16; ++j) { const unsigned short v = P[(row0 + j) * INP + C_VC + ch]; if (j & 1) vv[j >> 1] |= ((unsigned)v) << 16; else vv[j >> 1] = v; }
            *(u32x4*)(blk + GL_OVT + e * 32) = (u32x4){vv[0], vv[1], vv[2], vv[3]};
            *(u32x4*)(blk + GL_OVT + e * 32 + 16) = (u32x4){vv[4], vv[5], vv[6], vv[7]};
        }
    }
}

template <int DK, int MODE>
__device__ __forceinline__ void chain_sub(const LAS unsigned char* sb, f32x4 (&S)[DK / 16], float* op, int wave, int n, int q) {
    constexpr bool IS_GLA = (DK == 192);
    constexpr int NKS = DK / 32, NMB = DK / 16, ROWB = IS_GLA ? 400 : 256;
    constexpr int OQ = 0, OK = IS_GLA ? GL_OK : HG_OK, OKT = IS_GLA ? GL_OKT : HG_OKT, OVT = IS_GLA ? GL_OVT : HG_OVT, ODL = IS_GLA ? GL_ODL : HG_ODL;
    const u32x2 vfr = *(const LAS u32x2*)(sb + OVT + (16 * wave + n) * 32 + 8 * q);
    const bf16x8 vf8 = __builtin_bit_cast(bf16x8, (u32x4){vfr.x, vfr.y, 0u, 0u});
    if (MODE == 1) {
        bf16x8 qf[NKS], kf[NKS];
#pragma unroll
        for (int ks = 0; ks < NKS; ++ks) { const int c0 = 64 * ks + 16 * q, o0 = n * ROWB + (IS_GLA ? c0 : (c0 ^ (n << 4)));
            qf[ks] = __builtin_bit_cast(bf16x8, *(const LAS u32x4*)(sb + OQ + o0)); kf[ks] = __builtin_bit_cast(bf16x8, *(const LAS u32x4*)(sb + OK + o0)); }
        f32x4 ao = (f32x4){0.f, 0.f, 0.f, 0.f}, ap = ao, ao1 = ao, ap1 = ao;
#pragma unroll
        for (int ks = 0; ks < NKS; ++ks) {
            const bf16x8 sbf = __builtin_bit_cast(bf16x8, (u32x4){cvt_pk_bf16(S[2 * ks][0], S[2 * ks][1]), cvt_pk_bf16(S[2 * ks][2], S[2 * ks][3]), cvt_pk_bf16(S[2 * ks + 1][0], S[2 * ks + 1][1]), cvt_pk_bf16(S[2 * ks + 1][2], S[2 * ks + 1][3])});
            if (ks & 1) { ao1 = __builtin_amdgcn_mfma_f32_16x16x32_bf16(qf[ks], sbf, ao1, 0, 0, 0); ap1 = __builtin_amdgcn_mfma_f32_16x16x32_bf16(kf[ks], qf[ks], ap1, 0, 0, 0); }
            else { ao = __builtin_amdgcn_mfma_f32_16x16x32_bf16(qf[ks], sbf, ao, 0, 0, 0); ap = __builtin_amdgcn_mfma_f32_16x16x32_bf16(kf[ks], qf[ks], ap, 0, 0, 0); } }
        ao = ao + ao1; ap = ap + ap1;
#pragma unroll
        for (int r = 0; r < 4; ++r) if (4 * q + r > n) ap[r] = 0.f;
        const bf16x8 pa8 = __builtin_bit_cast(bf16x8, (u32x4){cvt_pk_bf16(ap[0], ap[1]), cvt_pk_bf16(ap[2], ap[3]), 0u, 0u});
        ao = __builtin_amdgcn_mfma_f32_16x16x32_bf16(pa8, vf8, ao, 0, 0, 0);
#pragma unroll
        for (int r = 0; r < 4; ++r) op[(size_t)(4 * q + r) * OW] = ao[r];
    }
#pragma unroll
    for (int mb = 0; mb < NMB; ++mb) {
        const f32x4 dl = *(const LAS f32x4*)(sb + ODL + (16 * mb + 4 * q) * 4);
        const u32x2 ktr = *(const LAS u32x2*)(sb + OKT + (16 * mb + n) * 32 + 8 * q);
        S[mb] = __builtin_amdgcn_mfma_f32_16x16x32_bf16(__builtin_bit_cast(bf16x8, (u32x4){ktr.x, ktr.y, 0u, 0u}), vf8, S[mb] * dl, 0, 0, 0); }
}
constexpr size_t ST_REC = 98304;
constexpr int NSEG_HG = 4, NSEG_GL = 6, NSEG_MAX = 6;
__device__ __forceinline__ int seg_u0(bool gla, int s) { return gla ? (s <= 2 ? 44 * s : 88 + 42 * (s - 2)) : 64 * s; }
__device__ __forceinline__ int seg_nu(bool gla, int s) { return gla ? (s < 2 ? 44 : 42) : 64; }
template <int DK, int MODE>
__device__ __forceinline__ void chain_item(const unsigned char* blk0, int vt_off, float* op0, unsigned char* st, int seg, int nunits, LAS unsigned char* lds, int wave, int lane) {
    asm volatile("" : "+v"(lane), "+s"(wave));
    constexpr bool IS_GLA = (DK == 192);
    constexpr int BLK = IS_GLA ? GL_BLK : HG_BLK, SUBB = IS_GLA ? GL_SHARED + 4096 : HG_BLK, NMB = DK / 16;
    constexpr int SH0 = MODE == 1 ? 0 : (IS_GLA ? GL_OKT : HG_OKT);
    constexpr int SH_PIECES = (MODE == 1 ? (IS_GLA ? GL_SHARED : HG_OVT) : (IS_GLA ? GL_ODL + 768 - GL_OKT : 4096)) / 16;
    constexpr int T_PIECES = IS_GLA ? 256 : (4096 + 512) / 16;
    constexpr int T_LDS = IS_GLA ? GL_OVT : HG_OVT;
    constexpr int PIECES = SH_PIECES + T_PIECES, UNITB = 2 * SUBB, NP = (2 * PIECES + 511) / 512;
    const int tid = wave * 64 + lane, n = lane & 15, q = lane >> 4;
    f32x4 S[NMB]; float dacc = 1.0f;
    constexpr int ODL_ = IS_GLA ? GL_ODL : HG_ODL;
#pragma unroll
    for (int mb = 0; mb < NMB; ++mb) S[mb] = (f32x4){0.f, 0.f, 0.f, 0.f};
    if (MODE == 1) {
        for (int s = 0; s < seg; ++s) { const unsigned char* rec = st + (size_t)s * 2 * ST_REC + (size_t)(wave * 64 + lane) * 16;
#pragma unroll
            for (int mb = 0; mb < NMB; ++mb) { const f32x4 h = *(const f32x4*)(rec + (size_t)mb * 8192), d = *(const f32x4*)(st + (size_t)s * 2 * ST_REC + ST_REC + (16 * mb + 4 * q) * 4); S[mb] = S[mb] * d + h; } }
    }
    u32x4 stgA[NP], stgB[NP];
#define CH_SRC(u, p_) (blk0 + (size_t)((u) * 2 + (p_) / PIECES) * BLK + (((p_) % PIECES) < SH_PIECES ? SH0 + ((p_) % PIECES) * 16 : (IS_GLA ? vt_off : HG_OVT) + (((p_) % PIECES) - SH_PIECES) * 16))
#define CH_DST(p_) (((p_) / PIECES) * SUBB + (((p_) % PIECES) < SH_PIECES ? SH0 + ((p_) % PIECES) * 16 : T_LDS + (((p_) % PIECES) - SH_PIECES) * 16))
#define CH_LOAD(stg, u) do { _Pragma("unroll") for (int r_ = 0; r_ < NP; ++r_) { const int p_ = r_ * 512 + tid; const bool ok_ = (NP * 512 == 2 * PIECES) || p_ < 2 * PIECES; const int pc_ = ok_ ? p_ : 0; stg[r_] = *(const u32x4*)CH_SRC(u, pc_); } } while (0)
#define CH_STORE(stg, buf) do { _Pragma("unroll") for (int r_ = 0; r_ < NP; ++r_) { const int p_ = r_ * 512 + tid; const bool ok_ = (NP * 512 == 2 * PIECES) || p_ < 2 * PIECES; const int pc_ = ok_ ? p_ : 0; \
        const int d_ = ok_ ? (buf) * UNITB + CH_DST(pc_) : 2 * UNITB + (p_ - 2 * PIECES) * 16; *(LAS u32x4*)(lds + d_) = stg[r_]; } } while (0)
#define CH_SYNC() do { asm volatile("s_waitcnt lgkmcnt(0)" ::: "memory"); __builtin_amdgcn_s_barrier(); asm volatile("" ::: "memory"); } while (0)
    CH_LOAD(stgA, 0); CH_STORE(stgA, 0);
    CH_LOAD(stgA, 1);
    CH_SYNC();
    float* op = op0 + 16 * wave + n;
    for (int u = 0; u < nunits; u += 2) {
        if (u + 2 < nunits) CH_LOAD(stgB, u + 2);
        chain_sub<DK, MODE>(lds, S, op + (size_t)(u * 32) * OW, wave, n, q);
        chain_sub<DK, MODE>(lds + SUBB, S, op + (size_t)(u * 32 + 16) * OW, wave, n, q);
        if (MODE == 0 && tid < DK) dacc *= *(const LAS float*)(lds + ODL_ + 4 * tid) * *(const LAS float*)(lds + SUBB + ODL_ + 4 * tid);
        CH_STORE(stgA, 1);
        CH_SYNC();
        if (u + 3 < nunits) CH_LOAD(stgA, u + 3);
        chain_sub<DK, MODE>(lds + UNITB, S, op + (size_t)(u * 32 + 32) * OW, wave, n, q);
        chain_sub<DK, MODE>(lds + UNITB + SUBB, S, op + (size_t)(u * 32 + 48) * OW, wave, n, q);
        if (MODE == 0 && tid < DK) dacc *= *(const LAS float*)(lds + UNITB + ODL_ + 4 * tid) * *(const LAS float*)(lds + UNITB + SUBB + ODL_ + 4 * tid);
        if (u + 2 < nunits) CH_STORE(stgB, 0);
        CH_SYNC();
    }
    if (MODE == 0) { unsigned char* rec = st + (size_t)seg * 2 * ST_REC + (size_t)(wave * 64 + lane) * 16;
#pragma unroll
        for (int mb = 0; mb < NMB; ++mb) *(f32x4*)(rec + (size_t)mb * 8192) = S[mb];
        if (tid < DK) *(float*)(st + (size_t)seg * 2 * ST_REC + ST_REC + 4 * tid) = dacc; }
#undef CH_SRC
#undef CH_DST
#undef CH_LOAD
#undef CH_STORE
#undef CH_SYNC
}

template <int MODE>
__device__ __forceinline__ void phase_chain(const Ctx& a, int l, LAS unsigned char* lds, int wave, int lane) {
    const int bx = blockIdx.x, G = gridDim.x;
    constexpr int nhg = 24 * (MODE == 0 ? NSEG_HG - 1 : NSEG_HG), nitems = nhg + 24 * (MODE == 0 ? NSEG_GL - 1 : NSEG_GL);
    for (int it = bx; it < nitems; it += G) {
        const bool gla = it >= nhg; const int j = gla ? it - nhg : it, c = j % 24, seg = j / 24, u0 = seg_u0(gla, seg), nu = seg_nu(gla, seg);
        unsigned char* st = a.ws() + WS_ST + (size_t)(gla ? 24 + c : c) * (NSEG_MAX - 1) * 2 * ST_REC;
        if (!gla) { const int b = c / 12, h = c % 12;
            chain_item<128, MODE>(a.ws() + WS_HGB + ((size_t)(b * 12 + h) * NSUB + 2 * u0) * HG_BLK, 0, (float*)(a.ws() + WS_O) + ((size_t)b * SEQ + u0 * 32) * OW + h * 128, st, seg, nu, lds, wave, lane); }
        else { const int b = c / 12, h = (c % 12) / 3, sl = c % 3;
            chain_item<192, MODE>(a.ws() + WS_GLB + ((size_t)(b * 4 + h) * NSUB + 2 * u0) * GL_BLK, GL_OVT + 4096 * sl, (float*)(a.ws() + WS_O) + ((size_t)b * SEQ + u0 * 32) * OW + HGW + h * 384 + sl * 128, st, seg, nu, lds, wave, lane); }
        __syncthreads();
    }
    if (MODE == 0) { for (int it = (G >= nitems + 16) ? bx - nitems : bx; it < 16; it += G) { if (it < 0) continue; s5_scan_item(a, l, it, wave, lane); } }
}
__device__ __forceinline__ float red16(float v) {
    v += __int_as_float(__builtin_amdgcn_mov_dpp(__float_as_int(v), 0xB1, 0xF, 0xF, true)); v += __int_as_float(__builtin_amdgcn_mov_dpp(__float_as_int(v), 0x4E, 0xF, 0xF, true));
    v += __int_as_float(__builtin_amdgcn_mov_dpp(__float_as_int(v), 0x141, 0xF, 0xF, true)); v += __int_as_float(__builtin_amdgcn_mov_dpp(__float_as_int(v), 0x140, 0xF, 0xF, true)); return v; }
__device__ __forceinline__ void phase_finalize(const Ctx& a, int l, int wave, int lane) {
    const bf16_t* P = (const bf16_t*)(a.ws() + WS_P); const float* O = (const float*)(a.ws() + WS_O); bf16_t* MX = (bf16_t*)(a.ws() + WS_MIXED);
    const float* hgg = a.in(I_HGG) + l * HGW; const float* hgb = a.in(I_HGB) + l * HGW; const float* glg = a.in(I_GLG) + l * HGW;
    const int gw = blockIdx.x * 8 + wave, NGW = gridDim.x * 8;
    for (int row = gw; row < MTOK; row += NGW) {
        const float* orow = O + (size_t)row * OW; const bf16_t* prow = P + (size_t)row * INP; bf16_t* mrow = MX + (size_t)row * DM;
#pragma unroll
        for (int it = 0; it < 3; ++it) { const int c = (it * 4 + (lane >> 4)) * 128 + (lane & 15) * 8;
            const f32x4 o0 = *(const f32x4*)(orow + c), o1 = *(const f32x4*)(orow + c + 4); const u32x4 gg = *(const u32x4*)(prow + C_GB + c);
            float v[8] = {sigmoidf_(bf_lo(gg.x)) * o0[0], sigmoidf_(bf_hi(gg.x)) * o0[1], sigmoidf_(bf_lo(gg.y)) * o0[2], sigmoidf_(bf_hi(gg.y)) * o0[3],
                          sigmoidf_(bf_lo(gg.z)) * o1[0], sigmoidf_(bf_hi(gg.z)) * o1[1], sigmoidf_(bf_lo(gg.w)) * o1[2], sigmoidf_(bf_hi(gg.w)) * o1[3]};
            float s = 0.f, ss = 0.f;
#pragma unroll
            for (int i = 0; i < 8; ++i) { s += v[i]; ss += v[i] * v[i]; }
            s = red16(s); ss = red16(ss);
            const float mu = s * (1.0f / 128.0f), rs = 1.0f / sqrtf(fmaxf(ss * (1.0f / 128.0f) - mu * mu, 0.f) + LN_EPS);
            const f32x4 g0 = *(const f32x4*)(hgg + c), g1 = *(const f32x4*)(hgg + c + 4), b0 = *(const f32x4*)(hgb + c), b1 = *(const f32x4*)(hgb + c + 4);
            u32x4 w; w.x = cvt_pk_bf16((v[0] - mu) * rs * g0[0] + b0[0], (v[1] - mu) * rs * g0[1] + b0[1]); w.y = cvt_pk_bf16((v[2] - mu) * rs * g0[2] + b0[2], (v[3] - mu) * rs * g0[3] + b0[3]);
            w.z = cvt_pk_bf16((v[4] - mu) * rs * g1[0] + b1[0], (v[5] - mu) * rs * g1[1] + b1[1]); w.w = cvt_pk_bf16((v[6] - mu) * rs * g1[2] + b1[2], (v[7] - mu) * rs * g1[3] + b1[3]);
            *(u32x4*)(mrow + S5W + c) = w; }
#pragma unroll
        for (int h = 0; h < 4; ++h) { const int c = h * 384 + lane * 8; const bool act = lane < 48;
            f32x4 o0 = (f32x4){0.f, 0.f, 0.f, 0.f}, o1 = o0; u32x4 gg = (u32x4){0u, 0u, 0u, 0u};
            if (act) { o0 = *(const f32x4*)(orow + HGW + c); o1 = *(const f32x4*)(orow + HGW + c + 4); gg = *(const u32x4*)(prow + C_GC + c); }
            const float ss = wave_sum((o0[0] * o0[0] + o0[1] * o0[1]) + (o0[2] * o0[2] + o0[3] * o0[3]) + (o1[0] * o1[0] + o1[1] * o1[1]) + (o1[2] * o1[2] + o1[3] * o1[3]));
            const float rms = 1.0f / sqrtf(ss * (1.0f / 384.0f) + LN_EPS);
            if (act) { const f32x4 g0 = *(const f32x4*)(glg + c), g1 = *(const f32x4*)(glg + c + 4);
                const float z[8] = {bf_lo(gg.x), bf_hi(gg.x), bf_lo(gg.y), bf_hi(gg.y), bf_lo(gg.z), bf_hi(gg.z), bf_lo(gg.w), bf_hi(gg.w)};
                u32x4 w; w.x = cvt_pk_bf16(o0[0] * rms * g0[0] * (z[0] * sigmoidf_(z[0])), o0[1] * rms * g0[1] * (z[1] * sigmoidf_(z[1])));
                w.y = cvt_pk_bf16(o0[2] * rms * g0[2] * (z[2] * sigmoidf_(z[2])), o0[3] * rms * g0[3] * (z[3] * sigmoidf_(z[3])));
                w.z = cvt_pk_bf16(o1[0] * rms * g1[0] * (z[4] * sigmoidf_(z[4])), o1[1] * rms * g1[1] * (z[5] * sigmoidf_(z[5])));
                w.w = cvt_pk_bf16(o1[2] * rms * g1[2] * (z[6] * sigmoidf_(z[6])), o1[3] * rms * g1[3] * (z[7] * sigmoidf_(z[7])));
                *(u32x4*)(mrow + S5W + HGW + c) = w; } }
    }
}

constexpr int PH_PRO = 0, PH_MOD = 1, PH_LN0 = 2, PH_L0 = 3, PH_PER_LAYER = 10, N_PHASES = PH_L0 + DEPTH * PH_PER_LAYER;
constexpr int CW_BAR = 4096;

__global__ void __launch_bounds__(512, 2) hybrid_fwd(Args args) {
    extern __shared__ __attribute__((aligned(16))) unsigned char lds_raw[];
    LAS unsigned char* lds = (LAS unsigned char*)lds_raw;
    const int wave = __builtin_amdgcn_readfirstlane((int)threadIdx.x >> 6);
#define lane lane_id_v()
    volatile LAS unsigned* MISC = (volatile LAS unsigned*)(lds + LDSCTL_OFF);
    Ctx ctx; ctx.t = (volatile LAS unsigned long long*)(lds + LDSCTL_OFF + 64);
    if (wave == 0) { const int ln_ = lane; unsigned long long v = 0ull;
#pragma unroll
        for (int i = 0; i < N_IN; ++i) v = (ln_ == i) ? (unsigned long long)args.in[i] : v;
        v = (ln_ == 30) ? (unsigned long long)args.out : v; v = (ln_ == 31) ? (unsigned long long)args.ws : v;
        if (ln_ < 32) ctx.t[ln_] = v;
        if (ln_ < 16) MISC[ln_] = 0u; }
    __syncthreads();
    const int lo = args.ph_lo, hi = args.ph_hi;
    XcdBarrier bar; bar.bar = (unsigned*)(ctx.ws() + WS_CTL) + CW_BAR; bar.x = 0; bar.st = nullptr; bar.w0 = (wave == 0) ? 1u : 0u;
    if (hi - lo > 1) bar = xcd_barrier_post((unsigned*)(ctx.ws() + WS_CTL) + CW_BAR, MISC + 8, (wave == 0) ? 1u : 0u);
#define IN(k) (lo <= (k) && (k) < hi)
#define OPQ() int ln = lane, wv = wave; asm volatile("" : "+s"(wv))
#define SEAM(k) do { if (IN(k) && IN((k) + 1)) xcd_barrier(bar); } while (0)
#define WSP(T, off) ((T*)(ctx.ws() + (off)))

    if (IN(PH_PRO)) { OPQ(); phase_prologue(ctx, lds, wv, ln); }
    SEAM(PH_PRO);
    if (IN(PH_MOD)) { OPQ(); phase_mod(ctx, wv, ln); }
    SEAM(PH_MOD);
    if (IN(PH_LN0)) { OPQ(); phase_h0(ctx.in(I_X), WSP(float, WS_MOD), WSP(bf16_t, WS_H), wv, ln); }
    SEAM(PH_LN0);

    for (int l = 0; l < DEPTH; ++l) {
        const int p0 = PH_L0 + l * PH_PER_LAYER;
        const size_t wto = WS_WT + (size_t)l * WT_LAYER, modo = WS_MOD + (size_t)l * NB * 6 * DM * 4;
        if (IN(p0 + 0)) { pg8::Gemm g{WSP(bf16_t, WS_H), WSP(const bf16_t, wto + WT_IN), MTOK, INP, DM}; pg8::StaticOrder S; S.init(MTOK, INP, (int)gridDim.x, (int)blockIdx.x);
            EpiProj E{WSP(bf16_t, WS_P), WSP(bf16_t, WS_UX)}; pg8::gemm_phase<EpiProj, pg8::StaticOrder, true, true>(lds, g, S, E, wave); }
        SEAM(p0 + 0);
        if (IN(p0 + 1)) {
            { pg8::Gemm g{WSP(bf16_t, WS_UX), WSP(const bf16_t, WS_S5W1 + (size_t)l * S5_W1_LAYER), 64 * 256, 64 * 256, S5K}; S5Order S{(int)gridDim.x, (int)blockIdx.x, 64, 0};
              EpiS5A E{WSP(float, WS_SLOC)}; pg8::gemm_phase<EpiS5A, S5Order, true, true>(lds, g, S, E, wave); }
            { OPQ(); phase_pre(ctx, l, wv, ln); }
            }
        SEAM(p0 + 1);
        if (IN(p0 + 2)) { OPQ(); phase_chain<0>(ctx, l, lds, wv, ln); }
        SEAM(p0 + 2);
        if (IN(p0 + 3)) {
            { pg8::Gemm g{WSP(bf16_t, WS_UX), WSP(const bf16_t, WS_S5T + (size_t)l * S5_T_LAYER), 64 * 256, 64 * 1024, S5K}; S5Order S{(int)gridDim.x, (int)blockIdx.x, 256, 2};
              EpiS5C E{WSP(bf16_t, WS_Z)}; pg8::gemm_phase<EpiS5C, S5Order, true, true>(lds, g, S, E, wave); }
            { OPQ(); phase_chain<1>(ctx, l, lds, wv, ln); } }
        SEAM(p0 + 3);
        if (IN(p0 + 4)) { pg8::Gemm g{WSP(bf16_t, WS_Z), WSP(const bf16_t, wto + WT_GLU), MTOK, S5W, S5W}; pg8::StaticOrder S; S.init(MTOK, S5W, (int)gridDim.x, (int)blockIdx.x);
            EpiGlu E{WSP(bf16_t, WS_Z), WSP(bf16_t, WS_MIXED), ctx.in(I_GLUB) + l * S5W}; pg8::gemm_phase<EpiGlu, pg8::StaticOrder, true, true>(lds, g, S, E, wave);
            { OPQ(); phase_finalize(ctx, l, wv, ln); } }
        SEAM(p0 + 4);
        if (IN(p0 + 5)) { pg8::Gemm g{WSP(bf16_t, WS_MIXED), WSP(const bf16_t, wto + WT_OUT), MTOK, DM, DM}; pg8::StaticOrder S; S.init(MTOK, DM, (int)gridDim.x, (int)blockIdx.x);
            EpiDelta E{WSP(bf16_t, WS_DELTA), WSP(float, modo) + 2 * DM};
            pg8::gemm_phase<EpiDelta, pg8::StaticOrder, true, true>(lds, g, S, E, wave); }
        SEAM(p0 + 5);
        if (IN(p0 + 6)) { OPQ(); phase_lnres<true>(l == 0 ? ctx.in(I_X) : ctx.out(), WSP(bf16_t, WS_DELTA), ctx.out(), ctx.in(I_LN1G) + l * DM, ctx.in(I_LN1B) + l * DM, WSP(float, modo), 3, 4, WSP(bf16_t, WS_H), lds, wv, ln); }
        SEAM(p0 + 6);
        if (IN(p0 + 7)) { pg8::Gemm g{WSP(bf16_t, WS_H), WSP(const bf16_t, wto + WT_GU), MTOK, 2 * DFF, DM}; pg8::StaticOrder S; S.init(MTOK, 2 * DFF, (int)gridDim.x, (int)blockIdx.x);
            EpiSwiglu E{WSP(bf16_t, WS_P)}; pg8::gemm_phase<EpiSwiglu, pg8::StaticOrder, true, true>(lds, g, S, E, wave); }
        SEAM(p0 + 7);
        if (IN(p0 + 8)) { pg8::Gemm g{WSP(bf16_t, WS_P), WSP(const bf16_t, wto + WT_DN), MTOK, DM, DFF}; pg8::StaticOrder S; S.init(MTOK, DM, (int)gridDim.x, (int)blockIdx.x);
            EpiDelta E{WSP(bf16_t, WS_DELTA), WSP(float, modo) + 5 * DM};
            pg8::gemm_phase<EpiDelta, pg8::StaticOrder, true, true>(lds, g, S, E, wave); }
        SEAM(p0 + 8);
        if (IN(p0 + 9)) { OPQ();
            if (l + 1 < DEPTH) phase_lnres<true>(ctx.out(), WSP(bf16_t, WS_DELTA), ctx.out(), ctx.in(I_LN2G) + l * DM, ctx.in(I_LN2B) + l * DM, WSP(float, modo) + (size_t)NB * 6 * DM, 0, 1, WSP(bf16_t, WS_H), lds, wv, ln);
            else phase_lnres<false>(ctx.out(), WSP(bf16_t, WS_DELTA), ctx.out(), ctx.in(I_LN2G) + l * DM, ctx.in(I_LN2B) + l * DM, nullptr, 0, 0, nullptr, lds, wv, ln);
        }
        SEAM(p0 + 9);
    }
#undef IN
#undef SEAM
#undef OPQ
#undef WSP
#undef lane
}

extern "C" void kernel_launch(void* const* d_in, const int* in_sizes, int n_in, void* d_out, int out_size, void* d_ws, size_t ws_size, hipStream_t stream) {
    static int grid = 0;
    if (grid == 0) {
        if (n_in != N_IN || out_size != MTOK * DM || ws_size < WS_END) { fprintf(stderr, "kernel_launch: unexpected problem (n_in %d, out %d, ws %zu < %zu); nothing launched\n", n_in, out_size, ws_size, (size_t)WS_END); grid = -1; return; }
        int dev = 0, cus = 0, per_cu = 0;
        if (hipGetDevice(&dev) != hipSuccess || hipDeviceGetAttribute(&cus, hipDeviceAttributeMultiprocessorCount, dev) != hipSuccess) { grid = -1; return; }
        if (hipFuncSetAttribute((const void*)hybrid_fwd, hipFuncAttributeMaxDynamicSharedMemorySize, LDS_BYTES) != hipSuccess) { fprintf(stderr, "kernel_launch: hipFuncSetAttribute failed\n"); grid = -1; return; }
        if (hipOccupancyMaxActiveBlocksPerMultiprocessor(&per_cu, (const void*)hybrid_fwd, 512, LDS_BYTES) != hipSuccess || per_cu < 1) fprintf(stderr, "kernel_launch: occupancy query reports %d blocks per CU\n", per_cu);
        (void)hipGetLastError();
        grid = cus;
    }
    if (grid < 0) return;
    (void)in_sizes;
    if (hipMemsetAsync((char*)d_ws + WS_CTL, 0, CTL_ZERO_BYTES, stream) != hipSuccess) return;
    Args a{};
    for (int i = 0; i < N_IN; ++i) a.in[i] = (const float*)d_in[i];
    a.out = (float*)d_out; a.ws = (unsigned char*)d_ws;
    a.ph_lo = 0; a.ph_hi = N_PHASES; hipLaunchKernelGGL(hybrid_fwd, dim3(grid), dim3(512), LDS_BYTES, stream, a);
}
```

```cpp
#include <hip/hip_runtime.h>
#include <cstdio>
#include <cstdint>
namespace pg8 {
#define PG8_LAS __attribute__((address_space(3)))
typedef unsigned short bf16_t;
typedef short bf16x8 __attribute__((ext_vector_type(8)));
typedef float f32x4 __attribute__((ext_vector_type(4)));
typedef unsigned u32x4 __attribute__((ext_vector_type(4)));
constexpr int BM = 256, BK = 64, HALF = 128, HTB = HALF * BK * 2  , STAGE_BYTES = 8 * HTB, NXCD = 8, WGM = 8;

__host__ __device__ __forceinline__ int lds_byte(int r, int c) { const int st = (r >> 4) * 2 + (c >> 5), rr = r & 15, cc = c & 31, ob = rr * 64 + cc * 2; return st * 1024 + (ob ^ (((ob >> 9) & 1) << 5)); }
__host__ __device__ __forceinline__ void stage_rc(int b, int& R, int& C) { const int st = b / 1024, sb = b % 1024, swz = sb ^ (((sb >> 9) & 1) << 5); R = (st >> 1) * 16 + swz / 64; C = (st & 1) * 32 + (swz % 64) / 2; }
__host__ __device__ __forceinline__ int perm32(int rho) { const int n = rho >> 4, i = rho & 15; return 8 * (i >> 2) + 4 * n + (i & 3); }

struct Unit { int pm, pn; };
struct Gemm { const bf16_t* A; const bf16_t* Bt; int M, N, K; };

struct StaticOrder {
    int nM, nN, nwg, G, c;
    __host__ __device__ void init(int M, int N, int G_, int c_) { nM = M / BM; nN = N / BM; nwg = nM * nN; G = G_; c = c_; }
    __host__ __device__ bool next(int i, Unit& u) const {
        const long L = (long)i * G + c; if (L >= nwg) return false;
        int wgid = (int)L; { const int q = nwg / NXCD, r = nwg % NXCD, xcd = wgid % NXCD, off = wgid / NXCD; wgid = (xcd < r ? xcd * (q + 1) : r * (q + 1) + (xcd - r) * q) + off; }
        const int nig = WGM * nN, gid = wgid / nig, fm = gid * WGM, gsz = (nM - fm) < WGM ? (nM - fm) : WGM;
        u.pm = fm + ((wgid % nig) % gsz); u.pn = (wgid % nig) / gsz; return true;
    }
    __device__ __forceinline__ void a_ready(const Unit&) const {}
    __device__ __forceinline__ void done(const Unit&) const {}
};
__device__ __forceinline__ unsigned cvt_pk_bf16(float lo, float hi) { unsigned r; asm volatile("v_cvt_pk_bf16_f32 %0, %1, %2" : "=v"(r) : "v"(lo), "v"(hi)); return r; }
typedef float f32x2 __attribute__((ext_vector_type(2)));
template <class Epi, class Sched, bool ALIGN_EPI = false, bool SP2 = false>
__device__ __forceinline__ void gemm_phase(PG8_LAS unsigned char* lds, const Gemm g, const Sched& S, const Epi& E, int wave_id) {
    int tid_; asm volatile("v_mbcnt_lo_u32_b32 %0, -1, 0\n\tv_mbcnt_hi_u32_b32 %0, -1, %0" : "=v"(tid_)); tid_ += wave_id * 64;
    const int tid = tid_, wid = __builtin_amdgcn_readfirstlane(tid >> 6), lane = tid & 63, wr = wid >> 2, wc = wid & 3, fr = lane & 15, fq = lane >> 4;
    const int K = g.K, nt = K / BK;
    unsigned voffA[2], voffB[2];
#pragma unroll
    for (int i = 0; i < 2; ++i) { int R, C; stage_rc(tid * 16 + i * 8192, R, C); const int Rb = Epi::PERM ? ((R & ~31) + perm32(R & 31)) : R;
        voffA[i] = (unsigned)(R * K + C) * 2u; voffB[i] = (unsigned)(Rb * K + C) * 2u; }
    const size_t kstep = (size_t)(BK * 2);
    const size_t hstep = (size_t)HALF * K * 2;
    const size_t tstep = 2 * hstep;
    const unsigned ldsw = (unsigned)wid * 1024u;
    const int aoff = lds_byte(wr * 64 + fr, fq * 8), boff = lds_byte(wc * 32 + fr, fq * 8);
#define PG8_SA(b, h) (((b) * 2 + (h)) * HTB)
#define PG8_SB(b, h) ((4 + (b) * 2 + (h)) * HTB)
#define PG8_STAGE(bufoff, gbase, voff) do { _Pragma("unroll") for (int _i = 0; _i < 2; ++_i) \
        __builtin_amdgcn_global_load_lds((const unsigned*)((const char*)(gbase) + (voff)[_i]), (PG8_LAS unsigned*)(lds + (bufoff) + ldsw + _i * 8192), 16, 0, 0); } while (0)
#define PG8_LDA(dst, b, h) do { _Pragma("unroll") for (int m = 0; m < 4; ++m) _Pragma("unroll") for (int k = 0; k < 2; ++k) dst[m][k] = *(const PG8_LAS bf16x8*)(lds + PG8_SA(b, h) + aoff + m * 2048 + k * 1024); } while (0)
#define PG8_LDB(dst, b, h) do { _Pragma("unroll") for (int n = 0; n < 2; ++n) _Pragma("unroll") for (int k = 0; k < 2; ++k) dst[n][k] = *(const PG8_LAS bf16x8*)(lds + PG8_SB(b, h) + boff + n * 2048 + k * 1024); } while (0)
#define PG8_MMA(ai, bj, At, Bt) do { __builtin_amdgcn_s_setprio(1); _Pragma("unroll") for (int m = 0; m < 4; ++m) _Pragma("unroll") for (int n = 0; n < 2; ++n) _Pragma("unroll") for (int k = 0; k < 2; ++k) \
        acc[ai][bj][m][n] = __builtin_amdgcn_mfma_f32_16x16x32_bf16(Bt[n][k], At[m][k], acc[ai][bj][m][n], 0, 0, 0); __builtin_amdgcn_s_setprio(0); } while (0)
#define PG8_WAIT_V(n) asm volatile("s_waitcnt vmcnt(" #n ")" ::: "memory")
#define PG8_WAIT_L(n) asm volatile("s_waitcnt lgkmcnt(" #n ")" ::: "memory")
#define PG8_BAR __builtin_amdgcn_s_barrier()
#define PG8_SCHED __builtin_amdgcn_sched_barrier(0)
    Unit cur, nxt; int ui = 0;
    if (!S.next(0, cur)) return;
    f32x4 acc[2][2][4][2];
#pragma unroll
    for (int a = 0; a < 2; ++a)
#pragma unroll
        for (int b = 0; b < 2; ++b)
#pragma unroll
            for (int m = 0; m < 4; ++m)
#pragma unroll
                for (int n = 0; n < 2; ++n) acc[a][b][m][n] = (f32x4){0.f, 0.f, 0.f, 0.f};
    bf16x8 At[4][2], B0[2][2], B1[2][2];
    const char* cA = (const char*)g.A + (size_t)cur.pm * tstep; const char* cB = (const char*)g.Bt + (size_t)cur.pn * tstep;
    S.a_ready(cur);
    if constexpr (SP2) {
        PG8_STAGE(PG8_SB(0, 0), cB, voffB); PG8_STAGE(PG8_SB(0, 1), cB + hstep, voffB); PG8_STAGE(PG8_SA(0, 0), cA, voffA); PG8_STAGE(PG8_SA(0, 1), cA + hstep, voffA);
        if (wr == 1) PG8_BAR;
        PG8_WAIT_V(2); PG8_BAR;
        PG8_STAGE(PG8_SB(1, 0), cB + kstep, voffB); PG8_STAGE(PG8_SA(1, 0), cA + kstep, voffA); PG8_STAGE(PG8_SB(1, 1), cB + hstep + kstep, voffB);
        PG8_WAIT_V(6); PG8_BAR;
    } else {
        PG8_STAGE(PG8_SB(0, 0), cB, voffB); PG8_STAGE(PG8_SA(0, 0), cA, voffA); PG8_STAGE(PG8_SB(0, 1), cB + hstep, voffB); PG8_STAGE(PG8_SA(0, 1), cA + hstep, voffA);
        if (wr == 1) PG8_BAR;
        PG8_WAIT_V(4); PG8_BAR;
        PG8_STAGE(PG8_SB(1, 0), cB + kstep, voffB); PG8_STAGE(PG8_SA(1, 0), cA + kstep, voffA); PG8_STAGE(PG8_SB(1, 1), cB + hstep + kstep, voffB);
        PG8_WAIT_V(6); PG8_BAR;
    }
    for (;;) {
        const bool has_next = S.next(ui + 1, nxt);
        const char* nA = has_next ? (const char*)g.A + (size_t)nxt.pm * tstep : cA; const char* nB = has_next ? (const char*)g.Bt + (size_t)nxt.pn * tstep : cB;
        for (int t = 0; t < nt; t += 2) {
            const bool last = (t == nt - 2);
            const char* a1 = cA + (size_t)(t + 1) * kstep;
            const char* a2 = last ? nA : cA + (size_t)(t + 2) * kstep; const char* b2 = last ? nB : cB + (size_t)(t + 2) * kstep;
            const char* a3 = a2 + kstep; const char* b3 = b2 + kstep;
            if (last && has_next) S.a_ready(nxt);
            if constexpr (SP2) {
            PG8_LDB(B0, 0, 0); PG8_LDB(B1, 0, 1); PG8_SCHED; PG8_LDA(At, 0, 0); PG8_STAGE(PG8_SA(1, 1), a1 + hstep, voffA);
            PG8_WAIT_V(8); PG8_WAIT_L(0); PG8_BAR; PG8_MMA(0, 0, At, B0); PG8_MMA(0, 1, At, B1); PG8_BAR; PG8_SCHED;
            PG8_LDA(At, 0, 1); PG8_STAGE(PG8_SB(0, 0), b2, voffB); PG8_STAGE(PG8_SB(0, 1), b2 + hstep, voffB); PG8_STAGE(PG8_SA(0, 0), a2, voffA);
            PG8_WAIT_V(8); PG8_WAIT_L(0); PG8_BAR; PG8_MMA(1, 0, At, B0); PG8_MMA(1, 1, At, B1); PG8_BAR; PG8_SCHED;
            PG8_LDB(B0, 1, 0); PG8_LDB(B1, 1, 1); PG8_SCHED; PG8_LDA(At, 1, 0); PG8_STAGE(PG8_SA(0, 1), a2 + hstep, voffA);
            PG8_WAIT_V(8); PG8_WAIT_L(0); PG8_BAR; PG8_MMA(0, 0, At, B0); PG8_MMA(0, 1, At, B1); PG8_BAR; PG8_SCHED;
            PG8_LDA(At, 1, 1); PG8_STAGE(PG8_SB(1, 0), b3, voffB); PG8_STAGE(PG8_SB(1, 1), b3 + hstep, voffB); PG8_STAGE(PG8_SA(1, 0), a3, voffA);
            PG8_WAIT_V(8); PG8_WAIT_L(0); PG8_BAR; PG8_MMA(1, 0, At, B0); PG8_MMA(1, 1, At, B1); PG8_BAR; PG8_SCHED;
            } else {
            PG8_LDB(B0, 0, 0); PG8_SCHED; PG8_LDA(At, 0, 0); PG8_STAGE(PG8_SA(1, 1), a1 + hstep, voffA);
            PG8_WAIT_L(8); PG8_BAR; PG8_WAIT_L(0); PG8_MMA(0, 0, At, B0); PG8_BAR; PG8_SCHED;
            PG8_LDB(B1, 0, 1); PG8_STAGE(PG8_SB(0, 0), b2, voffB);
            PG8_BAR; PG8_WAIT_L(0); PG8_MMA(0, 1, At, B1); PG8_BAR;
            PG8_LDA(At, 0, 1); PG8_STAGE(PG8_SA(0, 0), a2, voffA);
            PG8_BAR; PG8_WAIT_L(0); PG8_MMA(1, 0, At, B0); PG8_BAR; PG8_SCHED;
            PG8_STAGE(PG8_SB(0, 1), b2 + hstep, voffB);
            PG8_WAIT_V(6); PG8_BAR; PG8_MMA(1, 1, At, B1); PG8_BAR;
            PG8_LDB(B0, 1, 0); PG8_SCHED; PG8_LDA(At, 1, 0); PG8_STAGE(PG8_SA(0, 1), a2 + hstep, voffA);
            PG8_WAIT_L(8); PG8_BAR; PG8_WAIT_L(0); PG8_MMA(0, 0, At, B0); PG8_BAR; PG8_SCHED;
            PG8_LDB(B1, 1, 1); PG8_STAGE(PG8_SB(1, 0), b3, voffB);
            PG8_BAR; PG8_WAIT_L(0); PG8_MMA(0, 1, At, B1); PG8_BAR;
            PG8_LDA(At, 1, 1); PG8_STAGE(PG8_SA(1, 0), a3, voffA);
            PG8_BAR; PG8_WAIT_L(0); PG8_MMA(1, 0, At, B0); PG8_BAR; PG8_SCHED;
            PG8_STAGE(PG8_SB(1, 1), b3 + hstep, voffB);
            PG8_WAIT_V(6); PG8_BAR; PG8_MMA(1, 1, At, B1); PG8_BAR;
            }
        }
        if constexpr (ALIGN_EPI) { if (wr == 0) PG8_BAR; }
        if constexpr (!Epi::AFTER_DRAIN) { E(acc, cur, wr, wc, fr, fq); S.done(cur); }
        if (!has_next) break;
#pragma unroll
        for (int a = 0; a < 2; ++a)
#pragma unroll
            for (int b = 0; b < 2; ++b)
#pragma unroll
                for (int m = 0; m < 4; ++m)
#pragma unroll
                    for (int n = 0; n < 2; ++n) acc[a][b][m][n] = (f32x4){0.f, 0.f, 0.f, 0.f};
        cur = nxt; cA = nA; cB = nB; ++ui;
        if constexpr (ALIGN_EPI) { if (wr == 1) PG8_BAR; }
    }
    PG8_WAIT_V(0);
    if constexpr (!ALIGN_EPI) { if (wr == 0) PG8_BAR; }
    PG8_BAR;
    if constexpr (Epi::AFTER_DRAIN) { E.fused(acc, cur, wr, wc, fr, fq, lds, wid, lane); S.done(cur); }
#undef PG8_SA
#undef PG8_SB
#undef PG8_STAGE
#undef PG8_LDA
#undef PG8_LDB
#undef PG8_MMA
#undef PG8_WAIT_V
#undef PG8_WAIT_L
#undef PG8_BAR
#undef PG8_SCHED
}
}
#define LAS __attribute__((address_space(3)))
#define XB_TMO      128
#define XB_XCNT(j)  (256  + 64 * (j))
#define XB_XSUB(j)  (1280 + 64 * (j))
#define XB_XGEN(j)  (2304 + 64 * (j))
#define XB_TOP      3328
#define XB_TOPGEN   3392
#define XCD_BAR_WORDS 3456
#define XB_SPIN_CAP (1u << 24)

__device__ __forceinline__ unsigned xb_ld(unsigned* p)              { return __hip_atomic_load(p, __ATOMIC_RELAXED, __HIP_MEMORY_SCOPE_AGENT); }
__device__ __forceinline__ unsigned xb_add(unsigned* p, unsigned v) { return __hip_atomic_fetch_add(p, v, __ATOMIC_RELAXED, __HIP_MEMORY_SCOPE_AGENT); }
__device__ __forceinline__ unsigned xb_xcc_id() { return (unsigned)__builtin_amdgcn_s_getreg((3 << 11) | 20) & 0xFu; }
#define XB_SPIN(cond, bar) do { unsigned _sp = 0; while (cond) { __builtin_amdgcn_s_sleep(1); \
    if ((++_sp & 255u) == 0u) { if (xb_ld(&(bar)[XB_TMO])) break; if (_sp > XB_SPIN_CAP) { atomicAdd(&(bar)[XB_TMO], 1u); break; } } } } while (0)

struct XcdBarrier {
    unsigned* bar; unsigned x; unsigned w0;
    volatile LAS unsigned* st;
};

__device__ __forceinline__ bool xb_lane0() { return __builtin_amdgcn_mbcnt_hi(~0u, __builtin_amdgcn_mbcnt_lo(~0u, 0u)) == 0u; }
__device__ __forceinline__ XcdBarrier xcd_barrier_post(unsigned* bar, volatile LAS unsigned* st, unsigned w0) {
    XcdBarrier b; b.bar = bar; b.x = xb_xcc_id(); b.st = st; b.w0 = w0;
    if (w0 && xb_lane0()) (void)xb_add(&bar[XB_XCNT(b.x)], 1u);
    return b;
}
__device__ __forceinline__ void xcd_barrier_complete(unsigned* bar, unsigned x, unsigned& nloc, unsigned& nx) {
    const unsigned G = gridDim.x * gridDim.y * gridDim.z;
    unsigned sum, cnt, mine, sp = 0u;
    for (;;) {
        sum = 0u; cnt = 0u; mine = 0u;
#pragma unroll
        for (unsigned j = 0; j < 16; ++j) { const unsigned c = xb_ld(&bar[XB_XCNT(j)]); sum += c; cnt += (c > 0u) ? 1u : 0u; mine = (j == x) ? c : mine; }
        if (sum == G) break;
        __builtin_amdgcn_s_sleep(1);
        if ((++sp & 255u) == 0u) { if (xb_ld(&bar[XB_TMO])) break; if (sp > XB_SPIN_CAP) { atomicAdd(&bar[XB_TMO], 1u); break; } }
    }
    nloc = mine > 0u ? mine : 1u; nx = cnt > 0u ? cnt : 1u;
}

__device__ __forceinline__ void xcd_barrier(const XcdBarrier& b) {
    asm volatile("s_waitcnt vmcnt(0)" ::: "memory");
    __syncthreads();
    if (b.w0 && xb_lane0()) {
        unsigned* bar = b.bar;
        __builtin_amdgcn_s_waitcnt(0);
        unsigned nloc = b.st[0], nx = b.st[1];
        if (nloc == 0u) { xcd_barrier_complete(bar, b.x, nloc, nx); b.st[0] = nloc; b.st[1] = nx; }
        const unsigned old = xb_add(&bar[XB_XSUB(b.x)], 1u);
        const unsigned gen = old / nloc;
        if (old + 1u == (gen + 1u) * nloc) {
            __builtin_amdgcn_fence(__ATOMIC_RELEASE, "agent");
            asm volatile("s_waitcnt vmcnt(0)" ::: "memory");
            const unsigned og = xb_add(&bar[XB_TOP], 1u);
            const unsigned tg = og / nx;
            if (og + 1u == (tg + 1u) * nx) xb_add(&bar[XB_TOPGEN], 1u);
            else XB_SPIN(xb_ld(&bar[XB_TOPGEN]) == tg, bar);
            __builtin_amdgcn_fence(__ATOMIC_ACQUIRE, "agent");
            xb_add(&bar[XB_XGEN(b.x)], 1u);
            asm volatile("s_waitcnt vmcnt(0)" ::: "memory");
        } else {
            XB_SPIN(xb_ld(&bar[XB_XGEN(b.x)]) == gen, bar);
            __builtin_amdgcn_fence(__ATOMIC_ACQUIRE, "agent");
            asm volatile("s_waitcnt vmcnt(0)" ::: "memory");
        }
    }
    __syncthreads();
}

constexpr int DM = 4096, NB = 2, SEQ = 8192, MTOK = NB * SEQ, DEPTH = 4;
constexpr int S5W = 1024;
constexpr int HGW = 1536;
constexpr int GLKW = 768;
constexpr int INW = 11792, INP = 12032, DFF = 11008;
constexpr int OW = 3072;
constexpr int C_U = 0, C_QB = 1024, C_FB = 2560, C_IB = 4096, C_GB = 5632, C_QC = 7168, C_KC = 7936, C_VC = 8704, C_GC = 10240, C_LR = 11776;
constexpr float LN_EPS = 1e-5f;
constexpr float ALPHA = 1.6817928305074290861f;
constexpr float GLA_QSCALE = 0.07216878364870322f;

enum { I_X = 0, I_C, I_WADA, I_BADA, I_TABLE, I_WIN, I_WOUT, I_AREAL, I_AIMAG, I_LOGDT, I_BRE, I_BIM, I_CRE, I_CIM, I_S5D, I_GLUW, I_GLUB,
       I_LBRAW, I_HGG, I_HGB, I_WGATE, I_BGATE, I_GLG, I_WFG, I_WFU, I_WFD, I_LN1G, I_LN1B, I_LN2G, I_LN2B, N_IN };

constexpr size_t MiB = 1u << 20;
constexpr size_t WS_CTL = 0, CTL_ZERO_BYTES = 1 * MiB;
constexpr size_t WS_MOD = 1 * MiB;
constexpr size_t WS_MISC = 2 * MiB;
constexpr size_t WS_CONDPART = 12 * MiB;
constexpr size_t WS_H = 24 * MiB;
constexpr size_t WS_MIXED = WS_H + 128 * MiB;
constexpr size_t WS_Z = WS_MIXED + 128 * MiB;
constexpr size_t WS_O = WS_Z + 32 * MiB;
constexpr size_t WS_DELTA = WS_O;
constexpr size_t WS_P = WS_O + 192 * MiB;
constexpr size_t WS_WT = WS_P + 376 * MiB;
constexpr size_t WT_IN = 0, WT_OUT = 94 * MiB, WT_GU = 126 * MiB, WT_DN = 298 * MiB, WT_GLU = 384 * MiB, WT_LAYER = 386 * MiB;
constexpr size_t WS_HGB = WS_WT + DEPTH * WT_LAYER;
constexpr size_t WS_GLB = WS_HGB + 198 * MiB;
constexpr size_t WS_S5T = WS_GLB + 128 * MiB;
constexpr size_t WS_S5W1 = WS_S5T + 576 * MiB;
constexpr size_t WS_UX = WS_S5W1 + 144 * MiB;
constexpr size_t WS_SLOC = WS_UX + 36 * MiB;
constexpr size_t WS_LAM64 = WS_SLOC + 8 * MiB;
constexpr size_t WS_ST = WS_LAM64 + 1 * MiB;
constexpr size_t WS_END = WS_ST + 45 * MiB;
static_assert((size_t)INP * DM * 2 == 94 * MiB && (size_t)DM * DM * 2 == 32 * MiB && (size_t)2 * DFF * DM * 2 == 172 * MiB && (size_t)DM * DFF * 2 == 86 * MiB, "weight map");
static_assert((size_t)MTOK * INP * 2 == 376 * MiB && (size_t)MTOK * DFF * 2 <= 376 * MiB, "activation map");

constexpr int RING_BYTES = 131072;
constexpr int LDSCTL_OFF = 135168;
constexpr int LDS_BYTES = 147456;

#ifndef LAS
#define LAS __attribute__((address_space(3)))
#endif
typedef unsigned short bf16_t;
typedef float f32x4 __attribute__((ext_vector_type(4)));
typedef float f32x2 __attribute__((ext_vector_type(2)));
typedef unsigned u32x4 __attribute__((ext_vector_type(4)));
typedef unsigned u32x2 __attribute__((ext_vector_type(2)));
#define LDS_WAIT() asm volatile("s_waitcnt lgkmcnt(0)" ::: "memory")
#define VM_WAIT() asm volatile("s_waitcnt vmcnt(0)" ::: "memory")
typedef __bf16 bf16x2_t __attribute__((ext_vector_type(2)));
__device__ __forceinline__ unsigned cvt_pk_bf16(float lo, float hi) { return __builtin_bit_cast(unsigned, __builtin_convertvector((f32x2){lo, hi}, bf16x2_t)); }

__device__ __forceinline__ float bf_lo(unsigned w) { return __uint_as_float(w << 16); }
__device__ __forceinline__ float bf_hi(unsigned w) { return __uint_as_float(w & 0xffff0000u); }
__device__ __forceinline__ float bf2f(bf16_t b) { return __uint_as_float(((unsigned)b) << 16); }
__device__ __forceinline__ float wave_sum(float v) {
    v += __int_as_float(__builtin_amdgcn_mov_dpp(__float_as_int(v), 0xB1, 0xF, 0xF, true));
    v += __int_as_float(__builtin_amdgcn_mov_dpp(__float_as_int(v), 0x4E, 0xF, 0xF, true));
    v += __int_as_float(__builtin_amdgcn_mov_dpp(__float_as_int(v), 0x141, 0xF, 0xF, true));
    v += __int_as_float(__builtin_amdgcn_mov_dpp(__float_as_int(v), 0x140, 0xF, 0xF, true));
    v += __shfl_xor(v, 16); v += __shfl_xor(v, 32);
    return v;
}
__device__ __forceinline__ float sigmoidf_(float x) { return __builtin_amdgcn_rcpf(1.0f + __expf(-x)); }
__device__ __forceinline__ float gelu_tanh(float y) { const float a = 0.7978845608028654f * (y + 0.044715f * y * y * y); const float t = 1.0f - 2.0f * __builtin_amdgcn_rcpf(1.0f + __expf(2.0f * a)); return 0.5f * y * (1.0f + t); }

struct EpiProj {
    static constexpr bool PERM = true, AFTER_DRAIN = false;
    bf16_t* P; bf16_t* UX;
    __device__ __forceinline__ void operator()(const f32x4 (&acc)[2][2][4][2], const pg8::Unit& u, int wr, int wc, int fr, int fq) const {
        const int row0 = u.pm * 256 + wr * 64 + fr, col0 = u.pn * 256 + wc * 32 + 8 * fq;
        const bool s5 = u.pn < 4;
#pragma unroll
        for (int ai = 0; ai < 2; ++ai)
#pragma unroll
            for (int m = 0; m < 4; ++m) { const int row = row0 + ai * 128 + m * 16;
#pragma unroll
                for (int bj = 0; bj < 2; ++bj) { const f32x4 v0 = acc[ai][bj][m][0], v1 = acc[ai][bj][m][1]; const int col = col0 + bj * 128;
                    u32x4 w; w.x = cvt_pk_bf16(v0[0], v0[1]); w.y = cvt_pk_bf16(v0[2], v0[3]); w.z = cvt_pk_bf16(v1[0], v1[1]); w.w = cvt_pk_bf16(v1[2], v1[3]);
                    if (!s5) *(u32x4*)(P + (size_t)row * INP + col) = w;
                    else { bf16_t* ur = UX + (size_t)((col >> 4) * 256 + (row >> 6)) * 1152; *(u32x4*)(ur + (row & 63) * 16 + (col & 15)) = w;
                        if ((row & 63) == 0) { const u32x4 z = (u32x4){0u, 0u, 0u, 0u}; bf16_t* zp = ur + 1024 + ((col & 15) ? 64 : 0);
#pragma unroll
                            for (int i = 0; i < 8; ++i) *(u32x4*)(zp + 8 * i) = z; } } } }
    }
};
struct EpiSwiglu {
    static constexpr bool PERM = true, AFTER_DRAIN = false;
    bf16_t* HID;
    __device__ __forceinline__ void operator()(const f32x4 (&acc)[2][2][4][2], const pg8::Unit& u, int wr, int wc, int fr, int fq) const {
        const int row0 = u.pm * 256 + wr * 64 + fr, col0 = u.pn * 128 + wc * 32 + 8 * fq;
#pragma unroll
        for (int ai = 0; ai < 2; ++ai)
#pragma unroll
            for (int m = 0; m < 4; ++m) { bf16_t* rowp = HID + (size_t)(row0 + ai * 128 + m * 16) * DFF + col0;
                float o[8];
#pragma unroll
                for (int n = 0; n < 2; ++n)
#pragma unroll
                    for (int j = 0; j < 4; ++j) { const float g = acc[ai][0][m][n][j], up = acc[ai][1][m][n][j]; o[n * 4 + j] = g * __builtin_amdgcn_rcpf(1.0f + __expf(-g)) * up; }
                u32x4 w; w.x = cvt_pk_bf16(o[0], o[1]); w.y = cvt_pk_bf16(o[2], o[3]); w.z = cvt_pk_bf16(o[4], o[5]); w.w = cvt_pk_bf16(o[6], o[7]);
                *(u32x4*)rowp = w; }
    }
};
struct EpiGlu {
    static constexpr bool PERM = true, AFTER_DRAIN = false;
    const bf16_t* Z; bf16_t* MIXED; const float* bias;
    __device__ __forceinline__ void operator()(const f32x4 (&acc)[2][2][4][2], const pg8::Unit& u, int wr, int wc, int fr, int fq) const {
        const int row0 = u.pm * 256 + wr * 64 + fr, col0 = u.pn * 256 + wc * 32 + 8 * fq;
#pragma unroll
        for (int bj = 0; bj < 2; ++bj) {
            const f32x4 b0 = *(const f32x4*)(bias + col0 + bj * 128), b1 = *(const f32x4*)(bias + col0 + bj * 128 + 4);
#pragma unroll
            for (int ai = 0; ai < 2; ++ai)
#pragma unroll
                for (int m = 0; m < 4; ++m) { const size_t r = (size_t)(row0 + ai * 128 + m * 16);
                    const u32x4 zz = *(const u32x4*)(Z + r * S5W + col0 + bj * 128);
                    const f32x4 v0 = acc[ai][bj][m][0] + b0, v1 = acc[ai][bj][m][1] + b1;
                    u32x4 w;
                    w.x = cvt_pk_bf16(bf_lo(zz.x) * sigmoidf_(v0[0]), bf_hi(zz.x) * sigmoidf_(v0[1]));
                    w.y = cvt_pk_bf16(bf_lo(zz.y) * sigmoidf_(v0[2]), bf_hi(zz.y) * sigmoidf_(v0[3]));
                    w.z = cvt_pk_bf16(bf_lo(zz.z) * sigmoidf_(v1[0]), bf_hi(zz.z) * sigmoidf_(v1[1]));
                    w.w = cvt_pk_bf16(bf_lo(zz.w) * sigmoidf_(v1[2]), bf_hi(zz.w) * sigmoidf_(v1[3]));
                    *(u32x4*)(MIXED + r * DM + col0 + bj * 128) = w;
                    if (m & 1) asm volatile("" ::: "memory"); }
        }
    }
};
struct EpiDelta {
    static constexpr bool PERM = true, AFTER_DRAIN = false;
    bf16_t* D; const float* gate0;
    __device__ __forceinline__ void operator()(const f32x4 (&acc)[2][2][4][2], const pg8::Unit& u, int wr, int wc, int fr, int fq) const {
        const int row0 = u.pm * 256 + wr * 64 + fr, col0 = u.pn * 256 + wc * 32 + 8 * fq;
        const float* gp = gate0 + (u.pm >= 32 ? 6 * DM : 0) + col0;
        f32x4 g[2][2];
#pragma unroll
        for (int bj = 0; bj < 2; ++bj)
#pragma unroll
            for (int n = 0; n < 2; ++n) g[bj][n] = *(const f32x4*)(gp + bj * 128 + 4 * n) + 1.0f;
#pragma unroll
        for (int ai = 0; ai < 2; ++ai)
#pragma unroll
            for (int m = 0; m < 4; ++m) { bf16_t* rowp = D + (size_t)(row0 + ai * 128 + m * 16) * DM + col0;
#pragma unroll
                for (int bj = 0; bj < 2; ++bj) { const f32x4 v0 = acc[ai][bj][m][0] * g[bj][0], v1 = acc[ai][bj][m][1] * g[bj][1];
                    u32x4 w; w.x = cvt_pk_bf16(v0[0], v0[1]); w.y = cvt_pk_bf16(v0[2], v0[3]); w.z = cvt_pk_bf16(v1[0], v1[1]); w.w = cvt_pk_bf16(v1[2], v1[3]);
                    *(u32x4*)(rowp + bj * 128) = w; } }
    }
};

__device__ __forceinline__ int lane_id_v() { int r; asm volatile("v_mbcnt_lo_u32_b32 %0, -1, 0\n\tv_mbcnt_hi_u32_b32 %0, -1, %0" : "=v"(r)); return r; }
struct Args { const float* in[N_IN]; float* out; unsigned char* ws; int ph_lo, ph_hi; };
struct Ctx {
    volatile LAS unsigned long long* t;
    __device__ __forceinline__ unsigned long long ld(int i) const { const unsigned long long v = t[i];
        return ((unsigned long long)(unsigned)__builtin_amdgcn_readfirstlane((int)(v >> 32)) << 32) | (unsigned long long)(unsigned)__builtin_amdgcn_readfirstlane((int)(unsigned)v); }
    __device__ __forceinline__ const float* in(int i) const { return (const float*)ld(i); }
    __device__ __forceinline__ float* out() const { return (float*)ld(30); }
    __device__ __forceinline__ unsigned char* ws() const { return (unsigned char*)ld(31); }
};

constexpr int S5K = 1152;
constexpr size_t S5_T_LAYER = (size_t)64 * 1024 * S5K * 2, S5_W1_LAYER = (size_t)64 * 256 * S5K * 2;

struct S5Order {
    int G, c, n, sh;
    __device__ __forceinline__ bool next(int i, pg8::Unit& u) const { const int L = i * G + c; if (L >= n) return false; u.pm = L >> sh; u.pn = L; return true; }
    __device__ __forceinline__ void a_ready(const pg8::Unit&) const {}
    __device__ __forceinline__ void done(const pg8::Unit&) const {}
};
struct EpiS5A {
    static constexpr bool PERM = false, AFTER_DRAIN = false;
    float* Sloc;
    __device__ __forceinline__ void operator()(const f32x4 (&acc)[2][2][4][2], const pg8::Unit& u, int wr, int wc, int fr, int fq) const {
        const int row0 = u.pm * 256 + wr * 64 + fr, col0 = wc * 32 + 4 * fq;
#pragma unroll
        for (int ai = 0; ai < 2; ++ai)
#pragma unroll
            for (int m = 0; m < 4; ++m)
#pragma unroll
                for (int n = 0; n < 2; ++n) *(f32x4*)(Sloc + (size_t)(row0 + ai * 128 + m * 16) * 128 + col0 + n * 16) = acc[ai][0][m][n];
    }
};
struct EpiS5C {
    static constexpr bool PERM = true, AFTER_DRAIN = false;
    bf16_t* Z;
    __device__ __forceinline__ void operator()(const f32x4 (&acc)[2][2][4][2], const pg8::Unit& u, int wr, int wc, int fr, int fq) const {
        const int g = u.pm, c0 = wr * 64 + fr, cc0 = (u.pn & 3) * 256 + wc * 32 + 8 * fq;
#pragma unroll
        for (int ai = 0; ai < 2; ++ai)
#pragma unroll
            for (int m = 0; m < 4; ++m) { const int c = c0 + ai * 128 + m * 16;
#pragma unroll
                for (int bj = 0; bj < 2; ++bj) { const int cc = cc0 + bj * 128, t = cc >> 4, h0 = cc & 15;
                    const f32x4 v0 = acc[ai][bj][m][0], v1 = acc[ai][bj][m][1];
                    u32x4 w; w.x = cvt_pk_bf16(gelu_tanh(v0[0]), gelu_tanh(v0[1])); w.y = cvt_pk_bf16(gelu_tanh(v0[2]), gelu_tanh(v0[3]));
                    w.z = cvt_pk_bf16(gelu_tanh(v1[0]), gelu_tanh(v1[1])); w.w = cvt_pk_bf16(gelu_tanh(v1[2]), gelu_tanh(v1[3]));
                    *(u32x4*)(Z + (size_t)(c * 64 + t) * S5W + g * 16 + h0) = w; } }
    }
};
__device__ __forceinline__ void s5_tables_item(const Ctx& a, int lg, LAS unsigned char* lds, int wave, int lane) {
    LAS f32x2* LP = (LAS f32x2*)lds;
    LAS f32x2* BB = (LAS f32x2*)(lds + 33280);
    LAS f32x2* CC = (LAS f32x2*)(lds + 41472);
    LAS float* KT = (LAS float*)(lds + 49664);
    const int tid = wave * 64 + lane, l = lg >> 6, g = lg & 63;
    if (tid < 64) { const int p = tid;
        const double ar = (double)a.in(I_AREAL)[lg * 64 + p], ai = (double)a.in(I_AIMAG)[lg * 64 + p], dt = exp((double)a.in(I_LOGDT)[lg]);
        const double mag = exp(ar * dt), ang = ai * dt, lr = mag * cos(ang), li = mag * sin(ang);
        const double den = ar * ar + ai * ai, nr = lr - 1.0, ni = li, cr = (nr * ar + ni * ai) / den, ci = (ni * ar - nr * ai) / den;
        double pr = 1.0, pi = 0.0;
        for (int tau = 0; tau <= 64; ++tau) { LP[tau * 64 + p] = (f32x2){(float)pr, (float)pi}; const double nr2 = pr * lr - pi * li, ni2 = pr * li + pi * lr; pr = nr2; pi = ni2; }
        for (int h = 0; h < 16; ++h) { const double br = (double)a.in(I_BRE)[((size_t)lg * 64 + p) * 16 + h], bi = (double)a.in(I_BIM)[((size_t)lg * 64 + p) * 16 + h];
            BB[p * 16 + h] = (f32x2){(float)(cr * br - ci * bi), (float)(cr * bi + ci * br)}; }
    }
    for (int e = tid; e < 1024; e += 512) { const int h = e >> 6, p = e & 63; CC[e] = (f32x2){a.in(I_CRE)[((size_t)lg * 16 + h) * 64 + p], a.in(I_CIM)[((size_t)lg * 16 + h) * 64 + p]}; }
    __syncthreads();
    if (tid < 64) *(f32x2*)((float*)(a.ws() + WS_LAM64) + ((size_t)lg * 64 + tid) * 2) = LP[64 * 64 + tid];
    for (int e = tid; e < 64 * 256; e += 512) { const int tau = e >> 8, h = (e >> 4) & 15, hp = e & 15; float s = 0.f;
#pragma unroll 8
        for (int p = 0; p < 64; ++p) { const f32x2 c = CC[h * 64 + p], lm = LP[tau * 64 + p], b = BB[p * 16 + hp];
            const float xr = c.x * lm.x - c.y * lm.y, xi = c.x * lm.y + c.y * lm.x; s += xr * b.x - xi * b.y; }
        if (tau == 0 && h == hp) s += a.in(I_S5D)[l * S5W + g * 16 + h];
        KT[e] = s; }
    __syncthreads();
    bf16_t* T = (bf16_t*)(a.ws() + WS_S5T + (size_t)l * S5_T_LAYER) + (size_t)g * 1024 * S5K;
    for (int pc = tid; pc < 1024 * 144; pc += 512) { const int n = pc / 144, j = pc % 144, t = n >> 4, h = n & 15; float v[8];
        if (j < 128) { const int s = j >> 1, hp0 = (j & 1) * 8;
            if (s > t) {
#pragma unroll
                for (int i = 0; i < 8; ++i) v[i] = 0.f;
            } else { const LAS float* kp = KT + (t - s) * 256 + h * 16 + hp0; const f32x4 k0 = *(const LAS f32x4*)kp, k1 = *(const LAS f32x4*)(kp + 4);
                v[0] = k0[0]; v[1] = k0[1]; v[2] = k0[2]; v[3] = k0[3]; v[4] = k1[0]; v[5] = k1[1]; v[6] = k1[2]; v[7] = k1[3]; }
        } else { const int p0 = (j - 128) * 4;
#pragma unroll
            for (int i = 0; i < 4; ++i) { const f32x2 c = CC[h * 64 + p0 + i], lm = LP[(t + 1) * 64 + p0 + i]; v[2 * i] = c.x * lm.x - c.y * lm.y; v[2 * i + 1] = -(c.x * lm.y + c.y * lm.x); } }
        *(u32x4*)(T + (size_t)n * S5K + j * 8) = (u32x4){cvt_pk_bf16(v[0], v[1]), cvt_pk_bf16(v[2], v[3]), cvt_pk_bf16(v[4], v[5]), cvt_pk_bf16(v[6], v[7])}; }
    bf16_t* W1 = (bf16_t*)(a.ws() + WS_S5W1 + (size_t)l * S5_W1_LAYER) + (size_t)g * 256 * S5K;
    for (int pc = tid; pc < 256 * 144; pc += 512) { const int n = pc / 144, j = pc % 144; float v[8];
#pragma unroll
        for (int i = 0; i < 8; ++i) v[i] = 0.f;
        if (n < 128 && j < 128) { const int p = n >> 1, ri = n & 1, s = j >> 1, hp0 = (j & 1) * 8; const f32x2 lm = LP[(63 - s) * 64 + p];
#pragma unroll
            for (int i = 0; i < 8; ++i) { const f32x2 b = BB[p * 16 + hp0 + i]; v[i] = ri ? (lm.x * b.y + lm.y * b.x) : (lm.x * b.x - lm.y * b.y); } }
        *(u32x4*)(W1 + (size_t)n * S5K + j * 8) = (u32x4){cvt_pk_bf16(v[0], v[1]), cvt_pk_bf16(v[2], v[3]), cvt_pk_bf16(v[4], v[5]), cvt_pk_bf16(v[6], v[7])}; }
    __syncthreads();
}
__device__ __forceinline__ void s5_scan_item(const Ctx& a, int l, int item, int wave, int lane) {
    const int idx = item * 512 + wave * 64 + lane, g = idx >> 7, b = (idx >> 6) & 1, p = idx & 63;
    const f32x2 lam = *(const f32x2*)((const float*)(a.ws() + WS_LAM64) + ((size_t)(l * 64 + g) * 64 + p) * 2);
    const float* sl = (const float*)(a.ws() + WS_SLOC) + ((size_t)(g * 256 + b * 128)) * 128 + 2 * p;
    bf16_t* ux = (bf16_t*)(a.ws() + WS_UX) + ((size_t)(g * 256 + b * 128)) * S5K + 1024 + 2 * p;
    float xr = 0.f, xi = 0.f;
    for (int c0 = 0; c0 < 128; c0 += 8) { f32x2 s[8];
#pragma unroll
        for (int i = 0; i < 8; ++i) s[i] = *(const f32x2*)(sl + (size_t)(c0 + i) * 128);
#pragma unroll
        for (int i = 0; i < 8; ++i) { *(unsigned*)(ux + (size_t)(c0 + i) * S5K) = cvt_pk_bf16(xr, xi);
            const float nr = lam.x * xr - lam.y * xi + s[i].x, ni = lam.x * xi + lam.y * xr + s[i].y; xr = nr; xi = ni; } }
}

__device__ __forceinline__ void transpose_item(const float* W, int N, int k0, int n0, bf16_t* WT, int drow0, int Kd, LAS float* scr, int lane) {
    const int nl = 4 * (lane & 15), kq = lane >> 4;
    const bool valid = (n0 + nl) < N;
    f32x4 v[16];
#pragma unroll
    for (int i = 0; i < 16; ++i) { const int k = 4 * i + kq; v[i] = valid ? *(const f32x4*)(W + (size_t)(k0 + k) * N + n0 + nl) : (f32x4){0.f, 0.f, 0.f, 0.f}; }
#pragma unroll
    for (int i = 0; i < 16; ++i) { const int k = 4 * i + kq; LAS float* s = scr + k * 65 + nl; s[0] = v[i][0]; s[1] = v[i][1]; s[2] = v[i][2]; s[3] = v[i][3]; }
    LDS_WAIT();
    const int c = lane & 7;
#pragma unroll
    for (int j = 0; j < 8; ++j) { const int n = (lane >> 3) + 8 * j; const LAS float* s = scr + (8 * c) * 65 + n;
        u32x4 o; o.x = cvt_pk_bf16(s[0], s[65]); o.y = cvt_pk_bf16(s[130], s[195]); o.z = cvt_pk_bf16(s[260], s[325]); o.w = cvt_pk_bf16(s[390], s[455]);
        *(u32x4*)(WT + (size_t)(drow0 + n) * Kd + k0 + 8 * c) = o; }
    LDS_WAIT();
}
constexpr int NIT_IN = 64 * 188, NIT_OUT = 64 * 64, NIT_G = 64 * 172, NIT_DN = 172 * 64, NIT_GLU = 16 * 16;
constexpr int NIT_LAYER = NIT_IN + NIT_OUT + 2 * NIT_G + NIT_DN + NIT_GLU;
constexpr int NIT_TR = DEPTH * NIT_LAYER, NIT_COND = 64 * 96;

__device__ __forceinline__ void phase_prologue(const Ctx& a, LAS unsigned char* lds, int wave, int lane) {
    if (blockIdx.x & 1) { for (int lg = blockIdx.x; lg < DEPTH * 64; lg += gridDim.x) s5_tables_item(a, lg, lds, wave, lane); __syncthreads(); }
    LAS float* scr = (LAS float*)(lds + wave * 16640);
    const int gw = blockIdx.x * 8 + wave, NGW = gridDim.x * 8;
    for (int it = gw; it < NIT_TR + NIT_COND; it += NGW) {
        if (it < NIT_TR) {
            const int l = it / NIT_LAYER; int r = it % NIT_LAYER;
            unsigned char* wt = a.ws() + WS_WT + (size_t)l * WT_LAYER;
            if (r < NIT_IN) { const int kb = r / 188, nb = r % 188; transpose_item(a.in(I_WIN) + (size_t)l * DM * INW, INW, 64 * kb, 64 * nb, (bf16_t*)(wt + WT_IN), 64 * nb, DM, scr, lane); continue; } r -= NIT_IN;
            if (r < NIT_OUT) { const int kb = r / 64, nb = r % 64; transpose_item(a.in(I_WOUT) + (size_t)l * DM * DM, DM, 64 * kb, 64 * nb, (bf16_t*)(wt + WT_OUT), 64 * nb, DM, scr, lane); continue; } r -= NIT_OUT;
            if (r < NIT_G) { const int kb = r / 172, nb = r % 172, n0 = 64 * nb; transpose_item(a.in(I_WFG) + (size_t)l * DM * DFF, DFF, 64 * kb, n0, (bf16_t*)(wt + WT_GU), 256 * (n0 / 128) + (n0 % 128), DM, scr, lane); continue; } r -= NIT_G;
            if (r < NIT_G) { const int kb = r / 172, nb = r % 172, n0 = 64 * nb; transpose_item(a.in(I_WFU) + (size_t)l * DM * DFF, DFF, 64 * kb, n0, (bf16_t*)(wt + WT_GU), 256 * (n0 / 128) + 128 + (n0 % 128), DM, scr, lane); continue; } r -= NIT_G;
            if (r < NIT_DN) { const int kb = r / 64, nb = r % 64; transpose_item(a.in(I_WFD) + (size_t)l * DFF * DM, DM, 64 * kb, 64 * nb, (bf16_t*)(wt + WT_DN), 64 * nb, DFF, scr, lane); continue; } r -= NIT_DN;
            { const int kb = r / 16, nb = r % 16; transpose_item(a.in(I_GLUW) + (size_t)l * S5W * S5W, S5W, 64 * kb, 64 * nb, (bf16_t*)(wt + WT_GLU), 64 * nb, S5W, scr, lane); }
        } else {
            const int item = it - NIT_TR, kb = item / 96, jb = item % 96, k0 = 64 * kb, j0 = 256 * jb + 4 * lane;
            const float* c = a.in(I_C);
            float c0 = c[k0 + lane], c1 = c[DM + k0 + lane];
            c0 = c0 / (1.0f + expf(-c0)); c1 = c1 / (1.0f + expf(-c1));
            f32x4 a0 = (f32x4){0.f, 0.f, 0.f, 0.f}, a1 = a0;
            const float* w = a.in(I_WADA) + (size_t)k0 * (6 * DM) + j0;
#pragma unroll 8
            for (int kk = 0; kk < 64; ++kk) { const f32x4 wv = *(const f32x4*)(w + (size_t)kk * (6 * DM));
                const float s0 = __int_as_float(__builtin_amdgcn_readlane(__float_as_int(c0), kk)), s1 = __int_as_float(__builtin_amdgcn_readlane(__float_as_int(c1), kk));
                a0 += wv * s0; a1 += wv * s1; }
            float* cp = (float*)(a.ws() + WS_CONDPART);
            *(f32x4*)(cp + (size_t)(kb * 2 + 0) * (6 * DM) + j0) = a0;
            *(f32x4*)(cp + (size_t)(kb * 2 + 1) * (6 * DM) + j0) = a1;
        }
    }
    __syncthreads();
    if (!(blockIdx.x & 1)) { for (int lg = blockIdx.x; lg < DEPTH * 64; lg += gridDim.x) s5_tables_item(a, lg, lds, wave, lane); }
}
__device__ __forceinline__ void phase_mod(const Ctx& a, int wave, int lane) {
    const int gt = blockIdx.x * 512 + wave * 64 + lane, NT = gridDim.x * 512;
    const float* cp = (const float*)(a.ws() + WS_CONDPART);
    float* mod = (float*)(a.ws() + WS_MOD); float* misc = (float*)(a.ws() + WS_MISC);
    for (int idx = gt; idx < NB * 6 * DM; idx += NT) {
        const int b = idx / (6 * DM), j = idx % (6 * DM);
        float s = a.in(I_BADA)[j];
        for (int kb = 0; kb < 64; ++kb) s += cp[(size_t)(kb * 2 + b) * (6 * DM) + j];
        for (int l = 0; l < DEPTH; ++l) mod[(size_t)((l * 2 + b) * 6) * DM + j] = s + a.in(I_TABLE)[(size_t)l * 6 * DM + j];
    }
    for (int idx = gt; idx < DM; idx += NT) { misc[idx] = 1.0f; misc[DM + idx] = 0.0f; }
    for (int idx = gt; idx < HGW; idx += NT) {
        const float* raw = a.in(I_LBRAW); float r[DEPTH], mx = -3.0e38f;
#pragma unroll
        for (int l = 0; l < DEPTH; ++l) { r[l] = raw[l * HGW + idx]; mx = fmaxf(mx, r[l]); }
        float e[DEPTH], sum = 0.f;
#pragma unroll
        for (int l = 0; l < DEPTH; ++l) { e[l] = expf(r[l] - mx); sum += e[l]; }
        float cum = 0.f;
#pragma unroll
        for (int l = 0; l < DEPTH; ++l) { misc[2 * DM + l * HGW + idx] = cum; if (l + 1 < DEPTH) cum += e[l + 1] / sum; }
    }
}

__device__ __forceinline__ void phase_h0(const float* x, const float* modp, bf16_t* H, int wave, int lane) {
    for (int blk = blockIdx.x; blk < MTOK / 64; blk += gridDim.x) {
        const int r0 = blk * 64, b = (r0 >= SEQ) ? 1 : 0;
        f32x4 A[2], B[2];
#pragma unroll
        for (int jj = 0; jj < 2; ++jj) { const int c = 512 * wave + 256 * jj + 4 * lane; A[jj] = *(const f32x4*)(modp + (size_t)(b * 6 + 1) * DM + c) + 1.0f; B[jj] = *(const f32x4*)(modp + (size_t)(b * 6 + 0) * DM + c); }
#pragma unroll 8
        for (int rl = 0; rl < 64; ++rl) { const size_t off = (size_t)(r0 + rl) * DM + 512 * wave + 4 * lane;
#pragma unroll
            for (int jj = 0; jj < 2; ++jj) { const f32x4 v = *(const f32x4*)(x + off + 256 * jj), y = v * A[jj] + B[jj];
                u32x2 w; w.x = cvt_pk_bf16(y[0], y[1]); w.y = cvt_pk_bf16(y[2], y[3]); *(u32x2*)(H + off + 256 * jj) = w; } }
    }
}
template <bool WITH_H>
__device__ __forceinline__ void phase_lnres(const float* xprev, const bf16_t* delta, float* xout, const float* lng, const float* lnb, const float* modp, int i_shift, int i_scale, bf16_t* H,
                                            LAS unsigned char* lds, int wave, int lane) {
    LAS f32x2* red = (LAS f32x2*)lds;
    for (int blk = blockIdx.x; blk < MTOK / 64; blk += gridDim.x) {
        const int r0 = blk * 64, b = (r0 >= SEQ) ? 1 : 0;
        f32x4 G[2], Bt[2], A[2], B[2];
#pragma unroll
        for (int jj = 0; jj < 2; ++jj) { const int c = 512 * wave + 256 * jj + 4 * lane; G[jj] = *(const f32x4*)(lng + c); Bt[jj] = *(const f32x4*)(lnb + c);
            if (WITH_H) { A[jj] = *(const f32x4*)(modp + (size_t)(b * 6 + i_scale) * DM + c) + 1.0f; B[jj] = *(const f32x4*)(modp + (size_t)(b * 6 + i_shift) * DM + c); } }
        const size_t offb = (size_t)r0 * DM + 512 * wave + 4 * lane;
        f32x4 va[4][2], vb[4][2]; u32x2 da[4][2], db[4][2];
#define LN_LOAD(v_, d_, it_) do { _Pragma("unroll") for (int r = 0; r < 4; ++r) _Pragma("unroll") for (int jj = 0; jj < 2; ++jj) { \
            v_[r][jj] = *(const f32x4*)(xprev + offb + (size_t)((it_) * 4 + r) * DM + 256 * jj); d_[r][jj] = *(const u32x2*)(delta + offb + (size_t)((it_) * 4 + r) * DM + 256 * jj); } } while (0)
#define LN_STEP(v_, d_, it_) do { LAS f32x2* rb = red + ((it_) & 1) * 32; \
            _Pragma("unroll") for (int r = 0; r < 4; ++r) { float s1 = 0.f, s2 = 0.f; \
                _Pragma("unroll") for (int jj = 0; jj < 2; ++jj) { const f32x4 dd = (f32x4){bf_lo(d_[r][jj].x), bf_hi(d_[r][jj].x), bf_lo(d_[r][jj].y), bf_hi(d_[r][jj].y)}; const f32x4 y = v_[r][jj] * ALPHA + dd; v_[r][jj] = y; \
                    s1 += (y[0] + y[1]) + (y[2] + y[3]); s2 += (y[0] * y[0] + y[1] * y[1]) + (y[2] * y[2] + y[3] * y[3]); } \
                s1 = wave_sum(s1); s2 = wave_sum(s2); if (lane == 0) rb[r * 8 + wave] = (f32x2){s1, s2}; } \
            __syncthreads(); \
            _Pragma("unroll") for (int r = 0; r < 4; ++r) { float s1 = 0.f, s2 = 0.f; \
                _Pragma("unroll") for (int w = 0; w < 8; ++w) { const f32x2 p = rb[r * 8 + w]; s1 += p.x; s2 += p.y; } \
                const float mu = s1 * (1.0f / DM), rs = 1.0f / sqrtf(fmaxf(s2 * (1.0f / DM) - mu * mu, 0.f) + LN_EPS); \
                _Pragma("unroll") for (int jj = 0; jj < 2; ++jj) { const f32x4 x = ((v_[r][jj] - mu) * rs) * G[jj] + Bt[jj]; \
                    *(f32x4*)(xout + offb + (size_t)((it_) * 4 + r) * DM + 256 * jj) = x; \
                    if (WITH_H) { const f32x4 y = x * A[jj] + B[jj]; u32x2 w; w.x = cvt_pk_bf16(y[0], y[1]); w.y = cvt_pk_bf16(y[2], y[3]); *(u32x2*)(H + offb + (size_t)((it_) * 4 + r) * DM + 256 * jj) = w; } } } } while (0)
        LN_LOAD(va, da, 0);
        for (int it = 0; it < 16; it += 2) {
            LN_LOAD(vb, db, it + 1);
            LN_STEP(va, da, it);
            if (it + 2 < 16) LN_LOAD(va, da, it + 2);
            LN_STEP(vb, db, it + 1);
        }
#undef LN_LOAD
#undef LN_STEP
        __syncthreads();
    }
}

typedef short bf16x8 __attribute__((ext_vector_type(8)));
constexpr int HG_BLK = 33280, HG_OQ = 0, HG_OK = 8192, HG_OKT = 16384, HG_ODL = 24576, HG_OVT = 25088;
constexpr int GL_BLK = 63488, GL_OQ = 0, GL_OK = 12800, GL_OKT = 25600, GL_ODL = 37888, GL_SHARED = 38912, GL_OVT = 38912;
constexpr int NUNIT = SEQ / 32;

struct PreOut { unsigned char* blk; int oq, ok, okt, odl, rowb; bool swz; };
template <int HALF>
__device__ __forceinline__ float pre_half(const PreOut& P, int d, int pd, float b0, float (&g)[16], const float (&qq)[16], const float (&kk)[16], float (&kta)[16], unsigned (&kt)[16]) {
    float b = b0;
#pragma unroll
    for (int j = 0; j < 16; ++j) { b += g[j]; g[j] = b; }
    const float bl = b;
#pragma unroll
    for (int t = 0; t < 16; t += 2) {
        float kv[2];
#pragma unroll
        for (int tt = 0; tt < 2; ++tt) { const int j = t + tt, row = 16 * HALF + j; const float bj = g[j];
            const int off = row * P.rowb + (P.swz ? ((2 * pd) ^ (j << 4)) : 2 * pd);
            const float qv = qq[j] * __expf(bj), kc = kk[j] * __expf(fminf(-bj, 80.f));
            const float qn = __int_as_float(__builtin_amdgcn_mov_dpp(__float_as_int(qv), 0xB1, 0xF, 0xF, true)), kn = __int_as_float(__builtin_amdgcn_mov_dpp(__float_as_int(kc), 0xB1, 0xF, 0xF, true));
            if ((d & 1) == 0) { *(unsigned*)(P.blk + P.oq + off) = cvt_pk_bf16(qv, qn); *(unsigned*)(P.blk + P.ok + off) = cvt_pk_bf16(kc, kn); }
            kv[tt] = kk[j] * __expf(bl - bj); }
        if (HALF == 0) { kta[t] = kv[0]; kta[t + 1] = kv[1]; } else kt[4 * (t >> 2) + 2 + ((t & 3) >> 1)] = cvt_pk_bf16(kv[0], kv[1]); }
    return bl;
}
__device__ __forceinline__ void pre_tail(const PreOut& P, int d, float bl0, float bl, const float (&kta)[16], unsigned (&kt)[16]) {
    const float dlb = __expf(bl - bl0);
#pragma unroll
    for (int t = 0; t < 16; t += 2) kt[4 * (t >> 2) + ((t & 3) >> 1)] = cvt_pk_bf16(kta[t] * dlb, kta[t + 1] * dlb);
#pragma unroll
    for (int i = 0; i < 4; ++i) *(u32x4*)(P.blk + P.okt + d * 64 + 16 * i) = (u32x4){kt[4 * i], kt[4 * i + 1], kt[4 * i + 2], kt[4 * i + 3]};
    *(float*)(P.blk + P.odl + d * 4) = __expf(bl);
}
__device__ __forceinline__ void phase_pre(const Ctx& a, int l, LAS unsigned char* lds, int wave, int lane) {
    const bf16_t* P = (const bf16_t*)(a.ws() + WS_P);
    int tid = wave * 64 + lane;
    const bool bal = gridDim.x == 256;
    const int t_lo = bal ? (blockIdx.x < 64 ? 13 * (int)blockIdx.x : 832 + 17 * ((int)blockIdx.x - 64)) : (int)blockIdx.x;
    const int t_hi = bal ? t_lo + (blockIdx.x < 64 ? 13 : 17) : NB * NUNIT * 8, t_st = bal ? 1 : (int)gridDim.x;
    for (int task = t_lo; task < t_hi; task += t_st) {
        asm volatile("" : "+v"(tid));
        const int kind = bal ? (task & 7) : ((task + (task >> 8)) & 7), bu = task >> 3, b = bu / NUNIT, un = bu % NUNIT;
        const size_t row0 = (size_t)b * SEQ + un * 32;
        if (kind < 3) {
            const int ch = kind * 512 + tid, h = ch >> 7, d = ch & 127, pd = (d & ~31) + 8 * ((d >> 2) & 3) + 4 * ((d >> 4) & 1) + (d & 3);
            const float lb = ((const float*)(a.ws() + WS_MISC))[2 * DM + l * HGW + ch];
            unsigned char* blk = a.ws() + WS_HGB + ((size_t)(b * 12 + h) * NUNIT + un) * HG_BLK;
            const PreOut po{blk, HG_OQ, HG_OK, HG_OKT, HG_ODL, 256, true};
            float kta[16]; unsigned kt[16], vv[16]; float bl0 = 0.f, bl = 0.f;
#pragma unroll
            for (int half = 0; half < 2; ++half) {
                float g[16], qq[16], kk[16];
#pragma unroll
                for (int j = 0; j < 16; ++j) { const bf16_t* prow = P + (row0 + 16 * half + j) * INP;
                    const float qin = fmaxf(bf2f(prow[C_QB + ch]), -80.f), fin = fminf(fmaxf(bf2f(prow[C_FB + ch]), -80.f), 80.f);
                    const unsigned short v = prow[C_IB + ch];
                    const int w = 4 * (j >> 2) + 2 * half + ((j & 3) >> 1); if (j & 1) vv[w] |= ((unsigned)v) << 16; else vv[w] = v;
                    const float e = __expf(-fin), sg = __builtin_amdgcn_rcpf(1.0f + e);
                    const float f = lb + (1.0f - lb) * sg;
                    g[j] = fmaxf(__logf(f), -100.f); kk[j] = (1.0f - lb) * (e * sg); qq[j] = qin * __builtin_amdgcn_rcpf(1.0f + __expf(-qin)); }
                if (half == 0) { bl0 = pre_half<0>(po, d, pd, 0.f, g, qq, kk, kta, kt); } else { bl = pre_half<1>(po, d, pd, bl0, g, qq, kk, kta, kt); }
            }
#pragma unroll
            for (int i = 0; i < 4; ++i) *(u32x4*)(blk + HG_OVT + d * 64 + 16 * i) = (u32x4){vv[4 * i], vv[4 * i + 1], vv[4 * i + 2], vv[4 * i + 3]};
            pre_tail(po, d, bl0, bl, kta, kt);
        } else if (kind < 5) {
            __syncthreads();
            if (tid < 64) *(LAS u32x4*)(lds + tid * 16) = *(const u32x4*)(P + (row0 + (tid >> 1)) * INP + C_LR + 8 * (tid & 1));
            __syncthreads();
            if (tid < 384) {
                const int ch = (kind - 3) * 384 + tid, h = ch / 192, d = ch % 192, pd = (d & ~31) + 8 * ((d >> 2) & 3) + 4 * ((d >> 4) & 1) + (d & 3);
                unsigned char* blk = a.ws() + WS_GLB + ((size_t)(b * 4 + h) * NUNIT + un) * GL_BLK;
                const PreOut po{blk, GL_OQ, GL_OK, GL_OKT, GL_ODL, 400, false};
                float wg[16];
#pragma unroll
                for (int r = 0; r < 16; ++r) wg[r] = a.in(I_WGATE)[((size_t)l * 16 + r) * GLKW + ch];
                const float bgv = a.in(I_BGATE)[l * GLKW + ch];
                float kta[16]; unsigned kt[16]; float bl0 = 0.f, bl = 0.f;
#pragma unroll
                for (int half = 0; half < 2; ++half) {
                    float g[16], qq[16], kk[16];
#pragma unroll
                    for (int j = 0; j < 16; ++j) { const bf16_t* prow = P + (row0 + 16 * half + j) * INP;
                        const u32x4 l0 = *(const LAS u32x4*)(lds + (16 * half + j) * 32), l1 = *(const LAS u32x4*)(lds + (16 * half + j) * 32 + 16);
                        float x = bgv;
                        x += bf_lo(l0.x) * wg[0] + bf_hi(l0.x) * wg[1] + bf_lo(l0.y) * wg[2] + bf_hi(l0.y) * wg[3] + bf_lo(l0.z) * wg[4] + bf_hi(l0.z) * wg[5] + bf_lo(l0.w) * wg[6] + bf_hi(l0.w) * wg[7];
                        x += bf_lo(l1.x) * wg[8] + bf_hi(l1.x) * wg[9] + bf_lo(l1.y) * wg[10] + bf_hi(l1.y) * wg[11] + bf_lo(l1.z) * wg[12] + bf_hi(l1.z) * wg[13] + bf_lo(l1.w) * wg[14] + bf_hi(l1.w) * wg[15];
                        g[j] = (fminf(x, 0.f) - __logf(1.0f + __expf(-fabsf(x)))) * 0.0625f;
                        qq[j] = bf2f(prow[C_QC + ch]) * GLA_QSCALE; kk[j] = bf2f(prow[C_KC + ch]); }
                    if (half == 0) { bl0 = pre_half<0>(po, d, pd, 0.f, g, qq, kk, kta, kt); } else { bl = pre_half<1>(po, d, pd, bl0, g, qq, kk, kta, kt); }
                }
                pre_tail(po, d, bl0, bl, kta, kt);
            }
        } else {
            const int ch = (kind - 5) * 512 + tid, h = ch / 384, e = ch % 384;
            unsigned char* blk = a.ws() + WS_GLB + ((size_t)(b * 4 + h) * NUNIT + un) * GL_BLK;
            unsigned vv[16];
#pragma unroll
            for (int j = 0; j < 32; ++j) { const unsigned short v = P[(row0 + j) * INP + C_VC + ch];
                const int w = 4 * ((j >> 2) & 3) + 2 * (j >> 4) + ((j & 3) >> 1); if (j & 1) vv[w] |= ((unsigned)v) << 16; else vv[w] = v; }
#pragma unroll
            for (int i = 0; i < 4; ++i) *(u32x4*)(blk + GL_OVT + e * 64 + 16 * i) = (u32x4){vv[4 * i], vv[4 * i + 1], vv[4 * i + 2], vv[4 * i + 3]};
        }
    }
}

template <int DK, int MODE>
__device__ __forceinline__ void chain_unit(const LAS unsigned char* sb, f32x4 (&S)[DK / 16], float* op, int wave, int n, int q) {
    constexpr bool IS_GLA = (DK == 192);
    constexpr int NKS = DK / 32, NMB = DK / 16, ROWB = IS_GLA ? 400 : 256;
    constexpr int OQ = 0, OK = IS_GLA ? GL_OK : HG_OK, OKT = IS_GLA ? GL_OKT : HG_OKT, OVT = IS_GLA ? GL_OVT : HG_OVT, ODL = IS_GLA ? GL_ODL : HG_ODL;
    const bf16x8 vf8 = __builtin_bit_cast(bf16x8, *(const LAS u32x4*)(sb + OVT + (16 * wave + n) * 64 + 16 * q));
    if (MODE == 1) {
        bf16x8 sbf[NKS];
#pragma unroll
        for (int ks = 0; ks < NKS; ++ks) sbf[ks] = __builtin_bit_cast(bf16x8, (u32x4){cvt_pk_bf16(S[2 * ks][0], S[2 * ks][1]), cvt_pk_bf16(S[2 * ks][2], S[2 * ks][3]), cvt_pk_bf16(S[2 * ks + 1][0], S[2 * ks + 1][1]), cvt_pk_bf16(S[2 * ks + 1][2], S[2 * ks + 1][3])});
        const f32x4 zero = (f32x4){0.f, 0.f, 0.f, 0.f};
        bf16x8 kf0[NKS];
        unsigned p10a, p10b;
        {
            f32x4 ao = zero, ao1 = zero, ap = zero, ap1 = zero;
#pragma unroll
            for (int ks = 0; ks < NKS; ++ks) { const int c0 = 64 * ks + 16 * q, o0 = n * ROWB + (IS_GLA ? c0 : (c0 ^ (n << 4)));
                const bf16x8 qf = __builtin_bit_cast(bf16x8, *(const LAS u32x4*)(sb + OQ + o0)); kf0[ks] = __builtin_bit_cast(bf16x8, *(const LAS u32x4*)(sb + OK + o0));
                if (ks & 1) { ao1 = __builtin_amdgcn_mfma_f32_16x16x32_bf16(qf, sbf[ks], ao1, 0, 0, 0); ap1 = __builtin_amdgcn_mfma_f32_16x16x32_bf16(kf0[ks], qf, ap1, 0, 0, 0); }
                else { ao = __builtin_amdgcn_mfma_f32_16x16x32_bf16(qf, sbf[ks], ao, 0, 0, 0); ap = __builtin_amdgcn_mfma_f32_16x16x32_bf16(kf0[ks], qf, ap, 0, 0, 0); } }
            ao = ao + ao1; ap = ap + ap1;
#pragma unroll
            for (int r = 0; r < 4; ++r) if (4 * q + r > n) ap[r] = 0.f;
            const bf16x8 pa = __builtin_bit_cast(bf16x8, (u32x4){cvt_pk_bf16(ap[0], ap[1]), cvt_pk_bf16(ap[2], ap[3]), 0u, 0u});
            ao = __builtin_amdgcn_mfma_f32_16x16x32_bf16(pa, vf8, ao, 0, 0, 0);
#pragma unroll
            for (int r = 0; r < 4; ++r) op[(size_t)(4 * q + r) * OW] = ao[r];
        }
        {
            f32x4 ao = zero, ao1 = zero, ap = zero, ap1 = zero, ax = zero, ax1 = zero;
#pragma unroll
            for (int ks = 0; ks < NKS; ++ks) { const int c0 = 64 * ks + 16 * q, o1 = (16 + n) * ROWB + (IS_GLA ? c0 : (c0 ^ (n << 4)));
                const bf16x8 qf = __builtin_bit_cast(bf16x8, *(const LAS u32x4*)(sb + OQ + o1)), kf1 = __builtin_bit_cast(bf16x8, *(const LAS u32x4*)(sb + OK + o1));
                if (ks & 1) { ao1 = __builtin_amdgcn_mfma_f32_16x16x32_bf16(qf, sbf[ks], ao1, 0, 0, 0); ax1 = __builtin_amdgcn_mfma_f32_16x16x32_bf16(kf0[ks], qf, ax1, 0, 0, 0); ap1 = __builtin_amdgcn_mfma_f32_16x16x32_bf16(kf1, qf, ap1, 0, 0, 0); }
                else { ao = __builtin_amdgcn_mfma_f32_16x16x32_bf16(qf, sbf[ks], ao, 0, 0, 0); ax = __builtin_amdgcn_mfma_f32_16x16x32_bf16(kf0[ks], qf, ax, 0, 0, 0); ap = __builtin_amdgcn_mfma_f32_16x16x32_bf16(kf1, qf, ap, 0, 0, 0); } }
            ao = ao + ao1; ap = ap + ap1; ax = ax + ax1;
#pragma unroll
            for (int r = 0; r < 4; ++r) if (4 * q + r > n) ap[r] = 0.f;
            p10a = cvt_pk_bf16(ax[0], ax[1]); p10b = cvt_pk_bf16(ax[2], ax[3]);
            const bf16x8 pa = __builtin_bit_cast(bf16x8, (u32x4){p10a, p10b, cvt_pk_bf16(ap[0], ap[1]), cvt_pk_bf16(ap[2], ap[3])});
            ao = __builtin_amdgcn_mfma_f32_16x16x32_bf16(pa, vf8, ao, 0, 0, 0);
#pragma unroll
            for (int r = 0; r < 4; ++r) op[(size_t)(16 + 4 * q + r) * OW] = ao[r];
        }
    }
#pragma unroll
    for (int mb = 0; mb < NMB; ++mb) {
        const f32x4 dl = *(const LAS f32x4*)(sb + ODL + (16 * mb + 4 * q) * 4);
        const bf16x8 ktf = __builtin_bit_cast(bf16x8, *(const LAS u32x4*)(sb + OKT + (16 * mb + n) * 64 + 16 * q));
        S[mb] = __builtin_amdgcn_mfma_f32_16x16x32_bf16(ktf, vf8, S[mb] * dl, 0, 0, 0); }
}
constexpr size_t ST_REC = 98304;
constexpr int NSEG_HG = 4, NSEG_GL = 6, NSEG_MAX = 6;
__device__ __forceinline__ int seg_u0(bool gla, int s) { return gla ? (s <= 2 ? 44 * s : 88 + 42 * (s - 2)) : 64 * s; }
__device__ __forceinline__ int seg_nu(bool gla, int s) { return gla ? (s < 2 ? 44 : 42) : 64; }
template <int DK, int MODE>
__device__ __forceinline__ void chain_item(const unsigned char* blk0, int vt_off, float* op0, unsigned char* st, int seg, int nunits, LAS unsigned char* lds, int wave, int lane) {
    asm volatile("" : "+v"(lane), "+s"(wave));
    constexpr bool IS_GLA = (DK == 192);
    constexpr int BLK = IS_GLA ? GL_BLK : HG_BLK, UNITB = IS_GLA ? GL_SHARED + 8192 : HG_BLK, NMB = DK / 16;
    constexpr int SH0 = MODE == 1 ? 0 : (IS_GLA ? GL_OKT : HG_OKT);
    constexpr int SH_PIECES = (MODE == 1 ? (IS_GLA ? GL_SHARED : HG_BLK) : (IS_GLA ? GL_ODL + 768 - GL_OKT : HG_BLK - HG_OKT)) / 16;
    constexpr int T_PIECES = IS_GLA ? 512 : 0, T_LDS = GL_OVT;
    constexpr int PIECES = SH_PIECES + T_PIECES, NP = (PIECES + 511) / 512;
    constexpr int ODL_ = IS_GLA ? GL_ODL : HG_ODL;
    const int tid = wave * 64 + lane, n = lane & 15, q = lane >> 4;
    f32x4 S[NMB]; float dacc = 1.0f;
#pragma unroll
    for (int mb = 0; mb < NMB; ++mb) S[mb] = (f32x4){0.f, 0.f, 0.f, 0.f};
    if (MODE == 1) {
        for (int s = 0; s < seg; ++s) { const unsigned char* rec = st + (size_t)s * 2 * ST_REC + (size_t)(wave * 64 + lane) * 16;
#pragma unroll
            for (int mb = 0; mb < NMB; ++mb) { const f32x4 h = *(const f32x4*)(rec + (size_t)mb * 8192), d = *(const f32x4*)(st + (size_t)s * 2 * ST_REC + ST_REC + (16 * mb + 4 * q) * 4); S[mb] = S[mb] * d + h; } }
    }
    u32x4 stgA[NP], stgB[NP];
#define CH_SRC(u, p_) (blk0 + (size_t)(u) * BLK + ((p_) < SH_PIECES ? SH0 + (p_) * 16 : vt_off + ((p_) - SH_PIECES) * 16))
#define CH_DST(p_) ((p_) < SH_PIECES ? SH0 + (p_) * 16 : T_LDS + ((p_) - SH_PIECES) * 16)
#define CH_LOAD(stg, u) do { _Pragma("unroll") for (int r_ = 0; r_ < NP; ++r_) { const int p_ = r_ * 512 + tid; const bool ok_ = (NP * 512 == PIECES) || p_ < PIECES; const int pc_ = ok_ ? p_ : 0; stg[r_] = *(const u32x4*)CH_SRC(u, pc_); } } while (0)
#define CH_STORE(stg, buf) do { _Pragma("unroll") for (int r_ = 0; r_ < NP; ++r_) { const int p_ = r_ * 512 + tid; const bool ok_ = (NP * 512 == PIECES) || p_ < PIECES; const int pc_ = ok_ ? p_ : 0; \
        const int d_ = ok_ ? (buf) * UNITB + CH_DST(pc_) : 2 * UNITB + (p_ - PIECES) * 16; *(LAS u32x4*)(lds + d_) = stg[r_]; } } while (0)
#define CH_SYNC() do { asm volatile("s_waitcnt lgkmcnt(0)" ::: "memory"); __builtin_amdgcn_s_barrier(); asm volatile("" ::: "memory"); } while (0)
    CH_LOAD(stgA, 0); CH_STORE(stgA, 0);
    CH_LOAD(stgA, 1);
    CH_SYNC();
    float* op = op0 + 16 * wave + n;
    for (int u = 0; u < nunits; u += 2) {
        if (u + 2 < nunits) CH_LOAD(stgB, u + 2);
        chain_unit<DK, MODE>(lds, S, op + (size_t)(u * 32) * OW, wave, n, q);
        if (MODE == 0 && tid < DK) dacc *= *(const LAS float*)(lds + ODL_ + 4 * tid);
        CH_STORE(stgA, 1);
        CH_SYNC();
        if (u + 3 < nunits) CH_LOAD(stgA, u + 3);
        chain_unit<DK, MODE>(lds + UNITB, S, op + (size_t)(u * 32 + 32) * OW, wave, n, q);
        if (MODE == 0 && tid < DK) dacc *= *(const LAS float*)(lds + UNITB + ODL_ + 4 * tid);
        if (u + 2 < nunits) CH_STORE(stgB, 0);
        CH_SYNC();
    }
    if (MODE == 0) { unsigned char* rec = st + (size_t)seg * 2 * ST_REC + (size_t)(wave * 64 + lane) * 16;
#pragma unroll
        for (int mb = 0; mb < NMB; ++mb) *(f32x4*)(rec + (size_t)mb * 8192) = S[mb];
        if (tid < DK) *(float*)(st + (size_t)seg * 2 * ST_REC + ST_REC + 4 * tid) = dacc; }
#undef CH_SRC
#undef CH_DST
#undef CH_LOAD
#undef CH_STORE
#undef CH_SYNC
}

template <int MODE>
__device__ __forceinline__ void phase_chain(const Ctx& a, int l, LAS unsigned char* lds, int wave, int lane) {
    const int bx = blockIdx.x, G = gridDim.x;
    constexpr int nhg = 24 * (MODE == 0 ? NSEG_HG - 1 : NSEG_HG), nitems = nhg + 24 * (MODE == 0 ? NSEG_GL - 1 : NSEG_GL);
    for (int it = bx; it < nitems; it += G) {
        const bool gla = it >= nhg; const int j = gla ? it - nhg : it, c = j % 24, seg = j / 24, u0 = seg_u0(gla, seg), nu = seg_nu(gla, seg);
        unsigned char* st = a.ws() + WS_ST + (size_t)(gla ? 24 + c : c) * (NSEG_MAX - 1) * 2 * ST_REC;
        if (!gla) { const int b = c / 12, h = c % 12;
            chain_item<128, MODE>(a.ws() + WS_HGB + ((size_t)(b * 12 + h) * NUNIT + u0) * HG_BLK, 0, (float*)(a.ws() + WS_O) + ((size_t)b * SEQ + u0 * 32) * OW + h * 128, st, seg, nu, lds, wave, lane); }
        else { const int b = c / 12, h = (c % 12) / 3, sl = c % 3;
            chain_item<192, MODE>(a.ws() + WS_GLB + ((size_t)(b * 4 + h) * NUNIT + u0) * GL_BLK, GL_OVT + 8192 * sl, (float*)(a.ws() + WS_O) + ((size_t)b * SEQ + u0 * 32) * OW + HGW + h * 384 + sl * 128, st, seg, nu, lds, wave, lane); }
        __syncthreads();
    }
    if (MODE == 0) { for (int it = (G >= nitems + 16) ? bx - nitems : bx; it < 16; it += G) { if (it < 0) continue; s5_scan_item(a, l, it, wave, lane); } }
}
__device__ __forceinline__ float red16(float v) {
    v += __int_as_float(__builtin_amdgcn_mov_dpp(__float_as_int(v), 0xB1, 0xF, 0xF, true)); v += __int_as_float(__builtin_amdgcn_mov_dpp(__float_as_int(v), 0x4E, 0xF, 0xF, true));
    v += __int_as_float(__builtin_amdgcn_mov_dpp(__float_as_int(v), 0x141, 0xF, 0xF, true)); v += __int_as_float(__builtin_amdgcn_mov_dpp(__float_as_int(v), 0x140, 0xF, 0xF, true)); return v; }
__device__ __forceinline__ void phase_finalize(const Ctx& a, int l, int wave, int lane) {
    const bf16_t* P = (const bf16_t*)(a.ws() + WS_P); const float* O = (const float*)(a.ws() + WS_O); bf16_t* MX = (bf16_t*)(a.ws() + WS_MIXED);
    const float* hgg = a.in(I_HGG) + l * HGW; const float* hgb = a.in(I_HGB) + l * HGW; const float* glg = a.in(I_GLG) + l * HGW;
    const int gw = blockIdx.x * 8 + wave, NGW = gridDim.x * 8;
    for (int row = gw; row < MTOK; row += NGW) {
        const float* orow = O + (size_t)row * OW; const bf16_t* prow = P + (size_t)row * INP; bf16_t* mrow = MX + (size_t)row * DM;
#pragma unroll
        for (int it = 0; it < 3; ++it) { const int c = (it * 4 + (lane >> 4)) * 128 + (lane & 15) * 8;
            const f32x4 o0 = *(const f32x4*)(orow + c), o1 = *(const f32x4*)(orow + c + 4); const u32x4 gg = *(const u32x4*)(prow + C_GB + c);
            float v[8] = {sigmoidf_(bf_lo(gg.x)) * o0[0], sigmoidf_(bf_hi(gg.x)) * o0[1], sigmoidf_(bf_lo(gg.y)) * o0[2], sigmoidf_(bf_hi(gg.y)) * o0[3],
                          sigmoidf_(bf_lo(gg.z)) * o1[0], sigmoidf_(bf_hi(gg.z)) * o1[1], sigmoidf_(bf_lo(gg.w)) * o1[2], sigmoidf_(bf_hi(gg.w)) * o1[3]};
            float s = 0.f, ss = 0.f;
#pragma unroll
            for (int i = 0; i < 8; ++i) { s += v[i]; ss += v[i] * v[i]; }
            s = red16(s); ss = red16(ss);
            const float mu = s * (1.0f / 128.0f), rs = 1.0f / sqrtf(fmaxf(ss * (1.0f / 128.0f) - mu * mu, 0.f) + LN_EPS);
            const f32x4 g0 = *(const f32x4*)(hgg + c), g1 = *(const f32x4*)(hgg + c + 4), b0 = *(const f32x4*)(hgb + c), b1 = *(const f32x4*)(hgb + c + 4);
            u32x4 w; w.x = cvt_pk_bf16((v[0] - mu) * rs * g0[0] + b0[0], (v[1] - mu) * rs * g0[1] + b0[1]); w.y = cvt_pk_bf16((v[2] - mu) * rs * g0[2] + b0[2], (v[3] - mu) * rs * g0[3] + b0[3]);
            w.z = cvt_pk_bf16((v[4] - mu) * rs * g1[0] + b1[0], (v[5] - mu) * rs * g1[1] + b1[1]); w.w = cvt_pk_bf16((v[6] - mu) * rs * g1[2] + b1[2], (v[7] - mu) * rs * g1[3] + b1[3]);
            *(u32x4*)(mrow + S5W + c) = w; }
#pragma unroll
        for (int h = 0; h < 4; ++h) { const int c = h * 384 + lane * 8; const bool act = lane < 48;
            f32x4 o0 = (f32x4){0.f, 0.f, 0.f, 0.f}, o1 = o0; u32x4 gg = (u32x4){0u, 0u, 0u, 0u};
            if (act) { o0 = *(const f32x4*)(orow + HGW + c); o1 = *(const f32x4*)(orow + HGW + c + 4); gg = *(const u32x4*)(prow + C_GC + c); }
            const float ss = wave_sum((o0[0] * o0[0] + o0[1] * o0[1]) + (o0[2] * o0[2] + o0[3] * o0[3]) + (o1[0] * o1[0] + o1[1] * o1[1]) + (o1[2] * o1[2] + o1[3] * o1[3]));
            const float rms = 1.0f / sqrtf(ss * (1.0f / 384.0f) + LN_EPS);
            if (act) { const f32x4 g0 = *(const f32x4*)(glg + c), g1 = *(const f32x4*)(glg + c + 4);
                const float z[8] = {bf_lo(gg.x), bf_hi(gg.x), bf_lo(gg.y), bf_hi(gg.y), bf_lo(gg.z), bf_hi(gg.z), bf_lo(gg.w), bf_hi(gg.w)};
                u32x4 w; w.x = cvt_pk_bf16(o0[0] * rms * g0[0] * (z[0] * sigmoidf_(z[0])), o0[1] * rms * g0[1] * (z[1] * sigmoidf_(z[1])));
                w.y = cvt_pk_bf16(o0[2] * rms * g0[2] * (z[2] * sigmoidf_(z[2])), o0[3] * rms * g0[3] * (z[3] * sigmoidf_(z[3])));
                w.z = cvt_pk_bf16(o1[0] * rms * g1[0] * (z[4] * sigmoidf_(z[4])), o1[1] * rms * g1[1] * (z[5] * sigmoidf_(z[5])));
                w.w = cvt_pk_bf16(o1[2] * rms * g1[2] * (z[6] * sigmoidf_(z[6])), o1[3] * rms * g1[3] * (z[7] * sigmoidf_(z[7])));
                *(u32x4*)(mrow + S5W + HGW + c) = w; } }
    }
}

constexpr int PH_PRO = 0, PH_MOD = 1, PH_LN0 = 2, PH_L0 = 3, PH_PER_LAYER = 10, N_PHASES = PH_L0 + DEPTH * PH_PER_LAYER;
constexpr int CW_BAR = 4096;

__global__ void __launch_bounds__(512, 2) hybrid_fwd(Args args) {
    extern __shared__ __attribute__((aligned(16))) unsigned char lds_raw[];
    LAS unsigned char* lds = (LAS unsigned char*)lds_raw;
    const int wave = __builtin_amdgcn_readfirstlane((int)threadIdx.x >> 6);
#define lane lane_id_v()
    volatile LAS unsigned* MISC = (volatile LAS unsigned*)(lds + LDSCTL_OFF);
    Ctx ctx; ctx.t = (volatile LAS unsigned long long*)(lds + LDSCTL_OFF + 64);
    if (wave == 0) { const int ln_ = lane; unsigned long long v = 0ull;
#pragma unroll
        for (int i = 0; i < N_IN; ++i) v = (ln_ == i) ? (unsigned long long)args.in[i] : v;
        v = (ln_ == 30) ? (unsigned long long)args.out : v; v = (ln_ == 31) ? (unsigned long long)args.ws : v;
        if (ln_ < 32) ctx.t[ln_] = v;
        if (ln_ < 16) MISC[ln_] = 0u; }
    __syncthreads();
    const int lo = args.ph_lo, hi = args.ph_hi;
    XcdBarrier bar; bar.bar = (unsigned*)(ctx.ws() + WS_CTL) + CW_BAR; bar.x = 0; bar.st = nullptr; bar.w0 = (wave == 0) ? 1u : 0u;
    if (hi - lo > 1) bar = xcd_barrier_post((unsigned*)(ctx.ws() + WS_CTL) + CW_BAR, MISC + 8, (wave == 0) ? 1u : 0u);
#define IN(k) (lo <= (k) && (k) < hi)
#define OPQ() int ln = lane, wv = wave; asm volatile("" : "+s"(wv))
#define SEAM(k) do { if (IN(k) && IN((k) + 1)) xcd_barrier(bar); } while (0)
#define WSP(T, off) ((T*)(ctx.ws() + (off)))

    if (IN(PH_PRO)) { OPQ(); phase_prologue(ctx, lds, wv, ln); }
    SEAM(PH_PRO);
    if (IN(PH_MOD)) { OPQ(); phase_mod(ctx, wv, ln); }
    SEAM(PH_MOD);
    if (IN(PH_LN0)) { OPQ(); phase_h0(ctx.in(I_X), WSP(float, WS_MOD), WSP(bf16_t, WS_H), wv, ln); }
    SEAM(PH_LN0);

    for (int l = 0; l < DEPTH; ++l) {
        const int p0 = PH_L0 + l * PH_PER_LAYER;
        const size_t wto = WS_WT + (size_t)l * WT_LAYER, modo = WS_MOD + (size_t)l * NB * 6 * DM * 4;
        if (IN(p0 + 0)) { pg8::Gemm g{WSP(bf16_t, WS_H), WSP(const bf16_t, wto + WT_IN), MTOK, INP, DM}; pg8::StaticOrder S; S.init(MTOK, INP, (int)gridDim.x, (int)blockIdx.x);
            EpiProj E{WSP(bf16_t, WS_P), WSP(bf16_t, WS_UX)}; pg8::gemm_phase<EpiProj, pg8::StaticOrder, true, true>(lds, g, S, E, wave); }
        SEAM(p0 + 0);
        if (IN(p0 + 1)) {
            { pg8::Gemm g{WSP(bf16_t, WS_UX), WSP(const bf16_t, WS_S5W1 + (size_t)l * S5_W1_LAYER), 64 * 256, 64 * 256, S5K}; S5Order S{(int)gridDim.x, (int)blockIdx.x, 64, 0};
              EpiS5A E{WSP(float, WS_SLOC)}; pg8::gemm_phase<EpiS5A, S5Order, true, true>(lds, g, S, E, wave); }
            { OPQ(); phase_pre(ctx, l, lds, wv, ln); }
            }
        SEAM(p0 + 1);
        if (IN(p0 + 2)) { OPQ(); phase_chain<0>(ctx, l, lds, wv, ln); }
        SEAM(p0 + 2);
        if (IN(p0 + 3)) {
            { pg8::Gemm g{WSP(bf16_t, WS_UX), WSP(const bf16_t, WS_S5T + (size_t)l * S5_T_LAYER), 64 * 256, 64 * 1024, S5K}; S5Order S{(int)gridDim.x, (int)blockIdx.x, 256, 2};
              EpiS5C E{WSP(bf16_t, WS_Z)}; pg8::gemm_phase<EpiS5C, S5Order, true, true>(lds, g, S, E, wave); }
            { OPQ(); phase_chain<1>(ctx, l, lds, wv, ln); } }
        SEAM(p0 + 3);
        if (IN(p0 + 4)) { pg8::Gemm g{WSP(bf16_t, WS_Z), WSP(const bf16_t, wto + WT_GLU), MTOK, S5W, S5W}; pg8::StaticOrder S; S.init(MTOK, S5W, (int)gridDim.x, (int)blockIdx.x);
            EpiGlu E{WSP(bf16_t, WS_Z), WSP(bf16_t, WS_MIXED), ctx.in(I_GLUB) + l * S5W}; pg8::gemm_phase<EpiGlu, pg8::StaticOrder, true, true>(lds, g, S, E, wave);
            { OPQ(); phase_finalize(ctx, l, wv, ln); } }
        SEAM(p0 + 4);
        if (IN(p0 + 5)) { pg8::Gemm g{WSP(bf16_t, WS_MIXED), WSP(const bf16_t, wto + WT_OUT), MTOK, DM, DM}; pg8::StaticOrder S; S.init(MTOK, DM, (int)gridDim.x, (int)blockIdx.x);
            EpiDelta E{WSP(bf16_t, WS_DELTA), WSP(float, modo) + 2 * DM};
            pg8::gemm_phase<EpiDelta, pg8::StaticOrder, true, true>(lds, g, S, E, wave); }
        SEAM(p0 + 5);
        if (IN(p0 + 6)) { OPQ(); phase_lnres<true>(l == 0 ? ctx.in(I_X) : ctx.out(), WSP(bf16_t, WS_DELTA), ctx.out(), ctx.in(I_LN1G) + l * DM, ctx.in(I_LN1B) + l * DM, WSP(float, modo), 3, 4, WSP(bf16_t, WS_H), lds, wv, ln); }
        SEAM(p0 + 6);
        if (IN(p0 + 7)) { pg8::Gemm g{WSP(bf16_t, WS_H), WSP(const bf16_t, wto + WT_GU), MTOK, 2 * DFF, DM}; pg8::StaticOrder S; S.init(MTOK, 2 * DFF, (int)gridDim.x, (int)blockIdx.x);
            EpiSwiglu E{WSP(bf16_t, WS_P)}; pg8::gemm_phase<EpiSwiglu, pg8::StaticOrder, true, true>(lds, g, S, E, wave); }
        SEAM(p0 + 7);
        if (IN(p0 + 8)) { pg8::Gemm g{WSP(bf16_t, WS_P), WSP(const bf16_t, wto + WT_DN), MTOK, DM, DFF}; pg8::StaticOrder S; S.init(MTOK, DM, (int)gridDim.x, (int)blockIdx.x);
            EpiDelta E{WSP(bf16_t, WS_DELTA), WSP(float, modo) + 5 * DM};
            pg8::gemm_phase<EpiDelta, pg8::StaticOrder, true, true>(lds, g, S, E, wave); }
        SEAM(p0 + 8);
        if (IN(p0 + 9)) { OPQ();
            if (l + 1 < DEPTH) phase_lnres<true>(ctx.out(), WSP(bf16_t, WS_DELTA), ctx.out(), ctx.in(I_LN2G) + l * DM, ctx.in(I_LN2B) + l * DM, WSP(float, modo) + (size_t)NB * 6 * DM, 0, 1, WSP(bf16_t, WS_H), lds, wv, ln);
            else phase_lnres<false>(ctx.out(), WSP(bf16_t, WS_DELTA), ctx.out(), ctx.in(I_LN2G) + l * DM, ctx.in(I_LN2B) + l * DM, nullptr, 0, 0, nullptr, lds, wv, ln);
        }
        SEAM(p0 + 9);
    }
#undef IN
#undef SEAM
#undef OPQ
#undef WSP
#undef lane
}

extern "C" void kernel_launch(void* const* d_in, const int* in_sizes, int n_in, void* d_out, int out_size, void* d_ws, size_t ws_size, hipStream_t stream) {
    static int grid = 0;
    if (grid == 0) {
        if (n_in != N_IN || out_size != MTOK * DM || ws_size < WS_END) { fprintf(stderr, "kernel_launch: unexpected problem (n_in %d, out %d, ws %zu < %zu); nothing launched\n", n_in, out_size, ws_size, (size_t)WS_END); grid = -1; return; }
        int dev = 0, cus = 0, per_cu = 0;
        if (hipGetDevice(&dev) != hipSuccess || hipDeviceGetAttribute(&cus, hipDeviceAttributeMultiprocessorCount, dev) != hipSuccess) { grid = -1; return; }
        if (hipFuncSetAttribute((const void*)hybrid_fwd, hipFuncAttributeMaxDynamicSharedMemorySize, LDS_BYTES) != hipSuccess) { fprintf(stderr, "kernel_launch: hipFuncSetAttribute failed\n"); grid = -1; return; }
        if (hipOccupancyMaxActiveBlocksPerMultiprocessor(&per_cu, (const void*)hybrid_fwd, 512, LDS_BYTES) != hipSuccess || per_cu < 1) fprintf(stderr, "kernel_launch: occupancy query reports %d blocks per CU\n", per_cu);
        (void)hipGetLastError();
        grid = cus;
    }
    if (grid < 0) return;
    (void)in_sizes;
    if (hipMemsetAsync((char*)d_ws + WS_CTL, 0, CTL_ZERO_BYTES, stream) != hipSuccess) return;
    Args a{};
    for (int i = 0; i < N_IN; ++i) a.in[i] = (const float*)d_in[i];
    a.out = (float*)d_out; a.ws = (unsigned char*)d_ws;
    a.ph_lo = 0; a.ph_hi = N_PHASES; hipLaunchKernelGGL(hybrid_fwd, dim3(grid), dim3(512), LDS_BYTES, stream, a);
}
```

```cpp
#include <hip/hip_runtime.h>
#include <cstdio>
#include <cstdint>
namespace pg8 {
#define PG8_LAS __attribute__((address_space(3)))
typedef unsigned short bf16_t;
typedef short bf16x8 __attribute__((ext_vector_type(8)));
typedef float f32x4 __attribute__((ext_vector_type(4)));
typedef unsigned u32x4 __attribute__((ext_vector_type(4)));
constexpr int BM = 256, BK = 64, HALF = 128, HTB = HALF * BK * 2  , STAGE_BYTES = 8 * HTB, NXCD = 8, WGM = 8;

__host__ __device__ __forceinline__ int lds_byte(int r, int c) { const int st = (r >> 4) * 2 + (c >> 5), rr = r & 15, cc = c & 31, ob = rr * 64 + cc * 2; return st * 1024 + (ob ^ (((ob >> 9) & 1) << 5)); }
__host__ __device__ __forceinline__ void stage_rc(int b, int& R, int& C) { const int st = b / 1024, sb = b % 1024, swz = sb ^ (((sb >> 9) & 1) << 5); R = (st >> 1) * 16 + swz / 64; C = (st & 1) * 32 + (swz % 64) / 2; }
__host__ __device__ __forceinline__ int perm32(int rho) { const int n = rho >> 4, i = rho & 15; return 8 * (i >> 2) + 4 * n + (i & 3); }

struct Unit { int pm, pn; };
struct Gemm { const bf16_t* A; const bf16_t* Bt; int M, N, K; };

struct StaticOrder {
    int nM, nN, nwg, G, c;
    __host__ __device__ void init(int M, int N, int G_, int c_) { nM = M / BM; nN = N / BM; nwg = nM * nN; G = G_; c = c_; }
    __host__ __device__ bool next(int i, Unit& u) const {
        const long L = (long)i * G + c; if (L >= nwg) return false;
        int wgid = (int)L; { const int q = nwg / NXCD, r = nwg % NXCD, xcd = wgid % NXCD, off = wgid / NXCD; wgid = (xcd < r ? xcd * (q + 1) : r * (q + 1) + (xcd - r) * q) + off; }
        const int nig = WGM * nN, gid = wgid / nig, fm = gid * WGM, gsz = (nM - fm) < WGM ? (nM - fm) : WGM;
        u.pm = fm + ((wgid % nig) % gsz); u.pn = (wgid % nig) / gsz; return true;
    }
    __device__ __forceinline__ void a_ready(const Unit&) const {}
    __device__ __forceinline__ void done(const Unit&) const {}
};
__device__ __forceinline__ unsigned cvt_pk_bf16(float lo, float hi) { unsigned r; asm volatile("v_cvt_pk_bf16_f32 %0, %1, %2" : "=v"(r) : "v"(lo), "v"(hi)); return r; }
typedef float f32x2 __attribute__((ext_vector_type(2)));
template <class Epi, class Sched, bool ALIGN_EPI = false, bool SP2 = false>
__device__ __forceinline__ void gemm_phase(PG8_LAS unsigned char* lds, const Gemm g, const Sched& S, const Epi& E, int wave_id) {
    int tid_; asm volatile("v_mbcnt_lo_u32_b32 %0, -1, 0\n\tv_mbcnt_hi_u32_b32 %0, -1, %0" : "=v"(tid_)); tid_ += wave_id * 64;
    const int tid = tid_, wid = __builtin_amdgcn_readfirstlane(tid >> 6), lane = tid & 63, wr = wid >> 2, wc = wid & 3, fr = lane & 15, fq = lane >> 4;
    const int K = g.K, nt = K / BK;
    unsigned voffA[2], voffB[2];
#pragma unroll
    for (int i = 0; i < 2; ++i) { int R, C; stage_rc(tid * 16 + i * 8192, R, C); const int Rb = Epi::PERM ? ((R & ~31) + perm32(R & 31)) : R;
        voffA[i] = (unsigned)(R * K + C) * 2u; voffB[i] = (unsigned)(Rb * K + C) * 2u; }
    const size_t kstep = (size_t)(BK * 2);
    const size_t hstep = (size_t)HALF * K * 2;
    const size_t tstep = 2 * hstep;
    const unsigned ldsw = (unsigned)wid * 1024u;
    const int aoff = lds_byte(wr * 64 + fr, fq * 8), boff = lds_byte(wc * 32 + fr, fq * 8);
#define PG8_SA(b, h) (((b) * 2 + (h)) * HTB)
#define PG8_SB(b, h) ((4 + (b) * 2 + (h)) * HTB)
#define PG8_STAGE(bufoff, gbase, voff) do { _Pragma("unroll") for (int _i = 0; _i < 2; ++_i) \
        __builtin_amdgcn_global_load_lds((const unsigned*)((const char*)(gbase) + (voff)[_i]), (PG8_LAS unsigned*)(lds + (bufoff) + ldsw + _i * 8192), 16, 0, 0); } while (0)
#define PG8_LDA(dst, b, h) do { _Pragma("unroll") for (int m = 0; m < 4; ++m) _Pragma("unroll") for (int k = 0; k < 2; ++k) dst[m][k] = *(const PG8_LAS bf16x8*)(lds + PG8_SA(b, h) + aoff + m * 2048 + k * 1024); } while (0)
#define PG8_LDB(dst, b, h) do { _Pragma("unroll") for (int n = 0; n < 2; ++n) _Pragma("unroll") for (int k = 0; k < 2; ++k) dst[n][k] = *(const PG8_LAS bf16x8*)(lds + PG8_SB(b, h) + boff + n * 2048 + k * 1024); } while (0)
#define PG8_MMA(ai, bj, At, Bt) do { __builtin_amdgcn_s_setprio(1); _Pragma("unroll") for (int m = 0; m < 4; ++m) _Pragma("unroll") for (int n = 0; n < 2; ++n) _Pragma("unroll") for (int k = 0; k < 2; ++k) \
        acc[ai][bj][m][n] = __builtin_amdgcn_mfma_f32_16x16x32_bf16(Bt[n][k], At[m][k], acc[ai][bj][m][n], 0, 0, 0); __builtin_amdgcn_s_setprio(0); } while (0)
#define PG8_WAIT_V(n) asm volatile("s_waitcnt vmcnt(" #n ")" ::: "memory")
#define PG8_WAIT_L(n) asm volatile("s_waitcnt lgkmcnt(" #n ")" ::: "memory")
#define PG8_BAR __builtin_amdgcn_s_barrier()
#define PG8_SCHED __builtin_amdgcn_sched_barrier(0)
    Unit cur, nxt; int ui = 0;
    if (!S.next(0, cur)) return;
    f32x4 acc[2][2][4][2];
#pragma unroll
    for (int a = 0; a < 2; ++a)
#pragma unroll
        for (int b = 0; b < 2; ++b)
#pragma unroll
            for (int m = 0; m < 4; ++m)
#pragma unroll
                for (int n = 0; n < 2; ++n) acc[a][b][m][n] = (f32x4){0.f, 0.f, 0.f, 0.f};
    bf16x8 At[4][2], B0[2][2], B1[2][2];
    const char* cA = (const char*)g.A + (size_t)cur.pm * tstep; const char* cB = (const char*)g.Bt + (size_t)cur.pn * tstep;
    S.a_ready(cur);
    if constexpr (SP2) {
        PG8_STAGE(PG8_SB(0, 0), cB, voffB); PG8_STAGE(PG8_SB(0, 1), cB + hstep, voffB); PG8_STAGE(PG8_SA(0, 0), cA, voffA); PG8_STAGE(PG8_SA(0, 1), cA + hstep, voffA);
        if (wr == 1) PG8_BAR;
        PG8_WAIT_V(2); PG8_BAR;
        PG8_STAGE(PG8_SB(1, 0), cB + kstep, voffB); PG8_STAGE(PG8_SA(1, 0), cA + kstep, voffA); PG8_STAGE(PG8_SB(1, 1), cB + hstep + kstep, voffB);
        PG8_WAIT_V(6); PG8_BAR;
    } else {
        PG8_STAGE(PG8_SB(0, 0), cB, voffB); PG8_STAGE(PG8_SA(0, 0), cA, voffA); PG8_STAGE(PG8_SB(0, 1), cB + hstep, voffB); PG8_STAGE(PG8_SA(0, 1), cA + hstep, voffA);
        if (wr == 1) PG8_BAR;
        PG8_WAIT_V(4); PG8_BAR;
        PG8_STAGE(PG8_SB(1, 0), cB + kstep, voffB); PG8_STAGE(PG8_SA(1, 0), cA + kstep, voffA); PG8_STAGE(PG8_SB(1, 1), cB + hstep + kstep, voffB);
        PG8_WAIT_V(6); PG8_BAR;
    }
    for (;;) {
        const bool has_next = S.next(ui + 1, nxt);
        const char* nA = has_next ? (const char*)g.A + (size_t)nxt.pm * tstep : cA; const char* nB = has_next ? (const char*)g.Bt + (size_t)nxt.pn * tstep : cB;
        for (int t = 0; t < nt; t += 2) {
            const bool last = (t == nt - 2);
            const char* a1 = cA + (size_t)(t + 1) * kstep;
            const char* a2 = last ? nA : cA + (size_t)(t + 2) * kstep; const char* b2 = last ? nB : cB + (size_t)(t + 2) * kstep;
            const char* a3 = a2 + kstep; const char* b3 = b2 + kstep;
            if (last && has_next) S.a_ready(nxt);
            if constexpr (SP2) {
            PG8_LDB(B0, 0, 0); PG8_LDB(B1, 0, 1); PG8_SCHED; PG8_LDA(At, 0, 0); PG8_STAGE(PG8_SA(1, 1), a1 + hstep, voffA);
            PG8_WAIT_V(8); PG8_WAIT_L(0); PG8_BAR; PG8_MMA(0, 0, At, B0); PG8_MMA(0, 1, At, B1); PG8_BAR; PG8_SCHED;
            PG8_LDA(At, 0, 1); PG8_STAGE(PG8_SB(0, 0), b2, voffB); PG8_STAGE(PG8_SB(0, 1), b2 + hstep, voffB); PG8_STAGE(PG8_SA(0, 0), a2, voffA);
            PG8_WAIT_V(8); PG8_WAIT_L(0); PG8_BAR; PG8_MMA(1, 0, At, B0); PG8_MMA(1, 1, At, B1); PG8_BAR; PG8_SCHED;
            PG8_LDB(B0, 1, 0); PG8_LDB(B1, 1, 1); PG8_SCHED; PG8_LDA(At, 1, 0); PG8_STAGE(PG8_SA(0, 1), a2 + hstep, voffA);
            PG8_WAIT_V(8); PG8_WAIT_L(0); PG8_BAR; PG8_MMA(0, 0, At, B0); PG8_MMA(0, 1, At, B1); PG8_BAR; PG8_SCHED;
            PG8_LDA(At, 1, 1); PG8_STAGE(PG8_SB(1, 0), b3, voffB); PG8_STAGE(PG8_SB(1, 1), b3 + hstep, voffB); PG8_STAGE(PG8_SA(1, 0), a3, voffA);
            PG8_WAIT_V(8); PG8_WAIT_L(0); PG8_BAR; PG8_MMA(1, 0, At, B0); PG8_MMA(1, 1, At, B1); PG8_BAR; PG8_SCHED;
            } else {
            PG8_LDB(B0, 0, 0); PG8_SCHED; PG8_LDA(At, 0, 0); PG8_STAGE(PG8_SA(1, 1), a1 + hstep, voffA);
            PG8_WAIT_L(8); PG8_BAR; PG8_WAIT_L(0); PG8_MMA(0, 0, At, B0); PG8_BAR; PG8_SCHED;
            PG8_LDB(B1, 0, 1); PG8_STAGE(PG8_SB(0, 0), b2, voffB);
            PG8_BAR; PG8_WAIT_L(0); PG8_MMA(0, 1, At, B1); PG8_BAR;
            PG8_LDA(At, 0, 1); PG8_STAGE(PG8_SA(0, 0), a2, voffA);
            PG8_BAR; PG8_WAIT_L(0); PG8_MMA(1, 0, At, B0); PG8_BAR; PG8_SCHED;
            PG8_STAGE(PG8_SB(0, 1), b2 + hstep, voffB);
            PG8_WAIT_V(6); PG8_BAR; PG8_MMA(1, 1, At, B1); PG8_BAR;
            PG8_LDB(B0, 1, 0); PG8_SCHED; PG8_LDA(At, 1, 0); PG8_STAGE(PG8_SA(0, 1), a2 + hstep, voffA);
            PG8_WAIT_L(8); PG8_BAR; PG8_WAIT_L(0); PG8_MMA(0, 0, At, B0); PG8_BAR; PG8_SCHED;
            PG8_LDB(B1, 1, 1); PG8_STAGE(PG8_SB(1, 0), b3, voffB);
            PG8_BAR; PG8_WAIT_L(0); PG8_MMA(0, 1, At, B1); PG8_BAR;
            PG8_LDA(At, 1, 1); PG8_STAGE(PG8_SA(1, 0), a3, voffA);
            PG8_BAR; PG8_WAIT_L(0); PG8_MMA(1, 0, At, B0); PG8_BAR; PG8_SCHED;
            PG8_STAGE(PG8_SB(1, 1), b3 + hstep, voffB);
            PG8_WAIT_V(6); PG8_BAR; PG8_MMA(1, 1, At, B1); PG8_BAR;
            }
        }
        if constexpr (ALIGN_EPI) { if (wr == 0) PG8_BAR; }
        if constexpr (!Epi::AFTER_DRAIN) { E(acc, cur, wr, wc, fr, fq); S.done(cur); }
        if (!has_next) break;
#pragma unroll
        for (int a = 0; a < 2; ++a)
#pragma unroll
            for (int b = 0; b < 2; ++b)
#pragma unroll
                for (int m = 0; m < 4; ++m)
#pragma unroll
                    for (int n = 0; n < 2; ++n) acc[a][b][m][n] = (f32x4){0.f, 0.f, 0.f, 0.f};
        cur = nxt; cA = nA; cB = nB; ++ui;
        if constexpr (ALIGN_EPI) { if (wr == 1) PG8_BAR; }
    }
    PG8_WAIT_V(0);
    if constexpr (!ALIGN_EPI) { if (wr == 0) PG8_BAR; }
    PG8_BAR;
    if constexpr (Epi::AFTER_DRAIN) { E.fused(acc, cur, wr, wc, fr, fq, lds, wid, lane); S.done(cur); }
#undef PG8_SA
#undef PG8_SB
#undef PG8_STAGE
#undef PG8_LDA
#undef PG8_LDB
#undef PG8_MMA
#undef PG8_WAIT_V
#undef PG8_WAIT_L
#undef PG8_BAR
#undef PG8_SCHED
}
}
#define LAS __attribute__((address_space(3)))
#define XB_TMO      128
#define XB_XCNT(j)  (256  + 64 * (j))
#define XB_XSUB(j)  (1280 + 64 * (j))
#define XB_XGEN(j)  (2304 + 64 * (j))
#define XB_TOP      3328
#define XB_TOPGEN   3392
#define XCD_BAR_WORDS 3456
#define XB_SPIN_CAP (1u << 24)

__device__ __forceinline__ unsigned xb_ld(unsigned* p)              { return __hip_atomic_load(p, __ATOMIC_RELAXED, __HIP_MEMORY_SCOPE_AGENT); }
__device__ __forceinline__ unsigned xb_add(unsigned* p, unsigned v) { return __hip_atomic_fetch_add(p, v, __ATOMIC_RELAXED, __HIP_MEMORY_SCOPE_AGENT); }
__device__ __forceinline__ unsigned xb_xcc_id() { return (unsigned)__builtin_amdgcn_s_getreg((3 << 11) | 20) & 0xFu; }
#define XB_SPIN(cond, bar) do { unsigned _sp = 0; while (cond) { __builtin_amdgcn_s_sleep(1); \
    if ((++_sp & 255u) == 0u) { if (xb_ld(&(bar)[XB_TMO])) break; if (_sp > XB_SPIN_CAP) { atomicAdd(&(bar)[XB_TMO], 1u); break; } } } } while (0)

struct XcdBarrier {
    unsigned* bar; unsigned x; unsigned w0;
    volatile LAS unsigned* st;
};

__device__ __forceinline__ bool xb_lane0() { unsigned r; asm volatile("v_mbcnt_lo_u32_b32 %0, -1, 0\n\tv_mbcnt_hi_u32_b32 %0, -1, %0" : "=v"(r)); return r == 0u; }
__device__ __forceinline__ XcdBarrier xcd_barrier_post(unsigned* bar, volatile LAS unsigned* st, unsigned w0) {
    XcdBarrier b; b.bar = bar; b.x = xb_xcc_id(); b.st = st; b.w0 = w0;
    if (w0 && xb_lane0()) (void)xb_add(&bar[XB_XCNT(b.x)], 1u);
    return b;
}
__device__ __forceinline__ void xcd_barrier_complete(unsigned* bar, unsigned x, unsigned& nloc, unsigned& nx) {
    const unsigned G = gridDim.x * gridDim.y * gridDim.z;
    unsigned sum, cnt, mine, sp = 0u;
    for (;;) {
        sum = 0u; cnt = 0u; mine = 0u;
#pragma unroll
        for (unsigned j = 0; j < 16; ++j) { const unsigned c = xb_ld(&bar[XB_XCNT(j)]); sum += c; cnt += (c > 0u) ? 1u : 0u; mine = (j == x) ? c : mine; }
        if (sum == G) break;
        __builtin_amdgcn_s_sleep(1);
        if ((++sp & 255u) == 0u) { if (xb_ld(&bar[XB_TMO])) break; if (sp > XB_SPIN_CAP) { atomicAdd(&bar[XB_TMO], 1u); break; } }
    }
    nloc = mine > 0u ? mine : 1u; nx = cnt > 0u ? cnt : 1u;
}

__device__ __forceinline__ void xcd_barrier(const XcdBarrier& b) {
    asm volatile("s_waitcnt vmcnt(0)" ::: "memory");
    __syncthreads();
    if (b.w0 && xb_lane0()) {
        unsigned* bar = b.bar;
        __builtin_amdgcn_s_waitcnt(0);
        unsigned nloc = b.st[0], nx = b.st[1];
        if (nloc == 0u) { xcd_barrier_complete(bar, b.x, nloc, nx); b.st[0] = nloc; b.st[1] = nx; }
        const unsigned old = xb_add(&bar[XB_XSUB(b.x)], 1u);
        const unsigned gen = old / nloc;
        if (old + 1u == (gen + 1u) * nloc) {
            __builtin_amdgcn_fence(__ATOMIC_RELEASE, "agent");
            asm volatile("s_waitcnt vmcnt(0)" ::: "memory");
            const unsigned og = xb_add(&bar[XB_TOP], 1u);
            const unsigned tg = og / nx;
            if (og + 1u == (tg + 1u) * nx) xb_add(&bar[XB_TOPGEN], 1u);
            else XB_SPIN(xb_ld(&bar[XB_TOPGEN]) == tg, bar);
            __builtin_amdgcn_fence(__ATOMIC_ACQUIRE, "agent");
            xb_add(&bar[XB_XGEN(b.x)], 1u);
            asm volatile("s_waitcnt vmcnt(0)" ::: "memory");
        } else {
            XB_SPIN(xb_ld(&bar[XB_XGEN(b.x)]) == gen, bar);
            __builtin_amdgcn_fence(__ATOMIC_ACQUIRE, "agent");
            asm volatile("s_waitcnt vmcnt(0)" ::: "memory");
        }
    }
    __syncthreads();
}

constexpr int DM = 4096, NB = 2, SEQ = 8192, MTOK = NB * SEQ, DEPTH = 4;
constexpr int S5W = 1024;
constexpr int HGW = 1536;
constexpr int GLKW = 768;
constexpr int INW = 11792, INP = 12032, DFF = 11008;
constexpr int OW = 3072;
constexpr int C_U = 0, C_QB = 1024, C_FB = 2560, C_IB = 4096, C_GB = 5632, C_QC = 7168, C_KC = 7936, C_VC = 8704, C_GC = 10240, C_LR = 11776;
constexpr float LN_EPS = 1e-5f;
constexpr float ALPHA = 1.6817928305074290861f;
constexpr float GLA_QSCALE = 0.07216878364870322f;

enum { I_X = 0, I_C, I_WADA, I_BADA, I_TABLE, I_WIN, I_WOUT, I_AREAL, I_AIMAG, I_LOGDT, I_BRE, I_BIM, I_CRE, I_CIM, I_S5D, I_GLUW, I_GLUB,
       I_LBRAW, I_HGG, I_HGB, I_WGATE, I_BGATE, I_GLG, I_WFG, I_WFU, I_WFD, I_LN1G, I_LN1B, I_LN2G, I_LN2B, N_IN };

constexpr size_t MiB = 1u << 20;
constexpr size_t WS_CTL = 0, CTL_ZERO_BYTES = 1 * MiB;
constexpr size_t WS_MOD = 1 * MiB;
constexpr size_t WS_MISC = 2 * MiB;
constexpr size_t WS_CONDPART = 12 * MiB;
constexpr size_t WS_H = 24 * MiB;
constexpr size_t WS_MIXED = WS_H + 128 * MiB;
constexpr size_t WS_Z = WS_MIXED + 128 * MiB;
constexpr size_t WS_O = WS_Z + 32 * MiB;
constexpr size_t WS_DELTA = WS_O;
constexpr size_t WS_P = WS_O + 192 * MiB;
constexpr size_t WS_WT = WS_P + 376 * MiB;
constexpr size_t WT_IN = 0, WT_OUT = 94 * MiB, WT_GU = 126 * MiB, WT_DN = 298 * MiB, WT_GLU = 384 * MiB, WT_LAYER = 386 * MiB;
constexpr size_t WS_HGB = WS_WT + DEPTH * WT_LAYER;
constexpr size_t WS_GLB = WS_HGB + 198 * MiB;
constexpr size_t WS_S5T = WS_GLB + 128 * MiB;
constexpr size_t WS_S5W1 = WS_S5T + 576 * MiB;
constexpr size_t WS_UX = WS_S5W1 + 144 * MiB;
constexpr size_t WS_SLOC = WS_UX + 36 * MiB;
constexpr size_t WS_LAM64 = WS_SLOC + 8 * MiB;
constexpr size_t WS_ST = WS_LAM64 + 1 * MiB;
constexpr size_t WS_END = WS_ST + 45 * MiB;
static_assert((size_t)INP * DM * 2 == 94 * MiB && (size_t)DM * DM * 2 == 32 * MiB && (size_t)2 * DFF * DM * 2 == 172 * MiB && (size_t)DM * DFF * 2 == 86 * MiB, "weight map");
static_assert((size_t)MTOK * INP * 2 == 376 * MiB && (size_t)MTOK * DFF * 2 <= 376 * MiB, "activation map");

constexpr int RING_BYTES = 131072;
constexpr int LDSCTL_OFF = 135168;
constexpr int LDS_BYTES = 147456;

#ifndef LAS
#define LAS __attribute__((address_space(3)))
#endif
#define GAS __attribute__((address_space(1)))
typedef unsigned short bf16_t;
typedef float f32x4 __attribute__((ext_vector_type(4)));
typedef float f32x2 __attribute__((ext_vector_type(2)));
typedef unsigned u32x4 __attribute__((ext_vector_type(4)));
typedef unsigned u32x2 __attribute__((ext_vector_type(2)));
#define LDS_WAIT() asm volatile("s_waitcnt lgkmcnt(0)" ::: "memory")
#define VM_WAIT() asm volatile("s_waitcnt vmcnt(0)" ::: "memory")
typedef __bf16 bf16x2_t __attribute__((ext_vector_type(2)));
__device__ __forceinline__ unsigned cvt_pk_bf16(float lo, float hi) { return __builtin_bit_cast(unsigned, __builtin_convertvector((f32x2){lo, hi}, bf16x2_t)); }

__device__ __forceinline__ float bf_lo(unsigned w) { return __uint_as_float(w << 16); }
__device__ __forceinline__ float bf_hi(unsigned w) { return __uint_as_float(w & 0xffff0000u); }
__device__ __forceinline__ float bf2f(bf16_t b) { return __uint_as_float(((unsigned)b) << 16); }
__device__ __forceinline__ float wave_sum(float v) {
    v += __int_as_float(__builtin_amdgcn_mov_dpp(__float_as_int(v), 0xB1, 0xF, 0xF, true));
    v += __int_as_float(__builtin_amdgcn_mov_dpp(__float_as_int(v), 0x4E, 0xF, 0xF, true));
    v += __int_as_float(__builtin_amdgcn_mov_dpp(__float_as_int(v), 0x141, 0xF, 0xF, true));
    v += __int_as_float(__builtin_amdgcn_mov_dpp(__float_as_int(v), 0x140, 0xF, 0xF, true));
    const int b = __float_as_int(v);
    return (__int_as_float(__builtin_amdgcn_readlane(b, 0)) + __int_as_float(__builtin_amdgcn_readlane(b, 16))) + (__int_as_float(__builtin_amdgcn_readlane(b, 32)) + __int_as_float(__builtin_amdgcn_readlane(b, 48)));
}
__device__ __forceinline__ float sigmoidf_(float x) { return __builtin_amdgcn_rcpf(1.0f + __expf(-x)); }
__device__ __forceinline__ float gelu_tanh(float y) { const float a = 0.7978845608028654f * (y + 0.044715f * y * y * y); const float t = 1.0f - 2.0f * __builtin_amdgcn_rcpf(1.0f + __expf(2.0f * a)); return 0.5f * y * (1.0f + t); }

struct EpiProj {
    static constexpr bool PERM = true, AFTER_DRAIN = false;
    GAS bf16_t* P; GAS bf16_t* UX;
    __device__ __forceinline__ void operator()(const f32x4 (&acc)[2][2][4][2], const pg8::Unit& u, int wr, int wc, int fr, int fq) const {
        const int row0 = u.pm * 256 + wr * 64 + fr, col0 = u.pn * 256 + wc * 32 + 8 * fq;
        const bool s5 = u.pn < 4;
#pragma unroll
        for (int ai = 0; ai < 2; ++ai)
#pragma unroll
            for (int m = 0; m < 4; ++m) { const int row = row0 + ai * 128 + m * 16;
#pragma unroll
                for (int bj = 0; bj < 2; ++bj) { const f32x4 v0 = acc[ai][bj][m][0], v1 = acc[ai][bj][m][1]; const int col = col0 + bj * 128;
                    u32x4 w; w.x = cvt_pk_bf16(v0[0], v0[1]); w.y = cvt_pk_bf16(v0[2], v0[3]); w.z = cvt_pk_bf16(v1[0], v1[1]); w.w = cvt_pk_bf16(v1[2], v1[3]);
                    if (!s5) *(GAS u32x4*)(P + (size_t)row * INP + col) = w;
                    else { GAS bf16_t* ur = UX + (size_t)((col >> 4) * 256 + (row >> 6)) * 1152; *(GAS u32x4*)(ur + (row & 63) * 16 + (col & 15)) = w;
                        if ((row & 63) == 0) { const u32x4 z = (u32x4){0u, 0u, 0u, 0u}; GAS bf16_t* zp = ur + 1024 + ((col & 15) ? 64 : 0);
#pragma unroll
                            for (int i = 0; i < 8; ++i) *(GAS u32x4*)(zp + 8 * i) = z; } } } }
    }
};
struct EpiSwiglu {
    static constexpr bool PERM = true, AFTER_DRAIN = false;
    GAS bf16_t* HID;
    __device__ __forceinline__ void operator()(const f32x4 (&acc)[2][2][4][2], const pg8::Unit& u, int wr, int wc, int fr, int fq) const {
        const int row0 = u.pm * 256 + wr * 64 + fr, col0 = u.pn * 128 + wc * 32 + 8 * fq;
#pragma unroll
        for (int ai = 0; ai < 2; ++ai)
#pragma unroll
            for (int m = 0; m < 4; ++m) { GAS bf16_t* rowp = HID + (size_t)(row0 + ai * 128 + m * 16) * DFF + col0;
                float o[8];
#pragma unroll
                for (int n = 0; n < 2; ++n)
#pragma unroll
                    for (int j = 0; j < 4; ++j) { const float g = acc[ai][0][m][n][j], up = acc[ai][1][m][n][j]; o[n * 4 + j] = g * __builtin_amdgcn_rcpf(1.0f + __expf(-g)) * up; }
                u32x4 w; w.x = cvt_pk_bf16(o[0], o[1]); w.y = cvt_pk_bf16(o[2], o[3]); w.z = cvt_pk_bf16(o[4], o[5]); w.w = cvt_pk_bf16(o[6], o[7]);
                *(GAS u32x4*)rowp = w; }
    }
};
struct EpiGlu {
    static constexpr bool PERM = true, AFTER_DRAIN = false;
    const GAS bf16_t* Z; GAS bf16_t* MIXED; const GAS float* bias;
    __device__ __forceinline__ void operator()(const f32x4 (&acc)[2][2][4][2], const pg8::Unit& u, int wr, int wc, int fr, int fq) const {
        const int row0 = u.pm * 256 + wr * 64 + fr, col0 = u.pn * 256 + wc * 32 + 8 * fq;
#pragma unroll
        for (int bj = 0; bj < 2; ++bj) {
            const f32x4 b0 = *(const GAS f32x4*)(bias + col0 + bj * 128), b1 = *(const GAS f32x4*)(bias + col0 + bj * 128 + 4);
#pragma unroll
            for (int ai = 0; ai < 2; ++ai)
#pragma unroll
                for (int m = 0; m < 4; ++m) { const size_t r = (size_t)(row0 + ai * 128 + m * 16);
                    const u32x4 zz = *(const GAS u32x4*)(Z + r * S5W + col0 + bj * 128);
                    const f32x4 v0 = acc[ai][bj][m][0] + b0, v1 = acc[ai][bj][m][1] + b1;
                    u32x4 w;
                    w.x = cvt_pk_bf16(bf_lo(zz.x) * sigmoidf_(v0[0]), bf_hi(zz.x) * sigmoidf_(v0[1]));
                    w.y = cvt_pk_bf16(bf_lo(zz.y) * sigmoidf_(v0[2]), bf_hi(zz.y) * sigmoidf_(v0[3]));
                    w.z = cvt_pk_bf16(bf_lo(zz.z) * sigmoidf_(v1[0]), bf_hi(zz.z) * sigmoidf_(v1[1]));
                    w.w = cvt_pk_bf16(bf_lo(zz.w) * sigmoidf_(v1[2]), bf_hi(zz.w) * sigmoidf_(v1[3]));
                    *(GAS u32x4*)(MIXED + r * DM + col0 + bj * 128) = w;
                    if (m & 1) asm volatile("" ::: "memory"); }
        }
    }
};
struct EpiDelta {
    static constexpr bool PERM = true, AFTER_DRAIN = false;
    GAS bf16_t* D; const GAS float* gate0;
    __device__ __forceinline__ void operator()(const f32x4 (&acc)[2][2][4][2], const pg8::Unit& u, int wr, int wc, int fr, int fq) const {
        const int row0 = u.pm * 256 + wr * 64 + fr, col0 = u.pn * 256 + wc * 32 + 8 * fq;
        const GAS float* gp = gate0 + (u.pm >= 32 ? 6 * DM : 0) + col0;
        f32x4 g[2][2];
#pragma unroll
        for (int bj = 0; bj < 2; ++bj)
#pragma unroll
            for (int n = 0; n < 2; ++n) g[bj][n] = *(const GAS f32x4*)(gp + bj * 128 + 4 * n) + 1.0f;
#pragma unroll
        for (int ai = 0; ai < 2; ++ai)
#pragma unroll
            for (int m = 0; m < 4; ++m) { GAS bf16_t* rowp = D + (size_t)(row0 + ai * 128 + m * 16) * DM + col0;
#pragma unroll
                for (int bj = 0; bj < 2; ++bj) { const f32x4 v0 = acc[ai][bj][m][0] * g[bj][0], v1 = acc[ai][bj][m][1] * g[bj][1];
                    u32x4 w; w.x = cvt_pk_bf16(v0[0], v0[1]); w.y = cvt_pk_bf16(v0[2], v0[3]); w.z = cvt_pk_bf16(v1[0], v1[1]); w.w = cvt_pk_bf16(v1[2], v1[3]);
                    *(GAS u32x4*)(rowp + bj * 128) = w; } }
    }
};

__device__ __forceinline__ int lane_id_v() { int r; asm volatile("v_mbcnt_lo_u32_b32 %0, -1, 0\n\tv_mbcnt_hi_u32_b32 %0, -1, %0" : "=v"(r)); return r; }
struct Args { const float* in[N_IN]; float* out; unsigned char* ws; int ph_lo, ph_hi; };
struct Ctx {
    volatile LAS unsigned long long* t;
    __device__ __forceinline__ unsigned long long ld(int i) const { const unsigned long long v = t[i];
        return ((unsigned long long)(unsigned)__builtin_amdgcn_readfirstlane((int)(v >> 32)) << 32) | (unsigned long long)(unsigned)__builtin_amdgcn_readfirstlane((int)(unsigned)v); }
    __device__ __forceinline__ const GAS float* in(int i) const { return (const GAS float*)ld(i); }
    __device__ __forceinline__ GAS float* out() const { return (GAS float*)ld(30); }
    __device__ __forceinline__ GAS unsigned char* ws() const { return (GAS unsigned char*)ld(31); }
};

constexpr int S5K = 1152;
constexpr size_t S5_T_LAYER = (size_t)64 * 1024 * S5K * 2, S5_W1_LAYER = (size_t)64 * 256 * S5K * 2;

struct S5Order {
    int G, c, n, sh;
    __device__ __forceinline__ bool next(int i, pg8::Unit& u) const { const int L = i * G + c; if (L >= n) return false; u.pm = L >> sh; u.pn = L; return true; }
    __device__ __forceinline__ void a_ready(const pg8::Unit&) const {}
    __device__ __forceinline__ void done(const pg8::Unit&) const {}
};
struct EpiS5A {
    static constexpr bool PERM = false, AFTER_DRAIN = false;
    GAS float* Sloc;
    __device__ __forceinline__ void operator()(const f32x4 (&acc)[2][2][4][2], const pg8::Unit& u, int wr, int wc, int fr, int fq) const {
        const int row0 = u.pm * 256 + wr * 64 + fr, col0 = wc * 32 + 4 * fq;
#pragma unroll
        for (int ai = 0; ai < 2; ++ai)
#pragma unroll
            for (int m = 0; m < 4; ++m)
#pragma unroll
                for (int n = 0; n < 2; ++n) *(GAS f32x4*)(Sloc + (size_t)(row0 + ai * 128 + m * 16) * 128 + col0 + n * 16) = acc[ai][0][m][n];
    }
};
struct EpiS5C {
    static constexpr bool PERM = true, AFTER_DRAIN = false;
    GAS bf16_t* Z;
    __device__ __forceinline__ void operator()(const f32x4 (&acc)[2][2][4][2], const pg8::Unit& u, int wr, int wc, int fr, int fq) const {
        const int g = u.pm, c0 = wr * 64 + fr, cc0 = (u.pn & 3) * 256 + wc * 32 + 8 * fq;
#pragma unroll
        for (int ai = 0; ai < 2; ++ai)
#pragma unroll
            for (int m = 0; m < 4; ++m) { const int c = c0 + ai * 128 + m * 16;
#pragma unroll
                for (int bj = 0; bj < 2; ++bj) { const int cc = cc0 + bj * 128, t = cc >> 4, h0 = cc & 15;
                    const f32x4 v0 = acc[ai][bj][m][0], v1 = acc[ai][bj][m][1];
                    u32x4 w; w.x = cvt_pk_bf16(gelu_tanh(v0[0]), gelu_tanh(v0[1])); w.y = cvt_pk_bf16(gelu_tanh(v0[2]), gelu_tanh(v0[3]));
                    w.z = cvt_pk_bf16(gelu_tanh(v1[0]), gelu_tanh(v1[1])); w.w = cvt_pk_bf16(gelu_tanh(v1[2]), gelu_tanh(v1[3]));
                    *(GAS u32x4*)(Z + (size_t)(c * 64 + t) * S5W + g * 16 + h0) = w; } }
    }
};
__device__ __forceinline__ void s5_tables_item(const Ctx& a, int lg, LAS unsigned char* lds, int wave, int lane) {
    LAS f32x2* LP = (LAS f32x2*)lds;
    LAS f32x2* BB = (LAS f32x2*)(lds + 33280);
    LAS f32x2* CC = (LAS f32x2*)(lds + 41472);
    LAS float* KT = (LAS float*)(lds + 49664);
    const int tid = wave * 64 + lane, l = lg >> 6, g = lg & 63;
    if (tid < 64) { const int p = tid;
        const double ar = (double)a.in(I_AREAL)[lg * 64 + p], ai = (double)a.in(I_AIMAG)[lg * 64 + p], dt = exp((double)a.in(I_LOGDT)[lg]);
        const double mag = exp(ar * dt), ang = ai * dt, lr = mag * cos(ang), li = mag * sin(ang);
        const double den = ar * ar + ai * ai, nr = lr - 1.0, ni = li, cr = (nr * ar + ni * ai) / den, ci = (ni * ar - nr * ai) / den;
        double pr = 1.0, pi = 0.0;
        for (int tau = 0; tau <= 64; ++tau) { LP[tau * 64 + p] = (f32x2){(float)pr, (float)pi}; const double nr2 = pr * lr - pi * li, ni2 = pr * li + pi * lr; pr = nr2; pi = ni2; }
        for (int h = 0; h < 16; ++h) { const double br = (double)a.in(I_BRE)[((size_t)lg * 64 + p) * 16 + h], bi = (double)a.in(I_BIM)[((size_t)lg * 64 + p) * 16 + h];
            BB[p * 16 + h] = (f32x2){(float)(cr * br - ci * bi), (float)(cr * bi + ci * br)}; }
    }
    for (int e = tid; e < 1024; e += 512) { const int h = e >> 6, p = e & 63; CC[e] = (f32x2){a.in(I_CRE)[((size_t)lg * 16 + h) * 64 + p], a.in(I_CIM)[((size_t)lg * 16 + h) * 64 + p]}; }
    __syncthreads();
    if (tid < 64) *(GAS f32x2*)((GAS float*)(a.ws() + WS_LAM64) + ((size_t)lg * 64 + tid) * 2) = LP[64 * 64 + tid];
    for (int e = tid; e < 64 * 256; e += 512) { const int tau = e >> 8, h = (e >> 4) & 15, hp = e & 15; float s = 0.f;
#pragma unroll 8
        for (int p = 0; p < 64; ++p) { const f32x2 c = CC[h * 64 + p], lm = LP[tau * 64 + p], b = BB[p * 16 + hp];
            const float xr = c.x * lm.x - c.y * lm.y, xi = c.x * lm.y + c.y * lm.x; s += xr * b.x - xi * b.y; }
        if (tau == 0 && h == hp) s += a.in(I_S5D)[l * S5W + g * 16 + h];
        KT[e] = s; }
    __syncthreads();
    GAS bf16_t* T = (GAS bf16_t*)(a.ws() + WS_S5T + (size_t)l * S5_T_LAYER) + (size_t)g * 1024 * S5K;
    for (int pc = tid; pc < 1024 * 144; pc += 512) { const int n = pc / 144, j = pc % 144, t = n >> 4, h = n & 15; float v[8];
        if (j < 128) { const int s = j >> 1, hp0 = (j & 1) * 8;
            if (s > t) {
#pragma unroll
                for (int i = 0; i < 8; ++i) v[i] = 0.f;
            } else { const LAS float* kp = KT + (t - s) * 256 + h * 16 + hp0; const f32x4 k0 = *(const LAS f32x4*)kp, k1 = *(const LAS f32x4*)(kp + 4);
                v[0] = k0[0]; v[1] = k0[1]; v[2] = k0[2]; v[3] = k0[3]; v[4] = k1[0]; v[5] = k1[1]; v[6] = k1[2]; v[7] = k1[3]; }
        } else { const int p0 = (j - 128) * 4;
#pragma unroll
            for (int i = 0; i < 4; ++i) { const f32x2 c = CC[h * 64 + p0 + i], lm = LP[(t + 1) * 64 + p0 + i]; v[2 * i] = c.x * lm.x - c.y * lm.y; v[2 * i + 1] = -(c.x * lm.y + c.y * lm.x); } }
        *(GAS u32x4*)(T + (size_t)n * S5K + j * 8) = (u32x4){cvt_pk_bf16(v[0], v[1]), cvt_pk_bf16(v[2], v[3]), cvt_pk_bf16(v[4], v[5]), cvt_pk_bf16(v[6], v[7])}; }
    GAS bf16_t* W1 = (GAS bf16_t*)(a.ws() + WS_S5W1 + (size_t)l * S5_W1_LAYER) + (size_t)g * 256 * S5K;
    for (int pc = tid; pc < 256 * 144; pc += 512) { const int n = pc / 144, j = pc % 144; float v[8];
#pragma unroll
        for (int i = 0; i < 8; ++i) v[i] = 0.f;
        if (n < 128 && j < 128) { const int p = n >> 1, ri = n & 1, s = j >> 1, hp0 = (j & 1) * 8; const f32x2 lm = LP[(63 - s) * 64 + p];
#pragma unroll
            for (int i = 0; i < 8; ++i) { const f32x2 b = BB[p * 16 + hp0 + i]; v[i] = ri ? (lm.x * b.y + lm.y * b.x) : (lm.x * b.x - lm.y * b.y); } }
        *(GAS u32x4*)(W1 + (size_t)n * S5K + j * 8) = (u32x4){cvt_pk_bf16(v[0], v[1]), cvt_pk_bf16(v[2], v[3]), cvt_pk_bf16(v[4], v[5]), cvt_pk_bf16(v[6], v[7])}; }
    __syncthreads();
}
__device__ __forceinline__ void s5_scan_item(const Ctx& a, int l, int item, int wave, int lane) {
    const int idx = item * 512 + wave * 64 + lane, g = idx >> 7, b = (idx >> 6) & 1, p = idx & 63;
    const f32x2 lam = *(const GAS f32x2*)((const GAS float*)(a.ws() + WS_LAM64) + ((size_t)(l * 64 + g) * 64 + p) * 2);
    const GAS float* sl = (const GAS float*)(a.ws() + WS_SLOC) + ((size_t)(g * 256 + b * 128)) * 128 + 2 * p;
    GAS bf16_t* ux = (GAS bf16_t*)(a.ws() + WS_UX) + ((size_t)(g * 256 + b * 128)) * S5K + 1024 + 2 * p;
    float xr = 0.f, xi = 0.f;
    for (int c0 = 0; c0 < 128; c0 += 8) { f32x2 s[8];
#pragma unroll
        for (int i = 0; i < 8; ++i) s[i] = *(const GAS f32x2*)(sl + (size_t)(c0 + i) * 128);
#pragma unroll
        for (int i = 0; i < 8; ++i) { *(GAS unsigned*)(ux + (size_t)(c0 + i) * S5K) = cvt_pk_bf16(xr, xi);
            const float nr = lam.x * xr - lam.y * xi + s[i].x, ni = lam.x * xi + lam.y * xr + s[i].y; xr = nr; xi = ni; } }
}

__device__ __forceinline__ void transpose_item(const GAS float* W, int N, int k0, int n0, GAS bf16_t* WT, int drow0, int Kd, LAS float* scr, int lane) {
    const int nl = 4 * (lane & 15), kq = lane >> 4;
    const bool valid = (n0 + nl) < N;
    f32x4 v[16];
#pragma unroll
    for (int i = 0; i < 16; ++i) { const int k = 4 * i + kq; v[i] = valid ? *(const GAS f32x4*)(W + (size_t)(k0 + k) * N + n0 + nl) : (f32x4){0.f, 0.f, 0.f, 0.f}; }
#pragma unroll
    for (int i = 0; i < 16; ++i) { const int k = 4 * i + kq; LAS float* s = scr + k * 65 + nl; s[0] = v[i][0]; s[1] = v[i][1]; s[2] = v[i][2]; s[3] = v[i][3]; }
    LDS_WAIT();
    const int c = lane & 7;
#pragma unroll
    for (int j = 0; j < 8; ++j) { const int n = (lane >> 3) + 8 * j; const LAS float* s = scr + (8 * c) * 65 + n;
        u32x4 o; o.x = cvt_pk_bf16(s[0], s[65]); o.y = cvt_pk_bf16(s[130], s[195]); o.z = cvt_pk_bf16(s[260], s[325]); o.w = cvt_pk_bf16(s[390], s[455]);
        *(GAS u32x4*)(WT + (size_t)(drow0 + n) * Kd + k0 + 8 * c) = o; }
    LDS_WAIT();
}
constexpr int NIT_IN = 64 * 188, NIT_OUT = 64 * 64, NIT_G = 64 * 172, NIT_DN = 172 * 64, NIT_GLU = 16 * 16;
constexpr int NIT_LAYER = NIT_IN + NIT_OUT + 2 * NIT_G + NIT_DN + NIT_GLU;
constexpr int NIT_TR = DEPTH * NIT_LAYER, NIT_COND = 64 * 96;

__device__ __forceinline__ void phase_prologue(const Ctx& a, LAS unsigned char* lds, int wave, int lane) {
    if (blockIdx.x & 1) { for (int lg = blockIdx.x; lg < DEPTH * 64; lg += gridDim.x) s5_tables_item(a, lg, lds, wave, lane); __syncthreads(); }
    LAS float* scr = (LAS float*)(lds + wave * 16640);
    const int gw = blockIdx.x * 8 + wave, NGW = gridDim.x * 8;
    for (int it = gw; it < NIT_TR + NIT_COND; it += NGW) {
        if (it < NIT_TR) {
            const int l = it / NIT_LAYER; int r = it % NIT_LAYER;
            GAS unsigned char* wt = a.ws() + WS_WT + (size_t)l * WT_LAYER;
            if (r < NIT_IN) { const int kb = r / 188, nb = r % 188; transpose_item(a.in(I_WIN) + (size_t)l * DM * INW, INW, 64 * kb, 64 * nb, (GAS bf16_t*)(wt + WT_IN), 64 * nb, DM, scr, lane); continue; } r -= NIT_IN;
            if (r < NIT_OUT) { const int kb = r / 64, nb = r % 64; transpose_item(a.in(I_WOUT) + (size_t)l * DM * DM, DM, 64 * kb, 64 * nb, (GAS bf16_t*)(wt + WT_OUT), 64 * nb, DM, scr, lane); continue; } r -= NIT_OUT;
            if (r < NIT_G) { const int kb = r / 172, nb = r % 172, n0 = 64 * nb; transpose_item(a.in(I_WFG) + (size_t)l * DM * DFF, DFF, 64 * kb, n0, (GAS bf16_t*)(wt + WT_GU), 256 * (n0 / 128) + (n0 % 128), DM, scr, lane); continue; } r -= NIT_G;
            if (r < NIT_G) { const int kb = r / 172, nb = r % 172, n0 = 64 * nb; transpose_item(a.in(I_WFU) + (size_t)l * DM * DFF, DFF, 64 * kb, n0, (GAS bf16_t*)(wt + WT_GU), 256 * (n0 / 128) + 128 + (n0 % 128), DM, scr, lane); continue; } r -= NIT_G;
            if (r < NIT_DN) { const int kb = r / 64, nb = r % 64; transpose_item(a.in(I_WFD) + (size_t)l * DFF * DM, DM, 64 * kb, 64 * nb, (GAS bf16_t*)(wt + WT_DN), 64 * nb, DFF, scr, lane); continue; } r -= NIT_DN;
            { const int kb = r / 16, nb = r % 16; transpose_item(a.in(I_GLUW) + (size_t)l * S5W * S5W, S5W, 64 * kb, 64 * nb, (GAS bf16_t*)(wt + WT_GLU), 64 * nb, S5W, scr, lane); }
        } else {
            const int item = it - NIT_TR, kb = item / 96, jb = item % 96, k0 = 64 * kb, j0 = 256 * jb + 4 * lane;
            const GAS float* c = a.in(I_C);
            float c0 = c[k0 + lane], c1 = c[DM + k0 + lane];
            c0 = c0 / (1.0f + expf(-c0)); c1 = c1 / (1.0f + expf(-c1));
            f32x4 a0 = (f32x4){0.f, 0.f, 0.f, 0.f}, a1 = a0;
            const GAS float* w = a.in(I_WADA) + (size_t)k0 * (6 * DM) + j0;
#pragma unroll 8
            for (int kk = 0; kk < 64; ++kk) { const f32x4 wv = *(const GAS f32x4*)(w + (size_t)kk * (6 * DM));
                const float s0 = __int_as_float(__builtin_amdgcn_readlane(__float_as_int(c0), kk)), s1 = __int_as_float(__builtin_amdgcn_readlane(__float_as_int(c1), kk));
                a0 += wv * s0; a1 += wv * s1; }
            GAS float* cp = (GAS float*)(a.ws() + WS_CONDPART);
            *(GAS f32x4*)(cp + (size_t)(kb * 2 + 0) * (6 * DM) + j0) = a0;
            *(GAS f32x4*)(cp + (size_t)(kb * 2 + 1) * (6 * DM) + j0) = a1;
        }
    }
    __syncthreads();
    if (!(blockIdx.x & 1)) { for (int lg = blockIdx.x; lg < DEPTH * 64; lg += gridDim.x) s5_tables_item(a, lg, lds, wave, lane); }
}
__device__ __forceinline__ void phase_mod(const Ctx& a, int wave, int lane) {
    const int gt = blockIdx.x * 512 + wave * 64 + lane, NT = gridDim.x * 512;
    const GAS float* cp = (const GAS float*)(a.ws() + WS_CONDPART);
    GAS float* mod = (GAS float*)(a.ws() + WS_MOD); GAS float* misc = (GAS float*)(a.ws() + WS_MISC);
    for (int idx = gt; idx < NB * 6 * DM; idx += NT) {
        const int b = idx / (6 * DM), j = idx % (6 * DM);
        float s = a.in(I_BADA)[j];
        for (int kb = 0; kb < 64; ++kb) s += cp[(size_t)(kb * 2 + b) * (6 * DM) + j];
        for (int l = 0; l < DEPTH; ++l) mod[(size_t)((l * 2 + b) * 6) * DM + j] = s + a.in(I_TABLE)[(size_t)l * 6 * DM + j];
    }
    for (int idx = gt; idx < DM; idx += NT) { misc[idx] = 1.0f; misc[DM + idx] = 0.0f; }
    for (int idx = gt; idx < HGW; idx += NT) {
        const GAS float* raw = a.in(I_LBRAW); float r[DEPTH], mx = -3.0e38f;
#pragma unroll
        for (int l = 0; l < DEPTH; ++l) { r[l] = raw[l * HGW + idx]; mx = fmaxf(mx, r[l]); }
        float e[DEPTH], sum = 0.f;
#pragma unroll
        for (int l = 0; l < DEPTH; ++l) { e[l] = expf(r[l] - mx); sum += e[l]; }
        float cum = 0.f;
#pragma unroll
        for (int l = 0; l < DEPTH; ++l) { misc[2 * DM + l * HGW + idx] = cum; if (l + 1 < DEPTH) cum += e[l + 1] / sum; }
    }
}

__device__ __forceinline__ void phase_h0(const GAS float* x, const GAS float* modp, GAS bf16_t* H, int wave, int lane) {
    for (int blk = blockIdx.x; blk < MTOK / 64; blk += gridDim.x) {
        const int r0 = blk * 64, b = (r0 >= SEQ) ? 1 : 0;
        f32x4 A[2], B[2];
#pragma unroll
        for (int jj = 0; jj < 2; ++jj) { const int c = 512 * wave + 256 * jj + 4 * lane; A[jj] = *(const GAS f32x4*)(modp + (size_t)(b * 6 + 1) * DM + c) + 1.0f; B[jj] = *(const GAS f32x4*)(modp + (size_t)(b * 6 + 0) * DM + c); }
#pragma unroll 8
        for (int rl = 0; rl < 64; ++rl) { const size_t off = (size_t)(r0 + rl) * DM + 512 * wave + 4 * lane;
#pragma unroll
            for (int jj = 0; jj < 2; ++jj) { const f32x4 v = *(const GAS f32x4*)(x + off + 256 * jj), y = v * A[jj] + B[jj];
                u32x2 w; w.x = cvt_pk_bf16(y[0], y[1]); w.y = cvt_pk_bf16(y[2], y[3]); *(GAS u32x2*)(H + off + 256 * jj) = w; } }
    }
}
template <bool WITH_H>
__device__ __forceinline__ void phase_lnres(const GAS float* xprev, const GAS bf16_t* delta, GAS float* xout, const GAS float* lng, const GAS float* lnb, const GAS float* modp, int i_shift, int i_scale, GAS bf16_t* H,
                                            LAS unsigned char* lds, int wave, int lane) {
    LAS f32x2* red = (LAS f32x2*)lds;
    for (int blk = blockIdx.x; blk < MTOK / 64; blk += gridDim.x) {
        const int r0 = blk * 64, b = (r0 >= SEQ) ? 1 : 0;
        f32x4 G[2], Bt[2], A[2], B[2];
#pragma unroll
        for (int jj = 0; jj < 2; ++jj) { const int c = 512 * wave + 256 * jj + 4 * lane; G[jj] = *(const GAS f32x4*)(lng + c); Bt[jj] = *(const GAS f32x4*)(lnb + c);
            if (WITH_H) { A[jj] = *(const GAS f32x4*)(modp + (size_t)(b * 6 + i_scale) * DM + c) + 1.0f; B[jj] = *(const GAS f32x4*)(modp + (size_t)(b * 6 + i_shift) * DM + c); } }
        const size_t offb = (size_t)r0 * DM + 512 * wave + 4 * lane;
        f32x4 va[4][2], vb[4][2]; u32x2 da[4][2], db[4][2];
#define LN_LOAD(v_, d_, it_) do { _Pragma("unroll") for (int r = 0; r < 4; ++r) _Pragma("unroll") for (int jj = 0; jj < 2; ++jj) { \
            v_[r][jj] = *(const GAS f32x4*)(xprev + offb + (size_t)((it_) * 4 + r) * DM + 256 * jj); d_[r][jj] = *(const GAS u32x2*)(delta + offb + (size_t)((it_) * 4 + r) * DM + 256 * jj); } } while (0)
#define LN_STEP(v_, d_, it_) do { LAS f32x2* rb = red + ((it_) & 1) * 32; \
            _Pragma("unroll") for (int r = 0; r < 4; ++r) { float s1 = 0.f, s2 = 0.f; \
                _Pragma("unroll") for (int jj = 0; jj < 2; ++jj) { const f32x4 dd = (f32x4){bf_lo(d_[r][jj].x), bf_hi(d_[r][jj].x), bf_lo(d_[r][jj].y), bf_hi(d_[r][jj].y)}; const f32x4 y = v_[r][jj] * ALPHA + dd; v_[r][jj] = y; \
                    s1 += (y[0] + y[1]) + (y[2] + y[3]); s2 += (y[0] * y[0] + y[1] * y[1]) + (y[2] * y[2] + y[3] * y[3]); } \
                s1 = wave_sum(s1); s2 = wave_sum(s2); if (lane == 0) rb[r * 8 + wave] = (f32x2){s1, s2}; } \
            __syncthreads(); \
            _Pragma("unroll") for (int r = 0; r < 4; ++r) { float s1 = 0.f, s2 = 0.f; \
                _Pragma("unroll") for (int w = 0; w < 8; ++w) { const f32x2 p = rb[r * 8 + w]; s1 += p.x; s2 += p.y; } \
                const float mu = s1 * (1.0f / DM), rs = 1.0f / sqrtf(fmaxf(s2 * (1.0f / DM) - mu * mu, 0.f) + LN_EPS); \
                _Pragma("unroll") for (int jj = 0; jj < 2; ++jj) { const f32x4 x = ((v_[r][jj] - mu) * rs) * G[jj] + Bt[jj]; \
                    *(GAS f32x4*)(xout + offb + (size_t)((it_) * 4 + r) * DM + 256 * jj) = x; \
                    if (WITH_H) { const f32x4 y = x * A[jj] + B[jj]; u32x2 w; w.x = cvt_pk_bf16(y[0], y[1]); w.y = cvt_pk_bf16(y[2], y[3]); *(GAS u32x2*)(H + offb + (size_t)((it_) * 4 + r) * DM + 256 * jj) = w; } } } } while (0)
        LN_LOAD(va, da, 0);
        for (int it = 0; it < 16; it += 2) {
            LN_LOAD(vb, db, it + 1);
            LN_STEP(va, da, it);
            if (it + 2 < 16) LN_LOAD(va, da, it + 2);
            LN_STEP(vb, db, it + 1);
        }
#undef LN_LOAD
#undef LN_STEP
        __syncthreads();
    }
}

typedef short bf16x8 __attribute__((ext_vector_type(8)));
constexpr int HG_BLK = 33280, HG_OQ = 0, HG_OK = 8192, HG_OKT = 16384, HG_ODL = 24576, HG_OVT = 25088;
constexpr int GL_BLK = 63488, GL_OQ = 0, GL_OK = 12800, GL_OKT = 25600, GL_ODL = 37888, GL_SHARED = 38912, GL_OVT = 38912;
constexpr int NUNIT = SEQ / 32;

struct PreOut { GAS unsigned char* blk; int oq, ok, okt, odl, rowb; bool swz; };
template <int HALF>
__device__ __forceinline__ float pre_half(const PreOut& P, int d, int pd, float b0, float (&g)[16], const float (&qq)[16], const float (&kk)[16], float (&kta)[16], unsigned (&kt)[16]) {
    float b = b0;
#pragma unroll
    for (int j = 0; j < 16; ++j) { b += g[j]; g[j] = b; }
    const float bl = b;
#pragma unroll
    for (int t = 0; t < 16; t += 2) {
        float kv[2];
#pragma unroll
        for (int tt = 0; tt < 2; ++tt) { const int j = t + tt, row = 16 * HALF + j; const float bj = g[j];
            const int off = row * P.rowb + (P.swz ? ((2 * pd) ^ (j << 4)) : 2 * pd);
            const float qv = qq[j] * __expf(bj), kc = kk[j] * __expf(fminf(-bj, 80.f));
            const float qn = __int_as_float(__builtin_amdgcn_mov_dpp(__float_as_int(qv), 0xB1, 0xF, 0xF, true)), kn = __int_as_float(__builtin_amdgcn_mov_dpp(__float_as_int(kc), 0xB1, 0xF, 0xF, true));
            if ((d & 1) == 0) { *(GAS unsigned*)(P.blk + P.oq + off) = cvt_pk_bf16(qv, qn); *(GAS unsigned*)(P.blk + P.ok + off) = cvt_pk_bf16(kc, kn); }
            kv[tt] = kk[j] * __expf(bl - bj); }
        if (HALF == 0) { kta[t] = kv[0]; kta[t + 1] = kv[1]; } else kt[4 * (t >> 2) + 2 + ((t & 3) >> 1)] = cvt_pk_bf16(kv[0], kv[1]); }
    return bl;
}
__device__ __forceinline__ void pre_tail(const PreOut& P, int d, float bl0, float bl, const float (&kta)[16], unsigned (&kt)[16]) {
    const float dlb = __expf(bl - bl0);
#pragma unroll
    for (int t = 0; t < 16; t += 2) kt[4 * (t >> 2) + ((t & 3) >> 1)] = cvt_pk_bf16(kta[t] * dlb, kta[t + 1] * dlb);
#pragma unroll
    for (int i = 0; i < 4; ++i) *(GAS u32x4*)(P.blk + P.okt + d * 64 + 16 * i) = (u32x4){kt[4 * i], kt[4 * i + 1], kt[4 * i + 2], kt[4 * i + 3]};
    *(GAS float*)(P.blk + P.odl + d * 4) = __expf(bl);
}
__device__ __forceinline__ void phase_pre(const Ctx& a, int l, LAS unsigned char* lds, int wave, int lane) {
    const GAS bf16_t* P = (const GAS bf16_t*)(a.ws() + WS_P);
    int tid = wave * 64 + lane;
    const bool bal = gridDim.x == 256;
    const int t_lo = bal ? (blockIdx.x < 64 ? 13 * (int)blockIdx.x : 832 + 17 * ((int)blockIdx.x - 64)) : (int)blockIdx.x;
    const int t_hi = bal ? t_lo + (blockIdx.x < 64 ? 13 : 17) : NB * NUNIT * 8, t_st = bal ? 1 : (int)gridDim.x;
    for (int task = t_lo; task < t_hi; task += t_st) {
        asm volatile("" : "+v"(tid));
        const int kind = bal ? (task & 7) : ((task + (task >> 8)) & 7), bu = task >> 3, b = bu / NUNIT, un = bu % NUNIT;
        const size_t row0 = (size_t)b * SEQ + un * 32;
        if (kind < 3) {
            const int ch = kind * 512 + tid, h = ch >> 7, d = ch & 127, pd = (d & ~31) + 8 * ((d >> 2) & 3) + 4 * ((d >> 4) & 1) + (d & 3);
            const float lb = ((const GAS float*)(a.ws() + WS_MISC))[2 * DM + l * HGW + ch];
            GAS unsigned char* blk = a.ws() + WS_HGB + ((size_t)(b * 12 + h) * NUNIT + un) * HG_BLK;
            const PreOut po{blk, HG_OQ, HG_OK, HG_OKT, HG_ODL, 256, true};
            float kta[16]; unsigned kt[16], vv[16]; float bl0 = 0.f, bl = 0.f;
#pragma unroll
            for (int half = 0; half < 2; ++half) {
                float g[16], qq[16], kk[16];
#pragma unroll
                for (int j = 0; j < 16; ++j) { const GAS bf16_t* prow = P + (row0 + 16 * half + j) * INP;
                    const float qin = fmaxf(bf2f(prow[C_QB + ch]), -80.f), fin = fminf(fmaxf(bf2f(prow[C_FB + ch]), -80.f), 80.f);
                    const unsigned short v = prow[C_IB + ch];
                    const int w = 4 * (j >> 2) + 2 * half + ((j & 3) >> 1); if (j & 1) vv[w] |= ((unsigned)v) << 16; else vv[w] = v;
                    const float e = __expf(-fin), sg = __builtin_amdgcn_rcpf(1.0f + e);
                    const float f = lb + (1.0f - lb) * sg;
                    g[j] = fmaxf(__logf(f), -100.f); kk[j] = (1.0f - lb) * (e * sg); qq[j] = qin * __builtin_amdgcn_rcpf(1.0f + __expf(-qin)); }
                if (half == 0) { bl0 = pre_half<0>(po, d, pd, 0.f, g, qq, kk, kta, kt); } else { bl = pre_half<1>(po, d, pd, bl0, g, qq, kk, kta, kt); }
            }
#pragma unroll
            for (int i = 0; i < 4; ++i) *(GAS u32x4*)(blk + HG_OVT + d * 64 + 16 * i) = (u32x4){vv[4 * i], vv[4 * i + 1], vv[4 * i + 2], vv[4 * i + 3]};
            pre_tail(po, d, bl0, bl, kta, kt);
        } else if (kind < 5) {
            __syncthreads();
            if (tid < 64) *(LAS u32x4*)(lds + tid * 16) = *(const GAS u32x4*)(P + (row0 + (tid >> 1)) * INP + C_LR + 8 * (tid & 1));
            __syncthreads();
            if (tid < 384) {
                const int ch = (kind - 3) * 384 + tid, h = ch / 192, d = ch % 192, pd = (d & ~31) + 8 * ((d >> 2) & 3) + 4 * ((d >> 4) & 1) + (d & 3);
                GAS unsigned char* blk = a.ws() + WS_GLB + ((size_t)(b * 4 + h) * NUNIT + un) * GL_BLK;
                const PreOut po{blk, GL_OQ, GL_OK, GL_OKT, GL_ODL, 400, false};
                float wg[16];
#pragma unroll
                for (int r = 0; r < 16; ++r) wg[r] = a.in(I_WGATE)[((size_t)l * 16 + r) * GLKW + ch];
                const float bgv = a.in(I_BGATE)[l * GLKW + ch];
                float kta[16]; unsigned kt[16]; float bl0 = 0.f, bl = 0.f;
#pragma unroll
                for (int half = 0; half < 2; ++half) {
                    float g[16], qq[16], kk[16];
#pragma unroll
                    for (int j = 0; j < 16; ++j) { const GAS bf16_t* prow = P + (row0 + 16 * half + j) * INP;
                        const u32x4 l0 = *(const LAS u32x4*)(lds + (16 * half + j) * 32), l1 = *(const LAS u32x4*)(lds + (16 * half + j) * 32 + 16);
                        float x = bgv;
                        x += bf_lo(l0.x) * wg[0] + bf_hi(l0.x) * wg[1] + bf_lo(l0.y) * wg[2] + bf_hi(l0.y) * wg[3] + bf_lo(l0.z) * wg[4] + bf_hi(l0.z) * wg[5] + bf_lo(l0.w) * wg[6] + bf_hi(l0.w) * wg[7];
                        x += bf_lo(l1.x) * wg[8] + bf_hi(l1.x) * wg[9] + bf_lo(l1.y) * wg[10] + bf_hi(l1.y) * wg[11] + bf_lo(l1.z) * wg[12] + bf_hi(l1.z) * wg[13] + bf_lo(l1.w) * wg[14] + bf_hi(l1.w) * wg[15];
                        g[j] = (fminf(x, 0.f) - __logf(1.0f + __expf(-fabsf(x)))) * 0.0625f;
                        qq[j] = bf2f(prow[C_QC + ch]) * GLA_QSCALE; kk[j] = bf2f(prow[C_KC + ch]); }
                    if (half == 0) { bl0 = pre_half<0>(po, d, pd, 0.f, g, qq, kk, kta, kt); } else { bl = pre_half<1>(po, d, pd, bl0, g, qq, kk, kta, kt); }
                }
                pre_tail(po, d, bl0, bl, kta, kt);
            }
        } else {
            const int ch = (kind - 5) * 512 + tid, h = ch / 384, e = ch % 384;
            GAS unsigned char* blk = a.ws() + WS_GLB + ((size_t)(b * 4 + h) * NUNIT + un) * GL_BLK;
            unsigned vv[16];
#pragma unroll
            for (int j = 0; j < 32; ++j) { const unsigned short v = P[(row0 + j) * INP + C_VC + ch];
                const int w = 4 * ((j >> 2) & 3) + 2 * (j >> 4) + ((j & 3) >> 1); if (j & 1) vv[w] |= ((unsigned)v) << 16; else vv[w] = v; }
#pragma unroll
            for (int i = 0; i < 4; ++i) *(GAS u32x4*)(blk + GL_OVT + e * 64 + 16 * i) = (u32x4){vv[4 * i], vv[4 * i + 1], vv[4 * i + 2], vv[4 * i + 3]};
        }
    }
}

template <int DK, int MODE>
__device__ __forceinline__ void chain_unit(const LAS unsigned char* sb, f32x4 (&S)[DK / 16], GAS float* op, int wave, int n, int q) {
    constexpr bool IS_GLA = (DK == 192);
    constexpr int NKS = DK / 32, NMB = DK / 16, ROWB = IS_GLA ? 400 : 256;
    constexpr int OQ = 0, OK = IS_GLA ? GL_OK : HG_OK, OKT = IS_GLA ? GL_OKT : HG_OKT, OVT = IS_GLA ? GL_OVT : HG_OVT, ODL = IS_GLA ? GL_ODL : HG_ODL;
    const bf16x8 vf8 = __builtin_bit_cast(bf16x8, *(const LAS u32x4*)(sb + OVT + (16 * wave + n) * 64 + 16 * q));
    if (MODE == 1) {
        bf16x8 sbf[NKS];
#pragma unroll
        for (int ks = 0; ks < NKS; ++ks) sbf[ks] = __builtin_bit_cast(bf16x8, (u32x4){cvt_pk_bf16(S[2 * ks][0], S[2 * ks][1]), cvt_pk_bf16(S[2 * ks][2], S[2 * ks][3]), cvt_pk_bf16(S[2 * ks + 1][0], S[2 * ks + 1][1]), cvt_pk_bf16(S[2 * ks + 1][2], S[2 * ks + 1][3])});
        const f32x4 zero = (f32x4){0.f, 0.f, 0.f, 0.f};
        bf16x8 kf0[NKS];
        unsigned p10a, p10b;
        {
            f32x4 ao = zero, ao1 = zero, ap = zero, ap1 = zero;
#pragma unroll
            for (int ks = 0; ks < NKS; ++ks) { const int c0 = 64 * ks + 16 * q, o0 = n * ROWB + (IS_GLA ? c0 : (c0 ^ (n << 4)));
                const bf16x8 qf = __builtin_bit_cast(bf16x8, *(const LAS u32x4*)(sb + OQ + o0)); kf0[ks] = __builtin_bit_cast(bf16x8, *(const LAS u32x4*)(sb + OK + o0));
                if (ks & 1) { ao1 = __builtin_amdgcn_mfma_f32_16x16x32_bf16(qf, sbf[ks], ao1, 0, 0, 0); ap1 = __builtin_amdgcn_mfma_f32_16x16x32_bf16(kf0[ks], qf, ap1, 0, 0, 0); }
                else { ao = __builtin_amdgcn_mfma_f32_16x16x32_bf16(qf, sbf[ks], ao, 0, 0, 0); ap = __builtin_amdgcn_mfma_f32_16x16x32_bf16(kf0[ks], qf, ap, 0, 0, 0); } }
            ao = ao + ao1; ap = ap + ap1;
#pragma unroll
            for (int r = 0; r < 4; ++r) if (4 * q + r > n) ap[r] = 0.f;
            const bf16x8 pa = __builtin_bit_cast(bf16x8, (u32x4){cvt_pk_bf16(ap[0], ap[1]), cvt_pk_bf16(ap[2], ap[3]), 0u, 0u});
            ao = __builtin_amdgcn_mfma_f32_16x16x32_bf16(pa, vf8, ao, 0, 0, 0);
#pragma unroll
            for (int r = 0; r < 4; ++r) op[(size_t)(4 * q + r) * OW] = ao[r];
        }
        {
            f32x4 ao = zero, ao1 = zero, ap = zero, ap1 = zero, ax = zero, ax1 = zero;
#pragma unroll
            for (int ks = 0; ks < NKS; ++ks) { const int c0 = 64 * ks + 16 * q, o1 = (16 + n) * ROWB + (IS_GLA ? c0 : (c0 ^ (n << 4)));
                const bf16x8 qf = __builtin_bit_cast(bf16x8, *(const LAS u32x4*)(sb + OQ + o1)), kf1 = __builtin_bit_cast(bf16x8, *(const LAS u32x4*)(sb + OK + o1));
                if (ks & 1) { ao1 = __builtin_amdgcn_mfma_f32_16x16x32_bf16(qf, sbf[ks], ao1, 0, 0, 0); ax1 = __builtin_amdgcn_mfma_f32_16x16x32_bf16(kf0[ks], qf, ax1, 0, 0, 0); ap1 = __builtin_amdgcn_mfma_f32_16x16x32_bf16(kf1, qf, ap1, 0, 0, 0); }
                else { ao = __builtin_amdgcn_mfma_f32_16x16x32_bf16(qf, sbf[ks], ao, 0, 0, 0); ax = __builtin_amdgcn_mfma_f32_16x16x32_bf16(kf0[ks], qf, ax, 0, 0, 0); ap = __builtin_amdgcn_mfma_f32_16x16x32_bf16(kf1, qf, ap, 0, 0, 0); } }
            ao = ao + ao1; ap = ap + ap1; ax = ax + ax1;
#pragma unroll
            for (int r = 0; r < 4; ++r) if (4 * q + r > n) ap[r] = 0.f;
            p10a = cvt_pk_bf16(ax[0], ax[1]); p10b = cvt_pk_bf16(ax[2], ax[3]);
            const bf16x8 pa = __builtin_bit_cast(bf16x8, (u32x4){p10a, p10b, cvt_pk_bf16(ap[0], ap[1]), cvt_pk_bf16(ap[2], ap[3])});
            ao = __builtin_amdgcn_mfma_f32_16x16x32_bf16(pa, vf8, ao, 0, 0, 0);
#pragma unroll
            for (int r = 0; r < 4; ++r) op[(size_t)(16 + 4 * q + r) * OW] = ao[r];
        }
    }
#pragma unroll
    for (int mb = 0; mb < NMB; ++mb) {
        const f32x4 dl = *(const LAS f32x4*)(sb + ODL + (16 * mb + 4 * q) * 4);
        const bf16x8 ktf = __builtin_bit_cast(bf16x8, *(const LAS u32x4*)(sb + OKT + (16 * mb + n) * 64 + 16 * q));
        S[mb] = __builtin_amdgcn_mfma_f32_16x16x32_bf16(ktf, vf8, S[mb] * dl, 0, 0, 0); }
}
constexpr size_t ST_REC = 98304;
constexpr int NSEG_HG = 4, NSEG_GL = 6, NSEG_MAX = 6;
__device__ __forceinline__ int seg_u0(bool gla, int s) { return gla ? (s <= 2 ? 44 * s : 88 + 42 * (s - 2)) : 64 * s; }
__device__ __forceinline__ int seg_nu(bool gla, int s) { return gla ? (s < 2 ? 44 : 42) : 64; }
template <int DK, int MODE>
__device__ __forceinline__ void chain_item(const GAS unsigned char* blk0, int vt_off, GAS float* op0, GAS unsigned char* st, int seg, int nunits, LAS unsigned char* lds, int wave, int lane) {
    asm volatile("" : "+v"(lane), "+s"(wave));
    constexpr bool IS_GLA = (DK == 192);
    constexpr int BLK = IS_GLA ? GL_BLK : HG_BLK, UNITB = IS_GLA ? GL_SHARED + 8192 : HG_BLK, NMB = DK / 16;
    constexpr int SH0 = MODE == 1 ? 0 : (IS_GLA ? GL_OKT : HG_OKT);
    constexpr int SH_PIECES = (MODE == 1 ? (IS_GLA ? GL_SHARED : HG_BLK) : (IS_GLA ? GL_ODL + 768 - GL_OKT : HG_BLK - HG_OKT)) / 16;
    constexpr int T_PIECES = IS_GLA ? 512 : 0, T_LDS = GL_OVT;
    constexpr int PIECES = SH_PIECES + T_PIECES, NP = (PIECES + 511) / 512;
    constexpr int ODL_ = IS_GLA ? GL_ODL : HG_ODL;
    const int tid = wave * 64 + lane, n = lane & 15, q = lane >> 4;
    f32x4 S[NMB]; float dacc = 1.0f;
#pragma unroll
    for (int mb = 0; mb < NMB; ++mb) S[mb] = (f32x4){0.f, 0.f, 0.f, 0.f};
    if (MODE == 1) {
        for (int s = 0; s < seg; ++s) { const GAS unsigned char* rec = st + (size_t)s * 2 * ST_REC + (size_t)(wave * 64 + lane) * 16;
#pragma unroll
            for (int mb = 0; mb < NMB; ++mb) { const f32x4 h = *(const GAS f32x4*)(rec + (size_t)mb * 8192), d = *(const GAS f32x4*)(st + (size_t)s * 2 * ST_REC + ST_REC + (16 * mb + 4 * q) * 4); S[mb] = S[mb] * d + h; } }
    }
    u32x4 stgA[NP], stgB[NP];
#define CH_SRC(u, p_) (blk0 + (size_t)(u) * BLK + ((p_) < SH_PIECES ? SH0 + (p_) * 16 : vt_off + ((p_) - SH_PIECES) * 16))
#define CH_DST(p_) ((p_) < SH_PIECES ? SH0 + (p_) * 16 : T_LDS + ((p_) - SH_PIECES) * 16)
#define CH_LOAD(stg, u) do { _Pragma("unroll") for (int r_ = 0; r_ < NP; ++r_) { const int p_ = r_ * 512 + tid; const bool ok_ = (NP * 512 == PIECES) || p_ < PIECES; const int pc_ = ok_ ? p_ : 0; stg[r_] = *(const GAS u32x4*)CH_SRC(u, pc_); } } while (0)
#define CH_STORE(stg, buf) do { _Pragma("unroll") for (int r_ = 0; r_ < NP; ++r_) { const int p_ = r_ * 512 + tid; const bool ok_ = (NP * 512 == PIECES) || p_ < PIECES; const int pc_ = ok_ ? p_ : 0; \
        const int d_ = ok_ ? (buf) * UNITB + CH_DST(pc_) : 2 * UNITB + (p_ - PIECES) * 16; *(LAS u32x4*)(lds + d_) = stg[r_]; } } while (0)
#define CH_SYNC() do { asm volatile("s_waitcnt lgkmcnt(0)" ::: "memory"); __builtin_amdgcn_s_barrier(); asm volatile("" ::: "memory"); } while (0)
    CH_LOAD(stgA, 0); CH_STORE(stgA, 0);
    CH_LOAD(stgA, 1);
    CH_SYNC();
    GAS float* op = op0 + 16 * wave + n;
    for (int u = 0; u < nunits; u += 2) {
        if (u + 2 < nunits) CH_LOAD(stgB, u + 2);
        chain_unit<DK, MODE>(lds, S, op + (size_t)(u * 32) * OW, wave, n, q);
        if (MODE == 0 && tid < DK) dacc *= *(const LAS float*)(lds + ODL_ + 4 * tid);
        CH_STORE(stgA, 1);
        CH_SYNC();
        if (u + 3 < nunits) CH_LOAD(stgA, u + 3);
        chain_unit<DK, MODE>(lds + UNITB, S, op + (size_t)(u * 32 + 32) * OW, wave, n, q);
        if (MODE == 0 && tid < DK) dacc *= *(const LAS float*)(lds + UNITB + ODL_ + 4 * tid);
        if (u + 2 < nunits) CH_STORE(stgB, 0);
        CH_SYNC();
    }
    if (MODE == 0) { GAS unsigned char* rec = st + (size_t)seg * 2 * ST_REC + (size_t)(wave * 64 + lane) * 16;
#pragma unroll
        for (int mb = 0; mb < NMB; ++mb) *(GAS f32x4*)(rec + (size_t)mb * 8192) = S[mb];
        if (tid < DK) *(GAS float*)(st + (size_t)seg * 2 * ST_REC + ST_REC + 4 * tid) = dacc; }
#undef CH_SRC
#undef CH_DST
#undef CH_LOAD
#undef CH_STORE
#undef CH_SYNC
}

template <int MODE>
__device__ __forceinline__ void phase_chain(const Ctx& a, int l, LAS unsigned char* lds, int wave, int lane) {
    const int bx = blockIdx.x, G = gridDim.x;
    constexpr int nhg = 24 * (MODE == 0 ? NSEG_HG - 1 : NSEG_HG), nitems = nhg + 24 * (MODE == 0 ? NSEG_GL - 1 : NSEG_GL);
    for (int it = bx; it < nitems; it += G) {
        const bool gla = it >= nhg; const int j = gla ? it - nhg : it, c = j % 24, seg = j / 24, u0 = seg_u0(gla, seg), nu = seg_nu(gla, seg);
        GAS unsigned char* st = a.ws() + WS_ST + (size_t)(gla ? 24 + c : c) * (NSEG_MAX - 1) * 2 * ST_REC;
        if (!gla) { const int b = c / 12, h = c % 12;
            chain_item<128, MODE>(a.ws() + WS_HGB + ((size_t)(b * 12 + h) * NUNIT + u0) * HG_BLK, 0, (GAS float*)(a.ws() + WS_O) + ((size_t)b * SEQ + u0 * 32) * OW + h * 128, st, seg, nu, lds, wave, lane); }
        else { const int b = c / 12, h = (c % 12) / 3, sl = c % 3;
            chain_item<192, MODE>(a.ws() + WS_GLB + ((size_t)(b * 4 + h) * NUNIT + u0) * GL_BLK, GL_OVT + 8192 * sl, (GAS float*)(a.ws() + WS_O) + ((size_t)b * SEQ + u0 * 32) * OW + HGW + h * 384 + sl * 128, st, seg, nu, lds, wave, lane); }
        __syncthreads();
    }
    if (MODE == 0) { for (int it = (G >= nitems + 16) ? bx - nitems : bx; it < 16; it += G) { if (it < 0) continue; s5_scan_item(a, l, it, wave, lane); } }
}
__device__ __forceinline__ float red16(float v) {
    v += __int_as_float(__builtin_amdgcn_mov_dpp(__float_as_int(v), 0xB1, 0xF, 0xF, true)); v += __int_as_float(__builtin_amdgcn_mov_dpp(__float_as_int(v), 0x4E, 0xF, 0xF, true));
    v += __int_as_float(__builtin_amdgcn_mov_dpp(__float_as_int(v), 0x141, 0xF, 0xF, true)); v += __int_as_float(__builtin_amdgcn_mov_dpp(__float_as_int(v), 0x140, 0xF, 0xF, true)); return v; }
__device__ __forceinline__ void phase_finalize(const Ctx& a, int l, int wave, int lane) {
    const GAS bf16_t* P = (const GAS bf16_t*)(a.ws() + WS_P); const GAS float* O = (const GAS float*)(a.ws() + WS_O); GAS bf16_t* MX = (GAS bf16_t*)(a.ws() + WS_MIXED);
    const GAS float* hgg = a.in(I_HGG) + l * HGW; const GAS float* hgb = a.in(I_HGB) + l * HGW; const GAS float* glg = a.in(I_GLG) + l * HGW;
    const int gw = blockIdx.x * 8 + wave, NGW = gridDim.x * 8;
    for (int row = gw; row < MTOK; row += NGW) {
        const GAS float* orow = O + (size_t)row * OW; const GAS bf16_t* prow = P + (size_t)row * INP; GAS bf16_t* mrow = MX + (size_t)row * DM;
#pragma unroll
        for (int it = 0; it < 3; ++it) { const int c = (it * 4 + (lane >> 4)) * 128 + (lane & 15) * 8;
            const f32x4 o0 = *(const GAS f32x4*)(orow + c), o1 = *(const GAS f32x4*)(orow + c + 4); const u32x4 gg = *(const GAS u32x4*)(prow + C_GB + c);
            float v[8] = {sigmoidf_(bf_lo(gg.x)) * o0[0], sigmoidf_(bf_hi(gg.x)) * o0[1], sigmoidf_(bf_lo(gg.y)) * o0[2], sigmoidf_(bf_hi(gg.y)) * o0[3],
                          sigmoidf_(bf_lo(gg.z)) * o1[0], sigmoidf_(bf_hi(gg.z)) * o1[1], sigmoidf_(bf_lo(gg.w)) * o1[2], sigmoidf_(bf_hi(gg.w)) * o1[3]};
            float s = 0.f, ss = 0.f;
#pragma unroll
            for (int i = 0; i < 8; ++i) { s += v[i]; ss += v[i] * v[i]; }
            s = red16(s); ss = red16(ss);
            const float mu = s * (1.0f / 128.0f), rs = 1.0f / sqrtf(fmaxf(ss * (1.0f / 128.0f) - mu * mu, 0.f) + LN_EPS);
            const f32x4 g0 = *(const GAS f32x4*)(hgg + c), g1 = *(const GAS f32x4*)(hgg + c + 4), b0 = *(const GAS f32x4*)(hgb + c), b1 = *(const GAS f32x4*)(hgb + c + 4);
            u32x4 w; w.x = cvt_pk_bf16((v[0] - mu) * rs * g0[0] + b0[0], (v[1] - mu) * rs * g0[1] + b0[1]); w.y = cvt_pk_bf16((v[2] - mu) * rs * g0[2] + b0[2], (v[3] - mu) * rs * g0[3] + b0[3]);
            w.z = cvt_pk_bf16((v[4] - mu) * rs * g1[0] + b1[0], (v[5] - mu) * rs * g1[1] + b1[1]); w.w = cvt_pk_bf16((v[6] - mu) * rs * g1[2] + b1[2], (v[7] - mu) * rs * g1[3] + b1[3]);
            *(GAS u32x4*)(mrow + S5W + c) = w; }
#pragma unroll
        for (int h = 0; h < 4; ++h) { const int c = h * 384 + lane * 8; const bool act = lane < 48;
            f32x4 o0 = (f32x4){0.f, 0.f, 0.f, 0.f}, o1 = o0; u32x4 gg = (u32x4){0u, 0u, 0u, 0u};
            if (act) { o0 = *(const GAS f32x4*)(orow + HGW + c); o1 = *(const GAS f32x4*)(orow + HGW + c + 4); gg = *(const GAS u32x4*)(prow + C_GC + c); }
            const float ss = wave_sum((o0[0] * o0[0] + o0[1] * o0[1]) + (o0[2] * o0[2] + o0[3] * o0[3]) + (o1[0] * o1[0] + o1[1] * o1[1]) + (o1[2] * o1[2] + o1[3] * o1[3]));
            const float rms = 1.0f / sqrtf(ss * (1.0f / 384.0f) + LN_EPS);
            if (act) { const f32x4 g0 = *(const GAS f32x4*)(glg + c), g1 = *(const GAS f32x4*)(glg + c + 4);
                const float z[8] = {bf_lo(gg.x), bf_hi(gg.x), bf_lo(gg.y), bf_hi(gg.y), bf_lo(gg.z), bf_hi(gg.z), bf_lo(gg.w), bf_hi(gg.w)};
                u32x4 w; w.x = cvt_pk_bf16(o0[0] * rms * g0[0] * (z[0] * sigmoidf_(z[0])), o0[1] * rms * g0[1] * (z[1] * sigmoidf_(z[1])));
                w.y = cvt_pk_bf16(o0[2] * rms * g0[2] * (z[2] * sigmoidf_(z[2])), o0[3] * rms * g0[3] * (z[3] * sigmoidf_(z[3])));
                w.z = cvt_pk_bf16(o1[0] * rms * g1[0] * (z[4] * sigmoidf_(z[4])), o1[1] * rms * g1[1] * (z[5] * sigmoidf_(z[5])));
                w.w = cvt_pk_bf16(o1[2] * rms * g1[2] * (z[6] * sigmoidf_(z[6])), o1[3] * rms * g1[3] * (z[7] * sigmoidf_(z[7])));
                *(GAS u32x4*)(mrow + S5W + HGW + c) = w; } }
    }
}

constexpr int PH_PRO = 0, PH_MOD = 1, PH_LN0 = 2, PH_L0 = 3, PH_PER_LAYER = 10, N_PHASES = PH_L0 + DEPTH * PH_PER_LAYER;
constexpr int CW_BAR = 4096;

__global__ void __launch_bounds__(512, 2) hybrid_fwd(Args args) {
    extern __shared__ __attribute__((aligned(16))) unsigned char lds_raw[];
    LAS unsigned char* lds = (LAS unsigned char*)lds_raw;
    const int wave = __builtin_amdgcn_readfirstlane((int)threadIdx.x >> 6);
#define lane lane_id_v()
    volatile LAS unsigned* MISC = (volatile LAS unsigned*)(lds + LDSCTL_OFF);
    Ctx ctx; ctx.t = (volatile LAS unsigned long long*)(lds + LDSCTL_OFF + 64);
    if (wave == 0) { const int ln_ = lane; unsigned long long v = 0ull;
#pragma unroll
        for (int i = 0; i < N_IN; ++i) v = (ln_ == i) ? (unsigned long long)args.in[i] : v;
        v = (ln_ == 30) ? (unsigned long long)args.out : v; v = (ln_ == 31) ? (unsigned long long)args.ws : v;
        if (ln_ < 32) ctx.t[ln_] = v;
        if (ln_ < 16) MISC[ln_] = 0u; }
    __syncthreads();
    const int lo = args.ph_lo, hi = args.ph_hi;
    XcdBarrier bar; bar.bar = (unsigned*)(ctx.ws() + WS_CTL) + CW_BAR; bar.x = 0; bar.st = nullptr; bar.w0 = (wave == 0) ? 1u : 0u;
    if (hi - lo > 1) bar = xcd_barrier_post((unsigned*)(ctx.ws() + WS_CTL) + CW_BAR, MISC + 8, (wave == 0) ? 1u : 0u);
#define IN(k) (lo <= (k) && (k) < hi)
#define OPQ() int ln = lane, wv = wave; asm volatile("" : "+s"(wv))
#define SEAM(k) do { if (IN(k) && IN((k) + 1)) xcd_barrier(bar); } while (0)
#define WSP(T, off) ((GAS T*)(ctx.ws() + (off)))
#define WSG(T, off) ((T*)(ctx.ws() + (off)))

    if (IN(PH_PRO)) { OPQ(); phase_prologue(ctx, lds, wv, ln); }
    SEAM(PH_PRO);
    if (IN(PH_MOD)) { OPQ(); phase_mod(ctx, wv, ln); }
    SEAM(PH_MOD);
    if (IN(PH_LN0)) { OPQ(); phase_h0(ctx.in(I_X), WSP(float, WS_MOD), WSP(bf16_t, WS_H), wv, ln); }
    SEAM(PH_LN0);

    for (int l = 0; l < DEPTH; ++l) {
        const int p0 = PH_L0 + l * PH_PER_LAYER;
        const size_t wto = WS_WT + (size_t)l * WT_LAYER, modo = WS_MOD + (size_t)l * NB * 6 * DM * 4;
        if (IN(p0 + 0)) { pg8::Gemm g{WSG(bf16_t, WS_H), WSG(const bf16_t, wto + WT_IN), MTOK, INP, DM}; pg8::StaticOrder S; S.init(MTOK, INP, (int)gridDim.x, (int)blockIdx.x);
            EpiProj E{WSP(bf16_t, WS_P), WSP(bf16_t, WS_UX)}; pg8::gemm_phase<EpiProj, pg8::StaticOrder, true, true>(lds, g, S, E, wave); }
        SEAM(p0 + 0);
        if (IN(p0 + 1)) {
            { pg8::Gemm g{WSG(bf16_t, WS_UX), WSG(const bf16_t, WS_S5W1 + (size_t)l * S5_W1_LAYER), 64 * 256, 64 * 256, S5K}; S5Order S{(int)gridDim.x, (int)blockIdx.x, 64, 0};
              EpiS5A E{WSP(float, WS_SLOC)}; pg8::gemm_phase<EpiS5A, S5Order, true, true>(lds, g, S, E, wave); }
            { OPQ(); phase_pre(ctx, l, lds, wv, ln); }
            }
        SEAM(p0 + 1);
        if (IN(p0 + 2)) { OPQ(); phase_chain<0>(ctx, l, lds, wv, ln); }
        SEAM(p0 + 2);
        if (IN(p0 + 3)) {
            { pg8::Gemm g{WSG(bf16_t, WS_UX), WSG(const bf16_t, WS_S5T + (size_t)l * S5_T_LAYER), 64 * 256, 64 * 1024, S5K}; S5Order S{(int)gridDim.x, (int)blockIdx.x, 256, 2};
              EpiS5C E{WSP(bf16_t, WS_Z)}; pg8::gemm_phase<EpiS5C, S5Order, true, true>(lds, g, S, E, wave); }
            { OPQ(); phase_chain<1>(ctx, l, lds, wv, ln); } }
        SEAM(p0 + 3);
        if (IN(p0 + 4)) { pg8::Gemm g{WSG(bf16_t, WS_Z), WSG(const bf16_t, wto + WT_GLU), MTOK, S5W, S5W}; pg8::StaticOrder S; S.init(MTOK, S5W, (int)gridDim.x, (int)blockIdx.x);
            EpiGlu E{WSP(bf16_t, WS_Z), WSP(bf16_t, WS_MIXED), ctx.in(I_GLUB) + l * S5W}; pg8::gemm_phase<EpiGlu, pg8::StaticOrder, true, true>(lds, g, S, E, wave);
            { OPQ(); phase_finalize(ctx, l, wv, ln); } }
        SEAM(p0 + 4);
        if (IN(p0 + 5)) { pg8::Gemm g{WSG(bf16_t, WS_MIXED), WSG(const bf16_t, wto + WT_OUT), MTOK, DM, DM}; pg8::StaticOrder S; S.init(MTOK, DM, (int)gridDim.x, (int)blockIdx.x);
            EpiDelta E{WSP(bf16_t, WS_DELTA), WSP(float, modo) + 2 * DM};
            pg8::gemm_phase<EpiDelta, pg8::StaticOrder, true, true>(lds, g, S, E, wave); }
        SEAM(p0 + 5);
        if (IN(p0 + 6)) { OPQ(); phase_lnres<true>(l == 0 ? ctx.in(I_X) : ctx.out(), WSP(bf16_t, WS_DELTA), ctx.out(), ctx.in(I_LN1G) + l * DM, ctx.in(I_LN1B) + l * DM, WSP(float, modo), 3, 4, WSP(bf16_t, WS_H), lds, wv, ln); }
        SEAM(p0 + 6);
        if (IN(p0 + 7)) { pg8::Gemm g{WSG(bf16_t, WS_H), WSG(const bf16_t, wto + WT_GU), MTOK, 2 * DFF, DM}; pg8::StaticOrder S; S.init(MTOK, 2 * DFF, (int)gridDim.x, (int)blockIdx.x);
            EpiSwiglu E{WSP(bf16_t, WS_P)}; pg8::gemm_phase<EpiSwiglu, pg8::StaticOrder, true, true>(lds, g, S, E, wave); }
        SEAM(p0 + 7);
        if (IN(p0 + 8)) { pg8::Gemm g{WSG(bf16_t, WS_P), WSG(const bf16_t, wto + WT_DN), MTOK, DM, DFF}; pg8::StaticOrder S; S.init(MTOK, DM, (int)gridDim.x, (int)blockIdx.x);
            EpiDelta E{WSP(bf16_t, WS_DELTA), WSP(float, modo) + 5 * DM};
            pg8::gemm_phase<EpiDelta, pg8::StaticOrder, true, true>(lds, g, S, E, wave); }
        SEAM(p0 + 8);
        if (IN(p0 + 9)) { OPQ();
            if (l + 1 < DEPTH) phase_lnres<true>(ctx.out(), WSP(bf16_t, WS_DELTA), ctx.out(), ctx.in(I_LN2G) + l * DM, ctx.in(I_LN2B) + l * DM, WSP(float, modo) + (size_t)NB * 6 * DM, 0, 1, WSP(bf16_t, WS_H), lds, wv, ln);
            else phase_lnres<false>(ctx.out(), WSP(bf16_t, WS_DELTA), ctx.out(), ctx.in(I_LN2G) + l * DM, ctx.in(I_LN2B) + l * DM, nullptr, 0, 0, nullptr, lds, wv, ln);
        }
        SEAM(p0 + 9);
    }
#undef IN
#undef SEAM
#undef OPQ
#undef WSP
#undef WSG
#undef lane
}

extern "C" void kernel_launch(void* const* d_in, const int* in_sizes, int n_in, void* d_out, int out_size, void* d_ws, size_t ws_size, hipStream_t stream) {
    static int grid = 0;
    if (grid == 0) {
        if (n_in != N_IN || out_size != MTOK * DM || ws_size < WS_END) { fprintf(stderr, "kernel_launch: unexpected problem (n_in %d, out %d, ws %zu < %zu); nothing launched\n", n_in, out_size, ws_size, (size_t)WS_END); grid = -1; return; }
        int dev = 0, cus = 0, per_cu = 0;
        if (hipGetDevice(&dev) != hipSuccess || hipDeviceGetAttribute(&cus, hipDeviceAttributeMultiprocessorCount, dev) != hipSuccess) { grid = -1; return; }
        if (hipFuncSetAttribute((const void*)hybrid_fwd, hipFuncAttributeMaxDynamicSharedMemorySize, LDS_BYTES) != hipSuccess) { fprintf(stderr, "kernel_launch: hipFuncSetAttribute failed\n"); grid = -1; return; }
        if (hipOccupancyMaxActiveBlocksPerMultiprocessor(&per_cu, (const void*)hybrid_fwd, 512, LDS_BYTES) != hipSuccess || per_cu < 1) fprintf(stderr, "kernel_launch: occupancy query reports %d blocks per CU\n", per_cu);
        (void)hipGetLastError();
        grid = cus;
    }
    if (grid < 0) return;
    (void)in_sizes;
    if (hipMemsetAsync((char*)d_ws + WS_CTL, 0, CTL_ZERO_BYTES, stream) != hipSuccess) return;
    Args a{};
    for (int i = 0; i < N_IN; ++i) a.in[i] = (const float*)d_in[i];
    a.out = (float*)d_out; a.ws = (unsigned char*)d_ws;
    a.ph_lo = 0; a.ph_hi = N_PHASES; hipLaunchKernelGGL(hybrid_fwd, dim3(grid), dim3(512), LDS_BYTES, stream, a);
}
```

```cpp
#include <hip/hip_runtime.h>
#include <cstdio>
#include <cstdint>
namespace pg8 {
#define PG8_LAS __attribute__((address_space(3)))
typedef unsigned short bf16_t;
typedef short bf16x8 __attribute__((ext_vector_type(8)));
typedef float f32x4 __attribute__((ext_vector_type(4)));
typedef unsigned u32x4 __attribute__((ext_vector_type(4)));
constexpr int BM = 256, BK = 64, HALF = 128, HTB = HALF * BK * 2  , STAGE_BYTES = 8 * HTB, NXCD = 8, WGM = 8;

__host__ __device__ __forceinline__ int lds_byte(int r, int c) { const int st = (r >> 4) * 2 + (c >> 5), rr = r & 15, cc = c & 31, ob = rr * 64 + cc * 2; return st * 1024 + (ob ^ (((ob >> 9) & 1) << 5)); }
__host__ __device__ __forceinline__ void stage_rc(int b, int& R, int& C) { const int st = b / 1024, sb = b % 1024, swz = sb ^ (((sb >> 9) & 1) << 5); R = (st >> 1) * 16 + swz / 64; C = (st & 1) * 32 + (swz % 64) / 2; }
__host__ __device__ __forceinline__ int perm32(int rho) { const int n = rho >> 4, i = rho & 15; return 8 * (i >> 2) + 4 * n + (i & 3); }

struct Unit { int pm, pn; };
struct Gemm { const bf16_t* A; const bf16_t* Bt; int M, N, K; };

struct StaticOrder {
    int nM, nN, nwg, G, c;
    __host__ __device__ void init(int M, int N, int G_, int c_) { nM = M / BM; nN = N / BM; nwg = nM * nN; G = G_; c = c_; }
    __host__ __device__ bool next(int i, Unit& u) const {
        const long L = (long)i * G + c; if (L >= nwg) return false;
        int wgid = (int)L; { const int q = nwg / NXCD, r = nwg % NXCD, xcd = wgid % NXCD, off = wgid / NXCD; wgid = (xcd < r ? xcd * (q + 1) : r * (q + 1) + (xcd - r) * q) + off; }
        const int nig = WGM * nN, gid = wgid / nig, fm = gid * WGM, gsz = (nM - fm) < WGM ? (nM - fm) : WGM;
        u.pm = fm + ((wgid % nig) % gsz); u.pn = (wgid % nig) / gsz; return true;
    }
    __device__ __forceinline__ void a_ready(const Unit&) const {}
    __device__ __forceinline__ void done(const Unit&) const {}
};
__device__ __forceinline__ unsigned cvt_pk_bf16(float lo, float hi) { unsigned r; asm volatile("v_cvt_pk_bf16_f32 %0, %1, %2" : "=v"(r) : "v"(lo), "v"(hi)); return r; }
typedef float f32x2 __attribute__((ext_vector_type(2)));
template <class Epi, class Sched, bool ALIGN_EPI = false, bool SP2 = false>
__device__ __forceinline__ void gemm_phase(PG8_LAS unsigned char* lds, const Gemm g, const Sched& S, const Epi& E, int wave_id) {
    int tid_; asm volatile("v_mbcnt_lo_u32_b32 %0, -1, 0\n\tv_mbcnt_hi_u32_b32 %0, -1, %0" : "=v"(tid_)); tid_ += wave_id * 64;
    const int tid = tid_, wid = __builtin_amdgcn_readfirstlane(tid >> 6), lane = tid & 63, wr = wid >> 2, wc = wid & 3, fr = lane & 15, fq = lane >> 4;
    const int K = g.K, nt = K / BK;
    unsigned voffA[2], voffB[2];
#pragma unroll
    for (int i = 0; i < 2; ++i) { int R, C; stage_rc(tid * 16 + i * 8192, R, C); const int Rb = Epi::PERM ? ((R & ~31) + perm32(R & 31)) : R;
        voffA[i] = (unsigned)(R * K + C) * 2u; voffB[i] = (unsigned)(Rb * K + C) * 2u; }
    const size_t kstep = (size_t)(BK * 2);
    const size_t hstep = (size_t)HALF * K * 2;
    const size_t tstep = 2 * hstep;
    const unsigned ldsw = (unsigned)wid * 1024u;
    const int aoff = lds_byte(wr * 64 + fr, fq * 8), boff = lds_byte(wc * 32 + fr, fq * 8);
#define PG8_SA(b, h) (((b) * 2 + (h)) * HTB)
#define PG8_SB(b, h) ((4 + (b) * 2 + (h)) * HTB)
#define PG8_STAGE(bufoff, gbase, voff) do { _Pragma("unroll") for (int _i = 0; _i < 2; ++_i) \
        __builtin_amdgcn_global_load_lds((const unsigned*)((const char*)(gbase) + (voff)[_i]), (PG8_LAS unsigned*)(lds + (bufoff) + ldsw + _i * 8192), 16, 0, 0); } while (0)
#define PG8_LDA(dst, b, h) do { _Pragma("unroll") for (int m = 0; m < 4; ++m) _Pragma("unroll") for (int k = 0; k < 2; ++k) dst[m][k] = *(const PG8_LAS bf16x8*)(lds + PG8_SA(b, h) + aoff + m * 2048 + k * 1024); } while (0)
#define PG8_LDB(dst, b, h) do { _Pragma("unroll") for (int n = 0; n < 2; ++n) _Pragma("unroll") for (int k = 0; k < 2; ++k) dst[n][k] = *(const PG8_LAS bf16x8*)(lds + PG8_SB(b, h) + boff + n * 2048 + k * 1024); } while (0)
#define PG8_MMA(ai, bj, At, Bt) do { __builtin_amdgcn_s_setprio(1); _Pragma("unroll") for (int m = 0; m < 4; ++m) _Pragma("unroll") for (int n = 0; n < 2; ++n) _Pragma("unroll") for (int k = 0; k < 2; ++k) \
        acc[ai][bj][m][n] = __builtin_amdgcn_mfma_f32_16x16x32_bf16(Bt[n][k], At[m][k], acc[ai][bj][m][n], 0, 0, 0); __builtin_amdgcn_s_setprio(0); } while (0)
#define PG8_WAIT_V(n) asm volatile("s_waitcnt vmcnt(" #n ")" ::: "memory")
#define PG8_WAIT_L(n) asm volatile("s_waitcnt lgkmcnt(" #n ")" ::: "memory")
#define PG8_BAR __builtin_amdgcn_s_barrier()
#define PG8_SCHED __builtin_amdgcn_sched_barrier(0)
    Unit cur, nxt; int ui = 0;
    if (!S.next(0, cur)) return;
    f32x4 acc[2][2][4][2];
#pragma unroll
    for (int a = 0; a < 2; ++a)
#pragma unroll
        for (int b = 0; b < 2; ++b)
#pragma unroll
            for (int m = 0; m < 4; ++m)
#pragma unroll
                for (int n = 0; n < 2; ++n) acc[a][b][m][n] = (f32x4){0.f, 0.f, 0.f, 0.f};
    bf16x8 At[4][2], B0[2][2], B1[2][2];
    const char* cA = (const char*)g.A + (size_t)cur.pm * tstep; const char* cB = (const char*)g.Bt + (size_t)cur.pn * tstep;
    S.a_ready(cur);
    if constexpr (SP2) {
        PG8_STAGE(PG8_SB(0, 0), cB, voffB); PG8_STAGE(PG8_SB(0, 1), cB + hstep, voffB); PG8_STAGE(PG8_SA(0, 0), cA, voffA); PG8_STAGE(PG8_SA(0, 1), cA + hstep, voffA);
        if (wr == 1) PG8_BAR;
        PG8_WAIT_V(2); PG8_BAR;
        PG8_STAGE(PG8_SB(1, 0), cB + kstep, voffB); PG8_STAGE(PG8_SA(1, 0), cA + kstep, voffA); PG8_STAGE(PG8_SB(1, 1), cB + hstep + kstep, voffB);
        PG8_WAIT_V(6); PG8_BAR;
    } else {
        PG8_STAGE(PG8_SB(0, 0), cB, voffB); PG8_STAGE(PG8_SA(0, 0), cA, voffA); PG8_STAGE(PG8_SB(0, 1), cB + hstep, voffB); PG8_STAGE(PG8_SA(0, 1), cA + hstep, voffA);
        if (wr == 1) PG8_BAR;
        PG8_WAIT_V(4); PG8_BAR;
        PG8_STAGE(PG8_SB(1, 0), cB + kstep, voffB); PG8_STAGE(PG8_SA(1, 0), cA + kstep, voffA); PG8_STAGE(PG8_SB(1, 1), cB + hstep + kstep, voffB);
        PG8_WAIT_V(6); PG8_BAR;
    }
    for (;;) {
        const bool has_next = S.next(ui + 1, nxt);
        const char* nA = has_next ? (const char*)g.A + (size_t)nxt.pm * tstep : cA; const char* nB = has_next ? (const char*)g.Bt + (size_t)nxt.pn * tstep : cB;
        for (int t = 0; t < nt; t += 2) {
            const bool last = (t == nt - 2);
            const char* a1 = cA + (size_t)(t + 1) * kstep;
            const char* a2 = last ? nA : cA + (size_t)(t + 2) * kstep; const char* b2 = last ? nB : cB + (size_t)(t + 2) * kstep;
            const char* a3 = a2 + kstep; const char* b3 = b2 + kstep;
            if (last && has_next) S.a_ready(nxt);
            if constexpr (SP2) {
            PG8_LDB(B0, 0, 0); PG8_LDB(B1, 0, 1); PG8_SCHED; PG8_LDA(At, 0, 0); PG8_STAGE(PG8_SA(1, 1), a1 + hstep, voffA);
            PG8_WAIT_V(8); PG8_WAIT_L(0); PG8_BAR; PG8_MMA(0, 0, At, B0); PG8_MMA(0, 1, At, B1); PG8_BAR; PG8_SCHED;
            PG8_LDA(At, 0, 1); PG8_STAGE(PG8_SB(0, 0), b2, voffB); PG8_STAGE(PG8_SB(0, 1), b2 + hstep, voffB); PG8_STAGE(PG8_SA(0, 0), a2, voffA);
            PG8_WAIT_V(8); PG8_WAIT_L(0); PG8_BAR; PG8_MMA(1, 0, At, B0); PG8_MMA(1, 1, At, B1); PG8_BAR; PG8_SCHED;
            PG8_LDB(B0, 1, 0); PG8_LDB(B1, 1, 1); PG8_SCHED; PG8_LDA(At, 1, 0); PG8_STAGE(PG8_SA(0, 1), a2 + hstep, voffA);
            PG8_WAIT_V(8); PG8_WAIT_L(0); PG8_BAR; PG8_MMA(0, 0, At, B0); PG8_MMA(0, 1, At, B1); PG8_BAR; PG8_SCHED;
            PG8_LDA(At, 1, 1); PG8_STAGE(PG8_SB(1, 0), b3, voffB); PG8_STAGE(PG8_SB(1, 1), b3 + hstep, voffB); PG8_STAGE(PG8_SA(1, 0), a3, voffA);
            PG8_WAIT_V(8); PG8_WAIT_L(0); PG8_BAR; PG8_MMA(1, 0, At, B0); PG8_MMA(1, 1, At, B1); PG8_BAR; PG8_SCHED;
            } else {
            PG8_LDB(B0, 0, 0); PG8_SCHED; PG8_LDA(At, 0, 0); PG8_STAGE(PG8_SA(1, 1), a1 + hstep, voffA);
            PG8_WAIT_L(8); PG8_BAR; PG8_WAIT_L(0); PG8_MMA(0, 0, At, B0); PG8_BAR; PG8_SCHED;
            PG8_LDB(B1, 0, 1); PG8_STAGE(PG8_SB(0, 0), b2, voffB);
            PG8_BAR; PG8_WAIT_L(0); PG8_MMA(0, 1, At, B1); PG8_BAR;
            PG8_LDA(At, 0, 1); PG8_STAGE(PG8_SA(0, 0), a2, voffA);
            PG8_BAR; PG8_WAIT_L(0); PG8_MMA(1, 0, At, B0); PG8_BAR; PG8_SCHED;
            PG8_STAGE(PG8_SB(0, 1), b2 + hstep, voffB);
            PG8_WAIT_V(6); PG8_BAR; PG8_MMA(1, 1, At, B1); PG8_BAR;
            PG8_LDB(B0, 1, 0); PG8_SCHED; PG8_LDA(At, 1, 0); PG8_STAGE(PG8_SA(0, 1), a2 + hstep, voffA);
            PG8_WAIT_L(8); PG8_BAR; PG8_WAIT_L(0); PG8_MMA(0, 0, At, B0); PG8_BAR; PG8_SCHED;
            PG8_LDB(B1, 1, 1); PG8_STAGE(PG8_SB(1, 0), b3, voffB);
            PG8_BAR; PG8_WAIT_L(0); PG8_MMA(0, 1, At, B1); PG8_BAR;
            PG8_LDA(At, 1, 1); PG8_STAGE(PG8_SA(1, 0), a3, voffA);
            PG8_BAR; PG8_WAIT_L(0); PG8_MMA(1, 0, At, B0); PG8_BAR; PG8_SCHED;
            PG8_STAGE(PG8_SB(1, 1), b3 + hstep, voffB);
            PG8_WAIT_V(6); PG8_BAR; PG8_MMA(1, 1, At, B1); PG8_BAR;
            }
        }
        if constexpr (ALIGN_EPI) { if (wr == 0) PG8_BAR; }
        if constexpr (!Epi::AFTER_DRAIN) { E(acc, cur, wr, wc, fr, fq); S.done(cur); }
        if (!has_next) break;
#pragma unroll
        for (int a = 0; a < 2; ++a)
#pragma unroll
            for (int b = 0; b < 2; ++b)
#pragma unroll
                for (int m = 0; m < 4; ++m)
#pragma unroll
                    for (int n = 0; n < 2; ++n) acc[a][b][m][n] = (f32x4){0.f, 0.f, 0.f, 0.f};
        cur = nxt; cA = nA; cB = nB; ++ui;
        if constexpr (ALIGN_EPI) { if (wr == 1) PG8_BAR; }
    }
    PG8_WAIT_V(0);
    if constexpr (!ALIGN_EPI) { if (wr == 0) PG8_BAR; }
    PG8_BAR;
    if constexpr (Epi::AFTER_DRAIN) { E.fused(acc, cur, wr, wc, fr, fq, lds, wid, lane); S.done(cur); }
#undef PG8_SA
#undef PG8_SB
#undef PG8_STAGE
#undef PG8_LDA
#undef PG8_LDB
#undef PG8_MMA
#undef PG8_WAIT_V
#undef PG8_WAIT_L
#undef PG8_BAR
#undef PG8_SCHED
}
}
#define LAS __attribute__((address_space(3)))
#define XB_TMO      128
#define XB_XCNT(j)  (256  + 64 * (j))
#define XB_XSUB(j)  (1280 + 64 * (j))
#define XB_XGEN(j)  (2304 + 64 * (j))
#define XB_TOP      3328
#define XB_TOPGEN   3392
#define XCD_BAR_WORDS 3456
#define XB_SPIN_CAP (1u << 24)

__device__ __forceinline__ unsigned xb_ld(unsigned* p)              { return __hip_atomic_load(p, __ATOMIC_RELAXED, __HIP_MEMORY_SCOPE_AGENT); }
__device__ __forceinline__ unsigned xb_add(unsigned* p, unsigned v) { return __hip_atomic_fetch_add(p, v, __ATOMIC_RELAXED, __HIP_MEMORY_SCOPE_AGENT); }
__device__ __forceinline__ unsigned xb_xcc_id() { return (unsigned)__builtin_amdgcn_s_getreg((3 << 11) | 20) & 0xFu; }
#define XB_SPIN(cond, bar) do { unsigned _sp = 0; while (cond) { __builtin_amdgcn_s_sleep(1); \
    if ((++_sp & 255u) == 0u) { if (xb_ld(&(bar)[XB_TMO])) break; if (_sp > XB_SPIN_CAP) { atomicAdd(&(bar)[XB_TMO], 1u); break; } } } } while (0)

struct XcdBarrier {
    unsigned* bar; unsigned x; unsigned w0;
    volatile LAS unsigned* st;
};

__device__ __forceinline__ bool xb_lane0() { unsigned r; asm volatile("v_mbcnt_lo_u32_b32 %0, -1, 0\n\tv_mbcnt_hi_u32_b32 %0, -1, %0" : "=v"(r)); return r == 0u; }
__device__ __forceinline__ XcdBarrier xcd_barrier_post(unsigned* bar, volatile LAS unsigned* st, unsigned w0) {
    XcdBarrier b; b.bar = bar; b.x = xb_xcc_id(); b.st = st; b.w0 = w0;
    if (w0 && xb_lane0()) (void)xb_add(&bar[XB_XCNT(b.x)], 1u);
    return b;
}
__device__ __forceinline__ void xcd_barrier_complete(unsigned* bar, unsigned x, unsigned& nloc, unsigned& nx) {
    const unsigned G = gridDim.x * gridDim.y * gridDim.z;
    unsigned sum, cnt, mine, sp = 0u;
    for (;;) {
        sum = 0u; cnt = 0u; mine = 0u;
#pragma unroll
        for (unsigned j = 0; j < 16; ++j) { const unsigned c = xb_ld(&bar[XB_XCNT(j)]); sum += c; cnt += (c > 0u) ? 1u : 0u; mine = (j == x) ? c : mine; }
        if (sum == G) break;
        __builtin_amdgcn_s_sleep(1);
        if ((++sp & 255u) == 0u) { if (xb_ld(&bar[XB_TMO])) break; if (sp > XB_SPIN_CAP) { atomicAdd(&bar[XB_TMO], 1u); break; } }
    }
    nloc = mine > 0u ? mine : 1u; nx = cnt > 0u ? cnt : 1u;
}

__device__ __forceinline__ void xcd_barrier(const XcdBarrier& b) {
    asm volatile("s_waitcnt vmcnt(0)" ::: "memory");
    __syncthreads();
    if (b.w0 && xb_lane0()) {
        unsigned* bar = b.bar;
        __builtin_amdgcn_s_waitcnt(0);
        unsigned nloc = b.st[0], nx = b.st[1];
        if (nloc == 0u) { xcd_barrier_complete(bar, b.x, nloc, nx); b.st[0] = nloc; b.st[1] = nx; }
        const unsigned old = xb_add(&bar[XB_XSUB(b.x)], 1u);
        const unsigned gen = old / nloc;
        if (old + 1u == (gen + 1u) * nloc) {
            __builtin_amdgcn_fence(__ATOMIC_RELEASE, "agent");
            asm volatile("s_waitcnt vmcnt(0)" ::: "memory");
            const unsigned og = xb_add(&bar[XB_TOP], 1u);
            const unsigned tg = og / nx;
            if (og + 1u == (tg + 1u) * nx) xb_add(&bar[XB_TOPGEN], 1u);
            else XB_SPIN(xb_ld(&bar[XB_TOPGEN]) == tg, bar);
            __builtin_amdgcn_fence(__ATOMIC_ACQUIRE, "agent");
            xb_add(&bar[XB_XGEN(b.x)], 1u);
            asm volatile("s_waitcnt vmcnt(0)" ::: "memory");
        } else {
            XB_SPIN(xb_ld(&bar[XB_XGEN(b.x)]) == gen, bar);
            __builtin_amdgcn_fence(__ATOMIC_ACQUIRE, "agent");
            asm volatile("s_waitcnt vmcnt(0)" ::: "memory");
        }
    }
    __syncthreads();
}

constexpr int DM = 4096, NB = 2, SEQ = 8192, MTOK = NB * SEQ, DEPTH = 4;
constexpr int S5W = 1024;
constexpr int HGW = 1536;
constexpr int GLKW = 768;
constexpr int INW = 11792, INP = 12032, DFF = 11008;
constexpr int OW = 3072;
constexpr int C_U = 0, C_QB = 1024, C_FB = 2560, C_IB = 4096, C_GB = 5632, C_QC = 7168, C_KC = 7936, C_VC = 8704, C_GC = 10240, C_LR = 11776;
constexpr float LN_EPS = 1e-5f;
constexpr float ALPHA = 1.6817928305074290861f;
constexpr float GLA_QSCALE = 0.07216878364870322f;

enum { I_X = 0, I_C, I_WADA, I_BADA, I_TABLE, I_WIN, I_WOUT, I_AREAL, I_AIMAG, I_LOGDT, I_BRE, I_BIM, I_CRE, I_CIM, I_S5D, I_GLUW, I_GLUB,
       I_LBRAW, I_HGG, I_HGB, I_WGATE, I_BGATE, I_GLG, I_WFG, I_WFU, I_WFD, I_LN1G, I_LN1B, I_LN2G, I_LN2B, N_IN };

constexpr size_t MiB = 1u << 20;
constexpr size_t WS_CTL = 0, CTL_ZERO_BYTES = 1 * MiB;
constexpr size_t WS_MOD = 1 * MiB;
constexpr size_t WS_MISC = 2 * MiB;
constexpr size_t WS_CONDPART = 12 * MiB;
constexpr size_t WS_H = 24 * MiB;
constexpr size_t WS_MIXED = WS_H + 128 * MiB;
constexpr size_t WS_Z = WS_MIXED + 128 * MiB;
constexpr size_t WS_O = WS_Z + 32 * MiB;
constexpr size_t WS_DELTA = WS_O;
constexpr size_t WS_P = WS_O + 192 * MiB;
constexpr size_t WS_WT = WS_P + 376 * MiB;
constexpr size_t WT_IN = 0, WT_OUT = 94 * MiB, WT_GU = 126 * MiB, WT_DN = 298 * MiB, WT_GLU = 384 * MiB, WT_LAYER = 386 * MiB;
constexpr size_t WS_HGB = WS_WT + DEPTH * WT_LAYER;
constexpr size_t WS_GLB = WS_HGB + 198 * MiB;
constexpr size_t WS_S5T = WS_GLB + 128 * MiB;
constexpr size_t WS_S5W1 = WS_S5T + 576 * MiB;
constexpr size_t WS_UX = WS_S5W1 + 144 * MiB;
constexpr size_t WS_SLOC = WS_UX + 36 * MiB;
constexpr size_t WS_LAM64 = WS_SLOC + 8 * MiB;
constexpr size_t WS_ST = WS_LAM64 + 1 * MiB;
constexpr size_t WS_END = WS_ST + 45 * MiB;
static_assert((size_t)INP * DM * 2 == 94 * MiB && (size_t)DM * DM * 2 == 32 * MiB && (size_t)2 * DFF * DM * 2 == 172 * MiB && (size_t)DM * DFF * 2 == 86 * MiB, "weight map");
static_assert((size_t)MTOK * INP * 2 == 376 * MiB && (size_t)MTOK * DFF * 2 <= 376 * MiB, "activation map");

constexpr int RING_BYTES = 131072;
constexpr int LDSCTL_OFF = 135168;
constexpr int LDS_BYTES = 147456;

#ifndef LAS
#define LAS __attribute__((address_space(3)))
#endif
#define GAS __attribute__((address_space(1)))
typedef unsigned short bf16_t;
typedef float f32x4 __attribute__((ext_vector_type(4)));
typedef float f32x2 __attribute__((ext_vector_type(2)));
typedef unsigned u32x4 __attribute__((ext_vector_type(4)));
typedef unsigned u32x2 __attribute__((ext_vector_type(2)));
#define LDS_WAIT() asm volatile("s_waitcnt lgkmcnt(0)" ::: "memory")
#define VM_WAIT() asm volatile("s_waitcnt vmcnt(0)" ::: "memory")
typedef __bf16 bf16x2_t __attribute__((ext_vector_type(2)));
__device__ __forceinline__ unsigned cvt_pk_bf16(float lo, float hi) { return __builtin_bit_cast(unsigned, __builtin_convertvector((f32x2){lo, hi}, bf16x2_t)); }

__device__ __forceinline__ float bf_lo(unsigned w) { return __uint_as_float(w << 16); }
__device__ __forceinline__ float bf_hi(unsigned w) { return __uint_as_float(w & 0xffff0000u); }
__device__ __forceinline__ float bf2f(bf16_t b) { return __uint_as_float(((unsigned)b) << 16); }
__device__ __forceinline__ float wave_sum(float v) {
    v += __int_as_float(__builtin_amdgcn_mov_dpp(__float_as_int(v), 0xB1, 0xF, 0xF, true));
    v += __int_as_float(__builtin_amdgcn_mov_dpp(__float_as_int(v), 0x4E, 0xF, 0xF, true));
    v += __int_as_float(__builtin_amdgcn_mov_dpp(__float_as_int(v), 0x141, 0xF, 0xF, true));
    v += __int_as_float(__builtin_amdgcn_mov_dpp(__float_as_int(v), 0x140, 0xF, 0xF, true));
    const int b = __float_as_int(v);
    return (__int_as_float(__builtin_amdgcn_readlane(b, 0)) + __int_as_float(__builtin_amdgcn_readlane(b, 16))) + (__int_as_float(__builtin_amdgcn_readlane(b, 32)) + __int_as_float(__builtin_amdgcn_readlane(b, 48)));
}
__device__ __forceinline__ float sigmoidf_(float x) { return __builtin_amdgcn_rcpf(1.0f + __expf(-x)); }
__device__ __forceinline__ float gelu_tanh(float y) { const float a = 0.7978845608028654f * (y + 0.044715f * y * y * y); const float t = 1.0f - 2.0f * __builtin_amdgcn_rcpf(1.0f + __expf(2.0f * a)); return 0.5f * y * (1.0f + t); }

struct EpiProj {
    static constexpr bool PERM = true, AFTER_DRAIN = false;
    GAS bf16_t* P; GAS bf16_t* UX;
    __device__ __forceinline__ void operator()(const f32x4 (&acc)[2][2][4][2], const pg8::Unit& u, int wr, int wc, int fr, int fq) const {
        const int row0 = u.pm * 256 + wr * 64 + fr, col0 = u.pn * 256 + wc * 32 + 8 * fq;
        const bool s5 = u.pn < 4;
#pragma unroll
        for (int ai = 0; ai < 2; ++ai)
#pragma unroll
            for (int m = 0; m < 4; ++m) { const int row = row0 + ai * 128 + m * 16;
#pragma unroll
                for (int bj = 0; bj < 2; ++bj) { const f32x4 v0 = acc[ai][bj][m][0], v1 = acc[ai][bj][m][1]; const int col = col0 + bj * 128;
                    u32x4 w; w.x = cvt_pk_bf16(v0[0], v0[1]); w.y = cvt_pk_bf16(v0[2], v0[3]); w.z = cvt_pk_bf16(v1[0], v1[1]); w.w = cvt_pk_bf16(v1[2], v1[3]);
                    if (!s5) *(GAS u32x4*)(P + (size_t)row * INP + col) = w;
                    else { GAS bf16_t* ur = UX + (size_t)((col >> 4) * 256 + (row >> 6)) * 1152; *(GAS u32x4*)(ur + (row & 63) * 16 + (col & 15)) = w;
                        if ((row & 63) == 0) { const u32x4 z = (u32x4){0u, 0u, 0u, 0u}; GAS bf16_t* zp = ur + 1024 + ((col & 15) ? 64 : 0);
#pragma unroll
                            for (int i = 0; i < 8; ++i) *(GAS u32x4*)(zp + 8 * i) = z; } } } }
    }
};
struct EpiSwiglu {
    static constexpr bool PERM = true, AFTER_DRAIN = false;
    GAS bf16_t* HID;
    __device__ __forceinline__ void operator()(const f32x4 (&acc)[2][2][4][2], const pg8::Unit& u, int wr, int wc, int fr, int fq) const {
        const int row0 = u.pm * 256 + wr * 64 + fr, col0 = u.pn * 128 + wc * 32 + 8 * fq;
#pragma unroll
        for (int ai = 0; ai < 2; ++ai)
#pragma unroll
            for (int m = 0; m < 4; ++m) { GAS bf16_t* rowp = HID + (size_t)(row0 + ai * 128 + m * 16) * DFF + col0;
                float o[8];
#pragma unroll
                for (int n = 0; n < 2; ++n)
#pragma unroll
                    for (int j = 0; j < 4; ++j) { const float g = acc[ai][0][m][n][j], up = acc[ai][1][m][n][j]; o[n * 4 + j] = g * __builtin_amdgcn_rcpf(1.0f + __expf(-g)) * up; }
                u32x4 w; w.x = cvt_pk_bf16(o[0], o[1]); w.y = cvt_pk_bf16(o[2], o[3]); w.z = cvt_pk_bf16(o[4], o[5]); w.w = cvt_pk_bf16(o[6], o[7]);
                *(GAS u32x4*)rowp = w; }
    }
};
struct EpiGlu {
    static constexpr bool PERM = true, AFTER_DRAIN = false;
    const GAS bf16_t* Z; GAS bf16_t* MIXED; const GAS float* bias;
    __device__ __forceinline__ void operator()(const f32x4 (&acc)[2][2][4][2], const pg8::Unit& u, int wr, int wc, int fr, int fq) const {
        const int row0 = u.pm * 256 + wr * 64 + fr, col0 = u.pn * 256 + wc * 32 + 8 * fq;
#pragma unroll
        for (int bj = 0; bj < 2; ++bj) {
            const f32x4 b0 = *(const GAS f32x4*)(bias + col0 + bj * 128), b1 = *(const GAS f32x4*)(bias + col0 + bj * 128 + 4);
#pragma unroll
            for (int ai = 0; ai < 2; ++ai)
#pragma unroll
                for (int m = 0; m < 4; ++m) { const size_t r = (size_t)(row0 + ai * 128 + m * 16);
                    const u32x4 zz = *(const GAS u32x4*)(Z + r * S5W + col0 + bj * 128);
                    const f32x4 v0 = acc[ai][bj][m][0] + b0, v1 = acc[ai][bj][m][1] + b1;
                    u32x4 w;
                    w.x = cvt_pk_bf16(bf_lo(zz.x) * sigmoidf_(v0[0]), bf_hi(zz.x) * sigmoidf_(v0[1]));
                    w.y = cvt_pk_bf16(bf_lo(zz.y) * sigmoidf_(v0[2]), bf_hi(zz.y) * sigmoidf_(v0[3]));
                    w.z = cvt_pk_bf16(bf_lo(zz.z) * sigmoidf_(v1[0]), bf_hi(zz.z) * sigmoidf_(v1[1]));
                    w.w = cvt_pk_bf16(bf_lo(zz.w) * sigmoidf_(v1[2]), bf_hi(zz.w) * sigmoidf_(v1[3]));
                    *(GAS u32x4*)(MIXED + r * DM + col0 + bj * 128) = w;
                    if (m & 1) asm volatile("" ::: "memory"); }
        }
    }
};
struct EpiDelta {
    static constexpr bool PERM = true, AFTER_DRAIN = false;
    GAS bf16_t* D; const GAS float* gate0;
    __device__ __forceinline__ void operator()(const f32x4 (&acc)[2][2][4][2], const pg8::Unit& u, int wr, int wc, int fr, int fq) const {
        const int row0 = u.pm * 256 + wr * 64 + fr, col0 = u.pn * 256 + wc * 32 + 8 * fq;
        const GAS float* gp = gate0 + (u.pm >= 32 ? 6 * DM : 0) + col0;
        f32x4 g[2][2];
#pragma unroll
        for (int bj = 0; bj < 2; ++bj)
#pragma unroll
            for (int n = 0; n < 2; ++n) g[bj][n] = *(const GAS f32x4*)(gp + bj * 128 + 4 * n) + 1.0f;
#pragma unroll
        for (int ai = 0; ai < 2; ++ai)
#pragma unroll
            for (int m = 0; m < 4; ++m) { GAS bf16_t* rowp = D + (size_t)(row0 + ai * 128 + m * 16) * DM + col0;
#pragma unroll
                for (int bj = 0; bj < 2; ++bj) { const f32x4 v0 = acc[ai][bj][m][0] * g[bj][0], v1 = acc[ai][bj][m][1] * g[bj][1];
                    u32x4 w; w.x = cvt_pk_bf16(v0[0], v0[1]); w.y = cvt_pk_bf16(v0[2], v0[3]); w.z = cvt_pk_bf16(v1[0], v1[1]); w.w = cvt_pk_bf16(v1[2], v1[3]);
                    *(GAS u32x4*)(rowp + bj * 128) = w; } }
    }
};

__device__ __forceinline__ int lane_id_v() { int r; asm volatile("v_mbcnt_lo_u32_b32 %0, -1, 0\n\tv_mbcnt_hi_u32_b32 %0, -1, %0" : "=v"(r)); return r; }
struct Args { const float* in[N_IN]; float* out; unsigned char* ws; int ph_lo, ph_hi; };
struct Ctx {
    volatile LAS unsigned long long* t;
    __device__ __forceinline__ unsigned long long ld(int i) const { const unsigned long long v = t[i];
        return ((unsigned long long)(unsigned)__builtin_amdgcn_readfirstlane((int)(v >> 32)) << 32) | (unsigned long long)(unsigned)__builtin_amdgcn_readfirstlane((int)(unsigned)v); }
    __device__ __forceinline__ const GAS float* in(int i) const { return (const GAS float*)ld(i); }
    __device__ __forceinline__ GAS float* out() const { return (GAS float*)ld(30); }
    __device__ __forceinline__ GAS unsigned char* ws() const { return (GAS unsigned char*)ld(31); }
};

constexpr int S5K = 1152;
constexpr size_t S5_T_LAYER = (size_t)64 * 1024 * S5K * 2, S5_W1_LAYER = (size_t)64 * 256 * S5K * 2;

struct S5Order {
    int G, c, n, sh;
    __device__ __forceinline__ bool next(int i, pg8::Unit& u) const { const int L = i * G + c; if (L >= n) return false; u.pm = L >> sh; u.pn = L; return true; }
    __device__ __forceinline__ void a_ready(const pg8::Unit&) const {}
    __device__ __forceinline__ void done(const pg8::Unit&) const {}
};
struct EpiS5A {
    static constexpr bool PERM = false, AFTER_DRAIN = false;
    GAS float* Sloc;
    __device__ __forceinline__ void operator()(const f32x4 (&acc)[2][2][4][2], const pg8::Unit& u, int wr, int wc, int fr, int fq) const {
        const int row0 = u.pm * 256 + wr * 64 + fr, col0 = wc * 32 + 4 * fq;
#pragma unroll
        for (int ai = 0; ai < 2; ++ai)
#pragma unroll
            for (int m = 0; m < 4; ++m)
#pragma unroll
                for (int n = 0; n < 2; ++n) *(GAS f32x4*)(Sloc + (size_t)(row0 + ai * 128 + m * 16) * 128 + col0 + n * 16) = acc[ai][0][m][n];
    }
};
struct EpiS5C {
    static constexpr bool PERM = true, AFTER_DRAIN = false;
    GAS bf16_t* Z;
    __device__ __forceinline__ void operator()(const f32x4 (&acc)[2][2][4][2], const pg8::Unit& u, int wr, int wc, int fr, int fq) const {
        const int g = u.pm, c0 = wr * 64 + fr, cc0 = (u.pn & 3) * 256 + wc * 32 + 8 * fq;
#pragma unroll
        for (int ai = 0; ai < 2; ++ai)
#pragma unroll
            for (int m = 0; m < 4; ++m) { const int c = c0 + ai * 128 + m * 16;
#pragma unroll
                for (int bj = 0; bj < 2; ++bj) { const int cc = cc0 + bj * 128, t = cc >> 4, h0 = cc & 15;
                    const f32x4 v0 = acc[ai][bj][m][0], v1 = acc[ai][bj][m][1];
                    u32x4 w; w.x = cvt_pk_bf16(gelu_tanh(v0[0]), gelu_tanh(v0[1])); w.y = cvt_pk_bf16(gelu_tanh(v0[2]), gelu_tanh(v0[3]));
                    w.z = cvt_pk_bf16(gelu_tanh(v1[0]), gelu_tanh(v1[1])); w.w = cvt_pk_bf16(gelu_tanh(v1[2]), gelu_tanh(v1[3]));
                    *(GAS u32x4*)(Z + (size_t)(c * 64 + t) * S5W + g * 16 + h0) = w; } }
    }
};
__device__ __forceinline__ void s5_tables_item(const Ctx& a, int lg, LAS unsigned char* lds, int wave, int lane) {
    LAS f32x2* LP = (LAS f32x2*)lds;
    LAS f32x2* BB = (LAS f32x2*)(lds + 33280);
    LAS f32x2* CC = (LAS f32x2*)(lds + 41472);
    LAS float* KT = (LAS float*)(lds + 49664);
    const int tid = wave * 64 + lane, l = lg >> 6, g = lg & 63;
    if (tid < 64) { const int p = tid;
        const double ar = (double)a.in(I_AREAL)[lg * 64 + p], ai = (double)a.in(I_AIMAG)[lg * 64 + p], dt = exp((double)a.in(I_LOGDT)[lg]);
        const double mag = exp(ar * dt), ang = ai * dt, lr = mag * cos(ang), li = mag * sin(ang);
        const double den = ar * ar + ai * ai, nr = lr - 1.0, ni = li, cr = (nr * ar + ni * ai) / den, ci = (ni * ar - nr * ai) / den;
        double pr = 1.0, pi = 0.0;
        for (int tau = 0; tau <= 64; ++tau) { LP[tau * 64 + p] = (f32x2){(float)pr, (float)pi}; const double nr2 = pr * lr - pi * li, ni2 = pr * li + pi * lr; pr = nr2; pi = ni2; }
        for (int h = 0; h < 16; ++h) { const double br = (double)a.in(I_BRE)[((size_t)lg * 64 + p) * 16 + h], bi = (double)a.in(I_BIM)[((size_t)lg * 64 + p) * 16 + h];
            BB[p * 16 + h] = (f32x2){(float)(cr * br - ci * bi), (float)(cr * bi + ci * br)}; }
    }
    for (int e = tid; e < 1024; e += 512) { const int h = e >> 6, p = e & 63; CC[e] = (f32x2){a.in(I_CRE)[((size_t)lg * 16 + h) * 64 + p], a.in(I_CIM)[((size_t)lg * 16 + h) * 64 + p]}; }
    __syncthreads();
    if (tid < 64) *(GAS f32x2*)((GAS float*)(a.ws() + WS_LAM64) + ((size_t)lg * 64 + tid) * 2) = LP[64 * 64 + tid];
    for (int e = tid; e < 64 * 256; e += 512) { const int tau = e >> 8, h = (e >> 4) & 15, hp = e & 15; float s = 0.f;
#pragma unroll 8
        for (int p = 0; p < 64; ++p) { const f32x2 c = CC[h * 64 + p], lm = LP[tau * 64 + p], b = BB[p * 16 + hp];
            const float xr = c.x * lm.x - c.y * lm.y, xi = c.x * lm.y + c.y * lm.x; s += xr * b.x - xi * b.y; }
        if (tau == 0 && h == hp) s += a.in(I_S5D)[l * S5W + g * 16 + h];
        KT[e] = s; }
    __syncthreads();
    GAS bf16_t* T = (GAS bf16_t*)(a.ws() + WS_S5T + (size_t)l * S5_T_LAYER) + (size_t)g * 1024 * S5K;
    for (int pc = tid; pc < 1024 * 144; pc += 512) { const int n = pc / 144, j = pc % 144, t = n >> 4, h = n & 15; float v[8];
        if (j < 128) { const int s = j >> 1, hp0 = (j & 1) * 8;
            if (s > t) {
#pragma unroll
                for (int i = 0; i < 8; ++i) v[i] = 0.f;
            } else { const LAS float* kp = KT + (t - s) * 256 + h * 16 + hp0; const f32x4 k0 = *(const LAS f32x4*)kp, k1 = *(const LAS f32x4*)(kp + 4);
                v[0] = k0[0]; v[1] = k0[1]; v[2] = k0[2]; v[3] = k0[3]; v[4] = k1[0]; v[5] = k1[1]; v[6] = k1[2]; v[7] = k1[3]; }
        } else { const int p0 = (j - 128) * 4;
#pragma unroll
            for (int i = 0; i < 4; ++i) { const f32x2 c = CC[h * 64 + p0 + i], lm = LP[(t + 1) * 64 + p0 + i]; v[2 * i] = c.x * lm.x - c.y * lm.y; v[2 * i + 1] = -(c.x * lm.y + c.y * lm.x); } }
        *(GAS u32x4*)(T + (size_t)n * S5K + j * 8) = (u32x4){cvt_pk_bf16(v[0], v[1]), cvt_pk_bf16(v[2], v[3]), cvt_pk_bf16(v[4], v[5]), cvt_pk_bf16(v[6], v[7])}; }
    GAS bf16_t* W1 = (GAS bf16_t*)(a.ws() + WS_S5W1 + (size_t)l * S5_W1_LAYER) + (size_t)g * 256 * S5K;
    for (int pc = tid; pc < 256 * 144; pc += 512) { const int n = pc / 144, j = pc % 144; float v[8];
#pragma unroll
        for (int i = 0; i < 8; ++i) v[i] = 0.f;
        if (n < 128 && j < 128) { const int p = n >> 1, ri = n & 1, s = j >> 1, hp0 = (j & 1) * 8; const f32x2 lm = LP[(63 - s) * 64 + p];
#pragma unroll
            for (int i = 0; i < 8; ++i) { const f32x2 b = BB[p * 16 + hp0 + i]; v[i] = ri ? (lm.x * b.y + lm.y * b.x) : (lm.x * b.x - lm.y * b.y); } }
        *(GAS u32x4*)(W1 + (size_t)n * S5K + j * 8) = (u32x4){cvt_pk_bf16(v[0], v[1]), cvt_pk_bf16(v[2], v[3]), cvt_pk_bf16(v[4], v[5]), cvt_pk_bf16(v[6], v[7])}; }
    __syncthreads();
}
__device__ __forceinline__ void s5_scan_item(const Ctx& a, int l, int item, int wave, int lane) {
    const int idx = item * 512 + wave * 64 + lane, g = idx >> 7, b = (idx >> 6) & 1, p = idx & 63;
    const f32x2 lam = *(const GAS f32x2*)((const GAS float*)(a.ws() + WS_LAM64) + ((size_t)(l * 64 + g) * 64 + p) * 2);
    const GAS float* sl = (const GAS float*)(a.ws() + WS_SLOC) + ((size_t)(g * 256 + b * 128)) * 128 + 2 * p;
    GAS bf16_t* ux = (GAS bf16_t*)(a.ws() + WS_UX) + ((size_t)(g * 256 + b * 128)) * S5K + 1024 + 2 * p;
    float xr = 0.f, xi = 0.f;
    for (int c0 = 0; c0 < 128; c0 += 8) { f32x2 s[8];
#pragma unroll
        for (int i = 0; i < 8; ++i) s[i] = *(const GAS f32x2*)(sl + (size_t)(c0 + i) * 128);
#pragma unroll
        for (int i = 0; i < 8; ++i) { *(GAS unsigned*)(ux + (size_t)(c0 + i) * S5K) = cvt_pk_bf16(xr, xi);
            const float nr = lam.x * xr - lam.y * xi + s[i].x, ni = lam.x * xi + lam.y * xr + s[i].y; xr = nr; xi = ni; } }
}

__device__ __forceinline__ void transpose_item(const GAS float* W, int N, int k0, int n0, GAS bf16_t* WT, int drow0, int Kd, LAS float* scr, int lane) {
    const int nl = 4 * (lane & 15), kq = lane >> 4;
    const bool valid = (n0 + nl) < N;
    f32x4 v[16];
#pragma unroll
    for (int i = 0; i < 16; ++i) { const int k = 4 * i + kq; v[i] = valid ? *(const GAS f32x4*)(W + (size_t)(k0 + k) * N + n0 + nl) : (f32x4){0.f, 0.f, 0.f, 0.f}; }
#pragma unroll
    for (int i = 0; i < 16; ++i) { const int k = 4 * i + kq; LAS float* s = scr + k * 65 + nl; s[0] = v[i][0]; s[1] = v[i][1]; s[2] = v[i][2]; s[3] = v[i][3]; }
    LDS_WAIT();
    const int c = lane & 7;
#pragma unroll
    for (int j = 0; j < 8; ++j) { const int n = (lane >> 3) + 8 * j; const LAS float* s = scr + (8 * c) * 65 + n;
        u32x4 o; o.x = cvt_pk_bf16(s[0], s[65]); o.y = cvt_pk_bf16(s[130], s[195]); o.z = cvt_pk_bf16(s[260], s[325]); o.w = cvt_pk_bf16(s[390], s[455]);
        *(GAS u32x4*)(WT + (size_t)(drow0 + n) * Kd + k0 + 8 * c) = o; }
    LDS_WAIT();
}
constexpr int NIT_IN = 64 * 188, NIT_OUT = 64 * 64, NIT_G = 64 * 172, NIT_DN = 172 * 64, NIT_GLU = 16 * 16;
constexpr int NIT_LAYER = NIT_IN + NIT_OUT + 2 * NIT_G + NIT_DN + NIT_GLU;
constexpr int NIT_TR = DEPTH * NIT_LAYER, NIT_COND = 64 * 96;

__device__ __forceinline__ void phase_prologue(const Ctx& a, LAS unsigned char* lds, int wave, int lane) {
    if (blockIdx.x & 1) { for (int lg = blockIdx.x; lg < DEPTH * 64; lg += gridDim.x) s5_tables_item(a, lg, lds, wave, lane); __syncthreads(); }
    LAS float* scr = (LAS float*)(lds + wave * 16640);
    const int gw = blockIdx.x * 8 + wave, NGW = gridDim.x * 8;
    for (int it = gw; it < NIT_TR + NIT_COND; it += NGW) {
        if (it < NIT_TR) {
            const int l = it / NIT_LAYER; int r = it % NIT_LAYER;
            GAS unsigned char* wt = a.ws() + WS_WT + (size_t)l * WT_LAYER;
            if (r < NIT_IN) { const int kb = r / 188, nb = r % 188; transpose_item(a.in(I_WIN) + (size_t)l * DM * INW, INW, 64 * kb, 64 * nb, (GAS bf16_t*)(wt + WT_IN), 64 * nb, DM, scr, lane); continue; } r -= NIT_IN;
            if (r < NIT_OUT) { const int kb = r / 64, nb = r % 64; transpose_item(a.in(I_WOUT) + (size_t)l * DM * DM, DM, 64 * kb, 64 * nb, (GAS bf16_t*)(wt + WT_OUT), 64 * nb, DM, scr, lane); continue; } r -= NIT_OUT;
            if (r < NIT_G) { const int kb = r / 172, nb = r % 172, n0 = 64 * nb; transpose_item(a.in(I_WFG) + (size_t)l * DM * DFF, DFF, 64 * kb, n0, (GAS bf16_t*)(wt + WT_GU), 256 * (n0 / 128) + (n0 % 128), DM, scr, lane); continue; } r -= NIT_G;
            if (r < NIT_G) { const int kb = r / 172, nb = r % 172, n0 = 64 * nb; transpose_item(a.in(I_WFU) + (size_t)l * DM * DFF, DFF, 64 * kb, n0, (GAS bf16_t*)(wt + WT_GU), 256 * (n0 / 128) + 128 + (n0 % 128), DM, scr, lane); continue; } r -= NIT_G;
            if (r < NIT_DN) { const int kb = r / 64, nb = r % 64; transpose_item(a.in(I_WFD) + (size_t)l * DFF * DM, DM, 64 * kb, 64 * nb, (GAS bf16_t*)(wt + WT_DN), 64 * nb, DFF, scr, lane); continue; } r -= NIT_DN;
            { const int kb = r / 16, nb = r % 16; transpose_item(a.in(I_GLUW) + (size_t)l * S5W * S5W, S5W, 64 * kb, 64 * nb, (GAS bf16_t*)(wt + WT_GLU), 64 * nb, S5W, scr, lane); }
        } else {
            const int item = it - NIT_TR, kb = item / 96, jb = item % 96, k0 = 64 * kb, j0 = 256 * jb + 4 * lane;
            const GAS float* c = a.in(I_C);
            float c0 = c[k0 + lane], c1 = c[DM + k0 + lane];
            c0 = c0 / (1.0f + expf(-c0)); c1 = c1 / (1.0f + expf(-c1));
            f32x4 a0 = (f32x4){0.f, 0.f, 0.f, 0.f}, a1 = a0;
            const GAS float* w = a.in(I_WADA) + (size_t)k0 * (6 * DM) + j0;
#pragma unroll 8
            for (int kk = 0; kk < 64; ++kk) { const f32x4 wv = *(const GAS f32x4*)(w + (size_t)kk * (6 * DM));
                const float s0 = __int_as_float(__builtin_amdgcn_readlane(__float_as_int(c0), kk)), s1 = __int_as_float(__builtin_amdgcn_readlane(__float_as_int(c1), kk));
                a0 += wv * s0; a1 += wv * s1; }
            GAS float* cp = (GAS float*)(a.ws() + WS_CONDPART);
            *(GAS f32x4*)(cp + (size_t)(kb * 2 + 0) * (6 * DM) + j0) = a0;
            *(GAS f32x4*)(cp + (size_t)(kb * 2 + 1) * (6 * DM) + j0) = a1;
        }
    }
    __syncthreads();
    if (!(blockIdx.x & 1)) { for (int lg = blockIdx.x; lg < DEPTH * 64; lg += gridDim.x) s5_tables_item(a, lg, lds, wave, lane); }
}
__device__ __forceinline__ void phase_mod(const Ctx& a, int wave, int lane) {
    const int gt = blockIdx.x * 512 + wave * 64 + lane, NT = gridDim.x * 512;
    const GAS float* cp = (const GAS float*)(a.ws() + WS_CONDPART);
    GAS float* mod = (GAS float*)(a.ws() + WS_MOD); GAS float* misc = (GAS float*)(a.ws() + WS_MISC);
    for (int idx = gt; idx < NB * 6 * DM; idx += NT) {
        const int b = idx / (6 * DM), j = idx % (6 * DM);
        float s = a.in(I_BADA)[j];
        for (int kb = 0; kb < 64; ++kb) s += cp[(size_t)(kb * 2 + b) * (6 * DM) + j];
        for (int l = 0; l < DEPTH; ++l) mod[(size_t)((l * 2 + b) * 6) * DM + j] = s + a.in(I_TABLE)[(size_t)l * 6 * DM + j];
    }
    for (int idx = gt; idx < DM; idx += NT) { misc[idx] = 1.0f; misc[DM + idx] = 0.0f; }
    for (int idx = gt; idx < HGW; idx += NT) {
        const GAS float* raw = a.in(I_LBRAW); float r[DEPTH], mx = -3.0e38f;
#pragma unroll
        for (int l = 0; l < DEPTH; ++l) { r[l] = raw[l * HGW + idx]; mx = fmaxf(mx, r[l]); }
        float e[DEPTH], sum = 0.f;
#pragma unroll
        for (int l = 0; l < DEPTH; ++l) { e[l] = expf(r[l] - mx); sum += e[l]; }
        float cum = 0.f;
#pragma unroll
        for (int l = 0; l < DEPTH; ++l) { misc[2 * DM + l * HGW + idx] = cum; if (l + 1 < DEPTH) cum += e[l + 1] / sum; }
    }
}

__device__ __forceinline__ void phase_h0(const GAS float* x, const GAS float* modp, GAS bf16_t* H, int wave, int lane) {
    for (int blk = blockIdx.x; blk < MTOK / 64; blk += gridDim.x) {
        const int r0 = blk * 64, b = (r0 >= SEQ) ? 1 : 0;
        f32x4 A[2], B[2];
#pragma unroll
        for (int jj = 0; jj < 2; ++jj) { const int c = 512 * wave + 256 * jj + 4 * lane; A[jj] = *(const GAS f32x4*)(modp + (size_t)(b * 6 + 1) * DM + c) + 1.0f; B[jj] = *(const GAS f32x4*)(modp + (size_t)(b * 6 + 0) * DM + c); }
#pragma unroll 8
        for (int rl = 0; rl < 64; ++rl) { const size_t off = (size_t)(r0 + rl) * DM + 512 * wave + 4 * lane;
#pragma unroll
            for (int jj = 0; jj < 2; ++jj) { const f32x4 v = *(const GAS f32x4*)(x + off + 256 * jj), y = v * A[jj] + B[jj];
                u32x2 w; w.x = cvt_pk_bf16(y[0], y[1]); w.y = cvt_pk_bf16(y[2], y[3]); *(GAS u32x2*)(H + off + 256 * jj) = w; } }
    }
}
template <bool WITH_H>
__device__ __forceinline__ void phase_lnres(const GAS float* xprev, const GAS bf16_t* delta, GAS float* xout, const GAS float* lng, const GAS float* lnb, const GAS float* modp, int i_shift, int i_scale, GAS bf16_t* H,
                                            LAS unsigned char* lds, int wave, int lane) {
    LAS f32x2* red = (LAS f32x2*)lds;
    for (int blk = blockIdx.x; blk < MTOK / 64; blk += gridDim.x) {
        const int r0 = blk * 64, b = (r0 >= SEQ) ? 1 : 0;
        f32x4 G[2], Bt[2], A[2], B[2];
#pragma unroll
        for (int jj = 0; jj < 2; ++jj) { const int c = 512 * wave + 256 * jj + 4 * lane; G[jj] = *(const GAS f32x4*)(lng + c); Bt[jj] = *(const GAS f32x4*)(lnb + c);
            if (WITH_H) { A[jj] = *(const GAS f32x4*)(modp + (size_t)(b * 6 + i_scale) * DM + c) + 1.0f; B[jj] = *(const GAS f32x4*)(modp + (size_t)(b * 6 + i_shift) * DM + c); } }
        const size_t offb = (size_t)r0 * DM + 512 * wave + 4 * lane;
        f32x4 va[4][2], vb[4][2]; u32x2 da[4][2], db[4][2];
#define LN_LOAD(v_, d_, it_) do { _Pragma("unroll") for (int r = 0; r < 4; ++r) _Pragma("unroll") for (int jj = 0; jj < 2; ++jj) { \
            v_[r][jj] = *(const GAS f32x4*)(xprev + offb + (size_t)((it_) * 4 + r) * DM + 256 * jj); d_[r][jj] = *(const GAS u32x2*)(delta + offb + (size_t)((it_) * 4 + r) * DM + 256 * jj); } } while (0)
#define LN_STEP(v_, d_, it_) do { LAS f32x2* rb = red + ((it_) & 1) * 32; \
            _Pragma("unroll") for (int r = 0; r < 4; ++r) { float s1 = 0.f, s2 = 0.f; \
                _Pragma("unroll") for (int jj = 0; jj < 2; ++jj) { const f32x4 dd = (f32x4){bf_lo(d_[r][jj].x), bf_hi(d_[r][jj].x), bf_lo(d_[r][jj].y), bf_hi(d_[r][jj].y)}; const f32x4 y = v_[r][jj] * ALPHA + dd; v_[r][jj] = y; \
                    s1 += (y[0] + y[1]) + (y[2] + y[3]); s2 += (y[0] * y[0] + y[1] * y[1]) + (y[2] * y[2] + y[3] * y[3]); } \
                s1 = wave_sum(s1); s2 = wave_sum(s2); if (lane == 0) rb[r * 8 + wave] = (f32x2){s1, s2}; } \
            __syncthreads(); \
            _Pragma("unroll") for (int r = 0; r < 4; ++r) { float s1 = 0.f, s2 = 0.f; \
                _Pragma("unroll") for (int w = 0; w < 8; ++w) { const f32x2 p = rb[r * 8 + w]; s1 += p.x; s2 += p.y; } \
                const float mu = s1 * (1.0f / DM), rs = 1.0f / sqrtf(fmaxf(s2 * (1.0f / DM) - mu * mu, 0.f) + LN_EPS); \
                _Pragma("unroll") for (int jj = 0; jj < 2; ++jj) { const f32x4 x = ((v_[r][jj] - mu) * rs) * G[jj] + Bt[jj]; \
                    *(GAS f32x4*)(xout + offb + (size_t)((it_) * 4 + r) * DM + 256 * jj) = x; \
                    if (WITH_H) { const f32x4 y = x * A[jj] + B[jj]; u32x2 w; w.x = cvt_pk_bf16(y[0], y[1]); w.y = cvt_pk_bf16(y[2], y[3]); *(GAS u32x2*)(H + offb + (size_t)((it_) * 4 + r) * DM + 256 * jj) = w; } } } } while (0)
        LN_LOAD(va, da, 0);
        for (int it = 0; it < 16; it += 2) {
            LN_LOAD(vb, db, it + 1);
            LN_STEP(va, da, it);
            if (it + 2 < 16) LN_LOAD(va, da, it + 2);
            LN_STEP(vb, db, it + 1);
        }
#undef LN_LOAD
#undef LN_STEP
        __syncthreads();
    }
}

typedef short bf16x8 __attribute__((ext_vector_type(8)));
constexpr int HG_BLK = 33280, HG_OQ = 0, HG_OK = 8192, HG_OKT = 16384, HG_ODL = 24576, HG_OVT = 25088;
constexpr int GL_BLK = 63488, GL_OQ = 0, GL_OK = 12800, GL_OKT = 25600, GL_ODL = 37888, GL_SHARED = 38912, GL_OVT = 38912;
constexpr int NUNIT = SEQ / 32;

struct PreOut { GAS unsigned char* blk; int oq, ok, okt, odl, rowb; bool swz; };
__device__ __forceinline__ int slot_swz(int r) { return (0 - (r >> 2)) & 3; }
template <int HALF>
__device__ __forceinline__ float pre_half(const PreOut& P, int d, int pd, float e0, const float (&a)[16], const float (&qq)[16], const float (&kk)[16], float (&kta)[16], unsigned (&kt)[16], float& ph) {
    float w = 1.0f;
#pragma unroll
    for (int t = 14; t >= 0; t -= 2) { const float kv1 = kk[t + 1] * w; w *= a[t + 1]; const float kv0 = kk[t] * w; w *= a[t];
        if (HALF == 0) { kta[t] = kv0; kta[t + 1] = kv1; } else kt[4 * (t >> 2) + 2 + ((t & 3) >> 1)] = cvt_pk_bf16(kv0, kv1); }
    ph = w;
    float e = e0;
#pragma unroll
    for (int j = 0; j < 16; ++j) { const int row = 16 * HALF + j;
        e *= a[j];
        const int off = row * P.rowb + ((2 * pd) ^ ((P.swz ? j : ((j >> 1) & 7)) << 4));
        const float qv = qq[j] * e, kc = kk[j] * fminf(__builtin_amdgcn_rcpf(e), 5.5406224e34f);
        const float qn = __int_as_float(__builtin_amdgcn_mov_dpp(__float_as_int(qv), 0xB1, 0xF, 0xF, true)), kn = __int_as_float(__builtin_amdgcn_mov_dpp(__float_as_int(kc), 0xB1, 0xF, 0xF, true));
        if ((d & 1) == 0) { *(GAS unsigned*)(P.blk + P.oq + off) = cvt_pk_bf16(qv, qn); *(GAS unsigned*)(P.blk + P.ok + off) = cvt_pk_bf16(kc, kn); } }
    return e;
}
__device__ __forceinline__ void pre_tail(const PreOut& P, int d, float dlb, float eend, const float (&kta)[16], unsigned (&kt)[16]) {
#pragma unroll
    for (int t = 0; t < 16; t += 2) kt[4 * (t >> 2) + ((t & 3) >> 1)] = cvt_pk_bf16(kta[t] * dlb, kta[t + 1] * dlb);
#pragma unroll
    for (int i = 0; i < 4; ++i) *(GAS u32x4*)(P.blk + P.okt + d * 64 + 16 * (i ^ slot_swz(d))) = (u32x4){kt[4 * i], kt[4 * i + 1], kt[4 * i + 2], kt[4 * i + 3]};
    *(GAS float*)(P.blk + P.odl + d * 4) = eend;
}
__device__ __forceinline__ void glds16_asm(const GAS void* gsrc, unsigned lds_dst) { unsigned keep;
    asm volatile("s_mov_b32 %0, m0\n\ts_mov_b32 m0, %2\n\ts_nop 0\n\tglobal_load_lds_dwordx4 %1, off\n\ts_mov_b32 m0, %0" : "=&s"(keep) : "v"(gsrc), "s"(lds_dst) : "memory"); }
constexpr int PRE_IN = 49152, PRE_OUT = 2 * PRE_IN;
__device__ __forceinline__ void pre_hg_dma(const GAS bf16_t* P, int t, int half, LAS unsigned char* img, int wave, int lane) {
    const int bu = t / 3, kind = t - 3 * bu, b = bu / NUNIT, un = bu - b * NUNIT;
    const GAS bf16_t* src = P + ((size_t)b * SEQ + un * 32 + 16 * half) * INP + kind * 512 + 8 * lane;
    const unsigned dst = (unsigned)(size_t)img;
#pragma unroll
    for (int i = 0; i < 6; ++i) { const int r = wave * 6 + i, arr = r >> 4, j = r & 15;
        glds16_asm(src + (size_t)j * INP + (arr == 0 ? C_QB : arr == 1 ? C_FB : C_IB), dst + r * 1024); }
}
template <int HALF>
__device__ __forceinline__ float pre_half_l(LAS unsigned char* oq, LAS unsigned char* ok, int pd, float e0, const float (&a)[16], const float (&qq)[16], const float (&kk)[16], float (&kta)[16], unsigned (&kt)[16], float& ph) {
    float w = 1.0f;
#pragma unroll
    for (int t = 14; t >= 0; t -= 2) { const float kv1 = kk[t + 1] * w; w *= a[t + 1]; const float kv0 = kk[t] * w; w *= a[t];
        if (HALF == 0) { kta[t] = kv0; kta[t + 1] = kv1; } else kt[4 * (t >> 2) + 2 + ((t & 3) >> 1)] = cvt_pk_bf16(kv0, kv1); }
    ph = w;
    float e = e0;
#pragma unroll
    for (int j = 0; j < 16; ++j) { e *= a[j];
        const int off = j * 256 + ((2 * pd) ^ (j << 4));
        const float qv = qq[j] * e, kc = kk[j] * fminf(__builtin_amdgcn_rcpf(e), 5.5406224e34f);
        *(LAS unsigned short*)(oq + off) = (unsigned short)cvt_pk_bf16(qv, qv); *(LAS unsigned short*)(ok + off) = (unsigned short)cvt_pk_bf16(kc, kc); }
    return e;
}
__device__ __forceinline__ void phase_pre(const Ctx& a, int l, LAS unsigned char* lds, int wave, int lane) {
    const GAS bf16_t* P = (const GAS bf16_t*)(a.ws() + WS_P);
    int tid = wave * 64 + lane;
    const int bx = blockIdx.x, G = gridDim.x;
    {
        const int t_lo = (int)((long)(NB * NUNIT * 3) * bx / G), t_hi = (int)((long)(NB * NUNIT * 3) * (bx + 1) / G);
        float lbk[3];
#pragma unroll
        for (int k = 0; k < 3; ++k) lbk[k] = ((const GAS float*)(a.ws() + WS_MISC))[2 * DM + l * HGW + k * 512 + tid];
        asm volatile("" : "+v"(lbk[0]), "+v"(lbk[1]), "+v"(lbk[2]));
        __syncthreads();
        if (t_lo < t_hi) pre_hg_dma(P, t_lo, 0, lds, wave, lane);
        VM_WAIT();
        for (int t = t_lo; t < t_hi; ++t) {
            asm volatile("" : "+v"(tid));
            const int bu = t / 3, kind = t - 3 * bu, b = bu / NUNIT, un = bu - b * NUNIT;
            const int ch = kind * 512 + tid, hh = tid >> 7, d = tid & 127, pd = (d & ~31) + 8 * ((d >> 2) & 3) + 4 * ((d >> 4) & 1) + (d & 3);
            const float lb = kind == 0 ? lbk[0] : kind == 1 ? lbk[1] : lbk[2];
            GAS unsigned char* blk0 = a.ws() + WS_HGB + ((size_t)(b * 12 + kind * 4) * NUNIT + un) * HG_BLK;
            float kta[16]; unsigned kt[16], vv[16]; float e0 = 1.f, e1 = 1.f, ph = 1.f;
#pragma unroll
            for (int half = 0; half < 2; ++half) {
                __syncthreads();
                { const int nt = half ? t + 1 : t; if (nt < t_hi) pre_hg_dma(P, nt, half ^ 1, lds + (half ^ 1) * PRE_IN, wave, lane); }
                const LAS unsigned char* img = lds + half * PRE_IN + 2 * tid;
                float g[16], qq[16], kk[16];
                unsigned short rq[16], rf[16], rv[16];
#pragma unroll
                for (int j = 0; j < 16; ++j) { rq[j] = *(const LAS unsigned short*)(img + j * 1024); rf[j] = *(const LAS unsigned short*)(img + (16 + j) * 1024); rv[j] = *(const LAS unsigned short*)(img + (32 + j) * 1024); }
                asm volatile("" ::: "memory");
#pragma unroll
                for (int j = 0; j < 16; ++j) {
                    const float qin = fmaxf(bf2f(rq[j]), -80.f), fin = fminf(fmaxf(bf2f(rf[j]), -80.f), 80.f);
                    const unsigned short v = rv[j];
                    const int w = 4 * (j >> 2) + 2 * half + ((j & 3) >> 1); if (j & 1) vv[w] |= ((unsigned)v) << 16; else vv[w] = v;
                    const float e = __expf(-fin), sg = __builtin_amdgcn_rcpf(1.0f + e);
                    const float f = lb + (1.0f - lb) * sg;
                    g[j] = f; kk[j] = (1.0f - lb) * (e * sg); qq[j] = qin * __builtin_amdgcn_rcpf(1.0f + __expf(-qin)); }
                LAS unsigned char* oq = lds + PRE_OUT + hh * 4096; LAS unsigned char* ok = oq + 16384;
                if (half == 0) { e0 = pre_half_l<0>(oq, ok, pd, 1.0f, g, qq, kk, kta, kt, ph); } else { e1 = pre_half_l<1>(oq, ok, pd, e0, g, qq, kk, kta, kt, ph); }
                __syncthreads();
                VM_WAIT();
#pragma unroll
                for (int i = 0; i < 4; ++i) { const int pc = i * 512 + tid, c = pc >> 8, wi = pc & 255;
                    *(GAS u32x4*)(blk0 + (size_t)(c & 3) * NUNIT * HG_BLK + (c >> 2 ? HG_OK : HG_OQ) + half * 4096 + wi * 16) = *(const LAS u32x4*)(lds + PRE_OUT + c * 4096 + wi * 16); }
            }
            GAS unsigned char* blk = blk0 + (size_t)hh * NUNIT * HG_BLK;
            const PreOut po{blk, HG_OQ, HG_OK, HG_OKT, HG_ODL, 256, true};
#pragma unroll
            for (int i = 0; i < 4; ++i) *(GAS u32x4*)(blk + HG_OVT + d * 64 + 16 * (i ^ slot_swz(d))) = (u32x4){vv[4 * i], vv[4 * i + 1], vv[4 * i + 2], vv[4 * i + 3]};
            pre_tail(po, d, ph, e1, kta, kt);
        }
    }
    const bool bal = G == 256;
    const int t_lo = bal ? (bx < 64 ? 7 * bx : 448 + 11 * (bx - 64)) : bx;
    const int t_hi = bal ? t_lo + (bx < 64 ? 7 : 11) : NB * NUNIT * 5, t_st = bal ? 1 : G;
    for (int task = t_lo; task < t_hi; task += t_st) {
        asm volatile("" : "+v"(tid));
        const int bu = task / 5, kind = 3 + (task - 5 * bu), b = bu / NUNIT, un = bu % NUNIT;
        const size_t row0 = (size_t)b * SEQ + un * 32;
        if (kind < 5) {
            __syncthreads();
            if (tid < 64) *(LAS u32x4*)(lds + tid * 16) = *(const GAS u32x4*)(P + (row0 + (tid >> 1)) * INP + C_LR + 8 * (tid & 1));
            __syncthreads();
            if (tid < 384) {
                const int ch = (kind - 3) * 384 + tid, h = ch / 192, d = ch % 192, pd = (d & ~31) + 8 * ((d >> 2) & 3) + 4 * ((d >> 4) & 1) + (d & 3);
                GAS unsigned char* blk = a.ws() + WS_GLB + ((size_t)(b * 4 + h) * NUNIT + un) * GL_BLK;
                const PreOut po{blk, GL_OQ, GL_OK, GL_OKT, GL_ODL, 384, false};
                float wg[16];
#pragma unroll
                for (int r = 0; r < 16; ++r) wg[r] = a.in(I_WGATE)[((size_t)l * 16 + r) * GLKW + ch];
                const float bgv = a.in(I_BGATE)[l * GLKW + ch];
                float kta[16]; unsigned kt[16]; float e0 = 1.f, e1 = 1.f, ph = 1.f;
#pragma unroll
                for (int half = 0; half < 2; ++half) {
                    float g[16], qq[16], kk[16];
#pragma unroll
                    for (int j = 0; j < 16; ++j) { const GAS bf16_t* prow = P + (row0 + 16 * half + j) * INP;
                        const u32x4 l0 = *(const LAS u32x4*)(lds + (16 * half + j) * 32), l1 = *(const LAS u32x4*)(lds + (16 * half + j) * 32 + 16);
                        float x = bgv;
                        x += bf_lo(l0.x) * wg[0] + bf_hi(l0.x) * wg[1] + bf_lo(l0.y) * wg[2] + bf_hi(l0.y) * wg[3] + bf_lo(l0.z) * wg[4] + bf_hi(l0.z) * wg[5] + bf_lo(l0.w) * wg[6] + bf_hi(l0.w) * wg[7];
                        x += bf_lo(l1.x) * wg[8] + bf_hi(l1.x) * wg[9] + bf_lo(l1.y) * wg[10] + bf_hi(l1.y) * wg[11] + bf_lo(l1.z) * wg[12] + bf_hi(l1.z) * wg[13] + bf_lo(l1.w) * wg[14] + bf_hi(l1.w) * wg[15];
                        g[j] = __expf((fminf(x, 0.f) - __logf(1.0f + __expf(-fabsf(x)))) * 0.0625f);
                        qq[j] = bf2f(prow[C_QC + ch]) * GLA_QSCALE; kk[j] = bf2f(prow[C_KC + ch]); }
                    if (half == 0) { e0 = pre_half<0>(po, d, pd, 1.0f, g, qq, kk, kta, kt, ph); } else { e1 = pre_half<1>(po, d, pd, e0, g, qq, kk, kta, kt, ph); }
                }
                pre_tail(po, d, ph, e1, kta, kt);
            }
        } else {
            const int ch = (kind - 5) * 512 + tid, h = ch / 384, e = ch % 384;
            GAS unsigned char* blk = a.ws() + WS_GLB + ((size_t)(b * 4 + h) * NUNIT + un) * GL_BLK;
            unsigned vv[16]; unsigned short rv[32];
#pragma unroll
            for (int j = 0; j < 32; ++j) rv[j] = P[(row0 + j) * INP + C_VC + ch];
            asm volatile("" ::: "memory");
#pragma unroll
            for (int j = 0; j < 32; ++j) { const unsigned short v = rv[j];
                const int w = 4 * ((j >> 2) & 3) + 2 * (j >> 4) + ((j & 3) >> 1); if (j & 1) vv[w] |= ((unsigned)v) << 16; else vv[w] = v; }
#pragma unroll
            for (int i = 0; i < 4; ++i) *(GAS u32x4*)(blk + GL_OVT + e * 64 + 16 * (i ^ slot_swz(e))) = (u32x4){vv[4 * i], vv[4 * i + 1], vv[4 * i + 2], vv[4 * i + 3]};
        }
    }
}

template <int DK, int MODE>
__device__ __forceinline__ void chain_unit(const LAS unsigned char* sb, f32x4 (&S)[DK / 16], GAS float* op, int wave, int n, int q) {
    constexpr bool IS_GLA = (DK == 192);
    constexpr int NKS = DK / 32, NMB = DK / 16, ROWB = IS_GLA ? 384 : 256;
    constexpr int OQ = 0, OK = IS_GLA ? GL_OK : HG_OK, OKT = IS_GLA ? GL_OKT : HG_OKT, OVT = IS_GLA ? GL_OVT : HG_OVT, ODL = IS_GLA ? GL_ODL : HG_ODL;
    constexpr int UG = 4, NUG = NMB / UG;
#define CU_FENCE() asm volatile("" ::: "memory")
    bf16x8 ktf[2][UG]; f32x4 dlv[2][UG];
#define CU_LDU(g_, sl_) do { _Pragma("unroll") for (int u_ = 0; u_ < UG; ++u_) { const int mb_ = (g_) * UG + u_; \
        dlv[sl_][u_] = *(const LAS f32x4*)(sb + ODL + (16 * mb_ + 4 * q) * 4); ktf[sl_][u_] = __builtin_bit_cast(bf16x8, *(const LAS u32x4*)(sb + OKT + (16 * mb_ + n) * 64 + 16 * qs)); } } while (0)
#define CU_SBF(ks_) __builtin_bit_cast(bf16x8, (u32x4){cvt_pk_bf16(S[2 * (ks_)][0], S[2 * (ks_)][1]), cvt_pk_bf16(S[2 * (ks_)][2], S[2 * (ks_)][3]), cvt_pk_bf16(S[2 * (ks_) + 1][0], S[2 * (ks_) + 1][1]), cvt_pk_bf16(S[2 * (ks_) + 1][2], S[2 * (ks_) + 1][3])})
    const int qs = q ^ slot_swz(n);
    const bf16x8 vf8 = __builtin_bit_cast(bf16x8, *(const LAS u32x4*)(sb + OVT + (16 * wave + n) * 64 + 16 * qs));
    if (MODE == 1) {
        const f32x4 zero = (f32x4){0.f, 0.f, 0.f, 0.f};
        bf16x8 qf0[NKS], kf0[NKS], qf1[NKS], kf1[NKS];
#pragma unroll
        for (int ks = 0; ks < NKS; ++ks) { const int c0 = 64 * ks + 16 * q, o0 = n * ROWB + (c0 ^ ((IS_GLA ? ((n >> 1) & 7) : n) << 4));
            qf0[ks] = __builtin_bit_cast(bf16x8, *(const LAS u32x4*)(sb + OQ + o0)); kf0[ks] = __builtin_bit_cast(bf16x8, *(const LAS u32x4*)(sb + OK + o0)); }
        if (!IS_GLA) {
#pragma unroll
            for (int ks = 0; ks < NKS; ++ks) { const int c0 = 64 * ks + 16 * q, o1 = (16 + n) * ROWB + (c0 ^ (n << 4));
                qf1[ks] = __builtin_bit_cast(bf16x8, *(const LAS u32x4*)(sb + OQ + o1)); kf1[ks] = __builtin_bit_cast(bf16x8, *(const LAS u32x4*)(sb + OK + o1)); }
        }
        CU_FENCE();
        {
            f32x4 ao = zero, ao1 = zero, ap = zero, ap1 = zero;
#pragma unroll
            for (int ks = 0; ks < NKS; ++ks) { const bf16x8 sbf = CU_SBF(ks);
                if (ks & 1) { ao1 = __builtin_amdgcn_mfma_f32_16x16x32_bf16(qf0[ks], sbf, ao1, 0, 0, 0); ap1 = __builtin_amdgcn_mfma_f32_16x16x32_bf16(kf0[ks], qf0[ks], ap1, 0, 0, 0); }
                else { ao = __builtin_amdgcn_mfma_f32_16x16x32_bf16(qf0[ks], sbf, ao, 0, 0, 0); ap = __builtin_amdgcn_mfma_f32_16x16x32_bf16(kf0[ks], qf0[ks], ap, 0, 0, 0); } }
            if (IS_GLA) {
#pragma unroll
                for (int ks = 0; ks < NKS; ++ks) { const int c0 = 64 * ks + 16 * q, o1 = (16 + n) * ROWB + (c0 ^ (((n >> 1) & 7) << 4));
                    qf1[ks] = __builtin_bit_cast(bf16x8, *(const LAS u32x4*)(sb + OQ + o1)); kf1[ks] = __builtin_bit_cast(bf16x8, *(const LAS u32x4*)(sb + OK + o1)); }
                CU_FENCE();
            }
            ao = ao + ao1; ap = ap + ap1;
#pragma unroll
            for (int r = 0; r < 4; ++r) if (4 * q + r > n) ap[r] = 0.f;
            const bf16x8 pa = __builtin_bit_cast(bf16x8, (u32x4){cvt_pk_bf16(ap[0], ap[1]), cvt_pk_bf16(ap[2], ap[3]), 0u, 0u});
            ao = __builtin_amdgcn_mfma_f32_16x16x32_bf16(pa, vf8, ao, 0, 0, 0);
#pragma unroll
            for (int r = 0; r < 4; ++r) op[(size_t)(4 * q + r) * OW] = ao[r];
        }
        CU_LDU(0, 0);
        CU_FENCE();
        {
            f32x4 ao = zero, ao1 = zero, ap = zero, ap1 = zero, ax = zero, ax1 = zero;
#pragma unroll
            for (int ks = 0; ks < NKS; ++ks) { const bf16x8 sbf = CU_SBF(ks);
                if (ks & 1) { ao1 = __builtin_amdgcn_mfma_f32_16x16x32_bf16(qf1[ks], sbf, ao1, 0, 0, 0); ax1 = __builtin_amdgcn_mfma_f32_16x16x32_bf16(kf0[ks], qf1[ks], ax1, 0, 0, 0); ap1 = __builtin_amdgcn_mfma_f32_16x16x32_bf16(kf1[ks], qf1[ks], ap1, 0, 0, 0); }
                else { ao = __builtin_amdgcn_mfma_f32_16x16x32_bf16(qf1[ks], sbf, ao, 0, 0, 0); ax = __builtin_amdgcn_mfma_f32_16x16x32_bf16(kf0[ks], qf1[ks], ax, 0, 0, 0); ap = __builtin_amdgcn_mfma_f32_16x16x32_bf16(kf1[ks], qf1[ks], ap, 0, 0, 0); } }
            if (NUG > 1) { CU_LDU(1, 1); CU_FENCE(); }
            ao = ao + ao1; ap = ap + ap1; ax = ax + ax1;
#pragma unroll
            for (int r = 0; r < 4; ++r) if (4 * q + r > n) ap[r] = 0.f;
            const bf16x8 pa = __builtin_bit_cast(bf16x8, (u32x4){cvt_pk_bf16(ax[0], ax[1]), cvt_pk_bf16(ax[2], ax[3]), cvt_pk_bf16(ap[0], ap[1]), cvt_pk_bf16(ap[2], ap[3])});
            ao = __builtin_amdgcn_mfma_f32_16x16x32_bf16(pa, vf8, ao, 0, 0, 0);
#pragma unroll
            for (int r = 0; r < 4; ++r) op[(size_t)(16 + 4 * q + r) * OW] = ao[r];
        }
    } else {
        CU_LDU(0, 0);
        if (NUG > 1) CU_LDU(1, 1);
        CU_FENCE();
    }
#pragma unroll
    for (int g = 0; g < NUG; ++g) {
#pragma unroll
        for (int u = 0; u < UG; ++u) { const int mb = g * UG + u; S[mb] = __builtin_amdgcn_mfma_f32_16x16x32_bf16(ktf[g & 1][u], vf8, S[mb] * dlv[g & 1][u], 0, 0, 0); }
        if (g + 2 < NUG) { CU_LDU(g + 2, g & 1); CU_FENCE(); }
    }
#undef CU_FENCE
#undef CU_LDU
#undef CU_SBF
}
constexpr size_t ST_REC = 98304;
constexpr int NSEG_HG = 4, NSEG_GL = 6, NSEG_MAX = 6;
__device__ __forceinline__ int seg_u0(bool gla, int s) { return gla ? (s <= 2 ? 44 * s : 88 + 42 * (s - 2)) : 64 * s; }
__device__ __forceinline__ int seg_nu(bool gla, int s) { return gla ? (s < 2 ? 44 : 42) : 64; }
template <int DK, int MODE>
__device__ __forceinline__ void chain_item(const GAS unsigned char* blk0, int vt_off, GAS float* op0, GAS unsigned char* st, int seg, int nunits, LAS unsigned char* lds, int wave, int lane) {
    asm volatile("" : "+v"(lane), "+s"(wave));
    constexpr bool IS_GLA = (DK == 192);
    constexpr int BLK = IS_GLA ? GL_BLK : HG_BLK, UNITB = IS_GLA ? GL_SHARED + 8192 : HG_BLK, NMB = DK / 16;
    constexpr int SH0 = MODE == 1 ? 0 : (IS_GLA ? GL_OKT : HG_OKT);
    constexpr int SH_PIECES = (MODE == 1 ? (IS_GLA ? GL_SHARED : HG_BLK) : (IS_GLA ? GL_ODL + 768 - GL_OKT : HG_BLK - HG_OKT)) / 16;
    constexpr int T_PIECES = IS_GLA ? 512 : 0, T_LDS = GL_OVT;
    constexpr int PIECES = SH_PIECES + T_PIECES, NP = (PIECES + 511) / 512;
    constexpr int ODL_ = IS_GLA ? GL_ODL : HG_ODL;
    const int tid = wave * 64 + lane, n = lane & 15, q = lane >> 4;
    f32x4 S[NMB]; float dacc = 1.0f;
#pragma unroll
    for (int mb = 0; mb < NMB; ++mb) S[mb] = (f32x4){0.f, 0.f, 0.f, 0.f};
    if (MODE == 1) {
        for (int s = 0; s < seg; ++s) { const GAS unsigned char* rec = st + (size_t)s * 2 * ST_REC + (size_t)(wave * 64 + lane) * 16;
            f32x4 hh[NMB], dd[NMB];
#pragma unroll
            for (int mb = 0; mb < NMB; ++mb) { hh[mb] = *(const GAS f32x4*)(rec + (size_t)mb * 8192); dd[mb] = *(const GAS f32x4*)(st + (size_t)s * 2 * ST_REC + ST_REC + (16 * mb + 4 * q) * 4); }
            asm volatile("" ::: "memory");
#pragma unroll
            for (int mb = 0; mb < NMB; ++mb) S[mb] = S[mb] * dd[mb] + hh[mb]; }
    }
    u32x4 stgA[NP], stgB[NP];
#define CH_SRC(u, p_) (blk0 + (size_t)(u) * BLK + ((p_) < SH_PIECES ? SH0 + (p_) * 16 : vt_off + ((p_) - SH_PIECES) * 16))
#define CH_DST(p_) ((p_) < SH_PIECES ? SH0 + (p_) * 16 : T_LDS + ((p_) - SH_PIECES) * 16)
#define CH_LOAD(stg, u) do { _Pragma("unroll") for (int r_ = 0; r_ < NP; ++r_) { const int p_ = r_ * 512 + tid; const bool ok_ = (NP * 512 == PIECES) || p_ < PIECES; const int pc_ = ok_ ? p_ : 0; stg[r_] = *(const GAS u32x4*)CH_SRC(u, pc_); } } while (0)
#define CH_STORE(stg, buf) do { _Pragma("unroll") for (int r_ = 0; r_ < NP; ++r_) { const int p_ = r_ * 512 + tid; const bool ok_ = (NP * 512 == PIECES) || p_ < PIECES; const int pc_ = ok_ ? p_ : 0; \
        const int d_ = ok_ ? (buf) * UNITB + CH_DST(pc_) : 2 * UNITB + (p_ - PIECES) * 16; *(LAS u32x4*)(lds + d_) = stg[r_]; } } while (0)
#define CH_SYNC() do { asm volatile("s_waitcnt lgkmcnt(0)" ::: "memory"); __builtin_amdgcn_s_barrier(); asm volatile("" ::: "memory"); } while (0)
    CH_LOAD(stgA, 0); CH_STORE(stgA, 0);
    CH_LOAD(stgA, 1);
    CH_SYNC();
    GAS float* op = op0 + 16 * wave + n;
    for (int u = 0; u < nunits; u += 2) {
        if (u + 2 < nunits) CH_LOAD(stgB, u + 2);
        chain_unit<DK, MODE>(lds, S, op + (size_t)(u * 32) * OW, wave, n, q);
        if (MODE == 0 && tid < DK) dacc *= *(const LAS float*)(lds + ODL_ + 4 * tid);
        CH_STORE(stgA, 1);
        CH_SYNC();
        if (u + 3 < nunits) CH_LOAD(stgA, u + 3);
        chain_unit<DK, MODE>(lds + UNITB, S, op + (size_t)(u * 32 + 32) * OW, wave, n, q);
        if (MODE == 0 && tid < DK) dacc *= *(const LAS float*)(lds + UNITB + ODL_ + 4 * tid);
        if (u + 2 < nunits) CH_STORE(stgB, 0);
        CH_SYNC();
    }
    if (MODE == 0) { GAS unsigned char* rec = st + (size_t)seg * 2 * ST_REC + (size_t)(wave * 64 + lane) * 16;
#pragma unroll
        for (int mb = 0; mb < NMB; ++mb) *(GAS f32x4*)(rec + (size_t)mb * 8192) = S[mb];
        if (tid < DK) *(GAS float*)(st + (size_t)seg * 2 * ST_REC + ST_REC + 4 * tid) = dacc; }
#undef CH_SRC
#undef CH_DST
#undef CH_LOAD
#undef CH_STORE
#undef CH_SYNC
}

template <int MODE>
__device__ __forceinline__ void phase_chain(const Ctx& a, int l, LAS unsigned char* lds, int wave, int lane) {
    const int bx = blockIdx.x, G = gridDim.x;
    constexpr int nhg = 24 * (MODE == 0 ? NSEG_HG - 1 : NSEG_HG), nitems = nhg + 24 * (MODE == 0 ? NSEG_GL - 1 : NSEG_GL);
    for (int it = bx; it < nitems; it += G) {
        const bool gla = it >= nhg; const int j = gla ? it - nhg : it, c = j % 24, seg = j / 24, u0 = seg_u0(gla, seg), nu = seg_nu(gla, seg);
        GAS unsigned char* st = a.ws() + WS_ST + (size_t)(gla ? 24 + c : c) * (NSEG_MAX - 1) * 2 * ST_REC;
        if (!gla) { const int b = c / 12, h = c % 12;
            chain_item<128, MODE>(a.ws() + WS_HGB + ((size_t)(b * 12 + h) * NUNIT + u0) * HG_BLK, 0, (GAS float*)(a.ws() + WS_O) + ((size_t)b * SEQ + u0 * 32) * OW + h * 128, st, seg, nu, lds, wave, lane); }
        else { const int b = c / 12, h = (c % 12) / 3, sl = c % 3;
            chain_item<192, MODE>(a.ws() + WS_GLB + ((size_t)(b * 4 + h) * NUNIT + u0) * GL_BLK, GL_OVT + 8192 * sl, (GAS float*)(a.ws() + WS_O) + ((size_t)b * SEQ + u0 * 32) * OW + HGW + h * 384 + sl * 128, st, seg, nu, lds, wave, lane); }
        __syncthreads();
    }
    if (MODE == 0) { for (int it = (G >= nitems + 16) ? bx - nitems : bx; it < 16; it += G) { if (it < 0) continue; s5_scan_item(a, l, it, wave, lane); } }
}
__device__ __forceinline__ float red16(float v) {
    v += __int_as_float(__builtin_amdgcn_mov_dpp(__float_as_int(v), 0xB1, 0xF, 0xF, true)); v += __int_as_float(__builtin_amdgcn_mov_dpp(__float_as_int(v), 0x4E, 0xF, 0xF, true));
    v += __int_as_float(__builtin_amdgcn_mov_dpp(__float_as_int(v), 0x141, 0xF, 0xF, true)); v += __int_as_float(__builtin_amdgcn_mov_dpp(__float_as_int(v), 0x140, 0xF, 0xF, true)); return v; }
__device__ __forceinline__ void phase_finalize(const Ctx& a, int l, int wave, int lane) {
    const GAS bf16_t* P = (const GAS bf16_t*)(a.ws() + WS_P); const GAS float* O = (const GAS float*)(a.ws() + WS_O); GAS bf16_t* MX = (GAS bf16_t*)(a.ws() + WS_MIXED);
    const GAS float* hgg = a.in(I_HGG) + l * HGW; const GAS float* hgb = a.in(I_HGB) + l * HGW; const GAS float* glg = a.in(I_GLG) + l * HGW;
    const int gw = blockIdx.x * 8 + wave, NGW = gridDim.x * 8;
    for (int row = gw; row < MTOK; row += NGW) {
        const GAS float* orow = O + (size_t)row * OW; const GAS bf16_t* prow = P + (size_t)row * INP; GAS bf16_t* mrow = MX + (size_t)row * DM;
#pragma unroll
        for (int it = 0; it < 3; ++it) { const int c = (it * 4 + (lane >> 4)) * 128 + (lane & 15) * 8;
            const f32x4 o0 = *(const GAS f32x4*)(orow + c), o1 = *(const GAS f32x4*)(orow + c + 4); const u32x4 gg = *(const GAS u32x4*)(prow + C_GB + c);
            float v[8] = {sigmoidf_(bf_lo(gg.x)) * o0[0], sigmoidf_(bf_hi(gg.x)) * o0[1], sigmoidf_(bf_lo(gg.y)) * o0[2], sigmoidf_(bf_hi(gg.y)) * o0[3],
                          sigmoidf_(bf_lo(gg.z)) * o1[0], sigmoidf_(bf_hi(gg.z)) * o1[1], sigmoidf_(bf_lo(gg.w)) * o1[2], sigmoidf_(bf_hi(gg.w)) * o1[3]};
            float s = 0.f, ss = 0.f;
#pragma unroll
            for (int i = 0; i < 8; ++i) { s += v[i]; ss += v[i] * v[i]; }
            s = red16(s); ss = red16(ss);
            const float mu = s * (1.0f / 128.0f), rs = 1.0f / sqrtf(fmaxf(ss * (1.0f / 128.0f) - mu * mu, 0.f) + LN_EPS);
            const f32x4 g0 = *(const GAS f32x4*)(hgg + c), g1 = *(const GAS f32x4*)(hgg + c + 4), b0 = *(const GAS f32x4*)(hgb + c), b1 = *(const GAS f32x4*)(hgb + c + 4);
            u32x4 w; w.x = cvt_pk_bf16((v[0] - mu) * rs * g0[0] + b0[0], (v[1] - mu) * rs * g0[1] + b0[1]); w.y = cvt_pk_bf16((v[2] - mu) * rs * g0[2] + b0[2], (v[3] - mu) * rs * g0[3] + b0[3]);
            w.z = cvt_pk_bf16((v[4] - mu) * rs * g1[0] + b1[0], (v[5] - mu) * rs * g1[1] + b1[1]); w.w = cvt_pk_bf16((v[6] - mu) * rs * g1[2] + b1[2], (v[7] - mu) * rs * g1[3] + b1[3]);
            *(GAS u32x4*)(mrow + S5W + c) = w; }
#pragma unroll
        for (int h = 0; h < 4; ++h) { const int c = h * 384 + lane * 8; const bool act = lane < 48;
            f32x4 o0 = (f32x4){0.f, 0.f, 0.f, 0.f}, o1 = o0; u32x4 gg = (u32x4){0u, 0u, 0u, 0u};
            if (act) { o0 = *(const GAS f32x4*)(orow + HGW + c); o1 = *(const GAS f32x4*)(orow + HGW + c + 4); gg = *(const GAS u32x4*)(prow + C_GC + c); }
            const float ss = wave_sum((o0[0] * o0[0] + o0[1] * o0[1]) + (o0[2] * o0[2] + o0[3] * o0[3]) + (o1[0] * o1[0] + o1[1] * o1[1]) + (o1[2] * o1[2] + o1[3] * o1[3]));
            const float rms = 1.0f / sqrtf(ss * (1.0f / 384.0f) + LN_EPS);
            if (act) { const f32x4 g0 = *(const GAS f32x4*)(glg + c), g1 = *(const GAS f32x4*)(glg + c + 4);
                const float z[8] = {bf_lo(gg.x), bf_hi(gg.x), bf_lo(gg.y), bf_hi(gg.y), bf_lo(gg.z), bf_hi(gg.z), bf_lo(gg.w), bf_hi(gg.w)};
                u32x4 w; w.x = cvt_pk_bf16(o0[0] * rms * g0[0] * (z[0] * sigmoidf_(z[0])), o0[1] * rms * g0[1] * (z[1] * sigmoidf_(z[1])));
                w.y = cvt_pk_bf16(o0[2] * rms * g0[2] * (z[2] * sigmoidf_(z[2])), o0[3] * rms * g0[3] * (z[3] * sigmoidf_(z[3])));
                w.z = cvt_pk_bf16(o1[0] * rms * g1[0] * (z[4] * sigmoidf_(z[4])), o1[1] * rms * g1[1] * (z[5] * sigmoidf_(z[5])));
                w.w = cvt_pk_bf16(o1[2] * rms * g1[2] * (z[6] * sigmoidf_(z[6])), o1[3] * rms * g1[3] * (z[7] * sigmoidf_(z[7])));
                *(GAS u32x4*)(mrow + S5W + HGW + c) = w; } }
    }
}

constexpr int PH_PRO = 0, PH_MOD = 1, PH_LN0 = 2, PH_L0 = 3, PH_PER_LAYER = 10, N_PHASES = PH_L0 + DEPTH * PH_PER_LAYER;
constexpr int CW_BAR = 4096;

__global__ void __launch_bounds__(512, 2) hybrid_fwd(Args args) {
    extern __shared__ __attribute__((aligned(16))) unsigned char lds_raw[];
    LAS unsigned char* lds = (LAS unsigned char*)lds_raw;
    const int wave = __builtin_amdgcn_readfirstlane((int)threadIdx.x >> 6);
#define lane lane_id_v()
    volatile LAS unsigned* MISC = (volatile LAS unsigned*)(lds + LDSCTL_OFF);
    Ctx ctx; ctx.t = (volatile LAS unsigned long long*)(lds + LDSCTL_OFF + 64);
    if (wave == 0) { const int ln_ = lane; unsigned long long v = 0ull;
#pragma unroll
        for (int i = 0; i < N_IN; ++i) v = (ln_ == i) ? (unsigned long long)args.in[i] : v;
        v = (ln_ == 30) ? (unsigned long long)args.out : v; v = (ln_ == 31) ? (unsigned long long)args.ws : v;
        if (ln_ < 32) ctx.t[ln_] = v;
        if (ln_ < 16) MISC[ln_] = 0u; }
    __syncthreads();
    const int lo = args.ph_lo, hi = args.ph_hi;
    XcdBarrier bar; bar.bar = (unsigned*)(ctx.ws() + WS_CTL) + CW_BAR; bar.x = 0; bar.st = nullptr; bar.w0 = (wave == 0) ? 1u : 0u;
    if (hi - lo > 1) bar = xcd_barrier_post((unsigned*)(ctx.ws() + WS_CTL) + CW_BAR, MISC + 8, (wave == 0) ? 1u : 0u);
#define IN(k) (lo <= (k) && (k) < hi)
#define OPQ() int ln = lane, wv = wave; asm volatile("" : "+s"(wv))
#define SEAM(k) do { if (IN(k) && IN((k) + 1)) xcd_barrier(bar); } while (0)
#define WSP(T, off) ((GAS T*)(ctx.ws() + (off)))
#define WSG(T, off) ((T*)(ctx.ws() + (off)))

    if (IN(PH_PRO)) { OPQ(); phase_prologue(ctx, lds, wv, ln); }
    SEAM(PH_PRO);
    if (IN(PH_MOD)) { OPQ(); phase_mod(ctx, wv, ln); }
    SEAM(PH_MOD);
    if (IN(PH_LN0)) { OPQ(); phase_h0(ctx.in(I_X), WSP(float, WS_MOD), WSP(bf16_t, WS_H), wv, ln); }
    SEAM(PH_LN0);

    for (int l = 0; l < DEPTH; ++l) {
        const int p0 = PH_L0 + l * PH_PER_LAYER;
        const size_t wto = WS_WT + (size_t)l * WT_LAYER, modo = WS_MOD + (size_t)l * NB * 6 * DM * 4;
        if (IN(p0 + 0)) { pg8::Gemm g{WSG(bf16_t, WS_H), WSG(const bf16_t, wto + WT_IN), MTOK, INP, DM}; pg8::StaticOrder S; S.init(MTOK, INP, (int)gridDim.x, (int)blockIdx.x);
            EpiProj E{WSP(bf16_t, WS_P), WSP(bf16_t, WS_UX)}; pg8::gemm_phase<EpiProj, pg8::StaticOrder, true, true>(lds, g, S, E, wave); }
        SEAM(p0 + 0);
        if (IN(p0 + 1)) {
            { pg8::Gemm g{WSG(bf16_t, WS_UX), WSG(const bf16_t, WS_S5W1 + (size_t)l * S5_W1_LAYER), 64 * 256, 64 * 256, S5K}; S5Order S{(int)gridDim.x, (int)blockIdx.x, 64, 0};
              EpiS5A E{WSP(float, WS_SLOC)}; pg8::gemm_phase<EpiS5A, S5Order, true, true>(lds, g, S, E, wave); }
            { OPQ(); phase_pre(ctx, l, lds, wv, ln); }
            }
        SEAM(p0 + 1);
        if (IN(p0 + 2)) { OPQ(); phase_chain<0>(ctx, l, lds, wv, ln); }
        SEAM(p0 + 2);
        if (IN(p0 + 3)) {
            { pg8::Gemm g{WSG(bf16_t, WS_UX), WSG(const bf16_t, WS_S5T + (size_t)l * S5_T_LAYER), 64 * 256, 64 * 1024, S5K}; S5Order S{(int)gridDim.x, (int)blockIdx.x, 256, 2};
              EpiS5C E{WSP(bf16_t, WS_Z)}; pg8::gemm_phase<EpiS5C, S5Order, true, true>(lds, g, S, E, wave); }
            { OPQ(); phase_chain<1>(ctx, l, lds, wv, ln); }
            }
        SEAM(p0 + 3);
        if (IN(p0 + 4)) { pg8::Gemm g{WSG(bf16_t, WS_Z), WSG(const bf16_t, wto + WT_GLU), MTOK, S5W, S5W}; pg8::StaticOrder S; S.init(MTOK, S5W, (int)gridDim.x, (int)blockIdx.x);
            EpiGlu E{WSP(bf16_t, WS_Z), WSP(bf16_t, WS_MIXED), ctx.in(I_GLUB) + l * S5W}; pg8::gemm_phase<EpiGlu, pg8::StaticOrder, true, true>(lds, g, S, E, wave);
            { OPQ(); phase_finalize(ctx, l, wv, ln); } }
        SEAM(p0 + 4);
        if (IN(p0 + 5)) { pg8::Gemm g{WSG(bf16_t, WS_MIXED), WSG(const bf16_t, wto + WT_OUT), MTOK, DM, DM}; pg8::StaticOrder S; S.init(MTOK, DM, (int)gridDim.x, (int)blockIdx.x);
            EpiDelta E{WSP(bf16_t, WS_DELTA), WSP(float, modo) + 2 * DM};
            pg8::gemm_phase<EpiDelta, pg8::StaticOrder, true, true>(lds, g, S, E, wave); }
        SEAM(p0 + 5);
        if (IN(p0 + 6)) { OPQ(); phase_lnres<true>(l == 0 ? ctx.in(I_X) : ctx.out(), WSP(bf16_t, WS_DELTA), ctx.out(), ctx.in(I_LN1G) + l * DM, ctx.in(I_LN1B) + l * DM, WSP(float, modo), 3, 4, WSP(bf16_t, WS_H), lds, wv, ln); }
        SEAM(p0 + 6);
        if (IN(p0 + 7)) { pg8::Gemm g{WSG(bf16_t, WS_H), WSG(const bf16_t, wto + WT_GU), MTOK, 2 * DFF, DM}; pg8::StaticOrder S; S.init(MTOK, 2 * DFF, (int)gridDim.x, (int)blockIdx.x);
            EpiSwiglu E{WSP(bf16_t, WS_P)}; pg8::gemm_phase<EpiSwiglu, pg8::StaticOrder, true, true>(lds, g, S, E, wave); }
        SEAM(p0 + 7);
        if (IN(p0 + 8)) { pg8::Gemm g{WSG(bf16_t, WS_P), WSG(const bf16_t, wto + WT_DN), MTOK, DM, DFF}; pg8::StaticOrder S; S.init(MTOK, DM, (int)gridDim.x, (int)blockIdx.x);
            EpiDelta E{WSP(bf16_t, WS_DELTA), WSP(float, modo) + 5 * DM};
            pg8::gemm_phase<EpiDelta, pg8::StaticOrder, true, true>(lds, g, S, E, wave); }
        SEAM(p0 + 8);
        if (IN(p0 + 9)) { OPQ();
            if (l + 1 < DEPTH) phase_lnres<true>(ctx.out(), WSP(bf16_t, WS_DELTA), ctx.out(), ctx.in(I_LN2G) + l * DM, ctx.in(I_LN2B) + l * DM, WSP(float, modo) + (size_t)NB * 6 * DM, 0, 1, WSP(bf16_t, WS_H), lds, wv, ln);
            else phase_lnres<false>(ctx.out(), WSP(bf16_t, WS_DELTA), ctx.out(), ctx.in(I_LN2G) + l * DM, ctx.in(I_LN2B) + l * DM, nullptr, 0, 0, nullptr, lds, wv, ln);
        }
        SEAM(p0 + 9);
    }
#undef IN
#undef SEAM
#undef OPQ
#undef WSP
#undef WSG
#undef lane
}

extern "C" void kernel_launch(void* const* d_in, const int* in_sizes, int n_in, void* d_out, int out_size, void* d_ws, size_t ws_size, hipStream_t stream) {
    static int grid = 0;
    if (grid == 0) {
        if (n_in != N_IN || out_size != MTOK * DM || ws_size < WS_END) { fprintf(stderr, "kernel_launch: unexpected problem (n_in %d, out %d, ws %zu < %zu); nothing launched\n", n_in, out_size, ws_size, (size_t)WS_END); grid = -1; return; }
        int dev = 0, cus = 0, per_cu = 0;
        if (hipGetDevice(&dev) != hipSuccess || hipDeviceGetAttribute(&cus, hipDeviceAttributeMultiprocessorCount, dev) != hipSuccess) { grid = -1; return; }
        if (hipFuncSetAttribute((const void*)hybrid_fwd, hipFuncAttributeMaxDynamicSharedMemorySize, LDS_BYTES) != hipSuccess) { fprintf(stderr, "kernel_launch: hipFuncSetAttribute failed\n"); grid = -1; return; }
        if (hipOccupancyMaxActiveBlocksPerMultiprocessor(&per_cu, (const void*)hybrid_fwd, 512, LDS_BYTES) != hipSuccess || per_cu < 1) fprintf(stderr, "kernel_launch: occupancy query reports %d blocks per CU\n", per_cu);
        (void)hipGetLastError();
        grid = cus;
    }
    if (grid < 0) return;
    (void)in_sizes;
    if (hipMemsetAsync((char*)d_ws + WS_CTL, 0, CTL_ZERO_BYTES, stream) != hipSuccess) return;
    Args a{};
    for (int i = 0; i < N_IN; ++i) a.in[i] = (const float*)d_in[i];
    a.out = (float*)d_out; a.ws = (unsigned char*)d_ws;
    a.ph_lo = 0; a.ph_hi = N_PHASES; hipLaunchKernelGGL(hybrid_fwd, dim3(grid), dim3(512), LDS_BYTES, stream, a);
}
```

```cpp
#include <hip/hip_runtime.h>
#include <cstdio>
#include <cstdint>
namespace pg8 {
#define PG8_LAS __attribute__((address_space(3)))
typedef unsigned short bf16_t;
typedef short bf16x8 __attribute__((ext_vector_type(8)));
typedef float f32x4 __attribute__((ext_vector_type(4)));
typedef unsigned u32x4 __attribute__((ext_vector_type(4)));
constexpr int BM = 256, BK = 64, HALF = 128, HTB = HALF * BK * 2  , STAGE_BYTES = 8 * HTB, NXCD = 8, WGM = 8;

__host__ __device__ __forceinline__ int lds_byte(int r, int c) { const int st = (r >> 4) * 2 + (c >> 5), rr = r & 15, cc = c & 31, ob = rr * 64 + cc * 2; return st * 1024 + (ob ^ (((ob >> 9) & 1) << 5)); }
__host__ __device__ __forceinline__ void stage_rc(int b, int& R, int& C) { const int st = b / 1024, sb = b % 1024, swz = sb ^ (((sb >> 9) & 1) << 5); R = (st >> 1) * 16 + swz / 64; C = (st & 1) * 32 + (swz % 64) / 2; }
__host__ __device__ __forceinline__ int perm32(int rho) { const int n = rho >> 4, i = rho & 15; return 8 * (i >> 2) + 4 * n + (i & 3); }

struct Unit { int pm, pn; };
struct Gemm { const bf16_t* A; const bf16_t* Bt; int M, N, K; };

struct StaticOrder {
    int nM, nN, nwg, G, c;
    __host__ __device__ void init(int M, int N, int G_, int c_) { nM = M / BM; nN = N / BM; nwg = nM * nN; G = G_; c = c_; }
    __host__ __device__ bool next(int i, Unit& u) const {
        const long L = (long)i * G + c; if (L >= nwg) return false;
        int wgid = (int)L; { const int q = nwg / NXCD, r = nwg % NXCD, xcd = wgid % NXCD, off = wgid / NXCD; wgid = (xcd < r ? xcd * (q + 1) : r * (q + 1) + (xcd - r) * q) + off; }
        const int nig = WGM * nN, gid = wgid / nig, fm = gid * WGM, gsz = (nM - fm) < WGM ? (nM - fm) : WGM;
        u.pm = fm + ((wgid % nig) % gsz); u.pn = (wgid % nig) / gsz; return true;
    }
    __device__ __forceinline__ void a_ready(const Unit&) const {}
    __device__ __forceinline__ void done(const Unit&) const {}
};
__device__ __forceinline__ unsigned cvt_pk_bf16(float lo, float hi) { unsigned r; asm volatile("v_cvt_pk_bf16_f32 %0, %1, %2" : "=v"(r) : "v"(lo), "v"(hi)); return r; }
typedef float f32x2 __attribute__((ext_vector_type(2)));
template <class Epi, class Sched, bool ALIGN_EPI = false, bool SP2 = false>
__device__ __forceinline__ void gemm_phase(PG8_LAS unsigned char* lds, const Gemm g, const Sched& S, const Epi& E, int wave_id) {
    int tid_; asm volatile("v_mbcnt_lo_u32_b32 %0, -1, 0\n\tv_mbcnt_hi_u32_b32 %0, -1, %0" : "=v"(tid_)); tid_ += wave_id * 64;
    const int tid = tid_, wid = __builtin_amdgcn_readfirstlane(tid >> 6), lane = tid & 63, wr = wid >> 2, wc = wid & 3, fr = lane & 15, fq = lane >> 4;
    const int K = g.K, nt = K / BK;
    unsigned voffA[2], voffB[2];
#pragma unroll
    for (int i = 0; i < 2; ++i) { int R, C; stage_rc(tid * 16 + i * 8192, R, C); const int Rb = Epi::PERM ? ((R & ~31) + perm32(R & 31)) : R;
        voffA[i] = (unsigned)(R * K + C) * 2u; voffB[i] = (unsigned)(Rb * K + C) * 2u; }
    const size_t kstep = (size_t)(BK * 2);
    const size_t hstep = (size_t)HALF * K * 2;
    const size_t tstep = 2 * hstep;
    const unsigned ldsw = (unsigned)wid * 1024u;
    const int aoff = lds_byte(wr * 64 + fr, fq * 8), boff = lds_byte(wc * 32 + fr, fq * 8);
#define PG8_SA(b, h) (((b) * 2 + (h)) * HTB)
#define PG8_SB(b, h) ((4 + (b) * 2 + (h)) * HTB)
#define PG8_STAGE(bufoff, gbase, voff) do { _Pragma("unroll") for (int _i = 0; _i < 2; ++_i) \
        __builtin_amdgcn_global_load_lds((const unsigned*)((const char*)(gbase) + (voff)[_i]), (PG8_LAS unsigned*)(lds + (bufoff) + ldsw + _i * 8192), 16, 0, 0); } while (0)
#define PG8_LDA(dst, b, h) do { _Pragma("unroll") for (int m = 0; m < 4; ++m) _Pragma("unroll") for (int k = 0; k < 2; ++k) dst[m][k] = *(const PG8_LAS bf16x8*)(lds + PG8_SA(b, h) + aoff + m * 2048 + k * 1024); } while (0)
#define PG8_LDB(dst, b, h) do { _Pragma("unroll") for (int n = 0; n < 2; ++n) _Pragma("unroll") for (int k = 0; k < 2; ++k) dst[n][k] = *(const PG8_LAS bf16x8*)(lds + PG8_SB(b, h) + boff + n * 2048 + k * 1024); } while (0)
#define PG8_MMA(ai, bj, At, Bt) do { __builtin_amdgcn_s_setprio(1); _Pragma("unroll") for (int m = 0; m < 4; ++m) _Pragma("unroll") for (int n = 0; n < 2; ++n) _Pragma("unroll") for (int k = 0; k < 2; ++k) \
        acc[ai][bj][m][n] = __builtin_amdgcn_mfma_f32_16x16x32_bf16(Bt[n][k], At[m][k], acc[ai][bj][m][n], 0, 0, 0); __builtin_amdgcn_s_setprio(0); } while (0)
#define PG8_WAIT_V(n) asm volatile("s_waitcnt vmcnt(" #n ")" ::: "memory")
#define PG8_WAIT_L(n) asm volatile("s_waitcnt lgkmcnt(" #n ")" ::: "memory")
#define PG8_BAR __builtin_amdgcn_s_barrier()
#define PG8_SCHED __builtin_amdgcn_sched_barrier(0)
    Unit cur, nxt; int ui = 0;
    if (!S.next(0, cur)) return;
    f32x4 acc[2][2][4][2];
#pragma unroll
    for (int a = 0; a < 2; ++a)
#pragma unroll
        for (int b = 0; b < 2; ++b)
#pragma unroll
            for (int m = 0; m < 4; ++m)
#pragma unroll
                for (int n = 0; n < 2; ++n) acc[a][b][m][n] = (f32x4){0.f, 0.f, 0.f, 0.f};
    bf16x8 At[4][2], B0[2][2], B1[2][2];
    const char* cA = (const char*)g.A + (size_t)cur.pm * tstep; const char* cB = (const char*)g.Bt + (size_t)cur.pn * tstep;
    S.a_ready(cur);
    if constexpr (SP2) {
        PG8_STAGE(PG8_SB(0, 0), cB, voffB); PG8_STAGE(PG8_SB(0, 1), cB + hstep, voffB); PG8_STAGE(PG8_SA(0, 0), cA, voffA); PG8_STAGE(PG8_SA(0, 1), cA + hstep, voffA);
        if (wr == 1) PG8_BAR;
        PG8_WAIT_V(2); PG8_BAR;
        PG8_STAGE(PG8_SB(1, 0), cB + kstep, voffB); PG8_STAGE(PG8_SA(1, 0), cA + kstep, voffA); PG8_STAGE(PG8_SB(1, 1), cB + hstep + kstep, voffB);
        PG8_WAIT_V(6); PG8_BAR;
    } else {
        PG8_STAGE(PG8_SB(0, 0), cB, voffB); PG8_STAGE(PG8_SA(0, 0), cA, voffA); PG8_STAGE(PG8_SB(0, 1), cB + hstep, voffB); PG8_STAGE(PG8_SA(0, 1), cA + hstep, voffA);
        if (wr == 1) PG8_BAR;
        PG8_WAIT_V(4); PG8_BAR;
        PG8_STAGE(PG8_SB(1, 0), cB + kstep, voffB); PG8_STAGE(PG8_SA(1, 0), cA + kstep, voffA); PG8_STAGE(PG8_SB(1, 1), cB + hstep + kstep, voffB);
        PG8_WAIT_V(6); PG8_BAR;
    }
    for (;;) {
        const bool has_next = S.next(ui + 1, nxt);
        const char* nA = has_next ? (const char*)g.A + (size_t)nxt.pm * tstep : cA; const char* nB = has_next ? (const char*)g.Bt + (size_t)nxt.pn * tstep : cB;
        for (int t = 0; t < nt; t += 2) {
            const bool last = (t == nt - 2);
            const char* a1 = cA + (size_t)(t + 1) * kstep;
            const char* a2 = last ? nA : cA + (size_t)(t + 2) * kstep; const char* b2 = last ? nB : cB + (size_t)(t + 2) * kstep;
            const char* a3 = a2 + kstep; const char* b3 = b2 + kstep;
            if (last && has_next) S.a_ready(nxt);
            if constexpr (SP2) {
            PG8_LDB(B0, 0, 0); PG8_LDB(B1, 0, 1); PG8_SCHED; PG8_LDA(At, 0, 0); PG8_STAGE(PG8_SA(1, 1), a1 + hstep, voffA);
            PG8_WAIT_V(8); PG8_WAIT_L(0); PG8_BAR; PG8_MMA(0, 0, At, B0); PG8_MMA(0, 1, At, B1); PG8_BAR; PG8_SCHED;
            PG8_LDA(At, 0, 1); PG8_STAGE(PG8_SB(0, 0), b2, voffB); PG8_STAGE(PG8_SB(0, 1), b2 + hstep, voffB); PG8_STAGE(PG8_SA(0, 0), a2, voffA);
            PG8_WAIT_V(8); PG8_WAIT_L(0); PG8_BAR; PG8_MMA(1, 0, At, B0); PG8_MMA(1, 1, At, B1); PG8_BAR; PG8_SCHED;
            PG8_LDB(B0, 1, 0); PG8_LDB(B1, 1, 1); PG8_SCHED; PG8_LDA(At, 1, 0); PG8_STAGE(PG8_SA(0, 1), a2 + hstep, voffA);
            PG8_WAIT_V(8); PG8_WAIT_L(0); PG8_BAR; PG8_MMA(0, 0, At, B0); PG8_MMA(0, 1, At, B1); PG8_BAR; PG8_SCHED;
            PG8_LDA(At, 1, 1); PG8_STAGE(PG8_SB(1, 0), b3, voffB); PG8_STAGE(PG8_SB(1, 1), b3 + hstep, voffB); PG8_STAGE(PG8_SA(1, 0), a3, voffA);
            PG8_WAIT_V(8); PG8_WAIT_L(0); PG8_BAR; PG8_MMA(1, 0, At, B0); PG8_MMA(1, 1, At, B1); PG8_BAR; PG8_SCHED;
            } else {
            PG8_LDB(B0, 0, 0); PG8_SCHED; PG8_LDA(At, 0, 0); PG8_STAGE(PG8_SA(1, 1), a1 + hstep, voffA);
            PG8_WAIT_L(8); PG8_BAR; PG8_WAIT_L(0); PG8_MMA(0, 0, At, B0); PG8_BAR; PG8_SCHED;
            PG8_LDB(B1, 0, 1); PG8_STAGE(PG8_SB(0, 0), b2, voffB);
            PG8_BAR; PG8_WAIT_L(0); PG8_MMA(0, 1, At, B1); PG8_BAR;
            PG8_LDA(At, 0, 1); PG8_STAGE(PG8_SA(0, 0), a2, voffA);
            PG8_BAR; PG8_WAIT_L(0); PG8_MMA(1, 0, At, B0); PG8_BAR; PG8_SCHED;
            PG8_STAGE(PG8_SB(0, 1), b2 + hstep, voffB);
            PG8_WAIT_V(6); PG8_BAR; PG8_MMA(1, 1, At, B1); PG8_BAR;
            PG8_LDB(B0, 1, 0); PG8_SCHED; PG8_LDA(At, 1, 0); PG8_STAGE(PG8_SA(0, 1), a2 + hstep, voffA);
            PG8_WAIT_L(8); PG8_BAR; PG8_WAIT_L(0); PG8_MMA(0, 0, At, B0); PG8_BAR; PG8_SCHED;
            PG8_LDB(B1, 1, 1); PG8_STAGE(PG8_SB(1, 0), b3, voffB);
            PG8_BAR; PG8_WAIT_L(0); PG8_MMA(0, 1, At, B1); PG8_BAR;
            PG8_LDA(At, 1, 1); PG8_STAGE(PG8_SA(1, 0), a3, voffA);
            PG8_BAR; PG8_WAIT_L(0); PG8_MMA(1, 0, At, B0); PG8_BAR; PG8_SCHED;
            PG8_STAGE(PG8_SB(1, 1), b3 + hstep, voffB);
            PG8_WAIT_V(6); PG8_BAR; PG8_MMA(1, 1, At, B1); PG8_BAR;
            }
        }
        if constexpr (ALIGN_EPI) { if (wr == 0) PG8_BAR; }
        if constexpr (!Epi::AFTER_DRAIN) { E(acc, cur, wr, wc, fr, fq); S.done(cur); }
        if (!has_next) break;
#pragma unroll
        for (int a = 0; a < 2; ++a)
#pragma unroll
            for (int b = 0; b < 2; ++b)
#pragma unroll
                for (int m = 0; m < 4; ++m)
#pragma unroll
                    for (int n = 0; n < 2; ++n) acc[a][b][m][n] = (f32x4){0.f, 0.f, 0.f, 0.f};
        cur = nxt; cA = nA; cB = nB; ++ui;
        if constexpr (ALIGN_EPI) { if (wr == 1) PG8_BAR; }
    }
    PG8_WAIT_V(0);
    if constexpr (!ALIGN_EPI) { if (wr == 0) PG8_BAR; }
    PG8_BAR;
    if constexpr (Epi::AFTER_DRAIN) { E.fused(acc, cur, wr, wc, fr, fq, lds, wid, lane); S.done(cur); }
#undef PG8_SA
#undef PG8_SB
#undef PG8_STAGE
#undef PG8_LDA
#undef PG8_LDB
#undef PG8_MMA
#undef PG8_WAIT_V
#undef PG8_WAIT_L
#undef PG8_BAR
#undef PG8_SCHED
}
}
#define LAS __attribute__((address_space(3)))
#define XB_TMO      128
#define XB_XCNT(j)  (256  + 64 * (j))
#define XB_XSUB(j)  (1280 + 64 * (j))
#define XB_XGEN(j)  (2304 + 64 * (j))
#define XB_TOP      3328
#define XB_TOPGEN   3392
#define XCD_BAR_WORDS 3456
#define XB_SPIN_CAP (1u << 24)

__device__ __forceinline__ unsigned xb_ld(unsigned* p)              { return __hip_atomic_load(p, __ATOMIC_RELAXED, __HIP_MEMORY_SCOPE_AGENT); }
__device__ __forceinline__ unsigned xb_add(unsigned* p, unsigned v) { return __hip_atomic_fetch_add(p, v, __ATOMIC_RELAXED, __HIP_MEMORY_SCOPE_AGENT); }
__device__ __forceinline__ unsigned xb_xcc_id() { return (unsigned)__builtin_amdgcn_s_getreg((3 << 11) | 20) & 0xFu; }
#define XB_SPIN(cond, bar) do { unsigned _sp = 0; while (cond) { __builtin_amdgcn_s_sleep(1); \
    if ((++_sp & 255u) == 0u) { if (xb_ld(&(bar)[XB_TMO])) break; if (_sp > XB_SPIN_CAP) { atomicAdd(&(bar)[XB_TMO], 1u); break; } } } } while (0)

struct XcdBarrier {
    unsigned* bar; unsigned x; unsigned w0;
    volatile LAS unsigned* st;
};

__device__ __forceinline__ bool xb_lane0() { unsigned r; asm volatile("v_mbcnt_lo_u32_b32 %0, -1, 0\n\tv_mbcnt_hi_u32_b32 %0, -1, %0" : "=v"(r)); return r == 0u; }
__device__ __forceinline__ XcdBarrier xcd_barrier_post(unsigned* bar, volatile LAS unsigned* st, unsigned w0) {
    XcdBarrier b; b.bar = bar; b.x = xb_xcc_id(); b.st = st; b.w0 = w0;
    if (w0 && xb_lane0()) (void)xb_add(&bar[XB_XCNT(b.x)], 1u);
    return b;
}
__device__ __forceinline__ void xcd_barrier_complete(unsigned* bar, unsigned x, unsigned& nloc, unsigned& nx) {
    const unsigned G = gridDim.x * gridDim.y * gridDim.z;
    unsigned sum, cnt, mine, sp = 0u;
    for (;;) {
        sum = 0u; cnt = 0u; mine = 0u;
#pragma unroll
        for (unsigned j = 0; j < 16; ++j) { const unsigned c = xb_ld(&bar[XB_XCNT(j)]); sum += c; cnt += (c > 0u) ? 1u : 0u; mine = (j == x) ? c : mine; }
        if (sum == G) break;
        __builtin_amdgcn_s_sleep(1);
        if ((++sp & 255u) == 0u) { if (xb_ld(&bar[XB_TMO])) break; if (sp > XB_SPIN_CAP) { atomicAdd(&bar[XB_TMO], 1u); break; } }
    }
    nloc = mine > 0u ? mine : 1u; nx = cnt > 0u ? cnt : 1u;
}

__device__ __forceinline__ void xcd_barrier(const XcdBarrier& b) {
    asm volatile("s_waitcnt vmcnt(0)" ::: "memory");
    __syncthreads();
    if (b.w0 && xb_lane0()) {
        unsigned* bar = b.bar;
        __builtin_amdgcn_s_waitcnt(0);
        unsigned nloc = b.st[0], nx = b.st[1];
        if (nloc == 0u) { xcd_barrier_complete(bar, b.x, nloc, nx); b.st[0] = nloc; b.st[1] = nx; }
        const unsigned old = xb_add(&bar[XB_XSUB(b.x)], 1u);
        const unsigned gen = old / nloc;
        if (old + 1u == (gen + 1u) * nloc) {
            __builtin_amdgcn_fence(__ATOMIC_RELEASE, "agent");
            asm volatile("s_waitcnt vmcnt(0)" ::: "memory");
            const unsigned og = xb_add(&bar[XB_TOP], 1u);
            const unsigned tg = og / nx;
            if (og + 1u == (tg + 1u) * nx) xb_add(&bar[XB_TOPGEN], 1u);
            else XB_SPIN(xb_ld(&bar[XB_TOPGEN]) == tg, bar);
            __builtin_amdgcn_fence(__ATOMIC_ACQUIRE, "agent");
            xb_add(&bar[XB_XGEN(b.x)], 1u);
            asm volatile("s_waitcnt vmcnt(0)" ::: "memory");
        } else {
            XB_SPIN(xb_ld(&bar[XB_XGEN(b.x)]) == gen, bar);
            __builtin_amdgcn_fence(__ATOMIC_ACQUIRE, "agent");
            asm volatile("s_waitcnt vmcnt(0)" ::: "memory");
        }
    }
    __syncthreads();
}

constexpr int DM = 4096, NB = 2, SEQ = 8192, MTOK = NB * SEQ, DEPTH = 4;
constexpr int S5W = 1024;
constexpr int HGW = 1536;
constexpr int GLKW = 768;
constexpr int INW = 11792, INP = 12032, DFF = 11008;
constexpr int OW = 3072;
constexpr int C_U = 0, C_QB = 1024, C_FB = 2560, C_IB = 4096, C_GB = 5632, C_QC = 7168, C_KC = 7936, C_VC = 8704, C_GC = 10240, C_LR = 11776;
constexpr float LN_EPS = 1e-5f;
constexpr float ALPHA = 1.6817928305074290861f;
constexpr float GLA_QSCALE = 0.07216878364870322f;

enum { I_X = 0, I_C, I_WADA, I_BADA, I_TABLE, I_WIN, I_WOUT, I_AREAL, I_AIMAG, I_LOGDT, I_BRE, I_BIM, I_CRE, I_CIM, I_S5D, I_GLUW, I_GLUB,
       I_LBRAW, I_HGG, I_HGB, I_WGATE, I_BGATE, I_GLG, I_WFG, I_WFU, I_WFD, I_LN1G, I_LN1B, I_LN2G, I_LN2B, N_IN };

constexpr size_t MiB = 1u << 20;
constexpr size_t WS_CTL = 0, CTL_ZERO_BYTES = 1 * MiB;
constexpr size_t WS_MOD = 1 * MiB;
constexpr size_t WS_MISC = 2 * MiB;
constexpr size_t WS_CONDPART = 12 * MiB;
constexpr size_t WS_H = 24 * MiB;
constexpr size_t WS_MIXED = WS_H + 128 * MiB;
constexpr size_t WS_Z = WS_MIXED + 128 * MiB;
constexpr size_t WS_O = WS_Z + 32 * MiB;
constexpr size_t WS_DELTA = WS_O;
constexpr size_t WS_P = WS_O + 192 * MiB;
constexpr size_t WS_WT = WS_P + 376 * MiB;
constexpr size_t WT_IN = 0, WT_OUT = 94 * MiB, WT_GU = 126 * MiB, WT_DN = 298 * MiB, WT_GLU = 384 * MiB, WT_LAYER = 386 * MiB;
constexpr size_t WS_HGB = WS_WT + DEPTH * WT_LAYER;
constexpr size_t WS_GLB = WS_HGB + 198 * MiB;
constexpr size_t WS_S5T = WS_GLB + 128 * MiB;
constexpr size_t WS_S5W1 = WS_S5T + 576 * MiB;
constexpr size_t WS_UX = WS_S5W1 + 144 * MiB;
constexpr size_t WS_SLOC = WS_UX + 36 * MiB;
constexpr size_t WS_LAM64 = WS_SLOC + 8 * MiB;
constexpr size_t WS_ST = WS_LAM64 + 1 * MiB;
constexpr size_t WS_XL = WS_ST + 45 * MiB;
constexpr size_t WS_END = WS_XL + 64 * MiB;
static_assert(DEPTH >= 2, "the last layer's residual halves reuse layer 0's weight region");
static_assert((size_t)INP * DM * 2 == 94 * MiB && (size_t)DM * DM * 2 == 32 * MiB && (size_t)2 * DFF * DM * 2 == 172 * MiB && (size_t)DM * DFF * 2 == 86 * MiB, "weight map");
static_assert((size_t)MTOK * INP * 2 == 376 * MiB && (size_t)MTOK * DFF * 2 <= 376 * MiB, "activation map");

constexpr int RING_BYTES = 131072;
constexpr int LDSCTL_OFF = 135168;
constexpr int LDS_BYTES = 147456;

#ifndef LAS
#define LAS __attribute__((address_space(3)))
#endif
#define GAS __attribute__((address_space(1)))
typedef unsigned short bf16_t;
typedef float f32x4 __attribute__((ext_vector_type(4)));
typedef float f32x2 __attribute__((ext_vector_type(2)));
typedef unsigned u32x4 __attribute__((ext_vector_type(4)));
typedef unsigned u32x2 __attribute__((ext_vector_type(2)));
#define LDS_WAIT() asm volatile("s_waitcnt lgkmcnt(0)" ::: "memory")
#define VM_WAIT() asm volatile("s_waitcnt vmcnt(0)" ::: "memory")
typedef __bf16 bf16x2_t __attribute__((ext_vector_type(2)));
__device__ __forceinline__ unsigned cvt_pk_bf16(float lo, float hi) { return __builtin_bit_cast(unsigned, __builtin_convertvector((f32x2){lo, hi}, bf16x2_t)); }

__device__ __forceinline__ float bf_lo(unsigned w) { return __uint_as_float(w << 16); }
__device__ __forceinline__ float bf_hi(unsigned w) { return __uint_as_float(w & 0xffff0000u); }
__device__ __forceinline__ float bf2f(bf16_t b) { return __uint_as_float(((unsigned)b) << 16); }
__device__ __forceinline__ float wave_sum(float v) {
    v += __int_as_float(__builtin_amdgcn_mov_dpp(__float_as_int(v), 0xB1, 0xF, 0xF, true));
    v += __int_as_float(__builtin_amdgcn_mov_dpp(__float_as_int(v), 0x4E, 0xF, 0xF, true));
    v += __int_as_float(__builtin_amdgcn_mov_dpp(__float_as_int(v), 0x141, 0xF, 0xF, true));
    v += __int_as_float(__builtin_amdgcn_mov_dpp(__float_as_int(v), 0x140, 0xF, 0xF, true));
    const int b = __float_as_int(v);
    return (__int_as_float(__builtin_amdgcn_readlane(b, 0)) + __int_as_float(__builtin_amdgcn_readlane(b, 16))) + (__int_as_float(__builtin_amdgcn_readlane(b, 32)) + __int_as_float(__builtin_amdgcn_readlane(b, 48)));
}
__device__ __forceinline__ float sigmoidf_(float x) { return __builtin_amdgcn_rcpf(1.0f + __expf(-x)); }
__device__ __forceinline__ float gelu_tanh(float y) { const float a = 0.7978845608028654f * (y + 0.044715f * y * y * y); const float t = 1.0f - 2.0f * __builtin_amdgcn_rcpf(1.0f + __expf(2.0f * a)); return 0.5f * y * (1.0f + t); }

struct EpiProj {
    static constexpr bool PERM = true, AFTER_DRAIN = false;
    GAS bf16_t* P; GAS bf16_t* UX;
    __device__ __forceinline__ void operator()(const f32x4 (&acc)[2][2][4][2], const pg8::Unit& u, int wr, int wc, int fr, int fq) const {
        const int row0 = u.pm * 256 + wr * 64 + fr, col0 = u.pn * 256 + wc * 32 + 8 * fq;
        const bool s5 = u.pn < 4;
#pragma unroll
        for (int ai = 0; ai < 2; ++ai)
#pragma unroll
            for (int m = 0; m < 4; ++m) { const int row = row0 + ai * 128 + m * 16;
#pragma unroll
                for (int bj = 0; bj < 2; ++bj) { const f32x4 v0 = acc[ai][bj][m][0], v1 = acc[ai][bj][m][1]; const int col = col0 + bj * 128;
                    u32x4 w; w.x = cvt_pk_bf16(v0[0], v0[1]); w.y = cvt_pk_bf16(v0[2], v0[3]); w.z = cvt_pk_bf16(v1[0], v1[1]); w.w = cvt_pk_bf16(v1[2], v1[3]);
                    if (!s5) *(GAS u32x4*)(P + (size_t)row * INP + col) = w;
                    else { GAS bf16_t* ur = UX + (size_t)((col >> 4) * 256 + (row >> 6)) * 1152; *(GAS u32x4*)(ur + (row & 63) * 16 + (col & 15)) = w;
                        if ((row & 63) == 0) { const u32x4 z = (u32x4){0u, 0u, 0u, 0u}; GAS bf16_t* zp = ur + 1024 + ((col & 15) ? 64 : 0);
#pragma unroll
                            for (int i = 0; i < 8; ++i) *(GAS u32x4*)(zp + 8 * i) = z; } } } }
    }
};
struct EpiSwiglu {
    static constexpr bool PERM = true, AFTER_DRAIN = false;
    GAS bf16_t* HID;
    __device__ __forceinline__ void operator()(const f32x4 (&acc)[2][2][4][2], const pg8::Unit& u, int wr, int wc, int fr, int fq) const {
        const int row0 = u.pm * 256 + wr * 64 + fr, col0 = u.pn * 128 + wc * 32 + 8 * fq;
#pragma unroll
        for (int ai = 0; ai < 2; ++ai)
#pragma unroll
            for (int m = 0; m < 4; ++m) { GAS bf16_t* rowp = HID + (size_t)(row0 + ai * 128 + m * 16) * DFF + col0;
                float o[8];
#pragma unroll
                for (int n = 0; n < 2; ++n)
#pragma unroll
                    for (int j = 0; j < 4; ++j) { const float g = acc[ai][0][m][n][j], up = acc[ai][1][m][n][j]; o[n * 4 + j] = g * __builtin_amdgcn_rcpf(1.0f + __expf(-g)) * up; }
                u32x4 w; w.x = cvt_pk_bf16(o[0], o[1]); w.y = cvt_pk_bf16(o[2], o[3]); w.z = cvt_pk_bf16(o[4], o[5]); w.w = cvt_pk_bf16(o[6], o[7]);
                *(GAS u32x4*)rowp = w; }
    }
};
struct EpiGlu {
    static constexpr bool PERM = true, AFTER_DRAIN = false;
    const GAS bf16_t* Z; GAS bf16_t* MIXED; const GAS float* bias;
    __device__ __forceinline__ void operator()(const f32x4 (&acc)[2][2][4][2], const pg8::Unit& u, int wr, int wc, int fr, int fq) const {
        const int row0 = u.pm * 256 + wr * 64 + fr, col0 = u.pn * 256 + wc * 32 + 8 * fq;
#pragma unroll
        for (int bj = 0; bj < 2; ++bj) {
            const f32x4 b0 = *(const GAS f32x4*)(bias + col0 + bj * 128), b1 = *(const GAS f32x4*)(bias + col0 + bj * 128 + 4);
            u32x4 zq[2][4];
#pragma unroll
            for (int ai = 0; ai < 2; ++ai)
#pragma unroll
                for (int m = 0; m < 4; ++m) zq[ai][m] = *(const GAS u32x4*)(Z + (size_t)(row0 + ai * 128 + m * 16) * S5W + col0 + bj * 128);
            asm volatile("" ::: "memory");
#pragma unroll
            for (int ai = 0; ai < 2; ++ai)
#pragma unroll
                for (int m = 0; m < 4; ++m) { const size_t r = (size_t)(row0 + ai * 128 + m * 16);
                    const u32x4 zz = zq[ai][m];
                    const f32x4 v0 = acc[ai][bj][m][0] + b0, v1 = acc[ai][bj][m][1] + b1;
                    u32x4 w;
                    w.x = cvt_pk_bf16(bf_lo(zz.x) * sigmoidf_(v0[0]), bf_hi(zz.x) * sigmoidf_(v0[1]));
                    w.y = cvt_pk_bf16(bf_lo(zz.y) * sigmoidf_(v0[2]), bf_hi(zz.y) * sigmoidf_(v0[3]));
                    w.z = cvt_pk_bf16(bf_lo(zz.z) * sigmoidf_(v1[0]), bf_hi(zz.z) * sigmoidf_(v1[1]));
                    w.w = cvt_pk_bf16(bf_lo(zz.w) * sigmoidf_(v1[2]), bf_hi(zz.w) * sigmoidf_(v1[3]));
                    *(GAS u32x4*)(MIXED + r * DM + col0 + bj * 128) = w;
                    if (m & 1) asm volatile("" ::: "memory"); }
        }
    }
};
struct EpiDelta {
    static constexpr bool PERM = true, AFTER_DRAIN = false;
    GAS bf16_t* D; const GAS float* gate0;
    __device__ __forceinline__ void operator()(const f32x4 (&acc)[2][2][4][2], const pg8::Unit& u, int wr, int wc, int fr, int fq) const {
        const int row0 = u.pm * 256 + wr * 64 + fr, col0 = u.pn * 256 + wc * 32 + 8 * fq;
        const GAS float* gp = gate0 + (u.pm >= 32 ? 6 * DM : 0) + col0;
        f32x4 g[2][2];
#pragma unroll
        for (int bj = 0; bj < 2; ++bj)
#pragma unroll
            for (int n = 0; n < 2; ++n) g[bj][n] = *(const GAS f32x4*)(gp + bj * 128 + 4 * n) + 1.0f;
#pragma unroll
        for (int ai = 0; ai < 2; ++ai)
#pragma unroll
            for (int m = 0; m < 4; ++m) { GAS bf16_t* rowp = D + (size_t)(row0 + ai * 128 + m * 16) * DM + col0;
#pragma unroll
                for (int bj = 0; bj < 2; ++bj) { const f32x4 v0 = acc[ai][bj][m][0] * g[bj][0], v1 = acc[ai][bj][m][1] * g[bj][1];
                    u32x4 w; w.x = cvt_pk_bf16(v0[0], v0[1]); w.y = cvt_pk_bf16(v0[2], v0[3]); w.z = cvt_pk_bf16(v1[0], v1[1]); w.w = cvt_pk_bf16(v1[2], v1[3]);
                    *(GAS u32x4*)(rowp + bj * 128) = w; } }
    }
};

__device__ __forceinline__ int lane_id_v() { int r; asm volatile("v_mbcnt_lo_u32_b32 %0, -1, 0\n\tv_mbcnt_hi_u32_b32 %0, -1, %0" : "=v"(r)); return r; }
struct Args { const float* in[N_IN]; float* out; unsigned char* ws; int ph_lo, ph_hi; };
struct Ctx {
    volatile LAS unsigned long long* t;
    __device__ __forceinline__ unsigned long long ld(int i) const { const unsigned long long v = t[i];
        return ((unsigned long long)(unsigned)__builtin_amdgcn_readfirstlane((int)(v >> 32)) << 32) | (unsigned long long)(unsigned)__builtin_amdgcn_readfirstlane((int)(unsigned)v); }
    __device__ __forceinline__ const GAS float* in(int i) const { return (const GAS float*)ld(i); }
    __device__ __forceinline__ GAS float* out() const { return (GAS float*)ld(30); }
    __device__ __forceinline__ GAS unsigned char* ws() const { return (GAS unsigned char*)ld(31); }
};

constexpr int S5K = 1152;
constexpr size_t S5_T_LAYER = (size_t)64 * 1024 * S5K * 2, S5_W1_LAYER = (size_t)64 * 256 * S5K * 2;

struct S5Order {
    int G, c, n, sh;
    __device__ __forceinline__ bool next(int i, pg8::Unit& u) const { const int L = i * G + c; if (L >= n) return false; u.pm = L >> sh; u.pn = L; return true; }
    __device__ __forceinline__ void a_ready(const pg8::Unit&) const {}
    __device__ __forceinline__ void done(const pg8::Unit&) const {}
};
struct EpiS5A {
    static constexpr bool PERM = false, AFTER_DRAIN = false;
    GAS float* Sloc;
    __device__ __forceinline__ void operator()(const f32x4 (&acc)[2][2][4][2], const pg8::Unit& u, int wr, int wc, int fr, int fq) const {
        const int row0 = u.pm * 256 + wr * 64 + fr, col0 = wc * 32 + 4 * fq;
#pragma unroll
        for (int ai = 0; ai < 2; ++ai)
#pragma unroll
            for (int m = 0; m < 4; ++m)
#pragma unroll
                for (int n = 0; n < 2; ++n) *(GAS f32x4*)(Sloc + (size_t)(row0 + ai * 128 + m * 16) * 128 + col0 + n * 16) = acc[ai][0][m][n];
    }
};
struct EpiS5C {
    static constexpr bool PERM = true, AFTER_DRAIN = false;
    GAS bf16_t* Z;
    __device__ __forceinline__ void operator()(const f32x4 (&acc)[2][2][4][2], const pg8::Unit& u, int wr, int wc, int fr, int fq) const {
        const int g = u.pm, c0 = wr * 64 + fr, cc0 = (u.pn & 3) * 256 + wc * 32 + 8 * fq;
#pragma unroll
        for (int ai = 0; ai < 2; ++ai)
#pragma unroll
            for (int m = 0; m < 4; ++m) { const int c = c0 + ai * 128 + m * 16;
#pragma unroll
                for (int bj = 0; bj < 2; ++bj) { const int cc = cc0 + bj * 128, t = cc >> 4, h0 = cc & 15;
                    const f32x4 v0 = acc[ai][bj][m][0], v1 = acc[ai][bj][m][1];
                    u32x4 w; w.x = cvt_pk_bf16(gelu_tanh(v0[0]), gelu_tanh(v0[1])); w.y = cvt_pk_bf16(gelu_tanh(v0[2]), gelu_tanh(v0[3]));
                    w.z = cvt_pk_bf16(gelu_tanh(v1[0]), gelu_tanh(v1[1])); w.w = cvt_pk_bf16(gelu_tanh(v1[2]), gelu_tanh(v1[3]));
                    *(GAS u32x4*)(Z + (size_t)(c * 64 + t) * S5W + g * 16 + h0) = w; } }
    }
};
__device__ __forceinline__ void s5_tables_item(const Ctx& a, int lg, LAS unsigned char* lds, int wave, int lane) {
    LAS f32x2* LP = (LAS f32x2*)lds;
    LAS f32x2* BB = (LAS f32x2*)(lds + 33280);
    LAS f32x2* CC = (LAS f32x2*)(lds + 41472);
    LAS float* KT = (LAS float*)(lds + 49664);
    const int tid = wave * 64 + lane, l = lg >> 6, g = lg & 63;
    if (tid < 64) { const int p = tid;
        const double ar = (double)a.in(I_AREAL)[lg * 64 + p], ai = (double)a.in(I_AIMAG)[lg * 64 + p], dt = exp((double)a.in(I_LOGDT)[lg]);
        const double mag = exp(ar * dt), ang = ai * dt, lr = mag * cos(ang), li = mag * sin(ang);
        const double den = ar * ar + ai * ai, nr = lr - 1.0, ni = li, cr = (nr * ar + ni * ai) / den, ci = (ni * ar - nr * ai) / den;
        double pr = 1.0, pi = 0.0;
        for (int tau = 0; tau <= 64; ++tau) { LP[tau * 64 + p] = (f32x2){(float)pr, (float)pi}; const double nr2 = pr * lr - pi * li, ni2 = pr * li + pi * lr; pr = nr2; pi = ni2; }
        for (int h = 0; h < 16; ++h) { const double br = (double)a.in(I_BRE)[((size_t)lg * 64 + p) * 16 + h], bi = (double)a.in(I_BIM)[((size_t)lg * 64 + p) * 16 + h];
            BB[p * 16 + h] = (f32x2){(float)(cr * br - ci * bi), (float)(cr * bi + ci * br)}; }
    }
    for (int e = tid; e < 1024; e += 512) { const int h = e >> 6, p = e & 63; CC[e] = (f32x2){a.in(I_CRE)[((size_t)lg * 16 + h) * 64 + p], a.in(I_CIM)[((size_t)lg * 16 + h) * 64 + p]}; }
    __syncthreads();
    if (tid < 64) *(GAS f32x2*)((GAS float*)(a.ws() + WS_LAM64) + ((size_t)lg * 64 + tid) * 2) = LP[64 * 64 + tid];
    for (int e = tid; e < 64 * 256; e += 512) { const int tau = e >> 8, h = (e >> 4) & 15, hp = e & 15; float s = 0.f;
#pragma unroll 8
        for (int p = 0; p < 64; ++p) { const f32x2 c = CC[h * 64 + p], lm = LP[tau * 64 + p], b = BB[p * 16 + hp];
            const float xr = c.x * lm.x - c.y * lm.y, xi = c.x * lm.y + c.y * lm.x; s += xr * b.x - xi * b.y; }
        if (tau == 0 && h == hp) s += a.in(I_S5D)[l * S5W + g * 16 + h];
        KT[e] = s; }
    __syncthreads();
    GAS bf16_t* T = (GAS bf16_t*)(a.ws() + WS_S5T + (size_t)l * S5_T_LAYER) + (size_t)g * 1024 * S5K;
    for (int pc = tid; pc < 1024 * 144; pc += 512) { const int n = pc / 144, j = pc % 144, t = n >> 4, h = n & 15; float v[8];
        if (j < 128) { const int s = j >> 1, hp0 = (j & 1) * 8;
            if (s > t) {
#pragma unroll
                for (int i = 0; i < 8; ++i) v[i] = 0.f;
            } else { const LAS float* kp = KT + (t - s) * 256 + h * 16 + hp0; const f32x4 k0 = *(const LAS f32x4*)kp, k1 = *(const LAS f32x4*)(kp + 4);
                v[0] = k0[0]; v[1] = k0[1]; v[2] = k0[2]; v[3] = k0[3]; v[4] = k1[0]; v[5] = k1[1]; v[6] = k1[2]; v[7] = k1[3]; }
        } else { const int p0 = (j - 128) * 4;
#pragma unroll
            for (int i = 0; i < 4; ++i) { const f32x2 c = CC[h * 64 + p0 + i], lm = LP[(t + 1) * 64 + p0 + i]; v[2 * i] = c.x * lm.x - c.y * lm.y; v[2 * i + 1] = -(c.x * lm.y + c.y * lm.x); } }
        *(GAS u32x4*)(T + (size_t)n * S5K + j * 8) = (u32x4){cvt_pk_bf16(v[0], v[1]), cvt_pk_bf16(v[2], v[3]), cvt_pk_bf16(v[4], v[5]), cvt_pk_bf16(v[6], v[7])}; }
    GAS bf16_t* W1 = (GAS bf16_t*)(a.ws() + WS_S5W1 + (size_t)l * S5_W1_LAYER) + (size_t)g * 256 * S5K;
    for (int pc = tid; pc < 256 * 144; pc += 512) { const int n = pc / 144, j = pc % 144; float v[8];
#pragma unroll
        for (int i = 0; i < 8; ++i) v[i] = 0.f;
        if (n < 128 && j < 128) { const int p = n >> 1, ri = n & 1, s = j >> 1, hp0 = (j & 1) * 8; const f32x2 lm = LP[(63 - s) * 64 + p];
#pragma unroll
            for (int i = 0; i < 8; ++i) { const f32x2 b = BB[p * 16 + hp0 + i]; v[i] = ri ? (lm.x * b.y + lm.y * b.x) : (lm.x * b.x - lm.y * b.y); } }
        *(GAS u32x4*)(W1 + (size_t)n * S5K + j * 8) = (u32x4){cvt_pk_bf16(v[0], v[1]), cvt_pk_bf16(v[2], v[3]), cvt_pk_bf16(v[4], v[5]), cvt_pk_bf16(v[6], v[7])}; }
    __syncthreads();
}
__device__ __forceinline__ void s5_scan_item(const Ctx& a, int l, int item, int wave, int lane) {
    const int idx = item * 512 + wave * 64 + lane, g = idx >> 7, b = (idx >> 6) & 1, p = idx & 63;
    const f32x2 lam = *(const GAS f32x2*)((const GAS float*)(a.ws() + WS_LAM64) + ((size_t)(l * 64 + g) * 64 + p) * 2);
    const GAS float* sl = (const GAS float*)(a.ws() + WS_SLOC) + ((size_t)(g * 256 + b * 128)) * 128 + 2 * p;
    GAS bf16_t* ux = (GAS bf16_t*)(a.ws() + WS_UX) + ((size_t)(g * 256 + b * 128)) * S5K + 1024 + 2 * p;
    float xr = 0.f, xi = 0.f;
    for (int c0 = 0; c0 < 128; c0 += 8) { f32x2 s[8];
#pragma unroll
        for (int i = 0; i < 8; ++i) s[i] = *(const GAS f32x2*)(sl + (size_t)(c0 + i) * 128);
#pragma unroll
        for (int i = 0; i < 8; ++i) { *(GAS unsigned*)(ux + (size_t)(c0 + i) * S5K) = cvt_pk_bf16(xr, xi);
            const float nr = lam.x * xr - lam.y * xi + s[i].x, ni = lam.x * xi + lam.y * xr + s[i].y; xr = nr; xi = ni; } }
}

__device__ __forceinline__ void transpose_item(const GAS float* W, int N, int k0, int n0, GAS bf16_t* WT, int drow0, int Kd, LAS float* scr, int lane) {
    const int nl = 4 * (lane & 15), kq = lane >> 4;
    const bool valid = (n0 + nl) < N;
    f32x4 v[16];
#pragma unroll
    for (int i = 0; i < 16; ++i) { const int k = 4 * i + kq; v[i] = valid ? *(const GAS f32x4*)(W + (size_t)(k0 + k) * N + n0 + nl) : (f32x4){0.f, 0.f, 0.f, 0.f}; }
#pragma unroll
    for (int i = 0; i < 16; ++i) { const int k = 4 * i + kq; LAS float* s = scr + k * 65 + nl; s[0] = v[i][0]; s[1] = v[i][1]; s[2] = v[i][2]; s[3] = v[i][3]; }
    LDS_WAIT();
    const int c = lane & 7;
#pragma unroll
    for (int j = 0; j < 8; ++j) { const int n = (lane >> 3) + 8 * j; const LAS float* s = scr + (8 * c) * 65 + n;
        u32x4 o; o.x = cvt_pk_bf16(s[0], s[65]); o.y = cvt_pk_bf16(s[130], s[195]); o.z = cvt_pk_bf16(s[260], s[325]); o.w = cvt_pk_bf16(s[390], s[455]);
        *(GAS u32x4*)(WT + (size_t)(drow0 + n) * Kd + k0 + 8 * c) = o; }
    LDS_WAIT();
}
constexpr int NIT_IN = 64 * 188, NIT_OUT = 64 * 64, NIT_G = 64 * 172, NIT_DN = 172 * 64, NIT_GLU = 16 * 16;
constexpr int NIT_LAYER = NIT_IN + NIT_OUT + 2 * NIT_G + NIT_DN + NIT_GLU;
constexpr int NIT_TR = DEPTH * NIT_LAYER, NIT_COND = 64 * 96;

__device__ __forceinline__ void phase_prologue(const Ctx& a, LAS unsigned char* lds, int wave, int lane) {
    if (blockIdx.x & 1) { for (int lg = blockIdx.x; lg < DEPTH * 64; lg += gridDim.x) s5_tables_item(a, lg, lds, wave, lane); __syncthreads(); }
    LAS float* scr = (LAS float*)(lds + wave * 16640);
    const int gw = blockIdx.x * 8 + wave, NGW = gridDim.x * 8;
    for (int it = gw; it < NIT_TR + NIT_COND; it += NGW) {
        if (it < NIT_TR) {
            const int l = it / NIT_LAYER; int r = it % NIT_LAYER;
            GAS unsigned char* wt = a.ws() + WS_WT + (size_t)l * WT_LAYER;
            if (r < NIT_IN) { const int kb = r / 188, nb = r % 188; transpose_item(a.in(I_WIN) + (size_t)l * DM * INW, INW, 64 * kb, 64 * nb, (GAS bf16_t*)(wt + WT_IN), 64 * nb, DM, scr, lane); continue; } r -= NIT_IN;
            if (r < NIT_OUT) { const int kb = r / 64, nb = r % 64; transpose_item(a.in(I_WOUT) + (size_t)l * DM * DM, DM, 64 * kb, 64 * nb, (GAS bf16_t*)(wt + WT_OUT), 64 * nb, DM, scr, lane); continue; } r -= NIT_OUT;
            if (r < NIT_G) { const int kb = r / 172, nb = r % 172, n0 = 64 * nb; transpose_item(a.in(I_WFG) + (size_t)l * DM * DFF, DFF, 64 * kb, n0, (GAS bf16_t*)(wt + WT_GU), 256 * (n0 / 128) + (n0 % 128), DM, scr, lane); continue; } r -= NIT_G;
            if (r < NIT_G) { const int kb = r / 172, nb = r % 172, n0 = 64 * nb; transpose_item(a.in(I_WFU) + (size_t)l * DM * DFF, DFF, 64 * kb, n0, (GAS bf16_t*)(wt + WT_GU), 256 * (n0 / 128) + 128 + (n0 % 128), DM, scr, lane); continue; } r -= NIT_G;
            if (r < NIT_DN) { const int kb = r / 64, nb = r % 64; transpose_item(a.in(I_WFD) + (size_t)l * DFF * DM, DM, 64 * kb, 64 * nb, (GAS bf16_t*)(wt + WT_DN), 64 * nb, DFF, scr, lane); continue; } r -= NIT_DN;
            { const int kb = r / 16, nb = r % 16; transpose_item(a.in(I_GLUW) + (size_t)l * S5W * S5W, S5W, 64 * kb, 64 * nb, (GAS bf16_t*)(wt + WT_GLU), 64 * nb, S5W, scr, lane); }
        } else {
            const int item = it - NIT_TR, kb = item / 96, jb = item % 96, k0 = 64 * kb, j0 = 256 * jb + 4 * lane;
            const GAS float* c = a.in(I_C);
            float c0 = c[k0 + lane], c1 = c[DM + k0 + lane];
            c0 = c0 / (1.0f + expf(-c0)); c1 = c1 / (1.0f + expf(-c1));
            f32x4 a0 = (f32x4){0.f, 0.f, 0.f, 0.f}, a1 = a0;
            const GAS float* w = a.in(I_WADA) + (size_t)k0 * (6 * DM) + j0;
#pragma unroll 8
            for (int kk = 0; kk < 64; ++kk) { const f32x4 wv = *(const GAS f32x4*)(w + (size_t)kk * (6 * DM));
                const float s0 = __int_as_float(__builtin_amdgcn_readlane(__float_as_int(c0), kk)), s1 = __int_as_float(__builtin_amdgcn_readlane(__float_as_int(c1), kk));
                a0 += wv * s0; a1 += wv * s1; }
            GAS float* cp = (GAS float*)(a.ws() + WS_CONDPART);
            *(GAS f32x4*)(cp + (size_t)(kb * 2 + 0) * (6 * DM) + j0) = a0;
            *(GAS f32x4*)(cp + (size_t)(kb * 2 + 1) * (6 * DM) + j0) = a1;
        }
    }
    __syncthreads();
    if (!(blockIdx.x & 1)) { for (int lg = blockIdx.x; lg < DEPTH * 64; lg += gridDim.x) s5_tables_item(a, lg, lds, wave, lane); }
}
__device__ __forceinline__ void phase_mod(const Ctx& a, int wave, int lane) {
    const int gt = blockIdx.x * 512 + wave * 64 + lane, NT = gridDim.x * 512;
    const GAS float* cp = (const GAS float*)(a.ws() + WS_CONDPART);
    GAS float* mod = (GAS float*)(a.ws() + WS_MOD); GAS float* misc = (GAS float*)(a.ws() + WS_MISC);
    for (int idx = gt; idx < NB * 6 * DM; idx += NT) {
        const int b = idx / (6 * DM), j = idx % (6 * DM);
        float s = a.in(I_BADA)[j];
        for (int kb = 0; kb < 64; ++kb) s += cp[(size_t)(kb * 2 + b) * (6 * DM) + j];
        for (int l = 0; l < DEPTH; ++l) mod[(size_t)((l * 2 + b) * 6) * DM + j] = s + a.in(I_TABLE)[(size_t)l * 6 * DM + j];
    }
    for (int idx = gt; idx < DM; idx += NT) { misc[idx] = 1.0f; misc[DM + idx] = 0.0f; }
    for (int idx = gt; idx < HGW; idx += NT) {
        const GAS float* raw = a.in(I_LBRAW); float r[DEPTH], mx = -3.0e38f;
#pragma unroll
        for (int l = 0; l < DEPTH; ++l) { r[l] = raw[l * HGW + idx]; mx = fmaxf(mx, r[l]); }
        float e[DEPTH], sum = 0.f;
#pragma unroll
        for (int l = 0; l < DEPTH; ++l) { e[l] = expf(r[l] - mx); sum += e[l]; }
        float cum = 0.f;
#pragma unroll
        for (int l = 0; l < DEPTH; ++l) { misc[2 * DM + l * HGW + idx] = cum; if (l + 1 < DEPTH) cum += e[l + 1] / sum; }
    }
}

__device__ __forceinline__ void phase_h0(const GAS float* x, const GAS float* modp, GAS bf16_t* H, int wave, int lane) {
    for (int blk = blockIdx.x; blk < MTOK / 64; blk += gridDim.x) {
        const int r0 = blk * 64, b = (r0 >= SEQ) ? 1 : 0;
        f32x4 A[2], B[2];
#pragma unroll
        for (int jj = 0; jj < 2; ++jj) { const int c = 512 * wave + 256 * jj + 4 * lane; A[jj] = *(const GAS f32x4*)(modp + (size_t)(b * 6 + 1) * DM + c) + 1.0f; B[jj] = *(const GAS f32x4*)(modp + (size_t)(b * 6 + 0) * DM + c); }
#pragma unroll 8
        for (int rl = 0; rl < 64; ++rl) { const size_t off = (size_t)(r0 + rl) * DM + 512 * wave + 4 * lane;
#pragma unroll
            for (int jj = 0; jj < 2; ++jj) { const f32x4 v = *(const GAS f32x4*)(x + off + 256 * jj), y = v * A[jj] + B[jj];
                u32x2 w; w.x = cvt_pk_bf16(y[0], y[1]); w.y = cvt_pk_bf16(y[2], y[3]); *(GAS u32x2*)(H + off + 256 * jj) = w; } }
    }
}
struct XRes { GAS unsigned* hi; GAS unsigned* lo; };
template <bool WITH_H, bool XP32, bool XO32>
__device__ __forceinline__ void phase_lnres(const GAS float* xp32, XRes xp, const GAS bf16_t* delta, GAS float* xo32, XRes xo, const GAS float* lng, const GAS float* lnb, const GAS float* modp, int i_shift, int i_scale,
                                            GAS bf16_t* H, LAS unsigned char* lds, int wave, int lane) {
    LAS f32x2* red = (LAS f32x2*)lds;
    for (int blk = blockIdx.x; blk < MTOK / 64; blk += gridDim.x) {
        const int r0 = blk * 64, b = (r0 >= SEQ) ? 1 : 0;
        f32x4 G[2], Bt[2], A[2], B[2];
#pragma unroll
        for (int jj = 0; jj < 2; ++jj) { const int c = 512 * wave + 256 * jj + 4 * lane; G[jj] = *(const GAS f32x4*)(lng + c); Bt[jj] = *(const GAS f32x4*)(lnb + c);
            if (WITH_H) { A[jj] = *(const GAS f32x4*)(modp + (size_t)(b * 6 + i_scale) * DM + c) + 1.0f; B[jj] = *(const GAS f32x4*)(modp + (size_t)(b * 6 + i_shift) * DM + c); } }
        const size_t offb = (size_t)r0 * DM + 512 * wave + 4 * lane;
        f32x4 va[4][2], vb[4][2]; u32x2 da[4][2], db[4][2];
#define LN_LOAD(v_, d_, it_) do { _Pragma("unroll") for (int r = 0; r < 4; ++r) _Pragma("unroll") for (int jj = 0; jj < 2; ++jj) { const size_t o_ = offb + (size_t)((it_) * 4 + r) * DM + 256 * jj; \
            if (XP32) v_[r][jj] = *(const GAS f32x4*)(xp32 + o_); else { const u32x2 t_ = *(const GAS u32x2*)(xp.hi + (o_ >> 1)); const unsigned l_ = xp.lo[o_ >> 2]; \
                v_[r][jj][0] = __uint_as_float(t_.x); v_[r][jj][1] = __uint_as_float(t_.y); v_[r][jj][2] = __uint_as_float(l_); } \
            d_[r][jj] = *(const GAS u32x2*)(delta + o_); } } while (0)
#define LN_STEP(v_, d_, it_) do { LAS f32x2* rb = red + ((it_) & 1) * 32; \
            _Pragma("unroll") for (int r = 0; r < 4; ++r) { float s1 = 0.f, s2 = 0.f; \
                _Pragma("unroll") for (int jj = 0; jj < 2; ++jj) { const f32x4 dd = (f32x4){bf_lo(d_[r][jj].x), bf_hi(d_[r][jj].x), bf_lo(d_[r][jj].y), bf_hi(d_[r][jj].y)}; \
                    f32x4 xq = v_[r][jj]; \
                    if (!XP32) { const unsigned t0 = __float_as_uint(xq[0]), t1 = __float_as_uint(xq[1]), lw = __float_as_uint(xq[2]); \
                        xq[0] = __uint_as_float(__builtin_amdgcn_perm(t0, lw, 0x0504000cu)); xq[1] = __uint_as_float(__builtin_amdgcn_perm(t0, lw, 0x0706010cu)); \
                        xq[2] = __uint_as_float(__builtin_amdgcn_perm(t1, lw, 0x0504020cu)); xq[3] = __uint_as_float(__builtin_amdgcn_perm(t1, lw, 0x0706030cu)); } \
                    const f32x4 y = xq * ALPHA + dd; v_[r][jj] = y; \
                    s1 += (y[0] + y[1]) + (y[2] + y[3]); s2 += (y[0] * y[0] + y[1] * y[1]) + (y[2] * y[2] + y[3] * y[3]); } \
                s1 = wave_sum(s1); s2 = wave_sum(s2); if (lane == 0) rb[r * 8 + wave] = (f32x2){s1, s2}; } \
            __syncthreads(); \
            _Pragma("unroll") for (int r = 0; r < 4; ++r) { float s1 = 0.f, s2 = 0.f; \
                _Pragma("unroll") for (int w = 0; w < 8; ++w) { const f32x2 p = rb[r * 8 + w]; s1 += p.x; s2 += p.y; } \
                const float mu = s1 * (1.0f / DM), rs = 1.0f / sqrtf(fmaxf(s2 * (1.0f / DM) - mu * mu, 0.f) + LN_EPS); \
                _Pragma("unroll") for (int jj = 0; jj < 2; ++jj) { const f32x4 x = ((v_[r][jj] - mu) * rs) * G[jj] + Bt[jj]; const size_t o_ = offb + (size_t)((it_) * 4 + r) * DM + 256 * jj; \
                    if (XO32) *(GAS f32x4*)(xo32 + o_) = x; \
                    else { const unsigned q0 = __float_as_uint(x[0]) + 0x80u, q1 = __float_as_uint(x[1]) + 0x80u, q2 = __float_as_uint(x[2]) + 0x80u, q3 = __float_as_uint(x[3]) + 0x80u; \
                        *(GAS u32x2*)(xo.hi + (o_ >> 1)) = (u32x2){__builtin_amdgcn_perm(q1, q0, 0x07060302u), __builtin_amdgcn_perm(q3, q2, 0x07060302u)}; \
                        xo.lo[o_ >> 2] = __builtin_amdgcn_perm(q1, q0, 0x0c0c0501u) | __builtin_amdgcn_perm(q3, q2, 0x05010c0cu); } \
                    if (WITH_H) { const f32x4 y = x * A[jj] + B[jj]; u32x2 w; w.x = cvt_pk_bf16(y[0], y[1]); w.y = cvt_pk_bf16(y[2], y[3]); *(GAS u32x2*)(H + o_) = w; } } } } while (0)
        LN_LOAD(va, da, 0);
        for (int it = 0; it < 16; it += 2) {
            LN_LOAD(vb, db, it + 1);
            LN_STEP(va, da, it);
            if (it + 2 < 16) LN_LOAD(va, da, it + 2);
            LN_STEP(vb, db, it + 1);
        }
#undef LN_LOAD
#undef LN_STEP
        __syncthreads();
    }
}

typedef short bf16x8 __attribute__((ext_vector_type(8)));
constexpr int HG_BLK = 33280, HG_OQ = 0, HG_OK = 8192, HG_OKT = 16384, HG_ODL = 24576, HG_OVT = 25088;
constexpr int GL_BLK = 63488, GL_OQ = 0, GL_OK = 12800, GL_OKT = 25600, GL_ODL = 37888, GL_SHARED = 38912, GL_OVT = 38912;
constexpr int NUNIT = SEQ / 32;

struct PreOut { GAS unsigned char* blk; int oq, ok, okt, odl, rowb; bool swz; };
__device__ __forceinline__ int slot_swz(int r) { return (0 - (r >> 2)) & 3; }
template <int HALF>
__device__ __forceinline__ float pre_half(const PreOut& P, int d, int pd, float e0, const float (&a)[16], const float (&qq)[16], const float (&kk)[16], float (&kta)[16], unsigned (&kt)[16], float& ph) {
    float w = 1.0f;
#pragma unroll
    for (int t = 14; t >= 0; t -= 2) { const float kv1 = kk[t + 1] * w; w *= a[t + 1]; const float kv0 = kk[t] * w; w *= a[t];
        if (HALF == 0) { kta[t] = kv0; kta[t + 1] = kv1; } else kt[4 * (t >> 2) + 2 + ((t & 3) >> 1)] = cvt_pk_bf16(kv0, kv1); }
    ph = w;
    float e = e0;
#pragma unroll
    for (int j = 0; j < 16; ++j) { const int row = 16 * HALF + j;
        e *= a[j];
        const int off = row * P.rowb + ((2 * pd) ^ ((P.swz ? j : ((j >> 1) & 7)) << 4));
        const float qv = qq[j] * e, kc = kk[j] * fminf(__builtin_amdgcn_rcpf(e), 5.5406224e34f);
        const float qn = __int_as_float(__builtin_amdgcn_mov_dpp(__float_as_int(qv), 0xB1, 0xF, 0xF, true)), kn = __int_as_float(__builtin_amdgcn_mov_dpp(__float_as_int(kc), 0xB1, 0xF, 0xF, true));
        if ((d & 1) == 0) { *(GAS unsigned*)(P.blk + P.oq + off) = cvt_pk_bf16(qv, qn); *(GAS unsigned*)(P.blk + P.ok + off) = cvt_pk_bf16(kc, kn); } }
    return e;
}
__device__ __forceinline__ void pre_tail(const PreOut& P, int d, float dlb, float eend, const float (&kta)[16], unsigned (&kt)[16]) {
#pragma unroll
    for (int t = 0; t < 16; t += 2) kt[4 * (t >> 2) + ((t & 3) >> 1)] = cvt_pk_bf16(kta[t] * dlb, kta[t + 1] * dlb);
#pragma unroll
    for (int i = 0; i < 4; ++i) *(GAS u32x4*)(P.blk + P.okt + d * 64 + 16 * (i ^ slot_swz(d))) = (u32x4){kt[4 * i], kt[4 * i + 1], kt[4 * i + 2], kt[4 * i + 3]};
    *(GAS float*)(P.blk + P.odl + d * 4) = eend;
}
__device__ __forceinline__ void glds16_asm(const GAS void* gsrc, unsigned lds_dst) { unsigned keep;
    asm volatile("s_mov_b32 %0, m0\n\ts_mov_b32 m0, %2\n\ts_nop 0\n\tglobal_load_lds_dwordx4 %1, off\n\ts_mov_b32 m0, %0" : "=&s"(keep) : "v"(gsrc), "s"(lds_dst) : "memory"); }
constexpr int PRE_IN = 49152, PRE_OUT = 2 * PRE_IN;
__device__ __forceinline__ void pre_hg_dma(const GAS bf16_t* P, int t, int half, LAS unsigned char* img, int wave, int lane) {
    const int bu = t / 3, kind = t - 3 * bu, b = bu / NUNIT, un = bu - b * NUNIT;
    const GAS bf16_t* src = P + ((size_t)b * SEQ + un * 32 + 16 * half) * INP + kind * 512 + 8 * lane;
    const unsigned dst = (unsigned)(size_t)img;
#pragma unroll
    for (int i = 0; i < 6; ++i) { const int r = wave * 6 + i, arr = r >> 4, j = r & 15;
        glds16_asm(src + (size_t)j * INP + (arr == 0 ? C_QB : arr == 1 ? C_FB : C_IB), dst + r * 1024); }
}
template <int HALF>
__device__ __forceinline__ float pre_half_l(LAS unsigned char* oq, LAS unsigned char* ok, int pd, float e0, const float (&a)[16], const float (&qq)[16], const float (&kk)[16], float (&kta)[16], unsigned (&kt)[16], float& ph) {
    float w = 1.0f;
#pragma unroll
    for (int t = 14; t >= 0; t -= 2) { const float kv1 = kk[t + 1] * w; w *= a[t + 1]; const float kv0 = kk[t] * w; w *= a[t];
        if (HALF == 0) { kta[t] = kv0; kta[t + 1] = kv1; } else kt[4 * (t >> 2) + 2 + ((t & 3) >> 1)] = cvt_pk_bf16(kv0, kv1); }
    ph = w;
    float e = e0;
#pragma unroll
    for (int j = 0; j < 16; ++j) { e *= a[j];
        const int off = j * 256 + ((2 * pd) ^ (j << 4));
        const float qv = qq[j] * e, kc = kk[j] * fminf(__builtin_amdgcn_rcpf(e), 5.5406224e34f);
        *(LAS unsigned short*)(oq + off) = (unsigned short)cvt_pk_bf16(qv, qv); *(LAS unsigned short*)(ok + off) = (unsigned short)cvt_pk_bf16(kc, kc); }
    return e;
}
__device__ __forceinline__ void phase_pre(const Ctx& a, int l, LAS unsigned char* lds, int wave, int lane) {
    const GAS bf16_t* P = (const GAS bf16_t*)(a.ws() + WS_P);
    int tid = wave * 64 + lane;
    const int bx = blockIdx.x, G = gridDim.x;
    {
        const int t_lo = (int)((long)(NB * NUNIT * 3) * bx / G), t_hi = (int)((long)(NB * NUNIT * 3) * (bx + 1) / G);
        float lbk[3];
#pragma unroll
        for (int k = 0; k < 3; ++k) lbk[k] = ((const GAS float*)(a.ws() + WS_MISC))[2 * DM + l * HGW + k * 512 + tid];
        asm volatile("" : "+v"(lbk[0]), "+v"(lbk[1]), "+v"(lbk[2]));
        __syncthreads();
        if (t_lo < t_hi) pre_hg_dma(P, t_lo, 0, lds, wave, lane);
        VM_WAIT();
        for (int t = t_lo; t < t_hi; ++t) {
            asm volatile("" : "+v"(tid));
            const int bu = t / 3, kind = t - 3 * bu, b = bu / NUNIT, un = bu - b * NUNIT;
            const int ch = kind * 512 + tid, hh = tid >> 7, d = tid & 127, pd = (d & ~31) + 8 * ((d >> 2) & 3) + 4 * ((d >> 4) & 1) + (d & 3);
            const float lb = kind == 0 ? lbk[0] : kind == 1 ? lbk[1] : lbk[2];
            GAS unsigned char* blk0 = a.ws() + WS_HGB + ((size_t)(b * 12 + kind * 4) * NUNIT + un) * HG_BLK;
            float kta[16]; unsigned kt[16], vv[16]; float e0 = 1.f, e1 = 1.f, ph = 1.f;
#pragma unroll
            for (int half = 0; half < 2; ++half) {
                __syncthreads();
                { const int nt = half ? t + 1 : t; if (nt < t_hi) pre_hg_dma(P, nt, half ^ 1, lds + (half ^ 1) * PRE_IN, wave, lane); }
                const LAS unsigned char* img = lds + half * PRE_IN + 2 * tid;
                float g[16], qq[16], kk[16];
                unsigned short rq[16], rf[16], rv[16];
#pragma unroll
                for (int j = 0; j < 16; ++j) { rq[j] = *(const LAS unsigned short*)(img + j * 1024); rf[j] = *(const LAS unsigned short*)(img + (16 + j) * 1024); rv[j] = *(const LAS unsigned short*)(img + (32 + j) * 1024); }
                asm volatile("" ::: "memory");
#pragma unroll
                for (int j = 0; j < 16; ++j) {
                    const float qin = fmaxf(bf2f(rq[j]), -80.f), fin = fminf(fmaxf(bf2f(rf[j]), -80.f), 80.f);
                    const unsigned short v = rv[j];
                    const int w = 4 * (j >> 2) + 2 * half + ((j & 3) >> 1); if (j & 1) vv[w] |= ((unsigned)v) << 16; else vv[w] = v;
                    const float e = __expf(-fin), sg = __builtin_amdgcn_rcpf(1.0f + e);
                    const float f = lb + (1.0f - lb) * sg;
                    g[j] = f; kk[j] = (1.0f - lb) * (e * sg); qq[j] = qin * __builtin_amdgcn_rcpf(1.0f + __expf(-qin)); }
                LAS unsigned char* oq = lds + PRE_OUT + hh * 4096; LAS unsigned char* ok = oq + 16384;
                if (half == 0) { e0 = pre_half_l<0>(oq, ok, pd, 1.0f, g, qq, kk, kta, kt, ph); } else { e1 = pre_half_l<1>(oq, ok, pd, e0, g, qq, kk, kta, kt, ph); }
                __syncthreads();
                VM_WAIT();
#pragma unroll
                for (int i = 0; i < 4; ++i) { const int pc = i * 512 + tid, c = pc >> 8, wi = pc & 255;
                    *(GAS u32x4*)(blk0 + (size_t)(c & 3) * NUNIT * HG_BLK + (c >> 2 ? HG_OK : HG_OQ) + half * 4096 + wi * 16) = *(const LAS u32x4*)(lds + PRE_OUT + c * 4096 + wi * 16); }
            }
            GAS unsigned char* blk = blk0 + (size_t)hh * NUNIT * HG_BLK;
            const PreOut po{blk, HG_OQ, HG_OK, HG_OKT, HG_ODL, 256, true};
#pragma unroll
            for (int i = 0; i < 4; ++i) *(GAS u32x4*)(blk + HG_OVT + d * 64 + 16 * (i ^ slot_swz(d))) = (u32x4){vv[4 * i], vv[4 * i + 1], vv[4 * i + 2], vv[4 * i + 3]};
            pre_tail(po, d, ph, e1, kta, kt);
        }
    }
    const bool bal = G == 256;
    const int t_lo = bal ? (bx < 64 ? 7 * bx : 448 + 11 * (bx - 64)) : bx;
    const int t_hi = bal ? t_lo + (bx < 64 ? 7 : 11) : NB * NUNIT * 5, t_st = bal ? 1 : G;
    for (int task = t_lo; task < t_hi; task += t_st) {
        asm volatile("" : "+v"(tid));
        const int bu = task / 5, kind = 3 + (task - 5 * bu), b = bu / NUNIT, un = bu % NUNIT;
        const size_t row0 = (size_t)b * SEQ + un * 32;
        if (kind < 5) {
            __syncthreads();
            if (tid < 64) *(LAS u32x4*)(lds + tid * 16) = *(const GAS u32x4*)(P + (row0 + (tid >> 1)) * INP + C_LR + 8 * (tid & 1));
            __syncthreads();
            if (tid < 384) {
                const int ch = (kind - 3) * 384 + tid, h = ch / 192, d = ch % 192, pd = (d & ~31) + 8 * ((d >> 2) & 3) + 4 * ((d >> 4) & 1) + (d & 3);
                GAS unsigned char* blk = a.ws() + WS_GLB + ((size_t)(b * 4 + h) * NUNIT + un) * GL_BLK;
                const PreOut po{blk, GL_OQ, GL_OK, GL_OKT, GL_ODL, 384, false};
                float wg[16];
#pragma unroll
                for (int r = 0; r < 16; ++r) wg[r] = a.in(I_WGATE)[((size_t)l * 16 + r) * GLKW + ch];
                const float bgv = a.in(I_BGATE)[l * GLKW + ch];
                float kta[16]; unsigned kt[16]; float e0 = 1.f, e1 = 1.f, ph = 1.f;
#pragma unroll
                for (int half = 0; half < 2; ++half) {
                    float g[16], qq[16], kk[16];
#pragma unroll
                    for (int j = 0; j < 16; ++j) { const GAS bf16_t* prow = P + (row0 + 16 * half + j) * INP;
                        const u32x4 l0 = *(const LAS u32x4*)(lds + (16 * half + j) * 32), l1 = *(const LAS u32x4*)(lds + (16 * half + j) * 32 + 16);
                        float x = bgv;
                        x += bf_lo(l0.x) * wg[0] + bf_hi(l0.x) * wg[1] + bf_lo(l0.y) * wg[2] + bf_hi(l0.y) * wg[3] + bf_lo(l0.z) * wg[4] + bf_hi(l0.z) * wg[5] + bf_lo(l0.w) * wg[6] + bf_hi(l0.w) * wg[7];
                        x += bf_lo(l1.x) * wg[8] + bf_hi(l1.x) * wg[9] + bf_lo(l1.y) * wg[10] + bf_hi(l1.y) * wg[11] + bf_lo(l1.z) * wg[12] + bf_hi(l1.z) * wg[13] + bf_lo(l1.w) * wg[14] + bf_hi(l1.w) * wg[15];
                        g[j] = __expf((fminf(x, 0.f) - __logf(1.0f + __expf(-fabsf(x)))) * 0.0625f);
                        qq[j] = bf2f(prow[C_QC + ch]) * GLA_QSCALE; kk[j] = bf2f(prow[C_KC + ch]); }
                    if (half == 0) { e0 = pre_half<0>(po, d, pd, 1.0f, g, qq, kk, kta, kt, ph); } else { e1 = pre_half<1>(po, d, pd, e0, g, qq, kk, kta, kt, ph); }
                }
                pre_tail(po, d, ph, e1, kta, kt);
            }
        } else {
            const int ch = (kind - 5) * 512 + tid, h = ch / 384, e = ch % 384;
            GAS unsigned char* blk = a.ws() + WS_GLB + ((size_t)(b * 4 + h) * NUNIT + un) * GL_BLK;
            unsigned vv[16]; unsigned short rv[32];
#pragma unroll
            for (int j = 0; j < 32; ++j) rv[j] = P[(row0 + j) * INP + C_VC + ch];
            asm volatile("" ::: "memory");
#pragma unroll
            for (int j = 0; j < 32; ++j) { const unsigned short v = rv[j];
                const int w = 4 * ((j >> 2) & 3) + 2 * (j >> 4) + ((j & 3) >> 1); if (j & 1) vv[w] |= ((unsigned)v) << 16; else vv[w] = v; }
#pragma unroll
            for (int i = 0; i < 4; ++i) *(GAS u32x4*)(blk + GL_OVT + e * 64 + 16 * (i ^ slot_swz(e))) = (u32x4){vv[4 * i], vv[4 * i + 1], vv[4 * i + 2], vv[4 * i + 3]};
        }
    }
}

template <int DK, int MODE>
__device__ __forceinline__ void chain_unit(const LAS unsigned char* sb, f32x4 (&S)[DK / 16], GAS float* op, int wave, int n, int q) {
    constexpr bool IS_GLA = (DK == 192);
    constexpr int NKS = DK / 32, NMB = DK / 16, ROWB = IS_GLA ? 384 : 256;
    constexpr int OQ = 0, OK = IS_GLA ? GL_OK : HG_OK, OKT = IS_GLA ? GL_OKT : HG_OKT, OVT = IS_GLA ? GL_OVT : HG_OVT, ODL = IS_GLA ? GL_ODL : HG_ODL;
    constexpr int UG = 4, NUG = NMB / UG;
#define CU_FENCE() asm volatile("" ::: "memory")
    bf16x8 ktf[2][UG]; f32x4 dlv[2][UG];
#define CU_LDU(g_, sl_) do { _Pragma("unroll") for (int u_ = 0; u_ < UG; ++u_) { const int mb_ = (g_) * UG + u_; \
        dlv[sl_][u_] = *(const LAS f32x4*)(sb + ODL + (16 * mb_ + 4 * q) * 4); ktf[sl_][u_] = __builtin_bit_cast(bf16x8, *(const LAS u32x4*)(sb + OKT + (16 * mb_ + n) * 64 + 16 * qs)); } } while (0)
#define CU_SBF(ks_) __builtin_bit_cast(bf16x8, (u32x4){cvt_pk_bf16(S[2 * (ks_)][0], S[2 * (ks_)][1]), cvt_pk_bf16(S[2 * (ks_)][2], S[2 * (ks_)][3]), cvt_pk_bf16(S[2 * (ks_) + 1][0], S[2 * (ks_) + 1][1]), cvt_pk_bf16(S[2 * (ks_) + 1][2], S[2 * (ks_) + 1][3])})
    const int qs = q ^ slot_swz(n);
    const bf16x8 vf8 = __builtin_bit_cast(bf16x8, *(const LAS u32x4*)(sb + OVT + (16 * wave + n) * 64 + 16 * qs));
    if (MODE == 1) {
        const f32x4 zero = (f32x4){0.f, 0.f, 0.f, 0.f};
        bf16x8 qf0[NKS], kf0[NKS], qf1[NKS], kf1[NKS];
#pragma unroll
        for (int ks = 0; ks < NKS; ++ks) { const int c0 = 64 * ks + 16 * q, o0 = n * ROWB + (c0 ^ ((IS_GLA ? ((n >> 1) & 7) : n) << 4));
            qf0[ks] = __builtin_bit_cast(bf16x8, *(const LAS u32x4*)(sb + OQ + o0)); kf0[ks] = __builtin_bit_cast(bf16x8, *(const LAS u32x4*)(sb + OK + o0)); }
        if (!IS_GLA) {
#pragma unroll
            for (int ks = 0; ks < NKS; ++ks) { const int c0 = 64 * ks + 16 * q, o1 = (16 + n) * ROWB + (c0 ^ (n << 4));
                qf1[ks] = __builtin_bit_cast(bf16x8, *(const LAS u32x4*)(sb + OQ + o1)); kf1[ks] = __builtin_bit_cast(bf16x8, *(const LAS u32x4*)(sb + OK + o1)); }
        }
        CU_FENCE();
        {
            f32x4 ao = zero, ao1 = zero, ap = zero, ap1 = zero;
#pragma unroll
            for (int ks = 0; ks < NKS; ++ks) { const bf16x8 sbf = CU_SBF(ks);
                if (ks & 1) { ao1 = __builtin_amdgcn_mfma_f32_16x16x32_bf16(qf0[ks], sbf, ao1, 0, 0, 0); ap1 = __builtin_amdgcn_mfma_f32_16x16x32_bf16(kf0[ks], qf0[ks], ap1, 0, 0, 0); }
                else { ao = __builtin_amdgcn_mfma_f32_16x16x32_bf16(qf0[ks], sbf, ao, 0, 0, 0); ap = __builtin_amdgcn_mfma_f32_16x16x32_bf16(kf0[ks], qf0[ks], ap, 0, 0, 0); } }
            if (IS_GLA) {
#pragma unroll
                for (int ks = 0; ks < NKS; ++ks) { const int c0 = 64 * ks + 16 * q, o1 = (16 + n) * ROWB + (c0 ^ (((n >> 1) & 7) << 4));
                    qf1[ks] = __builtin_bit_cast(bf16x8, *(const LAS u32x4*)(sb + OQ + o1)); kf1[ks] = __builtin_bit_cast(bf16x8, *(const LAS u32x4*)(sb + OK + o1)); }
                CU_FENCE();
            }
            ao = ao + ao1; ap = ap + ap1;
#pragma unroll
            for (int r = 0; r < 4; ++r) if (4 * q + r > n) ap[r] = 0.f;
            const bf16x8 pa = __builtin_bit_cast(bf16x8, (u32x4){cvt_pk_bf16(ap[0], ap[1]), cvt_pk_bf16(ap[2], ap[3]), 0u, 0u});
            ao = __builtin_amdgcn_mfma_f32_16x16x32_bf16(pa, vf8, ao, 0, 0, 0);
#pragma unroll
            for (int r = 0; r < 4; ++r) op[(size_t)(4 * q + r) * OW] = ao[r];
        }
        CU_LDU(0, 0);
        CU_FENCE();
        {
            f32x4 ao = zero, ao1 = zero, ap = zero, ap1 = zero, ax = zero, ax1 = zero;
#pragma unroll
            for (int ks = 0; ks < NKS; ++ks) { const bf16x8 sbf = CU_SBF(ks);
                if (ks & 1) { ao1 = __builtin_amdgcn_mfma_f32_16x16x32_bf16(qf1[ks], sbf, ao1, 0, 0, 0); ax1 = __builtin_amdgcn_mfma_f32_16x16x32_bf16(kf0[ks], qf1[ks], ax1, 0, 0, 0); ap1 = __builtin_amdgcn_mfma_f32_16x16x32_bf16(kf1[ks], qf1[ks], ap1, 0, 0, 0); }
                else { ao = __builtin_amdgcn_mfma_f32_16x16x32_bf16(qf1[ks], sbf, ao, 0, 0, 0); ax = __builtin_amdgcn_mfma_f32_16x16x32_bf16(kf0[ks], qf1[ks], ax, 0, 0, 0); ap = __builtin_amdgcn_mfma_f32_16x16x32_bf16(kf1[ks], qf1[ks], ap, 0, 0, 0); } }
            if (NUG > 1) { CU_LDU(1, 1); CU_FENCE(); }
            ao = ao + ao1; ap = ap + ap1; ax = ax + ax1;
#pragma unroll
            for (int r = 0; r < 4; ++r) if (4 * q + r > n) ap[r] = 0.f;
            const bf16x8 pa = __builtin_bit_cast(bf16x8, (u32x4){cvt_pk_bf16(ax[0], ax[1]), cvt_pk_bf16(ax[2], ax[3]), cvt_pk_bf16(ap[0], ap[1]), cvt_pk_bf16(ap[2], ap[3])});
            ao = __builtin_amdgcn_mfma_f32_16x16x32_bf16(pa, vf8, ao, 0, 0, 0);
#pragma unroll
            for (int r = 0; r < 4; ++r) op[(size_t)(16 + 4 * q + r) * OW] = ao[r];
        }
    } else {
        CU_LDU(0, 0);
        if (NUG > 1) CU_LDU(1, 1);
        CU_FENCE();
    }
#pragma unroll
    for (int g = 0; g < NUG; ++g) {
#pragma unroll
        for (int u = 0; u < UG; ++u) { const int mb = g * UG + u; S[mb] = __builtin_amdgcn_mfma_f32_16x16x32_bf16(ktf[g & 1][u], vf8, S[mb] * dlv[g & 1][u], 0, 0, 0); }
        if (g + 2 < NUG) { CU_LDU(g + 2, g & 1); CU_FENCE(); }
    }
#undef CU_FENCE
#undef CU_LDU
#undef CU_SBF
}
constexpr size_t ST_REC = 98304;
constexpr int NSEG_HG = 4, NSEG_GL = 6, NSEG_MAX = 6;
__device__ __forceinline__ int seg_u0(bool gla, int s) { return gla ? (s <= 2 ? 44 * s : 88 + 42 * (s - 2)) : 64 * s; }
__device__ __forceinline__ int seg_nu(bool gla, int s) { return gla ? (s < 2 ? 44 : 42) : 64; }
template <int DK, int MODE>
__device__ __forceinline__ void chain_item(const GAS unsigned char* blk0, int vt_off, GAS float* op0, GAS unsigned char* st, int seg, int nunits, LAS unsigned char* lds, int wave, int lane) {
    asm volatile("" : "+v"(lane), "+s"(wave));
    constexpr bool IS_GLA = (DK == 192);
    constexpr int BLK = IS_GLA ? GL_BLK : HG_BLK, UNITB = IS_GLA ? GL_SHARED + 8192 : HG_BLK, NMB = DK / 16;
    constexpr int SH0 = MODE == 1 ? 0 : (IS_GLA ? GL_OKT : HG_OKT);
    constexpr int SH_PIECES = (MODE == 1 ? (IS_GLA ? GL_SHARED : HG_BLK) : (IS_GLA ? GL_ODL + 768 - GL_OKT : HG_BLK - HG_OKT)) / 16;
    constexpr int T_PIECES = IS_GLA ? 512 : 0, T_LDS = GL_OVT;
    constexpr int PIECES = SH_PIECES + T_PIECES, NP = (PIECES + 511) / 512;
    constexpr int ODL_ = IS_GLA ? GL_ODL : HG_ODL;
    const int tid = wave * 64 + lane, n = lane & 15, q = lane >> 4;
    f32x4 S[NMB]; float dacc = 1.0f;
#pragma unroll
    for (int mb = 0; mb < NMB; ++mb) S[mb] = (f32x4){0.f, 0.f, 0.f, 0.f};
    if (MODE == 1) {
        for (int s = 0; s < seg; ++s) { const GAS unsigned char* rec = st + (size_t)s * 2 * ST_REC + (size_t)(wave * 64 + lane) * 16;
            f32x4 hh[NMB], dd[NMB];
#pragma unroll
            for (int mb = 0; mb < NMB; ++mb) { hh[mb] = *(const GAS f32x4*)(rec + (size_t)mb * 8192); dd[mb] = *(const GAS f32x4*)(st + (size_t)s * 2 * ST_REC + ST_REC + (16 * mb + 4 * q) * 4); }
            asm volatile("" ::: "memory");
#pragma unroll
            for (int mb = 0; mb < NMB; ++mb) S[mb] = S[mb] * dd[mb] + hh[mb]; }
    }
    u32x4 stgA[NP], stgB[NP];
#define CH_SRC(u, p_) (blk0 + (size_t)(u) * BLK + ((p_) < SH_PIECES ? SH0 + (p_) * 16 : vt_off + ((p_) - SH_PIECES) * 16))
#define CH_DST(p_) ((p_) < SH_PIECES ? SH0 + (p_) * 16 : T_LDS + ((p_) - SH_PIECES) * 16)
#define CH_LOAD(stg, u) do { _Pragma("unroll") for (int r_ = 0; r_ < NP; ++r_) { const int p_ = r_ * 512 + tid; const bool ok_ = (NP * 512 == PIECES) || p_ < PIECES; const int pc_ = ok_ ? p_ : 0; stg[r_] = *(const GAS u32x4*)CH_SRC(u, pc_); } } while (0)
#define CH_STORE(stg, buf) do { _Pragma("unroll") for (int r_ = 0; r_ < NP; ++r_) { const int p_ = r_ * 512 + tid; const bool ok_ = (NP * 512 == PIECES) || p_ < PIECES; const int pc_ = ok_ ? p_ : 0; \
        const int d_ = ok_ ? (buf) * UNITB + CH_DST(pc_) : 2 * UNITB + (p_ - PIECES) * 16; *(LAS u32x4*)(lds + d_) = stg[r_]; } } while (0)
#define CH_SYNC() do { asm volatile("s_waitcnt lgkmcnt(0)" ::: "memory"); __builtin_amdgcn_s_barrier(); asm volatile("" ::: "memory"); } while (0)
    CH_LOAD(stgA, 0); CH_STORE(stgA, 0);
    CH_LOAD(stgA, 1);
    CH_SYNC();
    GAS float* op = op0 + 16 * wave + n;
    for (int u = 0; u < nunits; u += 2) {
        if (u + 2 < nunits) CH_LOAD(stgB, u + 2);
        chain_unit<DK, MODE>(lds, S, op + (size_t)(u * 32) * OW, wave, n, q);
        if (MODE == 0 && tid < DK) dacc *= *(const LAS float*)(lds + ODL_ + 4 * tid);
        CH_STORE(stgA, 1);
        CH_SYNC();
        if (u + 3 < nunits) CH_LOAD(stgA, u + 3);
        chain_unit<DK, MODE>(lds + UNITB, S, op + (size_t)(u * 32 + 32) * OW, wave, n, q);
        if (MODE == 0 && tid < DK) dacc *= *(const LAS float*)(lds + UNITB + ODL_ + 4 * tid);
        if (u + 2 < nunits) CH_STORE(stgB, 0);
        CH_SYNC();
    }
    if (MODE == 0) { GAS unsigned char* rec = st + (size_t)seg * 2 * ST_REC + (size_t)(wave * 64 + lane) * 16;
#pragma unroll
        for (int mb = 0; mb < NMB; ++mb) *(GAS f32x4*)(rec + (size_t)mb * 8192) = S[mb];
        if (tid < DK) *(GAS float*)(st + (size_t)seg * 2 * ST_REC + ST_REC + 4 * tid) = dacc; }
#undef CH_SRC
#undef CH_DST
#undef CH_LOAD
#undef CH_STORE
#undef CH_SYNC
}

template <int MODE>
__device__ __forceinline__ void phase_chain(const Ctx& a, int l, LAS unsigned char* lds, int wave, int lane) {
    const int bx = blockIdx.x, G = gridDim.x;
    constexpr int nhg = 24 * (MODE == 0 ? NSEG_HG - 1 : NSEG_HG), nitems = nhg + 24 * (MODE == 0 ? NSEG_GL - 1 : NSEG_GL);
    for (int it = bx; it < nitems; it += G) {
        const bool gla = it >= nhg; const int j = gla ? it - nhg : it, c = j % 24, seg = j / 24, u0 = seg_u0(gla, seg), nu = seg_nu(gla, seg);
        GAS unsigned char* st = a.ws() + WS_ST + (size_t)(gla ? 24 + c : c) * (NSEG_MAX - 1) * 2 * ST_REC;
        if (!gla) { const int b = c / 12, h = c % 12;
            chain_item<128, MODE>(a.ws() + WS_HGB + ((size_t)(b * 12 + h) * NUNIT + u0) * HG_BLK, 0, (GAS float*)(a.ws() + WS_O) + ((size_t)b * SEQ + u0 * 32) * OW + h * 128, st, seg, nu, lds, wave, lane); }
        else { const int b = c / 12, h = (c % 12) / 3, sl = c % 3;
            chain_item<192, MODE>(a.ws() + WS_GLB + ((size_t)(b * 4 + h) * NUNIT + u0) * GL_BLK, GL_OVT + 8192 * sl, (GAS float*)(a.ws() + WS_O) + ((size_t)b * SEQ + u0 * 32) * OW + HGW + h * 384 + sl * 128, st, seg, nu, lds, wave, lane); }
        __syncthreads();
    }
    if (MODE == 0) { for (int it = (G >= nitems + 16) ? bx - nitems : bx; it < 16; it += G) { if (it < 0) continue; s5_scan_item(a, l, it, wave, lane); } }
}
__device__ __forceinline__ float red16(float v) {
    v += __int_as_float(__builtin_amdgcn_mov_dpp(__float_as_int(v), 0xB1, 0xF, 0xF, true)); v += __int_as_float(__builtin_amdgcn_mov_dpp(__float_as_int(v), 0x4E, 0xF, 0xF, true));
    v += __int_as_float(__builtin_amdgcn_mov_dpp(__float_as_int(v), 0x141, 0xF, 0xF, true)); v += __int_as_float(__builtin_amdgcn_mov_dpp(__float_as_int(v), 0x140, 0xF, 0xF, true)); return v; }
__device__ __forceinline__ void phase_finalize(const Ctx& a, int l, int wave, int lane) {
    const GAS bf16_t* P = (const GAS bf16_t*)(a.ws() + WS_P); const GAS float* O = (const GAS float*)(a.ws() + WS_O); GAS bf16_t* MX = (GAS bf16_t*)(a.ws() + WS_MIXED);
    const GAS float* hgg = a.in(I_HGG) + l * HGW; const GAS float* hgb = a.in(I_HGB) + l * HGW; const GAS float* glg = a.in(I_GLG) + l * HGW;
    const int gw = blockIdx.x * 8 + wave, NGW = gridDim.x * 8;
    const bool act = lane < 48;
    f32x4 pg[3][2], pb[3][2], qg[4][2];
#pragma unroll
    for (int it = 0; it < 3; ++it) { const int c = (it * 4 + (lane >> 4)) * 128 + (lane & 15) * 8;
        pg[it][0] = *(const GAS f32x4*)(hgg + c); pg[it][1] = *(const GAS f32x4*)(hgg + c + 4); pb[it][0] = *(const GAS f32x4*)(hgb + c); pb[it][1] = *(const GAS f32x4*)(hgb + c + 4); }
#pragma unroll
    for (int h = 0; h < 4; ++h) { const int c = h * 384 + (act ? lane : 0) * 8; qg[h][0] = *(const GAS f32x4*)(glg + c); qg[h][1] = *(const GAS f32x4*)(glg + c + 4); }
    for (int row = gw; row < MTOK; row += NGW) {
        const GAS float* orow = O + (size_t)row * OW; const GAS bf16_t* prow = P + (size_t)row * INP; GAS bf16_t* mrow = MX + (size_t)row * DM;
        f32x4 o0[7], o1[7]; u32x4 gq[7];
#pragma unroll
        for (int it = 0; it < 3; ++it) { const int c = (it * 4 + (lane >> 4)) * 128 + (lane & 15) * 8;
            o0[it] = *(const GAS f32x4*)(orow + c); o1[it] = *(const GAS f32x4*)(orow + c + 4); gq[it] = *(const GAS u32x4*)(prow + C_GB + c); }
#pragma unroll
        for (int h = 0; h < 4; ++h) { const int c = h * 384 + (act ? lane : 0) * 8;
            o0[3 + h] = *(const GAS f32x4*)(orow + HGW + c); o1[3 + h] = *(const GAS f32x4*)(orow + HGW + c + 4); gq[3 + h] = *(const GAS u32x4*)(prow + C_GC + c); }
        asm volatile("" ::: "memory");
#pragma unroll
        for (int it = 0; it < 3; ++it) { const int c = (it * 4 + (lane >> 4)) * 128 + (lane & 15) * 8; const u32x4 gg = gq[it];
            float v[8] = {sigmoidf_(bf_lo(gg.x)) * o0[it][0], sigmoidf_(bf_hi(gg.x)) * o0[it][1], sigmoidf_(bf_lo(gg.y)) * o0[it][2], sigmoidf_(bf_hi(gg.y)) * o0[it][3],
                          sigmoidf_(bf_lo(gg.z)) * o1[it][0], sigmoidf_(bf_hi(gg.z)) * o1[it][1], sigmoidf_(bf_lo(gg.w)) * o1[it][2], sigmoidf_(bf_hi(gg.w)) * o1[it][3]};
            float s = 0.f, ss = 0.f;
#pragma unroll
            for (int i = 0; i < 8; ++i) { s += v[i]; ss += v[i] * v[i]; }
            s = red16(s); ss = red16(ss);
            const float mu = s * (1.0f / 128.0f), rs = 1.0f / sqrtf(fmaxf(ss * (1.0f / 128.0f) - mu * mu, 0.f) + LN_EPS);
            const f32x4 g0 = pg[it][0], g1 = pg[it][1], b0 = pb[it][0], b1 = pb[it][1];
            u32x4 w; w.x = cvt_pk_bf16((v[0] - mu) * rs * g0[0] + b0[0], (v[1] - mu) * rs * g0[1] + b0[1]); w.y = cvt_pk_bf16((v[2] - mu) * rs * g0[2] + b0[2], (v[3] - mu) * rs * g0[3] + b0[3]);
            w.z = cvt_pk_bf16((v[4] - mu) * rs * g1[0] + b1[0], (v[5] - mu) * rs * g1[1] + b1[1]); w.w = cvt_pk_bf16((v[6] - mu) * rs * g1[2] + b1[2], (v[7] - mu) * rs * g1[3] + b1[3]);
            *(GAS u32x4*)(mrow + S5W + c) = w; }
#pragma unroll
        for (int h = 0; h < 4; ++h) { const int c = h * 384 + lane * 8;
            f32x4 p0 = o0[3 + h], p1 = o1[3 + h]; const u32x4 gg = gq[3 + h];
            if (!act) { p0 = (f32x4){0.f, 0.f, 0.f, 0.f}; p1 = p0; }
            const float ss = wave_sum((p0[0] * p0[0] + p0[1] * p0[1]) + (p0[2] * p0[2] + p0[3] * p0[3]) + (p1[0] * p1[0] + p1[1] * p1[1]) + (p1[2] * p1[2] + p1[3] * p1[3]));
            const float rms = 1.0f / sqrtf(ss * (1.0f / 384.0f) + LN_EPS);
            if (act) { const f32x4 g0 = qg[h][0], g1 = qg[h][1];
                const float z[8] = {bf_lo(gg.x), bf_hi(gg.x), bf_lo(gg.y), bf_hi(gg.y), bf_lo(gg.z), bf_hi(gg.z), bf_lo(gg.w), bf_hi(gg.w)};
                u32x4 w; w.x = cvt_pk_bf16(p0[0] * rms * g0[0] * (z[0] * sigmoidf_(z[0])), p0[1] * rms * g0[1] * (z[1] * sigmoidf_(z[1])));
                w.y = cvt_pk_bf16(p0[2] * rms * g0[2] * (z[2] * sigmoidf_(z[2])), p0[3] * rms * g0[3] * (z[3] * sigmoidf_(z[3])));
                w.z = cvt_pk_bf16(p1[0] * rms * g1[0] * (z[4] * sigmoidf_(z[4])), p1[1] * rms * g1[1] * (z[5] * sigmoidf_(z[5])));
                w.w = cvt_pk_bf16(p1[2] * rms * g1[2] * (z[6] * sigmoidf_(z[6])), p1[3] * rms * g1[3] * (z[7] * sigmoidf_(z[7])));
                *(GAS u32x4*)(mrow + S5W + HGW + c) = w; } }
    }
}

constexpr int PH_PRO = 0, PH_MOD = 1, PH_LN0 = 2, PH_L0 = 3, PH_PER_LAYER = 10, N_PHASES = PH_L0 + DEPTH * PH_PER_LAYER;
constexpr int CW_BAR = 4096;

__global__ void __launch_bounds__(512, 2) hybrid_fwd(Args args) {
    extern __shared__ __attribute__((aligned(16))) unsigned char lds_raw[];
    LAS unsigned char* lds = (LAS unsigned char*)lds_raw;
    const int wave = __builtin_amdgcn_readfirstlane((int)threadIdx.x >> 6);
#define lane lane_id_v()
    volatile LAS unsigned* MISC = (volatile LAS unsigned*)(lds + LDSCTL_OFF);
    Ctx ctx; ctx.t = (volatile LAS unsigned long long*)(lds + LDSCTL_OFF + 64);
    if (wave == 0) { const int ln_ = lane; unsigned long long v = 0ull;
#pragma unroll
        for (int i = 0; i < N_IN; ++i) v = (ln_ == i) ? (unsigned long long)args.in[i] : v;
        v = (ln_ == 30) ? (unsigned long long)args.out : v; v = (ln_ == 31) ? (unsigned long long)args.ws : v;
        if (ln_ < 32) ctx.t[ln_] = v;
        if (ln_ < 16) MISC[ln_] = 0u; }
    __syncthreads();
    const int lo = args.ph_lo, hi = args.ph_hi;
    XcdBarrier bar; bar.bar = (unsigned*)(ctx.ws() + WS_CTL) + CW_BAR; bar.x = 0; bar.st = nullptr; bar.w0 = (wave == 0) ? 1u : 0u;
    if (hi - lo > 1) bar = xcd_barrier_post((unsigned*)(ctx.ws() + WS_CTL) + CW_BAR, MISC + 8, (wave == 0) ? 1u : 0u);
#define IN(k) (lo <= (k) && (k) < hi)
#define OPQ() int ln = lane, wv = wave; asm volatile("" : "+s"(wv))
#define SEAM(k) do { if (IN(k) && IN((k) + 1)) xcd_barrier(bar); } while (0)
#define WSP(T, off) ((GAS T*)(ctx.ws() + (off)))
#define WSG(T, off) ((T*)(ctx.ws() + (off)))

    if (IN(PH_PRO)) { OPQ(); phase_prologue(ctx, lds, wv, ln); }
    SEAM(PH_PRO);
    if (IN(PH_MOD)) { OPQ(); phase_mod(ctx, wv, ln); }
    SEAM(PH_MOD);
    if (IN(PH_LN0)) { OPQ(); phase_h0(ctx.in(I_X), WSP(float, WS_MOD), WSP(bf16_t, WS_H), wv, ln); }
    SEAM(PH_LN0);

    for (int l = 0; l < DEPTH; ++l) {
        const int p0 = PH_L0 + l * PH_PER_LAYER;
        const size_t wto = WS_WT + (size_t)l * WT_LAYER, modo = WS_MOD + (size_t)l * NB * 6 * DM * 4;
        if (IN(p0 + 0)) { pg8::Gemm g{WSG(bf16_t, WS_H), WSG(const bf16_t, wto + WT_IN), MTOK, INP, DM}; pg8::StaticOrder S; S.init(MTOK, INP, (int)gridDim.x, (int)blockIdx.x);
            EpiProj E{WSP(bf16_t, WS_P), WSP(bf16_t, WS_UX)}; pg8::gemm_phase<EpiProj, pg8::StaticOrder, true, true>(lds, g, S, E, wave); }
        SEAM(p0 + 0);
        if (IN(p0 + 1)) {
            { pg8::Gemm g{WSG(bf16_t, WS_UX), WSG(const bf16_t, WS_S5W1 + (size_t)l * S5_W1_LAYER), 64 * 256, 64 * 256, S5K}; S5Order S{(int)gridDim.x, (int)blockIdx.x, 64, 0};
              EpiS5A E{WSP(float, WS_SLOC)}; pg8::gemm_phase<EpiS5A, S5Order, true, true>(lds, g, S, E, wave); }
            { OPQ(); phase_pre(ctx, l, lds, wv, ln); }
            }
        SEAM(p0 + 1);
        if (IN(p0 + 2)) { OPQ(); phase_chain<0>(ctx, l, lds, wv, ln); }
        SEAM(p0 + 2);
        if (IN(p0 + 3)) {
            { pg8::Gemm g{WSG(bf16_t, WS_UX), WSG(const bf16_t, WS_S5T + (size_t)l * S5_T_LAYER), 64 * 256, 64 * 1024, S5K}; S5Order S{(int)gridDim.x, (int)blockIdx.x, 256, 2};
              EpiS5C E{WSP(bf16_t, WS_Z)}; pg8::gemm_phase<EpiS5C, S5Order, true, true>(lds, g, S, E, wave); }
            { OPQ(); phase_chain<1>(ctx, l, lds, wv, ln); }
            }
        SEAM(p0 + 3);
        if (IN(p0 + 4)) { pg8::Gemm g{WSG(bf16_t, WS_Z), WSG(const bf16_t, wto + WT_GLU), MTOK, S5W, S5W}; pg8::StaticOrder S; S.init(MTOK, S5W, (int)gridDim.x, (int)blockIdx.x);
            EpiGlu E{WSP(bf16_t, WS_Z), WSP(bf16_t, WS_MIXED), ctx.in(I_GLUB) + l * S5W}; pg8::gemm_phase<EpiGlu, pg8::StaticOrder, true, true>(lds, g, S, E, wave);
            { OPQ(); phase_finalize(ctx, l, wv, ln); } }
        SEAM(p0 + 4);
        if (IN(p0 + 5)) { pg8::Gemm g{WSG(bf16_t, WS_MIXED), WSG(const bf16_t, wto + WT_OUT), MTOK, DM, DM}; pg8::StaticOrder S; S.init(MTOK, DM, (int)gridDim.x, (int)blockIdx.x);
            EpiDelta E{WSP(bf16_t, WS_DELTA), WSP(float, modo) + 2 * DM};
            pg8::gemm_phase<EpiDelta, pg8::StaticOrder, true, true>(lds, g, S, E, wave); }
        SEAM(p0 + 5);
        if (IN(p0 + 6)) { OPQ(); const XRes xa{(GAS unsigned*)ctx.out(), WSP(unsigned, WS_XL)}, xb{l + 1 < DEPTH ? (GAS unsigned*)ctx.out() : WSP(unsigned, WS_WT), WSP(unsigned, WS_XL)};
            if (l == 0) phase_lnres<true, true, false>(ctx.in(I_X), xa, WSP(bf16_t, WS_DELTA), nullptr, xb, ctx.in(I_LN1G) + l * DM, ctx.in(I_LN1B) + l * DM, WSP(float, modo), 3, 4, WSP(bf16_t, WS_H), lds, wv, ln);
            else phase_lnres<true, false, false>(nullptr, xa, WSP(bf16_t, WS_DELTA), nullptr, xb, ctx.in(I_LN1G) + l * DM, ctx.in(I_LN1B) + l * DM, WSP(float, modo), 3, 4, WSP(bf16_t, WS_H), lds, wv, ln); }
        SEAM(p0 + 6);
        if (IN(p0 + 7)) { pg8::Gemm g{WSG(bf16_t, WS_H), WSG(const bf16_t, wto + WT_GU), MTOK, 2 * DFF, DM}; pg8::StaticOrder S; S.init(MTOK, 2 * DFF, (int)gridDim.x, (int)blockIdx.x);
            EpiSwiglu E{WSP(bf16_t, WS_P)}; pg8::gemm_phase<EpiSwiglu, pg8::StaticOrder, true, true>(lds, g, S, E, wave); }
        SEAM(p0 + 7);
        if (IN(p0 + 8)) { pg8::Gemm g{WSG(bf16_t, WS_P), WSG(const bf16_t, wto + WT_DN), MTOK, DM, DFF}; pg8::StaticOrder S; S.init(MTOK, DM, (int)gridDim.x, (int)blockIdx.x);
            EpiDelta E{WSP(bf16_t, WS_DELTA), WSP(float, modo) + 5 * DM};
            pg8::gemm_phase<EpiDelta, pg8::StaticOrder, true, true>(lds, g, S, E, wave); }
        SEAM(p0 + 8);
        if (IN(p0 + 9)) { OPQ();
            const XRes xb{l + 1 < DEPTH ? (GAS unsigned*)ctx.out() : WSP(unsigned, WS_WT), WSP(unsigned, WS_XL)};
            if (l + 1 < DEPTH) phase_lnres<true, false, false>(nullptr, xb, WSP(bf16_t, WS_DELTA), nullptr, xb, ctx.in(I_LN2G) + l * DM, ctx.in(I_LN2B) + l * DM, WSP(float, modo) + (size_t)NB * 6 * DM, 0, 1, WSP(bf16_t, WS_H), lds, wv, ln);
            else phase_lnres<false, false, true>(nullptr, xb, WSP(bf16_t, WS_DELTA), ctx.out(), xb, ctx.in(I_LN2G) + l * DM, ctx.in(I_LN2B) + l * DM, nullptr, 0, 0, nullptr, lds, wv, ln);
        }
        SEAM(p0 + 9);
    }
#undef IN
#undef SEAM
#undef OPQ
#undef WSP
#undef WSG
#undef lane
}

extern "C" void kernel_launch(void* const* d_in, const int* in_sizes, int n_in, void* d_out, int out_size, void* d_ws, size_t ws_size, hipStream_t stream) {
    static int grid = 0;
    if (grid == 0) {
        if (n_in != N_IN || out_size != MTOK * DM || ws_size < WS_END) { fprintf(stderr, "kernel_launch: unexpected problem (n_in %d, out %d, ws %zu < %zu); nothing launched\n", n_in, out_size, ws_size, (size_t)WS_END); grid = -1; return; }
        int dev = 0, cus = 0, per_cu = 0;
        if (hipGetDevice(&dev) != hipSuccess || hipDeviceGetAttribute(&cus, hipDeviceAttributeMultiprocessorCount, dev) != hipSuccess) { grid = -1; return; }
        if (hipFuncSetAttribute((const void*)hybrid_fwd, hipFuncAttributeMaxDynamicSharedMemorySize, LDS_BYTES) != hipSuccess) { fprintf(stderr, "kernel_launch: hipFuncSetAttribute failed\n"); grid = -1; return; }
        if (hipOccupancyMaxActiveBlocksPerMultiprocessor(&per_cu, (const void*)hybrid_fwd, 512, LDS_BYTES) != hipSuccess || per_cu < 1) fprintf(stderr, "kernel_launch: occupancy query reports %d blocks per CU\n", per_cu);
        (void)hipGetLastError();
        grid = cus;
    }
    if (grid < 0) return;
    (void)in_sizes;
    if (hipMemsetAsync((char*)d_ws + WS_CTL, 0, CTL_ZERO_BYTES, stream) != hipSuccess) return;
    Args a{};
    for (int i = 0; i < N_IN; ++i) a.in[i] = (const float*)d_in[i];
    a.out = (float*)d_out; a.ws = (unsigned char*)d_ws;
    a.ph_lo = 0; a.ph_hi = N_PHASES; hipLaunchKernelGGL(hybrid_fwd, dim3(grid), dim3(512), LDS_BYTES, stream, a);
}
```

```cpp
#include <hip/hip_runtime.h>
#include <cstdio>
#include <cstdint>
namespace pg8 {
#define PG8_LAS __attribute__((address_space(3)))
typedef unsigned short bf16_t;
typedef short bf16x8 __attribute__((ext_vector_type(8)));
typedef float f32x4 __attribute__((ext_vector_type(4)));
typedef unsigned u32x4 __attribute__((ext_vector_type(4)));
constexpr int BM = 256, BK = 64, HALF = 128, HTB = HALF * BK * 2  , STAGE_BYTES = 8 * HTB, NXCD = 8, WGM = 8;

__host__ __device__ __forceinline__ int lds_byte(int r, int c) { const int st = (r >> 4) * 2 + (c >> 5), rr = r & 15, cc = c & 31, ob = rr * 64 + cc * 2; return st * 1024 + (ob ^ (((ob >> 9) & 1) << 5)); }
__host__ __device__ __forceinline__ void stage_rc(int b, int& R, int& C) { const int st = b / 1024, sb = b % 1024, swz = sb ^ (((sb >> 9) & 1) << 5); R = (st >> 1) * 16 + swz / 64; C = (st & 1) * 32 + (swz % 64) / 2; }
__host__ __device__ __forceinline__ int perm32(int rho) { const int n = rho >> 4, i = rho & 15; return 8 * (i >> 2) + 4 * n + (i & 3); }

struct Unit { int pm, pn; };
struct Gemm { const bf16_t* A; const bf16_t* Bt; int M, N, K; };

template <int WGM_>
struct StaticOrderT {
    static constexpr int WGM = WGM_;
    int nM, nN, nwg, G, c;
    __host__ __device__ void init(int M, int N, int G_, int c_) { nM = M / BM; nN = N / BM; nwg = nM * nN; G = G_; c = c_; }
    __host__ __device__ bool next(int i, Unit& u) const {
        const long L = (long)i * G + c; if (L >= nwg) return false;
        int wgid = (int)L; { const int q = nwg / NXCD, r = nwg % NXCD, xcd = wgid % NXCD, off = wgid / NXCD; wgid = (xcd < r ? xcd * (q + 1) : r * (q + 1) + (xcd - r) * q) + off; }
        const int nig = WGM * nN, gid = wgid / nig, fm = gid * WGM, gsz = (nM - fm) < WGM ? (nM - fm) : WGM;
        u.pm = fm + ((wgid % nig) % gsz); u.pn = (wgid % nig) / gsz; return true;
    }
    __device__ __forceinline__ void a_ready(const Unit&) const {}
    __device__ __forceinline__ void done(const Unit&) const {}
};
typedef StaticOrderT<8> StaticOrder;
__device__ __forceinline__ unsigned cvt_pk_bf16(float lo, float hi) { unsigned r; asm volatile("v_cvt_pk_bf16_f32 %0, %1, %2" : "=v"(r) : "v"(lo), "v"(hi)); return r; }
typedef float f32x2 __attribute__((ext_vector_type(2)));
template <class Epi, class Sched, bool ALIGN_EPI = false, bool SP2 = false>
__device__ __forceinline__ void gemm_phase(PG8_LAS unsigned char* lds, const Gemm g, const Sched& S, const Epi& E, int wave_id) {
    int tid_; asm volatile("v_mbcnt_lo_u32_b32 %0, -1, 0\n\tv_mbcnt_hi_u32_b32 %0, -1, %0" : "=v"(tid_)); tid_ += wave_id * 64;
    const int tid = tid_, wid = __builtin_amdgcn_readfirstlane(tid >> 6), lane = tid & 63, wr = wid >> 2, wc = wid & 3, fr = lane & 15, fq = lane >> 4;
    const int K = g.K, nt = K / BK;
    unsigned voffA[2], voffB[2];
#pragma unroll
    for (int i = 0; i < 2; ++i) { int R, C; stage_rc(tid * 16 + i * 8192, R, C); const int Rb = Epi::PERM ? ((R & ~31) + perm32(R & 31)) : R;
        voffA[i] = (unsigned)(R * K + C) * 2u; voffB[i] = (unsigned)(Rb * K + C) * 2u; }
    const size_t kstep = (size_t)(BK * 2);
    const size_t hstep = (size_t)HALF * K * 2;
    const size_t tstep = 2 * hstep;
    const unsigned ldsw = (unsigned)wid * 1024u;
    const int aoff = lds_byte(wr * 64 + fr, fq * 8), boff = lds_byte(wc * 32 + fr, fq * 8);
#define PG8_SA(b, h) (((b) * 2 + (h)) * HTB)
#define PG8_SB(b, h) ((4 + (b) * 2 + (h)) * HTB)
#define PG8_STAGE(bufoff, gbase, voff) do { _Pragma("unroll") for (int _i = 0; _i < 2; ++_i) \
        __builtin_amdgcn_global_load_lds((const unsigned*)((const char*)(gbase) + (voff)[_i]), (PG8_LAS unsigned*)(lds + (bufoff) + ldsw + _i * 8192), 16, 0, 0); } while (0)
#define PG8_LDA(dst, b, h) do { _Pragma("unroll") for (int m = 0; m < 4; ++m) _Pragma("unroll") for (int k = 0; k < 2; ++k) dst[m][k] = *(const PG8_LAS bf16x8*)(lds + PG8_SA(b, h) + aoff + m * 2048 + k * 1024); } while (0)
#define PG8_LDB(dst, b, h) do { _Pragma("unroll") for (int n = 0; n < 2; ++n) _Pragma("unroll") for (int k = 0; k < 2; ++k) dst[n][k] = *(const PG8_LAS bf16x8*)(lds + PG8_SB(b, h) + boff + n * 2048 + k * 1024); } while (0)
#define PG8_MMA(ai, bj, At, Bt) do { __builtin_amdgcn_s_setprio(1); _Pragma("unroll") for (int m = 0; m < 4; ++m) _Pragma("unroll") for (int n = 0; n < 2; ++n) _Pragma("unroll") for (int k = 0; k < 2; ++k) \
        acc[ai][bj][m][n] = __builtin_amdgcn_mfma_f32_16x16x32_bf16(Bt[n][k], At[m][k], acc[ai][bj][m][n], 0, 0, 0); __builtin_amdgcn_s_setprio(0); } while (0)
#define PG8_WAIT_V(n) asm volatile("s_waitcnt vmcnt(" #n ")" ::: "memory")
#define PG8_WAIT_L(n) asm volatile("s_waitcnt lgkmcnt(" #n ")" ::: "memory")
#define PG8_BAR __builtin_amdgcn_s_barrier()
#define PG8_SCHED __builtin_amdgcn_sched_barrier(0)
    Unit cur, nxt; int ui = 0;
    if (!S.next(0, cur)) return;
    f32x4 acc[2][2][4][2];
#pragma unroll
    for (int a = 0; a < 2; ++a)
#pragma unroll
        for (int b = 0; b < 2; ++b)
#pragma unroll
            for (int m = 0; m < 4; ++m)
#pragma unroll
                for (int n = 0; n < 2; ++n) acc[a][b][m][n] = (f32x4){0.f, 0.f, 0.f, 0.f};
    bf16x8 At[4][2], B0[2][2], B1[2][2];
    const char* cA = (const char*)g.A + (size_t)cur.pm * tstep; const char* cB = (const char*)g.Bt + (size_t)cur.pn * tstep;
    S.a_ready(cur);
    if constexpr (SP2) {
        PG8_STAGE(PG8_SB(0, 0), cB, voffB); PG8_STAGE(PG8_SB(0, 1), cB + hstep, voffB); PG8_STAGE(PG8_SA(0, 0), cA, voffA); PG8_STAGE(PG8_SA(0, 1), cA + hstep, voffA);
        if (wr == 1) PG8_BAR;
        PG8_WAIT_V(2); PG8_BAR;
        PG8_STAGE(PG8_SB(1, 0), cB + kstep, voffB); PG8_STAGE(PG8_SA(1, 0), cA + kstep, voffA); PG8_STAGE(PG8_SB(1, 1), cB + hstep + kstep, voffB);
        PG8_WAIT_V(6); PG8_BAR;
    } else {
        PG8_STAGE(PG8_SB(0, 0), cB, voffB); PG8_STAGE(PG8_SA(0, 0), cA, voffA); PG8_STAGE(PG8_SB(0, 1), cB + hstep, voffB); PG8_STAGE(PG8_SA(0, 1), cA + hstep, voffA);
        if (wr == 1) PG8_BAR;
        PG8_WAIT_V(4); PG8_BAR;
        PG8_STAGE(PG8_SB(1, 0), cB + kstep, voffB); PG8_STAGE(PG8_SA(1, 0), cA + kstep, voffA); PG8_STAGE(PG8_SB(1, 1), cB + hstep + kstep, voffB);
        PG8_WAIT_V(6); PG8_BAR;
    }
    for (;;) {
        const bool has_next = S.next(ui + 1, nxt);
        const char* nA = has_next ? (const char*)g.A + (size_t)nxt.pm * tstep : cA; const char* nB = has_next ? (const char*)g.Bt + (size_t)nxt.pn * tstep : cB;
        for (int t = 0; t < nt; t += 2) {
            const bool last = (t == nt - 2);
            const char* a1 = cA + (size_t)(t + 1) * kstep;
            const char* a2 = last ? nA : cA + (size_t)(t + 2) * kstep; const char* b2 = last ? nB : cB + (size_t)(t + 2) * kstep;
            const char* a3 = a2 + kstep; const char* b3 = b2 + kstep;
            if (last && has_next) S.a_ready(nxt);
            if constexpr (SP2) {
            PG8_LDB(B0, 0, 0); PG8_LDB(B1, 0, 1); PG8_SCHED; PG8_LDA(At, 0, 0); PG8_STAGE(PG8_SA(1, 1), a1 + hstep, voffA);
            PG8_WAIT_V(8); PG8_WAIT_L(0); PG8_BAR; PG8_MMA(0, 0, At, B0); PG8_MMA(0, 1, At, B1); PG8_BAR; PG8_SCHED;
            PG8_LDA(At, 0, 1); PG8_STAGE(PG8_SB(0, 0), b2, voffB); PG8_STAGE(PG8_SB(0, 1), b2 + hstep, voffB); PG8_STAGE(PG8_SA(0, 0), a2, voffA);
            PG8_WAIT_V(8); PG8_WAIT_L(0); PG8_BAR; PG8_MMA(1, 0, At, B0); PG8_MMA(1, 1, At, B1); PG8_BAR; PG8_SCHED;
            PG8_LDB(B0, 1, 0); PG8_LDB(B1, 1, 1); PG8_SCHED; PG8_LDA(At, 1, 0); PG8_STAGE(PG8_SA(0, 1), a2 + hstep, voffA);
            PG8_WAIT_V(8); PG8_WAIT_L(0); PG8_BAR; PG8_MMA(0, 0, At, B0); PG8_MMA(0, 1, At, B1); PG8_BAR; PG8_SCHED;
            PG8_LDA(At, 1, 1); PG8_STAGE(PG8_SB(1, 0), b3, voffB); PG8_STAGE(PG8_SB(1, 1), b3 + hstep, voffB); PG8_STAGE(PG8_SA(1, 0), a3, voffA);
            PG8_WAIT_V(8); PG8_WAIT_L(0); PG8_BAR; PG8_MMA(1, 0, At, B0); PG8_MMA(1, 1, At, B1); PG8_BAR; PG8_SCHED;
            } else {
            PG8_LDB(B0, 0, 0); PG8_SCHED; PG8_LDA(At, 0, 0); PG8_STAGE(PG8_SA(1, 1), a1 + hstep, voffA);
            PG8_WAIT_L(8); PG8_BAR; PG8_WAIT_L(0); PG8_MMA(0, 0, At, B0); PG8_BAR; PG8_SCHED;
            PG8_LDB(B1, 0, 1); PG8_STAGE(PG8_SB(0, 0), b2, voffB);
            PG8_BAR; PG8_WAIT_L(0); PG8_MMA(0, 1, At, B1); PG8_BAR;
            PG8_LDA(At, 0, 1); PG8_STAGE(PG8_SA(0, 0), a2, voffA);
            PG8_BAR; PG8_WAIT_L(0); PG8_MMA(1, 0, At, B0); PG8_BAR; PG8_SCHED;
            PG8_STAGE(PG8_SB(0, 1), b2 + hstep, voffB);
            PG8_WAIT_V(6); PG8_BAR; PG8_MMA(1, 1, At, B1); PG8_BAR;
            PG8_LDB(B0, 1, 0); PG8_SCHED; PG8_LDA(At, 1, 0); PG8_STAGE(PG8_SA(0, 1), a2 + hstep, voffA);
            PG8_WAIT_L(8); PG8_BAR; PG8_WAIT_L(0); PG8_MMA(0, 0, At, B0); PG8_BAR; PG8_SCHED;
            PG8_LDB(B1, 1, 1); PG8_STAGE(PG8_SB(1, 0), b3, voffB);
            PG8_BAR; PG8_WAIT_L(0); PG8_MMA(0, 1, At, B1); PG8_BAR;
            PG8_LDA(At, 1, 1); PG8_STAGE(PG8_SA(1, 0), a3, voffA);
            PG8_BAR; PG8_WAIT_L(0); PG8_MMA(1, 0, At, B0); PG8_BAR; PG8_SCHED;
            PG8_STAGE(PG8_SB(1, 1), b3 + hstep, voffB);
            PG8_WAIT_V(6); PG8_BAR; PG8_MMA(1, 1, At, B1); PG8_BAR;
            }
        }
        if constexpr (ALIGN_EPI) { if (wr == 0) PG8_BAR; }
        if constexpr (!Epi::AFTER_DRAIN) { E(acc, cur, wr, wc, fr, fq); S.done(cur); }
        if (!has_next) break;
#pragma unroll
        for (int a = 0; a < 2; ++a)
#pragma unroll
            for (int b = 0; b < 2; ++b)
#pragma unroll
                for (int m = 0; m < 4; ++m)
#pragma unroll
                    for (int n = 0; n < 2; ++n) acc[a][b][m][n] = (f32x4){0.f, 0.f, 0.f, 0.f};
        cur = nxt; cA = nA; cB = nB; ++ui;
        if constexpr (ALIGN_EPI) { if (wr == 1) PG8_BAR; }
    }
    PG8_WAIT_V(0);
    if constexpr (!ALIGN_EPI) { if (wr == 0) PG8_BAR; }
    PG8_BAR;
    if constexpr (Epi::AFTER_DRAIN) { E.fused(acc, cur, wr, wc, fr, fq, lds, wid, lane); S.done(cur); }
#undef PG8_SA
#undef PG8_SB
#undef PG8_STAGE
#undef PG8_LDA
#undef PG8_LDB
#undef PG8_MMA
#undef PG8_WAIT_V
#undef PG8_WAIT_L
#undef PG8_BAR
#undef PG8_SCHED
}
}
#define LAS __attribute__((address_space(3)))
#define XB_TMO      128
#define XB_XCNT(j)  (256  + 64 * (j))
#define XB_XSUB(j)  (1280 + 64 * (j))
#define XB_XGEN(j)  (2304 + 64 * (j))
#define XB_TOP      3328
#define XB_TOPGEN   3392
#define XCD_BAR_WORDS 3456
#define XB_SPIN_CAP (1u << 24)

__device__ __forceinline__ unsigned xb_ld(unsigned* p)              { return __hip_atomic_load(p, __ATOMIC_RELAXED, __HIP_MEMORY_SCOPE_AGENT); }
__device__ __forceinline__ unsigned xb_add(unsigned* p, unsigned v) { return __hip_atomic_fetch_add(p, v, __ATOMIC_RELAXED, __HIP_MEMORY_SCOPE_AGENT); }
__device__ __forceinline__ unsigned xb_xcc_id() { return (unsigned)__builtin_amdgcn_s_getreg((3 << 11) | 20) & 0xFu; }
#define XB_SPIN(cond, bar) do { unsigned _sp = 0; while (cond) { __builtin_amdgcn_s_sleep(1); \
    if ((++_sp & 255u) == 0u) { if (xb_ld(&(bar)[XB_TMO])) break; if (_sp > XB_SPIN_CAP) { atomicAdd(&(bar)[XB_TMO], 1u); break; } } } } while (0)

struct XcdBarrier {
    unsigned* bar; unsigned x; unsigned w0;
    volatile LAS unsigned* st;
};

__device__ __forceinline__ bool xb_lane0() { unsigned r; asm volatile("v_mbcnt_lo_u32_b32 %0, -1, 0\n\tv_mbcnt_hi_u32_b32 %0, -1, %0" : "=v"(r)); return r == 0u; }
__device__ __forceinline__ XcdBarrier xcd_barrier_post(unsigned* bar, volatile LAS unsigned* st, unsigned w0) {
    XcdBarrier b; b.bar = bar; b.x = xb_xcc_id(); b.st = st; b.w0 = w0;
    if (w0 && xb_lane0()) (void)xb_add(&bar[XB_XCNT(b.x)], 1u);
    return b;
}
__device__ __forceinline__ void xcd_barrier_complete(unsigned* bar, unsigned x, unsigned& nloc, unsigned& nx) {
    const unsigned G = gridDim.x * gridDim.y * gridDim.z;
    unsigned sum, cnt, mine, sp = 0u;
    for (;;) {
        sum = 0u; cnt = 0u; mine = 0u;
#pragma unroll
        for (unsigned j = 0; j < 16; ++j) { const unsigned c = xb_ld(&bar[XB_XCNT(j)]); sum += c; cnt += (c > 0u) ? 1u : 0u; mine = (j == x) ? c : mine; }
        if (sum == G) break;
        __builtin_amdgcn_s_sleep(1);
        if ((++sp & 255u) == 0u) { if (xb_ld(&bar[XB_TMO])) break; if (sp > XB_SPIN_CAP) { atomicAdd(&bar[XB_TMO], 1u); break; } }
    }
    nloc = mine > 0u ? mine : 1u; nx = cnt > 0u ? cnt : 1u;
}

__device__ __forceinline__ void xcd_barrier(const XcdBarrier& b) {
    asm volatile("s_waitcnt vmcnt(0)" ::: "memory");
    __syncthreads();
    if (b.w0 && xb_lane0()) {
        unsigned* bar = b.bar;
        __builtin_amdgcn_s_waitcnt(0);
        unsigned nloc = b.st[0], nx = b.st[1];
        if (nloc == 0u) { xcd_barrier_complete(bar, b.x, nloc, nx); b.st[0] = nloc; b.st[1] = nx; }
        const unsigned old = xb_add(&bar[XB_XSUB(b.x)], 1u);
        const unsigned gen = old / nloc;
        if (old + 1u == (gen + 1u) * nloc) {
            __builtin_amdgcn_fence(__ATOMIC_RELEASE, "agent");
            asm volatile("s_waitcnt vmcnt(0)" ::: "memory");
            const unsigned og = xb_add(&bar[XB_TOP], 1u);
            const unsigned tg = og / nx;
            if (og + 1u == (tg + 1u) * nx) xb_add(&bar[XB_TOPGEN], 1u);
            else XB_SPIN(xb_ld(&bar[XB_TOPGEN]) == tg, bar);
            __builtin_amdgcn_fence(__ATOMIC_ACQUIRE, "agent");
            xb_add(&bar[XB_XGEN(b.x)], 1u);
            asm volatile("s_waitcnt vmcnt(0)" ::: "memory");
        } else {
            XB_SPIN(xb_ld(&bar[XB_XGEN(b.x)]) == gen, bar);
            __builtin_amdgcn_fence(__ATOMIC_ACQUIRE, "agent");
            asm volatile("s_waitcnt vmcnt(0)" ::: "memory");
        }
    }
    __syncthreads();
}

constexpr int DM = 4096, NB = 2, SEQ = 8192, MTOK = NB * SEQ, DEPTH = 4;
constexpr int S5W = 1024;
constexpr int HGW = 1536;
constexpr int GLKW = 768;
constexpr int INW = 11792, INP = 12032, DFF = 11008;
constexpr int OW = 3072;
constexpr int C_U = 0, C_QB = 1024, C_FB = 2560, C_IB = 4096, C_GB = 5632, C_QC = 7168, C_KC = 7936, C_VC = 8704, C_GC = 10240, C_LR = 11776;
constexpr float LN_EPS = 1e-5f;
constexpr float ALPHA = 1.6817928305074290861f;
constexpr float GLA_QSCALE = 0.07216878364870322f;

enum { I_X = 0, I_C, I_WADA, I_BADA, I_TABLE, I_WIN, I_WOUT, I_AREAL, I_AIMAG, I_LOGDT, I_BRE, I_BIM, I_CRE, I_CIM, I_S5D, I_GLUW, I_GLUB,
       I_LBRAW, I_HGG, I_HGB, I_WGATE, I_BGATE, I_GLG, I_WFG, I_WFU, I_WFD, I_LN1G, I_LN1B, I_LN2G, I_LN2B, N_IN };

constexpr size_t MiB = 1u << 20;
constexpr size_t WS_CTL = 0, CTL_ZERO_BYTES = 1 * MiB;
constexpr size_t WS_MOD = 1 * MiB;
constexpr size_t WS_MISC = 2 * MiB;
constexpr size_t WS_CONDPART = 12 * MiB;
constexpr size_t WS_H = 24 * MiB;
constexpr size_t WS_MIXED = WS_H + 128 * MiB;
constexpr size_t WS_Z = WS_MIXED + 128 * MiB;
constexpr size_t WS_O = WS_Z + 32 * MiB;
constexpr size_t WS_DELTA = WS_O;
constexpr size_t WS_P = WS_O + 192 * MiB;
constexpr size_t WS_WT = WS_P + 376 * MiB;
constexpr size_t WT_IN = 0, WT_OUT = 94 * MiB, WT_GU = 126 * MiB, WT_DN = 298 * MiB, WT_GLU = 384 * MiB, WT_LAYER = 386 * MiB;
constexpr size_t WS_HGB = WS_WT + DEPTH * WT_LAYER;
constexpr size_t WS_GLB = WS_HGB + 198 * MiB;
constexpr size_t WS_S5T = WS_GLB + 128 * MiB;
constexpr size_t WS_S5W1 = WS_S5T + 576 * MiB;
constexpr size_t WS_UX = WS_S5W1 + 144 * MiB;
constexpr size_t WS_SLOC = WS_UX + 36 * MiB;
constexpr size_t WS_LAM64 = WS_SLOC + 8 * MiB;
constexpr size_t WS_ST = WS_LAM64 + 1 * MiB;
constexpr size_t WS_XL = WS_ST + 45 * MiB;
constexpr size_t WS_END = WS_XL + 64 * MiB;
static_assert(DEPTH >= 2, "the last layer's residual halves reuse layer 0's weight region");
static_assert((size_t)INP * DM * 2 == 94 * MiB && (size_t)DM * DM * 2 == 32 * MiB && (size_t)2 * DFF * DM * 2 == 172 * MiB && (size_t)DM * DFF * 2 == 86 * MiB, "weight map");
static_assert((size_t)MTOK * INP * 2 == 376 * MiB && (size_t)MTOK * DFF * 2 <= 376 * MiB, "activation map");

constexpr int RING_BYTES = 131072;
constexpr int LDSCTL_OFF = 135168;
constexpr int LDS_BYTES = 147456;

#ifndef LAS
#define LAS __attribute__((address_space(3)))
#endif
#define GAS __attribute__((address_space(1)))
typedef unsigned short bf16_t;
typedef float f32x4 __attribute__((ext_vector_type(4)));
typedef float f32x2 __attribute__((ext_vector_type(2)));
typedef unsigned u32x4 __attribute__((ext_vector_type(4)));
typedef unsigned u32x2 __attribute__((ext_vector_type(2)));
#define LDS_WAIT() asm volatile("s_waitcnt lgkmcnt(0)" ::: "memory")
#define VM_WAIT() asm volatile("s_waitcnt vmcnt(0)" ::: "memory")
typedef __bf16 bf16x2_t __attribute__((ext_vector_type(2)));
__device__ __forceinline__ unsigned cvt_pk_bf16(float lo, float hi) { return __builtin_bit_cast(unsigned, __builtin_convertvector((f32x2){lo, hi}, bf16x2_t)); }

__device__ __forceinline__ float bf_lo(unsigned w) { return __uint_as_float(w << 16); }
__device__ __forceinline__ float bf_hi(unsigned w) { return __uint_as_float(w & 0xffff0000u); }
__device__ __forceinline__ float bf2f(bf16_t b) { return __uint_as_float(((unsigned)b) << 16); }
__device__ __forceinline__ float wave_sum(float v) {
    v += __int_as_float(__builtin_amdgcn_mov_dpp(__float_as_int(v), 0xB1, 0xF, 0xF, true));
    v += __int_as_float(__builtin_amdgcn_mov_dpp(__float_as_int(v), 0x4E, 0xF, 0xF, true));
    v += __int_as_float(__builtin_amdgcn_mov_dpp(__float_as_int(v), 0x141, 0xF, 0xF, true));
    v += __int_as_float(__builtin_amdgcn_mov_dpp(__float_as_int(v), 0x140, 0xF, 0xF, true));
    const int b = __float_as_int(v);
    return (__int_as_float(__builtin_amdgcn_readlane(b, 0)) + __int_as_float(__builtin_amdgcn_readlane(b, 16))) + (__int_as_float(__builtin_amdgcn_readlane(b, 32)) + __int_as_float(__builtin_amdgcn_readlane(b, 48)));
}
__device__ __forceinline__ float sigmoidf_(float x) { return __builtin_amdgcn_rcpf(1.0f + __expf(-x)); }
__device__ __forceinline__ float gelu_tanh(float y) { const float a = 0.7978845608028654f * (y + 0.044715f * y * y * y); const float t = 1.0f - 2.0f * __builtin_amdgcn_rcpf(1.0f + __expf(2.0f * a)); return 0.5f * y * (1.0f + t); }

struct EpiProj {
    static constexpr bool PERM = true, AFTER_DRAIN = false;
    GAS bf16_t* P; GAS bf16_t* UX;
    __device__ __forceinline__ void operator()(const f32x4 (&acc)[2][2][4][2], const pg8::Unit& u, int wr, int wc, int fr, int fq) const {
        const int row0 = u.pm * 256 + wr * 64 + fr, col0 = u.pn * 256 + wc * 32 + 8 * fq;
        const bool s5 = u.pn < 4;
#pragma unroll
        for (int ai = 0; ai < 2; ++ai)
#pragma unroll
            for (int m = 0; m < 4; ++m) { const int row = row0 + ai * 128 + m * 16;
#pragma unroll
                for (int bj = 0; bj < 2; ++bj) { const f32x4 v0 = acc[ai][bj][m][0], v1 = acc[ai][bj][m][1]; const int col = col0 + bj * 128;
                    u32x4 w; w.x = cvt_pk_bf16(v0[0], v0[1]); w.y = cvt_pk_bf16(v0[2], v0[3]); w.z = cvt_pk_bf16(v1[0], v1[1]); w.w = cvt_pk_bf16(v1[2], v1[3]);
                    if (!s5) *(GAS u32x4*)(P + (size_t)row * INP + col) = w;
                    else { GAS bf16_t* ur = UX + (size_t)((col >> 4) * 256 + (row >> 6)) * 1152; *(GAS u32x4*)(ur + (row & 63) * 16 + (col & 15)) = w;
                        if ((row & 63) == 0) { const u32x4 z = (u32x4){0u, 0u, 0u, 0u}; GAS bf16_t* zp = ur + 1024 + ((col & 15) ? 64 : 0);
#pragma unroll
                            for (int i = 0; i < 8; ++i) *(GAS u32x4*)(zp + 8 * i) = z; } } } }
    }
};
struct EpiSwiglu {
    static constexpr bool PERM = true, AFTER_DRAIN = false;
    GAS bf16_t* HID;
    __device__ __forceinline__ void operator()(const f32x4 (&acc)[2][2][4][2], const pg8::Unit& u, int wr, int wc, int fr, int fq) const {
        const int row0 = u.pm * 256 + wr * 64 + fr, col0 = u.pn * 128 + wc * 32 + 8 * fq;
#pragma unroll
        for (int ai = 0; ai < 2; ++ai)
#pragma unroll
            for (int m = 0; m < 4; ++m) { GAS bf16_t* rowp = HID + (size_t)(row0 + ai * 128 + m * 16) * DFF + col0;
                float o[8];
#pragma unroll
                for (int n = 0; n < 2; ++n)
#pragma unroll
                    for (int j = 0; j < 4; ++j) { const float g = acc[ai][0][m][n][j], up = acc[ai][1][m][n][j]; o[n * 4 + j] = g * __builtin_amdgcn_rcpf(1.0f + __expf(-g)) * up; }
                u32x4 w; w.x = cvt_pk_bf16(o[0], o[1]); w.y = cvt_pk_bf16(o[2], o[3]); w.z = cvt_pk_bf16(o[4], o[5]); w.w = cvt_pk_bf16(o[6], o[7]);
                *(GAS u32x4*)rowp = w; }
    }
};
struct EpiGlu {
    static constexpr bool PERM = true, AFTER_DRAIN = false;
    const GAS bf16_t* Z; GAS bf16_t* MIXED; const GAS float* bias;
    __device__ __forceinline__ void operator()(const f32x4 (&acc)[2][2][4][2], const pg8::Unit& u, int wr, int wc, int fr, int fq) const {
        const int row0 = u.pm * 256 + wr * 64 + fr, col0 = u.pn * 256 + wc * 32 + 8 * fq;
#pragma unroll
        for (int bj = 0; bj < 2; ++bj) {
            const f32x4 b0 = *(const GAS f32x4*)(bias + col0 + bj * 128), b1 = *(const GAS f32x4*)(bias + col0 + bj * 128 + 4);
            u32x4 zq[2][4];
#pragma unroll
            for (int ai = 0; ai < 2; ++ai)
#pragma unroll
                for (int m = 0; m < 4; ++m) zq[ai][m] = *(const GAS u32x4*)(Z + (size_t)(row0 + ai * 128 + m * 16) * S5W + col0 + bj * 128);
            asm volatile("" ::: "memory");
#pragma unroll
            for (int ai = 0; ai < 2; ++ai)
#pragma unroll
                for (int m = 0; m < 4; ++m) { const size_t r = (size_t)(row0 + ai * 128 + m * 16);
                    const u32x4 zz = zq[ai][m];
                    const f32x4 v0 = acc[ai][bj][m][0] + b0, v1 = acc[ai][bj][m][1] + b1;
                    u32x4 w;
                    w.x = cvt_pk_bf16(bf_lo(zz.x) * sigmoidf_(v0[0]), bf_hi(zz.x) * sigmoidf_(v0[1]));
                    w.y = cvt_pk_bf16(bf_lo(zz.y) * sigmoidf_(v0[2]), bf_hi(zz.y) * sigmoidf_(v0[3]));
                    w.z = cvt_pk_bf16(bf_lo(zz.z) * sigmoidf_(v1[0]), bf_hi(zz.z) * sigmoidf_(v1[1]));
                    w.w = cvt_pk_bf16(bf_lo(zz.w) * sigmoidf_(v1[2]), bf_hi(zz.w) * sigmoidf_(v1[3]));
                    *(GAS u32x4*)(MIXED + r * DM + col0 + bj * 128) = w;
                    if (m & 1) asm volatile("" ::: "memory"); }
        }
    }
};
struct EpiDelta {
    static constexpr bool PERM = true, AFTER_DRAIN = false;
    GAS bf16_t* D; const GAS float* gate0;
    __device__ __forceinline__ void operator()(const f32x4 (&acc)[2][2][4][2], const pg8::Unit& u, int wr, int wc, int fr, int fq) const {
        const int row0 = u.pm * 256 + wr * 64 + fr, col0 = u.pn * 256 + wc * 32 + 8 * fq;
        const GAS float* gp = gate0 + (u.pm >= 32 ? 6 * DM : 0) + col0;
        f32x4 g[2][2];
#pragma unroll
        for (int bj = 0; bj < 2; ++bj)
#pragma unroll
            for (int n = 0; n < 2; ++n) g[bj][n] = *(const GAS f32x4*)(gp + bj * 128 + 4 * n) + 1.0f;
#pragma unroll
        for (int ai = 0; ai < 2; ++ai)
#pragma unroll
            for (int m = 0; m < 4; ++m) { GAS bf16_t* rowp = D + (size_t)(row0 + ai * 128 + m * 16) * DM + col0;
#pragma unroll
                for (int bj = 0; bj < 2; ++bj) { const f32x4 v0 = acc[ai][bj][m][0] * g[bj][0], v1 = acc[ai][bj][m][1] * g[bj][1];
                    u32x4 w; w.x = cvt_pk_bf16(v0[0], v0[1]); w.y = cvt_pk_bf16(v0[2], v0[3]); w.z = cvt_pk_bf16(v1[0], v1[1]); w.w = cvt_pk_bf16(v1[2], v1[3]);
                    *(GAS u32x4*)(rowp + bj * 128) = w; } }
    }
};

__device__ __forceinline__ int lane_id_v() { int r; asm volatile("v_mbcnt_lo_u32_b32 %0, -1, 0\n\tv_mbcnt_hi_u32_b32 %0, -1, %0" : "=v"(r)); return r; }
struct Args { const float* in[N_IN]; float* out; unsigned char* ws; int ph_lo, ph_hi; };
struct Ctx {
    volatile LAS unsigned long long* t;
    __device__ __forceinline__ unsigned long long ld(int i) const { const unsigned long long v = t[i];
        return ((unsigned long long)(unsigned)__builtin_amdgcn_readfirstlane((int)(v >> 32)) << 32) | (unsigned long long)(unsigned)__builtin_amdgcn_readfirstlane((int)(unsigned)v); }
    __device__ __forceinline__ const GAS float* in(int i) const { return (const GAS float*)ld(i); }
    __device__ __forceinline__ GAS float* out() const { return (GAS float*)ld(30); }
    __device__ __forceinline__ GAS unsigned char* ws() const { return (GAS unsigned char*)ld(31); }
};

constexpr int S5K = 1152;
constexpr size_t S5_T_LAYER = (size_t)64 * 1024 * S5K * 2, S5_W1_LAYER = (size_t)64 * 256 * S5K * 2;

struct S5Order {
    int G, c, n, sh;
    __device__ __forceinline__ bool next(int i, pg8::Unit& u) const { const int L = i * G + c; if (L >= n) return false; u.pm = L >> sh; u.pn = L; return true; }
    __device__ __forceinline__ void a_ready(const pg8::Unit&) const {}
    __device__ __forceinline__ void done(const pg8::Unit&) const {}
};
struct EpiS5A {
    static constexpr bool PERM = false, AFTER_DRAIN = false;
    GAS float* Sloc;
    __device__ __forceinline__ void operator()(const f32x4 (&acc)[2][2][4][2], const pg8::Unit& u, int wr, int wc, int fr, int fq) const {
        const int row0 = u.pm * 256 + wr * 64 + fr, col0 = wc * 32 + 4 * fq;
#pragma unroll
        for (int ai = 0; ai < 2; ++ai)
#pragma unroll
            for (int m = 0; m < 4; ++m)
#pragma unroll
                for (int n = 0; n < 2; ++n) *(GAS f32x4*)(Sloc + (size_t)(row0 + ai * 128 + m * 16) * 128 + col0 + n * 16) = acc[ai][0][m][n];
    }
};
struct EpiS5C {
    static constexpr bool PERM = true, AFTER_DRAIN = false;
    GAS bf16_t* Z;
    __device__ __forceinline__ void operator()(const f32x4 (&acc)[2][2][4][2], const pg8::Unit& u, int wr, int wc, int fr, int fq) const {
        const int g = u.pm, c0 = wr * 64 + fr, cc0 = (u.pn & 3) * 256 + wc * 32 + 8 * fq;
#pragma unroll
        for (int ai = 0; ai < 2; ++ai)
#pragma unroll
            for (int m = 0; m < 4; ++m) { const int c = c0 + ai * 128 + m * 16;
#pragma unroll
                for (int bj = 0; bj < 2; ++bj) { const int cc = cc0 + bj * 128, t = cc >> 4, h0 = cc & 15;
                    const f32x4 v0 = acc[ai][bj][m][0], v1 = acc[ai][bj][m][1];
                    u32x4 w; w.x = cvt_pk_bf16(gelu_tanh(v0[0]), gelu_tanh(v0[1])); w.y = cvt_pk_bf16(gelu_tanh(v0[2]), gelu_tanh(v0[3]));
                    w.z = cvt_pk_bf16(gelu_tanh(v1[0]), gelu_tanh(v1[1])); w.w = cvt_pk_bf16(gelu_tanh(v1[2]), gelu_tanh(v1[3]));
                    *(GAS u32x4*)(Z + (size_t)(c * 64 + t) * S5W + g * 16 + h0) = w; } }
    }
};
__device__ __forceinline__ void s5_tables_item(const Ctx& a, int lg, LAS unsigned char* lds, int wave, int lane) {
    LAS f32x2* LP = (LAS f32x2*)lds;
    LAS f32x2* BB = (LAS f32x2*)(lds + 33280);
    LAS f32x2* CC = (LAS f32x2*)(lds + 41472);
    LAS float* KT = (LAS float*)(lds + 49664);
    const int tid = wave * 64 + lane, l = lg >> 6, g = lg & 63;
    if (tid < 64) { const int p = tid;
        const double ar = (double)a.in(I_AREAL)[lg * 64 + p], ai = (double)a.in(I_AIMAG)[lg * 64 + p], dt = exp((double)a.in(I_LOGDT)[lg]);
        const double mag = exp(ar * dt), ang = ai * dt, lr = mag * cos(ang), li = mag * sin(ang);
        const double den = ar * ar + ai * ai, nr = lr - 1.0, ni = li, cr = (nr * ar + ni * ai) / den, ci = (ni * ar - nr * ai) / den;
        double pr = 1.0, pi = 0.0;
        for (int tau = 0; tau <= 64; ++tau) { LP[tau * 64 + p] = (f32x2){(float)pr, (float)pi}; const double nr2 = pr * lr - pi * li, ni2 = pr * li + pi * lr; pr = nr2; pi = ni2; }
        for (int h = 0; h < 16; ++h) { const double br = (double)a.in(I_BRE)[((size_t)lg * 64 + p) * 16 + h], bi = (double)a.in(I_BIM)[((size_t)lg * 64 + p) * 16 + h];
            BB[p * 16 + h] = (f32x2){(float)(cr * br - ci * bi), (float)(cr * bi + ci * br)}; }
    }
    for (int e = tid; e < 1024; e += 512) { const int h = e >> 6, p = e & 63; CC[e] = (f32x2){a.in(I_CRE)[((size_t)lg * 16 + h) * 64 + p], a.in(I_CIM)[((size_t)lg * 16 + h) * 64 + p]}; }
    __syncthreads();
    if (tid < 64) *(GAS f32x2*)((GAS float*)(a.ws() + WS_LAM64) + ((size_t)lg * 64 + tid) * 2) = LP[64 * 64 + tid];
    for (int e = tid; e < 64 * 256; e += 512) { const int tau = e >> 8, h = (e >> 4) & 15, hp = e & 15; float s = 0.f;
#pragma unroll 8
        for (int p = 0; p < 64; ++p) { const f32x2 c = CC[h * 64 + p], lm = LP[tau * 64 + p], b = BB[p * 16 + hp];
            const float xr = c.x * lm.x - c.y * lm.y, xi = c.x * lm.y + c.y * lm.x; s += xr * b.x - xi * b.y; }
        if (tau == 0 && h == hp) s += a.in(I_S5D)[l * S5W + g * 16 + h];
        KT[e] = s; }
    __syncthreads();
    GAS bf16_t* T = (GAS bf16_t*)(a.ws() + WS_S5T + (size_t)l * S5_T_LAYER) + (size_t)g * 1024 * S5K;
    for (int pc = tid; pc < 1024 * 144; pc += 512) { const int n = pc / 144, j = pc % 144, t = n >> 4, h = n & 15; float v[8];
        if (j < 128) { const int s = j >> 1, hp0 = (j & 1) * 8;
            if (s > t) {
#pragma unroll
                for (int i = 0; i < 8; ++i) v[i] = 0.f;
            } else { const LAS float* kp = KT + (t - s) * 256 + h * 16 + hp0; const f32x4 k0 = *(const LAS f32x4*)kp, k1 = *(const LAS f32x4*)(kp + 4);
                v[0] = k0[0]; v[1] = k0[1]; v[2] = k0[2]; v[3] = k0[3]; v[4] = k1[0]; v[5] = k1[1]; v[6] = k1[2]; v[7] = k1[3]; }
        } else { const int p0 = (j - 128) * 4;
#pragma unroll
            for (int i = 0; i < 4; ++i) { const f32x2 c = CC[h * 64 + p0 + i], lm = LP[(t + 1) * 64 + p0 + i]; v[2 * i] = c.x * lm.x - c.y * lm.y; v[2 * i + 1] = -(c.x * lm.y + c.y * lm.x); } }
        *(GAS u32x4*)(T + (size_t)n * S5K + j * 8) = (u32x4){cvt_pk_bf16(v[0], v[1]), cvt_pk_bf16(v[2], v[3]), cvt_pk_bf16(v[4], v[5]), cvt_pk_bf16(v[6], v[7])}; }
    GAS bf16_t* W1 = (GAS bf16_t*)(a.ws() + WS_S5W1 + (size_t)l * S5_W1_LAYER) + (size_t)g * 256 * S5K;
    for (int pc = tid; pc < 256 * 144; pc += 512) { const int n = pc / 144, j = pc % 144; float v[8];
#pragma unroll
        for (int i = 0; i < 8; ++i) v[i] = 0.f;
        if (n < 128 && j < 128) { const int p = n >> 1, ri = n & 1, s = j >> 1, hp0 = (j & 1) * 8; const f32x2 lm = LP[(63 - s) * 64 + p];
#pragma unroll
            for (int i = 0; i < 8; ++i) { const f32x2 b = BB[p * 16 + hp0 + i]; v[i] = ri ? (lm.x * b.y + lm.y * b.x) : (lm.x * b.x - lm.y * b.y); } }
        *(GAS u32x4*)(W1 + (size_t)n * S5K + j * 8) = (u32x4){cvt_pk_bf16(v[0], v[1]), cvt_pk_bf16(v[2], v[3]), cvt_pk_bf16(v[4], v[5]), cvt_pk_bf16(v[6], v[7])}; }
    __syncthreads();
}
__device__ __forceinline__ void s5_scan_item(const Ctx& a, int l, int item, int wave, int lane) {
    const int idx = item * 512 + wave * 64 + lane, g = idx >> 7, b = (idx >> 6) & 1, p = idx & 63;
    const f32x2 lam = *(const GAS f32x2*)((const GAS float*)(a.ws() + WS_LAM64) + ((size_t)(l * 64 + g) * 64 + p) * 2);
    const GAS float* sl = (const GAS float*)(a.ws() + WS_SLOC) + ((size_t)(g * 256 + b * 128)) * 128 + 2 * p;
    GAS bf16_t* ux = (GAS bf16_t*)(a.ws() + WS_UX) + ((size_t)(g * 256 + b * 128)) * S5K + 1024 + 2 * p;
    float xr = 0.f, xi = 0.f;
    for (int c0 = 0; c0 < 128; c0 += 8) { f32x2 s[8];
#pragma unroll
        for (int i = 0; i < 8; ++i) s[i] = *(const GAS f32x2*)(sl + (size_t)(c0 + i) * 128);
#pragma unroll
        for (int i = 0; i < 8; ++i) { *(GAS unsigned*)(ux + (size_t)(c0 + i) * S5K) = cvt_pk_bf16(xr, xi);
            const float nr = lam.x * xr - lam.y * xi + s[i].x, ni = lam.x * xi + lam.y * xr + s[i].y; xr = nr; xi = ni; } }
}

__device__ __forceinline__ void transpose_item(const GAS float* W, int N, int k0, int n0, GAS bf16_t* WT, int drow0, int Kd, LAS float* scr, int lane) {
    const int nl = 4 * (lane & 15), kq = lane >> 4;
    const bool valid = (n0 + nl) < N;
    f32x4 v[16];
#pragma unroll
    for (int i = 0; i < 16; ++i) { const int k = 4 * i + kq; v[i] = valid ? *(const GAS f32x4*)(W + (size_t)(k0 + k) * N + n0 + nl) : (f32x4){0.f, 0.f, 0.f, 0.f}; }
#pragma unroll
    for (int i = 0; i < 16; ++i) { const int k = 4 * i + kq; LAS float* s = scr + k * 65 + nl; s[0] = v[i][0]; s[1] = v[i][1]; s[2] = v[i][2]; s[3] = v[i][3]; }
    LDS_WAIT();
    const int c = lane & 7;
#pragma unroll
    for (int j = 0; j < 8; ++j) { const int n = (lane >> 3) + 8 * j; const LAS float* s = scr + (8 * c) * 65 + n;
        u32x4 o; o.x = cvt_pk_bf16(s[0], s[65]); o.y = cvt_pk_bf16(s[130], s[195]); o.z = cvt_pk_bf16(s[260], s[325]); o.w = cvt_pk_bf16(s[390], s[455]);
        *(GAS u32x4*)(WT + (size_t)(drow0 + n) * Kd + k0 + 8 * c) = o; }
    LDS_WAIT();
}
constexpr int NIT_IN = 64 * 188, NIT_OUT = 64 * 64, NIT_G = 64 * 172, NIT_DN = 172 * 64, NIT_GLU = 16 * 16;
constexpr int NIT_LAYER = NIT_IN + NIT_OUT + 2 * NIT_G + NIT_DN + NIT_GLU;
constexpr int NIT_TR = DEPTH * NIT_LAYER, NIT_COND = 64 * 96;

__device__ __forceinline__ void phase_prologue(const Ctx& a, LAS unsigned char* lds, int wave, int lane) {
    if (blockIdx.x & 1) { for (int lg = blockIdx.x; lg < DEPTH * 64; lg += gridDim.x) s5_tables_item(a, lg, lds, wave, lane); __syncthreads(); }
    LAS float* scr = (LAS float*)(lds + wave * 16640);
    const int gw = blockIdx.x * 8 + wave, NGW = gridDim.x * 8;
    for (int it = gw; it < NIT_TR + NIT_COND; it += NGW) {
        if (it < NIT_TR) {
            const int l = it / NIT_LAYER; int r = it % NIT_LAYER;
            GAS unsigned char* wt = a.ws() + WS_WT + (size_t)l * WT_LAYER;
            if (r < NIT_IN) { const int kb = r / 188, nb = r % 188; transpose_item(a.in(I_WIN) + (size_t)l * DM * INW, INW, 64 * kb, 64 * nb, (GAS bf16_t*)(wt + WT_IN), 64 * nb, DM, scr, lane); continue; } r -= NIT_IN;
            if (r < NIT_OUT) { const int kb = r / 64, nb = r % 64; transpose_item(a.in(I_WOUT) + (size_t)l * DM * DM, DM, 64 * kb, 64 * nb, (GAS bf16_t*)(wt + WT_OUT), 64 * nb, DM, scr, lane); continue; } r -= NIT_OUT;
            if (r < NIT_G) { const int kb = r / 172, nb = r % 172, n0 = 64 * nb; transpose_item(a.in(I_WFG) + (size_t)l * DM * DFF, DFF, 64 * kb, n0, (GAS bf16_t*)(wt + WT_GU), 256 * (n0 / 128) + (n0 % 128), DM, scr, lane); continue; } r -= NIT_G;
            if (r < NIT_G) { const int kb = r / 172, nb = r % 172, n0 = 64 * nb; transpose_item(a.in(I_WFU) + (size_t)l * DM * DFF, DFF, 64 * kb, n0, (GAS bf16_t*)(wt + WT_GU), 256 * (n0 / 128) + 128 + (n0 % 128), DM, scr, lane); continue; } r -= NIT_G;
            if (r < NIT_DN) { const int kb = r / 64, nb = r % 64; transpose_item(a.in(I_WFD) + (size_t)l * DFF * DM, DM, 64 * kb, 64 * nb, (GAS bf16_t*)(wt + WT_DN), 64 * nb, DFF, scr, lane); continue; } r -= NIT_DN;
            { const int kb = r / 16, nb = r % 16; transpose_item(a.in(I_GLUW) + (size_t)l * S5W * S5W, S5W, 64 * kb, 64 * nb, (GAS bf16_t*)(wt + WT_GLU), 64 * nb, S5W, scr, lane); }
        } else {
            const int item = it - NIT_TR, kb = item / 96, jb = item % 96, k0 = 64 * kb, j0 = 256 * jb + 4 * lane;
            const GAS float* c = a.in(I_C);
            float c0 = c[k0 + lane], c1 = c[DM + k0 + lane];
            c0 = c0 / (1.0f + expf(-c0)); c1 = c1 / (1.0f + expf(-c1));
            f32x4 a0 = (f32x4){0.f, 0.f, 0.f, 0.f}, a1 = a0;
            const GAS float* w = a.in(I_WADA) + (size_t)k0 * (6 * DM) + j0;
#pragma unroll 8
            for (int kk = 0; kk < 64; ++kk) { const f32x4 wv = *(const GAS f32x4*)(w + (size_t)kk * (6 * DM));
                const float s0 = __int_as_float(__builtin_amdgcn_readlane(__float_as_int(c0), kk)), s1 = __int_as_float(__builtin_amdgcn_readlane(__float_as_int(c1), kk));
                a0 += wv * s0; a1 += wv * s1; }
            GAS float* cp = (GAS float*)(a.ws() + WS_CONDPART);
            *(GAS f32x4*)(cp + (size_t)(kb * 2 + 0) * (6 * DM) + j0) = a0;
            *(GAS f32x4*)(cp + (size_t)(kb * 2 + 1) * (6 * DM) + j0) = a1;
        }
    }
    __syncthreads();
    if (!(blockIdx.x & 1)) { for (int lg = blockIdx.x; lg < DEPTH * 64; lg += gridDim.x) s5_tables_item(a, lg, lds, wave, lane); }
}
__device__ __forceinline__ void phase_mod(const Ctx& a, int wave, int lane) {
    const int gt = blockIdx.x * 512 + wave * 64 + lane, NT = gridDim.x * 512;
    const GAS float* cp = (const GAS float*)(a.ws() + WS_CONDPART);
    GAS float* mod = (GAS float*)(a.ws() + WS_MOD); GAS float* misc = (GAS float*)(a.ws() + WS_MISC);
    for (int idx = gt; idx < NB * 6 * DM; idx += NT) {
        const int b = idx / (6 * DM), j = idx % (6 * DM);
        float s = a.in(I_BADA)[j];
        for (int kb = 0; kb < 64; ++kb) s += cp[(size_t)(kb * 2 + b) * (6 * DM) + j];
        for (int l = 0; l < DEPTH; ++l) mod[(size_t)((l * 2 + b) * 6) * DM + j] = s + a.in(I_TABLE)[(size_t)l * 6 * DM + j];
    }
    for (int idx = gt; idx < DM; idx += NT) { misc[idx] = 1.0f; misc[DM + idx] = 0.0f; }
    for (int idx = gt; idx < HGW; idx += NT) {
        const GAS float* raw = a.in(I_LBRAW); float r[DEPTH], mx = -3.0e38f;
#pragma unroll
        for (int l = 0; l < DEPTH; ++l) { r[l] = raw[l * HGW + idx]; mx = fmaxf(mx, r[l]); }
        float e[DEPTH], sum = 0.f;
#pragma unroll
        for (int l = 0; l < DEPTH; ++l) { e[l] = expf(r[l] - mx); sum += e[l]; }
        float cum = 0.f;
#pragma unroll
        for (int l = 0; l < DEPTH; ++l) { misc[2 * DM + l * HGW + idx] = cum; if (l + 1 < DEPTH) cum += e[l + 1] / sum; }
    }
}

__device__ __forceinline__ void phase_h0(const GAS float* x, const GAS float* modp, GAS bf16_t* H, int wave, int lane) {
    for (int blk = blockIdx.x; blk < MTOK / 64; blk += gridDim.x) {
        const int r0 = blk * 64, b = (r0 >= SEQ) ? 1 : 0;
        f32x4 A[2], B[2];
#pragma unroll
        for (int jj = 0; jj < 2; ++jj) { const int c = 512 * wave + 256 * jj + 4 * lane; A[jj] = *(const GAS f32x4*)(modp + (size_t)(b * 6 + 1) * DM + c) + 1.0f; B[jj] = *(const GAS f32x4*)(modp + (size_t)(b * 6 + 0) * DM + c); }
#pragma unroll 8
        for (int rl = 0; rl < 64; ++rl) { const size_t off = (size_t)(r0 + rl) * DM + 512 * wave + 4 * lane;
#pragma unroll
            for (int jj = 0; jj < 2; ++jj) { const f32x4 v = *(const GAS f32x4*)(x + off + 256 * jj), y = v * A[jj] + B[jj];
                u32x2 w; w.x = cvt_pk_bf16(y[0], y[1]); w.y = cvt_pk_bf16(y[2], y[3]); *(GAS u32x2*)(H + off + 256 * jj) = w; } }
    }
}
struct XRes { GAS unsigned* hi; GAS unsigned* lo; };
template <bool WITH_H, bool XP32, bool XO32>
__device__ __forceinline__ void phase_lnres(const GAS float* xp32, XRes xp, const GAS bf16_t* delta, GAS float* xo32, XRes xo, const GAS float* lng, const GAS float* lnb, const GAS float* modp, int i_shift, int i_scale,
                                            GAS bf16_t* H, LAS unsigned char* lds, int wave, int lane) {
    LAS f32x2* red = (LAS f32x2*)lds;
    for (int blk = blockIdx.x; blk < MTOK / 64; blk += gridDim.x) {
        const int r0 = blk * 64, b = (r0 >= SEQ) ? 1 : 0;
        f32x4 G[2], Bt[2], A[2], B[2];
#pragma unroll
        for (int jj = 0; jj < 2; ++jj) { const int c = 512 * wave + 256 * jj + 4 * lane; G[jj] = *(const GAS f32x4*)(lng + c); Bt[jj] = *(const GAS f32x4*)(lnb + c);
            if (WITH_H) { A[jj] = *(const GAS f32x4*)(modp + (size_t)(b * 6 + i_scale) * DM + c) + 1.0f; B[jj] = *(const GAS f32x4*)(modp + (size_t)(b * 6 + i_shift) * DM + c); } }
        const size_t offb = (size_t)r0 * DM + 512 * wave + 4 * lane;
        f32x4 va[4][2], vb[4][2]; u32x2 da[4][2], db[4][2];
#define LN_LOAD(v_, d_, it_) do { _Pragma("unroll") for (int r = 0; r < 4; ++r) _Pragma("unroll") for (int jj = 0; jj < 2; ++jj) { const size_t o_ = offb + (size_t)((it_) * 4 + r) * DM + 256 * jj; \
            if (XP32) v_[r][jj] = *(const GAS f32x4*)(xp32 + o_); else { const u32x2 t_ = *(const GAS u32x2*)(xp.hi + (o_ >> 1)); const unsigned l_ = xp.lo[o_ >> 2]; \
                v_[r][jj][0] = __uint_as_float(t_.x); v_[r][jj][1] = __uint_as_float(t_.y); v_[r][jj][2] = __uint_as_float(l_); } \
            d_[r][jj] = *(const GAS u32x2*)(delta + o_); } } while (0)
#define LN_STEP(v_, d_, it_) do { LAS f32x2* rb = red + ((it_) & 1) * 32; \
            _Pragma("unroll") for (int r = 0; r < 4; ++r) { float s1 = 0.f, s2 = 0.f; \
                _Pragma("unroll") for (int jj = 0; jj < 2; ++jj) { const f32x4 dd = (f32x4){bf_lo(d_[r][jj].x), bf_hi(d_[r][jj].x), bf_lo(d_[r][jj].y), bf_hi(d_[r][jj].y)}; \
                    f32x4 xq = v_[r][jj]; \
                    if (!XP32) { const unsigned t0 = __float_as_uint(xq[0]), t1 = __float_as_uint(xq[1]), lw = __float_as_uint(xq[2]); \
                        xq[0] = __uint_as_float(__builtin_amdgcn_perm(t0, lw, 0x0504000cu)); xq[1] = __uint_as_float(__builtin_amdgcn_perm(t0, lw, 0x0706010cu)); \
                        xq[2] = __uint_as_float(__builtin_amdgcn_perm(t1, lw, 0x0504020cu)); xq[3] = __uint_as_float(__builtin_amdgcn_perm(t1, lw, 0x0706030cu)); } \
                    const f32x4 y = xq * ALPHA + dd; v_[r][jj] = y; \
                    s1 += (y[0] + y[1]) + (y[2] + y[3]); s2 += (y[0] * y[0] + y[1] * y[1]) + (y[2] * y[2] + y[3] * y[3]); } \
                s1 = wave_sum(s1); s2 = wave_sum(s2); if (lane == 0) rb[r * 8 + wave] = (f32x2){s1, s2}; } \
            __syncthreads(); \
            _Pragma("unroll") for (int r = 0; r < 4; ++r) { float s1 = 0.f, s2 = 0.f; \
                _Pragma("unroll") for (int w = 0; w < 8; ++w) { const f32x2 p = rb[r * 8 + w]; s1 += p.x; s2 += p.y; } \
                const float mu = s1 * (1.0f / DM), rs = 1.0f / sqrtf(fmaxf(s2 * (1.0f / DM) - mu * mu, 0.f) + LN_EPS); \
                _Pragma("unroll") for (int jj = 0; jj < 2; ++jj) { const f32x4 x = ((v_[r][jj] - mu) * rs) * G[jj] + Bt[jj]; const size_t o_ = offb + (size_t)((it_) * 4 + r) * DM + 256 * jj; \
                    if (XO32) *(GAS f32x4*)(xo32 + o_) = x; \
                    else { const unsigned q0 = __float_as_uint(x[0]) + 0x80u, q1 = __float_as_uint(x[1]) + 0x80u, q2 = __float_as_uint(x[2]) + 0x80u, q3 = __float_as_uint(x[3]) + 0x80u; \
                        *(GAS u32x2*)(xo.hi + (o_ >> 1)) = (u32x2){__builtin_amdgcn_perm(q1, q0, 0x07060302u), __builtin_amdgcn_perm(q3, q2, 0x07060302u)}; \
                        xo.lo[o_ >> 2] = __builtin_amdgcn_perm(q1, q0, 0x0c0c0501u) | __builtin_amdgcn_perm(q3, q2, 0x05010c0cu); } \
                    if (WITH_H) { const f32x4 y = x * A[jj] + B[jj]; u32x2 w; w.x = cvt_pk_bf16(y[0], y[1]); w.y = cvt_pk_bf16(y[2], y[3]); *(GAS u32x2*)(H + o_) = w; } } } } while (0)
        LN_LOAD(va, da, 0);
        for (int it = 0; it < 16; it += 2) {
            LN_LOAD(vb, db, it + 1);
            LN_STEP(va, da, it);
            if (it + 2 < 16) LN_LOAD(va, da, it + 2);
            LN_STEP(vb, db, it + 1);
        }
#undef LN_LOAD
#undef LN_STEP
        __syncthreads();
    }
}

typedef short bf16x8 __attribute__((ext_vector_type(8)));
constexpr int HG_BLK = 33280, HG_OQ = 0, HG_OK = 8192, HG_OKT = 16384, HG_ODL = 24576, HG_OVT = 25088;
constexpr int GL_BLK = 63488, GL_OQ = 0, GL_OK = 12800, GL_OKT = 25600, GL_ODL = 37888, GL_SHARED = 38912, GL_OVT = 38912;
constexpr int NUNIT = SEQ / 32;

struct PreOut { GAS unsigned char* blk; int oq, ok, okt, odl, rowb; bool swz; };
__device__ __forceinline__ int slot_swz(int r) { return (0 - (r >> 2)) & 3; }
template <int HALF>
__device__ __forceinline__ float pre_half(const PreOut& P, int d, int pd, float e0, const float (&a)[16], const float (&qq)[16], const float (&kk)[16], float (&kta)[16], unsigned (&kt)[16], float& ph) {
    float w = 1.0f;
#pragma unroll
    for (int t = 14; t >= 0; t -= 2) { const float kv1 = kk[t + 1] * w; w *= a[t + 1]; const float kv0 = kk[t] * w; w *= a[t];
        if (HALF == 0) { kta[t] = kv0; kta[t + 1] = kv1; } else kt[4 * (t >> 2) + 2 + ((t & 3) >> 1)] = cvt_pk_bf16(kv0, kv1); }
    ph = w;
    float e = e0;
#pragma unroll
    for (int j = 0; j < 16; ++j) { const int row = 16 * HALF + j;
        e *= a[j];
        const int off = row * P.rowb + ((2 * pd) ^ ((P.swz ? j : ((j >> 1) & 7)) << 4));
        const float qv = qq[j] * e, kc = kk[j] * fminf(__builtin_amdgcn_rcpf(e), 5.5406224e34f);
        const float qn = __int_as_float(__builtin_amdgcn_mov_dpp(__float_as_int(qv), 0xB1, 0xF, 0xF, true)), kn = __int_as_float(__builtin_amdgcn_mov_dpp(__float_as_int(kc), 0xB1, 0xF, 0xF, true));
        if ((d & 1) == 0) { *(GAS unsigned*)(P.blk + P.oq + off) = cvt_pk_bf16(qv, qn); *(GAS unsigned*)(P.blk + P.ok + off) = cvt_pk_bf16(kc, kn); } }
    return e;
}
__device__ __forceinline__ void pre_tail(const PreOut& P, int d, float dlb, float eend, const float (&kta)[16], unsigned (&kt)[16]) {
#pragma unroll
    for (int t = 0; t < 16; t += 2) kt[4 * (t >> 2) + ((t & 3) >> 1)] = cvt_pk_bf16(kta[t] * dlb, kta[t + 1] * dlb);
#pragma unroll
    for (int i = 0; i < 4; ++i) *(GAS u32x4*)(P.blk + P.okt + d * 64 + 16 * (i ^ slot_swz(d))) = (u32x4){kt[4 * i], kt[4 * i + 1], kt[4 * i + 2], kt[4 * i + 3]};
    *(GAS float*)(P.blk + P.odl + d * 4) = eend;
}
__device__ __forceinline__ void glds16_asm(const GAS void* gsrc, unsigned lds_dst) { unsigned keep;
    asm volatile("s_mov_b32 %0, m0\n\ts_mov_b32 m0, %2\n\ts_nop 0\n\tglobal_load_lds_dwordx4 %1, off\n\ts_mov_b32 m0, %0" : "=&s"(keep) : "v"(gsrc), "s"(lds_dst) : "memory"); }
constexpr int PRE_IN = 49152, PRE_OUT = 2 * PRE_IN;
__device__ __forceinline__ void pre_hg_dma(const GAS bf16_t* P, int t, int half, LAS unsigned char* img, int wave, int lane) {
    const int bu = t / 3, kind = t - 3 * bu, b = bu / NUNIT, un = bu - b * NUNIT;
    const GAS bf16_t* src = P + ((size_t)b * SEQ + un * 32 + 16 * half) * INP + kind * 512 + 8 * lane;
    const unsigned dst = (unsigned)(size_t)img;
#pragma unroll
    for (int i = 0; i < 6; ++i) { const int r = wave * 6 + i, arr = r >> 4, j = r & 15;
        glds16_asm(src + (size_t)j * INP + (arr == 0 ? C_QB : arr == 1 ? C_FB : C_IB), dst + r * 1024); }
}
template <int HALF>
__device__ __forceinline__ float pre_half_l(LAS unsigned char* oq, LAS unsigned char* ok, int pd, float e0, const float (&a)[16], const float (&qq)[16], const float (&kk)[16], float (&kta)[16], unsigned (&kt)[16], float& ph) {
    float w = 1.0f;
#pragma unroll
    for (int t = 14; t >= 0; t -= 2) { const float kv1 = kk[t + 1] * w; w *= a[t + 1]; const float kv0 = kk[t] * w; w *= a[t];
        if (HALF == 0) { kta[t] = kv0; kta[t + 1] = kv1; } else kt[4 * (t >> 2) + 2 + ((t & 3) >> 1)] = cvt_pk_bf16(kv0, kv1); }
    ph = w;
    float e = e0;
#pragma unroll
    for (int j = 0; j < 16; ++j) { e *= a[j];
        const int off = j * 256 + ((2 * pd) ^ (j << 4));
        const float qv = qq[j] * e, kc = kk[j] * fminf(__builtin_amdgcn_rcpf(e), 5.5406224e34f);
        *(LAS unsigned short*)(oq + off) = (unsigned short)cvt_pk_bf16(qv, qv); *(LAS unsigned short*)(ok + off) = (unsigned short)cvt_pk_bf16(kc, kc); }
    return e;
}
__device__ __forceinline__ void phase_pre(const Ctx& a, int l, LAS unsigned char* lds, int wave, int lane) {
    const GAS bf16_t* P = (const GAS bf16_t*)(a.ws() + WS_P);
    int tid = wave * 64 + lane;
    const int bx = blockIdx.x, G = gridDim.x;
    {
        const int t_lo = (int)((long)(NB * NUNIT * 3) * bx / G), t_hi = (int)((long)(NB * NUNIT * 3) * (bx + 1) / G);
        float lbk[3];
#pragma unroll
        for (int k = 0; k < 3; ++k) lbk[k] = ((const GAS float*)(a.ws() + WS_MISC))[2 * DM + l * HGW + k * 512 + tid];
        asm volatile("" : "+v"(lbk[0]), "+v"(lbk[1]), "+v"(lbk[2]));
        __syncthreads();
        if (t_lo < t_hi) pre_hg_dma(P, t_lo, 0, lds, wave, lane);
        VM_WAIT();
        for (int t = t_lo; t < t_hi; ++t) {
            asm volatile("" : "+v"(tid));
            const int bu = t / 3, kind = t - 3 * bu, b = bu / NUNIT, un = bu - b * NUNIT;
            const int ch = kind * 512 + tid, hh = tid >> 7, d = tid & 127, pd = (d & ~31) + 8 * ((d >> 2) & 3) + 4 * ((d >> 4) & 1) + (d & 3);
            const float lb = kind == 0 ? lbk[0] : kind == 1 ? lbk[1] : lbk[2];
            GAS unsigned char* blk0 = a.ws() + WS_HGB + ((size_t)(b * 12 + kind * 4) * NUNIT + un) * HG_BLK;
            float kta[16]; unsigned kt[16], vv[16]; float e0 = 1.f, e1 = 1.f, ph = 1.f;
#pragma unroll
            for (int half = 0; half < 2; ++half) {
                __syncthreads();
                { const int nt = half ? t + 1 : t; if (nt < t_hi) pre_hg_dma(P, nt, half ^ 1, lds + (half ^ 1) * PRE_IN, wave, lane); }
                const LAS unsigned char* img = lds + half * PRE_IN + 2 * tid;
                float g[16], qq[16], kk[16];
                unsigned short rq[16], rf[16], rv[16];
#pragma unroll
                for (int j = 0; j < 16; ++j) { rq[j] = *(const LAS unsigned short*)(img + j * 1024); rf[j] = *(const LAS unsigned short*)(img + (16 + j) * 1024); rv[j] = *(const LAS unsigned short*)(img + (32 + j) * 1024); }
                asm volatile("" ::: "memory");
#pragma unroll
                for (int j = 0; j < 16; ++j) {
                    const float qin = fmaxf(bf2f(rq[j]), -80.f), fin = fminf(fmaxf(bf2f(rf[j]), -80.f), 80.f);
                    const unsigned short v = rv[j];
                    const int w = 4 * (j >> 2) + 2 * half + ((j & 3) >> 1); if (j & 1) vv[w] |= ((unsigned)v) << 16; else vv[w] = v;
                    const float e = __expf(-fin), sg = __builtin_amdgcn_rcpf(1.0f + e);
                    const float f = lb + (1.0f - lb) * sg;
                    g[j] = f; kk[j] = (1.0f - lb) * (e * sg); qq[j] = qin * __builtin_amdgcn_rcpf(1.0f + __expf(-qin)); }
                LAS unsigned char* oq = lds + PRE_OUT + hh * 4096; LAS unsigned char* ok = oq + 16384;
                if (half == 0) { e0 = pre_half_l<0>(oq, ok, pd, 1.0f, g, qq, kk, kta, kt, ph); } else { e1 = pre_half_l<1>(oq, ok, pd, e0, g, qq, kk, kta, kt, ph); }
                __syncthreads();
                VM_WAIT();
#pragma unroll
                for (int i = 0; i < 4; ++i) { const int pc = i * 512 + tid, c = pc >> 8, wi = pc & 255;
                    *(GAS u32x4*)(blk0 + (size_t)(c & 3) * NUNIT * HG_BLK + (c >> 2 ? HG_OK : HG_OQ) + half * 4096 + wi * 16) = *(const LAS u32x4*)(lds + PRE_OUT + c * 4096 + wi * 16); }
            }
            GAS unsigned char* blk = blk0 + (size_t)hh * NUNIT * HG_BLK;
            const PreOut po{blk, HG_OQ, HG_OK, HG_OKT, HG_ODL, 256, true};
#pragma unroll
            for (int i = 0; i < 4; ++i) *(GAS u32x4*)(blk + HG_OVT + d * 64 + 16 * (i ^ slot_swz(d))) = (u32x4){vv[4 * i], vv[4 * i + 1], vv[4 * i + 2], vv[4 * i + 3]};
            pre_tail(po, d, ph, e1, kta, kt);
        }
    }
    const bool bal = G == 256;
    const int t_lo = bal ? (bx < 64 ? 4 * bx : 256 + 12 * (bx - 64)) : bx;
    const int t_hi = bal ? t_lo + (bx < 64 ? 4 : 12) : NB * NUNIT * 5, t_st = bal ? 1 : G;
    for (int task = t_lo; task < t_hi; task += t_st) {
        asm volatile("" : "+v"(tid));
        const int bu = task / 5, kind = 3 + (task - 5 * bu), b = bu / NUNIT, un = bu % NUNIT;
        const size_t row0 = (size_t)b * SEQ + un * 32;
        if (kind < 5) {
            __syncthreads();
            if (tid < 64) *(LAS u32x4*)(lds + tid * 16) = *(const GAS u32x4*)(P + (row0 + (tid >> 1)) * INP + C_LR + 8 * (tid & 1));
            __syncthreads();
            if (tid < 384) {
                const int ch = (kind - 3) * 384 + tid, h = ch / 192, d = ch % 192, pd = (d & ~31) + 8 * ((d >> 2) & 3) + 4 * ((d >> 4) & 1) + (d & 3);
                GAS unsigned char* blk = a.ws() + WS_GLB + ((size_t)(b * 4 + h) * NUNIT + un) * GL_BLK;
                const PreOut po{blk, GL_OQ, GL_OK, GL_OKT, GL_ODL, 384, false};
                float wg[16];
#pragma unroll
                for (int r = 0; r < 16; ++r) wg[r] = a.in(I_WGATE)[((size_t)l * 16 + r) * GLKW + ch];
                const float bgv = a.in(I_BGATE)[l * GLKW + ch];
                float kta[16]; unsigned kt[16]; float e0 = 1.f, e1 = 1.f, ph = 1.f;
#pragma unroll
                for (int half = 0; half < 2; ++half) {
                    float g[16], qq[16], kk[16];
#pragma unroll
                    for (int j = 0; j < 16; ++j) { const GAS bf16_t* prow = P + (row0 + 16 * half + j) * INP;
                        const u32x4 l0 = *(const LAS u32x4*)(lds + (16 * half + j) * 32), l1 = *(const LAS u32x4*)(lds + (16 * half + j) * 32 + 16);
                        float x = bgv;
                        x += bf_lo(l0.x) * wg[0] + bf_hi(l0.x) * wg[1] + bf_lo(l0.y) * wg[2] + bf_hi(l0.y) * wg[3] + bf_lo(l0.z) * wg[4] + bf_hi(l0.z) * wg[5] + bf_lo(l0.w) * wg[6] + bf_hi(l0.w) * wg[7];
                        x += bf_lo(l1.x) * wg[8] + bf_hi(l1.x) * wg[9] + bf_lo(l1.y) * wg[10] + bf_hi(l1.y) * wg[11] + bf_lo(l1.z) * wg[12] + bf_hi(l1.z) * wg[13] + bf_lo(l1.w) * wg[14] + bf_hi(l1.w) * wg[15];
                        g[j] = __expf((fminf(x, 0.f) - __logf(1.0f + __expf(-fabsf(x)))) * 0.0625f);
                        qq[j] = bf2f(prow[C_QC + ch]) * GLA_QSCALE; kk[j] = bf2f(prow[C_KC + ch]); }
                    if (half == 0) { e0 = pre_half<0>(po, d, pd, 1.0f, g, qq, kk, kta, kt, ph); } else { e1 = pre_half<1>(po, d, pd, e0, g, qq, kk, kta, kt, ph); }
                }
                pre_tail(po, d, ph, e1, kta, kt);
            }
        } else {
            const int ch = (kind - 5) * 512 + tid, h = ch / 384, e = ch % 384;
            GAS unsigned char* blk = a.ws() + WS_GLB + ((size_t)(b * 4 + h) * NUNIT + un) * GL_BLK;
            unsigned vv[16]; unsigned short rv[32];
#pragma unroll
            for (int j = 0; j < 32; ++j) rv[j] = P[(row0 + j) * INP + C_VC + ch];
            asm volatile("" ::: "memory");
#pragma unroll
            for (int j = 0; j < 32; ++j) { const unsigned short v = rv[j];
                const int w = 4 * ((j >> 2) & 3) + 2 * (j >> 4) + ((j & 3) >> 1); if (j & 1) vv[w] |= ((unsigned)v) << 16; else vv[w] = v; }
#pragma unroll
            for (int i = 0; i < 4; ++i) *(GAS u32x4*)(blk + GL_OVT + e * 64 + 16 * (i ^ slot_swz(e))) = (u32x4){vv[4 * i], vv[4 * i + 1], vv[4 * i + 2], vv[4 * i + 3]};
        }
    }
}

template <int DK, int MODE>
__device__ __forceinline__ void chain_unit(const LAS unsigned char* sb, f32x4 (&S)[DK / 16], GAS float* op, int wave, int n, int q) {
    constexpr bool IS_GLA = (DK == 192);
    constexpr int NKS = DK / 32, NMB = DK / 16, ROWB = IS_GLA ? 384 : 256;
    constexpr int OQ = 0, OK = IS_GLA ? GL_OK : HG_OK, OKT = IS_GLA ? GL_OKT : HG_OKT, OVT = IS_GLA ? GL_OVT : HG_OVT, ODL = IS_GLA ? GL_ODL : HG_ODL;
    constexpr int UG = 4, NUG = NMB / UG;
#define CU_FENCE() asm volatile("" ::: "memory")
    bf16x8 ktf[2][UG]; f32x4 dlv[2][UG];
#define CU_LDU(g_, sl_) do { _Pragma("unroll") for (int u_ = 0; u_ < UG; ++u_) { const int mb_ = (g_) * UG + u_; \
        dlv[sl_][u_] = *(const LAS f32x4*)(sb + ODL + (16 * mb_ + 4 * q) * 4); ktf[sl_][u_] = __builtin_bit_cast(bf16x8, *(const LAS u32x4*)(sb + OKT + (16 * mb_ + n) * 64 + 16 * qs)); } } while (0)
#define CU_SBF(ks_) __builtin_bit_cast(bf16x8, (u32x4){cvt_pk_bf16(S[2 * (ks_)][0], S[2 * (ks_)][1]), cvt_pk_bf16(S[2 * (ks_)][2], S[2 * (ks_)][3]), cvt_pk_bf16(S[2 * (ks_) + 1][0], S[2 * (ks_) + 1][1]), cvt_pk_bf16(S[2 * (ks_) + 1][2], S[2 * (ks_) + 1][3])})
    const int qs = q ^ slot_swz(n);
    const bf16x8 vf8 = __builtin_bit_cast(bf16x8, *(const LAS u32x4*)(sb + OVT + (16 * wave + n) * 64 + 16 * qs));
    if (MODE == 1) {
        const f32x4 zero = (f32x4){0.f, 0.f, 0.f, 0.f};
        bf16x8 qf0[NKS], kf0[NKS], qf1[NKS], kf1[NKS];
#pragma unroll
        for (int ks = 0; ks < NKS; ++ks) { const int c0 = 64 * ks + 16 * q, o0 = n * ROWB + (c0 ^ ((IS_GLA ? ((n >> 1) & 7) : n) << 4));
            qf0[ks] = __builtin_bit_cast(bf16x8, *(const LAS u32x4*)(sb + OQ + o0)); kf0[ks] = __builtin_bit_cast(bf16x8, *(const LAS u32x4*)(sb + OK + o0)); }
        if (!IS_GLA) {
#pragma unroll
            for (int ks = 0; ks < NKS; ++ks) { const int c0 = 64 * ks + 16 * q, o1 = (16 + n) * ROWB + (c0 ^ (n << 4));
                qf1[ks] = __builtin_bit_cast(bf16x8, *(const LAS u32x4*)(sb + OQ + o1)); kf1[ks] = __builtin_bit_cast(bf16x8, *(const LAS u32x4*)(sb + OK + o1)); }
        }
        CU_FENCE();
        {
            f32x4 ao = zero, ao1 = zero, ap = zero, ap1 = zero;
#pragma unroll
            for (int ks = 0; ks < NKS; ++ks) { const bf16x8 sbf = CU_SBF(ks);
                if (ks & 1) { ao1 = __builtin_amdgcn_mfma_f32_16x16x32_bf16(qf0[ks], sbf, ao1, 0, 0, 0); ap1 = __builtin_amdgcn_mfma_f32_16x16x32_bf16(kf0[ks], qf0[ks], ap1, 0, 0, 0); }
                else { ao = __builtin_amdgcn_mfma_f32_16x16x32_bf16(qf0[ks], sbf, ao, 0, 0, 0); ap = __builtin_amdgcn_mfma_f32_16x16x32_bf16(kf0[ks], qf0[ks], ap, 0, 0, 0); } }
            if (IS_GLA) {
#pragma unroll
                for (int ks = 0; ks < NKS; ++ks) { const int c0 = 64 * ks + 16 * q, o1 = (16 + n) * ROWB + (c0 ^ (((n >> 1) & 7) << 4));
                    qf1[ks] = __builtin_bit_cast(bf16x8, *(const LAS u32x4*)(sb + OQ + o1)); kf1[ks] = __builtin_bit_cast(bf16x8, *(const LAS u32x4*)(sb + OK + o1)); }
                CU_FENCE();
            }
            ao = ao + ao1; ap = ap + ap1;
#pragma unroll
            for (int r = 0; r < 4; ++r) if (4 * q + r > n) ap[r] = 0.f;
            const bf16x8 pa = __builtin_bit_cast(bf16x8, (u32x4){cvt_pk_bf16(ap[0], ap[1]), cvt_pk_bf16(ap[2], ap[3]), 0u, 0u});
            ao = __builtin_amdgcn_mfma_f32_16x16x32_bf16(pa, vf8, ao, 0, 0, 0);
#pragma unroll
            for (int r = 0; r < 4; ++r) op[(size_t)(4 * q + r) * OW] = ao[r];
        }
        CU_LDU(0, 0);
        CU_FENCE();
        {
            f32x4 ao = zero, ao1 = zero, ap = zero, ap1 = zero, ax = zero, ax1 = zero;
#pragma unroll
            for (int ks = 0; ks < NKS; ++ks) { const bf16x8 sbf = CU_SBF(ks);
                if (ks & 1) { ao1 = __builtin_amdgcn_mfma_f32_16x16x32_bf16(qf1[ks], sbf, ao1, 0, 0, 0); ax1 = __builtin_amdgcn_mfma_f32_16x16x32_bf16(kf0[ks], qf1[ks], ax1, 0, 0, 0); ap1 = __builtin_amdgcn_mfma_f32_16x16x32_bf16(kf1[ks], qf1[ks], ap1, 0, 0, 0); }
                else { ao = __builtin_amdgcn_mfma_f32_16x16x32_bf16(qf1[ks], sbf, ao, 0, 0, 0); ax = __builtin_amdgcn_mfma_f32_16x16x32_bf16(kf0[ks], qf1[ks], ax, 0, 0, 0); ap = __builtin_amdgcn_mfma_f32_16x16x32_bf16(kf1[ks], qf1[ks], ap, 0, 0, 0); } }
            if (NUG > 1) { CU_LDU(1, 1); CU_FENCE(); }
            ao = ao + ao1; ap = ap + ap1; ax = ax + ax1;
#pragma unroll
            for (int r = 0; r < 4; ++r) if (4 * q + r > n) ap[r] = 0.f;
            const bf16x8 pa = __builtin_bit_cast(bf16x8, (u32x4){cvt_pk_bf16(ax[0], ax[1]), cvt_pk_bf16(ax[2], ax[3]), cvt_pk_bf16(ap[0], ap[1]), cvt_pk_bf16(ap[2], ap[3])});
            ao = __builtin_amdgcn_mfma_f32_16x16x32_bf16(pa, vf8, ao, 0, 0, 0);
#pragma unroll
            for (int r = 0; r < 4; ++r) op[(size_t)(16 + 4 * q + r) * OW] = ao[r];
        }
    } else {
        CU_LDU(0, 0);
        if (NUG > 1) CU_LDU(1, 1);
        CU_FENCE();
    }
#pragma unroll
    for (int g = 0; g < NUG; ++g) {
#pragma unroll
        for (int u = 0; u < UG; ++u) { const int mb = g * UG + u; S[mb] = __builtin_amdgcn_mfma_f32_16x16x32_bf16(ktf[g & 1][u], vf8, S[mb] * dlv[g & 1][u], 0, 0, 0); }
        if (g + 2 < NUG) { CU_LDU(g + 2, g & 1); CU_FENCE(); }
    }
#undef CU_FENCE
#undef CU_LDU
#undef CU_SBF
}
constexpr size_t ST_REC = 98304;
constexpr int NSEG_HG = 4, NSEG_GL = 6, NSEG_MAX = 6;
__device__ __forceinline__ int seg_u0(bool gla, int s) { return gla ? (s <= 2 ? 44 * s : 88 + 42 * (s - 2)) : 64 * s; }
__device__ __forceinline__ int seg_nu(bool gla, int s) { return gla ? (s < 2 ? 44 : 42) : 64; }
template <int DK, int MODE>
__device__ __forceinline__ void chain_item(const GAS unsigned char* blk0, int vt_off, GAS float* op0, GAS unsigned char* st, int seg, int nunits, LAS unsigned char* lds, int wave, int lane) {
    asm volatile("" : "+v"(lane), "+s"(wave));
    constexpr bool IS_GLA = (DK == 192);
    constexpr int BLK = IS_GLA ? GL_BLK : HG_BLK, UNITB = IS_GLA ? GL_SHARED + 8192 : HG_BLK, NMB = DK / 16;
    constexpr int SH0 = MODE == 1 ? 0 : (IS_GLA ? GL_OKT : HG_OKT);
    constexpr int SH_PIECES = (MODE == 1 ? (IS_GLA ? GL_SHARED : HG_BLK) : (IS_GLA ? GL_ODL + 768 - GL_OKT : HG_BLK - HG_OKT)) / 16;
    constexpr int T_PIECES = IS_GLA ? 512 : 0, T_LDS = GL_OVT;
    constexpr int PIECES = SH_PIECES + T_PIECES, NP = (PIECES + 511) / 512;
    constexpr int ODL_ = IS_GLA ? GL_ODL : HG_ODL;
    const int tid = wave * 64 + lane, n = lane & 15, q = lane >> 4;
    f32x4 S[NMB]; float dacc = 1.0f;
#pragma unroll
    for (int mb = 0; mb < NMB; ++mb) S[mb] = (f32x4){0.f, 0.f, 0.f, 0.f};
    if (MODE == 1) {
        for (int s = 0; s < seg; ++s) { const GAS unsigned char* rec = st + (size_t)s * 2 * ST_REC + (size_t)(wave * 64 + lane) * 16;
            f32x4 hh[NMB], dd[NMB];
#pragma unroll
            for (int mb = 0; mb < NMB; ++mb) { hh[mb] = *(const GAS f32x4*)(rec + (size_t)mb * 8192); dd[mb] = *(const GAS f32x4*)(st + (size_t)s * 2 * ST_REC + ST_REC + (16 * mb + 4 * q) * 4); }
            asm volatile("" ::: "memory");
#pragma unroll
            for (int mb = 0; mb < NMB; ++mb) S[mb] = S[mb] * dd[mb] + hh[mb]; }
    }
    u32x4 stgA[NP], stgB[NP];
#define CH_SRC(u, p_) (blk0 + (size_t)(u) * BLK + ((p_) < SH_PIECES ? SH0 + (p_) * 16 : vt_off + ((p_) - SH_PIECES) * 16))
#define CH_DST(p_) ((p_) < SH_PIECES ? SH0 + (p_) * 16 : T_LDS + ((p_) - SH_PIECES) * 16)
#define CH_LOAD(stg, u) do { _Pragma("unroll") for (int r_ = 0; r_ < NP; ++r_) { const int p_ = r_ * 512 + tid; const bool ok_ = (NP * 512 == PIECES) || p_ < PIECES; const int pc_ = ok_ ? p_ : 0; stg[r_] = *(const GAS u32x4*)CH_SRC(u, pc_); } } while (0)
#define CH_STORE(stg, buf) do { _Pragma("unroll") for (int r_ = 0; r_ < NP; ++r_) { const int p_ = r_ * 512 + tid; const bool ok_ = (NP * 512 == PIECES) || p_ < PIECES; const int pc_ = ok_ ? p_ : 0; \
        const int d_ = ok_ ? (buf) * UNITB + CH_DST(pc_) : 2 * UNITB + (p_ - PIECES) * 16; *(LAS u32x4*)(lds + d_) = stg[r_]; } } while (0)
#define CH_SYNC() do { asm volatile("s_waitcnt lgkmcnt(0)" ::: "memory"); __builtin_amdgcn_s_barrier(); asm volatile("" ::: "memory"); } while (0)
    CH_LOAD(stgA, 0); CH_STORE(stgA, 0);
    CH_LOAD(stgA, 1);
    CH_SYNC();
    GAS float* op = op0 + 16 * wave + n;
    for (int u = 0; u < nunits; u += 2) {
        if (u + 2 < nunits) CH_LOAD(stgB, u + 2);
        chain_unit<DK, MODE>(lds, S, op + (size_t)(u * 32) * OW, wave, n, q);
        if (MODE == 0 && tid < DK) dacc *= *(const LAS float*)(lds + ODL_ + 4 * tid);
        CH_STORE(stgA, 1);
        CH_SYNC();
        if (u + 3 < nunits) CH_LOAD(stgA, u + 3);
        chain_unit<DK, MODE>(lds + UNITB, S, op + (size_t)(u * 32 + 32) * OW, wave, n, q);
        if (MODE == 0 && tid < DK) dacc *= *(const LAS float*)(lds + UNITB + ODL_ + 4 * tid);
        if (u + 2 < nunits) CH_STORE(stgB, 0);
        CH_SYNC();
    }
    if (MODE == 0) { GAS unsigned char* rec = st + (size_t)seg * 2 * ST_REC + (size_t)(wave * 64 + lane) * 16;
#pragma unroll
        for (int mb = 0; mb < NMB; ++mb) *(GAS f32x4*)(rec + (size_t)mb * 8192) = S[mb];
        if (tid < DK) *(GAS float*)(st + (size_t)seg * 2 * ST_REC + ST_REC + 4 * tid) = dacc; }
#undef CH_SRC
#undef CH_DST
#undef CH_LOAD
#undef CH_STORE
#undef CH_SYNC
}

template <int MODE>
__device__ __forceinline__ void phase_chain(const Ctx& a, int l, LAS unsigned char* lds, int wave, int lane) {
    const int bx = blockIdx.x, G = gridDim.x;
    constexpr int nhg = 24 * (MODE == 0 ? NSEG_HG - 1 : NSEG_HG), nitems = nhg + 24 * (MODE == 0 ? NSEG_GL - 1 : NSEG_GL);
    for (int it = bx; it < nitems; it += G) {
        const bool gla = it >= nhg; const int j = gla ? it - nhg : it, c = j % 24, seg = j / 24, u0 = seg_u0(gla, seg), nu = seg_nu(gla, seg);
        GAS unsigned char* st = a.ws() + WS_ST + (size_t)(gla ? 24 + c : c) * (NSEG_MAX - 1) * 2 * ST_REC;
        if (!gla) { const int b = c / 12, h = c % 12;
            chain_item<128, MODE>(a.ws() + WS_HGB + ((size_t)(b * 12 + h) * NUNIT + u0) * HG_BLK, 0, (GAS float*)(a.ws() + WS_O) + ((size_t)b * SEQ + u0 * 32) * OW + h * 128, st, seg, nu, lds, wave, lane); }
        else { const int b = c / 12, h = (c % 12) / 3, sl = c % 3;
            chain_item<192, MODE>(a.ws() + WS_GLB + ((size_t)(b * 4 + h) * NUNIT + u0) * GL_BLK, GL_OVT + 8192 * sl, (GAS float*)(a.ws() + WS_O) + ((size_t)b * SEQ + u0 * 32) * OW + HGW + h * 384 + sl * 128, st, seg, nu, lds, wave, lane); }
        __syncthreads();
    }
    if (MODE == 0) { for (int it = (G >= nitems + 16) ? bx - nitems : bx; it < 16; it += G) { if (it < 0) continue; s5_scan_item(a, l, it, wave, lane); } }
}
__device__ __forceinline__ float red16(float v) {
    v += __int_as_float(__builtin_amdgcn_mov_dpp(__float_as_int(v), 0xB1, 0xF, 0xF, true)); v += __int_as_float(__builtin_amdgcn_mov_dpp(__float_as_int(v), 0x4E, 0xF, 0xF, true));
    v += __int_as_float(__builtin_amdgcn_mov_dpp(__float_as_int(v), 0x141, 0xF, 0xF, true)); v += __int_as_float(__builtin_amdgcn_mov_dpp(__float_as_int(v), 0x140, 0xF, 0xF, true)); return v; }
__device__ __forceinline__ void phase_finalize(const Ctx& a, int l, int wave, int lane) {
    const GAS bf16_t* P = (const GAS bf16_t*)(a.ws() + WS_P); const GAS float* O = (const GAS float*)(a.ws() + WS_O); GAS bf16_t* MX = (GAS bf16_t*)(a.ws() + WS_MIXED);
    const GAS float* hgg = a.in(I_HGG) + l * HGW; const GAS float* hgb = a.in(I_HGB) + l * HGW; const GAS float* glg = a.in(I_GLG) + l * HGW;
    const int gw = blockIdx.x * 8 + wave, NGW = gridDim.x * 8;
    const bool act = lane < 48;
    f32x4 pg[3][2], pb[3][2], qg[4][2];
#pragma unroll
    for (int it = 0; it < 3; ++it) { const int c = (it * 4 + (lane >> 4)) * 128 + (lane & 15) * 8;
        pg[it][0] = *(const GAS f32x4*)(hgg + c); pg[it][1] = *(const GAS f32x4*)(hgg + c + 4); pb[it][0] = *(const GAS f32x4*)(hgb + c); pb[it][1] = *(const GAS f32x4*)(hgb + c + 4); }
#pragma unroll
    for (int h = 0; h < 4; ++h) { const int c = h * 384 + (act ? lane : 0) * 8; qg[h][0] = *(const GAS f32x4*)(glg + c); qg[h][1] = *(const GAS f32x4*)(glg + c + 4); }
    for (int row = gw; row < MTOK; row += NGW) {
        const GAS float* orow = O + (size_t)row * OW; const GAS bf16_t* prow = P + (size_t)row * INP; GAS bf16_t* mrow = MX + (size_t)row * DM;
        f32x4 o0[7], o1[7]; u32x4 gq[7];
#pragma unroll
        for (int it = 0; it < 3; ++it) { const int c = (it * 4 + (lane >> 4)) * 128 + (lane & 15) * 8;
            o0[it] = *(const GAS f32x4*)(orow + c); o1[it] = *(const GAS f32x4*)(orow + c + 4); gq[it] = *(const GAS u32x4*)(prow + C_GB + c); }
#pragma unroll
        for (int h = 0; h < 4; ++h) { const int c = h * 384 + (act ? lane : 0) * 8;
            o0[3 + h] = *(const GAS f32x4*)(orow + HGW + c); o1[3 + h] = *(const GAS f32x4*)(orow + HGW + c + 4); gq[3 + h] = *(const GAS u32x4*)(prow + C_GC + c); }
        asm volatile("" ::: "memory");
#pragma unroll
        for (int it = 0; it < 3; ++it) { const int c = (it * 4 + (lane >> 4)) * 128 + (lane & 15) * 8; const u32x4 gg = gq[it];
            float v[8] = {sigmoidf_(bf_lo(gg.x)) * o0[it][0], sigmoidf_(bf_hi(gg.x)) * o0[it][1], sigmoidf_(bf_lo(gg.y)) * o0[it][2], sigmoidf_(bf_hi(gg.y)) * o0[it][3],
                          sigmoidf_(bf_lo(gg.z)) * o1[it][0], sigmoidf_(bf_hi(gg.z)) * o1[it][1], sigmoidf_(bf_lo(gg.w)) * o1[it][2], sigmoidf_(bf_hi(gg.w)) * o1[it][3]};
            float s = 0.f, ss = 0.f;
#pragma unroll
            for (int i = 0; i < 8; ++i) { s += v[i]; ss += v[i] * v[i]; }
            s = red16(s); ss = red16(ss);
            const float mu = s * (1.0f / 128.0f), rs = 1.0f / sqrtf(fmaxf(ss * (1.0f / 128.0f) - mu * mu, 0.f) + LN_EPS);
            const f32x4 g0 = pg[it][0], g1 = pg[it][1], b0 = pb[it][0], b1 = pb[it][1];
            u32x4 w; w.x = cvt_pk_bf16((v[0] - mu) * rs * g0[0] + b0[0], (v[1] - mu) * rs * g0[1] + b0[1]); w.y = cvt_pk_bf16((v[2] - mu) * rs * g0[2] + b0[2], (v[3] - mu) * rs * g0[3] + b0[3]);
            w.z = cvt_pk_bf16((v[4] - mu) * rs * g1[0] + b1[0], (v[5] - mu) * rs * g1[1] + b1[1]); w.w = cvt_pk_bf16((v[6] - mu) * rs * g1[2] + b1[2], (v[7] - mu) * rs * g1[3] + b1[3]);
            *(GAS u32x4*)(mrow + S5W + c) = w; }
#pragma unroll
        for (int h = 0; h < 4; ++h) { const int c = h * 384 + lane * 8;
            f32x4 p0 = o0[3 + h], p1 = o1[3 + h]; const u32x4 gg = gq[3 + h];
            if (!act) { p0 = (f32x4){0.f, 0.f, 0.f, 0.f}; p1 = p0; }
            const float ss = wave_sum((p0[0] * p0[0] + p0[1] * p0[1]) + (p0[2] * p0[2] + p0[3] * p0[3]) + (p1[0] * p1[0] + p1[1] * p1[1]) + (p1[2] * p1[2] + p1[3] * p1[3]));
            const float rms = 1.0f / sqrtf(ss * (1.0f / 384.0f) + LN_EPS);
            if (act) { const f32x4 g0 = qg[h][0], g1 = qg[h][1];
                const float z[8] = {bf_lo(gg.x), bf_hi(gg.x), bf_lo(gg.y), bf_hi(gg.y), bf_lo(gg.z), bf_hi(gg.z), bf_lo(gg.w), bf_hi(gg.w)};
                u32x4 w; w.x = cvt_pk_bf16(p0[0] * rms * g0[0] * (z[0] * sigmoidf_(z[0])), p0[1] * rms * g0[1] * (z[1] * sigmoidf_(z[1])));
                w.y = cvt_pk_bf16(p0[2] * rms * g0[2] * (z[2] * sigmoidf_(z[2])), p0[3] * rms * g0[3] * (z[3] * sigmoidf_(z[3])));
                w.z = cvt_pk_bf16(p1[0] * rms * g1[0] * (z[4] * sigmoidf_(z[4])), p1[1] * rms * g1[1] * (z[5] * sigmoidf_(z[5])));
                w.w = cvt_pk_bf16(p1[2] * rms * g1[2] * (z[6] * sigmoidf_(z[6])), p1[3] * rms * g1[3] * (z[7] * sigmoidf_(z[7])));
                *(GAS u32x4*)(mrow + S5W + HGW + c) = w; } }
    }
}

constexpr int PH_PRO = 0, PH_MOD = 1, PH_LN0 = 2, PH_L0 = 3, PH_PER_LAYER = 10, N_PHASES = PH_L0 + DEPTH * PH_PER_LAYER;
constexpr int CW_BAR = 4096;

__global__ void __launch_bounds__(512, 2) hybrid_fwd(Args args) {
    extern __shared__ __attribute__((aligned(16))) unsigned char lds_raw[];
    LAS unsigned char* lds = (LAS unsigned char*)lds_raw;
    const int wave = __builtin_amdgcn_readfirstlane((int)threadIdx.x >> 6);
#define lane lane_id_v()
    volatile LAS unsigned* MISC = (volatile LAS unsigned*)(lds + LDSCTL_OFF);
    Ctx ctx; ctx.t = (volatile LAS unsigned long long*)(lds + LDSCTL_OFF + 64);
    if (wave == 0) { const int ln_ = lane; unsigned long long v = 0ull;
#pragma unroll
        for (int i = 0; i < N_IN; ++i) v = (ln_ == i) ? (unsigned long long)args.in[i] : v;
        v = (ln_ == 30) ? (unsigned long long)args.out : v; v = (ln_ == 31) ? (unsigned long long)args.ws : v;
        if (ln_ < 32) ctx.t[ln_] = v;
        if (ln_ < 16) MISC[ln_] = 0u; }
    __syncthreads();
    const int lo = args.ph_lo, hi = args.ph_hi;
    XcdBarrier bar; bar.bar = (unsigned*)(ctx.ws() + WS_CTL) + CW_BAR; bar.x = 0; bar.st = nullptr; bar.w0 = (wave == 0) ? 1u : 0u;
    if (hi - lo > 1) bar = xcd_barrier_post((unsigned*)(ctx.ws() + WS_CTL) + CW_BAR, MISC + 8, (wave == 0) ? 1u : 0u);
#define IN(k) (lo <= (k) && (k) < hi)
#define OPQ() int ln = lane, wv = wave; asm volatile("" : "+s"(wv))
#define SEAM(k) do { if (IN(k) && IN((k) + 1)) xcd_barrier(bar); } while (0)
#define WSP(T, off) ((GAS T*)(ctx.ws() + (off)))
#define WSG(T, off) ((T*)(ctx.ws() + (off)))

    if (IN(PH_PRO)) { OPQ(); phase_prologue(ctx, lds, wv, ln); }
    SEAM(PH_PRO);
    if (IN(PH_MOD)) { OPQ(); phase_mod(ctx, wv, ln); }
    SEAM(PH_MOD);
    if (IN(PH_LN0)) { OPQ(); phase_h0(ctx.in(I_X), WSP(float, WS_MOD), WSP(bf16_t, WS_H), wv, ln); }
    SEAM(PH_LN0);

    for (int l = 0; l < DEPTH; ++l) {
        const int p0 = PH_L0 + l * PH_PER_LAYER;
        const size_t wto = WS_WT + (size_t)l * WT_LAYER, modo = WS_MOD + (size_t)l * NB * 6 * DM * 4;
        if (IN(p0 + 0)) { pg8::Gemm g{WSG(bf16_t, WS_H), WSG(const bf16_t, wto + WT_IN), MTOK, INP, DM}; pg8::StaticOrder S; S.init(MTOK, INP, (int)gridDim.x, (int)blockIdx.x);
            EpiProj E{WSP(bf16_t, WS_P), WSP(bf16_t, WS_UX)}; pg8::gemm_phase<EpiProj, pg8::StaticOrder, true, true>(lds, g, S, E, wave); }
        SEAM(p0 + 0);
        if (IN(p0 + 1)) {
            { pg8::Gemm g{WSG(bf16_t, WS_UX), WSG(const bf16_t, WS_S5W1 + (size_t)l * S5_W1_LAYER), 64 * 256, 64 * 256, S5K}; S5Order S{(int)gridDim.x, (int)blockIdx.x, 64, 0};
              EpiS5A E{WSP(float, WS_SLOC)}; pg8::gemm_phase<EpiS5A, S5Order, true, true>(lds, g, S, E, wave); }
            { OPQ(); phase_pre(ctx, l, lds, wv, ln); }
            }
        SEAM(p0 + 1);
        if (IN(p0 + 2)) { OPQ(); phase_chain<0>(ctx, l, lds, wv, ln); }
        SEAM(p0 + 2);
        if (IN(p0 + 3)) {
            { pg8::Gemm g{WSG(bf16_t, WS_UX), WSG(const bf16_t, WS_S5T + (size_t)l * S5_T_LAYER), 64 * 256, 64 * 1024, S5K}; S5Order S{(int)gridDim.x, (int)blockIdx.x, 256, 2};
              EpiS5C E{WSP(bf16_t, WS_Z)}; pg8::gemm_phase<EpiS5C, S5Order, true, true>(lds, g, S, E, wave);
            }
            { OPQ(); phase_chain<1>(ctx, l, lds, wv, ln); }
            }
        SEAM(p0 + 3);
        if (IN(p0 + 4)) { pg8::Gemm g{WSG(bf16_t, WS_Z), WSG(const bf16_t, wto + WT_GLU), MTOK, S5W, S5W}; pg8::StaticOrder S; S.init(MTOK, S5W, (int)gridDim.x, (int)blockIdx.x);
            EpiGlu E{WSP(bf16_t, WS_Z), WSP(bf16_t, WS_MIXED), ctx.in(I_GLUB) + l * S5W}; pg8::gemm_phase<EpiGlu, pg8::StaticOrder, true, true>(lds, g, S, E, wave);
            { OPQ(); phase_finalize(ctx, l, wv, ln); } }
        SEAM(p0 + 4);
        if (IN(p0 + 5)) { pg8::Gemm g{WSG(bf16_t, WS_MIXED), WSG(const bf16_t, wto + WT_OUT), MTOK, DM, DM}; pg8::StaticOrder S; S.init(MTOK, DM, (int)gridDim.x, (int)blockIdx.x);
            EpiDelta E{WSP(bf16_t, WS_DELTA), WSP(float, modo) + 2 * DM};
            pg8::gemm_phase<EpiDelta, pg8::StaticOrder, true, true>(lds, g, S, E, wave); }
        SEAM(p0 + 5);
        if (IN(p0 + 6)) { OPQ(); const XRes xa{(GAS unsigned*)ctx.out(), WSP(unsigned, WS_XL)}, xb{l + 1 < DEPTH ? (GAS unsigned*)ctx.out() : WSP(unsigned, WS_WT), WSP(unsigned, WS_XL)};
            if (l == 0) phase_lnres<true, true, false>(ctx.in(I_X), xa, WSP(bf16_t, WS_DELTA), nullptr, xb, ctx.in(I_LN1G) + l * DM, ctx.in(I_LN1B) + l * DM, WSP(float, modo), 3, 4, WSP(bf16_t, WS_H), lds, wv, ln);
            else phase_lnres<true, false, false>(nullptr, xa, WSP(bf16_t, WS_DELTA), nullptr, xb, ctx.in(I_LN1G) + l * DM, ctx.in(I_LN1B) + l * DM, WSP(float, modo), 3, 4, WSP(bf16_t, WS_H), lds, wv, ln); }
        SEAM(p0 + 6);
        if (IN(p0 + 7)) { pg8::Gemm g{WSG(bf16_t, WS_H), WSG(const bf16_t, wto + WT_GU), MTOK, 2 * DFF, DM}; pg8::StaticOrder S; S.init(MTOK, 2 * DFF, (int)gridDim.x, (int)blockIdx.x);
            EpiSwiglu E{WSP(bf16_t, WS_P)}; pg8::gemm_phase<EpiSwiglu, pg8::StaticOrder, true, true>(lds, g, S, E, wave); }
        SEAM(p0 + 7);
        if (IN(p0 + 8)) { pg8::Gemm g{WSG(bf16_t, WS_P), WSG(const bf16_t, wto + WT_DN), MTOK, DM, DFF}; pg8::StaticOrderT<2> S; S.init(MTOK, DM, (int)gridDim.x, (int)blockIdx.x);
            EpiDelta E{WSP(bf16_t, WS_DELTA), WSP(float, modo) + 5 * DM};
            pg8::gemm_phase<EpiDelta, pg8::StaticOrderT<2>, true, true>(lds, g, S, E, wave); }
        SEAM(p0 + 8);
        if (IN(p0 + 9)) { OPQ();
            const XRes xb{l + 1 < DEPTH ? (GAS unsigned*)ctx.out() : WSP(unsigned, WS_WT), WSP(unsigned, WS_XL)};
            if (l + 1 < DEPTH) phase_lnres<true, false, false>(nullptr, xb, WSP(bf16_t, WS_DELTA), nullptr, xb, ctx.in(I_LN2G) + l * DM, ctx.in(I_LN2B) + l * DM, WSP(float, modo) + (size_t)NB * 6 * DM, 0, 1, WSP(bf16_t, WS_H), lds, wv, ln);
            else phase_lnres<false, false, true>(nullptr, xb, WSP(bf16_t, WS_DELTA), ctx.out(), xb, ctx.in(I_LN2G) + l * DM, ctx.in(I_LN2B) + l * DM, nullptr, 0, 0, nullptr, lds, wv, ln);
        }
        SEAM(p0 + 9);
    }
#undef IN
#undef SEAM
#undef OPQ
#undef WSP
#undef WSG
#undef lane
}

extern "C" void kernel_launch(void* const* d_in, const int* in_sizes, int n_in, void* d_out, int out_size, void* d_ws, size_t ws_size, hipStream_t stream) {
    static int grid = 0;
    if (grid == 0) {
        if (n_in != N_IN || out_size != MTOK * DM || ws_size < WS_END) { fprintf(stderr, "kernel_launch: unexpected problem (n_in %d, out %d, ws %zu < %zu); nothing launched\n", n_in, out_size, ws_size, (size_t)WS_END); grid = -1; return; }
        int dev = 0, cus = 0, per_cu = 0;
        if (hipGetDevice(&dev) != hipSuccess || hipDeviceGetAttribute(&cus, hipDeviceAttributeMultiprocessorCount, dev) != hipSuccess) { grid = -1; return; }
        if (hipFuncSetAttribute((const void*)hybrid_fwd, hipFuncAttributeMaxDynamicSharedMemorySize, LDS_BYTES) != hipSuccess) { fprintf(stderr, "kernel_launch: hipFuncSetAttribute failed\n"); grid = -1; return; }
        if (hipOccupancyMaxActiveBlocksPerMultiprocessor(&per_cu, (const void*)hybrid_fwd, 512, LDS_BYTES) != hipSuccess || per_cu < 1) fprintf(stderr, "kernel_launch: occupancy query reports %d blocks per CU\n", per_cu);
        (void)hipGetLastError();
        grid = cus;
    }
    if (grid < 0) return;
    (void)in_sizes;
    if (hipMemsetAsync((char*)d_ws + WS_CTL, 0, CTL_ZERO_BYTES, stream) != hipSuccess) return;
    Args a{};
    for (int i = 0; i < N_IN; ++i) a.in[i] = (const float*)d_in[i];
    a.out = (float*)d_out; a.ws = (unsigned char*)d_ws;
    a.ph_lo = 0; a.ph_hi = N_PHASES; hipLaunchKernelGGL(hybrid_fwd, dim3(grid), dim3(512), LDS_BYTES, stream, a);
}
```

```cpp
#include <hip/hip_runtime.h>
#include <cstdio>
#include <cstdint>
namespace pg8 {
#define PG8_LAS __attribute__((address_space(3)))
typedef unsigned short bf16_t;
typedef short bf16x8 __attribute__((ext_vector_type(8)));
typedef float f32x4 __attribute__((ext_vector_type(4)));
typedef unsigned u32x4 __attribute__((ext_vector_type(4)));
constexpr int BM = 256, BK = 64, HALF = 128, HTB = HALF * BK * 2  , STAGE_BYTES = 8 * HTB, NXCD = 8, WGM = 8;

__host__ __device__ __forceinline__ int lds_byte(int r, int c) { const int st = (r >> 4) * 2 + (c >> 5), rr = r & 15, cc = c & 31, ob = rr * 64 + cc * 2; return st * 1024 + (ob ^ (((ob >> 9) & 1) << 5)); }
__host__ __device__ __forceinline__ void stage_rc(int b, int& R, int& C) { const int st = b / 1024, sb = b % 1024, swz = sb ^ (((sb >> 9) & 1) << 5); R = (st >> 1) * 16 + swz / 64; C = (st & 1) * 32 + (swz % 64) / 2; }
__host__ __device__ __forceinline__ int perm32(int rho) { const int n = rho >> 4, i = rho & 15; return 8 * (i >> 2) + 4 * n + (i & 3); }

struct Unit { int pm, pn; };
struct Gemm { const bf16_t* A; const bf16_t* Bt; int M, N, K; };

template <int WGM_>
struct StaticOrderT {
    static constexpr int WGM = WGM_;
    int nM, nN, nwg, G, c;
    __host__ __device__ void init(int M, int N, int G_, int c_) { nM = M / BM; nN = N / BM; nwg = nM * nN; G = G_; c = c_; }
    __host__ __device__ bool next(int i, Unit& u) const {
        const long L = (long)i * G + c; if (L >= nwg) return false;
        int wgid = (int)L; { const int q = nwg / NXCD, r = nwg % NXCD, xcd = wgid % NXCD, off = wgid / NXCD; wgid = (xcd < r ? xcd * (q + 1) : r * (q + 1) + (xcd - r) * q) + off; }
        const int nig = WGM * nN, gid = wgid / nig, fm = gid * WGM, gsz = (nM - fm) < WGM ? (nM - fm) : WGM;
        u.pm = fm + ((wgid % nig) % gsz); u.pn = (wgid % nig) / gsz; return true;
    }
    __device__ __forceinline__ void a_ready(const Unit&) const {}
    __device__ __forceinline__ void done(const Unit&) const {}
};
typedef StaticOrderT<8> StaticOrder;
__device__ __forceinline__ unsigned cvt_pk_bf16(float lo, float hi) { unsigned r; asm volatile("v_cvt_pk_bf16_f32 %0, %1, %2" : "=v"(r) : "v"(lo), "v"(hi)); return r; }
typedef float f32x2 __attribute__((ext_vector_type(2)));
template <class Epi, class Sched, bool ALIGN_EPI = false, bool SP2 = false>
__device__ __forceinline__ void gemm_phase(PG8_LAS unsigned char* lds, const Gemm g, const Sched& S, const Epi& E, int wave_id) {
    int tid_; asm volatile("v_mbcnt_lo_u32_b32 %0, -1, 0\n\tv_mbcnt_hi_u32_b32 %0, -1, %0" : "=v"(tid_)); tid_ += wave_id * 64;
    const int tid = tid_, wid = __builtin_amdgcn_readfirstlane(tid >> 6), lane = tid & 63, wr = wid >> 2, wc = wid & 3, fr = lane & 15, fq = lane >> 4;
    const int K = g.K, nt = K / BK;
    unsigned voffA[2], voffB[2];
#pragma unroll
    for (int i = 0; i < 2; ++i) { int R, C; stage_rc(tid * 16 + i * 8192, R, C); const int Rb = Epi::PERM ? ((R & ~31) + perm32(R & 31)) : R;
        voffA[i] = (unsigned)(R * K + C) * 2u; voffB[i] = (unsigned)(Rb * K + C) * 2u; }
    const size_t kstep = (size_t)(BK * 2);
    const size_t hstep = (size_t)HALF * K * 2;
    const size_t tstep = 2 * hstep;
    const unsigned ldsw = (unsigned)wid * 1024u;
    const int aoff = lds_byte(wr * 64 + fr, fq * 8), boff = lds_byte(wc * 32 + fr, fq * 8);
#define PG8_SA(b, h) (((b) * 2 + (h)) * HTB)
#define PG8_SB(b, h) ((4 + (b) * 2 + (h)) * HTB)
#define PG8_STAGE(bufoff, gbase, voff) do { _Pragma("unroll") for (int _i = 0; _i < 2; ++_i) \
        __builtin_amdgcn_global_load_lds((const unsigned*)((const char*)(gbase) + (voff)[_i]), (PG8_LAS unsigned*)(lds + (bufoff) + ldsw + _i * 8192), 16, 0, 0); } while (0)
#define PG8_LDA(dst, b, h) do { _Pragma("unroll") for (int m = 0; m < 4; ++m) _Pragma("unroll") for (int k = 0; k < 2; ++k) dst[m][k] = *(const PG8_LAS bf16x8*)(lds + PG8_SA(b, h) + aoff + m * 2048 + k * 1024); } while (0)
#define PG8_LDB(dst, b, h) do { _Pragma("unroll") for (int n = 0; n < 2; ++n) _Pragma("unroll") for (int k = 0; k < 2; ++k) dst[n][k] = *(const PG8_LAS bf16x8*)(lds + PG8_SB(b, h) + boff + n * 2048 + k * 1024); } while (0)
#define PG8_MMA(ai, bj, At, Bt) do { __builtin_amdgcn_s_setprio(1); _Pragma("unroll") for (int m = 0; m < 4; ++m) _Pragma("unroll") for (int n = 0; n < 2; ++n) _Pragma("unroll") for (int k = 0; k < 2; ++k) \
        acc[ai][bj][m][n] = __builtin_amdgcn_mfma_f32_16x16x32_bf16(Bt[n][k], At[m][k], acc[ai][bj][m][n], 0, 0, 0); __builtin_amdgcn_s_setprio(0); } while (0)
#define PG8_WAIT_V(n) asm volatile("s_waitcnt vmcnt(" #n ")" ::: "memory")
#define PG8_WAIT_L(n) asm volatile("s_waitcnt lgkmcnt(" #n ")" ::: "memory")
#define PG8_BAR __builtin_amdgcn_s_barrier()
#define PG8_SCHED __builtin_amdgcn_sched_barrier(0)
    Unit cur, nxt; int ui = 0;
    if (!S.next(0, cur)) return;
    f32x4 acc[2][2][4][2];
#pragma unroll
    for (int a = 0; a < 2; ++a)
#pragma unroll
        for (int b = 0; b < 2; ++b)
#pragma unroll
            for (int m = 0; m < 4; ++m)
#pragma unroll
                for (int n = 0; n < 2; ++n) acc[a][b][m][n] = (f32x4){0.f, 0.f, 0.f, 0.f};
    bf16x8 At[4][2], B0[2][2], B1[2][2];
    const char* cA = (const char*)g.A + (size_t)cur.pm * tstep; const char* cB = (const char*)g.Bt + (size_t)cur.pn * tstep;
    S.a_ready(cur);
    if constexpr (SP2) {
        PG8_STAGE(PG8_SB(0, 0), cB, voffB); PG8_STAGE(PG8_SB(0, 1), cB + hstep, voffB); PG8_STAGE(PG8_SA(0, 0), cA, voffA); PG8_STAGE(PG8_SA(0, 1), cA + hstep, voffA);
        if (wr == 1) PG8_BAR;
        PG8_WAIT_V(2); PG8_BAR;
        PG8_STAGE(PG8_SB(1, 0), cB + kstep, voffB); PG8_STAGE(PG8_SA(1, 0), cA + kstep, voffA); PG8_STAGE(PG8_SB(1, 1), cB + hstep + kstep, voffB);
        PG8_WAIT_V(6); PG8_BAR;
    } else {
        PG8_STAGE(PG8_SB(0, 0), cB, voffB); PG8_STAGE(PG8_SA(0, 0), cA, voffA); PG8_STAGE(PG8_SB(0, 1), cB + hstep, voffB); PG8_STAGE(PG8_SA(0, 1), cA + hstep, voffA);
        if (wr == 1) PG8_BAR;
        PG8_WAIT_V(4); PG8_BAR;
        PG8_STAGE(PG8_SB(1, 0), cB + kstep, voffB); PG8_STAGE(PG8_SA(1, 0), cA + kstep, voffA); PG8_STAGE(PG8_SB(1, 1), cB + hstep + kstep, voffB);
        PG8_WAIT_V(6); PG8_BAR;
    }
    for (;;) {
        const bool has_next = S.next(ui + 1, nxt);
        const char* nA = has_next ? (const char*)g.A + (size_t)nxt.pm * tstep : cA; const char* nB = has_next ? (const char*)g.Bt + (size_t)nxt.pn * tstep : cB;
        for (int t = 0; t < nt; t += 2) {
            const bool last = (t == nt - 2);
            const char* a1 = cA + (size_t)(t + 1) * kstep;
            const char* a2 = last ? nA : cA + (size_t)(t + 2) * kstep; const char* b2 = last ? nB : cB + (size_t)(t + 2) * kstep;
            const char* a3 = a2 + kstep; const char* b3 = b2 + kstep;
            if (last && has_next) S.a_ready(nxt);
            if constexpr (SP2) {
            PG8_LDB(B0, 0, 0); PG8_LDB(B1, 0, 1); PG8_SCHED; PG8_LDA(At, 0, 0); PG8_STAGE(PG8_SA(1, 1), a1 + hstep, voffA);
            PG8_WAIT_V(8); PG8_WAIT_L(0); PG8_BAR; PG8_MMA(0, 0, At, B0); PG8_MMA(0, 1, At, B1); PG8_BAR; PG8_SCHED;
            PG8_LDA(At, 0, 1); PG8_STAGE(PG8_SB(0, 0), b2, voffB); PG8_STAGE(PG8_SB(0, 1), b2 + hstep, voffB); PG8_STAGE(PG8_SA(0, 0), a2, voffA);
            PG8_WAIT_V(8); PG8_WAIT_L(0); PG8_BAR; PG8_MMA(1, 0, At, B0); PG8_MMA(1, 1, At, B1); PG8_BAR; PG8_SCHED;
            PG8_LDB(B0, 1, 0); PG8_LDB(B1, 1, 1); PG8_SCHED; PG8_LDA(At, 1, 0); PG8_STAGE(PG8_SA(0, 1), a2 + hstep, voffA);
            PG8_WAIT_V(8); PG8_WAIT_L(0); PG8_BAR; PG8_MMA(0, 0, At, B0); PG8_MMA(0, 1, At, B1); PG8_BAR; PG8_SCHED;
            PG8_LDA(At, 1, 1); PG8_STAGE(PG8_SB(1, 0), b3, voffB); PG8_STAGE(PG8_SB(1, 1), b3 + hstep, voffB); PG8_STAGE(PG8_SA(1, 0), a3, voffA);
            PG8_WAIT_V(8); PG8_WAIT_L(0); PG8_BAR; PG8_MMA(1, 0, At, B0); PG8_MMA(1, 1, At, B1); PG8_BAR; PG8_SCHED;
            } else {
            PG8_LDB(B0, 0, 0); PG8_SCHED; PG8_LDA(At, 0, 0); PG8_STAGE(PG8_SA(1, 1), a1 + hstep, voffA);
            PG8_WAIT_L(8); PG8_BAR; PG8_WAIT_L(0); PG8_MMA(0, 0, At, B0); PG8_BAR; PG8_SCHED;
            PG8_LDB(B1, 0, 1); PG8_STAGE(PG8_SB(0, 0), b2, voffB);
            PG8_BAR; PG8_WAIT_L(0); PG8_MMA(0, 1, At, B1); PG8_BAR;
            PG8_LDA(At, 0, 1); PG8_STAGE(PG8_SA(0, 0), a2, voffA);
            PG8_BAR; PG8_WAIT_L(0); PG8_MMA(1, 0, At, B0); PG8_BAR; PG8_SCHED;
            PG8_STAGE(PG8_SB(0, 1), b2 + hstep, voffB);
            PG8_WAIT_V(6); PG8_BAR; PG8_MMA(1, 1, At, B1); PG8_BAR;
            PG8_LDB(B0, 1, 0); PG8_SCHED; PG8_LDA(At, 1, 0); PG8_STAGE(PG8_SA(0, 1), a2 + hstep, voffA);
            PG8_WAIT_L(8); PG8_BAR; PG8_WAIT_L(0); PG8_MMA(0, 0, At, B0); PG8_BAR; PG8_SCHED;
            PG8_LDB(B1, 1, 1); PG8_STAGE(PG8_SB(1, 0), b3, voffB);
            PG8_BAR; PG8_WAIT_L(0); PG8_MMA(0, 1, At, B1); PG8_BAR;
            PG8_LDA(At, 1, 1); PG8_STAGE(PG8_SA(1, 0), a3, voffA);
            PG8_BAR; PG8_WAIT_L(0); PG8_MMA(1, 0, At, B0); PG8_BAR; PG8_SCHED;
            PG8_STAGE(PG8_SB(1, 1), b3 + hstep, voffB);
            PG8_WAIT_V(6); PG8_BAR; PG8_MMA(1, 1, At, B1); PG8_BAR;
            }
        }
        if constexpr (ALIGN_EPI) { if (wr == 0) PG8_BAR; }
        if constexpr (!Epi::AFTER_DRAIN) { E(acc, cur, wr, wc, fr, fq); S.done(cur); }
        if (!has_next) break;
#pragma unroll
        for (int a = 0; a < 2; ++a)
#pragma unroll
            for (int b = 0; b < 2; ++b)
#pragma unroll
                for (int m = 0; m < 4; ++m)
#pragma unroll
                    for (int n = 0; n < 2; ++n) acc[a][b][m][n] = (f32x4){0.f, 0.f, 0.f, 0.f};
        cur = nxt; cA = nA; cB = nB; ++ui;
        if constexpr (ALIGN_EPI) { if (wr == 1) PG8_BAR; }
    }
    PG8_WAIT_V(0);
    if constexpr (!ALIGN_EPI) { if (wr == 0) PG8_BAR; }
    PG8_BAR;
    if constexpr (Epi::AFTER_DRAIN) { E.fused(acc, cur, wr, wc, fr, fq, lds, wid, lane); S.done(cur); }
#undef PG8_SA
#undef PG8_SB
#undef PG8_STAGE
#undef PG8_LDA
#undef PG8_LDB
#undef PG8_MMA
#undef PG8_WAIT_V
#undef PG8_WAIT_L
#undef PG8_BAR
#undef PG8_SCHED
}
}
#define LAS __attribute__((address_space(3)))
#define XB_TMO      128
#define XB_XCNT(j)  (256  + 64 * (j))
#define XB_XSUB(j)  (1280 + 64 * (j))
#define XB_XGEN(j)  (2304 + 64 * (j))
#define XB_TOP      3328
#define XB_TOPGEN   3392
#define XCD_BAR_WORDS 3456
#define XB_SPIN_CAP (1u << 24)

__device__ __forceinline__ unsigned xb_ld(unsigned* p)              { return __hip_atomic_load(p, __ATOMIC_RELAXED, __HIP_MEMORY_SCOPE_AGENT); }
__device__ __forceinline__ unsigned xb_add(unsigned* p, unsigned v) { return __hip_atomic_fetch_add(p, v, __ATOMIC_RELAXED, __HIP_MEMORY_SCOPE_AGENT); }
__device__ __forceinline__ unsigned xb_xcc_id() { return (unsigned)__builtin_amdgcn_s_getreg((3 << 11) | 20) & 0xFu; }
#define XB_SPIN(cond, bar) do { unsigned _sp = 0; while (cond) { __builtin_amdgcn_s_sleep(1); \
    if ((++_sp & 255u) == 0u) { if (xb_ld(&(bar)[XB_TMO])) break; if (_sp > XB_SPIN_CAP) { atomicAdd(&(bar)[XB_TMO], 1u); break; } } } } while (0)

struct XcdBarrier {
    unsigned* bar; unsigned x; unsigned w0;
    volatile LAS unsigned* st;
};

__device__ __forceinline__ bool xb_lane0() { unsigned r; asm volatile("v_mbcnt_lo_u32_b32 %0, -1, 0\n\tv_mbcnt_hi_u32_b32 %0, -1, %0" : "=v"(r)); return r == 0u; }
__device__ __forceinline__ XcdBarrier xcd_barrier_post(unsigned* bar, volatile LAS unsigned* st, unsigned w0) {
    XcdBarrier b; b.bar = bar; b.x = xb_xcc_id(); b.st = st; b.w0 = w0;
    if (w0 && xb_lane0()) (void)xb_add(&bar[XB_XCNT(b.x)], 1u);
    return b;
}
__device__ __forceinline__ void xcd_barrier_complete(unsigned* bar, unsigned x, unsigned& nloc, unsigned& nx) {
    const unsigned G = gridDim.x * gridDim.y * gridDim.z;
    unsigned sum, cnt, mine, sp = 0u;
    for (;;) {
        sum = 0u; cnt = 0u; mine = 0u;
#pragma unroll
        for (unsigned j = 0; j < 16; ++j) { const unsigned c = xb_ld(&bar[XB_XCNT(j)]); sum += c; cnt += (c > 0u) ? 1u : 0u; mine = (j == x) ? c : mine; }
        if (sum == G) break;
        __builtin_amdgcn_s_sleep(1);
        if ((++sp & 255u) == 0u) { if (xb_ld(&bar[XB_TMO])) break; if (sp > XB_SPIN_CAP) { atomicAdd(&bar[XB_TMO], 1u); break; } }
    }
    nloc = mine > 0u ? mine : 1u; nx = cnt > 0u ? cnt : 1u;
}

__device__ __forceinline__ void xcd_barrier(const XcdBarrier& b) {
    asm volatile("s_waitcnt vmcnt(0)" ::: "memory");
    __syncthreads();
    if (b.w0 && xb_lane0()) {
        unsigned* bar = b.bar;
        __builtin_amdgcn_s_waitcnt(0);
        unsigned nloc = b.st[0], nx = b.st[1];
        if (nloc == 0u) { xcd_barrier_complete(bar, b.x, nloc, nx); b.st[0] = nloc; b.st[1] = nx; }
        const unsigned old = xb_add(&bar[XB_XSUB(b.x)], 1u);
        const unsigned gen = old / nloc;
        if (old + 1u == (gen + 1u) * nloc) {
            __builtin_amdgcn_fence(__ATOMIC_RELEASE, "agent");
            asm volatile("s_waitcnt vmcnt(0)" ::: "memory");
            const unsigned og = xb_add(&bar[XB_TOP], 1u);
            const unsigned tg = og / nx;
            if (og + 1u == (tg + 1u) * nx) xb_add(&bar[XB_TOPGEN], 1u);
            else XB_SPIN(xb_ld(&bar[XB_TOPGEN]) == tg, bar);
            __builtin_amdgcn_fence(__ATOMIC_ACQUIRE, "agent");
            xb_add(&bar[XB_XGEN(b.x)], 1u);
            asm volatile("s_waitcnt vmcnt(0)" ::: "memory");
        } else {
            XB_SPIN(xb_ld(&bar[XB_XGEN(b.x)]) == gen, bar);
            __builtin_amdgcn_fence(__ATOMIC_ACQUIRE, "agent");
            asm volatile("s_waitcnt vmcnt(0)" ::: "memory");
        }
    }
    __syncthreads();
}

constexpr int DM = 4096, NB = 2, SEQ = 8192, MTOK = NB * SEQ, DEPTH = 4;
constexpr int S5W = 1024;
constexpr int HGW = 1536;
constexpr int GLKW = 768;
constexpr int INW = 11792, INP = 12032, DFF = 11008;
constexpr int OW = 3072;
constexpr int C_U = 0, C_QB = 1024, C_FB = 2560, C_IB = 4096, C_GB = 5632, C_QC = 7168, C_KC = 7936, C_VC = 8704, C_GC = 10240, C_LR = 11776;
constexpr float LN_EPS = 1e-5f;
constexpr float ALPHA = 1.6817928305074290861f;
constexpr float GLA_QSCALE = 0.07216878364870322f;

enum { I_X = 0, I_C, I_WADA, I_BADA, I_TABLE, I_WIN, I_WOUT, I_AREAL, I_AIMAG, I_LOGDT, I_BRE, I_BIM, I_CRE, I_CIM, I_S5D, I_GLUW, I_GLUB,
       I_LBRAW, I_HGG, I_HGB, I_WGATE, I_BGATE, I_GLG, I_WFG, I_WFU, I_WFD, I_LN1G, I_LN1B, I_LN2G, I_LN2B, N_IN };

constexpr size_t MiB = 1u << 20;
constexpr size_t WS_CTL = 0, CTL_ZERO_BYTES = 1 * MiB;
constexpr size_t WS_MOD = 1 * MiB;
constexpr size_t WS_MISC = 2 * MiB;
constexpr size_t WS_CONDPART = 12 * MiB;
constexpr size_t WS_H = 24 * MiB;
constexpr size_t WS_MIXED = WS_H + 128 * MiB;
constexpr size_t WS_Z = WS_MIXED + 128 * MiB;
constexpr size_t WS_O = WS_Z + 32 * MiB;
constexpr size_t WS_DELTA = WS_O;
constexpr size_t WS_P = WS_O + 192 * MiB;
constexpr size_t WS_WT = WS_P + 376 * MiB;
constexpr size_t WT_IN = 0, WT_OUT = 94 * MiB, WT_GU = 126 * MiB, WT_DN = 298 * MiB, WT_GLU = 384 * MiB, WT_LAYER = 386 * MiB;
constexpr size_t WS_HGB = WS_WT + DEPTH * WT_LAYER;
constexpr size_t WS_GLB = WS_HGB + 198 * MiB;
constexpr size_t WS_S5T = WS_GLB + 128 * MiB;
constexpr size_t WS_S5W1 = WS_S5T + 576 * MiB;
constexpr size_t WS_UX = WS_S5W1 + 144 * MiB;
constexpr size_t WS_SLOC = WS_UX + 36 * MiB;
constexpr size_t WS_LAM64 = WS_SLOC + 8 * MiB;
constexpr size_t WS_ST = WS_LAM64 + 1 * MiB;
constexpr size_t WS_XL = WS_ST + 45 * MiB;
constexpr size_t WS_END = WS_XL + 64 * MiB;
static_assert(DEPTH >= 2, "the last layer's residual halves reuse layer 0's weight region");
static_assert((size_t)INP * DM * 2 == 94 * MiB && (size_t)DM * DM * 2 == 32 * MiB && (size_t)2 * DFF * DM * 2 == 172 * MiB && (size_t)DM * DFF * 2 == 86 * MiB, "weight map");
static_assert((size_t)MTOK * INP * 2 == 376 * MiB && (size_t)MTOK * DFF * 2 <= 376 * MiB, "activation map");

constexpr int RING_BYTES = 131072;
constexpr int LDSCTL_OFF = 135168;
constexpr int LDS_BYTES = 147456;

#ifndef LAS
#define LAS __attribute__((address_space(3)))
#endif
#define GAS __attribute__((address_space(1)))
typedef unsigned short bf16_t;
typedef float f32x4 __attribute__((ext_vector_type(4)));
typedef float f32x2 __attribute__((ext_vector_type(2)));
typedef unsigned u32x4 __attribute__((ext_vector_type(4)));
typedef unsigned u32x2 __attribute__((ext_vector_type(2)));
#define LDS_WAIT() asm volatile("s_waitcnt lgkmcnt(0)" ::: "memory")
#define VM_WAIT() asm volatile("s_waitcnt vmcnt(0)" ::: "memory")
typedef __bf16 bf16x2_t __attribute__((ext_vector_type(2)));
__device__ __forceinline__ unsigned cvt_pk_bf16(float lo, float hi) { return __builtin_bit_cast(unsigned, __builtin_convertvector((f32x2){lo, hi}, bf16x2_t)); }

__device__ __forceinline__ float bf_lo(unsigned w) { return __uint_as_float(w << 16); }
__device__ __forceinline__ float bf_hi(unsigned w) { return __uint_as_float(w & 0xffff0000u); }
__device__ __forceinline__ float bf2f(bf16_t b) { return __uint_as_float(((unsigned)b) << 16); }
__device__ __forceinline__ float wave_sum(float v) {
    v += __int_as_float(__builtin_amdgcn_mov_dpp(__float_as_int(v), 0xB1, 0xF, 0xF, true));
    v += __int_as_float(__builtin_amdgcn_mov_dpp(__float_as_int(v), 0x4E, 0xF, 0xF, true));
    v += __int_as_float(__builtin_amdgcn_mov_dpp(__float_as_int(v), 0x141, 0xF, 0xF, true));
    v += __int_as_float(__builtin_amdgcn_mov_dpp(__float_as_int(v), 0x140, 0xF, 0xF, true));
    const int b = __float_as_int(v);
    return (__int_as_float(__builtin_amdgcn_readlane(b, 0)) + __int_as_float(__builtin_amdgcn_readlane(b, 16))) + (__int_as_float(__builtin_amdgcn_readlane(b, 32)) + __int_as_float(__builtin_amdgcn_readlane(b, 48)));
}
__device__ __forceinline__ float sigmoidf_(float x) { return __builtin_amdgcn_rcpf(1.0f + __expf(-x)); }
__device__ __forceinline__ float gelu_tanh(float y) { const float a = 0.7978845608028654f * (y + 0.044715f * y * y * y); const float t = 1.0f - 2.0f * __builtin_amdgcn_rcpf(1.0f + __expf(2.0f * a)); return 0.5f * y * (1.0f + t); }

struct EpiProj {
    static constexpr bool PERM = true, AFTER_DRAIN = false;
    GAS bf16_t* P; GAS bf16_t* UX;
    __device__ __forceinline__ void operator()(const f32x4 (&acc)[2][2][4][2], const pg8::Unit& u, int wr, int wc, int fr, int fq) const {
        const int row0 = u.pm * 256 + wr * 64 + fr, col0 = u.pn * 256 + wc * 32 + 8 * fq;
        const bool s5 = u.pn < 4;
#pragma unroll
        for (int ai = 0; ai < 2; ++ai)
#pragma unroll
            for (int m = 0; m < 4; ++m) { const int row = row0 + ai * 128 + m * 16;
#pragma unroll
                for (int bj = 0; bj < 2; ++bj) { const f32x4 v0 = acc[ai][bj][m][0], v1 = acc[ai][bj][m][1]; const int col = col0 + bj * 128;
                    u32x4 w; w.x = cvt_pk_bf16(v0[0], v0[1]); w.y = cvt_pk_bf16(v0[2], v0[3]); w.z = cvt_pk_bf16(v1[0], v1[1]); w.w = cvt_pk_bf16(v1[2], v1[3]);
                    if (!s5) *(GAS u32x4*)(P + (size_t)row * INP + col) = w;
                    else { GAS bf16_t* ur = UX + (size_t)((col >> 4) * 256 + (row >> 6)) * 1152; *(GAS u32x4*)(ur + (row & 63) * 16 + (col & 15)) = w;
                        if ((row & 63) == 0) { const u32x4 z = (u32x4){0u, 0u, 0u, 0u}; GAS bf16_t* zp = ur + 1024 + ((col & 15) ? 64 : 0);
#pragma unroll
                            for (int i = 0; i < 8; ++i) *(GAS u32x4*)(zp + 8 * i) = z; } } } }
    }
};
struct EpiSwiglu {
    static constexpr bool PERM = true, AFTER_DRAIN = false;
    GAS bf16_t* HID;
    __device__ __forceinline__ void operator()(const f32x4 (&acc)[2][2][4][2], const pg8::Unit& u, int wr, int wc, int fr, int fq) const {
        const int row0 = u.pm * 256 + wr * 64 + fr, col0 = u.pn * 128 + wc * 32 + 8 * fq;
#pragma unroll
        for (int ai = 0; ai < 2; ++ai)
#pragma unroll
            for (int m = 0; m < 4; ++m) { GAS bf16_t* rowp = HID + (size_t)(row0 + ai * 128 + m * 16) * DFF + col0;
                float o[8];
#pragma unroll
                for (int n = 0; n < 2; ++n)
#pragma unroll
                    for (int j = 0; j < 4; ++j) { const float g = acc[ai][0][m][n][j], up = acc[ai][1][m][n][j]; o[n * 4 + j] = g * __builtin_amdgcn_rcpf(1.0f + __expf(-g)) * up; }
                u32x4 w; w.x = cvt_pk_bf16(o[0], o[1]); w.y = cvt_pk_bf16(o[2], o[3]); w.z = cvt_pk_bf16(o[4], o[5]); w.w = cvt_pk_bf16(o[6], o[7]);
                *(GAS u32x4*)rowp = w; }
    }
};
struct EpiGlu {
    static constexpr bool PERM = true, AFTER_DRAIN = false;
    const GAS bf16_t* Z; GAS bf16_t* MIXED; const GAS float* bias;
    __device__ __forceinline__ void operator()(const f32x4 (&acc)[2][2][4][2], const pg8::Unit& u, int wr, int wc, int fr, int fq) const {
        const int row0 = u.pm * 256 + wr * 64 + fr, col0 = u.pn * 256 + wc * 32 + 8 * fq;
#pragma unroll
        for (int bj = 0; bj < 2; ++bj) {
            const f32x4 b0 = *(const GAS f32x4*)(bias + col0 + bj * 128), b1 = *(const GAS f32x4*)(bias + col0 + bj * 128 + 4);
            u32x4 zq[2][4];
#pragma unroll
            for (int ai = 0; ai < 2; ++ai)
#pragma unroll
                for (int m = 0; m < 4; ++m) zq[ai][m] = *(const GAS u32x4*)(Z + (size_t)(row0 + ai * 128 + m * 16) * S5W + col0 + bj * 128);
            asm volatile("" ::: "memory");
#pragma unroll
            for (int ai = 0; ai < 2; ++ai)
#pragma unroll
                for (int m = 0; m < 4; ++m) { const size_t r = (size_t)(row0 + ai * 128 + m * 16);
                    const u32x4 zz = zq[ai][m];
                    const f32x4 v0 = acc[ai][bj][m][0] + b0, v1 = acc[ai][bj][m][1] + b1;
                    u32x4 w;
                    w.x = cvt_pk_bf16(bf_lo(zz.x) * sigmoidf_(v0[0]), bf_hi(zz.x) * sigmoidf_(v0[1]));
                    w.y = cvt_pk_bf16(bf_lo(zz.y) * sigmoidf_(v0[2]), bf_hi(zz.y) * sigmoidf_(v0[3]));
                    w.z = cvt_pk_bf16(bf_lo(zz.z) * sigmoidf_(v1[0]), bf_hi(zz.z) * sigmoidf_(v1[1]));
                    w.w = cvt_pk_bf16(bf_lo(zz.w) * sigmoidf_(v1[2]), bf_hi(zz.w) * sigmoidf_(v1[3]));
                    *(GAS u32x4*)(MIXED + r * DM + col0 + bj * 128) = w;
                    if (m & 1) asm volatile("" ::: "memory"); }
        }
    }
};
struct EpiDelta {
    static constexpr bool PERM = true, AFTER_DRAIN = false;
    GAS bf16_t* D; const GAS float* gate0;
    __device__ __forceinline__ void operator()(const f32x4 (&acc)[2][2][4][2], const pg8::Unit& u, int wr, int wc, int fr, int fq) const {
        const int row0 = u.pm * 256 + wr * 64 + fr, col0 = u.pn * 256 + wc * 32 + 8 * fq;
        const GAS float* gp = gate0 + (u.pm >= 32 ? 6 * DM : 0) + col0;
        f32x4 g[2][2];
#pragma unroll
        for (int bj = 0; bj < 2; ++bj)
#pragma unroll
            for (int n = 0; n < 2; ++n) g[bj][n] = *(const GAS f32x4*)(gp + bj * 128 + 4 * n) + 1.0f;
#pragma unroll
        for (int ai = 0; ai < 2; ++ai)
#pragma unroll
            for (int m = 0; m < 4; ++m) { GAS bf16_t* rowp = D + (size_t)(row0 + ai * 128 + m * 16) * DM + col0;
#pragma unroll
                for (int bj = 0; bj < 2; ++bj) { const f32x4 v0 = acc[ai][bj][m][0] * g[bj][0], v1 = acc[ai][bj][m][1] * g[bj][1];
                    u32x4 w; w.x = cvt_pk_bf16(v0[0], v0[1]); w.y = cvt_pk_bf16(v0[2], v0[3]); w.z = cvt_pk_bf16(v1[0], v1[1]); w.w = cvt_pk_bf16(v1[2], v1[3]);
                    *(GAS u32x4*)(rowp + bj * 128) = w; } }
    }
};

__device__ __forceinline__ int lane_id_v() { int r; asm volatile("v_mbcnt_lo_u32_b32 %0, -1, 0\n\tv_mbcnt_hi_u32_b32 %0, -1, %0" : "=v"(r)); return r; }
struct Args { const float* in[N_IN]; float* out; unsigned char* ws; int ph_lo, ph_hi; };
struct Ctx {
    volatile LAS unsigned long long* t;
    __device__ __forceinline__ unsigned long long ld(int i) const { const unsigned long long v = t[i];
        return ((unsigned long long)(unsigned)__builtin_amdgcn_readfirstlane((int)(v >> 32)) << 32) | (unsigned long long)(unsigned)__builtin_amdgcn_readfirstlane((int)(unsigned)v); }
    __device__ __forceinline__ const GAS float* in(int i) const { return (const GAS float*)ld(i); }
    __device__ __forceinline__ GAS float* out() const { return (GAS float*)ld(30); }
    __device__ __forceinline__ GAS unsigned char* ws() const { return (GAS unsigned char*)ld(31); }
};

constexpr int S5K = 1152;
constexpr size_t S5_T_LAYER = (size_t)64 * 1024 * S5K * 2, S5_W1_LAYER = (size_t)64 * 256 * S5K * 2;

struct S5Order {
    int G, c, n, sh;
    __device__ __forceinline__ bool next(int i, pg8::Unit& u) const { const int L = i * G + c; if (L >= n) return false; u.pm = L >> sh; u.pn = L; return true; }
    __device__ __forceinline__ void a_ready(const pg8::Unit&) const {}
    __device__ __forceinline__ void done(const pg8::Unit&) const {}
};
struct EpiS5A {
    static constexpr bool PERM = false, AFTER_DRAIN = false;
    GAS float* Sloc;
    __device__ __forceinline__ void operator()(const f32x4 (&acc)[2][2][4][2], const pg8::Unit& u, int wr, int wc, int fr, int fq) const {
        const int row0 = u.pm * 256 + wr * 64 + fr, col0 = wc * 32 + 4 * fq;
#pragma unroll
        for (int ai = 0; ai < 2; ++ai)
#pragma unroll
            for (int m = 0; m < 4; ++m)
#pragma unroll
                for (int n = 0; n < 2; ++n) *(GAS f32x4*)(Sloc + (size_t)(row0 + ai * 128 + m * 16) * 128 + col0 + n * 16) = acc[ai][0][m][n];
    }
};
struct EpiS5C {
    static constexpr bool PERM = true, AFTER_DRAIN = false;
    GAS bf16_t* Z;
    __device__ __forceinline__ void operator()(const f32x4 (&acc)[2][2][4][2], const pg8::Unit& u, int wr, int wc, int fr, int fq) const {
        const int g = u.pm, c0 = wr * 64 + fr, cc0 = (u.pn & 3) * 256 + wc * 32 + 8 * fq;
#pragma unroll
        for (int ai = 0; ai < 2; ++ai)
#pragma unroll
            for (int m = 0; m < 4; ++m) { const int c = c0 + ai * 128 + m * 16;
#pragma unroll
                for (int bj = 0; bj < 2; ++bj) { const int cc = cc0 + bj * 128, t = cc >> 4, h0 = cc & 15;
                    const f32x4 v0 = acc[ai][bj][m][0], v1 = acc[ai][bj][m][1];
                    u32x4 w; w.x = cvt_pk_bf16(gelu_tanh(v0[0]), gelu_tanh(v0[1])); w.y = cvt_pk_bf16(gelu_tanh(v0[2]), gelu_tanh(v0[3]));
                    w.z = cvt_pk_bf16(gelu_tanh(v1[0]), gelu_tanh(v1[1])); w.w = cvt_pk_bf16(gelu_tanh(v1[2]), gelu_tanh(v1[3]));
                    *(GAS u32x4*)(Z + (size_t)(c * 64 + t) * S5W + g * 16 + h0) = w; } }
    }
};
__device__ __forceinline__ void s5_tables_item(const Ctx& a, int lg, LAS unsigned char* lds, int wave, int lane) {
    LAS f32x2* LP = (LAS f32x2*)lds;
    LAS f32x2* BB = (LAS f32x2*)(lds + 33280);
    LAS f32x2* CC = (LAS f32x2*)(lds + 41472);
    LAS float* KT = (LAS float*)(lds + 49664);
    const int tid = wave * 64 + lane, l = lg >> 6, g = lg & 63;
    if (tid < 64) { const int p = tid;
        const double ar = (double)a.in(I_AREAL)[lg * 64 + p], ai = (double)a.in(I_AIMAG)[lg * 64 + p], dt = exp((double)a.in(I_LOGDT)[lg]);
        const double mag = exp(ar * dt), ang = ai * dt, lr = mag * cos(ang), li = mag * sin(ang);
        const double den = ar * ar + ai * ai, nr = lr - 1.0, ni = li, cr = (nr * ar + ni * ai) / den, ci = (ni * ar - nr * ai) / den;
        double pr = 1.0, pi = 0.0;
        for (int tau = 0; tau <= 64; ++tau) { LP[tau * 64 + p] = (f32x2){(float)pr, (float)pi}; const double nr2 = pr * lr - pi * li, ni2 = pr * li + pi * lr; pr = nr2; pi = ni2; }
        for (int h = 0; h < 16; ++h) { const double br = (double)a.in(I_BRE)[((size_t)lg * 64 + p) * 16 + h], bi = (double)a.in(I_BIM)[((size_t)lg * 64 + p) * 16 + h];
            BB[p * 16 + h] = (f32x2){(float)(cr * br - ci * bi), (float)(cr * bi + ci * br)}; }
    }
    for (int e = tid; e < 1024; e += 512) { const int h = e >> 6, p = e & 63; CC[e] = (f32x2){a.in(I_CRE)[((size_t)lg * 16 + h) * 64 + p], a.in(I_CIM)[((size_t)lg * 16 + h) * 64 + p]}; }
    __syncthreads();
    if (tid < 64) *(GAS f32x2*)((GAS float*)(a.ws() + WS_LAM64) + ((size_t)lg * 64 + tid) * 2) = LP[64 * 64 + tid];
    for (int e = tid; e < 64 * 256; e += 512) { const int tau = e >> 8, h = (e >> 4) & 15, hp = e & 15; float s = 0.f;
#pragma unroll 8
        for (int p = 0; p < 64; ++p) { const f32x2 c = CC[h * 64 + p], lm = LP[tau * 64 + p], b = BB[p * 16 + hp];
            const float xr = c.x * lm.x - c.y * lm.y, xi = c.x * lm.y + c.y * lm.x; s += xr * b.x - xi * b.y; }
        if (tau == 0 && h == hp) s += a.in(I_S5D)[l * S5W + g * 16 + h];
        KT[e] = s; }
    __syncthreads();
    GAS bf16_t* T = (GAS bf16_t*)(a.ws() + WS_S5T + (size_t)l * S5_T_LAYER) + (size_t)g * 1024 * S5K;
    for (int pc = tid; pc < 1024 * 144; pc += 512) { const int n = pc / 144, j = pc % 144, t = n >> 4, h = n & 15; float v[8];
        if (j < 128) { const int s = j >> 1, hp0 = (j & 1) * 8;
            if (s > t) {
#pragma unroll
                for (int i = 0; i < 8; ++i) v[i] = 0.f;
            } else { const LAS float* kp = KT + (t - s) * 256 + h * 16 + hp0; const f32x4 k0 = *(const LAS f32x4*)kp, k1 = *(const LAS f32x4*)(kp + 4);
                v[0] = k0[0]; v[1] = k0[1]; v[2] = k0[2]; v[3] = k0[3]; v[4] = k1[0]; v[5] = k1[1]; v[6] = k1[2]; v[7] = k1[3]; }
        } else { const int p0 = (j - 128) * 4;
#pragma unroll
            for (int i = 0; i < 4; ++i) { const f32x2 c = CC[h * 64 + p0 + i], lm = LP[(t + 1) * 64 + p0 + i]; v[2 * i] = c.x * lm.x - c.y * lm.y; v[2 * i + 1] = -(c.x * lm.y + c.y * lm.x); } }
        *(GAS u32x4*)(T + (size_t)n * S5K + j * 8) = (u32x4){cvt_pk_bf16(v[0], v[1]), cvt_pk_bf16(v[2], v[3]), cvt_pk_bf16(v[4], v[5]), cvt_pk_bf16(v[6], v[7])}; }
    GAS bf16_t* W1 = (GAS bf16_t*)(a.ws() + WS_S5W1 + (size_t)l * S5_W1_LAYER) + (size_t)g * 256 * S5K;
    for (int pc = tid; pc < 256 * 144; pc += 512) { const int n = pc / 144, j = pc % 144; float v[8];
#pragma unroll
        for (int i = 0; i < 8; ++i) v[i] = 0.f;
        if (n < 128 && j < 128) { const int p = n >> 1, ri = n & 1, s = j >> 1, hp0 = (j & 1) * 8; const f32x2 lm = LP[(63 - s) * 64 + p];
#pragma unroll
            for (int i = 0; i < 8; ++i) { const f32x2 b = BB[p * 16 + hp0 + i]; v[i] = ri ? (lm.x * b.y + lm.y * b.x) : (lm.x * b.x - lm.y * b.y); } }
        *(GAS u32x4*)(W1 + (size_t)n * S5K + j * 8) = (u32x4){cvt_pk_bf16(v[0], v[1]), cvt_pk_bf16(v[2], v[3]), cvt_pk_bf16(v[4], v[5]), cvt_pk_bf16(v[6], v[7])}; }
    __syncthreads();
}
__device__ __forceinline__ void s5_scan_item(const Ctx& a, int l, int item, int wave, int lane) {
    const int idx = item * 512 + wave * 64 + lane, g = idx >> 7, b = (idx >> 6) & 1, p = idx & 63;
    const f32x2 lam = *(const GAS f32x2*)((const GAS float*)(a.ws() + WS_LAM64) + ((size_t)(l * 64 + g) * 64 + p) * 2);
    const GAS float* sl = (const GAS float*)(a.ws() + WS_SLOC) + ((size_t)(g * 256 + b * 128)) * 128 + 2 * p;
    GAS bf16_t* ux = (GAS bf16_t*)(a.ws() + WS_UX) + ((size_t)(g * 256 + b * 128)) * S5K + 1024 + 2 * p;
    float xr = 0.f, xi = 0.f;
    for (int c0 = 0; c0 < 128; c0 += 8) { f32x2 s[8];
#pragma unroll
        for (int i = 0; i < 8; ++i) s[i] = *(const GAS f32x2*)(sl + (size_t)(c0 + i) * 128);
#pragma unroll
        for (int i = 0; i < 8; ++i) { *(GAS unsigned*)(ux + (size_t)(c0 + i) * S5K) = cvt_pk_bf16(xr, xi);
            const float nr = lam.x * xr - lam.y * xi + s[i].x, ni = lam.x * xi + lam.y * xr + s[i].y; xr = nr; xi = ni; } }
}

__device__ __forceinline__ void transpose_item(const GAS float* W, int N, int k0, int n0, GAS bf16_t* WT, int drow0, int Kd, LAS float* scr, int lane) {
    const int nl = 4 * (lane & 15), kq = lane >> 4;
    const bool valid = (n0 + nl) < N;
    f32x4 v[16];
#pragma unroll
    for (int i = 0; i < 16; ++i) { const int k = 4 * i + kq; v[i] = valid ? *(const GAS f32x4*)(W + (size_t)(k0 + k) * N + n0 + nl) : (f32x4){0.f, 0.f, 0.f, 0.f}; }
#pragma unroll
    for (int i = 0; i < 16; ++i) { const int k = 4 * i + kq; LAS float* s = scr + k * 65 + nl; s[0] = v[i][0]; s[1] = v[i][1]; s[2] = v[i][2]; s[3] = v[i][3]; }
    LDS_WAIT();
    const int c = lane & 7;
#pragma unroll
    for (int j = 0; j < 8; ++j) { const int n = (lane >> 3) + 8 * j; const LAS float* s = scr + (8 * c) * 65 + n;
        u32x4 o; o.x = cvt_pk_bf16(s[0], s[65]); o.y = cvt_pk_bf16(s[130], s[195]); o.z = cvt_pk_bf16(s[260], s[325]); o.w = cvt_pk_bf16(s[390], s[455]);
        *(GAS u32x4*)(WT + (size_t)(drow0 + n) * Kd + k0 + 8 * c) = o; }
    LDS_WAIT();
}
constexpr int NIT_IN = 64 * 188, NIT_OUT = 64 * 64, NIT_G = 64 * 172, NIT_DN = 172 * 64, NIT_GLU = 16 * 16;
constexpr int NIT_LAYER = NIT_IN + NIT_OUT + 2 * NIT_G + NIT_DN + NIT_GLU;
constexpr int NIT_TR = DEPTH * NIT_LAYER, NIT_COND = 64 * 96;

__device__ __forceinline__ void phase_prologue(const Ctx& a, LAS unsigned char* lds, int wave, int lane) {
    if (blockIdx.x & 1) { for (int lg = blockIdx.x; lg < DEPTH * 64; lg += gridDim.x) s5_tables_item(a, lg, lds, wave, lane); __syncthreads(); }
    LAS float* scr = (LAS float*)(lds + wave * 16640);
    const int gw = blockIdx.x * 8 + wave, NGW = gridDim.x * 8;
    for (int it = gw; it < NIT_TR + NIT_COND; it += NGW) {
        if (it < NIT_TR) {
            const int l = it / NIT_LAYER; int r = it % NIT_LAYER;
            GAS unsigned char* wt = a.ws() + WS_WT + (size_t)l * WT_LAYER;
            if (r < NIT_IN) { const int kb = r / 188, nb = r % 188; transpose_item(a.in(I_WIN) + (size_t)l * DM * INW, INW, 64 * kb, 64 * nb, (GAS bf16_t*)(wt + WT_IN), 64 * nb, DM, scr, lane); continue; } r -= NIT_IN;
            if (r < NIT_OUT) { const int kb = r / 64, nb = r % 64; transpose_item(a.in(I_WOUT) + (size_t)l * DM * DM, DM, 64 * kb, 64 * nb, (GAS bf16_t*)(wt + WT_OUT), 64 * nb, DM, scr, lane); continue; } r -= NIT_OUT;
            if (r < NIT_G) { const int kb = r / 172, nb = r % 172, n0 = 64 * nb; transpose_item(a.in(I_WFG) + (size_t)l * DM * DFF, DFF, 64 * kb, n0, (GAS bf16_t*)(wt + WT_GU), 256 * (n0 / 128) + (n0 % 128), DM, scr, lane); continue; } r -= NIT_G;
            if (r < NIT_G) { const int kb = r / 172, nb = r % 172, n0 = 64 * nb; transpose_item(a.in(I_WFU) + (size_t)l * DM * DFF, DFF, 64 * kb, n0, (GAS bf16_t*)(wt + WT_GU), 256 * (n0 / 128) + 128 + (n0 % 128), DM, scr, lane); continue; } r -= NIT_G;
            if (r < NIT_DN) { const int kb = r / 64, nb = r % 64; transpose_item(a.in(I_WFD) + (size_t)l * DFF * DM, DM, 64 * kb, 64 * nb, (GAS bf16_t*)(wt + WT_DN), 64 * nb, DFF, scr, lane); continue; } r -= NIT_DN;
            { const int kb = r / 16, nb = r % 16; transpose_item(a.in(I_GLUW) + (size_t)l * S5W * S5W, S5W, 64 * kb, 64 * nb, (GAS bf16_t*)(wt + WT_GLU), 64 * nb, S5W, scr, lane); }
        } else {
            const int item = it - NIT_TR, kb = item / 96, jb = item % 96, k0 = 64 * kb, j0 = 256 * jb + 4 * lane;
            const GAS float* c = a.in(I_C);
            float c0 = c[k0 + lane], c1 = c[DM + k0 + lane];
            c0 = c0 / (1.0f + expf(-c0)); c1 = c1 / (1.0f + expf(-c1));
            f32x4 a0 = (f32x4){0.f, 0.f, 0.f, 0.f}, a1 = a0;
            const GAS float* w = a.in(I_WADA) + (size_t)k0 * (6 * DM) + j0;
#pragma unroll 8
            for (int kk = 0; kk < 64; ++kk) { const f32x4 wv = *(const GAS f32x4*)(w + (size_t)kk * (6 * DM));
                const float s0 = __int_as_float(__builtin_amdgcn_readlane(__float_as_int(c0), kk)), s1 = __int_as_float(__builtin_amdgcn_readlane(__float_as_int(c1), kk));
                a0 += wv * s0; a1 += wv * s1; }
            GAS float* cp = (GAS float*)(a.ws() + WS_CONDPART);
            *(GAS f32x4*)(cp + (size_t)(kb * 2 + 0) * (6 * DM) + j0) = a0;
            *(GAS f32x4*)(cp + (size_t)(kb * 2 + 1) * (6 * DM) + j0) = a1;
        }
    }
    __syncthreads();
    if (!(blockIdx.x & 1)) { for (int lg = blockIdx.x; lg < DEPTH * 64; lg += gridDim.x) s5_tables_item(a, lg, lds, wave, lane); }
}
__device__ __forceinline__ void phase_mod(const Ctx& a, int wave, int lane) {
    const int gt = blockIdx.x * 512 + wave * 64 + lane, NT = gridDim.x * 512;
    const GAS float* cp = (const GAS float*)(a.ws() + WS_CONDPART);
    GAS float* mod = (GAS float*)(a.ws() + WS_MOD); GAS float* misc = (GAS float*)(a.ws() + WS_MISC);
    for (int idx = gt; idx < NB * 6 * DM; idx += NT) {
        const int b = idx / (6 * DM), j = idx % (6 * DM);
        float s = a.in(I_BADA)[j];
        for (int kb = 0; kb < 64; ++kb) s += cp[(size_t)(kb * 2 + b) * (6 * DM) + j];
        for (int l = 0; l < DEPTH; ++l) mod[(size_t)((l * 2 + b) * 6) * DM + j] = s + a.in(I_TABLE)[(size_t)l * 6 * DM + j];
    }
    for (int idx = gt; idx < DM; idx += NT) { misc[idx] = 1.0f; misc[DM + idx] = 0.0f; }
    for (int idx = gt; idx < HGW; idx += NT) {
        const GAS float* raw = a.in(I_LBRAW); float r[DEPTH], mx = -3.0e38f;
#pragma unroll
        for (int l = 0; l < DEPTH; ++l) { r[l] = raw[l * HGW + idx]; mx = fmaxf(mx, r[l]); }
        float e[DEPTH], sum = 0.f;
#pragma unroll
        for (int l = 0; l < DEPTH; ++l) { e[l] = expf(r[l] - mx); sum += e[l]; }
        float cum = 0.f;
#pragma unroll
        for (int l = 0; l < DEPTH; ++l) { misc[2 * DM + l * HGW + idx] = cum; if (l + 1 < DEPTH) cum += e[l + 1] / sum; }
    }
}

__device__ __forceinline__ void phase_h0(const GAS float* x, const GAS float* modp, GAS bf16_t* H, int wave, int lane) {
    for (int blk = blockIdx.x; blk < MTOK / 64; blk += gridDim.x) {
        const int r0 = blk * 64, b = (r0 >= SEQ) ? 1 : 0;
        f32x4 A[2], B[2];
#pragma unroll
        for (int jj = 0; jj < 2; ++jj) { const int c = 512 * wave + 256 * jj + 4 * lane; A[jj] = *(const GAS f32x4*)(modp + (size_t)(b * 6 + 1) * DM + c) + 1.0f; B[jj] = *(const GAS f32x4*)(modp + (size_t)(b * 6 + 0) * DM + c); }
#pragma unroll 8
        for (int rl = 0; rl < 64; ++rl) { const size_t off = (size_t)(r0 + rl) * DM + 512 * wave + 4 * lane;
#pragma unroll
            for (int jj = 0; jj < 2; ++jj) { const f32x4 v = *(const GAS f32x4*)(x + off + 256 * jj), y = v * A[jj] + B[jj];
                u32x2 w; w.x = cvt_pk_bf16(y[0], y[1]); w.y = cvt_pk_bf16(y[2], y[3]); *(GAS u32x2*)(H + off + 256 * jj) = w; } }
    }
}
struct XRes { GAS unsigned* hi; GAS unsigned* lo; };
template <bool WITH_H, bool XP32, bool XO32>
__device__ __forceinline__ void phase_lnres(const GAS float* xp32, XRes xp, const GAS bf16_t* delta, GAS float* xo32, XRes xo, const GAS float* lng, const GAS float* lnb, const GAS float* modp, int i_shift, int i_scale,
                                            GAS bf16_t* H, LAS unsigned char* lds, int wave, int lane) {
    LAS f32x2* red = (LAS f32x2*)lds;
    for (int blk = blockIdx.x; blk < MTOK / 64; blk += gridDim.x) {
        const int r0 = blk * 64, b = (r0 >= SEQ) ? 1 : 0;
        f32x4 G[2], Bt[2], A[2], B[2];
#pragma unroll
        for (int jj = 0; jj < 2; ++jj) { const int c = 512 * wave + 256 * jj + 4 * lane; G[jj] = *(const GAS f32x4*)(lng + c); Bt[jj] = *(const GAS f32x4*)(lnb + c);
            if (WITH_H) { A[jj] = *(const GAS f32x4*)(modp + (size_t)(b * 6 + i_scale) * DM + c) + 1.0f; B[jj] = *(const GAS f32x4*)(modp + (size_t)(b * 6 + i_shift) * DM + c); } }
        const size_t offb = (size_t)r0 * DM + 512 * wave + 4 * lane;
        f32x4 va[4][2], vb[4][2]; u32x2 da[4][2], db[4][2];
#define LN_LOAD(v_, d_, it_) do { _Pragma("unroll") for (int r = 0; r < 4; ++r) _Pragma("unroll") for (int jj = 0; jj < 2; ++jj) { const size_t o_ = offb + (size_t)((it_) * 4 + r) * DM + 256 * jj; \
            if (XP32) v_[r][jj] = *(const GAS f32x4*)(xp32 + o_); else { const u32x2 t_ = *(const GAS u32x2*)(xp.hi + (o_ >> 1)); const unsigned l_ = xp.lo[o_ >> 2]; \
                v_[r][jj][0] = __uint_as_float(t_.x); v_[r][jj][1] = __uint_as_float(t_.y); v_[r][jj][2] = __uint_as_float(l_); } \
            d_[r][jj] = *(const GAS u32x2*)(delta + o_); } } while (0)
#define LN_STEP(v_, d_, it_) do { LAS f32x2* rb = red + ((it_) & 1) * 32; \
            _Pragma("unroll") for (int r = 0; r < 4; ++r) { float s1 = 0.f, s2 = 0.f; \
                _Pragma("unroll") for (int jj = 0; jj < 2; ++jj) { const f32x4 dd = (f32x4){bf_lo(d_[r][jj].x), bf_hi(d_[r][jj].x), bf_lo(d_[r][jj].y), bf_hi(d_[r][jj].y)}; \
                    f32x4 xq = v_[r][jj]; \
                    if (!XP32) { const unsigned t0 = __float_as_uint(xq[0]), t1 = __float_as_uint(xq[1]), lw = __float_as_uint(xq[2]); \
                        xq[0] = __uint_as_float(__builtin_amdgcn_perm(t0, lw, 0x0504000cu)); xq[1] = __uint_as_float(__builtin_amdgcn_perm(t0, lw, 0x0706010cu)); \
                        xq[2] = __uint_as_float(__builtin_amdgcn_perm(t1, lw, 0x0504020cu)); xq[3] = __uint_as_float(__builtin_amdgcn_perm(t1, lw, 0x0706030cu)); } \
                    const f32x4 y = xq * ALPHA + dd; v_[r][jj] = y; \
                    s1 += (y[0] + y[1]) + (y[2] + y[3]); s2 += (y[0] * y[0] + y[1] * y[1]) + (y[2] * y[2] + y[3] * y[3]); } \
                s1 = wave_sum(s1); s2 = wave_sum(s2); if (lane == 0) rb[r * 8 + wave] = (f32x2){s1, s2}; } \
            __syncthreads(); \
            _Pragma("unroll") for (int r = 0; r < 4; ++r) { float s1 = 0.f, s2 = 0.f; \
                _Pragma("unroll") for (int w = 0; w < 8; ++w) { const f32x2 p = rb[r * 8 + w]; s1 += p.x; s2 += p.y; } \
                const float mu = s1 * (1.0f / DM), rs = 1.0f / sqrtf(fmaxf(s2 * (1.0f / DM) - mu * mu, 0.f) + LN_EPS); \
                _Pragma("unroll") for (int jj = 0; jj < 2; ++jj) { const f32x4 x = ((v_[r][jj] - mu) * rs) * G[jj] + Bt[jj]; const size_t o_ = offb + (size_t)((it_) * 4 + r) * DM + 256 * jj; \
                    if (XO32) *(GAS f32x4*)(xo32 + o_) = x; \
                    else { const unsigned q0 = __float_as_uint(x[0]) + 0x80u, q1 = __float_as_uint(x[1]) + 0x80u, q2 = __float_as_uint(x[2]) + 0x80u, q3 = __float_as_uint(x[3]) + 0x80u; \
                        *(GAS u32x2*)(xo.hi + (o_ >> 1)) = (u32x2){__builtin_amdgcn_perm(q1, q0, 0x07060302u), __builtin_amdgcn_perm(q3, q2, 0x07060302u)}; \
                        xo.lo[o_ >> 2] = __builtin_amdgcn_perm(q1, q0, 0x0c0c0501u) | __builtin_amdgcn_perm(q3, q2, 0x05010c0cu); } \
                    if (WITH_H) { const f32x4 y = x * A[jj] + B[jj]; u32x2 w; w.x = cvt_pk_bf16(y[0], y[1]); w.y = cvt_pk_bf16(y[2], y[3]); *(GAS u32x2*)(H + o_) = w; } } } } while (0)
        LN_LOAD(va, da, 0);
        for (int it = 0; it < 16; it += 2) {
            LN_LOAD(vb, db, it + 1);
            LN_STEP(va, da, it);
            if (it + 2 < 16) LN_LOAD(va, da, it + 2);
            LN_STEP(vb, db, it + 1);
        }
#undef LN_LOAD
#undef LN_STEP
        __syncthreads();
    }
}

typedef short bf16x8 __attribute__((ext_vector_type(8)));
constexpr int HG_BLK = 33280, HG_OQ = 0, HG_OK = 8192, HG_OKT = 16384, HG_ODL = 24576, HG_OVT = 25088;
constexpr int GL_BLK = 63488, GL_OQ = 0, GL_OK = 12800, GL_OKT = 25600, GL_ODL = 37888, GL_SHARED = 38912, GL_OVT = 38912;
constexpr int NUNIT = SEQ / 32;

struct PreOut { GAS unsigned char* blk; int oq, ok, okt, odl, rowb; bool swz; };
__device__ __forceinline__ int slot_swz(int r) { return (0 - (r >> 2)) & 3; }
template <int HALF>
__device__ __forceinline__ float pre_half(const PreOut& P, int d, int pd, float e0, const float (&a)[16], const float (&qq)[16], const float (&kk)[16], float (&kta)[16], unsigned (&kt)[16], float& ph) {
    float w = 1.0f;
#pragma unroll
    for (int t = 14; t >= 0; t -= 2) { const float kv1 = kk[t + 1] * w; w *= a[t + 1]; const float kv0 = kk[t] * w; w *= a[t];
        if (HALF == 0) { kta[t] = kv0; kta[t + 1] = kv1; } else kt[4 * (t >> 2) + 2 + ((t & 3) >> 1)] = cvt_pk_bf16(kv0, kv1); }
    ph = w;
    float e = e0;
#pragma unroll
    for (int j = 0; j < 16; ++j) { const int row = 16 * HALF + j;
        e *= a[j];
        const int off = row * P.rowb + ((2 * pd) ^ ((P.swz ? j : ((j >> 1) & 7)) << 4));
        const float qv = qq[j] * e, kc = kk[j] * fminf(__builtin_amdgcn_rcpf(e), 5.5406224e34f);
        const float qn = __int_as_float(__builtin_amdgcn_mov_dpp(__float_as_int(qv), 0xB1, 0xF, 0xF, true)), kn = __int_as_float(__builtin_amdgcn_mov_dpp(__float_as_int(kc), 0xB1, 0xF, 0xF, true));
        if ((d & 1) == 0) { *(GAS unsigned*)(P.blk + P.oq + off) = cvt_pk_bf16(qv, qn); *(GAS unsigned*)(P.blk + P.ok + off) = cvt_pk_bf16(kc, kn); } }
    return e;
}
__device__ __forceinline__ void pre_tail(const PreOut& P, int d, float dlb, float eend, const float (&kta)[16], unsigned (&kt)[16]) {
#pragma unroll
    for (int t = 0; t < 16; t += 2) kt[4 * (t >> 2) + ((t & 3) >> 1)] = cvt_pk_bf16(kta[t] * dlb, kta[t + 1] * dlb);
#pragma unroll
    for (int i = 0; i < 4; ++i) *(GAS u32x4*)(P.blk + P.okt + d * 64 + 16 * (i ^ slot_swz(d))) = (u32x4){kt[4 * i], kt[4 * i + 1], kt[4 * i + 2], kt[4 * i + 3]};
    *(GAS float*)(P.blk + P.odl + d * 4) = eend;
}
__device__ __forceinline__ void glds16_asm(const GAS void* gsrc, unsigned lds_dst) { unsigned keep;
    asm volatile("s_mov_b32 %0, m0\n\ts_mov_b32 m0, %2\n\ts_nop 0\n\tglobal_load_lds_dwordx4 %1, off\n\ts_mov_b32 m0, %0" : "=&s"(keep) : "v"(gsrc), "s"(lds_dst) : "memory"); }
constexpr int PRE_IN = 49152, PRE_OUT = 2 * PRE_IN;
__device__ __forceinline__ void pre_hg_dma(const GAS bf16_t* P, int t, int half, LAS unsigned char* img, int wave, int lane) {
    const int bu = t / 3, kind = t - 3 * bu, b = bu / NUNIT, un = bu - b * NUNIT;
    const GAS bf16_t* src = P + ((size_t)b * SEQ + un * 32 + 16 * half) * INP + kind * 512 + 8 * lane;
    const unsigned dst = (unsigned)(size_t)img;
#pragma unroll
    for (int i = 0; i < 6; ++i) { const int r = wave * 6 + i, arr = r >> 4, j = r & 15;
        glds16_asm(src + (size_t)j * INP + (arr == 0 ? C_QB : arr == 1 ? C_FB : C_IB), dst + r * 1024); }
}
template <int HALF>
__device__ __forceinline__ float pre_half_l(LAS unsigned char* oq, LAS unsigned char* ok, int pd, float e0, const float (&a)[16], const float (&qq)[16], const float (&kk)[16], float (&kta)[16], unsigned (&kt)[16], float& ph) {
    float w = 1.0f;
#pragma unroll
    for (int t = 14; t >= 0; t -= 2) { const float kv1 = kk[t + 1] * w; w *= a[t + 1]; const float kv0 = kk[t] * w; w *= a[t];
        if (HALF == 0) { kta[t] = kv0; kta[t + 1] = kv1; } else kt[4 * (t >> 2) + 2 + ((t & 3) >> 1)] = cvt_pk_bf16(kv0, kv1); }
    ph = w;
    float e = e0;
#pragma unroll
    for (int j = 0; j < 16; ++j) { e *= a[j];
        const int off = j * 256 + ((2 * pd) ^ (j << 4));
        const float qv = qq[j] * e, kc = kk[j] * fminf(__builtin_amdgcn_rcpf(e), 5.5406224e34f);
        *(LAS unsigned short*)(oq + off) = (unsigned short)cvt_pk_bf16(qv, qv); *(LAS unsigned short*)(ok + off) = (unsigned short)cvt_pk_bf16(kc, kc); }
    return e;
}
__device__ __forceinline__ void phase_pre(const Ctx& a, int l, LAS unsigned char* lds, int wave, int lane) {
    const GAS bf16_t* P = (const GAS bf16_t*)(a.ws() + WS_P);
    int tid = wave * 64 + lane;
    const int bx = blockIdx.x, G = gridDim.x;
    {
        const int t_lo = (int)((long)(NB * NUNIT * 3) * bx / G), t_hi = (int)((long)(NB * NUNIT * 3) * (bx + 1) / G);
        float lbk[3];
#pragma unroll
        for (int k = 0; k < 3; ++k) lbk[k] = ((const GAS float*)(a.ws() + WS_MISC))[2 * DM + l * HGW + k * 512 + tid];
        asm volatile("" : "+v"(lbk[0]), "+v"(lbk[1]), "+v"(lbk[2]));
        __syncthreads();
        if (t_lo < t_hi) pre_hg_dma(P, t_lo, 0, lds, wave, lane);
        VM_WAIT();
        for (int t = t_lo; t < t_hi; ++t) {
            asm volatile("" : "+v"(tid));
            const int bu = t / 3, kind = t - 3 * bu, b = bu / NUNIT, un = bu - b * NUNIT;
            const int ch = kind * 512 + tid, hh = tid >> 7, d = tid & 127, pd = (d & ~31) + 8 * ((d >> 2) & 3) + 4 * ((d >> 4) & 1) + (d & 3);
            const float lb = kind == 0 ? lbk[0] : kind == 1 ? lbk[1] : lbk[2];
            GAS unsigned char* blk0 = a.ws() + WS_HGB + ((size_t)(b * 12 + kind * 4) * NUNIT + un) * HG_BLK;
            float kta[16]; unsigned kt[16], vv[16]; float e0 = 1.f, e1 = 1.f, ph = 1.f;
#pragma unroll
            for (int half = 0; half < 2; ++half) {
                __syncthreads();
                { const int nt = half ? t + 1 : t; if (nt < t_hi) pre_hg_dma(P, nt, half ^ 1, lds + (half ^ 1) * PRE_IN, wave, lane); }
                const LAS unsigned char* img = lds + half * PRE_IN + 2 * tid;
                float g[16], qq[16], kk[16];
                unsigned short rq[16], rf[16], rv[16];
#pragma unroll
                for (int j = 0; j < 16; ++j) { rq[j] = *(const LAS unsigned short*)(img + j * 1024); rf[j] = *(const LAS unsigned short*)(img + (16 + j) * 1024); rv[j] = *(const LAS unsigned short*)(img + (32 + j) * 1024); }
                asm volatile("" ::: "memory");
#pragma unroll
                for (int j = 0; j < 16; ++j) {
                    const float qin = fmaxf(bf2f(rq[j]), -80.f), fin = fminf(fmaxf(bf2f(rf[j]), -80.f), 80.f);
                    const unsigned short v = rv[j];
                    const int w = 4 * (j >> 2) + 2 * half + ((j & 3) >> 1); if (j & 1) vv[w] |= ((unsigned)v) << 16; else vv[w] = v;
                    const float e = __expf(-fin), sg = __builtin_amdgcn_rcpf(1.0f + e);
                    const float f = lb + (1.0f - lb) * sg;
                    g[j] = f; kk[j] = (1.0f - lb) * (e * sg); qq[j] = qin * __builtin_amdgcn_rcpf(1.0f + __expf(-qin)); }
                LAS unsigned char* oq = lds + PRE_OUT + hh * 4096; LAS unsigned char* ok = oq + 16384;
                if (half == 0) { e0 = pre_half_l<0>(oq, ok, pd, 1.0f, g, qq, kk, kta, kt, ph); } else { e1 = pre_half_l<1>(oq, ok, pd, e0, g, qq, kk, kta, kt, ph); }
                __syncthreads();
                VM_WAIT();
#pragma unroll
                for (int i = 0; i < 4; ++i) { const int pc = i * 512 + tid, c = pc >> 8, wi = pc & 255;
                    *(GAS u32x4*)(blk0 + (size_t)(c & 3) * NUNIT * HG_BLK + (c >> 2 ? HG_OK : HG_OQ) + half * 4096 + wi * 16) = *(const LAS u32x4*)(lds + PRE_OUT + c * 4096 + wi * 16); }
            }
            GAS unsigned char* blk = blk0 + (size_t)hh * NUNIT * HG_BLK;
            const PreOut po{blk, HG_OQ, HG_OK, HG_OKT, HG_ODL, 256, true};
#pragma unroll
            for (int i = 0; i < 4; ++i) *(GAS u32x4*)(blk + HG_OVT + d * 64 + 16 * (i ^ slot_swz(d))) = (u32x4){vv[4 * i], vv[4 * i + 1], vv[4 * i + 2], vv[4 * i + 3]};
            pre_tail(po, d, ph, e1, kta, kt);
        }
    }
    const bool bal = G == 256;
    const int t_lo = bal ? (bx < 64 ? 4 * bx : 256 + 12 * (bx - 64)) : bx;
    const int t_hi = bal ? t_lo + (bx < 64 ? 4 : 12) : NB * NUNIT * 5, t_st = bal ? 1 : G;
    for (int task = t_lo; task < t_hi; task += t_st) {
        asm volatile("" : "+v"(tid));
        const int bu = task / 5, kind = 3 + (task - 5 * bu), b = bu / NUNIT, un = bu % NUNIT;
        const size_t row0 = (size_t)b * SEQ + un * 32;
        if (kind < 5) {
            __syncthreads();
            if (tid < 64) *(LAS u32x4*)(lds + tid * 16) = *(const GAS u32x4*)(P + (row0 + (tid >> 1)) * INP + C_LR + 8 * (tid & 1));
            __syncthreads();
            if (tid < 384) {
                const int ch = (kind - 3) * 384 + tid, h = ch / 192, d = ch % 192, pd = (d & ~31) + 8 * ((d >> 2) & 3) + 4 * ((d >> 4) & 1) + (d & 3);
                GAS unsigned char* blk = a.ws() + WS_GLB + ((size_t)(b * 4 + h) * NUNIT + un) * GL_BLK;
                const PreOut po{blk, GL_OQ, GL_OK, GL_OKT, GL_ODL, 384, false};
                float wg[16];
#pragma unroll
                for (int r = 0; r < 16; ++r) wg[r] = a.in(I_WGATE)[((size_t)l * 16 + r) * GLKW + ch];
                const float bgv = a.in(I_BGATE)[l * GLKW + ch];
                float kta[16]; unsigned kt[16]; float e0 = 1.f, e1 = 1.f, ph = 1.f;
#pragma unroll
                for (int half = 0; half < 2; ++half) {
                    float g[16], qq[16], kk[16];
#pragma unroll
                    for (int j = 0; j < 16; ++j) { const GAS bf16_t* prow = P + (row0 + 16 * half + j) * INP;
                        const u32x4 l0 = *(const LAS u32x4*)(lds + (16 * half + j) * 32), l1 = *(const LAS u32x4*)(lds + (16 * half + j) * 32 + 16);
                        float x = bgv;
                        x += bf_lo(l0.x) * wg[0] + bf_hi(l0.x) * wg[1] + bf_lo(l0.y) * wg[2] + bf_hi(l0.y) * wg[3] + bf_lo(l0.z) * wg[4] + bf_hi(l0.z) * wg[5] + bf_lo(l0.w) * wg[6] + bf_hi(l0.w) * wg[7];
                        x += bf_lo(l1.x) * wg[8] + bf_hi(l1.x) * wg[9] + bf_lo(l1.y) * wg[10] + bf_hi(l1.y) * wg[11] + bf_lo(l1.z) * wg[12] + bf_hi(l1.z) * wg[13] + bf_lo(l1.w) * wg[14] + bf_hi(l1.w) * wg[15];
                        g[j] = __expf((fminf(x, 0.f) - __logf(1.0f + __expf(-fabsf(x)))) * 0.0625f);
                        qq[j] = bf2f(prow[C_QC + ch]) * GLA_QSCALE; kk[j] = bf2f(prow[C_KC + ch]); }
                    if (half == 0) { e0 = pre_half<0>(po, d, pd, 1.0f, g, qq, kk, kta, kt, ph); } else { e1 = pre_half<1>(po, d, pd, e0, g, qq, kk, kta, kt, ph); }
                }
                pre_tail(po, d, ph, e1, kta, kt);
            }
        } else {
            const int ch = (kind - 5) * 512 + tid, h = ch / 384, e = ch % 384;
            GAS unsigned char* blk = a.ws() + WS_GLB + ((size_t)(b * 4 + h) * NUNIT + un) * GL_BLK;
            unsigned vv[16]; unsigned short rv[32];
#pragma unroll
            for (int j = 0; j < 32; ++j) rv[j] = P[(row0 + j) * INP + C_VC + ch];
            asm volatile("" ::: "memory");
#pragma unroll
            for (int j = 0; j < 32; ++j) { const unsigned short v = rv[j];
                const int w = 4 * ((j >> 2) & 3) + 2 * (j >> 4) + ((j & 3) >> 1); if (j & 1) vv[w] |= ((unsigned)v) << 16; else vv[w] = v; }
#pragma unroll
            for (int i = 0; i < 4; ++i) *(GAS u32x4*)(blk + GL_OVT + e * 64 + 16 * (i ^ slot_swz(e))) = (u32x4){vv[4 * i], vv[4 * i + 1], vv[4 * i + 2], vv[4 * i + 3]};
        }
    }
}

template <int DK, int MODE>
__device__ __forceinline__ void chain_unit(const LAS unsigned char* sb, f32x4 (&S)[DK / 16], GAS float* op, int wave, int n, int q) {
    constexpr bool IS_GLA = (DK == 192);
    constexpr int NKS = DK / 32, NMB = DK / 16, ROWB = IS_GLA ? 384 : 256;
    constexpr int OQ = 0, OK = IS_GLA ? GL_OK : HG_OK, OKT = IS_GLA ? GL_OKT : HG_OKT, OVT = IS_GLA ? GL_OVT : HG_OVT, ODL = IS_GLA ? GL_ODL : HG_ODL;
    constexpr int UG = 4, NUG = NMB / UG;
#define CU_FENCE() asm volatile("" ::: "memory")
    bf16x8 ktf[2][UG]; f32x4 dlv[2][UG];
#define CU_LDU(g_, sl_) do { _Pragma("unroll") for (int u_ = 0; u_ < UG; ++u_) { const int mb_ = (g_) * UG + u_; \
        dlv[sl_][u_] = *(const LAS f32x4*)(sb + ODL + (16 * mb_ + 4 * q) * 4); ktf[sl_][u_] = __builtin_bit_cast(bf16x8, *(const LAS u32x4*)(sb + OKT + (16 * mb_ + n) * 64 + 16 * qs)); } } while (0)
#define CU_SBF(ks_) __builtin_bit_cast(bf16x8, (u32x4){cvt_pk_bf16(S[2 * (ks_)][0], S[2 * (ks_)][1]), cvt_pk_bf16(S[2 * (ks_)][2], S[2 * (ks_)][3]), cvt_pk_bf16(S[2 * (ks_) + 1][0], S[2 * (ks_) + 1][1]), cvt_pk_bf16(S[2 * (ks_) + 1][2], S[2 * (ks_) + 1][3])})
    const int qs = q ^ slot_swz(n);
    const bf16x8 vf8 = __builtin_bit_cast(bf16x8, *(const LAS u32x4*)(sb + OVT + (16 * wave + n) * 64 + 16 * qs));
    if (MODE == 1) {
        const f32x4 zero = (f32x4){0.f, 0.f, 0.f, 0.f};
        bf16x8 qf0[NKS], kf0[NKS], qf1[NKS], kf1[NKS];
#pragma unroll
        for (int ks = 0; ks < NKS; ++ks) { const int c0 = 64 * ks + 16 * q, o0 = n * ROWB + (c0 ^ ((IS_GLA ? ((n >> 1) & 7) : n) << 4));
            qf0[ks] = __builtin_bit_cast(bf16x8, *(const LAS u32x4*)(sb + OQ + o0)); kf0[ks] = __builtin_bit_cast(bf16x8, *(const LAS u32x4*)(sb + OK + o0)); }
        if (!IS_GLA) {
#pragma unroll
            for (int ks = 0; ks < NKS; ++ks) { const int c0 = 64 * ks + 16 * q, o1 = (16 + n) * ROWB + (c0 ^ (n << 4));
                qf1[ks] = __builtin_bit_cast(bf16x8, *(const LAS u32x4*)(sb + OQ + o1)); kf1[ks] = __builtin_bit_cast(bf16x8, *(const LAS u32x4*)(sb + OK + o1)); }
        }
        CU_FENCE();
        {
            f32x4 ao = zero, ao1 = zero, ap = zero, ap1 = zero;
#pragma unroll
            for (int ks = 0; ks < NKS; ++ks) { const bf16x8 sbf = CU_SBF(ks);
                if (ks & 1) { ao1 = __builtin_amdgcn_mfma_f32_16x16x32_bf16(qf0[ks], sbf, ao1, 0, 0, 0); ap1 = __builtin_amdgcn_mfma_f32_16x16x32_bf16(kf0[ks], qf0[ks], ap1, 0, 0, 0); }
                else { ao = __builtin_amdgcn_mfma_f32_16x16x32_bf16(qf0[ks], sbf, ao, 0, 0, 0); ap = __builtin_amdgcn_mfma_f32_16x16x32_bf16(kf0[ks], qf0[ks], ap, 0, 0, 0); } }
            if (IS_GLA) {
#pragma unroll
                for (int ks = 0; ks < NKS; ++ks) { const int c0 = 64 * ks + 16 * q, o1 = (16 + n) * ROWB + (c0 ^ (((n >> 1) & 7) << 4));
                    qf1[ks] = __builtin_bit_cast(bf16x8, *(const LAS u32x4*)(sb + OQ + o1)); kf1[ks] = __builtin_bit_cast(bf16x8, *(const LAS u32x4*)(sb + OK + o1)); }
                CU_FENCE();
            }
            ao = ao + ao1; ap = ap + ap1;
#pragma unroll
            for (int r = 0; r < 4; ++r) if (4 * q + r > n) ap[r] = 0.f;
            const bf16x8 pa = __builtin_bit_cast(bf16x8, (u32x4){cvt_pk_bf16(ap[0], ap[1]), cvt_pk_bf16(ap[2], ap[3]), 0u, 0u});
            ao = __builtin_amdgcn_mfma_f32_16x16x32_bf16(pa, vf8, ao, 0, 0, 0);
#pragma unroll
            for (int r = 0; r < 4; ++r) op[(size_t)(4 * q + r) * OW] = ao[r];
        }
        CU_LDU(0, 0);
        CU_FENCE();
        {
            f32x4 ao = zero, ao1 = zero, ap = zero, ap1 = zero, ax = zero, ax1 = zero;
#pragma unroll
            for (int ks = 0; ks < NKS; ++ks) { const bf16x8 sbf = CU_SBF(ks);
                if (ks & 1) { ao1 = __builtin_amdgcn_mfma_f32_16x16x32_bf16(qf1[ks], sbf, ao1, 0, 0, 0); ax1 = __builtin_amdgcn_mfma_f32_16x16x32_bf16(kf0[ks], qf1[ks], ax1, 0, 0, 0); ap1 = __builtin_amdgcn_mfma_f32_16x16x32_bf16(kf1[ks], qf1[ks], ap1, 0, 0, 0); }
                else { ao = __builtin_amdgcn_mfma_f32_16x16x32_bf16(qf1[ks], sbf, ao, 0, 0, 0); ax = __builtin_amdgcn_mfma_f32_16x16x32_bf16(kf0[ks], qf1[ks], ax, 0, 0, 0); ap = __builtin_amdgcn_mfma_f32_16x16x32_bf16(kf1[ks], qf1[ks], ap, 0, 0, 0); } }
            if (NUG > 1) { CU_LDU(1, 1); CU_FENCE(); }
            ao = ao + ao1; ap = ap + ap1; ax = ax + ax1;
#pragma unroll
            for (int r = 0; r < 4; ++r) if (4 * q + r > n) ap[r] = 0.f;
            const bf16x8 pa = __builtin_bit_cast(bf16x8, (u32x4){cvt_pk_bf16(ax[0], ax[1]), cvt_pk_bf16(ax[2], ax[3]), cvt_pk_bf16(ap[0], ap[1]), cvt_pk_bf16(ap[2], ap[3])});
            ao = __builtin_amdgcn_mfma_f32_16x16x32_bf16(pa, vf8, ao, 0, 0, 0);
#pragma unroll
            for (int r = 0; r < 4; ++r) op[(size_t)(16 + 4 * q + r) * OW] = ao[r];
        }
    } else {
        CU_LDU(0, 0);
        if (NUG > 1) CU_LDU(1, 1);
        CU_FENCE();
    }
#pragma unroll
    for (int g = 0; g < NUG; ++g) {
#pragma unroll
        for (int u = 0; u < UG; ++u) { const int mb = g * UG + u; S[mb] = __builtin_amdgcn_mfma_f32_16x16x32_bf16(ktf[g & 1][u], vf8, S[mb] * dlv[g & 1][u], 0, 0, 0); }
        if (g + 2 < NUG) { CU_LDU(g + 2, g & 1); CU_FENCE(); }
    }
#undef CU_FENCE
#undef CU_LDU
#undef CU_SBF
}
constexpr size_t ST_REC = 98304;
constexpr int NSEG_HG = 4, NSEG_GL = 6, NSEG_MAX = 6;
__device__ __forceinline__ int seg_u0(bool gla, int s) { return gla ? (s <= 2 ? 44 * s : 88 + 42 * (s - 2)) : 64 * s; }
__device__ __forceinline__ int seg_nu(bool gla, int s) { return gla ? (s < 2 ? 44 : 42) : 64; }
template <int DK, int MODE>
__device__ __forceinline__ void chain_item(const GAS unsigned char* blk0, int vt_off, GAS float* op0, GAS unsigned char* st, int seg, int nunits, LAS unsigned char* lds, int wave, int lane) {
    asm volatile("" : "+v"(lane), "+s"(wave));
    constexpr bool IS_GLA = (DK == 192);
    constexpr int BLK = IS_GLA ? GL_BLK : HG_BLK, UNITB = IS_GLA ? GL_SHARED + 8192 : HG_BLK, NMB = DK / 16;
    constexpr int SH0 = MODE == 1 ? 0 : (IS_GLA ? GL_OKT : HG_OKT);
    constexpr int SH_PIECES = (MODE == 1 ? (IS_GLA ? GL_SHARED : HG_BLK) : (IS_GLA ? GL_ODL + 768 - GL_OKT : HG_BLK - HG_OKT)) / 16;
    constexpr int T_PIECES = IS_GLA ? 512 : 0, T_LDS = GL_OVT;
    constexpr int PIECES = SH_PIECES + T_PIECES, NP = (PIECES + 511) / 512;
    constexpr int ODL_ = IS_GLA ? GL_ODL : HG_ODL;
    const int tid = wave * 64 + lane, n = lane & 15, q = lane >> 4;
    f32x4 S[NMB]; float dacc = 1.0f;
#pragma unroll
    for (int mb = 0; mb < NMB; ++mb) S[mb] = (f32x4){0.f, 0.f, 0.f, 0.f};
    if (MODE == 1) {
        for (int s = 0; s < seg; ++s) { const GAS unsigned char* rec = st + (size_t)s * 2 * ST_REC + (size_t)(wave * 64 + lane) * 16;
            f32x4 hh[NMB], dd[NMB];
#pragma unroll
            for (int mb = 0; mb < NMB; ++mb) { hh[mb] = *(const GAS f32x4*)(rec + (size_t)mb * 8192); dd[mb] = *(const GAS f32x4*)(st + (size_t)s * 2 * ST_REC + ST_REC + (16 * mb + 4 * q) * 4); }
            asm volatile("" ::: "memory");
#pragma unroll
            for (int mb = 0; mb < NMB; ++mb) S[mb] = S[mb] * dd[mb] + hh[mb]; }
    }
    u32x4 stgA[NP], stgB[NP];
#define CH_SRC(u, p_) (blk0 + (size_t)(u) * BLK + ((p_) < SH_PIECES ? SH0 + (p_) * 16 : vt_off + ((p_) - SH_PIECES) * 16))
#define CH_DST(p_) ((p_) < SH_PIECES ? SH0 + (p_) * 16 : T_LDS + ((p_) - SH_PIECES) * 16)
#define CH_LOAD(stg, u) do { _Pragma("unroll") for (int r_ = 0; r_ < NP; ++r_) { const int p_ = r_ * 512 + tid; const bool ok_ = (NP * 512 == PIECES) || p_ < PIECES; const int pc_ = ok_ ? p_ : 0; stg[r_] = *(const GAS u32x4*)CH_SRC(u, pc_); } } while (0)
#define CH_STORE(stg, buf) do { _Pragma("unroll") for (int r_ = 0; r_ < NP; ++r_) { const int p_ = r_ * 512 + tid; const bool ok_ = (NP * 512 == PIECES) || p_ < PIECES; const int pc_ = ok_ ? p_ : 0; \
        const int d_ = ok_ ? (buf) * UNITB + CH_DST(pc_) : 2 * UNITB + (p_ - PIECES) * 16; *(LAS u32x4*)(lds + d_) = stg[r_]; } } while (0)
#define CH_SYNC() do { asm volatile("s_waitcnt lgkmcnt(0)" ::: "memory"); __builtin_amdgcn_s_barrier(); asm volatile("" ::: "memory"); } while (0)
    CH_LOAD(stgA, 0); CH_STORE(stgA, 0);
    CH_LOAD(stgA, 1);
    CH_SYNC();
    GAS float* op = op0 + 16 * wave + n;
    for (int u = 0; u < nunits; u += 2) {
        if (u + 2 < nunits) CH_LOAD(stgB, u + 2);
        chain_unit<DK, MODE>(lds, S, op + (size_t)(u * 32) * OW, wave, n, q);
        if (MODE == 0 && tid < DK) dacc *= *(const LAS float*)(lds + ODL_ + 4 * tid);
        CH_STORE(stgA, 1);
        CH_SYNC();
        if (u + 3 < nunits) CH_LOAD(stgA, u + 3);
        chain_unit<DK, MODE>(lds + UNITB, S, op + (size_t)(u * 32 + 32) * OW, wave, n, q);
        if (MODE == 0 && tid < DK) dacc *= *(const LAS float*)(lds + UNITB + ODL_ + 4 * tid);
        if (u + 2 < nunits) CH_STORE(stgB, 0);
        CH_SYNC();
    }
    if (MODE == 0) { GAS unsigned char* rec = st + (size_t)seg * 2 * ST_REC + (size_t)(wave * 64 + lane) * 16;
#pragma unroll
        for (int mb = 0; mb < NMB; ++mb) *(GAS f32x4*)(rec + (size_t)mb * 8192) = S[mb];
        if (tid < DK) *(GAS float*)(st + (size_t)seg * 2 * ST_REC + ST_REC + 4 * tid) = dacc; }
#undef CH_SRC
#undef CH_DST
#undef CH_LOAD
#undef CH_STORE
#undef CH_SYNC
}

template <int MODE>
__device__ __forceinline__ void phase_chain(const Ctx& a, int l, LAS unsigned char* lds, int wave, int lane) {
    const int bx = blockIdx.x, G = gridDim.x;
    constexpr int nhg = 24 * (MODE == 0 ? NSEG_HG - 1 : NSEG_HG), nitems = nhg + 24 * (MODE == 0 ? NSEG_GL - 1 : NSEG_GL);
    for (int it = bx; it < nitems; it += G) {
        const bool gla = it >= nhg; const int j = gla ? it - nhg : it;
        int c = j % 24, seg = j / 24;
        if (gla) { const int x = j & 7, i = j >> 3, sl = i % 3, trip = x + 8 * (i / 3); seg = trip >> 3; c = ((trip >> 2) & 1) * 12 + (trip & 3) * 3 + sl; }
        const int u0 = seg_u0(gla, seg), nu = seg_nu(gla, seg);
        GAS unsigned char* st = a.ws() + WS_ST + (size_t)(gla ? 24 + c : c) * (NSEG_MAX - 1) * 2 * ST_REC;
        if (!gla) { const int b = c / 12, h = c % 12;
            chain_item<128, MODE>(a.ws() + WS_HGB + ((size_t)(b * 12 + h) * NUNIT + u0) * HG_BLK, 0, (GAS float*)(a.ws() + WS_O) + ((size_t)b * SEQ + u0 * 32) * OW + h * 128, st, seg, nu, lds, wave, lane); }
        else { const int b = c / 12, h = (c % 12) / 3, sl = c % 3;
            chain_item<192, MODE>(a.ws() + WS_GLB + ((size_t)(b * 4 + h) * NUNIT + u0) * GL_BLK, GL_OVT + 8192 * sl, (GAS float*)(a.ws() + WS_O) + ((size_t)b * SEQ + u0 * 32) * OW + HGW + h * 384 + sl * 128, st, seg, nu, lds, wave, lane); }
        __syncthreads();
    }
    if (MODE == 0) { for (int it = (G >= nitems + 16) ? bx - nitems : bx; it < 16; it += G) { if (it < 0) continue; s5_scan_item(a, l, it, wave, lane); } }
}
__device__ __forceinline__ float red16(float v) {
    v += __int_as_float(__builtin_amdgcn_mov_dpp(__float_as_int(v), 0xB1, 0xF, 0xF, true)); v += __int_as_float(__builtin_amdgcn_mov_dpp(__float_as_int(v), 0x4E, 0xF, 0xF, true));
    v += __int_as_float(__builtin_amdgcn_mov_dpp(__float_as_int(v), 0x141, 0xF, 0xF, true)); v += __int_as_float(__builtin_amdgcn_mov_dpp(__float_as_int(v), 0x140, 0xF, 0xF, true)); return v; }
__device__ __forceinline__ void phase_finalize(const Ctx& a, int l, int wave, int lane) {
    const GAS bf16_t* P = (const GAS bf16_t*)(a.ws() + WS_P); const GAS float* O = (const GAS float*)(a.ws() + WS_O); GAS bf16_t* MX = (GAS bf16_t*)(a.ws() + WS_MIXED);
    const GAS float* hgg = a.in(I_HGG) + l * HGW; const GAS float* hgb = a.in(I_HGB) + l * HGW; const GAS float* glg = a.in(I_GLG) + l * HGW;
    const int gw = blockIdx.x * 8 + wave, NGW = gridDim.x * 8;
    const bool act = lane < 48;
    f32x4 pg[3][2], pb[3][2], qg[4][2];
#pragma unroll
    for (int it = 0; it < 3; ++it) { const int c = (it * 4 + (lane >> 4)) * 128 + (lane & 15) * 8;
        pg[it][0] = *(const GAS f32x4*)(hgg + c); pg[it][1] = *(const GAS f32x4*)(hgg + c + 4); pb[it][0] = *(const GAS f32x4*)(hgb + c); pb[it][1] = *(const GAS f32x4*)(hgb + c + 4); }
#pragma unroll
    for (int h = 0; h < 4; ++h) { const int c = h * 384 + (act ? lane : 0) * 8; qg[h][0] = *(const GAS f32x4*)(glg + c); qg[h][1] = *(const GAS f32x4*)(glg + c + 4); }
    for (int row = gw; row < MTOK; row += NGW) {
        const GAS float* orow = O + (size_t)row * OW; const GAS bf16_t* prow = P + (size_t)row * INP; GAS bf16_t* mrow = MX + (size_t)row * DM;
        f32x4 o0[7], o1[7]; u32x4 gq[7];
#pragma unroll
        for (int it = 0; it < 3; ++it) { const int c = (it * 4 + (lane >> 4)) * 128 + (lane & 15) * 8;
            o0[it] = *(const GAS f32x4*)(orow + c); o1[it] = *(const GAS f32x4*)(orow + c + 4); gq[it] = *(const GAS u32x4*)(prow + C_GB + c); }
#pragma unroll
        for (int h = 0; h < 4; ++h) { const int c = h * 384 + (act ? lane : 0) * 8;
            o0[3 + h] = *(const GAS f32x4*)(orow + HGW + c); o1[3 + h] = *(const GAS f32x4*)(orow + HGW + c + 4); gq[3 + h] = *(const GAS u32x4*)(prow + C_GC + c); }
        asm volatile("" ::: "memory");
#pragma unroll
        for (int it = 0; it < 3; ++it) { const int c = (it * 4 + (lane >> 4)) * 128 + (lane & 15) * 8; const u32x4 gg = gq[it];
            float v[8] = {sigmoidf_(bf_lo(gg.x)) * o0[it][0], sigmoidf_(bf_hi(gg.x)) * o0[it][1], sigmoidf_(bf_lo(gg.y)) * o0[it][2], sigmoidf_(bf_hi(gg.y)) * o0[it][3],
                          sigmoidf_(bf_lo(gg.z)) * o1[it][0], sigmoidf_(bf_hi(gg.z)) * o1[it][1], sigmoidf_(bf_lo(gg.w)) * o1[it][2], sigmoidf_(bf_hi(gg.w)) * o1[it][3]};
            float s = 0.f, ss = 0.f;
#pragma unroll
            for (int i = 0; i < 8; ++i) { s += v[i]; ss += v[i] * v[i]; }
            s = red16(s); ss = red16(ss);
            const float mu = s * (1.0f / 128.0f), rs = 1.0f / sqrtf(fmaxf(ss * (1.0f / 128.0f) - mu * mu, 0.f) + LN_EPS);
            const f32x4 g0 = pg[it][0], g1 = pg[it][1], b0 = pb[it][0], b1 = pb[it][1];
            u32x4 w; w.x = cvt_pk_bf16((v[0] - mu) * rs * g0[0] + b0[0], (v[1] - mu) * rs * g0[1] + b0[1]); w.y = cvt_pk_bf16((v[2] - mu) * rs * g0[2] + b0[2], (v[3] - mu) * rs * g0[3] + b0[3]);
            w.z = cvt_pk_bf16((v[4] - mu) * rs * g1[0] + b1[0], (v[5] - mu) * rs * g1[1] + b1[1]); w.w = cvt_pk_bf16((v[6] - mu) * rs * g1[2] + b1[2], (v[7] - mu) * rs * g1[3] + b1[3]);
            *(GAS u32x4*)(mrow + S5W + c) = w; }
#pragma unroll
        for (int h = 0; h < 4; ++h) { const int c = h * 384 + lane * 8;
            f32x4 p0 = o0[3 + h], p1 = o1[3 + h]; const u32x4 gg = gq[3 + h];
            if (!act) { p0 = (f32x4){0.f, 0.f, 0.f, 0.f}; p1 = p0; }
            const float ss = wave_sum((p0[0] * p0[0] + p0[1] * p0[1]) + (p0[2] * p0[2] + p0[3] * p0[3]) + (p1[0] * p1[0] + p1[1] * p1[1]) + (p1[2] * p1[2] + p1[3] * p1[3]));
            const float rms = 1.0f / sqrtf(ss * (1.0f / 384.0f) + LN_EPS);
            if (act) { const f32x4 g0 = qg[h][0], g1 = qg[h][1];
                const float z[8] = {bf_lo(gg.x), bf_hi(gg.x), bf_lo(gg.y), bf_hi(gg.y), bf_lo(gg.z), bf_hi(gg.z), bf_lo(gg.w), bf_hi(gg.w)};
                u32x4 w; w.x = cvt_pk_bf16(p0[0] * rms * g0[0] * (z[0] * sigmoidf_(z[0])), p0[1] * rms * g0[1] * (z[1] * sigmoidf_(z[1])));
                w.y = cvt_pk_bf16(p0[2] * rms * g0[2] * (z[2] * sigmoidf_(z[2])), p0[3] * rms * g0[3] * (z[3] * sigmoidf_(z[3])));
                w.z = cvt_pk_bf16(p1[0] * rms * g1[0] * (z[4] * sigmoidf_(z[4])), p1[1] * rms * g1[1] * (z[5] * sigmoidf_(z[5])));
                w.w = cvt_pk_bf16(p1[2] * rms * g1[2] * (z[6] * sigmoidf_(z[6])), p1[3] * rms * g1[3] * (z[7] * sigmoidf_(z[7])));
                *(GAS u32x4*)(mrow + S5W + HGW + c) = w; } }
    }
}

constexpr int PH_PRO = 0, PH_MOD = 1, PH_LN0 = 2, PH_L0 = 3, PH_PER_LAYER = 10, N_PHASES = PH_L0 + DEPTH * PH_PER_LAYER;
constexpr int CW_BAR = 4096;

__global__ void __launch_bounds__(512, 2) hybrid_fwd(Args args) {
    extern __shared__ __attribute__((aligned(16))) unsigned char lds_raw[];
    LAS unsigned char* lds = (LAS unsigned char*)lds_raw;
    const int wave = __builtin_amdgcn_readfirstlane((int)threadIdx.x >> 6);
#define lane lane_id_v()
    volatile LAS unsigned* MISC = (volatile LAS unsigned*)(lds + LDSCTL_OFF);
    Ctx ctx; ctx.t = (volatile LAS unsigned long long*)(lds + LDSCTL_OFF + 64);
    if (wave == 0) { const int ln_ = lane; unsigned long long v = 0ull;
#pragma unroll
        for (int i = 0; i < N_IN; ++i) v = (ln_ == i) ? (unsigned long long)args.in[i] : v;
        v = (ln_ == 30) ? (unsigned long long)args.out : v; v = (ln_ == 31) ? (unsigned long long)args.ws : v;
        if (ln_ < 32) ctx.t[ln_] = v;
        if (ln_ < 16) MISC[ln_] = 0u; }
    __syncthreads();
    const int lo = args.ph_lo, hi = args.ph_hi;
    XcdBarrier bar; bar.bar = (unsigned*)(ctx.ws() + WS_CTL) + CW_BAR; bar.x = 0; bar.st = nullptr; bar.w0 = (wave == 0) ? 1u : 0u;
    if (hi - lo > 1) bar = xcd_barrier_post((unsigned*)(ctx.ws() + WS_CTL) + CW_BAR, MISC + 8, (wave == 0) ? 1u : 0u);
#define IN(k) (lo <= (k) && (k) < hi)
#define OPQ() int ln = lane, wv = wave; asm volatile("" : "+s"(wv))
#define SEAM(k) do { if (IN(k) && IN((k) + 1)) xcd_barrier(bar); } while (0)
#define WSP(T, off) ((GAS T*)(ctx.ws() + (off)))
#define WSG(T, off) ((T*)(ctx.ws() + (off)))

    if (IN(PH_PRO)) { OPQ(); phase_prologue(ctx, lds, wv, ln); }
    SEAM(PH_PRO);
    if (IN(PH_MOD)) { OPQ(); phase_mod(ctx, wv, ln); }
    SEAM(PH_MOD);
    if (IN(PH_LN0)) { OPQ(); phase_h0(ctx.in(I_X), WSP(float, WS_MOD), WSP(bf16_t, WS_H), wv, ln); }
    SEAM(PH_LN0);

    for (int l = 0; l < DEPTH; ++l) {
        const int p0 = PH_L0 + l * PH_PER_LAYER;
        const size_t wto = WS_WT + (size_t)l * WT_LAYER, modo = WS_MOD + (size_t)l * NB * 6 * DM * 4;
        if (IN(p0 + 0)) { pg8::Gemm g{WSG(bf16_t, WS_H), WSG(const bf16_t, wto + WT_IN), MTOK, INP, DM}; pg8::StaticOrder S; S.init(MTOK, INP, (int)gridDim.x, (int)blockIdx.x);
            EpiProj E{WSP(bf16_t, WS_P), WSP(bf16_t, WS_UX)}; pg8::gemm_phase<EpiProj, pg8::StaticOrder, true, true>(lds, g, S, E, wave); }
        SEAM(p0 + 0);
        if (IN(p0 + 1)) {
            { pg8::Gemm g{WSG(bf16_t, WS_UX), WSG(const bf16_t, WS_S5W1 + (size_t)l * S5_W1_LAYER), 64 * 256, 64 * 256, S5K}; S5Order S{(int)gridDim.x, (int)blockIdx.x, 64, 0};
              EpiS5A E{WSP(float, WS_SLOC)}; pg8::gemm_phase<EpiS5A, S5Order, true, true>(lds, g, S, E, wave); }
            { OPQ(); phase_pre(ctx, l, lds, wv, ln); }
            }
        SEAM(p0 + 1);
        if (IN(p0 + 2)) { OPQ(); phase_chain<0>(ctx, l, lds, wv, ln); }
        SEAM(p0 + 2);
        if (IN(p0 + 3)) {
            { pg8::Gemm g{WSG(bf16_t, WS_UX), WSG(const bf16_t, WS_S5T + (size_t)l * S5_T_LAYER), 64 * 256, 64 * 1024, S5K}; S5Order S{(int)gridDim.x, (int)blockIdx.x, 256, 2};
              EpiS5C E{WSP(bf16_t, WS_Z)}; pg8::gemm_phase<EpiS5C, S5Order, true, true>(lds, g, S, E, wave);
            }
            { OPQ(); phase_chain<1>(ctx, l, lds, wv, ln); }
            }
        SEAM(p0 + 3);
        if (IN(p0 + 4)) { pg8::Gemm g{WSG(bf16_t, WS_Z), WSG(const bf16_t, wto + WT_GLU), MTOK, S5W, S5W}; pg8::StaticOrder S; S.init(MTOK, S5W, (int)gridDim.x, (int)blockIdx.x);
            EpiGlu E{WSP(bf16_t, WS_Z), WSP(bf16_t, WS_MIXED), ctx.in(I_GLUB) + l * S5W}; pg8::gemm_phase<EpiGlu, pg8::StaticOrder, true, true>(lds, g, S, E, wave);
            { OPQ(); phase_finalize(ctx, l, wv, ln); } }
        SEAM(p0 + 4);
        if (IN(p0 + 5)) { pg8::Gemm g{WSG(bf16_t, WS_MIXED), WSG(const bf16_t, wto + WT_OUT), MTOK, DM, DM}; pg8::StaticOrder S; S.init(MTOK, DM, (int)gridDim.x, (int)blockIdx.x);
            EpiDelta E{WSP(bf16_t, WS_DELTA), WSP(float, modo) + 2 * DM};
            pg8::gemm_phase<EpiDelta, pg8::StaticOrder, true, true>(lds, g, S, E, wave); }
        SEAM(p0 + 5);
        if (IN(p0 + 6)) { OPQ(); const XRes xa{(GAS unsigned*)ctx.out(), WSP(unsigned, WS_XL)}, xb{l + 1 < DEPTH ? (GAS unsigned*)ctx.out() : WSP(unsigned, WS_WT), WSP(unsigned, WS_XL)};
            if (l == 0) phase_lnres<true, true, false>(ctx.in(I_X), xa, WSP(bf16_t, WS_DELTA), nullptr, xb, ctx.in(I_LN1G) + l * DM, ctx.in(I_LN1B) + l * DM, WSP(float, modo), 3, 4, WSP(bf16_t, WS_H), lds, wv, ln);
            else phase_lnres<true, false, false>(nullptr, xa, WSP(bf16_t, WS_DELTA), nullptr, xb, ctx.in(I_LN1G) + l * DM, ctx.in(I_LN1B) + l * DM, WSP(float, modo), 3, 4, WSP(bf16_t, WS_H), lds, wv, ln); }
        SEAM(p0 + 6);
        if (IN(p0 + 7)) { pg8::Gemm g{WSG(bf16_t, WS_H), WSG(const bf16_t, wto + WT_GU), MTOK, 2 * DFF, DM}; pg8::StaticOrder S; S.init(MTOK, 2 * DFF, (int)gridDim.x, (int)blockIdx.x);
            EpiSwiglu E{WSP(bf16_t, WS_P)}; pg8::gemm_phase<EpiSwiglu, pg8::StaticOrder, true, true>(lds, g, S, E, wave); }
        SEAM(p0 + 7);
        if (IN(p0 + 8)) { pg8::Gemm g{WSG(bf16_t, WS_P), WSG(const bf16_t, wto + WT_DN), MTOK, DM, DFF}; pg8::StaticOrderT<2> S; S.init(MTOK, DM, (int)gridDim.x, (int)blockIdx.x);
            EpiDelta E{WSP(bf16_t, WS_DELTA), WSP(float, modo) + 5 * DM};
            pg8::gemm_phase<EpiDelta, pg8::StaticOrderT<2>, true, true>(lds, g, S, E, wave); }
        SEAM(p0 + 8);
        if (IN(p0 + 9)) { OPQ();
            const XRes xb{l + 1 < DEPTH ? (GAS unsigned*)ctx.out() : WSP(unsigned, WS_WT), WSP(unsigned, WS_XL)};
            if (l + 1 < DEPTH) phase_lnres<true, false, false>(nullptr, xb, WSP(bf16_t, WS_DELTA), nullptr, xb, ctx.in(I_LN2G) + l * DM, ctx.in(I_LN2B) + l * DM, WSP(float, modo) + (size_t)NB * 6 * DM, 0, 1, WSP(bf16_t, WS_H), lds, wv, ln);
            else phase_lnres<false, false, true>(nullptr, xb, WSP(bf16_t, WS_DELTA), ctx.out(), xb, ctx.in(I_LN2G) + l * DM, ctx.in(I_LN2B) + l * DM, nullptr, 0, 0, nullptr, lds, wv, ln);
        }
        SEAM(p0 + 9);
    }
#undef IN
#undef SEAM
#undef OPQ
#undef WSP
#undef WSG
#undef lane
}

extern "C" void kernel_launch(void* const* d_in, const int* in_sizes, int n_in, void* d_out, int out_size, void* d_ws, size_t ws_size, hipStream_t stream) {
    static int grid = 0;
    if (grid == 0) {
        if (n_in != N_IN || out_size != MTOK * DM || ws_size < WS_END) { fprintf(stderr, "kernel_launch: unexpected problem (n_in %d, out %d, ws %zu < %zu); nothing launched\n", n_in, out_size, ws_size, (size_t)WS_END); grid = -1; return; }
        int dev = 0, cus = 0, per_cu = 0;
        if (hipGetDevice(&dev) != hipSuccess || hipDeviceGetAttribute(&cus, hipDeviceAttributeMultiprocessorCount, dev) != hipSuccess) { grid = -1; return; }
        if (hipFuncSetAttribute((const void*)hybrid_fwd, hipFuncAttributeMaxDynamicSharedMemorySize, LDS_BYTES) != hipSuccess) { fprintf(stderr, "kernel_launch: hipFuncSetAttribute failed\n"); grid = -1; return; }
        if (hipOccupancyMaxActiveBlocksPerMultiprocessor(&per_cu, (const void*)hybrid_fwd, 512, LDS_BYTES) != hipSuccess || per_cu < 1) fprintf(stderr, "kernel_launch: occupancy query reports %d blocks per CU\n", per_cu);
        (void)hipGetLastError();
        grid = cus;
    }
    if (grid < 0) return;
    (void)in_sizes;
    if (hipMemsetAsync((char*)d_ws + WS_CTL, 0, CTL_ZERO_BYTES, stream) != hipSuccess) return;
    Args a{};
    for (int i = 0; i < N_IN; ++i) a.in[i] = (const float*)d_in[i];
    a.out = (float*)d_out; a.ws = (unsigned char*)d_ws;
    a.ph_lo = 0; a.ph_hi = N_PHASES; hipLaunchKernelGGL(hybrid_fwd, dim3(grid), dim3(512), LDS_BYTES, stream, a);
}
```

```cpp
#include <hip/hip_runtime.h>
#include <cstdio>
#include <cstdint>
namespace pg8 {
#define PG8_LAS __attribute__((address_space(3)))
typedef unsigned short bf16_t;
typedef short bf16x8 __attribute__((ext_vector_type(8)));
typedef float f32x4 __attribute__((ext_vector_type(4)));
typedef unsigned u32x4 __attribute__((ext_vector_type(4)));
constexpr int BM = 256, BK = 64, HALF = 128, HTB = HALF * BK * 2  , STAGE_BYTES = 8 * HTB, NXCD = 8, WGM = 8;

__host__ __device__ __forceinline__ int lds_byte(int r, int c) { const int st = (r >> 4) * 2 + (c >> 5), rr = r & 15, cc = c & 31, ob = rr * 64 + cc * 2; return st * 1024 + (ob ^ (((ob >> 9) & 1) << 5)); }
__host__ __device__ __forceinline__ void stage_rc(int b, int& R, int& C) { const int st = b / 1024, sb = b % 1024, swz = sb ^ (((sb >> 9) & 1) << 5); R = (st >> 1) * 16 + swz / 64; C = (st & 1) * 32 + (swz % 64) / 2; }
__host__ __device__ __forceinline__ int perm32(int rho) { const int n = rho >> 4, i = rho & 15; return 8 * (i >> 2) + 4 * n + (i & 3); }

struct Unit { int pm, pn; };
struct Gemm { const bf16_t* A; const bf16_t* Bt; int M, N, K; };

template <int WGM_>
struct StaticOrderT {
    static constexpr int WGM = WGM_;
    int nM, nN, nwg, G, c;
    __host__ __device__ void init(int M, int N, int G_, int c_) { nM = M / BM; nN = N / BM; nwg = nM * nN; G = G_; c = c_; }
    __host__ __device__ bool next(int i, Unit& u) const {
        const long L = (long)i * G + c; if (L >= nwg) return false;
        int wgid = (int)L; { const int q = nwg / NXCD, r = nwg % NXCD, xcd = wgid % NXCD, off = wgid / NXCD; wgid = (xcd < r ? xcd * (q + 1) : r * (q + 1) + (xcd - r) * q) + off; }
        const int nig = WGM * nN, gid = wgid / nig, fm = gid * WGM, gsz = (nM - fm) < WGM ? (nM - fm) : WGM;
        u.pm = fm + ((wgid % nig) % gsz); u.pn = (wgid % nig) / gsz; return true;
    }
    __device__ __forceinline__ void a_ready(const Unit&) const {}
    __device__ __forceinline__ void done(const Unit&) const {}
};
typedef StaticOrderT<8> StaticOrder;
__device__ __forceinline__ unsigned cvt_pk_bf16(float lo, float hi) { unsigned r; asm volatile("v_cvt_pk_bf16_f32 %0, %1, %2" : "=v"(r) : "v"(lo), "v"(hi)); return r; }
typedef float f32x2 __attribute__((ext_vector_type(2)));
template <class Epi, class Sched, bool ALIGN_EPI = false, bool SP2 = false>
__device__ __forceinline__ void gemm_phase(PG8_LAS unsigned char* lds, const Gemm g, const Sched& S, const Epi& E, int wave_id) {
    int tid_; asm volatile("v_mbcnt_lo_u32_b32 %0, -1, 0\n\tv_mbcnt_hi_u32_b32 %0, -1, %0" : "=v"(tid_)); tid_ += wave_id * 64;
    const int tid = tid_, wid = __builtin_amdgcn_readfirstlane(tid >> 6), lane = tid & 63, wr = wid >> 2, wc = wid & 3, fr = lane & 15, fq = lane >> 4;
    const int K = g.K, nt = K / BK;
    unsigned voffA[2], voffB[2];
#pragma unroll
    for (int i = 0; i < 2; ++i) { int R, C; stage_rc(tid * 16 + i * 8192, R, C); const int Rb = Epi::PERM ? ((R & ~31) + perm32(R & 31)) : R;
        voffA[i] = (unsigned)(R * K + C) * 2u; voffB[i] = (unsigned)(Rb * K + C) * 2u; }
    const size_t kstep = (size_t)(BK * 2);
    const size_t hstep = (size_t)HALF * K * 2;
    const size_t tstep = 2 * hstep;
    const unsigned ldsw = (unsigned)wid * 1024u;
    const int aoff = lds_byte(wr * 64 + fr, fq * 8), boff = lds_byte(wc * 32 + fr, fq * 8);
#define PG8_SA(b, h) (((b) * 2 + (h)) * HTB)
#define PG8_SB(b, h) ((4 + (b) * 2 + (h)) * HTB)
#define PG8_STAGE(bufoff, gbase, voff) do { _Pragma("unroll") for (int _i = 0; _i < 2; ++_i) \
        __builtin_amdgcn_global_load_lds((const unsigned*)((const char*)(gbase) + (voff)[_i]), (PG8_LAS unsigned*)(lds + (bufoff) + ldsw + _i * 8192), 16, 0, 0); } while (0)
#define PG8_LDA(dst, b, h) do { _Pragma("unroll") for (int m = 0; m < 4; ++m) _Pragma("unroll") for (int k = 0; k < 2; ++k) dst[m][k] = *(const PG8_LAS bf16x8*)(lds + PG8_SA(b, h) + aoff + m * 2048 + k * 1024); } while (0)
#define PG8_LDB(dst, b, h) do { _Pragma("unroll") for (int n = 0; n < 2; ++n) _Pragma("unroll") for (int k = 0; k < 2; ++k) dst[n][k] = *(const PG8_LAS bf16x8*)(lds + PG8_SB(b, h) + boff + n * 2048 + k * 1024); } while (0)
#define PG8_MMA(ai, bj, At, Bt) do { __builtin_amdgcn_s_setprio(1); _Pragma("unroll") for (int m = 0; m < 4; ++m) _Pragma("unroll") for (int n = 0; n < 2; ++n) _Pragma("unroll") for (int k = 0; k < 2; ++k) \
        acc[ai][bj][m][n] = __builtin_amdgcn_mfma_f32_16x16x32_bf16(Bt[n][k], At[m][k], acc[ai][bj][m][n], 0, 0, 0); __builtin_amdgcn_s_setprio(0); } while (0)
#define PG8_WAIT_V(n) asm volatile("s_waitcnt vmcnt(" #n ")" ::: "memory")
#define PG8_WAIT_L(n) asm volatile("s_waitcnt lgkmcnt(" #n ")" ::: "memory")
#define PG8_BAR __builtin_amdgcn_s_barrier()
#define PG8_SCHED __builtin_amdgcn_sched_barrier(0)
    Unit cur, nxt; int ui = 0;
    if (!S.next(0, cur)) return;
    f32x4 acc[2][2][4][2];
#pragma unroll
    for (int a = 0; a < 2; ++a)
#pragma unroll
        for (int b = 0; b < 2; ++b)
#pragma unroll
            for (int m = 0; m < 4; ++m)
#pragma unroll
                for (int n = 0; n < 2; ++n) acc[a][b][m][n] = (f32x4){0.f, 0.f, 0.f, 0.f};
    bf16x8 At[4][2], B0[2][2], B1[2][2];
    const char* cA = (const char*)g.A + (size_t)cur.pm * tstep; const char* cB = (const char*)g.Bt + (size_t)cur.pn * tstep;
    S.a_ready(cur);
    if constexpr (SP2) {
        PG8_STAGE(PG8_SB(0, 0), cB, voffB); PG8_STAGE(PG8_SB(0, 1), cB + hstep, voffB); PG8_STAGE(PG8_SA(0, 0), cA, voffA); PG8_STAGE(PG8_SA(0, 1), cA + hstep, voffA);
        if (wr == 1) PG8_BAR;
        PG8_WAIT_V(2); PG8_BAR;
        PG8_STAGE(PG8_SB(1, 0), cB + kstep, voffB); PG8_STAGE(PG8_SA(1, 0), cA + kstep, voffA); PG8_STAGE(PG8_SB(1, 1), cB + hstep + kstep, voffB);
        PG8_WAIT_V(6); PG8_BAR;
    } else {
        PG8_STAGE(PG8_SB(0, 0), cB, voffB); PG8_STAGE(PG8_SA(0, 0), cA, voffA); PG8_STAGE(PG8_SB(0, 1), cB + hstep, voffB); PG8_STAGE(PG8_SA(0, 1), cA + hstep, voffA);
        if (wr == 1) PG8_BAR;
        PG8_WAIT_V(4); PG8_BAR;
        PG8_STAGE(PG8_SB(1, 0), cB + kstep, voffB); PG8_STAGE(PG8_SA(1, 0), cA + kstep, voffA); PG8_STAGE(PG8_SB(1, 1), cB + hstep + kstep, voffB);
        PG8_WAIT_V(6); PG8_BAR;
    }
    for (;;) {
        const bool has_next = S.next(ui + 1, nxt);
        const char* nA = has_next ? (const char*)g.A + (size_t)nxt.pm * tstep : cA; const char* nB = has_next ? (const char*)g.Bt + (size_t)nxt.pn * tstep : cB;
        for (int t = 0; t < nt; t += 2) {
            const bool last = (t == nt - 2);
            const char* a1 = cA + (size_t)(t + 1) * kstep;
            const char* a2 = last ? nA : cA + (size_t)(t + 2) * kstep; const char* b2 = last ? nB : cB + (size_t)(t + 2) * kstep;
            const char* a3 = a2 + kstep; const char* b3 = b2 + kstep;
            if (last && has_next) S.a_ready(nxt);
            if constexpr (SP2) {
            PG8_LDB(B0, 0, 0); PG8_LDB(B1, 0, 1); PG8_SCHED; PG8_LDA(At, 0, 0); PG8_STAGE(PG8_SA(1, 1), a1 + hstep, voffA);
            PG8_WAIT_V(8); PG8_WAIT_L(0); PG8_BAR; PG8_MMA(0, 0, At, B0); PG8_MMA(0, 1, At, B1); PG8_BAR; PG8_SCHED;
            PG8_LDA(At, 0, 1); PG8_STAGE(PG8_SB(0, 0), b2, voffB); PG8_STAGE(PG8_SB(0, 1), b2 + hstep, voffB); PG8_STAGE(PG8_SA(0, 0), a2, voffA);
            PG8_WAIT_V(8); PG8_WAIT_L(0); PG8_BAR; PG8_MMA(1, 0, At, B0); PG8_MMA(1, 1, At, B1); PG8_BAR; PG8_SCHED;
            PG8_LDB(B0, 1, 0); PG8_LDB(B1, 1, 1); PG8_SCHED; PG8_LDA(At, 1, 0); PG8_STAGE(PG8_SA(0, 1), a2 + hstep, voffA);
            PG8_WAIT_V(8); PG8_WAIT_L(0); PG8_BAR; PG8_MMA(0, 0, At, B0); PG8_MMA(0, 1, At, B1); PG8_BAR; PG8_SCHED;
            PG8_LDA(At, 1, 1); PG8_STAGE(PG8_SB(1, 0), b3, voffB); PG8_STAGE(PG8_SB(1, 1), b3 + hstep, voffB); PG8_STAGE(PG8_SA(1, 0), a3, voffA);
            PG8_WAIT_V(8); PG8_WAIT_L(0); PG8_BAR; PG8_MMA(1, 0, At, B0); PG8_MMA(1, 1, At, B1); PG8_BAR; PG8_SCHED;
            } else {
            PG8_LDB(B0, 0, 0); PG8_SCHED; PG8_LDA(At, 0, 0); PG8_STAGE(PG8_SA(1, 1), a1 + hstep, voffA);
            PG8_WAIT_L(8); PG8_BAR; PG8_WAIT_L(0); PG8_MMA(0, 0, At, B0); PG8_BAR; PG8_SCHED;
            PG8_LDB(B1, 0, 1); PG8_STAGE(PG8_SB(0, 0), b2, voffB);
            PG8_BAR; PG8_WAIT_L(0); PG8_MMA(0, 1, At, B1); PG8_BAR;
            PG8_LDA(At, 0, 1); PG8_STAGE(PG8_SA(0, 0), a2, voffA);
            PG8_BAR; PG8_WAIT_L(0); PG8_MMA(1, 0, At, B0); PG8_BAR; PG8_SCHED;
            PG8_STAGE(PG8_SB(0, 1), b2 + hstep, voffB);
            PG8_WAIT_V(6); PG8_BAR; PG8_MMA(1, 1, At, B1); PG8_BAR;
            PG8_LDB(B0, 1, 0); PG8_SCHED; PG8_LDA(At, 1, 0); PG8_STAGE(PG8_SA(0, 1), a2 + hstep, voffA);
            PG8_WAIT_L(8); PG8_BAR; PG8_WAIT_L(0); PG8_MMA(0, 0, At, B0); PG8_BAR; PG8_SCHED;
            PG8_LDB(B1, 1, 1); PG8_STAGE(PG8_SB(1, 0), b3, voffB);
            PG8_BAR; PG8_WAIT_L(0); PG8_MMA(0, 1, At, B1); PG8_BAR;
            PG8_LDA(At, 1, 1); PG8_STAGE(PG8_SA(1, 0), a3, voffA);
            PG8_BAR; PG8_WAIT_L(0); PG8_MMA(1, 0, At, B0); PG8_BAR; PG8_SCHED;
            PG8_STAGE(PG8_SB(1, 1), b3 + hstep, voffB);
            PG8_WAIT_V(6); PG8_BAR; PG8_MMA(1, 1, At, B1); PG8_BAR;
            }
        }
        if constexpr (ALIGN_EPI) { if (wr == 0) PG8_BAR; }
        if constexpr (!Epi::AFTER_DRAIN) { E(acc, cur, wr, wc, fr, fq); S.done(cur); }
        if (!has_next) break;
#pragma unroll
        for (int a = 0; a < 2; ++a)
#pragma unroll
            for (int b = 0; b < 2; ++b)
#pragma unroll
                for (int m = 0; m < 4; ++m)
#pragma unroll
                    for (int n = 0; n < 2; ++n) acc[a][b][m][n] = (f32x4){0.f, 0.f, 0.f, 0.f};
        cur = nxt; cA = nA; cB = nB; ++ui;
        if constexpr (ALIGN_EPI) { if (wr == 1) PG8_BAR; }
    }
    PG8_WAIT_V(0);
    if constexpr (!ALIGN_EPI) { if (wr == 0) PG8_BAR; }
    PG8_BAR;
    if constexpr (Epi::AFTER_DRAIN) { E.fused(acc, cur, wr, wc, fr, fq, lds, wid, lane); S.done(cur); }
#undef PG8_SA
#undef PG8_SB
#undef PG8_STAGE
#undef PG8_LDA
#undef PG8_LDB
#undef PG8_MMA
#undef PG8_WAIT_V
#undef PG8_WAIT_L
#undef PG8_BAR
#undef PG8_SCHED
}
}
#define LAS __attribute__((address_space(3)))
#define XB_TMO      128
#define XB_XCNT(j)  (256  + 64 * (j))
#define XB_XSUB(j)  (1280 + 64 * (j))
#define XB_XGEN(j)  (2304 + 64 * (j))
#define XB_TOP      3328
#define XB_TOPGEN   3392
#define XCD_BAR_WORDS 3456
#define XB_SPIN_CAP (1u << 24)

__device__ __forceinline__ unsigned xb_ld(unsigned* p)              { return __hip_atomic_load(p, __ATOMIC_RELAXED, __HIP_MEMORY_SCOPE_AGENT); }
__device__ __forceinline__ unsigned xb_add(unsigned* p, unsigned v) { return __hip_atomic_fetch_add(p, v, __ATOMIC_RELAXED, __HIP_MEMORY_SCOPE_AGENT); }
__device__ __forceinline__ unsigned xb_xcc_id() { return (unsigned)__builtin_amdgcn_s_getreg((3 << 11) | 20) & 0xFu; }
#define XB_SPIN(cond, bar) do { unsigned _sp = 0; while (cond) { __builtin_amdgcn_s_sleep(1); \
    if ((++_sp & 255u) == 0u) { if (xb_ld(&(bar)[XB_TMO])) break; if (_sp > XB_SPIN_CAP) { atomicAdd(&(bar)[XB_TMO], 1u); break; } } } } while (0)

struct XcdBarrier {
    unsigned* bar; unsigned x; unsigned w0;
    volatile LAS unsigned* st;
};

__device__ __forceinline__ bool xb_lane0() { unsigned r; asm volatile("v_mbcnt_lo_u32_b32 %0, -1, 0\n\tv_mbcnt_hi_u32_b32 %0, -1, %0" : "=v"(r)); return r == 0u; }
__device__ __forceinline__ XcdBarrier xcd_barrier_post(unsigned* bar, volatile LAS unsigned* st, unsigned w0) {
    XcdBarrier b; b.bar = bar; b.x = xb_xcc_id(); b.st = st; b.w0 = w0;
    if (w0 && xb_lane0()) (void)xb_add(&bar[XB_XCNT(b.x)], 1u);
    return b;
}
__device__ __forceinline__ void xcd_barrier_complete(unsigned* bar, unsigned x, unsigned& nloc, unsigned& nx) {
    const unsigned G = gridDim.x * gridDim.y * gridDim.z;
    unsigned sum, cnt, mine, sp = 0u;
    for (;;) {
        sum = 0u; cnt = 0u; mine = 0u;
#pragma unroll
        for (unsigned j = 0; j < 16; ++j) { const unsigned c = xb_ld(&bar[XB_XCNT(j)]); sum += c; cnt += (c > 0u) ? 1u : 0u; mine = (j == x) ? c : mine; }
        if (sum == G) break;
        __builtin_amdgcn_s_sleep(1);
        if ((++sp & 255u) == 0u) { if (xb_ld(&bar[XB_TMO])) break; if (sp > XB_SPIN_CAP) { atomicAdd(&bar[XB_TMO], 1u); break; } }
    }
    nloc = mine > 0u ? mine : 1u; nx = cnt > 0u ? cnt : 1u;
}

__device__ __forceinline__ void xcd_barrier(const XcdBarrier& b) {
    asm volatile("s_waitcnt vmcnt(0)" ::: "memory");
    __syncthreads();
    if (b.w0 && xb_lane0()) {
        unsigned* bar = b.bar;
        __builtin_amdgcn_s_waitcnt(0);
        unsigned nloc = b.st[0], nx = b.st[1];
        if (nloc == 0u) { xcd_barrier_complete(bar, b.x, nloc, nx); b.st[0] = nloc; b.st[1] = nx; }
        const unsigned old = xb_add(&bar[XB_XSUB(b.x)], 1u);
        const unsigned gen = old / nloc;
        if (old + 1u == (gen + 1u) * nloc) {
            __builtin_amdgcn_fence(__ATOMIC_RELEASE, "agent");
            asm volatile("s_waitcnt vmcnt(0)" ::: "memory");
            const unsigned og = xb_add(&bar[XB_TOP], 1u);
            const unsigned tg = og / nx;
            if (og + 1u == (tg + 1u) * nx) xb_add(&bar[XB_TOPGEN], 1u);
            else XB_SPIN(xb_ld(&bar[XB_TOPGEN]) == tg, bar);
            __builtin_amdgcn_fence(__ATOMIC_ACQUIRE, "agent");
            xb_add(&bar[XB_XGEN(b.x)], 1u);
            asm volatile("s_waitcnt vmcnt(0)" ::: "memory");
        } else {
            XB_SPIN(xb_ld(&bar[XB_XGEN(b.x)]) == gen, bar);
            __builtin_amdgcn_fence(__ATOMIC_ACQUIRE, "agent");
            asm volatile("s_waitcnt vmcnt(0)" ::: "memory");
        }
    }
    __syncthreads();
}

constexpr int DM = 4096, NB = 2, SEQ = 8192, MTOK = NB * SEQ, DEPTH = 4;
constexpr int S5W = 1024;
constexpr int HGW = 1536;
constexpr int GLKW = 768;
constexpr int INW = 11792, INP = 12032, DFF = 11008;
constexpr int OW = 3072;
constexpr int C_U = 0, C_QB = 1024, C_FB = 2560, C_IB = 4096, C_GB = 5632, C_QC = 7168, C_KC = 7936, C_VC = 8704, C_GC = 10240, C_LR = 11776;
constexpr float LN_EPS = 1e-5f;
constexpr float ALPHA = 1.6817928305074290861f;
constexpr float GLA_QSCALE = 0.07216878364870322f;

enum { I_X = 0, I_C, I_WADA, I_BADA, I_TABLE, I_WIN, I_WOUT, I_AREAL, I_AIMAG, I_LOGDT, I_BRE, I_BIM, I_CRE, I_CIM, I_S5D, I_GLUW, I_GLUB,
       I_LBRAW, I_HGG, I_HGB, I_WGATE, I_BGATE, I_GLG, I_WFG, I_WFU, I_WFD, I_LN1G, I_LN1B, I_LN2G, I_LN2B, N_IN };

constexpr size_t MiB = 1u << 20;
constexpr size_t WS_CTL = 0, CTL_ZERO_BYTES = 1 * MiB;
constexpr size_t WS_MOD = 1 * MiB;
constexpr size_t WS_MISC = 2 * MiB;
constexpr size_t WS_CONDPART = 12 * MiB;
constexpr size_t WS_H = 24 * MiB;
constexpr size_t WS_MIXED = WS_H + 128 * MiB;
constexpr size_t WS_Z = WS_MIXED + 128 * MiB;
constexpr size_t WS_O = WS_Z + 32 * MiB;
constexpr size_t WS_DELTA = WS_O;
constexpr size_t WS_P = WS_O + 192 * MiB;
constexpr size_t WS_WT = WS_P + 376 * MiB;
constexpr size_t WT_IN = 0, WT_OUT = 94 * MiB, WT_GU = 126 * MiB, WT_DN = 298 * MiB, WT_GLU = 384 * MiB, WT_LAYER = 386 * MiB;
constexpr size_t WS_HGB = WS_WT + DEPTH * WT_LAYER;
constexpr size_t WS_GLB = WS_HGB + 198 * MiB;
constexpr size_t WS_S5T = WS_GLB + 128 * MiB;
constexpr size_t WS_S5W1 = WS_S5T + 576 * MiB;
constexpr size_t WS_UX = WS_S5W1 + 144 * MiB;
constexpr size_t WS_SLOC = WS_UX + 36 * MiB;
constexpr size_t WS_LAM64 = WS_SLOC + 8 * MiB;
constexpr size_t WS_ST = WS_LAM64 + 1 * MiB;
constexpr size_t WS_XL = WS_ST + 45 * MiB;
constexpr size_t WS_END = WS_XL + 64 * MiB;
static_assert(DEPTH >= 2, "the last layer's residual halves reuse layer 0's weight region");
static_assert((size_t)INP * DM * 2 == 94 * MiB && (size_t)DM * DM * 2 == 32 * MiB && (size_t)2 * DFF * DM * 2 == 172 * MiB && (size_t)DM * DFF * 2 == 86 * MiB, "weight map");
static_assert((size_t)MTOK * INP * 2 == 376 * MiB && (size_t)MTOK * DFF * 2 <= 376 * MiB, "activation map");

constexpr int RING_BYTES = 131072;
constexpr int LDSCTL_OFF = 135168;
constexpr int LDS_BYTES = 147456;

#ifndef LAS
#define LAS __attribute__((address_space(3)))
#endif
#define GAS __attribute__((address_space(1)))
typedef unsigned short bf16_t;
typedef float f32x4 __attribute__((ext_vector_type(4)));
typedef float f32x2 __attribute__((ext_vector_type(2)));
typedef unsigned u32x4 __attribute__((ext_vector_type(4)));
typedef unsigned u32x2 __attribute__((ext_vector_type(2)));
#define LDS_WAIT() asm volatile("s_waitcnt lgkmcnt(0)" ::: "memory")
#define VM_WAIT() asm volatile("s_waitcnt vmcnt(0)" ::: "memory")
typedef __bf16 bf16x2_t __attribute__((ext_vector_type(2)));
__device__ __forceinline__ unsigned cvt_pk_bf16(float lo, float hi) { return __builtin_bit_cast(unsigned, __builtin_convertvector((f32x2){lo, hi}, bf16x2_t)); }

__device__ __forceinline__ float bf_lo(unsigned w) { return __uint_as_float(w << 16); }
__device__ __forceinline__ float bf_hi(unsigned w) { return __uint_as_float(w & 0xffff0000u); }
__device__ __forceinline__ float bf2f(bf16_t b) { return __uint_as_float(((unsigned)b) << 16); }
__device__ __forceinline__ float wave_sum(float v) {
    v += __int_as_float(__builtin_amdgcn_mov_dpp(__float_as_int(v), 0xB1, 0xF, 0xF, true));
    v += __int_as_float(__builtin_amdgcn_mov_dpp(__float_as_int(v), 0x4E, 0xF, 0xF, true));
    v += __int_as_float(__builtin_amdgcn_mov_dpp(__float_as_int(v), 0x141, 0xF, 0xF, true));
    v += __int_as_float(__builtin_amdgcn_mov_dpp(__float_as_int(v), 0x140, 0xF, 0xF, true));
    const int b = __float_as_int(v);
    return (__int_as_float(__builtin_amdgcn_readlane(b, 0)) + __int_as_float(__builtin_amdgcn_readlane(b, 16))) + (__int_as_float(__builtin_amdgcn_readlane(b, 32)) + __int_as_float(__builtin_amdgcn_readlane(b, 48)));
}
__device__ __forceinline__ float sigmoidf_(float x) { return __builtin_amdgcn_rcpf(1.0f + __expf(-x)); }
__device__ __forceinline__ float gelu_tanh(float y) { const float a = 0.7978845608028654f * (y + 0.044715f * y * y * y); const float t = 1.0f - 2.0f * __builtin_amdgcn_rcpf(1.0f + __expf(2.0f * a)); return 0.5f * y * (1.0f + t); }

struct EpiProj {
    static constexpr bool PERM = true, AFTER_DRAIN = false;
    GAS bf16_t* P; GAS bf16_t* UX;
    __device__ __forceinline__ void operator()(const f32x4 (&acc)[2][2][4][2], const pg8::Unit& u, int wr, int wc, int fr, int fq) const {
        const int row0 = u.pm * 256 + wr * 64 + fr, col0 = u.pn * 256 + wc * 32 + 8 * fq;
        const bool s5 = u.pn < 4;
#pragma unroll
        for (int ai = 0; ai < 2; ++ai)
#pragma unroll
            for (int m = 0; m < 4; ++m) { const int row = row0 + ai * 128 + m * 16;
#pragma unroll
                for (int bj = 0; bj < 2; ++bj) { const f32x4 v0 = acc[ai][bj][m][0], v1 = acc[ai][bj][m][1]; const int col = col0 + bj * 128;
                    u32x4 w; w.x = cvt_pk_bf16(v0[0], v0[1]); w.y = cvt_pk_bf16(v0[2], v0[3]); w.z = cvt_pk_bf16(v1[0], v1[1]); w.w = cvt_pk_bf16(v1[2], v1[3]);
                    if (!s5) *(GAS u32x4*)(P + (size_t)row * INP + col) = w;
                    else { GAS bf16_t* ur = UX + (size_t)((col >> 4) * 256 + (row >> 6)) * 1152; *(GAS u32x4*)(ur + (row & 63) * 16 + (col & 15)) = w;
                        if ((row & 63) == 0) { const u32x4 z = (u32x4){0u, 0u, 0u, 0u}; GAS bf16_t* zp = ur + 1024 + ((col & 15) ? 64 : 0);
#pragma unroll
                            for (int i = 0; i < 8; ++i) *(GAS u32x4*)(zp + 8 * i) = z; } } } }
    }
};
struct EpiSwiglu {
    static constexpr bool PERM = true, AFTER_DRAIN = false;
    GAS bf16_t* HID;
    __device__ __forceinline__ void operator()(const f32x4 (&acc)[2][2][4][2], const pg8::Unit& u, int wr, int wc, int fr, int fq) const {
        const int row0 = u.pm * 256 + wr * 64 + fr, col0 = u.pn * 128 + wc * 32 + 8 * fq;
#pragma unroll
        for (int ai = 0; ai < 2; ++ai)
#pragma unroll
            for (int m = 0; m < 4; ++m) { GAS bf16_t* rowp = HID + (size_t)(row0 + ai * 128 + m * 16) * DFF + col0;
                float o[8];
#pragma unroll
                for (int n = 0; n < 2; ++n)
#pragma unroll
                    for (int j = 0; j < 4; ++j) { const float g = acc[ai][0][m][n][j], up = acc[ai][1][m][n][j]; o[n * 4 + j] = g * __builtin_amdgcn_rcpf(1.0f + __expf(-g)) * up; }
                u32x4 w; w.x = cvt_pk_bf16(o[0], o[1]); w.y = cvt_pk_bf16(o[2], o[3]); w.z = cvt_pk_bf16(o[4], o[5]); w.w = cvt_pk_bf16(o[6], o[7]);
                *(GAS u32x4*)rowp = w; }
    }
};
struct EpiGlu {
    static constexpr bool PERM = true, AFTER_DRAIN = false;
    const GAS bf16_t* Z; GAS bf16_t* MIXED; const GAS float* bias;
    __device__ __forceinline__ void operator()(const f32x4 (&acc)[2][2][4][2], const pg8::Unit& u, int wr, int wc, int fr, int fq) const {
        const int row0 = u.pm * 256 + wr * 64 + fr, col0 = u.pn * 256 + wc * 32 + 8 * fq;
#pragma unroll
        for (int bj = 0; bj < 2; ++bj) {
            const f32x4 b0 = *(const GAS f32x4*)(bias + col0 + bj * 128), b1 = *(const GAS f32x4*)(bias + col0 + bj * 128 + 4);
            u32x4 zq[2][4];
#pragma unroll
            for (int ai = 0; ai < 2; ++ai)
#pragma unroll
                for (int m = 0; m < 4; ++m) zq[ai][m] = *(const GAS u32x4*)(Z + (size_t)(row0 + ai * 128 + m * 16) * S5W + col0 + bj * 128);
            asm volatile("" ::: "memory");
#pragma unroll
            for (int ai = 0; ai < 2; ++ai)
#pragma unroll
                for (int m = 0; m < 4; ++m) { const size_t r = (size_t)(row0 + ai * 128 + m * 16);
                    const u32x4 zz = zq[ai][m];
                    const f32x4 v0 = acc[ai][bj][m][0] + b0, v1 = acc[ai][bj][m][1] + b1;
                    u32x4 w;
                    w.x = cvt_pk_bf16(bf_lo(zz.x) * sigmoidf_(v0[0]), bf_hi(zz.x) * sigmoidf_(v0[1]));
                    w.y = cvt_pk_bf16(bf_lo(zz.y) * sigmoidf_(v0[2]), bf_hi(zz.y) * sigmoidf_(v0[3]));
                    w.z = cvt_pk_bf16(bf_lo(zz.z) * sigmoidf_(v1[0]), bf_hi(zz.z) * sigmoidf_(v1[1]));
                    w.w = cvt_pk_bf16(bf_lo(zz.w) * sigmoidf_(v1[2]), bf_hi(zz.w) * sigmoidf_(v1[3]));
                    *(GAS u32x4*)(MIXED + r * DM + col0 + bj * 128) = w;
                    if (m & 1) asm volatile("" ::: "memory"); }
        }
    }
};
struct EpiDelta {
    static constexpr bool PERM = true, AFTER_DRAIN = false;
    GAS bf16_t* D; const GAS float* gate0;
    __device__ __forceinline__ void operator()(const f32x4 (&acc)[2][2][4][2], const pg8::Unit& u, int wr, int wc, int fr, int fq) const {
        const int row0 = u.pm * 256 + wr * 64 + fr, col0 = u.pn * 256 + wc * 32 + 8 * fq;
        const GAS float* gp = gate0 + (u.pm >= 32 ? 6 * DM : 0) + col0;
        f32x4 g[2][2];
#pragma unroll
        for (int bj = 0; bj < 2; ++bj)
#pragma unroll
            for (int n = 0; n < 2; ++n) g[bj][n] = *(const GAS f32x4*)(gp + bj * 128 + 4 * n) + 1.0f;
#pragma unroll
        for (int ai = 0; ai < 2; ++ai)
#pragma unroll
            for (int m = 0; m < 4; ++m) { GAS bf16_t* rowp = D + (size_t)(row0 + ai * 128 + m * 16) * DM + col0;
#pragma unroll
                for (int bj = 0; bj < 2; ++bj) { const f32x4 v0 = acc[ai][bj][m][0] * g[bj][0], v1 = acc[ai][bj][m][1] * g[bj][1];
                    u32x4 w; w.x = cvt_pk_bf16(v0[0], v0[1]); w.y = cvt_pk_bf16(v0[2], v0[3]); w.z = cvt_pk_bf16(v1[0], v1[1]); w.w = cvt_pk_bf16(v1[2], v1[3]);
                    *(GAS u32x4*)(rowp + bj * 128) = w; } }
    }
};

__device__ __forceinline__ int lane_id_v() { int r; asm volatile("v_mbcnt_lo_u32_b32 %0, -1, 0\n\tv_mbcnt_hi_u32_b32 %0, -1, %0" : "=v"(r)); return r; }
struct Args { const float* in[N_IN]; float* out; unsigned char* ws; int ph_lo, ph_hi; };
struct Ctx {
    volatile LAS unsigned long long* t;
    __device__ __forceinline__ unsigned long long ld(int i) const { const unsigned long long v = t[i];
        return ((unsigned long long)(unsigned)__builtin_amdgcn_readfirstlane((int)(v >> 32)) << 32) | (unsigned long long)(unsigned)__builtin_amdgcn_readfirstlane((int)(unsigned)v); }
    __device__ __forceinline__ const GAS float* in(int i) const { return (const GAS float*)ld(i); }
    __device__ __forceinline__ GAS float* out() const { return (GAS float*)ld(30); }
    __device__ __forceinline__ GAS unsigned char* ws() const { return (GAS unsigned char*)ld(31); }
};

constexpr int S5K = 1152;
constexpr size_t S5_T_LAYER = (size_t)64 * 1024 * S5K * 2, S5_W1_LAYER = (size_t)64 * 256 * S5K * 2;

struct S5Order {
    int G, c, n, sh;
    __device__ __forceinline__ bool next(int i, pg8::Unit& u) const { int L = i * G + c; if (L >= n) return false;
        if (sh == 2 && G == 256 && n == 256) { const int x = L & 7, j = L >> 3; L = ((x << 3) + (j >> 2)) * 4 + (j & 3); }
        u.pm = L >> sh; u.pn = L; return true; }
    __device__ __forceinline__ void a_ready(const pg8::Unit&) const {}
    __device__ __forceinline__ void done(const pg8::Unit&) const {}
};
struct EpiS5A {
    static constexpr bool PERM = false, AFTER_DRAIN = false;
    GAS float* Sloc;
    __device__ __forceinline__ void operator()(const f32x4 (&acc)[2][2][4][2], const pg8::Unit& u, int wr, int wc, int fr, int fq) const {
        const int row0 = u.pm * 256 + wr * 64 + fr, col0 = wc * 32 + 4 * fq;
#pragma unroll
        for (int ai = 0; ai < 2; ++ai)
#pragma unroll
            for (int m = 0; m < 4; ++m)
#pragma unroll
                for (int n = 0; n < 2; ++n) *(GAS f32x4*)(Sloc + (size_t)(row0 + ai * 128 + m * 16) * 128 + col0 + n * 16) = acc[ai][0][m][n];
    }
};
struct EpiS5C {
    static constexpr bool PERM = true, AFTER_DRAIN = false;
    GAS bf16_t* Z;
    __device__ __forceinline__ void operator()(const f32x4 (&acc)[2][2][4][2], const pg8::Unit& u, int wr, int wc, int fr, int fq) const {
        const int g = u.pm, c0 = wr * 64 + fr, cc0 = (u.pn & 3) * 256 + wc * 32 + 8 * fq;
#pragma unroll
        for (int ai = 0; ai < 2; ++ai)
#pragma unroll
            for (int m = 0; m < 4; ++m) { const int c = c0 + ai * 128 + m * 16;
#pragma unroll
                for (int bj = 0; bj < 2; ++bj) { const int cc = cc0 + bj * 128, t = cc >> 4, h0 = cc & 15;
                    const f32x4 v0 = acc[ai][bj][m][0], v1 = acc[ai][bj][m][1];
                    u32x4 w; w.x = cvt_pk_bf16(gelu_tanh(v0[0]), gelu_tanh(v0[1])); w.y = cvt_pk_bf16(gelu_tanh(v0[2]), gelu_tanh(v0[3]));
                    w.z = cvt_pk_bf16(gelu_tanh(v1[0]), gelu_tanh(v1[1])); w.w = cvt_pk_bf16(gelu_tanh(v1[2]), gelu_tanh(v1[3]));
                    *(GAS u32x4*)(Z + (size_t)(c * 64 + t) * S5W + g * 16 + h0) = w; } }
    }
};
__device__ __forceinline__ void s5_tables_item(const Ctx& a, int lg, LAS unsigned char* lds, int wave, int lane) {
    LAS f32x2* LP = (LAS f32x2*)lds;
    LAS f32x2* BB = (LAS f32x2*)(lds + 33280);
    LAS f32x2* CC = (LAS f32x2*)(lds + 41472);
    LAS float* KT = (LAS float*)(lds + 49664);
    const int tid = wave * 64 + lane, l = lg >> 6, g = lg & 63;
    if (tid < 64) { const int p = tid;
        const double ar = (double)a.in(I_AREAL)[lg * 64 + p], ai = (double)a.in(I_AIMAG)[lg * 64 + p], dt = exp((double)a.in(I_LOGDT)[lg]);
        const double mag = exp(ar * dt), ang = ai * dt, lr = mag * cos(ang), li = mag * sin(ang);
        const double den = ar * ar + ai * ai, nr = lr - 1.0, ni = li, cr = (nr * ar + ni * ai) / den, ci = (ni * ar - nr * ai) / den;
        double pr = 1.0, pi = 0.0;
        for (int tau = 0; tau <= 64; ++tau) { LP[tau * 64 + p] = (f32x2){(float)pr, (float)pi}; const double nr2 = pr * lr - pi * li, ni2 = pr * li + pi * lr; pr = nr2; pi = ni2; }
        for (int h = 0; h < 16; ++h) { const double br = (double)a.in(I_BRE)[((size_t)lg * 64 + p) * 16 + h], bi = (double)a.in(I_BIM)[((size_t)lg * 64 + p) * 16 + h];
            BB[p * 16 + h] = (f32x2){(float)(cr * br - ci * bi), (float)(cr * bi + ci * br)}; }
    }
    for (int e = tid; e < 1024; e += 512) { const int h = e >> 6, p = e & 63; CC[e] = (f32x2){a.in(I_CRE)[((size_t)lg * 16 + h) * 64 + p], a.in(I_CIM)[((size_t)lg * 16 + h) * 64 + p]}; }
    __syncthreads();
    if (tid < 64) *(GAS f32x2*)((GAS float*)(a.ws() + WS_LAM64) + ((size_t)lg * 64 + tid) * 2) = LP[64 * 64 + tid];
    for (int e = tid; e < 64 * 256; e += 512) { const int tau = e >> 8, h = (e >> 4) & 15, hp = e & 15; float s = 0.f;
#pragma unroll 8
        for (int p = 0; p < 64; ++p) { const f32x2 c = CC[h * 64 + p], lm = LP[tau * 64 + p], b = BB[p * 16 + hp];
            const float xr = c.x * lm.x - c.y * lm.y, xi = c.x * lm.y + c.y * lm.x; s += xr * b.x - xi * b.y; }
        if (tau == 0 && h == hp) s += a.in(I_S5D)[l * S5W + g * 16 + h];
        KT[e] = s; }
    __syncthreads();
    GAS bf16_t* T = (GAS bf16_t*)(a.ws() + WS_S5T + (size_t)l * S5_T_LAYER) + (size_t)g * 1024 * S5K;
    for (int pc = tid; pc < 1024 * 144; pc += 512) { const int n = pc / 144, j = pc % 144, t = n >> 4, h = n & 15; float v[8];
        if (j < 128) { const int s = j >> 1, hp0 = (j & 1) * 8;
            if (s > t) {
#pragma unroll
                for (int i = 0; i < 8; ++i) v[i] = 0.f;
            } else { const LAS float* kp = KT + (t - s) * 256 + h * 16 + hp0; const f32x4 k0 = *(const LAS f32x4*)kp, k1 = *(const LAS f32x4*)(kp + 4);
                v[0] = k0[0]; v[1] = k0[1]; v[2] = k0[2]; v[3] = k0[3]; v[4] = k1[0]; v[5] = k1[1]; v[6] = k1[2]; v[7] = k1[3]; }
        } else { const int p0 = (j - 128) * 4;
#pragma unroll
            for (int i = 0; i < 4; ++i) { const f32x2 c = CC[h * 64 + p0 + i], lm = LP[(t + 1) * 64 + p0 + i]; v[2 * i] = c.x * lm.x - c.y * lm.y; v[2 * i + 1] = -(c.x * lm.y + c.y * lm.x); } }
        *(GAS u32x4*)(T + (size_t)n * S5K + j * 8) = (u32x4){cvt_pk_bf16(v[0], v[1]), cvt_pk_bf16(v[2], v[3]), cvt_pk_bf16(v[4], v[5]), cvt_pk_bf16(v[6], v[7])}; }
    GAS bf16_t* W1 = (GAS bf16_t*)(a.ws() + WS_S5W1 + (size_t)l * S5_W1_LAYER) + (size_t)g * 256 * S5K;
    for (int pc = tid; pc < 256 * 144; pc += 512) { const int n = pc / 144, j = pc % 144; float v[8];
#pragma unroll
        for (int i = 0; i < 8; ++i) v[i] = 0.f;
        if (n < 128 && j < 128) { const int p = n >> 1, ri = n & 1, s = j >> 1, hp0 = (j & 1) * 8; const f32x2 lm = LP[(63 - s) * 64 + p];
#pragma unroll
            for (int i = 0; i < 8; ++i) { const f32x2 b = BB[p * 16 + hp0 + i]; v[i] = ri ? (lm.x * b.y + lm.y * b.x) : (lm.x * b.x - lm.y * b.y); } }
        *(GAS u32x4*)(W1 + (size_t)n * S5K + j * 8) = (u32x4){cvt_pk_bf16(v[0], v[1]), cvt_pk_bf16(v[2], v[3]), cvt_pk_bf16(v[4], v[5]), cvt_pk_bf16(v[6], v[7])}; }
    __syncthreads();
}
__device__ __forceinline__ void s5_scan_item(const Ctx& a, int l, int item, int wave, int lane) {
    const int idx = item * 512 + wave * 64 + lane, g = idx >> 7, b = (idx >> 6) & 1, p = idx & 63;
    const f32x2 lam = *(const GAS f32x2*)((const GAS float*)(a.ws() + WS_LAM64) + ((size_t)(l * 64 + g) * 64 + p) * 2);
    const GAS float* sl = (const GAS float*)(a.ws() + WS_SLOC) + ((size_t)(g * 256 + b * 128)) * 128 + 2 * p;
    GAS bf16_t* ux = (GAS bf16_t*)(a.ws() + WS_UX) + ((size_t)(g * 256 + b * 128)) * S5K + 1024 + 2 * p;
    float xr = 0.f, xi = 0.f;
    for (int c0 = 0; c0 < 128; c0 += 8) { f32x2 s[8];
#pragma unroll
        for (int i = 0; i < 8; ++i) s[i] = *(const GAS f32x2*)(sl + (size_t)(c0 + i) * 128);
#pragma unroll
        for (int i = 0; i < 8; ++i) { *(GAS unsigned*)(ux + (size_t)(c0 + i) * S5K) = cvt_pk_bf16(xr, xi);
            const float nr = lam.x * xr - lam.y * xi + s[i].x, ni = lam.x * xi + lam.y * xr + s[i].y; xr = nr; xi = ni; } }
}

__device__ __forceinline__ void transpose_item(const GAS float* W, int N, int k0, int n0, GAS bf16_t* WT, int drow0, int Kd, LAS float* scr, int lane) {
    const int nl = 4 * (lane & 15), kq = lane >> 4;
    const bool valid = (n0 + nl) < N;
    f32x4 v[16];
#pragma unroll
    for (int i = 0; i < 16; ++i) { const int k = 4 * i + kq; v[i] = valid ? *(const GAS f32x4*)(W + (size_t)(k0 + k) * N + n0 + nl) : (f32x4){0.f, 0.f, 0.f, 0.f}; }
#pragma unroll
    for (int i = 0; i < 16; ++i) { const int k = 4 * i + kq; LAS float* s = scr + k * 65 + nl; s[0] = v[i][0]; s[1] = v[i][1]; s[2] = v[i][2]; s[3] = v[i][3]; }
    LDS_WAIT();
    const int c = lane & 7;
#pragma unroll
    for (int j = 0; j < 8; ++j) { const int n = (lane >> 3) + 8 * j; const LAS float* s = scr + (8 * c) * 65 + n;
        u32x4 o; o.x = cvt_pk_bf16(s[0], s[65]); o.y = cvt_pk_bf16(s[130], s[195]); o.z = cvt_pk_bf16(s[260], s[325]); o.w = cvt_pk_bf16(s[390], s[455]);
        *(GAS u32x4*)(WT + (size_t)(drow0 + n) * Kd + k0 + 8 * c) = o; }
    LDS_WAIT();
}
constexpr int NIT_IN = 64 * 188, NIT_OUT = 64 * 64, NIT_G = 64 * 172, NIT_DN = 172 * 64, NIT_GLU = 16 * 16;
constexpr int NIT_LAYER = NIT_IN + NIT_OUT + 2 * NIT_G + NIT_DN + NIT_GLU;
constexpr int NIT_TR = DEPTH * NIT_LAYER, NIT_COND = 64 * 96;

__device__ __forceinline__ void phase_prologue(const Ctx& a, LAS unsigned char* lds, int wave, int lane) {
    if (blockIdx.x & 1) { for (int lg = blockIdx.x; lg < DEPTH * 64; lg += gridDim.x) s5_tables_item(a, lg, lds, wave, lane); __syncthreads(); }
    LAS float* scr = (LAS float*)(lds + wave * 16640);
    const int gw = blockIdx.x * 8 + wave, NGW = gridDim.x * 8;
    for (int it = gw; it < NIT_TR + NIT_COND; it += NGW) {
        if (it < NIT_TR) {
            const int l = it / NIT_LAYER; int r = it % NIT_LAYER;
            GAS unsigned char* wt = a.ws() + WS_WT + (size_t)l * WT_LAYER;
            if (r < NIT_IN) { const int kb = r / 188, nb = r % 188; transpose_item(a.in(I_WIN) + (size_t)l * DM * INW, INW, 64 * kb, 64 * nb, (GAS bf16_t*)(wt + WT_IN), 64 * nb, DM, scr, lane); continue; } r -= NIT_IN;
            if (r < NIT_OUT) { const int kb = r / 64, nb = r % 64; transpose_item(a.in(I_WOUT) + (size_t)l * DM * DM, DM, 64 * kb, 64 * nb, (GAS bf16_t*)(wt + WT_OUT), 64 * nb, DM, scr, lane); continue; } r -= NIT_OUT;
            if (r < NIT_G) { const int kb = r / 172, nb = r % 172, n0 = 64 * nb; transpose_item(a.in(I_WFG) + (size_t)l * DM * DFF, DFF, 64 * kb, n0, (GAS bf16_t*)(wt + WT_GU), 256 * (n0 / 128) + (n0 % 128), DM, scr, lane); continue; } r -= NIT_G;
            if (r < NIT_G) { const int kb = r / 172, nb = r % 172, n0 = 64 * nb; transpose_item(a.in(I_WFU) + (size_t)l * DM * DFF, DFF, 64 * kb, n0, (GAS bf16_t*)(wt + WT_GU), 256 * (n0 / 128) + 128 + (n0 % 128), DM, scr, lane); continue; } r -= NIT_G;
            if (r < NIT_DN) { const int kb = r / 64, nb = r % 64; transpose_item(a.in(I_WFD) + (size_t)l * DFF * DM, DM, 64 * kb, 64 * nb, (GAS bf16_t*)(wt + WT_DN), 64 * nb, DFF, scr, lane); continue; } r -= NIT_DN;
            { const int kb = r / 16, nb = r % 16; transpose_item(a.in(I_GLUW) + (size_t)l * S5W * S5W, S5W, 64 * kb, 64 * nb, (GAS bf16_t*)(wt + WT_GLU), 64 * nb, S5W, scr, lane); }
        } else {
            const int item = it - NIT_TR, kb = item / 96, jb = item % 96, k0 = 64 * kb, j0 = 256 * jb + 4 * lane;
            const GAS float* c = a.in(I_C);
            float c0 = c[k0 + lane], c1 = c[DM + k0 + lane];
            c0 = c0 / (1.0f + expf(-c0)); c1 = c1 / (1.0f + expf(-c1));
            f32x4 a0 = (f32x4){0.f, 0.f, 0.f, 0.f}, a1 = a0;
            const GAS float* w = a.in(I_WADA) + (size_t)k0 * (6 * DM) + j0;
#pragma unroll 8
            for (int kk = 0; kk < 64; ++kk) { const f32x4 wv = *(const GAS f32x4*)(w + (size_t)kk * (6 * DM));
                const float s0 = __int_as_float(__builtin_amdgcn_readlane(__float_as_int(c0), kk)), s1 = __int_as_float(__builtin_amdgcn_readlane(__float_as_int(c1), kk));
                a0 += wv * s0; a1 += wv * s1; }
            GAS float* cp = (GAS float*)(a.ws() + WS_CONDPART);
            *(GAS f32x4*)(cp + (size_t)(kb * 2 + 0) * (6 * DM) + j0) = a0;
            *(GAS f32x4*)(cp + (size_t)(kb * 2 + 1) * (6 * DM) + j0) = a1;
        }
    }
    __syncthreads();
    if (!(blockIdx.x & 1)) { for (int lg = blockIdx.x; lg < DEPTH * 64; lg += gridDim.x) s5_tables_item(a, lg, lds, wave, lane); }
}
__device__ __forceinline__ void phase_mod(const Ctx& a, int wave, int lane) {
    const int gt = blockIdx.x * 512 + wave * 64 + lane, NT = gridDim.x * 512;
    const GAS float* cp = (const GAS float*)(a.ws() + WS_CONDPART);
    GAS float* mod = (GAS float*)(a.ws() + WS_MOD); GAS float* misc = (GAS float*)(a.ws() + WS_MISC);
    for (int idx = gt; idx < NB * 6 * DM; idx += NT) {
        const int b = idx / (6 * DM), j = idx % (6 * DM);
        float s = a.in(I_BADA)[j];
        for (int kb = 0; kb < 64; ++kb) s += cp[(size_t)(kb * 2 + b) * (6 * DM) + j];
        for (int l = 0; l < DEPTH; ++l) mod[(size_t)((l * 2 + b) * 6) * DM + j] = s + a.in(I_TABLE)[(size_t)l * 6 * DM + j];
    }
    for (int idx = gt; idx < DM; idx += NT) { misc[idx] = 1.0f; misc[DM + idx] = 0.0f; }
    for (int idx = gt; idx < HGW; idx += NT) {
        const GAS float* raw = a.in(I_LBRAW); float r[DEPTH], mx = -3.0e38f;
#pragma unroll
        for (int l = 0; l < DEPTH; ++l) { r[l] = raw[l * HGW + idx]; mx = fmaxf(mx, r[l]); }
        float e[DEPTH], sum = 0.f;
#pragma unroll
        for (int l = 0; l < DEPTH; ++l) { e[l] = expf(r[l] - mx); sum += e[l]; }
        float cum = 0.f;
#pragma unroll
        for (int l = 0; l < DEPTH; ++l) { misc[2 * DM + l * HGW + idx] = cum; if (l + 1 < DEPTH) cum += e[l + 1] / sum; }
    }
}

__device__ __forceinline__ void phase_h0(const GAS float* x, const GAS float* modp, GAS bf16_t* H, int wave, int lane) {
    for (int blk = blockIdx.x; blk < MTOK / 64; blk += gridDim.x) {
        const int r0 = blk * 64, b = (r0 >= SEQ) ? 1 : 0;
        f32x4 A[2], B[2];
#pragma unroll
        for (int jj = 0; jj < 2; ++jj) { const int c = 512 * wave + 256 * jj + 4 * lane; A[jj] = *(const GAS f32x4*)(modp + (size_t)(b * 6 + 1) * DM + c) + 1.0f; B[jj] = *(const GAS f32x4*)(modp + (size_t)(b * 6 + 0) * DM + c); }
#pragma unroll 8
        for (int rl = 0; rl < 64; ++rl) { const size_t off = (size_t)(r0 + rl) * DM + 512 * wave + 4 * lane;
#pragma unroll
            for (int jj = 0; jj < 2; ++jj) { const f32x4 v = *(const GAS f32x4*)(x + off + 256 * jj), y = v * A[jj] + B[jj];
                u32x2 w; w.x = cvt_pk_bf16(y[0], y[1]); w.y = cvt_pk_bf16(y[2], y[3]); *(GAS u32x2*)(H + off + 256 * jj) = w; } }
    }
}
struct XRes { GAS unsigned* hi; GAS unsigned* lo; };
template <bool WITH_H, bool XP32, bool XO32>
__device__ __forceinline__ void phase_lnres(const GAS float* xp32, XRes xp, const GAS bf16_t* delta, GAS float* xo32, XRes xo, const GAS float* lng, const GAS float* lnb, const GAS float* modp, int i_shift, int i_scale,
                                            GAS bf16_t* H, LAS unsigned char* lds, int wave, int lane) {
    LAS f32x2* red = (LAS f32x2*)lds;
    for (int blk = blockIdx.x; blk < MTOK / 64; blk += gridDim.x) {
        const int r0 = blk * 64, b = (r0 >= SEQ) ? 1 : 0;
        f32x4 G[2], Bt[2], A[2], B[2];
#pragma unroll
        for (int jj = 0; jj < 2; ++jj) { const int c = 512 * wave + 256 * jj + 4 * lane; G[jj] = *(const GAS f32x4*)(lng + c); Bt[jj] = *(const GAS f32x4*)(lnb + c);
            if (WITH_H) { A[jj] = *(const GAS f32x4*)(modp + (size_t)(b * 6 + i_scale) * DM + c) + 1.0f; B[jj] = *(const GAS f32x4*)(modp + (size_t)(b * 6 + i_shift) * DM + c); } }
        const size_t offb = (size_t)r0 * DM + 512 * wave + 4 * lane;
        f32x4 va[4][2], vb[4][2]; u32x2 da[4][2], db[4][2];
#define LN_LOAD(v_, d_, it_) do { _Pragma("unroll") for (int r = 0; r < 4; ++r) _Pragma("unroll") for (int jj = 0; jj < 2; ++jj) { const size_t o_ = offb + (size_t)((it_) * 4 + r) * DM + 256 * jj; \
            if (XP32) v_[r][jj] = *(const GAS f32x4*)(xp32 + o_); else { const u32x2 t_ = *(const GAS u32x2*)(xp.hi + (o_ >> 1)); const unsigned l_ = xp.lo[o_ >> 2]; \
                v_[r][jj][0] = __uint_as_float(t_.x); v_[r][jj][1] = __uint_as_float(t_.y); v_[r][jj][2] = __uint_as_float(l_); } \
            d_[r][jj] = *(const GAS u32x2*)(delta + o_); } } while (0)
#define LN_STEP(v_, d_, it_) do { LAS f32x2* rb = red + ((it_) & 1) * 32; \
            _Pragma("unroll") for (int r = 0; r < 4; ++r) { float s1 = 0.f, s2 = 0.f; \
                _Pragma("unroll") for (int jj = 0; jj < 2; ++jj) { const f32x4 dd = (f32x4){bf_lo(d_[r][jj].x), bf_hi(d_[r][jj].x), bf_lo(d_[r][jj].y), bf_hi(d_[r][jj].y)}; \
                    f32x4 xq = v_[r][jj]; \
                    if (!XP32) { const unsigned t0 = __float_as_uint(xq[0]), t1 = __float_as_uint(xq[1]), lw = __float_as_uint(xq[2]); \
                        xq[0] = __uint_as_float(__builtin_amdgcn_perm(t0, lw, 0x0504000cu)); xq[1] = __uint_as_float(__builtin_amdgcn_perm(t0, lw, 0x0706010cu)); \
                        xq[2] = __uint_as_float(__builtin_amdgcn_perm(t1, lw, 0x0504020cu)); xq[3] = __uint_as_float(__builtin_amdgcn_perm(t1, lw, 0x0706030cu)); } \
                    const f32x4 y = xq * ALPHA + dd; v_[r][jj] = y; \
                    s1 += (y[0] + y[1]) + (y[2] + y[3]); s2 += (y[0] * y[0] + y[1] * y[1]) + (y[2] * y[2] + y[3] * y[3]); } \
                s1 = wave_sum(s1); s2 = wave_sum(s2); if (lane == 0) rb[r * 8 + wave] = (f32x2){s1, s2}; } \
            __syncthreads(); \
            _Pragma("unroll") for (int r = 0; r < 4; ++r) { float s1 = 0.f, s2 = 0.f; \
                _Pragma("unroll") for (int w = 0; w < 8; ++w) { const f32x2 p = rb[r * 8 + w]; s1 += p.x; s2 += p.y; } \
                const float mu = s1 * (1.0f / DM), rs = 1.0f / sqrtf(fmaxf(s2 * (1.0f / DM) - mu * mu, 0.f) + LN_EPS); \
                _Pragma("unroll") for (int jj = 0; jj < 2; ++jj) { const f32x4 x = ((v_[r][jj] - mu) * rs) * G[jj] + Bt[jj]; const size_t o_ = offb + (size_t)((it_) * 4 + r) * DM + 256 * jj; \
                    if (XO32) *(GAS f32x4*)(xo32 + o_) = x; \
                    else { const unsigned q0 = __float_as_uint(x[0]) + 0x80u, q1 = __float_as_uint(x[1]) + 0x80u, q2 = __float_as_uint(x[2]) + 0x80u, q3 = __float_as_uint(x[3]) + 0x80u; \
                        *(GAS u32x2*)(xo.hi + (o_ >> 1)) = (u32x2){__builtin_amdgcn_perm(q1, q0, 0x07060302u), __builtin_amdgcn_perm(q3, q2, 0x07060302u)}; \
                        xo.lo[o_ >> 2] = __builtin_amdgcn_perm(q1, q0, 0x0c0c0501u) | __builtin_amdgcn_perm(q3, q2, 0x05010c0cu); } \
                    if (WITH_H) { const f32x4 y = x * A[jj] + B[jj]; u32x2 w; w.x = cvt_pk_bf16(y[0], y[1]); w.y = cvt_pk_bf16(y[2], y[3]); *(GAS u32x2*)(H + o_) = w; } } } } while (0)
        LN_LOAD(va, da, 0);
        for (int it = 0; it < 16; it += 2) {
            LN_LOAD(vb, db, it + 1);
            LN_STEP(va, da, it);
            if (it + 2 < 16) LN_LOAD(va, da, it + 2);
            LN_STEP(vb, db, it + 1);
        }
#undef LN_LOAD
#undef LN_STEP
        __syncthreads();
    }
}

typedef short bf16x8 __attribute__((ext_vector_type(8)));
constexpr int HG_BLK = 33280, HG_OQ = 0, HG_OK = 8192, HG_OKT = 16384, HG_ODL = 24576, HG_OVT = 25088;
constexpr int GL_BLK = 63488, GL_OQ = 0, GL_OK = 12800, GL_OKT = 25600, GL_ODL = 37888, GL_SHARED = 38912, GL_OVT = 38912;
constexpr int NUNIT = SEQ / 32;

struct PreOut { GAS unsigned char* blk; int oq, ok, okt, odl, rowb; bool swz; };
__device__ __forceinline__ int slot_swz(int r) { return (0 - (r >> 2)) & 3; }
template <int HALF>
__device__ __forceinline__ float pre_half(const PreOut& P, int d, int pd, float e0, const float (&a)[16], const float (&qq)[16], const float (&kk)[16], float (&kta)[16], unsigned (&kt)[16], float& ph) {
    float w = 1.0f;
#pragma unroll
    for (int t = 14; t >= 0; t -= 2) { const float kv1 = kk[t + 1] * w; w *= a[t + 1]; const float kv0 = kk[t] * w; w *= a[t];
        if (HALF == 0) { kta[t] = kv0; kta[t + 1] = kv1; } else kt[4 * (t >> 2) + 2 + ((t & 3) >> 1)] = cvt_pk_bf16(kv0, kv1); }
    ph = w;
    float e = e0;
#pragma unroll
    for (int j = 0; j < 16; ++j) { const int row = 16 * HALF + j;
        e *= a[j];
        const int off = row * P.rowb + ((2 * pd) ^ ((P.swz ? j : ((j >> 1) & 7)) << 4));
        const float qv = qq[j] * e, kc = kk[j] * fminf(__builtin_amdgcn_rcpf(e), 5.5406224e34f);
        const float qn = __int_as_float(__builtin_amdgcn_mov_dpp(__float_as_int(qv), 0xB1, 0xF, 0xF, true)), kn = __int_as_float(__builtin_amdgcn_mov_dpp(__float_as_int(kc), 0xB1, 0xF, 0xF, true));
        if ((d & 1) == 0) { *(GAS unsigned*)(P.blk + P.oq + off) = cvt_pk_bf16(qv, qn); *(GAS unsigned*)(P.blk + P.ok + off) = cvt_pk_bf16(kc, kn); } }
    return e;
}
__device__ __forceinline__ void pre_tail(const PreOut& P, int d, float dlb, float eend, const float (&kta)[16], unsigned (&kt)[16]) {
#pragma unroll
    for (int t = 0; t < 16; t += 2) kt[4 * (t >> 2) + ((t & 3) >> 1)] = cvt_pk_bf16(kta[t] * dlb, kta[t + 1] * dlb);
#pragma unroll
    for (int i = 0; i < 4; ++i) *(GAS u32x4*)(P.blk + P.okt + d * 64 + 16 * (i ^ slot_swz(d))) = (u32x4){kt[4 * i], kt[4 * i + 1], kt[4 * i + 2], kt[4 * i + 3]};
    *(GAS float*)(P.blk + P.odl + d * 4) = eend;
}
__device__ __forceinline__ void glds16_asm(const GAS void* gsrc, unsigned lds_dst) { unsigned keep;
    asm volatile("s_mov_b32 %0, m0\n\ts_mov_b32 m0, %2\n\ts_nop 0\n\tglobal_load_lds_dwordx4 %1, off\n\ts_mov_b32 m0, %0" : "=&s"(keep) : "v"(gsrc), "s"(lds_dst) : "memory"); }
constexpr int PRE_IN = 49152, PRE_OUT = 2 * PRE_IN;
__device__ __forceinline__ void pre_hg_dma(const GAS bf16_t* P, int t, int half, LAS unsigned char* img, int wave, int lane) {
    const int bu = t / 3, kind = t - 3 * bu, b = bu / NUNIT, un = bu - b * NUNIT;
    const GAS bf16_t* src = P + ((size_t)b * SEQ + un * 32 + 16 * half) * INP + kind * 512 + 8 * lane;
    const unsigned dst = (unsigned)(size_t)img;
#pragma unroll
    for (int i = 0; i < 6; ++i) { const int r = wave * 6 + i, arr = r >> 4, j = r & 15;
        glds16_asm(src + (size_t)j * INP + (arr == 0 ? C_QB : arr == 1 ? C_FB : C_IB), dst + r * 1024); }
}
template <int HALF>
__device__ __forceinline__ float pre_half_l(LAS unsigned char* oq, LAS unsigned char* ok, int pd, float e0, const float (&a)[16], const float (&qq)[16], const float (&kk)[16], float (&kta)[16], unsigned (&kt)[16], float& ph) {
    float w = 1.0f;
#pragma unroll
    for (int t = 14; t >= 0; t -= 2) { const float kv1 = kk[t + 1] * w; w *= a[t + 1]; const float kv0 = kk[t] * w; w *= a[t];
        if (HALF == 0) { kta[t] = kv0; kta[t + 1] = kv1; } else kt[4 * (t >> 2) + 2 + ((t & 3) >> 1)] = cvt_pk_bf16(kv0, kv1); }
    ph = w;
    float e = e0;
#pragma unroll
    for (int j = 0; j < 16; ++j) { e *= a[j];
        const int off = j * 256 + ((2 * pd) ^ (j << 4));
        const float qv = qq[j] * e, kc = kk[j] * fminf(__builtin_amdgcn_rcpf(e), 5.5406224e34f);
        *(LAS unsigned short*)(oq + off) = (unsigned short)cvt_pk_bf16(qv, qv); *(LAS unsigned short*)(ok + off) = (unsigned short)cvt_pk_bf16(kc, kc); }
    return e;
}
__device__ __forceinline__ void phase_pre(const Ctx& a, int l, LAS unsigned char* lds, int wave, int lane) {
    const GAS bf16_t* P = (const GAS bf16_t*)(a.ws() + WS_P);
    int tid = wave * 64 + lane;
    const int bx = blockIdx.x, G = gridDim.x;
    {
        const int t_lo = (int)((long)(NB * NUNIT * 3) * bx / G), t_hi = (int)((long)(NB * NUNIT * 3) * (bx + 1) / G);
        float lbk[3];
#pragma unroll
        for (int k = 0; k < 3; ++k) lbk[k] = ((const GAS float*)(a.ws() + WS_MISC))[2 * DM + l * HGW + k * 512 + tid];
        asm volatile("" : "+v"(lbk[0]), "+v"(lbk[1]), "+v"(lbk[2]));
        __syncthreads();
        if (t_lo < t_hi) pre_hg_dma(P, t_lo, 0, lds, wave, lane);
        VM_WAIT();
        for (int t = t_lo; t < t_hi; ++t) {
            asm volatile("" : "+v"(tid));
            const int bu = t / 3, kind = t - 3 * bu, b = bu / NUNIT, un = bu - b * NUNIT;
            const int ch = kind * 512 + tid, hh = tid >> 7, d = tid & 127, pd = (d & ~31) + 8 * ((d >> 2) & 3) + 4 * ((d >> 4) & 1) + (d & 3);
            const float lb = kind == 0 ? lbk[0] : kind == 1 ? lbk[1] : lbk[2];
            GAS unsigned char* blk0 = a.ws() + WS_HGB + ((size_t)(b * 12 + kind * 4) * NUNIT + un) * HG_BLK;
            float kta[16]; unsigned kt[16], vv[16]; float e0 = 1.f, e1 = 1.f, ph = 1.f;
#pragma unroll
            for (int half = 0; half < 2; ++half) {
                __syncthreads();
                { const int nt = half ? t + 1 : t; if (nt < t_hi) pre_hg_dma(P, nt, half ^ 1, lds + (half ^ 1) * PRE_IN, wave, lane); }
                const LAS unsigned char* img = lds + half * PRE_IN + 2 * tid;
                float g[16], qq[16], kk[16];
                unsigned short rq[16], rf[16], rv[16];
#pragma unroll
                for (int j = 0; j < 16; ++j) { rq[j] = *(const LAS unsigned short*)(img + j * 1024); rf[j] = *(const LAS unsigned short*)(img + (16 + j) * 1024); rv[j] = *(const LAS unsigned short*)(img + (32 + j) * 1024); }
                asm volatile("" ::: "memory");
#pragma unroll
                for (int j = 0; j < 16; ++j) {
                    const float qin = fmaxf(bf2f(rq[j]), -80.f), fin = fminf(fmaxf(bf2f(rf[j]), -80.f), 80.f);
                    const unsigned short v = rv[j];
                    const int w = 4 * (j >> 2) + 2 * half + ((j & 3) >> 1); if (j & 1) vv[w] |= ((unsigned)v) << 16; else vv[w] = v;
                    const float e = __expf(-fin), sg = __builtin_amdgcn_rcpf(1.0f + e);
                    const float f = lb + (1.0f - lb) * sg;
                    g[j] = f; kk[j] = (1.0f - lb) * (e * sg); qq[j] = qin * __builtin_amdgcn_rcpf(1.0f + __expf(-qin)); }
                LAS unsigned char* oq = lds + PRE_OUT + hh * 4096; LAS unsigned char* ok = oq + 16384;
                if (half == 0) { e0 = pre_half_l<0>(oq, ok, pd, 1.0f, g, qq, kk, kta, kt, ph); } else { e1 = pre_half_l<1>(oq, ok, pd, e0, g, qq, kk, kta, kt, ph); }
                __syncthreads();
                VM_WAIT();
#pragma unroll
                for (int i = 0; i < 4; ++i) { const int pc = i * 512 + tid, c = pc >> 8, wi = pc & 255;
                    *(GAS u32x4*)(blk0 + (size_t)(c & 3) * NUNIT * HG_BLK + (c >> 2 ? HG_OK : HG_OQ) + half * 4096 + wi * 16) = *(const LAS u32x4*)(lds + PRE_OUT + c * 4096 + wi * 16); }
            }
            GAS unsigned char* blk = blk0 + (size_t)hh * NUNIT * HG_BLK;
            const PreOut po{blk, HG_OQ, HG_OK, HG_OKT, HG_ODL, 256, true};
#pragma unroll
            for (int i = 0; i < 4; ++i) *(GAS u32x4*)(blk + HG_OVT + d * 64 + 16 * (i ^ slot_swz(d))) = (u32x4){vv[4 * i], vv[4 * i + 1], vv[4 * i + 2], vv[4 * i + 3]};
            pre_tail(po, d, ph, e1, kta, kt);
        }
    }
    const bool bal = G == 256;
    const int t_lo = bal ? (bx < 64 ? 4 * bx : 256 + 12 * (bx - 64)) : bx;
    const int t_hi = bal ? t_lo + (bx < 64 ? 4 : 12) : NB * NUNIT * 5, t_st = bal ? 1 : G;
    for (int task = t_lo; task < t_hi; task += t_st) {
        asm volatile("" : "+v"(tid));
        const int bu = task / 5, kind = 3 + (task - 5 * bu), b = bu / NUNIT, un = bu % NUNIT;
        const size_t row0 = (size_t)b * SEQ + un * 32;
        if (kind < 5) {
            __syncthreads();
            if (tid < 64) *(LAS u32x4*)(lds + tid * 16) = *(const GAS u32x4*)(P + (row0 + (tid >> 1)) * INP + C_LR + 8 * (tid & 1));
            __syncthreads();
            if (tid < 384) {
                const int ch = (kind - 3) * 384 + tid, h = ch / 192, d = ch % 192, pd = (d & ~31) + 8 * ((d >> 2) & 3) + 4 * ((d >> 4) & 1) + (d & 3);
                GAS unsigned char* blk = a.ws() + WS_GLB + ((size_t)(b * 4 + h) * NUNIT + un) * GL_BLK;
                const PreOut po{blk, GL_OQ, GL_OK, GL_OKT, GL_ODL, 384, false};
                float wg[16];
#pragma unroll
                for (int r = 0; r < 16; ++r) wg[r] = a.in(I_WGATE)[((size_t)l * 16 + r) * GLKW + ch];
                const float bgv = a.in(I_BGATE)[l * GLKW + ch];
                float kta[16]; unsigned kt[16]; float e0 = 1.f, e1 = 1.f, ph = 1.f;
#pragma unroll
                for (int half = 0; half < 2; ++half) {
                    float g[16], qq[16], kk[16];
#pragma unroll
                    for (int j = 0; j < 16; ++j) { const GAS bf16_t* prow = P + (row0 + 16 * half + j) * INP;
                        const u32x4 l0 = *(const LAS u32x4*)(lds + (16 * half + j) * 32), l1 = *(const LAS u32x4*)(lds + (16 * half + j) * 32 + 16);
                        float x = bgv;
                        x += bf_lo(l0.x) * wg[0] + bf_hi(l0.x) * wg[1] + bf_lo(l0.y) * wg[2] + bf_hi(l0.y) * wg[3] + bf_lo(l0.z) * wg[4] + bf_hi(l0.z) * wg[5] + bf_lo(l0.w) * wg[6] + bf_hi(l0.w) * wg[7];
                        x += bf_lo(l1.x) * wg[8] + bf_hi(l1.x) * wg[9] + bf_lo(l1.y) * wg[10] + bf_hi(l1.y) * wg[11] + bf_lo(l1.z) * wg[12] + bf_hi(l1.z) * wg[13] + bf_lo(l1.w) * wg[14] + bf_hi(l1.w) * wg[15];
                        g[j] = __expf((fminf(x, 0.f) - __logf(1.0f + __expf(-fabsf(x)))) * 0.0625f);
                        qq[j] = bf2f(prow[C_QC + ch]) * GLA_QSCALE; kk[j] = bf2f(prow[C_KC + ch]); }
                    if (half == 0) { e0 = pre_half<0>(po, d, pd, 1.0f, g, qq, kk, kta, kt, ph); } else { e1 = pre_half<1>(po, d, pd, e0, g, qq, kk, kta, kt, ph); }
                }
                pre_tail(po, d, ph, e1, kta, kt);
            }
        } else {
            const int ch = (kind - 5) * 512 + tid, h = ch / 384, e = ch % 384;
            GAS unsigned char* blk = a.ws() + WS_GLB + ((size_t)(b * 4 + h) * NUNIT + un) * GL_BLK;
            unsigned vv[16]; unsigned short rv[32];
#pragma unroll
            for (int j = 0; j < 32; ++j) rv[j] = P[(row0 + j) * INP + C_VC + ch];
            asm volatile("" ::: "memory");
#pragma unroll
            for (int j = 0; j < 32; ++j) { const unsigned short v = rv[j];
                const int w = 4 * ((j >> 2) & 3) + 2 * (j >> 4) + ((j & 3) >> 1); if (j & 1) vv[w] |= ((unsigned)v) << 16; else vv[w] = v; }
#pragma unroll
            for (int i = 0; i < 4; ++i) *(GAS u32x4*)(blk + GL_OVT + e * 64 + 16 * (i ^ slot_swz(e))) = (u32x4){vv[4 * i], vv[4 * i + 1], vv[4 * i + 2], vv[4 * i + 3]};
        }
    }
}

template <int DK, int MODE>
__device__ __forceinline__ void chain_unit(const LAS unsigned char* sb, f32x4 (&S)[DK / 16], GAS float* op, int wave, int n, int q) {
    constexpr bool IS_GLA = (DK == 192);
    constexpr int NKS = DK / 32, NMB = DK / 16, ROWB = IS_GLA ? 384 : 256;
    constexpr int OQ = 0, OK = IS_GLA ? GL_OK : HG_OK, OKT = IS_GLA ? GL_OKT : HG_OKT, OVT = IS_GLA ? GL_OVT : HG_OVT, ODL = IS_GLA ? GL_ODL : HG_ODL;
    constexpr int UG = 4, NUG = NMB / UG;
#define CU_FENCE() asm volatile("" ::: "memory")
    bf16x8 ktf[2][UG]; f32x4 dlv[2][UG];
#define CU_LDU(g_, sl_) do { _Pragma("unroll") for (int u_ = 0; u_ < UG; ++u_) { const int mb_ = (g_) * UG + u_; \
        dlv[sl_][u_] = *(const LAS f32x4*)(sb + ODL + (16 * mb_ + 4 * q) * 4); ktf[sl_][u_] = __builtin_bit_cast(bf16x8, *(const LAS u32x4*)(sb + OKT + (16 * mb_ + n) * 64 + 16 * qs)); } } while (0)
#define CU_SBF(ks_) __builtin_bit_cast(bf16x8, (u32x4){cvt_pk_bf16(S[2 * (ks_)][0], S[2 * (ks_)][1]), cvt_pk_bf16(S[2 * (ks_)][2], S[2 * (ks_)][3]), cvt_pk_bf16(S[2 * (ks_) + 1][0], S[2 * (ks_) + 1][1]), cvt_pk_bf16(S[2 * (ks_) + 1][2], S[2 * (ks_) + 1][3])})
    const int qs = q ^ slot_swz(n);
    const bf16x8 vf8 = __builtin_bit_cast(bf16x8, *(const LAS u32x4*)(sb + OVT + (16 * wave + n) * 64 + 16 * qs));
    if (MODE == 1) {
        const f32x4 zero = (f32x4){0.f, 0.f, 0.f, 0.f};
        bf16x8 qf0[NKS], kf0[NKS], qf1[NKS], kf1[NKS];
#pragma unroll
        for (int ks = 0; ks < NKS; ++ks) { const int c0 = 64 * ks + 16 * q, o0 = n * ROWB + (c0 ^ ((IS_GLA ? ((n >> 1) & 7) : n) << 4));
            qf0[ks] = __builtin_bit_cast(bf16x8, *(const LAS u32x4*)(sb + OQ + o0)); kf0[ks] = __builtin_bit_cast(bf16x8, *(const LAS u32x4*)(sb + OK + o0)); }
        if (!IS_GLA) {
#pragma unroll
            for (int ks = 0; ks < NKS; ++ks) { const int c0 = 64 * ks + 16 * q, o1 = (16 + n) * ROWB + (c0 ^ (n << 4));
                qf1[ks] = __builtin_bit_cast(bf16x8, *(const LAS u32x4*)(sb + OQ + o1)); kf1[ks] = __builtin_bit_cast(bf16x8, *(const LAS u32x4*)(sb + OK + o1)); }
        }
        CU_FENCE();
        {
            f32x4 ao = zero, ao1 = zero, ap = zero, ap1 = zero;
#pragma unroll
            for (int ks = 0; ks < NKS; ++ks) { const bf16x8 sbf = CU_SBF(ks);
                if (ks & 1) { ao1 = __builtin_amdgcn_mfma_f32_16x16x32_bf16(qf0[ks], sbf, ao1, 0, 0, 0); ap1 = __builtin_amdgcn_mfma_f32_16x16x32_bf16(kf0[ks], qf0[ks], ap1, 0, 0, 0); }
                else { ao = __builtin_amdgcn_mfma_f32_16x16x32_bf16(qf0[ks], sbf, ao, 0, 0, 0); ap = __builtin_amdgcn_mfma_f32_16x16x32_bf16(kf0[ks], qf0[ks], ap, 0, 0, 0); } }
            if (IS_GLA) {
#pragma unroll
                for (int ks = 0; ks < NKS; ++ks) { const int c0 = 64 * ks + 16 * q, o1 = (16 + n) * ROWB + (c0 ^ (((n >> 1) & 7) << 4));
                    qf1[ks] = __builtin_bit_cast(bf16x8, *(const LAS u32x4*)(sb + OQ + o1)); kf1[ks] = __builtin_bit_cast(bf16x8, *(const LAS u32x4*)(sb + OK + o1)); }
                CU_FENCE();
            }
            ao = ao + ao1; ap = ap + ap1;
#pragma unroll
            for (int r = 0; r < 4; ++r) if (4 * q + r > n) ap[r] = 0.f;
            const bf16x8 pa = __builtin_bit_cast(bf16x8, (u32x4){cvt_pk_bf16(ap[0], ap[1]), cvt_pk_bf16(ap[2], ap[3]), 0u, 0u});
            ao = __builtin_amdgcn_mfma_f32_16x16x32_bf16(pa, vf8, ao, 0, 0, 0);
#pragma unroll
            for (int r = 0; r < 4; ++r) op[(size_t)(4 * q + r) * OW] = ao[r];
        }
        CU_LDU(0, 0);
        CU_FENCE();
        {
            f32x4 ao = zero, ao1 = zero, ap = zero, ap1 = zero, ax = zero, ax1 = zero;
#pragma unroll
            for (int ks = 0; ks < NKS; ++ks) { const bf16x8 sbf = CU_SBF(ks);
                if (ks & 1) { ao1 = __builtin_amdgcn_mfma_f32_16x16x32_bf16(qf1[ks], sbf, ao1, 0, 0, 0); ax1 = __builtin_amdgcn_mfma_f32_16x16x32_bf16(kf0[ks], qf1[ks], ax1, 0, 0, 0); ap1 = __builtin_amdgcn_mfma_f32_16x16x32_bf16(kf1[ks], qf1[ks], ap1, 0, 0, 0); }
                else { ao = __builtin_amdgcn_mfma_f32_16x16x32_bf16(qf1[ks], sbf, ao, 0, 0, 0); ax = __builtin_amdgcn_mfma_f32_16x16x32_bf16(kf0[ks], qf1[ks], ax, 0, 0, 0); ap = __builtin_amdgcn_mfma_f32_16x16x32_bf16(kf1[ks], qf1[ks], ap, 0, 0, 0); } }
            if (NUG > 1) { CU_LDU(1, 1); CU_FENCE(); }
            ao = ao + ao1; ap = ap + ap1; ax = ax + ax1;
#pragma unroll
            for (int r = 0; r < 4; ++r) if (4 * q + r > n) ap[r] = 0.f;
            const bf16x8 pa = __builtin_bit_cast(bf16x8, (u32x4){cvt_pk_bf16(ax[0], ax[1]), cvt_pk_bf16(ax[2], ax[3]), cvt_pk_bf16(ap[0], ap[1]), cvt_pk_bf16(ap[2], ap[3])});
            ao = __builtin_amdgcn_mfma_f32_16x16x32_bf16(pa, vf8, ao, 0, 0, 0);
#pragma unroll
            for (int r = 0; r < 4; ++r) op[(size_t)(16 + 4 * q + r) * OW] = ao[r];
        }
    } else {
        CU_LDU(0, 0);
        if (NUG > 1) CU_LDU(1, 1);
        CU_FENCE();
    }
#pragma unroll
    for (int g = 0; g < NUG; ++g) {
#pragma unroll
        for (int u = 0; u < UG; ++u) { const int mb = g * UG + u; S[mb] = __builtin_amdgcn_mfma_f32_16x16x32_bf16(ktf[g & 1][u], vf8, S[mb] * dlv[g & 1][u], 0, 0, 0); }
        if (g + 2 < NUG) { CU_LDU(g + 2, g & 1); CU_FENCE(); }
    }
#undef CU_FENCE
#undef CU_LDU
#undef CU_SBF
}
constexpr size_t ST_REC = 98304;
constexpr int NSEG_HG = 4, NSEG_GL = 6, NSEG_MAX = 6;
__device__ __forceinline__ int seg_u0(bool gla, int s) { return gla ? (s <= 2 ? 44 * s : 88 + 42 * (s - 2)) : 64 * s; }
__device__ __forceinline__ int seg_nu(bool gla, int s) { return gla ? (s < 2 ? 44 : 42) : 64; }
template <int DK, int MODE>
__device__ __forceinline__ void chain_item(const GAS unsigned char* blk0, int vt_off, GAS float* op0, GAS unsigned char* st, int seg, int nunits, LAS unsigned char* lds, int wave, int lane) {
    asm volatile("" : "+v"(lane), "+s"(wave));
    constexpr bool IS_GLA = (DK == 192);
    constexpr int BLK = IS_GLA ? GL_BLK : HG_BLK, UNITB = IS_GLA ? GL_SHARED + 8192 : HG_BLK, NMB = DK / 16;
    constexpr int SH0 = MODE == 1 ? 0 : (IS_GLA ? GL_OKT : HG_OKT);
    constexpr int SH_PIECES = (MODE == 1 ? (IS_GLA ? GL_SHARED : HG_BLK) : (IS_GLA ? GL_ODL + 768 - GL_OKT : HG_BLK - HG_OKT)) / 16;
    constexpr int T_PIECES = IS_GLA ? 512 : 0, T_LDS = GL_OVT;
    constexpr int PIECES = SH_PIECES + T_PIECES, NP = (PIECES + 511) / 512;
    constexpr int ODL_ = IS_GLA ? GL_ODL : HG_ODL;
    const int tid = wave * 64 + lane, n = lane & 15, q = lane >> 4;
    f32x4 S[NMB]; float dacc = 1.0f;
#pragma unroll
    for (int mb = 0; mb < NMB; ++mb) S[mb] = (f32x4){0.f, 0.f, 0.f, 0.f};
    if (MODE == 1) {
        for (int s = 0; s < seg; ++s) { const GAS unsigned char* rec = st + (size_t)s * 2 * ST_REC + (size_t)(wave * 64 + lane) * 16;
            f32x4 hh[NMB], dd[NMB];
#pragma unroll
            for (int mb = 0; mb < NMB; ++mb) { hh[mb] = *(const GAS f32x4*)(rec + (size_t)mb * 8192); dd[mb] = *(const GAS f32x4*)(st + (size_t)s * 2 * ST_REC + ST_REC + (16 * mb + 4 * q) * 4); }
            asm volatile("" ::: "memory");
#pragma unroll
            for (int mb = 0; mb < NMB; ++mb) S[mb] = S[mb] * dd[mb] + hh[mb]; }
    }
    u32x4 stgA[NP], stgB[NP];
#define CH_SRC(u, p_) (blk0 + (size_t)(u) * BLK + ((p_) < SH_PIECES ? SH0 + (p_) * 16 : vt_off + ((p_) - SH_PIECES) * 16))
#define CH_DST(p_) ((p_) < SH_PIECES ? SH0 + (p_) * 16 : T_LDS + ((p_) - SH_PIECES) * 16)
#define CH_LOAD(stg, u) do { _Pragma("unroll") for (int r_ = 0; r_ < NP; ++r_) { const int p_ = r_ * 512 + tid; const bool ok_ = (NP * 512 == PIECES) || p_ < PIECES; const int pc_ = ok_ ? p_ : 0; stg[r_] = *(const GAS u32x4*)CH_SRC(u, pc_); } } while (0)
#define CH_STORE(stg, buf) do { _Pragma("unroll") for (int r_ = 0; r_ < NP; ++r_) { const int p_ = r_ * 512 + tid; const bool ok_ = (NP * 512 == PIECES) || p_ < PIECES; const int pc_ = ok_ ? p_ : 0; \
        const int d_ = ok_ ? (buf) * UNITB + CH_DST(pc_) : 2 * UNITB + (p_ - PIECES) * 16; *(LAS u32x4*)(lds + d_) = stg[r_]; } } while (0)
#define CH_SYNC() do { asm volatile("s_waitcnt lgkmcnt(0)" ::: "memory"); __builtin_amdgcn_s_barrier(); asm volatile("" ::: "memory"); } while (0)
    CH_LOAD(stgA, 0); CH_STORE(stgA, 0);
    CH_LOAD(stgA, 1);
    CH_SYNC();
    GAS float* op = op0 + 16 * wave + n;
    for (int u = 0; u < nunits; u += 2) {
        if (u + 2 < nunits) CH_LOAD(stgB, u + 2);
        chain_unit<DK, MODE>(lds, S, op + (size_t)(u * 32) * OW, wave, n, q);
        if (MODE == 0 && tid < DK) dacc *= *(const LAS float*)(lds + ODL_ + 4 * tid);
        CH_STORE(stgA, 1);
        CH_SYNC();
        if (u + 3 < nunits) CH_LOAD(stgA, u + 3);
        chain_unit<DK, MODE>(lds + UNITB, S, op + (size_t)(u * 32 + 32) * OW, wave, n, q);
        if (MODE == 0 && tid < DK) dacc *= *(const LAS float*)(lds + UNITB + ODL_ + 4 * tid);
        if (u + 2 < nunits) CH_STORE(stgB, 0);
        CH_SYNC();
    }
    if (MODE == 0) { GAS unsigned char* rec = st + (size_t)seg * 2 * ST_REC + (size_t)(wave * 64 + lane) * 16;
#pragma unroll
        for (int mb = 0; mb < NMB; ++mb) *(GAS f32x4*)(rec + (size_t)mb * 8192) = S[mb];
        if (tid < DK) *(GAS float*)(st + (size_t)seg * 2 * ST_REC + ST_REC + 4 * tid) = dacc; }
#undef CH_SRC
#undef CH_DST
#undef CH_LOAD
#undef CH_STORE
#undef CH_SYNC
}

template <int MODE>
__device__ __forceinline__ void phase_chain(const Ctx& a, int l, LAS unsigned char* lds, int wave, int lane) {
    const int bx = blockIdx.x, G = gridDim.x;
    constexpr int nhg = 24 * (MODE == 0 ? NSEG_HG - 1 : NSEG_HG), nitems = nhg + 24 * (MODE == 0 ? NSEG_GL - 1 : NSEG_GL);
    for (int it = bx; it < nitems; it += G) {
        const bool gla = it >= nhg; const int j = gla ? it - nhg : it;
        int c = j % 24, seg = j / 24;
        if (gla) { const int x = j & 7, i = j >> 3, sl = i % 3, trip = x + 8 * (i / 3); seg = trip >> 3; c = ((trip >> 2) & 1) * 12 + (trip & 3) * 3 + sl; }
        const int u0 = seg_u0(gla, seg), nu = seg_nu(gla, seg);
        GAS unsigned char* st = a.ws() + WS_ST + (size_t)(gla ? 24 + c : c) * (NSEG_MAX - 1) * 2 * ST_REC;
        if (!gla) { const int b = c / 12, h = c % 12;
            chain_item<128, MODE>(a.ws() + WS_HGB + ((size_t)(b * 12 + h) * NUNIT + u0) * HG_BLK, 0, (GAS float*)(a.ws() + WS_O) + ((size_t)b * SEQ + u0 * 32) * OW + h * 128, st, seg, nu, lds, wave, lane); }
        else { const int b = c / 12, h = (c % 12) / 3, sl = c % 3;
            chain_item<192, MODE>(a.ws() + WS_GLB + ((size_t)(b * 4 + h) * NUNIT + u0) * GL_BLK, GL_OVT + 8192 * sl, (GAS float*)(a.ws() + WS_O) + ((size_t)b * SEQ + u0 * 32) * OW + HGW + h * 384 + sl * 128, st, seg, nu, lds, wave, lane); }
        __syncthreads();
    }
    if (MODE == 0) { for (int it = (G >= nitems + 16) ? bx - nitems : bx; it < 16; it += G) { if (it < 0) continue; s5_scan_item(a, l, it, wave, lane); } }
}
__device__ __forceinline__ float red16(float v) {
    v += __int_as_float(__builtin_amdgcn_mov_dpp(__float_as_int(v), 0xB1, 0xF, 0xF, true)); v += __int_as_float(__builtin_amdgcn_mov_dpp(__float_as_int(v), 0x4E, 0xF, 0xF, true));
    v += __int_as_float(__builtin_amdgcn_mov_dpp(__float_as_int(v), 0x141, 0xF, 0xF, true)); v += __int_as_float(__builtin_amdgcn_mov_dpp(__float_as_int(v), 0x140, 0xF, 0xF, true)); return v; }
__device__ __forceinline__ void phase_finalize(const Ctx& a, int l, int wave, int lane) {
    const GAS bf16_t* P = (const GAS bf16_t*)(a.ws() + WS_P); const GAS float* O = (const GAS float*)(a.ws() + WS_O); GAS bf16_t* MX = (GAS bf16_t*)(a.ws() + WS_MIXED);
    const GAS float* hgg = a.in(I_HGG) + l * HGW; const GAS float* hgb = a.in(I_HGB) + l * HGW; const GAS float* glg = a.in(I_GLG) + l * HGW;
    const int gw = blockIdx.x * 8 + wave, NGW = gridDim.x * 8;
    const bool act = lane < 48;
    f32x4 pg[3][2], pb[3][2], qg[4][2];
#pragma unroll
    for (int it = 0; it < 3; ++it) { const int c = (it * 4 + (lane >> 4)) * 128 + (lane & 15) * 8;
        pg[it][0] = *(const GAS f32x4*)(hgg + c); pg[it][1] = *(const GAS f32x4*)(hgg + c + 4); pb[it][0] = *(const GAS f32x4*)(hgb + c); pb[it][1] = *(const GAS f32x4*)(hgb + c + 4); }
#pragma unroll
    for (int h = 0; h < 4; ++h) { const int c = h * 384 + (act ? lane : 0) * 8; qg[h][0] = *(const GAS f32x4*)(glg + c); qg[h][1] = *(const GAS f32x4*)(glg + c + 4); }
    for (int row = gw; row < MTOK; row += NGW) {
        const GAS float* orow = O + (size_t)row * OW; const GAS bf16_t* prow = P + (size_t)row * INP; GAS bf16_t* mrow = MX + (size_t)row * DM;
        f32x4 o0[7], o1[7]; u32x4 gq[7];
#pragma unroll
        for (int it = 0; it < 3; ++it) { const int c = (it * 4 + (lane >> 4)) * 128 + (lane & 15) * 8;
            o0[it] = *(const GAS f32x4*)(orow + c); o1[it] = *(const GAS f32x4*)(orow + c + 4); gq[it] = *(const GAS u32x4*)(prow + C_GB + c); }
#pragma unroll
        for (int h = 0; h < 4; ++h) { const int c = h * 384 + (act ? lane : 0) * 8;
            o0[3 + h] = *(const GAS f32x4*)(orow + HGW + c); o1[3 + h] = *(const GAS f32x4*)(orow + HGW + c + 4); gq[3 + h] = *(const GAS u32x4*)(prow + C_GC + c); }
        asm volatile("" ::: "memory");
#pragma unroll
        for (int it = 0; it < 3; ++it) { const int c = (it * 4 + (lane >> 4)) * 128 + (lane & 15) * 8; const u32x4 gg = gq[it];
            float v[8] = {sigmoidf_(bf_lo(gg.x)) * o0[it][0], sigmoidf_(bf_hi(gg.x)) * o0[it][1], sigmoidf_(bf_lo(gg.y)) * o0[it][2], sigmoidf_(bf_hi(gg.y)) * o0[it][3],
                          sigmoidf_(bf_lo(gg.z)) * o1[it][0], sigmoidf_(bf_hi(gg.z)) * o1[it][1], sigmoidf_(bf_lo(gg.w)) * o1[it][2], sigmoidf_(bf_hi(gg.w)) * o1[it][3]};
            float s = 0.f, ss = 0.f;
#pragma unroll
            for (int i = 0; i < 8; ++i) { s += v[i]; ss += v[i] * v[i]; }
            s = red16(s); ss = red16(ss);
            const float mu = s * (1.0f / 128.0f), rs = 1.0f / sqrtf(fmaxf(ss * (1.0f / 128.0f) - mu * mu, 0.f) + LN_EPS);
            const f32x4 g0 = pg[it][0], g1 = pg[it][1], b0 = pb[it][0], b1 = pb[it][1];
            u32x4 w; w.x = cvt_pk_bf16((v[0] - mu) * rs * g0[0] + b0[0], (v[1] - mu) * rs * g0[1] + b0[1]); w.y = cvt_pk_bf16((v[2] - mu) * rs * g0[2] + b0[2], (v[3] - mu) * rs * g0[3] + b0[3]);
            w.z = cvt_pk_bf16((v[4] - mu) * rs * g1[0] + b1[0], (v[5] - mu) * rs * g1[1] + b1[1]); w.w = cvt_pk_bf16((v[6] - mu) * rs * g1[2] + b1[2], (v[7] - mu) * rs * g1[3] + b1[3]);
            *(GAS u32x4*)(mrow + S5W + c) = w; }
#pragma unroll
        for (int h = 0; h < 4; ++h) { const int c = h * 384 + lane * 8;
            f32x4 p0 = o0[3 + h], p1 = o1[3 + h]; const u32x4 gg = gq[3 + h];
            if (!act) { p0 = (f32x4){0.f, 0.f, 0.f, 0.f}; p1 = p0; }
            const float ss = wave_sum((p0[0] * p0[0] + p0[1] * p0[1]) + (p0[2] * p0[2] + p0[3] * p0[3]) + (p1[0] * p1[0] + p1[1] * p1[1]) + (p1[2] * p1[2] + p1[3] * p1[3]));
            const float rms = 1.0f / sqrtf(ss * (1.0f / 384.0f) + LN_EPS);
            if (act) { const f32x4 g0 = qg[h][0], g1 = qg[h][1];
                const float z[8] = {bf_lo(gg.x), bf_hi(gg.x), bf_lo(gg.y), bf_hi(gg.y), bf_lo(gg.z), bf_hi(gg.z), bf_lo(gg.w), bf_hi(gg.w)};
                u32x4 w; w.x = cvt_pk_bf16(p0[0] * rms * g0[0] * (z[0] * sigmoidf_(z[0])), p0[1] * rms * g0[1] * (z[1] * sigmoidf_(z[1])));
                w.y = cvt_pk_bf16(p0[2] * rms * g0[2] * (z[2] * sigmoidf_(z[2])), p0[3] * rms * g0[3] * (z[3] * sigmoidf_(z[3])));
                w.z = cvt_pk_bf16(p1[0] * rms * g1[0] * (z[4] * sigmoidf_(z[4])), p1[1] * rms * g1[1] * (z[5] * sigmoidf_(z[5])));
                w.w = cvt_pk_bf16(p1[2] * rms * g1[2] * (z[6] * sigmoidf_(z[6])), p1[3] * rms * g1[3] * (z[7] * sigmoidf_(z[7])));
                *(GAS u32x4*)(mrow + S5W + HGW + c) = w; } }
    }
}

constexpr int PH_PRO = 0, PH_MOD = 1, PH_LN0 = 2, PH_L0 = 3, PH_PER_LAYER = 10, N_PHASES = PH_L0 + DEPTH * PH_PER_LAYER;
constexpr int CW_BAR = 4096;

__global__ void __launch_bounds__(512, 2) hybrid_fwd(Args args) {
    extern __shared__ __attribute__((aligned(16))) unsigned char lds_raw[];
    LAS unsigned char* lds = (LAS unsigned char*)lds_raw;
    const int wave = __builtin_amdgcn_readfirstlane((int)threadIdx.x >> 6);
#define lane lane_id_v()
    volatile LAS unsigned* MISC = (volatile LAS unsigned*)(lds + LDSCTL_OFF);
    Ctx ctx; ctx.t = (volatile LAS unsigned long long*)(lds + LDSCTL_OFF + 64);
    if (wave == 0) { const int ln_ = lane; unsigned long long v = 0ull;
#pragma unroll
        for (int i = 0; i < N_IN; ++i) v = (ln_ == i) ? (unsigned long long)args.in[i] : v;
        v = (ln_ == 30) ? (unsigned long long)args.out : v; v = (ln_ == 31) ? (unsigned long long)args.ws : v;
        if (ln_ < 32) ctx.t[ln_] = v;
        if (ln_ < 16) MISC[ln_] = 0u; }
    __syncthreads();
    const int lo = args.ph_lo, hi = args.ph_hi;
    XcdBarrier bar; bar.bar = (unsigned*)(ctx.ws() + WS_CTL) + CW_BAR; bar.x = 0; bar.st = nullptr; bar.w0 = (wave == 0) ? 1u : 0u;
    if (hi - lo > 1) bar = xcd_barrier_post((unsigned*)(ctx.ws() + WS_CTL) + CW_BAR, MISC + 8, (wave == 0) ? 1u : 0u);
#define IN(k) (lo <= (k) && (k) < hi)
#define OPQ() int ln = lane, wv = wave; asm volatile("" : "+s"(wv))
#define SEAM(k) do { if (IN(k) && IN((k) + 1)) xcd_barrier(bar); } while (0)
#define WSP(T, off) ((GAS T*)(ctx.ws() + (off)))
#define WSG(T, off) ((T*)(ctx.ws() + (off)))

    if (IN(PH_PRO)) { OPQ(); phase_prologue(ctx, lds, wv, ln); }
    SEAM(PH_PRO);
    if (IN(PH_MOD)) { OPQ(); phase_mod(ctx, wv, ln); }
    SEAM(PH_MOD);
    if (IN(PH_LN0)) { OPQ(); phase_h0(ctx.in(I_X), WSP(float, WS_MOD), WSP(bf16_t, WS_H), wv, ln); }
    SEAM(PH_LN0);

    for (int l = 0; l < DEPTH; ++l) {
        const int p0 = PH_L0 + l * PH_PER_LAYER;
        const size_t wto = WS_WT + (size_t)l * WT_LAYER, modo = WS_MOD + (size_t)l * NB * 6 * DM * 4;
        if (IN(p0 + 0)) { pg8::Gemm g{WSG(bf16_t, WS_H), WSG(const bf16_t, wto + WT_IN), MTOK, INP, DM}; pg8::StaticOrder S; S.init(MTOK, INP, (int)gridDim.x, (int)blockIdx.x);
            EpiProj E{WSP(bf16_t, WS_P), WSP(bf16_t, WS_UX)}; pg8::gemm_phase<EpiProj, pg8::StaticOrder, true, true>(lds, g, S, E, wave); }
        SEAM(p0 + 0);
        if (IN(p0 + 1)) {
            { pg8::Gemm g{WSG(bf16_t, WS_UX), WSG(const bf16_t, WS_S5W1 + (size_t)l * S5_W1_LAYER), 64 * 256, 64 * 256, S5K}; S5Order S{(int)gridDim.x, (int)blockIdx.x, 64, 0};
              EpiS5A E{WSP(float, WS_SLOC)}; pg8::gemm_phase<EpiS5A, S5Order, true, true>(lds, g, S, E, wave); }
            { OPQ(); phase_pre(ctx, l, lds, wv, ln); }
            }
        SEAM(p0 + 1);
        if (IN(p0 + 2)) { OPQ(); phase_chain<0>(ctx, l, lds, wv, ln); }
        SEAM(p0 + 2);
        if (IN(p0 + 3)) {
            { pg8::Gemm g{WSG(bf16_t, WS_UX), WSG(const bf16_t, WS_S5T + (size_t)l * S5_T_LAYER), 64 * 256, 64 * 1024, S5K}; S5Order S{(int)gridDim.x, (int)blockIdx.x, 256, 2};
              EpiS5C E{WSP(bf16_t, WS_Z)}; pg8::gemm_phase<EpiS5C, S5Order, true, true>(lds, g, S, E, wave);
            }
            { OPQ(); phase_chain<1>(ctx, l, lds, wv, ln); }
            }
        SEAM(p0 + 3);
        if (IN(p0 + 4)) { pg8::Gemm g{WSG(bf16_t, WS_Z), WSG(const bf16_t, wto + WT_GLU), MTOK, S5W, S5W}; pg8::StaticOrder S; S.init(MTOK, S5W, (int)gridDim.x, (int)blockIdx.x);
            EpiGlu E{WSP(bf16_t, WS_Z), WSP(bf16_t, WS_MIXED), ctx.in(I_GLUB) + l * S5W}; pg8::gemm_phase<EpiGlu, pg8::StaticOrder, true, true>(lds, g, S, E, wave);
            { OPQ(); phase_finalize(ctx, l, wv, ln); } }
        SEAM(p0 + 4);
        if (IN(p0 + 5)) { pg8::Gemm g{WSG(bf16_t, WS_MIXED), WSG(const bf16_t, wto + WT_OUT), MTOK, DM, DM}; pg8::StaticOrder S; S.init(MTOK, DM, (int)gridDim.x, (int)blockIdx.x);
            EpiDelta E{WSP(bf16_t, WS_DELTA), WSP(float, modo) + 2 * DM};
            pg8::gemm_phase<EpiDelta, pg8::StaticOrder, true, true>(lds, g, S, E, wave); }
        SEAM(p0 + 5);
        if (IN(p0 + 6)) { OPQ(); const XRes xa{(GAS unsigned*)ctx.out(), WSP(unsigned, WS_XL)}, xb{l + 1 < DEPTH ? (GAS unsigned*)ctx.out() : WSP(unsigned, WS_WT), WSP(unsigned, WS_XL)};
            if (l == 0) phase_lnres<true, true, false>(ctx.in(I_X), xa, WSP(bf16_t, WS_DELTA), nullptr, xb, ctx.in(I_LN1G) + l * DM, ctx.in(I_LN1B) + l * DM, WSP(float, modo), 3, 4, WSP(bf16_t, WS_H), lds, wv, ln);
            else phase_lnres<true, false, false>(nullptr, xa, WSP(bf16_t, WS_DELTA), nullptr, xb, ctx.in(I_LN1G) + l * DM, ctx.in(I_LN1B) + l * DM, WSP(float, modo), 3, 4, WSP(bf16_t, WS_H), lds, wv, ln); }
        SEAM(p0 + 6);
        if (IN(p0 + 7)) { pg8::Gemm g{WSG(bf16_t, WS_H), WSG(const bf16_t, wto + WT_GU), MTOK, 2 * DFF, DM}; pg8::StaticOrder S; S.init(MTOK, 2 * DFF, (int)gridDim.x, (int)blockIdx.x);
            EpiSwiglu E{WSP(bf16_t, WS_P)}; pg8::gemm_phase<EpiSwiglu, pg8::StaticOrder, true, true>(lds, g, S, E, wave); }
        SEAM(p0 + 7);
        if (IN(p0 + 8)) { pg8::Gemm g{WSG(bf16_t, WS_P), WSG(const bf16_t, wto + WT_DN), MTOK, DM, DFF}; pg8::StaticOrderT<2> S; S.init(MTOK, DM, (int)gridDim.x, (int)blockIdx.x);
            EpiDelta E{WSP(bf16_t, WS_DELTA), WSP(float, modo) + 5 * DM};
            pg8::gemm_phase<EpiDelta, pg8::StaticOrderT<2>, true, true>(lds, g, S, E, wave); }
        SEAM(p0 + 8);
        if (IN(p0 + 9)) { OPQ();
            const XRes xb{l + 1 < DEPTH ? (GAS unsigned*)ctx.out() : WSP(unsigned, WS_WT), WSP(unsigned, WS_XL)};
            if (l + 1 < DEPTH) phase_lnres<true, false, false>(nullptr, xb, WSP(bf16_t, WS_DELTA), nullptr, xb, ctx.in(I_LN2G) + l * DM, ctx.in(I_LN2B) + l * DM, WSP(float, modo) + (size_t)NB * 6 * DM, 0, 1, WSP(bf16_t, WS_H), lds, wv, ln);
            else phase_lnres<false, false, true>(nullptr, xb, WSP(bf16_t, WS_DELTA), ctx.out(), xb, ctx.in(I_LN2G) + l * DM, ctx.in(I_LN2B) + l * DM, nullptr, 0, 0, nullptr, lds, wv, ln);
        }
        SEAM(p0 + 9);
    }
#undef IN
#undef SEAM
#undef OPQ
#undef WSP
#undef WSG
#undef lane
}

extern "C" void kernel_launch(void* const* d_in, const int* in_sizes, int n_in, void* d_out, int out_size, void* d_ws, size_t ws_size, hipStream_t stream) {
    static int grid = 0;
    if (grid == 0) {
        if (n_in != N_IN || out_size != MTOK * DM || ws_size < WS_END) { fprintf(stderr, "kernel_launch: unexpected problem (n_in %d, out %d, ws %zu < %zu); nothing launched\n", n_in, out_size, ws_size, (size_t)WS_END); grid = -1; return; }
        int dev = 0, cus = 0, per_cu = 0;
        if (hipGetDevice(&dev) != hipSuccess || hipDeviceGetAttribute(&cus, hipDeviceAttributeMultiprocessorCount, dev) != hipSuccess) { grid = -1; return; }
        if (hipFuncSetAttribute((const void*)hybrid_fwd, hipFuncAttributeMaxDynamicSharedMemorySize, LDS_BYTES) != hipSuccess) { fprintf(stderr, "kernel_launch: hipFuncSetAttribute failed\n"); grid = -1; return; }
        if (hipOccupancyMaxActiveBlocksPerMultiprocessor(&per_cu, (const void*)hybrid_fwd, 512, LDS_BYTES) != hipSuccess || per_cu < 1) fprintf(stderr, "kernel_launch: occupancy query reports %d blocks per CU\n", per_cu);
        (void)hipGetLastError();
        grid = cus;
    }
    if (grid < 0) return;
    (void)in_sizes;
    if (hipMemsetAsync((char*)d_ws + WS_CTL, 0, CTL_ZERO_BYTES, stream) != hipSuccess) return;
    Args a{};
    for (int i = 0; i < N_IN; ++i) a.in[i] = (const float*)d_in[i];
    a.out = (float*)d_out; a.ws = (unsigned char*)d_ws;
    a.ph_lo = 0; a.ph_hi = N_PHASES; hipLaunchKernelGGL(hybrid_fwd, dim3(grid), dim3(512), LDS_BYTES, stream, a);
}
```

```cpp
#include <hip/hip_runtime.h>
#include <cstdio>
#include <cstdint>
namespace pg8 {
#define PG8_LAS __attribute__((address_space(3)))
typedef unsigned short bf16_t;
typedef short bf16x8 __attribute__((ext_vector_type(8)));
typedef float f32x4 __attribute__((ext_vector_type(4)));
typedef unsigned u32x4 __attribute__((ext_vector_type(4)));
constexpr int BM = 256, BK = 64, HALF = 128, HTB = HALF * BK * 2  , STAGE_BYTES = 8 * HTB, NXCD = 8, WGM = 8;

__host__ __device__ __forceinline__ int lds_byte(int r, int c) { const int st = (r >> 4) * 2 + (c >> 5), rr = r & 15, cc = c & 31, ob = rr * 64 + cc * 2; return st * 1024 + (ob ^ (((ob >> 9) & 1) << 5)); }
__host__ __device__ __forceinline__ void stage_rc(int b, int& R, int& C) { const int st = b / 1024, sb = b % 1024, swz = sb ^ (((sb >> 9) & 1) << 5); R = (st >> 1) * 16 + swz / 64; C = (st & 1) * 32 + (swz % 64) / 2; }
__host__ __device__ __forceinline__ int perm32(int rho) { const int n = rho >> 4, i = rho & 15; return 8 * (i >> 2) + 4 * n + (i & 3); }

struct Unit { int pm, pn; };
struct Gemm { const bf16_t* A; const bf16_t* Bt; int M, N, K; };

template <int WGM_>
struct StaticOrderT {
    static constexpr int WGM = WGM_;
    int nM, nN, nwg, G, c;
    __host__ __device__ void init(int M, int N, int G_, int c_) { nM = M / BM; nN = N / BM; nwg = nM * nN; G = G_; c = c_; }
    __host__ __device__ bool next(int i, Unit& u) const {
        const long L = (long)i * G + c; if (L >= nwg) return false;
        int wgid = (int)L; { const int q = nwg / NXCD, r = nwg % NXCD, xcd = wgid % NXCD, off = wgid / NXCD; wgid = (xcd < r ? xcd * (q + 1) : r * (q + 1) + (xcd - r) * q) + off; }
        const int nig = WGM * nN, gid = wgid / nig, fm = gid * WGM, gsz = (nM - fm) < WGM ? (nM - fm) : WGM;
        u.pm = fm + ((wgid % nig) % gsz); u.pn = (wgid % nig) / gsz; return true;
    }
    __device__ __forceinline__ void a_ready(const Unit&) const {}
    __device__ __forceinline__ void done(const Unit&) const {}
};
typedef StaticOrderT<8> StaticOrder;
__device__ __forceinline__ unsigned cvt_pk_bf16(float lo, float hi) { unsigned r; asm volatile("v_cvt_pk_bf16_f32 %0, %1, %2" : "=v"(r) : "v"(lo), "v"(hi)); return r; }
typedef float f32x2 __attribute__((ext_vector_type(2)));
template <class Epi, class Sched, bool ALIGN_EPI = false, bool SP2 = false>
__device__ __forceinline__ void gemm_phase(PG8_LAS unsigned char* lds, const Gemm g, const Sched& S, const Epi& E, int wave_id) {
    int tid_; asm volatile("v_mbcnt_lo_u32_b32 %0, -1, 0\n\tv_mbcnt_hi_u32_b32 %0, -1, %0" : "=v"(tid_)); tid_ += wave_id * 64;
    const int tid = tid_, wid = __builtin_amdgcn_readfirstlane(tid >> 6), lane = tid & 63, wr = wid >> 2, wc = wid & 3, fr = lane & 15, fq = lane >> 4;
    const int K = g.K, nt = K / BK;
    unsigned voffA[2], voffB[2];
#pragma unroll
    for (int i = 0; i < 2; ++i) { int R, C; stage_rc(tid * 16 + i * 8192, R, C); const int Rb = Epi::PERM ? ((R & ~31) + perm32(R & 31)) : R;
        voffA[i] = (unsigned)(R * K + C) * 2u; voffB[i] = (unsigned)(Rb * K + C) * 2u; }
    const size_t kstep = (size_t)(BK * 2);
    const size_t hstep = (size_t)HALF * K * 2;
    const size_t tstep = 2 * hstep;
    const unsigned ldsw = (unsigned)wid * 1024u;
    const int aoff = lds_byte(wr * 64 + fr, fq * 8), boff = lds_byte(wc * 32 + fr, fq * 8);
#define PG8_SA(b, h) (((b) * 2 + (h)) * HTB)
#define PG8_SB(b, h) ((4 + (b) * 2 + (h)) * HTB)
#define PG8_STAGE(bufoff, gbase, voff) do { _Pragma("unroll") for (int _i = 0; _i < 2; ++_i) \
        __builtin_amdgcn_global_load_lds((const unsigned*)((const char*)(gbase) + (voff)[_i]), (PG8_LAS unsigned*)(lds + (bufoff) + ldsw + _i * 8192), 16, 0, 0); } while (0)
#define PG8_LDA(dst, b, h) do { _Pragma("unroll") for (int m = 0; m < 4; ++m) _Pragma("unroll") for (int k = 0; k < 2; ++k) dst[m][k] = *(const PG8_LAS bf16x8*)(lds + PG8_SA(b, h) + aoff + m * 2048 + k * 1024); } while (0)
#define PG8_LDB(dst, b, h) do { _Pragma("unroll") for (int n = 0; n < 2; ++n) _Pragma("unroll") for (int k = 0; k < 2; ++k) dst[n][k] = *(const PG8_LAS bf16x8*)(lds + PG8_SB(b, h) + boff + n * 2048 + k * 1024); } while (0)
#define PG8_MMA(ai, bj, At, Bt) do { __builtin_amdgcn_s_setprio(1); _Pragma("unroll") for (int m = 0; m < 4; ++m) _Pragma("unroll") for (int n = 0; n < 2; ++n) _Pragma("unroll") for (int k = 0; k < 2; ++k) \
        acc[ai][bj][m][n] = __builtin_amdgcn_mfma_f32_16x16x32_bf16(Bt[n][k], At[m][k], acc[ai][bj][m][n], 0, 0, 0); __builtin_amdgcn_s_setprio(0); } while (0)
#define PG8_WAIT_V(n) asm volatile("s_waitcnt vmcnt(" #n ")" ::: "memory")
#define PG8_WAIT_L(n) asm volatile("s_waitcnt lgkmcnt(" #n ")" ::: "memory")
#define PG8_BAR __builtin_amdgcn_s_barrier()
#define PG8_SCHED __builtin_amdgcn_sched_barrier(0)
    Unit cur, nxt; int ui = 0;
    if (!S.next(0, cur)) return;
    f32x4 acc[2][2][4][2];
#pragma unroll
    for (int a = 0; a < 2; ++a)
#pragma unroll
        for (int b = 0; b < 2; ++b)
#pragma unroll
            for (int m = 0; m < 4; ++m)
#pragma unroll
                for (int n = 0; n < 2; ++n) acc[a][b][m][n] = (f32x4){0.f, 0.f, 0.f, 0.f};
    bf16x8 At[4][2], B0[2][2], B1[2][2];
    const char* cA = (const char*)g.A + (size_t)cur.pm * tstep; const char* cB = (const char*)g.Bt + (size_t)cur.pn * tstep;
    S.a_ready(cur);
    if constexpr (SP2) {
        PG8_STAGE(PG8_SB(0, 0), cB, voffB); PG8_STAGE(PG8_SB(0, 1), cB + hstep, voffB); PG8_STAGE(PG8_SA(0, 0), cA, voffA); PG8_STAGE(PG8_SA(0, 1), cA + hstep, voffA);
        if (wr == 1) PG8_BAR;
        PG8_WAIT_V(2); PG8_BAR;
        PG8_STAGE(PG8_SB(1, 0), cB + kstep, voffB); PG8_STAGE(PG8_SA(1, 0), cA + kstep, voffA); PG8_STAGE(PG8_SB(1, 1), cB + hstep + kstep, voffB);
        PG8_WAIT_V(6); PG8_BAR;
    } else {
        PG8_STAGE(PG8_SB(0, 0), cB, voffB); PG8_STAGE(PG8_SA(0, 0), cA, voffA); PG8_STAGE(PG8_SB(0, 1), cB + hstep, voffB); PG8_STAGE(PG8_SA(0, 1), cA + hstep, voffA);
        if (wr == 1) PG8_BAR;
        PG8_WAIT_V(4); PG8_BAR;
        PG8_STAGE(PG8_SB(1, 0), cB + kstep, voffB); PG8_STAGE(PG8_SA(1, 0), cA + kstep, voffA); PG8_STAGE(PG8_SB(1, 1), cB + hstep + kstep, voffB);
        PG8_WAIT_V(6); PG8_BAR;
    }
    for (;;) {
        const bool has_next = S.next(ui + 1, nxt);
        const char* nA = has_next ? (const char*)g.A + (size_t)nxt.pm * tstep : cA; const char* nB = has_next ? (const char*)g.Bt + (size_t)nxt.pn * tstep : cB;
        for (int t = 0; t < nt; t += 2) {
            const bool last = (t == nt - 2);
            const char* a1 = cA + (size_t)(t + 1) * kstep;
            const char* a2 = last ? nA : cA + (size_t)(t + 2) * kstep; const char* b2 = last ? nB : cB + (size_t)(t + 2) * kstep;
            const char* a3 = a2 + kstep; const char* b3 = b2 + kstep;
            if (last && has_next) S.a_ready(nxt);
            if constexpr (SP2) {
            PG8_LDB(B0, 0, 0); PG8_LDB(B1, 0, 1); PG8_SCHED; PG8_LDA(At, 0, 0); PG8_STAGE(PG8_SA(1, 1), a1 + hstep, voffA);
            PG8_WAIT_V(8); PG8_WAIT_L(0); PG8_BAR; PG8_MMA(0, 0, At, B0); PG8_MMA(0, 1, At, B1); PG8_BAR; PG8_SCHED;
            PG8_LDA(At, 0, 1); PG8_STAGE(PG8_SB(0, 0), b2, voffB); PG8_STAGE(PG8_SB(0, 1), b2 + hstep, voffB); PG8_STAGE(PG8_SA(0, 0), a2, voffA);
            PG8_WAIT_V(8); PG8_WAIT_L(0); PG8_BAR; PG8_MMA(1, 0, At, B0); PG8_MMA(1, 1, At, B1); PG8_BAR; PG8_SCHED;
            PG8_LDB(B0, 1, 0); PG8_LDB(B1, 1, 1); PG8_SCHED; PG8_LDA(At, 1, 0); PG8_STAGE(PG8_SA(0, 1), a2 + hstep, voffA);
            PG8_WAIT_V(8); PG8_WAIT_L(0); PG8_BAR; PG8_MMA(0, 0, At, B0); PG8_MMA(0, 1, At, B1); PG8_BAR; PG8_SCHED;
            PG8_LDA(At, 1, 1); PG8_STAGE(PG8_SB(1, 0), b3, voffB); PG8_STAGE(PG8_SB(1, 1), b3 + hstep, voffB); PG8_STAGE(PG8_SA(1, 0), a3, voffA);
            PG8_WAIT_V(8); PG8_WAIT_L(0); PG8_BAR; PG8_MMA(1, 0, At, B0); PG8_MMA(1, 1, At, B1); PG8_BAR; PG8_SCHED;
            } else {
            PG8_LDB(B0, 0, 0); PG8_SCHED; PG8_LDA(At, 0, 0); PG8_STAGE(PG8_SA(1, 1), a1 + hstep, voffA);
            PG8_WAIT_L(8); PG8_BAR; PG8_WAIT_L(0); PG8_MMA(0, 0, At, B0); PG8_BAR; PG8_SCHED;
            PG8_LDB(B1, 0, 1); PG8_STAGE(PG8_SB(0, 0), b2, voffB);
            PG8_BAR; PG8_WAIT_L(0); PG8_MMA(0, 1, At, B1); PG8_BAR;
            PG8_LDA(At, 0, 1); PG8_STAGE(PG8_SA(0, 0), a2, voffA);
            PG8_BAR; PG8_WAIT_L(0); PG8_MMA(1, 0, At, B0); PG8_BAR; PG8_SCHED;
            PG8_STAGE(PG8_SB(0, 1), b2 + hstep, voffB);
            PG8_WAIT_V(6); PG8_BAR; PG8_MMA(1, 1, At, B1); PG8_BAR;
            PG8_LDB(B0, 1, 0); PG8_SCHED; PG8_LDA(At, 1, 0); PG8_STAGE(PG8_SA(0, 1), a2 + hstep, voffA);
            PG8_WAIT_L(8); PG8_BAR; PG8_WAIT_L(0); PG8_MMA(0, 0, At, B0); PG8_BAR; PG8_SCHED;
            PG8_LDB(B1, 1, 1); PG8_STAGE(PG8_SB(1, 0), b3, voffB);
            PG8_BAR; PG8_WAIT_L(0); PG8_MMA(0, 1, At, B1); PG8_BAR;
            PG8_LDA(At, 1, 1); PG8_STAGE(PG8_SA(1, 0), a3, voffA);
            PG8_BAR; PG8_WAIT_L(0); PG8_MMA(1, 0, At, B0); PG8_BAR; PG8_SCHED;
            PG8_STAGE(PG8_SB(1, 1), b3 + hstep, voffB);
            PG8_WAIT_V(6); PG8_BAR; PG8_MMA(1, 1, At, B1); PG8_BAR;
            }
        }
        if constexpr (ALIGN_EPI) { if (wr == 0) PG8_BAR; }
        if constexpr (!Epi::AFTER_DRAIN) { E(acc, cur, wr, wc, fr, fq); S.done(cur); }
        if (!has_next) break;
#pragma unroll
        for (int a = 0; a < 2; ++a)
#pragma unroll
            for (int b = 0; b < 2; ++b)
#pragma unroll
                for (int m = 0; m < 4; ++m)
#pragma unroll
                    for (int n = 0; n < 2; ++n) acc[a][b][m][n] = (f32x4){0.f, 0.f, 0.f, 0.f};
        cur = nxt; cA = nA; cB = nB; ++ui;
        if constexpr (ALIGN_EPI) { if (wr == 1) PG8_BAR; }
    }
    PG8_WAIT_V(0);
    if constexpr (!ALIGN_EPI) { if (wr == 0) PG8_BAR; }
    PG8_BAR;
    if constexpr (Epi::AFTER_DRAIN) { E.fused(acc, cur, wr, wc, fr, fq, lds, wid, lane); S.done(cur); }
#undef PG8_SA
#undef PG8_SB
#undef PG8_STAGE
#undef PG8_LDA
#undef PG8_LDB
#undef PG8_MMA
#undef PG8_WAIT_V
#undef PG8_WAIT_L
#undef PG8_BAR
#undef PG8_SCHED
}
}
#define LAS __attribute__((address_space(3)))
#define XB_TMO      128
#define XB_XCNT(j)  (256  + 64 * (j))
#define XB_XSUB(j)  (1280 + 64 * (j))
#define XB_XGEN(j)  (2304 + 64 * (j))
#define XB_TOP      3328
#define XB_TOPGEN   3392
#define XCD_BAR_WORDS 3456
#define XB_SPIN_CAP (1u << 24)

__device__ __forceinline__ unsigned xb_ld(unsigned* p)              { return __hip_atomic_load(p, __ATOMIC_RELAXED, __HIP_MEMORY_SCOPE_AGENT); }
__device__ __forceinline__ unsigned xb_add(unsigned* p, unsigned v) { return __hip_atomic_fetch_add(p, v, __ATOMIC_RELAXED, __HIP_MEMORY_SCOPE_AGENT); }
__device__ __forceinline__ unsigned xb_xcc_id() { return (unsigned)__builtin_amdgcn_s_getreg((3 << 11) | 20) & 0xFu; }
#define XB_SPIN(cond, bar) do { unsigned _sp = 0; while (cond) { __builtin_amdgcn_s_sleep(1); \
    if ((++_sp & 255u) == 0u) { if (xb_ld(&(bar)[XB_TMO])) break; if (_sp > XB_SPIN_CAP) { atomicAdd(&(bar)[XB_TMO], 1u); break; } } } } while (0)

struct XcdBarrier {
    unsigned* bar; unsigned x; unsigned w0;
    volatile LAS unsigned* st;
};

__device__ __forceinline__ bool xb_lane0() { unsigned r; asm volatile("v_mbcnt_lo_u32_b32 %0, -1, 0\n\tv_mbcnt_hi_u32_b32 %0, -1, %0" : "=v"(r)); return r == 0u; }
__device__ __forceinline__ XcdBarrier xcd_barrier_post(unsigned* bar, volatile LAS unsigned* st, unsigned w0) {
    XcdBarrier b; b.bar = bar; b.x = xb_xcc_id(); b.st = st; b.w0 = w0;
    if (w0 && xb_lane0()) (void)xb_add(&bar[XB_XCNT(b.x)], 1u);
    return b;
}
__device__ __forceinline__ void xcd_barrier_complete(unsigned* bar, unsigned x, unsigned& nloc, unsigned& nx) {
    const unsigned G = gridDim.x * gridDim.y * gridDim.z;
    unsigned sum, cnt, mine, sp = 0u;
    for (;;) {
        sum = 0u; cnt = 0u; mine = 0u;
#pragma unroll
        for (unsigned j = 0; j < 16; ++j) { const unsigned c = xb_ld(&bar[XB_XCNT(j)]); sum += c; cnt += (c > 0u) ? 1u : 0u; mine = (j == x) ? c : mine; }
        if (sum == G) break;
        __builtin_amdgcn_s_sleep(1);
        if ((++sp & 255u) == 0u) { if (xb_ld(&bar[XB_TMO])) break; if (sp > XB_SPIN_CAP) { atomicAdd(&bar[XB_TMO], 1u); break; } }
    }
    nloc = mine > 0u ? mine : 1u; nx = cnt > 0u ? cnt : 1u;
}

__device__ __forceinline__ void xcd_barrier(const XcdBarrier& b) {
    asm volatile("s_waitcnt vmcnt(0)" ::: "memory");
    __syncthreads();
    if (b.w0 && xb_lane0()) {
        unsigned* bar = b.bar;
        __builtin_amdgcn_s_waitcnt(0);
        unsigned nloc = b.st[0], nx = b.st[1];
        if (nloc == 0u) { xcd_barrier_complete(bar, b.x, nloc, nx); b.st[0] = nloc; b.st[1] = nx; }
        const unsigned old = xb_add(&bar[XB_XSUB(b.x)], 1u);
        const unsigned gen = old / nloc;
        if (old + 1u == (gen + 1u) * nloc) {
            __builtin_amdgcn_fence(__ATOMIC_RELEASE, "agent");
            asm volatile("s_waitcnt vmcnt(0)" ::: "memory");
            const unsigned og = xb_add(&bar[XB_TOP], 1u);
            const unsigned tg = og / nx;
            if (og + 1u == (tg + 1u) * nx) xb_add(&bar[XB_TOPGEN], 1u);
            else XB_SPIN(xb_ld(&bar[XB_TOPGEN]) == tg, bar);
            __builtin_amdgcn_fence(__ATOMIC_ACQUIRE, "agent");
            xb_add(&bar[XB_XGEN(b.x)], 1u);
            asm volatile("s_waitcnt vmcnt(0)" ::: "memory");
        } else {
            XB_SPIN(xb_ld(&bar[XB_XGEN(b.x)]) == gen, bar);
            __builtin_amdgcn_fence(__ATOMIC_ACQUIRE, "agent");
            asm volatile("s_waitcnt vmcnt(0)" ::: "memory");
        }
    }
    __syncthreads();
}

constexpr int DM = 4096, NB = 2, SEQ = 8192, MTOK = NB * SEQ, DEPTH = 4;
constexpr int S5W = 1024;
constexpr int HGW = 1536;
constexpr int GLKW = 768;
constexpr int INW = 11792, INP = 12032, DFF = 11008;
constexpr int OW = 3072;
constexpr int C_U = 0, C_QB = 1024, C_FB = 2560, C_IB = 4096, C_GB = 5632, C_QC = 7168, C_KC = 7936, C_VC = 8704, C_GC = 10240, C_LR = 11776;
constexpr float LN_EPS = 1e-5f;
constexpr float ALPHA = 1.6817928305074290861f;
constexpr float GLA_QSCALE = 0.07216878364870322f;

enum { I_X = 0, I_C, I_WADA, I_BADA, I_TABLE, I_WIN, I_WOUT, I_AREAL, I_AIMAG, I_LOGDT, I_BRE, I_BIM, I_CRE, I_CIM, I_S5D, I_GLUW, I_GLUB,
       I_LBRAW, I_HGG, I_HGB, I_WGATE, I_BGATE, I_GLG, I_WFG, I_WFU, I_WFD, I_LN1G, I_LN1B, I_LN2G, I_LN2B, N_IN };

constexpr size_t MiB = 1u << 20;
constexpr size_t WS_CTL = 0, CTL_ZERO_BYTES = 1 * MiB;
constexpr size_t WS_MOD = 1 * MiB;
constexpr size_t WS_MISC = 2 * MiB;
constexpr size_t WS_CONDPART = 12 * MiB;
constexpr size_t WS_H = 24 * MiB;
constexpr size_t WS_MIXED = WS_H + 128 * MiB;
constexpr size_t WS_Z = WS_MIXED + 128 * MiB;
constexpr size_t WS_O = WS_Z + 32 * MiB;
constexpr size_t WS_DELTA = WS_O;
constexpr size_t WS_P = WS_O + 192 * MiB;
constexpr size_t WS_WT = WS_P + 376 * MiB;
constexpr size_t WT_IN = 0, WT_OUT = 94 * MiB, WT_GU = 126 * MiB, WT_DN = 298 * MiB, WT_GLU = 384 * MiB, WT_LAYER = 386 * MiB;
constexpr size_t WS_HGB = WS_WT + DEPTH * WT_LAYER;
constexpr size_t WS_GLB = WS_HGB + 198 * MiB;
constexpr size_t WS_S5T = WS_GLB + 128 * MiB;
constexpr size_t WS_S5W1 = WS_S5T + 576 * MiB;
constexpr size_t WS_UX = WS_S5W1 + 144 * MiB;
constexpr size_t WS_SLOC = WS_UX + 36 * MiB;
constexpr size_t WS_LAM64 = WS_SLOC + 8 * MiB;
constexpr size_t WS_ST = WS_LAM64 + 1 * MiB;
constexpr size_t WS_XL = WS_ST + 45 * MiB;
constexpr size_t WS_END = WS_XL + 64 * MiB;
static_assert(DEPTH >= 2, "the last layer's residual halves reuse layer 0's weight region");
static_assert((size_t)INP * DM * 2 == 94 * MiB && (size_t)DM * DM * 2 == 32 * MiB && (size_t)2 * DFF * DM * 2 == 172 * MiB && (size_t)DM * DFF * 2 == 86 * MiB, "weight map");
static_assert((size_t)MTOK * INP * 2 == 376 * MiB && (size_t)MTOK * DFF * 2 <= 376 * MiB, "activation map");

constexpr int RING_BYTES = 131072;
constexpr int LDSCTL_OFF = 135168;
constexpr int LDS_BYTES = 147456;

#ifndef LAS
#define LAS __attribute__((address_space(3)))
#endif
#define GAS __attribute__((address_space(1)))
typedef unsigned short bf16_t;
typedef float f32x4 __attribute__((ext_vector_type(4)));
typedef float f32x2 __attribute__((ext_vector_type(2)));
typedef unsigned u32x4 __attribute__((ext_vector_type(4)));
typedef unsigned u32x2 __attribute__((ext_vector_type(2)));
#define LDS_WAIT() asm volatile("s_waitcnt lgkmcnt(0)" ::: "memory")
#define VM_WAIT() asm volatile("s_waitcnt vmcnt(0)" ::: "memory")
typedef __bf16 bf16x2_t __attribute__((ext_vector_type(2)));
__device__ __forceinline__ unsigned cvt_pk_bf16(float lo, float hi) { return __builtin_bit_cast(unsigned, __builtin_convertvector((f32x2){lo, hi}, bf16x2_t)); }

__device__ __forceinline__ float bf_lo(unsigned w) { return __uint_as_float(w << 16); }
__device__ __forceinline__ float bf_hi(unsigned w) { return __uint_as_float(w & 0xffff0000u); }
__device__ __forceinline__ float bf2f(bf16_t b) { return __uint_as_float(((unsigned)b) << 16); }
__device__ __forceinline__ float wave_sum(float v) {
    v += __int_as_float(__builtin_amdgcn_mov_dpp(__float_as_int(v), 0xB1, 0xF, 0xF, true));
    v += __int_as_float(__builtin_amdgcn_mov_dpp(__float_as_int(v), 0x4E, 0xF, 0xF, true));
    v += __int_as_float(__builtin_amdgcn_mov_dpp(__float_as_int(v), 0x141, 0xF, 0xF, true));
    v += __int_as_float(__builtin_amdgcn_mov_dpp(__float_as_int(v), 0x140, 0xF, 0xF, true));
    const int b = __float_as_int(v);
    return (__int_as_float(__builtin_amdgcn_readlane(b, 0)) + __int_as_float(__builtin_amdgcn_readlane(b, 16))) + (__int_as_float(__builtin_amdgcn_readlane(b, 32)) + __int_as_float(__builtin_amdgcn_readlane(b, 48)));
}
__device__ __forceinline__ float sigmoidf_(float x) { return __builtin_amdgcn_rcpf(1.0f + __expf(-x)); }
__device__ __forceinline__ float gelu_tanh(float y) { const float a = 0.7978845608028654f * (y + 0.044715f * y * y * y); const float t = 1.0f - 2.0f * __builtin_amdgcn_rcpf(1.0f + __expf(2.0f * a)); return 0.5f * y * (1.0f + t); }

struct EpiProj {
    static constexpr bool PERM = true, AFTER_DRAIN = false;
    GAS bf16_t* P; GAS bf16_t* UX;
    __device__ __forceinline__ void operator()(const f32x4 (&acc)[2][2][4][2], const pg8::Unit& u, int wr, int wc, int fr, int fq) const {
        const int row0 = u.pm * 256 + wr * 64 + fr, col0 = u.pn * 256 + wc * 32 + 8 * fq;
        const bool s5 = u.pn < 4;
#pragma unroll
        for (int ai = 0; ai < 2; ++ai)
#pragma unroll
            for (int m = 0; m < 4; ++m) { const int row = row0 + ai * 128 + m * 16;
#pragma unroll
                for (int bj = 0; bj < 2; ++bj) { const f32x4 v0 = acc[ai][bj][m][0], v1 = acc[ai][bj][m][1]; const int col = col0 + bj * 128;
                    u32x4 w; w.x = cvt_pk_bf16(v0[0], v0[1]); w.y = cvt_pk_bf16(v0[2], v0[3]); w.z = cvt_pk_bf16(v1[0], v1[1]); w.w = cvt_pk_bf16(v1[2], v1[3]);
                    if (!s5) *(GAS u32x4*)(P + (size_t)row * INP + col) = w;
                    else { GAS bf16_t* ur = UX + (size_t)((col >> 4) * 256 + (row >> 6)) * 1152; *(GAS u32x4*)(ur + (row & 63) * 16 + (col & 15)) = w;
                        if ((row & 63) == 0) { const u32x4 z = (u32x4){0u, 0u, 0u, 0u}; GAS bf16_t* zp = ur + 1024 + ((col & 15) ? 64 : 0);
#pragma unroll
                            for (int i = 0; i < 8; ++i) *(GAS u32x4*)(zp + 8 * i) = z; } } } }
    }
};
struct EpiSwiglu {
    static constexpr bool PERM = true, AFTER_DRAIN = false;
    GAS bf16_t* HID;
    __device__ __forceinline__ void operator()(const f32x4 (&acc)[2][2][4][2], const pg8::Unit& u, int wr, int wc, int fr, int fq) const {
        const int row0 = u.pm * 256 + wr * 64 + fr, col0 = u.pn * 128 + wc * 32 + 8 * fq;
#pragma unroll
        for (int ai = 0; ai < 2; ++ai)
#pragma unroll
            for (int m = 0; m < 4; ++m) { GAS bf16_t* rowp = HID + (size_t)(row0 + ai * 128 + m * 16) * DFF + col0;
                float o[8];
#pragma unroll
                for (int n = 0; n < 2; ++n)
#pragma unroll
                    for (int j = 0; j < 4; ++j) { const float g = acc[ai][0][m][n][j], up = acc[ai][1][m][n][j]; o[n * 4 + j] = g * __builtin_amdgcn_rcpf(1.0f + __expf(-g)) * up; }
                u32x4 w; w.x = cvt_pk_bf16(o[0], o[1]); w.y = cvt_pk_bf16(o[2], o[3]); w.z = cvt_pk_bf16(o[4], o[5]); w.w = cvt_pk_bf16(o[6], o[7]);
                *(GAS u32x4*)rowp = w; }
    }
};
struct EpiGlu {
    static constexpr bool PERM = true, AFTER_DRAIN = false;
    const GAS bf16_t* Z; GAS bf16_t* MIXED; const GAS float* bias;
    __device__ __forceinline__ void operator()(const f32x4 (&acc)[2][2][4][2], const pg8::Unit& u, int wr, int wc, int fr, int fq) const {
        const int row0 = u.pm * 256 + wr * 64 + fr, col0 = u.pn * 256 + wc * 32 + 8 * fq;
#pragma unroll
        for (int bj = 0; bj < 2; ++bj) {
            const f32x4 b0 = *(const GAS f32x4*)(bias + col0 + bj * 128), b1 = *(const GAS f32x4*)(bias + col0 + bj * 128 + 4);
            u32x4 zq[2][4];
#pragma unroll
            for (int ai = 0; ai < 2; ++ai)
#pragma unroll
                for (int m = 0; m < 4; ++m) zq[ai][m] = *(const GAS u32x4*)(Z + (size_t)(row0 + ai * 128 + m * 16) * S5W + col0 + bj * 128);
            asm volatile("" ::: "memory");
#pragma unroll
            for (int ai = 0; ai < 2; ++ai)
#pragma unroll
                for (int m = 0; m < 4; ++m) { const size_t r = (size_t)(row0 + ai * 128 + m * 16);
                    const u32x4 zz = zq[ai][m];
                    const f32x4 v0 = acc[ai][bj][m][0] + b0, v1 = acc[ai][bj][m][1] + b1;
                    u32x4 w;
                    w.x = cvt_pk_bf16(bf_lo(zz.x) * sigmoidf_(v0[0]), bf_hi(zz.x) * sigmoidf_(v0[1]));
                    w.y = cvt_pk_bf16(bf_lo(zz.y) * sigmoidf_(v0[2]), bf_hi(zz.y) * sigmoidf_(v0[3]));
                    w.z = cvt_pk_bf16(bf_lo(zz.z) * sigmoidf_(v1[0]), bf_hi(zz.z) * sigmoidf_(v1[1]));
                    w.w = cvt_pk_bf16(bf_lo(zz.w) * sigmoidf_(v1[2]), bf_hi(zz.w) * sigmoidf_(v1[3]));
                    *(GAS u32x4*)(MIXED + r * DM + col0 + bj * 128) = w;
                    if (m & 1) asm volatile("" ::: "memory"); }
        }
    }
};
struct EpiDelta {
    static constexpr bool PERM = true, AFTER_DRAIN = false;
    GAS bf16_t* D; const GAS float* gate0;
    __device__ __forceinline__ void operator()(const f32x4 (&acc)[2][2][4][2], const pg8::Unit& u, int wr, int wc, int fr, int fq) const {
        const int row0 = u.pm * 256 + wr * 64 + fr, col0 = u.pn * 256 + wc * 32 + 8 * fq;
        const GAS float* gp = gate0 + (u.pm >= 32 ? 6 * DM : 0) + col0;
        f32x4 g[2][2];
#pragma unroll
        for (int bj = 0; bj < 2; ++bj)
#pragma unroll
            for (int n = 0; n < 2; ++n) g[bj][n] = *(const GAS f32x4*)(gp + bj * 128 + 4 * n) + 1.0f;
#pragma unroll
        for (int ai = 0; ai < 2; ++ai)
#pragma unroll
            for (int m = 0; m < 4; ++m) { GAS bf16_t* rowp = D + (size_t)(row0 + ai * 128 + m * 16) * DM + col0;
#pragma unroll
                for (int bj = 0; bj < 2; ++bj) { const f32x4 v0 = acc[ai][bj][m][0] * g[bj][0], v1 = acc[ai][bj][m][1] * g[bj][1];
                    u32x4 w; w.x = cvt_pk_bf16(v0[0], v0[1]); w.y = cvt_pk_bf16(v0[2], v0[3]); w.z = cvt_pk_bf16(v1[0], v1[1]); w.w = cvt_pk_bf16(v1[2], v1[3]);
                    *(GAS u32x4*)(rowp + bj * 128) = w; } }
    }
};

__device__ __forceinline__ int lane_id_v() { int r; asm volatile("v_mbcnt_lo_u32_b32 %0, -1, 0\n\tv_mbcnt_hi_u32_b32 %0, -1, %0" : "=v"(r)); return r; }
struct Args { const float* in[N_IN]; float* out; unsigned char* ws; int ph_lo, ph_hi; };
struct Ctx {
    volatile LAS unsigned long long* t;
    __device__ __forceinline__ unsigned long long ld(int i) const { const unsigned long long v = t[i];
        return ((unsigned long long)(unsigned)__builtin_amdgcn_readfirstlane((int)(v >> 32)) << 32) | (unsigned long long)(unsigned)__builtin_amdgcn_readfirstlane((int)(unsigned)v); }
    __device__ __forceinline__ const GAS float* in(int i) const { return (const GAS float*)ld(i); }
    __device__ __forceinline__ GAS float* out() const { return (GAS float*)ld(30); }
    __device__ __forceinline__ GAS unsigned char* ws() const { return (GAS unsigned char*)ld(31); }
};

constexpr int S5K = 1152;
constexpr size_t S5_T_LAYER = (size_t)64 * 1024 * S5K * 2, S5_W1_LAYER = (size_t)64 * 256 * S5K * 2;

struct S5Order {
    int G, c, n, sh;
    __device__ __forceinline__ bool next(int i, pg8::Unit& u) const { int L = i * G + c; if (L >= n) return false;
        if (sh == 2 && G == 256 && n == 256) { const int x = L & 7, j = L >> 3; L = ((x << 3) + (j >> 2)) * 4 + (j & 3); }
        u.pm = L >> sh; u.pn = L; return true; }
    __device__ __forceinline__ void a_ready(const pg8::Unit&) const {}
    __device__ __forceinline__ void done(const pg8::Unit&) const {}
};
struct EpiS5A {
    static constexpr bool PERM = false, AFTER_DRAIN = false;
    GAS float* Sloc;
    __device__ __forceinline__ void operator()(const f32x4 (&acc)[2][2][4][2], const pg8::Unit& u, int wr, int wc, int fr, int fq) const {
        const int row0 = u.pm * 256 + wr * 64 + fr, col0 = wc * 32 + 4 * fq;
#pragma unroll
        for (int ai = 0; ai < 2; ++ai)
#pragma unroll
            for (int m = 0; m < 4; ++m)
#pragma unroll
                for (int n = 0; n < 2; ++n) *(GAS f32x4*)(Sloc + (size_t)(row0 + ai * 128 + m * 16) * 128 + col0 + n * 16) = acc[ai][0][m][n];
    }
};
struct EpiS5C {
    static constexpr bool PERM = true, AFTER_DRAIN = false;
    GAS bf16_t* Z;
    __device__ __forceinline__ void operator()(const f32x4 (&acc)[2][2][4][2], const pg8::Unit& u, int wr, int wc, int fr, int fq) const {
        const int g = u.pm, c0 = wr * 64 + fr, cc0 = (u.pn & 3) * 256 + wc * 32 + 8 * fq;
#pragma unroll
        for (int ai = 0; ai < 2; ++ai)
#pragma unroll
            for (int m = 0; m < 4; ++m) { const int c = c0 + ai * 128 + m * 16;
#pragma unroll
                for (int bj = 0; bj < 2; ++bj) { const int cc = cc0 + bj * 128, t = cc >> 4, h0 = cc & 15;
                    const f32x4 v0 = acc[ai][bj][m][0], v1 = acc[ai][bj][m][1];
                    u32x4 w; w.x = cvt_pk_bf16(gelu_tanh(v0[0]), gelu_tanh(v0[1])); w.y = cvt_pk_bf16(gelu_tanh(v0[2]), gelu_tanh(v0[3]));
                    w.z = cvt_pk_bf16(gelu_tanh(v1[0]), gelu_tanh(v1[1])); w.w = cvt_pk_bf16(gelu_tanh(v1[2]), gelu_tanh(v1[3]));
                    *(GAS u32x4*)(Z + (size_t)(c * 64 + t) * S5W + g * 16 + h0) = w; } }
    }
};
__device__ __forceinline__ void s5_tables_item(const Ctx& a, int lg, LAS unsigned char* lds, int wave, int lane) {
    LAS f32x2* LP = (LAS f32x2*)lds;
    LAS f32x2* BB = (LAS f32x2*)(lds + 33280);
    LAS f32x2* CC = (LAS f32x2*)(lds + 41472);
    LAS float* KT = (LAS float*)(lds + 49664);
    const int tid = wave * 64 + lane, l = lg >> 6, g = lg & 63;
    if (tid < 64) { const int p = tid;
        const double ar = (double)a.in(I_AREAL)[lg * 64 + p], ai = (double)a.in(I_AIMAG)[lg * 64 + p], dt = exp((double)a.in(I_LOGDT)[lg]);
        const double mag = exp(ar * dt), ang = ai * dt, lr = mag * cos(ang), li = mag * sin(ang);
        const double den = ar * ar + ai * ai, nr = lr - 1.0, ni = li, cr = (nr * ar + ni * ai) / den, ci = (ni * ar - nr * ai) / den;
        double pr = 1.0, pi = 0.0;
        for (int tau = 0; tau <= 64; ++tau) { LP[tau * 64 + p] = (f32x2){(float)pr, (float)pi}; const double nr2 = pr * lr - pi * li, ni2 = pr * li + pi * lr; pr = nr2; pi = ni2; }
        for (int h = 0; h < 16; ++h) { const double br = (double)a.in(I_BRE)[((size_t)lg * 64 + p) * 16 + h], bi = (double)a.in(I_BIM)[((size_t)lg * 64 + p) * 16 + h];
            BB[p * 16 + h] = (f32x2){(float)(cr * br - ci * bi), (float)(cr * bi + ci * br)}; }
    }
    for (int e = tid; e < 1024; e += 512) { const int h = e >> 6, p = e & 63; CC[e] = (f32x2){a.in(I_CRE)[((size_t)lg * 16 + h) * 64 + p], a.in(I_CIM)[((size_t)lg * 16 + h) * 64 + p]}; }
    __syncthreads();
    if (tid < 64) *(GAS f32x2*)((GAS float*)(a.ws() + WS_LAM64) + ((size_t)lg * 64 + tid) * 2) = LP[64 * 64 + tid];
    for (int e = tid; e < 64 * 256; e += 512) { const int tau = e >> 8, h = (e >> 4) & 15, hp = e & 15; float s = 0.f;
#pragma unroll 8
        for (int p = 0; p < 64; ++p) { const f32x2 c = CC[h * 64 + p], lm = LP[tau * 64 + p], b = BB[p * 16 + hp];
            const float xr = c.x * lm.x - c.y * lm.y, xi = c.x * lm.y + c.y * lm.x; s += xr * b.x - xi * b.y; }
        if (tau == 0 && h == hp) s += a.in(I_S5D)[l * S5W + g * 16 + h];
        KT[e] = s; }
    __syncthreads();
    GAS bf16_t* T = (GAS bf16_t*)(a.ws() + WS_S5T + (size_t)l * S5_T_LAYER) + (size_t)g * 1024 * S5K;
    for (int pc = tid; pc < 1024 * 144; pc += 512) { const int n = pc / 144, j = pc % 144, t = n >> 4, h = n & 15; float v[8];
        if (j < 128) { const int s = j >> 1, hp0 = (j & 1) * 8;
            if (s > t) {
#pragma unroll
                for (int i = 0; i < 8; ++i) v[i] = 0.f;
            } else { const LAS float* kp = KT + (t - s) * 256 + h * 16 + hp0; const f32x4 k0 = *(const LAS f32x4*)kp, k1 = *(const LAS f32x4*)(kp + 4);
                v[0] = k0[0]; v[1] = k0[1]; v[2] = k0[2]; v[3] = k0[3]; v[4] = k1[0]; v[5] = k1[1]; v[6] = k1[2]; v[7] = k1[3]; }
        } else { const int p0 = (j - 128) * 4;
#pragma unroll
            for (int i = 0; i < 4; ++i) { const f32x2 c = CC[h * 64 + p0 + i], lm = LP[(t + 1) * 64 + p0 + i]; v[2 * i] = c.x * lm.x - c.y * lm.y; v[2 * i + 1] = -(c.x * lm.y + c.y * lm.x); } }
        *(GAS u32x4*)(T + (size_t)n * S5K + j * 8) = (u32x4){cvt_pk_bf16(v[0], v[1]), cvt_pk_bf16(v[2], v[3]), cvt_pk_bf16(v[4], v[5]), cvt_pk_bf16(v[6], v[7])}; }
    GAS bf16_t* W1 = (GAS bf16_t*)(a.ws() + WS_S5W1 + (size_t)l * S5_W1_LAYER) + (size_t)g * 256 * S5K;
    for (int pc = tid; pc < 256 * 144; pc += 512) { const int n = pc / 144, j = pc % 144; float v[8];
#pragma unroll
        for (int i = 0; i < 8; ++i) v[i] = 0.f;
        if (n < 128 && j < 128) { const int p = n >> 1, ri = n & 1, s = j >> 1, hp0 = (j & 1) * 8; const f32x2 lm = LP[(63 - s) * 64 + p];
#pragma unroll
            for (int i = 0; i < 8; ++i) { const f32x2 b = BB[p * 16 + hp0 + i]; v[i] = ri ? (lm.x * b.y + lm.y * b.x) : (lm.x * b.x - lm.y * b.y); } }
        *(GAS u32x4*)(W1 + (size_t)n * S5K + j * 8) = (u32x4){cvt_pk_bf16(v[0], v[1]), cvt_pk_bf16(v[2], v[3]), cvt_pk_bf16(v[4], v[5]), cvt_pk_bf16(v[6], v[7])}; }
    __syncthreads();
}
__device__ __forceinline__ void s5_scan_item(const Ctx& a, int l, int item, int wave, int lane) {
    const int idx = item * 512 + wave * 64 + lane, g = idx >> 7, b = (idx >> 6) & 1, p = idx & 63;
    const f32x2 lam = *(const GAS f32x2*)((const GAS float*)(a.ws() + WS_LAM64) + ((size_t)(l * 64 + g) * 64 + p) * 2);
    const GAS float* sl = (const GAS float*)(a.ws() + WS_SLOC) + ((size_t)(g * 256 + b * 128)) * 128 + 2 * p;
    GAS bf16_t* ux = (GAS bf16_t*)(a.ws() + WS_UX) + ((size_t)(g * 256 + b * 128)) * S5K + 1024 + 2 * p;
    float xr = 0.f, xi = 0.f;
    for (int c0 = 0; c0 < 128; c0 += 8) { f32x2 s[8];
#pragma unroll
        for (int i = 0; i < 8; ++i) s[i] = *(const GAS f32x2*)(sl + (size_t)(c0 + i) * 128);
#pragma unroll
        for (int i = 0; i < 8; ++i) { *(GAS unsigned*)(ux + (size_t)(c0 + i) * S5K) = cvt_pk_bf16(xr, xi);
            const float nr = lam.x * xr - lam.y * xi + s[i].x, ni = lam.x * xi + lam.y * xr + s[i].y; xr = nr; xi = ni; } }
}

__device__ __forceinline__ void transpose_item(const GAS float* W, int N, int k0, int n0, GAS bf16_t* WT, int drow0, int Kd, LAS float* scr, int lane) {
    const int nl = 4 * (lane & 15), kq = lane >> 4;
    const bool valid = (n0 + nl) < N;
    f32x4 v[16];
#pragma unroll
    for (int i = 0; i < 16; ++i) { const int k = 4 * i + kq; v[i] = valid ? *(const GAS f32x4*)(W + (size_t)(k0 + k) * N + n0 + nl) : (f32x4){0.f, 0.f, 0.f, 0.f}; }
#pragma unroll
    for (int i = 0; i < 16; ++i) { const int k = 4 * i + kq; LAS float* s = scr + k * 65 + nl; s[0] = v[i][0]; s[1] = v[i][1]; s[2] = v[i][2]; s[3] = v[i][3]; }
    LDS_WAIT();
    const int c = lane & 7;
#pragma unroll
    for (int j = 0; j < 8; ++j) { const int n = (lane >> 3) + 8 * j; const LAS float* s = scr + (8 * c) * 65 + n;
        u32x4 o; o.x = cvt_pk_bf16(s[0], s[65]); o.y = cvt_pk_bf16(s[130], s[195]); o.z = cvt_pk_bf16(s[260], s[325]); o.w = cvt_pk_bf16(s[390], s[455]);
        *(GAS u32x4*)(WT + (size_t)(drow0 + n) * Kd + k0 + 8 * c) = o; }
    LDS_WAIT();
}
constexpr int NIT_IN = 64 * 188, NIT_OUT = 64 * 64, NIT_G = 64 * 172, NIT_DN = 172 * 64, NIT_GLU = 16 * 16;
constexpr int NIT_LAYER = NIT_IN + NIT_OUT + 2 * NIT_G + NIT_DN + NIT_GLU;
constexpr int NIT_TR = DEPTH * NIT_LAYER, NIT_COND = 64 * 96;

__device__ __forceinline__ void phase_prologue(const Ctx& a, LAS unsigned char* lds, int wave, int lane) {
    if (blockIdx.x & 1) { for (int lg = blockIdx.x; lg < DEPTH * 64; lg += gridDim.x) s5_tables_item(a, lg, lds, wave, lane); __syncthreads(); }
    LAS float* scr = (LAS float*)(lds + wave * 16640);
    const int gw = blockIdx.x * 8 + wave, NGW = gridDim.x * 8;
    for (int it = gw; it < NIT_TR + NIT_COND; it += NGW) {
        if (it < NIT_TR) {
            const int l = it / NIT_LAYER; int r = it % NIT_LAYER;
            GAS unsigned char* wt = a.ws() + WS_WT + (size_t)l * WT_LAYER;
            if (r < NIT_IN) { const int kb = r / 188, nb = r % 188; transpose_item(a.in(I_WIN) + (size_t)l * DM * INW, INW, 64 * kb, 64 * nb, (GAS bf16_t*)(wt + WT_IN), 64 * nb, DM, scr, lane); continue; } r -= NIT_IN;
            if (r < NIT_OUT) { const int kb = r / 64, nb = r % 64; transpose_item(a.in(I_WOUT) + (size_t)l * DM * DM, DM, 64 * kb, 64 * nb, (GAS bf16_t*)(wt + WT_OUT), 64 * nb, DM, scr, lane); continue; } r -= NIT_OUT;
            if (r < NIT_G) { const int kb = r / 172, nb = r % 172, n0 = 64 * nb; transpose_item(a.in(I_WFG) + (size_t)l * DM * DFF, DFF, 64 * kb, n0, (GAS bf16_t*)(wt + WT_GU), 256 * (n0 / 128) + (n0 % 128), DM, scr, lane); continue; } r -= NIT_G;
            if (r < NIT_G) { const int kb = r / 172, nb = r % 172, n0 = 64 * nb; transpose_item(a.in(I_WFU) + (size_t)l * DM * DFF, DFF, 64 * kb, n0, (GAS bf16_t*)(wt + WT_GU), 256 * (n0 / 128) + 128 + (n0 % 128), DM, scr, lane); continue; } r -= NIT_G;
            if (r < NIT_DN) { const int kb = r / 64, nb = r % 64; transpose_item(a.in(I_WFD) + (size_t)l * DFF * DM, DM, 64 * kb, 64 * nb, (GAS bf16_t*)(wt + WT_DN), 64 * nb, DFF, scr, lane); continue; } r -= NIT_DN;
            { const int kb = r / 16, nb = r % 16; transpose_item(a.in(I_GLUW) + (size_t)l * S5W * S5W, S5W, 64 * kb, 64 * nb, (GAS bf16_t*)(wt + WT_GLU), 64 * nb, S5W, scr, lane); }
        } else {
            const int item = it - NIT_TR, kb = item / 96, jb = item % 96, k0 = 64 * kb, j0 = 256 * jb + 4 * lane;
            const GAS float* c = a.in(I_C);
            float c0 = c[k0 + lane], c1 = c[DM + k0 + lane];
            c0 = c0 / (1.0f + expf(-c0)); c1 = c1 / (1.0f + expf(-c1));
            f32x4 a0 = (f32x4){0.f, 0.f, 0.f, 0.f}, a1 = a0;
            const GAS float* w = a.in(I_WADA) + (size_t)k0 * (6 * DM) + j0;
#pragma unroll 8
            for (int kk = 0; kk < 64; ++kk) { const f32x4 wv = *(const GAS f32x4*)(w + (size_t)kk * (6 * DM));
                const float s0 = __int_as_float(__builtin_amdgcn_readlane(__float_as_int(c0), kk)), s1 = __int_as_float(__builtin_amdgcn_readlane(__float_as_int(c1), kk));
                a0 += wv * s0; a1 += wv * s1; }
            GAS float* cp = (GAS float*)(a.ws() + WS_CONDPART);
            *(GAS f32x4*)(cp + (size_t)(kb * 2 + 0) * (6 * DM) + j0) = a0;
            *(GAS f32x4*)(cp + (size_t)(kb * 2 + 1) * (6 * DM) + j0) = a1;
        }
    }
    __syncthreads();
    if (!(blockIdx.x & 1)) { for (int lg = blockIdx.x; lg < DEPTH * 64; lg += gridDim.x) s5_tables_item(a, lg, lds, wave, lane); }
}
__device__ __forceinline__ void phase_mod(const Ctx& a, int wave, int lane) {
    const int gt = blockIdx.x * 512 + wave * 64 + lane, NT = gridDim.x * 512;
    const GAS float* cp = (const GAS float*)(a.ws() + WS_CONDPART);
    GAS float* mod = (GAS float*)(a.ws() + WS_MOD); GAS float* misc = (GAS float*)(a.ws() + WS_MISC);
    for (int idx = gt; idx < NB * 6 * DM; idx += NT) {
        const int b = idx / (6 * DM), j = idx % (6 * DM);
        float s = a.in(I_BADA)[j];
        for (int kb = 0; kb < 64; ++kb) s += cp[(size_t)(kb * 2 + b) * (6 * DM) + j];
        for (int l = 0; l < DEPTH; ++l) mod[(size_t)((l * 2 + b) * 6) * DM + j] = s + a.in(I_TABLE)[(size_t)l * 6 * DM + j];
    }
    for (int idx = gt; idx < DM; idx += NT) { misc[idx] = 1.0f; misc[DM + idx] = 0.0f; }
    for (int idx = gt; idx < HGW; idx += NT) {
        const GAS float* raw = a.in(I_LBRAW); float r[DEPTH], mx = -3.0e38f;
#pragma unroll
        for (int l = 0; l < DEPTH; ++l) { r[l] = raw[l * HGW + idx]; mx = fmaxf(mx, r[l]); }
        float e[DEPTH], sum = 0.f;
#pragma unroll
        for (int l = 0; l < DEPTH; ++l) { e[l] = expf(r[l] - mx); sum += e[l]; }
        float cum = 0.f;
#pragma unroll
        for (int l = 0; l < DEPTH; ++l) { misc[2 * DM + l * HGW + idx] = cum; if (l + 1 < DEPTH) cum += e[l + 1] / sum; }
    }
}

__device__ __forceinline__ void phase_h0(const GAS float* x, const GAS float* modp, GAS bf16_t* H, int wave, int lane) {
    for (int blk = blockIdx.x; blk < MTOK / 64; blk += gridDim.x) {
        const int r0 = blk * 64, b = (r0 >= SEQ) ? 1 : 0;
        f32x4 A[2], B[2];
#pragma unroll
        for (int jj = 0; jj < 2; ++jj) { const int c = 512 * wave + 256 * jj + 4 * lane; A[jj] = *(const GAS f32x4*)(modp + (size_t)(b * 6 + 1) * DM + c) + 1.0f; B[jj] = *(const GAS f32x4*)(modp + (size_t)(b * 6 + 0) * DM + c); }
#pragma unroll 8
        for (int rl = 0; rl < 64; ++rl) { const size_t off = (size_t)(r0 + rl) * DM + 512 * wave + 4 * lane;
#pragma unroll
            for (int jj = 0; jj < 2; ++jj) { const f32x4 v = *(const GAS f32x4*)(x + off + 256 * jj), y = v * A[jj] + B[jj];
                u32x2 w; w.x = cvt_pk_bf16(y[0], y[1]); w.y = cvt_pk_bf16(y[2], y[3]); *(GAS u32x2*)(H + off + 256 * jj) = w; } }
    }
}
struct XRes { GAS unsigned* hi; GAS unsigned* lo; };
template <bool WITH_H, bool XP32, bool XO32>
__device__ __forceinline__ void phase_lnres(const GAS float* xp32, XRes xp, const GAS bf16_t* delta, GAS float* xo32, XRes xo, const GAS float* lng, const GAS float* lnb, const GAS float* modp, int i_shift, int i_scale,
                                            GAS bf16_t* H, LAS unsigned char* lds, int wave, int lane) {
    LAS f32x2* red = (LAS f32x2*)lds;
    for (int blk = blockIdx.x; blk < MTOK / 64; blk += gridDim.x) {
        const int r0 = blk * 64, b = (r0 >= SEQ) ? 1 : 0;
        f32x4 G[2], Bt[2], A[2], B[2];
#pragma unroll
        for (int jj = 0; jj < 2; ++jj) { const int c = 512 * wave + 256 * jj + 4 * lane; G[jj] = *(const GAS f32x4*)(lng + c); Bt[jj] = *(const GAS f32x4*)(lnb + c);
            if (WITH_H) { A[jj] = *(const GAS f32x4*)(modp + (size_t)(b * 6 + i_scale) * DM + c) + 1.0f; B[jj] = *(const GAS f32x4*)(modp + (size_t)(b * 6 + i_shift) * DM + c); } }
        const size_t offb = (size_t)r0 * DM + 512 * wave + 4 * lane;
        f32x4 va[4][2], vb[4][2]; u32x2 da[4][2], db[4][2];
#define LN_LOAD(v_, d_, it_) do { _Pragma("unroll") for (int r = 0; r < 4; ++r) _Pragma("unroll") for (int jj = 0; jj < 2; ++jj) { const size_t o_ = offb + (size_t)((it_) * 4 + r) * DM + 256 * jj; \
            if (XP32) v_[r][jj] = *(const GAS f32x4*)(xp32 + o_); else { const u32x2 t_ = *(const GAS u32x2*)(xp.hi + (o_ >> 1)); const unsigned l_ = xp.lo[o_ >> 2]; \
                v_[r][jj][0] = __uint_as_float(t_.x); v_[r][jj][1] = __uint_as_float(t_.y); v_[r][jj][2] = __uint_as_float(l_); } \
            d_[r][jj] = *(const GAS u32x2*)(delta + o_); } } while (0)
#define LN_STEP(v_, d_, it_) do { LAS f32x2* rb = red + ((it_) & 1) * 32; \
            _Pragma("unroll") for (int r = 0; r < 4; ++r) { float s1 = 0.f, s2 = 0.f; \
                _Pragma("unroll") for (int jj = 0; jj < 2; ++jj) { const f32x4 dd = (f32x4){bf_lo(d_[r][jj].x), bf_hi(d_[r][jj].x), bf_lo(d_[r][jj].y), bf_hi(d_[r][jj].y)}; \
                    f32x4 xq = v_[r][jj]; \
                    if (!XP32) { const unsigned t0 = __float_as_uint(xq[0]), t1 = __float_as_uint(xq[1]), lw = __float_as_uint(xq[2]); \
                        xq[0] = __uint_as_float(__builtin_amdgcn_perm(t0, lw, 0x0504000cu)); xq[1] = __uint_as_float(__builtin_amdgcn_perm(t0, lw, 0x0706010cu)); \
                        xq[2] = __uint_as_float(__builtin_amdgcn_perm(t1, lw, 0x0504020cu)); xq[3] = __uint_as_float(__builtin_amdgcn_perm(t1, lw, 0x0706030cu)); } \
                    const f32x4 y = xq * ALPHA + dd; v_[r][jj] = y; \
                    s1 += (y[0] + y[1]) + (y[2] + y[3]); s2 += (y[0] * y[0] + y[1] * y[1]) + (y[2] * y[2] + y[3] * y[3]); } \
                s1 = wave_sum(s1); s2 = wave_sum(s2); if (lane == 0) rb[r * 8 + wave] = (f32x2){s1, s2}; } \
            __syncthreads(); \
            _Pragma("unroll") for (int r = 0; r < 4; ++r) { float s1 = 0.f, s2 = 0.f; \
                _Pragma("unroll") for (int w = 0; w < 8; ++w) { const f32x2 p = rb[r * 8 + w]; s1 += p.x; s2 += p.y; } \
                const float mu = s1 * (1.0f / DM), rs = 1.0f / sqrtf(fmaxf(s2 * (1.0f / DM) - mu * mu, 0.f) + LN_EPS); \
                _Pragma("unroll") for (int jj = 0; jj < 2; ++jj) { const f32x4 x = ((v_[r][jj] - mu) * rs) * G[jj] + Bt[jj]; const size_t o_ = offb + (size_t)((it_) * 4 + r) * DM + 256 * jj; \
                    if (XO32) *(GAS f32x4*)(xo32 + o_) = x; \
                    else { const unsigned q0 = __float_as_uint(x[0]) + 0x80u, q1 = __float_as_uint(x[1]) + 0x80u, q2 = __float_as_uint(x[2]) + 0x80u, q3 = __float_as_uint(x[3]) + 0x80u; \
                        *(GAS u32x2*)(xo.hi + (o_ >> 1)) = (u32x2){__builtin_amdgcn_perm(q1, q0, 0x07060302u), __builtin_amdgcn_perm(q3, q2, 0x07060302u)}; \
                        xo.lo[o_ >> 2] = __builtin_amdgcn_perm(q1, q0, 0x0c0c0501u) | __builtin_amdgcn_perm(q3, q2, 0x05010c0cu); } \
                    if (WITH_H) { const f32x4 y = x * A[jj] + B[jj]; u32x2 w; w.x = cvt_pk_bf16(y[0], y[1]); w.y = cvt_pk_bf16(y[2], y[3]); *(GAS u32x2*)(H + o_) = w; } } } } while (0)
        LN_LOAD(va, da, 0);
        for (int it = 0; it < 16; it += 2) {
            LN_LOAD(vb, db, it + 1);
            LN_STEP(va, da, it);
            if (it + 2 < 16) LN_LOAD(va, da, it + 2);
            LN_STEP(vb, db, it + 1);
        }
#undef LN_LOAD
#undef LN_STEP
        __syncthreads();
    }
}

typedef short bf16x8 __attribute__((ext_vector_type(8)));
constexpr int HG_BLK = 33280, HG_OQ = 0, HG_OK = 8192, HG_OKT = 16384, HG_ODL = 24576, HG_OVT = 25088;
constexpr int GL_BLK = 63488, GL_OQ = 0, GL_OK = 12800, GL_OKT = 25600, GL_ODL = 37888, GL_SHARED = 38912, GL_OVT = 38912;
constexpr int NUNIT = SEQ / 32;

struct PreOut { GAS unsigned char* blk; int oq, ok, okt, odl, rowb; bool swz; };
__device__ __forceinline__ int slot_swz(int r) { return (0 - (r >> 2)) & 3; }
template <int HALF>
__device__ __forceinline__ float pre_half(const PreOut& P, int d, int pd, float e0, const float (&a)[16], const float (&qq)[16], const float (&kk)[16], float (&kta)[16], unsigned (&kt)[16], float& ph) {
    float w = 1.0f;
#pragma unroll
    for (int t = 14; t >= 0; t -= 2) { const float kv1 = kk[t + 1] * w; w *= a[t + 1]; const float kv0 = kk[t] * w; w *= a[t];
        if (HALF == 0) { kta[t] = kv0; kta[t + 1] = kv1; } else kt[4 * (t >> 2) + 2 + ((t & 3) >> 1)] = cvt_pk_bf16(kv0, kv1); }
    ph = w;
    float e = e0;
#pragma unroll
    for (int j = 0; j < 16; ++j) { const int row = 16 * HALF + j;
        e *= a[j];
        const int off = row * P.rowb + ((2 * pd) ^ ((P.swz ? j : ((j >> 1) & 7)) << 4));
        const float qv = qq[j] * e, kc = kk[j] * fminf(__builtin_amdgcn_rcpf(e), 5.5406224e34f);
        const float qn = __int_as_float(__builtin_amdgcn_mov_dpp(__float_as_int(qv), 0xB1, 0xF, 0xF, true)), kn = __int_as_float(__builtin_amdgcn_mov_dpp(__float_as_int(kc), 0xB1, 0xF, 0xF, true));
        if ((d & 1) == 0) { *(GAS unsigned*)(P.blk + P.oq + off) = cvt_pk_bf16(qv, qn); *(GAS unsigned*)(P.blk + P.ok + off) = cvt_pk_bf16(kc, kn); } }
    return e;
}
__device__ __forceinline__ void pre_tail(const PreOut& P, int d, float dlb, float eend, const float (&kta)[16], unsigned (&kt)[16]) {
#pragma unroll
    for (int t = 0; t < 16; t += 2) kt[4 * (t >> 2) + ((t & 3) >> 1)] = cvt_pk_bf16(kta[t] * dlb, kta[t + 1] * dlb);
#pragma unroll
    for (int i = 0; i < 4; ++i) *(GAS u32x4*)(P.blk + P.okt + d * 64 + 16 * (i ^ slot_swz(d))) = (u32x4){kt[4 * i], kt[4 * i + 1], kt[4 * i + 2], kt[4 * i + 3]};
    *(GAS float*)(P.blk + P.odl + d * 4) = eend;
}
__device__ __forceinline__ void glds16_asm(const GAS void* gsrc, unsigned lds_dst) { unsigned keep;
    asm volatile("s_mov_b32 %0, m0\n\ts_mov_b32 m0, %2\n\ts_nop 0\n\tglobal_load_lds_dwordx4 %1, off\n\ts_mov_b32 m0, %0" : "=&s"(keep) : "v"(gsrc), "s"(lds_dst) : "memory"); }
constexpr int PRE_IN = 49152, PRE_OUT = 2 * PRE_IN;
__device__ __forceinline__ void pre_hg_dma(const GAS bf16_t* P, int t, int half, LAS unsigned char* img, int wave, int lane) {
    const int bu = t / 3, kind = t - 3 * bu, b = bu / NUNIT, un = bu - b * NUNIT;
    const GAS bf16_t* src = P + ((size_t)b * SEQ + un * 32 + 16 * half) * INP + kind * 512 + 8 * lane;
    const unsigned dst = (unsigned)(size_t)img;
#pragma unroll
    for (int i = 0; i < 6; ++i) { const int r = wave * 6 + i, arr = r >> 4, j = r & 15;
        glds16_asm(src + (size_t)j * INP + (arr == 0 ? C_QB : arr == 1 ? C_FB : C_IB), dst + r * 1024); }
}
template <int HALF>
__device__ __forceinline__ float pre_half_l(LAS unsigned char* oq, LAS unsigned char* ok, int pd, float e0, const float (&a)[16], const float (&qq)[16], const float (&kk)[16], float (&kta)[16], unsigned (&kt)[16], float& ph) {
    float w = 1.0f;
#pragma unroll
    for (int t = 14; t >= 0; t -= 2) { const float kv1 = kk[t + 1] * w; w *= a[t + 1]; const float kv0 = kk[t] * w; w *= a[t];
        if (HALF == 0) { kta[t] = kv0; kta[t + 1] = kv1; } else kt[4 * (t >> 2) + 2 + ((t & 3) >> 1)] = cvt_pk_bf16(kv0, kv1); }
    ph = w;
    float e = e0;
#pragma unroll
    for (int j = 0; j < 16; ++j) { e *= a[j];
        const int off = j * 256 + ((2 * pd) ^ (j << 4));
        const float qv = qq[j] * e, kc = kk[j] * fminf(__builtin_amdgcn_rcpf(e), 5.5406224e34f);
        *(LAS unsigned short*)(oq + off) = (unsigned short)cvt_pk_bf16(qv, qv); *(LAS unsigned short*)(ok + off) = (unsigned short)cvt_pk_bf16(kc, kc); }
    return e;
}
__device__ __forceinline__ void phase_pre(const Ctx& a, int l, LAS unsigned char* lds, int wave, int lane) {
    const GAS bf16_t* P = (const GAS bf16_t*)(a.ws() + WS_P);
    int tid = wave * 64 + lane;
    const int bx = blockIdx.x, G = gridDim.x;
    const bool bal = G == 256;
    const int t_lo = bal ? (bx < 64 ? 4 * bx : 256 + 12 * (bx - 64)) : bx;
    const int t_hi = bal ? t_lo + (bx < 64 ? 4 : 12) : NB * NUNIT * 5, t_st = bal ? 1 : G;
    for (int task = t_lo; task < t_hi; task += t_st) {
        asm volatile("" : "+v"(tid));
        const int bu = task / 5, kind = 3 + (task - 5 * bu), b = bu / NUNIT, un = bu % NUNIT;
        const size_t row0 = (size_t)b * SEQ + un * 32;
        if (kind < 5) {
            __syncthreads();
            if (tid < 64) *(LAS u32x4*)(lds + tid * 16) = *(const GAS u32x4*)(P + (row0 + (tid >> 1)) * INP + C_LR + 8 * (tid & 1));
            __syncthreads();
            if (tid < 384) {
                const int ch = (kind - 3) * 384 + tid, h = ch / 192, d = ch % 192, pd = (d & ~31) + 8 * ((d >> 2) & 3) + 4 * ((d >> 4) & 1) + (d & 3);
                GAS unsigned char* blk = a.ws() + WS_GLB + ((size_t)(b * 4 + h) * NUNIT + un) * GL_BLK;
                const PreOut po{blk, GL_OQ, GL_OK, GL_OKT, GL_ODL, 384, false};
                float wg[16];
#pragma unroll
                for (int r = 0; r < 16; ++r) wg[r] = a.in(I_WGATE)[((size_t)l * 16 + r) * GLKW + ch];
                const float bgv = a.in(I_BGATE)[l * GLKW + ch];
                float kta[16]; unsigned kt[16]; float e0 = 1.f, e1 = 1.f, ph = 1.f;
#pragma unroll
                for (int half = 0; half < 2; ++half) {
                    float g[16], qq[16], kk[16];
#pragma unroll
                    for (int j = 0; j < 16; ++j) { const GAS bf16_t* prow = P + (row0 + 16 * half + j) * INP;
                        const u32x4 l0 = *(const LAS u32x4*)(lds + (16 * half + j) * 32), l1 = *(const LAS u32x4*)(lds + (16 * half + j) * 32 + 16);
                        float x = bgv;
                        x += bf_lo(l0.x) * wg[0] + bf_hi(l0.x) * wg[1] + bf_lo(l0.y) * wg[2] + bf_hi(l0.y) * wg[3] + bf_lo(l0.z) * wg[4] + bf_hi(l0.z) * wg[5] + bf_lo(l0.w) * wg[6] + bf_hi(l0.w) * wg[7];
                        x += bf_lo(l1.x) * wg[8] + bf_hi(l1.x) * wg[9] + bf_lo(l1.y) * wg[10] + bf_hi(l1.y) * wg[11] + bf_lo(l1.z) * wg[12] + bf_hi(l1.z) * wg[13] + bf_lo(l1.w) * wg[14] + bf_hi(l1.w) * wg[15];
                        g[j] = __expf((fminf(x, 0.f) - __logf(1.0f + __expf(-fabsf(x)))) * 0.0625f);
                        qq[j] = bf2f(prow[C_QC + ch]) * GLA_QSCALE; kk[j] = bf2f(prow[C_KC + ch]); }
                    if (half == 0) { e0 = pre_half<0>(po, d, pd, 1.0f, g, qq, kk, kta, kt, ph); } else { e1 = pre_half<1>(po, d, pd, e0, g, qq, kk, kta, kt, ph); }
                }
                pre_tail(po, d, ph, e1, kta, kt);
            }
        } else {
            const int ch = (kind - 5) * 512 + tid, h = ch / 384, e = ch % 384;
            GAS unsigned char* blk = a.ws() + WS_GLB + ((size_t)(b * 4 + h) * NUNIT + un) * GL_BLK;
            unsigned vv[16]; unsigned short rv[32];
#pragma unroll
            for (int j = 0; j < 32; ++j) rv[j] = P[(row0 + j) * INP + C_VC + ch];
            asm volatile("" ::: "memory");
#pragma unroll
            for (int j = 0; j < 32; ++j) { const unsigned short v = rv[j];
                const int w = 4 * ((j >> 2) & 3) + 2 * (j >> 4) + ((j & 3) >> 1); if (j & 1) vv[w] |= ((unsigned)v) << 16; else vv[w] = v; }
#pragma unroll
            for (int i = 0; i < 4; ++i) *(GAS u32x4*)(blk + GL_OVT + e * 64 + 16 * (i ^ slot_swz(e))) = (u32x4){vv[4 * i], vv[4 * i + 1], vv[4 * i + 2], vv[4 * i + 3]};
        }
    }
    __syncthreads();
    {
        const int t_lo = (int)((long)(NB * NUNIT * 3) * bx / G), t_hi = (int)((long)(NB * NUNIT * 3) * (bx + 1) / G);
        float lbk[3];
#pragma unroll
        for (int k = 0; k < 3; ++k) lbk[k] = ((const GAS float*)(a.ws() + WS_MISC))[2 * DM + l * HGW + k * 512 + tid];
        asm volatile("" : "+v"(lbk[0]), "+v"(lbk[1]), "+v"(lbk[2]));
        __syncthreads();
        if (t_lo < t_hi) pre_hg_dma(P, t_lo, 0, lds, wave, lane);
        VM_WAIT();
        for (int t = t_lo; t < t_hi; ++t) {
            asm volatile("" : "+v"(tid));
            const int bu = t / 3, kind = t - 3 * bu, b = bu / NUNIT, un = bu - b * NUNIT;
            const int ch = kind * 512 + tid, hh = tid >> 7, d = tid & 127, pd = (d & ~31) + 8 * ((d >> 2) & 3) + 4 * ((d >> 4) & 1) + (d & 3);
            const float lb = kind == 0 ? lbk[0] : kind == 1 ? lbk[1] : lbk[2];
            GAS unsigned char* blk0 = a.ws() + WS_HGB + ((size_t)(b * 12 + kind * 4) * NUNIT + un) * HG_BLK;
            float kta[16]; unsigned kt[16], vv[16]; float e0 = 1.f, e1 = 1.f, ph = 1.f;
#pragma unroll
            for (int half = 0; half < 2; ++half) {
                __syncthreads();
                { const int nt = half ? t + 1 : t; if (nt < t_hi) pre_hg_dma(P, nt, half ^ 1, lds + (half ^ 1) * PRE_IN, wave, lane); }
                const LAS unsigned char* img = lds + half * PRE_IN + 2 * tid;
                float g[16], qq[16], kk[16];
                unsigned short rq[16], rf[16], rv[16];
#pragma unroll
                for (int j = 0; j < 16; ++j) { rq[j] = *(const LAS unsigned short*)(img + j * 1024); rf[j] = *(const LAS unsigned short*)(img + (16 + j) * 1024); rv[j] = *(const LAS unsigned short*)(img + (32 + j) * 1024); }
                asm volatile("" ::: "memory");
#pragma unroll
                for (int j = 0; j < 16; ++j) {
                    const float qin = fmaxf(bf2f(rq[j]), -80.f), fin = fminf(fmaxf(bf2f(rf[j]), -80.f), 80.f);
                    const unsigned short v = rv[j];
                    const int w = 4 * (j >> 2) + 2 * half + ((j & 3) >> 1); if (j & 1) vv[w] |= ((unsigned)v) << 16; else vv[w] = v;
                    const float e = __expf(-fin), sg = __builtin_amdgcn_rcpf(1.0f + e);
                    const float f = lb + (1.0f - lb) * sg;
                    g[j] = f; kk[j] = (1.0f - lb) * (e * sg); qq[j] = qin * __builtin_amdgcn_rcpf(1.0f + __expf(-qin)); }
                LAS unsigned char* oq = lds + PRE_OUT + hh * 4096; LAS unsigned char* ok = oq + 16384;
                if (half == 0) { e0 = pre_half_l<0>(oq, ok, pd, 1.0f, g, qq, kk, kta, kt, ph); } else { e1 = pre_half_l<1>(oq, ok, pd, e0, g, qq, kk, kta, kt, ph); }
                __syncthreads();
                VM_WAIT();
#pragma unroll
                for (int i = 0; i < 4; ++i) { const int pc = i * 512 + tid, c = pc >> 8, wi = pc & 255;
                    *(GAS u32x4*)(blk0 + (size_t)(c & 3) * NUNIT * HG_BLK + (c >> 2 ? HG_OK : HG_OQ) + half * 4096 + wi * 16) = *(const LAS u32x4*)(lds + PRE_OUT + c * 4096 + wi * 16); }
            }
            GAS unsigned char* blk = blk0 + (size_t)hh * NUNIT * HG_BLK;
            const PreOut po{blk, HG_OQ, HG_OK, HG_OKT, HG_ODL, 256, true};
#pragma unroll
            for (int i = 0; i < 4; ++i) *(GAS u32x4*)(blk + HG_OVT + d * 64 + 16 * (i ^ slot_swz(d))) = (u32x4){vv[4 * i], vv[4 * i + 1], vv[4 * i + 2], vv[4 * i + 3]};
            pre_tail(po, d, ph, e1, kta, kt);
        }
    }
}

template <int DK, int MODE>
__device__ __forceinline__ void chain_unit(const LAS unsigned char* sb, f32x4 (&S)[DK / 16], GAS float* op, int wave, int n, int q) {
    constexpr bool IS_GLA = (DK == 192);
    constexpr int NKS = DK / 32, NMB = DK / 16, ROWB = IS_GLA ? 384 : 256;
    constexpr int OQ = 0, OK = IS_GLA ? GL_OK : HG_OK, OKT = IS_GLA ? GL_OKT : HG_OKT, OVT = IS_GLA ? GL_OVT : HG_OVT, ODL = IS_GLA ? GL_ODL : HG_ODL;
    constexpr int UG = 4, NUG = NMB / UG;
#define CU_FENCE() asm volatile("" ::: "memory")
    bf16x8 ktf[2][UG]; f32x4 dlv[2][UG];
#define CU_LDU(g_, sl_) do { _Pragma("unroll") for (int u_ = 0; u_ < UG; ++u_) { const int mb_ = (g_) * UG + u_; \
        dlv[sl_][u_] = *(const LAS f32x4*)(sb + ODL + (16 * mb_ + 4 * q) * 4); ktf[sl_][u_] = __builtin_bit_cast(bf16x8, *(const LAS u32x4*)(sb + OKT + (16 * mb_ + n) * 64 + 16 * qs)); } } while (0)
#define CU_SBF(ks_) __builtin_bit_cast(bf16x8, (u32x4){cvt_pk_bf16(S[2 * (ks_)][0], S[2 * (ks_)][1]), cvt_pk_bf16(S[2 * (ks_)][2], S[2 * (ks_)][3]), cvt_pk_bf16(S[2 * (ks_) + 1][0], S[2 * (ks_) + 1][1]), cvt_pk_bf16(S[2 * (ks_) + 1][2], S[2 * (ks_) + 1][3])})
    const int qs = q ^ slot_swz(n);
    const bf16x8 vf8 = __builtin_bit_cast(bf16x8, *(const LAS u32x4*)(sb + OVT + (16 * wave + n) * 64 + 16 * qs));
    if (MODE == 1) {
        const f32x4 zero = (f32x4){0.f, 0.f, 0.f, 0.f};
        bf16x8 qf0[NKS], kf0[NKS], qf1[NKS], kf1[NKS];
#pragma unroll
        for (int ks = 0; ks < NKS; ++ks) { const int c0 = 64 * ks + 16 * q, o0 = n * ROWB + (c0 ^ ((IS_GLA ? ((n >> 1) & 7) : n) << 4));
            qf0[ks] = __builtin_bit_cast(bf16x8, *(const LAS u32x4*)(sb + OQ + o0)); kf0[ks] = __builtin_bit_cast(bf16x8, *(const LAS u32x4*)(sb + OK + o0)); }
        if (!IS_GLA) {
#pragma unroll
            for (int ks = 0; ks < NKS; ++ks) { const int c0 = 64 * ks + 16 * q, o1 = (16 + n) * ROWB + (c0 ^ (n << 4));
                qf1[ks] = __builtin_bit_cast(bf16x8, *(const LAS u32x4*)(sb + OQ + o1)); kf1[ks] = __builtin_bit_cast(bf16x8, *(const LAS u32x4*)(sb + OK + o1)); }
        }
        CU_FENCE();
        {
            f32x4 ao = zero, ao1 = zero, ap = zero, ap1 = zero;
#pragma unroll
            for (int ks = 0; ks < NKS; ++ks) { const bf16x8 sbf = CU_SBF(ks);
                if (ks & 1) { ao1 = __builtin_amdgcn_mfma_f32_16x16x32_bf16(qf0[ks], sbf, ao1, 0, 0, 0); ap1 = __builtin_amdgcn_mfma_f32_16x16x32_bf16(kf0[ks], qf0[ks], ap1, 0, 0, 0); }
                else { ao = __builtin_amdgcn_mfma_f32_16x16x32_bf16(qf0[ks], sbf, ao, 0, 0, 0); ap = __builtin_amdgcn_mfma_f32_16x16x32_bf16(kf0[ks], qf0[ks], ap, 0, 0, 0); } }
            if (IS_GLA) {
#pragma unroll
                for (int ks = 0; ks < NKS; ++ks) { const int c0 = 64 * ks + 16 * q, o1 = (16 + n) * ROWB + (c0 ^ (((n >> 1) & 7) << 4));
                    qf1[ks] = __builtin_bit_cast(bf16x8, *(const LAS u32x4*)(sb + OQ + o1)); kf1[ks] = __builtin_bit_cast(bf16x8, *(const LAS u32x4*)(sb + OK + o1)); }
                CU_FENCE();
            }
            ao = ao + ao1; ap = ap + ap1;
#pragma unroll
            for (int r = 0; r < 4; ++r) if (4 * q + r > n) ap[r] = 0.f;
            const bf16x8 pa = __builtin_bit_cast(bf16x8, (u32x4){cvt_pk_bf16(ap[0], ap[1]), cvt_pk_bf16(ap[2], ap[3]), 0u, 0u});
            ao = __builtin_amdgcn_mfma_f32_16x16x32_bf16(pa, vf8, ao, 0, 0, 0);
#pragma unroll
            for (int r = 0; r < 4; ++r) op[(size_t)(4 * q + r) * OW] = ao[r];
        }
        CU_LDU(0, 0);
        CU_FENCE();
        {
            f32x4 ao = zero, ao1 = zero, ap = zero, ap1 = zero, ax = zero, ax1 = zero;
#pragma unroll
            for (int ks = 0; ks < NKS; ++ks) { const bf16x8 sbf = CU_SBF(ks);
                if (ks & 1) { ao1 = __builtin_amdgcn_mfma_f32_16x16x32_bf16(qf1[ks], sbf, ao1, 0, 0, 0); ax1 = __builtin_amdgcn_mfma_f32_16x16x32_bf16(kf0[ks], qf1[ks], ax1, 0, 0, 0); ap1 = __builtin_amdgcn_mfma_f32_16x16x32_bf16(kf1[ks], qf1[ks], ap1, 0, 0, 0); }
                else { ao = __builtin_amdgcn_mfma_f32_16x16x32_bf16(qf1[ks], sbf, ao, 0, 0, 0); ax = __builtin_amdgcn_mfma_f32_16x16x32_bf16(kf0[ks], qf1[ks], ax, 0, 0, 0); ap = __builtin_amdgcn_mfma_f32_16x16x32_bf16(kf1[ks], qf1[ks], ap, 0, 0, 0); } }
            if (NUG > 1) { CU_LDU(1, 1); CU_FENCE(); }
            ao = ao + ao1; ap = ap + ap1; ax = ax + ax1;
#pragma unroll
            for (int r = 0; r < 4; ++r) if (4 * q + r > n) ap[r] = 0.f;
            const bf16x8 pa = __builtin_bit_cast(bf16x8, (u32x4){cvt_pk_bf16(ax[0], ax[1]), cvt_pk_bf16(ax[2], ax[3]), cvt_pk_bf16(ap[0], ap[1]), cvt_pk_bf16(ap[2], ap[3])});
            ao = __builtin_amdgcn_mfma_f32_16x16x32_bf16(pa, vf8, ao, 0, 0, 0);
#pragma unroll
            for (int r = 0; r < 4; ++r) op[(size_t)(16 + 4 * q + r) * OW] = ao[r];
        }
    } else {
        CU_LDU(0, 0);
        if (NUG > 1) CU_LDU(1, 1);
        CU_FENCE();
    }
#pragma unroll
    for (int g = 0; g < NUG; ++g) {
#pragma unroll
        for (int u = 0; u < UG; ++u) { const int mb = g * UG + u; S[mb] = __builtin_amdgcn_mfma_f32_16x16x32_bf16(ktf[g & 1][u], vf8, S[mb] * dlv[g & 1][u], 0, 0, 0); }
        if (g + 2 < NUG) { CU_LDU(g + 2, g & 1); CU_FENCE(); }
    }
#undef CU_FENCE
#undef CU_LDU
#undef CU_SBF
}
constexpr size_t ST_REC = 98304;
constexpr int NSEG_HG = 4, NSEG_GL = 6, NSEG_MAX = 6;
__device__ __forceinline__ int seg_u0(bool gla, int s) { return gla ? (s <= 2 ? 44 * s : 88 + 42 * (s - 2)) : 64 * s; }
__device__ __forceinline__ int seg_nu(bool gla, int s) { return gla ? (s < 2 ? 44 : 42) : 64; }
template <int DK, int MODE>
__device__ __forceinline__ void chain_item(const GAS unsigned char* blk0, int vt_off, GAS float* op0, GAS unsigned char* st, int seg, int nunits, LAS unsigned char* lds, int wave, int lane) {
    asm volatile("" : "+v"(lane), "+s"(wave));
    constexpr bool IS_GLA = (DK == 192);
    constexpr int BLK = IS_GLA ? GL_BLK : HG_BLK, UNITB = IS_GLA ? GL_SHARED + 8192 : HG_BLK, NMB = DK / 16;
    constexpr int SH0 = MODE == 1 ? 0 : (IS_GLA ? GL_OKT : HG_OKT);
    constexpr int SH_PIECES = (MODE == 1 ? (IS_GLA ? GL_SHARED : HG_BLK) : (IS_GLA ? GL_ODL + 768 - GL_OKT : HG_BLK - HG_OKT)) / 16;
    constexpr int T_PIECES = IS_GLA ? 512 : 0, T_LDS = GL_OVT;
    constexpr int PIECES = SH_PIECES + T_PIECES, NP = (PIECES + 511) / 512;
    constexpr int ODL_ = IS_GLA ? GL_ODL : HG_ODL;
    const int tid = wave * 64 + lane, n = lane & 15, q = lane >> 4;
    f32x4 S[NMB]; float dacc = 1.0f;
#pragma unroll
    for (int mb = 0; mb < NMB; ++mb) S[mb] = (f32x4){0.f, 0.f, 0.f, 0.f};
    if (MODE == 1) {
        for (int s = 0; s < seg; ++s) { const GAS unsigned char* rec = st + (size_t)s * 2 * ST_REC + (size_t)(wave * 64 + lane) * 16;
            f32x4 hh[NMB], dd[NMB];
#pragma unroll
            for (int mb = 0; mb < NMB; ++mb) { hh[mb] = *(const GAS f32x4*)(rec + (size_t)mb * 8192); dd[mb] = *(const GAS f32x4*)(st + (size_t)s * 2 * ST_REC + ST_REC + (16 * mb + 4 * q) * 4); }
            asm volatile("" ::: "memory");
#pragma unroll
            for (int mb = 0; mb < NMB; ++mb) S[mb] = S[mb] * dd[mb] + hh[mb]; }
    }
    u32x4 stgA[NP], stgB[NP];
#define CH_SRC(u, p_) (blk0 + (size_t)(u) * BLK + ((p_) < SH_PIECES ? SH0 + (p_) * 16 : vt_off + ((p_) - SH_PIECES) * 16))
#define CH_DST(p_) ((p_) < SH_PIECES ? SH0 + (p_) * 16 : T_LDS + ((p_) - SH_PIECES) * 16)
#define CH_LOAD(stg, u) do { _Pragma("unroll") for (int r_ = 0; r_ < NP; ++r_) { const int p_ = r_ * 512 + tid; const bool ok_ = (NP * 512 == PIECES) || p_ < PIECES; const int pc_ = ok_ ? p_ : 0; stg[r_] = *(const GAS u32x4*)CH_SRC(u, pc_); } } while (0)
#define CH_STORE(stg, buf) do { _Pragma("unroll") for (int r_ = 0; r_ < NP; ++r_) { const int p_ = r_ * 512 + tid; const bool ok_ = (NP * 512 == PIECES) || p_ < PIECES; const int pc_ = ok_ ? p_ : 0; \
        const int d_ = ok_ ? (buf) * UNITB + CH_DST(pc_) : 2 * UNITB + (p_ - PIECES) * 16; *(LAS u32x4*)(lds + d_) = stg[r_]; } } while (0)
#define CH_SYNC() do { asm volatile("s_waitcnt lgkmcnt(0)" ::: "memory"); __builtin_amdgcn_s_barrier(); asm volatile("" ::: "memory"); } while (0)
    CH_LOAD(stgA, 0); CH_STORE(stgA, 0);
    CH_LOAD(stgA, 1);
    CH_SYNC();
    GAS float* op = op0 + 16 * wave + n;
    for (int u = 0; u < nunits; u += 2) {
        if (u + 2 < nunits) CH_LOAD(stgB, u + 2);
        chain_unit<DK, MODE>(lds, S, op + (size_t)(u * 32) * OW, wave, n, q);
        if (MODE == 0 && tid < DK) dacc *= *(const LAS float*)(lds + ODL_ + 4 * tid);
        CH_STORE(stgA, 1);
        CH_SYNC();
        if (u + 3 < nunits) CH_LOAD(stgA, u + 3);
        chain_unit<DK, MODE>(lds + UNITB, S, op + (size_t)(u * 32 + 32) * OW, wave, n, q);
        if (MODE == 0 && tid < DK) dacc *= *(const LAS float*)(lds + UNITB + ODL_ + 4 * tid);
        if (u + 2 < nunits) CH_STORE(stgB, 0);
        CH_SYNC();
    }
    if (MODE == 0) { GAS unsigned char* rec = st + (size_t)seg * 2 * ST_REC + (size_t)(wave * 64 + lane) * 16;
#pragma unroll
        for (int mb = 0; mb < NMB; ++mb) *(GAS f32x4*)(rec + (size_t)mb * 8192) = S[mb];
        if (tid < DK) *(GAS float*)(st + (size_t)seg * 2 * ST_REC + ST_REC + 4 * tid) = dacc; }
#undef CH_SRC
#undef CH_DST
#undef CH_LOAD
#undef CH_STORE
#undef CH_SYNC
}

template <int MODE>
__device__ __forceinline__ void phase_chain(const Ctx& a, int l, LAS unsigned char* lds, int wave, int lane) {
    const int bx = blockIdx.x, G = gridDim.x;
    constexpr int nhg = 24 * (MODE == 0 ? NSEG_HG - 1 : NSEG_HG), nitems = nhg + 24 * (MODE == 0 ? NSEG_GL - 1 : NSEG_GL);
    for (int it = bx; it < nitems; it += G) {
        const bool gla = it >= nhg; const int j = gla ? it - nhg : it;
        int c = j % 24, seg = j / 24;
        if (gla) { const int x = j & 7, i = j >> 3, sl = i % 3, trip = x + 8 * (i / 3); seg = trip >> 3; c = ((trip >> 2) & 1) * 12 + (trip & 3) * 3 + sl; }
        const int u0 = seg_u0(gla, seg), nu = seg_nu(gla, seg);
        GAS unsigned char* st = a.ws() + WS_ST + (size_t)(gla ? 24 + c : c) * (NSEG_MAX - 1) * 2 * ST_REC;
        if (!gla) { const int b = c / 12, h = c % 12;
            chain_item<128, MODE>(a.ws() + WS_HGB + ((size_t)(b * 12 + h) * NUNIT + u0) * HG_BLK, 0, (GAS float*)(a.ws() + WS_O) + ((size_t)b * SEQ + u0 * 32) * OW + h * 128, st, seg, nu, lds, wave, lane); }
        else { const int b = c / 12, h = (c % 12) / 3, sl = c % 3;
            chain_item<192, MODE>(a.ws() + WS_GLB + ((size_t)(b * 4 + h) * NUNIT + u0) * GL_BLK, GL_OVT + 8192 * sl, (GAS float*)(a.ws() + WS_O) + ((size_t)b * SEQ + u0 * 32) * OW + HGW + h * 384 + sl * 128, st, seg, nu, lds, wave, lane); }
        __syncthreads();
    }
    if (MODE == 0) { for (int it = (G >= nitems + 16) ? bx - nitems : bx; it < 16; it += G) { if (it < 0) continue; s5_scan_item(a, l, it, wave, lane); } }
}
__device__ __forceinline__ float red16(float v) {
    v += __int_as_float(__builtin_amdgcn_mov_dpp(__float_as_int(v), 0xB1, 0xF, 0xF, true)); v += __int_as_float(__builtin_amdgcn_mov_dpp(__float_as_int(v), 0x4E, 0xF, 0xF, true));
    v += __int_as_float(__builtin_amdgcn_mov_dpp(__float_as_int(v), 0x141, 0xF, 0xF, true)); v += __int_as_float(__builtin_amdgcn_mov_dpp(__float_as_int(v), 0x140, 0xF, 0xF, true)); return v; }
__device__ __forceinline__ void phase_finalize(const Ctx& a, int l, int wave, int lane) {
    const GAS bf16_t* P = (const GAS bf16_t*)(a.ws() + WS_P); const GAS float* O = (const GAS float*)(a.ws() + WS_O); GAS bf16_t* MX = (GAS bf16_t*)(a.ws() + WS_MIXED);
    const GAS float* hgg = a.in(I_HGG) + l * HGW; const GAS float* hgb = a.in(I_HGB) + l * HGW; const GAS float* glg = a.in(I_GLG) + l * HGW;
    const int gw = blockIdx.x * 8 + wave, NGW = gridDim.x * 8;
    const bool act = lane < 48;
    f32x4 pg[3][2], pb[3][2], qg[4][2];
#pragma unroll
    for (int it = 0; it < 3; ++it) { const int c = (it * 4 + (lane >> 4)) * 128 + (lane & 15) * 8;
        pg[it][0] = *(const GAS f32x4*)(hgg + c); pg[it][1] = *(const GAS f32x4*)(hgg + c + 4); pb[it][0] = *(const GAS f32x4*)(hgb + c); pb[it][1] = *(const GAS f32x4*)(hgb + c + 4); }
#pragma unroll
    for (int h = 0; h < 4; ++h) { const int c = h * 384 + (act ? lane : 0) * 8; qg[h][0] = *(const GAS f32x4*)(glg + c); qg[h][1] = *(const GAS f32x4*)(glg + c + 4); }
    for (int row = gw; row < MTOK; row += NGW) {
        const GAS float* orow = O + (size_t)row * OW; const GAS bf16_t* prow = P + (size_t)row * INP; GAS bf16_t* mrow = MX + (size_t)row * DM;
        f32x4 o0[7], o1[7]; u32x4 gq[7];
#pragma unroll
        for (int it = 0; it < 3; ++it) { const int c = (it * 4 + (lane >> 4)) * 128 + (lane & 15) * 8;
            o0[it] = *(const GAS f32x4*)(orow + c); o1[it] = *(const GAS f32x4*)(orow + c + 4); gq[it] = *(const GAS u32x4*)(prow + C_GB + c); }
#pragma unroll
        for (int h = 0; h < 4; ++h) { const int c = h * 384 + (act ? lane : 0) * 8;
            o0[3 + h] = *(const GAS f32x4*)(orow + HGW + c); o1[3 + h] = *(const GAS f32x4*)(orow + HGW + c + 4); gq[3 + h] = *(const GAS u32x4*)(prow + C_GC + c); }
        asm volatile("" ::: "memory");
#pragma unroll
        for (int it = 0; it < 3; ++it) { const int c = (it * 4 + (lane >> 4)) * 128 + (lane & 15) * 8; const u32x4 gg = gq[it];
            float v[8] = {sigmoidf_(bf_lo(gg.x)) * o0[it][0], sigmoidf_(bf_hi(gg.x)) * o0[it][1], sigmoidf_(bf_lo(gg.y)) * o0[it][2], sigmoidf_(bf_hi(gg.y)) * o0[it][3],
                          sigmoidf_(bf_lo(gg.z)) * o1[it][0], sigmoidf_(bf_hi(gg.z)) * o1[it][1], sigmoidf_(bf_lo(gg.w)) * o1[it][2], sigmoidf_(bf_hi(gg.w)) * o1[it][3]};
            float s = 0.f, ss = 0.f;
#pragma unroll
            for (int i = 0; i < 8; ++i) { s += v[i]; ss += v[i] * v[i]; }
            s = red16(s); ss = red16(ss);
            const float mu = s * (1.0f / 128.0f), rs = 1.0f / sqrtf(fmaxf(ss * (1.0f / 128.0f) - mu * mu, 0.f) + LN_EPS);
            const f32x4 g0 = pg[it][0], g1 = pg[it][1], b0 = pb[it][0], b1 = pb[it][1];
            u32x4 w; w.x = cvt_pk_bf16((v[0] - mu) * rs * g0[0] + b0[0], (v[1] - mu) * rs * g0[1] + b0[1]); w.y = cvt_pk_bf16((v[2] - mu) * rs * g0[2] + b0[2], (v[3] - mu) * rs * g0[3] + b0[3]);
            w.z = cvt_pk_bf16((v[4] - mu) * rs * g1[0] + b1[0], (v[5] - mu) * rs * g1[1] + b1[1]); w.w = cvt_pk_bf16((v[6] - mu) * rs * g1[2] + b1[2], (v[7] - mu) * rs * g1[3] + b1[3]);
            *(GAS u32x4*)(mrow + S5W + c) = w; }
#pragma unroll
        for (int h = 0; h < 4; ++h) { const int c = h * 384 + lane * 8;
            f32x4 p0 = o0[3 + h], p1 = o1[3 + h]; const u32x4 gg = gq[3 + h];
            if (!act) { p0 = (f32x4){0.f, 0.f, 0.f, 0.f}; p1 = p0; }
            const float ss = wave_sum((p0[0] * p0[0] + p0[1] * p0[1]) + (p0[2] * p0[2] + p0[3] * p0[3]) + (p1[0] * p1[0] + p1[1] * p1[1]) + (p1[2] * p1[2] + p1[3] * p1[3]));
            const float rms = 1.0f / sqrtf(ss * (1.0f / 384.0f) + LN_EPS);
            if (act) { const f32x4 g0 = qg[h][0], g1 = qg[h][1];
                const float z[8] = {bf_lo(gg.x), bf_hi(gg.x), bf_lo(gg.y), bf_hi(gg.y), bf_lo(gg.z), bf_hi(gg.z), bf_lo(gg.w), bf_hi(gg.w)};
                u32x4 w; w.x = cvt_pk_bf16(p0[0] * rms * g0[0] * (z[0] * sigmoidf_(z[0])), p0[1] * rms * g0[1] * (z[1] * sigmoidf_(z[1])));
                w.y = cvt_pk_bf16(p0[2] * rms * g0[2] * (z[2] * sigmoidf_(z[2])), p0[3] * rms * g0[3] * (z[3] * sigmoidf_(z[3])));
                w.z = cvt_pk_bf16(p1[0] * rms * g1[0] * (z[4] * sigmoidf_(z[4])), p1[1] * rms * g1[1] * (z[5] * sigmoidf_(z[5])));
                w.w = cvt_pk_bf16(p1[2] * rms * g1[2] * (z[6] * sigmoidf_(z[6])), p1[3] * rms * g1[3] * (z[7] * sigmoidf_(z[7])));
                *(GAS u32x4*)(mrow + S5W + HGW + c) = w; } }
    }
}

constexpr int PH_PRO = 0, PH_MOD = 1, PH_LN0 = 2, PH_L0 = 3, PH_PER_LAYER = 10, N_PHASES = PH_L0 + DEPTH * PH_PER_LAYER;
constexpr int CW_BAR = 4096;

__global__ void __launch_bounds__(512, 2) hybrid_fwd(Args args) {
    extern __shared__ __attribute__((aligned(16))) unsigned char lds_raw[];
    LAS unsigned char* lds = (LAS unsigned char*)lds_raw;
    const int wave = __builtin_amdgcn_readfirstlane((int)threadIdx.x >> 6);
#define lane lane_id_v()
    volatile LAS unsigned* MISC = (volatile LAS unsigned*)(lds + LDSCTL_OFF);
    Ctx ctx; ctx.t = (volatile LAS unsigned long long*)(lds + LDSCTL_OFF + 64);
    if (wave == 0) { const int ln_ = lane; unsigned long long v = 0ull;
#pragma unroll
        for (int i = 0; i < N_IN; ++i) v = (ln_ == i) ? (unsigned long long)args.in[i] : v;
        v = (ln_ == 30) ? (unsigned long long)args.out : v; v = (ln_ == 31) ? (unsigned long long)args.ws : v;
        if (ln_ < 32) ctx.t[ln_] = v;
        if (ln_ < 16) MISC[ln_] = 0u; }
    __syncthreads();
    const int lo = args.ph_lo, hi = args.ph_hi;
    XcdBarrier bar; bar.bar = (unsigned*)(ctx.ws() + WS_CTL) + CW_BAR; bar.x = 0; bar.st = nullptr; bar.w0 = (wave == 0) ? 1u : 0u;
    if (hi - lo > 1) bar = xcd_barrier_post((unsigned*)(ctx.ws() + WS_CTL) + CW_BAR, MISC + 8, (wave == 0) ? 1u : 0u);
#define IN(k) (lo <= (k) && (k) < hi)
#define OPQ() int ln = lane, wv = wave; asm volatile("" : "+s"(wv))
#define SEAM(k) do { if (IN(k) && IN((k) + 1)) xcd_barrier(bar); } while (0)
#define WSP(T, off) ((GAS T*)(ctx.ws() + (off)))
#define WSG(T, off) ((T*)(ctx.ws() + (off)))

    if (IN(PH_PRO)) { OPQ(); phase_prologue(ctx, lds, wv, ln); }
    SEAM(PH_PRO);
    if (IN(PH_MOD)) { OPQ(); phase_mod(ctx, wv, ln); }
    SEAM(PH_MOD);
    if (IN(PH_LN0)) { OPQ(); phase_h0(ctx.in(I_X), WSP(float, WS_MOD), WSP(bf16_t, WS_H), wv, ln); }
    SEAM(PH_LN0);

    for (int l = 0; l < DEPTH; ++l) {
        const int p0 = PH_L0 + l * PH_PER_LAYER;
        const size_t wto = WS_WT + (size_t)l * WT_LAYER, modo = WS_MOD + (size_t)l * NB * 6 * DM * 4;
        if (IN(p0 + 0)) { pg8::Gemm g{WSG(bf16_t, WS_H), WSG(const bf16_t, wto + WT_IN), MTOK, INP, DM}; pg8::StaticOrder S; S.init(MTOK, INP, (int)gridDim.x, (int)blockIdx.x);
            EpiProj E{WSP(bf16_t, WS_P), WSP(bf16_t, WS_UX)}; pg8::gemm_phase<EpiProj, pg8::StaticOrder, true, true>(lds, g, S, E, wave); }
        SEAM(p0 + 0);
        if (IN(p0 + 1)) {
            { pg8::Gemm g{WSG(bf16_t, WS_UX), WSG(const bf16_t, WS_S5W1 + (size_t)l * S5_W1_LAYER), 64 * 256, 64 * 256, S5K}; S5Order S{(int)gridDim.x, (int)blockIdx.x, 64, 0};
              EpiS5A E{WSP(float, WS_SLOC)}; pg8::gemm_phase<EpiS5A, S5Order, true, true>(lds, g, S, E, wave); }
            { OPQ(); phase_pre(ctx, l, lds, wv, ln); }
            }
        SEAM(p0 + 1);
        if (IN(p0 + 2)) { OPQ(); phase_chain<0>(ctx, l, lds, wv, ln); }
        SEAM(p0 + 2);
        if (IN(p0 + 3)) {
            { pg8::Gemm g{WSG(bf16_t, WS_UX), WSG(const bf16_t, WS_S5T + (size_t)l * S5_T_LAYER), 64 * 256, 64 * 1024, S5K}; S5Order S{(int)gridDim.x, (int)blockIdx.x, 256, 2};
              EpiS5C E{WSP(bf16_t, WS_Z)}; pg8::gemm_phase<EpiS5C, S5Order, true, true>(lds, g, S, E, wave);
            }
            { OPQ(); phase_chain<1>(ctx, l, lds, wv, ln); }
            }
        SEAM(p0 + 3);
        if (IN(p0 + 4)) { pg8::Gemm g{WSG(bf16_t, WS_Z), WSG(const bf16_t, wto + WT_GLU), MTOK, S5W, S5W}; pg8::StaticOrder S; S.init(MTOK, S5W, (int)gridDim.x, (int)blockIdx.x);
            EpiGlu E{WSP(bf16_t, WS_Z), WSP(bf16_t, WS_MIXED), ctx.in(I_GLUB) + l * S5W}; pg8::gemm_phase<EpiGlu, pg8::StaticOrder, true, true>(lds, g, S, E, wave);
            { OPQ(); phase_finalize(ctx, l, wv, ln); } }
        SEAM(p0 + 4);
        if (IN(p0 + 5)) { pg8::Gemm g{WSG(bf16_t, WS_MIXED), WSG(const bf16_t, wto + WT_OUT), MTOK, DM, DM}; pg8::StaticOrder S; S.init(MTOK, DM, (int)gridDim.x, (int)blockIdx.x);
            EpiDelta E{WSP(bf16_t, WS_DELTA), WSP(float, modo) + 2 * DM};
            pg8::gemm_phase<EpiDelta, pg8::StaticOrder, true, true>(lds, g, S, E, wave); }
        SEAM(p0 + 5);
        if (IN(p0 + 6)) { OPQ(); const XRes xa{(GAS unsigned*)ctx.out(), WSP(unsigned, WS_XL)}, xb{l + 1 < DEPTH ? (GAS unsigned*)ctx.out() : WSP(unsigned, WS_WT), WSP(unsigned, WS_XL)};
            if (l == 0) phase_lnres<true, true, false>(ctx.in(I_X), xa, WSP(bf16_t, WS_DELTA), nullptr, xb, ctx.in(I_LN1G) + l * DM, ctx.in(I_LN1B) + l * DM, WSP(float, modo), 3, 4, WSP(bf16_t, WS_H), lds, wv, ln);
            else phase_lnres<true, false, false>(nullptr, xa, WSP(bf16_t, WS_DELTA), nullptr, xb, ctx.in(I_LN1G) + l * DM, ctx.in(I_LN1B) + l * DM, WSP(float, modo), 3, 4, WSP(bf16_t, WS_H), lds, wv, ln); }
        SEAM(p0 + 6);
        if (IN(p0 + 7)) { pg8::Gemm g{WSG(bf16_t, WS_H), WSG(const bf16_t, wto + WT_GU), MTOK, 2 * DFF, DM}; pg8::StaticOrder S; S.init(MTOK, 2 * DFF, (int)gridDim.x, (int)blockIdx.x);
            EpiSwiglu E{WSP(bf16_t, WS_P)}; pg8::gemm_phase<EpiSwiglu, pg8::StaticOrder, true, true>(lds, g, S, E, wave); }
        SEAM(p0 + 7);
        if (IN(p0 + 8)) { pg8::Gemm g{WSG(bf16_t, WS_P), WSG(const bf16_t, wto + WT_DN), MTOK, DM, DFF}; pg8::StaticOrderT<2> S; S.init(MTOK, DM, (int)gridDim.x, (int)blockIdx.x);
            EpiDelta E{WSP(bf16_t, WS_DELTA), WSP(float, modo) + 5 * DM};
            pg8::gemm_phase<EpiDelta, pg8::StaticOrderT<2>, true, true>(lds, g, S, E, wave); }
        SEAM(p0 + 8);
        if (IN(p0 + 9)) { OPQ();
            const XRes xb{l + 1 < DEPTH ? (GAS unsigned*)ctx.out() : WSP(unsigned, WS_WT), WSP(unsigned, WS_XL)};
            if (l + 1 < DEPTH) phase_lnres<true, false, false>(nullptr, xb, WSP(bf16_t, WS_DELTA), nullptr, xb, ctx.in(I_LN2G) + l * DM, ctx.in(I_LN2B) + l * DM, WSP(float, modo) + (size_t)NB * 6 * DM, 0, 1, WSP(bf16_t, WS_H), lds, wv, ln);
            else phase_lnres<false, false, true>(nullptr, xb, WSP(bf16_t, WS_DELTA), ctx.out(), xb, ctx.in(I_LN2G) + l * DM, ctx.in(I_LN2B) + l * DM, nullptr, 0, 0, nullptr, lds, wv, ln);
        }
        SEAM(p0 + 9);
    }
#undef IN
#undef SEAM
#undef OPQ
#undef WSP
#undef WSG
#undef lane
}

extern "C" void kernel_launch(void* const* d_in, const int* in_sizes, int n_in, void* d_out, int out_size, void* d_ws, size_t ws_size, hipStream_t stream) {
    static int grid = 0;
    if (grid == 0) {
        if (n_in != N_IN || out_size != MTOK * DM || ws_size < WS_END) { fprintf(stderr, "kernel_launch: unexpected problem (n_in %d, out %d, ws %zu < %zu); nothing launched\n", n_in, out_size, ws_size, (size_t)WS_END); grid = -1; return; }
        int dev = 0, cus = 0, per_cu = 0;
        if (hipGetDevice(&dev) != hipSuccess || hipDeviceGetAttribute(&cus, hipDeviceAttributeMultiprocessorCount, dev) != hipSuccess) { grid = -1; return; }
        if (hipFuncSetAttribute((const void*)hybrid_fwd, hipFuncAttributeMaxDynamicSharedMemorySize, LDS_BYTES) != hipSuccess) { fprintf(stderr, "kernel_launch: hipFuncSetAttribute failed\n"); grid = -1; return; }
        if (hipOccupancyMaxActiveBlocksPerMultiprocessor(&per_cu, (const void*)hybrid_fwd, 512, LDS_BYTES) != hipSuccess || per_cu < 1) fprintf(stderr, "kernel_launch: occupancy query reports %d blocks per CU\n", per_cu);
        (void)hipGetLastError();
        grid = cus;
    }
    if (grid < 0) return;
    (void)in_sizes;
    if (hipMemsetAsync((char*)d_ws + WS_CTL, 0, CTL_ZERO_BYTES, stream) != hipSuccess) return;
    Args a{};
    for (int i = 0; i < N_IN; ++i) a.in[i] = (const float*)d_in[i];
    a.out = (float*)d_out; a.ws = (unsigned char*)d_ws;
    a.ph_lo = 0; a.ph_hi = N_PHASES; hipLaunchKernelGGL(hybrid_fwd, dim3(grid), dim3(512), LDS_BYTES, stream, a);
}
```
